# Optimizing an MI355X kernel written in HIP

```python
import jax
import jax.numpy as jnp
from jax import lax
import numpy as np

D_MODEL = 1024
BATCH = 32
SEQ = 2048
DEPTH = 2

CHUNK = 64
PLE_DIM = 256
NORM_EPS = 1e-6
N_EVEN = (DEPTH + 1) // 2
N_ODD = DEPTH // 2
A_HEADS = 8
A_HEAD_DIM = 64
A_KV_DIM = 64
A_WIDTH = A_HEADS * A_HEAD_DIM
IDX_HEADS = 4
IDX_DIM = 64
TOPK_MAX = 256
B_HEADS = 8
B_HEAD_DIM = 64
B_WIDTH = B_HEADS * B_HEAD_DIM
DECAY_LORA = 64
AAA_LORA = 64
GATE_LORA = 128
RWKV_GN_EPS = 64e-5
A_COLS = (A_WIDTH, A_KV_DIM, A_KV_DIM, IDX_HEADS * IDX_DIM, IDX_DIM, IDX_HEADS)
B_COLS = (B_WIDTH, B_WIDTH, B_WIDTH, DECAY_LORA, AAA_LORA, GATE_LORA)
A_TOTAL = sum(A_COLS)
B_TOTAL = sum(B_COLS)
MIX_WIDTH = A_WIDTH + B_WIDTH
C_INNER = 2 * D_MODEL
C_HEADS = 4
C_HEAD_DIM = C_INNER // C_HEADS
C_CONV = 4
C_QKV_BLOCK = 4
C_GN_EPS = 1e-5
FFN_HIDDEN = -(-(8 * D_MODEL) // (3 * 256)) * 256

kernel_name = "hybrid_dsa_rwkv7_mlstm_trunk"


def _split_cols(u, sizes):
    cuts = [int(c) for c in np.cumsum(sizes)[:-1]]
    return jnp.split(u, cuts, axis=-1)


def rms_norm(x, g, eps=NORM_EPS):
    xf = x.astype(jnp.float32)
    y = xf * lax.rsqrt(jnp.mean(xf * xf, axis=-1, keepdims=True) + eps)
    return (y * g).astype(x.dtype)


def head_norm(y, eps):
    y = y.astype(jnp.float32)
    mean = jnp.mean(y, axis=-1, keepdims=True)
    var = jnp.mean(jnp.square(y - mean), axis=-1, keepdims=True)
    return (y - mean) * lax.rsqrt(var + eps)


def token_shift(u, mu):
    prev = jnp.pad(u, ((0, 0), (1, 0), (0, 0)))[:, :-1]
    return u + mu * (prev - u)


def dsa_attention(q, k, v, iq, ik, iw, q_gain, k_gain):
    B_, S_ = q.shape[0], q.shape[1]
    n_chunks = S_ // CHUNK
    k_sel = min(TOPK_MAX, S_ // 4)
    q = rms_norm(q, q_gain)
    k = rms_norm(k, k_gain)
    iw = iw * (IDX_HEADS ** -0.5 * IDX_DIM ** -0.5)
    key_pos = jnp.arange(S_)

    def to_chunks(t):
        return jnp.moveaxis(t.reshape((B_, n_chunks, CHUNK) + t.shape[2:]), 1, 0)

    def one_chunk(args):
        c, qc, iqc, iwc = args
        limit = (c + 1) * CHUNK
        logits = jnp.einsum('bthd,bsd->bths', iqc, ik, preferred_element_type=jnp.float32)
        score = jnp.einsum('bth,bths->bts', iwc.astype(jnp.float32), jax.nn.relu(logits))
        score = jnp.where(key_pos[None, None, :] < limit, score, -jnp.inf)
        _, idx = lax.top_k(score, k_sel)
        valid = idx < limit
        kg = jax.vmap(lambda kb, ib: kb[ib])(k, idx)
        vg = jax.vmap(lambda vb, ib: vb[ib])(v, idx)
        s = jnp.einsum('bthd,btjd->bthj', qc, kg, preferred_element_type=jnp.float32) * (A_HEAD_DIM ** -0.5)
        s = jnp.where(valid[:, :, None, :], s, -jnp.inf)
        pr = jax.nn.softmax(s, axis=-1)
        return jnp.einsum('bthj,btjd->bthd', pr.astype(vg.dtype), vg)

    out = lax.map(one_chunk, (jnp.arange(n_chunks), to_chunks(q), to_chunks(iq), to_chunks(iw)))
    return jnp.moveaxis(out, 0, 1).reshape(B_, S_, A_WIDTH)


def rwkv7_time_mix(u, mu, w0, w2, a0, a2, g2, k_k, k_a, r_k, gn_g, gn_b):
    B_, S_ = u.shape[0], u.shape[1]
    u = token_shift(u, mu)
    r, k, v, xw, xa, xg = _split_cols(u, B_COLS)
    w_raw = -jax.nn.softplus(-(w0 + jnp.tanh(xw) @ w2)) - 0.5
    decay = jnp.exp(-jnp.exp(w_raw.astype(jnp.float32)))
    a = jax.nn.sigmoid(a0 + xa @ a2)
    g = jax.nn.sigmoid(xg) @ g2
    heads = lambda t: t.astype(jnp.float32).reshape(B_, S_, B_HEADS, B_HEAD_DIM)
    kk = heads(k * k_k)
    kk = kk / jnp.maximum(jnp.linalg.norm(kk, axis=-1, keepdims=True), 1e-12)
    k = k * (1.0 + (a - 1.0) * k_a)
    r_h, k_h, v_h, a_h, w_h = heads(r), heads(k), heads(v), heads(a), heads(decay)

    def step(state, inp):
        r_t, w_t, k_t, v_t, kk_t, a_t = inp
        sa = jnp.einsum('bhvk,bhk->bhv', state, -kk_t)
        state = (state * w_t[:, :, None, :] + sa[..., None] * (kk_t * a_t)[:, :, None, :]
                 + v_t[..., None] * k_t[:, :, None, :])
        return state, jnp.einsum('bhvk,bhk->bhv', state, r_t)

    xs = tuple(jnp.moveaxis(t, 1, 0) for t in (r_h, w_h, k_h, v_h, kk, a_h))
    state0 = jnp.zeros((B_, B_HEADS, B_HEAD_DIM, B_HEAD_DIM), jnp.float32)
    _, y = lax.scan(step, state0, xs)
    y = jnp.moveaxis(y, 0, 1)
    y = head_norm(y, RWKV_GN_EPS).reshape(B_, S_, B_WIDTH) * gn_g + gn_b
    bonus = jnp.sum(r_h * k_h * r_k, axis=-1, keepdims=True) * v_h
    y = (y + bonus.reshape(B_, S_, B_WIDTH)) * g
    return y.astype(u.dtype)


def mlstm_chunkwise(q, k, v, i_pre, f_pre):
    B_, S_, H, Dh = q.shape
    n_chunks = S_ // CHUNK
    f32 = jnp.float32
    cq = lambda t: t.astype(f32).reshape(B_, n_chunks, CHUNK, H, Dh).transpose(1, 0, 3, 2, 4)
    cg = lambda t: t.astype(f32).reshape(B_, n_chunks, CHUNK, H).transpose(1, 0, 3, 2)
    log_f = jax.nn.log_sigmoid(f_pre.astype(f32))
    tril = jnp.tril(jnp.ones((CHUNK, CHUNK), dtype=bool))

    def step(carry, inp):
        C, nv, m = carry
        qc, kc, vc, ic, lfc = inp
        b = jnp.cumsum(lfc, axis=-1)
        d = b[..., :, None] - b[..., None, :] + ic[..., None, :]
        d = jnp.where(tril, d, -jnp.inf)
        inter = b + m[..., None]
        m_t = jnp.maximum(inter, jnp.max(d, axis=-1))
        wts = jnp.exp(d - m_t[..., None])
        sc = jnp.exp(inter - m_t)
        qk = jnp.einsum('bhtd,bhsd->bhts', qc, kc) * wts
        num = jnp.einsum('bhts,bhsd->bhtd', qk, vc) + sc[..., None] * jnp.einsum('bhtd,bhde->bhte', qc, C)
        den = jnp.sum(qk, axis=-1) + sc * jnp.einsum('bhtd,bhd->bht', qc, nv)
        h = num / jnp.maximum(jnp.abs(den), jnp.exp(-m_t))[..., None]
        b_last = b[..., -1]
        g_s = b_last[..., None] - b + ic
        m_new = jnp.maximum(b_last + m, jnp.max(g_s, axis=-1))
        dc = jnp.exp(b_last + m - m_new)
        ws = jnp.exp(g_s - m_new[..., None])
        C = dc[..., None, None] * C + jnp.einsum('bhs,bhsd,bhse->bhde', ws, kc, vc)
        nv = dc[..., None] * nv + jnp.einsum('bhs,bhsd->bhd', ws, kc)
        return (C, nv, m_new), h

    carry0 = (jnp.zeros((B_, H, Dh, Dh), f32), jnp.zeros((B_, H, Dh), f32), jnp.zeros((B_, H), f32))
    _, hs = lax.scan(step, carry0, (cq(q), cq(k), cq(v), cg(i_pre), cg(log_f)))
    return hs.transpose(1, 0, 3, 2, 4).reshape(B_, S_, H, Dh)


def even_mixer(h, w_in, a_q_gain, a_k_gain, b_mu, b_w0, b_w2, b_a0, b_a2, b_g2, b_k_k, b_k_a,
               b_r_k, b_gn_g, b_gn_b, w_out):
    B_, S_ = h.shape[0], h.shape[1]
    u = h @ w_in
    qa, ka, va, iq, ik, iw = _split_cols(u[..., :A_TOTAL], A_COLS)
    ya = dsa_attention(qa.reshape(B_, S_, A_HEADS, A_HEAD_DIM), ka, va,
                       iq.reshape(B_, S_, IDX_HEADS, IDX_DIM), ik, iw, a_q_gain, a_k_gain)
    yb = rwkv7_time_mix(u[..., A_TOTAL:], b_mu, b_w0, b_w2, b_a0, b_a2, b_g2, b_k_k, b_k_a,
                        b_r_k, b_gn_g, b_gn_b)
    return jnp.concatenate([ya, yb.astype(ya.dtype)], axis=-1) @ w_out


def odd_mixer(h, w_up, conv_w, conv_b, wq, wk, wv, w_if, b_i, b_f, mh_g, skip, w_down):
    B_, S_ = h.shape[0], h.shape[1]
    xm, z = jnp.split(h @ w_up, 2, axis=-1)
    xc = lax.conv_general_dilated(xm, conv_w, (1,), [(C_CONV - 1, 0)],
                                  dimension_numbers=('NWC', 'WIO', 'NWC'),
                                  feature_group_count=C_INNER) + conv_b
    xc = jax.nn.silu(xc)

    def headwise(t, w):
        tb = t.reshape(B_, S_, C_INNER // C_QKV_BLOCK, C_QKV_BLOCK)
        return jnp.einsum('bsgi,gij->bsgj', tb, w).reshape(B_, S_, C_INNER)

    q = headwise(xc, wq)
    k = headwise(xc, wk)
    v = headwise(xm, wv)
    gates = jnp.concatenate([q, k, v], axis=-1) @ w_if
    i_pre = gates[..., :C_HEADS] + b_i
    f_pre = gates[..., C_HEADS:] + b_f
    hh = lambda t: t.reshape(B_, S_, C_HEADS, C_HEAD_DIM)
    y = mlstm_chunkwise(hh(q), hh(k) * (C_HEAD_DIM ** -0.5), hh(v), i_pre, f_pre)
    y = head_norm(y, C_GN_EPS).reshape(B_, S_, C_INNER) * mh_g
    y = (y + skip * xc) * jax.nn.silu(z)
    return y.astype(h.dtype) @ w_down


def swiglu_ffn(x, g, w_gate, w_up, w_down):
    h = rms_norm(x, g)
    return (jax.nn.silu(h @ w_gate) * (h @ w_up)) @ w_down


def per_layer_embedding(x, p_i, w_ple, g, w_gate):
    gate = jax.nn.sigmoid(rms_norm(x, g) @ w_gate)
    return (p_i @ w_ple) * gate


def setup_inputs(seed: int = 0) -> dict:
    key = jax.random.key(seed)
    ks = iter(jax.random.split(key, 40))
    nrm = lambda shape, scale: jax.random.normal(next(ks), shape, jnp.float32) * scale
    gain = lambda shape: 1.0 + 0.02 * jax.random.normal(next(ks), shape, jnp.float32)
    D = D_MODEL
    return {
        'x': nrm((BATCH, SEQ, D), 1.0),
        'p': nrm((DEPTH, BATCH, SEQ, PLE_DIM), 1.0),
        'mix_norm': gain((DEPTH, D)),
        'a_q_gain': gain((N_EVEN, A_HEAD_DIM)),
        'a_k_gain': gain((N_EVEN, A_KV_DIM)),
        'w_in_e': nrm((N_EVEN, D, A_TOTAL + B_TOTAL), D ** -0.5),
        'b_mu': jax.random.uniform(next(ks), (N_EVEN, B_TOTAL), jnp.float32),
        'b_w0': jax.random.uniform(next(ks), (N_EVEN, B_WIDTH), jnp.float32, minval=-5.0, maxval=0.5),
        'b_w2': nrm((N_EVEN, DECAY_LORA, B_WIDTH), 0.1),
        'b_a0': nrm((N_EVEN, B_WIDTH), 0.1),
        'b_a2': nrm((N_EVEN, AAA_LORA, B_WIDTH), 0.5 * AAA_LORA ** -0.5),
        'b_g2': nrm((N_EVEN, GATE_LORA, B_WIDTH), GATE_LORA ** -0.5),
        'b_k_k': 0.85 + 0.02 * jax.random.normal(next(ks), (N_EVEN, B_WIDTH), jnp.float32),
        'b_k_a': gain((N_EVEN, B_WIDTH)),
        'b_r_k': nrm((N_EVEN, B_HEADS, B_HEAD_DIM), 0.1),
        'b_gn_g': gain((N_EVEN, B_WIDTH)),
        'b_gn_b': nrm((N_EVEN, B_WIDTH), 0.01),
        'w_out_e': nrm((N_EVEN, MIX_WIDTH, D), MIX_WIDTH ** -0.5),
        'c_w_up': nrm((N_ODD, D, 2 * C_INNER), D ** -0.5),
        'c_conv_w': nrm((N_ODD, C_CONV, 1, C_INNER), C_CONV ** -0.5),
        'c_conv_b': nrm((N_ODD, C_INNER), 0.01),
        'c_wq': nrm((N_ODD, C_INNER // C_QKV_BLOCK, C_QKV_BLOCK, C_QKV_BLOCK), C_QKV_BLOCK ** -0.5),
        'c_wk': nrm((N_ODD, C_INNER // C_QKV_BLOCK, C_QKV_BLOCK, C_QKV_BLOCK), C_QKV_BLOCK ** -0.5),
        'c_wv': nrm((N_ODD, C_INNER // C_QKV_BLOCK, C_QKV_BLOCK, C_QKV_BLOCK), C_QKV_BLOCK ** -0.5),
        'c_w_if': nrm((N_ODD, 3 * C_INNER, 2 * C_HEADS), 0.5 * (3 * C_INNER) ** -0.5),
        'c_b_i': nrm((N_ODD, C_HEADS), 0.1),
        'c_b_f': jnp.linspace(3.0, 6.0, C_HEADS)[None, :] + nrm((N_ODD, C_HEADS), 0.1),
        'c_mh_g': gain((N_ODD, C_INNER)),
        'c_skip': gain((N_ODD, C_INNER)),
        'c_w_down': nrm((N_ODD, C_INNER, D), C_INNER ** -0.5),
        'ffn_norm': gain((DEPTH, D)),
        'ffn_w_gate': nrm((DEPTH, D, FFN_HIDDEN), D ** -0.5),
        'ffn_w_up': nrm((DEPTH, D, FFN_HIDDEN), D ** -0.5),
        'ffn_w_down': nrm((DEPTH, FFN_HIDDEN, D), FFN_HIDDEN ** -0.5),
        'ple_w': nrm((DEPTH, PLE_DIM, D), PLE_DIM ** -0.5),
        'ple_norm': gain((DEPTH, D)),
        'ple_w_gate': nrm((DEPTH, D, D), D ** -0.5),
    }


def reference(x, p, mix_norm, a_q_gain, a_k_gain, w_in_e, b_mu, b_w0, b_w2, b_a0, b_a2, b_g2,
              b_k_k, b_k_a, b_r_k, b_gn_g, b_gn_b, w_out_e, c_w_up, c_conv_w, c_conv_b, c_wq,
              c_wk, c_wv, c_w_if, c_b_i, c_b_f, c_mh_g, c_skip, c_w_down, ffn_norm, ffn_w_gate,
              ffn_w_up, ffn_w_down, ple_w, ple_norm, ple_w_gate):
    for i in range(DEPTH):
        j = i // 2
        h = rms_norm(x, mix_norm[i])
        if i % 2 == 0:
            x = x + even_mixer(h, w_in_e[j], a_q_gain[j], a_k_gain[j], b_mu[j], b_w0[j], b_w2[j],
                               b_a0[j], b_a2[j], b_g2[j], b_k_k[j], b_k_a[j], b_r_k[j],
                               b_gn_g[j], b_gn_b[j], w_out_e[j])
        else:
            x = x + odd_mixer(h, c_w_up[j], c_conv_w[j], c_conv_b[j], c_wq[j], c_wk[j], c_wv[j],
                              c_w_if[j], c_b_i[j], c_b_f[j], c_mh_g[j], c_skip[j], c_w_down[j])
        x = x + swiglu_ffn(x, ffn_norm[i], ffn_w_gate[i], ffn_w_up[i], ffn_w_down[i])
        x = x + per_layer_embedding(x, p[i], ple_w[i], ple_norm[i], ple_w_gate[i])
    return x
```

```cpp
#include <hip/hip_runtime.h>
#include <cstdio>
#include <cstdint>
namespace pg8 {
#define PG8_LAS __attribute__((address_space(3)))
typedef unsigned short bf16_t;
typedef short bf16x8 __attribute__((ext_vector_type(8)));
typedef float f32x4 __attribute__((ext_vector_type(4)));
typedef unsigned u32x4 __attribute__((ext_vector_type(4)));
constexpr int BM = 256, BK = 64, HALF = 128, HTB = HALF * BK * 2  , STAGE_BYTES = 8 * HTB, NXCD = 8, WGM = 8;

__host__ __device__ __forceinline__ int lds_byte(int r, int c) { const int st = (r >> 4) * 2 + (c >> 5), rr = r & 15, cc = c & 31, ob = rr * 64 + cc * 2; return st * 1024 + (ob ^ (((ob >> 9) & 1) << 5)); }
__host__ __device__ __forceinline__ void stage_rc(int b, int& R, int& C) { const int st = b / 1024, sb = b % 1024, swz = sb ^ (((sb >> 9) & 1) << 5); R = (st >> 1) * 16 + swz / 64; C = (st & 1) * 32 + (swz % 64) / 2; }
__host__ __device__ __forceinline__ int perm32(int rho) { const int n = rho >> 4, i = rho & 15; return 8 * (i >> 2) + 4 * n + (i & 3); }

struct Unit { int pm, pn; };
struct Gemm { const bf16_t* A; const bf16_t* Bt; int M, N, K; };

struct StaticOrder {
    int nM, nN, nwg, G, c;
    __host__ __device__ void init(int M, int N, int G_, int c_) { nM = M / BM; nN = N / BM; nwg = nM * nN; G = G_; c = c_; }
    __host__ __device__ bool next(int i, Unit& u) const {
        const long L = (long)i * G + c; if (L >= nwg) return false;
        int wgid = (int)L; { const int q = nwg / NXCD, r = nwg % NXCD, xcd = wgid % NXCD, off = wgid / NXCD; wgid = (xcd < r ? xcd * (q + 1) : r * (q + 1) + (xcd - r) * q) + off; }
        const int nig = WGM * nN, gid = wgid / nig, fm = gid * WGM, gsz = (nM - fm) < WGM ? (nM - fm) : WGM;
        u.pm = fm + ((wgid % nig) % gsz); u.pn = (wgid % nig) / gsz; return true;
    }
    __device__ __forceinline__ void a_ready(const Unit&) const {}
    __device__ __forceinline__ void done(const Unit&) const {}
};

__device__ __forceinline__ unsigned cvt_pk_bf16(float lo, float hi) { unsigned r; asm volatile("v_cvt_pk_bf16_f32 %0, %1, %2" : "=v"(r) : "v"(lo), "v"(hi)); return r; }
typedef float f32x2 __attribute__((ext_vector_type(2)));
__device__ __forceinline__ f32x2 gelu_pk(f32x2 v) {
    const f32x2 av = __builtin_elementwise_abs(v), d = av * 0.2316418882f + 1.0f;
    f32x2 t; t.x = __builtin_amdgcn_rcpf(d.x); t.y = __builtin_amdgcn_rcpf(d.y);
    f32x2 q = t * 0.5307027145f + (-0.7265760135f); q = q * t + 0.7107068705f; q = q * t + (-0.142248368f); q = q * t + 0.127414796f; q = q * t;
    const f32x2 s = (v * v) * (-0.72134752044f);
    f32x2 e; e.x = __builtin_amdgcn_exp2f(s.x); e.y = __builtin_amdgcn_exp2f(s.y);
    const f32x2 m = v * (q * e), r = v - m;
    f32x2 o; o.x = v.x < 0.f ? m.x : r.x; o.y = v.y < 0.f ? m.y : r.y; return o;
}

template <class Epi, class Sched, bool ALIGN_EPI = false, bool SP2 = false>
__device__ __forceinline__ void gemm_phase(PG8_LAS unsigned char* lds, const Gemm g, const Sched& S, const Epi& E) {
    const int tid = threadIdx.x, wid = __builtin_amdgcn_readfirstlane(tid >> 6), lane = tid & 63, wr = wid >> 2, wc = wid & 3, fr = lane & 15, fq = lane >> 4;
    const int K = g.K, nt = K / BK;
    unsigned voffA[2], voffB[2];
#pragma unroll
    for (int i = 0; i < 2; ++i) { int R, C; stage_rc(tid * 16 + i * 8192, R, C); const int Rb = Epi::PERM ? ((R & ~31) + perm32(R & 31)) : R;
        voffA[i] = (unsigned)(R * K + C) * 2u; voffB[i] = (unsigned)(Rb * K + C) * 2u; }
    const size_t kstep = (size_t)(BK * 2);
    const size_t hstep = (size_t)HALF * K * 2;
    const size_t tstep = 2 * hstep;
    const unsigned ldsw = (unsigned)wid * 1024u;
    const int aoff = lds_byte(wr * 64 + fr, fq * 8), boff = lds_byte(wc * 32 + fr, fq * 8);
#define PG8_SA(b, h) (((b) * 2 + (h)) * HTB)
#define PG8_SB(b, h) ((4 + (b) * 2 + (h)) * HTB)
#define PG8_STAGE(bufoff, gbase, voff) do { _Pragma("unroll") for (int _i = 0; _i < 2; ++_i) \
        __builtin_amdgcn_global_load_lds((const unsigned*)((const char*)(gbase) + (voff)[_i]), (PG8_LAS unsigned*)(lds + (bufoff) + ldsw + _i * 8192), 16, 0, 0); } while (0)
#define PG8_LDA(dst, b, h) do { _Pragma("unroll") for (int m = 0; m < 4; ++m) _Pragma("unroll") for (int k = 0; k < 2; ++k) dst[m][k] = *(const PG8_LAS bf16x8*)(lds + PG8_SA(b, h) + aoff + m * 2048 + k * 1024); } while (0)
#define PG8_LDB(dst, b, h) do { _Pragma("unroll") for (int n = 0; n < 2; ++n) _Pragma("unroll") for (int k = 0; k < 2; ++k) dst[n][k] = *(const PG8_LAS bf16x8*)(lds + PG8_SB(b, h) + boff + n * 2048 + k * 1024); } while (0)
#define PG8_MMA(ai, bj, At, Bt) do { __builtin_amdgcn_s_setprio(1); _Pragma("unroll") for (int m = 0; m < 4; ++m) _Pragma("unroll") for (int n = 0; n < 2; ++n) _Pragma("unroll") for (int k = 0; k < 2; ++k) \
        acc[ai][bj][m][n] = __builtin_amdgcn_mfma_f32_16x16x32_bf16(Bt[n][k], At[m][k], acc[ai][bj][m][n], 0, 0, 0); __builtin_amdgcn_s_setprio(0); } while (0)
#define PG8_WAIT_V(n) asm volatile("s_waitcnt vmcnt(" #n ")" ::: "memory")
#define PG8_WAIT_L(n) asm volatile("s_waitcnt lgkmcnt(" #n ")" ::: "memory")
#define PG8_BAR __builtin_amdgcn_s_barrier()
#define PG8_SCHED __builtin_amdgcn_sched_barrier(0)
    Unit cur, nxt; int ui = 0;
    if (!S.next(0, cur)) return;
    f32x4 acc[2][2][4][2];
#pragma unroll
    for (int a = 0; a < 2; ++a)
#pragma unroll
        for (int b = 0; b < 2; ++b)
#pragma unroll
            for (int m = 0; m < 4; ++m)
#pragma unroll
                for (int n = 0; n < 2; ++n) acc[a][b][m][n] = (f32x4){0.f, 0.f, 0.f, 0.f};
    bf16x8 At[4][2], B0[2][2], B1[2][2];
    const char* cA = (const char*)g.A + (size_t)cur.pm * tstep; const char* cB = (const char*)g.Bt + (size_t)cur.pn * tstep;
    S.a_ready(cur);
    if constexpr (SP2) {
        PG8_STAGE(PG8_SB(0, 0), cB, voffB); PG8_STAGE(PG8_SB(0, 1), cB + hstep, voffB); PG8_STAGE(PG8_SA(0, 0), cA, voffA); PG8_STAGE(PG8_SA(0, 1), cA + hstep, voffA);
        if (wr == 1) PG8_BAR;
        PG8_WAIT_V(2); PG8_BAR;
        PG8_STAGE(PG8_SB(1, 0), cB + kstep, voffB); PG8_STAGE(PG8_SA(1, 0), cA + kstep, voffA); PG8_STAGE(PG8_SB(1, 1), cB + hstep + kstep, voffB);
        PG8_WAIT_V(6); PG8_BAR;
    } else {
        PG8_STAGE(PG8_SB(0, 0), cB, voffB); PG8_STAGE(PG8_SA(0, 0), cA, voffA); PG8_STAGE(PG8_SB(0, 1), cB + hstep, voffB); PG8_STAGE(PG8_SA(0, 1), cA + hstep, voffA);
        if (wr == 1) PG8_BAR;
        PG8_WAIT_V(4); PG8_BAR;
        PG8_STAGE(PG8_SB(1, 0), cB + kstep, voffB); PG8_STAGE(PG8_SA(1, 0), cA + kstep, voffA); PG8_STAGE(PG8_SB(1, 1), cB + hstep + kstep, voffB);
        PG8_WAIT_V(6); PG8_BAR;
    }
    for (;;) {
        const bool has_next = S.next(ui + 1, nxt);
        const char* nA = has_next ? (const char*)g.A + (size_t)nxt.pm * tstep : cA; const char* nB = has_next ? (const char*)g.Bt + (size_t)nxt.pn * tstep : cB;
        for (int t = 0; t < nt; t += 2) {
            const bool last = (t == nt - 2);
            const char* a1 = cA + (size_t)(t + 1) * kstep;
            const char* a2 = last ? nA : cA + (size_t)(t + 2) * kstep; const char* b2 = last ? nB : cB + (size_t)(t + 2) * kstep;
            const char* a3 = a2 + kstep; const char* b3 = b2 + kstep;
            if (last && has_next) S.a_ready(nxt);
            if constexpr (SP2) {
            PG8_LDB(B0, 0, 0); PG8_LDB(B1, 0, 1); PG8_SCHED; PG8_LDA(At, 0, 0); PG8_STAGE(PG8_SA(1, 1), a1 + hstep, voffA);
            PG8_WAIT_V(8); PG8_WAIT_L(0); PG8_BAR; PG8_MMA(0, 0, At, B0); PG8_MMA(0, 1, At, B1); PG8_BAR; PG8_SCHED;
            PG8_LDA(At, 0, 1); PG8_STAGE(PG8_SB(0, 0), b2, voffB); PG8_STAGE(PG8_SB(0, 1), b2 + hstep, voffB); PG8_STAGE(PG8_SA(0, 0), a2, voffA);
            PG8_WAIT_V(8); PG8_WAIT_L(0); PG8_BAR; PG8_MMA(1, 0, At, B0); PG8_MMA(1, 1, At, B1); PG8_BAR; PG8_SCHED;
            PG8_LDB(B0, 1, 0); PG8_LDB(B1, 1, 1); PG8_SCHED; PG8_LDA(At, 1, 0); PG8_STAGE(PG8_SA(0, 1), a2 + hstep, voffA);
            PG8_WAIT_V(8); PG8_WAIT_L(0); PG8_BAR; PG8_MMA(0, 0, At, B0); PG8_MMA(0, 1, At, B1); PG8_BAR; PG8_SCHED;
            PG8_LDA(At, 1, 1); PG8_STAGE(PG8_SB(1, 0), b3, voffB); PG8_STAGE(PG8_SB(1, 1), b3 + hstep, voffB); PG8_STAGE(PG8_SA(1, 0), a3, voffA);
            PG8_WAIT_V(8); PG8_WAIT_L(0); PG8_BAR; PG8_MMA(1, 0, At, B0); PG8_MMA(1, 1, At, B1); PG8_BAR; PG8_SCHED;
            } else {
            PG8_LDB(B0, 0, 0); PG8_SCHED; PG8_LDA(At, 0, 0); PG8_STAGE(PG8_SA(1, 1), a1 + hstep, voffA);
            PG8_WAIT_L(8); PG8_BAR; PG8_WAIT_L(0); PG8_MMA(0, 0, At, B0); PG8_BAR; PG8_SCHED;
            PG8_LDB(B1, 0, 1); PG8_STAGE(PG8_SB(0, 0), b2, voffB);
            PG8_BAR; PG8_WAIT_L(0); PG8_MMA(0, 1, At, B1); PG8_BAR;
            PG8_LDA(At, 0, 1); PG8_STAGE(PG8_SA(0, 0), a2, voffA);
            PG8_BAR; PG8_WAIT_L(0); PG8_MMA(1, 0, At, B0); PG8_BAR; PG8_SCHED;
            PG8_STAGE(PG8_SB(0, 1), b2 + hstep, voffB);
            PG8_WAIT_V(6); PG8_BAR; PG8_MMA(1, 1, At, B1); PG8_BAR;
            PG8_LDB(B0, 1, 0); PG8_SCHED; PG8_LDA(At, 1, 0); PG8_STAGE(PG8_SA(0, 1), a2 + hstep, voffA);
            PG8_WAIT_L(8); PG8_BAR; PG8_WAIT_L(0); PG8_MMA(0, 0, At, B0); PG8_BAR; PG8_SCHED;
            PG8_LDB(B1, 1, 1); PG8_STAGE(PG8_SB(1, 0), b3, voffB);
            PG8_BAR; PG8_WAIT_L(0); PG8_MMA(0, 1, At, B1); PG8_BAR;
            PG8_LDA(At, 1, 1); PG8_STAGE(PG8_SA(1, 0), a3, voffA);
            PG8_BAR; PG8_WAIT_L(0); PG8_MMA(1, 0, At, B0); PG8_BAR; PG8_SCHED;
            PG8_STAGE(PG8_SB(1, 1), b3 + hstep, voffB);
            PG8_WAIT_V(6); PG8_BAR; PG8_MMA(1, 1, At, B1); PG8_BAR;
            }
        }
        if constexpr (ALIGN_EPI) { if (wr == 0) PG8_BAR; }
        if constexpr (!Epi::AFTER_DRAIN) { E(acc, cur, wr, wc, fr, fq); S.done(cur); }
        if (!has_next) break;
#pragma unroll
        for (int a = 0; a < 2; ++a)
#pragma unroll
            for (int b = 0; b < 2; ++b)
#pragma unroll
                for (int m = 0; m < 4; ++m)
#pragma unroll
                    for (int n = 0; n < 2; ++n) acc[a][b][m][n] = (f32x4){0.f, 0.f, 0.f, 0.f};
        cur = nxt; cA = nA; cB = nB; ++ui;
        if constexpr (ALIGN_EPI) { if (wr == 1) PG8_BAR; }
    }
    PG8_WAIT_V(0);
    if constexpr (!ALIGN_EPI) { if (wr == 0) PG8_BAR; }
    PG8_BAR;
    if constexpr (Epi::AFTER_DRAIN) { E.fused(acc, cur, wr, wc, fr, fq, lds, wid, lane); S.done(cur); }
#undef PG8_SA
#undef PG8_SB
#undef PG8_STAGE
#undef PG8_LDA
#undef PG8_LDB
#undef PG8_MMA
#undef PG8_WAIT_V
#undef PG8_WAIT_L
#undef PG8_BAR
#undef PG8_SCHED
}
}
namespace pg8 {
__device__ __forceinline__ float sigmoidf_(float x) { return __builtin_amdgcn_rcpf(1.0f + __builtin_amdgcn_exp2f(-1.4426950408889634f * x)); }
struct EpiBf16Split {
    static constexpr bool PERM = true, AFTER_DRAIN = false;
    bf16_t* O0; int ld0; int nt0; bf16_t* O1; int ld1;
    __device__ __forceinline__ void operator()(const f32x4 (&acc)[2][2][4][2], const Unit& u, int wr, int wc, int fr, int fq) const {
        const bool first = u.pn < nt0; bf16_t* base = first ? O0 : O1; const int ld = first ? ld0 : ld1; const int colt = (first ? u.pn : u.pn - nt0) * BM;
        const int row0 = u.pm * BM + wr * 64 + fr, col0 = colt + wc * 32 + 8 * fq;
#pragma unroll
        for (int ai = 0; ai < 2; ++ai)
#pragma unroll
            for (int m = 0; m < 4; ++m) { bf16_t* rowp = base + (size_t)(row0 + ai * HALF + m * 16) * ld + col0;
#pragma unroll
                for (int bj = 0; bj < 2; ++bj) { const f32x4 v0 = acc[ai][bj][m][0], v1 = acc[ai][bj][m][1];
                    u32x4 w; w.x = cvt_pk_bf16(v0[0], v0[1]); w.y = cvt_pk_bf16(v0[2], v0[3]); w.z = cvt_pk_bf16(v1[0], v1[1]); w.w = cvt_pk_bf16(v1[2], v1[3]);
                    *(u32x4*)(rowp + bj * HALF) = w; } }
    }
};
struct EpiResF32 {
    static constexpr bool PERM = false, AFTER_DRAIN = false;
    const float* base; float* out; int ldc;
    __device__ __forceinline__ void operator()(const f32x4 (&acc)[2][2][4][2], const Unit& u, int wr, int wc, int fr, int fq) const {
        const int row0 = u.pm * BM + wr * 64 + fr, col0 = u.pn * BM + wc * 32 + 4 * fq;
#pragma unroll
        for (int ai = 0; ai < 2; ++ai)
#pragma unroll
            for (int m = 0; m < 4; ++m) { const size_t off = (size_t)(row0 + ai * HALF + m * 16) * ldc + col0;
#pragma unroll
                for (int bj = 0; bj < 2; ++bj)
#pragma unroll
                    for (int n = 0; n < 2; ++n) { const f32x4 b = *(const f32x4*)(base + off + bj * HALF + n * 16); *(f32x4*)(out + off + bj * HALF + n * 16) = b + acc[ai][bj][m][n]; } }
    }
};
struct EpiSwiglu {
    static constexpr bool PERM = false, AFTER_DRAIN = false;
    bf16_t* H; int ldh;
    __device__ __forceinline__ void operator()(const f32x4 (&acc)[2][2][4][2], const Unit& u, int wr, int wc, int fr, int fq) const {
        const int row0 = u.pm * BM + wr * 64 + fr, hc0 = u.pn * (BM / 2) + wc * 16 + 4 * fq;
#pragma unroll
        for (int ai = 0; ai < 2; ++ai)
#pragma unroll
            for (int m = 0; m < 4; ++m) { bf16_t* rowp = H + (size_t)(row0 + ai * HALF + m * 16) * ldh + hc0;
#pragma unroll
                for (int bj = 0; bj < 2; ++bj) { const f32x4 g = acc[ai][bj][m][0], up = acc[ai][bj][m][1]; float h[4];
#pragma unroll
                    for (int i = 0; i < 4; ++i) h[i] = g[i] * sigmoidf_(g[i]) * up[i];
                    typedef unsigned u32x2 __attribute__((ext_vector_type(2)));
                    u32x2 w; w.x = cvt_pk_bf16(h[0], h[1]); w.y = cvt_pk_bf16(h[2], h[3]);
                    *(u32x2*)(rowp + bj * (HALF / 2)) = w; } }
    }
};
struct EpiPle {
    static constexpr bool PERM = false, AFTER_DRAIN = false;
    const float* base; float* out; const bf16_t* E; int ldc;
    __device__ __forceinline__ void operator()(const f32x4 (&acc)[2][2][4][2], const Unit& u, int wr, int wc, int fr, int fq) const {
        const int row0 = u.pm * BM + wr * 64 + fr, col0 = u.pn * BM + wc * 32 + 4 * fq;
        typedef unsigned u32x2 __attribute__((ext_vector_type(2)));
#pragma unroll
        for (int ai = 0; ai < 2; ++ai)
#pragma unroll
            for (int m = 0; m < 4; ++m) { const size_t off = (size_t)(row0 + ai * HALF + m * 16) * ldc + col0;
#pragma unroll
                for (int bj = 0; bj < 2; ++bj)
#pragma unroll
                    for (int n = 0; n < 2; ++n) { const size_t o = off + bj * HALF + n * 16; const f32x4 b = *(const f32x4*)(base + o); const u32x2 e = *(const u32x2*)(E + o); const f32x4 a = acc[ai][bj][m][n];
                        f32x4 r; r[0] = b[0] + __uint_as_float(e.x << 16) * sigmoidf_(a[0]); r[1] = b[1] + __uint_as_float(e.x & 0xffff0000u) * sigmoidf_(a[1]);
                        r[2] = b[2] + __uint_as_float(e.y << 16) * sigmoidf_(a[2]); r[3] = b[3] + __uint_as_float(e.y & 0xffff0000u) * sigmoidf_(a[3]);
                        *(f32x4*)(out + o) = r; } }
    }
};
}
#ifndef PG8_SP2
#define PG8_SP2 true
#endif
#ifndef PG8_ALIGN
#define PG8_ALIGN true
#endif
constexpr int NB = 32, SEQ = 2048, T = NB * SEQ, D = 1024;
constexpr int NU = 2816, UA_W = 1024, UB_W = 1792;
constexpr int FF = 2816, CI = 2048, TH = T / 2;
constexpr int NWAVES = 8;
constexpr float NORM_EPS = 1e-6f, LOG2E = 1.4426950408889634f;
constexpr int UA_K = 512, UA_V = 576, UA_IQ = 640, UA_IK = 896, UA_IW = 960;
constexpr size_t MiB = 1u << 20, QMiB = 1u << 18;
constexpr size_t WS_CTL = 0, CTL_ZERO_BYTES = 1 * MiB;
constexpr size_t WS_WIN = 4 * QMiB, WS_WLORA = 26 * QMiB, WS_WOUT = 29 * QMiB;
constexpr size_t WS_WGU0 = 37 * QMiB, WS_WD0 = 81 * QMiB, WS_WPLE0 = 103 * QMiB, WS_WPG0 = 105 * QMiB, WS_LAYER_STRIDE = 76 * QMiB;
constexpr size_t WS_WUP = 189 * QMiB, WS_WDOWN = 221 * QMiB, WS_W12 = 237 * QMiB;
static_assert(WS_WPG0 + 8 * QMiB == WS_WGU0 + WS_LAYER_STRIDE && WS_WPG0 + WS_LAYER_STRIDE + 8 * QMiB == WS_WUP && WS_W12 + QMiB <= 60 * MiB, "weight map");
constexpr size_t ACT = 60 * MiB;
constexpr size_t WS_XB = ACT, WS_UA = ACT + 128 * MiB, WS_UB = ACT + 256 * MiB, WS_LIN = ACT + 480 * MiB, WS_LOUT = ACT + 512 * MiB;
constexpr size_t WS_QN = ACT + 704 * MiB, WS_KN = ACT + 768 * MiB, WS_VT = ACT + 776 * MiB, WS_MASK = ACT + 784 * MiB, WS_SCR = ACT + 800 * MiB;
constexpr size_t WS_H = ACT + 128 * MiB, WS_E = ACT + 480 * MiB, WS_PB = ACT + 608 * MiB;
constexpr size_t WS_XBH = ACT, WS_XM = ACT + 64 * MiB, WS_Z = ACT + 192 * MiB, WS_XC = ACT + 320 * MiB, WS_Q = ACT + 448 * MiB, WS_K = ACT + 576 * MiB, WS_V = ACT + 704 * MiB;
constexpr size_t WS_GI = ACT + 832 * MiB, WS_GA = WS_GI + 1 * MiB, WS_GAM = WS_GI + 2 * MiB, WS_GEM = WS_GI + 3 * MiB;
constexpr size_t WS_END = ACT + 961 * MiB;
static_assert(WS_END <= 1024 * MiB, "workspace");
constexpr int CW_TMO = 0, CW_BAR = 4096;
constexpr int LDS_BYTES = 155648;
constexpr int MISC_OFF = LDS_BYTES - 256;
#define GAS __attribute__((address_space(1)))
#define LAS __attribute__((address_space(3)))
typedef unsigned short bf16;
typedef unsigned v4u __attribute__((ext_vector_type(4)));
typedef unsigned v2u __attribute__((ext_vector_type(2)));
typedef float f32x4 __attribute__((ext_vector_type(4)));
typedef float f32x2 __attribute__((ext_vector_type(2)));
typedef float f32x8 __attribute__((ext_vector_type(8)));
typedef short bf16x8 __attribute__((ext_vector_type(8)));
typedef short s16x4 __attribute__((ext_vector_type(4)));
typedef GAS unsigned gu32;
#define RLX_AGENT __ATOMIC_RELAXED, __HIP_MEMORY_SCOPE_AGENT
#define LDS_WAIT() asm volatile("s_waitcnt lgkmcnt(0)" ::: "memory")
#define VM_WAIT() asm volatile("s_waitcnt vmcnt(0)" ::: "memory")
__device__ __forceinline__ unsigned f2bf(float f) { unsigned u = __builtin_bit_cast(unsigned, f); return (u + 0x7fffu + ((u >> 16) & 1u)) >> 16; }

#define XB_TMO      128
#define XB_XCNT(j)  (256  + 64 * (j))
#define XB_XSUB(j)  (1280 + 64 * (j))
#define XB_XGEN(j)  (2304 + 64 * (j))
#define XB_TOP      3328
#define XB_TOPGEN   3392
#define XCD_BAR_WORDS 3456
#define XB_SPIN_CAP (1u << 18)

__device__ __forceinline__ unsigned xb_ld(unsigned* p)              { return __hip_atomic_load(p, __ATOMIC_RELAXED, __HIP_MEMORY_SCOPE_AGENT); }
__device__ __forceinline__ unsigned xb_add(unsigned* p, unsigned v) { return __hip_atomic_fetch_add(p, v, __ATOMIC_RELAXED, __HIP_MEMORY_SCOPE_AGENT); }
__device__ __forceinline__ unsigned xb_xcc_id() { return (unsigned)__builtin_amdgcn_s_getreg((3 << 11) | 20) & 0xFu; }
#define XB_SPIN(cond, bar) do { unsigned _sp = 0; while (cond) { __builtin_amdgcn_s_sleep(1); \
    if ((++_sp & 255u) == 0u) { if (xb_ld(&(bar)[XB_TMO])) break; if (_sp > XB_SPIN_CAP) { atomicAdd(&(bar)[XB_TMO], 1u); break; } } } } while (0)

struct XcdBarrier {
    unsigned* bar; unsigned x;
    volatile LAS unsigned* st;
};

__device__ __forceinline__ XcdBarrier xcd_barrier_post(unsigned* bar, volatile LAS unsigned* st) {
    XcdBarrier b; b.bar = bar; b.x = xb_xcc_id(); b.st = st;
    if (threadIdx.x == 0) (void)xb_add(&bar[XB_XCNT(b.x)], 1u);
    return b;
}
__device__ __forceinline__ void xcd_barrier_complete(unsigned* bar, unsigned x, unsigned& nloc, unsigned& nx) {
    const unsigned G = gridDim.x * gridDim.y * gridDim.z;
    unsigned sum, cnt, mine, sp = 0u;
    for (;;) {
        sum = 0u; cnt = 0u; mine = 0u;
#pragma unroll
        for (unsigned j = 0; j < 16; ++j) { const unsigned c = xb_ld(&bar[XB_XCNT(j)]); sum += c; cnt += (c > 0u) ? 1u : 0u; mine = (j == x) ? c : mine; }
        if (sum == G) break;
        __builtin_amdgcn_s_sleep(1);
        if ((++sp & 255u) == 0u) { if (xb_ld(&bar[XB_TMO])) break; if (sp > XB_SPIN_CAP) { atomicAdd(&bar[XB_TMO], 1u); break; } }
    }
    nloc = mine > 0u ? mine : 1u; nx = cnt > 0u ? cnt : 1u;
}

__device__ __forceinline__ void xcd_barrier(const XcdBarrier& b) {
    asm volatile("s_waitcnt vmcnt(0)" ::: "memory");
    __syncthreads();
    if (threadIdx.x == 0) {
        unsigned* bar = b.bar;
        __builtin_amdgcn_s_waitcnt(0);
        unsigned nloc = b.st[0], nx = b.st[1];
        if (nloc == 0u) { xcd_barrier_complete(bar, b.x, nloc, nx); b.st[0] = nloc; b.st[1] = nx; }
        const unsigned old = xb_add(&bar[XB_XSUB(b.x)], 1u);
        const unsigned gen = old / nloc;
        if (old + 1u == (gen + 1u) * nloc) {
            __builtin_amdgcn_fence(__ATOMIC_RELEASE, "agent");
            asm volatile("s_waitcnt vmcnt(0)" ::: "memory");
            const unsigned og = xb_add(&bar[XB_TOP], 1u);
            const unsigned tg = og / nx;
            if (og + 1u == (tg + 1u) * nx) xb_add(&bar[XB_TOPGEN], 1u);
            else XB_SPIN(xb_ld(&bar[XB_TOPGEN]) == tg, bar);
            __builtin_amdgcn_fence(__ATOMIC_ACQUIRE, "agent");
            xb_add(&bar[XB_XGEN(b.x)], 1u);
            asm volatile("s_waitcnt vmcnt(0)" ::: "memory");
        } else {
            XB_SPIN(xb_ld(&bar[XB_XGEN(b.x)]) == gen, bar);
            __builtin_amdgcn_fence(__ATOMIC_ACQUIRE, "agent");
            asm volatile("s_waitcnt vmcnt(0)" ::: "memory");
        }
    }
    __syncthreads();
}

struct Frame {
    LAS unsigned char* lds;
    unsigned char* ws;
    const float* const* in;
    int tid, lane, wave, G, bid;
};
struct Args { const float* in[37]; float* out; unsigned char* ws; int ph_lo, ph_hi, use_bar, pad; };

__device__ __forceinline__ float wave_sum(float v) {
#pragma unroll
    for (int o = 1; o < 64; o <<= 1) v += __shfl_xor(v, o);
    return v;
}
__device__ __forceinline__ float wave_max(float v) {
#pragma unroll
    for (int o = 1; o < 64; o <<= 1) v = fmaxf(v, __shfl_xor(v, o));
    return v;
}
__device__ __forceinline__ float bflo(unsigned u) { return __uint_as_float(u << 16); }
__device__ __forceinline__ float bfhi(unsigned u) { return __uint_as_float(u & 0xffff0000u); }
__device__ __forceinline__ float bf1(bf16 h) { return __uint_as_float(((unsigned)h) << 16); }
__device__ __forceinline__ unsigned pk2(float lo, float hi) { return pg8::cvt_pk_bf16(lo, hi); }
__device__ __forceinline__ float sigm(float x) { return 1.0f / (1.0f + __expf(-x)); }
__device__ __forceinline__ float softplusf_(float x) { return fmaxf(x, 0.f) + log1pf(__expf(-fabsf(x))); }
__device__ __forceinline__ void unpack8(const v4u& r, float (&f)[8]) { f[0] = bflo(r.x); f[1] = bfhi(r.x); f[2] = bflo(r.y); f[3] = bfhi(r.y); f[4] = bflo(r.z); f[5] = bfhi(r.z); f[6] = bflo(r.w); f[7] = bfhi(r.w); }
__device__ __forceinline__ v4u pack8(const float (&f)[8]) { v4u o; o.x = pk2(f[0], f[1]); o.y = pk2(f[2], f[3]); o.z = pk2(f[4], f[5]); o.w = pk2(f[6], f[7]); return o; }

template <class Fn> __device__ __forceinline__ void wprep(bf16* dst, int N, int K, Fn f, int gt, int NT) {
    const int items = N * (K >> 3);
    for (int it = gt; it < items; it += NT) { const int n = it % N, k0 = (it / N) << 3; float v[8];
#pragma unroll
        for (int j = 0; j < 8; ++j) v[j] = f(k0 + j, n);
        *(v4u*)(dst + (size_t)n * K + k0) = pack8(v); }
}
__device__ __forceinline__ void phase_prologue(Frame& F, const Args& a) {
    const int gt = F.bid * 512 + F.tid, NT = F.G * 512; unsigned char* ws = F.ws;
    { const float* W = a.in[5];
      wprep((bf16*)(ws + WS_WIN), NU, D, [=](int k, int n) { const int c = n < 964 ? n : (n < 1024 ? -1 : n - 60); return c < 0 ? 0.f : W[(size_t)k * 2756 + c]; }, gt, NT); }
    { const float* w2 = a.in[8]; const float* a2 = a.in[10]; const float* g2 = a.in[11];
      wprep((bf16*)(ws + WS_WLORA), 1536, 256, [=](int k, int n) { if (n < 512) return k < 64 ? w2[k * 512 + n] : 0.f; if (n < 1024) return (k >= 64 && k < 128) ? a2[(k - 64) * 512 + n - 512] : 0.f; return k >= 128 ? g2[(k - 128) * 512 + n - 1024] : 0.f; }, gt, NT); }
    { const float* W = a.in[17]; wprep((bf16*)(ws + WS_WOUT), D, D, [=](int k, int n) { return W[(size_t)k * D + n]; }, gt, NT); }
    for (int L = 0; L < 2; ++L) {
        const float* wg = a.in[31] + (size_t)L * D * FF; const float* wu = a.in[32] + (size_t)L * D * FF; const float* wd = a.in[33] + (size_t)L * FF * D;
        const float* wp = a.in[34] + (size_t)L * 256 * D; const float* wpg = a.in[36] + (size_t)L * D * D;
        wprep((bf16*)(ws + WS_WGU0 + L * WS_LAYER_STRIDE), 2 * FF, D, [=](int k, int n) { const int hid = 16 * (n >> 5) + (n & 15); return ((n & 31) >= 16 ? wu : wg)[(size_t)k * FF + hid]; }, gt, NT);
        wprep((bf16*)(ws + WS_WD0 + L * WS_LAYER_STRIDE), D, FF, [=](int k, int n) { return wd[(size_t)k * D + n]; }, gt, NT);
        wprep((bf16*)(ws + WS_WPLE0 + L * WS_LAYER_STRIDE), D, 256, [=](int k, int n) { return wp[(size_t)k * D + n]; }, gt, NT);
        wprep((bf16*)(ws + WS_WPG0 + L * WS_LAYER_STRIDE), D, D, [=](int k, int n) { return wpg[(size_t)k * D + n]; }, gt, NT);
    }
    { const float* W = a.in[18]; wprep((bf16*)(ws + WS_WUP), 2 * CI, D, [=](int k, int n) { return W[(size_t)k * (2 * CI) + n]; }, gt, NT); }
    { const float* W = a.in[29]; wprep((bf16*)(ws + WS_WDOWN), D, CI, [=](int k, int n) { return W[(size_t)k * D + n]; }, gt, NT); }
    { const float* wq = a.in[21]; const float* wk = a.in[22]; const float* wv = a.in[23]; const float* wif = a.in[24]; float* W12 = (float*)(ws + WS_W12);
      for (int it = gt; it < 4096 * 8; it += NT) { const int o = it & 7, c = (it >> 3) & 2047, part = it >> 14, g = c >> 2, i = c & 3; float s = 0.f;
          if (part == 0) { for (int j = 0; j < 4; ++j) s += wq[(g * 4 + i) * 4 + j] * wif[(size_t)(4 * g + j) * 8 + o] + wk[(g * 4 + i) * 4 + j] * wif[(size_t)(2048 + 4 * g + j) * 8 + o]; }
          else { for (int j = 0; j < 4; ++j) s += wv[(g * 4 + i) * 4 + j] * wif[(size_t)(4096 + 4 * g + j) * 8 + o]; }
          W12[it] = s; } }
}
__device__ __forceinline__ void phase_norm(Frame& F, const float* src, const float* gain, bf16* dst, int nrows) {
    const int gw = F.bid * NWAVES + F.wave, NGW = F.G * NWAVES, lane = F.lane;
    f32x4 g[4];
#pragma unroll
    for (int j = 0; j < 4; ++j) g[j] = *((const f32x4*)gain + lane + 64 * j);
    for (int m = gw; m < nrows; m += NGW) {
        const f32x4* xr = (const f32x4*)(src + (size_t)m * D) + lane; f32x4 v[4]; float s = 0.f;
#pragma unroll
        for (int j = 0; j < 4; ++j) { v[j] = xr[64 * j]; s += (v[j].x * v[j].x + v[j].y * v[j].y) + (v[j].z * v[j].z + v[j].w * v[j].w); }
        const float r = rsqrtf(wave_sum(s) * (1.f / D) + NORM_EPS);
        v2u* o = (v2u*)(dst + (size_t)m * D) + lane;
#pragma unroll
        for (int j = 0; j < 4; ++j) { v2u w; w.x = pk2(v[j].x * r * g[j].x, v[j].y * r * g[j].y); w.y = pk2(v[j].z * r * g[j].z, v[j].w * r * g[j].w); o[64 * j] = w; }
    }
}
__device__ __forceinline__ void phase_cvt_p(Frame& F, const float* p, bf16* pb) {
    const size_t gt = (size_t)F.bid * 512 + F.tid, NT = (size_t)F.G * 512, n8 = (size_t)T * 256 / 8;
    for (size_t i = gt; i < n8; i += NT) { const f32x4 a = *((const f32x4*)p + 2 * i), b = *((const f32x4*)p + 2 * i + 1); v4u o; o.x = pk2(a.x, a.y); o.y = pk2(a.z, a.w); o.z = pk2(b.x, b.y); o.w = pk2(b.z, b.w); *((v4u*)pb + i) = o; }
}
constexpr float QSCALE = 0.125f * LOG2E;
__device__ __forceinline__ void phase_prepA(Frame& F, const Args& a) {
    unsigned char* ws = F.ws; const bf16* UA = (const bf16*)(ws + WS_UA); const bf16* UB = (const bf16*)(ws + WS_UB);
    bf16* LIN = (bf16*)(ws + WS_LIN); bf16* QN = (bf16*)(ws + WS_QN); bf16* KN = (bf16*)(ws + WS_KN); bf16* VT = (bf16*)(ws + WS_VT);
    const float* mu = a.in[6]; const float* gq = a.in[3]; const float* gk = a.in[4];
    { const int gt = F.bid * 512 + F.tid, NT = F.G * 512;
      for (int it = gt; it < T * 32; it += NT) { const int t = it >> 5, c8 = (it & 31) << 3;
          float u[8], p[8], o[8]; unpack8(*(const v4u*)(UB + (size_t)t * UB_W + 1536 + c8), u);
          if ((t & (SEQ - 1)) != 0) unpack8(*(const v4u*)(UB + (size_t)(t - 1) * UB_W + 1536 + c8), p); else { for (int j = 0; j < 8; ++j) p[j] = 0.f; }
#pragma unroll
          for (int j = 0; j < 8; ++j) { const float s = u[j] + mu[1536 + c8 + j] * (p[j] - u[j]); o[j] = c8 < 64 ? tanhf(s) : (c8 < 128 ? s : sigm(s)); }
          *(v4u*)(LIN + (size_t)t * 256 + c8) = pack8(o); } }
    { const int gw = F.bid * NWAVES + F.wave, NGW = F.G * NWAVES, lane = F.lane; float gqv[8], gkv[8];
#pragma unroll
      for (int j = 0; j < 8; ++j) { gqv[j] = gq[((lane & 7) << 3) + j] * QSCALE; gkv[j] = gk[((lane & 7) << 3) + j]; }
      for (int t = gw; t < T; t += NGW) {
          float q[8], k[8]; unpack8(*(const v4u*)(UA + (size_t)t * UA_W + 8 * lane), q); unpack8(*(const v4u*)(UA + (size_t)t * UA_W + UA_K + 8 * (lane & 7)), k);
          float sq = 0.f, sk = 0.f;
#pragma unroll
          for (int j = 0; j < 8; ++j) { sq += q[j] * q[j]; sk += k[j] * k[j]; }
          sq += __shfl_xor(sq, 1); sq += __shfl_xor(sq, 2); sq += __shfl_xor(sq, 4); sk += __shfl_xor(sk, 1); sk += __shfl_xor(sk, 2); sk += __shfl_xor(sk, 4);
          const float rq = rsqrtf(sq * (1.f / 64.f) + NORM_EPS), rk = rsqrtf(sk * (1.f / 64.f) + NORM_EPS);
#pragma unroll
          for (int j = 0; j < 8; ++j) { q[j] *= rq * gqv[j]; k[j] *= rk * gkv[j]; }
          *(v4u*)(QN + (size_t)t * 512 + 8 * lane) = pack8(q);
          if (lane < 8) *(v4u*)(KN + (size_t)t * 64 + 8 * lane) = pack8(k); } }
    { LAS bf16* tile = (LAS bf16*)F.lds;
      for (int u = F.bid; u < T / 64; u += F.G) { const int t0 = u * 64, b = t0 / SEQ, s0 = t0 % SEQ; const int tok = F.tid >> 3, c8 = (F.tid & 7) << 3;
          *(LAS v4u*)(tile + tok * 72 + c8) = *(const v4u*)(UA + (size_t)(t0 + tok) * UA_W + UA_V + c8);
          __syncthreads();
          const int d = F.tid >> 3, s8 = (F.tid & 7) << 3; v4u o; unsigned short e[8];
#pragma unroll
          for (int j = 0; j < 8; ++j) e[j] = tile[(s8 + j) * 72 + d];
          o.x = e[0] | ((unsigned)e[1] << 16); o.y = e[2] | ((unsigned)e[3] << 16); o.z = e[4] | ((unsigned)e[5] << 16); o.w = e[6] | ((unsigned)e[7] << 16);
          *(v4u*)(VT + ((size_t)b * 64 + d) * SEQ + s0 + s8) = o;
          __syncthreads(); } }
}
constexpr int IDX_STRIDE = 2052, KSEL = 256;
__device__ __forceinline__ void topk_select(const LAS float* row, int limit, unsigned* maskrow, int lane) {
    unsigned long long mybits = 0ull; const int nj = limit >> 6;
    if (limit <= KSEL) { mybits = lane < nj ? ~0ull : 0ull; }
    else {
        unsigned key[32];
#pragma unroll
        for (int j = 0; j < 32; ++j) { unsigned k = 0u; if (j < nj) { unsigned u = __float_as_uint(row[64 * j + lane]); if (u == 0x80000000u) u = 0u; k = (u & 0x80000000u) ? ~u : (u | 0x80000000u); } key[j] = k; }
        unsigned prefix = 0u; bool exact = false;
        for (int bit = 31; bit >= 0; --bit) { const unsigned cand = prefix | (1u << bit); int cnt = 0;
#pragma unroll
            for (int j = 0; j < 32; ++j) if (j < nj) cnt += __builtin_popcountll(__ballot(key[j] >= cand));
            if (cnt >= KSEL) { prefix = cand; if (cnt == KSEL) { exact = true; break; } } }
        int need = 0;
        if (!exact) { int cgt = 0;
#pragma unroll
            for (int j = 0; j < 32; ++j) if (j < nj) cgt += __builtin_popcountll(__ballot(key[j] > prefix));
            need = KSEL - cgt; }
        int running = 0; const unsigned long long below = (1ull << lane) - 1ull;
#pragma unroll
        for (int j = 0; j < 32; ++j) if (j < nj) {
            const bool gt = exact ? (key[j] >= prefix) : (key[j] > prefix); const bool tie = (!exact) && key[j] == prefix;
            const unsigned long long tb = __ballot(tie); const int rank = running + __builtin_popcountll(tb & below); running += __builtin_popcountll(tb);
            const unsigned long long sb = __ballot(gt || (tie && rank < need)); if (lane == j) mybits = sb; }
    }
    if (lane < 32) { v2u w; w.x = (unsigned)mybits; w.y = (unsigned)(mybits >> 32); *(v2u*)(maskrow + 2 * lane) = w; }
}
__device__ __forceinline__ void phase_indexer(Frame& F) {
    unsigned char* ws = F.ws; const bf16* UA = (const bf16*)(ws + WS_UA); unsigned* MASK = (unsigned*)(ws + WS_MASK);
    LAS float* sc = (LAS float*)F.lds; const int lane = F.lane, w = F.wave, fr = lane & 15, fq = lane >> 4;
    for (int r = 0;; ++r) { const int u = r * F.G + ((r & 1) ? (F.G - 1 - F.bid) : F.bid); if (u >= NB * 128) break;
        const int c = 31 - (u >> 7), rest = u & 127, b = rest >> 2, g4 = rest & 3, limit = 64 * (c + 1), tq0 = b * SEQ + c * 64 + g4 * 16;
        const bf16* UAb = UA + (size_t)b * SEQ * UA_W;
        bf16x8 qf[4][2]; float iwv[4];
        { const bf16* qp = UA + (size_t)(tq0 + fr) * UA_W;
#pragma unroll
          for (int hh = 0; hh < 4; ++hh) { qf[hh][0] = *(const bf16x8*)(qp + UA_IQ + hh * 64 + fq * 8); qf[hh][1] = *(const bf16x8*)(qp + UA_IQ + hh * 64 + 32 + fq * 8); iwv[hh] = bf1(qp[UA_IW + hh]) * (1.f / 16.f); } }
        for (int kt = w; kt < (limit >> 4); kt += NWAVES) {
            const bf16* kp = UAb + (size_t)(kt * 16 + fr) * UA_W + UA_IK + fq * 8; const bf16x8 a0 = *(const bf16x8*)kp, a1 = *(const bf16x8*)(kp + 32);
            f32x4 s = {0.f, 0.f, 0.f, 0.f};
#pragma unroll
            for (int hh = 0; hh < 4; ++hh) { f32x4 d = {0.f, 0.f, 0.f, 0.f}; d = __builtin_amdgcn_mfma_f32_16x16x32_bf16(a0, qf[hh][0], d, 0, 0, 0); d = __builtin_amdgcn_mfma_f32_16x16x32_bf16(a1, qf[hh][1], d, 0, 0, 0);
#pragma unroll
                for (int j = 0; j < 4; ++j) s[j] += iwv[hh] * fmaxf(d[j], 0.f); }
            *(LAS f32x4*)(sc + fr * IDX_STRIDE + kt * 16 + fq * 4) = s; }
        __syncthreads();
#pragma unroll 1
        for (int qq = 0; qq < 2; ++qq) { const int q = 2 * w + qq; topk_select(sc + q * IDX_STRIDE, limit, MASK + (size_t)(tq0 + q) * 64, lane); }
        __syncthreads(); }
}
__device__ __forceinline__ bf16x8 mk8(v2u lo, v2u hi) { v4u t; t.x = lo.x; t.y = lo.y; t.z = hi.x; t.w = hi.y; return __builtin_bit_cast(bf16x8, t); }
__device__ __forceinline__ void phase_dsa_attn(Frame& F, const Args& a) {
    unsigned char* ws = F.ws; const bf16* QN = (const bf16*)(ws + WS_QN); const bf16* KN = (const bf16*)(ws + WS_KN); const bf16* VT = (const bf16*)(ws + WS_VT);
    const unsigned* MASK = (const unsigned*)(ws + WS_MASK); bf16* MIX = (bf16*)(ws + WS_XB);
    const int lane = F.lane, w = F.wave, fr = lane & 15, fq = lane >> 4;
    const float mb = 8.f * LOG2E * wave_max(fabsf(a.in[3][lane])) * wave_max(fabsf(a.in[4][lane]));
    for (int r = 0;; ++r) { const int u = r * F.G + ((r & 1) ? (F.G - 1 - F.bid) : F.bid); if (u >= NB * 32) break;
        const int c = 31 - (u >> 5), b = u & 31, limit = 64 * (c + 1), t0 = b * SEQ + 64 * c;
        bf16x8 qf[4][2];
#pragma unroll
        for (int i = 0; i < 4; ++i) { const bf16* qp = QN + (size_t)(t0 + 16 * i + fr) * 512 + w * 64 + fq * 8; qf[i][0] = *(const bf16x8*)qp; qf[i][1] = *(const bf16x8*)(qp + 32); }
        f32x4 O[4][4]; float l[4];
#pragma unroll
        for (int i = 0; i < 4; ++i) { l[i] = 0.f;
#pragma unroll
            for (int dt = 0; dt < 4; ++dt) O[i][dt] = (f32x4){0.f, 0.f, 0.f, 0.f}; }
        const bf16* Kb = KN + (size_t)b * SEQ * 64; const bf16* Vb = VT + (size_t)b * 64 * SEQ; const unsigned* Mb = MASK + (size_t)t0 * 64;
        for (int kt = 0; kt < (limit >> 5); ++kt) {
            bf16x8 kf[2][2], vf[4]; unsigned mw[4];
#pragma unroll
            for (int s2 = 0; s2 < 2; ++s2) { const bf16* kp = Kb + (size_t)(32 * kt + 16 * s2 + fr) * 64 + fq * 8; kf[s2][0] = *(const bf16x8*)kp; kf[s2][1] = *(const bf16x8*)(kp + 32); }
#pragma unroll
            for (int dt = 0; dt < 4; ++dt) { const bf16* vp = Vb + (size_t)(16 * dt + fr) * SEQ + 32 * kt + 4 * fq; vf[dt] = mk8(*(const v2u*)vp, *(const v2u*)(vp + 16)); }
#pragma unroll
            for (int i = 0; i < 4; ++i) mw[i] = Mb[(size_t)(16 * i + fr) * 64 + kt];
#pragma unroll
            for (int i = 0; i < 4; ++i) {
                f32x4 s0 = {0.f, 0.f, 0.f, 0.f}, s1 = {0.f, 0.f, 0.f, 0.f};
                s0 = __builtin_amdgcn_mfma_f32_16x16x32_bf16(kf[0][0], qf[i][0], s0, 0, 0, 0); s0 = __builtin_amdgcn_mfma_f32_16x16x32_bf16(kf[0][1], qf[i][1], s0, 0, 0, 0);
                s1 = __builtin_amdgcn_mfma_f32_16x16x32_bf16(kf[1][0], qf[i][0], s1, 0, 0, 0); s1 = __builtin_amdgcn_mfma_f32_16x16x32_bf16(kf[1][1], qf[i][1], s1, 0, 0, 0);
                const unsigned b0 = mw[i] >> (4 * fq), b1 = mw[i] >> (16 + 4 * fq); float p[8];
#pragma unroll
                for (int j = 0; j < 4; ++j) { p[j] = ((b0 >> j) & 1u) ? __builtin_amdgcn_exp2f(s0[j] - mb) : 0.f; p[4 + j] = ((b1 >> j) & 1u) ? __builtin_amdgcn_exp2f(s1[j] - mb) : 0.f; }
                l[i] += ((p[0] + p[1]) + (p[2] + p[3])) + ((p[4] + p[5]) + (p[6] + p[7]));
                const bf16x8 pa = __builtin_bit_cast(bf16x8, pack8(p));
#pragma unroll
                for (int dt = 0; dt < 4; ++dt) O[i][dt] = __builtin_amdgcn_mfma_f32_16x16x32_bf16(pa, vf[dt], O[i][dt], 0, 0, 0);
            } }
#pragma unroll
        for (int i = 0; i < 4; ++i) { float li = l[i]; li += __shfl_xor(li, 16); li += __shfl_xor(li, 32);
#pragma unroll
            for (int j = 0; j < 4; ++j) { const float inv = 1.0f / __shfl(li, 4 * fq + j); bf16* op = MIX + (size_t)(t0 + 16 * i + 4 * fq + j) * D + w * 64 + fr;
#pragma unroll
                for (int dt = 0; dt < 4; ++dt) op[16 * dt] = (bf16)f2bf(O[i][dt][j] * inv); } }
    }
}
typedef unsigned u32x16 __attribute__((ext_vector_type(16)));
__device__ __forceinline__ void sload24(f32x8& W_, u32x16& P_, const float* p) { asm volatile("s_load_dwordx8 %0, %2, 0x0\n\ts_load_dwordx16 %1, %2, 0x20" : "=&s"(W_), "=&s"(P_) : "s"(p) : "memory"); }
#define SWAIT2(W_, P_) asm volatile("s_waitcnt lgkmcnt(0)" : "+s"(W_), "+s"(P_) :: "memory")
__device__ __forceinline__ float sbf(unsigned u, int j) { return (j & 1) ? __uint_as_float(u & 0xffff0000u) : __uint_as_float(u << 16); }
constexpr int SCR_CHUNK = 24, SCR_STEP = 8 * SCR_CHUNK;
constexpr size_t SCR_BLK_BYTES = (size_t)SEQ * SCR_STEP * 4;
constexpr int SCR_NA = 85;
static_assert((size_t)SCR_NA * SCR_BLK_BYTES <= 128 * MiB && WS_QN + (size_t)(256 - SCR_NA) * SCR_BLK_BYTES <= 1024 * MiB, "scan scratch");
__device__ __forceinline__ void phase_rwkv(Frame& F, const Args& a) {
    unsigned char* ws = F.ws; const bf16* UB = (const bf16*)(ws + WS_UB); const bf16* LOUT = (const bf16*)(ws + WS_LOUT); bf16* MIX = (bf16*)(ws + WS_XB);
    const float* mu = a.in[6]; const float* w0 = a.in[7]; const float* a0 = a.in[9]; const float* k_k = a.in[12]; const float* k_a = a.in[13]; const float* r_k = a.in[14]; const float* gn_g = a.in[15]; const float* gn_b = a.in[16];
    const int lane = F.lane, w = F.wave;
    LAS float* vx_s = (LAS float*)F.lds;
    LAS float* g_s = vx_s + 4096;
    LAS float* yacc = g_s + 4096;
    LAS float* bonus_s = yacc + 4096;
    LAS float* part = bonus_s + 64;
    for (int bh = F.bid; bh < NB * 8; bh += F.G) {
        const int b = bh >> 3, h = bh & 7, c = h * 64 + lane;
        float* scr = (float*)(F.bid < SCR_NA ? ws + WS_UA + (size_t)F.bid * SCR_BLK_BYTES : ws + WS_QN + (size_t)(F.bid - SCR_NA) * SCR_BLK_BYTES);
        const float mur = mu[c], muk = mu[512 + c], muv = mu[1024 + c], w0c = w0[c], a0c = a0[c], kkc = k_k[c], kac = k_a[c], rkc = r_k[c], gng = gn_g[c], gnb = gn_b[c];
        float S[8];
#pragma unroll
        for (int j = 0; j < 8; ++j) S[j] = 0.f;
        for (int batch = 0; batch < SEQ / 64; ++batch) {
            float* sb = scr + (size_t)batch * 64 * SCR_STEP;
            for (int i = 0; i < 8; ++i) { const int step = w + 8 * i, sl = batch * 64 + step; const size_t t = (size_t)b * SEQ + sl;
                const bf16* up = UB + t * UB_W + c; float ur = bf1(up[0]), uk = bf1(up[512]), uv = bf1(up[1024]), pr = 0.f, pk = 0.f, pv = 0.f;
                if (sl > 0) { pr = bf1(up[-UB_W]); pk = bf1(up[512 - UB_W]); pv = bf1(up[1024 - UB_W]); }
                const float rr = ur + mur * (pr - ur), kx = uk + muk * (pk - uk), vx = uv + muv * (pv - uv);
                const bf16* lp = LOUT + t * 1536 + c; const float wd = bf1(lp[0]), ad = bf1(lp[512]), gg = bf1(lp[1024]);
                const float wraw = -softplusf_(-(w0c + wd)) - 0.5f, decay = __expf(-__expf(wraw)), av = sigm(a0c + ad);
                float kk = kx * kkc; const float nrm = sqrtf(wave_sum(kk * kk)); kk = kk / fmaxf(nrm, 1e-12f);
                const float km = kx * (1.f + (av - 1.f) * kac); const float bon = wave_sum(rr * km * rkc);
                float* sp = sb + step * SCR_STEP + (lane >> 3) * SCR_CHUNK; bf16* sh = (bf16*)(sp + 8) + (lane & 7);
                sp[lane & 7] = decay; sh[0] = (bf16)f2bf(-kk); sh[8] = (bf16)f2bf(kk * av); sh[16] = (bf16)f2bf(km); sh[24] = (bf16)f2bf(rr);
                vx_s[step * 64 + lane] = vx; g_s[step * 64 + lane] = gg; yacc[step * 64 + lane] = 0.f; if (lane == 0) bonus_s[step] = bon; }
            VM_WAIT(); LDS_WAIT(); __syncthreads();
            const float* wp = sb + w * SCR_CHUNK;
            f32x8 Aw, Bw; u32x16 Ap, Bp;
            sload24(Aw, Ap, wp); SWAIT2(Aw, Ap);
#define RWKV_STEP(W_, P_, W2_, P2_, step) do { \
                float p0 = S[0] * sbf(P_[0], 0), p1 = S[1] * sbf(P_[0], 1); p0 = fmaf(S[2], sbf(P_[1], 0), p0); p1 = fmaf(S[3], sbf(P_[1], 1), p1); p0 = fmaf(S[4], sbf(P_[2], 0), p0); p1 = fmaf(S[5], sbf(P_[2], 1), p1); p0 = fmaf(S[6], sbf(P_[3], 0), p0); p1 = fmaf(S[7], sbf(P_[3], 1), p1); \
                LAS float* pp = part + (((step) & 1) * 64 + lane) * 8; pp[w] = p0 + p1; \
                const float vv = vx_s[(step) * 64 + lane]; \
                LDS_WAIT(); __builtin_amdgcn_s_barrier(); asm volatile("" ::: "memory"); \
                const f32x4 q0 = *(LAS f32x4*)pp, q1 = *(LAS f32x4*)(pp + 4); LDS_WAIT(); \
                if ((step) < 63) sload24(W2_, P2_, wp + ((step) + 1) * SCR_STEP); \
                const float sa = ((q0[0] + q0[1]) + (q0[2] + q0[3])) + ((q1[0] + q1[1]) + (q1[2] + q1[3])); float y0 = 0.f, y1 = 0.f; \
                _Pragma("unroll") for (int j = 0; j < 8; j += 2) { const int jh = j >> 1; S[j] = fmaf(S[j], W_[j], fmaf(sa, sbf(P_[4 + jh], 0), vv * sbf(P_[8 + jh], 0))); S[j + 1] = fmaf(S[j + 1], W_[j + 1], fmaf(sa, sbf(P_[4 + jh], 1), vv * sbf(P_[8 + jh], 1))); y0 = fmaf(S[j], sbf(P_[12 + jh], 0), y0); y1 = fmaf(S[j + 1], sbf(P_[12 + jh], 1), y1); } \
                __builtin_amdgcn_ds_faddf(yacc + (step) * 64 + lane, y0 + y1, 0, 0, false); \
                SWAIT2(W2_, P2_); } while (0)
            for (int s2 = 0; s2 < 64; s2 += 2) {
                RWKV_STEP(Aw, Ap, Bw, Bp, s2);
                RWKV_STEP(Bw, Bp, Aw, Ap, s2 + 1);
            }
            LDS_WAIT(); __syncthreads();
            for (int i = 0; i < 8; ++i) { const int step = w + 8 * i; const size_t t = (size_t)b * SEQ + batch * 64 + step;
                const float y = yacc[step * 64 + lane], mean = wave_sum(y) * (1.f / 64.f), dlt = y - mean, var = wave_sum(dlt * dlt) * (1.f / 64.f);
                const float yn = dlt * rsqrtf(var + 64e-5f) * gng + gnb; const float o = (yn + bonus_s[step] * vx_s[step * 64 + lane]) * g_s[step * 64 + lane];
                MIX[t * D + 512 + c] = (bf16)f2bf(o); }
            LDS_WAIT(); __syncthreads();
        }
    }
}
__device__ __forceinline__ void phase_l1prep(Frame& F, const Args& a, int hb) {
    unsigned char* ws = F.ws; const bf16* XM = (const bf16*)(ws + WS_XM); bf16* XC = (bf16*)(ws + WS_XC); bf16* Q = (bf16*)(ws + WS_Q); bf16* K = (bf16*)(ws + WS_K); bf16* V = (bf16*)(ws + WS_V);
    float* GI = (float*)(ws + WS_GI); const float* W12 = (const float*)(ws + WS_W12);
    const float* cw = a.in[19]; const float* cb = a.in[20]; const float* wq = a.in[21]; const float* wk = a.in[22]; const float* wv = a.in[23]; const float* b_i = a.in[25]; const float* b_f = a.in[26];
    const int g = F.tid, lane = F.lane, w = F.wave; LAS float* red = (LAS float*)F.lds;
    float cwr[4][4], cbr[4], wqr[16], wkr[16], wvr[16], w1[32], w2[32];
#pragma unroll
    for (int j = 0; j < 4; ++j)
#pragma unroll
        for (int i = 0; i < 4; ++i) cwr[j][i] = cw[j * CI + 4 * g + i];
#pragma unroll
    for (int i = 0; i < 4; ++i) cbr[i] = cb[4 * g + i];
#pragma unroll
    for (int i = 0; i < 16; ++i) { wqr[i] = wq[g * 16 + i]; wkr[i] = wk[g * 16 + i]; wvr[i] = wv[g * 16 + i]; }
#pragma unroll
    for (int i = 0; i < 32; ++i) { w1[i] = W12[(size_t)(4 * g) * 8 + i]; w2[i] = W12[(size_t)(2048 + 4 * g) * 8 + i]; }
    const int per = TH / F.G;
    const int tb = F.bid * per;
    float x0[4], x1[4], x2[4];
    for (int n = 0; n < per; ++n) { const int t = tb + n, sl = t & (SEQ - 1);
        if (n == 0 || sl == 0) {
#pragma unroll
            for (int i = 0; i < 4; ++i) { x0[i] = 0.f; x1[i] = 0.f; x2[i] = 0.f; }
            if (sl >= 1) { const v2u r = *(const v2u*)(XM + (size_t)(t - 1) * CI + 4 * g); x2[0] = bflo(r.x); x2[1] = bfhi(r.x); x2[2] = bflo(r.y); x2[3] = bfhi(r.y); }
            if (sl >= 2) { const v2u r = *(const v2u*)(XM + (size_t)(t - 2) * CI + 4 * g); x1[0] = bflo(r.x); x1[1] = bfhi(r.x); x1[2] = bflo(r.y); x1[3] = bfhi(r.y); }
            if (sl >= 3) { const v2u r = *(const v2u*)(XM + (size_t)(t - 3) * CI + 4 * g); x0[0] = bflo(r.x); x0[1] = bfhi(r.x); x0[2] = bflo(r.y); x0[3] = bfhi(r.y); }
        }
        float x3[4]; { const v2u r = *(const v2u*)(XM + (size_t)t * CI + 4 * g); x3[0] = bflo(r.x); x3[1] = bfhi(r.x); x3[2] = bflo(r.y); x3[3] = bfhi(r.y); }
        float xc[4], q[4], k[4], v[4];
#pragma unroll
        for (int i = 0; i < 4; ++i) { const float s = cbr[i] + cwr[0][i] * x0[i] + cwr[1][i] * x1[i] + cwr[2][i] * x2[i] + cwr[3][i] * x3[i]; xc[i] = s * sigm(s); }
#pragma unroll
        for (int j = 0; j < 4; ++j) { q[j] = xc[0] * wqr[j] + xc[1] * wqr[4 + j] + xc[2] * wqr[8 + j] + xc[3] * wqr[12 + j]; k[j] = xc[0] * wkr[j] + xc[1] * wkr[4 + j] + xc[2] * wkr[8 + j] + xc[3] * wkr[12 + j];
            v[j] = x3[0] * wvr[j] + x3[1] * wvr[4 + j] + x3[2] * wvr[8 + j] + x3[3] * wvr[12 + j]; }
        float gsum[8];
#pragma unroll
        for (int o = 0; o < 8; ++o) { float s = 0.f;
#pragma unroll
            for (int i = 0; i < 4; ++i) s += xc[i] * w1[i * 8 + o] + x3[i] * w2[i * 8 + o];
            gsum[o] = s; }
        const size_t off = (size_t)t * CI + 4 * g; const float ks = 0.044194173824159216f;
        { v2u o; o.x = pk2(xc[0], xc[1]); o.y = pk2(xc[2], xc[3]); *(v2u*)(XC + off) = o; o.x = pk2(q[0], q[1]); o.y = pk2(q[2], q[3]); *(v2u*)(Q + off) = o;
          o.x = pk2(k[0] * ks, k[1] * ks); o.y = pk2(k[2] * ks, k[3] * ks); *(v2u*)(K + off) = o; o.x = pk2(v[0], v[1]); o.y = pk2(v[2], v[3]); *(v2u*)(V + off) = o; }
#pragma unroll
        for (int o = 0; o < 8; ++o) gsum[o] = wave_sum(gsum[o]);
        LAS float* rp = red + (n & 1) * 64;
        if (lane == 0) {
#pragma unroll
            for (int o = 0; o < 8; ++o) rp[w * 8 + o] = gsum[o]; }
        LDS_WAIT(); __syncthreads();
        if (F.tid < 8) { float s = 0.f;
#pragma unroll
            for (int ww = 0; ww < 8; ++ww) s += rp[ww * 8 + F.tid];
            GI[(size_t)t * 8 + F.tid] = s + (F.tid < 4 ? b_i[F.tid] : b_f[F.tid - 4]); }
#pragma unroll
        for (int i = 0; i < 4; ++i) { x0[i] = x1[i]; x1[i] = x2[i]; x2[i] = x3[i]; }
    }
}
__device__ __forceinline__ void phase_gatescan(Frame& F) {
    unsigned char* ws = F.ws; const float* GI = (const float*)(ws + WS_GI); float* GA = (float*)(ws + WS_GA); float* GAM = (float*)(ws + WS_GAM); float* GEM = (float*)(ws + WS_GEM);
    const int gw = F.bid * NWAVES + F.wave, NGW = F.G * NWAVES, lane = F.lane;
    for (int sq = gw; sq < (NB / 2) * 4; sq += NGW) { const int bl = sq >> 2, h = sq & 3; float cF = 0.f, cA = -INFINITY;
        for (int ch = 0; ch < SEQ / 64; ++ch) { const size_t t = (size_t)bl * SEQ + ch * 64 + lane; const float ip = GI[t * 8 + h], fp = GI[t * 8 + 4 + h];
            float lf = -softplusf_(-fp);
#pragma unroll
            for (int o = 1; o < 64; o <<= 1) { const float n = __shfl_up(lf, o); if (lane >= o) lf += n; }
            const float Fv = cF + lf; const float av = ip - Fv; float A = av;
#pragma unroll
            for (int o = 1; o < 64; o <<= 1) { const float n = __shfl_up(A, o); if (lane >= o) A = fmaxf(A, n); }
            A = fmaxf(A, cA);
            GA[t * 4 + h] = av; GAM[t * 4 + h] = A; GEM[t * 4 + h] = __expf(-(Fv + A));
            cF = __shfl(Fv, 63); cA = __shfl(A, 63); } }
}
constexpr int ML_QS = 1040, ML_PS = 144;
constexpr int ML_Q = 0, ML_V = 64 * ML_QS, ML_P = 2 * 64 * ML_QS, ML_DEN = ML_P + 64 * ML_PS, ML_ST = ML_DEN + 1024, ML_MR = ML_ST + 4096, ML_AT = ML_MR + 512, ML_END = ML_AT + 512;
static_assert(ML_END <= MISC_OFF, "mLSTM LDS");
__device__ __forceinline__ bf16x8 tr_read2(unsigned addr0, unsigned addr1) { s16x4 lo, hi;
    asm volatile("ds_read_b64_tr_b16 %0, %2\n\tds_read_b64_tr_b16 %1, %3\n\ts_waitcnt lgkmcnt(0)" : "=&v"(lo), "=&v"(hi) : "v"(addr0), "v"(addr1) : "memory");
    return (bf16x8){lo[0], lo[1], lo[2], lo[3], hi[0], hi[1], hi[2], hi[3]}; }
__device__ __forceinline__ void phase_mlstm(Frame& F, const Args& a) {
    unsigned char* ws = F.ws; const bf16* Q = (const bf16*)(ws + WS_Q); const bf16* K = (const bf16*)(ws + WS_K); const bf16* V = (const bf16*)(ws + WS_V); const bf16* XC = (const bf16*)(ws + WS_XC); const bf16* Z = (const bf16*)(ws + WS_Z);
    bf16* YC = (bf16*)(ws + WS_XM); const float* GA = (const float*)(ws + WS_GA); const float* GAM = (const float*)(ws + WS_GAM); const float* GEM = (const float*)(ws + WS_GEM);
    const float* mh_g = a.in[27]; const float* skip = a.in[28];
    const int tid = F.tid, lane = F.lane, w = F.wave, fr = lane & 15, fq = lane >> 4; LAS unsigned char* lds = F.lds;
    LAS float* den4 = (LAS float*)(lds + ML_DEN); LAS float* stats = (LAS float*)(lds + ML_ST); LAS float* mr = (LAS float*)(lds + ML_MR); LAS float* At_s = (LAS float*)(lds + ML_AT); LAS float* em_s = At_s + 64;
    const int st = w & 3, tt0 = 2 * (w >> 2);
    const unsigned vtr_base = (unsigned)(size_t)(lds + ML_V) + (unsigned)((8 * fq + ((lane & 15) >> 2)) * ML_QS + (64 * w + 4 * (lane & 3)) * 2);
    for (int r = 0;; ++r) { const int u = r * F.G + ((r & 1) ? (F.G - 1 - F.bid) : F.bid); if (u >= 2048) break;
        const int qi = 31 - (u >> 6), bh = u & 63, bl = bh >> 2, h = bh & 3; const size_t t0 = (size_t)bl * SEQ + 64 * qi;
#pragma unroll
        for (int k8 = 0; k8 < 8; ++k8) { const int ch = tid + 512 * k8, row = ch >> 6, c16 = ch & 63; *(LAS v4u*)(lds + ML_Q + row * ML_QS + c16 * 16) = *(const v4u*)(Q + (t0 + row) * CI + h * 512 + c16 * 8); }
        if (tid < 64) { At_s[tid] = GAM[(t0 + tid) * 4 + h]; em_s[tid] = GEM[(t0 + tid) * 4 + h]; }
        f32x4 O[4][4]; float denp[2] = {0.f, 0.f};
#pragma unroll
        for (int i = 0; i < 4; ++i)
#pragma unroll
            for (int e = 0; e < 4; ++e) O[i][e] = (f32x4){0.f, 0.f, 0.f, 0.f};
        LDS_WAIT(); __syncthreads();
        float At[2]; At[0] = At_s[16 * tt0 + fr]; At[1] = At_s[16 * (tt0 + 1) + fr];
        for (int j = 0; j <= qi; ++j) { const size_t s0 = (size_t)bl * SEQ + 64 * j;
            v4u vreg[8];
#pragma unroll
            for (int k8 = 0; k8 < 8; ++k8) { const int ch = tid + 512 * k8, row = ch >> 6, c16 = ch & 63; vreg[k8] = *(const v4u*)(V + (s0 + row) * CI + h * 512 + c16 * 8); }
            f32x4 sacc[2] = {(f32x4){0.f, 0.f, 0.f, 0.f}, (f32x4){0.f, 0.f, 0.f, 0.f}};
            const bf16* kp = K + (s0 + 16 * st + fr) * CI + h * 512 + fq * 8;
#pragma unroll 4
            for (int ks = 0; ks < 16; ++ks) { const bf16x8 kf = *(const bf16x8*)(kp + 32 * ks);
#pragma unroll
                for (int x = 0; x < 2; ++x) { const bf16x8 qf = *(const LAS bf16x8*)(lds + ML_Q + (16 * (tt0 + x) + fr) * ML_QS + (32 * ks + 8 * fq) * 2); sacc[x] = __builtin_amdgcn_mfma_f32_16x16x32_bf16(kf, qf, sacc[x], 0, 0, 0); } }
            float as[4];
#pragma unroll
            for (int i = 0; i < 4; ++i) as[i] = GA[(s0 + 16 * st + 4 * fq + i) * 4 + h];
            v2u pw[2];
#pragma unroll
            for (int x = 0; x < 2; ++x) { float p[4];
#pragma unroll
                for (int i = 0; i < 4; ++i) { const bool ok = (j < qi) || (16 * st + 4 * fq + i <= 16 * (tt0 + x) + fr); p[i] = ok ? sacc[x][i] * __builtin_amdgcn_exp2f((as[i] - At[x]) * LOG2E) : 0.f; }
                denp[x] += (p[0] + p[1]) + (p[2] + p[3]); pw[x].x = pk2(p[0], p[1]); pw[x].y = pk2(p[2], p[3]); }
            __syncthreads();
#pragma unroll
            for (int x = 0; x < 2; ++x) *(LAS v2u*)(lds + ML_P + (16 * (tt0 + x) + fr) * ML_PS + (16 * st + 4 * fq) * 2) = pw[x];
#pragma unroll
            for (int k8 = 0; k8 < 8; ++k8) { const int ch = tid + 512 * k8, row = ch >> 6, c16 = ch & 63; *(LAS v4u*)(lds + ML_V + row * ML_QS + c16 * 16) = vreg[k8]; }
            LDS_WAIT(); __syncthreads();
#pragma unroll
            for (int k2 = 0; k2 < 2; ++k2) { bf16x8 vf[4], pf[4];
#pragma unroll
                for (int e = 0; e < 4; ++e) { const unsigned ad = vtr_base + (unsigned)(32 * k2 * ML_QS + 32 * e); vf[e] = tr_read2(ad, ad + 4 * ML_QS); }
#pragma unroll
                for (int i = 0; i < 4; ++i) pf[i] = *(const LAS bf16x8*)(lds + ML_P + (16 * i + fr) * ML_PS + (32 * k2 + 8 * fq) * 2);
#pragma unroll
                for (int i = 0; i < 4; ++i)
#pragma unroll
                    for (int e = 0; e < 4; ++e) O[i][e] = __builtin_amdgcn_mfma_f32_16x16x32_bf16(pf[i], vf[e], O[i][e], 0, 0, 0); }
        }
#pragma unroll
        for (int x = 0; x < 2; ++x) { float d = denp[x]; d += __shfl_xor(d, 16); d += __shfl_xor(d, 32); if (fq == 0) den4[st * 64 + 16 * (tt0 + x) + fr] = d; }
        LDS_WAIT(); __syncthreads();
        float s1[4][4], s2[4][4];
#pragma unroll
        for (int i = 0; i < 4; ++i)
#pragma unroll
            for (int jj = 0; jj < 4; ++jj) { const int t = 16 * i + 4 * fq + jj; const float dn = (den4[t] + den4[64 + t]) + (den4[128 + t] + den4[192 + t]); const float inv = 1.0f / fmaxf(fabsf(dn), em_s[t]); float a1 = 0.f, a2 = 0.f;
#pragma unroll
                for (int e = 0; e < 4; ++e) { const float hv = O[i][e][jj] * inv; O[i][e][jj] = hv; a1 += hv; a2 += hv * hv; }
                s1[i][jj] = a1; s2[i][jj] = a2; }
#pragma unroll
        for (int i = 0; i < 4; ++i)
#pragma unroll
            for (int jj = 0; jj < 4; ++jj) { float a1 = s1[i][jj], a2 = s2[i][jj];
#pragma unroll
                for (int o = 1; o < 16; o <<= 1) { a1 += __shfl_xor(a1, o); a2 += __shfl_xor(a2, o); }
                if (fr == 0) { const int t = 16 * i + 4 * fq + jj; stats[(w * 64 + t) * 2] = a1; stats[(w * 64 + t) * 2 + 1] = a2; } }
        LDS_WAIT(); __syncthreads();
        if (tid < 64) { float a1 = 0.f, a2 = 0.f;
#pragma unroll
            for (int ww = 0; ww < 8; ++ww) { a1 += stats[(ww * 64 + tid) * 2]; a2 += stats[(ww * 64 + tid) * 2 + 1]; }
            const float mean = a1 * (1.f / 512.f), var = fmaxf(a2 * (1.f / 512.f) - mean * mean, 0.f); mr[2 * tid] = mean; mr[2 * tid + 1] = rsqrtf(var + 1e-5f); }
        LDS_WAIT(); __syncthreads();
#pragma unroll
        for (int e = 0; e < 4; ++e) { const int cc = h * 512 + 64 * w + 16 * e + fr; const float gmul = mh_g[cc], sk = skip[cc];
#pragma unroll
            for (int i = 0; i < 4; ++i)
#pragma unroll
                for (int jj = 0; jj < 4; ++jj) { const int t = 16 * i + 4 * fq + jj; const size_t off = (t0 + t) * CI + cc; const float zz = bf1(Z[off]), xcv = bf1(XC[off]);
                    const float y = ((O[i][e][jj] - mr[2 * t]) * mr[2 * t + 1] * gmul + sk * xcv) * (zz * sigm(zz)); YC[off] = (bf16)f2bf(y); } }
        __syncthreads();
    }
}
#define GEMM_PHASE(EPI, Aptr, Bptr, M_, N_, K_, ...) do { pg8::Gemm g{(const pg8::bf16_t*)(Aptr), (const pg8::bf16_t*)(Bptr), (M_), (N_), (K_)}; pg8::StaticOrder So; So.init((M_), (N_), F.G, F.bid); \
        pg8::EPI Ep{__VA_ARGS__}; pg8::gemm_phase<pg8::EPI, pg8::StaticOrder, PG8_ALIGN, PG8_SP2>(F.lds, g, So, Ep); } while (0)
__global__ void __launch_bounds__(NWAVES * 64, 2) trunk_fwd(Args args) {
    extern __shared__ __attribute__((aligned(16))) unsigned char lds_raw[];
    Frame F; F.lds = (LAS unsigned char*)lds_raw; F.ws = args.ws; F.in = nullptr;
    F.tid = threadIdx.x; F.lane = F.tid & 63; F.wave = __builtin_amdgcn_readfirstlane(F.tid >> 6); F.G = gridDim.x; F.bid = blockIdx.x;
    volatile LAS unsigned* MISC = (volatile LAS unsigned*)(F.lds + MISC_OFF);
    if (F.tid < 64) MISC[F.tid] = 0u;
    __syncthreads();
    XcdBarrier bar; bar.bar = (unsigned*)(args.ws + WS_CTL) + CW_BAR; bar.x = 0; bar.st = nullptr;
    if (args.use_bar) bar = xcd_barrier_post((unsigned*)(args.ws + WS_CTL) + CW_BAR, MISC + 8);
    const int lo = args.ph_lo, hi = args.ph_hi;
#ifndef ONLY_SITE
#define ONLY_SITE -1
#endif
#define EN(n) (ONLY_SITE < 0 || ONLY_SITE == (n))
#define IN(k) (lo <= (k) && (k) < hi)
#define SEAM(k) do { if (IN(k) && IN((k) + 1)) xcd_barrier(bar); } while (0)
    unsigned char* ws = args.ws; float* out = args.out;
    if (EN(0) && IN(0)) { phase_prologue(F, args); } SEAM(0);
    if (EN(1) && IN(1)) { phase_norm(F, args.in[0], args.in[2], (bf16*)(ws + WS_XB), T); } SEAM(1);
    if (EN(2) && IN(2)) { GEMM_PHASE(EpiBf16Split, ws + WS_XB, ws + WS_WIN, T, NU, D, (pg8::bf16_t*)(ws + WS_UA), UA_W, 4, (pg8::bf16_t*)(ws + WS_UB), UB_W); } SEAM(2);
    if (EN(3) && IN(3)) { phase_prepA(F, args); } SEAM(3);
    if (EN(4) && IN(4)) { GEMM_PHASE(EpiBf16Split, ws + WS_LIN, ws + WS_WLORA, T, 1536, 256, (pg8::bf16_t*)(ws + WS_LOUT), 1536, 1 << 20, nullptr, 0); } SEAM(4);
    if (EN(5) && IN(5)) { phase_indexer(F); } SEAM(5);
    if (EN(6) && IN(6)) { phase_dsa_attn(F, args); } SEAM(6);
    if (EN(7) && IN(7)) { phase_rwkv(F, args); } SEAM(7);
    if (EN(8) && IN(8)) { GEMM_PHASE(EpiResF32, ws + WS_XB, ws + WS_WOUT, T, D, D, args.in[0], out, D); } SEAM(8);
#define FFN_PLE(L, pb) do { const size_t lw = (size_t)(L) * WS_LAYER_STRIDE; \
        if (EN(20) && IN(pb)) { phase_norm(F, out, args.in[30] + (L) * D, (bf16*)(ws + WS_XB), T); } SEAM(pb); \
        if (EN(21) && IN((pb) + 1)) { GEMM_PHASE(EpiSwiglu, ws + WS_XB, ws + WS_WGU0 + lw, T, 2 * FF, D, (pg8::bf16_t*)(ws + WS_H), FF); } SEAM((pb) + 1); \
        if (EN(22) && IN((pb) + 2)) { GEMM_PHASE(EpiResF32, ws + WS_H, ws + WS_WD0 + lw, T, D, FF, out, out, D); } SEAM((pb) + 2); \
        if (EN(23) && IN((pb) + 3)) { phase_norm(F, out, args.in[35] + (L) * D, (bf16*)(ws + WS_XB), T); phase_cvt_p(F, args.in[1] + (size_t)(L) * T * 256, (bf16*)(ws + WS_PB)); } SEAM((pb) + 3); \
        if (EN(24) && IN((pb) + 4)) { GEMM_PHASE(EpiBf16Split, ws + WS_PB, ws + WS_WPLE0 + lw, T, D, 256, (pg8::bf16_t*)(ws + WS_E), D, 1 << 20, nullptr, 0); } SEAM((pb) + 4); \
        if (EN(25) && IN((pb) + 5)) { GEMM_PHASE(EpiPle, ws + WS_XB, ws + WS_WPG0 + lw, T, D, D, out, out, (const pg8::bf16_t*)(ws + WS_E), D); } SEAM((pb) + 5); } while (0)
#define L1_HALF(hb, p1) do { float* xh = out + (size_t)(hb) * TH * D; \
        if (EN(10) && IN(p1)) { phase_norm(F, xh, args.in[2] + D, (bf16*)(ws + WS_XBH), TH); } SEAM(p1); \
        if (EN(11) && IN((p1) + 1)) { GEMM_PHASE(EpiBf16Split, ws + WS_XBH, ws + WS_WUP, TH, 2 * CI, D, (pg8::bf16_t*)(ws + WS_XM), CI, 8, (pg8::bf16_t*)(ws + WS_Z), CI); } SEAM((p1) + 1); \
        if (EN(12) && IN((p1) + 2)) { phase_l1prep(F, args, hb); } SEAM((p1) + 2); \
        if (EN(13) && IN((p1) + 3)) { phase_gatescan(F); } SEAM((p1) + 3); \
        if (EN(14) && IN((p1) + 4)) { phase_mlstm(F, args); } SEAM((p1) + 4); \
        if (EN(15) && IN((p1) + 5)) { GEMM_PHASE(EpiResF32, ws + WS_XM, ws + WS_WDOWN, TH, D, CI, xh, xh, D); } SEAM((p1) + 5); } while (0)
    FFN_PLE(0, 9);
    L1_HALF(0, 15);
    L1_HALF(1, 21);
    FFN_PLE(1, 27);
#undef IN
#undef SEAM
}
constexpr int N_PHASES = 33;

#ifndef MK_ONE_LAUNCH
#define MK_ONE_LAUNCH 0
#endif
extern "C" void kernel_launch(void* const* d_in, const int* in_sizes, int n_in, void* d_out, int out_size, void* d_ws, size_t ws_size, hipStream_t stream) {
    static int grid = 0;
    if (grid == 0) {
        if (n_in != 37 || in_sizes[0] != T * D || out_size != T * D || ws_size < WS_END) { fprintf(stderr, "kernel_launch: unexpected shapes (n_in %d, in0 %d, out %d, ws %zu < %zu); nothing launched\n", n_in, n_in > 0 ? in_sizes[0] : -1, out_size, ws_size, (size_t)WS_END); grid = -1; return; }
        int dev = 0, cus = 0, per_cu = 0;
        if (hipGetDevice(&dev) != hipSuccess || hipDeviceGetAttribute(&cus, hipDeviceAttributeMultiprocessorCount, dev) != hipSuccess) { grid = -1; return; }
        if (hipFuncSetAttribute((const void*)trunk_fwd, hipFuncAttributeMaxDynamicSharedMemorySize, LDS_BYTES) != hipSuccess) { fprintf(stderr, "kernel_launch: hipFuncSetAttribute failed\n"); grid = -1; return; }
        if (hipOccupancyMaxActiveBlocksPerMultiprocessor(&per_cu, (const void*)trunk_fwd, NWAVES * 64, LDS_BYTES) != hipSuccess || per_cu < 1) { fprintf(stderr, "kernel_launch: occupancy query says %d\n", per_cu); }
        (void)hipGetLastError();
        grid = cus;
        if (grid != 256) { fprintf(stderr, "kernel_launch: built for 256 CUs, found %d; nothing launched\n", cus); grid = -1; return; }
    }
    if (grid < 0) return;
    if (hipMemsetAsync((char*)d_ws + WS_CTL, 0, CTL_ZERO_BYTES, stream) != hipSuccess) return;
    Args a{};
    for (int i = 0; i < 37; ++i) a.in[i] = (const float*)d_in[i];
    a.out = (float*)d_out; a.ws = (unsigned char*)d_ws; a.pad = 0;
#if MK_ONE_LAUNCH
    a.ph_lo = 0; a.ph_hi = N_PHASES; a.use_bar = 1;
    hipLaunchKernelGGL(trunk_fwd, dim3(grid), dim3(NWAVES * 64), LDS_BYTES, stream, a);
#else
    for (int p = 0; p < N_PHASES; ++p) { a.ph_lo = p; a.ph_hi = p + 1; a.use_bar = 0; hipLaunchKernelGGL(trunk_fwd, dim3(grid), dim3(NWAVES * 64), LDS_BYTES, stream, a); }
#endif
}
```

```cpp
#include <hip/hip_runtime.h>
#include <cstdio>
#include <cstdint>
namespace pg8 {
#define PG8_LAS __attribute__((address_space(3)))
typedef unsigned short bf16_t;
typedef short bf16x8 __attribute__((ext_vector_type(8)));
typedef float f32x4 __attribute__((ext_vector_type(4)));
typedef unsigned u32x4 __attribute__((ext_vector_type(4)));
constexpr int BM = 256, BK = 64, HALF = 128, HTB = HALF * BK * 2  , STAGE_BYTES = 8 * HTB, NXCD = 8, WGM = 8;

__host__ __device__ __forceinline__ int lds_byte(int r, int c) { const int st = (r >> 4) * 2 + (c >> 5), rr = r & 15, cc = c & 31, ob = rr * 64 + cc * 2; return st * 1024 + (ob ^ (((ob >> 9) & 1) << 5)); }
__host__ __device__ __forceinline__ void stage_rc(int b, int& R, int& C) { const int st = b / 1024, sb = b % 1024, swz = sb ^ (((sb >> 9) & 1) << 5); R = (st >> 1) * 16 + swz / 64; C = (st & 1) * 32 + (swz % 64) / 2; }
__host__ __device__ __forceinline__ int perm32(int rho) { const int n = rho >> 4, i = rho & 15; return 8 * (i >> 2) + 4 * n + (i & 3); }

struct Unit { int pm, pn; };
struct Gemm { const bf16_t* A; const bf16_t* Bt; int M, N, K; };

struct StaticOrder {
    int nM, nN, nwg, G, c;
    __host__ __device__ void init(int M, int N, int G_, int c_) { nM = M / BM; nN = N / BM; nwg = nM * nN; G = G_; c = c_; }
    __host__ __device__ bool next(int i, Unit& u) const {
        const long L = (long)i * G + c; if (L >= nwg) return false;
        int wgid = (int)L; { const int q = nwg / NXCD, r = nwg % NXCD, xcd = wgid % NXCD, off = wgid / NXCD; wgid = (xcd < r ? xcd * (q + 1) : r * (q + 1) + (xcd - r) * q) + off; }
        const int nig = WGM * nN, gid = wgid / nig, fm = gid * WGM, gsz = (nM - fm) < WGM ? (nM - fm) : WGM;
        u.pm = fm + ((wgid % nig) % gsz); u.pn = (wgid % nig) / gsz; return true;
    }
    __device__ __forceinline__ void a_ready(const Unit&) const {}
    __device__ __forceinline__ void done(const Unit&) const {}
};

__device__ __forceinline__ unsigned cvt_pk_bf16(float lo, float hi) { unsigned r; asm volatile("v_cvt_pk_bf16_f32 %0, %1, %2" : "=v"(r) : "v"(lo), "v"(hi)); return r; }
typedef float f32x2 __attribute__((ext_vector_type(2)));
__device__ __forceinline__ f32x2 gelu_pk(f32x2 v) {
    const f32x2 av = __builtin_elementwise_abs(v), d = av * 0.2316418882f + 1.0f;
    f32x2 t; t.x = __builtin_amdgcn_rcpf(d.x); t.y = __builtin_amdgcn_rcpf(d.y);
    f32x2 q = t * 0.5307027145f + (-0.7265760135f); q = q * t + 0.7107068705f; q = q * t + (-0.142248368f); q = q * t + 0.127414796f; q = q * t;
    const f32x2 s = (v * v) * (-0.72134752044f);
    f32x2 e; e.x = __builtin_amdgcn_exp2f(s.x); e.y = __builtin_amdgcn_exp2f(s.y);
    const f32x2 m = v * (q * e), r = v - m;
    f32x2 o; o.x = v.x < 0.f ? m.x : r.x; o.y = v.y < 0.f ? m.y : r.y; return o;
}

template <class Epi, class Sched, bool ALIGN_EPI = false, bool SP2 = false>
__device__ __forceinline__ void gemm_phase(PG8_LAS unsigned char* lds, const Gemm g, const Sched& S, const Epi& E) {
    const int tid = threadIdx.x, wid = __builtin_amdgcn_readfirstlane(tid >> 6), lane = tid & 63, wr = wid >> 2, wc = wid & 3, fr = lane & 15, fq = lane >> 4;
    const int K = g.K, nt = K / BK;
    unsigned voffA[2], voffB[2];
#pragma unroll
    for (int i = 0; i < 2; ++i) { int R, C; stage_rc(tid * 16 + i * 8192, R, C); const int Rb = Epi::PERM ? ((R & ~31) + perm32(R & 31)) : R;
        voffA[i] = (unsigned)(R * K + C) * 2u; voffB[i] = (unsigned)(Rb * K + C) * 2u; }
    const size_t kstep = (size_t)(BK * 2);
    const size_t hstep = (size_t)HALF * K * 2;
    const size_t tstep = 2 * hstep;
    const unsigned ldsw = (unsigned)wid * 1024u;
    const int aoff = lds_byte(wr * 64 + fr, fq * 8), boff = lds_byte(wc * 32 + fr, fq * 8);
#define PG8_SA(b, h) (((b) * 2 + (h)) * HTB)
#define PG8_SB(b, h) ((4 + (b) * 2 + (h)) * HTB)
#define PG8_STAGE(bufoff, gbase, voff) do { _Pragma("unroll") for (int _i = 0; _i < 2; ++_i) \
        __builtin_amdgcn_global_load_lds((const unsigned*)((const char*)(gbase) + (voff)[_i]), (PG8_LAS unsigned*)(lds + (bufoff) + ldsw + _i * 8192), 16, 0, 0); } while (0)
#define PG8_LDA(dst, b, h) do { _Pragma("unroll") for (int m = 0; m < 4; ++m) _Pragma("unroll") for (int k = 0; k < 2; ++k) dst[m][k] = *(const PG8_LAS bf16x8*)(lds + PG8_SA(b, h) + aoff + m * 2048 + k * 1024); } while (0)
#define PG8_LDB(dst, b, h) do { _Pragma("unroll") for (int n = 0; n < 2; ++n) _Pragma("unroll") for (int k = 0; k < 2; ++k) dst[n][k] = *(const PG8_LAS bf16x8*)(lds + PG8_SB(b, h) + boff + n * 2048 + k * 1024); } while (0)
#define PG8_MMA(ai, bj, At, Bt) do { __builtin_amdgcn_s_setprio(1); _Pragma("unroll") for (int m = 0; m < 4; ++m) _Pragma("unroll") for (int n = 0; n < 2; ++n) _Pragma("unroll") for (int k = 0; k < 2; ++k) \
        acc[ai][bj][m][n] = __builtin_amdgcn_mfma_f32_16x16x32_bf16(Bt[n][k], At[m][k], acc[ai][bj][m][n], 0, 0, 0); __builtin_amdgcn_s_setprio(0); } while (0)
#define PG8_WAIT_V(n) asm volatile("s_waitcnt vmcnt(" #n ")" ::: "memory")
#define PG8_WAIT_L(n) asm volatile("s_waitcnt lgkmcnt(" #n ")" ::: "memory")
#define PG8_BAR __builtin_amdgcn_s_barrier()
#define PG8_SCHED __builtin_amdgcn_sched_barrier(0)
    Unit cur, nxt; int ui = 0;
    if (!S.next(0, cur)) return;
    f32x4 acc[2][2][4][2];
#pragma unroll
    for (int a = 0; a < 2; ++a)
#pragma unroll
        for (int b = 0; b < 2; ++b)
#pragma unroll
            for (int m = 0; m < 4; ++m)
#pragma unroll
                for (int n = 0; n < 2; ++n) acc[a][b][m][n] = (f32x4){0.f, 0.f, 0.f, 0.f};
    bf16x8 At[4][2], B0[2][2], B1[2][2];
    const char* cA = (const char*)g.A + (size_t)cur.pm * tstep; const char* cB = (const char*)g.Bt + (size_t)cur.pn * tstep;
    S.a_ready(cur);
    if constexpr (SP2) {
        PG8_STAGE(PG8_SB(0, 0), cB, voffB); PG8_STAGE(PG8_SB(0, 1), cB + hstep, voffB); PG8_STAGE(PG8_SA(0, 0), cA, voffA); PG8_STAGE(PG8_SA(0, 1), cA + hstep, voffA);
        if (wr == 1) PG8_BAR;
        PG8_WAIT_V(2); PG8_BAR;
        PG8_STAGE(PG8_SB(1, 0), cB + kstep, voffB); PG8_STAGE(PG8_SA(1, 0), cA + kstep, voffA); PG8_STAGE(PG8_SB(1, 1), cB + hstep + kstep, voffB);
        PG8_WAIT_V(6); PG8_BAR;
    } else {
        PG8_STAGE(PG8_SB(0, 0), cB, voffB); PG8_STAGE(PG8_SA(0, 0), cA, voffA); PG8_STAGE(PG8_SB(0, 1), cB + hstep, voffB); PG8_STAGE(PG8_SA(0, 1), cA + hstep, voffA);
        if (wr == 1) PG8_BAR;
        PG8_WAIT_V(4); PG8_BAR;
        PG8_STAGE(PG8_SB(1, 0), cB + kstep, voffB); PG8_STAGE(PG8_SA(1, 0), cA + kstep, voffA); PG8_STAGE(PG8_SB(1, 1), cB + hstep + kstep, voffB);
        PG8_WAIT_V(6); PG8_BAR;
    }
    for (;;) {
        const bool has_next = S.next(ui + 1, nxt);
        const char* nA = has_next ? (const char*)g.A + (size_t)nxt.pm * tstep : cA; const char* nB = has_next ? (const char*)g.Bt + (size_t)nxt.pn * tstep : cB;
        for (int t = 0; t < nt; t += 2) {
            const bool last = (t == nt - 2);
            const char* a1 = cA + (size_t)(t + 1) * kstep;
            const char* a2 = last ? nA : cA + (size_t)(t + 2) * kstep; const char* b2 = last ? nB : cB + (size_t)(t + 2) * kstep;
            const char* a3 = a2 + kstep; const char* b3 = b2 + kstep;
            if (last && has_next) S.a_ready(nxt);
            if constexpr (SP2) {
            PG8_LDB(B0, 0, 0); PG8_LDB(B1, 0, 1); PG8_SCHED; PG8_LDA(At, 0, 0); PG8_STAGE(PG8_SA(1, 1), a1 + hstep, voffA);
            PG8_WAIT_V(8); PG8_WAIT_L(0); PG8_BAR; PG8_MMA(0, 0, At, B0); PG8_MMA(0, 1, At, B1); PG8_BAR; PG8_SCHED;
            PG8_LDA(At, 0, 1); PG8_STAGE(PG8_SB(0, 0), b2, voffB); PG8_STAGE(PG8_SB(0, 1), b2 + hstep, voffB); PG8_STAGE(PG8_SA(0, 0), a2, voffA);
            PG8_WAIT_V(8); PG8_WAIT_L(0); PG8_BAR; PG8_MMA(1, 0, At, B0); PG8_MMA(1, 1, At, B1); PG8_BAR; PG8_SCHED;
            PG8_LDB(B0, 1, 0); PG8_LDB(B1, 1, 1); PG8_SCHED; PG8_LDA(At, 1, 0); PG8_STAGE(PG8_SA(0, 1), a2 + hstep, voffA);
            PG8_WAIT_V(8); PG8_WAIT_L(0); PG8_BAR; PG8_MMA(0, 0, At, B0); PG8_MMA(0, 1, At, B1); PG8_BAR; PG8_SCHED;
            PG8_LDA(At, 1, 1); PG8_STAGE(PG8_SB(1, 0), b3, voffB); PG8_STAGE(PG8_SB(1, 1), b3 + hstep, voffB); PG8_STAGE(PG8_SA(1, 0), a3, voffA);
            PG8_WAIT_V(8); PG8_WAIT_L(0); PG8_BAR; PG8_MMA(1, 0, At, B0); PG8_MMA(1, 1, At, B1); PG8_BAR; PG8_SCHED;
            } else {
            PG8_LDB(B0, 0, 0); PG8_SCHED; PG8_LDA(At, 0, 0); PG8_STAGE(PG8_SA(1, 1), a1 + hstep, voffA);
            PG8_WAIT_L(8); PG8_BAR; PG8_WAIT_L(0); PG8_MMA(0, 0, At, B0); PG8_BAR; PG8_SCHED;
            PG8_LDB(B1, 0, 1); PG8_STAGE(PG8_SB(0, 0), b2, voffB);
            PG8_BAR; PG8_WAIT_L(0); PG8_MMA(0, 1, At, B1); PG8_BAR;
            PG8_LDA(At, 0, 1); PG8_STAGE(PG8_SA(0, 0), a2, voffA);
            PG8_BAR; PG8_WAIT_L(0); PG8_MMA(1, 0, At, B0); PG8_BAR; PG8_SCHED;
            PG8_STAGE(PG8_SB(0, 1), b2 + hstep, voffB);
            PG8_WAIT_V(6); PG8_BAR; PG8_MMA(1, 1, At, B1); PG8_BAR;
            PG8_LDB(B0, 1, 0); PG8_SCHED; PG8_LDA(At, 1, 0); PG8_STAGE(PG8_SA(0, 1), a2 + hstep, voffA);
            PG8_WAIT_L(8); PG8_BAR; PG8_WAIT_L(0); PG8_MMA(0, 0, At, B0); PG8_BAR; PG8_SCHED;
            PG8_LDB(B1, 1, 1); PG8_STAGE(PG8_SB(1, 0), b3, voffB);
            PG8_BAR; PG8_WAIT_L(0); PG8_MMA(0, 1, At, B1); PG8_BAR;
            PG8_LDA(At, 1, 1); PG8_STAGE(PG8_SA(1, 0), a3, voffA);
            PG8_BAR; PG8_WAIT_L(0); PG8_MMA(1, 0, At, B0); PG8_BAR; PG8_SCHED;
            PG8_STAGE(PG8_SB(1, 1), b3 + hstep, voffB);
            PG8_WAIT_V(6); PG8_BAR; PG8_MMA(1, 1, At, B1); PG8_BAR;
            }
        }
        if constexpr (ALIGN_EPI) { if (wr == 0) PG8_BAR; }
        if constexpr (!Epi::AFTER_DRAIN) { E(acc, cur, wr, wc, fr, fq); S.done(cur); }
        if (!has_next) break;
#pragma unroll
        for (int a = 0; a < 2; ++a)
#pragma unroll
            for (int b = 0; b < 2; ++b)
#pragma unroll
                for (int m = 0; m < 4; ++m)
#pragma unroll
                    for (int n = 0; n < 2; ++n) acc[a][b][m][n] = (f32x4){0.f, 0.f, 0.f, 0.f};
        cur = nxt; cA = nA; cB = nB; ++ui;
        if constexpr (ALIGN_EPI) { if (wr == 1) PG8_BAR; }
    }
    PG8_WAIT_V(0);
    if constexpr (!ALIGN_EPI) { if (wr == 0) PG8_BAR; }
    PG8_BAR;
    if constexpr (Epi::AFTER_DRAIN) { E.fused(acc, cur, wr, wc, fr, fq, lds, wid, lane); S.done(cur); }
#undef PG8_SA
#undef PG8_SB
#undef PG8_STAGE
#undef PG8_LDA
#undef PG8_LDB
#undef PG8_MMA
#undef PG8_WAIT_V
#undef PG8_WAIT_L
#undef PG8_BAR
#undef PG8_SCHED
}
}
namespace pg8 {
__device__ __forceinline__ float sigmoidf_(float x) { return __builtin_amdgcn_rcpf(1.0f + __builtin_amdgcn_exp2f(-1.4426950408889634f * x)); }
struct EpiBf16Split {
    static constexpr bool PERM = true, AFTER_DRAIN = false;
    bf16_t* O0; int ld0; int nt0; bf16_t* O1; int ld1;
    __device__ __forceinline__ void operator()(const f32x4 (&acc)[2][2][4][2], const Unit& u, int wr, int wc, int fr, int fq) const {
        const bool first = u.pn < nt0; bf16_t* base = first ? O0 : O1; const int ld = first ? ld0 : ld1; const int colt = (first ? u.pn : u.pn - nt0) * BM;
        const int row0 = u.pm * BM + wr * 64 + fr, col0 = colt + wc * 32 + 8 * fq;
#pragma unroll
        for (int ai = 0; ai < 2; ++ai)
#pragma unroll
            for (int m = 0; m < 4; ++m) { bf16_t* rowp = base + (size_t)(row0 + ai * HALF + m * 16) * ld + col0;
#pragma unroll
                for (int bj = 0; bj < 2; ++bj) { const f32x4 v0 = acc[ai][bj][m][0], v1 = acc[ai][bj][m][1];
                    u32x4 w; w.x = cvt_pk_bf16(v0[0], v0[1]); w.y = cvt_pk_bf16(v0[2], v0[3]); w.z = cvt_pk_bf16(v1[0], v1[1]); w.w = cvt_pk_bf16(v1[2], v1[3]);
                    *(u32x4*)(rowp + bj * HALF) = w; } }
    }
};
struct EpiResF32 {
    static constexpr bool PERM = false, AFTER_DRAIN = false;
    const float* base; float* out; int ldc;
    __device__ __forceinline__ void operator()(const f32x4 (&acc)[2][2][4][2], const Unit& u, int wr, int wc, int fr, int fq) const {
        const int row0 = u.pm * BM + wr * 64 + fr, col0 = u.pn * BM + wc * 32 + 4 * fq;
#pragma unroll
        for (int ai = 0; ai < 2; ++ai)
#pragma unroll
            for (int m = 0; m < 4; ++m) { const size_t off = (size_t)(row0 + ai * HALF + m * 16) * ldc + col0;
#pragma unroll
                for (int bj = 0; bj < 2; ++bj)
#pragma unroll
                    for (int n = 0; n < 2; ++n) { const f32x4 b = *(const f32x4*)(base + off + bj * HALF + n * 16); *(f32x4*)(out + off + bj * HALF + n * 16) = b + acc[ai][bj][m][n]; } }
    }
};
struct EpiSwiglu {
    static constexpr bool PERM = false, AFTER_DRAIN = false;
    bf16_t* H; int ldh;
    __device__ __forceinline__ void operator()(const f32x4 (&acc)[2][2][4][2], const Unit& u, int wr, int wc, int fr, int fq) const {
        const int row0 = u.pm * BM + wr * 64 + fr, hc0 = u.pn * (BM / 2) + wc * 16 + 4 * fq;
#pragma unroll
        for (int ai = 0; ai < 2; ++ai)
#pragma unroll
            for (int m = 0; m < 4; ++m) { bf16_t* rowp = H + (size_t)(row0 + ai * HALF + m * 16) * ldh + hc0;
#pragma unroll
                for (int bj = 0; bj < 2; ++bj) { const f32x4 g = acc[ai][bj][m][0], up = acc[ai][bj][m][1]; float h[4];
#pragma unroll
                    for (int i = 0; i < 4; ++i) h[i] = g[i] * sigmoidf_(g[i]) * up[i];
                    typedef unsigned u32x2 __attribute__((ext_vector_type(2)));
                    u32x2 w; w.x = cvt_pk_bf16(h[0], h[1]); w.y = cvt_pk_bf16(h[2], h[3]);
                    *(u32x2*)(rowp + bj * (HALF / 2)) = w; } }
    }
};
struct EpiPle {
    static constexpr bool PERM = false, AFTER_DRAIN = false;
    const float* base; float* out; const bf16_t* E; int ldc;
    __device__ __forceinline__ void operator()(const f32x4 (&acc)[2][2][4][2], const Unit& u, int wr, int wc, int fr, int fq) const {
        const int row0 = u.pm * BM + wr * 64 + fr, col0 = u.pn * BM + wc * 32 + 4 * fq;
        typedef unsigned u32x2 __attribute__((ext_vector_type(2)));
#pragma unroll
        for (int ai = 0; ai < 2; ++ai)
#pragma unroll
            for (int m = 0; m < 4; ++m) { const size_t off = (size_t)(row0 + ai * HALF + m * 16) * ldc + col0;
#pragma unroll
                for (int bj = 0; bj < 2; ++bj)
#pragma unroll
                    for (int n = 0; n < 2; ++n) { const size_t o = off + bj * HALF + n * 16; const f32x4 b = *(const f32x4*)(base + o); const u32x2 e = *(const u32x2*)(E + o); const f32x4 a = acc[ai][bj][m][n];
                        f32x4 r; r[0] = b[0] + __uint_as_float(e.x << 16) * sigmoidf_(a[0]); r[1] = b[1] + __uint_as_float(e.x & 0xffff0000u) * sigmoidf_(a[1]);
                        r[2] = b[2] + __uint_as_float(e.y << 16) * sigmoidf_(a[2]); r[3] = b[3] + __uint_as_float(e.y & 0xffff0000u) * sigmoidf_(a[3]);
                        *(f32x4*)(out + o) = r; } }
    }
};
}
#ifndef PG8_SP2
#define PG8_SP2 true
#endif
#ifndef PG8_ALIGN
#define PG8_ALIGN true
#endif
constexpr int NB = 32, SEQ = 2048, T = NB * SEQ, D = 1024;
constexpr int NU = 2816, UA_W = 1024, UB_W = 1792;
constexpr int FF = 2816, CI = 2048, TH = T / 2;
constexpr int NWAVES = 8;
constexpr float NORM_EPS = 1e-6f, LOG2E = 1.4426950408889634f;
constexpr int UA_K = 512, UA_V = 576, UA_IQ = 640, UA_IK = 896, UA_IW = 960;
constexpr size_t MiB = 1u << 20, QMiB = 1u << 18;
constexpr size_t WS_CTL = 0, CTL_ZERO_BYTES = 1 * MiB;
constexpr size_t WS_WIN = 4 * QMiB, WS_WLORA = 26 * QMiB, WS_WOUT = 29 * QMiB;
constexpr size_t WS_WGU0 = 37 * QMiB, WS_WD0 = 81 * QMiB, WS_WPLE0 = 103 * QMiB, WS_WPG0 = 105 * QMiB, WS_LAYER_STRIDE = 76 * QMiB;
constexpr size_t WS_WUP = 189 * QMiB, WS_WDOWN = 221 * QMiB, WS_W12 = 237 * QMiB;
static_assert(WS_WPG0 + 8 * QMiB == WS_WGU0 + WS_LAYER_STRIDE && WS_WPG0 + WS_LAYER_STRIDE + 8 * QMiB == WS_WUP && WS_W12 + QMiB <= 60 * MiB, "weight map");
constexpr size_t ACT = 60 * MiB;
constexpr size_t WS_XB = ACT, WS_UA = ACT + 128 * MiB, WS_UB = ACT + 256 * MiB, WS_LIN = ACT + 480 * MiB, WS_LOUT = ACT + 512 * MiB;
constexpr size_t WS_QN = ACT + 704 * MiB, WS_KN = ACT + 768 * MiB, WS_VT = ACT + 776 * MiB, WS_MASK = ACT + 784 * MiB, WS_SCR = ACT + 800 * MiB;
constexpr size_t WS_H = ACT + 128 * MiB, WS_E = ACT + 480 * MiB, WS_PB = ACT + 608 * MiB;
constexpr size_t WS_XBH = ACT, WS_XM = ACT + 64 * MiB, WS_Z = ACT + 192 * MiB, WS_XC = ACT + 320 * MiB, WS_Q = ACT + 448 * MiB, WS_K = ACT + 576 * MiB, WS_V = ACT + 704 * MiB;
constexpr size_t WS_GI = ACT + 832 * MiB, WS_GA = WS_GI + 1 * MiB, WS_GAM = WS_GI + 2 * MiB, WS_GEM = WS_GI + 3 * MiB;
constexpr size_t WS_END = ACT + 961 * MiB;
static_assert(WS_END <= 1024 * MiB, "workspace");
constexpr int CW_TMO = 0, CW_BAR = 4096;
constexpr int LDS_BYTES = 155648;
constexpr int MISC_OFF = LDS_BYTES - 256;
#define GAS __attribute__((address_space(1)))
#define LAS __attribute__((address_space(3)))
typedef unsigned short bf16;
typedef unsigned v4u __attribute__((ext_vector_type(4)));
typedef unsigned v2u __attribute__((ext_vector_type(2)));
typedef float f32x4 __attribute__((ext_vector_type(4)));
typedef float f32x2 __attribute__((ext_vector_type(2)));
typedef float f32x8 __attribute__((ext_vector_type(8)));
typedef short bf16x8 __attribute__((ext_vector_type(8)));
typedef short s16x4 __attribute__((ext_vector_type(4)));
typedef GAS unsigned gu32;
#define RLX_AGENT __ATOMIC_RELAXED, __HIP_MEMORY_SCOPE_AGENT
#define LDS_WAIT() asm volatile("s_waitcnt lgkmcnt(0)" ::: "memory")
#define VM_WAIT() asm volatile("s_waitcnt vmcnt(0)" ::: "memory")
__device__ __forceinline__ unsigned f2bf(float f) { unsigned u = __builtin_bit_cast(unsigned, f); return (u + 0x7fffu + ((u >> 16) & 1u)) >> 16; }

#define XB_TMO      128
#define XB_XCNT(j)  (256  + 64 * (j))
#define XB_XSUB(j)  (1280 + 64 * (j))
#define XB_XGEN(j)  (2304 + 64 * (j))
#define XB_TOP      3328
#define XB_TOPGEN   3392
#define XCD_BAR_WORDS 3456
#define XB_SPIN_CAP (1u << 18)

__device__ __forceinline__ unsigned xb_ld(unsigned* p)              { return __hip_atomic_load(p, __ATOMIC_RELAXED, __HIP_MEMORY_SCOPE_AGENT); }
__device__ __forceinline__ unsigned xb_add(unsigned* p, unsigned v) { return __hip_atomic_fetch_add(p, v, __ATOMIC_RELAXED, __HIP_MEMORY_SCOPE_AGENT); }
__device__ __forceinline__ unsigned xb_xcc_id() { return (unsigned)__builtin_amdgcn_s_getreg((3 << 11) | 20) & 0xFu; }
#define XB_SPIN(cond, bar) do { unsigned _sp = 0; while (cond) { __builtin_amdgcn_s_sleep(1); \
    if ((++_sp & 255u) == 0u) { if (xb_ld(&(bar)[XB_TMO])) break; if (_sp > XB_SPIN_CAP) { atomicAdd(&(bar)[XB_TMO], 1u); break; } } } } while (0)

struct XcdBarrier {
    unsigned* bar; unsigned x;
    volatile LAS unsigned* st;
};

__device__ __forceinline__ XcdBarrier xcd_barrier_post(unsigned* bar, volatile LAS unsigned* st) {
    XcdBarrier b; b.bar = bar; b.x = xb_xcc_id(); b.st = st;
    if (threadIdx.x == 0) (void)xb_add(&bar[XB_XCNT(b.x)], 1u);
    return b;
}
__device__ __forceinline__ void xcd_barrier_complete(unsigned* bar, unsigned x, unsigned& nloc, unsigned& nx) {
    const unsigned G = gridDim.x * gridDim.y * gridDim.z;
    unsigned sum, cnt, mine, sp = 0u;
    for (;;) {
        sum = 0u; cnt = 0u; mine = 0u;
#pragma unroll
        for (unsigned j = 0; j < 16; ++j) { const unsigned c = xb_ld(&bar[XB_XCNT(j)]); sum += c; cnt += (c > 0u) ? 1u : 0u; mine = (j == x) ? c : mine; }
        if (sum == G) break;
        __builtin_amdgcn_s_sleep(1);
        if ((++sp & 255u) == 0u) { if (xb_ld(&bar[XB_TMO])) break; if (sp > XB_SPIN_CAP) { atomicAdd(&bar[XB_TMO], 1u); break; } }
    }
    nloc = mine > 0u ? mine : 1u; nx = cnt > 0u ? cnt : 1u;
}

__device__ __forceinline__ void xcd_barrier(const XcdBarrier& b) {
    asm volatile("s_waitcnt vmcnt(0)" ::: "memory");
    __syncthreads();
    if (threadIdx.x == 0) {
        unsigned* bar = b.bar;
        __builtin_amdgcn_s_waitcnt(0);
        unsigned nloc = b.st[0], nx = b.st[1];
        if (nloc == 0u) { xcd_barrier_complete(bar, b.x, nloc, nx); b.st[0] = nloc; b.st[1] = nx; }
        const unsigned old = xb_add(&bar[XB_XSUB(b.x)], 1u);
        const unsigned gen = old / nloc;
        if (old + 1u == (gen + 1u) * nloc) {
            __builtin_amdgcn_fence(__ATOMIC_RELEASE, "agent");
            asm volatile("s_waitcnt vmcnt(0)" ::: "memory");
            const unsigned og = xb_add(&bar[XB_TOP], 1u);
            const unsigned tg = og / nx;
            if (og + 1u == (tg + 1u) * nx) xb_add(&bar[XB_TOPGEN], 1u);
            else XB_SPIN(xb_ld(&bar[XB_TOPGEN]) == tg, bar);
            __builtin_amdgcn_fence(__ATOMIC_ACQUIRE, "agent");
            xb_add(&bar[XB_XGEN(b.x)], 1u);
            asm volatile("s_waitcnt vmcnt(0)" ::: "memory");
        } else {
            XB_SPIN(xb_ld(&bar[XB_XGEN(b.x)]) == gen, bar);
            __builtin_amdgcn_fence(__ATOMIC_ACQUIRE, "agent");
            asm volatile("s_waitcnt vmcnt(0)" ::: "memory");
        }
    }
    __syncthreads();
}

struct Frame {
    LAS unsigned char* lds;
    unsigned char* ws;
    const float* const* in;
    int tid, lane, wave, G, bid;
};
struct Args { const float* in[37]; float* out; unsigned char* ws; int ph_lo, ph_hi, use_bar, pad; };

__device__ __forceinline__ float wave_sum(float v) {
#pragma unroll
    for (int o = 1; o < 64; o <<= 1) v += __shfl_xor(v, o);
    return v;
}
__device__ __forceinline__ float wave_max(float v) {
#pragma unroll
    for (int o = 1; o < 64; o <<= 1) v = fmaxf(v, __shfl_xor(v, o));
    return v;
}
__device__ __forceinline__ float bflo(unsigned u) { return __uint_as_float(u << 16); }
__device__ __forceinline__ float bfhi(unsigned u) { return __uint_as_float(u & 0xffff0000u); }
__device__ __forceinline__ float bf1(bf16 h) { return __uint_as_float(((unsigned)h) << 16); }
__device__ __forceinline__ unsigned pk2(float lo, float hi) { return pg8::cvt_pk_bf16(lo, hi); }
__device__ __forceinline__ float sigm(float x) { return 1.0f / (1.0f + __expf(-x)); }
__device__ __forceinline__ float softplusf_(float x) { return fmaxf(x, 0.f) + log1pf(__expf(-fabsf(x))); }
__device__ __forceinline__ void unpack8(const v4u& r, float (&f)[8]) { f[0] = bflo(r.x); f[1] = bfhi(r.x); f[2] = bflo(r.y); f[3] = bfhi(r.y); f[4] = bflo(r.z); f[5] = bfhi(r.z); f[6] = bflo(r.w); f[7] = bfhi(r.w); }
__device__ __forceinline__ v4u pack8(const float (&f)[8]) { v4u o; o.x = pk2(f[0], f[1]); o.y = pk2(f[2], f[3]); o.z = pk2(f[4], f[5]); o.w = pk2(f[6], f[7]); return o; }

template <class Fn> __device__ __forceinline__ void wprep(bf16* dst, int N, int K, Fn f, int gt, int NT) {
    const int items = N * (K >> 3);
    for (int it = gt; it < items; it += NT) { const int n = it % N, k0 = (it / N) << 3; float v[8];
#pragma unroll
        for (int j = 0; j < 8; ++j) v[j] = f(k0 + j, n);
        *(v4u*)(dst + (size_t)n * K + k0) = pack8(v); }
}
__device__ __forceinline__ void phase_prologue(Frame& F, const Args& a) {
    const int gt = F.bid * 512 + F.tid, NT = F.G * 512; unsigned char* ws = F.ws;
    { const float* W = a.in[5];
      wprep((bf16*)(ws + WS_WIN), NU, D, [=](int k, int n) { const int c = n < 964 ? n : (n < 1024 ? -1 : n - 60); return c < 0 ? 0.f : W[(size_t)k * 2756 + c]; }, gt, NT); }
    { const float* w2 = a.in[8]; const float* a2 = a.in[10]; const float* g2 = a.in[11];
      wprep((bf16*)(ws + WS_WLORA), 1536, 256, [=](int k, int n) { if (n < 512) return k < 64 ? w2[k * 512 + n] : 0.f; if (n < 1024) return (k >= 64 && k < 128) ? a2[(k - 64) * 512 + n - 512] : 0.f; return k >= 128 ? g2[(k - 128) * 512 + n - 1024] : 0.f; }, gt, NT); }
    { const float* W = a.in[17]; wprep((bf16*)(ws + WS_WOUT), D, D, [=](int k, int n) { return W[(size_t)k * D + n]; }, gt, NT); }
    for (int L = 0; L < 2; ++L) {
        const float* wg = a.in[31] + (size_t)L * D * FF; const float* wu = a.in[32] + (size_t)L * D * FF; const float* wd = a.in[33] + (size_t)L * FF * D;
        const float* wp = a.in[34] + (size_t)L * 256 * D; const float* wpg = a.in[36] + (size_t)L * D * D;
        wprep((bf16*)(ws + WS_WGU0 + L * WS_LAYER_STRIDE), 2 * FF, D, [=](int k, int n) { const int hid = 16 * (n >> 5) + (n & 15); return ((n & 31) >= 16 ? wu : wg)[(size_t)k * FF + hid]; }, gt, NT);
        wprep((bf16*)(ws + WS_WD0 + L * WS_LAYER_STRIDE), D, FF, [=](int k, int n) { return wd[(size_t)k * D + n]; }, gt, NT);
        wprep((bf16*)(ws + WS_WPLE0 + L * WS_LAYER_STRIDE), D, 256, [=](int k, int n) { return wp[(size_t)k * D + n]; }, gt, NT);
        wprep((bf16*)(ws + WS_WPG0 + L * WS_LAYER_STRIDE), D, D, [=](int k, int n) { return wpg[(size_t)k * D + n]; }, gt, NT);
    }
    { const float* W = a.in[18]; wprep((bf16*)(ws + WS_WUP), 2 * CI, D, [=](int k, int n) { return W[(size_t)k * (2 * CI) + n]; }, gt, NT); }
    { const float* W = a.in[29]; wprep((bf16*)(ws + WS_WDOWN), D, CI, [=](int k, int n) { return W[(size_t)k * D + n]; }, gt, NT); }
    { const float* wq = a.in[21]; const float* wk = a.in[22]; const float* wv = a.in[23]; const float* wif = a.in[24]; float* W12 = (float*)(ws + WS_W12);
      for (int it = gt; it < 4096 * 8; it += NT) { const int o = it & 7, c = (it >> 3) & 2047, part = it >> 14, g = c >> 2, i = c & 3; float s = 0.f;
          if (part == 0) { for (int j = 0; j < 4; ++j) s += wq[(g * 4 + i) * 4 + j] * wif[(size_t)(4 * g + j) * 8 + o] + wk[(g * 4 + i) * 4 + j] * wif[(size_t)(2048 + 4 * g + j) * 8 + o]; }
          else { for (int j = 0; j < 4; ++j) s += wv[(g * 4 + i) * 4 + j] * wif[(size_t)(4096 + 4 * g + j) * 8 + o]; }
          W12[it] = s; } }
}
__device__ __forceinline__ void phase_norm(Frame& F, const float* src, const float* gain, bf16* dst, int nrows) {
    const int gw = F.bid * NWAVES + F.wave, NGW = F.G * NWAVES, lane = F.lane;
    f32x4 g[4];
#pragma unroll
    for (int j = 0; j < 4; ++j) g[j] = *((const f32x4*)gain + lane + 64 * j);
    for (int m = gw; m < nrows; m += NGW) {
        const f32x4* xr = (const f32x4*)(src + (size_t)m * D) + lane; f32x4 v[4]; float s = 0.f;
#pragma unroll
        for (int j = 0; j < 4; ++j) { v[j] = xr[64 * j]; s += (v[j].x * v[j].x + v[j].y * v[j].y) + (v[j].z * v[j].z + v[j].w * v[j].w); }
        const float r = rsqrtf(wave_sum(s) * (1.f / D) + NORM_EPS);
        v2u* o = (v2u*)(dst + (size_t)m * D) + lane;
#pragma unroll
        for (int j = 0; j < 4; ++j) { v2u w; w.x = pk2(v[j].x * r * g[j].x, v[j].y * r * g[j].y); w.y = pk2(v[j].z * r * g[j].z, v[j].w * r * g[j].w); o[64 * j] = w; }
    }
}
__device__ __forceinline__ void phase_cvt_p(Frame& F, const float* p, bf16* pb) {
    const size_t gt = (size_t)F.bid * 512 + F.tid, NT = (size_t)F.G * 512, n8 = (size_t)T * 256 / 8;
    for (size_t i = gt; i < n8; i += NT) { const f32x4 a = *((const f32x4*)p + 2 * i), b = *((const f32x4*)p + 2 * i + 1); v4u o; o.x = pk2(a.x, a.y); o.y = pk2(a.z, a.w); o.z = pk2(b.x, b.y); o.w = pk2(b.z, b.w); *((v4u*)pb + i) = o; }
}
constexpr float QSCALE = 0.125f * LOG2E;
__device__ __forceinline__ void phase_prepA(Frame& F, const Args& a) {
    unsigned char* ws = F.ws; const bf16* UA = (const bf16*)(ws + WS_UA); const bf16* UB = (const bf16*)(ws + WS_UB);
    bf16* LIN = (bf16*)(ws + WS_LIN); bf16* QN = (bf16*)(ws + WS_QN); bf16* KN = (bf16*)(ws + WS_KN); bf16* VT = (bf16*)(ws + WS_VT);
    const float* mu = a.in[6]; const float* gq = a.in[3]; const float* gk = a.in[4];
    { const int gt = F.bid * 512 + F.tid, NT = F.G * 512;
      for (int it = gt; it < T * 32; it += NT) { const int t = it >> 5, c8 = (it & 31) << 3;
          float u[8], p[8], o[8]; unpack8(*(const v4u*)(UB + (size_t)t * UB_W + 1536 + c8), u);
          if ((t & (SEQ - 1)) != 0) unpack8(*(const v4u*)(UB + (size_t)(t - 1) * UB_W + 1536 + c8), p); else { for (int j = 0; j < 8; ++j) p[j] = 0.f; }
#pragma unroll
          for (int j = 0; j < 8; ++j) { const float s = u[j] + mu[1536 + c8 + j] * (p[j] - u[j]); o[j] = c8 < 64 ? tanhf(s) : (c8 < 128 ? s : sigm(s)); }
          *(v4u*)(LIN + (size_t)t * 256 + c8) = pack8(o); } }
    { const int gw = F.bid * NWAVES + F.wave, NGW = F.G * NWAVES, lane = F.lane; float gqv[8], gkv[8];
#pragma unroll
      for (int j = 0; j < 8; ++j) { gqv[j] = gq[((lane & 7) << 3) + j] * QSCALE; gkv[j] = gk[((lane & 7) << 3) + j]; }
      for (int t = gw; t < T; t += NGW) {
          float q[8], k[8]; unpack8(*(const v4u*)(UA + (size_t)t * UA_W + 8 * lane), q); unpack8(*(const v4u*)(UA + (size_t)t * UA_W + UA_K + 8 * (lane & 7)), k);
          float sq = 0.f, sk = 0.f;
#pragma unroll
          for (int j = 0; j < 8; ++j) { sq += q[j] * q[j]; sk += k[j] * k[j]; }
          sq += __shfl_xor(sq, 1); sq += __shfl_xor(sq, 2); sq += __shfl_xor(sq, 4); sk += __shfl_xor(sk, 1); sk += __shfl_xor(sk, 2); sk += __shfl_xor(sk, 4);
          const float rq = rsqrtf(sq * (1.f / 64.f) + NORM_EPS), rk = rsqrtf(sk * (1.f / 64.f) + NORM_EPS);
#pragma unroll
          for (int j = 0; j < 8; ++j) { q[j] *= rq * gqv[j]; k[j] *= rk * gkv[j]; }
          *(v4u*)(QN + (size_t)t * 512 + 8 * lane) = pack8(q);
          if (lane < 8) *(v4u*)(KN + (size_t)t * 64 + 8 * lane) = pack8(k); } }
    { LAS bf16* tile = (LAS bf16*)F.lds;
      for (int u = F.bid; u < T / 64; u += F.G) { const int t0 = u * 64, b = t0 / SEQ, s0 = t0 % SEQ; const int tok = F.tid >> 3, c8 = (F.tid & 7) << 3;
          *(LAS v4u*)(tile + tok * 72 + c8) = *(const v4u*)(UA + (size_t)(t0 + tok) * UA_W + UA_V + c8);
          __syncthreads();
          const int d = F.tid >> 3, s8 = (F.tid & 7) << 3; v4u o; unsigned short e[8];
#pragma unroll
          for (int j = 0; j < 8; ++j) e[j] = tile[(s8 + j) * 72 + d];
          o.x = e[0] | ((unsigned)e[1] << 16); o.y = e[2] | ((unsigned)e[3] << 16); o.z = e[4] | ((unsigned)e[5] << 16); o.w = e[6] | ((unsigned)e[7] << 16);
          *(v4u*)(VT + ((size_t)b * 64 + d) * SEQ + s0 + s8) = o;
          __syncthreads(); } }
}
constexpr int IDX_STRIDE = 2052, KSEL = 256;
__device__ __forceinline__ void topk_select(const LAS float* row, int limit, unsigned* maskrow, int lane) {
    unsigned long long mybits = 0ull; const int nj = limit >> 6;
    if (limit <= KSEL) { mybits = lane < nj ? ~0ull : 0ull; }
    else {
        unsigned key[32];
#pragma unroll
        for (int j = 0; j < 32; ++j) { unsigned k = 0u; if (j < nj) { unsigned u = __float_as_uint(row[64 * j + lane]); if (u == 0x80000000u) u = 0u; k = (u & 0x80000000u) ? ~u : (u | 0x80000000u); } key[j] = k; }
        unsigned prefix = 0u; bool exact = false;
        for (int bit = 31; bit >= 0; --bit) { const unsigned cand = prefix | (1u << bit); int cnt = 0;
#pragma unroll
            for (int j = 0; j < 32; ++j) if (j < nj) cnt += __builtin_popcountll(__ballot(key[j] >= cand));
            if (cnt >= KSEL) { prefix = cand; if (cnt == KSEL) { exact = true; break; } } }
        int need = 0;
        if (!exact) { int cgt = 0;
#pragma unroll
            for (int j = 0; j < 32; ++j) if (j < nj) cgt += __builtin_popcountll(__ballot(key[j] > prefix));
            need = KSEL - cgt; }
        int running = 0; const unsigned long long below = (1ull << lane) - 1ull;
#pragma unroll
        for (int j = 0; j < 32; ++j) if (j < nj) {
            const bool gt = exact ? (key[j] >= prefix) : (key[j] > prefix); const bool tie = (!exact) && key[j] == prefix;
            const unsigned long long tb = __ballot(tie); const int rank = running + __builtin_popcountll(tb & below); running += __builtin_popcountll(tb);
            const unsigned long long sb = __ballot(gt || (tie && rank < need)); if (lane == j) mybits = sb; }
    }
    if (lane < 32) { v2u w; w.x = (unsigned)mybits; w.y = (unsigned)(mybits >> 32); *(v2u*)(maskrow + 2 * lane) = w; }
}
__device__ __forceinline__ void phase_indexer(Frame& F) {
    unsigned char* ws = F.ws; const bf16* UA = (const bf16*)(ws + WS_UA); unsigned* MASK = (unsigned*)(ws + WS_MASK);
    LAS float* sc = (LAS float*)F.lds; const int lane = F.lane, w = F.wave, fr = lane & 15, fq = lane >> 4;
    for (int r = 0;; ++r) { const int u = r * F.G + ((r & 1) ? (F.G - 1 - F.bid) : F.bid); if (u >= NB * 128) break;
        const int c = 31 - (u >> 7), rest = u & 127, b = rest >> 2, g4 = rest & 3, limit = 64 * (c + 1), tq0 = b * SEQ + c * 64 + g4 * 16;
        const bf16* UAb = UA + (size_t)b * SEQ * UA_W;
        bf16x8 qf[4][2]; float iwv[4];
        { const bf16* qp = UA + (size_t)(tq0 + fr) * UA_W;
#pragma unroll
          for (int hh = 0; hh < 4; ++hh) { qf[hh][0] = *(const bf16x8*)(qp + UA_IQ + hh * 64 + fq * 8); qf[hh][1] = *(const bf16x8*)(qp + UA_IQ + hh * 64 + 32 + fq * 8); iwv[hh] = bf1(qp[UA_IW + hh]) * (1.f / 16.f); } }
        for (int kt = w; kt < (limit >> 4); kt += NWAVES) {
            const bf16* kp = UAb + (size_t)(kt * 16 + fr) * UA_W + UA_IK + fq * 8; const bf16x8 a0 = *(const bf16x8*)kp, a1 = *(const bf16x8*)(kp + 32);
            f32x4 s = {0.f, 0.f, 0.f, 0.f};
#pragma unroll
            for (int hh = 0; hh < 4; ++hh) { f32x4 d = {0.f, 0.f, 0.f, 0.f}; d = __builtin_amdgcn_mfma_f32_16x16x32_bf16(a0, qf[hh][0], d, 0, 0, 0); d = __builtin_amdgcn_mfma_f32_16x16x32_bf16(a1, qf[hh][1], d, 0, 0, 0);
#pragma unroll
                for (int j = 0; j < 4; ++j) s[j] += iwv[hh] * fmaxf(d[j], 0.f); }
            *(LAS f32x4*)(sc + fr * IDX_STRIDE + kt * 16 + fq * 4) = s; }
        __syncthreads();
#pragma unroll 1
        for (int qq = 0; qq < 2; ++qq) { const int q = 2 * w + qq; topk_select(sc + q * IDX_STRIDE, limit, MASK + (size_t)(tq0 + q) * 64, lane); }
        __syncthreads(); }
}
__device__ __forceinline__ bf16x8 mk8(v2u lo, v2u hi) { v4u t; t.x = lo.x; t.y = lo.y; t.z = hi.x; t.w = hi.y; return __builtin_bit_cast(bf16x8, t); }
__device__ __forceinline__ void phase_dsa_attn(Frame& F, const Args& a) {
    unsigned char* ws = F.ws; const bf16* QN = (const bf16*)(ws + WS_QN); const bf16* KN = (const bf16*)(ws + WS_KN); const bf16* VT = (const bf16*)(ws + WS_VT);
    const unsigned* MASK = (const unsigned*)(ws + WS_MASK); bf16* MIX = (bf16*)(ws + WS_XB);
    const int lane = F.lane, w = F.wave, fr = lane & 15, fq = lane >> 4;
    const float mb = 8.f * LOG2E * wave_max(fabsf(a.in[3][lane])) * wave_max(fabsf(a.in[4][lane]));
    for (int r = 0;; ++r) { const int u = r * F.G + ((r & 1) ? (F.G - 1 - F.bid) : F.bid); if (u >= NB * 32) break;
        const int c = 31 - (u >> 5), b = u & 31, limit = 64 * (c + 1), t0 = b * SEQ + 64 * c;
        bf16x8 qf[4][2];
#pragma unroll
        for (int i = 0; i < 4; ++i) { const bf16* qp = QN + (size_t)(t0 + 16 * i + fr) * 512 + w * 64 + fq * 8; qf[i][0] = *(const bf16x8*)qp; qf[i][1] = *(const bf16x8*)(qp + 32); }
        f32x4 O[4][4]; float l[4];
#pragma unroll
        for (int i = 0; i < 4; ++i) { l[i] = 0.f;
#pragma unroll
            for (int dt = 0; dt < 4; ++dt) O[i][dt] = (f32x4){0.f, 0.f, 0.f, 0.f}; }
        const bf16* Kb = KN + (size_t)b * SEQ * 64; const bf16* Vb = VT + (size_t)b * 64 * SEQ; const unsigned* Mb = MASK + (size_t)t0 * 64;
        for (int kt = 0; kt < (limit >> 5); ++kt) {
            bf16x8 kf[2][2], vf[4]; unsigned mw[4];
#pragma unroll
            for (int s2 = 0; s2 < 2; ++s2) { const bf16* kp = Kb + (size_t)(32 * kt + 16 * s2 + fr) * 64 + fq * 8; kf[s2][0] = *(const bf16x8*)kp; kf[s2][1] = *(const bf16x8*)(kp + 32); }
#pragma unroll
            for (int dt = 0; dt < 4; ++dt) { const bf16* vp = Vb + (size_t)(16 * dt + fr) * SEQ + 32 * kt + 4 * fq; vf[dt] = mk8(*(const v2u*)vp, *(const v2u*)(vp + 16)); }
#pragma unroll
            for (int i = 0; i < 4; ++i) mw[i] = Mb[(size_t)(16 * i + fr) * 64 + kt];
#pragma unroll
            for (int i = 0; i < 4; ++i) {
                f32x4 s0 = {0.f, 0.f, 0.f, 0.f}, s1 = {0.f, 0.f, 0.f, 0.f};
                s0 = __builtin_amdgcn_mfma_f32_16x16x32_bf16(kf[0][0], qf[i][0], s0, 0, 0, 0); s0 = __builtin_amdgcn_mfma_f32_16x16x32_bf16(kf[0][1], qf[i][1], s0, 0, 0, 0);
                s1 = __builtin_amdgcn_mfma_f32_16x16x32_bf16(kf[1][0], qf[i][0], s1, 0, 0, 0); s1 = __builtin_amdgcn_mfma_f32_16x16x32_bf16(kf[1][1], qf[i][1], s1, 0, 0, 0);
                const unsigned b0 = mw[i] >> (4 * fq), b1 = mw[i] >> (16 + 4 * fq); float p[8];
#pragma unroll
                for (int j = 0; j < 4; ++j) { p[j] = ((b0 >> j) & 1u) ? __builtin_amdgcn_exp2f(s0[j] - mb) : 0.f; p[4 + j] = ((b1 >> j) & 1u) ? __builtin_amdgcn_exp2f(s1[j] - mb) : 0.f; }
                l[i] += ((p[0] + p[1]) + (p[2] + p[3])) + ((p[4] + p[5]) + (p[6] + p[7]));
                const bf16x8 pa = __builtin_bit_cast(bf16x8, pack8(p));
#pragma unroll
                for (int dt = 0; dt < 4; ++dt) O[i][dt] = __builtin_amdgcn_mfma_f32_16x16x32_bf16(pa, vf[dt], O[i][dt], 0, 0, 0);
            } }
#pragma unroll
        for (int i = 0; i < 4; ++i) { float li = l[i]; li += __shfl_xor(li, 16); li += __shfl_xor(li, 32);
#pragma unroll
            for (int j = 0; j < 4; ++j) { const float inv = 1.0f / __shfl(li, 4 * fq + j); bf16* op = MIX + (size_t)(t0 + 16 * i + 4 * fq + j) * D + w * 64 + fr;
#pragma unroll
                for (int dt = 0; dt < 4; ++dt) op[16 * dt] = (bf16)f2bf(O[i][dt][j] * inv); } }
    }
}
typedef unsigned u32x16 __attribute__((ext_vector_type(16)));
__device__ __forceinline__ void sload24(f32x8& W_, u32x16& P_, const float* p) { asm volatile("s_load_dwordx8 %0, %2, 0x0\n\ts_load_dwordx16 %1, %2, 0x20" : "=&s"(W_), "=&s"(P_) : "s"(p) : "memory"); }
#define SWAIT2(W_, P_) asm volatile("s_waitcnt lgkmcnt(0)" : "+s"(W_), "+s"(P_) :: "memory")
__device__ __forceinline__ float sbf(unsigned u, int j) { return (j & 1) ? __uint_as_float(u & 0xffff0000u) : __uint_as_float(u << 16); }
constexpr int SCR_CHUNK = 24, SCR_STEP = 8 * SCR_CHUNK;
constexpr size_t SCR_BLK_BYTES = (size_t)SEQ * SCR_STEP * 4;
constexpr int SCR_NA = 85;
static_assert((size_t)SCR_NA * SCR_BLK_BYTES <= 128 * MiB && WS_QN + (size_t)(256 - SCR_NA) * SCR_BLK_BYTES <= 1024 * MiB, "scan scratch");
__device__ __forceinline__ void phase_rwkv(Frame& F, const Args& a) {
    unsigned char* ws = F.ws; const bf16* UB = (const bf16*)(ws + WS_UB); const bf16* LOUT = (const bf16*)(ws + WS_LOUT); bf16* MIX = (bf16*)(ws + WS_XB);
    const float* mu = a.in[6]; const float* w0 = a.in[7]; const float* a0 = a.in[9]; const float* k_k = a.in[12]; const float* k_a = a.in[13]; const float* r_k = a.in[14]; const float* gn_g = a.in[15]; const float* gn_b = a.in[16];
    const int lane = F.lane, w = F.wave;
    LAS float* vx_s = (LAS float*)F.lds;
    LAS float* g_s = vx_s + 4096;
    LAS float* yacc = g_s + 4096;
    LAS float* bonus_s = yacc + 4096;
    LAS float* part = bonus_s + 64;
    for (int bh = F.bid; bh < NB * 8; bh += F.G) {
        const int b = bh >> 3, h = bh & 7, c = h * 64 + lane;
        float* scr = (float*)(F.bid < SCR_NA ? ws + WS_UA + (size_t)F.bid * SCR_BLK_BYTES : ws + WS_QN + (size_t)(F.bid - SCR_NA) * SCR_BLK_BYTES);
        const float mur = mu[c], muk = mu[512 + c], muv = mu[1024 + c], w0c = w0[c], a0c = a0[c], kkc = k_k[c], kac = k_a[c], rkc = r_k[c], gng = gn_g[c], gnb = gn_b[c];
        float S[8];
#pragma unroll
        for (int j = 0; j < 8; ++j) S[j] = 0.f;
        for (int batch = 0; batch < SEQ / 64; ++batch) {
            float* sb = scr + (size_t)batch * 64 * SCR_STEP;
            for (int i = 0; i < 8; ++i) { const int step = w + 8 * i, sl = batch * 64 + step; const size_t t = (size_t)b * SEQ + sl;
                const bf16* up = UB + t * UB_W + c; float ur = bf1(up[0]), uk = bf1(up[512]), uv = bf1(up[1024]), pr = 0.f, pk = 0.f, pv = 0.f;
                if (sl > 0) { pr = bf1(up[-UB_W]); pk = bf1(up[512 - UB_W]); pv = bf1(up[1024 - UB_W]); }
                const float rr = ur + mur * (pr - ur), kx = uk + muk * (pk - uk), vx = uv + muv * (pv - uv);
                const bf16* lp = LOUT + t * 1536 + c; const float wd = bf1(lp[0]), ad = bf1(lp[512]), gg = bf1(lp[1024]);
                const float wraw = -softplusf_(-(w0c + wd)) - 0.5f, decay = __expf(-__expf(wraw)), av = sigm(a0c + ad);
                float kk = kx * kkc; const float nrm = sqrtf(wave_sum(kk * kk)); kk = kk / fmaxf(nrm, 1e-12f);
                const float km = kx * (1.f + (av - 1.f) * kac); const float bon = wave_sum(rr * km * rkc);
                float* sp = sb + step * SCR_STEP + (lane >> 3) * SCR_CHUNK; bf16* sh = (bf16*)(sp + 8) + (lane & 7);
                sp[lane & 7] = decay; sh[0] = (bf16)f2bf(-kk); sh[8] = (bf16)f2bf(kk * av); sh[16] = (bf16)f2bf(km); sh[24] = (bf16)f2bf(rr);
                vx_s[step * 64 + lane] = vx; g_s[step * 64 + lane] = gg; yacc[step * 64 + lane] = 0.f; if (lane == 0) bonus_s[step] = bon; }
            VM_WAIT(); LDS_WAIT(); __syncthreads();
            const float* wp = sb + w * SCR_CHUNK;
            f32x8 Aw, Bw; u32x16 Ap, Bp;
            sload24(Aw, Ap, wp); SWAIT2(Aw, Ap);
#define RWKV_STEP(W_, P_, W2_, P2_, step) do { \
                float p0 = S[0] * sbf(P_[0], 0), p1 = S[1] * sbf(P_[0], 1); p0 = fmaf(S[2], sbf(P_[1], 0), p0); p1 = fmaf(S[3], sbf(P_[1], 1), p1); p0 = fmaf(S[4], sbf(P_[2], 0), p0); p1 = fmaf(S[5], sbf(P_[2], 1), p1); p0 = fmaf(S[6], sbf(P_[3], 0), p0); p1 = fmaf(S[7], sbf(P_[3], 1), p1); \
                LAS float* pp = part + (((step) & 1) * 64 + lane) * 8; pp[w] = p0 + p1; \
                const float vv = vx_s[(step) * 64 + lane]; \
                LDS_WAIT(); __builtin_amdgcn_s_barrier(); asm volatile("" ::: "memory"); \
                const f32x4 q0 = *(LAS f32x4*)pp, q1 = *(LAS f32x4*)(pp + 4); LDS_WAIT(); \
                if ((step) < 63) sload24(W2_, P2_, wp + ((step) + 1) * SCR_STEP); \
                const float sa = ((q0[0] + q0[1]) + (q0[2] + q0[3])) + ((q1[0] + q1[1]) + (q1[2] + q1[3])); float y0 = 0.f, y1 = 0.f; \
                _Pragma("unroll") for (int j = 0; j < 8; j += 2) { const int jh = j >> 1; S[j] = fmaf(S[j], W_[j], fmaf(sa, sbf(P_[4 + jh], 0), vv * sbf(P_[8 + jh], 0))); S[j + 1] = fmaf(S[j + 1], W_[j + 1], fmaf(sa, sbf(P_[4 + jh], 1), vv * sbf(P_[8 + jh], 1))); y0 = fmaf(S[j], sbf(P_[12 + jh], 0), y0); y1 = fmaf(S[j + 1], sbf(P_[12 + jh], 1), y1); } \
                __builtin_amdgcn_ds_faddf(yacc + (step) * 64 + lane, y0 + y1, 0, 0, false); \
                SWAIT2(W2_, P2_); } while (0)
            for (int s2 = 0; s2 < 64; s2 += 2) {
                RWKV_STEP(Aw, Ap, Bw, Bp, s2);
                RWKV_STEP(Bw, Bp, Aw, Ap, s2 + 1);
            }
            LDS_WAIT(); __syncthreads();
            for (int i = 0; i < 8; ++i) { const int step = w + 8 * i; const size_t t = (size_t)b * SEQ + batch * 64 + step;
                const float y = yacc[step * 64 + lane], mean = wave_sum(y) * (1.f / 64.f), dlt = y - mean, var = wave_sum(dlt * dlt) * (1.f / 64.f);
                const float yn = dlt * rsqrtf(var + 64e-5f) * gng + gnb; const float o = (yn + bonus_s[step] * vx_s[step * 64 + lane]) * g_s[step * 64 + lane];
                MIX[t * D + 512 + c] = (bf16)f2bf(o); }
            LDS_WAIT(); __syncthreads();
        }
    }
}
__device__ __forceinline__ void phase_l1prep(Frame& F, const Args& a, int hb) {
    unsigned char* ws = F.ws; const bf16* XM = (const bf16*)(ws + WS_XM); bf16* XC = (bf16*)(ws + WS_XC); bf16* Q = (bf16*)(ws + WS_Q); bf16* K = (bf16*)(ws + WS_K); bf16* V = (bf16*)(ws + WS_V);
    float* GI = (float*)(ws + WS_GI); const float* W12 = (const float*)(ws + WS_W12);
    const float* cw = a.in[19]; const float* cb = a.in[20]; const float* wq = a.in[21]; const float* wk = a.in[22]; const float* wv = a.in[23]; const float* b_i = a.in[25]; const float* b_f = a.in[26];
    const int g = F.tid, lane = F.lane, w = F.wave; LAS float* red = (LAS float*)F.lds;
    float cwr[4][4], cbr[4], wqr[16], wkr[16], wvr[16], w1[32], w2[32];
#pragma unroll
    for (int j = 0; j < 4; ++j)
#pragma unroll
        for (int i = 0; i < 4; ++i) cwr[j][i] = cw[j * CI + 4 * g + i];
#pragma unroll
    for (int i = 0; i < 4; ++i) cbr[i] = cb[4 * g + i];
#pragma unroll
    for (int i = 0; i < 16; ++i) { wqr[i] = wq[g * 16 + i]; wkr[i] = wk[g * 16 + i]; wvr[i] = wv[g * 16 + i]; }
#pragma unroll
    for (int i = 0; i < 32; ++i) { w1[i] = W12[(size_t)(4 * g) * 8 + i]; w2[i] = W12[(size_t)(2048 + 4 * g) * 8 + i]; }
    const int per = TH / F.G;
    const int tb = F.bid * per;
    float x0[4], x1[4], x2[4];
    for (int n = 0; n < per; ++n) { const int t = tb + n, sl = t & (SEQ - 1);
        if (n == 0 || sl == 0) {
#pragma unroll
            for (int i = 0; i < 4; ++i) { x0[i] = 0.f; x1[i] = 0.f; x2[i] = 0.f; }
            if (sl >= 1) { const v2u r = *(const v2u*)(XM + (size_t)(t - 1) * CI + 4 * g); x2[0] = bflo(r.x); x2[1] = bfhi(r.x); x2[2] = bflo(r.y); x2[3] = bfhi(r.y); }
            if (sl >= 2) { const v2u r = *(const v2u*)(XM + (size_t)(t - 2) * CI + 4 * g); x1[0] = bflo(r.x); x1[1] = bfhi(r.x); x1[2] = bflo(r.y); x1[3] = bfhi(r.y); }
            if (sl >= 3) { const v2u r = *(const v2u*)(XM + (size_t)(t - 3) * CI + 4 * g); x0[0] = bflo(r.x); x0[1] = bfhi(r.x); x0[2] = bflo(r.y); x0[3] = bfhi(r.y); }
        }
        float x3[4]; { const v2u r = *(const v2u*)(XM + (size_t)t * CI + 4 * g); x3[0] = bflo(r.x); x3[1] = bfhi(r.x); x3[2] = bflo(r.y); x3[3] = bfhi(r.y); }
        float xc[4], q[4], k[4], v[4];
#pragma unroll
        for (int i = 0; i < 4; ++i) { const float s = cbr[i] + cwr[0][i] * x0[i] + cwr[1][i] * x1[i] + cwr[2][i] * x2[i] + cwr[3][i] * x3[i]; xc[i] = s * sigm(s); }
#pragma unroll
        for (int j = 0; j < 4; ++j) { q[j] = xc[0] * wqr[j] + xc[1] * wqr[4 + j] + xc[2] * wqr[8 + j] + xc[3] * wqr[12 + j]; k[j] = xc[0] * wkr[j] + xc[1] * wkr[4 + j] + xc[2] * wkr[8 + j] + xc[3] * wkr[12 + j];
            v[j] = x3[0] * wvr[j] + x3[1] * wvr[4 + j] + x3[2] * wvr[8 + j] + x3[3] * wvr[12 + j]; }
        float gsum[8];
#pragma unroll
        for (int o = 0; o < 8; ++o) { float s = 0.f;
#pragma unroll
            for (int i = 0; i < 4; ++i) s += xc[i] * w1[i * 8 + o] + x3[i] * w2[i * 8 + o];
            gsum[o] = s; }
        const size_t off = (size_t)t * CI + 4 * g; const float ks = 0.044194173824159216f;
        { v2u o; o.x = pk2(xc[0], xc[1]); o.y = pk2(xc[2], xc[3]); *(v2u*)(XC + off) = o; o.x = pk2(q[0], q[1]); o.y = pk2(q[2], q[3]); *(v2u*)(Q + off) = o;
          o.x = pk2(k[0] * ks, k[1] * ks); o.y = pk2(k[2] * ks, k[3] * ks); *(v2u*)(K + off) = o; o.x = pk2(v[0], v[1]); o.y = pk2(v[2], v[3]); *(v2u*)(V + off) = o; }
#pragma unroll
        for (int o = 0; o < 8; ++o) gsum[o] = wave_sum(gsum[o]);
        LAS float* rp = red + (n & 1) * 64;
        if (lane == 0) {
#pragma unroll
            for (int o = 0; o < 8; ++o) rp[w * 8 + o] = gsum[o]; }
        LDS_WAIT(); __syncthreads();
        if (F.tid < 8) { float s = 0.f;
#pragma unroll
            for (int ww = 0; ww < 8; ++ww) s += rp[ww * 8 + F.tid];
            GI[(size_t)t * 8 + F.tid] = s + (F.tid < 4 ? b_i[F.tid] : b_f[F.tid - 4]); }
#pragma unroll
        for (int i = 0; i < 4; ++i) { x0[i] = x1[i]; x1[i] = x2[i]; x2[i] = x3[i]; }
    }
}
__device__ __forceinline__ void phase_gatescan(Frame& F) {
    unsigned char* ws = F.ws; const float* GI = (const float*)(ws + WS_GI); float* GA = (float*)(ws + WS_GA); float* GAM = (float*)(ws + WS_GAM); float* GEM = (float*)(ws + WS_GEM);
    const int gw = F.bid * NWAVES + F.wave, NGW = F.G * NWAVES, lane = F.lane;
    for (int sq = gw; sq < (NB / 2) * 4; sq += NGW) { const int bl = sq >> 2, h = sq & 3; float cF = 0.f, cA = -INFINITY;
        for (int ch = 0; ch < SEQ / 64; ++ch) { const size_t t = (size_t)bl * SEQ + ch * 64 + lane; const float ip = GI[t * 8 + h], fp = GI[t * 8 + 4 + h];
            float lf = -softplusf_(-fp);
#pragma unroll
            for (int o = 1; o < 64; o <<= 1) { const float n = __shfl_up(lf, o); if (lane >= o) lf += n; }
            const float Fv = cF + lf; const float av = ip - Fv; float A = av;
#pragma unroll
            for (int o = 1; o < 64; o <<= 1) { const float n = __shfl_up(A, o); if (lane >= o) A = fmaxf(A, n); }
            A = fmaxf(A, cA);
            GA[t * 4 + h] = av; GAM[t * 4 + h] = A; GEM[t * 4 + h] = __expf(-(Fv + A));
            cF = __shfl(Fv, 63); cA = __shfl(A, 63); } }
}
constexpr int ML_QS = 1040, ML_PS = 144;
constexpr int ML_Q = 0, ML_V = 64 * ML_QS, ML_P = 2 * 64 * ML_QS, ML_DEN = ML_P + 64 * ML_PS, ML_ST = ML_DEN + 1024, ML_MR = ML_ST + 4096, ML_AT = ML_MR + 512, ML_END = ML_AT + 512;
static_assert(ML_END <= MISC_OFF, "mLSTM LDS");
__device__ __forceinline__ bf16x8 tr_read2(unsigned addr0, unsigned addr1) { s16x4 lo, hi;
    asm volatile("ds_read_b64_tr_b16 %0, %2\n\tds_read_b64_tr_b16 %1, %3\n\ts_waitcnt lgkmcnt(0)" : "=&v"(lo), "=&v"(hi) : "v"(addr0), "v"(addr1) : "memory");
    return (bf16x8){lo[0], lo[1], lo[2], lo[3], hi[0], hi[1], hi[2], hi[3]}; }
__device__ __forceinline__ void phase_mlstm(Frame& F, const Args& a) {
    unsigned char* ws = F.ws; const bf16* Q = (const bf16*)(ws + WS_Q); const bf16* K = (const bf16*)(ws + WS_K); const bf16* V = (const bf16*)(ws + WS_V); const bf16* XC = (const bf16*)(ws + WS_XC); const bf16* Z = (const bf16*)(ws + WS_Z);
    bf16* YC = (bf16*)(ws + WS_XM); const float* GA = (const float*)(ws + WS_GA); const float* GAM = (const float*)(ws + WS_GAM); const float* GEM = (const float*)(ws + WS_GEM);
    const float* mh_g = a.in[27]; const float* skip = a.in[28];
    const int tid = F.tid, lane = F.lane, w = F.wave, fr = lane & 15, fq = lane >> 4; LAS unsigned char* lds = F.lds;
    LAS float* den4 = (LAS float*)(lds + ML_DEN); LAS float* stats = (LAS float*)(lds + ML_ST); LAS float* mr = (LAS float*)(lds + ML_MR); LAS float* At_s = (LAS float*)(lds + ML_AT); LAS float* em_s = At_s + 64;
    const int st = w & 3, tt0 = 2 * (w >> 2);
    const unsigned vtr_base = (unsigned)(size_t)(lds + ML_V) + (unsigned)((8 * fq + ((lane & 15) >> 2)) * ML_QS + (64 * w + 4 * (lane & 3)) * 2);
    for (int r = 0;; ++r) { const int u = r * F.G + ((r & 1) ? (F.G - 1 - F.bid) : F.bid); if (u >= 2048) break;
        const int qi = 31 - (u >> 6), bh = u & 63, bl = bh >> 2, h = bh & 3; const size_t t0 = (size_t)bl * SEQ + 64 * qi;
#pragma unroll
        for (int k8 = 0; k8 < 8; ++k8) { const int ch = tid + 512 * k8, row = ch >> 6, c16 = ch & 63; *(LAS v4u*)(lds + ML_Q + row * ML_QS + c16 * 16) = *(const v4u*)(Q + (t0 + row) * CI + h * 512 + c16 * 8); }
        if (tid < 64) { At_s[tid] = GAM[(t0 + tid) * 4 + h]; em_s[tid] = GEM[(t0 + tid) * 4 + h]; }
        f32x4 O[4][4]; float denp[2] = {0.f, 0.f};
#pragma unroll
        for (int i = 0; i < 4; ++i)
#pragma unroll
            for (int e = 0; e < 4; ++e) O[i][e] = (f32x4){0.f, 0.f, 0.f, 0.f};
        LDS_WAIT(); __syncthreads();
        float At[2]; At[0] = At_s[16 * tt0 + fr]; At[1] = At_s[16 * (tt0 + 1) + fr];
        for (int j = 0; j <= qi; ++j) { const size_t s0 = (size_t)bl * SEQ + 64 * j;
            v4u vreg[8];
#pragma unroll
            for (int k8 = 0; k8 < 8; ++k8) { const int ch = tid + 512 * k8, row = ch >> 6, c16 = ch & 63; vreg[k8] = *(const v4u*)(V + (s0 + row) * CI + h * 512 + c16 * 8); }
            f32x4 sacc[2] = {(f32x4){0.f, 0.f, 0.f, 0.f}, (f32x4){0.f, 0.f, 0.f, 0.f}};
            const bf16* kp = K + (s0 + 16 * st + fr) * CI + h * 512 + fq * 8;
#pragma unroll 4
            for (int ks = 0; ks < 16; ++ks) { const bf16x8 kf = *(const bf16x8*)(kp + 32 * ks);
#pragma unroll
                for (int x = 0; x < 2; ++x) { const bf16x8 qf = *(const LAS bf16x8*)(lds + ML_Q + (16 * (tt0 + x) + fr) * ML_QS + (32 * ks + 8 * fq) * 2); sacc[x] = __builtin_amdgcn_mfma_f32_16x16x32_bf16(kf, qf, sacc[x], 0, 0, 0); } }
            float as[4];
#pragma unroll
            for (int i = 0; i < 4; ++i) as[i] = GA[(s0 + 16 * st + 4 * fq + i) * 4 + h];
            v2u pw[2];
#pragma unroll
            for (int x = 0; x < 2; ++x) { float p[4];
#pragma unroll
                for (int i = 0; i < 4; ++i) { const bool ok = (j < qi) || (16 * st + 4 * fq + i <= 16 * (tt0 + x) + fr); p[i] = ok ? sacc[x][i] * __builtin_amdgcn_exp2f((as[i] - At[x]) * LOG2E) : 0.f; }
                denp[x] += (p[0] + p[1]) + (p[2] + p[3]); pw[x].x = pk2(p[0], p[1]); pw[x].y = pk2(p[2], p[3]); }
            __syncthreads();
#pragma unroll
            for (int x = 0; x < 2; ++x) *(LAS v2u*)(lds + ML_P + (16 * (tt0 + x) + fr) * ML_PS + (16 * st + 4 * fq) * 2) = pw[x];
#pragma unroll
            for (int k8 = 0; k8 < 8; ++k8) { const int ch = tid + 512 * k8, row = ch >> 6, c16 = ch & 63; *(LAS v4u*)(lds + ML_V + row * ML_QS + c16 * 16) = vreg[k8]; }
            LDS_WAIT(); __syncthreads();
#pragma unroll
            for (int k2 = 0; k2 < 2; ++k2) { bf16x8 vf[4], pf[4];
#pragma unroll
                for (int e = 0; e < 4; ++e) { const unsigned ad = vtr_base + (unsigned)(32 * k2 * ML_QS + 32 * e); vf[e] = tr_read2(ad, ad + 4 * ML_QS); }
#pragma unroll
                for (int i = 0; i < 4; ++i) pf[i] = *(const LAS bf16x8*)(lds + ML_P + (16 * i + fr) * ML_PS + (32 * k2 + 8 * fq) * 2);
#pragma unroll
                for (int i = 0; i < 4; ++i)
#pragma unroll
                    for (int e = 0; e < 4; ++e) O[i][e] = __builtin_amdgcn_mfma_f32_16x16x32_bf16(pf[i], vf[e], O[i][e], 0, 0, 0); }
        }
#pragma unroll
        for (int x = 0; x < 2; ++x) { float d = denp[x]; d += __shfl_xor(d, 16); d += __shfl_xor(d, 32); if (fq == 0) den4[st * 64 + 16 * (tt0 + x) + fr] = d; }
        LDS_WAIT(); __syncthreads();
        float s1[4][4], s2[4][4];
#pragma unroll
        for (int i = 0; i < 4; ++i)
#pragma unroll
            for (int jj = 0; jj < 4; ++jj) { const int t = 16 * i + 4 * fq + jj; const float dn = (den4[t] + den4[64 + t]) + (den4[128 + t] + den4[192 + t]); const float inv = 1.0f / fmaxf(fabsf(dn), em_s[t]); float a1 = 0.f, a2 = 0.f;
#pragma unroll
                for (int e = 0; e < 4; ++e) { const float hv = O[i][e][jj] * inv; O[i][e][jj] = hv; a1 += hv; a2 += hv * hv; }
                s1[i][jj] = a1; s2[i][jj] = a2; }
#pragma unroll
        for (int i = 0; i < 4; ++i)
#pragma unroll
            for (int jj = 0; jj < 4; ++jj) { float a1 = s1[i][jj], a2 = s2[i][jj];
#pragma unroll
                for (int o = 1; o < 16; o <<= 1) { a1 += __shfl_xor(a1, o); a2 += __shfl_xor(a2, o); }
                if (fr == 0) { const int t = 16 * i + 4 * fq + jj; stats[(w * 64 + t) * 2] = a1; stats[(w * 64 + t) * 2 + 1] = a2; } }
        LDS_WAIT(); __syncthreads();
        if (tid < 64) { float a1 = 0.f, a2 = 0.f;
#pragma unroll
            for (int ww = 0; ww < 8; ++ww) { a1 += stats[(ww * 64 + tid) * 2]; a2 += stats[(ww * 64 + tid) * 2 + 1]; }
            const float mean = a1 * (1.f / 512.f), var = fmaxf(a2 * (1.f / 512.f) - mean * mean, 0.f); mr[2 * tid] = mean; mr[2 * tid + 1] = rsqrtf(var + 1e-5f); }
        LDS_WAIT(); __syncthreads();
#pragma unroll
        for (int e = 0; e < 4; ++e) { const int cc = h * 512 + 64 * w + 16 * e + fr; const float gmul = mh_g[cc], sk = skip[cc];
#pragma unroll
            for (int i = 0; i < 4; ++i)
#pragma unroll
                for (int jj = 0; jj < 4; ++jj) { const int t = 16 * i + 4 * fq + jj; const size_t off = (t0 + t) * CI + cc; const float zz = bf1(Z[off]), xcv = bf1(XC[off]);
                    const float y = ((O[i][e][jj] - mr[2 * t]) * mr[2 * t + 1] * gmul + sk * xcv) * (zz * sigm(zz)); YC[off] = (bf16)f2bf(y); } }
        __syncthreads();
    }
}
#define GEMM_PHASE(EPI, Aptr, Bptr, M_, N_, K_, ...) do { pg8::Gemm g{(const pg8::bf16_t*)(Aptr), (const pg8::bf16_t*)(Bptr), (M_), (N_), (K_)}; pg8::StaticOrder So; So.init((M_), (N_), F.G, F.bid); \
        pg8::EPI Ep{__VA_ARGS__}; pg8::gemm_phase<pg8::EPI, pg8::StaticOrder, PG8_ALIGN, PG8_SP2>(F.lds, g, So, Ep); } while (0)
__global__ void __launch_bounds__(NWAVES * 64, 2) trunk_fwd(Args args) {
    extern __shared__ __attribute__((aligned(16))) unsigned char lds_raw[];
    Frame F; F.lds = (LAS unsigned char*)lds_raw; F.ws = args.ws; F.in = nullptr;
    F.tid = threadIdx.x; F.lane = F.tid & 63; F.wave = __builtin_amdgcn_readfirstlane(F.tid >> 6); F.G = gridDim.x; F.bid = blockIdx.x;
    volatile LAS unsigned* MISC = (volatile LAS unsigned*)(F.lds + MISC_OFF);
    if (F.tid < 64) MISC[F.tid] = 0u;
    __syncthreads();
    XcdBarrier bar; bar.bar = (unsigned*)(args.ws + WS_CTL) + CW_BAR; bar.x = 0; bar.st = nullptr;
    if (args.use_bar) bar = xcd_barrier_post((unsigned*)(args.ws + WS_CTL) + CW_BAR, MISC + 8);
    const int lo = args.ph_lo, hi = args.ph_hi;
#ifndef ONLY_SITE
#define ONLY_SITE -1
#endif
#define EN(n) (ONLY_SITE < 0 || ONLY_SITE == (n))
#define IN(k) (lo <= (k) && (k) < hi)
#define SEAM(k) do { if (IN(k) && IN((k) + 1)) xcd_barrier(bar); } while (0)
    unsigned char* ws = args.ws; float* out = args.out;
    if (EN(0) && IN(0)) { phase_prologue(F, args); } SEAM(0);
    if (EN(1) && IN(1)) { phase_norm(F, args.in[0], args.in[2], (bf16*)(ws + WS_XB), T); } SEAM(1);
    if (EN(2) && IN(2)) { GEMM_PHASE(EpiBf16Split, ws + WS_XB, ws + WS_WIN, T, NU, D, (pg8::bf16_t*)(ws + WS_UA), UA_W, 4, (pg8::bf16_t*)(ws + WS_UB), UB_W); } SEAM(2);
    if (EN(3) && IN(3)) { phase_prepA(F, args); } SEAM(3);
    if (EN(4) && IN(4)) { GEMM_PHASE(EpiBf16Split, ws + WS_LIN, ws + WS_WLORA, T, 1536, 256, (pg8::bf16_t*)(ws + WS_LOUT), 1536, 1 << 20, nullptr, 0); } SEAM(4);
    if (EN(5) && IN(5)) { phase_indexer(F); } SEAM(5);
    if (EN(6) && IN(6)) { phase_dsa_attn(F, args); } SEAM(6);
    if (EN(7) && IN(7)) { phase_rwkv(F, args); } SEAM(7);
    if (EN(8) && IN(8)) { GEMM_PHASE(EpiResF32, ws + WS_XB, ws + WS_WOUT, T, D, D, args.in[0], out, D); } SEAM(8);
#define FFN_PLE(L, pb) do { const size_t lw = (size_t)(L) * WS_LAYER_STRIDE; \
        if (EN(20) && IN(pb)) { phase_norm(F, out, args.in[30] + (L) * D, (bf16*)(ws + WS_XB), T); } SEAM(pb); \
        if (EN(21) && IN((pb) + 1)) { GEMM_PHASE(EpiSwiglu, ws + WS_XB, ws + WS_WGU0 + lw, T, 2 * FF, D, (pg8::bf16_t*)(ws + WS_H), FF); } SEAM((pb) + 1); \
        if (EN(22) && IN((pb) + 2)) { GEMM_PHASE(EpiResF32, ws + WS_H, ws + WS_WD0 + lw, T, D, FF, out, out, D); } SEAM((pb) + 2); \
        if (EN(23) && IN((pb) + 3)) { phase_norm(F, out, args.in[35] + (L) * D, (bf16*)(ws + WS_XB), T); phase_cvt_p(F, args.in[1] + (size_t)(L) * T * 256, (bf16*)(ws + WS_PB)); } SEAM((pb) + 3); \
        if (EN(24) && IN((pb) + 4)) { GEMM_PHASE(EpiBf16Split, ws + WS_PB, ws + WS_WPLE0 + lw, T, D, 256, (pg8::bf16_t*)(ws + WS_E), D, 1 << 20, nullptr, 0); } SEAM((pb) + 4); \
        if (EN(25) && IN((pb) + 5)) { GEMM_PHASE(EpiPle, ws + WS_XB, ws + WS_WPG0 + lw, T, D, D, out, out, (const pg8::bf16_t*)(ws + WS_E), D); } SEAM((pb) + 5); } while (0)
#define L1_HALF(hb, p1) do { float* xh = out + (size_t)(hb) * TH * D; \
        if (EN(10) && IN(p1)) { phase_norm(F, xh, args.in[2] + D, (bf16*)(ws + WS_XBH), TH); } SEAM(p1); \
        if (EN(11) && IN((p1) + 1)) { GEMM_PHASE(EpiBf16Split, ws + WS_XBH, ws + WS_WUP, TH, 2 * CI, D, (pg8::bf16_t*)(ws + WS_XM), CI, 8, (pg8::bf16_t*)(ws + WS_Z), CI); } SEAM((p1) + 1); \
        if (EN(12) && IN((p1) + 2)) { phase_l1prep(F, args, hb); } SEAM((p1) + 2); \
        if (EN(13) && IN((p1) + 3)) { phase_gatescan(F); } SEAM((p1) + 3); \
        if (EN(14) && IN((p1) + 4)) { phase_mlstm(F, args); } SEAM((p1) + 4); \
        if (EN(15) && IN((p1) + 5)) { GEMM_PHASE(EpiResF32, ws + WS_XM, ws + WS_WDOWN, TH, D, CI, xh, xh, D); } SEAM((p1) + 5); } while (0)
    FFN_PLE(0, 9);
    L1_HALF(0, 15);
    L1_HALF(1, 21);
    FFN_PLE(1, 27);
#undef IN
#undef SEAM
}
constexpr int N_PHASES = 33;

#ifndef MK_ONE_LAUNCH
#define MK_ONE_LAUNCH 1
#endif
extern "C" void kernel_launch(void* const* d_in, const int* in_sizes, int n_in, void* d_out, int out_size, void* d_ws, size_t ws_size, hipStream_t stream) {
    static int grid = 0;
    if (grid == 0) {
        if (n_in != 37 || in_sizes[0] != T * D || out_size != T * D || ws_size < WS_END) { fprintf(stderr, "kernel_launch: unexpected shapes (n_in %d, in0 %d, out %d, ws %zu < %zu); nothing launched\n", n_in, n_in > 0 ? in_sizes[0] : -1, out_size, ws_size, (size_t)WS_END); grid = -1; return; }
        int dev = 0, cus = 0, per_cu = 0;
        if (hipGetDevice(&dev) != hipSuccess || hipDeviceGetAttribute(&cus, hipDeviceAttributeMultiprocessorCount, dev) != hipSuccess) { grid = -1; return; }
        if (hipFuncSetAttribute((const void*)trunk_fwd, hipFuncAttributeMaxDynamicSharedMemorySize, LDS_BYTES) != hipSuccess) { fprintf(stderr, "kernel_launch: hipFuncSetAttribute failed\n"); grid = -1; return; }
        if (hipOccupancyMaxActiveBlocksPerMultiprocessor(&per_cu, (const void*)trunk_fwd, NWAVES * 64, LDS_BYTES) != hipSuccess || per_cu < 1) { fprintf(stderr, "kernel_launch: occupancy query says %d\n", per_cu); }
        (void)hipGetLastError();
        grid = cus;
        if (grid != 256) { fprintf(stderr, "kernel_launch: built for 256 CUs, found %d; nothing launched\n", cus); grid = -1; return; }
    }
    if (grid < 0) return;
    if (hipMemsetAsync((char*)d_ws + WS_CTL, 0, CTL_ZERO_BYTES, stream) != hipSuccess) return;
    Args a{};
    for (int i = 0; i < 37; ++i) a.in[i] = (const float*)d_in[i];
    a.out = (float*)d_out; a.ws = (unsigned char*)d_ws; a.pad = 0;
#if MK_ONE_LAUNCH
    a.ph_lo = 0; a.ph_hi = N_PHASES; a.use_bar = 1;
    hipLaunchKernelGGL(trunk_fwd, dim3(grid), dim3(NWAVES * 64), LDS_BYTES, stream, a);
#else
    for (int p = 0; p < N_PHASES; ++p) { a.ph_lo = p; a.ph_hi = p + 1; a.use_bar = 0; hipLaunchKernelGGL(trunk_fwd, dim3(grid), dim3(NWAVES * 64), LDS_BYTES, stream, a); }
#endif
}
```

```cpp
#include <hip/hip_runtime.h>
#include <cstdio>
#include <cstdint>
namespace pg8 {
#define PG8_LAS __attribute__((address_space(3)))
typedef unsigned short bf16_t;
typedef short bf16x8 __attribute__((ext_vector_type(8)));
typedef float f32x4 __attribute__((ext_vector_type(4)));
typedef unsigned u32x4 __attribute__((ext_vector_type(4)));
constexpr int BM = 256, BK = 64, HALF = 128, HTB = HALF * BK * 2  , STAGE_BYTES = 8 * HTB, NXCD = 8, WGM = 8;

__host__ __device__ __forceinline__ int lds_byte(int r, int c) { const int st = (r >> 4) * 2 + (c >> 5), rr = r & 15, cc = c & 31, ob = rr * 64 + cc * 2; return st * 1024 + (ob ^ (((ob >> 9) & 1) << 5)); }
__host__ __device__ __forceinline__ void stage_rc(int b, int& R, int& C) { const int st = b / 1024, sb = b % 1024, swz = sb ^ (((sb >> 9) & 1) << 5); R = (st >> 1) * 16 + swz / 64; C = (st & 1) * 32 + (swz % 64) / 2; }
__host__ __device__ __forceinline__ int perm32(int rho) { const int n = rho >> 4, i = rho & 15; return 8 * (i >> 2) + 4 * n + (i & 3); }

struct Unit { int pm, pn; };
struct Gemm { const bf16_t* A; const bf16_t* Bt; int M, N, K; };

struct StaticOrder {
    int nM, nN, nwg, G, c;
    __host__ __device__ void init(int M, int N, int G_, int c_) { nM = M / BM; nN = N / BM; nwg = nM * nN; G = G_; c = c_; }
    __host__ __device__ bool next(int i, Unit& u) const {
        const long L = (long)i * G + c; if (L >= nwg) return false;
        int wgid = (int)L; { const int q = nwg / NXCD, r = nwg % NXCD, xcd = wgid % NXCD, off = wgid / NXCD; wgid = (xcd < r ? xcd * (q + 1) : r * (q + 1) + (xcd - r) * q) + off; }
        const int nig = WGM * nN, gid = wgid / nig, fm = gid * WGM, gsz = (nM - fm) < WGM ? (nM - fm) : WGM;
        u.pm = fm + ((wgid % nig) % gsz); u.pn = (wgid % nig) / gsz; return true;
    }
    __device__ __forceinline__ void a_ready(const Unit&) const {}
    __device__ __forceinline__ void done(const Unit&) const {}
};

__device__ __forceinline__ unsigned cvt_pk_bf16(float lo, float hi) { unsigned r; asm volatile("v_cvt_pk_bf16_f32 %0, %1, %2" : "=v"(r) : "v"(lo), "v"(hi)); return r; }
typedef float f32x2 __attribute__((ext_vector_type(2)));
__device__ __forceinline__ f32x2 gelu_pk(f32x2 v) {
    const f32x2 av = __builtin_elementwise_abs(v), d = av * 0.2316418882f + 1.0f;
    f32x2 t; t.x = __builtin_amdgcn_rcpf(d.x); t.y = __builtin_amdgcn_rcpf(d.y);
    f32x2 q = t * 0.5307027145f + (-0.7265760135f); q = q * t + 0.7107068705f; q = q * t + (-0.142248368f); q = q * t + 0.127414796f; q = q * t;
    const f32x2 s = (v * v) * (-0.72134752044f);
    f32x2 e; e.x = __builtin_amdgcn_exp2f(s.x); e.y = __builtin_amdgcn_exp2f(s.y);
    const f32x2 m = v * (q * e), r = v - m;
    f32x2 o; o.x = v.x < 0.f ? m.x : r.x; o.y = v.y < 0.f ? m.y : r.y; return o;
}

template <class Epi, class Sched, bool ALIGN_EPI = false, bool SP2 = false>
__device__ __forceinline__ void gemm_phase(PG8_LAS unsigned char* lds, const Gemm g, const Sched& S, const Epi& E) {
    const int tid = threadIdx.x, wid = __builtin_amdgcn_readfirstlane(tid >> 6), lane = tid & 63, wr = wid >> 2, wc = wid & 3, fr = lane & 15, fq = lane >> 4;
    const int K = g.K, nt = K / BK;
    unsigned voffA[2], voffB[2];
#pragma unroll
    for (int i = 0; i < 2; ++i) { int R, C; stage_rc(tid * 16 + i * 8192, R, C); const int Rb = Epi::PERM ? ((R & ~31) + perm32(R & 31)) : R;
        voffA[i] = (unsigned)(R * K + C) * 2u; voffB[i] = (unsigned)(Rb * K + C) * 2u; }
    const size_t kstep = (size_t)(BK * 2);
    const size_t hstep = (size_t)HALF * K * 2;
    const size_t tstep = 2 * hstep;
    const unsigned ldsw = (unsigned)wid * 1024u;
    const int aoff = lds_byte(wr * 64 + fr, fq * 8), boff = lds_byte(wc * 32 + fr, fq * 8);
#define PG8_SA(b, h) (((b) * 2 + (h)) * HTB)
#define PG8_SB(b, h) ((4 + (b) * 2 + (h)) * HTB)
#define PG8_STAGE(bufoff, gbase, voff) do { _Pragma("unroll") for (int _i = 0; _i < 2; ++_i) \
        __builtin_amdgcn_global_load_lds((const unsigned*)((const char*)(gbase) + (voff)[_i]), (PG8_LAS unsigned*)(lds + (bufoff) + ldsw + _i * 8192), 16, 0, 0); } while (0)
#define PG8_LDA(dst, b, h) do { _Pragma("unroll") for (int m = 0; m < 4; ++m) _Pragma("unroll") for (int k = 0; k < 2; ++k) dst[m][k] = *(const PG8_LAS bf16x8*)(lds + PG8_SA(b, h) + aoff + m * 2048 + k * 1024); } while (0)
#define PG8_LDB(dst, b, h) do { _Pragma("unroll") for (int n = 0; n < 2; ++n) _Pragma("unroll") for (int k = 0; k < 2; ++k) dst[n][k] = *(const PG8_LAS bf16x8*)(lds + PG8_SB(b, h) + boff + n * 2048 + k * 1024); } while (0)
#define PG8_MMA(ai, bj, At, Bt) do { __builtin_amdgcn_s_setprio(1); _Pragma("unroll") for (int m = 0; m < 4; ++m) _Pragma("unroll") for (int n = 0; n < 2; ++n) _Pragma("unroll") for (int k = 0; k < 2; ++k) \
        acc[ai][bj][m][n] = __builtin_amdgcn_mfma_f32_16x16x32_bf16(Bt[n][k], At[m][k], acc[ai][bj][m][n], 0, 0, 0); __builtin_amdgcn_s_setprio(0); } while (0)
#define PG8_WAIT_V(n) asm volatile("s_waitcnt vmcnt(" #n ")" ::: "memory")
#define PG8_WAIT_L(n) asm volatile("s_waitcnt lgkmcnt(" #n ")" ::: "memory")
#define PG8_BAR __builtin_amdgcn_s_barrier()
#define PG8_SCHED __builtin_amdgcn_sched_barrier(0)
    Unit cur, nxt; int ui = 0;
    if (!S.next(0, cur)) return;
    f32x4 acc[2][2][4][2];
#pragma unroll
    for (int a = 0; a < 2; ++a)
#pragma unroll
        for (int b = 0; b < 2; ++b)
#pragma unroll
            for (int m = 0; m < 4; ++m)
#pragma unroll
                for (int n = 0; n < 2; ++n) acc[a][b][m][n] = (f32x4){0.f, 0.f, 0.f, 0.f};
    bf16x8 At[4][2], B0[2][2], B1[2][2];
    const char* cA = (const char*)g.A + (size_t)cur.pm * tstep; const char* cB = (const char*)g.Bt + (size_t)cur.pn * tstep;
    S.a_ready(cur);
    if constexpr (SP2) {
        PG8_STAGE(PG8_SB(0, 0), cB, voffB); PG8_STAGE(PG8_SB(0, 1), cB + hstep, voffB); PG8_STAGE(PG8_SA(0, 0), cA, voffA); PG8_STAGE(PG8_SA(0, 1), cA + hstep, voffA);
        if (wr == 1) PG8_BAR;
        PG8_WAIT_V(2); PG8_BAR;
        PG8_STAGE(PG8_SB(1, 0), cB + kstep, voffB); PG8_STAGE(PG8_SA(1, 0), cA + kstep, voffA); PG8_STAGE(PG8_SB(1, 1), cB + hstep + kstep, voffB);
        PG8_WAIT_V(6); PG8_BAR;
    } else {
        PG8_STAGE(PG8_SB(0, 0), cB, voffB); PG8_STAGE(PG8_SA(0, 0), cA, voffA); PG8_STAGE(PG8_SB(0, 1), cB + hstep, voffB); PG8_STAGE(PG8_SA(0, 1), cA + hstep, voffA);
        if (wr == 1) PG8_BAR;
        PG8_WAIT_V(4); PG8_BAR;
        PG8_STAGE(PG8_SB(1, 0), cB + kstep, voffB); PG8_STAGE(PG8_SA(1, 0), cA + kstep, voffA); PG8_STAGE(PG8_SB(1, 1), cB + hstep + kstep, voffB);
        PG8_WAIT_V(6); PG8_BAR;
    }
    for (;;) {
        const bool has_next = S.next(ui + 1, nxt);
        const char* nA = has_next ? (const char*)g.A + (size_t)nxt.pm * tstep : cA; const char* nB = has_next ? (const char*)g.Bt + (size_t)nxt.pn * tstep : cB;
        for (int t = 0; t < nt; t += 2) {
            const bool last = (t == nt - 2);
            const char* a1 = cA + (size_t)(t + 1) * kstep;
            const char* a2 = last ? nA : cA + (size_t)(t + 2) * kstep; const char* b2 = last ? nB : cB + (size_t)(t + 2) * kstep;
            const char* a3 = a2 + kstep; const char* b3 = b2 + kstep;
            if (last && has_next) S.a_ready(nxt);
            if constexpr (SP2) {
            PG8_LDB(B0, 0, 0); PG8_LDB(B1, 0, 1); PG8_SCHED; PG8_LDA(At, 0, 0); PG8_STAGE(PG8_SA(1, 1), a1 + hstep, voffA);
            PG8_WAIT_V(8); PG8_WAIT_L(0); PG8_BAR; PG8_MMA(0, 0, At, B0); PG8_MMA(0, 1, At, B1); PG8_BAR; PG8_SCHED;
            PG8_LDA(At, 0, 1); PG8_STAGE(PG8_SB(0, 0), b2, voffB); PG8_STAGE(PG8_SB(0, 1), b2 + hstep, voffB); PG8_STAGE(PG8_SA(0, 0), a2, voffA);
            PG8_WAIT_V(8); PG8_WAIT_L(0); PG8_BAR; PG8_MMA(1, 0, At, B0); PG8_MMA(1, 1, At, B1); PG8_BAR; PG8_SCHED;
            PG8_LDB(B0, 1, 0); PG8_LDB(B1, 1, 1); PG8_SCHED; PG8_LDA(At, 1, 0); PG8_STAGE(PG8_SA(0, 1), a2 + hstep, voffA);
            PG8_WAIT_V(8); PG8_WAIT_L(0); PG8_BAR; PG8_MMA(0, 0, At, B0); PG8_MMA(0, 1, At, B1); PG8_BAR; PG8_SCHED;
            PG8_LDA(At, 1, 1); PG8_STAGE(PG8_SB(1, 0), b3, voffB); PG8_STAGE(PG8_SB(1, 1), b3 + hstep, voffB); PG8_STAGE(PG8_SA(1, 0), a3, voffA);
            PG8_WAIT_V(8); PG8_WAIT_L(0); PG8_BAR; PG8_MMA(1, 0, At, B0); PG8_MMA(1, 1, At, B1); PG8_BAR; PG8_SCHED;
            } else {
            PG8_LDB(B0, 0, 0); PG8_SCHED; PG8_LDA(At, 0, 0); PG8_STAGE(PG8_SA(1, 1), a1 + hstep, voffA);
            PG8_WAIT_L(8); PG8_BAR; PG8_WAIT_L(0); PG8_MMA(0, 0, At, B0); PG8_BAR; PG8_SCHED;
            PG8_LDB(B1, 0, 1); PG8_STAGE(PG8_SB(0, 0), b2, voffB);
            PG8_BAR; PG8_WAIT_L(0); PG8_MMA(0, 1, At, B1); PG8_BAR;
            PG8_LDA(At, 0, 1); PG8_STAGE(PG8_SA(0, 0), a2, voffA);
            PG8_BAR; PG8_WAIT_L(0); PG8_MMA(1, 0, At, B0); PG8_BAR; PG8_SCHED;
            PG8_STAGE(PG8_SB(0, 1), b2 + hstep, voffB);
            PG8_WAIT_V(6); PG8_BAR; PG8_MMA(1, 1, At, B1); PG8_BAR;
            PG8_LDB(B0, 1, 0); PG8_SCHED; PG8_LDA(At, 1, 0); PG8_STAGE(PG8_SA(0, 1), a2 + hstep, voffA);
            PG8_WAIT_L(8); PG8_BAR; PG8_WAIT_L(0); PG8_MMA(0, 0, At, B0); PG8_BAR; PG8_SCHED;
            PG8_LDB(B1, 1, 1); PG8_STAGE(PG8_SB(1, 0), b3, voffB);
            PG8_BAR; PG8_WAIT_L(0); PG8_MMA(0, 1, At, B1); PG8_BAR;
            PG8_LDA(At, 1, 1); PG8_STAGE(PG8_SA(1, 0), a3, voffA);
            PG8_BAR; PG8_WAIT_L(0); PG8_MMA(1, 0, At, B0); PG8_BAR; PG8_SCHED;
            PG8_STAGE(PG8_SB(1, 1), b3 + hstep, voffB);
            PG8_WAIT_V(6); PG8_BAR; PG8_MMA(1, 1, At, B1); PG8_BAR;
            }
        }
        if constexpr (ALIGN_EPI) { if (wr == 0) PG8_BAR; }
        if constexpr (!Epi::AFTER_DRAIN) { E(acc, cur, wr, wc, fr, fq); S.done(cur); }
        if (!has_next) break;
#pragma unroll
        for (int a = 0; a < 2; ++a)
#pragma unroll
            for (int b = 0; b < 2; ++b)
#pragma unroll
                for (int m = 0; m < 4; ++m)
#pragma unroll
                    for (int n = 0; n < 2; ++n) acc[a][b][m][n] = (f32x4){0.f, 0.f, 0.f, 0.f};
        cur = nxt; cA = nA; cB = nB; ++ui;
        if constexpr (ALIGN_EPI) { if (wr == 1) PG8_BAR; }
    }
    PG8_WAIT_V(0);
    if constexpr (!ALIGN_EPI) { if (wr == 0) PG8_BAR; }
    PG8_BAR;
    if constexpr (Epi::AFTER_DRAIN) { E.fused(acc, cur, wr, wc, fr, fq, lds, wid, lane); S.done(cur); }
#undef PG8_SA
#undef PG8_SB
#undef PG8_STAGE
#undef PG8_LDA
#undef PG8_LDB
#undef PG8_MMA
#undef PG8_WAIT_V
#undef PG8_WAIT_L
#undef PG8_BAR
#undef PG8_SCHED
}
}
namespace pg8 {
__device__ __forceinline__ float sigmoidf_(float x) { return __builtin_amdgcn_rcpf(1.0f + __builtin_amdgcn_exp2f(-1.4426950408889634f * x)); }
struct EpiBf16Split {
    static constexpr bool PERM = true, AFTER_DRAIN = false;
    bf16_t* O0; int ld0; int nt0; bf16_t* O1; int ld1;
    __device__ __forceinline__ void operator()(const f32x4 (&acc)[2][2][4][2], const Unit& u, int wr, int wc, int fr, int fq) const {
        const bool first = u.pn < nt0; bf16_t* base = first ? O0 : O1; const int ld = first ? ld0 : ld1; const int colt = (first ? u.pn : u.pn - nt0) * BM;
        const int row0 = u.pm * BM + wr * 64 + fr, col0 = colt + wc * 32 + 8 * fq;
#pragma unroll
        for (int ai = 0; ai < 2; ++ai)
#pragma unroll
            for (int m = 0; m < 4; ++m) { bf16_t* rowp = base + (size_t)(row0 + ai * HALF + m * 16) * ld + col0;
#pragma unroll
                for (int bj = 0; bj < 2; ++bj) { const f32x4 v0 = acc[ai][bj][m][0], v1 = acc[ai][bj][m][1];
                    u32x4 w; w.x = cvt_pk_bf16(v0[0], v0[1]); w.y = cvt_pk_bf16(v0[2], v0[3]); w.z = cvt_pk_bf16(v1[0], v1[1]); w.w = cvt_pk_bf16(v1[2], v1[3]);
                    *(u32x4*)(rowp + bj * HALF) = w; } }
    }
};
struct EpiResF32 {
    static constexpr bool PERM = false, AFTER_DRAIN = false;
    const float* base; float* out; int ldc;
    __device__ __forceinline__ void operator()(const f32x4 (&acc)[2][2][4][2], const Unit& u, int wr, int wc, int fr, int fq) const {
        const int row0 = u.pm * BM + wr * 64 + fr, col0 = u.pn * BM + wc * 32 + 4 * fq;
#pragma unroll
        for (int ai = 0; ai < 2; ++ai)
#pragma unroll
            for (int m = 0; m < 4; ++m) { const size_t off = (size_t)(row0 + ai * HALF + m * 16) * ldc + col0;
#pragma unroll
                for (int bj = 0; bj < 2; ++bj)
#pragma unroll
                    for (int n = 0; n < 2; ++n) { const f32x4 b = *(const f32x4*)(base + off + bj * HALF + n * 16); *(f32x4*)(out + off + bj * HALF + n * 16) = b + acc[ai][bj][m][n]; } }
    }
};
struct EpiSwiglu {
    static constexpr bool PERM = false, AFTER_DRAIN = false;
    bf16_t* H; int ldh;
    __device__ __forceinline__ void operator()(const f32x4 (&acc)[2][2][4][2], const Unit& u, int wr, int wc, int fr, int fq) const {
        const int row0 = u.pm * BM + wr * 64 + fr, hc0 = u.pn * (BM / 2) + wc * 16 + 4 * fq;
#pragma unroll
        for (int ai = 0; ai < 2; ++ai)
#pragma unroll
            for (int m = 0; m < 4; ++m) { bf16_t* rowp = H + (size_t)(row0 + ai * HALF + m * 16) * ldh + hc0;
#pragma unroll
                for (int bj = 0; bj < 2; ++bj) { const f32x4 g = acc[ai][bj][m][0], up = acc[ai][bj][m][1]; float h[4];
#pragma unroll
                    for (int i = 0; i < 4; ++i) h[i] = g[i] * sigmoidf_(g[i]) * up[i];
                    typedef unsigned u32x2 __attribute__((ext_vector_type(2)));
                    u32x2 w; w.x = cvt_pk_bf16(h[0], h[1]); w.y = cvt_pk_bf16(h[2], h[3]);
                    *(u32x2*)(rowp + bj * (HALF / 2)) = w; } }
    }
};
struct EpiPle {
    static constexpr bool PERM = false, AFTER_DRAIN = false;
    const float* base; float* out; const bf16_t* E; int ldc;
    __device__ __forceinline__ void operator()(const f32x4 (&acc)[2][2][4][2], const Unit& u, int wr, int wc, int fr, int fq) const {
        const int row0 = u.pm * BM + wr * 64 + fr, col0 = u.pn * BM + wc * 32 + 4 * fq;
        typedef unsigned u32x2 __attribute__((ext_vector_type(2)));
#pragma unroll
        for (int ai = 0; ai < 2; ++ai)
#pragma unroll
            for (int m = 0; m < 4; ++m) { const size_t off = (size_t)(row0 + ai * HALF + m * 16) * ldc + col0;
#pragma unroll
                for (int bj = 0; bj < 2; ++bj)
#pragma unroll
                    for (int n = 0; n < 2; ++n) { const size_t o = off + bj * HALF + n * 16; const f32x4 b = *(const f32x4*)(base + o); const u32x2 e = *(const u32x2*)(E + o); const f32x4 a = acc[ai][bj][m][n];
                        f32x4 r; r[0] = b[0] + __uint_as_float(e.x << 16) * sigmoidf_(a[0]); r[1] = b[1] + __uint_as_float(e.x & 0xffff0000u) * sigmoidf_(a[1]);
                        r[2] = b[2] + __uint_as_float(e.y << 16) * sigmoidf_(a[2]); r[3] = b[3] + __uint_as_float(e.y & 0xffff0000u) * sigmoidf_(a[3]);
                        *(f32x4*)(out + o) = r; } }
    }
};
}
#ifndef PG8_SP2
#define PG8_SP2 true
#endif
#ifndef PG8_ALIGN
#define PG8_ALIGN true
#endif
constexpr int NB = 32, SEQ = 2048, T = NB * SEQ, D = 1024;
constexpr int NU = 2816, UA_W = 1024, UB_W = 1792;
constexpr int FF = 2816, CI = 2048, TH = T / 2;
constexpr int NWAVES = 8;
constexpr float NORM_EPS = 1e-6f, LOG2E = 1.4426950408889634f;
constexpr int UA_K = 512, UA_V = 576, UA_IQ = 640, UA_IK = 896, UA_IW = 960;
constexpr size_t MiB = 1u << 20, QMiB = 1u << 18;
constexpr size_t WS_CTL = 0, CTL_ZERO_BYTES = 1 * MiB;
constexpr size_t WS_WIN = 4 * QMiB, WS_WLORA = 26 * QMiB, WS_WOUT = 29 * QMiB;
constexpr size_t WS_WGU0 = 37 * QMiB, WS_WD0 = 81 * QMiB, WS_WPLE0 = 103 * QMiB, WS_WPG0 = 105 * QMiB, WS_LAYER_STRIDE = 76 * QMiB;
constexpr size_t WS_WUP = 189 * QMiB, WS_WDOWN = 221 * QMiB, WS_W12 = 237 * QMiB;
static_assert(WS_WPG0 + 8 * QMiB == WS_WGU0 + WS_LAYER_STRIDE && WS_WPG0 + WS_LAYER_STRIDE + 8 * QMiB == WS_WUP && WS_W12 + QMiB <= 60 * MiB, "weight map");
constexpr size_t ACT = 60 * MiB;
constexpr size_t WS_XB = ACT, WS_UA = ACT + 128 * MiB, WS_UB = ACT + 256 * MiB, WS_LIN = ACT + 480 * MiB, WS_LOUT = ACT + 512 * MiB;
constexpr size_t WS_QN = ACT + 704 * MiB, WS_KN = ACT + 768 * MiB, WS_VT = ACT + 776 * MiB, WS_MASK = ACT + 784 * MiB, WS_SCR = ACT + 800 * MiB;
constexpr size_t WS_H = ACT + 128 * MiB, WS_E = ACT + 480 * MiB, WS_PB = ACT + 608 * MiB;
constexpr size_t WS_XBH = ACT, WS_XM = ACT + 64 * MiB, WS_Z = ACT + 192 * MiB, WS_XC = ACT + 320 * MiB, WS_Q = ACT + 448 * MiB, WS_K = ACT + 576 * MiB, WS_V = ACT + 704 * MiB;
constexpr size_t WS_GI = ACT + 832 * MiB, WS_GA = WS_GI + 1 * MiB, WS_GAM = WS_GI + 2 * MiB, WS_GEM = WS_GI + 3 * MiB;
constexpr size_t WS_END = ACT + 840 * MiB;
static_assert(WS_END <= 1024 * MiB, "workspace");
constexpr int CW_TMO = 0, CW_BAR = 4096;
constexpr int LDS_BYTES = 155648;
constexpr int MISC_OFF = LDS_BYTES - 256;
#define GAS __attribute__((address_space(1)))
#define LAS __attribute__((address_space(3)))
typedef unsigned short bf16;
typedef unsigned v4u __attribute__((ext_vector_type(4)));
typedef unsigned v2u __attribute__((ext_vector_type(2)));
typedef float f32x4 __attribute__((ext_vector_type(4)));
typedef float f32x2 __attribute__((ext_vector_type(2)));
typedef float f32x8 __attribute__((ext_vector_type(8)));
typedef short bf16x8 __attribute__((ext_vector_type(8)));
typedef short s16x4 __attribute__((ext_vector_type(4)));
typedef GAS unsigned gu32;
#define RLX_AGENT __ATOMIC_RELAXED, __HIP_MEMORY_SCOPE_AGENT
#define LDS_WAIT() asm volatile("s_waitcnt lgkmcnt(0)" ::: "memory")
#define VM_WAIT() asm volatile("s_waitcnt vmcnt(0)" ::: "memory")
__device__ __forceinline__ unsigned f2bf(float f) { unsigned u = __builtin_bit_cast(unsigned, f); return (u + 0x7fffu + ((u >> 16) & 1u)) >> 16; }

#define XB_TMO      128
#define XB_XCNT(j)  (256  + 64 * (j))
#define XB_XSUB(j)  (1280 + 64 * (j))
#define XB_XGEN(j)  (2304 + 64 * (j))
#define XB_TOP      3328
#define XB_TOPGEN   3392
#define XCD_BAR_WORDS 3456
#define XB_SPIN_CAP (1u << 18)

__device__ __forceinline__ unsigned xb_ld(unsigned* p)              { return __hip_atomic_load(p, __ATOMIC_RELAXED, __HIP_MEMORY_SCOPE_AGENT); }
__device__ __forceinline__ unsigned xb_add(unsigned* p, unsigned v) { return __hip_atomic_fetch_add(p, v, __ATOMIC_RELAXED, __HIP_MEMORY_SCOPE_AGENT); }
__device__ __forceinline__ unsigned xb_xcc_id() { return (unsigned)__builtin_amdgcn_s_getreg((3 << 11) | 20) & 0xFu; }
#define XB_SPIN(cond, bar) do { unsigned _sp = 0; while (cond) { __builtin_amdgcn_s_sleep(1); \
    if ((++_sp & 255u) == 0u) { if (xb_ld(&(bar)[XB_TMO])) break; if (_sp > XB_SPIN_CAP) { atomicAdd(&(bar)[XB_TMO], 1u); break; } } } } while (0)

struct XcdBarrier {
    unsigned* bar; unsigned x;
    volatile LAS unsigned* st;
};

__device__ __forceinline__ XcdBarrier xcd_barrier_post(unsigned* bar, volatile LAS unsigned* st) {
    XcdBarrier b; b.bar = bar; b.x = xb_xcc_id(); b.st = st;
    if (threadIdx.x == 0) (void)xb_add(&bar[XB_XCNT(b.x)], 1u);
    return b;
}
__device__ __forceinline__ void xcd_barrier_complete(unsigned* bar, unsigned x, unsigned& nloc, unsigned& nx) {
    const unsigned G = gridDim.x * gridDim.y * gridDim.z;
    unsigned sum, cnt, mine, sp = 0u;
    for (;;) {
        sum = 0u; cnt = 0u; mine = 0u;
#pragma unroll
        for (unsigned j = 0; j < 16; ++j) { const unsigned c = xb_ld(&bar[XB_XCNT(j)]); sum += c; cnt += (c > 0u) ? 1u : 0u; mine = (j == x) ? c : mine; }
        if (sum == G) break;
        __builtin_amdgcn_s_sleep(1);
        if ((++sp & 255u) == 0u) { if (xb_ld(&bar[XB_TMO])) break; if (sp > XB_SPIN_CAP) { atomicAdd(&bar[XB_TMO], 1u); break; } }
    }
    nloc = mine > 0u ? mine : 1u; nx = cnt > 0u ? cnt : 1u;
}

__device__ __forceinline__ void xcd_barrier(const XcdBarrier& b) {
    asm volatile("s_waitcnt vmcnt(0)" ::: "memory");
    __syncthreads();
    if (threadIdx.x == 0) {
        unsigned* bar = b.bar;
        __builtin_amdgcn_s_waitcnt(0);
        unsigned nloc = b.st[0], nx = b.st[1];
        if (nloc == 0u) { xcd_barrier_complete(bar, b.x, nloc, nx); b.st[0] = nloc; b.st[1] = nx; }
        const unsigned old = xb_add(&bar[XB_XSUB(b.x)], 1u);
        const unsigned gen = old / nloc;
        if (old + 1u == (gen + 1u) * nloc) {
            __builtin_amdgcn_fence(__ATOMIC_RELEASE, "agent");
            asm volatile("s_waitcnt vmcnt(0)" ::: "memory");
            const unsigned og = xb_add(&bar[XB_TOP], 1u);
            const unsigned tg = og / nx;
            if (og + 1u == (tg + 1u) * nx) xb_add(&bar[XB_TOPGEN], 1u);
            else XB_SPIN(xb_ld(&bar[XB_TOPGEN]) == tg, bar);
            __builtin_amdgcn_fence(__ATOMIC_ACQUIRE, "agent");
            xb_add(&bar[XB_XGEN(b.x)], 1u);
            asm volatile("s_waitcnt vmcnt(0)" ::: "memory");
        } else {
            XB_SPIN(xb_ld(&bar[XB_XGEN(b.x)]) == gen, bar);
            __builtin_amdgcn_fence(__ATOMIC_ACQUIRE, "agent");
            asm volatile("s_waitcnt vmcnt(0)" ::: "memory");
        }
    }
    __syncthreads();
}

struct Frame {
    LAS unsigned char* lds;
    unsigned char* ws;
    const float* const* in;
    int tid, lane, wave, G, bid;
};
struct Args { const float* in[37]; float* out; unsigned char* ws; int ph_lo, ph_hi, use_bar, pad; };

__device__ __forceinline__ float wave_sum(float v) {
#pragma unroll
    for (int o = 1; o < 64; o <<= 1) v += __shfl_xor(v, o);
    return v;
}
__device__ __forceinline__ float wave_max(float v) {
#pragma unroll
    for (int o = 1; o < 64; o <<= 1) v = fmaxf(v, __shfl_xor(v, o));
    return v;
}
__device__ __forceinline__ float bflo(unsigned u) { return __uint_as_float(u << 16); }
__device__ __forceinline__ float bfhi(unsigned u) { return __uint_as_float(u & 0xffff0000u); }
__device__ __forceinline__ float bf1(bf16 h) { return __uint_as_float(((unsigned)h) << 16); }
__device__ __forceinline__ unsigned pk2(float lo, float hi) { return pg8::cvt_pk_bf16(lo, hi); }
__device__ __forceinline__ float sigm(float x) { return 1.0f / (1.0f + __expf(-x)); }
__device__ __forceinline__ float softplusf_(float x) { return fmaxf(x, 0.f) + log1pf(__expf(-fabsf(x))); }
__device__ __forceinline__ void unpack8(const v4u& r, float (&f)[8]) { f[0] = bflo(r.x); f[1] = bfhi(r.x); f[2] = bflo(r.y); f[3] = bfhi(r.y); f[4] = bflo(r.z); f[5] = bfhi(r.z); f[6] = bflo(r.w); f[7] = bfhi(r.w); }
__device__ __forceinline__ v4u pack8(const float (&f)[8]) { v4u o; o.x = pk2(f[0], f[1]); o.y = pk2(f[2], f[3]); o.z = pk2(f[4], f[5]); o.w = pk2(f[6], f[7]); return o; }

template <class Fn> __device__ __forceinline__ void wprep(bf16* dst, int N, int K, Fn f, int gt, int NT) {
    const int items = N * (K >> 3);
    for (int it = gt; it < items; it += NT) { const int n = it % N, k0 = (it / N) << 3; float v[8];
#pragma unroll
        for (int j = 0; j < 8; ++j) v[j] = f(k0 + j, n);
        *(v4u*)(dst + (size_t)n * K + k0) = pack8(v); }
}
__device__ __forceinline__ void phase_prologue(Frame& F, const Args& a) {
    const int gt = F.bid * 512 + F.tid, NT = F.G * 512; unsigned char* ws = F.ws;
    { const float* W = a.in[5];
      wprep((bf16*)(ws + WS_WIN), NU, D, [=](int k, int n) { const int c = n < 964 ? n : (n < 1024 ? -1 : n - 60); return c < 0 ? 0.f : W[(size_t)k * 2756 + c]; }, gt, NT); }
    { const float* w2 = a.in[8]; const float* a2 = a.in[10]; const float* g2 = a.in[11];
      wprep((bf16*)(ws + WS_WLORA), 1536, 256, [=](int k, int n) { if (n < 512) return k < 64 ? w2[k * 512 + n] : 0.f; if (n < 1024) return (k >= 64 && k < 128) ? a2[(k - 64) * 512 + n - 512] : 0.f; return k >= 128 ? g2[(k - 128) * 512 + n - 1024] : 0.f; }, gt, NT); }
    { const float* W = a.in[17]; wprep((bf16*)(ws + WS_WOUT), D, D, [=](int k, int n) { return W[(size_t)k * D + n]; }, gt, NT); }
    for (int L = 0; L < 2; ++L) {
        const float* wg = a.in[31] + (size_t)L * D * FF; const float* wu = a.in[32] + (size_t)L * D * FF; const float* wd = a.in[33] + (size_t)L * FF * D;
        const float* wp = a.in[34] + (size_t)L * 256 * D; const float* wpg = a.in[36] + (size_t)L * D * D;
        wprep((bf16*)(ws + WS_WGU0 + L * WS_LAYER_STRIDE), 2 * FF, D, [=](int k, int n) { const int hid = 16 * (n >> 5) + (n & 15); return ((n & 31) >= 16 ? wu : wg)[(size_t)k * FF + hid]; }, gt, NT);
        wprep((bf16*)(ws + WS_WD0 + L * WS_LAYER_STRIDE), D, FF, [=](int k, int n) { return wd[(size_t)k * D + n]; }, gt, NT);
        wprep((bf16*)(ws + WS_WPLE0 + L * WS_LAYER_STRIDE), D, 256, [=](int k, int n) { return wp[(size_t)k * D + n]; }, gt, NT);
        wprep((bf16*)(ws + WS_WPG0 + L * WS_LAYER_STRIDE), D, D, [=](int k, int n) { return wpg[(size_t)k * D + n]; }, gt, NT);
    }
    { const float* W = a.in[18]; wprep((bf16*)(ws + WS_WUP), 2 * CI, D, [=](int k, int n) { return W[(size_t)k * (2 * CI) + n]; }, gt, NT); }
    { const float* W = a.in[29]; wprep((bf16*)(ws + WS_WDOWN), D, CI, [=](int k, int n) { return W[(size_t)k * D + n]; }, gt, NT); }
    { const float* wq = a.in[21]; const float* wk = a.in[22]; const float* wv = a.in[23]; const float* wif = a.in[24]; float* W12 = (float*)(ws + WS_W12);
      for (int it = gt; it < 4096 * 8; it += NT) { const int o = it & 7, c = (it >> 3) & 2047, part = it >> 14, g = c >> 2, i = c & 3; float s = 0.f;
          if (part == 0) { for (int j = 0; j < 4; ++j) s += wq[(g * 4 + i) * 4 + j] * wif[(size_t)(4 * g + j) * 8 + o] + wk[(g * 4 + i) * 4 + j] * wif[(size_t)(2048 + 4 * g + j) * 8 + o]; }
          else { for (int j = 0; j < 4; ++j) s += wv[(g * 4 + i) * 4 + j] * wif[(size_t)(4096 + 4 * g + j) * 8 + o]; }
          W12[it] = s; } }
}
__device__ __forceinline__ void phase_norm(Frame& F, const float* src, const float* gain, bf16* dst, int nrows) {
    const int gw = F.bid * NWAVES + F.wave, NGW = F.G * NWAVES, lane = F.lane;
    f32x4 g[4];
#pragma unroll
    for (int j = 0; j < 4; ++j) g[j] = *((const f32x4*)gain + lane + 64 * j);
    for (int m = gw; m < nrows; m += NGW) {
        const f32x4* xr = (const f32x4*)(src + (size_t)m * D) + lane; f32x4 v[4]; float s = 0.f;
#pragma unroll
        for (int j = 0; j < 4; ++j) { v[j] = xr[64 * j]; s += (v[j].x * v[j].x + v[j].y * v[j].y) + (v[j].z * v[j].z + v[j].w * v[j].w); }
        const float r = rsqrtf(wave_sum(s) * (1.f / D) + NORM_EPS);
        v2u* o = (v2u*)(dst + (size_t)m * D) + lane;
#pragma unroll
        for (int j = 0; j < 4; ++j) { v2u w; w.x = pk2(v[j].x * r * g[j].x, v[j].y * r * g[j].y); w.y = pk2(v[j].z * r * g[j].z, v[j].w * r * g[j].w); o[64 * j] = w; }
    }
}
__device__ __forceinline__ void phase_cvt_p(Frame& F, const float* p, bf16* pb) {
    const size_t gt = (size_t)F.bid * 512 + F.tid, NT = (size_t)F.G * 512, n8 = (size_t)T * 256 / 8;
    for (size_t i = gt; i < n8; i += NT) { const f32x4 a = *((const f32x4*)p + 2 * i), b = *((const f32x4*)p + 2 * i + 1); v4u o; o.x = pk2(a.x, a.y); o.y = pk2(a.z, a.w); o.z = pk2(b.x, b.y); o.w = pk2(b.z, b.w); *((v4u*)pb + i) = o; }
}
constexpr float QSCALE = 0.125f * LOG2E;
__device__ __forceinline__ void phase_prepA(Frame& F, const Args& a) {
    unsigned char* ws = F.ws; const bf16* UA = (const bf16*)(ws + WS_UA); const bf16* UB = (const bf16*)(ws + WS_UB);
    bf16* LIN = (bf16*)(ws + WS_LIN); bf16* QN = (bf16*)(ws + WS_QN); bf16* KN = (bf16*)(ws + WS_KN); bf16* VT = (bf16*)(ws + WS_VT);
    const float* mu = a.in[6]; const float* gq = a.in[3]; const float* gk = a.in[4];
    { const int gt = F.bid * 512 + F.tid, NT = F.G * 512;
      for (int it = gt; it < T * 32; it += NT) { const int t = it >> 5, c8 = (it & 31) << 3;
          float u[8], p[8], o[8]; unpack8(*(const v4u*)(UB + (size_t)t * UB_W + 1536 + c8), u);
          if ((t & (SEQ - 1)) != 0) unpack8(*(const v4u*)(UB + (size_t)(t - 1) * UB_W + 1536 + c8), p); else { for (int j = 0; j < 8; ++j) p[j] = 0.f; }
#pragma unroll
          for (int j = 0; j < 8; ++j) { const float s = u[j] + mu[1536 + c8 + j] * (p[j] - u[j]); o[j] = c8 < 64 ? tanhf(s) : (c8 < 128 ? s : sigm(s)); }
          *(v4u*)(LIN + (size_t)t * 256 + c8) = pack8(o); } }
    { const int gw = F.bid * NWAVES + F.wave, NGW = F.G * NWAVES, lane = F.lane; float gqv[8], gkv[8];
#pragma unroll
      for (int j = 0; j < 8; ++j) { gqv[j] = gq[((lane & 7) << 3) + j] * QSCALE; gkv[j] = gk[((lane & 7) << 3) + j]; }
      for (int t = gw; t < T; t += NGW) {
          float q[8], k[8]; unpack8(*(const v4u*)(UA + (size_t)t * UA_W + 8 * lane), q); unpack8(*(const v4u*)(UA + (size_t)t * UA_W + UA_K + 8 * (lane & 7)), k);
          float sq = 0.f, sk = 0.f;
#pragma unroll
          for (int j = 0; j < 8; ++j) { sq += q[j] * q[j]; sk += k[j] * k[j]; }
          sq += __shfl_xor(sq, 1); sq += __shfl_xor(sq, 2); sq += __shfl_xor(sq, 4); sk += __shfl_xor(sk, 1); sk += __shfl_xor(sk, 2); sk += __shfl_xor(sk, 4);
          const float rq = rsqrtf(sq * (1.f / 64.f) + NORM_EPS), rk = rsqrtf(sk * (1.f / 64.f) + NORM_EPS);
#pragma unroll
          for (int j = 0; j < 8; ++j) { q[j] *= rq * gqv[j]; k[j] *= rk * gkv[j]; }
          *(v4u*)(QN + (size_t)t * 512 + 8 * lane) = pack8(q);
          if (lane < 8) *(v4u*)(KN + (size_t)t * 64 + 8 * lane) = pack8(k); } }
    { LAS bf16* tile = (LAS bf16*)F.lds;
      for (int u = F.bid; u < T / 64; u += F.G) { const int t0 = u * 64, b = t0 / SEQ, s0 = t0 % SEQ; const int tok = F.tid >> 3, c8 = (F.tid & 7) << 3;
          *(LAS v4u*)(tile + tok * 72 + c8) = *(const v4u*)(UA + (size_t)(t0 + tok) * UA_W + UA_V + c8);
          __syncthreads();
          const int d = F.tid >> 3, s8 = (F.tid & 7) << 3; v4u o; unsigned short e[8];
#pragma unroll
          for (int j = 0; j < 8; ++j) e[j] = tile[(s8 + j) * 72 + d];
          o.x = e[0] | ((unsigned)e[1] << 16); o.y = e[2] | ((unsigned)e[3] << 16); o.z = e[4] | ((unsigned)e[5] << 16); o.w = e[6] | ((unsigned)e[7] << 16);
          *(v4u*)(VT + ((size_t)b * 64 + d) * SEQ + s0 + s8) = o;
          __syncthreads(); } }
}
constexpr int IDX_STRIDE = 2052, KSEL = 256;
__device__ __forceinline__ void topk_select(const LAS float* row, int limit, unsigned* maskrow, int lane) {
    unsigned long long mybits = 0ull; const int nj = limit >> 6;
    if (limit <= KSEL) { mybits = lane < nj ? ~0ull : 0ull; }
    else {
        unsigned key[32];
#pragma unroll
        for (int j = 0; j < 32; ++j) { unsigned k = 0u; if (j < nj) { unsigned u = __float_as_uint(row[64 * j + lane]); if (u == 0x80000000u) u = 0u; k = (u & 0x80000000u) ? ~u : (u | 0x80000000u); } key[j] = k; }
        unsigned prefix = 0u; bool exact = false;
        for (int bit = 31; bit >= 0; --bit) { const unsigned cand = prefix | (1u << bit); int cnt = 0;
#pragma unroll
            for (int j = 0; j < 32; ++j) if (j < nj) cnt += __builtin_popcountll(__ballot(key[j] >= cand));
            if (cnt >= KSEL) { prefix = cand; if (cnt == KSEL) { exact = true; break; } } }
        int need = 0;
        if (!exact) { int cgt = 0;
#pragma unroll
            for (int j = 0; j < 32; ++j) if (j < nj) cgt += __builtin_popcountll(__ballot(key[j] > prefix));
            need = KSEL - cgt; }
        int running = 0; const unsigned long long below = (1ull << lane) - 1ull;
#pragma unroll
        for (int j = 0; j < 32; ++j) if (j < nj) {
            const bool gt = exact ? (key[j] >= prefix) : (key[j] > prefix); const bool tie = (!exact) && key[j] == prefix;
            const unsigned long long tb = __ballot(tie); const int rank = running + __builtin_popcountll(tb & below); running += __builtin_popcountll(tb);
            const unsigned long long sb = __ballot(gt || (tie && rank < need)); if (lane == j) mybits = sb; }
    }
    if (lane < 32) { v2u w; w.x = (unsigned)mybits; w.y = (unsigned)(mybits >> 32); *(v2u*)(maskrow + 2 * lane) = w; }
}
__device__ __forceinline__ void phase_indexer(Frame& F) {
    unsigned char* ws = F.ws; const bf16* UA = (const bf16*)(ws + WS_UA); unsigned* MASK = (unsigned*)(ws + WS_MASK);
    LAS float* sc = (LAS float*)F.lds; const int lane = F.lane, w = F.wave, fr = lane & 15, fq = lane >> 4;
    for (int r = 0;; ++r) { const int u = r * F.G + ((r & 1) ? (F.G - 1 - F.bid) : F.bid); if (u >= NB * 128) break;
        const int c = 31 - (u >> 7), rest = u & 127, b = rest >> 2, g4 = rest & 3, limit = 64 * (c + 1), tq0 = b * SEQ + c * 64 + g4 * 16;
        const bf16* UAb = UA + (size_t)b * SEQ * UA_W;
        bf16x8 qf[4][2]; float iwv[4];
        { const bf16* qp = UA + (size_t)(tq0 + fr) * UA_W;
#pragma unroll
          for (int hh = 0; hh < 4; ++hh) { qf[hh][0] = *(const bf16x8*)(qp + UA_IQ + hh * 64 + fq * 8); qf[hh][1] = *(const bf16x8*)(qp + UA_IQ + hh * 64 + 32 + fq * 8); iwv[hh] = bf1(qp[UA_IW + hh]) * (1.f / 16.f); } }
        for (int kt = w; kt < (limit >> 4); kt += NWAVES) {
            const bf16* kp = UAb + (size_t)(kt * 16 + fr) * UA_W + UA_IK + fq * 8; const bf16x8 a0 = *(const bf16x8*)kp, a1 = *(const bf16x8*)(kp + 32);
            f32x4 s = {0.f, 0.f, 0.f, 0.f};
#pragma unroll
            for (int hh = 0; hh < 4; ++hh) { f32x4 d = {0.f, 0.f, 0.f, 0.f}; d = __builtin_amdgcn_mfma_f32_16x16x32_bf16(a0, qf[hh][0], d, 0, 0, 0); d = __builtin_amdgcn_mfma_f32_16x16x32_bf16(a1, qf[hh][1], d, 0, 0, 0);
#pragma unroll
                for (int j = 0; j < 4; ++j) s[j] += iwv[hh] * fmaxf(d[j], 0.f); }
            *(LAS f32x4*)(sc + fr * IDX_STRIDE + kt * 16 + fq * 4) = s; }
        __syncthreads();
#pragma unroll 1
        for (int qq = 0; qq < 2; ++qq) { const int q = 2 * w + qq; topk_select(sc + q * IDX_STRIDE, limit, MASK + (size_t)(tq0 + q) * 64, lane); }
        __syncthreads(); }
}
__device__ __forceinline__ bf16x8 mk8(v2u lo, v2u hi) { v4u t; t.x = lo.x; t.y = lo.y; t.z = hi.x; t.w = hi.y; return __builtin_bit_cast(bf16x8, t); }
__device__ __forceinline__ void phase_dsa_attn(Frame& F, const Args& a) {
    unsigned char* ws = F.ws; const bf16* QN = (const bf16*)(ws + WS_QN); const bf16* KN = (const bf16*)(ws + WS_KN); const bf16* VT = (const bf16*)(ws + WS_VT);
    const unsigned* MASK = (const unsigned*)(ws + WS_MASK); bf16* MIX = (bf16*)(ws + WS_XB);
    const int lane = F.lane, w = F.wave, fr = lane & 15, fq = lane >> 4;
    const float mb = 8.f * LOG2E * wave_max(fabsf(a.in[3][lane])) * wave_max(fabsf(a.in[4][lane]));
    for (int r = 0;; ++r) { const int u = r * F.G + ((r & 1) ? (F.G - 1 - F.bid) : F.bid); if (u >= NB * 32) break;
        const int c = 31 - (u >> 5), b = u & 31, limit = 64 * (c + 1), t0 = b * SEQ + 64 * c;
        bf16x8 qf[4][2];
#pragma unroll
        for (int i = 0; i < 4; ++i) { const bf16* qp = QN + (size_t)(t0 + 16 * i + fr) * 512 + w * 64 + fq * 8; qf[i][0] = *(const bf16x8*)qp; qf[i][1] = *(const bf16x8*)(qp + 32); }
        f32x4 O[4][4]; float l[4];
#pragma unroll
        for (int i = 0; i < 4; ++i) { l[i] = 0.f;
#pragma unroll
            for (int dt = 0; dt < 4; ++dt) O[i][dt] = (f32x4){0.f, 0.f, 0.f, 0.f}; }
        const bf16* Kb = KN + (size_t)b * SEQ * 64; const bf16* Vb = VT + (size_t)b * 64 * SEQ; const unsigned* Mb = MASK + (size_t)t0 * 64;
        for (int kt = 0; kt < (limit >> 5); ++kt) {
            bf16x8 kf[2][2], vf[4]; unsigned mw[4];
#pragma unroll
            for (int s2 = 0; s2 < 2; ++s2) { const bf16* kp = Kb + (size_t)(32 * kt + 16 * s2 + fr) * 64 + fq * 8; kf[s2][0] = *(const bf16x8*)kp; kf[s2][1] = *(const bf16x8*)(kp + 32); }
#pragma unroll
            for (int dt = 0; dt < 4; ++dt) { const bf16* vp = Vb + (size_t)(16 * dt + fr) * SEQ + 32 * kt + 4 * fq; vf[dt] = mk8(*(const v2u*)vp, *(const v2u*)(vp + 16)); }
#pragma unroll
            for (int i = 0; i < 4; ++i) mw[i] = Mb[(size_t)(16 * i + fr) * 64 + kt];
#pragma unroll
            for (int i = 0; i < 4; ++i) {
                f32x4 s0 = {0.f, 0.f, 0.f, 0.f}, s1 = {0.f, 0.f, 0.f, 0.f};
                s0 = __builtin_amdgcn_mfma_f32_16x16x32_bf16(kf[0][0], qf[i][0], s0, 0, 0, 0); s0 = __builtin_amdgcn_mfma_f32_16x16x32_bf16(kf[0][1], qf[i][1], s0, 0, 0, 0);
                s1 = __builtin_amdgcn_mfma_f32_16x16x32_bf16(kf[1][0], qf[i][0], s1, 0, 0, 0); s1 = __builtin_amdgcn_mfma_f32_16x16x32_bf16(kf[1][1], qf[i][1], s1, 0, 0, 0);
                const unsigned b0 = mw[i] >> (4 * fq), b1 = mw[i] >> (16 + 4 * fq); float p[8];
#pragma unroll
                for (int j = 0; j < 4; ++j) { p[j] = ((b0 >> j) & 1u) ? __builtin_amdgcn_exp2f(s0[j] - mb) : 0.f; p[4 + j] = ((b1 >> j) & 1u) ? __builtin_amdgcn_exp2f(s1[j] - mb) : 0.f; }
                l[i] += ((p[0] + p[1]) + (p[2] + p[3])) + ((p[4] + p[5]) + (p[6] + p[7]));
                const bf16x8 pa = __builtin_bit_cast(bf16x8, pack8(p));
#pragma unroll
                for (int dt = 0; dt < 4; ++dt) O[i][dt] = __builtin_amdgcn_mfma_f32_16x16x32_bf16(pa, vf[dt], O[i][dt], 0, 0, 0);
            } }
#pragma unroll
        for (int i = 0; i < 4; ++i) { float li = l[i]; li += __shfl_xor(li, 16); li += __shfl_xor(li, 32);
#pragma unroll
            for (int j = 0; j < 4; ++j) { const float inv = 1.0f / __shfl(li, 4 * fq + j); bf16* op = MIX + (size_t)(t0 + 16 * i + 4 * fq + j) * D + w * 64 + fr;
#pragma unroll
                for (int dt = 0; dt < 4; ++dt) op[16 * dt] = (bf16)f2bf(O[i][dt][j] * inv); } }
    }
}
#define DPPQ(q) "quad_perm:[" #q "," #q "," #q "," #q "] row_mask:0xf bank_mask:0xf"
#define DPP_MUL(d, a, b, q) asm("v_mul_f32_dpp %0, %1, %2 " DPPQ(q) : "=v"(d) : "v"(a), "v"(b))
#define DPP_FMAC(d, a, b, q) asm("v_fmac_f32_dpp %0, %1, %2 " DPPQ(q) : "+v"(d) : "v"(a), "v"(b))
__device__ __forceinline__ void phase_rwkv(Frame& F, const Args& a) {
    unsigned char* ws = F.ws; const bf16* UB = (const bf16*)(ws + WS_UB); const bf16* LOUT = (const bf16*)(ws + WS_LOUT); bf16* MIX = (bf16*)(ws + WS_XB);
    const float* mu = a.in[6]; const float* w0 = a.in[7]; const float* a0 = a.in[9]; const float* k_k = a.in[12]; const float* k_a = a.in[13]; const float* r_k = a.in[14]; const float* gn_g = a.in[15]; const float* gn_b = a.in[16];
    const int lane = F.lane, w = F.wave;
    LAS float* vecs = (LAS float*)F.lds;
    LAS float* vx_s = vecs + 5 * 4096;
    LAS float* g_s = vx_s + 4096;
    LAS float* yacc = g_s + 4096;
    LAS float* bonus_s = yacc + 4096;
    LAS float* part = bonus_s + 64;
    for (int bh = F.bid; bh < NB * 8; bh += F.G) {
        const int b = bh >> 3, h = bh & 7, c = h * 64 + lane;
        const float mur = mu[c], muk = mu[512 + c], muv = mu[1024 + c], w0c = w0[c], a0c = a0[c], kkc = k_k[c], kac = k_a[c], rkc = r_k[c], gng = gn_g[c], gnb = gn_b[c];
        float S[8];
#pragma unroll
        for (int j = 0; j < 8; ++j) S[j] = 0.f;
        for (int batch = 0; batch < SEQ / 64; ++batch) {
#ifndef RWKV_PREP_REP
#define RWKV_PREP_REP 1
#endif
            for (int i_ = 0; i_ < 8 * RWKV_PREP_REP; ++i_) { const int i = i_ & 7; const int step = w + 8 * i, sl = batch * 64 + step; const size_t t = (size_t)b * SEQ + sl;
                const bf16* up = UB + t * UB_W + c; float ur = bf1(up[0]), uk = bf1(up[512]), uv = bf1(up[1024]), pr = 0.f, pk = 0.f, pv = 0.f;
                if (sl > 0) { pr = bf1(up[-UB_W]); pk = bf1(up[512 - UB_W]); pv = bf1(up[1024 - UB_W]); }
                const float rr = ur + mur * (pr - ur), kx = uk + muk * (pk - uk), vx = uv + muv * (pv - uv);
                const bf16* lp = LOUT + t * 1536 + c; const float wd = bf1(lp[0]), ad = bf1(lp[512]), gg = bf1(lp[1024]);
                const float wraw = -softplusf_(-(w0c + wd)) - 0.5f, decay = __expf(-__expf(wraw)), av = sigm(a0c + ad);
                float kk = kx * kkc; const float nrm = sqrtf(wave_sum(kk * kk)); kk = kk / fmaxf(nrm, 1e-12f);
                const float km = kx * (1.f + (av - 1.f) * kac); const float bon = wave_sum(rr * km * rkc);
                LAS float* sp = vecs + step * 64 + lane;
                sp[0] = decay; sp[4096] = -kk; sp[8192] = kk * av; sp[12288] = km; sp[16384] = rr;
                vx_s[step * 64 + lane] = vx; g_s[step * 64 + lane] = gg; yacc[step * 64 + lane] = 0.f; if (lane == 0) bonus_s[step] = bon; }
            LDS_WAIT(); __syncthreads();
            const LAS float* vq = vecs + 8 * w + (lane & 3);
#ifdef PROBE_BAR
#define PROBE_X __builtin_amdgcn_s_barrier(); asm volatile("" ::: "memory");
#else
#define PROBE_X
#endif
#ifdef PROBE_DPP
#define PROBE_Y(X) { float d0_ = dmy, d1_ = dmy; _Pragma("unroll") for (int r_ = 0; r_ < 5; ++r_) { DPP_FMAC(d0_, X[0], S[0], 0); DPP_FMAC(d1_, X[1], S[4], 0); DPP_FMAC(d0_, X[2], S[1], 1); DPP_FMAC(d1_, X[3], S[5], 1); DPP_FMAC(d0_, X[4], S[2], 2); DPP_FMAC(d1_, X[5], S[6], 2); DPP_FMAC(d0_, X[6], S[3], 3); DPP_FMAC(d1_, X[7], S[7], 3); } dmy = d0_ + d1_; }
#else
#define PROBE_Y(X)
#endif
#define RW_LOAD(X, step) do { const LAS float* q_ = vq + (step) * 64; X[0] = q_[0]; X[1] = q_[4]; X[2] = q_[4096]; X[3] = q_[4100]; X[4] = q_[8192]; X[5] = q_[8196]; X[6] = q_[12288]; X[7] = q_[12292]; X[8] = q_[16384]; X[9] = q_[16388]; X[10] = vx_s[(step) * 64 + lane]; } while (0)
#define RW_HALF(X, o, jb) do { float t_; \
                DPP_MUL(t_, X[6 + o], vv, 0); DPP_FMAC(t_, X[4 + o], sa, 0); DPP_FMAC(t_, X[0 + o], S[jb + 0], 0); S[jb + 0] = t_; \
                DPP_MUL(t_, X[6 + o], vv, 1); DPP_FMAC(t_, X[4 + o], sa, 1); DPP_FMAC(t_, X[0 + o], S[jb + 1], 1); S[jb + 1] = t_; \
                DPP_MUL(t_, X[6 + o], vv, 2); DPP_FMAC(t_, X[4 + o], sa, 2); DPP_FMAC(t_, X[0 + o], S[jb + 2], 2); S[jb + 2] = t_; \
                DPP_MUL(t_, X[6 + o], vv, 3); DPP_FMAC(t_, X[4 + o], sa, 3); DPP_FMAC(t_, X[0 + o], S[jb + 3], 3); S[jb + 3] = t_; } while (0)
#define RWKV_STEP(X, Y, step) do { float pa, pb; \
                DPP_MUL(pa, X[2], S[0], 0); DPP_MUL(pb, X[3], S[4], 0); DPP_FMAC(pa, X[2], S[1], 1); DPP_FMAC(pb, X[3], S[5], 1); DPP_FMAC(pa, X[2], S[2], 2); DPP_FMAC(pb, X[3], S[6], 2); DPP_FMAC(pa, X[2], S[3], 3); DPP_FMAC(pb, X[3], S[7], 3); \
                LAS float* pp = part + (((step) & 1) * 64 + lane) * 16; pp[w] = pa + pb; pp[8 + w] = yprev; \
                if ((step) < 63) RW_LOAD(Y, (step) + 1); \
                LDS_WAIT(); __builtin_amdgcn_s_barrier(); asm volatile("" ::: "memory"); PROBE_X \
                const f32x4 q0 = *(LAS f32x4*)pp, q1 = *(LAS f32x4*)(pp + 4); \
                if ((step) > 0 && w == (((step) - 1) & 7)) { const f32x4 y0_ = *(LAS f32x4*)(pp + 8), y1_ = *(LAS f32x4*)(pp + 12); yacc[((step) - 1) * 64 + lane] = ((y0_[0] + y0_[1]) + (y0_[2] + y0_[3])) + ((y1_[0] + y1_[1]) + (y1_[2] + y1_[3])); } \
                LDS_WAIT(); \
                const float sa = ((q0[0] + q0[1]) + (q0[2] + q0[3])) + ((q1[0] + q1[1]) + (q1[2] + q1[3])); const float vv = X[10]; \
                RW_HALF(X, 0, 0); RW_HALF(X, 1, 4); \
                float ya, yb; DPP_MUL(ya, X[8], S[0], 0); DPP_MUL(yb, X[9], S[4], 0); DPP_FMAC(ya, X[8], S[1], 1); DPP_FMAC(yb, X[9], S[5], 1); DPP_FMAC(ya, X[8], S[2], 2); DPP_FMAC(yb, X[9], S[6], 2); DPP_FMAC(ya, X[8], S[3], 3); DPP_FMAC(yb, X[9], S[7], 3); \
                PROBE_Y(X) yprev = ya + yb; } while (0)
#ifndef SCAN_REP
#define SCAN_REP 1
#endif
            float Ssave[8];
            for (int rep_ = 0; rep_ < SCAN_REP; ++rep_) {
            if (SCAN_REP > 1) { for (int j = 0; j < 8; ++j) { if (rep_ == 0) Ssave[j] = S[j]; else S[j] = Ssave[j]; } if (rep_) { for (int st_ = 0; st_ < 64; ++st_) yacc[st_ * 64 + lane] = 0.f; LDS_WAIT(); __syncthreads(); } }
            float XA[11], XB_[11]; float dmy = 0.f, yprev = 0.f;
            RW_LOAD(XA, 0);
            for (int s2 = 0; s2 < 64; s2 += 2) {
                RWKV_STEP(XA, XB_, s2);
                RWKV_STEP(XB_, XA, s2 + 1);
            }
            asm volatile("" :: "v"(dmy));
            { LAS float* pp = part + lane * 16; pp[8 + w] = yprev; LDS_WAIT(); __syncthreads();
              if (w == 7) { const f32x4 y0_ = *(LAS f32x4*)(pp + 8), y1_ = *(LAS f32x4*)(pp + 12); yacc[63 * 64 + lane] = ((y0_[0] + y0_[1]) + (y0_[2] + y0_[3])) + ((y1_[0] + y1_[1]) + (y1_[2] + y1_[3])); } }
            LDS_WAIT(); __syncthreads();
            }
            for (int i = 0; i < 8; ++i) { const int step = w + 8 * i; const size_t t = (size_t)b * SEQ + batch * 64 + step;
                const float y = yacc[step * 64 + lane], mean = wave_sum(y) * (1.f / 64.f), dlt = y - mean, var = wave_sum(dlt * dlt) * (1.f / 64.f);
                const float yn = dlt * rsqrtf(var + 64e-5f) * gng + gnb; const float o = (yn + bonus_s[step] * vx_s[step * 64 + lane]) * g_s[step * 64 + lane];
                MIX[t * D + 512 + c] = (bf16)f2bf(o); }
            LDS_WAIT(); __syncthreads();
        }
    }
}
__device__ __forceinline__ void phase_l1prep(Frame& F, const Args& a, int hb) {
    unsigned char* ws = F.ws; const bf16* XM = (const bf16*)(ws + WS_XM); bf16* XC = (bf16*)(ws + WS_XC); bf16* Q = (bf16*)(ws + WS_Q); bf16* K = (bf16*)(ws + WS_K); bf16* V = (bf16*)(ws + WS_V);
    float* GI = (float*)(ws + WS_GI); const float* W12 = (const float*)(ws + WS_W12);
    const float* cw = a.in[19]; const float* cb = a.in[20]; const float* wq = a.in[21]; const float* wk = a.in[22]; const float* wv = a.in[23]; const float* b_i = a.in[25]; const float* b_f = a.in[26];
    const int g = F.tid, lane = F.lane, w = F.wave; LAS float* red = (LAS float*)F.lds;
    float cwr[4][4], cbr[4], wqr[16], wkr[16], wvr[16], w1[32], w2[32];
#pragma unroll
    for (int j = 0; j < 4; ++j)
#pragma unroll
        for (int i = 0; i < 4; ++i) cwr[j][i] = cw[j * CI + 4 * g + i];
#pragma unroll
    for (int i = 0; i < 4; ++i) cbr[i] = cb[4 * g + i];
#pragma unroll
    for (int i = 0; i < 16; ++i) { wqr[i] = wq[g * 16 + i]; wkr[i] = wk[g * 16 + i]; wvr[i] = wv[g * 16 + i]; }
#pragma unroll
    for (int i = 0; i < 32; ++i) { w1[i] = W12[(size_t)(4 * g) * 8 + i]; w2[i] = W12[(size_t)(2048 + 4 * g) * 8 + i]; }
    const int per = TH / F.G;
    const int tb = F.bid * per;
    float x0[4], x1[4], x2[4];
    for (int n = 0; n < per; ++n) { const int t = tb + n, sl = t & (SEQ - 1);
        if (n == 0 || sl == 0) {
#pragma unroll
            for (int i = 0; i < 4; ++i) { x0[i] = 0.f; x1[i] = 0.f; x2[i] = 0.f; }
            if (sl >= 1) { const v2u r = *(const v2u*)(XM + (size_t)(t - 1) * CI + 4 * g); x2[0] = bflo(r.x); x2[1] = bfhi(r.x); x2[2] = bflo(r.y); x2[3] = bfhi(r.y); }
            if (sl >= 2) { const v2u r = *(const v2u*)(XM + (size_t)(t - 2) * CI + 4 * g); x1[0] = bflo(r.x); x1[1] = bfhi(r.x); x1[2] = bflo(r.y); x1[3] = bfhi(r.y); }
            if (sl >= 3) { const v2u r = *(const v2u*)(XM + (size_t)(t - 3) * CI + 4 * g); x0[0] = bflo(r.x); x0[1] = bfhi(r.x); x0[2] = bflo(r.y); x0[3] = bfhi(r.y); }
        }
        float x3[4]; { const v2u r = *(const v2u*)(XM + (size_t)t * CI + 4 * g); x3[0] = bflo(r.x); x3[1] = bfhi(r.x); x3[2] = bflo(r.y); x3[3] = bfhi(r.y); }
        float xc[4], q[4], k[4], v[4];
#pragma unroll
        for (int i = 0; i < 4; ++i) { const float s = cbr[i] + cwr[0][i] * x0[i] + cwr[1][i] * x1[i] + cwr[2][i] * x2[i] + cwr[3][i] * x3[i]; xc[i] = s * sigm(s); }
#pragma unroll
        for (int j = 0; j < 4; ++j) { q[j] = xc[0] * wqr[j] + xc[1] * wqr[4 + j] + xc[2] * wqr[8 + j] + xc[3] * wqr[12 + j]; k[j] = xc[0] * wkr[j] + xc[1] * wkr[4 + j] + xc[2] * wkr[8 + j] + xc[3] * wkr[12 + j];
            v[j] = x3[0] * wvr[j] + x3[1] * wvr[4 + j] + x3[2] * wvr[8 + j] + x3[3] * wvr[12 + j]; }
        float gsum[8];
#pragma unroll
        for (int o = 0; o < 8; ++o) { float s = 0.f;
#pragma unroll
            for (int i = 0; i < 4; ++i) s += xc[i] * w1[i * 8 + o] + x3[i] * w2[i * 8 + o];
            gsum[o] = s; }
        const size_t off = (size_t)t * CI + 4 * g; const float ks = 0.044194173824159216f;
        { v2u o; o.x = pk2(xc[0], xc[1]); o.y = pk2(xc[2], xc[3]); *(v2u*)(XC + off) = o; o.x = pk2(q[0], q[1]); o.y = pk2(q[2], q[3]); *(v2u*)(Q + off) = o;
          o.x = pk2(k[0] * ks, k[1] * ks); o.y = pk2(k[2] * ks, k[3] * ks); *(v2u*)(K + off) = o; o.x = pk2(v[0], v[1]); o.y = pk2(v[2], v[3]); *(v2u*)(V + off) = o; }
#pragma unroll
        for (int o = 0; o < 8; ++o) gsum[o] = wave_sum(gsum[o]);
        LAS float* rp = red + (n & 1) * 64;
        if (lane == 0) {
#pragma unroll
            for (int o = 0; o < 8; ++o) rp[w * 8 + o] = gsum[o]; }
        LDS_WAIT(); __syncthreads();
        if (F.tid < 8) { float s = 0.f;
#pragma unroll
            for (int ww = 0; ww < 8; ++ww) s += rp[ww * 8 + F.tid];
            GI[(size_t)t * 8 + F.tid] = s + (F.tid < 4 ? b_i[F.tid] : b_f[F.tid - 4]); }
#pragma unroll
        for (int i = 0; i < 4; ++i) { x0[i] = x1[i]; x1[i] = x2[i]; x2[i] = x3[i]; }
    }
}
__device__ __forceinline__ void phase_gatescan(Frame& F) {
    unsigned char* ws = F.ws; const float* GI = (const float*)(ws + WS_GI); float* GA = (float*)(ws + WS_GA); float* GAM = (float*)(ws + WS_GAM); float* GEM = (float*)(ws + WS_GEM);
    const int gw = F.bid * NWAVES + F.wave, NGW = F.G * NWAVES, lane = F.lane;
    for (int sq = gw; sq < (NB / 2) * 4; sq += NGW) { const int bl = sq >> 2, h = sq & 3; float cF = 0.f, cA = -INFINITY;
        for (int ch = 0; ch < SEQ / 64; ++ch) { const size_t t = (size_t)bl * SEQ + ch * 64 + lane; const float ip = GI[t * 8 + h], fp = GI[t * 8 + 4 + h];
            float lf = -softplusf_(-fp);
#pragma unroll
            for (int o = 1; o < 64; o <<= 1) { const float n = __shfl_up(lf, o); if (lane >= o) lf += n; }
            const float Fv = cF + lf; const float av = ip - Fv; float A = av;
#pragma unroll
            for (int o = 1; o < 64; o <<= 1) { const float n = __shfl_up(A, o); if (lane >= o) A = fmaxf(A, n); }
            A = fmaxf(A, cA);
            GA[t * 4 + h] = av; GAM[t * 4 + h] = A; GEM[t * 4 + h] = __expf(-(Fv + A));
            cF = __shfl(Fv, 63); cA = __shfl(A, 63); } }
}
constexpr int ML_QS = 1040, ML_PS = 144;
constexpr int ML_Q = 0, ML_V = 64 * ML_QS, ML_P = 2 * 64 * ML_QS, ML_DEN = ML_P + 64 * ML_PS, ML_ST = ML_DEN + 1024, ML_MR = ML_ST + 4096, ML_AT = ML_MR + 512, ML_END = ML_AT + 512;
static_assert(ML_END <= MISC_OFF, "mLSTM LDS");
__device__ __forceinline__ bf16x8 tr_read2(unsigned addr0, unsigned addr1) { s16x4 lo, hi;
    asm volatile("ds_read_b64_tr_b16 %0, %2\n\tds_read_b64_tr_b16 %1, %3\n\ts_waitcnt lgkmcnt(0)" : "=&v"(lo), "=&v"(hi) : "v"(addr0), "v"(addr1) : "memory");
    return (bf16x8){lo[0], lo[1], lo[2], lo[3], hi[0], hi[1], hi[2], hi[3]}; }
__device__ __forceinline__ void phase_mlstm(Frame& F, const Args& a) {
    unsigned char* ws = F.ws; const bf16* Q = (const bf16*)(ws + WS_Q); const bf16* K = (const bf16*)(ws + WS_K); const bf16* V = (const bf16*)(ws + WS_V); const bf16* XC = (const bf16*)(ws + WS_XC); const bf16* Z = (const bf16*)(ws + WS_Z);
    bf16* YC = (bf16*)(ws + WS_XM); const float* GA = (const float*)(ws + WS_GA); const float* GAM = (const float*)(ws + WS_GAM); const float* GEM = (const float*)(ws + WS_GEM);
    const float* mh_g = a.in[27]; const float* skip = a.in[28];
    const int tid = F.tid, lane = F.lane, w = F.wave, fr = lane & 15, fq = lane >> 4; LAS unsigned char* lds = F.lds;
    LAS float* den4 = (LAS float*)(lds + ML_DEN); LAS float* stats = (LAS float*)(lds + ML_ST); LAS float* mr = (LAS float*)(lds + ML_MR); LAS float* At_s = (LAS float*)(lds + ML_AT); LAS float* em_s = At_s + 64;
    const int st = w & 3, tt0 = 2 * (w >> 2);
    const unsigned vtr_base = (unsigned)(size_t)(lds + ML_V) + (unsigned)((8 * fq + ((lane & 15) >> 2)) * ML_QS + (64 * w + 4 * (lane & 3)) * 2);
    for (int r = 0;; ++r) { const int u = r * F.G + ((r & 1) ? (F.G - 1 - F.bid) : F.bid); if (u >= 2048) break;
        const int qi = 31 - (u >> 6), bh = u & 63, bl = bh >> 2, h = bh & 3; const size_t t0 = (size_t)bl * SEQ + 64 * qi;
#pragma unroll
        for (int k8 = 0; k8 < 8; ++k8) { const int ch = tid + 512 * k8, row = ch >> 6, c16 = ch & 63; *(LAS v4u*)(lds + ML_Q + row * ML_QS + c16 * 16) = *(const v4u*)(Q + (t0 + row) * CI + h * 512 + c16 * 8); }
        if (tid < 64) { At_s[tid] = GAM[(t0 + tid) * 4 + h]; em_s[tid] = GEM[(t0 + tid) * 4 + h]; }
        f32x4 O[4][4]; float denp[2] = {0.f, 0.f};
#pragma unroll
        for (int i = 0; i < 4; ++i)
#pragma unroll
            for (int e = 0; e < 4; ++e) O[i][e] = (f32x4){0.f, 0.f, 0.f, 0.f};
        LDS_WAIT(); __syncthreads();
        float At[2]; At[0] = At_s[16 * tt0 + fr]; At[1] = At_s[16 * (tt0 + 1) + fr];
        for (int j = 0; j <= qi; ++j) { const size_t s0 = (size_t)bl * SEQ + 64 * j;
            v4u vreg[8];
#pragma unroll
            for (int k8 = 0; k8 < 8; ++k8) { const int ch = tid + 512 * k8, row = ch >> 6, c16 = ch & 63; vreg[k8] = *(const v4u*)(V + (s0 + row) * CI + h * 512 + c16 * 8); }
            f32x4 sacc[2] = {(f32x4){0.f, 0.f, 0.f, 0.f}, (f32x4){0.f, 0.f, 0.f, 0.f}};
            const bf16* kp = K + (s0 + 16 * st + fr) * CI + h * 512 + fq * 8;
#pragma unroll 4
            for (int ks = 0; ks < 16; ++ks) { const bf16x8 kf = *(const bf16x8*)(kp + 32 * ks);
#pragma unroll
                for (int x = 0; x < 2; ++x) { const bf16x8 qf = *(const LAS bf16x8*)(lds + ML_Q + (16 * (tt0 + x) + fr) * ML_QS + (32 * ks + 8 * fq) * 2); sacc[x] = __builtin_amdgcn_mfma_f32_16x16x32_bf16(kf, qf, sacc[x], 0, 0, 0); } }
            float as[4];
#pragma unroll
            for (int i = 0; i < 4; ++i) as[i] = GA[(s0 + 16 * st + 4 * fq + i) * 4 + h];
            v2u pw[2];
#pragma unroll
            for (int x = 0; x < 2; ++x) { float p[4];
#pragma unroll
                for (int i = 0; i < 4; ++i) { const bool ok = (j < qi) || (16 * st + 4 * fq + i <= 16 * (tt0 + x) + fr); p[i] = ok ? sacc[x][i] * __builtin_amdgcn_exp2f((as[i] - At[x]) * LOG2E) : 0.f; }
                denp[x] += (p[0] + p[1]) + (p[2] + p[3]); pw[x].x = pk2(p[0], p[1]); pw[x].y = pk2(p[2], p[3]); }
            __syncthreads();
#pragma unroll
            for (int x = 0; x < 2; ++x) *(LAS v2u*)(lds + ML_P + (16 * (tt0 + x) + fr) * ML_PS + (16 * st + 4 * fq) * 2) = pw[x];
#pragma unroll
            for (int k8 = 0; k8 < 8; ++k8) { const int ch = tid + 512 * k8, row = ch >> 6, c16 = ch & 63; *(LAS v4u*)(lds + ML_V + row * ML_QS + c16 * 16) = vreg[k8]; }
            LDS_WAIT(); __syncthreads();
#pragma unroll
            for (int k2 = 0; k2 < 2; ++k2) { bf16x8 vf[4], pf[4];
#pragma unroll
                for (int e = 0; e < 4; ++e) { const unsigned ad = vtr_base + (unsigned)(32 * k2 * ML_QS + 32 * e); vf[e] = tr_read2(ad, ad + 4 * ML_QS); }
#pragma unroll
                for (int i = 0; i < 4; ++i) pf[i] = *(const LAS bf16x8*)(lds + ML_P + (16 * i + fr) * ML_PS + (32 * k2 + 8 * fq) * 2);
#pragma unroll
                for (int i = 0; i < 4; ++i)
#pragma unroll
                    for (int e = 0; e < 4; ++e) O[i][e] = __builtin_amdgcn_mfma_f32_16x16x32_bf16(pf[i], vf[e], O[i][e], 0, 0, 0); }
        }
#pragma unroll
        for (int x = 0; x < 2; ++x) { float d = denp[x]; d += __shfl_xor(d, 16); d += __shfl_xor(d, 32); if (fq == 0) den4[st * 64 + 16 * (tt0 + x) + fr] = d; }
        LDS_WAIT(); __syncthreads();
        float s1[4][4], s2[4][4];
#pragma unroll
        for (int i = 0; i < 4; ++i)
#pragma unroll
            for (int jj = 0; jj < 4; ++jj) { const int t = 16 * i + 4 * fq + jj; const float dn = (den4[t] + den4[64 + t]) + (den4[128 + t] + den4[192 + t]); const float inv = 1.0f / fmaxf(fabsf(dn), em_s[t]); float a1 = 0.f, a2 = 0.f;
#pragma unroll
                for (int e = 0; e < 4; ++e) { const float hv = O[i][e][jj] * inv; O[i][e][jj] = hv; a1 += hv; a2 += hv * hv; }
                s1[i][jj] = a1; s2[i][jj] = a2; }
#pragma unroll
        for (int i = 0; i < 4; ++i)
#pragma unroll
            for (int jj = 0; jj < 4; ++jj) { float a1 = s1[i][jj], a2 = s2[i][jj];
#pragma unroll
                for (int o = 1; o < 16; o <<= 1) { a1 += __shfl_xor(a1, o); a2 += __shfl_xor(a2, o); }
                if (fr == 0) { const int t = 16 * i + 4 * fq + jj; stats[(w * 64 + t) * 2] = a1; stats[(w * 64 + t) * 2 + 1] = a2; } }
        LDS_WAIT(); __syncthreads();
        if (tid < 64) { float a1 = 0.f, a2 = 0.f;
#pragma unroll
            for (int ww = 0; ww < 8; ++ww) { a1 += stats[(ww * 64 + tid) * 2]; a2 += stats[(ww * 64 + tid) * 2 + 1]; }
            const float mean = a1 * (1.f / 512.f), var = fmaxf(a2 * (1.f / 512.f) - mean * mean, 0.f); mr[2 * tid] = mean; mr[2 * tid + 1] = rsqrtf(var + 1e-5f); }
        LDS_WAIT(); __syncthreads();
#pragma unroll
        for (int e = 0; e < 4; ++e) { const int cc = h * 512 + 64 * w + 16 * e + fr; const float gmul = mh_g[cc], sk = skip[cc];
#pragma unroll
            for (int i = 0; i < 4; ++i)
#pragma unroll
                for (int jj = 0; jj < 4; ++jj) { const int t = 16 * i + 4 * fq + jj; const size_t off = (t0 + t) * CI + cc; const float zz = bf1(Z[off]), xcv = bf1(XC[off]);
                    const float y = ((O[i][e][jj] - mr[2 * t]) * mr[2 * t + 1] * gmul + sk * xcv) * (zz * sigm(zz)); YC[off] = (bf16)f2bf(y); } }
        __syncthreads();
    }
}
#define GEMM_PHASE(EPI, Aptr, Bptr, M_, N_, K_, ...) do { pg8::Gemm g{(const pg8::bf16_t*)(Aptr), (const pg8::bf16_t*)(Bptr), (M_), (N_), (K_)}; pg8::StaticOrder So; So.init((M_), (N_), F.G, F.bid); \
        pg8::EPI Ep{__VA_ARGS__}; pg8::gemm_phase<pg8::EPI, pg8::StaticOrder, PG8_ALIGN, PG8_SP2>(F.lds, g, So, Ep); } while (0)
__global__ void __launch_bounds__(NWAVES * 64, 2) trunk_fwd(Args args) {
    extern __shared__ __attribute__((aligned(16))) unsigned char lds_raw[];
    Frame F; F.lds = (LAS unsigned char*)lds_raw; F.ws = args.ws; F.in = nullptr;
    F.tid = threadIdx.x; F.lane = F.tid & 63; F.wave = __builtin_amdgcn_readfirstlane(F.tid >> 6); F.G = gridDim.x; F.bid = blockIdx.x;
    volatile LAS unsigned* MISC = (volatile LAS unsigned*)(F.lds + MISC_OFF);
    if (F.tid < 64) MISC[F.tid] = 0u;
    __syncthreads();
    XcdBarrier bar; bar.bar = (unsigned*)(args.ws + WS_CTL) + CW_BAR; bar.x = 0; bar.st = nullptr;
    if (args.use_bar) bar = xcd_barrier_post((unsigned*)(args.ws + WS_CTL) + CW_BAR, MISC + 8);
    const int lo = args.ph_lo, hi = args.ph_hi;
#ifndef ONLY_SITE
#define ONLY_SITE -1
#endif
#define EN(n) (ONLY_SITE < 0 || ONLY_SITE == (n))
#ifndef REP_MASK
#define REP_MASK 0u
#endif
#define NREP(n) (((REP_MASK >> (n)) & 1u) ? 2 : 1)
#define IN(k) (lo <= (k) && (k) < hi)
#define SEAM(k) do { if (IN(k) && IN((k) + 1)) xcd_barrier(bar); } while (0)
    unsigned char* ws = args.ws; float* out = args.out;
    if (EN(0) && IN(0)) { for (int rep_ = 0; rep_ < NREP(0); ++rep_) { if (rep_) xcd_barrier(bar); phase_prologue(F, args); } } SEAM(0);
    if (EN(1) && IN(1)) { for (int rep_ = 0; rep_ < NREP(1); ++rep_) { if (rep_) xcd_barrier(bar); phase_norm(F, args.in[0], args.in[2], (bf16*)(ws + WS_XB), T); } } SEAM(1);
    if (EN(2) && IN(2)) { for (int rep_ = 0; rep_ < NREP(2); ++rep_) { if (rep_) xcd_barrier(bar); GEMM_PHASE(EpiBf16Split, ws + WS_XB, ws + WS_WIN, T, NU, D, (pg8::bf16_t*)(ws + WS_UA), UA_W, 4, (pg8::bf16_t*)(ws + WS_UB), UB_W); } } SEAM(2);
    if (EN(3) && IN(3)) { for (int rep_ = 0; rep_ < NREP(3); ++rep_) { if (rep_) xcd_barrier(bar); phase_prepA(F, args); } } SEAM(3);
    if (EN(4) && IN(4)) { for (int rep_ = 0; rep_ < NREP(4); ++rep_) { if (rep_) xcd_barrier(bar); GEMM_PHASE(EpiBf16Split, ws + WS_LIN, ws + WS_WLORA, T, 1536, 256, (pg8::bf16_t*)(ws + WS_LOUT), 1536, 1 << 20, nullptr, 0); } } SEAM(4);
    if (EN(5) && IN(5)) { for (int rep_ = 0; rep_ < NREP(5); ++rep_) { if (rep_) xcd_barrier(bar); phase_indexer(F); } } SEAM(5);
    if (EN(6) && IN(6)) { for (int rep_ = 0; rep_ < NREP(6); ++rep_) { if (rep_) xcd_barrier(bar); phase_dsa_attn(F, args); } } SEAM(6);
    if (EN(7) && IN(7)) { for (int rep_ = 0; rep_ < NREP(7); ++rep_) { if (rep_) xcd_barrier(bar); phase_rwkv(F, args); } } SEAM(7);
    if (EN(8) && IN(8)) { for (int rep_ = 0; rep_ < NREP(8); ++rep_) { if (rep_) xcd_barrier(bar); GEMM_PHASE(EpiResF32, ws + WS_XB, ws + WS_WOUT, T, D, D, args.in[0], out, D); } } SEAM(8);
#define FFN_PLE(L, pb) do { const size_t lw = (size_t)(L) * WS_LAYER_STRIDE; \
        if (EN(20) && IN(pb)) { for (int rep_ = 0; rep_ < NREP(20); ++rep_) { if (rep_) xcd_barrier(bar); phase_norm(F, out, args.in[30] + (L) * D, (bf16*)(ws + WS_XB), T); } } SEAM(pb); \
        if (EN(21) && IN((pb) + 1)) { for (int rep_ = 0; rep_ < NREP(21); ++rep_) { if (rep_) xcd_barrier(bar); GEMM_PHASE(EpiSwiglu, ws + WS_XB, ws + WS_WGU0 + lw, T, 2 * FF, D, (pg8::bf16_t*)(ws + WS_H), FF); } } SEAM((pb) + 1); \
        if (EN(22) && IN((pb) + 2)) { for (int rep_ = 0; rep_ < NREP(22); ++rep_) { if (rep_) xcd_barrier(bar); GEMM_PHASE(EpiResF32, ws + WS_H, ws + WS_WD0 + lw, T, D, FF, out, out, D); } } SEAM((pb) + 2); \
        if (EN(23) && IN((pb) + 3)) { for (int rep_ = 0; rep_ < NREP(23); ++rep_) { if (rep_) xcd_barrier(bar); phase_norm(F, out, args.in[35] + (L) * D, (bf16*)(ws + WS_XB), T); phase_cvt_p(F, args.in[1] + (size_t)(L) * T * 256, (bf16*)(ws + WS_PB)); } } SEAM((pb) + 3); \
        if (EN(24) && IN((pb) + 4)) { for (int rep_ = 0; rep_ < NREP(24); ++rep_) { if (rep_) xcd_barrier(bar); GEMM_PHASE(EpiBf16Split, ws + WS_PB, ws + WS_WPLE0 + lw, T, D, 256, (pg8::bf16_t*)(ws + WS_E), D, 1 << 20, nullptr, 0); } } SEAM((pb) + 4); \
        if (EN(25) && IN((pb) + 5)) { for (int rep_ = 0; rep_ < NREP(25); ++rep_) { if (rep_) xcd_barrier(bar); GEMM_PHASE(EpiPle, ws + WS_XB, ws + WS_WPG0 + lw, T, D, D, out, out, (const pg8::bf16_t*)(ws + WS_E), D); } } SEAM((pb) + 5); } while (0)
#define L1_HALF(hb, p1) do { float* xh = out + (size_t)(hb) * TH * D; \
        if (EN(10) && IN(p1)) { for (int rep_ = 0; rep_ < NREP(10); ++rep_) { if (rep_) xcd_barrier(bar); phase_norm(F, xh, args.in[2] + D, (bf16*)(ws + WS_XBH), TH); } } SEAM(p1); \
        if (EN(11) && IN((p1) + 1)) { for (int rep_ = 0; rep_ < NREP(11); ++rep_) { if (rep_) xcd_barrier(bar); GEMM_PHASE(EpiBf16Split, ws + WS_XBH, ws + WS_WUP, TH, 2 * CI, D, (pg8::bf16_t*)(ws + WS_XM), CI, 8, (pg8::bf16_t*)(ws + WS_Z), CI); } } SEAM((p1) + 1); \
        if (EN(12) && IN((p1) + 2)) { for (int rep_ = 0; rep_ < NREP(12); ++rep_) { if (rep_) xcd_barrier(bar); phase_l1prep(F, args, hb); } } SEAM((p1) + 2); \
        if (EN(13) && IN((p1) + 3)) { for (int rep_ = 0; rep_ < NREP(13); ++rep_) { if (rep_) xcd_barrier(bar); phase_gatescan(F); } } SEAM((p1) + 3); \
        if (EN(14) && IN((p1) + 4)) { for (int rep_ = 0; rep_ < NREP(14); ++rep_) { if (rep_) xcd_barrier(bar); phase_mlstm(F, args); } } SEAM((p1) + 4); \
        if (EN(15) && IN((p1) + 5)) { for (int rep_ = 0; rep_ < NREP(15); ++rep_) { if (rep_) xcd_barrier(bar); GEMM_PHASE(EpiResF32, ws + WS_XM, ws + WS_WDOWN, TH, D, CI, xh, xh, D); } } SEAM((p1) + 5); } while (0)
    FFN_PLE(0, 9);
    L1_HALF(0, 15);
    L1_HALF(1, 21);
    FFN_PLE(1, 27);
#undef IN
#undef SEAM
}
constexpr int N_PHASES = 33;

#ifndef MK_ONE_LAUNCH
#define MK_ONE_LAUNCH 1
#endif
extern "C" void kernel_launch(void* const* d_in, const int* in_sizes, int n_in, void* d_out, int out_size, void* d_ws, size_t ws_size, hipStream_t stream) {
    static int grid = 0;
    if (grid == 0) {
        if (n_in != 37 || in_sizes[0] != T * D || out_size != T * D || ws_size < WS_END) { fprintf(stderr, "kernel_launch: unexpected shapes (n_in %d, in0 %d, out %d, ws %zu < %zu); nothing launched\n", n_in, n_in > 0 ? in_sizes[0] : -1, out_size, ws_size, (size_t)WS_END); grid = -1; return; }
        int dev = 0, cus = 0, per_cu = 0;
        if (hipGetDevice(&dev) != hipSuccess || hipDeviceGetAttribute(&cus, hipDeviceAttributeMultiprocessorCount, dev) != hipSuccess) { grid = -1; return; }
        if (hipFuncSetAttribute((const void*)trunk_fwd, hipFuncAttributeMaxDynamicSharedMemorySize, LDS_BYTES) != hipSuccess) { fprintf(stderr, "kernel_launch: hipFuncSetAttribute failed\n"); grid = -1; return; }
        if (hipOccupancyMaxActiveBlocksPerMultiprocessor(&per_cu, (const void*)trunk_fwd, NWAVES * 64, LDS_BYTES) != hipSuccess || per_cu < 1) { fprintf(stderr, "kernel_launch: occupancy query says %d\n", per_cu); }
        (void)hipGetLastError();
        grid = cus;
        if (grid != 256) { fprintf(stderr, "kernel_launch: built for 256 CUs, found %d; nothing launched\n", cus); grid = -1; return; }
    }
    if (grid < 0) return;
    if (hipMemsetAsync((char*)d_ws + WS_CTL, 0, CTL_ZERO_BYTES, stream) != hipSuccess) return;
    Args a{};
    for (int i = 0; i < 37; ++i) a.in[i] = (const float*)d_in[i];
    a.out = (float*)d_out; a.ws = (unsigned char*)d_ws; a.pad = 0;
#if MK_ONE_LAUNCH
    a.ph_lo = 0; a.ph_hi = N_PHASES; a.use_bar = 1;
    hipLaunchKernelGGL(trunk_fwd, dim3(grid), dim3(NWAVES * 64), LDS_BYTES, stream, a);
#else
    for (int p = 0; p < N_PHASES; ++p) { a.ph_lo = p; a.ph_hi = p + 1; a.use_bar = 0; hipLaunchKernelGGL(trunk_fwd, dim3(grid), dim3(NWAVES * 64), LDS_BYTES, stream, a); }
#endif
}
```

```cpp
#include <hip/hip_runtime.h>
#include <cstdio>
#include <cstdint>
namespace pg8 {
#define PG8_LAS __attribute__((address_space(3)))
typedef unsigned short bf16_t;
typedef short bf16x8 __attribute__((ext_vector_type(8)));
typedef float f32x4 __attribute__((ext_vector_type(4)));
typedef unsigned u32x4 __attribute__((ext_vector_type(4)));
constexpr int BM = 256, BK = 64, HALF = 128, HTB = HALF * BK * 2  , STAGE_BYTES = 8 * HTB, NXCD = 8, WGM = 8;

__host__ __device__ __forceinline__ int lds_byte(int r, int c) { const int st = (r >> 4) * 2 + (c >> 5), rr = r & 15, cc = c & 31, ob = rr * 64 + cc * 2; return st * 1024 + (ob ^ (((ob >> 9) & 1) << 5)); }
__host__ __device__ __forceinline__ void stage_rc(int b, int& R, int& C) { const int st = b / 1024, sb = b % 1024, swz = sb ^ (((sb >> 9) & 1) << 5); R = (st >> 1) * 16 + swz / 64; C = (st & 1) * 32 + (swz % 64) / 2; }
__host__ __device__ __forceinline__ int perm32(int rho) { const int n = rho >> 4, i = rho & 15; return 8 * (i >> 2) + 4 * n + (i & 3); }

struct Unit { int pm, pn; };
struct Gemm { const bf16_t* A; const bf16_t* Bt; int M, N, K; };

struct StaticOrder {
    int nM, nN, nwg, G, c;
    __host__ __device__ void init(int M, int N, int G_, int c_) { nM = M / BM; nN = N / BM; nwg = nM * nN; G = G_; c = c_; }
    __host__ __device__ bool next(int i, Unit& u) const {
        const long L = (long)i * G + c; if (L >= nwg) return false;
        int wgid = (int)L; { const int q = nwg / NXCD, r = nwg % NXCD, xcd = wgid % NXCD, off = wgid / NXCD; wgid = (xcd < r ? xcd * (q + 1) : r * (q + 1) + (xcd - r) * q) + off; }
        const int nig = WGM * nN, gid = wgid / nig, fm = gid * WGM, gsz = (nM - fm) < WGM ? (nM - fm) : WGM;
        u.pm = fm + ((wgid % nig) % gsz); u.pn = (wgid % nig) / gsz; return true;
    }
    __device__ __forceinline__ void a_ready(const Unit&) const {}
    __device__ __forceinline__ void done(const Unit&) const {}
};

__device__ __forceinline__ unsigned cvt_pk_bf16(float lo, float hi) { unsigned r; asm volatile("v_cvt_pk_bf16_f32 %0, %1, %2" : "=v"(r) : "v"(lo), "v"(hi)); return r; }
typedef float f32x2 __attribute__((ext_vector_type(2)));
__device__ __forceinline__ f32x2 gelu_pk(f32x2 v) {
    const f32x2 av = __builtin_elementwise_abs(v), d = av * 0.2316418882f + 1.0f;
    f32x2 t; t.x = __builtin_amdgcn_rcpf(d.x); t.y = __builtin_amdgcn_rcpf(d.y);
    f32x2 q = t * 0.5307027145f + (-0.7265760135f); q = q * t + 0.7107068705f; q = q * t + (-0.142248368f); q = q * t + 0.127414796f; q = q * t;
    const f32x2 s = (v * v) * (-0.72134752044f);
    f32x2 e; e.x = __builtin_amdgcn_exp2f(s.x); e.y = __builtin_amdgcn_exp2f(s.y);
    const f32x2 m = v * (q * e), r = v - m;
    f32x2 o; o.x = v.x < 0.f ? m.x : r.x; o.y = v.y < 0.f ? m.y : r.y; return o;
}

template <class Epi, class Sched, bool ALIGN_EPI = false, bool SP2 = false>
__device__ __forceinline__ void gemm_phase(PG8_LAS unsigned char* lds, const Gemm g, const Sched& S, const Epi& E) {
    const int tid = threadIdx.x, wid = __builtin_amdgcn_readfirstlane(tid >> 6), lane = tid & 63, wr = wid >> 2, wc = wid & 3, fr = lane & 15, fq = lane >> 4;
    const int K = g.K, nt = K / BK;
    unsigned voffA[2], voffB[2];
#pragma unroll
    for (int i = 0; i < 2; ++i) { int R, C; stage_rc(tid * 16 + i * 8192, R, C); const int Rb = Epi::PERM ? ((R & ~31) + perm32(R & 31)) : R;
        voffA[i] = (unsigned)(R * K + C) * 2u; voffB[i] = (unsigned)(Rb * K + C) * 2u; }
    const size_t kstep = (size_t)(BK * 2);
    const size_t hstep = (size_t)HALF * K * 2;
    const size_t tstep = 2 * hstep;
    const unsigned ldsw = (unsigned)wid * 1024u;
    const int aoff = lds_byte(wr * 64 + fr, fq * 8), boff = lds_byte(wc * 32 + fr, fq * 8);
#define PG8_SA(b, h) (((b) * 2 + (h)) * HTB)
#define PG8_SB(b, h) ((4 + (b) * 2 + (h)) * HTB)
#define PG8_STAGE(bufoff, gbase, voff) do { _Pragma("unroll") for (int _i = 0; _i < 2; ++_i) \
        __builtin_amdgcn_global_load_lds((const unsigned*)((const char*)(gbase) + (voff)[_i]), (PG8_LAS unsigned*)(lds + (bufoff) + ldsw + _i * 8192), 16, 0, 0); } while (0)
#define PG8_LDA(dst, b, h) do { _Pragma("unroll") for (int m = 0; m < 4; ++m) _Pragma("unroll") for (int k = 0; k < 2; ++k) dst[m][k] = *(const PG8_LAS bf16x8*)(lds + PG8_SA(b, h) + aoff + m * 2048 + k * 1024); } while (0)
#define PG8_LDB(dst, b, h) do { _Pragma("unroll") for (int n = 0; n < 2; ++n) _Pragma("unroll") for (int k = 0; k < 2; ++k) dst[n][k] = *(const PG8_LAS bf16x8*)(lds + PG8_SB(b, h) + boff + n * 2048 + k * 1024); } while (0)
#define PG8_MMA(ai, bj, At, Bt) do { __builtin_amdgcn_s_setprio(1); _Pragma("unroll") for (int m = 0; m < 4; ++m) _Pragma("unroll") for (int n = 0; n < 2; ++n) _Pragma("unroll") for (int k = 0; k < 2; ++k) \
        acc[ai][bj][m][n] = __builtin_amdgcn_mfma_f32_16x16x32_bf16(Bt[n][k], At[m][k], acc[ai][bj][m][n], 0, 0, 0); __builtin_amdgcn_s_setprio(0); } while (0)
#define PG8_WAIT_V(n) asm volatile("s_waitcnt vmcnt(" #n ")" ::: "memory")
#define PG8_WAIT_L(n) asm volatile("s_waitcnt lgkmcnt(" #n ")" ::: "memory")
#define PG8_BAR __builtin_amdgcn_s_barrier()
#define PG8_SCHED __builtin_amdgcn_sched_barrier(0)
    Unit cur, nxt; int ui = 0;
    if (!S.next(0, cur)) return;
    f32x4 acc[2][2][4][2];
#pragma unroll
    for (int a = 0; a < 2; ++a)
#pragma unroll
        for (int b = 0; b < 2; ++b)
#pragma unroll
            for (int m = 0; m < 4; ++m)
#pragma unroll
                for (int n = 0; n < 2; ++n) acc[a][b][m][n] = (f32x4){0.f, 0.f, 0.f, 0.f};
    bf16x8 At[4][2], B0[2][2], B1[2][2];
    const char* cA = (const char*)g.A + (size_t)cur.pm * tstep; const char* cB = (const char*)g.Bt + (size_t)cur.pn * tstep;
    S.a_ready(cur);
    if constexpr (SP2) {
        PG8_STAGE(PG8_SB(0, 0), cB, voffB); PG8_STAGE(PG8_SB(0, 1), cB + hstep, voffB); PG8_STAGE(PG8_SA(0, 0), cA, voffA); PG8_STAGE(PG8_SA(0, 1), cA + hstep, voffA);
        if (wr == 1) PG8_BAR;
        PG8_WAIT_V(2); PG8_BAR;
        PG8_STAGE(PG8_SB(1, 0), cB + kstep, voffB); PG8_STAGE(PG8_SA(1, 0), cA + kstep, voffA); PG8_STAGE(PG8_SB(1, 1), cB + hstep + kstep, voffB);
        PG8_WAIT_V(6); PG8_BAR;
    } else {
        PG8_STAGE(PG8_SB(0, 0), cB, voffB); PG8_STAGE(PG8_SA(0, 0), cA, voffA); PG8_STAGE(PG8_SB(0, 1), cB + hstep, voffB); PG8_STAGE(PG8_SA(0, 1), cA + hstep, voffA);
        if (wr == 1) PG8_BAR;
        PG8_WAIT_V(4); PG8_BAR;
        PG8_STAGE(PG8_SB(1, 0), cB + kstep, voffB); PG8_STAGE(PG8_SA(1, 0), cA + kstep, voffA); PG8_STAGE(PG8_SB(1, 1), cB + hstep + kstep, voffB);
        PG8_WAIT_V(6); PG8_BAR;
    }
    for (;;) {
        const bool has_next = S.next(ui + 1, nxt);
        const char* nA = has_next ? (const char*)g.A + (size_t)nxt.pm * tstep : cA; const char* nB = has_next ? (const char*)g.Bt + (size_t)nxt.pn * tstep : cB;
        for (int t = 0; t < nt; t += 2) {
            const bool last = (t == nt - 2);
            const char* a1 = cA + (size_t)(t + 1) * kstep;
            const char* a2 = last ? nA : cA + (size_t)(t + 2) * kstep; const char* b2 = last ? nB : cB + (size_t)(t + 2) * kstep;
            const char* a3 = a2 + kstep; const char* b3 = b2 + kstep;
            if (last && has_next) S.a_ready(nxt);
            if constexpr (SP2) {
            PG8_LDB(B0, 0, 0); PG8_LDB(B1, 0, 1); PG8_SCHED; PG8_LDA(At, 0, 0); PG8_STAGE(PG8_SA(1, 1), a1 + hstep, voffA);
            PG8_WAIT_V(8); PG8_WAIT_L(0); PG8_BAR; PG8_MMA(0, 0, At, B0); PG8_MMA(0, 1, At, B1); PG8_BAR; PG8_SCHED;
            PG8_LDA(At, 0, 1); PG8_STAGE(PG8_SB(0, 0), b2, voffB); PG8_STAGE(PG8_SB(0, 1), b2 + hstep, voffB); PG8_STAGE(PG8_SA(0, 0), a2, voffA);
            PG8_WAIT_V(8); PG8_WAIT_L(0); PG8_BAR; PG8_MMA(1, 0, At, B0); PG8_MMA(1, 1, At, B1); PG8_BAR; PG8_SCHED;
            PG8_LDB(B0, 1, 0); PG8_LDB(B1, 1, 1); PG8_SCHED; PG8_LDA(At, 1, 0); PG8_STAGE(PG8_SA(0, 1), a2 + hstep, voffA);
            PG8_WAIT_V(8); PG8_WAIT_L(0); PG8_BAR; PG8_MMA(0, 0, At, B0); PG8_MMA(0, 1, At, B1); PG8_BAR; PG8_SCHED;
            PG8_LDA(At, 1, 1); PG8_STAGE(PG8_SB(1, 0), b3, voffB); PG8_STAGE(PG8_SB(1, 1), b3 + hstep, voffB); PG8_STAGE(PG8_SA(1, 0), a3, voffA);
            PG8_WAIT_V(8); PG8_WAIT_L(0); PG8_BAR; PG8_MMA(1, 0, At, B0); PG8_MMA(1, 1, At, B1); PG8_BAR; PG8_SCHED;
            } else {
            PG8_LDB(B0, 0, 0); PG8_SCHED; PG8_LDA(At, 0, 0); PG8_STAGE(PG8_SA(1, 1), a1 + hstep, voffA);
            PG8_WAIT_L(8); PG8_BAR; PG8_WAIT_L(0); PG8_MMA(0, 0, At, B0); PG8_BAR; PG8_SCHED;
            PG8_LDB(B1, 0, 1); PG8_STAGE(PG8_SB(0, 0), b2, voffB);
            PG8_BAR; PG8_WAIT_L(0); PG8_MMA(0, 1, At, B1); PG8_BAR;
            PG8_LDA(At, 0, 1); PG8_STAGE(PG8_SA(0, 0), a2, voffA);
            PG8_BAR; PG8_WAIT_L(0); PG8_MMA(1, 0, At, B0); PG8_BAR; PG8_SCHED;
            PG8_STAGE(PG8_SB(0, 1), b2 + hstep, voffB);
            PG8_WAIT_V(6); PG8_BAR; PG8_MMA(1, 1, At, B1); PG8_BAR;
            PG8_LDB(B0, 1, 0); PG8_SCHED; PG8_LDA(At, 1, 0); PG8_STAGE(PG8_SA(0, 1), a2 + hstep, voffA);
            PG8_WAIT_L(8); PG8_BAR; PG8_WAIT_L(0); PG8_MMA(0, 0, At, B0); PG8_BAR; PG8_SCHED;
            PG8_LDB(B1, 1, 1); PG8_STAGE(PG8_SB(1, 0), b3, voffB);
            PG8_BAR; PG8_WAIT_L(0); PG8_MMA(0, 1, At, B1); PG8_BAR;
            PG8_LDA(At, 1, 1); PG8_STAGE(PG8_SA(1, 0), a3, voffA);
            PG8_BAR; PG8_WAIT_L(0); PG8_MMA(1, 0, At, B0); PG8_BAR; PG8_SCHED;
            PG8_STAGE(PG8_SB(1, 1), b3 + hstep, voffB);
            PG8_WAIT_V(6); PG8_BAR; PG8_MMA(1, 1, At, B1); PG8_BAR;
            }
        }
        if constexpr (ALIGN_EPI) { if (wr == 0) PG8_BAR; }
        if constexpr (!Epi::AFTER_DRAIN) { E(acc, cur, wr, wc, fr, fq); S.done(cur); }
        if (!has_next) break;
#pragma unroll
        for (int a = 0; a < 2; ++a)
#pragma unroll
            for (int b = 0; b < 2; ++b)
#pragma unroll
                for (int m = 0; m < 4; ++m)
#pragma unroll
                    for (int n = 0; n < 2; ++n) acc[a][b][m][n] = (f32x4){0.f, 0.f, 0.f, 0.f};
        cur = nxt; cA = nA; cB = nB; ++ui;
        if constexpr (ALIGN_EPI) { if (wr == 1) PG8_BAR; }
    }
    PG8_WAIT_V(0);
    if constexpr (!ALIGN_EPI) { if (wr == 0) PG8_BAR; }
    PG8_BAR;
    if constexpr (Epi::AFTER_DRAIN) { E.fused(acc, cur, wr, wc, fr, fq, lds, wid, lane); S.done(cur); }
#undef PG8_SA
#undef PG8_SB
#undef PG8_STAGE
#undef PG8_LDA
#undef PG8_LDB
#undef PG8_MMA
#undef PG8_WAIT_V
#undef PG8_WAIT_L
#undef PG8_BAR
#undef PG8_SCHED
}
}
namespace pg8 {
__device__ __forceinline__ float sigmoidf_(float x) { return __builtin_amdgcn_rcpf(1.0f + __builtin_amdgcn_exp2f(-1.4426950408889634f * x)); }
struct EpiBf16Split {
    static constexpr bool PERM = true, AFTER_DRAIN = false;
    bf16_t* O0; int ld0; int nt0; bf16_t* O1; int ld1;
    __device__ __forceinline__ void operator()(const f32x4 (&acc)[2][2][4][2], const Unit& u, int wr, int wc, int fr, int fq) const {
        const bool first = u.pn < nt0; bf16_t* base = first ? O0 : O1; const int ld = first ? ld0 : ld1; const int colt = (first ? u.pn : u.pn - nt0) * BM;
        const int row0 = u.pm * BM + wr * 64 + fr, col0 = colt + wc * 32 + 8 * fq;
#pragma unroll
        for (int ai = 0; ai < 2; ++ai)
#pragma unroll
            for (int m = 0; m < 4; ++m) { bf16_t* rowp = base + (size_t)(row0 + ai * HALF + m * 16) * ld + col0;
#pragma unroll
                for (int bj = 0; bj < 2; ++bj) { const f32x4 v0 = acc[ai][bj][m][0], v1 = acc[ai][bj][m][1];
                    u32x4 w; w.x = cvt_pk_bf16(v0[0], v0[1]); w.y = cvt_pk_bf16(v0[2], v0[3]); w.z = cvt_pk_bf16(v1[0], v1[1]); w.w = cvt_pk_bf16(v1[2], v1[3]);
                    *(u32x4*)(rowp + bj * HALF) = w; } }
    }
};
struct EpiResF32 {
    static constexpr bool PERM = false, AFTER_DRAIN = false;
    const float* base; float* out; int ldc;
    __device__ __forceinline__ void operator()(const f32x4 (&acc)[2][2][4][2], const Unit& u, int wr, int wc, int fr, int fq) const {
        const int row0 = u.pm * BM + wr * 64 + fr, col0 = u.pn * BM + wc * 32 + 4 * fq;
#pragma unroll
        for (int ai = 0; ai < 2; ++ai)
#pragma unroll
            for (int m = 0; m < 4; ++m) { const size_t off = (size_t)(row0 + ai * HALF + m * 16) * ldc + col0;
#pragma unroll
                for (int bj = 0; bj < 2; ++bj)
#pragma unroll
                    for (int n = 0; n < 2; ++n) { const f32x4 b = *(const f32x4*)(base + off + bj * HALF + n * 16); *(f32x4*)(out + off + bj * HALF + n * 16) = b + acc[ai][bj][m][n]; } }
    }
};
struct EpiSwiglu {
    static constexpr bool PERM = false, AFTER_DRAIN = false;
    bf16_t* H; int ldh;
    __device__ __forceinline__ void operator()(const f32x4 (&acc)[2][2][4][2], const Unit& u, int wr, int wc, int fr, int fq) const {
        const int row0 = u.pm * BM + wr * 64 + fr, hc0 = u.pn * (BM / 2) + wc * 16 + 4 * fq;
#pragma unroll
        for (int ai = 0; ai < 2; ++ai)
#pragma unroll
            for (int m = 0; m < 4; ++m) { bf16_t* rowp = H + (size_t)(row0 + ai * HALF + m * 16) * ldh + hc0;
#pragma unroll
                for (int bj = 0; bj < 2; ++bj) { const f32x4 g = acc[ai][bj][m][0], up = acc[ai][bj][m][1]; float h[4];
#pragma unroll
                    for (int i = 0; i < 4; ++i) h[i] = g[i] * sigmoidf_(g[i]) * up[i];
                    typedef unsigned u32x2 __attribute__((ext_vector_type(2)));
                    u32x2 w; w.x = cvt_pk_bf16(h[0], h[1]); w.y = cvt_pk_bf16(h[2], h[3]);
                    *(u32x2*)(rowp + bj * (HALF / 2)) = w; } }
    }
};
struct EpiPle {
    static constexpr bool PERM = false, AFTER_DRAIN = false;
    const float* base; float* out; const bf16_t* E; int ldc;
    __device__ __forceinline__ void operator()(const f32x4 (&acc)[2][2][4][2], const Unit& u, int wr, int wc, int fr, int fq) const {
        const int row0 = u.pm * BM + wr * 64 + fr, col0 = u.pn * BM + wc * 32 + 4 * fq;
        typedef unsigned u32x2 __attribute__((ext_vector_type(2)));
#pragma unroll
        for (int ai = 0; ai < 2; ++ai)
#pragma unroll
            for (int m = 0; m < 4; ++m) { const size_t off = (size_t)(row0 + ai * HALF + m * 16) * ldc + col0;
#pragma unroll
                for (int bj = 0; bj < 2; ++bj)
#pragma unroll
                    for (int n = 0; n < 2; ++n) { const size_t o = off + bj * HALF + n * 16; const f32x4 b = *(const f32x4*)(base + o); const u32x2 e = *(const u32x2*)(E + o); const f32x4 a = acc[ai][bj][m][n];
                        f32x4 r; r[0] = b[0] + __uint_as_float(e.x << 16) * sigmoidf_(a[0]); r[1] = b[1] + __uint_as_float(e.x & 0xffff0000u) * sigmoidf_(a[1]);
                        r[2] = b[2] + __uint_as_float(e.y << 16) * sigmoidf_(a[2]); r[3] = b[3] + __uint_as_float(e.y & 0xffff0000u) * sigmoidf_(a[3]);
                        *(f32x4*)(out + o) = r; } }
    }
};
__device__ __forceinline__ float rms_r(const float* rsq, int row) { return rsqrtf(rsq[row] * (1.0f / 1024.0f) + 1e-6f); }
__device__ __forceinline__ void norm_out(const f32x4 (&x)[2][2], bf16_t* xb, size_t off, float* rsq_out, int row, int fq) {
    typedef unsigned u32x2 __attribute__((ext_vector_type(2))); float s = 0.f;
#pragma unroll
    for (int bj = 0; bj < 2; ++bj)
#pragma unroll
        for (int n = 0; n < 2; ++n) { const f32x4 v = x[bj][n]; s += (v[0] * v[0] + v[1] * v[1]) + (v[2] * v[2] + v[3] * v[3]); u32x2 w; w.x = cvt_pk_bf16(v[0], v[1]); w.y = cvt_pk_bf16(v[2], v[3]); *(u32x2*)(xb + off + bj * HALF + n * 16) = w; }
    s += __shfl_xor(s, 16); s += __shfl_xor(s, 32);
    if (fq == 0) __hip_atomic_fetch_add(rsq_out + row, s, __ATOMIC_RELAXED, __HIP_MEMORY_SCOPE_AGENT);
}
struct EpiBf16SplitR {
    static constexpr bool PERM = true, AFTER_DRAIN = false;
    bf16_t* O0; int ld0; int nt0; bf16_t* O1; int ld1; const float* rsq;
    __device__ __forceinline__ void operator()(const f32x4 (&acc)[2][2][4][2], const Unit& u, int wr, int wc, int fr, int fq) const {
        const bool first = u.pn < nt0; bf16_t* base = first ? O0 : O1; const int ld = first ? ld0 : ld1; const int colt = (first ? u.pn : u.pn - nt0) * BM;
        const int row0 = u.pm * BM + wr * 64 + fr, col0 = colt + wc * 32 + 8 * fq;
#pragma unroll
        for (int ai = 0; ai < 2; ++ai)
#pragma unroll
            for (int m = 0; m < 4; ++m) { const int row = row0 + ai * HALF + m * 16; const float r = rms_r(rsq, row); bf16_t* rowp = base + (size_t)row * ld + col0;
#pragma unroll
                for (int bj = 0; bj < 2; ++bj) { const f32x4 v0 = acc[ai][bj][m][0] * r, v1 = acc[ai][bj][m][1] * r;
                    u32x4 w; w.x = cvt_pk_bf16(v0[0], v0[1]); w.y = cvt_pk_bf16(v0[2], v0[3]); w.z = cvt_pk_bf16(v1[0], v1[1]); w.w = cvt_pk_bf16(v1[2], v1[3]);
                    *(u32x4*)(rowp + bj * HALF) = w; } }
    }
};
struct EpiSwigluR {
    static constexpr bool PERM = false, AFTER_DRAIN = false;
    bf16_t* H; int ldh; const float* rsq;
    __device__ __forceinline__ void operator()(const f32x4 (&acc)[2][2][4][2], const Unit& u, int wr, int wc, int fr, int fq) const {
        const int row0 = u.pm * BM + wr * 64 + fr, hc0 = u.pn * (BM / 2) + wc * 16 + 4 * fq;
#pragma unroll
        for (int ai = 0; ai < 2; ++ai)
#pragma unroll
            for (int m = 0; m < 4; ++m) { const int row = row0 + ai * HALF + m * 16; const float r = rms_r(rsq, row); bf16_t* rowp = H + (size_t)row * ldh + hc0;
#pragma unroll
                for (int bj = 0; bj < 2; ++bj) { const f32x4 g = acc[ai][bj][m][0] * r, up = acc[ai][bj][m][1] * r; float h[4];
#pragma unroll
                    for (int i = 0; i < 4; ++i) h[i] = g[i] * sigmoidf_(g[i]) * up[i];
                    typedef unsigned u32x2 __attribute__((ext_vector_type(2)));
                    u32x2 w; w.x = cvt_pk_bf16(h[0], h[1]); w.y = cvt_pk_bf16(h[2], h[3]);
                    *(u32x2*)(rowp + bj * (HALF / 2)) = w; } }
    }
};
struct EpiResN {
    static constexpr bool PERM = false, AFTER_DRAIN = false;
    const float* base; float* out; int ldc; bf16_t* XBo; float* rsq_out;
    __device__ __forceinline__ void operator()(const f32x4 (&acc)[2][2][4][2], const Unit& u, int wr, int wc, int fr, int fq) const {
        const int row0 = u.pm * BM + wr * 64 + fr, col0 = u.pn * BM + wc * 32 + 4 * fq;
#pragma unroll
        for (int ai = 0; ai < 2; ++ai)
#pragma unroll
            for (int m = 0; m < 4; ++m) { const int row = row0 + ai * HALF + m * 16; const size_t off = (size_t)row * ldc + col0; f32x4 x[2][2];
#pragma unroll
                for (int bj = 0; bj < 2; ++bj)
#pragma unroll
                    for (int n = 0; n < 2; ++n) { const f32x4 b = *(const f32x4*)(base + off + bj * HALF + n * 16); x[bj][n] = b + acc[ai][bj][m][n]; *(f32x4*)(out + off + bj * HALF + n * 16) = x[bj][n]; }
                if (XBo) norm_out(x, XBo, off, rsq_out, row, fq); }
    }
};
struct EpiPleN {
    static constexpr bool PERM = false, AFTER_DRAIN = false;
    const float* base; float* out; const bf16_t* E; int ldc; const float* rsq_in; bf16_t* XBo; float* rsq_out;
    __device__ __forceinline__ void operator()(const f32x4 (&acc)[2][2][4][2], const Unit& u, int wr, int wc, int fr, int fq) const {
        const int row0 = u.pm * BM + wr * 64 + fr, col0 = u.pn * BM + wc * 32 + 4 * fq;
        typedef unsigned u32x2 __attribute__((ext_vector_type(2)));
#pragma unroll
        for (int ai = 0; ai < 2; ++ai)
#pragma unroll
            for (int m = 0; m < 4; ++m) { const int row = row0 + ai * HALF + m * 16; const size_t off = (size_t)row * ldc + col0; const float r = rms_r(rsq_in, row); f32x4 x[2][2];
#pragma unroll
                for (int bj = 0; bj < 2; ++bj)
#pragma unroll
                    for (int n = 0; n < 2; ++n) { const size_t o = off + bj * HALF + n * 16; const f32x4 b = *(const f32x4*)(base + o); const u32x2 e = *(const u32x2*)(E + o); const f32x4 a = acc[ai][bj][m][n] * r;
                        f32x4 v; v[0] = b[0] + __uint_as_float(e.x << 16) * sigmoidf_(a[0]); v[1] = b[1] + __uint_as_float(e.x & 0xffff0000u) * sigmoidf_(a[1]);
                        v[2] = b[2] + __uint_as_float(e.y << 16) * sigmoidf_(a[2]); v[3] = b[3] + __uint_as_float(e.y & 0xffff0000u) * sigmoidf_(a[3]);
                        x[bj][n] = v; *(f32x4*)(out + o) = v; }
                if (XBo) norm_out(x, XBo, off, rsq_out, row, fq); }
    }
};
}
#ifndef PG8_SP2
#define PG8_SP2 true
#endif
#ifndef PG8_ALIGN
#define PG8_ALIGN true
#endif
constexpr int NB = 32, SEQ = 2048, T = NB * SEQ, D = 1024;
constexpr int NU = 2816, UA_W = 1024, UB_W = 1792;
constexpr int FF = 2816, CI = 2048, TH = T / 2;
constexpr int NWAVES = 8;
constexpr float NORM_EPS = 1e-6f, LOG2E = 1.4426950408889634f;
constexpr int UA_K = 512, UA_V = 576, UA_IQ = 640, UA_IK = 896, UA_IW = 960;
constexpr size_t MiB = 1u << 20, QMiB = 1u << 18;
constexpr size_t WS_CTL = 0, CTL_ZERO_BYTES = 1 * MiB;
constexpr size_t WS_WIN = 4 * QMiB, WS_WLORA = 26 * QMiB, WS_WOUT = 29 * QMiB;
constexpr size_t WS_WGU0 = 37 * QMiB, WS_WD0 = 81 * QMiB, WS_WPLE0 = 103 * QMiB, WS_WPG0 = 105 * QMiB, WS_LAYER_STRIDE = 76 * QMiB;
constexpr size_t WS_WUP = 189 * QMiB, WS_WDOWN = 221 * QMiB, WS_W12 = 237 * QMiB;
static_assert(WS_WPG0 + 8 * QMiB == WS_WGU0 + WS_LAYER_STRIDE && WS_WPG0 + WS_LAYER_STRIDE + 8 * QMiB == WS_WUP && WS_W12 + QMiB <= 60 * MiB, "weight map");
constexpr size_t ACT = 60 * MiB;
constexpr size_t WS_XB = ACT, WS_UA = ACT + 128 * MiB, WS_UB = ACT + 256 * MiB, WS_LIN = ACT + 480 * MiB, WS_LOUT = ACT + 512 * MiB;
constexpr size_t WS_QN = ACT + 704 * MiB, WS_KN = ACT + 768 * MiB, WS_VT = ACT + 776 * MiB, WS_MASK = ACT + 784 * MiB;
constexpr size_t WS_XB2 = ACT + 768 * MiB;
constexpr size_t WS_H = ACT + 128 * MiB, WS_E = ACT + 480 * MiB, WS_PB = ACT + 896 * MiB;
constexpr size_t WS_XM = ACT, WS_Z = ACT + 128 * MiB, WS_XC = ACT + 256 * MiB, WS_Q = ACT + 384 * MiB, WS_K = ACT + 512 * MiB, WS_V = ACT + 640 * MiB;
constexpr size_t WS_RS = ACT + 928 * MiB, RS_ONE = (size_t)T * 4, RS_BYTES = 6 * RS_ONE;
constexpr size_t WS_GI = ACT + 930 * MiB, WS_GA = WS_GI + 1 * MiB, WS_GAM = WS_GI + 2 * MiB, WS_GEM = WS_GI + 3 * MiB;
constexpr size_t WS_END = ACT + 934 * MiB;
static_assert(WS_END <= 1024 * MiB, "workspace");
constexpr int CW_TMO = 0, CW_BAR = 4096;
constexpr int LDS_BYTES = 155648;
constexpr int MISC_OFF = LDS_BYTES - 256;
#define GAS __attribute__((address_space(1)))
#define LAS __attribute__((address_space(3)))
typedef unsigned short bf16;
typedef unsigned v4u __attribute__((ext_vector_type(4)));
typedef unsigned v2u __attribute__((ext_vector_type(2)));
typedef float f32x4 __attribute__((ext_vector_type(4)));
typedef float f32x2 __attribute__((ext_vector_type(2)));
typedef float f32x8 __attribute__((ext_vector_type(8)));
typedef short bf16x8 __attribute__((ext_vector_type(8)));
typedef short s16x4 __attribute__((ext_vector_type(4)));
typedef GAS unsigned gu32;
#define RLX_AGENT __ATOMIC_RELAXED, __HIP_MEMORY_SCOPE_AGENT
#define LDS_WAIT() asm volatile("s_waitcnt lgkmcnt(0)" ::: "memory")
#define VM_WAIT() asm volatile("s_waitcnt vmcnt(0)" ::: "memory")
__device__ __forceinline__ unsigned f2bf(float f) { unsigned u = __builtin_bit_cast(unsigned, f); return (u + 0x7fffu + ((u >> 16) & 1u)) >> 16; }

#define XB_TMO      128
#define XB_XCNT(j)  (256  + 64 * (j))
#define XB_XSUB(j)  (1280 + 64 * (j))
#define XB_XGEN(j)  (2304 + 64 * (j))
#define XB_TOP      3328
#define XB_TOPGEN   3392
#define XCD_BAR_WORDS 3456
#define XB_SPIN_CAP (1u << 18)

__device__ __forceinline__ unsigned xb_ld(unsigned* p)              { return __hip_atomic_load(p, __ATOMIC_RELAXED, __HIP_MEMORY_SCOPE_AGENT); }
__device__ __forceinline__ unsigned xb_add(unsigned* p, unsigned v) { return __hip_atomic_fetch_add(p, v, __ATOMIC_RELAXED, __HIP_MEMORY_SCOPE_AGENT); }
__device__ __forceinline__ unsigned xb_xcc_id() { return (unsigned)__builtin_amdgcn_s_getreg((3 << 11) | 20) & 0xFu; }
#define XB_SPIN(cond, bar) do { unsigned _sp = 0; while (cond) { __builtin_amdgcn_s_sleep(1); \
    if ((++_sp & 255u) == 0u) { if (xb_ld(&(bar)[XB_TMO])) break; if (_sp > XB_SPIN_CAP) { atomicAdd(&(bar)[XB_TMO], 1u); break; } } } } while (0)

struct XcdBarrier {
    unsigned* bar; unsigned x;
    volatile LAS unsigned* st;
};

__device__ __forceinline__ XcdBarrier xcd_barrier_post(unsigned* bar, volatile LAS unsigned* st) {
    XcdBarrier b; b.bar = bar; b.x = xb_xcc_id(); b.st = st;
    if (threadIdx.x == 0) (void)xb_add(&bar[XB_XCNT(b.x)], 1u);
    return b;
}
__device__ __forceinline__ void xcd_barrier_complete(unsigned* bar, unsigned x, unsigned& nloc, unsigned& nx) {
    const unsigned G = gridDim.x * gridDim.y * gridDim.z;
    unsigned sum, cnt, mine, sp = 0u;
    for (;;) {
        sum = 0u; cnt = 0u; mine = 0u;
#pragma unroll
        for (unsigned j = 0; j < 16; ++j) { const unsigned c = xb_ld(&bar[XB_XCNT(j)]); sum += c; cnt += (c > 0u) ? 1u : 0u; mine = (j == x) ? c : mine; }
        if (sum == G) break;
        __builtin_amdgcn_s_sleep(1);
        if ((++sp & 255u) == 0u) { if (xb_ld(&bar[XB_TMO])) break; if (sp > XB_SPIN_CAP) { atomicAdd(&bar[XB_TMO], 1u); break; } }
    }
    nloc = mine > 0u ? mine : 1u; nx = cnt > 0u ? cnt : 1u;
}

__device__ __forceinline__ void xcd_barrier(const XcdBarrier& b) {
    asm volatile("s_waitcnt vmcnt(0)" ::: "memory");
    __syncthreads();
    if (threadIdx.x == 0) {
        unsigned* bar = b.bar;
        __builtin_amdgcn_s_waitcnt(0);
        unsigned nloc = b.st[0], nx = b.st[1];
        if (nloc == 0u) { xcd_barrier_complete(bar, b.x, nloc, nx); b.st[0] = nloc; b.st[1] = nx; }
        const unsigned old = xb_add(&bar[XB_XSUB(b.x)], 1u);
        const unsigned gen = old / nloc;
        if (old + 1u == (gen + 1u) * nloc) {
            __builtin_amdgcn_fence(__ATOMIC_RELEASE, "agent");
            asm volatile("s_waitcnt vmcnt(0)" ::: "memory");
            const unsigned og = xb_add(&bar[XB_TOP], 1u);
            const unsigned tg = og / nx;
            if (og + 1u == (tg + 1u) * nx) xb_add(&bar[XB_TOPGEN], 1u);
            else XB_SPIN(xb_ld(&bar[XB_TOPGEN]) == tg, bar);
            __builtin_amdgcn_fence(__ATOMIC_ACQUIRE, "agent");
            xb_add(&bar[XB_XGEN(b.x)], 1u);
            asm volatile("s_waitcnt vmcnt(0)" ::: "memory");
        } else {
            XB_SPIN(xb_ld(&bar[XB_XGEN(b.x)]) == gen, bar);
            __builtin_amdgcn_fence(__ATOMIC_ACQUIRE, "agent");
            asm volatile("s_waitcnt vmcnt(0)" ::: "memory");
        }
    }
    __syncthreads();
}

struct Frame {
    LAS unsigned char* lds;
    unsigned char* ws;
    const float* const* in;
    int tid, lane, wave, G, bid;
};
struct Args { const float* in[37]; float* out; unsigned char* ws; int ph_lo, ph_hi, use_bar, pad; };

__device__ __forceinline__ float wave_sum(float v) {
#pragma unroll
    for (int o = 1; o < 64; o <<= 1) v += __shfl_xor(v, o);
    return v;
}
__device__ __forceinline__ float wave_max(float v) {
#pragma unroll
    for (int o = 1; o < 64; o <<= 1) v = fmaxf(v, __shfl_xor(v, o));
    return v;
}
__device__ __forceinline__ float bflo(unsigned u) { return __uint_as_float(u << 16); }
__device__ __forceinline__ float bfhi(unsigned u) { return __uint_as_float(u & 0xffff0000u); }
__device__ __forceinline__ float bf1(bf16 h) { return __uint_as_float(((unsigned)h) << 16); }
__device__ __forceinline__ unsigned pk2(float lo, float hi) { return pg8::cvt_pk_bf16(lo, hi); }
__device__ __forceinline__ float sigm(float x) { return 1.0f / (1.0f + __expf(-x)); }
__device__ __forceinline__ float softplusf_(float x) { return fmaxf(x, 0.f) + log1pf(__expf(-fabsf(x))); }
__device__ __forceinline__ void unpack8(const v4u& r, float (&f)[8]) { f[0] = bflo(r.x); f[1] = bfhi(r.x); f[2] = bflo(r.y); f[3] = bfhi(r.y); f[4] = bflo(r.z); f[5] = bfhi(r.z); f[6] = bflo(r.w); f[7] = bfhi(r.w); }
__device__ __forceinline__ v4u pack8(const float (&f)[8]) { v4u o; o.x = pk2(f[0], f[1]); o.y = pk2(f[2], f[3]); o.z = pk2(f[4], f[5]); o.w = pk2(f[6], f[7]); return o; }

template <class Fn> __device__ __forceinline__ void wprep(bf16* dst, int N, int K, Fn f, int gt, int NT) {
    const int items = N * (K >> 3);
    for (int it = gt; it < items; it += NT) { const int n = it % N, k0 = (it / N) << 3; float v[8];
#pragma unroll
        for (int j = 0; j < 8; ++j) v[j] = f(k0 + j, n);
        *(v4u*)(dst + (size_t)n * K + k0) = pack8(v); }
}
__device__ __forceinline__ void phase_prologue(Frame& F, const Args& a) {
    const int gt = F.bid * 512 + F.tid, NT = F.G * 512; unsigned char* ws = F.ws;
    { const float* W = a.in[5]; const float* gn0 = a.in[2];
      wprep((bf16*)(ws + WS_WIN), NU, D, [=](int k, int n) { const int c = n < 964 ? n : (n < 1024 ? -1 : n - 60); return c < 0 ? 0.f : W[(size_t)k * 2756 + c] * gn0[k]; }, gt, NT); }
    { const float* w2 = a.in[8]; const float* a2 = a.in[10]; const float* g2 = a.in[11];
      wprep((bf16*)(ws + WS_WLORA), 1536, 256, [=](int k, int n) { if (n < 512) return k < 64 ? w2[k * 512 + n] : 0.f; if (n < 1024) return (k >= 64 && k < 128) ? a2[(k - 64) * 512 + n - 512] : 0.f; return k >= 128 ? g2[(k - 128) * 512 + n - 1024] : 0.f; }, gt, NT); }
    { const float* W = a.in[17]; wprep((bf16*)(ws + WS_WOUT), D, D, [=](int k, int n) { return W[(size_t)k * D + n]; }, gt, NT); }
    for (int L = 0; L < 2; ++L) {
        const float* wg = a.in[31] + (size_t)L * D * FF; const float* wu = a.in[32] + (size_t)L * D * FF; const float* wd = a.in[33] + (size_t)L * FF * D;
        const float* wp = a.in[34] + (size_t)L * 256 * D; const float* wpg = a.in[36] + (size_t)L * D * D; const float* gnf = a.in[30] + L * D; const float* gnp = a.in[35] + L * D;
        wprep((bf16*)(ws + WS_WGU0 + L * WS_LAYER_STRIDE), 2 * FF, D, [=](int k, int n) { const int hid = 16 * (n >> 5) + (n & 15); return ((n & 31) >= 16 ? wu : wg)[(size_t)k * FF + hid] * gnf[k]; }, gt, NT);
        wprep((bf16*)(ws + WS_WD0 + L * WS_LAYER_STRIDE), D, FF, [=](int k, int n) { return wd[(size_t)k * D + n]; }, gt, NT);
        wprep((bf16*)(ws + WS_WPLE0 + L * WS_LAYER_STRIDE), D, 256, [=](int k, int n) { return wp[(size_t)k * D + n]; }, gt, NT);
        wprep((bf16*)(ws + WS_WPG0 + L * WS_LAYER_STRIDE), D, D, [=](int k, int n) { return wpg[(size_t)k * D + n] * gnp[k]; }, gt, NT);
    }
    { const float* W = a.in[18]; const float* gn1 = a.in[2] + D; wprep((bf16*)(ws + WS_WUP), 2 * CI, D, [=](int k, int n) { return W[(size_t)k * (2 * CI) + n] * gn1[k]; }, gt, NT); }
    { const float* W = a.in[29]; wprep((bf16*)(ws + WS_WDOWN), D, CI, [=](int k, int n) { return W[(size_t)k * D + n]; }, gt, NT); }
    { const float* wq = a.in[21]; const float* wk = a.in[22]; const float* wv = a.in[23]; const float* wif = a.in[24]; float* W12 = (float*)(ws + WS_W12);
      for (int it = gt; it < 4096 * 8; it += NT) { const int o = it & 7, c = (it >> 3) & 2047, part = it >> 14, g = c >> 2, i = c & 3; float s = 0.f;
          if (part == 0) { for (int j = 0; j < 4; ++j) s += wq[(g * 4 + i) * 4 + j] * wif[(size_t)(4 * g + j) * 8 + o] + wk[(g * 4 + i) * 4 + j] * wif[(size_t)(2048 + 4 * g + j) * 8 + o]; }
          else { for (int j = 0; j < 4; ++j) s += wv[(g * 4 + i) * 4 + j] * wif[(size_t)(4096 + 4 * g + j) * 8 + o]; }
          W12[it] = s; } }
}
__device__ __forceinline__ void phase_norm(Frame& F, const float* src, const float* gain, bf16* dst, int nrows) {
    const int gw = F.bid * NWAVES + F.wave, NGW = F.G * NWAVES, lane = F.lane;
    f32x4 g[4];
#pragma unroll
    for (int j = 0; j < 4; ++j) g[j] = *((const f32x4*)gain + lane + 64 * j);
    for (int m = gw; m < nrows; m += NGW) {
        const f32x4* xr = (const f32x4*)(src + (size_t)m * D) + lane; f32x4 v[4]; float s = 0.f;
#pragma unroll
        for (int j = 0; j < 4; ++j) { v[j] = xr[64 * j]; s += (v[j].x * v[j].x + v[j].y * v[j].y) + (v[j].z * v[j].z + v[j].w * v[j].w); }
        const float r = rsqrtf(wave_sum(s) * (1.f / D) + NORM_EPS);
        v2u* o = (v2u*)(dst + (size_t)m * D) + lane;
#pragma unroll
        for (int j = 0; j < 4; ++j) { v2u w; w.x = pk2(v[j].x * r * g[j].x, v[j].y * r * g[j].y); w.y = pk2(v[j].z * r * g[j].z, v[j].w * r * g[j].w); o[64 * j] = w; }
    }
}
__device__ __forceinline__ void phase_cast_sq(Frame& F, const float* src, bf16* dst, float* rsq, int nrows) {
    const int gw = F.bid * NWAVES + F.wave, NGW = F.G * NWAVES, lane = F.lane;
    for (int m = gw; m < nrows; m += NGW) {
        const f32x4* xr = (const f32x4*)(src + (size_t)m * D) + lane; f32x4 v[4]; float s = 0.f;
#pragma unroll
        for (int j = 0; j < 4; ++j) { v[j] = xr[64 * j]; s += (v[j].x * v[j].x + v[j].y * v[j].y) + (v[j].z * v[j].z + v[j].w * v[j].w); }
        s = wave_sum(s); if (lane == 0) rsq[m] = s;
        v2u* o = (v2u*)(dst + (size_t)m * D) + lane;
#pragma unroll
        for (int j = 0; j < 4; ++j) { v2u w; w.x = pk2(v[j].x, v[j].y); w.y = pk2(v[j].z, v[j].w); o[64 * j] = w; }
    }
}
__device__ __forceinline__ void phase_cvt_p(Frame& F, const float* p, bf16* pb) {
    const size_t gt = (size_t)F.bid * 512 + F.tid, NT = (size_t)F.G * 512, n8 = (size_t)T * 256 / 8;
    for (size_t i0 = gt; i0 < n8; i0 += 4 * NT) { f32x4 a[4], b[4];
#pragma unroll
        for (int q4 = 0; q4 < 4; ++q4) { const size_t i = i0 + q4 * NT; if (i < n8) { a[q4] = *((const f32x4*)p + 2 * i); b[q4] = *((const f32x4*)p + 2 * i + 1); } }
#pragma unroll
        for (int q4 = 0; q4 < 4; ++q4) { const size_t i = i0 + q4 * NT; if (i < n8) { v4u o; o.x = pk2(a[q4].x, a[q4].y); o.y = pk2(a[q4].z, a[q4].w); o.z = pk2(b[q4].x, b[q4].y); o.w = pk2(b[q4].z, b[q4].w); *((v4u*)pb + i) = o; } } }
}
constexpr float QSCALE = 0.125f * LOG2E;
__device__ __forceinline__ void phase_prepA(Frame& F, const Args& a) {
    unsigned char* ws = F.ws; const bf16* UA = (const bf16*)(ws + WS_UA); const bf16* UB = (const bf16*)(ws + WS_UB);
    bf16* LIN = (bf16*)(ws + WS_LIN); bf16* QN = (bf16*)(ws + WS_QN); bf16* KN = (bf16*)(ws + WS_KN); bf16* VT = (bf16*)(ws + WS_VT);
    const float* mu = a.in[6]; const float* gq = a.in[3]; const float* gk = a.in[4];
    { const int gt = F.bid * 512 + F.tid, NT = F.G * 512; const int c8 = (gt & 31) << 3; float muv[8];
#pragma unroll
      for (int j = 0; j < 8; ++j) muv[j] = mu[1536 + c8 + j];
      for (int it0 = gt; it0 < T * 32; it0 += 4 * NT) { v4u ru[4], rp[4];
#pragma unroll
          for (int q4 = 0; q4 < 4; ++q4) { const int it = it0 + q4 * NT; if (it < T * 32) { const int t = it >> 5; ru[q4] = *(const v4u*)(UB + (size_t)t * UB_W + 1536 + c8); rp[q4] = *(const v4u*)(UB + (size_t)((t & (SEQ - 1)) ? t - 1 : t) * UB_W + 1536 + c8); } }
#pragma unroll
          for (int q4 = 0; q4 < 4; ++q4) { const int it = it0 + q4 * NT; if (it < T * 32) { const int t = it >> 5; float u[8], p[8], o[8]; unpack8(ru[q4], u); unpack8(rp[q4], p); const float pm = (t & (SEQ - 1)) ? 1.f : 0.f;
#pragma unroll
              for (int j = 0; j < 8; ++j) { const float s = u[j] + muv[j] * (p[j] * pm - u[j]); o[j] = c8 < 64 ? tanhf(s) : (c8 < 128 ? s : sigm(s)); }
              *(v4u*)(LIN + (size_t)t * 256 + c8) = pack8(o); } } } }
    { const int gw = F.bid * NWAVES + F.wave, NGW = F.G * NWAVES, lane = F.lane; float gqv[8], gkv[8];
#pragma unroll
      for (int j = 0; j < 8; ++j) { gqv[j] = gq[((lane & 7) << 3) + j] * QSCALE; gkv[j] = gk[((lane & 7) << 3) + j]; }
      for (int t0 = gw; t0 < T; t0 += 4 * NGW) { v4u rq[4], rk[4];
#pragma unroll
          for (int q4 = 0; q4 < 4; ++q4) { const int t = t0 + q4 * NGW; if (t < T) { rq[q4] = *(const v4u*)(UA + (size_t)t * UA_W + 8 * lane); rk[q4] = *(const v4u*)(UA + (size_t)t * UA_W + UA_K + 8 * (lane & 7)); } }
#pragma unroll
          for (int q4 = 0; q4 < 4; ++q4) { const int t = t0 + q4 * NGW; if (t < T) {
              float q[8], k[8]; unpack8(rq[q4], q); unpack8(rk[q4], k);
              float sq = 0.f, sk = 0.f;
#pragma unroll
              for (int j = 0; j < 8; ++j) { sq += q[j] * q[j]; sk += k[j] * k[j]; }
              sq += __shfl_xor(sq, 1); sq += __shfl_xor(sq, 2); sq += __shfl_xor(sq, 4); sk += __shfl_xor(sk, 1); sk += __shfl_xor(sk, 2); sk += __shfl_xor(sk, 4);
              const float rq_ = rsqrtf(sq * (1.f / 64.f) + NORM_EPS), rk_ = rsqrtf(sk * (1.f / 64.f) + NORM_EPS);
#pragma unroll
              for (int j = 0; j < 8; ++j) { q[j] *= rq_ * gqv[j]; k[j] *= rk_ * gkv[j]; }
              *(v4u*)(QN + (size_t)t * 512 + 8 * lane) = pack8(q);
              if (lane < 8) *(v4u*)(KN + (size_t)t * 64 + 8 * lane) = pack8(k); } } } }
    { LAS bf16* tile = (LAS bf16*)F.lds;
      for (int u = F.bid; u < T / 64; u += F.G) { const int t0 = u * 64, b = t0 / SEQ, s0 = t0 % SEQ; const int tok = F.tid >> 3, c8 = (F.tid & 7) << 3;
          *(LAS v4u*)(tile + tok * 72 + c8) = *(const v4u*)(UA + (size_t)(t0 + tok) * UA_W + UA_V + c8);
          __syncthreads();
          const int d = F.tid >> 3, s8 = (F.tid & 7) << 3; v4u o; unsigned short e[8];
#pragma unroll
          for (int j = 0; j < 8; ++j) e[j] = tile[(s8 + j) * 72 + d];
          o.x = e[0] | ((unsigned)e[1] << 16); o.y = e[2] | ((unsigned)e[3] << 16); o.z = e[4] | ((unsigned)e[5] << 16); o.w = e[6] | ((unsigned)e[7] << 16);
          *(v4u*)(VT + ((size_t)b * 64 + d) * SEQ + s0 + s8) = o;
          __syncthreads(); } }
}
constexpr int IDX_STRIDE = 2052, KSEL = 256;
__device__ __forceinline__ void topk_select(const LAS float* row, int limit, unsigned* maskrow, int lane) {
    unsigned long long mybits = 0ull; const int nj = limit >> 6;
    if (limit <= KSEL) { mybits = lane < nj ? ~0ull : 0ull; }
    else {
        unsigned key[32];
#pragma unroll
        for (int j = 0; j < 32; ++j) { unsigned k = 0u; if (j < nj) { unsigned u = __float_as_uint(row[64 * j + lane]); if (u == 0x80000000u) u = 0u; k = (u & 0x80000000u) ? ~u : (u | 0x80000000u); } key[j] = k; }
        unsigned prefix = 0u; bool exact = false;
        for (int bit = 31; bit >= 0; --bit) { const unsigned cand = prefix | (1u << bit); int cnt = 0;
#pragma unroll
            for (int g8 = 0; g8 < 4; ++g8) if (8 * g8 < nj) {
#pragma unroll
                for (int jj = 0; jj < 8; ++jj) cnt += __builtin_popcountll(__ballot(key[8 * g8 + jj] >= cand)); }
            if (cnt >= KSEL) { prefix = cand; if (cnt == KSEL) { exact = true; break; } } }
        int need = 0;
        if (!exact) { int cgt = 0;
#pragma unroll
            for (int j = 0; j < 32; ++j) cgt += __builtin_popcountll(__ballot(key[j] > prefix));
            need = KSEL - cgt; }
        int running = 0; const unsigned long long below = (1ull << lane) - 1ull;
#pragma unroll
        for (int j = 0; j < 32; ++j) if (j < nj) {
            const bool gt = exact ? (key[j] >= prefix) : (key[j] > prefix); const bool tie = (!exact) && key[j] == prefix;
            const unsigned long long tb = __ballot(tie); const int rank = running + __builtin_popcountll(tb & below); running += __builtin_popcountll(tb);
            const unsigned long long sb = __ballot(gt || (tie && rank < need)); if (lane == j) mybits = sb; }
    }
    if (lane < 32) { v2u w; w.x = (unsigned)mybits; w.y = (unsigned)(mybits >> 32); *(v2u*)(maskrow + 2 * lane) = w; }
}
__device__ __forceinline__ void phase_indexer(Frame& F) {
    unsigned char* ws = F.ws; const bf16* UA = (const bf16*)(ws + WS_UA); unsigned* MASK = (unsigned*)(ws + WS_MASK);
    LAS float* sc = (LAS float*)F.lds; const int lane = F.lane, w = F.wave, fr = lane & 15, fq = lane >> 4;
    for (int r = 0;; ++r) { const int u = r * F.G + ((r & 1) ? (F.G - 1 - F.bid) : F.bid); if (u >= NB * 128) break;
        const int c = 31 - (u >> 7), rest = u & 127, b = rest >> 2, g4 = rest & 3, limit = 64 * (c + 1), tq0 = b * SEQ + c * 64 + g4 * 16;
        const bf16* UAb = UA + (size_t)b * SEQ * UA_W;
        bf16x8 qf[4][2]; float iwv[4];
        { const bf16* qp = UA + (size_t)(tq0 + fr) * UA_W;
#pragma unroll
          for (int hh = 0; hh < 4; ++hh) { qf[hh][0] = *(const bf16x8*)(qp + UA_IQ + hh * 64 + fq * 8); qf[hh][1] = *(const bf16x8*)(qp + UA_IQ + hh * 64 + 32 + fq * 8); iwv[hh] = bf1(qp[UA_IW + hh]) * (1.f / 16.f); } }
#ifndef IDX_SCORE_REP
#define IDX_SCORE_REP 1
#endif
#ifndef IDX_SEL_REP
#define IDX_SEL_REP 1
#endif
        for (int rp_ = 0; rp_ < IDX_SCORE_REP; ++rp_)
        for (int kt = w; kt < (limit >> 4); kt += NWAVES) {
            const bf16* kp = UAb + (size_t)(kt * 16 + fr) * UA_W + UA_IK + fq * 8; const bf16x8 a0 = *(const bf16x8*)kp, a1 = *(const bf16x8*)(kp + 32);
            f32x4 s = {0.f, 0.f, 0.f, 0.f};
#pragma unroll
            for (int hh = 0; hh < 4; ++hh) { f32x4 d = {0.f, 0.f, 0.f, 0.f}; d = __builtin_amdgcn_mfma_f32_16x16x32_bf16(a0, qf[hh][0], d, 0, 0, 0); d = __builtin_amdgcn_mfma_f32_16x16x32_bf16(a1, qf[hh][1], d, 0, 0, 0);
#pragma unroll
                for (int j = 0; j < 4; ++j) s[j] += iwv[hh] * fmaxf(d[j], 0.f); }
            *(LAS f32x4*)(sc + fr * IDX_STRIDE + kt * 16 + fq * 4) = s; }
        __syncthreads();
#pragma unroll 1
        for (int qq = 0; qq < 2 * IDX_SEL_REP; ++qq) { const int q = 2 * w + (qq & 1); topk_select(sc + q * IDX_STRIDE, limit, MASK + (size_t)(tq0 + q) * 64, lane); }
        __syncthreads(); }
}
__device__ __forceinline__ bf16x8 mk8(v2u lo, v2u hi) { v4u t; t.x = lo.x; t.y = lo.y; t.z = hi.x; t.w = hi.y; return __builtin_bit_cast(bf16x8, t); }
__device__ __forceinline__ void phase_dsa_attn(Frame& F, const Args& a) {
    unsigned char* ws = F.ws; const bf16* QN = (const bf16*)(ws + WS_QN); const bf16* KN = (const bf16*)(ws + WS_KN); const bf16* VT = (const bf16*)(ws + WS_VT);
    const unsigned* MASK = (const unsigned*)(ws + WS_MASK); bf16* MIX = (bf16*)(ws + WS_XB);
    const int lane = F.lane, w = F.wave, fr = lane & 15, fq = lane >> 4;
    const float mb = 8.f * LOG2E * wave_max(fabsf(a.in[3][lane])) * wave_max(fabsf(a.in[4][lane]));
    for (int r = 0;; ++r) { const int u = r * F.G + ((r & 1) ? (F.G - 1 - F.bid) : F.bid); if (u >= NB * 32) break;
        const int c = 31 - (u >> 5), b = u & 31, limit = 64 * (c + 1), t0 = b * SEQ + 64 * c;
        bf16x8 qf[4][2];
#pragma unroll
        for (int i = 0; i < 4; ++i) { const bf16* qp = QN + (size_t)(t0 + 16 * i + fr) * 512 + w * 64 + fq * 8; qf[i][0] = *(const bf16x8*)qp; qf[i][1] = *(const bf16x8*)(qp + 32); }
        f32x4 O[4][4]; float l[4];
#pragma unroll
        for (int i = 0; i < 4; ++i) { l[i] = 0.f;
#pragma unroll
            for (int dt = 0; dt < 4; ++dt) O[i][dt] = (f32x4){0.f, 0.f, 0.f, 0.f}; }
        const bf16* Kb = KN + (size_t)b * SEQ * 64; const bf16* Vb = VT + (size_t)b * 64 * SEQ; const unsigned* Mb = MASK + (size_t)t0 * 64;
        for (int kt = 0; kt < (limit >> 5); ++kt) {
            bf16x8 kf[2][2], vf[4]; unsigned mw[4];
#pragma unroll
            for (int s2 = 0; s2 < 2; ++s2) { const bf16* kp = Kb + (size_t)(32 * kt + 16 * s2 + fr) * 64 + fq * 8; kf[s2][0] = *(const bf16x8*)kp; kf[s2][1] = *(const bf16x8*)(kp + 32); }
#pragma unroll
            for (int dt = 0; dt < 4; ++dt) { const bf16* vp = Vb + (size_t)(16 * dt + fr) * SEQ + 32 * kt + 4 * fq; vf[dt] = mk8(*(const v2u*)vp, *(const v2u*)(vp + 16)); }
#pragma unroll
            for (int i = 0; i < 4; ++i) mw[i] = Mb[(size_t)(16 * i + fr) * 64 + kt];
#pragma unroll
            for (int i = 0; i < 4; ++i) {
                f32x4 s0 = {0.f, 0.f, 0.f, 0.f}, s1 = {0.f, 0.f, 0.f, 0.f};
                s0 = __builtin_amdgcn_mfma_f32_16x16x32_bf16(kf[0][0], qf[i][0], s0, 0, 0, 0); s0 = __builtin_amdgcn_mfma_f32_16x16x32_bf16(kf[0][1], qf[i][1], s0, 0, 0, 0);
                s1 = __builtin_amdgcn_mfma_f32_16x16x32_bf16(kf[1][0], qf[i][0], s1, 0, 0, 0); s1 = __builtin_amdgcn_mfma_f32_16x16x32_bf16(kf[1][1], qf[i][1], s1, 0, 0, 0);
                const unsigned b0 = mw[i] >> (4 * fq), b1 = mw[i] >> (16 + 4 * fq); float p[8];
#pragma unroll
                for (int j = 0; j < 4; ++j) { p[j] = ((b0 >> j) & 1u) ? __builtin_amdgcn_exp2f(s0[j] - mb) : 0.f; p[4 + j] = ((b1 >> j) & 1u) ? __builtin_amdgcn_exp2f(s1[j] - mb) : 0.f; }
                l[i] += ((p[0] + p[1]) + (p[2] + p[3])) + ((p[4] + p[5]) + (p[6] + p[7]));
                const bf16x8 pa = __builtin_bit_cast(bf16x8, pack8(p));
#pragma unroll
                for (int dt = 0; dt < 4; ++dt) O[i][dt] = __builtin_amdgcn_mfma_f32_16x16x32_bf16(pa, vf[dt], O[i][dt], 0, 0, 0);
            } }
#pragma unroll
        for (int i = 0; i < 4; ++i) { float li = l[i]; li += __shfl_xor(li, 16); li += __shfl_xor(li, 32);
#pragma unroll
            for (int j = 0; j < 4; ++j) { const float inv = 1.0f / __shfl(li, 4 * fq + j); bf16* op = MIX + (size_t)(t0 + 16 * i + 4 * fq + j) * D + w * 64 + fr;
#pragma unroll
                for (int dt = 0; dt < 4; ++dt) op[16 * dt] = (bf16)f2bf(O[i][dt][j] * inv); } }
    }
}
#define DPPQ(q) "quad_perm:[" #q "," #q "," #q "," #q "] row_mask:0xf bank_mask:0xf"
#define DPP_MUL(d, a, b, q) asm("v_mul_f32_dpp %0, %1, %2 " DPPQ(q) : "=v"(d) : "v"(a), "v"(b))
#define DPP_FMAC(d, a, b, q) asm("v_fmac_f32_dpp %0, %1, %2 " DPPQ(q) : "+v"(d) : "v"(a), "v"(b))
__device__ __forceinline__ void phase_rwkv(Frame& F, const Args& a) {
    unsigned char* ws = F.ws; const bf16* UB = (const bf16*)(ws + WS_UB); const bf16* LOUT = (const bf16*)(ws + WS_LOUT); bf16* MIX = (bf16*)(ws + WS_XB);
    const float* mu = a.in[6]; const float* w0 = a.in[7]; const float* a0 = a.in[9]; const float* k_k = a.in[12]; const float* k_a = a.in[13]; const float* r_k = a.in[14]; const float* gn_g = a.in[15]; const float* gn_b = a.in[16];
    const int lane = F.lane, w = F.wave;
    LAS float* vecs = (LAS float*)F.lds;
    LAS float* vx_s = vecs + 5 * 4096;
    LAS float* g_s = vx_s + 4096;
    LAS float* yacc = g_s + 4096;
    LAS float* bonus_s = yacc + 4096;
    LAS float* part = bonus_s + 64;
    for (int bh = F.bid; bh < NB * 8; bh += F.G) {
        const int b = bh >> 3, h = bh & 7, c = h * 64 + lane;
        const float mur = mu[c], muk = mu[512 + c], muv = mu[1024 + c], w0c = w0[c], a0c = a0[c], kkc = k_k[c], kac = k_a[c], rkc = r_k[c], gng = gn_g[c], gnb = gn_b[c];
        float S[8];
#pragma unroll
        for (int j = 0; j < 8; ++j) S[j] = 0.f;
        float r_ur[8], r_uk[8], r_uv[8], r_pr[8], r_pk[8], r_pv[8], r_wd[8], r_ad[8], r_gg[8];
#define RW_RAW(batch_) do { _Pragma("unroll") for (int i = 0; i < 8; ++i) { const int sl = (batch_) * 64 + w + 8 * i; const size_t t = (size_t)b * SEQ + sl; const bf16* up = UB + t * UB_W + c; const bf16* pp_ = sl > 0 ? up - UB_W : up; \
            r_ur[i] = bf1(up[0]); r_uk[i] = bf1(up[512]); r_uv[i] = bf1(up[1024]); r_pr[i] = bf1(pp_[0]); r_pk[i] = bf1(pp_[512]); r_pv[i] = bf1(pp_[1024]); \
            const bf16* lp = LOUT + t * 1536 + c; r_wd[i] = bf1(lp[0]); r_ad[i] = bf1(lp[512]); r_gg[i] = bf1(lp[1024]); } } while (0)
        RW_RAW(0);
        for (int batch = 0; batch < SEQ / 64; ++batch) {
#pragma unroll
            for (int i = 0; i < 8; ++i) { const int step = w + 8 * i, sl = batch * 64 + step; const float pm = sl > 0 ? 1.f : 0.f;
                const float ur = r_ur[i], uk = r_uk[i], uv = r_uv[i], pr = r_pr[i] * pm, pk = r_pk[i] * pm, pv = r_pv[i] * pm;
                const float rr = ur + mur * (pr - ur), kx = uk + muk * (pk - uk), vx = uv + muv * (pv - uv);
                const float wd = r_wd[i], ad = r_ad[i], gg = r_gg[i];
                const float wraw = -softplusf_(-(w0c + wd)) - 0.5f, decay = __expf(-__expf(wraw)), av = sigm(a0c + ad);
                float kk = kx * kkc; const float nrm = sqrtf(wave_sum(kk * kk)); kk = kk / fmaxf(nrm, 1e-12f);
                const float km = kx * (1.f + (av - 1.f) * kac); const float bon = wave_sum(rr * km * rkc);
                LAS float* sp = vecs + step * 64 + lane;
                sp[0] = decay; sp[4096] = -kk; sp[8192] = kk * av; sp[12288] = km; sp[16384] = rr;
                vx_s[step * 64 + lane] = vx; g_s[step * 64 + lane] = gg; if (lane == 0) bonus_s[step] = bon; }
            if (batch + 1 < SEQ / 64) RW_RAW(batch + 1);
            LDS_WAIT(); __syncthreads();
            const LAS float* vq = vecs + 8 * w + (lane & 3);
#ifdef PROBE_BAR
#define PROBE_X __builtin_amdgcn_s_barrier(); asm volatile("" ::: "memory");
#else
#define PROBE_X
#endif
#ifdef PROBE_DPP
#define PROBE_Y(X) { float d0_ = dmy, d1_ = dmy; _Pragma("unroll") for (int r_ = 0; r_ < 5; ++r_) { DPP_FMAC(d0_, X[0], S[0], 0); DPP_FMAC(d1_, X[1], S[4], 0); DPP_FMAC(d0_, X[2], S[1], 1); DPP_FMAC(d1_, X[3], S[5], 1); DPP_FMAC(d0_, X[4], S[2], 2); DPP_FMAC(d1_, X[5], S[6], 2); DPP_FMAC(d0_, X[6], S[3], 3); DPP_FMAC(d1_, X[7], S[7], 3); } dmy = d0_ + d1_; }
#else
#define PROBE_Y(X)
#endif
#define RW_LOAD(X, step) do { const LAS float* q_ = vq + (step) * 64; X[0] = q_[0]; X[1] = q_[4]; X[2] = q_[4096]; X[3] = q_[4100]; X[4] = q_[8192]; X[5] = q_[8196]; X[6] = q_[12288]; X[7] = q_[12292]; X[8] = q_[16384]; X[9] = q_[16388]; X[10] = vx_s[(step) * 64 + lane]; } while (0)
#define RW_HALF(X, o, jb) do { float t_; \
                DPP_MUL(t_, X[6 + o], vv, 0); DPP_FMAC(t_, X[4 + o], sa, 0); DPP_FMAC(t_, X[0 + o], S[jb + 0], 0); S[jb + 0] = t_; \
                DPP_MUL(t_, X[6 + o], vv, 1); DPP_FMAC(t_, X[4 + o], sa, 1); DPP_FMAC(t_, X[0 + o], S[jb + 1], 1); S[jb + 1] = t_; \
                DPP_MUL(t_, X[6 + o], vv, 2); DPP_FMAC(t_, X[4 + o], sa, 2); DPP_FMAC(t_, X[0 + o], S[jb + 2], 2); S[jb + 2] = t_; \
                DPP_MUL(t_, X[6 + o], vv, 3); DPP_FMAC(t_, X[4 + o], sa, 3); DPP_FMAC(t_, X[0 + o], S[jb + 3], 3); S[jb + 3] = t_; } while (0)
#define RWKV_STEP(X, Y, step) do { float pa, pb; \
                DPP_MUL(pa, X[2], S[0], 0); DPP_MUL(pb, X[3], S[4], 0); DPP_FMAC(pa, X[2], S[1], 1); DPP_FMAC(pb, X[3], S[5], 1); DPP_FMAC(pa, X[2], S[2], 2); DPP_FMAC(pb, X[3], S[6], 2); DPP_FMAC(pa, X[2], S[3], 3); DPP_FMAC(pb, X[3], S[7], 3); \
                LAS float* pp = part + (((step) & 1) * 64 + lane) * 16; pp[w] = pa + pb; pp[8 + w] = yprev; \
                if ((step) < 63) RW_LOAD(Y, (step) + 1); \
                LDS_WAIT(); __builtin_amdgcn_s_barrier(); asm volatile("" ::: "memory"); PROBE_X \
                const f32x4 q0 = *(LAS f32x4*)pp, q1 = *(LAS f32x4*)(pp + 4); \
                if ((step) > 0 && w == (((step) - 1) & 7)) { const f32x4 y0_ = *(LAS f32x4*)(pp + 8), y1_ = *(LAS f32x4*)(pp + 12); yacc[((step) - 1) * 64 + lane] = ((y0_[0] + y0_[1]) + (y0_[2] + y0_[3])) + ((y1_[0] + y1_[1]) + (y1_[2] + y1_[3])); } \
                LDS_WAIT(); \
                const float sa = ((q0[0] + q0[1]) + (q0[2] + q0[3])) + ((q1[0] + q1[1]) + (q1[2] + q1[3])); const float vv = X[10]; \
                RW_HALF(X, 0, 0); RW_HALF(X, 1, 4); \
                float ya, yb; DPP_MUL(ya, X[8], S[0], 0); DPP_MUL(yb, X[9], S[4], 0); DPP_FMAC(ya, X[8], S[1], 1); DPP_FMAC(yb, X[9], S[5], 1); DPP_FMAC(ya, X[8], S[2], 2); DPP_FMAC(yb, X[9], S[6], 2); DPP_FMAC(ya, X[8], S[3], 3); DPP_FMAC(yb, X[9], S[7], 3); \
                PROBE_Y(X) yprev = ya + yb; } while (0)
#ifndef SCAN_REP
#define SCAN_REP 1
#endif
            float Ssave[8];
            for (int rep_ = 0; rep_ < SCAN_REP; ++rep_) {
            if (SCAN_REP > 1) { for (int j = 0; j < 8; ++j) { if (rep_ == 0) Ssave[j] = S[j]; else S[j] = Ssave[j]; } if (rep_) { for (int st_ = 0; st_ < 64; ++st_) yacc[st_ * 64 + lane] = 0.f; LDS_WAIT(); __syncthreads(); } }
            float XA[11], XB_[11]; float dmy = 0.f, yprev = 0.f;
            RW_LOAD(XA, 0);
            for (int s2 = 0; s2 < 64; s2 += 2) {
                RWKV_STEP(XA, XB_, s2);
                RWKV_STEP(XB_, XA, s2 + 1);
            }
            asm volatile("" :: "v"(dmy));
            { LAS float* pp = part + lane * 16; pp[8 + w] = yprev; LDS_WAIT(); __syncthreads();
              if (w == 7) { const f32x4 y0_ = *(LAS f32x4*)(pp + 8), y1_ = *(LAS f32x4*)(pp + 12); yacc[63 * 64 + lane] = ((y0_[0] + y0_[1]) + (y0_[2] + y0_[3])) + ((y1_[0] + y1_[1]) + (y1_[2] + y1_[3])); } }
            LDS_WAIT(); __syncthreads();
            }
            for (int i = 0; i < 8; ++i) { const int step = w + 8 * i; const size_t t = (size_t)b * SEQ + batch * 64 + step;
                const float y = yacc[step * 64 + lane], mean = wave_sum(y) * (1.f / 64.f), dlt = y - mean, var = wave_sum(dlt * dlt) * (1.f / 64.f);
                const float yn = dlt * rsqrtf(var + 64e-5f) * gng + gnb; const float o = (yn + bonus_s[step] * vx_s[step * 64 + lane]) * g_s[step * 64 + lane];
                MIX[t * D + 512 + c] = (bf16)f2bf(o); }
            LDS_WAIT(); __syncthreads();
        }
    }
}
__device__ __forceinline__ void phase_l1prep(Frame& F, const Args& a, int hb) {
    unsigned char* ws = F.ws; const bf16* XM = (const bf16*)(ws + WS_XM); bf16* XC = (bf16*)(ws + WS_XC); bf16* Q = (bf16*)(ws + WS_Q); bf16* K = (bf16*)(ws + WS_K); bf16* V = (bf16*)(ws + WS_V);
    float* GI = (float*)(ws + WS_GI); const float* W12 = (const float*)(ws + WS_W12);
    const float* cw = a.in[19]; const float* cb = a.in[20]; const float* wq = a.in[21]; const float* wk = a.in[22]; const float* wv = a.in[23]; const float* b_i = a.in[25]; const float* b_f = a.in[26];
    const int g = F.tid, lane = F.lane, w = F.wave; LAS float* red = (LAS float*)F.lds;
    float cwr[4][4], cbr[4], wqr[16], wkr[16], wvr[16], w1[32], w2[32];
#pragma unroll
    for (int j = 0; j < 4; ++j)
#pragma unroll
        for (int i = 0; i < 4; ++i) cwr[j][i] = cw[j * CI + 4 * g + i];
#pragma unroll
    for (int i = 0; i < 4; ++i) cbr[i] = cb[4 * g + i];
#pragma unroll
    for (int i = 0; i < 16; ++i) { wqr[i] = wq[g * 16 + i]; wkr[i] = wk[g * 16 + i]; wvr[i] = wv[g * 16 + i]; }
#pragma unroll
    for (int i = 0; i < 32; ++i) { w1[i] = W12[(size_t)(4 * g) * 8 + i]; w2[i] = W12[(size_t)(2048 + 4 * g) * 8 + i]; }
    const int per = TH / F.G;
    const int tb = F.bid * per;
    float x0[4], x1[4], x2[4];
    { const int sl = tb & (SEQ - 1);
#pragma unroll
      for (int i = 0; i < 4; ++i) { x0[i] = 0.f; x1[i] = 0.f; x2[i] = 0.f; }
      if (sl >= 1) { const v2u r = *(const v2u*)(XM + (size_t)(tb - 1) * CI + 4 * g); x2[0] = bflo(r.x); x2[1] = bfhi(r.x); x2[2] = bflo(r.y); x2[3] = bfhi(r.y); }
      if (sl >= 2) { const v2u r = *(const v2u*)(XM + (size_t)(tb - 2) * CI + 4 * g); x1[0] = bflo(r.x); x1[1] = bfhi(r.x); x1[2] = bflo(r.y); x1[3] = bfhi(r.y); }
      if (sl >= 3) { const v2u r = *(const v2u*)(XM + (size_t)(tb - 3) * CI + 4 * g); x0[0] = bflo(r.x); x0[1] = bfhi(r.x); x0[2] = bflo(r.y); x0[3] = bfhi(r.y); } }
    v2u xnext[2];
#pragma unroll
    for (int tk = 0; tk < 2; ++tk) xnext[tk] = *(const v2u*)(XM + (size_t)(tb + tk) * CI + 4 * g);
    for (int n4 = 0; n4 < per / 2; ++n4) { const int t4 = tb + 2 * n4;
        float gs[16]; v2u xr[2];
        xr[0] = xnext[0]; xr[1] = xnext[1];
        if (n4 + 1 < per / 2) {
#pragma unroll
            for (int tk = 0; tk < 2; ++tk) xnext[tk] = *(const v2u*)(XM + (size_t)(t4 + 2 + tk) * CI + 4 * g); }
#pragma unroll
        for (int tk = 0; tk < 2; ++tk) { const int t = t4 + tk;
            float x3[4]; x3[0] = bflo(xr[tk].x); x3[1] = bfhi(xr[tk].x); x3[2] = bflo(xr[tk].y); x3[3] = bfhi(xr[tk].y);
            float xc[4], q[4], k[4], v[4];
#pragma unroll
            for (int i = 0; i < 4; ++i) { const float s = cbr[i] + cwr[0][i] * x0[i] + cwr[1][i] * x1[i] + cwr[2][i] * x2[i] + cwr[3][i] * x3[i]; xc[i] = s * sigm(s); }
#pragma unroll
            for (int j = 0; j < 4; ++j) { q[j] = xc[0] * wqr[j] + xc[1] * wqr[4 + j] + xc[2] * wqr[8 + j] + xc[3] * wqr[12 + j]; k[j] = xc[0] * wkr[j] + xc[1] * wkr[4 + j] + xc[2] * wkr[8 + j] + xc[3] * wkr[12 + j];
                v[j] = x3[0] * wvr[j] + x3[1] * wvr[4 + j] + x3[2] * wvr[8 + j] + x3[3] * wvr[12 + j]; }
#pragma unroll
            for (int o = 0; o < 8; ++o) { float s = 0.f;
#pragma unroll
                for (int i = 0; i < 4; ++i) s += xc[i] * w1[i * 8 + o] + x3[i] * w2[i * 8 + o];
                gs[tk * 8 + o] = s; }
            const size_t off = (size_t)t * CI + 4 * g; const float ks = 0.044194173824159216f;
            { v2u o; o.x = pk2(xc[0], xc[1]); o.y = pk2(xc[2], xc[3]); *(v2u*)(XC + off) = o; o.x = pk2(q[0], q[1]); o.y = pk2(q[2], q[3]); *(v2u*)(Q + off) = o;
              o.x = pk2(k[0] * ks, k[1] * ks); o.y = pk2(k[2] * ks, k[3] * ks); *(v2u*)(K + off) = o; o.x = pk2(v[0], v[1]); o.y = pk2(v[2], v[3]); *(v2u*)(V + off) = o; }
#pragma unroll
            for (int i = 0; i < 4; ++i) { x0[i] = x1[i]; x1[i] = x2[i]; x2[i] = x3[i]; } }
#define L1_STAGE(mask, n) { const bool hi_ = (lane & (mask)) != 0; _Pragma("unroll") for (int i = 0; i < (n) / 2; ++i) { const float send_ = hi_ ? gs[i] : gs[(n) / 2 + i]; const float keep_ = hi_ ? gs[(n) / 2 + i] : gs[i]; gs[i] = keep_ + __shfl_xor(send_, (mask)); } }
        L1_STAGE(32, 16) L1_STAGE(16, 8) L1_STAGE(8, 4) L1_STAGE(4, 2)
#undef L1_STAGE
        gs[0] += __shfl_xor(gs[0], 2); gs[0] += __shfl_xor(gs[0], 1);
        LAS float* rp = red + (n4 & 1) * 128;
        if ((lane & 3) == 0) rp[w * 16 + (lane >> 2)] = gs[0];
        LDS_WAIT(); __syncthreads();
        if (F.tid < 16) { float s = 0.f;
#pragma unroll
            for (int ww = 0; ww < 8; ++ww) s += rp[ww * 16 + F.tid];
            const int o = F.tid & 7; GI[(size_t)(t4 + (F.tid >> 3)) * 8 + o] = s + (o < 4 ? b_i[o] : b_f[o - 4]); }
    }
}
__device__ __forceinline__ void phase_gatescan(Frame& F) {
    unsigned char* ws = F.ws; const float* GI = (const float*)(ws + WS_GI); float* GA = (float*)(ws + WS_GA); float* GAM = (float*)(ws + WS_GAM); float* GEM = (float*)(ws + WS_GEM);
    const int lane = F.lane, w = F.wave, tid = F.tid; LAS float* wtot = (LAS float*)F.lds;
    for (int sq = F.bid; sq < (NB / 2) * 4; sq += F.G) { const int bl = sq >> 2, h = sq & 3; const size_t tq = (size_t)bl * SEQ + 4 * tid;
        float ip[4], c[4];
#pragma unroll
        for (int k = 0; k < 4; ++k) { ip[k] = GI[(tq + k) * 8 + h]; c[k] = -softplusf_(-GI[(tq + k) * 8 + 4 + h]); }
        c[1] += c[0]; c[2] += c[1]; c[3] += c[2];
        float inc = c[3];
#pragma unroll
        for (int o = 1; o < 64; o <<= 1) { const float n = __shfl_up(inc, o); if (lane >= o) inc += n; }
        if (lane == 63) wtot[w] = inc;
        LDS_WAIT(); __syncthreads();
        float off = inc - c[3];
#pragma unroll
        for (int ww = 0; ww < 8; ++ww) if (ww < w) off += wtot[ww];
        float Fv[4], av[4], m[4];
#pragma unroll
        for (int k = 0; k < 4; ++k) { Fv[k] = off + c[k]; av[k] = ip[k] - Fv[k]; }
        m[0] = av[0]; m[1] = fmaxf(m[0], av[1]); m[2] = fmaxf(m[1], av[2]); m[3] = fmaxf(m[2], av[3]);
        float incm = m[3];
#pragma unroll
        for (int o = 1; o < 64; o <<= 1) { const float n = __shfl_up(incm, o); if (lane >= o) incm = fmaxf(incm, n); }
        if (lane == 63) wtot[8 + w] = incm;
        LDS_WAIT(); __syncthreads();
        float offm = __shfl_up(incm, 1); if (lane == 0) offm = -INFINITY;
#pragma unroll
        for (int ww = 0; ww < 8; ++ww) if (ww < w) offm = fmaxf(offm, wtot[8 + ww]);
#pragma unroll
        for (int k = 0; k < 4; ++k) { const float A = fmaxf(offm, m[k]); GA[(tq + k) * 4 + h] = av[k]; GAM[(tq + k) * 4 + h] = A; GEM[(tq + k) * 4 + h] = __expf(-(Fv[k] + A)); }
        LDS_WAIT(); __syncthreads();
    }
}
constexpr int ML_PITCH = 1040, ML_TILE = 32 * ML_PITCH, ML_PP = 80, ML_PT = 64 * ML_PP;
constexpr int ML_K = 0, ML_V = 2 * ML_TILE, ML_P = 4 * ML_TILE, ML_DEN = ML_P + 2 * ML_PT, ML_AT = ML_DEN + 512, ML_AS = ML_AT + 256, ML_END = ML_AS + 8192;
constexpr int ML_ST = ML_P, ML_MR = ML_P + 4096;
static_assert(ML_MR + 512 <= ML_DEN, "mLSTM LDS tables");
static_assert(ML_END <= MISC_OFF, "mLSTM LDS");
__device__ __forceinline__ void tr_read_v4(unsigned a, bf16x8 (&vf)[4]) { s16x4 l0, h0, l1, h1, l2, h2, l3, h3;
    asm volatile("ds_read_b64_tr_b16 %0, %8\n\tds_read_b64_tr_b16 %1, %8 offset:4160\n\tds_read_b64_tr_b16 %2, %8 offset:32\n\tds_read_b64_tr_b16 %3, %8 offset:4192\n\t"
                 "ds_read_b64_tr_b16 %4, %8 offset:64\n\tds_read_b64_tr_b16 %5, %8 offset:4224\n\tds_read_b64_tr_b16 %6, %8 offset:96\n\tds_read_b64_tr_b16 %7, %8 offset:4256\n\ts_waitcnt lgkmcnt(0)"
                 : "=&v"(l0), "=&v"(h0), "=&v"(l1), "=&v"(h1), "=&v"(l2), "=&v"(h2), "=&v"(l3), "=&v"(h3) : "v"(a) : "memory");
    vf[0] = (bf16x8){l0[0], l0[1], l0[2], l0[3], h0[0], h0[1], h0[2], h0[3]}; vf[1] = (bf16x8){l1[0], l1[1], l1[2], l1[3], h1[0], h1[1], h1[2], h1[3]};
    vf[2] = (bf16x8){l2[0], l2[1], l2[2], l2[3], h2[0], h2[1], h2[2], h2[3]}; vf[3] = (bf16x8){l3[0], l3[1], l3[2], l3[3], h3[0], h3[1], h3[2], h3[3]}; }
static_assert(4 * ML_PITCH == 4160, "tr_read_v4 offsets");
__device__ __forceinline__ void phase_mlstm(Frame& F, const Args& a) {
    unsigned char* ws = F.ws; const bf16* Q = (const bf16*)(ws + WS_Q); const bf16* K = (const bf16*)(ws + WS_K); const bf16* V = (const bf16*)(ws + WS_V); const bf16* XC = (const bf16*)(ws + WS_XC); const bf16* Z = (const bf16*)(ws + WS_Z);
    bf16* YC = (bf16*)(ws + WS_XM); const float* GA = (const float*)(ws + WS_GA); const float* GAM = (const float*)(ws + WS_GAM); const float* GEM = (const float*)(ws + WS_GEM);
    const float* mh_g = a.in[27]; const float* skip = a.in[28];
    const int tid = F.tid, lane = F.lane, w = F.wave, fr = lane & 15, fq = lane >> 4; LAS unsigned char* lds = F.lds;
    LAS float* den2 = (LAS float*)(lds + ML_DEN); LAS float* stats = (LAS float*)(lds + ML_ST); LAS float* mr = (LAS float*)(lds + ML_MR); LAS float* em_s = (LAS float*)(lds + ML_AT); LAS float* as_s = (LAS float*)(lds + ML_AS);
    const int tt = w >> 1, st = w & 1;
    const unsigned vtr_lane = (unsigned)((8 * fq + ((lane & 15) >> 2)) * ML_PITCH + (64 * w + 4 * (lane & 3)) * 2);
#define ML_DMA(gbase, tile_off) do { _Pragma("unroll") for (int r4 = 0; r4 < 4; ++r4) { const int rr = w + 8 * r4; \
        __builtin_amdgcn_global_load_lds((const unsigned*)((gbase) + (size_t)rr * CI + lane * 8), (LAS unsigned*)(lds + (tile_off) + rr * ML_PITCH), 16, 0, 0); } } while (0)
    for (int r = 0; r < 8; ++r) { const int xcd = F.bid & 7, cq = F.bid >> 3; if (F.G != 256) break;
        const int qi = (r & 1) ? 31 - cq : cq, bh = xcd + 8 * r, bl = bh >> 2, h = bh & 3; const size_t t0 = (size_t)bl * SEQ + 64 * qi; const int nk = 2 * (qi + 1);
        const bf16* Kb = K + (size_t)bl * SEQ * CI + h * 512; const bf16* Vb = V + (size_t)bl * SEQ * CI + h * 512;
        ML_DMA(Kb, ML_K); ML_DMA(Vb, ML_V);
        bf16x8 qf[16];
        { const bf16* qp = Q + (t0 + 16 * tt + fr) * CI + h * 512 + fq * 8;
#pragma unroll
          for (int ks = 0; ks < 16; ++ks) qf[ks] = *(const bf16x8*)(qp + 32 * ks); }
        const float At = GAM[(t0 + 16 * tt + fr) * 4 + h];
        if (tid < 64) em_s[tid] = GEM[(t0 + tid) * 4 + h];
#pragma unroll
        for (int i4 = 0; i4 < 4; ++i4) { const int sidx = tid + 512 * i4; if (sidx < 64 * (qi + 1)) as_s[sidx] = GA[((size_t)bl * SEQ + sidx) * 4 + h]; }
        VM_WAIT(); LDS_WAIT();
        f32x4 O[4][4]; float denp = 0.f;
#pragma unroll
        for (int i = 0; i < 4; ++i)
#pragma unroll
            for (int e = 0; e < 4; ++e) O[i][e] = (f32x4){0.f, 0.f, 0.f, 0.f};
        for (int j = 0; j < nk; ++j) { const int buf = j & 1;
            asm volatile("s_waitcnt vmcnt(0)" ::: "memory");
            __builtin_amdgcn_s_barrier(); asm volatile("" ::: "memory");
            if (j + 1 < nk) { ML_DMA(Kb + (size_t)(32 * (j + 1)) * CI, ML_K + (buf ^ 1) * ML_TILE); ML_DMA(Vb + (size_t)(32 * (j + 1)) * CI, ML_V + (buf ^ 1) * ML_TILE); }
            f32x4 sacc = {0.f, 0.f, 0.f, 0.f};
            { const LAS unsigned char* kl = lds + ML_K + buf * ML_TILE + (16 * st + fr) * ML_PITCH + fq * 16;
#pragma unroll
              for (int ks = 0; ks < 16; ++ks) { const bf16x8 kf = *(const LAS bf16x8*)(kl + 64 * ks); sacc = __builtin_amdgcn_mfma_f32_16x16x32_bf16(kf, qf[ks], sacc, 0, 0, 0); } }
            float p[4]; const f32x4 asv = *(const LAS f32x4*)(as_s + 32 * j + 16 * st + 4 * fq); const float as[4] = {asv[0], asv[1], asv[2], asv[3]};
#pragma unroll
            for (int i = 0; i < 4; ++i) { const bool ok = (32 * j + 16 * st + 4 * fq + i) <= (64 * qi + 16 * tt + fr); p[i] = ok ? sacc[i] * __builtin_amdgcn_exp2f((as[i] - At) * LOG2E) : 0.f; }
            denp += (p[0] + p[1]) + (p[2] + p[3]);
            { v2u pw; pw.x = pk2(p[0], p[1]); pw.y = pk2(p[2], p[3]); *(LAS v2u*)(lds + ML_P + buf * ML_PT + (16 * tt + fr) * ML_PP + (16 * st + 4 * fq) * 2) = pw; }
            LDS_WAIT(); __builtin_amdgcn_s_barrier(); asm volatile("" ::: "memory");
            { bf16x8 vf[4], pf[4]; const unsigned vb = (unsigned)(size_t)(lds + ML_V + buf * ML_TILE) + vtr_lane;
              tr_read_v4(vb, vf);
#pragma unroll
              for (int i = 0; i < 4; ++i) pf[i] = *(const LAS bf16x8*)(lds + ML_P + buf * ML_PT + (16 * i + fr) * ML_PP + fq * 16);
#pragma unroll
              for (int i = 0; i < 4; ++i)
#pragma unroll
                  for (int e = 0; e < 4; ++e) O[i][e] = __builtin_amdgcn_mfma_f32_16x16x32_bf16(pf[i], vf[e], O[i][e], 0, 0, 0); }
        }
        { float d = denp; d += __shfl_xor(d, 16); d += __shfl_xor(d, 32); if (fq == 0) den2[st * 64 + 16 * tt + fr] = d; }
        LDS_WAIT(); __syncthreads();
        float s1[4][4], s2[4][4];
#pragma unroll
        for (int i = 0; i < 4; ++i)
#pragma unroll
            for (int jj = 0; jj < 4; ++jj) { const int t = 16 * i + 4 * fq + jj; const float dn = den2[t] + den2[64 + t]; const float inv = 1.0f / fmaxf(fabsf(dn), em_s[t]); float a1 = 0.f, a2 = 0.f;
#pragma unroll
                for (int e = 0; e < 4; ++e) { const float hv = O[i][e][jj] * inv; O[i][e][jj] = hv; a1 += hv; a2 += hv * hv; }
                s1[i][jj] = a1; s2[i][jj] = a2; }
#pragma unroll
        for (int i = 0; i < 4; ++i)
#pragma unroll
            for (int jj = 0; jj < 4; ++jj) { float a1 = s1[i][jj], a2 = s2[i][jj];
#pragma unroll
                for (int o = 1; o < 16; o <<= 1) { a1 += __shfl_xor(a1, o); a2 += __shfl_xor(a2, o); }
                if (fr == 0) { const int t = 16 * i + 4 * fq + jj; stats[(w * 64 + t) * 2] = a1; stats[(w * 64 + t) * 2 + 1] = a2; } }
        LDS_WAIT(); __syncthreads();
        if (tid < 64) { float a1 = 0.f, a2 = 0.f;
#pragma unroll
            for (int ww = 0; ww < 8; ++ww) { a1 += stats[(ww * 64 + tid) * 2]; a2 += stats[(ww * 64 + tid) * 2 + 1]; }
            const float mean = a1 * (1.f / 512.f), var = fmaxf(a2 * (1.f / 512.f) - mean * mean, 0.f); mr[2 * tid] = mean; mr[2 * tid + 1] = rsqrtf(var + 1e-5f); }
        LDS_WAIT(); __syncthreads();
#pragma unroll
        for (int e = 0; e < 4; ++e) { const int cc = h * 512 + 64 * w + 16 * e + fr; const float gmul = mh_g[cc], sk = skip[cc];
#pragma unroll
            for (int i = 0; i < 4; ++i)
#pragma unroll
                for (int jj = 0; jj < 4; ++jj) { const int t = 16 * i + 4 * fq + jj; const size_t off = (t0 + t) * CI + cc; const float zz = bf1(Z[off]), xcv = bf1(XC[off]);
                    const float y = ((O[i][e][jj] - mr[2 * t]) * mr[2 * t + 1] * gmul + sk * xcv) * (zz * sigm(zz)); YC[off] = (bf16)f2bf(y); } }
        VM_WAIT(); __syncthreads();
    }
#undef ML_DMA
}
#define GEMM_PHASE(EPI, Aptr, Bptr, M_, N_, K_, ...) do { pg8::Gemm g{(const pg8::bf16_t*)(Aptr), (const pg8::bf16_t*)(Bptr), (M_), (N_), (K_)}; pg8::StaticOrder So; So.init((M_), (N_), F.G, F.bid); \
        pg8::EPI Ep{__VA_ARGS__}; pg8::gemm_phase<pg8::EPI, pg8::StaticOrder, PG8_ALIGN, PG8_SP2>(F.lds, g, So, Ep); } while (0)
__global__ void __launch_bounds__(NWAVES * 64, 2) trunk_fwd(Args args) {
    extern __shared__ __attribute__((aligned(16))) unsigned char lds_raw[];
    Frame F; F.lds = (LAS unsigned char*)lds_raw; F.ws = args.ws; F.in = nullptr;
    F.tid = threadIdx.x; F.lane = F.tid & 63; F.wave = __builtin_amdgcn_readfirstlane(F.tid >> 6); F.G = gridDim.x; F.bid = blockIdx.x;
    volatile LAS unsigned* MISC = (volatile LAS unsigned*)(F.lds + MISC_OFF);
    if (F.tid < 64) MISC[F.tid] = 0u;
    __syncthreads();
    XcdBarrier bar; bar.bar = (unsigned*)(args.ws + WS_CTL) + CW_BAR; bar.x = 0; bar.st = nullptr;
    if (args.use_bar) bar = xcd_barrier_post((unsigned*)(args.ws + WS_CTL) + CW_BAR, MISC + 8);
    const int lo = args.ph_lo, hi = args.ph_hi;
#ifndef ONLY_SITE
#define ONLY_SITE -1
#endif
#define EN(n) (ONLY_SITE < 0 || ONLY_SITE == (n))
#ifndef REP_MASK
#define REP_MASK 0u
#endif
#define NREP(n) (((REP_MASK >> (n)) & 1u) ? 2 : 1)
#define IN(k) (lo <= (k) && (k) < hi)
#define SEAM(k) do { if (IN(k) && IN((k) + 1)) xcd_barrier(bar); } while (0)
    unsigned char* ws = args.ws; float* out = args.out;
    float* RS = (float*)(ws + WS_RS);
#define RSN(i) (RS + (size_t)(i) * T)
#define PH(site, k, ...) if (EN(site) && IN(k)) { for (int rep_ = 0; rep_ < NREP(site); ++rep_) { if (rep_) xcd_barrier(bar); __VA_ARGS__ } } SEAM(k);
    PH(0, 0, phase_prologue(F, args); phase_cast_sq(F, args.in[0], (bf16*)(ws + WS_XB2), RSN(0), T); phase_cvt_p(F, args.in[1], (bf16*)(ws + WS_PB));)
    PH(2, 1, GEMM_PHASE(EpiBf16SplitR, ws + WS_XB2, ws + WS_WIN, T, NU, D, (pg8::bf16_t*)(ws + WS_UA), UA_W, 4, (pg8::bf16_t*)(ws + WS_UB), UB_W, RSN(0));)
    PH(3, 2, phase_prepA(F, args);)
    PH(4, 3, GEMM_PHASE(EpiBf16Split, ws + WS_LIN, ws + WS_WLORA, T, 1536, 256 + args.pad, (pg8::bf16_t*)(ws + WS_LOUT), 1536, 1 << 20, nullptr, 0);)
    PH(5, 4, phase_indexer(F);)
    PH(6, 5, phase_dsa_attn(F, args);)
    PH(7, 6, phase_rwkv(F, args);)
    PH(8, 7, GEMM_PHASE(EpiResN, ws + WS_XB, ws + WS_WOUT, T, D, D, args.in[0], out, D, (pg8::bf16_t*)(ws + WS_XB2), RSN(1));)
#define FFN_PLE(L, pb, rs_a, rs_b, rs_c, xcopy_out) do { const size_t lw = (size_t)(L) * WS_LAYER_STRIDE; \
        PH(21, (pb), GEMM_PHASE(EpiSwigluR, ws + WS_XB2, ws + WS_WGU0 + lw, T, 2 * FF, D, (pg8::bf16_t*)(ws + WS_H), FF, RSN(rs_a));) \
        PH(22, (pb) + 1, GEMM_PHASE(EpiResN, ws + WS_H, ws + WS_WD0 + lw, T, D, FF, out, out, D, (pg8::bf16_t*)(ws + WS_XB), RSN(rs_b));) \
        PH(24, (pb) + 2, GEMM_PHASE(EpiBf16Split, ws + WS_PB, ws + WS_WPLE0 + lw, T, D, 256 + args.pad, (pg8::bf16_t*)(ws + WS_E), D, 1 << 20, nullptr, 0);) \
        PH(25, (pb) + 3, GEMM_PHASE(EpiPleN, ws + WS_XB, ws + WS_WPG0 + lw, T, D, D, out, out, (const pg8::bf16_t*)(ws + WS_E), D, RSN(rs_b), (pg8::bf16_t*)(xcopy_out), RSN(rs_c));) } while (0)
#define L1_HALF(hb, p1) do { float* xh = out + (size_t)(hb) * TH * D; bf16* xbh = (bf16*)(ws + WS_XB2) + (size_t)(hb) * TH * D; \
        PH(11, (p1), GEMM_PHASE(EpiBf16SplitR, xbh, ws + WS_WUP, TH, 2 * CI, D, (pg8::bf16_t*)(ws + WS_XM), CI, 8, (pg8::bf16_t*)(ws + WS_Z), CI, RSN(3) + (size_t)(hb) * TH);) \
        PH(12, (p1) + 1, phase_l1prep(F, args, hb);) \
        PH(13, (p1) + 2, phase_gatescan(F); if ((hb) == 0) phase_cvt_p(F, args.in[1] + (size_t)T * 256, (bf16*)(ws + WS_PB));) \
        PH(14, (p1) + 3, phase_mlstm(F, args);) \
        PH(15, (p1) + 4, GEMM_PHASE(EpiResN, ws + WS_XM, ws + WS_WDOWN, TH, D, CI, xh, xh, D, (pg8::bf16_t*)xbh, RSN(4) + (size_t)(hb) * TH);) } while (0)
    FFN_PLE(0, 8, 1, 2, 3, ws + WS_XB2);
    L1_HALF(0, 12);
    L1_HALF(1, 17);
    FFN_PLE(1, 22, 4, 5, 5, nullptr);
#undef IN
#undef SEAM
}
constexpr int N_PHASES = 26;

#ifndef MK_ONE_LAUNCH
#define MK_ONE_LAUNCH 1
#endif
extern "C" void kernel_launch(void* const* d_in, const int* in_sizes, int n_in, void* d_out, int out_size, void* d_ws, size_t ws_size, hipStream_t stream) {
    static int grid = 0;
    if (grid == 0) {
        if (n_in != 37 || in_sizes[0] != T * D || out_size != T * D || ws_size < WS_END) { fprintf(stderr, "kernel_launch: unexpected shapes (n_in %d, in0 %d, out %d, ws %zu < %zu); nothing launched\n", n_in, n_in > 0 ? in_sizes[0] : -1, out_size, ws_size, (size_t)WS_END); grid = -1; return; }
        int dev = 0, cus = 0, per_cu = 0;
        if (hipGetDevice(&dev) != hipSuccess || hipDeviceGetAttribute(&cus, hipDeviceAttributeMultiprocessorCount, dev) != hipSuccess) { grid = -1; return; }
        if (hipFuncSetAttribute((const void*)trunk_fwd, hipFuncAttributeMaxDynamicSharedMemorySize, LDS_BYTES) != hipSuccess) { fprintf(stderr, "kernel_launch: hipFuncSetAttribute failed\n"); grid = -1; return; }
        if (hipOccupancyMaxActiveBlocksPerMultiprocessor(&per_cu, (const void*)trunk_fwd, NWAVES * 64, LDS_BYTES) != hipSuccess || per_cu < 1) { fprintf(stderr, "kernel_launch: occupancy query says %d\n", per_cu); }
        (void)hipGetLastError();
        grid = cus;
        if (grid != 256) { fprintf(stderr, "kernel_launch: built for 256 CUs, found %d; nothing launched\n", cus); grid = -1; return; }
    }
    if (grid < 0) return;
    if (hipMemsetAsync((char*)d_ws + WS_CTL, 0, CTL_ZERO_BYTES, stream) != hipSuccess) return;
    if (hipMemsetAsync((char*)d_ws + WS_RS, 0, RS_BYTES, stream) != hipSuccess) return;
    Args a{};
    for (int i = 0; i < 37; ++i) a.in[i] = (const float*)d_in[i];
    a.out = (float*)d_out; a.ws = (unsigned char*)d_ws; a.pad = 0;
#if MK_ONE_LAUNCH
    a.ph_lo = 0; a.ph_hi = N_PHASES; a.use_bar = 1;
    hipLaunchKernelGGL(trunk_fwd, dim3(grid), dim3(NWAVES * 64), LDS_BYTES, stream, a);
#else
    for (int p = 0; p < N_PHASES; ++p) { a.ph_lo = p; a.ph_hi = p + 1; a.use_bar = 0; hipLaunchKernelGGL(trunk_fwd, dim3(grid), dim3(NWAVES * 64), LDS_BYTES, stream, a); }
#endif
}
```

```cpp
#include <hip/hip_runtime.h>
#include <cstdio>
#include <cstdint>
namespace pg8 {
#define PG8_LAS __attribute__((address_space(3)))
typedef unsigned short bf16_t;
typedef short bf16x8 __attribute__((ext_vector_type(8)));
typedef float f32x4 __attribute__((ext_vector_type(4)));
typedef unsigned u32x4 __attribute__((ext_vector_type(4)));
constexpr int BM = 256, BK = 64, HALF = 128, HTB = HALF * BK * 2  , STAGE_BYTES = 8 * HTB, NXCD = 8, WGM = 8;

__host__ __device__ __forceinline__ int lds_byte(int r, int c) { const int st = (r >> 4) * 2 + (c >> 5), rr = r & 15, cc = c & 31, ob = rr * 64 + cc * 2; return st * 1024 + (ob ^ (((ob >> 9) & 1) << 5)); }
__host__ __device__ __forceinline__ void stage_rc(int b, int& R, int& C) { const int st = b / 1024, sb = b % 1024, swz = sb ^ (((sb >> 9) & 1) << 5); R = (st >> 1) * 16 + swz / 64; C = (st & 1) * 32 + (swz % 64) / 2; }
__host__ __device__ __forceinline__ int perm32(int rho) { const int n = rho >> 4, i = rho & 15; return 8 * (i >> 2) + 4 * n + (i & 3); }

struct Unit { int pm, pn; };
struct Gemm { const bf16_t* A; const bf16_t* Bt; int M, N, K; };

struct StaticOrder {
    int nM, nN, nwg, G, c;
    __host__ __device__ void init(int M, int N, int G_, int c_) { nM = M / BM; nN = N / BM; nwg = nM * nN; G = G_; c = c_; }
    __host__ __device__ bool next(int i, Unit& u) const {
        const long L = (long)i * G + c; if (L >= nwg) return false;
        int wgid = (int)L; { const int q = nwg / NXCD, r = nwg % NXCD, xcd = wgid % NXCD, off = wgid / NXCD; wgid = (xcd < r ? xcd * (q + 1) : r * (q + 1) + (xcd - r) * q) + off; }
        const int nig = WGM * nN, gid = wgid / nig, fm = gid * WGM, gsz = (nM - fm) < WGM ? (nM - fm) : WGM;
        u.pm = fm + ((wgid % nig) % gsz); u.pn = (wgid % nig) / gsz; return true;
    }
    __device__ __forceinline__ void a_ready(const Unit&) const {}
    __device__ __forceinline__ void done(const Unit&) const {}
};

__device__ __forceinline__ unsigned cvt_pk_bf16(float lo, float hi) { unsigned r; asm volatile("v_cvt_pk_bf16_f32 %0, %1, %2" : "=v"(r) : "v"(lo), "v"(hi)); return r; }
typedef float f32x2 __attribute__((ext_vector_type(2)));
__device__ __forceinline__ f32x2 gelu_pk(f32x2 v) {
    const f32x2 av = __builtin_elementwise_abs(v), d = av * 0.2316418882f + 1.0f;
    f32x2 t; t.x = __builtin_amdgcn_rcpf(d.x); t.y = __builtin_amdgcn_rcpf(d.y);
    f32x2 q = t * 0.5307027145f + (-0.7265760135f); q = q * t + 0.7107068705f; q = q * t + (-0.142248368f); q = q * t + 0.127414796f; q = q * t;
    const f32x2 s = (v * v) * (-0.72134752044f);
    f32x2 e; e.x = __builtin_amdgcn_exp2f(s.x); e.y = __builtin_amdgcn_exp2f(s.y);
    const f32x2 m = v * (q * e), r = v - m;
    f32x2 o; o.x = v.x < 0.f ? m.x : r.x; o.y = v.y < 0.f ? m.y : r.y; return o;
}

template <class Epi, class Sched, bool ALIGN_EPI = false, bool SP2 = false>
__device__ __forceinline__ void gemm_phase(PG8_LAS unsigned char* lds, const Gemm g, const Sched& S, const Epi& E) {
    const int tid = threadIdx.x, wid = __builtin_amdgcn_readfirstlane(tid >> 6), lane = tid & 63, wr = wid >> 2, wc = wid & 3, fr = lane & 15, fq = lane >> 4;
    const int K = g.K, nt = K / BK;
    unsigned voffA[2], voffB[2];
#pragma unroll
    for (int i = 0; i < 2; ++i) { int R, C; stage_rc(tid * 16 + i * 8192, R, C); const int Rb = Epi::PERM ? ((R & ~31) + perm32(R & 31)) : R;
        voffA[i] = (unsigned)(R * K + C) * 2u; voffB[i] = (unsigned)(Rb * K + C) * 2u; }
    const size_t kstep = (size_t)(BK * 2);
    const size_t hstep = (size_t)HALF * K * 2;
    const size_t tstep = 2 * hstep;
    const unsigned ldsw = (unsigned)wid * 1024u;
    const int aoff = lds_byte(wr * 64 + fr, fq * 8), boff = lds_byte(wc * 32 + fr, fq * 8);
#define PG8_SA(b, h) (((b) * 2 + (h)) * HTB)
#define PG8_SB(b, h) ((4 + (b) * 2 + (h)) * HTB)
#define PG8_STAGE(bufoff, gbase, voff) do { _Pragma("unroll") for (int _i = 0; _i < 2; ++_i) \
        __builtin_amdgcn_global_load_lds((const unsigned*)((const char*)(gbase) + (voff)[_i]), (PG8_LAS unsigned*)(lds + (bufoff) + ldsw + _i * 8192), 16, 0, 0); } while (0)
#define PG8_LDA(dst, b, h) do { _Pragma("unroll") for (int m = 0; m < 4; ++m) _Pragma("unroll") for (int k = 0; k < 2; ++k) dst[m][k] = *(const PG8_LAS bf16x8*)(lds + PG8_SA(b, h) + aoff + m * 2048 + k * 1024); } while (0)
#define PG8_LDB(dst, b, h) do { _Pragma("unroll") for (int n = 0; n < 2; ++n) _Pragma("unroll") for (int k = 0; k < 2; ++k) dst[n][k] = *(const PG8_LAS bf16x8*)(lds + PG8_SB(b, h) + boff + n * 2048 + k * 1024); } while (0)
#define PG8_MMA(ai, bj, At, Bt) do { __builtin_amdgcn_s_setprio(1); _Pragma("unroll") for (int m = 0; m < 4; ++m) _Pragma("unroll") for (int n = 0; n < 2; ++n) _Pragma("unroll") for (int k = 0; k < 2; ++k) \
        acc[ai][bj][m][n] = __builtin_amdgcn_mfma_f32_16x16x32_bf16(Bt[n][k], At[m][k], acc[ai][bj][m][n], 0, 0, 0); __builtin_amdgcn_s_setprio(0); } while (0)
#define PG8_WAIT_V(n) asm volatile("s_waitcnt vmcnt(" #n ")" ::: "memory")
#define PG8_WAIT_L(n) asm volatile("s_waitcnt lgkmcnt(" #n ")" ::: "memory")
#define PG8_BAR __builtin_amdgcn_s_barrier()
#define PG8_SCHED __builtin_amdgcn_sched_barrier(0)
    Unit cur, nxt; int ui = 0;
    if (!S.next(0, cur)) return;
    f32x4 acc[2][2][4][2];
#pragma unroll
    for (int a = 0; a < 2; ++a)
#pragma unroll
        for (int b = 0; b < 2; ++b)
#pragma unroll
            for (int m = 0; m < 4; ++m)
#pragma unroll
                for (int n = 0; n < 2; ++n) acc[a][b][m][n] = (f32x4){0.f, 0.f, 0.f, 0.f};
    bf16x8 At[4][2], B0[2][2], B1[2][2];
    const char* cA = (const char*)g.A + (size_t)cur.pm * tstep; const char* cB = (const char*)g.Bt + (size_t)cur.pn * tstep;
    S.a_ready(cur);
    if constexpr (SP2) {
        PG8_STAGE(PG8_SB(0, 0), cB, voffB); PG8_STAGE(PG8_SB(0, 1), cB + hstep, voffB); PG8_STAGE(PG8_SA(0, 0), cA, voffA); PG8_STAGE(PG8_SA(0, 1), cA + hstep, voffA);
        if (wr == 1) PG8_BAR;
        PG8_WAIT_V(2); PG8_BAR;
        PG8_STAGE(PG8_SB(1, 0), cB + kstep, voffB); PG8_STAGE(PG8_SA(1, 0), cA + kstep, voffA); PG8_STAGE(PG8_SB(1, 1), cB + hstep + kstep, voffB);
        PG8_WAIT_V(6); PG8_BAR;
    } else {
        PG8_STAGE(PG8_SB(0, 0), cB, voffB); PG8_STAGE(PG8_SA(0, 0), cA, voffA); PG8_STAGE(PG8_SB(0, 1), cB + hstep, voffB); PG8_STAGE(PG8_SA(0, 1), cA + hstep, voffA);
        if (wr == 1) PG8_BAR;
        PG8_WAIT_V(4); PG8_BAR;
        PG8_STAGE(PG8_SB(1, 0), cB + kstep, voffB); PG8_STAGE(PG8_SA(1, 0), cA + kstep, voffA); PG8_STAGE(PG8_SB(1, 1), cB + hstep + kstep, voffB);
        PG8_WAIT_V(6); PG8_BAR;
    }
    for (;;) {
        const bool has_next = S.next(ui + 1, nxt);
        const char* nA = has_next ? (const char*)g.A + (size_t)nxt.pm * tstep : cA; const char* nB = has_next ? (const char*)g.Bt + (size_t)nxt.pn * tstep : cB;
        for (int t = 0; t < nt; t += 2) {
            const bool last = (t == nt - 2);
            const char* a1 = cA + (size_t)(t + 1) * kstep;
            const char* a2 = last ? nA : cA + (size_t)(t + 2) * kstep; const char* b2 = last ? nB : cB + (size_t)(t + 2) * kstep;
            const char* a3 = a2 + kstep; const char* b3 = b2 + kstep;
            if (last && has_next) S.a_ready(nxt);
            if constexpr (SP2) {
            PG8_LDB(B0, 0, 0); PG8_LDB(B1, 0, 1); PG8_SCHED; PG8_LDA(At, 0, 0); PG8_STAGE(PG8_SA(1, 1), a1 + hstep, voffA);
            PG8_WAIT_V(8); PG8_WAIT_L(0); PG8_BAR; PG8_MMA(0, 0, At, B0); PG8_MMA(0, 1, At, B1); PG8_BAR; PG8_SCHED;
            PG8_LDA(At, 0, 1); PG8_STAGE(PG8_SB(0, 0), b2, voffB); PG8_STAGE(PG8_SB(0, 1), b2 + hstep, voffB); PG8_STAGE(PG8_SA(0, 0), a2, voffA);
            PG8_WAIT_V(8); PG8_WAIT_L(0); PG8_BAR; PG8_MMA(1, 0, At, B0); PG8_MMA(1, 1, At, B1); PG8_BAR; PG8_SCHED;
            PG8_LDB(B0, 1, 0); PG8_LDB(B1, 1, 1); PG8_SCHED; PG8_LDA(At, 1, 0); PG8_STAGE(PG8_SA(0, 1), a2 + hstep, voffA);
            PG8_WAIT_V(8); PG8_WAIT_L(0); PG8_BAR; PG8_MMA(0, 0, At, B0); PG8_MMA(0, 1, At, B1); PG8_BAR; PG8_SCHED;
            PG8_LDA(At, 1, 1); PG8_STAGE(PG8_SB(1, 0), b3, voffB); PG8_STAGE(PG8_SB(1, 1), b3 + hstep, voffB); PG8_STAGE(PG8_SA(1, 0), a3, voffA);
            PG8_WAIT_V(8); PG8_WAIT_L(0); PG8_BAR; PG8_MMA(1, 0, At, B0); PG8_MMA(1, 1, At, B1); PG8_BAR; PG8_SCHED;
            } else {
            PG8_LDB(B0, 0, 0); PG8_SCHED; PG8_LDA(At, 0, 0); PG8_STAGE(PG8_SA(1, 1), a1 + hstep, voffA);
            PG8_WAIT_L(8); PG8_BAR; PG8_WAIT_L(0); PG8_MMA(0, 0, At, B0); PG8_BAR; PG8_SCHED;
            PG8_LDB(B1, 0, 1); PG8_STAGE(PG8_SB(0, 0), b2, voffB);
            PG8_BAR; PG8_WAIT_L(0); PG8_MMA(0, 1, At, B1); PG8_BAR;
            PG8_LDA(At, 0, 1); PG8_STAGE(PG8_SA(0, 0), a2, voffA);
            PG8_BAR; PG8_WAIT_L(0); PG8_MMA(1, 0, At, B0); PG8_BAR; PG8_SCHED;
            PG8_STAGE(PG8_SB(0, 1), b2 + hstep, voffB);
            PG8_WAIT_V(6); PG8_BAR; PG8_MMA(1, 1, At, B1); PG8_BAR;
            PG8_LDB(B0, 1, 0); PG8_SCHED; PG8_LDA(At, 1, 0); PG8_STAGE(PG8_SA(0, 1), a2 + hstep, voffA);
            PG8_WAIT_L(8); PG8_BAR; PG8_WAIT_L(0); PG8_MMA(0, 0, At, B0); PG8_BAR; PG8_SCHED;
            PG8_LDB(B1, 1, 1); PG8_STAGE(PG8_SB(1, 0), b3, voffB);
            PG8_BAR; PG8_WAIT_L(0); PG8_MMA(0, 1, At, B1); PG8_BAR;
            PG8_LDA(At, 1, 1); PG8_STAGE(PG8_SA(1, 0), a3, voffA);
            PG8_BAR; PG8_WAIT_L(0); PG8_MMA(1, 0, At, B0); PG8_BAR; PG8_SCHED;
            PG8_STAGE(PG8_SB(1, 1), b3 + hstep, voffB);
            PG8_WAIT_V(6); PG8_BAR; PG8_MMA(1, 1, At, B1); PG8_BAR;
            }
        }
        if constexpr (ALIGN_EPI) { if (wr == 0) PG8_BAR; }
        if constexpr (!Epi::AFTER_DRAIN) { E(acc, cur, wr, wc, fr, fq); S.done(cur); }
        if (!has_next) break;
#pragma unroll
        for (int a = 0; a < 2; ++a)
#pragma unroll
            for (int b = 0; b < 2; ++b)
#pragma unroll
                for (int m = 0; m < 4; ++m)
#pragma unroll
                    for (int n = 0; n < 2; ++n) acc[a][b][m][n] = (f32x4){0.f, 0.f, 0.f, 0.f};
        cur = nxt; cA = nA; cB = nB; ++ui;
        if constexpr (ALIGN_EPI) { if (wr == 1) PG8_BAR; }
    }
    PG8_WAIT_V(0);
    if constexpr (!ALIGN_EPI) { if (wr == 0) PG8_BAR; }
    PG8_BAR;
    if constexpr (Epi::AFTER_DRAIN) { E.fused(acc, cur, wr, wc, fr, fq, lds, wid, lane); S.done(cur); }
#undef PG8_SA
#undef PG8_SB
#undef PG8_STAGE
#undef PG8_LDA
#undef PG8_LDB
#undef PG8_MMA
#undef PG8_WAIT_V
#undef PG8_WAIT_L
#undef PG8_BAR
#undef PG8_SCHED
}
}
namespace pg8 {
__device__ __forceinline__ float sigmoidf_(float x) { return __builtin_amdgcn_rcpf(1.0f + __builtin_amdgcn_exp2f(-1.4426950408889634f * x)); }
struct EpiBf16Split {
    static constexpr bool PERM = true, AFTER_DRAIN = false;
    bf16_t* O0; int ld0; int nt0; bf16_t* O1; int ld1;
    __device__ __forceinline__ void operator()(const f32x4 (&acc)[2][2][4][2], const Unit& u, int wr, int wc, int fr, int fq) const {
        const bool first = u.pn < nt0; bf16_t* base = first ? O0 : O1; const int ld = first ? ld0 : ld1; const int colt = (first ? u.pn : u.pn - nt0) * BM;
        const int row0 = u.pm * BM + wr * 64 + fr, col0 = colt + wc * 32 + 8 * fq;
#pragma unroll
        for (int ai = 0; ai < 2; ++ai)
#pragma unroll
            for (int m = 0; m < 4; ++m) { bf16_t* rowp = base + (size_t)(row0 + ai * HALF + m * 16) * ld + col0;
#pragma unroll
                for (int bj = 0; bj < 2; ++bj) { const f32x4 v0 = acc[ai][bj][m][0], v1 = acc[ai][bj][m][1];
                    u32x4 w; w.x = cvt_pk_bf16(v0[0], v0[1]); w.y = cvt_pk_bf16(v0[2], v0[3]); w.z = cvt_pk_bf16(v1[0], v1[1]); w.w = cvt_pk_bf16(v1[2], v1[3]);
                    *(u32x4*)(rowp + bj * HALF) = w; } }
    }
};
struct EpiResF32 {
    static constexpr bool PERM = false, AFTER_DRAIN = false;
    const float* base; float* out; int ldc;
    __device__ __forceinline__ void operator()(const f32x4 (&acc)[2][2][4][2], const Unit& u, int wr, int wc, int fr, int fq) const {
        const int row0 = u.pm * BM + wr * 64 + fr, col0 = u.pn * BM + wc * 32 + 4 * fq;
#pragma unroll
        for (int ai = 0; ai < 2; ++ai)
#pragma unroll
            for (int m = 0; m < 4; ++m) { const size_t off = (size_t)(row0 + ai * HALF + m * 16) * ldc + col0;
#pragma unroll
                for (int bj = 0; bj < 2; ++bj)
#pragma unroll
                    for (int n = 0; n < 2; ++n) { const f32x4 b = *(const f32x4*)(base + off + bj * HALF + n * 16); *(f32x4*)(out + off + bj * HALF + n * 16) = b + acc[ai][bj][m][n]; } }
    }
};
struct EpiSwiglu {
    static constexpr bool PERM = false, AFTER_DRAIN = false;
    bf16_t* H; int ldh;
    __device__ __forceinline__ void operator()(const f32x4 (&acc)[2][2][4][2], const Unit& u, int wr, int wc, int fr, int fq) const {
        const int row0 = u.pm * BM + wr * 64 + fr, hc0 = u.pn * (BM / 2) + wc * 16 + 4 * fq;
#pragma unroll
        for (int ai = 0; ai < 2; ++ai)
#pragma unroll
            for (int m = 0; m < 4; ++m) { bf16_t* rowp = H + (size_t)(row0 + ai * HALF + m * 16) * ldh + hc0;
#pragma unroll
                for (int bj = 0; bj < 2; ++bj) { const f32x4 g = acc[ai][bj][m][0], up = acc[ai][bj][m][1]; float h[4];
#pragma unroll
                    for (int i = 0; i < 4; ++i) h[i] = g[i] * sigmoidf_(g[i]) * up[i];
                    typedef unsigned u32x2 __attribute__((ext_vector_type(2)));
                    u32x2 w; w.x = cvt_pk_bf16(h[0], h[1]); w.y = cvt_pk_bf16(h[2], h[3]);
                    *(u32x2*)(rowp + bj * (HALF / 2)) = w; } }
    }
};
struct EpiPle {
    static constexpr bool PERM = false, AFTER_DRAIN = false;
    const float* base; float* out; const bf16_t* E; int ldc;
    __device__ __forceinline__ void operator()(const f32x4 (&acc)[2][2][4][2], const Unit& u, int wr, int wc, int fr, int fq) const {
        const int row0 = u.pm * BM + wr * 64 + fr, col0 = u.pn * BM + wc * 32 + 4 * fq;
        typedef unsigned u32x2 __attribute__((ext_vector_type(2)));
#pragma unroll
        for (int ai = 0; ai < 2; ++ai)
#pragma unroll
            for (int m = 0; m < 4; ++m) { const size_t off = (size_t)(row0 + ai * HALF + m * 16) * ldc + col0;
#pragma unroll
                for (int bj = 0; bj < 2; ++bj)
#pragma unroll
                    for (int n = 0; n < 2; ++n) { const size_t o = off + bj * HALF + n * 16; const f32x4 b = *(const f32x4*)(base + o); const u32x2 e = *(const u32x2*)(E + o); const f32x4 a = acc[ai][bj][m][n];
                        f32x4 r; r[0] = b[0] + __uint_as_float(e.x << 16) * sigmoidf_(a[0]); r[1] = b[1] + __uint_as_float(e.x & 0xffff0000u) * sigmoidf_(a[1]);
                        r[2] = b[2] + __uint_as_float(e.y << 16) * sigmoidf_(a[2]); r[3] = b[3] + __uint_as_float(e.y & 0xffff0000u) * sigmoidf_(a[3]);
                        *(f32x4*)(out + o) = r; } }
    }
};
__device__ __forceinline__ float rms_r(const float* rsq, int row) { const f32x4* p = (const f32x4*)(rsq + (size_t)row * 16); const f32x4 a = p[0], b = p[1], c = p[2], d = p[3];
    const float s = (((a[0] + a[1]) + (a[2] + a[3])) + ((b[0] + b[1]) + (b[2] + b[3]))) + (((c[0] + c[1]) + (c[2] + c[3])) + ((d[0] + d[1]) + (d[2] + d[3]))); return rsqrtf(s * (1.0f / 1024.0f) + 1e-6f); }
__device__ __forceinline__ void norm_out(const f32x4 (&x)[2][2], bf16_t* xb, size_t off, float* rsq_out, int row, int fq, int slot) {
    typedef unsigned u32x2 __attribute__((ext_vector_type(2))); float s = 0.f;
#pragma unroll
    for (int bj = 0; bj < 2; ++bj)
#pragma unroll
        for (int n = 0; n < 2; ++n) { const f32x4 v = x[bj][n]; s += (v[0] * v[0] + v[1] * v[1]) + (v[2] * v[2] + v[3] * v[3]); u32x2 w; w.x = cvt_pk_bf16(v[0], v[1]); w.y = cvt_pk_bf16(v[2], v[3]); *(u32x2*)(xb + off + bj * HALF + n * 16) = w; }
    s += __shfl_xor(s, 16); s += __shfl_xor(s, 32);
    if (fq == 0) rsq_out[(size_t)row * 16 + slot] = s;
}
struct EpiBf16SplitR {
    static constexpr bool PERM = true, AFTER_DRAIN = false;
    bf16_t* O0; int ld0; int nt0; bf16_t* O1; int ld1; const float* rsq;
    __device__ __forceinline__ void operator()(const f32x4 (&acc)[2][2][4][2], const Unit& u, int wr, int wc, int fr, int fq) const {
        const bool first = u.pn < nt0; bf16_t* base = first ? O0 : O1; const int ld = first ? ld0 : ld1; const int colt = (first ? u.pn : u.pn - nt0) * BM;
        const int row0 = u.pm * BM + wr * 64 + fr, col0 = colt + wc * 32 + 8 * fq;
#pragma unroll
        for (int ai = 0; ai < 2; ++ai)
#pragma unroll
            for (int m = 0; m < 4; ++m) { const int row = row0 + ai * HALF + m * 16; const float r = rms_r(rsq, row); bf16_t* rowp = base + (size_t)row * ld + col0;
#pragma unroll
                for (int bj = 0; bj < 2; ++bj) { const f32x4 v0 = acc[ai][bj][m][0] * r, v1 = acc[ai][bj][m][1] * r;
                    u32x4 w; w.x = cvt_pk_bf16(v0[0], v0[1]); w.y = cvt_pk_bf16(v0[2], v0[3]); w.z = cvt_pk_bf16(v1[0], v1[1]); w.w = cvt_pk_bf16(v1[2], v1[3]);
                    *(u32x4*)(rowp + bj * HALF) = w; } }
    }
};
struct EpiSwigluR {
    static constexpr bool PERM = false, AFTER_DRAIN = false;
    bf16_t* H; int ldh; const float* rsq;
    __device__ __forceinline__ void operator()(const f32x4 (&acc)[2][2][4][2], const Unit& u, int wr, int wc, int fr, int fq) const {
        const int row0 = u.pm * BM + wr * 64 + fr, hc0 = u.pn * (BM / 2) + wc * 16 + 4 * fq;
#pragma unroll
        for (int ai = 0; ai < 2; ++ai)
#pragma unroll
            for (int m = 0; m < 4; ++m) { const int row = row0 + ai * HALF + m * 16; const float r = rms_r(rsq, row); bf16_t* rowp = H + (size_t)row * ldh + hc0;
#pragma unroll
                for (int bj = 0; bj < 2; ++bj) { const f32x4 g = acc[ai][bj][m][0] * r, up = acc[ai][bj][m][1] * r; float h[4];
#pragma unroll
                    for (int i = 0; i < 4; ++i) h[i] = g[i] * sigmoidf_(g[i]) * up[i];
                    typedef unsigned u32x2 __attribute__((ext_vector_type(2)));
                    u32x2 w; w.x = cvt_pk_bf16(h[0], h[1]); w.y = cvt_pk_bf16(h[2], h[3]);
                    *(u32x2*)(rowp + bj * (HALF / 2)) = w; } }
    }
};
struct EpiResN {
    static constexpr bool PERM = false, AFTER_DRAIN = false;
    const float* base; float* out; int ldc; bf16_t* XBo; float* rsq_out;
    __device__ __forceinline__ void operator()(const f32x4 (&acc)[2][2][4][2], const Unit& u, int wr, int wc, int fr, int fq) const {
        const int row0 = u.pm * BM + wr * 64 + fr, col0 = u.pn * BM + wc * 32 + 4 * fq;
#pragma unroll
        for (int ai = 0; ai < 2; ++ai)
#pragma unroll
            for (int m = 0; m < 4; ++m) { const int row = row0 + ai * HALF + m * 16; const size_t off = (size_t)row * ldc + col0; f32x4 x[2][2];
#pragma unroll
                for (int bj = 0; bj < 2; ++bj)
#pragma unroll
                    for (int n = 0; n < 2; ++n) { const f32x4 b = *(const f32x4*)(base + off + bj * HALF + n * 16); x[bj][n] = b + acc[ai][bj][m][n]; *(f32x4*)(out + off + bj * HALF + n * 16) = x[bj][n]; }
                if (XBo) norm_out(x, XBo, off, rsq_out, row, fq, u.pn * 4 + wc); }
    }
};
struct EpiPleN {
    static constexpr bool PERM = false, AFTER_DRAIN = false;
    const float* base; float* out; const bf16_t* E; int ldc; const float* rsq_in; bf16_t* XBo; float* rsq_out;
    __device__ __forceinline__ void operator()(const f32x4 (&acc)[2][2][4][2], const Unit& u, int wr, int wc, int fr, int fq) const {
        const int row0 = u.pm * BM + wr * 64 + fr, col0 = u.pn * BM + wc * 32 + 4 * fq;
        typedef unsigned u32x2 __attribute__((ext_vector_type(2)));
#pragma unroll
        for (int ai = 0; ai < 2; ++ai)
#pragma unroll
            for (int m = 0; m < 4; ++m) { const int row = row0 + ai * HALF + m * 16; const size_t off = (size_t)row * ldc + col0; const float r = rms_r(rsq_in, row); f32x4 x[2][2];
#pragma unroll
                for (int bj = 0; bj < 2; ++bj)
#pragma unroll
                    for (int n = 0; n < 2; ++n) { const size_t o = off + bj * HALF + n * 16; const f32x4 b = *(const f32x4*)(base + o); const u32x2 e = *(const u32x2*)(E + o); const f32x4 a = acc[ai][bj][m][n] * r;
                        f32x4 v; v[0] = b[0] + __uint_as_float(e.x << 16) * sigmoidf_(a[0]); v[1] = b[1] + __uint_as_float(e.x & 0xffff0000u) * sigmoidf_(a[1]);
                        v[2] = b[2] + __uint_as_float(e.y << 16) * sigmoidf_(a[2]); v[3] = b[3] + __uint_as_float(e.y & 0xffff0000u) * sigmoidf_(a[3]);
                        x[bj][n] = v; *(f32x4*)(out + o) = v; }
                if (XBo) norm_out(x, XBo, off, rsq_out, row, fq, u.pn * 4 + wc); }
    }
};
__device__ __forceinline__ f32x4 ld_base4(const float* p) { return *(const f32x4*)p; }
__device__ __forceinline__ f32x4 ld_base4(const bf16_t* p) { typedef unsigned u32x2 __attribute__((ext_vector_type(2))); const u32x2 e = *(const u32x2*)p; return (f32x4){__uint_as_float(e.x << 16), __uint_as_float(e.x & 0xffff0000u), __uint_as_float(e.y << 16), __uint_as_float(e.y & 0xffff0000u)}; }
template <class BaseT> struct EpiRes2 {
    static constexpr bool PERM = false, AFTER_DRAIN = false;
    const BaseT* base; bf16_t* out; int ldc; float* rsq_out;
    __device__ __forceinline__ void operator()(const f32x4 (&acc)[2][2][4][2], const Unit& u, int wr, int wc, int fr, int fq) const {
        const int row0 = u.pm * BM + wr * 64 + fr, col0 = u.pn * BM + wc * 32 + 4 * fq;
#pragma unroll
        for (int ai = 0; ai < 2; ++ai)
#pragma unroll
            for (int m = 0; m < 4; ++m) { const int row = row0 + ai * HALF + m * 16; const size_t off = (size_t)row * ldc + col0; f32x4 x[2][2];
#pragma unroll
                for (int bj = 0; bj < 2; ++bj)
#pragma unroll
                    for (int n = 0; n < 2; ++n) x[bj][n] = ld_base4(base + off + bj * HALF + n * 16) + acc[ai][bj][m][n];
                norm_out(x, out, off, rsq_out, row, fq, u.pn * 4 + wc); }
    }
};
template <bool OUT_F32> struct EpiPle2 {
    static constexpr bool PERM = false, AFTER_DRAIN = false;
    const bf16_t* base; void* out; const bf16_t* E; int ldc; const float* rsq_in; float* rsq_out;
    __device__ __forceinline__ void operator()(const f32x4 (&acc)[2][2][4][2], const Unit& u, int wr, int wc, int fr, int fq) const {
        const int row0 = u.pm * BM + wr * 64 + fr, col0 = u.pn * BM + wc * 32 + 4 * fq;
#pragma unroll
        for (int ai = 0; ai < 2; ++ai)
#pragma unroll
            for (int m = 0; m < 4; ++m) { const int row = row0 + ai * HALF + m * 16; const size_t off = (size_t)row * ldc + col0; const float r = rms_r(rsq_in, row); f32x4 x[2][2];
#pragma unroll
                for (int bj = 0; bj < 2; ++bj)
#pragma unroll
                    for (int n = 0; n < 2; ++n) { const size_t o = off + bj * HALF + n * 16; const f32x4 b = ld_base4(base + o), e = ld_base4(E + o), a = acc[ai][bj][m][n] * r; f32x4 v;
#pragma unroll
                        for (int i = 0; i < 4; ++i) v[i] = b[i] + e[i] * sigmoidf_(a[i]);
                        x[bj][n] = v; if (OUT_F32) *(f32x4*)((float*)out + o) = v; }
                if (!OUT_F32) norm_out(x, (bf16_t*)out, off, rsq_out, row, fq, u.pn * 4 + wc); }
    }
};
}
#ifndef PG8_SP2
#define PG8_SP2 true
#endif
#ifndef PG8_ALIGN
#define PG8_ALIGN true
#endif
constexpr int NB = 32, SEQ = 2048, T = NB * SEQ, D = 1024;
constexpr int NU = 2816, UA_W = 1024, UB_W = 1792;
constexpr int FF = 2816, CI = 2048, TH = T / 2;
constexpr int NWAVES = 8;
constexpr float NORM_EPS = 1e-6f, LOG2E = 1.4426950408889634f;
constexpr int UA_K = 512, UA_V = 576, UA_IQ = 640, UA_IK = 896, UA_IW = 960;
constexpr size_t MiB = 1u << 20, QMiB = 1u << 18;
constexpr size_t WS_CTL = 0, CTL_ZERO_BYTES = 1 * MiB;
constexpr size_t WS_WIN = 4 * QMiB, WS_WLORA = 26 * QMiB, WS_WOUT = 29 * QMiB;
constexpr size_t WS_WGU0 = 37 * QMiB, WS_WD0 = 81 * QMiB, WS_WPLE0 = 103 * QMiB, WS_WPG0 = 105 * QMiB, WS_LAYER_STRIDE = 76 * QMiB;
constexpr size_t WS_WUP = 189 * QMiB, WS_WDOWN = 221 * QMiB, WS_W12 = 237 * QMiB;
static_assert(WS_WPG0 + 8 * QMiB == WS_WGU0 + WS_LAYER_STRIDE && WS_WPG0 + WS_LAYER_STRIDE + 8 * QMiB == WS_WUP && WS_W12 + QMiB <= 60 * MiB, "weight map");
constexpr size_t ACT = 60 * MiB;
constexpr size_t WS_XB = ACT, WS_UA = ACT + 128 * MiB, WS_UB = ACT + 256 * MiB, WS_LIN = ACT + 480 * MiB, WS_LOUT = ACT + 512 * MiB;
constexpr size_t WS_QN = ACT + 704 * MiB, WS_KN = ACT + 768 * MiB, WS_VT = ACT + 776 * MiB, WS_MASK = ACT + 784 * MiB;
constexpr size_t WS_XB2 = ACT + 768 * MiB;
constexpr size_t WS_H = ACT + 128 * MiB, WS_E = ACT + 480 * MiB, WS_PB = ACT + 896 * MiB;
constexpr size_t WS_XM = ACT, WS_Z = ACT + 128 * MiB, WS_XC = ACT + 256 * MiB, WS_Q = ACT + 384 * MiB, WS_K = ACT + 512 * MiB, WS_V = ACT + 640 * MiB;
constexpr size_t WS_RS = ACT + 928 * MiB, RS_ONE = (size_t)T * 16 * 4;
constexpr size_t WS_GI = ACT + 952 * MiB, WS_GA = WS_GI + 1 * MiB, WS_GAM = WS_GI + 2 * MiB, WS_GEM = WS_GI + 3 * MiB;
constexpr size_t WS_END = ACT + 956 * MiB;
static_assert(WS_END <= 1024 * MiB, "workspace");
constexpr int CW_TMO = 0, CW_BAR = 4096;
constexpr int LDS_BYTES = 155648;
constexpr int MISC_OFF = LDS_BYTES - 256;
#define GAS __attribute__((address_space(1)))
#define LAS __attribute__((address_space(3)))
typedef unsigned short bf16;
typedef unsigned v4u __attribute__((ext_vector_type(4)));
typedef unsigned v2u __attribute__((ext_vector_type(2)));
typedef float f32x4 __attribute__((ext_vector_type(4)));
typedef float f32x2 __attribute__((ext_vector_type(2)));
typedef float f32x8 __attribute__((ext_vector_type(8)));
typedef short bf16x8 __attribute__((ext_vector_type(8)));
typedef short s16x4 __attribute__((ext_vector_type(4)));
typedef GAS unsigned gu32;
#define RLX_AGENT __ATOMIC_RELAXED, __HIP_MEMORY_SCOPE_AGENT
#define LDS_WAIT() asm volatile("s_waitcnt lgkmcnt(0)" ::: "memory")
#define VM_WAIT() asm volatile("s_waitcnt vmcnt(0)" ::: "memory")
__device__ __forceinline__ unsigned f2bf(float f) { unsigned u = __builtin_bit_cast(unsigned, f); return (u + 0x7fffu + ((u >> 16) & 1u)) >> 16; }

#define XB_TMO      128
#define XB_XCNT(j)  (256  + 64 * (j))
#define XB_XSUB(j)  (1280 + 64 * (j))
#define XB_XGEN(j)  (2304 + 64 * (j))
#define XB_TOP      3328
#define XB_TOPGEN   3392
#define XCD_BAR_WORDS 3456
#define XB_SPIN_CAP (1u << 18)

__device__ __forceinline__ unsigned xb_ld(unsigned* p)              { return __hip_atomic_load(p, __ATOMIC_RELAXED, __HIP_MEMORY_SCOPE_AGENT); }
__device__ __forceinline__ unsigned xb_add(unsigned* p, unsigned v) { return __hip_atomic_fetch_add(p, v, __ATOMIC_RELAXED, __HIP_MEMORY_SCOPE_AGENT); }
__device__ __forceinline__ unsigned xb_xcc_id() { return (unsigned)__builtin_amdgcn_s_getreg((3 << 11) | 20) & 0xFu; }
#define XB_SPIN(cond, bar) do { unsigned _sp = 0; while (cond) { __builtin_amdgcn_s_sleep(1); \
    if ((++_sp & 255u) == 0u) { if (xb_ld(&(bar)[XB_TMO])) break; if (_sp > XB_SPIN_CAP) { atomicAdd(&(bar)[XB_TMO], 1u); break; } } } } while (0)

struct XcdBarrier {
    unsigned* bar; unsigned x;
    volatile LAS unsigned* st;
};

__device__ __forceinline__ XcdBarrier xcd_barrier_post(unsigned* bar, volatile LAS unsigned* st) {
    XcdBarrier b; b.bar = bar; b.x = xb_xcc_id(); b.st = st;
    if (threadIdx.x == 0) (void)xb_add(&bar[XB_XCNT(b.x)], 1u);
    return b;
}
__device__ __forceinline__ void xcd_barrier_complete(unsigned* bar, unsigned x, unsigned& nloc, unsigned& nx) {
    const unsigned G = gridDim.x * gridDim.y * gridDim.z;
    unsigned sum, cnt, mine, sp = 0u;
    for (;;) {
        sum = 0u; cnt = 0u; mine = 0u;
#pragma unroll
        for (unsigned j = 0; j < 16; ++j) { const unsigned c = xb_ld(&bar[XB_XCNT(j)]); sum += c; cnt += (c > 0u) ? 1u : 0u; mine = (j == x) ? c : mine; }
        if (sum == G) break;
        __builtin_amdgcn_s_sleep(1);
        if ((++sp & 255u) == 0u) { if (xb_ld(&bar[XB_TMO])) break; if (sp > XB_SPIN_CAP) { atomicAdd(&bar[XB_TMO], 1u); break; } }
    }
    nloc = mine > 0u ? mine : 1u; nx = cnt > 0u ? cnt : 1u;
}

__device__ __forceinline__ void xcd_barrier(const XcdBarrier& b) {
    asm volatile("s_waitcnt vmcnt(0)" ::: "memory");
    __syncthreads();
    if (threadIdx.x == 0) {
        unsigned* bar = b.bar;
        __builtin_amdgcn_s_waitcnt(0);
        unsigned nloc = b.st[0], nx = b.st[1];
        if (nloc == 0u) { xcd_barrier_complete(bar, b.x, nloc, nx); b.st[0] = nloc; b.st[1] = nx; }
        const unsigned old = xb_add(&bar[XB_XSUB(b.x)], 1u);
        const unsigned gen = old / nloc;
        if (old + 1u == (gen + 1u) * nloc) {
            __builtin_amdgcn_fence(__ATOMIC_RELEASE, "agent");
            asm volatile("s_waitcnt vmcnt(0)" ::: "memory");
            const unsigned og = xb_add(&bar[XB_TOP], 1u);
            const unsigned tg = og / nx;
            if (og + 1u == (tg + 1u) * nx) xb_add(&bar[XB_TOPGEN], 1u);
            else XB_SPIN(xb_ld(&bar[XB_TOPGEN]) == tg, bar);
            __builtin_amdgcn_fence(__ATOMIC_ACQUIRE, "agent");
            xb_add(&bar[XB_XGEN(b.x)], 1u);
            asm volatile("s_waitcnt vmcnt(0)" ::: "memory");
        } else {
            XB_SPIN(xb_ld(&bar[XB_XGEN(b.x)]) == gen, bar);
            __builtin_amdgcn_fence(__ATOMIC_ACQUIRE, "agent");
            asm volatile("s_waitcnt vmcnt(0)" ::: "memory");
        }
    }
    __syncthreads();
}

struct Frame {
    LAS unsigned char* lds;
    unsigned char* ws;
    const float* const* in;
    int tid, lane, wave, G, bid;
};
struct Args { const float* in[37]; float* out; unsigned char* ws; int ph_lo, ph_hi, use_bar, pad; };

__device__ __forceinline__ float wave_sum(float v) {
#pragma unroll
    for (int o = 1; o < 64; o <<= 1) v += __shfl_xor(v, o);
    return v;
}
__device__ __forceinline__ float wave_max(float v) {
#pragma unroll
    for (int o = 1; o < 64; o <<= 1) v = fmaxf(v, __shfl_xor(v, o));
    return v;
}
__device__ __forceinline__ float bflo(unsigned u) { return __uint_as_float(u << 16); }
__device__ __forceinline__ float bfhi(unsigned u) { return __uint_as_float(u & 0xffff0000u); }
__device__ __forceinline__ float bf1(bf16 h) { return __uint_as_float(((unsigned)h) << 16); }
__device__ __forceinline__ unsigned pk2(float lo, float hi) { return pg8::cvt_pk_bf16(lo, hi); }
__device__ __forceinline__ float sigm(float x) { return 1.0f / (1.0f + __expf(-x)); }
__device__ __forceinline__ float softplusf_(float x) { return fmaxf(x, 0.f) + log1pf(__expf(-fabsf(x))); }
__device__ __forceinline__ void unpack8(const v4u& r, float (&f)[8]) { f[0] = bflo(r.x); f[1] = bfhi(r.x); f[2] = bflo(r.y); f[3] = bfhi(r.y); f[4] = bflo(r.z); f[5] = bfhi(r.z); f[6] = bflo(r.w); f[7] = bfhi(r.w); }
__device__ __forceinline__ v4u pack8(const float (&f)[8]) { v4u o; o.x = pk2(f[0], f[1]); o.y = pk2(f[2], f[3]); o.z = pk2(f[4], f[5]); o.w = pk2(f[6], f[7]); return o; }

template <class Fn> __device__ __forceinline__ void wprep(bf16* dst, int N, int K, Fn f, int gt, int NT) {
    const int items = N * (K >> 3);
    for (int it = gt; it < items; it += NT) { const int n = it % N, k0 = (it / N) << 3; float v[8];
#pragma unroll
        for (int j = 0; j < 8; ++j) v[j] = f(k0 + j, n);
        *(v4u*)(dst + (size_t)n * K + k0) = pack8(v); }
}
__device__ __forceinline__ void phase_prologue(Frame& F, const Args& a) {
    const int gt = F.bid * 512 + F.tid, NT = F.G * 512; unsigned char* ws = F.ws;
    { const float* W = a.in[5]; const float* gn0 = a.in[2];
      wprep((bf16*)(ws + WS_WIN), NU, D, [=](int k, int n) { const int c = n < 964 ? n : (n < 1024 ? -1 : n - 60); return c < 0 ? 0.f : W[(size_t)k * 2756 + c] * gn0[k]; }, gt, NT); }
    { const float* w2 = a.in[8]; const float* a2 = a.in[10]; const float* g2 = a.in[11];
      wprep((bf16*)(ws + WS_WLORA), 1536, 256, [=](int k, int n) { if (n < 512) return k < 64 ? w2[k * 512 + n] : 0.f; if (n < 1024) return (k >= 64 && k < 128) ? a2[(k - 64) * 512 + n - 512] : 0.f; return k >= 128 ? g2[(k - 128) * 512 + n - 1024] : 0.f; }, gt, NT); }
    { const float* W = a.in[17]; wprep((bf16*)(ws + WS_WOUT), D, D, [=](int k, int n) { return W[(size_t)k * D + n]; }, gt, NT); }
    for (int L = 0; L < 2; ++L) {
        const float* wg = a.in[31] + (size_t)L * D * FF; const float* wu = a.in[32] + (size_t)L * D * FF; const float* wd = a.in[33] + (size_t)L * FF * D;
        const float* wp = a.in[34] + (size_t)L * 256 * D; const float* wpg = a.in[36] + (size_t)L * D * D; const float* gnf = a.in[30] + L * D; const float* gnp = a.in[35] + L * D;
        wprep((bf16*)(ws + WS_WGU0 + L * WS_LAYER_STRIDE), 2 * FF, D, [=](int k, int n) { const int hid = 16 * (n >> 5) + (n & 15); return ((n & 31) >= 16 ? wu : wg)[(size_t)k * FF + hid] * gnf[k]; }, gt, NT);
        wprep((bf16*)(ws + WS_WD0 + L * WS_LAYER_STRIDE), D, FF, [=](int k, int n) { return wd[(size_t)k * D + n]; }, gt, NT);
        wprep((bf16*)(ws + WS_WPLE0 + L * WS_LAYER_STRIDE), D, 256, [=](int k, int n) { return wp[(size_t)k * D + n]; }, gt, NT);
        wprep((bf16*)(ws + WS_WPG0 + L * WS_LAYER_STRIDE), D, D, [=](int k, int n) { return wpg[(size_t)k * D + n] * gnp[k]; }, gt, NT);
    }
    { const float* W = a.in[18]; const float* gn1 = a.in[2] + D; wprep((bf16*)(ws + WS_WUP), 2 * CI, D, [=](int k, int n) { return W[(size_t)k * (2 * CI) + n] * gn1[k]; }, gt, NT); }
    { const float* W = a.in[29]; wprep((bf16*)(ws + WS_WDOWN), D, CI, [=](int k, int n) { return W[(size_t)k * D + n]; }, gt, NT); }
    { const float* wq = a.in[21]; const float* wk = a.in[22]; const float* wv = a.in[23]; const float* wif = a.in[24]; float* W12 = (float*)(ws + WS_W12);
      for (int it = gt; it < 4096 * 8; it += NT) { const int o = it & 7, c = (it >> 3) & 2047, part = it >> 14, g = c >> 2, i = c & 3; float s = 0.f;
          if (part == 0) { for (int j = 0; j < 4; ++j) s += wq[(g * 4 + i) * 4 + j] * wif[(size_t)(4 * g + j) * 8 + o] + wk[(g * 4 + i) * 4 + j] * wif[(size_t)(2048 + 4 * g + j) * 8 + o]; }
          else { for (int j = 0; j < 4; ++j) s += wv[(g * 4 + i) * 4 + j] * wif[(size_t)(4096 + 4 * g + j) * 8 + o]; }
          W12[it] = s; } }
}
__device__ __forceinline__ void phase_norm(Frame& F, const float* src, const float* gain, bf16* dst, int nrows) {
    const int gw = F.bid * NWAVES + F.wave, NGW = F.G * NWAVES, lane = F.lane;
    f32x4 g[4];
#pragma unroll
    for (int j = 0; j < 4; ++j) g[j] = *((const f32x4*)gain + lane + 64 * j);
    for (int m = gw; m < nrows; m += NGW) {
        const f32x4* xr = (const f32x4*)(src + (size_t)m * D) + lane; f32x4 v[4]; float s = 0.f;
#pragma unroll
        for (int j = 0; j < 4; ++j) { v[j] = xr[64 * j]; s += (v[j].x * v[j].x + v[j].y * v[j].y) + (v[j].z * v[j].z + v[j].w * v[j].w); }
        const float r = rsqrtf(wave_sum(s) * (1.f / D) + NORM_EPS);
        v2u* o = (v2u*)(dst + (size_t)m * D) + lane;
#pragma unroll
        for (int j = 0; j < 4; ++j) { v2u w; w.x = pk2(v[j].x * r * g[j].x, v[j].y * r * g[j].y); w.y = pk2(v[j].z * r * g[j].z, v[j].w * r * g[j].w); o[64 * j] = w; }
    }
}
__device__ __forceinline__ void phase_cast_sq(Frame& F, const float* src, bf16* dst, float* rsq, int nrows) {
    const int gw = F.bid * NWAVES + F.wave, NGW = F.G * NWAVES, lane = F.lane;
    for (int m = gw; m < nrows; m += NGW) {
        const f32x4* xr = (const f32x4*)(src + (size_t)m * D) + lane; f32x4 v[4]; float s = 0.f;
#pragma unroll
        for (int j = 0; j < 4; ++j) { v[j] = xr[64 * j]; s += (v[j].x * v[j].x + v[j].y * v[j].y) + (v[j].z * v[j].z + v[j].w * v[j].w); }
        s = wave_sum(s); if (lane < 16) rsq[(size_t)m * 16 + lane] = lane == 0 ? s : 0.f;
        v2u* o = (v2u*)(dst + (size_t)m * D) + lane;
#pragma unroll
        for (int j = 0; j < 4; ++j) { v2u w; w.x = pk2(v[j].x, v[j].y); w.y = pk2(v[j].z, v[j].w); o[64 * j] = w; }
    }
}
__device__ __forceinline__ void phase_cvt_p(Frame& F, const float* p, bf16* pb) {
    const size_t gt = (size_t)F.bid * 512 + F.tid, NT = (size_t)F.G * 512, n8 = (size_t)T * 256 / 8;
    for (size_t i0 = gt; i0 < n8; i0 += 4 * NT) { f32x4 a[4], b[4];
#pragma unroll
        for (int q4 = 0; q4 < 4; ++q4) { const size_t i = i0 + q4 * NT; if (i < n8) { a[q4] = *((const f32x4*)p + 2 * i); b[q4] = *((const f32x4*)p + 2 * i + 1); } }
#pragma unroll
        for (int q4 = 0; q4 < 4; ++q4) { const size_t i = i0 + q4 * NT; if (i < n8) { v4u o; o.x = pk2(a[q4].x, a[q4].y); o.y = pk2(a[q4].z, a[q4].w); o.z = pk2(b[q4].x, b[q4].y); o.w = pk2(b[q4].z, b[q4].w); *((v4u*)pb + i) = o; } } }
}
constexpr float QSCALE = 0.125f * LOG2E;
__device__ __forceinline__ void phase_prepA(Frame& F, const Args& a) {
    unsigned char* ws = F.ws; const bf16* UA = (const bf16*)(ws + WS_UA); const bf16* UB = (const bf16*)(ws + WS_UB);
    bf16* LIN = (bf16*)(ws + WS_LIN); bf16* QN = (bf16*)(ws + WS_QN); bf16* KN = (bf16*)(ws + WS_KN); bf16* VT = (bf16*)(ws + WS_VT);
    const float* mu = a.in[6]; const float* gq = a.in[3]; const float* gk = a.in[4];
    { const int gt = F.bid * 512 + F.tid, NT = F.G * 512; const int c8 = (gt & 31) << 3; float muv[8];
#pragma unroll
      for (int j = 0; j < 8; ++j) muv[j] = mu[1536 + c8 + j];
      for (int it0 = gt; it0 < T * 32; it0 += 4 * NT) { v4u ru[4], rp[4];
#pragma unroll
          for (int q4 = 0; q4 < 4; ++q4) { const int it = it0 + q4 * NT; if (it < T * 32) { const int t = it >> 5; ru[q4] = *(const v4u*)(UB + (size_t)t * UB_W + 1536 + c8); rp[q4] = *(const v4u*)(UB + (size_t)((t & (SEQ - 1)) ? t - 1 : t) * UB_W + 1536 + c8); } }
#pragma unroll
          for (int q4 = 0; q4 < 4; ++q4) { const int it = it0 + q4 * NT; if (it < T * 32) { const int t = it >> 5; float u[8], p[8], o[8]; unpack8(ru[q4], u); unpack8(rp[q4], p); const float pm = (t & (SEQ - 1)) ? 1.f : 0.f;
#pragma unroll
              for (int j = 0; j < 8; ++j) { const float s = u[j] + muv[j] * (p[j] * pm - u[j]); o[j] = c8 < 64 ? tanhf(s) : (c8 < 128 ? s : sigm(s)); }
              *(v4u*)(LIN + (size_t)t * 256 + c8) = pack8(o); } } } }
    { const int gw = F.bid * NWAVES + F.wave, NGW = F.G * NWAVES, lane = F.lane; float gqv[8], gkv[8];
#pragma unroll
      for (int j = 0; j < 8; ++j) { gqv[j] = gq[((lane & 7) << 3) + j] * QSCALE; gkv[j] = gk[((lane & 7) << 3) + j]; }
      for (int t0 = gw; t0 < T; t0 += 4 * NGW) { v4u rq[4], rk[4];
#pragma unroll
          for (int q4 = 0; q4 < 4; ++q4) { const int t = t0 + q4 * NGW; if (t < T) { rq[q4] = *(const v4u*)(UA + (size_t)t * UA_W + 8 * lane); rk[q4] = *(const v4u*)(UA + (size_t)t * UA_W + UA_K + 8 * (lane & 7)); } }
#pragma unroll
          for (int q4 = 0; q4 < 4; ++q4) { const int t = t0 + q4 * NGW; if (t < T) {
              float q[8], k[8]; unpack8(rq[q4], q); unpack8(rk[q4], k);
              float sq = 0.f, sk = 0.f;
#pragma unroll
              for (int j = 0; j < 8; ++j) { sq += q[j] * q[j]; sk += k[j] * k[j]; }
              sq += __shfl_xor(sq, 1); sq += __shfl_xor(sq, 2); sq += __shfl_xor(sq, 4); sk += __shfl_xor(sk, 1); sk += __shfl_xor(sk, 2); sk += __shfl_xor(sk, 4);
              const float rq_ = rsqrtf(sq * (1.f / 64.f) + NORM_EPS), rk_ = rsqrtf(sk * (1.f / 64.f) + NORM_EPS);
#pragma unroll
              for (int j = 0; j < 8; ++j) { q[j] *= rq_ * gqv[j]; k[j] *= rk_ * gkv[j]; }
              *(v4u*)(QN + (size_t)t * 512 + 8 * lane) = pack8(q);
              if (lane < 8) *(v4u*)(KN + (size_t)t * 64 + 8 * lane) = pack8(k); } } } }
    { const int gt = F.bid * 512 + F.tid, NT = F.G * 512;
      for (int it = gt; it < T * 8; it += NT) { const int t = it >> 3, c8 = (it & 7) << 3; *(v4u*)(VT + (size_t)t * 64 + c8) = *(const v4u*)(UA + (size_t)t * UA_W + UA_V + c8); } }
}
constexpr int IDX_STRIDE = 2052, KSEL = 256;
__device__ __forceinline__ void topk_select(const LAS float* row, int limit, unsigned* maskrow, int lane) {
    unsigned long long mybits = 0ull; const int nj = limit >> 6;
    if (limit <= KSEL) { mybits = lane < nj ? ~0ull : 0ull; }
    else {
        unsigned key[32];
#pragma unroll
        for (int j = 0; j < 32; ++j) { unsigned k = 0u; if (j < nj) { unsigned u = __float_as_uint(row[64 * j + lane]); if (u == 0x80000000u) u = 0u; k = (u & 0x80000000u) ? ~u : (u | 0x80000000u); } key[j] = k; }
        unsigned prefix = 0u; bool exact = false;
        for (int bit = 31; bit >= 0; --bit) { const unsigned cand = prefix | (1u << bit); int cnt = 0;
#pragma unroll
            for (int g8 = 0; g8 < 4; ++g8) if (8 * g8 < nj) {
#pragma unroll
                for (int jj = 0; jj < 8; ++jj) cnt += __builtin_popcountll(__ballot(key[8 * g8 + jj] >= cand)); }
            if (cnt >= KSEL) { prefix = cand; if (cnt == KSEL) { exact = true; break; } } }
        int need = 0;
        if (!exact) { int cgt = 0;
#pragma unroll
            for (int j = 0; j < 32; ++j) cgt += __builtin_popcountll(__ballot(key[j] > prefix));
            need = KSEL - cgt; }
        int running = 0; const unsigned long long below = (1ull << lane) - 1ull;
#pragma unroll
        for (int j = 0; j < 32; ++j) if (j < nj) {
            const bool gt = exact ? (key[j] >= prefix) : (key[j] > prefix); const bool tie = (!exact) && key[j] == prefix;
            const unsigned long long tb = __ballot(tie); const int rank = running + __builtin_popcountll(tb & below); running += __builtin_popcountll(tb);
            const unsigned long long sb = __ballot(gt || (tie && rank < need)); if (lane == j) mybits = sb; }
    }
    if (lane < 32) { v2u w; w.x = (unsigned)mybits; w.y = (unsigned)(mybits >> 32); *(v2u*)(maskrow + 2 * lane) = w; }
}
__device__ __forceinline__ void phase_indexer(Frame& F) {
    unsigned char* ws = F.ws; const bf16* UA = (const bf16*)(ws + WS_UA); unsigned* MASK = (unsigned*)(ws + WS_MASK);
    LAS float* sc = (LAS float*)F.lds; const int lane = F.lane, w = F.wave, fr = lane & 15, fq = lane >> 4;
    for (int r = 0;; ++r) { const int u = r * F.G + ((r & 1) ? (F.G - 1 - F.bid) : F.bid); if (u >= NB * 128) break;
        const int c = 31 - (u >> 7), rest = u & 127, b = rest >> 2, g4 = rest & 3, limit = 64 * (c + 1), tq0 = b * SEQ + c * 64 + g4 * 16;
        const bf16* UAb = UA + (size_t)b * SEQ * UA_W;
        bf16x8 qf[4][2]; float iwv[4];
        { const bf16* qp = UA + (size_t)(tq0 + fr) * UA_W;
#pragma unroll
          for (int hh = 0; hh < 4; ++hh) { qf[hh][0] = *(const bf16x8*)(qp + UA_IQ + hh * 64 + fq * 8); qf[hh][1] = *(const bf16x8*)(qp + UA_IQ + hh * 64 + 32 + fq * 8); iwv[hh] = bf1(qp[UA_IW + hh]) * (1.f / 16.f); } }
#ifndef IDX_SCORE_REP
#define IDX_SCORE_REP 1
#endif
#ifndef IDX_SEL_REP
#define IDX_SEL_REP 1
#endif
        for (int rp_ = 0; rp_ < IDX_SCORE_REP; ++rp_)
        for (int kt = w; kt < (limit >> 4); kt += NWAVES) {
            const bf16* kp = UAb + (size_t)(kt * 16 + fr) * UA_W + UA_IK + fq * 8; const bf16x8 a0 = *(const bf16x8*)kp, a1 = *(const bf16x8*)(kp + 32);
            f32x4 s = {0.f, 0.f, 0.f, 0.f};
#pragma unroll
            for (int hh = 0; hh < 4; ++hh) { f32x4 d = {0.f, 0.f, 0.f, 0.f}; d = __builtin_amdgcn_mfma_f32_16x16x32_bf16(a0, qf[hh][0], d, 0, 0, 0); d = __builtin_amdgcn_mfma_f32_16x16x32_bf16(a1, qf[hh][1], d, 0, 0, 0);
#pragma unroll
                for (int j = 0; j < 4; ++j) s[j] += iwv[hh] * fmaxf(d[j], 0.f); }
            *(LAS f32x4*)(sc + fr * IDX_STRIDE + kt * 16 + fq * 4) = s; }
        __syncthreads();
#pragma unroll 1
        for (int qq = 0; qq < 2 * IDX_SEL_REP; ++qq) { const int q = 2 * w + (qq & 1); topk_select(sc + q * IDX_STRIDE, limit, MASK + (size_t)(tq0 + q) * 64, lane); }
        __syncthreads(); }
}
constexpr int DA_K = 0, DA_V = 8192, DA_M = 16384, DA_STAGE = 16384 + 512;
__device__ __forceinline__ bf16x8 mk8(v2u lo, v2u hi) { v4u t; t.x = lo.x; t.y = lo.y; t.z = hi.x; t.w = hi.y; return __builtin_bit_cast(bf16x8, t); }
__device__ __forceinline__ void tr_read_v4d(unsigned a, bf16x8 (&vf)[4]) { s16x4 l0, h0, l1, h1, l2, h2, l3, h3;
    asm volatile("ds_read_b64_tr_b16 %0, %8\n\tds_read_b64_tr_b16 %1, %8 offset:512\n\tds_read_b64_tr_b16 %2, %8 offset:32\n\tds_read_b64_tr_b16 %3, %8 offset:544\n\t"
                 "ds_read_b64_tr_b16 %4, %8 offset:64\n\tds_read_b64_tr_b16 %5, %8 offset:576\n\tds_read_b64_tr_b16 %6, %8 offset:96\n\tds_read_b64_tr_b16 %7, %8 offset:608\n\ts_waitcnt lgkmcnt(0)"
                 : "=&v"(l0), "=&v"(h0), "=&v"(l1), "=&v"(h1), "=&v"(l2), "=&v"(h2), "=&v"(l3), "=&v"(h3) : "v"(a) : "memory");
    vf[0] = (bf16x8){l0[0], l0[1], l0[2], l0[3], h0[0], h0[1], h0[2], h0[3]}; vf[1] = (bf16x8){l1[0], l1[1], l1[2], l1[3], h1[0], h1[1], h1[2], h1[3]};
    vf[2] = (bf16x8){l2[0], l2[1], l2[2], l2[3], h2[0], h2[1], h2[2], h2[3]}; vf[3] = (bf16x8){l3[0], l3[1], l3[2], l3[3], h3[0], h3[1], h3[2], h3[3]}; }
__device__ __forceinline__ void phase_dsa_attn(Frame& F, const Args& a) {
    unsigned char* ws = F.ws; const bf16* QN = (const bf16*)(ws + WS_QN); const bf16* KN = (const bf16*)(ws + WS_KN); const bf16* VN = (const bf16*)(ws + WS_VT);
    const unsigned* MASK = (const unsigned*)(ws + WS_MASK); bf16* MIX = (bf16*)(ws + WS_XB);
    const int lane = F.lane, w = F.wave, fr = lane & 15, fq = lane >> 4; LAS unsigned char* lds = F.lds;
    const float mb = 8.f * LOG2E * wave_max(fabsf(a.in[3][lane])) * wave_max(fabsf(a.in[4][lane]));
    const unsigned vtr_lane = (unsigned)((8 * fq + ((lane & 15) >> 2)) * 128 + 4 * (lane & 3) * 2);
    for (int r = 0;; ++r) { const int u = r * F.G + ((r & 1) ? (F.G - 1 - F.bid) : F.bid); if (u >= NB * 32) break;
        const int c = 31 - (u >> 5), b = u & 31, nst = c + 1, t0 = b * SEQ + 64 * c;
        const bf16* Kb = KN + (size_t)b * SEQ * 64; const bf16* Vb = VN + (size_t)b * SEQ * 64; const unsigned* Mb = MASK + (size_t)t0 * 64;
#define DA_DMA(st_, buf_) do { const int so_ = (buf_) * DA_STAGE; \
            __builtin_amdgcn_global_load_lds((const unsigned*)(Kb + (size_t)(64 * (st_) + 8 * w) * 64 + lane * 8), (LAS unsigned*)(lds + so_ + DA_K + w * 1024), 16, 0, 0); \
            __builtin_amdgcn_global_load_lds((const unsigned*)(Vb + (size_t)(64 * (st_) + 8 * w) * 64 + lane * 8), (LAS unsigned*)(lds + so_ + DA_V + w * 1024), 16, 0, 0); \
            if (w < 2) __builtin_amdgcn_global_load_lds(Mb + (size_t)lane * 64 + 2 * (st_) + w, (LAS unsigned*)(lds + so_ + DA_M + w * 256), 4, 0, 0); } while (0)
        DA_DMA(0, 0);
        bf16x8 qf[4][2];
#pragma unroll
        for (int i = 0; i < 4; ++i) { const bf16* qp = QN + (size_t)(t0 + 16 * i + fr) * 512 + w * 64 + fq * 8; qf[i][0] = *(const bf16x8*)qp; qf[i][1] = *(const bf16x8*)(qp + 32); }
        f32x4 O[4][4]; float l[4];
#pragma unroll
        for (int i = 0; i < 4; ++i) { l[i] = 0.f;
#pragma unroll
            for (int dt = 0; dt < 4; ++dt) O[i][dt] = (f32x4){0.f, 0.f, 0.f, 0.f}; }
        for (int st = 0; st < nst; ++st) { const int buf = st & 1; const LAS unsigned char* sb = lds + buf * DA_STAGE;
            asm volatile("s_waitcnt vmcnt(0)" ::: "memory");
            __builtin_amdgcn_s_barrier(); asm volatile("" ::: "memory");
            if (st + 1 < nst) DA_DMA(st + 1, buf ^ 1);
#pragma unroll
            for (int sub = 0; sub < 2; ++sub) {
                bf16x8 kf[2][2], vf[4]; unsigned mw[4];
#pragma unroll
                for (int s2 = 0; s2 < 2; ++s2) { const LAS unsigned char* kp = sb + DA_K + (32 * sub + 8 * (fr >> 2) + 4 * s2 + (fr & 3)) * 128 + fq * 16;   kf[s2][0] = *(const LAS bf16x8*)kp; kf[s2][1] = *(const LAS bf16x8*)(kp + 64); }
#pragma unroll
                for (int i = 0; i < 4; ++i) mw[i] = *(const LAS unsigned*)(sb + DA_M + sub * 256 + (16 * i + fr) * 4);
                tr_read_v4d((unsigned)(size_t)(sb + DA_V + sub * 4096) + vtr_lane, vf);
#pragma unroll
                for (int i = 0; i < 4; ++i) {
                    f32x4 s0 = {0.f, 0.f, 0.f, 0.f}, s1 = {0.f, 0.f, 0.f, 0.f};
                    s0 = __builtin_amdgcn_mfma_f32_16x16x32_bf16(kf[0][0], qf[i][0], s0, 0, 0, 0); s0 = __builtin_amdgcn_mfma_f32_16x16x32_bf16(kf[0][1], qf[i][1], s0, 0, 0, 0);
                    s1 = __builtin_amdgcn_mfma_f32_16x16x32_bf16(kf[1][0], qf[i][0], s1, 0, 0, 0); s1 = __builtin_amdgcn_mfma_f32_16x16x32_bf16(kf[1][1], qf[i][1], s1, 0, 0, 0);
                    const unsigned b0 = mw[i] >> (8 * fq), b1 = mw[i] >> (8 * fq + 4); float p[8];
#pragma unroll
                    for (int j = 0; j < 4; ++j) { p[j] = ((b0 >> j) & 1u) ? __builtin_amdgcn_exp2f(s0[j] - mb) : 0.f; p[4 + j] = ((b1 >> j) & 1u) ? __builtin_amdgcn_exp2f(s1[j] - mb) : 0.f; }
                    l[i] += ((p[0] + p[1]) + (p[2] + p[3])) + ((p[4] + p[5]) + (p[6] + p[7]));
                    const bf16x8 pa = __builtin_bit_cast(bf16x8, pack8(p));
#pragma unroll
                    for (int dt = 0; dt < 4; ++dt) O[i][dt] = __builtin_amdgcn_mfma_f32_16x16x32_bf16(pa, vf[dt], O[i][dt], 0, 0, 0);
                } } }
#undef DA_DMA
#pragma unroll
        for (int i = 0; i < 4; ++i) { float li = l[i]; li += __shfl_xor(li, 16); li += __shfl_xor(li, 32);
#pragma unroll
            for (int j = 0; j < 4; ++j) { const float inv = 1.0f / __shfl(li, 4 * fq + j); bf16* op = MIX + (size_t)(t0 + 16 * i + 4 * fq + j) * D + w * 64 + fr;
#pragma unroll
                for (int dt = 0; dt < 4; ++dt) op[16 * dt] = (bf16)f2bf(O[i][dt][j] * inv); } }
        VM_WAIT(); __syncthreads();
    }
}
#define DPPQ(q) "quad_perm:[" #q "," #q "," #q "," #q "] row_mask:0xf bank_mask:0xf"
#define DPP_MUL(d, a, b, q) asm("v_mul_f32_dpp %0, %1, %2 " DPPQ(q) : "=v"(d) : "v"(a), "v"(b))
#define DPP_FMAC(d, a, b, q) asm("v_fmac_f32_dpp %0, %1, %2 " DPPQ(q) : "+v"(d) : "v"(a), "v"(b))
__device__ __forceinline__ void phase_rwkv(Frame& F, const Args& a) {
    unsigned char* ws = F.ws; const bf16* UB = (const bf16*)(ws + WS_UB); const bf16* LOUT = (const bf16*)(ws + WS_LOUT); bf16* MIX = (bf16*)(ws + WS_XB);
    const float* mu = a.in[6]; const float* w0 = a.in[7]; const float* a0 = a.in[9]; const float* k_k = a.in[12]; const float* k_a = a.in[13]; const float* r_k = a.in[14]; const float* gn_g = a.in[15]; const float* gn_b = a.in[16];
    const int lane = F.lane, w = F.wave;
    LAS float* vecs = (LAS float*)F.lds;
    LAS float* vx_s = vecs + 5 * 4096;
    LAS float* g_s = vx_s + 4096;
    LAS float* yacc = g_s + 4096;
    LAS float* bonus_s = yacc + 4096;
    LAS float* c1_s = bonus_s + 64;
    LAS float* c2_s = c1_s + 64;
    LAS float* part = c2_s + 64;
    for (int bh = F.bid; bh < NB * 8; bh += F.G) {
        const int b = bh >> 3, h = bh & 7, c = h * 64 + lane;
        const float mur = mu[c], muk = mu[512 + c], muv = mu[1024 + c], w0c = w0[c], a0c = a0[c], kkc = k_k[c], kac = k_a[c], rkc = r_k[c], gng = gn_g[c], gnb = gn_b[c];
        float S[8];
#pragma unroll
        for (int j = 0; j < 8; ++j) S[j] = 0.f;
        float r_ur[8], r_uk[8], r_uv[8], r_pr[8], r_pk[8], r_pv[8], r_wd[8], r_ad[8], r_gg[8];
#define RW_RAW(batch_) do { _Pragma("unroll") for (int i = 0; i < 8; ++i) { const int sl = (batch_) * 64 + 2 * (w + 8 * (i >> 1)) + (i & 1); const size_t t = (size_t)b * SEQ + sl; const bf16* up = UB + t * UB_W + c; const bf16* pp_ = sl > 0 ? up - UB_W : up; \
            r_ur[i] = bf1(up[0]); r_uk[i] = bf1(up[512]); r_uv[i] = bf1(up[1024]); r_pr[i] = bf1(pp_[0]); r_pk[i] = bf1(pp_[512]); r_pv[i] = bf1(pp_[1024]); \
            const bf16* lp = LOUT + t * 1536 + c; r_wd[i] = bf1(lp[0]); r_ad[i] = bf1(lp[512]); r_gg[i] = bf1(lp[1024]); } } while (0)
        RW_RAW(0);
        for (int batch = 0; batch < SEQ / 64; ++batch) {
            float pdecay = 0.f, pbb = 0.f, pkm = 0.f;
#pragma unroll
            for (int i = 0; i < 8; ++i) { const int step = 2 * (w + 8 * (i >> 1)) + (i & 1), sl = batch * 64 + step; const float pm = sl > 0 ? 1.f : 0.f;
                const float ur = r_ur[i], uk = r_uk[i], uv = r_uv[i], pr = r_pr[i] * pm, pk = r_pk[i] * pm, pv = r_pv[i] * pm;
                const float rr = ur + mur * (pr - ur), kx = uk + muk * (pk - uk), vx = uv + muv * (pv - uv);
                const float wd = r_wd[i], ad = r_ad[i], gg = r_gg[i];
                const float wraw = -softplusf_(-(w0c + wd)) - 0.5f, decay = __expf(-__expf(wraw)), av = sigm(a0c + ad);
                float kk = kx * kkc; const float nrm = sqrtf(wave_sum(kk * kk)); kk = kk / fmaxf(nrm, 1e-12f);
                const float km = kx * (1.f + (av - 1.f) * kac); const float bon = wave_sum(rr * km * rkc);
                LAS float* sp = vecs + step * 64 + lane; float nk = -kk;
                if (i & 1) { const float d1 = wave_sum(pbb * nk), d2 = wave_sum(pkm * nk); if (lane == 0) { c1_s[step] = d1; c2_s[step] = d2; } nk *= pdecay; }
                sp[0] = decay; sp[4096] = nk; sp[8192] = kk * av; sp[12288] = km; sp[16384] = rr;
                pdecay = decay; pbb = kk * av; pkm = km;
                vx_s[step * 64 + lane] = vx; g_s[step * 64 + lane] = gg; if (lane == 0) bonus_s[step] = bon; }
            if (batch + 1 < SEQ / 64) RW_RAW(batch + 1);
            LDS_WAIT(); __syncthreads();
            const LAS float* vq = vecs + 8 * w + (lane & 3);
#ifdef PROBE_BAR
#define PROBE_X __builtin_amdgcn_s_barrier(); asm volatile("" ::: "memory");
#else
#define PROBE_X
#endif
#ifdef PROBE_DPP
#define PROBE_Y(X) { float d0_ = dmy, d1_ = dmy; _Pragma("unroll") for (int r_ = 0; r_ < 5; ++r_) { DPP_FMAC(d0_, X[0], S[0], 0); DPP_FMAC(d1_, X[1], S[4], 0); DPP_FMAC(d0_, X[2], S[1], 1); DPP_FMAC(d1_, X[3], S[5], 1); DPP_FMAC(d0_, X[4], S[2], 2); DPP_FMAC(d1_, X[5], S[6], 2); DPP_FMAC(d0_, X[6], S[3], 3); DPP_FMAC(d1_, X[7], S[7], 3); } dmy = d0_ + d1_; }
#else
#define PROBE_Y(X)
#endif
#define RW_LOAD(X, step) do { const LAS float* q_ = vq + (step) * 64; X[0] = q_[0]; X[1] = q_[4]; X[2] = q_[4096]; X[3] = q_[4100]; X[4] = q_[8192]; X[5] = q_[8196]; X[6] = q_[12288]; X[7] = q_[12292]; X[8] = q_[16384]; X[9] = q_[16388]; X[10] = vx_s[(step) * 64 + lane]; } while (0)
#define RW_HALF(X, o, jb) do { float t_; \
                DPP_MUL(t_, X[6 + o], vv, 0); DPP_FMAC(t_, X[4 + o], sa, 0); DPP_FMAC(t_, X[0 + o], S[jb + 0], 0); S[jb + 0] = t_; \
                DPP_MUL(t_, X[6 + o], vv, 1); DPP_FMAC(t_, X[4 + o], sa, 1); DPP_FMAC(t_, X[0 + o], S[jb + 1], 1); S[jb + 1] = t_; \
                DPP_MUL(t_, X[6 + o], vv, 2); DPP_FMAC(t_, X[4 + o], sa, 2); DPP_FMAC(t_, X[0 + o], S[jb + 2], 2); S[jb + 2] = t_; \
                DPP_MUL(t_, X[6 + o], vv, 3); DPP_FMAC(t_, X[4 + o], sa, 3); DPP_FMAC(t_, X[0 + o], S[jb + 3], 3); S[jb + 3] = t_; } while (0)
#define RW_UPD(X, sa_, vv_) do { const float sa = (sa_), vv = (vv_); RW_HALF(X, 0, 0); RW_HALF(X, 1, 4); } while (0)
#define RW_Y(X, yv) do { float ya, yb; DPP_MUL(ya, X[8], S[0], 0); DPP_MUL(yb, X[9], S[4], 0); DPP_FMAC(ya, X[8], S[1], 1); DPP_FMAC(yb, X[9], S[5], 1); DPP_FMAC(ya, X[8], S[2], 2); DPP_FMAC(yb, X[9], S[6], 2); DPP_FMAC(ya, X[8], S[3], 3); DPP_FMAC(yb, X[9], S[7], 3); yv = ya + yb; } while (0)
#define RW_RD8(base_) (((base_)[0] + (base_)[64]) + ((base_)[128] + (base_)[192])) + (((base_)[256] + (base_)[320]) + ((base_)[384] + (base_)[448]))
#define RWKV_PAIR(X1, X2, Y1, Y2, pi) do { float pa, pb, qa, qb; \
                DPP_MUL(pa, X1[2], S[0], 0); DPP_MUL(pb, X1[3], S[4], 0); DPP_MUL(qa, X2[2], S[0], 0); DPP_MUL(qb, X2[3], S[4], 0); \
                DPP_FMAC(pa, X1[2], S[1], 1); DPP_FMAC(pb, X1[3], S[5], 1); DPP_FMAC(qa, X2[2], S[1], 1); DPP_FMAC(qb, X2[3], S[5], 1); \
                DPP_FMAC(pa, X1[2], S[2], 2); DPP_FMAC(pb, X1[3], S[6], 2); DPP_FMAC(qa, X2[2], S[2], 2); DPP_FMAC(qb, X2[3], S[6], 2); \
                DPP_FMAC(pa, X1[2], S[3], 3); DPP_FMAC(pb, X1[3], S[7], 3); DPP_FMAC(qa, X2[2], S[3], 3); DPP_FMAC(qb, X2[3], S[7], 3); \
                LAS float* pp = part + ((pi) & 1) * 2048 + lane; pp[w * 64] = pa + pb; pp[(8 + w) * 64] = qa + qb; pp[(16 + w) * 64] = yprev1; pp[(24 + w) * 64] = yprev2; \
                const float c1 = c1_s[2 * (pi) + 1], c2 = c2_s[2 * (pi) + 1]; \
                if ((pi) < 31) { RW_LOAD(Y1, 2 * (pi) + 2); RW_LOAD(Y2, 2 * (pi) + 3); } \
                LDS_WAIT(); __builtin_amdgcn_s_barrier(); asm volatile("" ::: "memory"); \
                const float sa1 = RW_RD8(pp); const float x2s = RW_RD8(pp + 512); \
                if ((pi) > 0 && w == (((pi) - 1) & 7)) { yacc[(2 * (pi) - 2) * 64 + lane] = RW_RD8(pp + 1024); yacc[(2 * (pi) - 1) * 64 + lane] = RW_RD8(pp + 1536); } \
                LDS_WAIT(); \
                const float sa2 = x2s + sa1 * c1 + X1[10] * c2; \
                RW_UPD(X1, sa1, X1[10]); RW_Y(X1, yprev1); RW_UPD(X2, sa2, X2[10]); RW_Y(X2, yprev2); } while (0)
#ifndef SCAN_REP
#define SCAN_REP 1
#endif
            { float XA1[11], XA2[11], XB1[11], XB2[11]; float yprev1 = 0.f, yprev2 = 0.f;
            RW_LOAD(XA1, 0); RW_LOAD(XA2, 1);
            for (int p2 = 0; p2 < 32; p2 += 2) {
                RWKV_PAIR(XA1, XA2, XB1, XB2, p2);
                RWKV_PAIR(XB1, XB2, XA1, XA2, p2 + 1);
            }
            { LAS float* pp = part + lane; pp[(16 + w) * 64] = yprev1; pp[(24 + w) * 64] = yprev2; LDS_WAIT(); __syncthreads();
              if (w == 7) { yacc[62 * 64 + lane] = RW_RD8(pp + 1024); yacc[63 * 64 + lane] = RW_RD8(pp + 1536); } }
            LDS_WAIT(); __syncthreads();
            }
            for (int i = 0; i < 8; ++i) { const int step = w + 8 * i; const size_t t = (size_t)b * SEQ + batch * 64 + step;
                const float y = yacc[step * 64 + lane], mean = wave_sum(y) * (1.f / 64.f), dlt = y - mean, var = wave_sum(dlt * dlt) * (1.f / 64.f);
                const float yn = dlt * rsqrtf(var + 64e-5f) * gng + gnb; const float o = (yn + bonus_s[step] * vx_s[step * 64 + lane]) * g_s[step * 64 + lane];
                MIX[t * D + 512 + c] = (bf16)f2bf(o); }
            LDS_WAIT(); __syncthreads();
        }
    }
}
__device__ __forceinline__ void phase_l1prep(Frame& F, const Args& a, int hb) {
    unsigned char* ws = F.ws; const bf16* XM = (const bf16*)(ws + WS_XM); bf16* XC = (bf16*)(ws + WS_XC); bf16* Q = (bf16*)(ws + WS_Q); bf16* K = (bf16*)(ws + WS_K); bf16* V = (bf16*)(ws + WS_V);
    float* GI = (float*)(ws + WS_GI); const float* W12 = (const float*)(ws + WS_W12);
    const float* cw = a.in[19]; const float* cb = a.in[20]; const float* wq = a.in[21]; const float* wk = a.in[22]; const float* wv = a.in[23]; const float* b_i = a.in[25]; const float* b_f = a.in[26];
    const int g = F.tid, lane = F.lane, w = F.wave; LAS float* red = (LAS float*)F.lds;
    float cwr[4][4], cbr[4], wqr[16], wkr[16], wvr[16], w1[32], w2[32];
#pragma unroll
    for (int j = 0; j < 4; ++j)
#pragma unroll
        for (int i = 0; i < 4; ++i) cwr[j][i] = cw[j * CI + 4 * g + i];
#pragma unroll
    for (int i = 0; i < 4; ++i) cbr[i] = cb[4 * g + i];
#pragma unroll
    for (int i = 0; i < 16; ++i) { wqr[i] = wq[g * 16 + i]; wkr[i] = wk[g * 16 + i]; wvr[i] = wv[g * 16 + i]; }
#pragma unroll
    for (int i = 0; i < 32; ++i) { w1[i] = W12[(size_t)(4 * g) * 8 + i]; w2[i] = W12[(size_t)(2048 + 4 * g) * 8 + i]; }
    const int per = TH / F.G;
    const int tb = F.bid * per;
    float x0[4], x1[4], x2[4];
    { const int sl = tb & (SEQ - 1);
#pragma unroll
      for (int i = 0; i < 4; ++i) { x0[i] = 0.f; x1[i] = 0.f; x2[i] = 0.f; }
      if (sl >= 1) { const v2u r = *(const v2u*)(XM + (size_t)(tb - 1) * CI + 4 * g); x2[0] = bflo(r.x); x2[1] = bfhi(r.x); x2[2] = bflo(r.y); x2[3] = bfhi(r.y); }
      if (sl >= 2) { const v2u r = *(const v2u*)(XM + (size_t)(tb - 2) * CI + 4 * g); x1[0] = bflo(r.x); x1[1] = bfhi(r.x); x1[2] = bflo(r.y); x1[3] = bfhi(r.y); }
      if (sl >= 3) { const v2u r = *(const v2u*)(XM + (size_t)(tb - 3) * CI + 4 * g); x0[0] = bflo(r.x); x0[1] = bfhi(r.x); x0[2] = bflo(r.y); x0[3] = bfhi(r.y); } }
    v2u xnext[2];
#pragma unroll
    for (int tk = 0; tk < 2; ++tk) xnext[tk] = *(const v2u*)(XM + (size_t)(tb + tk) * CI + 4 * g);
    for (int n4 = 0; n4 < per / 2; ++n4) { const int t4 = tb + 2 * n4;
        float gs[16]; v2u xr[2];
        xr[0] = xnext[0]; xr[1] = xnext[1];
        if (n4 + 1 < per / 2) {
#pragma unroll
            for (int tk = 0; tk < 2; ++tk) xnext[tk] = *(const v2u*)(XM + (size_t)(t4 + 2 + tk) * CI + 4 * g); }
#pragma unroll
        for (int tk = 0; tk < 2; ++tk) { const int t = t4 + tk;
            float x3[4]; x3[0] = bflo(xr[tk].x); x3[1] = bfhi(xr[tk].x); x3[2] = bflo(xr[tk].y); x3[3] = bfhi(xr[tk].y);
            float xc[4], q[4], k[4], v[4];
#pragma unroll
            for (int i = 0; i < 4; ++i) { const float s = cbr[i] + cwr[0][i] * x0[i] + cwr[1][i] * x1[i] + cwr[2][i] * x2[i] + cwr[3][i] * x3[i]; xc[i] = s * sigm(s); }
#pragma unroll
            for (int j = 0; j < 4; ++j) { q[j] = xc[0] * wqr[j] + xc[1] * wqr[4 + j] + xc[2] * wqr[8 + j] + xc[3] * wqr[12 + j]; k[j] = xc[0] * wkr[j] + xc[1] * wkr[4 + j] + xc[2] * wkr[8 + j] + xc[3] * wkr[12 + j];
                v[j] = x3[0] * wvr[j] + x3[1] * wvr[4 + j] + x3[2] * wvr[8 + j] + x3[3] * wvr[12 + j]; }
#pragma unroll
            for (int o = 0; o < 8; ++o) { float s = 0.f;
#pragma unroll
                for (int i = 0; i < 4; ++i) s += xc[i] * w1[i * 8 + o] + x3[i] * w2[i * 8 + o];
                gs[tk * 8 + o] = s; }
            const size_t off = (size_t)t * CI + 4 * g; const float ks = 0.044194173824159216f;
            { v2u o; o.x = pk2(xc[0], xc[1]); o.y = pk2(xc[2], xc[3]); *(v2u*)(XC + off) = o; o.x = pk2(q[0], q[1]); o.y = pk2(q[2], q[3]); *(v2u*)(Q + off) = o;
              o.x = pk2(k[0] * ks, k[1] * ks); o.y = pk2(k[2] * ks, k[3] * ks); *(v2u*)(K + off) = o; o.x = pk2(v[0], v[1]); o.y = pk2(v[2], v[3]); *(v2u*)(V + off) = o; }
#pragma unroll
            for (int i = 0; i < 4; ++i) { x0[i] = x1[i]; x1[i] = x2[i]; x2[i] = x3[i]; } }
#define L1_STAGE(mask, n) { const bool hi_ = (lane & (mask)) != 0; _Pragma("unroll") for (int i = 0; i < (n) / 2; ++i) { const float send_ = hi_ ? gs[i] : gs[(n) / 2 + i]; const float keep_ = hi_ ? gs[(n) / 2 + i] : gs[i]; gs[i] = keep_ + __shfl_xor(send_, (mask)); } }
        L1_STAGE(32, 16) L1_STAGE(16, 8) L1_STAGE(8, 4) L1_STAGE(4, 2)
#undef L1_STAGE
        gs[0] += __shfl_xor(gs[0], 2); gs[0] += __shfl_xor(gs[0], 1);
        LAS float* rp = red + (n4 & 1) * 128;
        if ((lane & 3) == 0) rp[w * 16 + (lane >> 2)] = gs[0];
        LDS_WAIT(); __syncthreads();
        if (F.tid < 16) { float s = 0.f;
#pragma unroll
            for (int ww = 0; ww < 8; ++ww) s += rp[ww * 16 + F.tid];
            const int o = F.tid & 7; GI[(size_t)(t4 + (F.tid >> 3)) * 8 + o] = s + (o < 4 ? b_i[o] : b_f[o - 4]); }
    }
}
__device__ __forceinline__ void phase_gatescan(Frame& F) {
    unsigned char* ws = F.ws; const float* GI = (const float*)(ws + WS_GI); float* GA = (float*)(ws + WS_GA); float* GAM = (float*)(ws + WS_GAM); float* GEM = (float*)(ws + WS_GEM);
    const int lane = F.lane, w = F.wave, tid = F.tid; LAS float* wtot = (LAS float*)F.lds;
    for (int sq = F.bid; sq < (NB / 2) * 4; sq += F.G) { const int bl = sq >> 2, h = sq & 3; const size_t tq = (size_t)bl * SEQ + 4 * tid;
        float ip[4], c[4];
#pragma unroll
        for (int k = 0; k < 4; ++k) { ip[k] = GI[(tq + k) * 8 + h]; c[k] = -softplusf_(-GI[(tq + k) * 8 + 4 + h]); }
        c[1] += c[0]; c[2] += c[1]; c[3] += c[2];
        float inc = c[3];
#pragma unroll
        for (int o = 1; o < 64; o <<= 1) { const float n = __shfl_up(inc, o); if (lane >= o) inc += n; }
        if (lane == 63) wtot[w] = inc;
        LDS_WAIT(); __syncthreads();
        float off = inc - c[3];
#pragma unroll
        for (int ww = 0; ww < 8; ++ww) if (ww < w) off += wtot[ww];
        float Fv[4], av[4], m[4];
#pragma unroll
        for (int k = 0; k < 4; ++k) { Fv[k] = off + c[k]; av[k] = ip[k] - Fv[k]; }
        m[0] = av[0]; m[1] = fmaxf(m[0], av[1]); m[2] = fmaxf(m[1], av[2]); m[3] = fmaxf(m[2], av[3]);
        float incm = m[3];
#pragma unroll
        for (int o = 1; o < 64; o <<= 1) { const float n = __shfl_up(incm, o); if (lane >= o) incm = fmaxf(incm, n); }
        if (lane == 63) wtot[8 + w] = incm;
        LDS_WAIT(); __syncthreads();
        float offm = __shfl_up(incm, 1); if (lane == 0) offm = -INFINITY;
#pragma unroll
        for (int ww = 0; ww < 8; ++ww) if (ww < w) offm = fmaxf(offm, wtot[8 + ww]);
#pragma unroll
        for (int k = 0; k < 4; ++k) { const float A = fmaxf(offm, m[k]); GA[(tq + k) * 4 + h] = av[k]; GAM[(tq + k) * 4 + h] = A; GEM[(tq + k) * 4 + h] = __expf(-(Fv[k] + A)); }
        LDS_WAIT(); __syncthreads();
    }
}
constexpr int ML_PITCH = 1040, ML_TILE = 32 * ML_PITCH, ML_PP = 80, ML_PT = 64 * ML_PP;
constexpr int ML_K = 0, ML_V = 2 * ML_TILE, ML_P = 4 * ML_TILE, ML_DEN = ML_P + 2 * ML_PT, ML_AT = ML_DEN + 512, ML_AS = ML_AT + 256, ML_END = ML_AS + 8192;
constexpr int ML_ST = ML_P, ML_MR = ML_P + 4096;
static_assert(ML_MR + 512 <= ML_DEN, "mLSTM LDS tables");
static_assert(ML_END <= MISC_OFF, "mLSTM LDS");
__device__ __forceinline__ void tr_read_v4(unsigned a, bf16x8 (&vf)[4]) { s16x4 l0, h0, l1, h1, l2, h2, l3, h3;
    asm volatile("ds_read_b64_tr_b16 %0, %8\n\tds_read_b64_tr_b16 %1, %8 offset:4160\n\tds_read_b64_tr_b16 %2, %8 offset:32\n\tds_read_b64_tr_b16 %3, %8 offset:4192\n\t"
                 "ds_read_b64_tr_b16 %4, %8 offset:64\n\tds_read_b64_tr_b16 %5, %8 offset:4224\n\tds_read_b64_tr_b16 %6, %8 offset:96\n\tds_read_b64_tr_b16 %7, %8 offset:4256\n\ts_waitcnt lgkmcnt(0)"
                 : "=&v"(l0), "=&v"(h0), "=&v"(l1), "=&v"(h1), "=&v"(l2), "=&v"(h2), "=&v"(l3), "=&v"(h3) : "v"(a) : "memory");
    vf[0] = (bf16x8){l0[0], l0[1], l0[2], l0[3], h0[0], h0[1], h0[2], h0[3]}; vf[1] = (bf16x8){l1[0], l1[1], l1[2], l1[3], h1[0], h1[1], h1[2], h1[3]};
    vf[2] = (bf16x8){l2[0], l2[1], l2[2], l2[3], h2[0], h2[1], h2[2], h2[3]}; vf[3] = (bf16x8){l3[0], l3[1], l3[2], l3[3], h3[0], h3[1], h3[2], h3[3]}; }
static_assert(4 * ML_PITCH == 4160, "tr_read_v4 offsets");
__device__ __forceinline__ void phase_mlstm(Frame& F, const Args& a) {
    unsigned char* ws = F.ws; const bf16* Q = (const bf16*)(ws + WS_Q); const bf16* K = (const bf16*)(ws + WS_K); const bf16* V = (const bf16*)(ws + WS_V); const bf16* XC = (const bf16*)(ws + WS_XC); const bf16* Z = (const bf16*)(ws + WS_Z);
    bf16* YC = (bf16*)(ws + WS_XM); const float* GA = (const float*)(ws + WS_GA); const float* GAM = (const float*)(ws + WS_GAM); const float* GEM = (const float*)(ws + WS_GEM);
    const float* mh_g = a.in[27]; const float* skip = a.in[28];
    const int tid = F.tid, lane = F.lane, w = F.wave, fr = lane & 15, fq = lane >> 4; LAS unsigned char* lds = F.lds;
    LAS float* den2 = (LAS float*)(lds + ML_DEN); LAS float* stats = (LAS float*)(lds + ML_ST); LAS float* mr = (LAS float*)(lds + ML_MR); LAS float* em_s = (LAS float*)(lds + ML_AT); LAS float* as_s = (LAS float*)(lds + ML_AS);
    const int tt = w >> 1, st = w & 1;
    const unsigned vtr_lane = (unsigned)((8 * fq + ((lane & 15) >> 2)) * ML_PITCH + (64 * w + 4 * (lane & 3)) * 2);
#define ML_DMA(gbase, tile_off) do { _Pragma("unroll") for (int r4 = 0; r4 < 4; ++r4) { const int rr = w + 8 * r4; \
        __builtin_amdgcn_global_load_lds((const unsigned*)((gbase) + (size_t)rr * CI + lane * 8), (LAS unsigned*)(lds + (tile_off) + rr * ML_PITCH), 16, 0, 0); } } while (0)
    for (int r = 0; r < 8; ++r) { const int xcd = F.bid & 7, cq = F.bid >> 3; if (F.G != 256) break;
        const int qi = (r & 1) ? 31 - cq : cq, bh = xcd + 8 * r, bl = bh >> 2, h = bh & 3; const size_t t0 = (size_t)bl * SEQ + 64 * qi; const int nk = 2 * (qi + 1);
        const bf16* Kb = K + (size_t)bl * SEQ * CI + h * 512; const bf16* Vb = V + (size_t)bl * SEQ * CI + h * 512;
        ML_DMA(Kb, ML_K); ML_DMA(Vb, ML_V);
        bf16x8 qf[16];
        { const bf16* qp = Q + (t0 + 16 * tt + fr) * CI + h * 512 + fq * 8;
#pragma unroll
          for (int ks = 0; ks < 16; ++ks) qf[ks] = *(const bf16x8*)(qp + 32 * ks); }
        const float At = GAM[(t0 + 16 * tt + fr) * 4 + h];
        if (tid < 64) em_s[tid] = GEM[(t0 + tid) * 4 + h];
#pragma unroll
        for (int i4 = 0; i4 < 4; ++i4) { const int sidx = tid + 512 * i4; if (sidx < 64 * (qi + 1)) as_s[sidx] = GA[((size_t)bl * SEQ + sidx) * 4 + h]; }
        VM_WAIT(); LDS_WAIT();
        f32x4 O[4][4]; float denp = 0.f;
#pragma unroll
        for (int i = 0; i < 4; ++i)
#pragma unroll
            for (int e = 0; e < 4; ++e) O[i][e] = (f32x4){0.f, 0.f, 0.f, 0.f};
        for (int j = 0; j < nk; ++j) { const int buf = j & 1;
            asm volatile("s_waitcnt vmcnt(0)" ::: "memory");
            __builtin_amdgcn_s_barrier(); asm volatile("" ::: "memory");
            if (j + 1 < nk) { ML_DMA(Kb + (size_t)(32 * (j + 1)) * CI, ML_K + (buf ^ 1) * ML_TILE); ML_DMA(Vb + (size_t)(32 * (j + 1)) * CI, ML_V + (buf ^ 1) * ML_TILE); }
            f32x4 sacc = {0.f, 0.f, 0.f, 0.f};
            { const LAS unsigned char* kl = lds + ML_K + buf * ML_TILE + (16 * st + fr) * ML_PITCH + fq * 16;
#pragma unroll
              for (int ks = 0; ks < 16; ++ks) { const bf16x8 kf = *(const LAS bf16x8*)(kl + 64 * ks); sacc = __builtin_amdgcn_mfma_f32_16x16x32_bf16(kf, qf[ks], sacc, 0, 0, 0); } }
            float p[4]; const f32x4 asv = *(const LAS f32x4*)(as_s + 32 * j + 16 * st + 4 * fq); const float as[4] = {asv[0], asv[1], asv[2], asv[3]};
#pragma unroll
            for (int i = 0; i < 4; ++i) { const bool ok = (32 * j + 16 * st + 4 * fq + i) <= (64 * qi + 16 * tt + fr); p[i] = ok ? sacc[i] * __builtin_amdgcn_exp2f((as[i] - At) * LOG2E) : 0.f; }
            denp += (p[0] + p[1]) + (p[2] + p[3]);
            { v2u pw; pw.x = pk2(p[0], p[1]); pw.y = pk2(p[2], p[3]); *(LAS v2u*)(lds + ML_P + buf * ML_PT + (16 * tt + fr) * ML_PP + (16 * st + 4 * fq) * 2) = pw; }
            LDS_WAIT(); __builtin_amdgcn_s_barrier(); asm volatile("" ::: "memory");
            { bf16x8 vf[4], pf[4]; const unsigned vb = (unsigned)(size_t)(lds + ML_V + buf * ML_TILE) + vtr_lane;
              tr_read_v4(vb, vf);
#pragma unroll
              for (int i = 0; i < 4; ++i) pf[i] = *(const LAS bf16x8*)(lds + ML_P + buf * ML_PT + (16 * i + fr) * ML_PP + fq * 16);
#pragma unroll
              for (int i = 0; i < 4; ++i)
#pragma unroll
                  for (int e = 0; e < 4; ++e) O[i][e] = __builtin_amdgcn_mfma_f32_16x16x32_bf16(pf[i], vf[e], O[i][e], 0, 0, 0); }
        }
        { float d = denp; d += __shfl_xor(d, 16); d += __shfl_xor(d, 32); if (fq == 0) den2[st * 64 + 16 * tt + fr] = d; }
        LDS_WAIT(); __syncthreads();
        float s1[4][4], s2[4][4];
#pragma unroll
        for (int i = 0; i < 4; ++i)
#pragma unroll
            for (int jj = 0; jj < 4; ++jj) { const int t = 16 * i + 4 * fq + jj; const float dn = den2[t] + den2[64 + t]; const float inv = 1.0f / fmaxf(fabsf(dn), em_s[t]); float a1 = 0.f, a2 = 0.f;
#pragma unroll
                for (int e = 0; e < 4; ++e) { const float hv = O[i][e][jj] * inv; O[i][e][jj] = hv; a1 += hv; a2 += hv * hv; }
                s1[i][jj] = a1; s2[i][jj] = a2; }
#pragma unroll
        for (int i = 0; i < 4; ++i)
#pragma unroll
            for (int jj = 0; jj < 4; ++jj) { float a1 = s1[i][jj], a2 = s2[i][jj];
#pragma unroll
                for (int o = 1; o < 16; o <<= 1) { a1 += __shfl_xor(a1, o); a2 += __shfl_xor(a2, o); }
                if (fr == 0) { const int t = 16 * i + 4 * fq + jj; stats[(w * 64 + t) * 2] = a1; stats[(w * 64 + t) * 2 + 1] = a2; } }
        LDS_WAIT(); __syncthreads();
        if (tid < 64) { float a1 = 0.f, a2 = 0.f;
#pragma unroll
            for (int ww = 0; ww < 8; ++ww) { a1 += stats[(ww * 64 + tid) * 2]; a2 += stats[(ww * 64 + tid) * 2 + 1]; }
            const float mean = a1 * (1.f / 512.f), var = fmaxf(a2 * (1.f / 512.f) - mean * mean, 0.f); mr[2 * tid] = mean; mr[2 * tid + 1] = rsqrtf(var + 1e-5f); }
        LDS_WAIT(); __syncthreads();
#pragma unroll
        for (int e = 0; e < 4; ++e) { const int cc = h * 512 + 64 * w + 16 * e + fr; const float gmul = mh_g[cc], sk = skip[cc];
#pragma unroll
            for (int i = 0; i < 4; ++i)
#pragma unroll
                for (int jj = 0; jj < 4; ++jj) { const int t = 16 * i + 4 * fq + jj; const size_t off = (t0 + t) * CI + cc; const float zz = bf1(Z[off]), xcv = bf1(XC[off]);
                    const float y = ((O[i][e][jj] - mr[2 * t]) * mr[2 * t + 1] * gmul + sk * xcv) * (zz * sigm(zz)); YC[off] = (bf16)f2bf(y); } }
        VM_WAIT(); __syncthreads();
    }
#undef ML_DMA
}
#define GEMM_PHASE(EPI, Aptr, Bptr, M_, N_, K_, ...) do { pg8::Gemm g{(const pg8::bf16_t*)(Aptr), (const pg8::bf16_t*)(Bptr), (M_), (N_), (K_)}; pg8::StaticOrder So; So.init((M_), (N_), F.G, F.bid); \
        pg8::EPI Ep{__VA_ARGS__}; pg8::gemm_phase<pg8::EPI, pg8::StaticOrder, PG8_ALIGN, PG8_SP2>(F.lds, g, So, Ep); } while (0)
namespace pg8 { typedef EpiRes2<float> EpiResF; typedef EpiRes2<bf16_t> EpiResB; typedef EpiPle2<false> EpiPleB; typedef EpiPle2<true> EpiPleF; }
__global__ void __launch_bounds__(NWAVES * 64, 2) trunk_fwd(Args args) {
    extern __shared__ __attribute__((aligned(16))) unsigned char lds_raw[];
    Frame F; F.lds = (LAS unsigned char*)lds_raw; F.ws = args.ws; F.in = nullptr;
    F.tid = threadIdx.x; F.lane = F.tid & 63; F.wave = __builtin_amdgcn_readfirstlane(F.tid >> 6); F.G = gridDim.x; F.bid = blockIdx.x;
    volatile LAS unsigned* MISC = (volatile LAS unsigned*)(F.lds + MISC_OFF);
    if (F.tid < 64) MISC[F.tid] = 0u;
    __syncthreads();
    XcdBarrier bar; bar.bar = (unsigned*)(args.ws + WS_CTL) + CW_BAR; bar.x = 0; bar.st = nullptr;
    if (args.use_bar) bar = xcd_barrier_post((unsigned*)(args.ws + WS_CTL) + CW_BAR, MISC + 8);
    const int lo = args.ph_lo, hi = args.ph_hi;
#ifndef ONLY_SITE
#define ONLY_SITE -1
#endif
#define EN(n) (ONLY_SITE < 0 || ONLY_SITE == (n))
#ifndef REP_MASK
#define REP_MASK 0u
#endif
#define NREP(n) (((REP_MASK >> (n)) & 1u) ? 2 : 1)
#define IN(k) (lo <= (k) && (k) < hi)
#define SEAM(k) do { if (IN(k) && IN((k) + 1)) xcd_barrier(bar); } while (0)
    unsigned char* ws = args.ws; float* out = args.out;
    float* RS = (float*)(ws + WS_RS);
#define RSN(i) (RS + (size_t)(i) * T * 16)
#define PH(site, k, ...) if (EN(site) && IN(k)) { for (int rep_ = 0; rep_ < NREP(site); ++rep_) { if (rep_) xcd_barrier(bar); __VA_ARGS__ } } SEAM(k);
    PH(0, 0, phase_prologue(F, args); phase_cast_sq(F, args.in[0], (bf16*)(ws + WS_XB2), RSN(0), T); phase_cvt_p(F, args.in[1], (bf16*)(ws + WS_PB));)
    PH(2, 1, GEMM_PHASE(EpiBf16SplitR, ws + WS_XB2, ws + WS_WIN, T, NU, D, (pg8::bf16_t*)(ws + WS_UA), UA_W, 4, (pg8::bf16_t*)(ws + WS_UB), UB_W, RSN(0));)
    PH(3, 2, phase_prepA(F, args);)
    PH(4, 3, GEMM_PHASE(EpiBf16Split, ws + WS_LIN, ws + WS_WLORA, T, 1536, 256 + args.pad, (pg8::bf16_t*)(ws + WS_LOUT), 1536, 1 << 20, nullptr, 0);)
    PH(5, 4, phase_indexer(F);)
    PH(6, 5, phase_dsa_attn(F, args);)
    PH(7, 6, phase_rwkv(F, args);)
    PH(8, 7, GEMM_PHASE(EpiResF, ws + WS_XB, ws + WS_WOUT, T, D, D, args.in[0], (pg8::bf16_t*)(ws + WS_XB2), D, RSN(1));)
#define FFN_PLE(L, pb, rs_a, rs_b, rs_c, PLE_EPI, ple_out) do { const size_t lw = (size_t)(L) * WS_LAYER_STRIDE; \
        PH(21, (pb), GEMM_PHASE(EpiSwigluR, ws + WS_XB2, ws + WS_WGU0 + lw, T, 2 * FF, D, (pg8::bf16_t*)(ws + WS_H), FF, RSN(rs_a));) \
        PH(22, (pb) + 1, GEMM_PHASE(EpiResB, ws + WS_H, ws + WS_WD0 + lw, T, D, FF, (const pg8::bf16_t*)(ws + WS_XB2), (pg8::bf16_t*)(ws + WS_XB), D, RSN(rs_b));) \
        PH(24, (pb) + 2, GEMM_PHASE(EpiBf16Split, ws + WS_PB, ws + WS_WPLE0 + lw, T, D, 256 + args.pad, (pg8::bf16_t*)(ws + WS_E), D, 1 << 20, nullptr, 0);) \
        PH(25, (pb) + 3, GEMM_PHASE(PLE_EPI, ws + WS_XB, ws + WS_WPG0 + lw, T, D, D, (const pg8::bf16_t*)(ws + WS_XB), (void*)(ple_out), (const pg8::bf16_t*)(ws + WS_E), D, RSN(rs_b), RSN(rs_c));) } while (0)
#define L1_HALF(hb, p1) do { bf16* xbh = (bf16*)(ws + WS_XB2) + (size_t)(hb) * TH * D; \
        PH(11, (p1), GEMM_PHASE(EpiBf16SplitR, xbh, ws + WS_WUP, TH, 2 * CI, D, (pg8::bf16_t*)(ws + WS_XM), CI, 8, (pg8::bf16_t*)(ws + WS_Z), CI, RSN(3) + (size_t)(hb) * TH * 16);) \
        PH(12, (p1) + 1, phase_l1prep(F, args, hb);) \
        PH(13, (p1) + 2, phase_gatescan(F); if ((hb) == 0) phase_cvt_p(F, args.in[1] + (size_t)T * 256, (bf16*)(ws + WS_PB));) \
        PH(14, (p1) + 3, phase_mlstm(F, args);) \
        PH(15, (p1) + 4, GEMM_PHASE(EpiResB, ws + WS_XM, ws + WS_WDOWN, TH, D, CI, (const pg8::bf16_t*)xbh, (pg8::bf16_t*)xbh, D, RSN(4) + (size_t)(hb) * TH * 16);) } while (0)
    FFN_PLE(0, 8, 1, 2, 3, EpiPleB, ws + WS_XB2);
    L1_HALF(0, 12);
    L1_HALF(1, 17);
    FFN_PLE(1, 22, 4, 5, 5, EpiPleF, out);
#undef IN
#undef SEAM
}
constexpr int N_PHASES = 26;

#ifndef MK_ONE_LAUNCH
#define MK_ONE_LAUNCH 1
#endif
extern "C" void kernel_launch(void* const* d_in, const int* in_sizes, int n_in, void* d_out, int out_size, void* d_ws, size_t ws_size, hipStream_t stream) {
    static int grid = 0;
    if (grid == 0) {
        if (n_in != 37 || in_sizes[0] != T * D || out_size != T * D || ws_size < WS_END) { fprintf(stderr, "kernel_launch: unexpected shapes (n_in %d, in0 %d, out %d, ws %zu < %zu); nothing launched\n", n_in, n_in > 0 ? in_sizes[0] : -1, out_size, ws_size, (size_t)WS_END); grid = -1; return; }
        int dev = 0, cus = 0, per_cu = 0;
        if (hipGetDevice(&dev) != hipSuccess || hipDeviceGetAttribute(&cus, hipDeviceAttributeMultiprocessorCount, dev) != hipSuccess) { grid = -1; return; }
        if (hipFuncSetAttribute((const void*)trunk_fwd, hipFuncAttributeMaxDynamicSharedMemorySize, LDS_BYTES) != hipSuccess) { fprintf(stderr, "kernel_launch: hipFuncSetAttribute failed\n"); grid = -1; return; }
        if (hipOccupancyMaxActiveBlocksPerMultiprocessor(&per_cu, (const void*)trunk_fwd, NWAVES * 64, LDS_BYTES) != hipSuccess || per_cu < 1) { fprintf(stderr, "kernel_launch: occupancy query says %d\n", per_cu); }
        (void)hipGetLastError();
        grid = cus;
        if (grid != 256) { fprintf(stderr, "kernel_launch: built for 256 CUs, found %d; nothing launched\n", cus); grid = -1; return; }
    }
    if (grid < 0) return;
    if (hipMemsetAsync((char*)d_ws + WS_CTL, 0, CTL_ZERO_BYTES, stream) != hipSuccess) return;
    Args a{};
    for (int i = 0; i < 37; ++i) a.in[i] = (const float*)d_in[i];
    a.out = (float*)d_out; a.ws = (unsigned char*)d_ws; a.pad = 0;
#if MK_ONE_LAUNCH
    a.ph_lo = 0; a.ph_hi = N_PHASES; a.use_bar = 1;
    hipLaunchKernelGGL(trunk_fwd, dim3(grid), dim3(NWAVES * 64), LDS_BYTES, stream, a);
#else
    for (int p = 0; p < N_PHASES; ++p) { a.ph_lo = p; a.ph_hi = p + 1; a.use_bar = 0; hipLaunchKernelGGL(trunk_fwd, dim3(grid), dim3(NWAVES * 64), LDS_BYTES, stream, a); }
#endif
}
```

```cpp
#include <hip/hip_runtime.h>
#include <cstdio>
#include <cstdint>
namespace pg8 {
#define PG8_LAS __attribute__((address_space(3)))
typedef unsigned short bf16_t;
typedef short bf16x8 __attribute__((ext_vector_type(8)));
typedef float f32x4 __attribute__((ext_vector_type(4)));
typedef unsigned u32x4 __attribute__((ext_vector_type(4)));
constexpr int BM = 256, BK = 64, HALF = 128, HTB = HALF * BK * 2  , STAGE_BYTES = 8 * HTB, NXCD = 8, WGM = 8;

__host__ __device__ __forceinline__ int lds_byte(int r, int c) { const int st = (r >> 4) * 2 + (c >> 5), rr = r & 15, cc = c & 31, ob = rr * 64 + cc * 2; return st * 1024 + (ob ^ (((ob >> 9) & 1) << 5)); }
__host__ __device__ __forceinline__ void stage_rc(int b, int& R, int& C) { const int st = b / 1024, sb = b % 1024, swz = sb ^ (((sb >> 9) & 1) << 5); R = (st >> 1) * 16 + swz / 64; C = (st & 1) * 32 + (swz % 64) / 2; }
__host__ __device__ __forceinline__ int perm32(int rho) { const int n = rho >> 4, i = rho & 15; return 8 * (i >> 2) + 4 * n + (i & 3); }

struct Unit { int pm, pn; };
struct Gemm { const bf16_t* A; const bf16_t* Bt; int M, N, K; };

struct StaticOrder {
    int nM, nN, nwg, G, c;
    __host__ __device__ void init(int M, int N, int G_, int c_) { nM = M / BM; nN = N / BM; nwg = nM * nN; G = G_; c = c_; }
    __host__ __device__ bool next(int i, Unit& u) const {
        const long L = (long)i * G + c; if (L >= nwg) return false;
        int wgid = (int)L; { const int q = nwg / NXCD, r = nwg % NXCD, xcd = wgid % NXCD, off = wgid / NXCD; wgid = (xcd < r ? xcd * (q + 1) : r * (q + 1) + (xcd - r) * q) + off; }
        const int nig = WGM * nN, gid = wgid / nig, fm = gid * WGM, gsz = (nM - fm) < WGM ? (nM - fm) : WGM;
        u.pm = fm + ((wgid % nig) % gsz); u.pn = (wgid % nig) / gsz; return true;
    }
    __device__ __forceinline__ void a_ready(const Unit&) const {}
    __device__ __forceinline__ void done(const Unit&) const {}
};

__device__ __forceinline__ unsigned cvt_pk_bf16(float lo, float hi) { unsigned r; asm volatile("v_cvt_pk_bf16_f32 %0, %1, %2" : "=v"(r) : "v"(lo), "v"(hi)); return r; }
typedef float f32x2 __attribute__((ext_vector_type(2)));
__device__ __forceinline__ f32x2 gelu_pk(f32x2 v) {
    const f32x2 av = __builtin_elementwise_abs(v), d = av * 0.2316418882f + 1.0f;
    f32x2 t; t.x = __builtin_amdgcn_rcpf(d.x); t.y = __builtin_amdgcn_rcpf(d.y);
    f32x2 q = t * 0.5307027145f + (-0.7265760135f); q = q * t + 0.7107068705f; q = q * t + (-0.142248368f); q = q * t + 0.127414796f; q = q * t;
    const f32x2 s = (v * v) * (-0.72134752044f);
    f32x2 e; e.x = __builtin_amdgcn_exp2f(s.x); e.y = __builtin_amdgcn_exp2f(s.y);
    const f32x2 m = v * (q * e), r = v - m;
    f32x2 o; o.x = v.x < 0.f ? m.x : r.x; o.y = v.y < 0.f ? m.y : r.y; return o;
}

template <class Epi, class Sched, bool ALIGN_EPI = false, bool SP2 = false>
__device__ __forceinline__ void gemm_phase(PG8_LAS unsigned char* lds, const Gemm g, const Sched& S, const Epi& E) {
    const int tid = threadIdx.x, wid = __builtin_amdgcn_readfirstlane(tid >> 6), lane = tid & 63, wr = wid >> 2, wc = wid & 3, fr = lane & 15, fq = lane >> 4;
    const int K = g.K, nt = K / BK;
    unsigned voffA[2], voffB[2];
#pragma unroll
    for (int i = 0; i < 2; ++i) { int R, C; stage_rc(tid * 16 + i * 8192, R, C); const int Rb = Epi::PERM ? ((R & ~31) + perm32(R & 31)) : R;
        voffA[i] = (unsigned)(R * K + C) * 2u; voffB[i] = (unsigned)(Rb * K + C) * 2u; }
    const size_t kstep = (size_t)(BK * 2);
    const size_t hstep = (size_t)HALF * K * 2;
    const size_t tstep = 2 * hstep;
    const unsigned ldsw = (unsigned)wid * 1024u;
    const int aoff = lds_byte(wr * 64 + fr, fq * 8), boff = lds_byte(wc * 32 + fr, fq * 8);
#define PG8_SA(b, h) (((b) * 2 + (h)) * HTB)
#define PG8_SB(b, h) ((4 + (b) * 2 + (h)) * HTB)
#define PG8_STAGE(bufoff, gbase, voff) do { _Pragma("unroll") for (int _i = 0; _i < 2; ++_i) \
        __builtin_amdgcn_global_load_lds((const unsigned*)((const char*)(gbase) + (voff)[_i]), (PG8_LAS unsigned*)(lds + (bufoff) + ldsw + _i * 8192), 16, 0, 0); } while (0)
#define PG8_LDA(dst, b, h) do { _Pragma("unroll") for (int m = 0; m < 4; ++m) _Pragma("unroll") for (int k = 0; k < 2; ++k) dst[m][k] = *(const PG8_LAS bf16x8*)(lds + PG8_SA(b, h) + aoff + m * 2048 + k * 1024); } while (0)
#define PG8_LDB(dst, b, h) do { _Pragma("unroll") for (int n = 0; n < 2; ++n) _Pragma("unroll") for (int k = 0; k < 2; ++k) dst[n][k] = *(const PG8_LAS bf16x8*)(lds + PG8_SB(b, h) + boff + n * 2048 + k * 1024); } while (0)
#define PG8_MMA(ai, bj, At, Bt) do { __builtin_amdgcn_s_setprio(1); _Pragma("unroll") for (int m = 0; m < 4; ++m) _Pragma("unroll") for (int n = 0; n < 2; ++n) _Pragma("unroll") for (int k = 0; k < 2; ++k) \
        acc[ai][bj][m][n] = __builtin_amdgcn_mfma_f32_16x16x32_bf16(Bt[n][k], At[m][k], acc[ai][bj][m][n], 0, 0, 0); __builtin_amdgcn_s_setprio(0); } while (0)
#define PG8_WAIT_V(n) asm volatile("s_waitcnt vmcnt(" #n ")" ::: "memory")
#define PG8_WAIT_L(n) asm volatile("s_waitcnt lgkmcnt(" #n ")" ::: "memory")
#define PG8_BAR __builtin_amdgcn_s_barrier()
#define PG8_SCHED __builtin_amdgcn_sched_barrier(0)
    Unit cur, nxt; int ui = 0;
    if (!S.next(0, cur)) return;
    f32x4 acc[2][2][4][2];
#pragma unroll
    for (int a = 0; a < 2; ++a)
#pragma unroll
        for (int b = 0; b < 2; ++b)
#pragma unroll
            for (int m = 0; m < 4; ++m)
#pragma unroll
                for (int n = 0; n < 2; ++n) acc[a][b][m][n] = (f32x4){0.f, 0.f, 0.f, 0.f};
    bf16x8 At[4][2], B0[2][2], B1[2][2];
    const char* cA = (const char*)g.A + (size_t)cur.pm * tstep; const char* cB = (const char*)g.Bt + (size_t)cur.pn * tstep;
    S.a_ready(cur);
    if constexpr (SP2) {
        PG8_STAGE(PG8_SB(0, 0), cB, voffB); PG8_STAGE(PG8_SB(0, 1), cB + hstep, voffB); PG8_STAGE(PG8_SA(0, 0), cA, voffA); PG8_STAGE(PG8_SA(0, 1), cA + hstep, voffA);
        if (wr == 1) PG8_BAR;
        PG8_WAIT_V(2); PG8_BAR;
        PG8_STAGE(PG8_SB(1, 0), cB + kstep, voffB); PG8_STAGE(PG8_SA(1, 0), cA + kstep, voffA); PG8_STAGE(PG8_SB(1, 1), cB + hstep + kstep, voffB);
        PG8_WAIT_V(6); PG8_BAR;
    } else {
        PG8_STAGE(PG8_SB(0, 0), cB, voffB); PG8_STAGE(PG8_SA(0, 0), cA, voffA); PG8_STAGE(PG8_SB(0, 1), cB + hstep, voffB); PG8_STAGE(PG8_SA(0, 1), cA + hstep, voffA);
        if (wr == 1) PG8_BAR;
        PG8_WAIT_V(4); PG8_BAR;
        PG8_STAGE(PG8_SB(1, 0), cB + kstep, voffB); PG8_STAGE(PG8_SA(1, 0), cA + kstep, voffA); PG8_STAGE(PG8_SB(1, 1), cB + hstep + kstep, voffB);
        PG8_WAIT_V(6); PG8_BAR;
    }
    for (;;) {
        const bool has_next = S.next(ui + 1, nxt);
        const char* nA = has_next ? (const char*)g.A + (size_t)nxt.pm * tstep : cA; const char* nB = has_next ? (const char*)g.Bt + (size_t)nxt.pn * tstep : cB;
        for (int t = 0; t < nt; t += 2) {
            const bool last = (t == nt - 2);
            const char* a1 = cA + (size_t)(t + 1) * kstep;
            const char* a2 = last ? nA : cA + (size_t)(t + 2) * kstep; const char* b2 = last ? nB : cB + (size_t)(t + 2) * kstep;
            const char* a3 = a2 + kstep; const char* b3 = b2 + kstep;
            if (last && has_next) S.a_ready(nxt);
            if constexpr (SP2) {
            PG8_LDB(B0, 0, 0); PG8_LDB(B1, 0, 1); PG8_SCHED; PG8_LDA(At, 0, 0); PG8_STAGE(PG8_SA(1, 1), a1 + hstep, voffA);
            PG8_WAIT_V(8); PG8_WAIT_L(0); PG8_BAR; PG8_MMA(0, 0, At, B0); PG8_MMA(0, 1, At, B1); PG8_BAR; PG8_SCHED;
            PG8_LDA(At, 0, 1); PG8_STAGE(PG8_SB(0, 0), b2, voffB); PG8_STAGE(PG8_SB(0, 1), b2 + hstep, voffB); PG8_STAGE(PG8_SA(0, 0), a2, voffA);
            PG8_WAIT_V(8); PG8_WAIT_L(0); PG8_BAR; PG8_MMA(1, 0, At, B0); PG8_MMA(1, 1, At, B1); PG8_BAR; PG8_SCHED;
            PG8_LDB(B0, 1, 0); PG8_LDB(B1, 1, 1); PG8_SCHED; PG8_LDA(At, 1, 0); PG8_STAGE(PG8_SA(0, 1), a2 + hstep, voffA);
            PG8_WAIT_V(8); PG8_WAIT_L(0); PG8_BAR; PG8_MMA(0, 0, At, B0); PG8_MMA(0, 1, At, B1); PG8_BAR; PG8_SCHED;
            PG8_LDA(At, 1, 1); PG8_STAGE(PG8_SB(1, 0), b3, voffB); PG8_STAGE(PG8_SB(1, 1), b3 + hstep, voffB); PG8_STAGE(PG8_SA(1, 0), a3, voffA);
            PG8_WAIT_V(8); PG8_WAIT_L(0); PG8_BAR; PG8_MMA(1, 0, At, B0); PG8_MMA(1, 1, At, B1); PG8_BAR; PG8_SCHED;
            } else {
            PG8_LDB(B0, 0, 0); PG8_SCHED; PG8_LDA(At, 0, 0); PG8_STAGE(PG8_SA(1, 1), a1 + hstep, voffA);
            PG8_WAIT_L(8); PG8_BAR; PG8_WAIT_L(0); PG8_MMA(0, 0, At, B0); PG8_BAR; PG8_SCHED;
            PG8_LDB(B1, 0, 1); PG8_STAGE(PG8_SB(0, 0), b2, voffB);
            PG8_BAR; PG8_WAIT_L(0); PG8_MMA(0, 1, At, B1); PG8_BAR;
            PG8_LDA(At, 0, 1); PG8_STAGE(PG8_SA(0, 0), a2, voffA);
            PG8_BAR; PG8_WAIT_L(0); PG8_MMA(1, 0, At, B0); PG8_BAR; PG8_SCHED;
            PG8_STAGE(PG8_SB(0, 1), b2 + hstep, voffB);
            PG8_WAIT_V(6); PG8_BAR; PG8_MMA(1, 1, At, B1); PG8_BAR;
            PG8_LDB(B0, 1, 0); PG8_SCHED; PG8_LDA(At, 1, 0); PG8_STAGE(PG8_SA(0, 1), a2 + hstep, voffA);
            PG8_WAIT_L(8); PG8_BAR; PG8_WAIT_L(0); PG8_MMA(0, 0, At, B0); PG8_BAR; PG8_SCHED;
            PG8_LDB(B1, 1, 1); PG8_STAGE(PG8_SB(1, 0), b3, voffB);
            PG8_BAR; PG8_WAIT_L(0); PG8_MMA(0, 1, At, B1); PG8_BAR;
            PG8_LDA(At, 1, 1); PG8_STAGE(PG8_SA(1, 0), a3, voffA);
            PG8_BAR; PG8_WAIT_L(0); PG8_MMA(1, 0, At, B0); PG8_BAR; PG8_SCHED;
            PG8_STAGE(PG8_SB(1, 1), b3 + hstep, voffB);
            PG8_WAIT_V(6); PG8_BAR; PG8_MMA(1, 1, At, B1); PG8_BAR;
            }
        }
        if constexpr (ALIGN_EPI) { if (wr == 0) PG8_BAR; }
        if constexpr (!Epi::AFTER_DRAIN) { E(acc, cur, wr, wc, fr, fq); S.done(cur); }
        if (!has_next) break;
#pragma unroll
        for (int a = 0; a < 2; ++a)
#pragma unroll
            for (int b = 0; b < 2; ++b)
#pragma unroll
                for (int m = 0; m < 4; ++m)
#pragma unroll
                    for (int n = 0; n < 2; ++n) acc[a][b][m][n] = (f32x4){0.f, 0.f, 0.f, 0.f};
        cur = nxt; cA = nA; cB = nB; ++ui;
        if constexpr (ALIGN_EPI) { if (wr == 1) PG8_BAR; }
    }
    PG8_WAIT_V(0);
    if constexpr (!ALIGN_EPI) { if (wr == 0) PG8_BAR; }
    PG8_BAR;
    if constexpr (Epi::AFTER_DRAIN) { E.fused(acc, cur, wr, wc, fr, fq, lds, wid, lane); S.done(cur); }
#undef PG8_SA
#undef PG8_SB
#undef PG8_STAGE
#undef PG8_LDA
#undef PG8_LDB
#undef PG8_MMA
#undef PG8_WAIT_V
#undef PG8_WAIT_L
#undef PG8_BAR
#undef PG8_SCHED
}
}
namespace pg8 {
__device__ __forceinline__ float sigmoidf_(float x) { return __builtin_amdgcn_rcpf(1.0f + __builtin_amdgcn_exp2f(-1.4426950408889634f * x)); }
struct EpiBf16Split {
    static constexpr bool PERM = true, AFTER_DRAIN = false;
    bf16_t* O0; int ld0; int nt0; bf16_t* O1; int ld1;
    __device__ __forceinline__ void operator()(const f32x4 (&acc)[2][2][4][2], const Unit& u, int wr, int wc, int fr, int fq) const {
        const bool first = u.pn < nt0; bf16_t* base = first ? O0 : O1; const int ld = first ? ld0 : ld1; const int colt = (first ? u.pn : u.pn - nt0) * BM;
        const int row0 = u.pm * BM + wr * 64 + fr, col0 = colt + wc * 32 + 8 * fq;
#pragma unroll
        for (int ai = 0; ai < 2; ++ai)
#pragma unroll
            for (int m = 0; m < 4; ++m) { bf16_t* rowp = base + (size_t)(row0 + ai * HALF + m * 16) * ld + col0;
#pragma unroll
                for (int bj = 0; bj < 2; ++bj) { const f32x4 v0 = acc[ai][bj][m][0], v1 = acc[ai][bj][m][1];
                    u32x4 w; w.x = cvt_pk_bf16(v0[0], v0[1]); w.y = cvt_pk_bf16(v0[2], v0[3]); w.z = cvt_pk_bf16(v1[0], v1[1]); w.w = cvt_pk_bf16(v1[2], v1[3]);
                    *(u32x4*)(rowp + bj * HALF) = w; } }
    }
};
struct EpiResF32 {
    static constexpr bool PERM = false, AFTER_DRAIN = false;
    const float* base; float* out; int ldc;
    __device__ __forceinline__ void operator()(const f32x4 (&acc)[2][2][4][2], const Unit& u, int wr, int wc, int fr, int fq) const {
        const int row0 = u.pm * BM + wr * 64 + fr, col0 = u.pn * BM + wc * 32 + 4 * fq;
#pragma unroll
        for (int ai = 0; ai < 2; ++ai)
#pragma unroll
            for (int m = 0; m < 4; ++m) { const size_t off = (size_t)(row0 + ai * HALF + m * 16) * ldc + col0;
#pragma unroll
                for (int bj = 0; bj < 2; ++bj)
#pragma unroll
                    for (int n = 0; n < 2; ++n) { const f32x4 b = *(const f32x4*)(base + off + bj * HALF + n * 16); *(f32x4*)(out + off + bj * HALF + n * 16) = b + acc[ai][bj][m][n]; } }
    }
};
struct EpiSwiglu {
    static constexpr bool PERM = false, AFTER_DRAIN = false;
    bf16_t* H; int ldh;
    __device__ __forceinline__ void operator()(const f32x4 (&acc)[2][2][4][2], const Unit& u, int wr, int wc, int fr, int fq) const {
        const int row0 = u.pm * BM + wr * 64 + fr, hc0 = u.pn * (BM / 2) + wc * 16 + 4 * fq;
#pragma unroll
        for (int ai = 0; ai < 2; ++ai)
#pragma unroll
            for (int m = 0; m < 4; ++m) { bf16_t* rowp = H + (size_t)(row0 + ai * HALF + m * 16) * ldh + hc0;
#pragma unroll
                for (int bj = 0; bj < 2; ++bj) { const f32x4 g = acc[ai][bj][m][0], up = acc[ai][bj][m][1]; float h[4];
#pragma unroll
                    for (int i = 0; i < 4; ++i) h[i] = g[i] * sigmoidf_(g[i]) * up[i];
                    typedef unsigned u32x2 __attribute__((ext_vector_type(2)));
                    u32x2 w; w.x = cvt_pk_bf16(h[0], h[1]); w.y = cvt_pk_bf16(h[2], h[3]);
                    *(u32x2*)(rowp + bj * (HALF / 2)) = w; } }
    }
};
struct EpiPle {
    static constexpr bool PERM = false, AFTER_DRAIN = false;
    const float* base; float* out; const bf16_t* E; int ldc;
    __device__ __forceinline__ void operator()(const f32x4 (&acc)[2][2][4][2], const Unit& u, int wr, int wc, int fr, int fq) const {
        const int row0 = u.pm * BM + wr * 64 + fr, col0 = u.pn * BM + wc * 32 + 4 * fq;
        typedef unsigned u32x2 __attribute__((ext_vector_type(2)));
#pragma unroll
        for (int ai = 0; ai < 2; ++ai)
#pragma unroll
            for (int m = 0; m < 4; ++m) { const size_t off = (size_t)(row0 + ai * HALF + m * 16) * ldc + col0;
#pragma unroll
                for (int bj = 0; bj < 2; ++bj)
#pragma unroll
                    for (int n = 0; n < 2; ++n) { const size_t o = off + bj * HALF + n * 16; const f32x4 b = *(const f32x4*)(base + o); const u32x2 e = *(const u32x2*)(E + o); const f32x4 a = acc[ai][bj][m][n];
                        f32x4 r; r[0] = b[0] + __uint_as_float(e.x << 16) * sigmoidf_(a[0]); r[1] = b[1] + __uint_as_float(e.x & 0xffff0000u) * sigmoidf_(a[1]);
                        r[2] = b[2] + __uint_as_float(e.y << 16) * sigmoidf_(a[2]); r[3] = b[3] + __uint_as_float(e.y & 0xffff0000u) * sigmoidf_(a[3]);
                        *(f32x4*)(out + o) = r; } }
    }
};
__device__ __forceinline__ float rms_r(const float* rsq, int row) { const f32x4* p = (const f32x4*)(rsq + (size_t)row * 16); const f32x4 a = p[0], b = p[1], c = p[2], d = p[3];
    const float s = (((a[0] + a[1]) + (a[2] + a[3])) + ((b[0] + b[1]) + (b[2] + b[3]))) + (((c[0] + c[1]) + (c[2] + c[3])) + ((d[0] + d[1]) + (d[2] + d[3]))); return rsqrtf(s * (1.0f / 1024.0f) + 1e-6f); }
__device__ __forceinline__ void norm_out(const f32x4 (&x)[2][2], bf16_t* xb, size_t off, float* rsq_out, int row, int fq, int slot) {
    typedef unsigned u32x2 __attribute__((ext_vector_type(2))); float s = 0.f;
#pragma unroll
    for (int bj = 0; bj < 2; ++bj)
#pragma unroll
        for (int n = 0; n < 2; ++n) { const f32x4 v = x[bj][n]; s += (v[0] * v[0] + v[1] * v[1]) + (v[2] * v[2] + v[3] * v[3]); u32x2 w; w.x = cvt_pk_bf16(v[0], v[1]); w.y = cvt_pk_bf16(v[2], v[3]); *(u32x2*)(xb + off + bj * HALF + n * 16) = w; }
    s += __shfl_xor(s, 16); s += __shfl_xor(s, 32);
    if (fq == 0) rsq_out[(size_t)row * 16 + slot] = s;
}
struct EpiBf16SplitR {
    static constexpr bool PERM = true, AFTER_DRAIN = false;
    bf16_t* O0; int ld0; int nt0; bf16_t* O1; int ld1; const float* rsq;
    __device__ __forceinline__ void operator()(const f32x4 (&acc)[2][2][4][2], const Unit& u, int wr, int wc, int fr, int fq) const {
        const bool first = u.pn < nt0; bf16_t* base = first ? O0 : O1; const int ld = first ? ld0 : ld1; const int colt = (first ? u.pn : u.pn - nt0) * BM;
        const int row0 = u.pm * BM + wr * 64 + fr, col0 = colt + wc * 32 + 8 * fq;
#pragma unroll
        for (int ai = 0; ai < 2; ++ai)
#pragma unroll
            for (int m = 0; m < 4; ++m) { const int row = row0 + ai * HALF + m * 16; const float r = rms_r(rsq, row); bf16_t* rowp = base + (size_t)row * ld + col0;
#pragma unroll
                for (int bj = 0; bj < 2; ++bj) { const f32x4 v0 = acc[ai][bj][m][0] * r, v1 = acc[ai][bj][m][1] * r;
                    u32x4 w; w.x = cvt_pk_bf16(v0[0], v0[1]); w.y = cvt_pk_bf16(v0[2], v0[3]); w.z = cvt_pk_bf16(v1[0], v1[1]); w.w = cvt_pk_bf16(v1[2], v1[3]);
                    *(u32x4*)(rowp + bj * HALF) = w; } }
    }
};
struct EpiSwigluR {
    static constexpr bool PERM = false, AFTER_DRAIN = false;
    bf16_t* H; int ldh; const float* rsq;
    __device__ __forceinline__ void operator()(const f32x4 (&acc)[2][2][4][2], const Unit& u, int wr, int wc, int fr, int fq) const {
        const int row0 = u.pm * BM + wr * 64 + fr, hc0 = u.pn * (BM / 2) + wc * 16 + 4 * fq;
#pragma unroll
        for (int ai = 0; ai < 2; ++ai)
#pragma unroll
            for (int m = 0; m < 4; ++m) { const int row = row0 + ai * HALF + m * 16; const float r = rms_r(rsq, row); bf16_t* rowp = H + (size_t)row * ldh + hc0;
#pragma unroll
                for (int bj = 0; bj < 2; ++bj) { const f32x4 g = acc[ai][bj][m][0] * r, up = acc[ai][bj][m][1] * r; float h[4];
#pragma unroll
                    for (int i = 0; i < 4; ++i) h[i] = g[i] * sigmoidf_(g[i]) * up[i];
                    typedef unsigned u32x2 __attribute__((ext_vector_type(2)));
                    u32x2 w; w.x = cvt_pk_bf16(h[0], h[1]); w.y = cvt_pk_bf16(h[2], h[3]);
                    *(u32x2*)(rowp + bj * (HALF / 2)) = w; } }
    }
};
struct EpiResN {
    static constexpr bool PERM = false, AFTER_DRAIN = false;
    const float* base; float* out; int ldc; bf16_t* XBo; float* rsq_out;
    __device__ __forceinline__ void operator()(const f32x4 (&acc)[2][2][4][2], const Unit& u, int wr, int wc, int fr, int fq) const {
        const int row0 = u.pm * BM + wr * 64 + fr, col0 = u.pn * BM + wc * 32 + 4 * fq;
#pragma unroll
        for (int ai = 0; ai < 2; ++ai)
#pragma unroll
            for (int m = 0; m < 4; ++m) { const int row = row0 + ai * HALF + m * 16; const size_t off = (size_t)row * ldc + col0; f32x4 x[2][2];
#pragma unroll
                for (int bj = 0; bj < 2; ++bj)
#pragma unroll
                    for (int n = 0; n < 2; ++n) { const f32x4 b = *(const f32x4*)(base + off + bj * HALF + n * 16); x[bj][n] = b + acc[ai][bj][m][n]; *(f32x4*)(out + off + bj * HALF + n * 16) = x[bj][n]; }
                if (XBo) norm_out(x, XBo, off, rsq_out, row, fq, u.pn * 4 + wc); }
    }
};
struct EpiPleN {
    static constexpr bool PERM = false, AFTER_DRAIN = false;
    const float* base; float* out; const bf16_t* E; int ldc; const float* rsq_in; bf16_t* XBo; float* rsq_out;
    __device__ __forceinline__ void operator()(const f32x4 (&acc)[2][2][4][2], const Unit& u, int wr, int wc, int fr, int fq) const {
        const int row0 = u.pm * BM + wr * 64 + fr, col0 = u.pn * BM + wc * 32 + 4 * fq;
        typedef unsigned u32x2 __attribute__((ext_vector_type(2)));
#pragma unroll
        for (int ai = 0; ai < 2; ++ai)
#pragma unroll
            for (int m = 0; m < 4; ++m) { const int row = row0 + ai * HALF + m * 16; const size_t off = (size_t)row * ldc + col0; const float r = rms_r(rsq_in, row); f32x4 x[2][2];
#pragma unroll
                for (int bj = 0; bj < 2; ++bj)
#pragma unroll
                    for (int n = 0; n < 2; ++n) { const size_t o = off + bj * HALF + n * 16; const f32x4 b = *(const f32x4*)(base + o); const u32x2 e = *(const u32x2*)(E + o); const f32x4 a = acc[ai][bj][m][n] * r;
                        f32x4 v; v[0] = b[0] + __uint_as_float(e.x << 16) * sigmoidf_(a[0]); v[1] = b[1] + __uint_as_float(e.x & 0xffff0000u) * sigmoidf_(a[1]);
                        v[2] = b[2] + __uint_as_float(e.y << 16) * sigmoidf_(a[2]); v[3] = b[3] + __uint_as_float(e.y & 0xffff0000u) * sigmoidf_(a[3]);
                        x[bj][n] = v; *(f32x4*)(out + o) = v; }
                if (XBo) norm_out(x, XBo, off, rsq_out, row, fq, u.pn * 4 + wc); }
    }
};
__device__ __forceinline__ f32x4 ld_base4(const float* p) { return *(const f32x4*)p; }
__device__ __forceinline__ f32x4 ld_base4(const bf16_t* p) { typedef unsigned u32x2 __attribute__((ext_vector_type(2))); const u32x2 e = *(const u32x2*)p; return (f32x4){__uint_as_float(e.x << 16), __uint_as_float(e.x & 0xffff0000u), __uint_as_float(e.y << 16), __uint_as_float(e.y & 0xffff0000u)}; }
template <class BaseT> struct EpiRes2 {
    static constexpr bool PERM = false, AFTER_DRAIN = false;
    const BaseT* base; bf16_t* out; int ldc; float* rsq_out;
    __device__ __forceinline__ void operator()(const f32x4 (&acc)[2][2][4][2], const Unit& u, int wr, int wc, int fr, int fq) const {
        const int row0 = u.pm * BM + wr * 64 + fr, col0 = u.pn * BM + wc * 32 + 4 * fq;
#pragma unroll
        for (int ai = 0; ai < 2; ++ai)
#pragma unroll
            for (int m = 0; m < 4; ++m) { const int row = row0 + ai * HALF + m * 16; const size_t off = (size_t)row * ldc + col0; f32x4 x[2][2];
#pragma unroll
                for (int bj = 0; bj < 2; ++bj)
#pragma unroll
                    for (int n = 0; n < 2; ++n) x[bj][n] = ld_base4(base + off + bj * HALF + n * 16) + acc[ai][bj][m][n];
                norm_out(x, out, off, rsq_out, row, fq, u.pn * 4 + wc); }
    }
};
template <bool OUT_F32> struct EpiPle2 {
    static constexpr bool PERM = false, AFTER_DRAIN = false;
    const bf16_t* base; void* out; const bf16_t* E; int ldc; const float* rsq_in; float* rsq_out;
    __device__ __forceinline__ void operator()(const f32x4 (&acc)[2][2][4][2], const Unit& u, int wr, int wc, int fr, int fq) const {
        const int row0 = u.pm * BM + wr * 64 + fr, col0 = u.pn * BM + wc * 32 + 4 * fq;
#pragma unroll
        for (int ai = 0; ai < 2; ++ai)
#pragma unroll
            for (int m = 0; m < 4; ++m) { const int row = row0 + ai * HALF + m * 16; const size_t off = (size_t)row * ldc + col0; const float r = rms_r(rsq_in, row); f32x4 x[2][2];
#pragma unroll
                for (int bj = 0; bj < 2; ++bj)
#pragma unroll
                    for (int n = 0; n < 2; ++n) { const size_t o = off + bj * HALF + n * 16; const f32x4 b = ld_base4(base + o), e = ld_base4(E + o), a = acc[ai][bj][m][n] * r; f32x4 v;
#pragma unroll
                        for (int i = 0; i < 4; ++i) v[i] = b[i] + e[i] * sigmoidf_(a[i]);
                        x[bj][n] = v; if (OUT_F32) *(f32x4*)((float*)out + o) = v; }
                if (!OUT_F32) norm_out(x, (bf16_t*)out, off, rsq_out, row, fq, u.pn * 4 + wc); }
    }
};
}
#ifndef PG8_SP2
#define PG8_SP2 true
#endif
#ifndef PG8_ALIGN
#define PG8_ALIGN true
#endif
constexpr int NB = 32, SEQ = 2048, T = NB * SEQ, D = 1024;
constexpr int NU = 2816, UA_W = 1024, UB_W = 1792;
constexpr int FF = 2816, CI = 2048, TH = T / 2;
constexpr int NWAVES = 8;
constexpr float NORM_EPS = 1e-6f, LOG2E = 1.4426950408889634f;
constexpr int UA_K = 512, UA_V = 576, UA_IQ = 640, UA_IK = 896, UA_IW = 960;
constexpr size_t MiB = 1u << 20, QMiB = 1u << 18;
constexpr size_t WS_CTL = 0, CTL_ZERO_BYTES = 1 * MiB;
constexpr size_t WS_WIN = 4 * QMiB, WS_WLORA = 26 * QMiB, WS_WOUT = 29 * QMiB;
constexpr size_t WS_WGU0 = 37 * QMiB, WS_WD0 = 81 * QMiB, WS_WPLE0 = 103 * QMiB, WS_WPG0 = 105 * QMiB, WS_LAYER_STRIDE = 76 * QMiB;
constexpr size_t WS_WUP = 189 * QMiB, WS_WDOWN = 221 * QMiB, WS_W12 = 237 * QMiB;
static_assert(WS_WPG0 + 8 * QMiB == WS_WGU0 + WS_LAYER_STRIDE && WS_WPG0 + WS_LAYER_STRIDE + 8 * QMiB == WS_WUP && WS_W12 + QMiB <= 60 * MiB, "weight map");
constexpr size_t ACT = 60 * MiB;
constexpr size_t WS_XB = ACT, WS_UA = ACT + 128 * MiB, WS_UB = ACT + 256 * MiB, WS_LIN = ACT + 480 * MiB, WS_LOUT = ACT + 512 * MiB;
constexpr size_t WS_QN = ACT + 704 * MiB, WS_KN = ACT + 768 * MiB, WS_VT = ACT + 776 * MiB, WS_MASK = ACT + 784 * MiB;
constexpr size_t WS_XB2 = ACT + 768 * MiB;
constexpr size_t WS_H = ACT + 128 * MiB, WS_E = ACT + 480 * MiB, WS_PB = ACT + 896 * MiB;
constexpr size_t WS_XM = ACT, WS_Z = ACT + 128 * MiB, WS_XC = ACT + 256 * MiB, WS_Q = ACT + 384 * MiB, WS_K = ACT + 512 * MiB, WS_V = ACT + 640 * MiB;
constexpr size_t WS_RS = ACT + 928 * MiB, RS_ONE = (size_t)T * 16 * 4;
constexpr size_t WS_GI = ACT + 952 * MiB, WS_GA = WS_GI + 1 * MiB, WS_GAM = WS_GI + 2 * MiB, WS_GEM = WS_GI + 3 * MiB;
constexpr size_t WS_END = ACT + 956 * MiB;
static_assert(WS_END <= 1024 * MiB, "workspace");
constexpr int CW_TMO = 0, CW_BAR = 4096, CW_XRANK = 8192;
constexpr int LDS_BYTES = 155648;
constexpr int MISC_OFF = LDS_BYTES - 256;
#define GAS __attribute__((address_space(1)))
#define LAS __attribute__((address_space(3)))
typedef unsigned short bf16;
typedef unsigned v4u __attribute__((ext_vector_type(4)));
typedef unsigned v2u __attribute__((ext_vector_type(2)));
typedef float f32x4 __attribute__((ext_vector_type(4)));
typedef float f32x2 __attribute__((ext_vector_type(2)));
typedef float f32x8 __attribute__((ext_vector_type(8)));
typedef short bf16x8 __attribute__((ext_vector_type(8)));
typedef short s16x4 __attribute__((ext_vector_type(4)));
typedef GAS unsigned gu32;
#define RLX_AGENT __ATOMIC_RELAXED, __HIP_MEMORY_SCOPE_AGENT
#define LDS_WAIT() asm volatile("s_waitcnt lgkmcnt(0)" ::: "memory")
#define VM_WAIT() asm volatile("s_waitcnt vmcnt(0)" ::: "memory")
__device__ __forceinline__ unsigned f2bf(float f) { unsigned u = __builtin_bit_cast(unsigned, f); return (u + 0x7fffu + ((u >> 16) & 1u)) >> 16; }

#define XB_TMO      128
#define XB_XCNT(j)  (256  + 64 * (j))
#define XB_XSUB(j)  (1280 + 64 * (j))
#define XB_XGEN(j)  (2304 + 64 * (j))
#define XB_TOP      3328
#define XB_TOPGEN   3392
#define XCD_BAR_WORDS 3456
#define XB_SPIN_CAP (1u << 18)

__device__ __forceinline__ unsigned xb_ld(unsigned* p)              { return __hip_atomic_load(p, __ATOMIC_RELAXED, __HIP_MEMORY_SCOPE_AGENT); }
__device__ __forceinline__ unsigned xb_add(unsigned* p, unsigned v) { return __hip_atomic_fetch_add(p, v, __ATOMIC_RELAXED, __HIP_MEMORY_SCOPE_AGENT); }
__device__ __forceinline__ unsigned xb_xcc_id() { return (unsigned)__builtin_amdgcn_s_getreg((3 << 11) | 20) & 0xFu; }
#define XB_SPIN(cond, bar) do { unsigned _sp = 0; while (cond) { __builtin_amdgcn_s_sleep(1); \
    if ((++_sp & 255u) == 0u) { if (xb_ld(&(bar)[XB_TMO])) break; if (_sp > XB_SPIN_CAP) { atomicAdd(&(bar)[XB_TMO], 1u); break; } } } } while (0)

struct XcdBarrier {
    unsigned* bar; unsigned x;
    volatile LAS unsigned* st;
};

__device__ __forceinline__ XcdBarrier xcd_barrier_post(unsigned* bar, volatile LAS unsigned* st) {
    XcdBarrier b; b.bar = bar; b.x = xb_xcc_id(); b.st = st;
    if (threadIdx.x == 0) (void)xb_add(&bar[XB_XCNT(b.x)], 1u);
    return b;
}
__device__ __forceinline__ void xcd_barrier_complete(unsigned* bar, unsigned x, unsigned& nloc, unsigned& nx) {
    const unsigned G = gridDim.x * gridDim.y * gridDim.z;
    unsigned sum, cnt, mine, sp = 0u;
    for (;;) {
        sum = 0u; cnt = 0u; mine = 0u;
#pragma unroll
        for (unsigned j = 0; j < 16; ++j) { const unsigned c = xb_ld(&bar[XB_XCNT(j)]); sum += c; cnt += (c > 0u) ? 1u : 0u; mine = (j == x) ? c : mine; }
        if (sum == G) break;
        __builtin_amdgcn_s_sleep(1);
        if ((++sp & 255u) == 0u) { if (xb_ld(&bar[XB_TMO])) break; if (sp > XB_SPIN_CAP) { atomicAdd(&bar[XB_TMO], 1u); break; } }
    }
    nloc = mine > 0u ? mine : 1u; nx = cnt > 0u ? cnt : 1u;
}

__device__ __forceinline__ void xcd_barrier(const XcdBarrier& b) {
    asm volatile("s_waitcnt vmcnt(0)" ::: "memory");
    __syncthreads();
    if (threadIdx.x == 0) {
        unsigned* bar = b.bar;
        __builtin_amdgcn_s_waitcnt(0);
        unsigned nloc = b.st[0], nx = b.st[1];
        if (nloc == 0u) { xcd_barrier_complete(bar, b.x, nloc, nx); b.st[0] = nloc; b.st[1] = nx; }
        const unsigned old = xb_add(&bar[XB_XSUB(b.x)], 1u);
        const unsigned gen = old / nloc;
        if (old + 1u == (gen + 1u) * nloc) {
            __builtin_amdgcn_fence(__ATOMIC_RELEASE, "agent");
            asm volatile("s_waitcnt vmcnt(0)" ::: "memory");
            const unsigned og = xb_add(&bar[XB_TOP], 1u);
            const unsigned tg = og / nx;
            if (og + 1u == (tg + 1u) * nx) xb_add(&bar[XB_TOPGEN], 1u);
            else XB_SPIN(xb_ld(&bar[XB_TOPGEN]) == tg, bar);
            __builtin_amdgcn_fence(__ATOMIC_ACQUIRE, "agent");
            xb_add(&bar[XB_XGEN(b.x)], 1u);
            asm volatile("s_waitcnt vmcnt(0)" ::: "memory");
        } else {
            XB_SPIN(xb_ld(&bar[XB_XGEN(b.x)]) == gen, bar);
            __builtin_amdgcn_fence(__ATOMIC_ACQUIRE, "agent");
            asm volatile("s_waitcnt vmcnt(0)" ::: "memory");
        }
    }
    __syncthreads();
}

struct Frame {
    LAS unsigned char* lds;
    unsigned char* ws;
    const float* const* in;
    int tid, lane, wave, G, bid;
};
struct Args { const float* in[37]; float* out; unsigned char* ws; int ph_lo, ph_hi, use_bar, pad; };

__device__ __forceinline__ float dpp_f(float v, int ctrl_qp1) { return v; }
#define DPP_MOVF(v, ctrl) __builtin_bit_cast(float, __builtin_amdgcn_mov_dpp(__builtin_bit_cast(int, (v)), (ctrl), 0xf, 0xf, true))
__device__ __forceinline__ float wave_sum(float v) {
    v += DPP_MOVF(v, 0xB1);
    v += DPP_MOVF(v, 0x4E);
    v += DPP_MOVF(v, 0x141);
    v += DPP_MOVF(v, 0x140);
    v += __shfl_xor(v, 16); v += __shfl_xor(v, 32);
    return v;
}
__device__ __forceinline__ float wave_max(float v) {
#pragma unroll
    for (int o = 1; o < 64; o <<= 1) v = fmaxf(v, __shfl_xor(v, o));
    return v;
}
__device__ __forceinline__ float bflo(unsigned u) { return __uint_as_float(u << 16); }
__device__ __forceinline__ float bfhi(unsigned u) { return __uint_as_float(u & 0xffff0000u); }
__device__ __forceinline__ float bf1(bf16 h) { return __uint_as_float(((unsigned)h) << 16); }
__device__ __forceinline__ unsigned pk2(float lo, float hi) { return pg8::cvt_pk_bf16(lo, hi); }
__device__ __forceinline__ float sigm(float x) { return __builtin_amdgcn_rcpf(1.0f + __builtin_amdgcn_exp2f(-LOG2E * x)); }
__device__ __forceinline__ float softplusf_(float x) { return fmaxf(x, 0.f) + log1pf(__expf(-fabsf(x))); }
__device__ __forceinline__ void unpack8(const v4u& r, float (&f)[8]) { f[0] = bflo(r.x); f[1] = bfhi(r.x); f[2] = bflo(r.y); f[3] = bfhi(r.y); f[4] = bflo(r.z); f[5] = bfhi(r.z); f[6] = bflo(r.w); f[7] = bfhi(r.w); }
__device__ __forceinline__ v4u pack8(const float (&f)[8]) { v4u o; o.x = pk2(f[0], f[1]); o.y = pk2(f[2], f[3]); o.z = pk2(f[4], f[5]); o.w = pk2(f[6], f[7]); return o; }

template <class Fn> __device__ __forceinline__ void wprep(bf16* dst, int N, int K, Fn f, int gt, int NT) {
    const int items = N * (K >> 3);
    for (int it = gt; it < items; it += NT) { const int n = it % N, k0 = (it / N) << 3; float v[8];
#pragma unroll
        for (int j = 0; j < 8; ++j) v[j] = f(k0 + j, n);
        *(v4u*)(dst + (size_t)n * K + k0) = pack8(v); }
}
__device__ __forceinline__ void phase_prologue(Frame& F, const Args& a) {
    const int gt = F.bid * 512 + F.tid, NT = F.G * 512; unsigned char* ws = F.ws;
    { const float* W = a.in[5]; const float* gn0 = a.in[2];
      wprep((bf16*)(ws + WS_WIN), NU, D, [=](int k, int n) { const int c = n < 964 ? n : (n < 1024 ? -1 : n - 60); return c < 0 ? 0.f : W[(size_t)k * 2756 + c] * gn0[k]; }, gt, NT); }
    { const float* w2 = a.in[8]; const float* a2 = a.in[10]; const float* g2 = a.in[11];
      wprep((bf16*)(ws + WS_WLORA), 1536, 256, [=](int k, int n) { if (n < 512) return k < 64 ? w2[k * 512 + n] : 0.f; if (n < 1024) return (k >= 64 && k < 128) ? a2[(k - 64) * 512 + n - 512] : 0.f; return k >= 128 ? g2[(k - 128) * 512 + n - 1024] : 0.f; }, gt, NT); }
    { const float* W = a.in[17]; wprep((bf16*)(ws + WS_WOUT), D, D, [=](int k, int n) { return W[(size_t)k * D + n]; }, gt, NT); }
    for (int L = 0; L < 2; ++L) {
        const float* wg = a.in[31] + (size_t)L * D * FF; const float* wu = a.in[32] + (size_t)L * D * FF; const float* wd = a.in[33] + (size_t)L * FF * D;
        const float* wp = a.in[34] + (size_t)L * 256 * D; const float* wpg = a.in[36] + (size_t)L * D * D; const float* gnf = a.in[30] + L * D; const float* gnp = a.in[35] + L * D;
        wprep((bf16*)(ws + WS_WGU0 + L * WS_LAYER_STRIDE), 2 * FF, D, [=](int k, int n) { const int hid = 16 * (n >> 5) + (n & 15); return ((n & 31) >= 16 ? wu : wg)[(size_t)k * FF + hid] * gnf[k]; }, gt, NT);
        wprep((bf16*)(ws + WS_WD0 + L * WS_LAYER_STRIDE), D, FF, [=](int k, int n) { return wd[(size_t)k * D + n]; }, gt, NT);
        wprep((bf16*)(ws + WS_WPLE0 + L * WS_LAYER_STRIDE), D, 256, [=](int k, int n) { return wp[(size_t)k * D + n]; }, gt, NT);
        wprep((bf16*)(ws + WS_WPG0 + L * WS_LAYER_STRIDE), D, D, [=](int k, int n) { return wpg[(size_t)k * D + n] * gnp[k]; }, gt, NT);
    }
    { const float* W = a.in[18]; const float* gn1 = a.in[2] + D; wprep((bf16*)(ws + WS_WUP), 2 * CI, D, [=](int k, int n) { return W[(size_t)k * (2 * CI) + n] * gn1[k]; }, gt, NT); }
    { const float* W = a.in[29]; wprep((bf16*)(ws + WS_WDOWN), D, CI, [=](int k, int n) { return W[(size_t)k * D + n]; }, gt, NT); }
    { const float* wq = a.in[21]; const float* wk = a.in[22]; const float* wv = a.in[23]; const float* wif = a.in[24]; float* W12 = (float*)(ws + WS_W12);
      for (int it = gt; it < 4096 * 8; it += NT) { const int o = it & 7, c = (it >> 3) & 2047, part = it >> 14, g = c >> 2, i = c & 3; float s = 0.f;
          if (part == 0) { for (int j = 0; j < 4; ++j) s += wq[(g * 4 + i) * 4 + j] * wif[(size_t)(4 * g + j) * 8 + o] + wk[(g * 4 + i) * 4 + j] * wif[(size_t)(2048 + 4 * g + j) * 8 + o]; }
          else { for (int j = 0; j < 4; ++j) s += wv[(g * 4 + i) * 4 + j] * wif[(size_t)(4096 + 4 * g + j) * 8 + o]; }
          W12[it] = s; } }
}
__device__ __forceinline__ void phase_norm(Frame& F, const float* src, const float* gain, bf16* dst, int nrows) {
    const int gw = F.bid * NWAVES + F.wave, NGW = F.G * NWAVES, lane = F.lane;
    f32x4 g[4];
#pragma unroll
    for (int j = 0; j < 4; ++j) g[j] = *((const f32x4*)gain + lane + 64 * j);
    for (int m = gw; m < nrows; m += NGW) {
        const f32x4* xr = (const f32x4*)(src + (size_t)m * D) + lane; f32x4 v[4]; float s = 0.f;
#pragma unroll
        for (int j = 0; j < 4; ++j) { v[j] = xr[64 * j]; s += (v[j].x * v[j].x + v[j].y * v[j].y) + (v[j].z * v[j].z + v[j].w * v[j].w); }
        const float r = rsqrtf(wave_sum(s) * (1.f / D) + NORM_EPS);
        v2u* o = (v2u*)(dst + (size_t)m * D) + lane;
#pragma unroll
        for (int j = 0; j < 4; ++j) { v2u w; w.x = pk2(v[j].x * r * g[j].x, v[j].y * r * g[j].y); w.y = pk2(v[j].z * r * g[j].z, v[j].w * r * g[j].w); o[64 * j] = w; }
    }
}
__device__ __forceinline__ void phase_cast_sq(Frame& F, const float* src, bf16* dst, float* rsq, int nrows) {
    const int gw = F.bid * NWAVES + F.wave, NGW = F.G * NWAVES, lane = F.lane;
    for (int m = gw; m < nrows; m += NGW) {
        const f32x4* xr = (const f32x4*)(src + (size_t)m * D) + lane; f32x4 v[4]; float s = 0.f;
#pragma unroll
        for (int j = 0; j < 4; ++j) { v[j] = xr[64 * j]; s += (v[j].x * v[j].x + v[j].y * v[j].y) + (v[j].z * v[j].z + v[j].w * v[j].w); }
        s = wave_sum(s); if (lane < 16) rsq[(size_t)m * 16 + lane] = lane == 0 ? s : 0.f;
        v2u* o = (v2u*)(dst + (size_t)m * D) + lane;
#pragma unroll
        for (int j = 0; j < 4; ++j) { v2u w; w.x = pk2(v[j].x, v[j].y); w.y = pk2(v[j].z, v[j].w); o[64 * j] = w; }
    }
}
__device__ __forceinline__ void phase_cvt_p(Frame& F, const float* p, bf16* pb) {
    const size_t gt = (size_t)F.bid * 512 + F.tid, NT = (size_t)F.G * 512, n8 = (size_t)T * 256 / 8;
    for (size_t i0 = gt; i0 < n8; i0 += 4 * NT) { f32x4 a[4], b[4];
#pragma unroll
        for (int q4 = 0; q4 < 4; ++q4) { const size_t i = i0 + q4 * NT; if (i < n8) { a[q4] = *((const f32x4*)p + 2 * i); b[q4] = *((const f32x4*)p + 2 * i + 1); } }
#pragma unroll
        for (int q4 = 0; q4 < 4; ++q4) { const size_t i = i0 + q4 * NT; if (i < n8) { v4u o; o.x = pk2(a[q4].x, a[q4].y); o.y = pk2(a[q4].z, a[q4].w); o.z = pk2(b[q4].x, b[q4].y); o.w = pk2(b[q4].z, b[q4].w); *((v4u*)pb + i) = o; } } }
}
constexpr float QSCALE = 0.125f * LOG2E;
__device__ __forceinline__ void phase_prepA(Frame& F, const Args& a) {
    unsigned char* ws = F.ws; const bf16* UA = (const bf16*)(ws + WS_UA); const bf16* UB = (const bf16*)(ws + WS_UB);
    bf16* LIN = (bf16*)(ws + WS_LIN); bf16* QN = (bf16*)(ws + WS_QN); bf16* KN = (bf16*)(ws + WS_KN); bf16* VT = (bf16*)(ws + WS_VT);
    const float* mu = a.in[6]; const float* gq = a.in[3]; const float* gk = a.in[4];
    { const int gt = F.bid * 512 + F.tid, NT = F.G * 512; const int c8 = (gt & 31) << 3; float muv[8];
#pragma unroll
      for (int j = 0; j < 8; ++j) muv[j] = mu[1536 + c8 + j];
      for (int it0 = gt; it0 < T * 32; it0 += 4 * NT) { v4u ru[4], rp[4];
#pragma unroll
          for (int q4 = 0; q4 < 4; ++q4) { const int it = it0 + q4 * NT; if (it < T * 32) { const int t = it >> 5; ru[q4] = *(const v4u*)(UB + (size_t)t * UB_W + 1536 + c8); rp[q4] = *(const v4u*)(UB + (size_t)((t & (SEQ - 1)) ? t - 1 : t) * UB_W + 1536 + c8); } }
#pragma unroll
          for (int q4 = 0; q4 < 4; ++q4) { const int it = it0 + q4 * NT; if (it < T * 32) { const int t = it >> 5; float u[8], p[8], o[8]; unpack8(ru[q4], u); unpack8(rp[q4], p); const float pm = (t & (SEQ - 1)) ? 1.f : 0.f;
#pragma unroll
              for (int j = 0; j < 8; ++j) { const float s = u[j] + muv[j] * (p[j] * pm - u[j]); o[j] = c8 < 64 ? (1.0f - 2.0f * __builtin_amdgcn_rcpf(1.0f + __builtin_amdgcn_exp2f(2.0f * LOG2E * s))) : (c8 < 128 ? s : sigm(s));     }
              *(v4u*)(LIN + (size_t)t * 256 + c8) = pack8(o); } } } }
    { const int gw = F.bid * NWAVES + F.wave, NGW = F.G * NWAVES, lane = F.lane; float gqv[8], gkv[8];
#pragma unroll
      for (int j = 0; j < 8; ++j) { gqv[j] = gq[((lane & 7) << 3) + j] * QSCALE; gkv[j] = gk[((lane & 7) << 3) + j]; }
      for (int t0 = gw; t0 < T; t0 += 4 * NGW) { v4u rq[4], rk[4];
#pragma unroll
          for (int q4 = 0; q4 < 4; ++q4) { const int t = t0 + q4 * NGW; if (t < T) { rq[q4] = *(const v4u*)(UA + (size_t)t * UA_W + 8 * lane); rk[q4] = *(const v4u*)(UA + (size_t)t * UA_W + UA_K + 8 * (lane & 7)); } }
#pragma unroll
          for (int q4 = 0; q4 < 4; ++q4) { const int t = t0 + q4 * NGW; if (t < T) {
              float q[8], k[8]; unpack8(rq[q4], q); unpack8(rk[q4], k);
              float sq = 0.f, sk = 0.f;
#pragma unroll
              for (int j = 0; j < 8; ++j) { sq += q[j] * q[j]; sk += k[j] * k[j]; }
              sq += __shfl_xor(sq, 1); sq += __shfl_xor(sq, 2); sq += __shfl_xor(sq, 4); sk += __shfl_xor(sk, 1); sk += __shfl_xor(sk, 2); sk += __shfl_xor(sk, 4);
              const float rq_ = rsqrtf(sq * (1.f / 64.f) + NORM_EPS), rk_ = rsqrtf(sk * (1.f / 64.f) + NORM_EPS);
#pragma unroll
              for (int j = 0; j < 8; ++j) { q[j] *= rq_ * gqv[j]; k[j] *= rk_ * gkv[j]; }
              *(v4u*)(QN + (size_t)t * 512 + 8 * lane) = pack8(q);
              if (lane < 8) *(v4u*)(KN + (size_t)t * 64 + 8 * lane) = pack8(k); } } } }
    { const int gt = F.bid * 512 + F.tid, NT = F.G * 512;
      for (int it = gt; it < T * 8; it += NT) { const int t = it >> 3, c8 = (it & 7) << 3; *(v4u*)(VT + (size_t)t * 64 + c8) = *(const v4u*)(UA + (size_t)t * UA_W + UA_V + c8); } }
}
constexpr int IDX_STRIDE = 2052, KSEL = 256;
__device__ __forceinline__ void topk_select(const LAS float* row, int limit, unsigned* maskrow, int lane) {
    unsigned long long mybits = 0ull; const int nj = limit >> 6;
    if (limit <= KSEL) { mybits = lane < nj ? ~0ull : 0ull; }
    else {
        unsigned key[32];
#pragma unroll
        for (int j = 0; j < 32; ++j) { unsigned k = 0u; if (j < nj) { unsigned u = __float_as_uint(row[64 * j + lane]); if (u == 0x80000000u) u = 0u; k = (u & 0x80000000u) ? ~u : (u | 0x80000000u); } key[j] = k; }
        unsigned prefix = 0u; bool exact = false;
        for (int bit = 31; bit >= 0; --bit) { const unsigned cand = prefix | (1u << bit); int cnt = 0;
#pragma unroll
            for (int g8 = 0; g8 < 4; ++g8) if (8 * g8 < nj) {
#pragma unroll
                for (int jj = 0; jj < 8; ++jj) cnt += __builtin_popcountll(__ballot(key[8 * g8 + jj] >= cand)); }
            if (cnt >= KSEL) { prefix = cand; if (cnt == KSEL) { exact = true; break; } } }
        int need = 0;
        if (!exact) { int cgt = 0;
#pragma unroll
            for (int j = 0; j < 32; ++j) cgt += __builtin_popcountll(__ballot(key[j] > prefix));
            need = KSEL - cgt; }
        int running = 0; const unsigned long long below = (1ull << lane) - 1ull;
#pragma unroll
        for (int j = 0; j < 32; ++j) if (j < nj) {
            const bool gt = exact ? (key[j] >= prefix) : (key[j] > prefix); const bool tie = (!exact) && key[j] == prefix;
            const unsigned long long tb = __ballot(tie); const int rank = running + __builtin_popcountll(tb & below); running += __builtin_popcountll(tb);
            const unsigned long long sb = __ballot(gt || (tie && rank < need)); if (lane == j) mybits = sb; }
    }
    if (lane < 32) { v2u w; w.x = (unsigned)mybits; w.y = (unsigned)(mybits >> 32); *(v2u*)(maskrow + 2 * lane) = w; }
}
__device__ __forceinline__ void phase_indexer(Frame& F) {
    unsigned char* ws = F.ws; const bf16* UA = (const bf16*)(ws + WS_UA); unsigned* MASK = (unsigned*)(ws + WS_MASK);
    LAS float* sc = (LAS float*)F.lds; const int lane = F.lane, w = F.wave, fr = lane & 15, fq = lane >> 4;
    for (int r = 0;; ++r) { const int u = r * F.G + ((r & 1) ? (F.G - 1 - F.bid) : F.bid); if (u >= NB * 128) break;
        const int c = 31 - (u >> 7), rest = u & 127, b = rest >> 2, g4 = rest & 3, limit = 64 * (c + 1), tq0 = b * SEQ + c * 64 + g4 * 16;
        const bf16* UAb = UA + (size_t)b * SEQ * UA_W;
        bf16x8 qf[4][2]; float iwv[4];
        { const bf16* qp = UA + (size_t)(tq0 + fr) * UA_W;
#pragma unroll
          for (int hh = 0; hh < 4; ++hh) { qf[hh][0] = *(const bf16x8*)(qp + UA_IQ + hh * 64 + fq * 8); qf[hh][1] = *(const bf16x8*)(qp + UA_IQ + hh * 64 + 32 + fq * 8); iwv[hh] = bf1(qp[UA_IW + hh]) * (1.f / 16.f); } }
#ifndef IDX_SCORE_REP
#define IDX_SCORE_REP 1
#endif
#ifndef IDX_SEL_REP
#define IDX_SEL_REP 1
#endif
        for (int rp_ = 0; rp_ < IDX_SCORE_REP; ++rp_)
        for (int kt = w; kt < (limit >> 4); kt += NWAVES) {
            const bf16* kp = UAb + (size_t)(kt * 16 + fr) * UA_W + UA_IK + fq * 8; const bf16x8 a0 = *(const bf16x8*)kp, a1 = *(const bf16x8*)(kp + 32);
            f32x4 s = {0.f, 0.f, 0.f, 0.f};
#pragma unroll
            for (int hh = 0; hh < 4; ++hh) { f32x4 d = {0.f, 0.f, 0.f, 0.f}; d = __builtin_amdgcn_mfma_f32_16x16x32_bf16(a0, qf[hh][0], d, 0, 0, 0); d = __builtin_amdgcn_mfma_f32_16x16x32_bf16(a1, qf[hh][1], d, 0, 0, 0);
#pragma unroll
                for (int j = 0; j < 4; ++j) s[j] += iwv[hh] * fmaxf(d[j], 0.f); }
            *(LAS f32x4*)(sc + fr * IDX_STRIDE + kt * 16 + fq * 4) = s; }
        __syncthreads();
#pragma unroll 1
        for (int qq = 0; qq < 2 * IDX_SEL_REP; ++qq) { const int q = 2 * w + (qq & 1); topk_select(sc + q * IDX_STRIDE, limit, MASK + (size_t)(tq0 + q) * 64, lane); }
        __syncthreads(); }
}
constexpr int DA_K = 0, DA_V = 8192, DA_M = 16384, DA_STAGE = 16384 + 512;
__device__ __forceinline__ bf16x8 mk8(v2u lo, v2u hi) { v4u t; t.x = lo.x; t.y = lo.y; t.z = hi.x; t.w = hi.y; return __builtin_bit_cast(bf16x8, t); }
__device__ __forceinline__ void tr_read_v4d(unsigned a, bf16x8 (&vf)[4]) { s16x4 l0, h0, l1, h1, l2, h2, l3, h3;
    asm volatile("ds_read_b64_tr_b16 %0, %8\n\tds_read_b64_tr_b16 %1, %8 offset:512\n\tds_read_b64_tr_b16 %2, %8 offset:32\n\tds_read_b64_tr_b16 %3, %8 offset:544\n\t"
                 "ds_read_b64_tr_b16 %4, %8 offset:64\n\tds_read_b64_tr_b16 %5, %8 offset:576\n\tds_read_b64_tr_b16 %6, %8 offset:96\n\tds_read_b64_tr_b16 %7, %8 offset:608\n\ts_waitcnt lgkmcnt(0)"
                 : "=&v"(l0), "=&v"(h0), "=&v"(l1), "=&v"(h1), "=&v"(l2), "=&v"(h2), "=&v"(l3), "=&v"(h3) : "v"(a) : "memory");
    vf[0] = (bf16x8){l0[0], l0[1], l0[2], l0[3], h0[0], h0[1], h0[2], h0[3]}; vf[1] = (bf16x8){l1[0], l1[1], l1[2], l1[3], h1[0], h1[1], h1[2], h1[3]};
    vf[2] = (bf16x8){l2[0], l2[1], l2[2], l2[3], h2[0], h2[1], h2[2], h2[3]}; vf[3] = (bf16x8){l3[0], l3[1], l3[2], l3[3], h3[0], h3[1], h3[2], h3[3]}; }
__device__ __forceinline__ void phase_dsa_attn(Frame& F, const Args& a) {
    unsigned char* ws = F.ws; const bf16* QN = (const bf16*)(ws + WS_QN); const bf16* KN = (const bf16*)(ws + WS_KN); const bf16* VN = (const bf16*)(ws + WS_VT);
    const unsigned* MASK = (const unsigned*)(ws + WS_MASK); bf16* MIX = (bf16*)(ws + WS_XB);
    const int lane = F.lane, w = F.wave, fr = lane & 15, fq = lane >> 4; LAS unsigned char* lds = F.lds;
    const float mb = 8.f * LOG2E * wave_max(fabsf(a.in[3][lane])) * wave_max(fabsf(a.in[4][lane]));
    const unsigned vtr_lane = (unsigned)((8 * fq + ((lane & 15) >> 2)) * 128 + 4 * (lane & 3) * 2);
    for (int r = 0;; ++r) { const int u = r * F.G + ((r & 1) ? (F.G - 1 - F.bid) : F.bid); if (u >= NB * 32) break;
        const int c = 31 - (u >> 5), b = u & 31, nst = c + 1, t0 = b * SEQ + 64 * c;
        const bf16* Kb = KN + (size_t)b * SEQ * 64; const bf16* Vb = VN + (size_t)b * SEQ * 64; const unsigned* Mb = MASK + (size_t)t0 * 64;
#define DA_DMA(st_, buf_) do { const int so_ = (buf_) * DA_STAGE; \
            __builtin_amdgcn_global_load_lds((const unsigned*)(Kb + (size_t)(64 * (st_) + 8 * w) * 64 + lane * 8), (LAS unsigned*)(lds + so_ + DA_K + w * 1024), 16, 0, 0); \
            __builtin_amdgcn_global_load_lds((const unsigned*)(Vb + (size_t)(64 * (st_) + 8 * w) * 64 + lane * 8), (LAS unsigned*)(lds + so_ + DA_V + w * 1024), 16, 0, 0); \
            if (w < 2) __builtin_amdgcn_global_load_lds(Mb + (size_t)lane * 64 + 2 * (st_) + w, (LAS unsigned*)(lds + so_ + DA_M + w * 256), 4, 0, 0); } while (0)
        DA_DMA(0, 0);
        bf16x8 qf[4][2];
#pragma unroll
        for (int i = 0; i < 4; ++i) { const bf16* qp = QN + (size_t)(t0 + 16 * i + fr) * 512 + w * 64 + fq * 8; qf[i][0] = *(const bf16x8*)qp; qf[i][1] = *(const bf16x8*)(qp + 32); }
        f32x4 O[4][4]; float l[4];
#pragma unroll
        for (int i = 0; i < 4; ++i) { l[i] = 0.f;
#pragma unroll
            for (int dt = 0; dt < 4; ++dt) O[i][dt] = (f32x4){0.f, 0.f, 0.f, 0.f}; }
        for (int st = 0; st < nst; ++st) { const int buf = st & 1; const LAS unsigned char* sb = lds + buf * DA_STAGE;
            asm volatile("s_waitcnt vmcnt(0)" ::: "memory");
            __builtin_amdgcn_s_barrier(); asm volatile("" ::: "memory");
            if (st + 1 < nst) DA_DMA(st + 1, buf ^ 1);
#pragma unroll
            for (int sub = 0; sub < 2; ++sub) {
                bf16x8 kf[2][2], vf[4]; unsigned mw[4];
#pragma unroll
                for (int s2 = 0; s2 < 2; ++s2) { const LAS unsigned char* kp = sb + DA_K + (32 * sub + 8 * (fr >> 2) + 4 * s2 + (fr & 3)) * 128 + fq * 16;   kf[s2][0] = *(const LAS bf16x8*)kp; kf[s2][1] = *(const LAS bf16x8*)(kp + 64); }
#pragma unroll
                for (int i = 0; i < 4; ++i) mw[i] = *(const LAS unsigned*)(sb + DA_M + sub * 256 + (16 * i + fr) * 4);
                tr_read_v4d((unsigned)(size_t)(sb + DA_V + sub * 4096) + vtr_lane, vf);
#pragma unroll
                for (int i = 0; i < 4; ++i) {
                    f32x4 s0 = {0.f, 0.f, 0.f, 0.f}, s1 = {0.f, 0.f, 0.f, 0.f};
                    s0 = __builtin_amdgcn_mfma_f32_16x16x32_bf16(kf[0][0], qf[i][0], s0, 0, 0, 0); s0 = __builtin_amdgcn_mfma_f32_16x16x32_bf16(kf[0][1], qf[i][1], s0, 0, 0, 0);
                    s1 = __builtin_amdgcn_mfma_f32_16x16x32_bf16(kf[1][0], qf[i][0], s1, 0, 0, 0); s1 = __builtin_amdgcn_mfma_f32_16x16x32_bf16(kf[1][1], qf[i][1], s1, 0, 0, 0);
                    const unsigned b0 = mw[i] >> (8 * fq), b1 = mw[i] >> (8 * fq + 4); float p[8];
#pragma unroll
                    for (int j = 0; j < 4; ++j) { p[j] = ((b0 >> j) & 1u) ? __builtin_amdgcn_exp2f(s0[j] - mb) : 0.f; p[4 + j] = ((b1 >> j) & 1u) ? __builtin_amdgcn_exp2f(s1[j] - mb) : 0.f; }
                    l[i] += ((p[0] + p[1]) + (p[2] + p[3])) + ((p[4] + p[5]) + (p[6] + p[7]));
                    const bf16x8 pa = __builtin_bit_cast(bf16x8, pack8(p));
#pragma unroll
                    for (int dt = 0; dt < 4; ++dt) O[i][dt] = __builtin_amdgcn_mfma_f32_16x16x32_bf16(pa, vf[dt], O[i][dt], 0, 0, 0);
                } } }
#undef DA_DMA
#pragma unroll
        for (int i = 0; i < 4; ++i) { float li = l[i]; li += __shfl_xor(li, 16); li += __shfl_xor(li, 32);
#pragma unroll
            for (int j = 0; j < 4; ++j) { const float inv = 1.0f / __shfl(li, 4 * fq + j); bf16* op = MIX + (size_t)(t0 + 16 * i + 4 * fq + j) * D + w * 64 + fr;
#pragma unroll
                for (int dt = 0; dt < 4; ++dt) op[16 * dt] = (bf16)f2bf(O[i][dt][j] * inv); } }
        VM_WAIT(); __syncthreads();
    }
}
__device__ __forceinline__ float rw_decay(float x) { const float sp = fmaxf(-x, 0.f) + 0.6931471805599453f * __builtin_amdgcn_logf(1.0f + __builtin_amdgcn_exp2f(-LOG2E * fabsf(x)));
    return __builtin_amdgcn_exp2f(-LOG2E * __builtin_amdgcn_exp2f(-LOG2E * (sp + 0.5f))); }
#define MF32(a_, b_, c_) __builtin_amdgcn_mfma_f32_16x16x4f32((a_), (b_), (c_), 0, 0, 0)
constexpr int RL_AH = 0, RL_BH = 4096, RL_KH = 8192, RL_RH = 12288, RL_VX = 16384, RL_GS = 20480, RL_YA = 24576, RL_GR = 28672, RL_PM = 32768, RL_GC = 33792, RL_BON = 34048, RL_END = 34112;
static_assert(RL_END * 4 <= MISC_OFF, "RWKV LDS");
__device__ __forceinline__ void phase_rwkv(Frame& F, const Args& a) {
    unsigned char* ws = F.ws; const bf16* UB = (const bf16*)(ws + WS_UB); const bf16* LOUT = (const bf16*)(ws + WS_LOUT); bf16* MIX = (bf16*)(ws + WS_XB);
    const float* mu = a.in[6]; const float* w0 = a.in[7]; const float* a0 = a.in[9]; const float* k_k = a.in[12]; const float* k_a = a.in[13]; const float* r_k = a.in[14]; const float* gn_g = a.in[15]; const float* gn_b = a.in[16];
    const int lane = F.lane, w = F.wave, n = lane & 15, q = lane >> 4;
    LAS float* L = (LAS float*)F.lds;
    for (int bh = F.bid; bh < NB * 8; bh += F.G) {
        const int b = bh >> 3, h = bh & 7, c = h * 64 + lane;
        const float mur = mu[c], muk = mu[512 + c], muv = mu[1024 + c], w0c = w0[c], a0c = a0[c], kkc = k_k[c], kac = k_a[c], rkc = r_k[c], gng = gn_g[c], gnb = gn_b[c];
        f32x4 Z[4];
#pragma unroll
        for (int kt = 0; kt < 4; ++kt) Z[kt] = (f32x4){0.f, 0.f, 0.f, 0.f};
        const int ch = w >> 1, hs = w & 1;
        float r_ur[8], r_uk[8], r_uv[8], r_pr[8], r_pk[8], r_pv[8], r_wd[8], r_ad[8], r_gg[8], r_wf[8];
#define RW_RAW(batch_) do { _Pragma("unroll") for (int i = 0; i < 8; ++i) { const int sl = (batch_) * 64 + 16 * ch + 8 * hs + i; const size_t t = (size_t)b * SEQ + sl; const bf16* up = UB + t * UB_W + c; const bf16* pp_ = sl > 0 ? up - UB_W : up; \
            r_ur[i] = bf1(up[0]); r_uk[i] = bf1(up[512]); r_uv[i] = bf1(up[1024]); r_pr[i] = bf1(pp_[0]); r_pk[i] = bf1(pp_[512]); r_pv[i] = bf1(pp_[1024]); \
            const bf16* lp = LOUT + t * 1536 + c; r_wd[i] = bf1(lp[0]); r_ad[i] = bf1(lp[512]); r_gg[i] = bf1(lp[1024]); \
            r_wf[i] = bf1(LOUT[((size_t)b * SEQ + (batch_) * 64 + 16 * ch + i) * 1536 + c]); } } while (0)
        RW_RAW(0);
        for (int batch = 0; batch < SEQ / 64; ++batch) {
            { float gcur = 1.f;
              if (hs) {
#pragma unroll
                  for (int i = 0; i < 8; ++i) gcur *= rw_decay(w0c + r_wf[i]); }
#pragma unroll
              for (int i = 0; i < 8; ++i) { const int tl = 16 * ch + 8 * hs + i, sl = batch * 64 + tl; const float pm = sl > 0 ? 1.f : 0.f;
                const float ur = r_ur[i], uk = r_uk[i], uv = r_uv[i], pr = r_pr[i] * pm, pk = r_pk[i] * pm, pv = r_pv[i] * pm;
                const float rr = ur + mur * (pr - ur), kx = uk + muk * (pk - uk), vx = uv + muv * (pv - uv);
                const float decay = rw_decay(w0c + r_wd[i]), av = sigm(a0c + r_ad[i]);
                float kk = kx * kkc; kk = kk * rsqrtf(fmaxf(wave_sum(kk * kk), 1e-24f));
                const float km = kx * (1.f + (av - 1.f) * kac); const float bon = wave_sum(rr * km * rkc);
                const float gprev = gcur; gcur *= decay; const float ig = __builtin_amdgcn_rcpf(gcur);
                L[RL_AH + tl * 64 + lane] = -kk * gprev; L[RL_BH + tl * 64 + lane] = kk * av * ig; L[RL_KH + tl * 64 + lane] = km * ig; L[RL_RH + tl * 64 + lane] = rr * gcur;
                L[RL_VX + tl * 64 + lane] = vx; L[RL_GS + tl * 64 + lane] = r_gg[i]; if (lane == 0) L[RL_BON + tl] = bon; }
              if (hs) L[RL_GC + ch * 64 + lane] = gcur; }
            LDS_WAIT(); __syncthreads();
            if (batch + 1 < SEQ / 64) RW_RAW(batch + 1);
            { const LAS float* ah = L + RL_AH + 16 * ch * 64; const LAS float* bhm = L + RL_BH + 16 * ch * 64; const LAS float* khm = L + RL_KH + 16 * ch * 64; const LAS float* rhm = L + RL_RH + 16 * ch * 64;
              LAS float* gr = L + RL_GR + ch * 1024; LAS float* pm_ = L + RL_PM + ch * 256;
              if (hs == 0) {
                  f32x4 m = {0.f, 0.f, 0.f, 0.f};
#pragma unroll
                  for (int s = 0; s < 16; ++s) m = MF32(bhm[n * 64 + 4 * s + q], ah[n * 64 + 4 * s + q], m);
                  f32x4 tm;
#pragma unroll
                  for (int j = 0; j < 4; ++j) { m[j] = (4 * q + j < n) ? m[j] : 0.f; tm[j] = m[j] + ((4 * q + j == n) ? 1.f : 0.f); pm_[(4 * q + j) * 16 + n] = m[j]; gr[(4 * q + j) * 16 + n] = tm[j]; }
#pragma unroll
                  for (int rd = 0; rd < 3; ++rd) { LDS_WAIT();
                      f32x4 p2 = {0.f, 0.f, 0.f, 0.f};
#pragma unroll
                      for (int s = 0; s < 4; ++s) p2 = MF32(pm_[n * 16 + 4 * s + q], pm_[(4 * s + q) * 16 + n], p2);
                      f32x4 ip, t2 = {0.f, 0.f, 0.f, 0.f};
#pragma unroll
                      for (int j = 0; j < 4; ++j) ip[j] = p2[j] + ((4 * q + j == n) ? 1.f : 0.f);
#pragma unroll
                      for (int j = 0; j < 4; ++j) t2 = MF32(gr[n * 16 + 4 * q + j], ip[j], t2);
                      LDS_WAIT();
#pragma unroll
                      for (int j = 0; j < 4; ++j) { pm_[(4 * q + j) * 16 + n] = p2[j]; gr[(4 * q + j) * 16 + n] = t2[j]; } }
              } else {
                  f32x4 mk = {0.f, 0.f, 0.f, 0.f}, nb = {0.f, 0.f, 0.f, 0.f}, nk = {0.f, 0.f, 0.f, 0.f};
#pragma unroll
                  for (int s = 0; s < 16; ++s) { const float av_ = ah[n * 64 + 4 * s + q], rv_ = rhm[n * 64 + 4 * s + q], bv_ = bhm[n * 64 + 4 * s + q], kv_ = khm[n * 64 + 4 * s + q];
                      mk = MF32(kv_, av_, mk); nb = MF32(bv_, rv_, nb); nk = MF32(kv_, rv_, nk); }
#pragma unroll
                  for (int j = 0; j < 4; ++j) { const int s_ = 4 * q + j; gr[256 + s_ * 16 + n] = (s_ < n) ? mk[j] : 0.f; gr[512 + s_ * 16 + n] = (s_ <= n) ? nb[j] : 0.f; gr[768 + s_ * 16 + n] = (s_ <= n) ? nk[j] : 0.f; } } }
            LDS_WAIT(); __syncthreads();
#ifndef RW_C_REP
#define RW_C_REP 1
#endif
            if (w < 4) { const int v = 16 * w + n; f32x4 Zs[4]; for (int kt = 0; kt < 4; ++kt) Zs[kt] = Z[kt];
              for (int rc_ = 0; rc_ < RW_C_REP; ++rc_) { if (rc_) for (int kt = 0; kt < 4; ++kt) Z[kt] = Zs[kt];
#pragma unroll 1
                for (int cc = 0; cc < 4; ++cc) { const LAS float* ah = L + RL_AH + 16 * cc * 64; const LAS float* bhm = L + RL_BH + 16 * cc * 64; const LAS float* khm = L + RL_KH + 16 * cc * 64; const LAS float* rhm = L + RL_RH + 16 * cc * 64;
                    const LAS float* vx = L + RL_VX + 16 * cc * 64; const LAS float* gr = L + RL_GR + cc * 1024;
                    float vb[4];
#pragma unroll
                    for (int s = 0; s < 4; ++s) vb[s] = vx[(4 * s + q) * 64 + v];
                    f32x4 X = {0.f, 0.f, 0.f, 0.f}, Y = {0.f, 0.f, 0.f, 0.f};
#pragma unroll
                    for (int kt = 0; kt < 4; ++kt)
#pragma unroll
                        for (int j = 0; j < 4; ++j) { X = MF32(ah[n * 64 + 16 * kt + 4 * q + j], Z[kt][j], X); Y = MF32(rhm[n * 64 + 16 * kt + 4 * q + j], Z[kt][j], Y); }
#pragma unroll
                    for (int s = 0; s < 4; ++s) { X = MF32(gr[256 + (4 * s + q) * 16 + n], vb[s], X); Y = MF32(gr[768 + (4 * s + q) * 16 + n], vb[s], Y); }
                    f32x4 U = {0.f, 0.f, 0.f, 0.f};
#pragma unroll
                    for (int j = 0; j < 4; ++j) U = MF32(gr[(4 * q + j) * 16 + n], X[j], U);
#pragma unroll
                    for (int j = 0; j < 4; ++j) Y = MF32(gr[512 + (4 * q + j) * 16 + n], U[j], Y);
#pragma unroll
                    for (int j = 0; j < 4; ++j) L[RL_YA + (16 * cc + 4 * q + j) * 64 + v] = Y[j];
#pragma unroll
                    for (int kt = 0; kt < 4; ++kt) {
#pragma unroll
                        for (int j = 0; j < 4; ++j) Z[kt] = MF32(bhm[(4 * q + j) * 64 + 16 * kt + n], U[j], Z[kt]);
#pragma unroll
                        for (int s = 0; s < 4; ++s) Z[kt] = MF32(khm[(4 * s + q) * 64 + 16 * kt + n], vb[s], Z[kt]);
                        const f32x4 gc = *(const LAS f32x4*)(L + RL_GC + cc * 64 + 16 * kt + 4 * q); Z[kt] = Z[kt] * gc; } } } }
            LDS_WAIT(); __syncthreads();
            for (int i = 0; i < 8; ++i) { const int step = w + 8 * i; const size_t t = (size_t)b * SEQ + batch * 64 + step;
                const float y = L[RL_YA + step * 64 + lane], mean = wave_sum(y) * (1.f / 64.f), dlt = y - mean, var = wave_sum(dlt * dlt) * (1.f / 64.f);
                const float yn = dlt * rsqrtf(var + 64e-5f) * gng + gnb; const float o = (yn + L[RL_BON + step] * L[RL_VX + step * 64 + lane]) * L[RL_GS + step * 64 + lane];
                MIX[t * D + 512 + c] = (bf16)f2bf(o); }
            LDS_WAIT(); __syncthreads();
        }
#undef RW_RAW
    }
}
__device__ __forceinline__ void phase_l1prep(Frame& F, const Args& a, int hb) {
    unsigned char* ws = F.ws; const bf16* XM = (const bf16*)(ws + WS_XM); bf16* XC = (bf16*)(ws + WS_XC); bf16* Q = (bf16*)(ws + WS_Q); bf16* K = (bf16*)(ws + WS_K); bf16* V = (bf16*)(ws + WS_V);
    float* GI = (float*)(ws + WS_GI); const float* W12 = (const float*)(ws + WS_W12);
    const float* cw = a.in[19]; const float* cb = a.in[20]; const float* wq = a.in[21]; const float* wk = a.in[22]; const float* wv = a.in[23]; const float* b_i = a.in[25]; const float* b_f = a.in[26];
    const int g = F.tid, lane = F.lane, w = F.wave; LAS float* red = (LAS float*)F.lds;
    float cwr[4][4], cbr[4], wqr[16], wkr[16], wvr[16], w1[32], w2[32];
#pragma unroll
    for (int j = 0; j < 4; ++j)
#pragma unroll
        for (int i = 0; i < 4; ++i) cwr[j][i] = cw[j * CI + 4 * g + i];
#pragma unroll
    for (int i = 0; i < 4; ++i) cbr[i] = cb[4 * g + i];
#pragma unroll
    for (int i = 0; i < 16; ++i) { wqr[i] = wq[g * 16 + i]; wkr[i] = wk[g * 16 + i]; wvr[i] = wv[g * 16 + i]; }
#pragma unroll
    for (int i = 0; i < 32; ++i) { w1[i] = W12[(size_t)(4 * g) * 8 + i]; w2[i] = W12[(size_t)(2048 + 4 * g) * 8 + i]; }
    const int per = TH / F.G;
    const int tb = F.bid * per;
    float x0[4], x1[4], x2[4];
    { const int sl = tb & (SEQ - 1);
#pragma unroll
      for (int i = 0; i < 4; ++i) { x0[i] = 0.f; x1[i] = 0.f; x2[i] = 0.f; }
      if (sl >= 1) { const v2u r = *(const v2u*)(XM + (size_t)(tb - 1) * CI + 4 * g); x2[0] = bflo(r.x); x2[1] = bfhi(r.x); x2[2] = bflo(r.y); x2[3] = bfhi(r.y); }
      if (sl >= 2) { const v2u r = *(const v2u*)(XM + (size_t)(tb - 2) * CI + 4 * g); x1[0] = bflo(r.x); x1[1] = bfhi(r.x); x1[2] = bflo(r.y); x1[3] = bfhi(r.y); }
      if (sl >= 3) { const v2u r = *(const v2u*)(XM + (size_t)(tb - 3) * CI + 4 * g); x0[0] = bflo(r.x); x0[1] = bfhi(r.x); x0[2] = bflo(r.y); x0[3] = bfhi(r.y); } }
    v2u xnext[2];
#pragma unroll
    for (int tk = 0; tk < 2; ++tk) xnext[tk] = *(const v2u*)(XM + (size_t)(tb + tk) * CI + 4 * g);
    for (int n4 = 0; n4 < per / 2; ++n4) { const int t4 = tb + 2 * n4;
        float gs[16]; v2u xr[2];
        xr[0] = xnext[0]; xr[1] = xnext[1];
        if (n4 + 1 < per / 2) {
#pragma unroll
            for (int tk = 0; tk < 2; ++tk) xnext[tk] = *(const v2u*)(XM + (size_t)(t4 + 2 + tk) * CI + 4 * g); }
#pragma unroll
        for (int tk = 0; tk < 2; ++tk) { const int t = t4 + tk;
            float x3[4]; x3[0] = bflo(xr[tk].x); x3[1] = bfhi(xr[tk].x); x3[2] = bflo(xr[tk].y); x3[3] = bfhi(xr[tk].y);
            float xc[4], q[4], k[4], v[4];
#pragma unroll
            for (int i = 0; i < 4; ++i) { const float s = cbr[i] + cwr[0][i] * x0[i] + cwr[1][i] * x1[i] + cwr[2][i] * x2[i] + cwr[3][i] * x3[i]; xc[i] = s * sigm(s); }
#pragma unroll
            for (int j = 0; j < 4; ++j) { q[j] = xc[0] * wqr[j] + xc[1] * wqr[4 + j] + xc[2] * wqr[8 + j] + xc[3] * wqr[12 + j]; k[j] = xc[0] * wkr[j] + xc[1] * wkr[4 + j] + xc[2] * wkr[8 + j] + xc[3] * wkr[12 + j];
                v[j] = x3[0] * wvr[j] + x3[1] * wvr[4 + j] + x3[2] * wvr[8 + j] + x3[3] * wvr[12 + j]; }
#pragma unroll
            for (int o = 0; o < 8; ++o) { float s = 0.f;
#pragma unroll
                for (int i = 0; i < 4; ++i) s += xc[i] * w1[i * 8 + o] + x3[i] * w2[i * 8 + o];
                gs[tk * 8 + o] = s; }
            const size_t off = (size_t)t * CI + 4 * g; const float ks = 0.044194173824159216f;
            { v2u o; o.x = pk2(xc[0], xc[1]); o.y = pk2(xc[2], xc[3]); *(v2u*)(XC + off) = o; o.x = pk2(q[0], q[1]); o.y = pk2(q[2], q[3]); *(v2u*)(Q + off) = o;
              o.x = pk2(k[0] * ks, k[1] * ks); o.y = pk2(k[2] * ks, k[3] * ks); *(v2u*)(K + off) = o; o.x = pk2(v[0], v[1]); o.y = pk2(v[2], v[3]); *(v2u*)(V + off) = o; }
#pragma unroll
            for (int i = 0; i < 4; ++i) { x0[i] = x1[i]; x1[i] = x2[i]; x2[i] = x3[i]; } }
#define L1_STAGE(mask, n) { const bool hi_ = (lane & (mask)) != 0; _Pragma("unroll") for (int i = 0; i < (n) / 2; ++i) { const float send_ = hi_ ? gs[i] : gs[(n) / 2 + i]; const float keep_ = hi_ ? gs[(n) / 2 + i] : gs[i]; gs[i] = keep_ + __shfl_xor(send_, (mask)); } }
        L1_STAGE(32, 16) L1_STAGE(16, 8) L1_STAGE(8, 4) L1_STAGE(4, 2)
#undef L1_STAGE
        gs[0] += __shfl_xor(gs[0], 2); gs[0] += __shfl_xor(gs[0], 1);
        LAS float* rp = red + (n4 & 1) * 128;
        if ((lane & 3) == 0) rp[w * 16 + (lane >> 2)] = gs[0];
        LDS_WAIT(); __syncthreads();
        if (F.tid < 16) { float s = 0.f;
#pragma unroll
            for (int ww = 0; ww < 8; ++ww) s += rp[ww * 16 + F.tid];
            const int o = F.tid & 7; GI[(size_t)(t4 + (F.tid >> 3)) * 8 + o] = s + (o < 4 ? b_i[o] : b_f[o - 4]); }
    }
}
__device__ __forceinline__ void phase_gatescan(Frame& F) {
    unsigned char* ws = F.ws; const float* GI = (const float*)(ws + WS_GI); float* GA = (float*)(ws + WS_GA); float* GAM = (float*)(ws + WS_GAM); float* GEM = (float*)(ws + WS_GEM);
    const int lane = F.lane, w = F.wave, tid = F.tid; LAS float* wtot = (LAS float*)F.lds;
    for (int sq = F.bid; sq < (NB / 2) * 4; sq += F.G) { const int bl = sq >> 2, h = sq & 3; const size_t tq = (size_t)bl * SEQ + 4 * tid;
        float ip[4], c[4];
#pragma unroll
        for (int k = 0; k < 4; ++k) { ip[k] = GI[(tq + k) * 8 + h]; c[k] = -softplusf_(-GI[(tq + k) * 8 + 4 + h]); }
        c[1] += c[0]; c[2] += c[1]; c[3] += c[2];
        float inc = c[3];
#pragma unroll
        for (int o = 1; o < 64; o <<= 1) { const float n = __shfl_up(inc, o); if (lane >= o) inc += n; }
        if (lane == 63) wtot[w] = inc;
        LDS_WAIT(); __syncthreads();
        float off = inc - c[3];
#pragma unroll
        for (int ww = 0; ww < 8; ++ww) if (ww < w) off += wtot[ww];
        float Fv[4], av[4], m[4];
#pragma unroll
        for (int k = 0; k < 4; ++k) { Fv[k] = off + c[k]; av[k] = ip[k] - Fv[k]; }
        m[0] = av[0]; m[1] = fmaxf(m[0], av[1]); m[2] = fmaxf(m[1], av[2]); m[3] = fmaxf(m[2], av[3]);
        float incm = m[3];
#pragma unroll
        for (int o = 1; o < 64; o <<= 1) { const float n = __shfl_up(incm, o); if (lane >= o) incm = fmaxf(incm, n); }
        if (lane == 63) wtot[8 + w] = incm;
        LDS_WAIT(); __syncthreads();
        float offm = __shfl_up(incm, 1); if (lane == 0) offm = -INFINITY;
#pragma unroll
        for (int ww = 0; ww < 8; ++ww) if (ww < w) offm = fmaxf(offm, wtot[8 + ww]);
#pragma unroll
        for (int k = 0; k < 4; ++k) { const float A = fmaxf(offm, m[k]); GA[(tq + k) * 4 + h] = av[k]; GAM[(tq + k) * 4 + h] = A; GEM[(tq + k) * 4 + h] = __expf(-(Fv[k] + A)); }
        LDS_WAIT(); __syncthreads();
    }
}
constexpr int ML_PITCH = 1040, ML_TILE = 32 * ML_PITCH, ML_PP = 80, ML_PT = 64 * ML_PP;
constexpr int ML_K = 0, ML_V = 2 * ML_TILE, ML_P = 4 * ML_TILE, ML_DEN = ML_P + 2 * ML_PT, ML_AT = ML_DEN + 512, ML_AS = ML_AT + 256, ML_END = ML_AS + 8192;
constexpr int ML_ST = ML_P, ML_MR = ML_P + 4096;
static_assert(ML_MR + 512 <= ML_DEN, "mLSTM LDS tables");
static_assert(ML_END <= MISC_OFF, "mLSTM LDS");
__device__ __forceinline__ void tr_read_v4(unsigned a, bf16x8 (&vf)[4]) { s16x4 l0, h0, l1, h1, l2, h2, l3, h3;
    asm volatile("ds_read_b64_tr_b16 %0, %8\n\tds_read_b64_tr_b16 %1, %8 offset:4160\n\tds_read_b64_tr_b16 %2, %8 offset:32\n\tds_read_b64_tr_b16 %3, %8 offset:4192\n\t"
                 "ds_read_b64_tr_b16 %4, %8 offset:64\n\tds_read_b64_tr_b16 %5, %8 offset:4224\n\tds_read_b64_tr_b16 %6, %8 offset:96\n\tds_read_b64_tr_b16 %7, %8 offset:4256\n\ts_waitcnt lgkmcnt(0)"
                 : "=&v"(l0), "=&v"(h0), "=&v"(l1), "=&v"(h1), "=&v"(l2), "=&v"(h2), "=&v"(l3), "=&v"(h3) : "v"(a) : "memory");
    vf[0] = (bf16x8){l0[0], l0[1], l0[2], l0[3], h0[0], h0[1], h0[2], h0[3]}; vf[1] = (bf16x8){l1[0], l1[1], l1[2], l1[3], h1[0], h1[1], h1[2], h1[3]};
    vf[2] = (bf16x8){l2[0], l2[1], l2[2], l2[3], h2[0], h2[1], h2[2], h2[3]}; vf[3] = (bf16x8){l3[0], l3[1], l3[2], l3[3], h3[0], h3[1], h3[2], h3[3]}; }
static_assert(4 * ML_PITCH == 4160, "tr_read_v4 offsets");
__device__ __forceinline__ void phase_mlstm(Frame& F, const Args& a) {
    unsigned char* ws = F.ws; const bf16* Q = (const bf16*)(ws + WS_Q); const bf16* K = (const bf16*)(ws + WS_K); const bf16* V = (const bf16*)(ws + WS_V); const bf16* XC = (const bf16*)(ws + WS_XC); const bf16* Z = (const bf16*)(ws + WS_Z);
    bf16* YC = (bf16*)(ws + WS_XM); const float* GA = (const float*)(ws + WS_GA); const float* GAM = (const float*)(ws + WS_GAM); const float* GEM = (const float*)(ws + WS_GEM);
    const float* mh_g = a.in[27]; const float* skip = a.in[28];
    const int tid = F.tid, lane = F.lane, w = F.wave, fr = lane & 15, fq = lane >> 4; LAS unsigned char* lds = F.lds;
    LAS float* den2 = (LAS float*)(lds + ML_DEN); LAS float* stats = (LAS float*)(lds + ML_ST); LAS float* mr = (LAS float*)(lds + ML_MR); LAS float* em_s = (LAS float*)(lds + ML_AT); LAS float* as_s = (LAS float*)(lds + ML_AS);
    const int tt = w >> 1, st = w & 1;
    const unsigned vtr_lane = (unsigned)((8 * fq + ((lane & 15) >> 2)) * ML_PITCH + (64 * w + 4 * (lane & 3)) * 2);
#ifndef ML_DMA_REP
#define ML_DMA_REP 1
#endif
#define ML_DMA(gbase, tile_off) do { _Pragma("unroll") for (int r4_ = 0; r4_ < 4 * ML_DMA_REP; ++r4_) { const int r4 = r4_ & 3; const int rr = w + 8 * r4; \
        __builtin_amdgcn_global_load_lds((const unsigned*)((gbase) + (size_t)rr * CI + lane * 8), (LAS unsigned*)(lds + (tile_off) + rr * ML_PITCH), 16, 0, 0); } } while (0)
    for (int r = 0; r < 8; ++r) { const int xcd = F.bid & 7, cq = F.bid >> 3, c16 = cq & 15; if (F.G != 256) break;
        const int part = r & 1, qi = part ? 31 - c16 : c16, bh = xcd + 8 * ((cq >> 4) + 2 * (r >> 1)), bl = bh >> 2, h = bh & 3; const size_t t0 = (size_t)bl * SEQ + 64 * qi; const int nk = 2 * (qi + 1), jstart = part ? 2 * (c16 + 1) : 0;
        const bf16* Kb = K + (size_t)bl * SEQ * CI + h * 512; const bf16* Vb = V + (size_t)bl * SEQ * CI + h * 512;
        ML_DMA(Kb + (size_t)(32 * jstart) * CI, ML_K); ML_DMA(Vb + (size_t)(32 * jstart) * CI, ML_V);
        bf16x8 qf[16];
        { const bf16* qp = Q + (t0 + 16 * tt + fr) * CI + h * 512 + fq * 8;
#pragma unroll
          for (int ks = 0; ks < 16; ++ks) qf[ks] = *(const bf16x8*)(qp + 32 * ks); }
        const float At = GAM[(t0 + 16 * tt + fr) * 4 + h];
        if (tid < 64) em_s[tid] = GEM[(t0 + tid) * 4 + h];
#pragma unroll
        for (int i4 = 0; i4 < 4; ++i4) { const int sidx = tid + 512 * i4; if (sidx < 64 * (qi + 1)) as_s[sidx] = GA[((size_t)bl * SEQ + sidx) * 4 + h]; }
        VM_WAIT(); LDS_WAIT();
        f32x4 O[4][4]; float denp = 0.f;
#pragma unroll
        for (int i = 0; i < 4; ++i)
#pragma unroll
            for (int e = 0; e < 4; ++e) O[i][e] = (f32x4){0.f, 0.f, 0.f, 0.f};
        for (int jj = 0; jj < nk; ++jj) { const int buf = jj & 1; int j = jj + jstart; if (j >= nk) j -= nk; int jn = j + 1; if (jn >= nk) jn -= nk;
            asm volatile("s_waitcnt vmcnt(0)" ::: "memory");
            __builtin_amdgcn_s_barrier(); asm volatile("" ::: "memory");
            if (jj + 1 < nk) ML_DMA(Kb + (size_t)(32 * jn) * CI, ML_K + (buf ^ 1) * ML_TILE);
            f32x4 sacc = {0.f, 0.f, 0.f, 0.f}, sacb = {0.f, 0.f, 0.f, 0.f};
            { const LAS unsigned char* kl = lds + ML_K + buf * ML_TILE + (16 * st + fr) * ML_PITCH + fq * 16;
#pragma unroll
              for (int ks = 0; ks < 16; ks += 2) { const bf16x8 kf = *(const LAS bf16x8*)(kl + 64 * ks), kg = *(const LAS bf16x8*)(kl + 64 * ks + 64);
                  sacc = __builtin_amdgcn_mfma_f32_16x16x32_bf16(kf, qf[ks], sacc, 0, 0, 0); sacb = __builtin_amdgcn_mfma_f32_16x16x32_bf16(kg, qf[ks + 1], sacb, 0, 0, 0); if ((ks & 3) == 2) __builtin_amdgcn_sched_barrier(0); } }
            sacc += sacb;
#ifdef ML_S_REP
            { f32x4 s2a = {0.f, 0.f, 0.f, 0.f}, s2b = {0.f, 0.f, 0.f, 0.f}; const LAS unsigned char* kl = lds + ML_K + buf * ML_TILE + (16 * st + fr) * ML_PITCH + fq * 16; asm volatile("" ::: "memory");
#pragma unroll
              for (int ks = 0; ks < 16; ks += 2) { const bf16x8 kf = *(const LAS bf16x8*)(kl + 64 * ks), kg = *(const LAS bf16x8*)(kl + 64 * ks + 64);
                  s2a = __builtin_amdgcn_mfma_f32_16x16x32_bf16(kf, qf[ks], s2a, 0, 0, 0); s2b = __builtin_amdgcn_mfma_f32_16x16x32_bf16(kg, qf[ks + 1], s2b, 0, 0, 0); if ((ks & 3) == 2) __builtin_amdgcn_sched_barrier(0); }
              sacc = (sacc + (s2a + s2b)) * 0.5f; }
#endif
            float p[4]; const f32x4 asv = *(const LAS f32x4*)(as_s + 32 * j + 16 * st + 4 * fq); const float as[4] = {asv[0], asv[1], asv[2], asv[3]};
#pragma unroll
            for (int i = 0; i < 4; ++i) { const bool ok = (32 * j + 16 * st + 4 * fq + i) <= (64 * qi + 16 * tt + fr); p[i] = ok ? sacc[i] * __builtin_amdgcn_exp2f((as[i] - At) * LOG2E) : 0.f; }
            denp += (p[0] + p[1]) + (p[2] + p[3]);
            { v2u pw; pw.x = pk2(p[0], p[1]); pw.y = pk2(p[2], p[3]); *(LAS v2u*)(lds + ML_P + buf * ML_PT + (16 * tt + fr) * ML_PP + (16 * st + 4 * fq) * 2) = pw; }
            LDS_WAIT(); __builtin_amdgcn_s_barrier(); asm volatile("" ::: "memory");
            if (jj + 1 < nk) ML_DMA(Vb + (size_t)(32 * jn) * CI, ML_V + (buf ^ 1) * ML_TILE);
            { bf16x8 vf[4], pf[4]; const unsigned vb = (unsigned)(size_t)(lds + ML_V + buf * ML_TILE) + vtr_lane;
              tr_read_v4(vb, vf);
#pragma unroll
              for (int i = 0; i < 4; ++i) pf[i] = *(const LAS bf16x8*)(lds + ML_P + buf * ML_PT + (16 * i + fr) * ML_PP + fq * 16);
#pragma unroll
              for (int i = 0; i < 4; ++i)
#pragma unroll
                  for (int e = 0; e < 4; ++e) O[i][e] = __builtin_amdgcn_mfma_f32_16x16x32_bf16(pf[i], vf[e], O[i][e], 0, 0, 0); }
        }
        { float d = denp; d += __shfl_xor(d, 16); d += __shfl_xor(d, 32); if (fq == 0) den2[st * 64 + 16 * tt + fr] = d; }
        LDS_WAIT(); __syncthreads();
        { const LAS float* den_q = den2 + 4 * fq; const LAS float* em_q = em_s + 4 * fq; LAS float* st_q = stats + (w * 64 + 4 * fq) * 2;
#pragma unroll
          for (int i = 0; i < 4; ++i) {
#pragma unroll
            for (int jj = 0; jj < 4; ++jj) { const float dn = den_q[16 * i + jj] + den_q[64 + 16 * i + jj]; const float inv = 1.0f / fmaxf(fabsf(dn), em_q[16 * i + jj]); float a1 = 0.f, a2 = 0.f;
#pragma unroll
                for (int e = 0; e < 4; ++e) { const float hv = O[i][e][jj] * inv; O[i][e][jj] = hv; a1 += hv; a2 += hv * hv; }
#pragma unroll
                for (int o = 1; o < 16; o <<= 1) { a1 += __shfl_xor(a1, o); a2 += __shfl_xor(a2, o); }
                if (fr == 0) { st_q[(16 * i + jj) * 2] = a1; st_q[(16 * i + jj) * 2 + 1] = a2; } } } }
        LDS_WAIT(); __syncthreads();
        if (tid < 64) { float a1 = 0.f, a2 = 0.f;
#pragma unroll
            for (int ww = 0; ww < 8; ++ww) { a1 += stats[(ww * 64 + tid) * 2]; a2 += stats[(ww * 64 + tid) * 2 + 1]; }
            const float mean = a1 * (1.f / 512.f), var = fmaxf(a2 * (1.f / 512.f) - mean * mean, 0.f); mr[2 * tid] = mean; mr[2 * tid + 1] = rsqrtf(var + 1e-5f); }
        LDS_WAIT(); __syncthreads();
        { LAS float* ytile = (LAS float*)lds; LAS float* yt_q = ytile + 4 * fq * 516 + 64 * w + fr; const LAS float* mr_q = mr + 8 * fq;
#pragma unroll
          for (int i = 0; i < 4; ++i)
#pragma unroll
            for (int jj = 0; jj < 4; ++jj) { const float mean = mr_q[(16 * i + jj) * 2], rstd = mr_q[(16 * i + jj) * 2 + 1];
#pragma unroll
                for (int e = 0; e < 4; ++e) yt_q[(16 * i + jj) * 516 + 16 * e] = (O[i][e][jj] - mean) * rstd; }
          LDS_WAIT(); __syncthreads();
          const int c8 = (tid & 63) * 8, cc = h * 512 + c8; float gm[8], sk[8];
#pragma unroll
          for (int q = 0; q < 8; ++q) { gm[q] = mh_g[cc + q]; sk[q] = skip[cc + q]; }
#pragma unroll
          for (int k8 = 0; k8 < 8; ++k8) { const int row = (tid >> 6) + 8 * k8; const size_t off = (t0 + row) * CI + cc;
              const v4u zr = *(const v4u*)(Z + off), xr = *(const v4u*)(XC + off); const f32x4 y0 = *(const LAS f32x4*)(ytile + row * 516 + c8), y1 = *(const LAS f32x4*)(ytile + row * 516 + c8 + 4);
              float zf[8], xf[8], o[8]; unpack8(zr, zf); unpack8(xr, xf);
#pragma unroll
              for (int q = 0; q < 8; ++q) { const float yv = q < 4 ? y0[q & 3] : y1[q & 3]; o[q] = (yv * gm[q] + sk[q] * xf[q]) * (zf[q] * sigm(zf[q])); }
              *(v4u*)(YC + off) = pack8(o); if (k8 & 1) asm volatile("" ::: "memory"); } }
        VM_WAIT(); __syncthreads();
    }
#undef ML_DMA
}
#define GEMM_PHASE(EPI, Aptr, Bptr, M_, N_, K_, ...) do { pg8::Gemm g{(const pg8::bf16_t*)(Aptr), (const pg8::bf16_t*)(Bptr), (M_), (N_), (K_)}; pg8::StaticOrder So; So.init((M_), (N_), F.G, F.bid); \
        pg8::EPI Ep{__VA_ARGS__}; pg8::gemm_phase<pg8::EPI, pg8::StaticOrder, PG8_ALIGN, PG8_SP2>(F.lds, g, So, Ep); } while (0)
namespace pg8 { typedef EpiRes2<float> EpiResF; typedef EpiRes2<bf16_t> EpiResB; typedef EpiPle2<false> EpiPleB; typedef EpiPle2<true> EpiPleF; }
__global__ void __launch_bounds__(NWAVES * 64, 2) trunk_fwd(Args args) {
    extern __shared__ __attribute__((aligned(16))) unsigned char lds_raw[];
    Frame F; F.lds = (LAS unsigned char*)lds_raw; F.ws = args.ws; F.in = nullptr;
    F.tid = threadIdx.x; F.lane = F.tid & 63; F.wave = __builtin_amdgcn_readfirstlane(F.tid >> 6); F.G = gridDim.x; F.bid = blockIdx.x;
    volatile LAS unsigned* MISC = (volatile LAS unsigned*)(F.lds + MISC_OFF);
    if (F.tid < 64) MISC[F.tid] = 0u;
    __syncthreads();
    XcdBarrier bar; bar.bar = (unsigned*)(args.ws + WS_CTL) + CW_BAR; bar.x = 0; bar.st = nullptr;
    if (args.use_bar) bar = xcd_barrier_post((unsigned*)(args.ws + WS_CTL) + CW_BAR, MISC + 8);
    unsigned* xrank = (unsigned*)(args.ws + WS_CTL) + CW_XRANK; const unsigned my_xcc = xb_xcc_id();
    if (args.use_bar && F.tid == 0) MISC[12] = xb_add(&xrank[64 * my_xcc], 1u);
    const int lo = args.ph_lo, hi = args.ph_hi;
#ifndef ONLY_SITE
#define ONLY_SITE -1
#endif
#define EN(n) (ONLY_SITE < 0 || ONLY_SITE == (n))
#ifndef REP_MASK
#define REP_MASK 0u
#endif
#define NREP(n) (((REP_MASK >> (n)) & 1u) ? 2 : 1)
#define IN(k) (lo <= (k) && (k) < hi)
#define SEAM(k) do { if (IN(k) && IN((k) + 1)) xcd_barrier(bar); } while (0)
    unsigned char* ws = args.ws; float* out = args.out;
    float* RS = (float*)(ws + WS_RS);
#define RSN(i) (RS + (size_t)(i) * T * 16)
#define PH(site, k, ...) if (EN(site) && IN(k)) { for (int rep_ = 0; rep_ < NREP(site); ++rep_) { if (rep_) xcd_barrier(bar); __VA_ARGS__ } } SEAM(k);
    PH(0, 0, phase_prologue(F, args); phase_cast_sq(F, args.in[0], (bf16*)(ws + WS_XB2), RSN(0), T); phase_cvt_p(F, args.in[1], (bf16*)(ws + WS_PB));)
    if (args.use_bar && lo == 0 && hi > 1) {
        bool ok = F.G == 256; for (int x = 0; x < 16; ++x) { const unsigned cx = xb_ld(&xrank[64 * x]); ok = ok && (cx == (x < 8 ? 32u : 0u)); }
        const unsigned rk = MISC[12]; if (ok && rk < 32u && my_xcc < 8u) F.bid = (int)(rk * 8u + my_xcc); }
    PH(2, 1, GEMM_PHASE(EpiBf16SplitR, ws + WS_XB2, ws + WS_WIN, T, NU, D, (pg8::bf16_t*)(ws + WS_UA), UA_W, 4, (pg8::bf16_t*)(ws + WS_UB), UB_W, RSN(0));)
    PH(3, 2, phase_prepA(F, args);)
    PH(4, 3, GEMM_PHASE(EpiBf16Split, ws + WS_LIN, ws + WS_WLORA, T, 1536, 256 + args.pad, (pg8::bf16_t*)(ws + WS_LOUT), 1536, 1 << 20, nullptr, 0);)
    PH(5, 4, phase_indexer(F);)
    PH(6, 5, phase_dsa_attn(F, args);)
    PH(7, 6, phase_rwkv(F, args);)
    PH(8, 7, GEMM_PHASE(EpiResF, ws + WS_XB, ws + WS_WOUT, T, D, D, args.in[0], (pg8::bf16_t*)(ws + WS_XB2), D, RSN(1));)
#define FFN_PLE(L, pb, rs_a, rs_b, rs_c, PLE_EPI, ple_out) do { const size_t lw = (size_t)(L) * WS_LAYER_STRIDE; \
        PH(21, (pb), GEMM_PHASE(EpiSwigluR, ws + WS_XB2, ws + WS_WGU0 + lw, T, 2 * FF, D, (pg8::bf16_t*)(ws + WS_H), FF, RSN(rs_a));) \
        PH(22, (pb) + 1, GEMM_PHASE(EpiResB, ws + WS_H, ws + WS_WD0 + lw, T, D, FF, (const pg8::bf16_t*)(ws + WS_XB2), (pg8::bf16_t*)(ws + WS_XB), D, RSN(rs_b));) \
        PH(24, (pb) + 2, GEMM_PHASE(EpiBf16Split, ws + WS_PB, ws + WS_WPLE0 + lw, T, D, 256 + args.pad, (pg8::bf16_t*)(ws + WS_E), D, 1 << 20, nullptr, 0);) \
        PH(25, (pb) + 3, GEMM_PHASE(PLE_EPI, ws + WS_XB, ws + WS_WPG0 + lw, T, D, D, (const pg8::bf16_t*)(ws + WS_XB), (void*)(ple_out), (const pg8::bf16_t*)(ws + WS_E), D, RSN(rs_b), RSN(rs_c));) } while (0)
#define L1_HALF(hb, p1) do { bf16* xbh = (bf16*)(ws + WS_XB2) + (size_t)(hb) * TH * D; \
        PH(11, (p1), GEMM_PHASE(EpiBf16SplitR, xbh, ws + WS_WUP, TH, 2 * CI, D, (pg8::bf16_t*)(ws + WS_XM), CI, 8, (pg8::bf16_t*)(ws + WS_Z), CI, RSN(3) + (size_t)(hb) * TH * 16);) \
        PH(12, (p1) + 1, phase_l1prep(F, args, hb);) \
        PH(13, (p1) + 2, phase_gatescan(F); if ((hb) == 0) phase_cvt_p(F, args.in[1] + (size_t)T * 256, (bf16*)(ws + WS_PB));) \
        PH(14, (p1) + 3, phase_mlstm(F, args);) \
        PH(15, (p1) + 4, GEMM_PHASE(EpiResB, ws + WS_XM, ws + WS_WDOWN, TH, D, CI, (const pg8::bf16_t*)xbh, (pg8::bf16_t*)xbh, D, RSN(4) + (size_t)(hb) * TH * 16);) } while (0)
    FFN_PLE(0, 8, 1, 2, 3, EpiPleB, ws + WS_XB2);
    L1_HALF(0, 12);
    L1_HALF(1, 17);
    FFN_PLE(1, 22, 4, 5, 5, EpiPleF, out);
#undef IN
#undef SEAM
}
constexpr int N_PHASES = 26;

#ifndef MK_ONE_LAUNCH
#define MK_ONE_LAUNCH 1
#endif
extern "C" void kernel_launch(void* const* d_in, const int* in_sizes, int n_in, void* d_out, int out_size, void* d_ws, size_t ws_size, hipStream_t stream) {
    static int grid = 0;
    if (grid == 0) {
        if (n_in != 37 || in_sizes[0] != T * D || out_size != T * D || ws_size < WS_END) { fprintf(stderr, "kernel_launch: unexpected shapes (n_in %d, in0 %d, out %d, ws %zu < %zu); nothing launched\n", n_in, n_in > 0 ? in_sizes[0] : -1, out_size, ws_size, (size_t)WS_END); grid = -1; return; }
        int dev = 0, cus = 0, per_cu = 0;
        if (hipGetDevice(&dev) != hipSuccess || hipDeviceGetAttribute(&cus, hipDeviceAttributeMultiprocessorCount, dev) != hipSuccess) { grid = -1; return; }
        if (hipFuncSetAttribute((const void*)trunk_fwd, hipFuncAttributeMaxDynamicSharedMemorySize, LDS_BYTES) != hipSuccess) { fprintf(stderr, "kernel_launch: hipFuncSetAttribute failed\n"); grid = -1; return; }
        if (hipOccupancyMaxActiveBlocksPerMultiprocessor(&per_cu, (const void*)trunk_fwd, NWAVES * 64, LDS_BYTES) != hipSuccess || per_cu < 1) { fprintf(stderr, "kernel_launch: occupancy query says %d\n", per_cu); }
        (void)hipGetLastError();
        grid = cus;
        if (grid != 256) { fprintf(stderr, "kernel_launch: built for 256 CUs, found %d; nothing launched\n", cus); grid = -1; return; }
    }
    if (grid < 0) return;
    if (hipMemsetAsync((char*)d_ws + WS_CTL, 0, CTL_ZERO_BYTES, stream) != hipSuccess) return;
    Args a{};
    for (int i = 0; i < 37; ++i) a.in[i] = (const float*)d_in[i];
    a.out = (float*)d_out; a.ws = (unsigned char*)d_ws; a.pad = 0;
#if MK_ONE_LAUNCH
    a.ph_lo = 0; a.ph_hi = N_PHASES; a.use_bar = 1;
    hipLaunchKernelGGL(trunk_fwd, dim3(grid), dim3(NWAVES * 64), LDS_BYTES, stream, a);
#else
    for (int p = 0; p < N_PHASES; ++p) { a.ph_lo = p; a.ph_hi = p + 1; a.use_bar = 0; hipLaunchKernelGGL(trunk_fwd, dim3(grid), dim3(NWAVES * 64), LDS_BYTES, stream, a); }
#endif
}
```

```cpp
#include <hip/hip_runtime.h>
#include <cstdio>
#include <cstdint>
namespace pg8 {
#define PG8_LAS __attribute__((address_space(3)))
typedef unsigned short bf16_t;
typedef short bf16x8 __attribute__((ext_vector_type(8)));
typedef float f32x4 __attribute__((ext_vector_type(4)));
typedef unsigned u32x4 __attribute__((ext_vector_type(4)));
constexpr int BM = 256, BK = 64, HALF = 128, HTB = HALF * BK * 2  , STAGE_BYTES = 8 * HTB, NXCD = 8, WGM = 8;

__host__ __device__ __forceinline__ int lds_byte(int r, int c) { const int st = (r >> 4) * 2 + (c >> 5), rr = r & 15, cc = c & 31, ob = rr * 64 + cc * 2; return st * 1024 + (ob ^ (((ob >> 9) & 1) << 5)); }
__host__ __device__ __forceinline__ void stage_rc(int b, int& R, int& C) { const int st = b / 1024, sb = b % 1024, swz = sb ^ (((sb >> 9) & 1) << 5); R = (st >> 1) * 16 + swz / 64; C = (st & 1) * 32 + (swz % 64) / 2; }
__host__ __device__ __forceinline__ int perm32(int rho) { const int n = rho >> 4, i = rho & 15; return 8 * (i >> 2) + 4 * n + (i & 3); }

struct Unit { int pm, pn; };
struct Gemm { const bf16_t* A; const bf16_t* Bt; int M, N, K; };

struct StaticOrder {
    int nM, nN, nwg, G, c;
    __host__ __device__ void init(int M, int N, int G_, int c_) { nM = M / BM; nN = N / BM; nwg = nM * nN; G = G_; c = c_; }
    __host__ __device__ bool next(int i, Unit& u) const {
        const long L = (long)i * G + c; if (L >= nwg) return false;
        int wgid = (int)L; { const int q = nwg / NXCD, r = nwg % NXCD, xcd = wgid % NXCD, off = wgid / NXCD; wgid = (xcd < r ? xcd * (q + 1) : r * (q + 1) + (xcd - r) * q) + off; }
        const int nig = WGM * nN, gid = wgid / nig, fm = gid * WGM, gsz = (nM - fm) < WGM ? (nM - fm) : WGM;
        u.pm = fm + ((wgid % nig) % gsz); u.pn = (wgid % nig) / gsz; return true;
    }
    __device__ __forceinline__ void a_ready(const Unit&) const {}
    __device__ __forceinline__ void done(const Unit&) const {}
};

__device__ __forceinline__ unsigned cvt_pk_bf16(float lo, float hi) { unsigned r; asm volatile("v_cvt_pk_bf16_f32 %0, %1, %2" : "=v"(r) : "v"(lo), "v"(hi)); return r; }
typedef float f32x2 __attribute__((ext_vector_type(2)));
__device__ __forceinline__ f32x2 gelu_pk(f32x2 v) {
    const f32x2 av = __builtin_elementwise_abs(v), d = av * 0.2316418882f + 1.0f;
    f32x2 t; t.x = __builtin_amdgcn_rcpf(d.x); t.y = __builtin_amdgcn_rcpf(d.y);
    f32x2 q = t * 0.5307027145f + (-0.7265760135f); q = q * t + 0.7107068705f; q = q * t + (-0.142248368f); q = q * t + 0.127414796f; q = q * t;
    const f32x2 s = (v * v) * (-0.72134752044f);
    f32x2 e; e.x = __builtin_amdgcn_exp2f(s.x); e.y = __builtin_amdgcn_exp2f(s.y);
    const f32x2 m = v * (q * e), r = v - m;
    f32x2 o; o.x = v.x < 0.f ? m.x : r.x; o.y = v.y < 0.f ? m.y : r.y; return o;
}

template <class Epi, class Sched, bool ALIGN_EPI = false, bool SP2 = false>
__device__ __forceinline__ void gemm_phase(PG8_LAS unsigned char* lds, const Gemm g, const Sched& S, const Epi& E) {
    const int tid = threadIdx.x, wid = __builtin_amdgcn_readfirstlane(tid >> 6), lane = tid & 63, wr = wid >> 2, wc = wid & 3, fr = lane & 15, fq = lane >> 4;
    const int K = g.K, nt = K / BK;
    unsigned voffA[2], voffB[2];
#pragma unroll
    for (int i = 0; i < 2; ++i) { int R, C; stage_rc(tid * 16 + i * 8192, R, C); const int Rb = Epi::PERM ? ((R & ~31) + perm32(R & 31)) : R;
        voffA[i] = (unsigned)(R * K + C) * 2u; voffB[i] = (unsigned)(Rb * K + C) * 2u; }
    const size_t kstep = (size_t)(BK * 2);
    const size_t hstep = (size_t)HALF * K * 2;
    const size_t tstep = 2 * hstep;
    const unsigned ldsw = (unsigned)wid * 1024u;
    const int aoff = lds_byte(wr * 64 + fr, fq * 8), boff = lds_byte(wc * 32 + fr, fq * 8);
#define PG8_SA(b, h) (((b) * 2 + (h)) * HTB)
#define PG8_SB(b, h) ((4 + (b) * 2 + (h)) * HTB)
#define PG8_STAGE(bufoff, gbase, voff) do { _Pragma("unroll") for (int _i = 0; _i < 2; ++_i) \
        __builtin_amdgcn_global_load_lds((const unsigned*)((const char*)(gbase) + (voff)[_i]), (PG8_LAS unsigned*)(lds + (bufoff) + ldsw + _i * 8192), 16, 0, 0); } while (0)
#define PG8_LDA(dst, b, h) do { _Pragma("unroll") for (int m = 0; m < 4; ++m) _Pragma("unroll") for (int k = 0; k < 2; ++k) dst[m][k] = *(const PG8_LAS bf16x8*)(lds + PG8_SA(b, h) + aoff + m * 2048 + k * 1024); } while (0)
#define PG8_LDB(dst, b, h) do { _Pragma("unroll") for (int n = 0; n < 2; ++n) _Pragma("unroll") for (int k = 0; k < 2; ++k) dst[n][k] = *(const PG8_LAS bf16x8*)(lds + PG8_SB(b, h) + boff + n * 2048 + k * 1024); } while (0)
#define PG8_MMA(ai, bj, At, Bt) do { __builtin_amdgcn_s_setprio(1); _Pragma("unroll") for (int m = 0; m < 4; ++m) _Pragma("unroll") for (int n = 0; n < 2; ++n) _Pragma("unroll") for (int k = 0; k < 2; ++k) \
        acc[ai][bj][m][n] = __builtin_amdgcn_mfma_f32_16x16x32_bf16(Bt[n][k], At[m][k], acc[ai][bj][m][n], 0, 0, 0); __builtin_amdgcn_s_setprio(0); } while (0)
#define PG8_WAIT_V(n) asm volatile("s_waitcnt vmcnt(" #n ")" ::: "memory")
#define PG8_WAIT_L(n) asm volatile("s_waitcnt lgkmcnt(" #n ")" ::: "memory")
#define PG8_BAR __builtin_amdgcn_s_barrier()
#define PG8_SCHED __builtin_amdgcn_sched_barrier(0)
    Unit cur, nxt; int ui = 0;
    if (!S.next(0, cur)) return;
    f32x4 acc[2][2][4][2];
#pragma unroll
    for (int a = 0; a < 2; ++a)
#pragma unroll
        for (int b = 0; b < 2; ++b)
#pragma unroll
            for (int m = 0; m < 4; ++m)
#pragma unroll
                for (int n = 0; n < 2; ++n) acc[a][b][m][n] = (f32x4){0.f, 0.f, 0.f, 0.f};
    bf16x8 At[4][2], B0[2][2], B1[2][2];
    const char* cA = (const char*)g.A + (size_t)cur.pm * tstep; const char* cB = (const char*)g.Bt + (size_t)cur.pn * tstep;
    S.a_ready(cur);
    if constexpr (SP2) {
        PG8_STAGE(PG8_SB(0, 0), cB, voffB); PG8_STAGE(PG8_SB(0, 1), cB + hstep, voffB); PG8_STAGE(PG8_SA(0, 0), cA, voffA); PG8_STAGE(PG8_SA(0, 1), cA + hstep, voffA);
        if (wr == 1) PG8_BAR;
        PG8_WAIT_V(2); PG8_BAR;
        PG8_STAGE(PG8_SB(1, 0), cB + kstep, voffB); PG8_STAGE(PG8_SA(1, 0), cA + kstep, voffA); PG8_STAGE(PG8_SB(1, 1), cB + hstep + kstep, voffB);
        PG8_WAIT_V(6); PG8_BAR;
    } else {
        PG8_STAGE(PG8_SB(0, 0), cB, voffB); PG8_STAGE(PG8_SA(0, 0), cA, voffA); PG8_STAGE(PG8_SB(0, 1), cB + hstep, voffB); PG8_STAGE(PG8_SA(0, 1), cA + hstep, voffA);
        if (wr == 1) PG8_BAR;
        PG8_WAIT_V(4); PG8_BAR;
        PG8_STAGE(PG8_SB(1, 0), cB + kstep, voffB); PG8_STAGE(PG8_SA(1, 0), cA + kstep, voffA); PG8_STAGE(PG8_SB(1, 1), cB + hstep + kstep, voffB);
        PG8_WAIT_V(6); PG8_BAR;
    }
    for (;;) {
        const bool has_next = S.next(ui + 1, nxt);
        const char* nA = has_next ? (const char*)g.A + (size_t)nxt.pm * tstep : cA; const char* nB = has_next ? (const char*)g.Bt + (size_t)nxt.pn * tstep : cB;
        for (int t = 0; t < nt; t += 2) {
            const bool last = (t == nt - 2);
            const char* a1 = cA + (size_t)(t + 1) * kstep;
            const char* a2 = last ? nA : cA + (size_t)(t + 2) * kstep; const char* b2 = last ? nB : cB + (size_t)(t + 2) * kstep;
            const char* a3 = a2 + kstep; const char* b3 = b2 + kstep;
            if (last && has_next) S.a_ready(nxt);
            if constexpr (SP2) {
            PG8_LDB(B0, 0, 0); PG8_LDB(B1, 0, 1); PG8_SCHED; PG8_LDA(At, 0, 0); PG8_STAGE(PG8_SA(1, 1), a1 + hstep, voffA);
            PG8_WAIT_V(8); PG8_WAIT_L(0); PG8_BAR; PG8_MMA(0, 0, At, B0); PG8_MMA(0, 1, At, B1); PG8_BAR; PG8_SCHED;
            PG8_LDA(At, 0, 1); PG8_STAGE(PG8_SB(0, 0), b2, voffB); PG8_STAGE(PG8_SB(0, 1), b2 + hstep, voffB); PG8_STAGE(PG8_SA(0, 0), a2, voffA);
            PG8_WAIT_V(8); PG8_WAIT_L(0); PG8_BAR; PG8_MMA(1, 0, At, B0); PG8_MMA(1, 1, At, B1); PG8_BAR; PG8_SCHED;
            PG8_LDB(B0, 1, 0); PG8_LDB(B1, 1, 1); PG8_SCHED; PG8_LDA(At, 1, 0); PG8_STAGE(PG8_SA(0, 1), a2 + hstep, voffA);
            PG8_WAIT_V(8); PG8_WAIT_L(0); PG8_BAR; PG8_MMA(0, 0, At, B0); PG8_MMA(0, 1, At, B1); PG8_BAR; PG8_SCHED;
            PG8_LDA(At, 1, 1); PG8_STAGE(PG8_SB(1, 0), b3, voffB); PG8_STAGE(PG8_SB(1, 1), b3 + hstep, voffB); PG8_STAGE(PG8_SA(1, 0), a3, voffA);
            PG8_WAIT_V(8); PG8_WAIT_L(0); PG8_BAR; PG8_MMA(1, 0, At, B0); PG8_MMA(1, 1, At, B1); PG8_BAR; PG8_SCHED;
            } else {
            PG8_LDB(B0, 0, 0); PG8_SCHED; PG8_LDA(At, 0, 0); PG8_STAGE(PG8_SA(1, 1), a1 + hstep, voffA);
            PG8_WAIT_L(8); PG8_BAR; PG8_WAIT_L(0); PG8_MMA(0, 0, At, B0); PG8_BAR; PG8_SCHED;
            PG8_LDB(B1, 0, 1); PG8_STAGE(PG8_SB(0, 0), b2, voffB);
            PG8_BAR; PG8_WAIT_L(0); PG8_MMA(0, 1, At, B1); PG8_BAR;
            PG8_LDA(At, 0, 1); PG8_STAGE(PG8_SA(0, 0), a2, voffA);
            PG8_BAR; PG8_WAIT_L(0); PG8_MMA(1, 0, At, B0); PG8_BAR; PG8_SCHED;
            PG8_STAGE(PG8_SB(0, 1), b2 + hstep, voffB);
            PG8_WAIT_V(6); PG8_BAR; PG8_MMA(1, 1, At, B1); PG8_BAR;
            PG8_LDB(B0, 1, 0); PG8_SCHED; PG8_LDA(At, 1, 0); PG8_STAGE(PG8_SA(0, 1), a2 + hstep, voffA);
            PG8_WAIT_L(8); PG8_BAR; PG8_WAIT_L(0); PG8_MMA(0, 0, At, B0); PG8_BAR; PG8_SCHED;
            PG8_LDB(B1, 1, 1); PG8_STAGE(PG8_SB(1, 0), b3, voffB);
            PG8_BAR; PG8_WAIT_L(0); PG8_MMA(0, 1, At, B1); PG8_BAR;
            PG8_LDA(At, 1, 1); PG8_STAGE(PG8_SA(1, 0), a3, voffA);
            PG8_BAR; PG8_WAIT_L(0); PG8_MMA(1, 0, At, B0); PG8_BAR; PG8_SCHED;
            PG8_STAGE(PG8_SB(1, 1), b3 + hstep, voffB);
            PG8_WAIT_V(6); PG8_BAR; PG8_MMA(1, 1, At, B1); PG8_BAR;
            }
        }
        if constexpr (ALIGN_EPI) { if (wr == 0) PG8_BAR; }
        if constexpr (!Epi::AFTER_DRAIN) { E(acc, cur, wr, wc, fr, fq); S.done(cur); }
        if (!has_next) break;
#pragma unroll
        for (int a = 0; a < 2; ++a)
#pragma unroll
            for (int b = 0; b < 2; ++b)
#pragma unroll
                for (int m = 0; m < 4; ++m)
#pragma unroll
                    for (int n = 0; n < 2; ++n) acc[a][b][m][n] = (f32x4){0.f, 0.f, 0.f, 0.f};
        cur = nxt; cA = nA; cB = nB; ++ui;
        if constexpr (ALIGN_EPI) { if (wr == 1) PG8_BAR; }
    }
    PG8_WAIT_V(0);
    if constexpr (!ALIGN_EPI) { if (wr == 0) PG8_BAR; }
    PG8_BAR;
    if constexpr (Epi::AFTER_DRAIN) { E.fused(acc, cur, wr, wc, fr, fq, lds, wid, lane); S.done(cur); }
#undef PG8_SA
#undef PG8_SB
#undef PG8_STAGE
#undef PG8_LDA
#undef PG8_LDB
#undef PG8_MMA
#undef PG8_WAIT_V
#undef PG8_WAIT_L
#undef PG8_BAR
#undef PG8_SCHED
}
}
namespace pg8 {
__device__ __forceinline__ float sigmoidf_(float x) { return __builtin_amdgcn_rcpf(1.0f + __builtin_amdgcn_exp2f(-1.4426950408889634f * x)); }
struct EpiBf16Split {
    static constexpr bool PERM = true, AFTER_DRAIN = false;
    bf16_t* O0; int ld0; int nt0; bf16_t* O1; int ld1;
    __device__ __forceinline__ void operator()(const f32x4 (&acc)[2][2][4][2], const Unit& u, int wr, int wc, int fr, int fq) const {
        const bool first = u.pn < nt0; bf16_t* base = first ? O0 : O1; const int ld = first ? ld0 : ld1; const int colt = (first ? u.pn : u.pn - nt0) * BM;
        const int row0 = u.pm * BM + wr * 64 + fr, col0 = colt + wc * 32 + 8 * fq;
#pragma unroll
        for (int ai = 0; ai < 2; ++ai)
#pragma unroll
            for (int m = 0; m < 4; ++m) { bf16_t* rowp = base + (size_t)(row0 + ai * HALF + m * 16) * ld + col0;
#pragma unroll
                for (int bj = 0; bj < 2; ++bj) { const f32x4 v0 = acc[ai][bj][m][0], v1 = acc[ai][bj][m][1];
                    u32x4 w; w.x = cvt_pk_bf16(v0[0], v0[1]); w.y = cvt_pk_bf16(v0[2], v0[3]); w.z = cvt_pk_bf16(v1[0], v1[1]); w.w = cvt_pk_bf16(v1[2], v1[3]);
                    *(u32x4*)(rowp + bj * HALF) = w; } }
    }
};
struct EpiResF32 {
    static constexpr bool PERM = false, AFTER_DRAIN = false;
    const float* base; float* out; int ldc;
    __device__ __forceinline__ void operator()(const f32x4 (&acc)[2][2][4][2], const Unit& u, int wr, int wc, int fr, int fq) const {
        const int row0 = u.pm * BM + wr * 64 + fr, col0 = u.pn * BM + wc * 32 + 4 * fq;
#pragma unroll
        for (int ai = 0; ai < 2; ++ai)
#pragma unroll
            for (int m = 0; m < 4; ++m) { const size_t off = (size_t)(row0 + ai * HALF + m * 16) * ldc + col0;
#pragma unroll
                for (int bj = 0; bj < 2; ++bj)
#pragma unroll
                    for (int n = 0; n < 2; ++n) { const f32x4 b = *(const f32x4*)(base + off + bj * HALF + n * 16); *(f32x4*)(out + off + bj * HALF + n * 16) = b + acc[ai][bj][m][n]; } }
    }
};
struct EpiSwiglu {
    static constexpr bool PERM = false, AFTER_DRAIN = false;
    bf16_t* H; int ldh;
    __device__ __forceinline__ void operator()(const f32x4 (&acc)[2][2][4][2], const Unit& u, int wr, int wc, int fr, int fq) const {
        const int row0 = u.pm * BM + wr * 64 + fr, hc0 = u.pn * (BM / 2) + wc * 16 + 4 * fq;
#pragma unroll
        for (int ai = 0; ai < 2; ++ai)
#pragma unroll
            for (int m = 0; m < 4; ++m) { bf16_t* rowp = H + (size_t)(row0 + ai * HALF + m * 16) * ldh + hc0;
#pragma unroll
                for (int bj = 0; bj < 2; ++bj) { const f32x4 g = acc[ai][bj][m][0], up = acc[ai][bj][m][1]; float h[4];
#pragma unroll
                    for (int i = 0; i < 4; ++i) h[i] = g[i] * sigmoidf_(g[i]) * up[i];
                    typedef unsigned u32x2 __attribute__((ext_vector_type(2)));
                    u32x2 w; w.x = cvt_pk_bf16(h[0], h[1]); w.y = cvt_pk_bf16(h[2], h[3]);
                    *(u32x2*)(rowp + bj * (HALF / 2)) = w; } }
    }
};
struct EpiPle {
    static constexpr bool PERM = false, AFTER_DRAIN = false;
    const float* base; float* out; const bf16_t* E; int ldc;
    __device__ __forceinline__ void operator()(const f32x4 (&acc)[2][2][4][2], const Unit& u, int wr, int wc, int fr, int fq) const {
        const int row0 = u.pm * BM + wr * 64 + fr, col0 = u.pn * BM + wc * 32 + 4 * fq;
        typedef unsigned u32x2 __attribute__((ext_vector_type(2)));
#pragma unroll
        for (int ai = 0; ai < 2; ++ai)
#pragma unroll
            for (int m = 0; m < 4; ++m) { const size_t off = (size_t)(row0 + ai * HALF + m * 16) * ldc + col0;
#pragma unroll
                for (int bj = 0; bj < 2; ++bj)
#pragma unroll
                    for (int n = 0; n < 2; ++n) { const size_t o = off + bj * HALF + n * 16; const f32x4 b = *(const f32x4*)(base + o); const u32x2 e = *(const u32x2*)(E + o); const f32x4 a = acc[ai][bj][m][n];
                        f32x4 r; r[0] = b[0] + __uint_as_float(e.x << 16) * sigmoidf_(a[0]); r[1] = b[1] + __uint_as_float(e.x & 0xffff0000u) * sigmoidf_(a[1]);
                        r[2] = b[2] + __uint_as_float(e.y << 16) * sigmoidf_(a[2]); r[3] = b[3] + __uint_as_float(e.y & 0xffff0000u) * sigmoidf_(a[3]);
                        *(f32x4*)(out + o) = r; } }
    }
};
__device__ __forceinline__ float rms_r(const float* rsq, int row) { const f32x4* p = (const f32x4*)(rsq + (size_t)row * 16); const f32x4 a = p[0], b = p[1], c = p[2], d = p[3];
    const float s = (((a[0] + a[1]) + (a[2] + a[3])) + ((b[0] + b[1]) + (b[2] + b[3]))) + (((c[0] + c[1]) + (c[2] + c[3])) + ((d[0] + d[1]) + (d[2] + d[3]))); return rsqrtf(s * (1.0f / 1024.0f) + 1e-6f); }
__device__ __forceinline__ void norm_out(const f32x4 (&x)[2][2], bf16_t* xb, size_t off, float* rsq_out, int row, int fq, int slot) {
    typedef unsigned u32x2 __attribute__((ext_vector_type(2))); float s = 0.f;
#pragma unroll
    for (int bj = 0; bj < 2; ++bj)
#pragma unroll
        for (int n = 0; n < 2; ++n) { const f32x4 v = x[bj][n]; s += (v[0] * v[0] + v[1] * v[1]) + (v[2] * v[2] + v[3] * v[3]); u32x2 w; w.x = cvt_pk_bf16(v[0], v[1]); w.y = cvt_pk_bf16(v[2], v[3]); *(u32x2*)(xb + off + bj * HALF + n * 16) = w; }
    s += __shfl_xor(s, 16); s += __shfl_xor(s, 32);
    if (fq == 0) rsq_out[(size_t)row * 16 + slot] = s;
}
struct EpiBf16SplitR {
    static constexpr bool PERM = true, AFTER_DRAIN = false;
    bf16_t* O0; int ld0; int nt0; bf16_t* O1; int ld1; const float* rsq;
    __device__ __forceinline__ void operator()(const f32x4 (&acc)[2][2][4][2], const Unit& u, int wr, int wc, int fr, int fq) const {
        const bool first = u.pn < nt0; bf16_t* base = first ? O0 : O1; const int ld = first ? ld0 : ld1; const int colt = (first ? u.pn : u.pn - nt0) * BM;
        const int row0 = u.pm * BM + wr * 64 + fr, col0 = colt + wc * 32 + 8 * fq;
#pragma unroll
        for (int ai = 0; ai < 2; ++ai)
#pragma unroll
            for (int m = 0; m < 4; ++m) { const int row = row0 + ai * HALF + m * 16; const float r = rms_r(rsq, row); bf16_t* rowp = base + (size_t)row * ld + col0;
#pragma unroll
                for (int bj = 0; bj < 2; ++bj) { const f32x4 v0 = acc[ai][bj][m][0] * r, v1 = acc[ai][bj][m][1] * r;
                    u32x4 w; w.x = cvt_pk_bf16(v0[0], v0[1]); w.y = cvt_pk_bf16(v0[2], v0[3]); w.z = cvt_pk_bf16(v1[0], v1[1]); w.w = cvt_pk_bf16(v1[2], v1[3]);
                    *(u32x4*)(rowp + bj * HALF) = w; } }
    }
};
struct EpiSwigluR {
    static constexpr bool PERM = false, AFTER_DRAIN = false;
    bf16_t* H; int ldh; const float* rsq;
    __device__ __forceinline__ void operator()(const f32x4 (&acc)[2][2][4][2], const Unit& u, int wr, int wc, int fr, int fq) const {
        const int row0 = u.pm * BM + wr * 64 + fr, hc0 = u.pn * (BM / 2) + wc * 16 + 4 * fq;
#pragma unroll
        for (int ai = 0; ai < 2; ++ai)
#pragma unroll
            for (int m = 0; m < 4; ++m) { const int row = row0 + ai * HALF + m * 16; const float r = rms_r(rsq, row); bf16_t* rowp = H + (size_t)row * ldh + hc0;
#pragma unroll
                for (int bj = 0; bj < 2; ++bj) { const f32x4 g = acc[ai][bj][m][0] * r, up = acc[ai][bj][m][1] * r; float h[4];
#pragma unroll
                    for (int i = 0; i < 4; ++i) h[i] = g[i] * sigmoidf_(g[i]) * up[i];
                    typedef unsigned u32x2 __attribute__((ext_vector_type(2)));
                    u32x2 w; w.x = cvt_pk_bf16(h[0], h[1]); w.y = cvt_pk_bf16(h[2], h[3]);
                    *(u32x2*)(rowp + bj * (HALF / 2)) = w; } }
    }
};
struct EpiResN {
    static constexpr bool PERM = false, AFTER_DRAIN = false;
    const float* base; float* out; int ldc; bf16_t* XBo; float* rsq_out;
    __device__ __forceinline__ void operator()(const f32x4 (&acc)[2][2][4][2], const Unit& u, int wr, int wc, int fr, int fq) const {
        const int row0 = u.pm * BM + wr * 64 + fr, col0 = u.pn * BM + wc * 32 + 4 * fq;
#pragma unroll
        for (int ai = 0; ai < 2; ++ai)
#pragma unroll
            for (int m = 0; m < 4; ++m) { const int row = row0 + ai * HALF + m * 16; const size_t off = (size_t)row * ldc + col0; f32x4 x[2][2];
#pragma unroll
                for (int bj = 0; bj < 2; ++bj)
#pragma unroll
                    for (int n = 0; n < 2; ++n) { const f32x4 b = *(const f32x4*)(base + off + bj * HALF + n * 16); x[bj][n] = b + acc[ai][bj][m][n]; *(f32x4*)(out + off + bj * HALF + n * 16) = x[bj][n]; }
                if (XBo) norm_out(x, XBo, off, rsq_out, row, fq, u.pn * 4 + wc); }
    }
};
struct EpiPleN {
    static constexpr bool PERM = false, AFTER_DRAIN = false;
    const float* base; float* out; const bf16_t* E; int ldc; const float* rsq_in; bf16_t* XBo; float* rsq_out;
    __device__ __forceinline__ void operator()(const f32x4 (&acc)[2][2][4][2], const Unit& u, int wr, int wc, int fr, int fq) const {
        const int row0 = u.pm * BM + wr * 64 + fr, col0 = u.pn * BM + wc * 32 + 4 * fq;
        typedef unsigned u32x2 __attribute__((ext_vector_type(2)));
#pragma unroll
        for (int ai = 0; ai < 2; ++ai)
#pragma unroll
            for (int m = 0; m < 4; ++m) { const int row = row0 + ai * HALF + m * 16; const size_t off = (size_t)row * ldc + col0; const float r = rms_r(rsq_in, row); f32x4 x[2][2];
#pragma unroll
                for (int bj = 0; bj < 2; ++bj)
#pragma unroll
                    for (int n = 0; n < 2; ++n) { const size_t o = off + bj * HALF + n * 16; const f32x4 b = *(const f32x4*)(base + o); const u32x2 e = *(const u32x2*)(E + o); const f32x4 a = acc[ai][bj][m][n] * r;
                        f32x4 v; v[0] = b[0] + __uint_as_float(e.x << 16) * sigmoidf_(a[0]); v[1] = b[1] + __uint_as_float(e.x & 0xffff0000u) * sigmoidf_(a[1]);
                        v[2] = b[2] + __uint_as_float(e.y << 16) * sigmoidf_(a[2]); v[3] = b[3] + __uint_as_float(e.y & 0xffff0000u) * sigmoidf_(a[3]);
                        x[bj][n] = v; *(f32x4*)(out + o) = v; }
                if (XBo) norm_out(x, XBo, off, rsq_out, row, fq, u.pn * 4 + wc); }
    }
};
__device__ __forceinline__ f32x4 ld_base4(const float* p) { return *(const f32x4*)p; }
__device__ __forceinline__ f32x4 ld_base4(const bf16_t* p) { typedef unsigned u32x2 __attribute__((ext_vector_type(2))); const u32x2 e = *(const u32x2*)p; return (f32x4){__uint_as_float(e.x << 16), __uint_as_float(e.x & 0xffff0000u), __uint_as_float(e.y << 16), __uint_as_float(e.y & 0xffff0000u)}; }
template <class BaseT> struct EpiRes2 {
    static constexpr bool PERM = false, AFTER_DRAIN = false;
    const BaseT* base; bf16_t* out; int ldc; float* rsq_out;
    __device__ __forceinline__ void operator()(const f32x4 (&acc)[2][2][4][2], const Unit& u, int wr, int wc, int fr, int fq) const {
        const int row0 = u.pm * BM + wr * 64 + fr, col0 = u.pn * BM + wc * 32 + 4 * fq;
#pragma unroll
        for (int ai = 0; ai < 2; ++ai)
#pragma unroll
            for (int m = 0; m < 4; ++m) { const int row = row0 + ai * HALF + m * 16; const size_t off = (size_t)row * ldc + col0; f32x4 x[2][2];
#pragma unroll
                for (int bj = 0; bj < 2; ++bj)
#pragma unroll
                    for (int n = 0; n < 2; ++n) x[bj][n] = ld_base4(base + off + bj * HALF + n * 16) + acc[ai][bj][m][n];
                norm_out(x, out, off, rsq_out, row, fq, u.pn * 4 + wc); }
    }
};
template <bool OUT_F32> struct EpiPle2 {
    static constexpr bool PERM = false, AFTER_DRAIN = false;
    const bf16_t* base; void* out; const bf16_t* E; int ldc; const float* rsq_in; float* rsq_out;
    __device__ __forceinline__ void operator()(const f32x4 (&acc)[2][2][4][2], const Unit& u, int wr, int wc, int fr, int fq) const {
        const int row0 = u.pm * BM + wr * 64 + fr, col0 = u.pn * BM + wc * 32 + 4 * fq;
#pragma unroll
        for (int ai = 0; ai < 2; ++ai)
#pragma unroll
            for (int m = 0; m < 4; ++m) { const int row = row0 + ai * HALF + m * 16; const size_t off = (size_t)row * ldc + col0; const float r = rms_r(rsq_in, row); f32x4 x[2][2];
#pragma unroll
                for (int bj = 0; bj < 2; ++bj)
#pragma unroll
                    for (int n = 0; n < 2; ++n) { const size_t o = off + bj * HALF + n * 16; const f32x4 b = ld_base4(base + o), e = ld_base4(E + o), a = acc[ai][bj][m][n] * r; f32x4 v;
#pragma unroll
                        for (int i = 0; i < 4; ++i) v[i] = b[i] + e[i] * sigmoidf_(a[i]);
                        x[bj][n] = v; if (OUT_F32) *(f32x4*)((float*)out + o) = v; }
                if (!OUT_F32) norm_out(x, (bf16_t*)out, off, rsq_out, row, fq, u.pn * 4 + wc); }
    }
};
}
#ifndef PG8_SP2
#define PG8_SP2 true
#endif
#ifndef PG8_ALIGN
#define PG8_ALIGN true
#endif
constexpr int NB = 32, SEQ = 2048, T = NB * SEQ, D = 1024;
constexpr int NU = 2816, UA_W = 1024, UB_W = 1792;
constexpr int FF = 2816, CI = 2048, TH = T / 2;
constexpr int NWAVES = 8;
constexpr float NORM_EPS = 1e-6f, LOG2E = 1.4426950408889634f;
constexpr int UA_K = 512, UA_V = 576, UA_IQ = 640, UA_IK = 896, UA_IW = 960;
constexpr size_t MiB = 1u << 20, QMiB = 1u << 18;
constexpr size_t WS_CTL = 0, CTL_ZERO_BYTES = 1 * MiB;
constexpr size_t WS_WIN = 4 * QMiB, WS_WLORA = 26 * QMiB, WS_WOUT = 29 * QMiB;
constexpr size_t WS_WGU0 = 37 * QMiB, WS_WD0 = 81 * QMiB, WS_WPLE0 = 103 * QMiB, WS_WPG0 = 105 * QMiB, WS_LAYER_STRIDE = 76 * QMiB;
constexpr size_t WS_WUP = 189 * QMiB, WS_WDOWN = 221 * QMiB, WS_W12 = 237 * QMiB;
static_assert(WS_WPG0 + 8 * QMiB == WS_WGU0 + WS_LAYER_STRIDE && WS_WPG0 + WS_LAYER_STRIDE + 8 * QMiB == WS_WUP && WS_W12 + QMiB <= 60 * MiB, "weight map");
constexpr size_t ACT = 60 * MiB;
constexpr size_t WS_XB = ACT, WS_UA = ACT + 128 * MiB, WS_UB = ACT + 256 * MiB, WS_LIN = ACT + 480 * MiB, WS_LOUT = ACT + 512 * MiB;
constexpr size_t WS_QN = ACT + 704 * MiB, WS_KN = ACT + 768 * MiB, WS_VT = ACT + 776 * MiB, WS_MASK = ACT + 784 * MiB;
constexpr size_t WS_XB2 = ACT + 768 * MiB;
constexpr size_t WS_H = ACT + 128 * MiB, WS_E = ACT + 480 * MiB, WS_PB = ACT + 896 * MiB;
constexpr size_t WS_XM = ACT, WS_Z = ACT + 128 * MiB, WS_XC = ACT + 256 * MiB, WS_Q = ACT + 384 * MiB, WS_K = ACT + 512 * MiB, WS_V = ACT + 640 * MiB;
constexpr size_t WS_RS = ACT + 928 * MiB, RS_ONE = (size_t)T * 16 * 4;
constexpr size_t WS_GI = ACT + 952 * MiB, WS_GA = WS_GI + 1 * MiB, WS_GAM = WS_GI + 2 * MiB, WS_GEM = WS_GI + 3 * MiB;
constexpr size_t WS_END = ACT + 956 * MiB;
static_assert(WS_END <= 1024 * MiB, "workspace");
constexpr int CW_TMO = 0, CW_BAR = 4096, CW_XRANK = 8192;
constexpr int LDS_BYTES = 155648;
constexpr int MISC_OFF = LDS_BYTES - 256;
#define GAS __attribute__((address_space(1)))
#define LAS __attribute__((address_space(3)))
typedef unsigned short bf16;
typedef unsigned v4u __attribute__((ext_vector_type(4)));
typedef unsigned v2u __attribute__((ext_vector_type(2)));
typedef float f32x4 __attribute__((ext_vector_type(4)));
typedef float f32x2 __attribute__((ext_vector_type(2)));
typedef float f32x8 __attribute__((ext_vector_type(8)));
typedef short bf16x8 __attribute__((ext_vector_type(8)));
typedef short s16x4 __attribute__((ext_vector_type(4)));
typedef GAS unsigned gu32;
#define RLX_AGENT __ATOMIC_RELAXED, __HIP_MEMORY_SCOPE_AGENT
#define LDS_WAIT() asm volatile("s_waitcnt lgkmcnt(0)" ::: "memory")
#define VM_WAIT() asm volatile("s_waitcnt vmcnt(0)" ::: "memory")
__device__ __forceinline__ unsigned f2bf(float f) { unsigned u = __builtin_bit_cast(unsigned, f); return (u + 0x7fffu + ((u >> 16) & 1u)) >> 16; }

#define XB_TMO      128
#define XB_XCNT(j)  (256  + 64 * (j))
#define XB_XSUB(j)  (1280 + 64 * (j))
#define XB_XGEN(j)  (2304 + 64 * (j))
#define XB_TOP      3328
#define XB_TOPGEN   3392
#define XCD_BAR_WORDS 3456
#define XB_SPIN_CAP (1u << 18)

__device__ __forceinline__ unsigned xb_ld(unsigned* p)              { return __hip_atomic_load(p, __ATOMIC_RELAXED, __HIP_MEMORY_SCOPE_AGENT); }
__device__ __forceinline__ unsigned xb_add(unsigned* p, unsigned v) { return __hip_atomic_fetch_add(p, v, __ATOMIC_RELAXED, __HIP_MEMORY_SCOPE_AGENT); }
__device__ __forceinline__ unsigned xb_xcc_id() { return (unsigned)__builtin_amdgcn_s_getreg((3 << 11) | 20) & 0xFu; }
#define XB_SPIN(cond, bar) do { unsigned _sp = 0; while (cond) { __builtin_amdgcn_s_sleep(1); \
    if ((++_sp & 255u) == 0u) { if (xb_ld(&(bar)[XB_TMO])) break; if (_sp > XB_SPIN_CAP) { atomicAdd(&(bar)[XB_TMO], 1u); break; } } } } while (0)

struct XcdBarrier {
    unsigned* bar; unsigned x;
    volatile LAS unsigned* st;
};

__device__ __forceinline__ XcdBarrier xcd_barrier_post(unsigned* bar, volatile LAS unsigned* st) {
    XcdBarrier b; b.bar = bar; b.x = xb_xcc_id(); b.st = st;
    if (threadIdx.x == 0) (void)xb_add(&bar[XB_XCNT(b.x)], 1u);
    return b;
}
__device__ __forceinline__ void xcd_barrier_complete(unsigned* bar, unsigned x, unsigned& nloc, unsigned& nx) {
    const unsigned G = gridDim.x * gridDim.y * gridDim.z;
    unsigned sum, cnt, mine, sp = 0u;
    for (;;) {
        sum = 0u; cnt = 0u; mine = 0u;
#pragma unroll
        for (unsigned j = 0; j < 16; ++j) { const unsigned c = xb_ld(&bar[XB_XCNT(j)]); sum += c; cnt += (c > 0u) ? 1u : 0u; mine = (j == x) ? c : mine; }
        if (sum == G) break;
        __builtin_amdgcn_s_sleep(1);
        if ((++sp & 255u) == 0u) { if (xb_ld(&bar[XB_TMO])) break; if (sp > XB_SPIN_CAP) { atomicAdd(&bar[XB_TMO], 1u); break; } }
    }
    nloc = mine > 0u ? mine : 1u; nx = cnt > 0u ? cnt : 1u;
}

__device__ __forceinline__ void xcd_barrier(const XcdBarrier& b) {
    asm volatile("s_waitcnt vmcnt(0)" ::: "memory");
    __syncthreads();
    if (threadIdx.x == 0) {
        unsigned* bar = b.bar;
        __builtin_amdgcn_s_waitcnt(0);
        unsigned nloc = b.st[0], nx = b.st[1];
        if (nloc == 0u) { xcd_barrier_complete(bar, b.x, nloc, nx); b.st[0] = nloc; b.st[1] = nx; }
        const unsigned old = xb_add(&bar[XB_XSUB(b.x)], 1u);
        const unsigned gen = old / nloc;
        if (old + 1u == (gen + 1u) * nloc) {
            __builtin_amdgcn_fence(__ATOMIC_RELEASE, "agent");
            asm volatile("s_waitcnt vmcnt(0)" ::: "memory");
            const unsigned og = xb_add(&bar[XB_TOP], 1u);
            const unsigned tg = og / nx;
            if (og + 1u == (tg + 1u) * nx) xb_add(&bar[XB_TOPGEN], 1u);
            else XB_SPIN(xb_ld(&bar[XB_TOPGEN]) == tg, bar);
            __builtin_amdgcn_fence(__ATOMIC_ACQUIRE, "agent");
            xb_add(&bar[XB_XGEN(b.x)], 1u);
            asm volatile("s_waitcnt vmcnt(0)" ::: "memory");
        } else {
            XB_SPIN(xb_ld(&bar[XB_XGEN(b.x)]) == gen, bar);
            __builtin_amdgcn_fence(__ATOMIC_ACQUIRE, "agent");
            asm volatile("s_waitcnt vmcnt(0)" ::: "memory");
        }
    }
    __syncthreads();
}

struct Frame {
    LAS unsigned char* lds;
    unsigned char* ws;
    const float* const* in;
    int tid, lane, wave, G, bid;
};
struct Args { const float* in[37]; float* out; unsigned char* ws; int ph_lo, ph_hi, use_bar, pad; };

__device__ __forceinline__ float dpp_f(float v, int ctrl_qp1) { return v; }
#define DPP_MOVF(v, ctrl) __builtin_bit_cast(float, __builtin_amdgcn_mov_dpp(__builtin_bit_cast(int, (v)), (ctrl), 0xf, 0xf, true))
__device__ __forceinline__ float wave_sum(float v) {
    v += DPP_MOVF(v, 0xB1);
    v += DPP_MOVF(v, 0x4E);
    v += DPP_MOVF(v, 0x141);
    v += DPP_MOVF(v, 0x140);
    v += __shfl_xor(v, 16); v += __shfl_xor(v, 32);
    return v;
}
__device__ __forceinline__ float wave_max(float v) {
#pragma unroll
    for (int o = 1; o < 64; o <<= 1) v = fmaxf(v, __shfl_xor(v, o));
    return v;
}
__device__ __forceinline__ float bflo(unsigned u) { return __uint_as_float(u << 16); }
__device__ __forceinline__ float bfhi(unsigned u) { return __uint_as_float(u & 0xffff0000u); }
__device__ __forceinline__ float bf1(bf16 h) { return __uint_as_float(((unsigned)h) << 16); }
__device__ __forceinline__ unsigned pk2(float lo, float hi) { return pg8::cvt_pk_bf16(lo, hi); }
__device__ __forceinline__ float sigm(float x) { return __builtin_amdgcn_rcpf(1.0f + __builtin_amdgcn_exp2f(-LOG2E * x)); }
__device__ __forceinline__ float softplusf_(float x) { return fmaxf(x, 0.f) + log1pf(__expf(-fabsf(x))); }
__device__ __forceinline__ void unpack8(const v4u& r, float (&f)[8]) { f[0] = bflo(r.x); f[1] = bfhi(r.x); f[2] = bflo(r.y); f[3] = bfhi(r.y); f[4] = bflo(r.z); f[5] = bfhi(r.z); f[6] = bflo(r.w); f[7] = bfhi(r.w); }
__device__ __forceinline__ v4u pack8(const float (&f)[8]) { v4u o; o.x = pk2(f[0], f[1]); o.y = pk2(f[2], f[3]); o.z = pk2(f[4], f[5]); o.w = pk2(f[6], f[7]); return o; }

template <class Fn> __device__ __forceinline__ void wprep(bf16* dst, int N, int K, Fn f, int gt, int NT) {
    const int items = N * (K >> 3);
    for (int it = gt; it < items; it += NT) { const int n = it % N, k0 = (it / N) << 3; float v[8];
#pragma unroll
        for (int j = 0; j < 8; ++j) v[j] = f(k0 + j, n);
        *(v4u*)(dst + (size_t)n * K + k0) = pack8(v); }
}
__device__ __forceinline__ void phase_prologue(Frame& F, const Args& a) {
    const int gt = F.bid * 512 + F.tid, NT = F.G * 512; unsigned char* ws = F.ws;
    { const float* W = a.in[5]; const float* gn0 = a.in[2];
      wprep((bf16*)(ws + WS_WIN), NU, D, [=](int k, int n) { const int c = n < 964 ? n : (n < 1024 ? -1 : n - 60); return c < 0 ? 0.f : W[(size_t)k * 2756 + c] * gn0[k]; }, gt, NT); }
    { const float* w2 = a.in[8]; const float* a2 = a.in[10]; const float* g2 = a.in[11];
      wprep((bf16*)(ws + WS_WLORA), 1536, 256, [=](int k, int n) { if (n < 512) return k < 64 ? w2[k * 512 + n] : 0.f; if (n < 1024) return (k >= 64 && k < 128) ? a2[(k - 64) * 512 + n - 512] : 0.f; return k >= 128 ? g2[(k - 128) * 512 + n - 1024] : 0.f; }, gt, NT); }
    { const float* W = a.in[17]; wprep((bf16*)(ws + WS_WOUT), D, D, [=](int k, int n) { return W[(size_t)k * D + n]; }, gt, NT); }
    for (int L = 0; L < 2; ++L) {
        const float* wg = a.in[31] + (size_t)L * D * FF; const float* wu = a.in[32] + (size_t)L * D * FF; const float* wd = a.in[33] + (size_t)L * FF * D;
        const float* wp = a.in[34] + (size_t)L * 256 * D; const float* wpg = a.in[36] + (size_t)L * D * D; const float* gnf = a.in[30] + L * D; const float* gnp = a.in[35] + L * D;
        wprep((bf16*)(ws + WS_WGU0 + L * WS_LAYER_STRIDE), 2 * FF, D, [=](int k, int n) { const int hid = 16 * (n >> 5) + (n & 15); return ((n & 31) >= 16 ? wu : wg)[(size_t)k * FF + hid] * gnf[k]; }, gt, NT);
        wprep((bf16*)(ws + WS_WD0 + L * WS_LAYER_STRIDE), D, FF, [=](int k, int n) { return wd[(size_t)k * D + n]; }, gt, NT);
        wprep((bf16*)(ws + WS_WPLE0 + L * WS_LAYER_STRIDE), D, 256, [=](int k, int n) { return wp[(size_t)k * D + n]; }, gt, NT);
        wprep((bf16*)(ws + WS_WPG0 + L * WS_LAYER_STRIDE), D, D, [=](int k, int n) { return wpg[(size_t)k * D + n] * gnp[k]; }, gt, NT);
    }
    { const float* W = a.in[18]; const float* gn1 = a.in[2] + D; wprep((bf16*)(ws + WS_WUP), 2 * CI, D, [=](int k, int n) { return W[(size_t)k * (2 * CI) + n] * gn1[k]; }, gt, NT); }
    { const float* W = a.in[29]; wprep((bf16*)(ws + WS_WDOWN), D, CI, [=](int k, int n) { return W[(size_t)k * D + n]; }, gt, NT); }
    { const float* wq = a.in[21]; const float* wk = a.in[22]; const float* wv = a.in[23]; const float* wif = a.in[24]; float* W12 = (float*)(ws + WS_W12);
      for (int it = gt; it < 4096 * 8; it += NT) { const int o = it & 7, c = (it >> 3) & 2047, part = it >> 14, g = c >> 2, i = c & 3; float s = 0.f;
          if (part == 0) { for (int j = 0; j < 4; ++j) s += wq[(g * 4 + i) * 4 + j] * wif[(size_t)(4 * g + j) * 8 + o] + wk[(g * 4 + i) * 4 + j] * wif[(size_t)(2048 + 4 * g + j) * 8 + o]; }
          else { for (int j = 0; j < 4; ++j) s += wv[(g * 4 + i) * 4 + j] * wif[(size_t)(4096 + 4 * g + j) * 8 + o]; }
          W12[it] = s; } }
}
__device__ __forceinline__ void phase_norm(Frame& F, const float* src, const float* gain, bf16* dst, int nrows) {
    const int gw = F.bid * NWAVES + F.wave, NGW = F.G * NWAVES, lane = F.lane;
    f32x4 g[4];
#pragma unroll
    for (int j = 0; j < 4; ++j) g[j] = *((const f32x4*)gain + lane + 64 * j);
    for (int m = gw; m < nrows; m += NGW) {
        const f32x4* xr = (const f32x4*)(src + (size_t)m * D) + lane; f32x4 v[4]; float s = 0.f;
#pragma unroll
        for (int j = 0; j < 4; ++j) { v[j] = xr[64 * j]; s += (v[j].x * v[j].x + v[j].y * v[j].y) + (v[j].z * v[j].z + v[j].w * v[j].w); }
        const float r = rsqrtf(wave_sum(s) * (1.f / D) + NORM_EPS);
        v2u* o = (v2u*)(dst + (size_t)m * D) + lane;
#pragma unroll
        for (int j = 0; j < 4; ++j) { v2u w; w.x = pk2(v[j].x * r * g[j].x, v[j].y * r * g[j].y); w.y = pk2(v[j].z * r * g[j].z, v[j].w * r * g[j].w); o[64 * j] = w; }
    }
}
__device__ __forceinline__ void phase_cast_sq(Frame& F, const float* src, bf16* dst, float* rsq, int nrows) {
    const int gw = F.bid * NWAVES + F.wave, NGW = F.G * NWAVES, lane = F.lane;
    for (int m = gw; m < nrows; m += NGW) {
        const f32x4* xr = (const f32x4*)(src + (size_t)m * D) + lane; f32x4 v[4]; float s = 0.f;
#pragma unroll
        for (int j = 0; j < 4; ++j) { v[j] = xr[64 * j]; s += (v[j].x * v[j].x + v[j].y * v[j].y) + (v[j].z * v[j].z + v[j].w * v[j].w); }
        s = wave_sum(s); if (lane < 16) rsq[(size_t)m * 16 + lane] = lane == 0 ? s : 0.f;
        v2u* o = (v2u*)(dst + (size_t)m * D) + lane;
#pragma unroll
        for (int j = 0; j < 4; ++j) { v2u w; w.x = pk2(v[j].x, v[j].y); w.y = pk2(v[j].z, v[j].w); o[64 * j] = w; }
    }
}
__device__ __forceinline__ void phase_cvt_p(Frame& F, const float* p, bf16* pb) {
    const size_t gt = (size_t)F.bid * 512 + F.tid, NT = (size_t)F.G * 512, n8 = (size_t)T * 256 / 8;
    for (size_t i0 = gt; i0 < n8; i0 += 4 * NT) { f32x4 a[4], b[4];
#pragma unroll
        for (int q4 = 0; q4 < 4; ++q4) { const size_t i = i0 + q4 * NT; if (i < n8) { a[q4] = *((const f32x4*)p + 2 * i); b[q4] = *((const f32x4*)p + 2 * i + 1); } }
#pragma unroll
        for (int q4 = 0; q4 < 4; ++q4) { const size_t i = i0 + q4 * NT; if (i < n8) { v4u o; o.x = pk2(a[q4].x, a[q4].y); o.y = pk2(a[q4].z, a[q4].w); o.z = pk2(b[q4].x, b[q4].y); o.w = pk2(b[q4].z, b[q4].w); *((v4u*)pb + i) = o; } } }
}
constexpr float QSCALE = 0.125f * LOG2E;
__device__ __forceinline__ void phase_prepA(Frame& F, const Args& a) {
    unsigned char* ws = F.ws; const bf16* UA = (const bf16*)(ws + WS_UA); const bf16* UB = (const bf16*)(ws + WS_UB);
    bf16* LIN = (bf16*)(ws + WS_LIN); bf16* QN = (bf16*)(ws + WS_QN); bf16* KN = (bf16*)(ws + WS_KN); bf16* VT = (bf16*)(ws + WS_VT);
    const float* mu = a.in[6]; const float* gq = a.in[3]; const float* gk = a.in[4];
    { const int gt = F.bid * 512 + F.tid, NT = F.G * 512; const int c8 = (gt & 31) << 3; float muv[8];
#pragma unroll
      for (int j = 0; j < 8; ++j) muv[j] = mu[1536 + c8 + j];
      for (int it0 = gt; it0 < T * 32; it0 += 4 * NT) { v4u ru[4], rp[4];
#pragma unroll
          for (int q4 = 0; q4 < 4; ++q4) { const int it = it0 + q4 * NT; if (it < T * 32) { const int t = it >> 5; ru[q4] = *(const v4u*)(UB + (size_t)t * UB_W + 1536 + c8); rp[q4] = *(const v4u*)(UB + (size_t)((t & (SEQ - 1)) ? t - 1 : t) * UB_W + 1536 + c8); } }
#pragma unroll
          for (int q4 = 0; q4 < 4; ++q4) { const int it = it0 + q4 * NT; if (it < T * 32) { const int t = it >> 5; float u[8], p[8], o[8]; unpack8(ru[q4], u); unpack8(rp[q4], p); const float pm = (t & (SEQ - 1)) ? 1.f : 0.f;
#pragma unroll
              for (int j = 0; j < 8; ++j) { const float s = u[j] + muv[j] * (p[j] * pm - u[j]); o[j] = c8 < 64 ? (1.0f - 2.0f * __builtin_amdgcn_rcpf(1.0f + __builtin_amdgcn_exp2f(2.0f * LOG2E * s))) : (c8 < 128 ? s : sigm(s));     }
              *(v4u*)(LIN + (size_t)t * 256 + c8) = pack8(o); } } } }
    { const int gw = F.bid * NWAVES + F.wave, NGW = F.G * NWAVES, lane = F.lane; float gqv[8], gkv[8];
#pragma unroll
      for (int j = 0; j < 8; ++j) { gqv[j] = gq[((lane & 7) << 3) + j] * QSCALE; gkv[j] = gk[((lane & 7) << 3) + j]; }
      for (int t0 = gw; t0 < T; t0 += 4 * NGW) { v4u rq[4], rk[4];
#pragma unroll
          for (int q4 = 0; q4 < 4; ++q4) { const int t = t0 + q4 * NGW; if (t < T) { rq[q4] = *(const v4u*)(UA + (size_t)t * UA_W + 8 * lane); rk[q4] = *(const v4u*)(UA + (size_t)t * UA_W + UA_K + 8 * (lane & 7)); } }
#pragma unroll
          for (int q4 = 0; q4 < 4; ++q4) { const int t = t0 + q4 * NGW; if (t < T) {
              float q[8], k[8]; unpack8(rq[q4], q); unpack8(rk[q4], k);
              float sq = 0.f, sk = 0.f;
#pragma unroll
              for (int j = 0; j < 8; ++j) { sq += q[j] * q[j]; sk += k[j] * k[j]; }
              sq += __shfl_xor(sq, 1); sq += __shfl_xor(sq, 2); sq += __shfl_xor(sq, 4); sk += __shfl_xor(sk, 1); sk += __shfl_xor(sk, 2); sk += __shfl_xor(sk, 4);
              const float rq_ = rsqrtf(sq * (1.f / 64.f) + NORM_EPS), rk_ = rsqrtf(sk * (1.f / 64.f) + NORM_EPS);
#pragma unroll
              for (int j = 0; j < 8; ++j) { q[j] *= rq_ * gqv[j]; k[j] *= rk_ * gkv[j]; }
              *(v4u*)(QN + (size_t)t * 512 + 8 * lane) = pack8(q);
              if (lane < 8) *(v4u*)(KN + (size_t)t * 64 + 8 * lane) = pack8(k); } } } }
    { const int gt = F.bid * 512 + F.tid, NT = F.G * 512;
      for (int it = gt; it < T * 8; it += NT) { const int t = it >> 3, c8 = (it & 7) << 3; *(v4u*)(VT + (size_t)t * 64 + c8) = *(const v4u*)(UA + (size_t)t * UA_W + UA_V + c8); } }
}
constexpr int IDX_STRIDE = 2052, KSEL = 256;
__device__ __forceinline__ void topk_select(const LAS float* row, int limit, unsigned* maskrow, int lane) {
    unsigned long long mybits = 0ull; const int nj = limit >> 6;
    if (limit <= KSEL) { mybits = lane < nj ? ~0ull : 0ull; }
    else {
        unsigned key[32];
#pragma unroll
        for (int j = 0; j < 32; ++j) key[j] = 0u;
#pragma unroll
        for (int g8 = 0; g8 < 4; ++g8) if (8 * g8 < nj) {
#pragma unroll
            for (int jj = 0; jj < 8; ++jj) { const int j = 8 * g8 + jj; unsigned u = __float_as_uint(row[64 * j + lane]); if (u == 0x80000000u) u = 0u; const unsigned k = (u & 0x80000000u) ? ~u : (u | 0x80000000u); key[j] = (j < nj) ? k : 0u; } }
        unsigned prefix = 0u; bool exact = false;
        for (int bit = 31; bit >= 0; --bit) { const unsigned cand = prefix | (1u << bit); int c0 = 0, c1 = 0;
#pragma unroll
            for (int g8 = 0; g8 < 4; ++g8) if (8 * g8 < nj) {
#pragma unroll
                for (int jj = 0; jj < 8; jj += 2) { c0 += (key[8 * g8 + jj] >= cand) ? 1 : 0; c1 += (key[8 * g8 + jj + 1] >= cand) ? 1 : 0; } }
            int cnt = c0 + c1;
            cnt += __builtin_amdgcn_mov_dpp(cnt, 0xB1, 0xf, 0xf, true); cnt += __builtin_amdgcn_mov_dpp(cnt, 0x4E, 0xf, 0xf, true); cnt += __builtin_amdgcn_mov_dpp(cnt, 0x141, 0xf, 0xf, true); cnt += __builtin_amdgcn_mov_dpp(cnt, 0x140, 0xf, 0xf, true);
            cnt = __builtin_amdgcn_readlane(cnt, 0) + __builtin_amdgcn_readlane(cnt, 16) + __builtin_amdgcn_readlane(cnt, 32) + __builtin_amdgcn_readlane(cnt, 48);
            if (cnt >= KSEL) { prefix = cand; if (cnt == KSEL) { exact = true; break; } } }
        int need = 0;
        if (!exact) { int cgt = 0;
#pragma unroll
            for (int j = 0; j < 32; ++j) cgt += __builtin_popcountll(__ballot(key[j] > prefix));
            need = KSEL - cgt; }
        int running = 0; const unsigned long long below = (1ull << lane) - 1ull;
#pragma unroll
        for (int g8 = 0; g8 < 4; ++g8) if (8 * g8 < nj)
#pragma unroll
        for (int jj = 0; jj < 8; ++jj) { const int j = 8 * g8 + jj;
            const bool gt = exact ? (key[j] >= prefix) : (key[j] > prefix); const bool tie = (!exact) && key[j] == prefix;
            const unsigned long long tb = __ballot(tie); const int rank = running + __builtin_popcountll(tb & below); running += __builtin_popcountll(tb);
            const unsigned long long sb = __ballot(gt || (tie && rank < need)); if (lane == j) mybits = sb; }
    }
    if (lane < 32) { v2u w; w.x = (unsigned)mybits; w.y = (unsigned)(mybits >> 32); *(v2u*)(maskrow + 2 * lane) = w; }
}
__device__ __forceinline__ void phase_indexer(Frame& F) {
    unsigned char* ws = F.ws; const bf16* UA = (const bf16*)(ws + WS_UA); unsigned* MASK = (unsigned*)(ws + WS_MASK);
    LAS float* sc = (LAS float*)F.lds; const int lane = F.lane, w = F.wave, fr = lane & 15, fq = lane >> 4;
    for (int r = 0;; ++r) { const int u = r * F.G + ((r & 1) ? (F.G - 1 - F.bid) : F.bid); if (u >= NB * 128) break;
        const int c = 31 - (u >> 7), rest = u & 127, b = rest >> 2, g4 = rest & 3, limit = 64 * (c + 1), tq0 = b * SEQ + c * 64 + g4 * 16;
        const bf16* UAb = UA + (size_t)b * SEQ * UA_W;
        bf16x8 qf[4][2]; float iwv[4];
        { const bf16* qp = UA + (size_t)(tq0 + fr) * UA_W;
#pragma unroll
          for (int hh = 0; hh < 4; ++hh) { qf[hh][0] = *(const bf16x8*)(qp + UA_IQ + hh * 64 + fq * 8); qf[hh][1] = *(const bf16x8*)(qp + UA_IQ + hh * 64 + 32 + fq * 8); iwv[hh] = bf1(qp[UA_IW + hh]) * (1.f / 16.f); } }
#ifndef IDX_SCORE_REP
#define IDX_SCORE_REP 1
#endif
#ifndef IDX_SEL_REP
#define IDX_SEL_REP 1
#endif
        for (int rp_ = 0; rp_ < IDX_SCORE_REP; ++rp_)
        for (int kt = w; kt < (limit >> 4); kt += NWAVES) {
            const bf16* kp = UAb + (size_t)(kt * 16 + fr) * UA_W + UA_IK + fq * 8; const bf16x8 a0 = *(const bf16x8*)kp, a1 = *(const bf16x8*)(kp + 32);
            f32x4 s = {0.f, 0.f, 0.f, 0.f};
#pragma unroll
            for (int hh = 0; hh < 4; ++hh) { f32x4 d = {0.f, 0.f, 0.f, 0.f}; d = __builtin_amdgcn_mfma_f32_16x16x32_bf16(a0, qf[hh][0], d, 0, 0, 0); d = __builtin_amdgcn_mfma_f32_16x16x32_bf16(a1, qf[hh][1], d, 0, 0, 0);
#pragma unroll
                for (int j = 0; j < 4; ++j) s[j] += iwv[hh] * fmaxf(d[j], 0.f); }
            *(LAS f32x4*)(sc + fr * IDX_STRIDE + kt * 16 + fq * 4) = s; }
        __syncthreads();
#pragma unroll 1
        for (int qq = 0; qq < 2 * IDX_SEL_REP; ++qq) { const int q = 2 * w + (qq & 1); topk_select(sc + q * IDX_STRIDE, limit, MASK + (size_t)(tq0 + q) * 64, lane); }
        __syncthreads(); }
}
constexpr int DA_K = 0, DA_V = 8192, DA_M = 16384, DA_STAGE = 16384 + 512;
__device__ __forceinline__ bf16x8 mk8(v2u lo, v2u hi) { v4u t; t.x = lo.x; t.y = lo.y; t.z = hi.x; t.w = hi.y; return __builtin_bit_cast(bf16x8, t); }
__device__ __forceinline__ void tr_read_v4d(unsigned a, bf16x8 (&vf)[4]) { s16x4 l0, h0, l1, h1, l2, h2, l3, h3;
    asm volatile("ds_read_b64_tr_b16 %0, %8\n\tds_read_b64_tr_b16 %1, %8 offset:512\n\tds_read_b64_tr_b16 %2, %8 offset:32\n\tds_read_b64_tr_b16 %3, %8 offset:544\n\t"
                 "ds_read_b64_tr_b16 %4, %8 offset:64\n\tds_read_b64_tr_b16 %5, %8 offset:576\n\tds_read_b64_tr_b16 %6, %8 offset:96\n\tds_read_b64_tr_b16 %7, %8 offset:608\n\ts_waitcnt lgkmcnt(0)"
                 : "=&v"(l0), "=&v"(h0), "=&v"(l1), "=&v"(h1), "=&v"(l2), "=&v"(h2), "=&v"(l3), "=&v"(h3) : "v"(a) : "memory");
    vf[0] = (bf16x8){l0[0], l0[1], l0[2], l0[3], h0[0], h0[1], h0[2], h0[3]}; vf[1] = (bf16x8){l1[0], l1[1], l1[2], l1[3], h1[0], h1[1], h1[2], h1[3]};
    vf[2] = (bf16x8){l2[0], l2[1], l2[2], l2[3], h2[0], h2[1], h2[2], h2[3]}; vf[3] = (bf16x8){l3[0], l3[1], l3[2], l3[3], h3[0], h3[1], h3[2], h3[3]}; }
__device__ __forceinline__ void phase_dsa_attn(Frame& F, const Args& a) {
    unsigned char* ws = F.ws; const bf16* QN = (const bf16*)(ws + WS_QN); const bf16* KN = (const bf16*)(ws + WS_KN); const bf16* VN = (const bf16*)(ws + WS_VT);
    const unsigned* MASK = (const unsigned*)(ws + WS_MASK); bf16* MIX = (bf16*)(ws + WS_XB);
    const int lane = F.lane, w = F.wave, fr = lane & 15, fq = lane >> 4; LAS unsigned char* lds = F.lds;
    const float mb = 8.f * LOG2E * wave_max(fabsf(a.in[3][lane])) * wave_max(fabsf(a.in[4][lane]));
    const unsigned vtr_lane = (unsigned)((8 * fq + ((lane & 15) >> 2)) * 128 + 4 * (lane & 3) * 2);
    for (int r = 0;; ++r) { const int u = r * F.G + ((r & 1) ? (F.G - 1 - F.bid) : F.bid); if (u >= NB * 32) break;
        const int c = 31 - (u >> 5), b = u & 31, nst = c + 1, t0 = b * SEQ + 64 * c;
        const bf16* Kb = KN + (size_t)b * SEQ * 64; const bf16* Vb = VN + (size_t)b * SEQ * 64; const unsigned* Mb = MASK + (size_t)t0 * 64;
#define DA_DMA(st_, buf_) do { const int so_ = (buf_) * DA_STAGE; \
            __builtin_amdgcn_global_load_lds((const unsigned*)(Kb + (size_t)(64 * (st_) + 8 * w) * 64 + lane * 8), (LAS unsigned*)(lds + so_ + DA_K + w * 1024), 16, 0, 0); \
            __builtin_amdgcn_global_load_lds((const unsigned*)(Vb + (size_t)(64 * (st_) + 8 * w) * 64 + lane * 8), (LAS unsigned*)(lds + so_ + DA_V + w * 1024), 16, 0, 0); \
            if (w < 2) __builtin_amdgcn_global_load_lds(Mb + (size_t)lane * 64 + 2 * (st_) + w, (LAS unsigned*)(lds + so_ + DA_M + w * 256), 4, 0, 0); } while (0)
        DA_DMA(0, 0);
        bf16x8 qf[4][2];
#pragma unroll
        for (int i = 0; i < 4; ++i) { const bf16* qp = QN + (size_t)(t0 + 16 * i + fr) * 512 + w * 64 + fq * 8; qf[i][0] = *(const bf16x8*)qp; qf[i][1] = *(const bf16x8*)(qp + 32); }
        f32x4 O[4][4]; float l[4];
#pragma unroll
        for (int i = 0; i < 4; ++i) { l[i] = 0.f;
#pragma unroll
            for (int dt = 0; dt < 4; ++dt) O[i][dt] = (f32x4){0.f, 0.f, 0.f, 0.f}; }
        for (int st = 0; st < nst; ++st) { const int buf = st & 1; const LAS unsigned char* sb = lds + buf * DA_STAGE;
            asm volatile("s_waitcnt vmcnt(0)" ::: "memory");
            __builtin_amdgcn_s_barrier(); asm volatile("" ::: "memory");
            if (st + 1 < nst) DA_DMA(st + 1, buf ^ 1);
#pragma unroll
            for (int sub = 0; sub < 2; ++sub) {
                bf16x8 kf[2][2], vf[4]; unsigned mw[4];
#pragma unroll
                for (int s2 = 0; s2 < 2; ++s2) { const LAS unsigned char* kp = sb + DA_K + (32 * sub + 8 * (fr >> 2) + 4 * s2 + (fr & 3)) * 128 + fq * 16;   kf[s2][0] = *(const LAS bf16x8*)kp; kf[s2][1] = *(const LAS bf16x8*)(kp + 64); }
#pragma unroll
                for (int i = 0; i < 4; ++i) mw[i] = *(const LAS unsigned*)(sb + DA_M + sub * 256 + (16 * i + fr) * 4);
                tr_read_v4d((unsigned)(size_t)(sb + DA_V + sub * 4096) + vtr_lane, vf);
#pragma unroll
                for (int i = 0; i < 4; ++i) {
                    f32x4 s0 = {0.f, 0.f, 0.f, 0.f}, s1 = {0.f, 0.f, 0.f, 0.f};
                    s0 = __builtin_amdgcn_mfma_f32_16x16x32_bf16(kf[0][0], qf[i][0], s0, 0, 0, 0); s0 = __builtin_amdgcn_mfma_f32_16x16x32_bf16(kf[0][1], qf[i][1], s0, 0, 0, 0);
                    s1 = __builtin_amdgcn_mfma_f32_16x16x32_bf16(kf[1][0], qf[i][0], s1, 0, 0, 0); s1 = __builtin_amdgcn_mfma_f32_16x16x32_bf16(kf[1][1], qf[i][1], s1, 0, 0, 0);
                    const unsigned b0 = mw[i] >> (8 * fq), b1 = mw[i] >> (8 * fq + 4); float p[8];
#pragma unroll
                    for (int j = 0; j < 4; ++j) { p[j] = ((b0 >> j) & 1u) ? __builtin_amdgcn_exp2f(s0[j] - mb) : 0.f; p[4 + j] = ((b1 >> j) & 1u) ? __builtin_amdgcn_exp2f(s1[j] - mb) : 0.f; }
                    l[i] += ((p[0] + p[1]) + (p[2] + p[3])) + ((p[4] + p[5]) + (p[6] + p[7]));
                    const bf16x8 pa = __builtin_bit_cast(bf16x8, pack8(p));
#pragma unroll
                    for (int dt = 0; dt < 4; ++dt) O[i][dt] = __builtin_amdgcn_mfma_f32_16x16x32_bf16(pa, vf[dt], O[i][dt], 0, 0, 0);
                } } }
#undef DA_DMA
#pragma unroll
        for (int i = 0; i < 4; ++i) { float li = l[i]; li += __shfl_xor(li, 16); li += __shfl_xor(li, 32);
#pragma unroll
            for (int j = 0; j < 4; ++j) { const float inv = 1.0f / __shfl(li, 4 * fq + j); bf16* op = MIX + (size_t)(t0 + 16 * i + 4 * fq + j) * D + w * 64 + fr;
#pragma unroll
                for (int dt = 0; dt < 4; ++dt) op[16 * dt] = (bf16)f2bf(O[i][dt][j] * inv); } }
        VM_WAIT(); __syncthreads();
    }
}
__device__ __forceinline__ float rw_decay(float x) { const float sp = fmaxf(-x, 0.f) + 0.6931471805599453f * __builtin_amdgcn_logf(1.0f + __builtin_amdgcn_exp2f(-LOG2E * fabsf(x)));
    return __builtin_amdgcn_exp2f(-LOG2E * __builtin_amdgcn_exp2f(-LOG2E * (sp + 0.5f))); }
#define MF32(a_, b_, c_) __builtin_amdgcn_mfma_f32_16x16x4f32((a_), (b_), (c_), 0, 0, 0)
constexpr int RL_AH = 0, RL_BH = 4096, RL_KH = 8192, RL_RH = 12288, RL_VX = 16384, RL_GS = 20480, RL_YA = 24576, RL_GR = 28672, RL_PM = 32768, RL_GC = 33792, RL_BON = 34048, RL_END = 34112;
static_assert(RL_END * 4 <= MISC_OFF, "RWKV LDS");
__device__ __forceinline__ void phase_rwkv(Frame& F, const Args& a) {
    unsigned char* ws = F.ws; const bf16* UB = (const bf16*)(ws + WS_UB); const bf16* LOUT = (const bf16*)(ws + WS_LOUT); bf16* MIX = (bf16*)(ws + WS_XB);
    const float* mu = a.in[6]; const float* w0 = a.in[7]; const float* a0 = a.in[9]; const float* k_k = a.in[12]; const float* k_a = a.in[13]; const float* r_k = a.in[14]; const float* gn_g = a.in[15]; const float* gn_b = a.in[16];
    const int lane = F.lane, w = F.wave, n = lane & 15, q = lane >> 4;
    LAS float* L = (LAS float*)F.lds;
    for (int bh = F.bid; bh < NB * 8; bh += F.G) {
        const int b = bh >> 3, h = bh & 7, c = h * 64 + lane;
        const float mur = mu[c], muk = mu[512 + c], muv = mu[1024 + c], w0c = w0[c], a0c = a0[c], kkc = k_k[c], kac = k_a[c], rkc = r_k[c], gng = gn_g[c], gnb = gn_b[c];
        f32x4 Z[4];
#pragma unroll
        for (int kt = 0; kt < 4; ++kt) Z[kt] = (f32x4){0.f, 0.f, 0.f, 0.f};
        const int ch = w >> 1, hs = w & 1;
        float r_ur[8], r_uk[8], r_uv[8], r_pr[8], r_pk[8], r_pv[8], r_wd[8], r_ad[8], r_gg[8], r_wf[8];
#define RW_RAW(batch_) do { _Pragma("unroll") for (int i = 0; i < 8; ++i) { const int sl = (batch_) * 64 + 16 * ch + 8 * hs + i; const size_t t = (size_t)b * SEQ + sl; const bf16* up = UB + t * UB_W + c; const bf16* pp_ = sl > 0 ? up - UB_W : up; \
            r_ur[i] = bf1(up[0]); r_uk[i] = bf1(up[512]); r_uv[i] = bf1(up[1024]); r_pr[i] = bf1(pp_[0]); r_pk[i] = bf1(pp_[512]); r_pv[i] = bf1(pp_[1024]); \
            const bf16* lp = LOUT + t * 1536 + c; r_wd[i] = bf1(lp[0]); r_ad[i] = bf1(lp[512]); r_gg[i] = bf1(lp[1024]); \
            r_wf[i] = bf1(LOUT[((size_t)b * SEQ + (batch_) * 64 + 16 * ch + i) * 1536 + c]); } } while (0)
        RW_RAW(0);
        for (int batch = 0; batch < SEQ / 64; ++batch) {
            { float gcur = 1.f;
              if (hs) {
#pragma unroll
                  for (int i = 0; i < 8; ++i) gcur *= rw_decay(w0c + r_wf[i]); }
#pragma unroll
              for (int i = 0; i < 8; ++i) { const int tl = 16 * ch + 8 * hs + i, sl = batch * 64 + tl; const float pm = sl > 0 ? 1.f : 0.f;
                const float ur = r_ur[i], uk = r_uk[i], uv = r_uv[i], pr = r_pr[i] * pm, pk = r_pk[i] * pm, pv = r_pv[i] * pm;
                const float rr = ur + mur * (pr - ur), kx = uk + muk * (pk - uk), vx = uv + muv * (pv - uv);
                const float decay = rw_decay(w0c + r_wd[i]), av = sigm(a0c + r_ad[i]);
                float kk = kx * kkc; kk = kk * rsqrtf(fmaxf(wave_sum(kk * kk), 1e-24f));
                const float km = kx * (1.f + (av - 1.f) * kac); const float bon = wave_sum(rr * km * rkc);
                const float gprev = gcur; gcur *= decay; const float ig = __builtin_amdgcn_rcpf(gcur);
                L[RL_AH + tl * 64 + lane] = -kk * gprev; L[RL_BH + tl * 64 + lane] = kk * av * ig; L[RL_KH + tl * 64 + lane] = km * ig; L[RL_RH + tl * 64 + lane] = rr * gcur;
                L[RL_VX + tl * 64 + lane] = vx; L[RL_GS + tl * 64 + lane] = r_gg[i]; if (lane == 0) L[RL_BON + tl] = bon; }
              if (hs) L[RL_GC + ch * 64 + lane] = gcur; }
            LDS_WAIT(); __syncthreads();
            if (batch + 1 < SEQ / 64) RW_RAW(batch + 1);
            { const LAS float* ah = L + RL_AH + 16 * ch * 64; const LAS float* bhm = L + RL_BH + 16 * ch * 64; const LAS float* khm = L + RL_KH + 16 * ch * 64; const LAS float* rhm = L + RL_RH + 16 * ch * 64;
              LAS float* gr = L + RL_GR + ch * 1024; LAS float* pm_ = L + RL_PM + ch * 256;
              if (hs == 0) {
                  f32x4 m = {0.f, 0.f, 0.f, 0.f};
#pragma unroll
                  for (int s = 0; s < 16; ++s) m = MF32(bhm[n * 64 + 4 * s + q], ah[n * 64 + 4 * s + q], m);
                  f32x4 tm;
#pragma unroll
                  for (int j = 0; j < 4; ++j) { m[j] = (4 * q + j < n) ? m[j] : 0.f; tm[j] = m[j] + ((4 * q + j == n) ? 1.f : 0.f); pm_[(4 * q + j) * 16 + n] = m[j]; gr[(4 * q + j) * 16 + n] = tm[j]; }
#pragma unroll
                  for (int rd = 0; rd < 3; ++rd) { LDS_WAIT();
                      f32x4 p2 = {0.f, 0.f, 0.f, 0.f};
#pragma unroll
                      for (int s = 0; s < 4; ++s) p2 = MF32(pm_[n * 16 + 4 * s + q], pm_[(4 * s + q) * 16 + n], p2);
                      f32x4 ip, t2 = {0.f, 0.f, 0.f, 0.f};
#pragma unroll
                      for (int j = 0; j < 4; ++j) ip[j] = p2[j] + ((4 * q + j == n) ? 1.f : 0.f);
#pragma unroll
                      for (int j = 0; j < 4; ++j) t2 = MF32(gr[n * 16 + 4 * q + j], ip[j], t2);
                      LDS_WAIT();
#pragma unroll
                      for (int j = 0; j < 4; ++j) { pm_[(4 * q + j) * 16 + n] = p2[j]; gr[(4 * q + j) * 16 + n] = t2[j]; } }
              } else {
                  f32x4 mk = {0.f, 0.f, 0.f, 0.f}, nb = {0.f, 0.f, 0.f, 0.f}, nk = {0.f, 0.f, 0.f, 0.f};
#pragma unroll
                  for (int s = 0; s < 16; ++s) { const float av_ = ah[n * 64 + 4 * s + q], rv_ = rhm[n * 64 + 4 * s + q], bv_ = bhm[n * 64 + 4 * s + q], kv_ = khm[n * 64 + 4 * s + q];
                      mk = MF32(kv_, av_, mk); nb = MF32(bv_, rv_, nb); nk = MF32(kv_, rv_, nk); }
#pragma unroll
                  for (int j = 0; j < 4; ++j) { const int s_ = 4 * q + j; gr[256 + s_ * 16 + n] = (s_ < n) ? mk[j] : 0.f; gr[512 + s_ * 16 + n] = (s_ <= n) ? nb[j] : 0.f; gr[768 + s_ * 16 + n] = (s_ <= n) ? nk[j] : 0.f; } } }
            LDS_WAIT(); __syncthreads();
#ifndef RW_C_REP
#define RW_C_REP 1
#endif
            if (w < 4) { const int v = 16 * w + n; f32x4 Zs[4]; for (int kt = 0; kt < 4; ++kt) Zs[kt] = Z[kt];
              for (int rc_ = 0; rc_ < RW_C_REP; ++rc_) { if (rc_) for (int kt = 0; kt < 4; ++kt) Z[kt] = Zs[kt];
#pragma unroll 1
                for (int cc = 0; cc < 4; ++cc) { const LAS float* ah = L + RL_AH + 16 * cc * 64; const LAS float* bhm = L + RL_BH + 16 * cc * 64; const LAS float* khm = L + RL_KH + 16 * cc * 64; const LAS float* rhm = L + RL_RH + 16 * cc * 64;
                    const LAS float* vx = L + RL_VX + 16 * cc * 64; const LAS float* gr = L + RL_GR + cc * 1024;
                    float vb[4];
#pragma unroll
                    for (int s = 0; s < 4; ++s) vb[s] = vx[(4 * s + q) * 64 + v];
                    f32x4 X = {0.f, 0.f, 0.f, 0.f}, Y = {0.f, 0.f, 0.f, 0.f};
#pragma unroll
                    for (int kt = 0; kt < 4; ++kt)
#pragma unroll
                        for (int j = 0; j < 4; ++j) { X = MF32(ah[n * 64 + 16 * kt + 4 * q + j], Z[kt][j], X); Y = MF32(rhm[n * 64 + 16 * kt + 4 * q + j], Z[kt][j], Y); }
#pragma unroll
                    for (int s = 0; s < 4; ++s) { X = MF32(gr[256 + (4 * s + q) * 16 + n], vb[s], X); Y = MF32(gr[768 + (4 * s + q) * 16 + n], vb[s], Y); }
                    f32x4 U = {0.f, 0.f, 0.f, 0.f};
#pragma unroll
                    for (int j = 0; j < 4; ++j) U = MF32(gr[(4 * q + j) * 16 + n], X[j], U);
#pragma unroll
                    for (int j = 0; j < 4; ++j) Y = MF32(gr[512 + (4 * q + j) * 16 + n], U[j], Y);
#pragma unroll
                    for (int j = 0; j < 4; ++j) L[RL_YA + (16 * cc + 4 * q + j) * 64 + v] = Y[j];
#pragma unroll
                    for (int kt = 0; kt < 4; ++kt) {
#pragma unroll
                        for (int j = 0; j < 4; ++j) Z[kt] = MF32(bhm[(4 * q + j) * 64 + 16 * kt + n], U[j], Z[kt]);
#pragma unroll
                        for (int s = 0; s < 4; ++s) Z[kt] = MF32(khm[(4 * s + q) * 64 + 16 * kt + n], vb[s], Z[kt]);
                        const f32x4 gc = *(const LAS f32x4*)(L + RL_GC + cc * 64 + 16 * kt + 4 * q); Z[kt] = Z[kt] * gc; } } } }
            LDS_WAIT(); __syncthreads();
#pragma unroll
            for (int i = 0; i < 8; ++i) { const int step = w + 8 * i; const size_t t = (size_t)b * SEQ + batch * 64 + step;
                const float y = L[RL_YA + step * 64 + lane], mean = wave_sum(y) * (1.f / 64.f), dlt = y - mean, var = fmaxf(wave_sum(y * y) * (1.f / 64.f) - mean * mean, 0.f);
                const float yn = dlt * rsqrtf(var + 64e-5f) * gng + gnb; const float o = (yn + L[RL_BON + step] * L[RL_VX + step * 64 + lane]) * L[RL_GS + step * 64 + lane];
                MIX[t * D + 512 + c] = (bf16)f2bf(o); }
            LDS_WAIT(); __syncthreads();
        }
#undef RW_RAW
    }
}
__device__ __forceinline__ void phase_l1prep(Frame& F, const Args& a, int hb) {
    unsigned char* ws = F.ws; const bf16* XM = (const bf16*)(ws + WS_XM); bf16* XC = (bf16*)(ws + WS_XC); bf16* Q = (bf16*)(ws + WS_Q); bf16* K = (bf16*)(ws + WS_K); bf16* V = (bf16*)(ws + WS_V);
    float* GI = (float*)(ws + WS_GI); const float* W12 = (const float*)(ws + WS_W12);
    const float* cw = a.in[19]; const float* cb = a.in[20]; const float* wq = a.in[21]; const float* wk = a.in[22]; const float* wv = a.in[23]; const float* b_i = a.in[25]; const float* b_f = a.in[26];
    const int g = F.tid, lane = F.lane, w = F.wave; LAS float* red = (LAS float*)F.lds;
    float cwr[4][4], cbr[4], wqr[16], wkr[16], wvr[16], w1[32], w2[32];
#pragma unroll
    for (int j = 0; j < 4; ++j)
#pragma unroll
        for (int i = 0; i < 4; ++i) cwr[j][i] = cw[j * CI + 4 * g + i];
#pragma unroll
    for (int i = 0; i < 4; ++i) cbr[i] = cb[4 * g + i];
#pragma unroll
    for (int i = 0; i < 16; ++i) { wqr[i] = wq[g * 16 + i]; wkr[i] = wk[g * 16 + i]; wvr[i] = wv[g * 16 + i]; }
#pragma unroll
    for (int i = 0; i < 32; ++i) { w1[i] = W12[(size_t)(4 * g) * 8 + i]; w2[i] = W12[(size_t)(2048 + 4 * g) * 8 + i]; }
    const int per = TH / F.G;
    const int tb = F.bid * per;
    float x0[4], x1[4], x2[4];
    { const int sl = tb & (SEQ - 1);
#pragma unroll
      for (int i = 0; i < 4; ++i) { x0[i] = 0.f; x1[i] = 0.f; x2[i] = 0.f; }
      if (sl >= 1) { const v2u r = *(const v2u*)(XM + (size_t)(tb - 1) * CI + 4 * g); x2[0] = bflo(r.x); x2[1] = bfhi(r.x); x2[2] = bflo(r.y); x2[3] = bfhi(r.y); }
      if (sl >= 2) { const v2u r = *(const v2u*)(XM + (size_t)(tb - 2) * CI + 4 * g); x1[0] = bflo(r.x); x1[1] = bfhi(r.x); x1[2] = bflo(r.y); x1[3] = bfhi(r.y); }
      if (sl >= 3) { const v2u r = *(const v2u*)(XM + (size_t)(tb - 3) * CI + 4 * g); x0[0] = bflo(r.x); x0[1] = bfhi(r.x); x0[2] = bflo(r.y); x0[3] = bfhi(r.y); } }
    constexpr int L1PF = 4;
    v2u xq[L1PF][2];
#pragma unroll
    for (int pq = 0; pq < L1PF; ++pq)
#pragma unroll
        for (int tk = 0; tk < 2; ++tk) xq[pq][tk] = *(const v2u*)(XM + (size_t)(tb + 2 * pq + tk) * CI + 4 * g);
    for (int n4 = 0; n4 < per / 2; ++n4) { const int t4 = tb + 2 * n4;
        float gs[16]; v2u xr[2];
        xr[0] = xq[0][0]; xr[1] = xq[0][1];
#pragma unroll
        for (int pq = 0; pq + 1 < L1PF; ++pq) { xq[pq][0] = xq[pq + 1][0]; xq[pq][1] = xq[pq + 1][1]; }
        { const int tn = (n4 + L1PF < per / 2) ? t4 + 2 * L1PF : t4;
#pragma unroll
          for (int tk = 0; tk < 2; ++tk) xq[L1PF - 1][tk] = *(const v2u*)(XM + (size_t)(tn + tk) * CI + 4 * g); }
#pragma unroll
        for (int tk = 0; tk < 2; ++tk) { const int t = t4 + tk;
            float x3[4]; x3[0] = bflo(xr[tk].x); x3[1] = bfhi(xr[tk].x); x3[2] = bflo(xr[tk].y); x3[3] = bfhi(xr[tk].y);
            float xc[4], q[4], k[4], v[4];
#pragma unroll
            for (int i = 0; i < 4; ++i) { const float s = fmaf(cwr[3][i], x3[i], fmaf(cwr[2][i], x2[i], fmaf(cwr[1][i], x1[i], fmaf(cwr[0][i], x0[i], cbr[i])))); xc[i] = s * sigm(s); }
#pragma unroll
            for (int j = 0; j < 4; ++j) { q[j] = fmaf(xc[3], wqr[12 + j], fmaf(xc[2], wqr[8 + j], fmaf(xc[1], wqr[4 + j], xc[0] * wqr[j]))); k[j] = fmaf(xc[3], wkr[12 + j], fmaf(xc[2], wkr[8 + j], fmaf(xc[1], wkr[4 + j], xc[0] * wkr[j])));
                v[j] = fmaf(x3[3], wvr[12 + j], fmaf(x3[2], wvr[8 + j], fmaf(x3[1], wvr[4 + j], x3[0] * wvr[j]))); }
#pragma unroll
            for (int o = 0; o < 8; ++o) { float s = 0.f;
#pragma unroll
                for (int i = 0; i < 4; ++i) s = fmaf(x3[i], w2[i * 8 + o], fmaf(xc[i], w1[i * 8 + o], s));
                gs[tk * 8 + o] = s; }
            const size_t off = (size_t)t * CI + 4 * g; const float ks = 0.044194173824159216f;
            { v2u o; o.x = pk2(xc[0], xc[1]); o.y = pk2(xc[2], xc[3]); *(v2u*)(XC + off) = o; o.x = pk2(q[0], q[1]); o.y = pk2(q[2], q[3]); *(v2u*)(Q + off) = o;
              o.x = pk2(k[0] * ks, k[1] * ks); o.y = pk2(k[2] * ks, k[3] * ks); *(v2u*)(K + off) = o; o.x = pk2(v[0], v[1]); o.y = pk2(v[2], v[3]); *(v2u*)(V + off) = o; }
#pragma unroll
            for (int i = 0; i < 4; ++i) { x0[i] = x1[i]; x1[i] = x2[i]; x2[i] = x3[i]; } }
#define L1_STAGE(mask, n) { const bool hi_ = (lane & (mask)) != 0; _Pragma("unroll") for (int i = 0; i < (n) / 2; ++i) { const float send_ = hi_ ? gs[i] : gs[(n) / 2 + i]; const float keep_ = hi_ ? gs[(n) / 2 + i] : gs[i]; gs[i] = keep_ + __shfl_xor(send_, (mask)); } }
        L1_STAGE(32, 16) L1_STAGE(16, 8) L1_STAGE(8, 4) L1_STAGE(4, 2)
#undef L1_STAGE
        gs[0] += __shfl_xor(gs[0], 2); gs[0] += __shfl_xor(gs[0], 1);
        LAS float* rp = red + (n4 & 1) * 128;
        if ((lane & 3) == 0) rp[w * 16 + (lane >> 2)] = gs[0];
        LDS_WAIT(); __syncthreads();
        if (F.tid < 16) { float s = 0.f;
#pragma unroll
            for (int ww = 0; ww < 8; ++ww) s += rp[ww * 16 + F.tid];
            const int o = F.tid & 7; GI[(size_t)(t4 + (F.tid >> 3)) * 8 + o] = s + (o < 4 ? b_i[o] : b_f[o - 4]); }
    }
}
__device__ __forceinline__ void phase_gatescan(Frame& F) {
    unsigned char* ws = F.ws; const float* GI = (const float*)(ws + WS_GI); float* GA = (float*)(ws + WS_GA); float* GAM = (float*)(ws + WS_GAM); float* GEM = (float*)(ws + WS_GEM);
    const int lane = F.lane, w = F.wave, tid = F.tid; LAS float* wtot = (LAS float*)F.lds;
    for (int sq = F.bid; sq < (NB / 2) * 4; sq += F.G) { const int bl = sq >> 2, h = sq & 3; const size_t tq = (size_t)bl * SEQ + 4 * tid;
        float ip[4], c[4];
#pragma unroll
        for (int k = 0; k < 4; ++k) { ip[k] = GI[(tq + k) * 8 + h]; c[k] = -softplusf_(-GI[(tq + k) * 8 + 4 + h]); }
        c[1] += c[0]; c[2] += c[1]; c[3] += c[2];
        float inc = c[3];
#pragma unroll
        for (int o = 1; o < 64; o <<= 1) { const float n = __shfl_up(inc, o); if (lane >= o) inc += n; }
        if (lane == 63) wtot[w] = inc;
        LDS_WAIT(); __syncthreads();
        float off = inc - c[3];
#pragma unroll
        for (int ww = 0; ww < 8; ++ww) if (ww < w) off += wtot[ww];
        float Fv[4], av[4], m[4];
#pragma unroll
        for (int k = 0; k < 4; ++k) { Fv[k] = off + c[k]; av[k] = ip[k] - Fv[k]; }
        m[0] = av[0]; m[1] = fmaxf(m[0], av[1]); m[2] = fmaxf(m[1], av[2]); m[3] = fmaxf(m[2], av[3]);
        float incm = m[3];
#pragma unroll
        for (int o = 1; o < 64; o <<= 1) { const float n = __shfl_up(incm, o); if (lane >= o) incm = fmaxf(incm, n); }
        if (lane == 63) wtot[8 + w] = incm;
        LDS_WAIT(); __syncthreads();
        float offm = __shfl_up(incm, 1); if (lane == 0) offm = -INFINITY;
#pragma unroll
        for (int ww = 0; ww < 8; ++ww) if (ww < w) offm = fmaxf(offm, wtot[8 + ww]);
#pragma unroll
        for (int k = 0; k < 4; ++k) { const float A = fmaxf(offm, m[k]); GA[(tq + k) * 4 + h] = av[k]; GAM[(tq + k) * 4 + h] = A; GEM[(tq + k) * 4 + h] = __expf(-(Fv[k] + A)); }
        LDS_WAIT(); __syncthreads();
    }
}
constexpr int ML_PITCH = 1040, ML_TILE = 32 * ML_PITCH, ML_PP = 80, ML_PT = 64 * ML_PP;
constexpr int ML_K = 0, ML_V = 2 * ML_TILE, ML_P = 4 * ML_TILE, ML_DEN = ML_P + 2 * ML_PT, ML_AT = ML_DEN + 512, ML_AS = ML_AT + 256, ML_END = ML_AS + 8192;
constexpr int ML_ST = ML_P, ML_MR = ML_P + 4096;
static_assert(ML_MR + 512 <= ML_DEN, "mLSTM LDS tables");
static_assert(ML_END <= MISC_OFF, "mLSTM LDS");
__device__ __forceinline__ void tr_read_v4(unsigned a, bf16x8 (&vf)[4]) { s16x4 l0, h0, l1, h1, l2, h2, l3, h3;
    asm volatile("ds_read_b64_tr_b16 %0, %8\n\tds_read_b64_tr_b16 %1, %8 offset:4160\n\tds_read_b64_tr_b16 %2, %8 offset:32\n\tds_read_b64_tr_b16 %3, %8 offset:4192\n\t"
                 "ds_read_b64_tr_b16 %4, %8 offset:64\n\tds_read_b64_tr_b16 %5, %8 offset:4224\n\tds_read_b64_tr_b16 %6, %8 offset:96\n\tds_read_b64_tr_b16 %7, %8 offset:4256\n\ts_waitcnt lgkmcnt(0)"
                 : "=&v"(l0), "=&v"(h0), "=&v"(l1), "=&v"(h1), "=&v"(l2), "=&v"(h2), "=&v"(l3), "=&v"(h3) : "v"(a) : "memory");
    vf[0] = (bf16x8){l0[0], l0[1], l0[2], l0[3], h0[0], h0[1], h0[2], h0[3]}; vf[1] = (bf16x8){l1[0], l1[1], l1[2], l1[3], h1[0], h1[1], h1[2], h1[3]};
    vf[2] = (bf16x8){l2[0], l2[1], l2[2], l2[3], h2[0], h2[1], h2[2], h2[3]}; vf[3] = (bf16x8){l3[0], l3[1], l3[2], l3[3], h3[0], h3[1], h3[2], h3[3]}; }
static_assert(4 * ML_PITCH == 4160, "tr_read_v4 offsets");
__device__ __forceinline__ void phase_mlstm(Frame& F, const Args& a) {
    unsigned char* ws = F.ws; const bf16* Q = (const bf16*)(ws + WS_Q); const bf16* K = (const bf16*)(ws + WS_K); const bf16* V = (const bf16*)(ws + WS_V); const bf16* XC = (const bf16*)(ws + WS_XC); const bf16* Z = (const bf16*)(ws + WS_Z);
    bf16* YC = (bf16*)(ws + WS_XM); const float* GA = (const float*)(ws + WS_GA); const float* GAM = (const float*)(ws + WS_GAM); const float* GEM = (const float*)(ws + WS_GEM);
    const float* mh_g = a.in[27]; const float* skip = a.in[28];
    const int tid = F.tid, lane = F.lane, w = F.wave, fr = lane & 15, fq = lane >> 4; LAS unsigned char* lds = F.lds;
    LAS float* den2 = (LAS float*)(lds + ML_DEN); LAS float* stats = (LAS float*)(lds + ML_ST); LAS float* mr = (LAS float*)(lds + ML_MR); LAS float* em_s = (LAS float*)(lds + ML_AT); LAS float* as_s = (LAS float*)(lds + ML_AS);
    const int tt = w >> 1, st = w & 1;
    const unsigned vtr_lane = (unsigned)((8 * fq + ((lane & 15) >> 2)) * ML_PITCH + (64 * w + 4 * (lane & 3)) * 2);
#ifndef ML_DMA_REP
#define ML_DMA_REP 1
#endif
#define ML_DMA(gbase, tile_off) do { _Pragma("unroll") for (int r4_ = 0; r4_ < 4 * ML_DMA_REP; ++r4_) { const int r4 = r4_ & 3; const int rr = w + 8 * r4; \
        __builtin_amdgcn_global_load_lds((const unsigned*)((gbase) + (size_t)rr * CI + lane * 8), (LAS unsigned*)(lds + (tile_off) + rr * ML_PITCH), 16, 0, 0); } } while (0)
    for (int r = 0; r < 8; ++r) { const int xcd = F.bid & 7, cq = F.bid >> 3, c16 = cq & 15; if (F.G != 256) break;
        const int part = r & 1, qi = part ? 31 - c16 : c16, bh = xcd + 8 * ((cq >> 4) + 2 * (r >> 1)), bl = bh >> 2, h = bh & 3; const size_t t0 = (size_t)bl * SEQ + 64 * qi; const int nk = 2 * (qi + 1), jstart = part ? 2 * (c16 + 1) : 0;
        const bf16* Kb = K + (size_t)bl * SEQ * CI + h * 512; const bf16* Vb = V + (size_t)bl * SEQ * CI + h * 512;
        ML_DMA(Kb + (size_t)(32 * jstart) * CI, ML_K); ML_DMA(Vb + (size_t)(32 * jstart) * CI, ML_V);
        bf16x8 qf[16];
        { const bf16* qp = Q + (t0 + 16 * tt + fr) * CI + h * 512 + fq * 8;
#pragma unroll
          for (int ks = 0; ks < 16; ++ks) qf[ks] = *(const bf16x8*)(qp + 32 * ks); }
        const float At = GAM[(t0 + 16 * tt + fr) * 4 + h];
        if (tid < 64) em_s[tid] = GEM[(t0 + tid) * 4 + h];
#pragma unroll
        for (int i4 = 0; i4 < 4; ++i4) { const int sidx = tid + 512 * i4; if (sidx < 64 * (qi + 1)) as_s[sidx] = GA[((size_t)bl * SEQ + sidx) * 4 + h]; }
        VM_WAIT(); LDS_WAIT();
        f32x4 O[4][4]; float denp = 0.f;
#pragma unroll
        for (int i = 0; i < 4; ++i)
#pragma unroll
            for (int e = 0; e < 4; ++e) O[i][e] = (f32x4){0.f, 0.f, 0.f, 0.f};
        for (int jj = 0; jj < nk; ++jj) { const int buf = jj & 1; int j = jj + jstart; if (j >= nk) j -= nk; int jn = j + 1; if (jn >= nk) jn -= nk;
            asm volatile("s_waitcnt vmcnt(0)" ::: "memory");
            __builtin_amdgcn_s_barrier(); asm volatile("" ::: "memory");
            if (jj + 1 < nk) ML_DMA(Kb + (size_t)(32 * jn) * CI, ML_K + (buf ^ 1) * ML_TILE);
            f32x4 sacc = {0.f, 0.f, 0.f, 0.f}, sacb = {0.f, 0.f, 0.f, 0.f};
            { const LAS unsigned char* kl = lds + ML_K + buf * ML_TILE + (16 * st + fr) * ML_PITCH + fq * 16;
#pragma unroll
              for (int ks = 0; ks < 16; ks += 2) { const bf16x8 kf = *(const LAS bf16x8*)(kl + 64 * ks), kg = *(const LAS bf16x8*)(kl + 64 * ks + 64);
                  sacc = __builtin_amdgcn_mfma_f32_16x16x32_bf16(kf, qf[ks], sacc, 0, 0, 0); sacb = __builtin_amdgcn_mfma_f32_16x16x32_bf16(kg, qf[ks + 1], sacb, 0, 0, 0); if ((ks & 3) == 2) __builtin_amdgcn_sched_barrier(0); } }
            sacc += sacb;
#ifdef ML_S_REP
            { f32x4 s2a = {0.f, 0.f, 0.f, 0.f}, s2b = {0.f, 0.f, 0.f, 0.f}; const LAS unsigned char* kl = lds + ML_K + buf * ML_TILE + (16 * st + fr) * ML_PITCH + fq * 16; asm volatile("" ::: "memory");
#pragma unroll
              for (int ks = 0; ks < 16; ks += 2) { const bf16x8 kf = *(const LAS bf16x8*)(kl + 64 * ks), kg = *(const LAS bf16x8*)(kl + 64 * ks + 64);
                  s2a = __builtin_amdgcn_mfma_f32_16x16x32_bf16(kf, qf[ks], s2a, 0, 0, 0); s2b = __builtin_amdgcn_mfma_f32_16x16x32_bf16(kg, qf[ks + 1], s2b, 0, 0, 0); if ((ks & 3) == 2) __builtin_amdgcn_sched_barrier(0); }
              sacc = (sacc + (s2a + s2b)) * 0.5f; }
#endif
            float p[4]; const f32x4 asv = *(const LAS f32x4*)(as_s + 32 * j + 16 * st + 4 * fq); const float as[4] = {asv[0], asv[1], asv[2], asv[3]};
#pragma unroll
            for (int i = 0; i < 4; ++i) { const bool ok = (32 * j + 16 * st + 4 * fq + i) <= (64 * qi + 16 * tt + fr); p[i] = ok ? sacc[i] * __builtin_amdgcn_exp2f((as[i] - At) * LOG2E) : 0.f; }
            denp += (p[0] + p[1]) + (p[2] + p[3]);
            { v2u pw; pw.x = pk2(p[0], p[1]); pw.y = pk2(p[2], p[3]); *(LAS v2u*)(lds + ML_P + buf * ML_PT + (16 * tt + fr) * ML_PP + (16 * st + 4 * fq) * 2) = pw; }
            LDS_WAIT(); __builtin_amdgcn_s_barrier(); asm volatile("" ::: "memory");
            if (jj + 1 < nk) ML_DMA(Vb + (size_t)(32 * jn) * CI, ML_V + (buf ^ 1) * ML_TILE);
            { bf16x8 vf[4], pf[4]; const unsigned vb = (unsigned)(size_t)(lds + ML_V + buf * ML_TILE) + vtr_lane;
              tr_read_v4(vb, vf);
#pragma unroll
              for (int i = 0; i < 4; ++i) pf[i] = *(const LAS bf16x8*)(lds + ML_P + buf * ML_PT + (16 * i + fr) * ML_PP + fq * 16);
#pragma unroll
              for (int i = 0; i < 4; ++i)
#pragma unroll
                  for (int e = 0; e < 4; ++e) O[i][e] = __builtin_amdgcn_mfma_f32_16x16x32_bf16(pf[i], vf[e], O[i][e], 0, 0, 0); }
        }
        { float d = denp; d += __shfl_xor(d, 16); d += __shfl_xor(d, 32); if (fq == 0) den2[st * 64 + 16 * tt + fr] = d; }
        LDS_WAIT(); __syncthreads();
        { const LAS float* den_q = den2 + 4 * fq; const LAS float* em_q = em_s + 4 * fq; LAS float* st_q = stats + (w * 64 + 4 * fq) * 2;
#pragma unroll
          for (int i = 0; i < 4; ++i) {
#pragma unroll
            for (int jj = 0; jj < 4; ++jj) { const float dn = den_q[16 * i + jj] + den_q[64 + 16 * i + jj]; const float inv = 1.0f / fmaxf(fabsf(dn), em_q[16 * i + jj]); float a1 = 0.f, a2 = 0.f;
#pragma unroll
                for (int e = 0; e < 4; ++e) { const float hv = O[i][e][jj] * inv; O[i][e][jj] = hv; a1 += hv; a2 += hv * hv; }
                { a1 += DPP_MOVF(a1, 0xB1); a2 += DPP_MOVF(a2, 0xB1); a1 += DPP_MOVF(a1, 0x4E); a2 += DPP_MOVF(a2, 0x4E); a1 += DPP_MOVF(a1, 0x141); a2 += DPP_MOVF(a2, 0x141); a1 += DPP_MOVF(a1, 0x140); a2 += DPP_MOVF(a2, 0x140); }
                if (fr == 0) { st_q[(16 * i + jj) * 2] = a1; st_q[(16 * i + jj) * 2 + 1] = a2; } } } }
        LDS_WAIT(); __syncthreads();
        if (tid < 64) { float a1 = 0.f, a2 = 0.f;
#pragma unroll
            for (int ww = 0; ww < 8; ++ww) { a1 += stats[(ww * 64 + tid) * 2]; a2 += stats[(ww * 64 + tid) * 2 + 1]; }
            const float mean = a1 * (1.f / 512.f), var = fmaxf(a2 * (1.f / 512.f) - mean * mean, 0.f); mr[2 * tid] = mean; mr[2 * tid + 1] = rsqrtf(var + 1e-5f); }
        LDS_WAIT(); __syncthreads();
        { LAS float* ytile = (LAS float*)lds; LAS float* yt_q = ytile + 4 * fq * 516 + 64 * w + fr; const LAS float* mr_q = mr + 8 * fq;
#pragma unroll
          for (int i = 0; i < 4; ++i)
#pragma unroll
            for (int jj = 0; jj < 4; ++jj) { const float mean = mr_q[(16 * i + jj) * 2], rstd = mr_q[(16 * i + jj) * 2 + 1];
#pragma unroll
                for (int e = 0; e < 4; ++e) yt_q[(16 * i + jj) * 516 + 16 * e] = (O[i][e][jj] - mean) * rstd; }
          LDS_WAIT(); __syncthreads();
          const int c8 = (tid & 63) * 8, cc = h * 512 + c8; float gm[8], sk[8];
#pragma unroll
          for (int q = 0; q < 8; ++q) { gm[q] = mh_g[cc + q]; sk[q] = skip[cc + q]; }
#pragma unroll
          for (int k8 = 0; k8 < 8; ++k8) { const int row = (tid >> 6) + 8 * k8; const size_t off = (t0 + row) * CI + cc;
              const v4u zr = *(const v4u*)(Z + off), xr = *(const v4u*)(XC + off); const f32x4 y0 = *(const LAS f32x4*)(ytile + row * 516 + c8), y1 = *(const LAS f32x4*)(ytile + row * 516 + c8 + 4);
              float zf[8], xf[8], o[8]; unpack8(zr, zf); unpack8(xr, xf);
#pragma unroll
              for (int q = 0; q < 8; ++q) { const float yv = q < 4 ? y0[q & 3] : y1[q & 3]; o[q] = (yv * gm[q] + sk[q] * xf[q]) * (zf[q] * sigm(zf[q])); }
              *(v4u*)(YC + off) = pack8(o); if (k8 & 1) asm volatile("" ::: "memory"); } }
        VM_WAIT(); __syncthreads();
    }
#undef ML_DMA
}
#define GEMM_PHASE(EPI, Aptr, Bptr, M_, N_, K_, ...) do { pg8::Gemm g{(const pg8::bf16_t*)(Aptr), (const pg8::bf16_t*)(Bptr), (M_), (N_), (K_)}; pg8::StaticOrder So; So.init((M_), (N_), F.G, F.bid); \
        pg8::EPI Ep{__VA_ARGS__}; pg8::gemm_phase<pg8::EPI, pg8::StaticOrder, PG8_ALIGN, PG8_SP2>(F.lds, g, So, Ep); } while (0)
namespace pg8 { typedef EpiRes2<float> EpiResF; typedef EpiRes2<bf16_t> EpiResB; typedef EpiPle2<false> EpiPleB; typedef EpiPle2<true> EpiPleF; }
__global__ void __launch_bounds__(NWAVES * 64, 2) trunk_fwd(Args args) {
    extern __shared__ __attribute__((aligned(16))) unsigned char lds_raw[];
    Frame F; F.lds = (LAS unsigned char*)lds_raw; F.ws = args.ws; F.in = nullptr;
    F.tid = threadIdx.x; F.lane = F.tid & 63; F.wave = __builtin_amdgcn_readfirstlane(F.tid >> 6); F.G = gridDim.x; F.bid = blockIdx.x;
    volatile LAS unsigned* MISC = (volatile LAS unsigned*)(F.lds + MISC_OFF);
    if (F.tid < 64) MISC[F.tid] = 0u;
    __syncthreads();
    XcdBarrier bar; bar.bar = (unsigned*)(args.ws + WS_CTL) + CW_BAR; bar.x = 0; bar.st = nullptr;
    if (args.use_bar) bar = xcd_barrier_post((unsigned*)(args.ws + WS_CTL) + CW_BAR, MISC + 8);
    unsigned* xrank = (unsigned*)(args.ws + WS_CTL) + CW_XRANK; const unsigned my_xcc = xb_xcc_id();
    if (args.use_bar && F.tid == 0) MISC[12] = xb_add(&xrank[64 * my_xcc], 1u);
    const int lo = args.ph_lo, hi = args.ph_hi;
#ifndef ONLY_SITE
#define ONLY_SITE -1
#endif
#define EN(n) (ONLY_SITE < 0 || ONLY_SITE == (n))
#ifndef REP_MASK
#define REP_MASK 0u
#endif
#define NREP(n) (((REP_MASK >> (n)) & 1u) ? 2 : 1)
#define IN(k) (lo <= (k) && (k) < hi)
#define SEAM(k) do { if (IN(k) && IN((k) + 1)) xcd_barrier(bar); } while (0)
    unsigned char* ws = args.ws; float* out = args.out;
    float* RS = (float*)(ws + WS_RS);
#define RSN(i) (RS + (size_t)(i) * T * 16)
#define PH(site, k, ...) if (EN(site) && IN(k)) { for (int rep_ = 0; rep_ < NREP(site); ++rep_) { if (rep_) xcd_barrier(bar); __VA_ARGS__ } } SEAM(k);
    PH(0, 0, phase_prologue(F, args); phase_cast_sq(F, args.in[0], (bf16*)(ws + WS_XB2), RSN(0), T); phase_cvt_p(F, args.in[1], (bf16*)(ws + WS_PB));)
    if (args.use_bar && lo == 0 && hi > 1) {
        bool ok = F.G == 256; for (int x = 0; x < 16; ++x) { const unsigned cx = xb_ld(&xrank[64 * x]); ok = ok && (cx == (x < 8 ? 32u : 0u)); }
        const unsigned rk = MISC[12]; if (ok && rk < 32u && my_xcc < 8u) F.bid = (int)(rk * 8u + my_xcc); }
    PH(2, 1, GEMM_PHASE(EpiBf16SplitR, ws + WS_XB2, ws + WS_WIN, T, NU, D, (pg8::bf16_t*)(ws + WS_UA), UA_W, 4, (pg8::bf16_t*)(ws + WS_UB), UB_W, RSN(0));)
    PH(3, 2, phase_prepA(F, args);)
    PH(4, 3, GEMM_PHASE(EpiBf16Split, ws + WS_LIN, ws + WS_WLORA, T, 1536, 256 + args.pad, (pg8::bf16_t*)(ws + WS_LOUT), 1536, 1 << 20, nullptr, 0);)
    PH(5, 4, phase_indexer(F);)
    PH(6, 5, phase_dsa_attn(F, args);)
    PH(7, 6, phase_rwkv(F, args);)
    PH(8, 7, GEMM_PHASE(EpiResF, ws + WS_XB, ws + WS_WOUT, T, D, D, args.in[0], (pg8::bf16_t*)(ws + WS_XB2), D, RSN(1));)
#define FFN_PLE(L, pb, rs_a, rs_b, rs_c, PLE_EPI, ple_out) do { const size_t lw = (size_t)(L) * WS_LAYER_STRIDE; \
        PH(21, (pb), GEMM_PHASE(EpiSwigluR, ws + WS_XB2, ws + WS_WGU0 + lw, T, 2 * FF, D, (pg8::bf16_t*)(ws + WS_H), FF, RSN(rs_a));) \
        PH(22, (pb) + 1, GEMM_PHASE(EpiResB, ws + WS_H, ws + WS_WD0 + lw, T, D, FF, (const pg8::bf16_t*)(ws + WS_XB2), (pg8::bf16_t*)(ws + WS_XB), D, RSN(rs_b));) \
        PH(24, (pb) + 2, GEMM_PHASE(EpiBf16Split, ws + WS_PB, ws + WS_WPLE0 + lw, T, D, 256 + args.pad, (pg8::bf16_t*)(ws + WS_E), D, 1 << 20, nullptr, 0);) \
        PH(25, (pb) + 3, GEMM_PHASE(PLE_EPI, ws + WS_XB, ws + WS_WPG0 + lw, T, D, D, (const pg8::bf16_t*)(ws + WS_XB), (void*)(ple_out), (const pg8::bf16_t*)(ws + WS_E), D, RSN(rs_b), RSN(rs_c));) } while (0)
#define L1_HALF(hb, p1) do { bf16* xbh = (bf16*)(ws + WS_XB2) + (size_t)(hb) * TH * D; \
        PH(11, (p1), GEMM_PHASE(EpiBf16SplitR, xbh, ws + WS_WUP, TH, 2 * CI, D, (pg8::bf16_t*)(ws + WS_XM), CI, 8, (pg8::bf16_t*)(ws + WS_Z), CI, RSN(3) + (size_t)(hb) * TH * 16);) \
        PH(12, (p1) + 1, phase_l1prep(F, args, hb);) \
        PH(13, (p1) + 2, phase_gatescan(F); if ((hb) == 0) phase_cvt_p(F, args.in[1] + (size_t)T * 256, (bf16*)(ws + WS_PB));) \
        PH(14, (p1) + 3, phase_mlstm(F, args);) \
        PH(15, (p1) + 4, GEMM_PHASE(EpiResB, ws + WS_XM, ws + WS_WDOWN, TH, D, CI, (const pg8::bf16_t*)xbh, (pg8::bf16_t*)xbh, D, RSN(4) + (size_t)(hb) * TH * 16);) } while (0)
    FFN_PLE(0, 8, 1, 2, 3, EpiPleB, ws + WS_XB2);
    L1_HALF(0, 12);
    L1_HALF(1, 17);
    FFN_PLE(1, 22, 4, 5, 5, EpiPleF, out);
#undef IN
#undef SEAM
}
constexpr int N_PHASES = 26;

#ifndef MK_ONE_LAUNCH
#define MK_ONE_LAUNCH 1
#endif
extern "C" void kernel_launch(void* const* d_in, const int* in_sizes, int n_in, void* d_out, int out_size, void* d_ws, size_t ws_size, hipStream_t stream) {
    static int grid = 0;
    if (grid == 0) {
        if (n_in != 37 || in_sizes[0] != T * D || out_size != T * D || ws_size < WS_END) { fprintf(stderr, "kernel_launch: unexpected shapes (n_in %d, in0 %d, out %d, ws %zu < %zu); nothing launched\n", n_in, n_in > 0 ? in_sizes[0] : -1, out_size, ws_size, (size_t)WS_END); grid = -1; return; }
        int dev = 0, cus = 0, per_cu = 0;
        if (hipGetDevice(&dev) != hipSuccess || hipDeviceGetAttribute(&cus, hipDeviceAttributeMultiprocessorCount, dev) != hipSuccess) { grid = -1; return; }
        if (hipFuncSetAttribute((const void*)trunk_fwd, hipFuncAttributeMaxDynamicSharedMemorySize, LDS_BYTES) != hipSuccess) { fprintf(stderr, "kernel_launch: hipFuncSetAttribute failed\n"); grid = -1; return; }
        if (hipOccupancyMaxActiveBlocksPerMultiprocessor(&per_cu, (const void*)trunk_fwd, NWAVES * 64, LDS_BYTES) != hipSuccess || per_cu < 1) { fprintf(stderr, "kernel_launch: occupancy query says %d\n", per_cu); }
        (void)hipGetLastError();
        grid = cus;
        if (grid != 256) { fprintf(stderr, "kernel_launch: built for 256 CUs, found %d; nothing launched\n", cus); grid = -1; return; }
    }
    if (grid < 0) return;
    if (hipMemsetAsync((char*)d_ws + WS_CTL, 0, CTL_ZERO_BYTES, stream) != hipSuccess) return;
    Args a{};
    for (int i = 0; i < 37; ++i) a.in[i] = (const float*)d_in[i];
    a.out = (float*)d_out; a.ws = (unsigned char*)d_ws; a.pad = 0;
#if MK_ONE_LAUNCH
    a.ph_lo = 0; a.ph_hi = N_PHASES; a.use_bar = 1;
    hipLaunchKernelGGL(trunk_fwd, dim3(grid), dim3(NWAVES * 64), LDS_BYTES, stream, a);
#else
    for (int p = 0; p < N_PHASES; ++p) { a.ph_lo = p; a.ph_hi = p + 1; a.use_bar = 0; hipLaunchKernelGGL(trunk_fwd, dim3(grid), dim3(NWAVES * 64), LDS_BYTES, stream, a); }
#endif
}
```

```cpp
#include <hip/hip_runtime.h>
#include <cstdio>
#include <cstdint>
namespace pg8 {
#define PG8_LAS __attribute__((address_space(3)))
typedef unsigned short bf16_t;
typedef short bf16x8 __attribute__((ext_vector_type(8)));
typedef float f32x4 __attribute__((ext_vector_type(4)));
typedef unsigned u32x4 __attribute__((ext_vector_type(4)));
constexpr int BM = 256, BK = 64, HALF = 128, HTB = HALF * BK * 2  , STAGE_BYTES = 8 * HTB, NXCD = 8, WGM = 8;

__host__ __device__ __forceinline__ int lds_byte(int r, int c) { const int st = (r >> 4) * 2 + (c >> 5), rr = r & 15, cc = c & 31, ob = rr * 64 + cc * 2; return st * 1024 + (ob ^ (((ob >> 9) & 1) << 5)); }
__host__ __device__ __forceinline__ void stage_rc(int b, int& R, int& C) { const int st = b / 1024, sb = b % 1024, swz = sb ^ (((sb >> 9) & 1) << 5); R = (st >> 1) * 16 + swz / 64; C = (st & 1) * 32 + (swz % 64) / 2; }
__host__ __device__ __forceinline__ int perm32(int rho) { const int n = rho >> 4, i = rho & 15; return 8 * (i >> 2) + 4 * n + (i & 3); }

struct Unit { int pm, pn; };
struct Gemm { const bf16_t* A; const bf16_t* Bt; int M, N, K; };

struct StaticOrder {
    int nM, nN, nwg, G, c;
    __host__ __device__ void init(int M, int N, int G_, int c_) { nM = M / BM; nN = N / BM; nwg = nM * nN; G = G_; c = c_; }
    __host__ __device__ bool next(int i, Unit& u) const {
        const long L = (long)i * G + c; if (L >= nwg) return false;
        int wgid = (int)L; { const int q = nwg / NXCD, r = nwg % NXCD, xcd = wgid % NXCD, off = wgid / NXCD; wgid = (xcd < r ? xcd * (q + 1) : r * (q + 1) + (xcd - r) * q) + off; }
        const int nig = WGM * nN, gid = wgid / nig, fm = gid * WGM, gsz = (nM - fm) < WGM ? (nM - fm) : WGM;
        u.pm = fm + ((wgid % nig) % gsz); u.pn = (wgid % nig) / gsz; return true;
    }
    __device__ __forceinline__ void a_ready(const Unit&) const {}
    __device__ __forceinline__ void done(const Unit&) const {}
};

__device__ __forceinline__ unsigned cvt_pk_bf16(float lo, float hi) { unsigned r; asm volatile("v_cvt_pk_bf16_f32 %0, %1, %2" : "=v"(r) : "v"(lo), "v"(hi)); return r; }
typedef float f32x2 __attribute__((ext_vector_type(2)));
__device__ __forceinline__ f32x2 gelu_pk(f32x2 v) {
    const f32x2 av = __builtin_elementwise_abs(v), d = av * 0.2316418882f + 1.0f;
    f32x2 t; t.x = __builtin_amdgcn_rcpf(d.x); t.y = __builtin_amdgcn_rcpf(d.y);
    f32x2 q = t * 0.5307027145f + (-0.7265760135f); q = q * t + 0.7107068705f; q = q * t + (-0.142248368f); q = q * t + 0.127414796f; q = q * t;
    const f32x2 s = (v * v) * (-0.72134752044f);
    f32x2 e; e.x = __builtin_amdgcn_exp2f(s.x); e.y = __builtin_amdgcn_exp2f(s.y);
    const f32x2 m = v * (q * e), r = v - m;
    f32x2 o; o.x = v.x < 0.f ? m.x : r.x; o.y = v.y < 0.f ? m.y : r.y; return o;
}

template <class Epi, class Sched, bool ALIGN_EPI = false, bool SP2 = false>
__device__ __forceinline__ void gemm_phase(PG8_LAS unsigned char* lds, const Gemm g, const Sched& S, const Epi& E) {
    const int tid = threadIdx.x, wid = __builtin_amdgcn_readfirstlane(tid >> 6), lane = tid & 63, wr = wid >> 2, wc = wid & 3, fr = lane & 15, fq = lane >> 4;
    const int K = g.K, nt = K / BK;
    unsigned voffA[2], voffB[2];
#pragma unroll
    for (int i = 0; i < 2; ++i) { int R, C; stage_rc(tid * 16 + i * 8192, R, C); const int Rb = Epi::PERM ? ((R & ~31) + perm32(R & 31)) : R;
        voffA[i] = (unsigned)(R * K + C) * 2u; voffB[i] = (unsigned)(Rb * K + C) * 2u; }
    const size_t kstep = (size_t)(BK * 2);
    const size_t hstep = (size_t)HALF * K * 2;
    const size_t tstep = 2 * hstep;
    const unsigned ldsw = (unsigned)wid * 1024u;
    const int aoff = lds_byte(wr * 64 + fr, fq * 8), boff = lds_byte(wc * 32 + fr, fq * 8);
#define PG8_SA(b, h) (((b) * 2 + (h)) * HTB)
#define PG8_SB(b, h) ((4 + (b) * 2 + (h)) * HTB)
#define PG8_STAGE(bufoff, gbase, voff) do { _Pragma("unroll") for (int _i = 0; _i < 2; ++_i) \
        __builtin_amdgcn_global_load_lds((const unsigned*)((const char*)(gbase) + (voff)[_i]), (PG8_LAS unsigned*)(lds + (bufoff) + ldsw + _i * 8192), 16, 0, 0); } while (0)
#define PG8_LDA(dst, b, h) do { _Pragma("unroll") for (int m = 0; m < 4; ++m) _Pragma("unroll") for (int k = 0; k < 2; ++k) dst[m][k] = *(const PG8_LAS bf16x8*)(lds + PG8_SA(b, h) + aoff + m * 2048 + k * 1024); } while (0)
#define PG8_LDB(dst, b, h) do { _Pragma("unroll") for (int n = 0; n < 2; ++n) _Pragma("unroll") for (int k = 0; k < 2; ++k) dst[n][k] = *(const PG8_LAS bf16x8*)(lds + PG8_SB(b, h) + boff + n * 2048 + k * 1024); } while (0)
#define PG8_MMA(ai, bj, At, Bt) do { __builtin_amdgcn_s_setprio(1); _Pragma("unroll") for (int m = 0; m < 4; ++m) _Pragma("unroll") for (int n = 0; n < 2; ++n) _Pragma("unroll") for (int k = 0; k < 2; ++k) \
        acc[ai][bj][m][n] = __builtin_amdgcn_mfma_f32_16x16x32_bf16(Bt[n][k], At[m][k], acc[ai][bj][m][n], 0, 0, 0); __builtin_amdgcn_s_setprio(0); } while (0)
#define PG8_WAIT_V(n) asm volatile("s_waitcnt vmcnt(" #n ")" ::: "memory")
#define PG8_WAIT_L(n) asm volatile("s_waitcnt lgkmcnt(" #n ")" ::: "memory")
#define PG8_BAR __builtin_amdgcn_s_barrier()
#define PG8_SCHED __builtin_amdgcn_sched_barrier(0)
    Unit cur, nxt; int ui = 0;
    if (!S.next(0, cur)) return;
    f32x4 acc[2][2][4][2];
#pragma unroll
    for (int a = 0; a < 2; ++a)
#pragma unroll
        for (int b = 0; b < 2; ++b)
#pragma unroll
            for (int m = 0; m < 4; ++m)
#pragma unroll
                for (int n = 0; n < 2; ++n) acc[a][b][m][n] = (f32x4){0.f, 0.f, 0.f, 0.f};
    bf16x8 At[4][2], B0[2][2], B1[2][2];
    const char* cA = (const char*)g.A + (size_t)cur.pm * tstep; const char* cB = (const char*)g.Bt + (size_t)cur.pn * tstep;
    S.a_ready(cur);
    if constexpr (SP2) {
        PG8_STAGE(PG8_SB(0, 0), cB, voffB); PG8_STAGE(PG8_SB(0, 1), cB + hstep, voffB); PG8_STAGE(PG8_SA(0, 0), cA, voffA); PG8_STAGE(PG8_SA(0, 1), cA + hstep, voffA);
        if (wr == 1) PG8_BAR;
        PG8_WAIT_V(2); PG8_BAR;
        PG8_STAGE(PG8_SB(1, 0), cB + kstep, voffB); PG8_STAGE(PG8_SA(1, 0), cA + kstep, voffA); PG8_STAGE(PG8_SB(1, 1), cB + hstep + kstep, voffB);
        PG8_WAIT_V(6); PG8_BAR;
    } else {
        PG8_STAGE(PG8_SB(0, 0), cB, voffB); PG8_STAGE(PG8_SA(0, 0), cA, voffA); PG8_STAGE(PG8_SB(0, 1), cB + hstep, voffB); PG8_STAGE(PG8_SA(0, 1), cA + hstep, voffA);
        if (wr == 1) PG8_BAR;
        PG8_WAIT_V(4); PG8_BAR;
        PG8_STAGE(PG8_SB(1, 0), cB + kstep, voffB); PG8_STAGE(PG8_SA(1, 0), cA + kstep, voffA); PG8_STAGE(PG8_SB(1, 1), cB + hstep + kstep, voffB);
        PG8_WAIT_V(6); PG8_BAR;
    }
    for (;;) {
        const bool has_next = S.next(ui + 1, nxt);
        const char* nA = has_next ? (const char*)g.A + (size_t)nxt.pm * tstep : cA; const char* nB = has_next ? (const char*)g.Bt + (size_t)nxt.pn * tstep : cB;
        for (int t = 0; t < nt; t += 2) {
            const bool last = (t == nt - 2);
            const char* a1 = cA + (size_t)(t + 1) * kstep;
            const char* a2 = last ? nA : cA + (size_t)(t + 2) * kstep; const char* b2 = last ? nB : cB + (size_t)(t + 2) * kstep;
            const char* a3 = a2 + kstep; const char* b3 = b2 + kstep;
            if (last && has_next) S.a_ready(nxt);
            if constexpr (SP2) {
            PG8_LDB(B0, 0, 0); PG8_LDB(B1, 0, 1); PG8_SCHED; PG8_LDA(At, 0, 0); PG8_STAGE(PG8_SA(1, 1), a1 + hstep, voffA);
            PG8_WAIT_V(8); PG8_WAIT_L(0); PG8_BAR; PG8_MMA(0, 0, At, B0); PG8_MMA(0, 1, At, B1); PG8_BAR; PG8_SCHED;
            PG8_LDA(At, 0, 1); PG8_STAGE(PG8_SB(0, 0), b2, voffB); PG8_STAGE(PG8_SB(0, 1), b2 + hstep, voffB); PG8_STAGE(PG8_SA(0, 0), a2, voffA);
            PG8_WAIT_V(8); PG8_WAIT_L(0); PG8_BAR; PG8_MMA(1, 0, At, B0); PG8_MMA(1, 1, At, B1); PG8_BAR; PG8_SCHED;
            PG8_LDB(B0, 1, 0); PG8_LDB(B1, 1, 1); PG8_SCHED; PG8_LDA(At, 1, 0); PG8_STAGE(PG8_SA(0, 1), a2 + hstep, voffA);
            PG8_WAIT_V(8); PG8_WAIT_L(0); PG8_BAR; PG8_MMA(0, 0, At, B0); PG8_MMA(0, 1, At, B1); PG8_BAR; PG8_SCHED;
            PG8_LDA(At, 1, 1); PG8_STAGE(PG8_SB(1, 0), b3, voffB); PG8_STAGE(PG8_SB(1, 1), b3 + hstep, voffB); PG8_STAGE(PG8_SA(1, 0), a3, voffA);
            PG8_WAIT_V(8); PG8_WAIT_L(0); PG8_BAR; PG8_MMA(1, 0, At, B0); PG8_MMA(1, 1, At, B1); PG8_BAR; PG8_SCHED;
            } else {
            PG8_LDB(B0, 0, 0); PG8_SCHED; PG8_LDA(At, 0, 0); PG8_STAGE(PG8_SA(1, 1), a1 + hstep, voffA);
            PG8_WAIT_L(8); PG8_BAR; PG8_WAIT_L(0); PG8_MMA(0, 0, At, B0); PG8_BAR; PG8_SCHED;
            PG8_LDB(B1, 0, 1); PG8_STAGE(PG8_SB(0, 0), b2, voffB);
            PG8_BAR; PG8_WAIT_L(0); PG8_MMA(0, 1, At, B1); PG8_BAR;
            PG8_LDA(At, 0, 1); PG8_STAGE(PG8_SA(0, 0), a2, voffA);
            PG8_BAR; PG8_WAIT_L(0); PG8_MMA(1, 0, At, B0); PG8_BAR; PG8_SCHED;
            PG8_STAGE(PG8_SB(0, 1), b2 + hstep, voffB);
            PG8_WAIT_V(6); PG8_BAR; PG8_MMA(1, 1, At, B1); PG8_BAR;
            PG8_LDB(B0, 1, 0); PG8_SCHED; PG8_LDA(At, 1, 0); PG8_STAGE(PG8_SA(0, 1), a2 + hstep, voffA);
            PG8_WAIT_L(8); PG8_BAR; PG8_WAIT_L(0); PG8_MMA(0, 0, At, B0); PG8_BAR; PG8_SCHED;
            PG8_LDB(B1, 1, 1); PG8_STAGE(PG8_SB(1, 0), b3, voffB);
            PG8_BAR; PG8_WAIT_L(0); PG8_MMA(0, 1, At, B1); PG8_BAR;
            PG8_LDA(At, 1, 1); PG8_STAGE(PG8_SA(1, 0), a3, voffA);
            PG8_BAR; PG8_WAIT_L(0); PG8_MMA(1, 0, At, B0); PG8_BAR; PG8_SCHED;
            PG8_STAGE(PG8_SB(1, 1), b3 + hstep, voffB);
            PG8_WAIT_V(6); PG8_BAR; PG8_MMA(1, 1, At, B1); PG8_BAR;
            }
        }
        if constexpr (ALIGN_EPI) { if (wr == 0) PG8_BAR; }
        if constexpr (!Epi::AFTER_DRAIN) { E(acc, cur, wr, wc, fr, fq); S.done(cur); }
        if (!has_next) break;
#pragma unroll
        for (int a = 0; a < 2; ++a)
#pragma unroll
            for (int b = 0; b < 2; ++b)
#pragma unroll
                for (int m = 0; m < 4; ++m)
#pragma unroll
                    for (int n = 0; n < 2; ++n) acc[a][b][m][n] = (f32x4){0.f, 0.f, 0.f, 0.f};
        cur = nxt; cA = nA; cB = nB; ++ui;
        if constexpr (ALIGN_EPI) { if (wr == 1) PG8_BAR; }
    }
    PG8_WAIT_V(0);
    if constexpr (!ALIGN_EPI) { if (wr == 0) PG8_BAR; }
    PG8_BAR;
    if constexpr (Epi::AFTER_DRAIN) { E.fused(acc, cur, wr, wc, fr, fq, lds, wid, lane); S.done(cur); }
#undef PG8_SA
#undef PG8_SB
#undef PG8_STAGE
#undef PG8_LDA
#undef PG8_LDB
#undef PG8_MMA
#undef PG8_WAIT_V
#undef PG8_WAIT_L
#undef PG8_BAR
#undef PG8_SCHED
}
}
namespace pg8 {
__device__ __forceinline__ float sigmoidf_(float x) { return __builtin_amdgcn_rcpf(1.0f + __builtin_amdgcn_exp2f(-1.4426950408889634f * x)); }
struct EpiBf16Split {
    static constexpr bool PERM = true, AFTER_DRAIN = false;
    bf16_t* O0; int ld0; int nt0; bf16_t* O1; int ld1;
    __device__ __forceinline__ void operator()(const f32x4 (&acc)[2][2][4][2], const Unit& u, int wr, int wc, int fr, int fq) const {
        const bool first = u.pn < nt0; bf16_t* base = first ? O0 : O1; const int ld = first ? ld0 : ld1; const int colt = (first ? u.pn : u.pn - nt0) * BM;
        const int row0 = u.pm * BM + wr * 64 + fr, col0 = colt + wc * 32 + 8 * fq;
#pragma unroll
        for (int ai = 0; ai < 2; ++ai)
#pragma unroll
            for (int m = 0; m < 4; ++m) { bf16_t* rowp = base + (size_t)(row0 + ai * HALF + m * 16) * ld + col0;
#pragma unroll
                for (int bj = 0; bj < 2; ++bj) { const f32x4 v0 = acc[ai][bj][m][0], v1 = acc[ai][bj][m][1];
                    u32x4 w; w.x = cvt_pk_bf16(v0[0], v0[1]); w.y = cvt_pk_bf16(v0[2], v0[3]); w.z = cvt_pk_bf16(v1[0], v1[1]); w.w = cvt_pk_bf16(v1[2], v1[3]);
                    *(u32x4*)(rowp + bj * HALF) = w; } }
    }
};
struct EpiResF32 {
    static constexpr bool PERM = false, AFTER_DRAIN = false;
    const float* base; float* out; int ldc;
    __device__ __forceinline__ void operator()(const f32x4 (&acc)[2][2][4][2], const Unit& u, int wr, int wc, int fr, int fq) const {
        const int row0 = u.pm * BM + wr * 64 + fr, col0 = u.pn * BM + wc * 32 + 4 * fq;
#pragma unroll
        for (int ai = 0; ai < 2; ++ai)
#pragma unroll
            for (int m = 0; m < 4; ++m) { const size_t off = (size_t)(row0 + ai * HALF + m * 16) * ldc + col0;
#pragma unroll
                for (int bj = 0; bj < 2; ++bj)
#pragma unroll
                    for (int n = 0; n < 2; ++n) { const f32x4 b = *(const f32x4*)(base + off + bj * HALF + n * 16); *(f32x4*)(out + off + bj * HALF + n * 16) = b + acc[ai][bj][m][n]; } }
    }
};
struct EpiSwiglu {
    static constexpr bool PERM = false, AFTER_DRAIN = false;
    bf16_t* H; int ldh;
    __device__ __forceinline__ void operator()(const f32x4 (&acc)[2][2][4][2], const Unit& u, int wr, int wc, int fr, int fq) const {
        const int row0 = u.pm * BM + wr * 64 + fr, hc0 = u.pn * (BM / 2) + wc * 16 + 4 * fq;
#pragma unroll
        for (int ai = 0; ai < 2; ++ai)
#pragma unroll
            for (int m = 0; m < 4; ++m) { bf16_t* rowp = H + (size_t)(row0 + ai * HALF + m * 16) * ldh + hc0;
#pragma unroll
                for (int bj = 0; bj < 2; ++bj) { const f32x4 g = acc[ai][bj][m][0], up = acc[ai][bj][m][1]; float h[4];
#pragma unroll
                    for (int i = 0; i < 4; ++i) h[i] = g[i] * sigmoidf_(g[i]) * up[i];
                    typedef unsigned u32x2 __attribute__((ext_vector_type(2)));
                    u32x2 w; w.x = cvt_pk_bf16(h[0], h[1]); w.y = cvt_pk_bf16(h[2], h[3]);
                    *(u32x2*)(rowp + bj * (HALF / 2)) = w; } }
    }
};
struct EpiPle {
    static constexpr bool PERM = false, AFTER_DRAIN = false;
    const float* base; float* out; const bf16_t* E; int ldc;
    __device__ __forceinline__ void operator()(const f32x4 (&acc)[2][2][4][2], const Unit& u, int wr, int wc, int fr, int fq) const {
        const int row0 = u.pm * BM + wr * 64 + fr, col0 = u.pn * BM + wc * 32 + 4 * fq;
        typedef unsigned u32x2 __attribute__((ext_vector_type(2)));
#pragma unroll
        for (int ai = 0; ai < 2; ++ai)
#pragma unroll
            for (int m = 0; m < 4; ++m) { const size_t off = (size_t)(row0 + ai * HALF + m * 16) * ldc + col0;
#pragma unroll
                for (int bj = 0; bj < 2; ++bj)
#pragma unroll
                    for (int n = 0; n < 2; ++n) { const size_t o = off + bj * HALF + n * 16; const f32x4 b = *(const f32x4*)(base + o); const u32x2 e = *(const u32x2*)(E + o); const f32x4 a = acc[ai][bj][m][n];
                        f32x4 r; r[0] = b[0] + __uint_as_float(e.x << 16) * sigmoidf_(a[0]); r[1] = b[1] + __uint_as_float(e.x & 0xffff0000u) * sigmoidf_(a[1]);
                        r[2] = b[2] + __uint_as_float(e.y << 16) * sigmoidf_(a[2]); r[3] = b[3] + __uint_as_float(e.y & 0xffff0000u) * sigmoidf_(a[3]);
                        *(f32x4*)(out + o) = r; } }
    }
};
__device__ __forceinline__ float rms_r(const float* rsq, int row) { const f32x4* p = (const f32x4*)(rsq + (size_t)row * 16); const f32x4 a = p[0], b = p[1], c = p[2], d = p[3];
    const float s = (((a[0] + a[1]) + (a[2] + a[3])) + ((b[0] + b[1]) + (b[2] + b[3]))) + (((c[0] + c[1]) + (c[2] + c[3])) + ((d[0] + d[1]) + (d[2] + d[3]))); return rsqrtf(s * (1.0f / 1024.0f) + 1e-6f); }
__device__ __forceinline__ void norm_out(const f32x4 (&x)[2][2], bf16_t* xb, size_t off, float* rsq_out, int row, int fq, int slot) {
    typedef unsigned u32x2 __attribute__((ext_vector_type(2))); float s = 0.f;
#pragma unroll
    for (int bj = 0; bj < 2; ++bj)
#pragma unroll
        for (int n = 0; n < 2; ++n) { const f32x4 v = x[bj][n]; s += (v[0] * v[0] + v[1] * v[1]) + (v[2] * v[2] + v[3] * v[3]); u32x2 w; w.x = cvt_pk_bf16(v[0], v[1]); w.y = cvt_pk_bf16(v[2], v[3]); *(u32x2*)(xb + off + bj * HALF + n * 16) = w; }
    s += __shfl_xor(s, 16); s += __shfl_xor(s, 32);
    if (fq == 0) rsq_out[(size_t)row * 16 + slot] = s;
}
struct EpiBf16SplitR {
    static constexpr bool PERM = true, AFTER_DRAIN = false;
    bf16_t* O0; int ld0; int nt0; bf16_t* O1; int ld1; const float* rsq;
    __device__ __forceinline__ void operator()(const f32x4 (&acc)[2][2][4][2], const Unit& u, int wr, int wc, int fr, int fq) const {
        const bool first = u.pn < nt0; bf16_t* base = first ? O0 : O1; const int ld = first ? ld0 : ld1; const int colt = (first ? u.pn : u.pn - nt0) * BM;
        const int row0 = u.pm * BM + wr * 64 + fr, col0 = colt + wc * 32 + 8 * fq;
#pragma unroll
        for (int ai = 0; ai < 2; ++ai)
#pragma unroll
            for (int m = 0; m < 4; ++m) { const int row = row0 + ai * HALF + m * 16; const float r = rms_r(rsq, row); bf16_t* rowp = base + (size_t)row * ld + col0;
#pragma unroll
                for (int bj = 0; bj < 2; ++bj) { const f32x4 v0 = acc[ai][bj][m][0] * r, v1 = acc[ai][bj][m][1] * r;
                    u32x4 w; w.x = cvt_pk_bf16(v0[0], v0[1]); w.y = cvt_pk_bf16(v0[2], v0[3]); w.z = cvt_pk_bf16(v1[0], v1[1]); w.w = cvt_pk_bf16(v1[2], v1[3]);
                    *(u32x4*)(rowp + bj * HALF) = w; } }
    }
};
struct EpiSwigluR {
    static constexpr bool PERM = false, AFTER_DRAIN = false;
    bf16_t* H; int ldh; const float* rsq;
    __device__ __forceinline__ void operator()(const f32x4 (&acc)[2][2][4][2], const Unit& u, int wr, int wc, int fr, int fq) const {
        const int row0 = u.pm * BM + wr * 64 + fr, hc0 = u.pn * (BM / 2) + wc * 16 + 4 * fq;
#pragma unroll
        for (int ai = 0; ai < 2; ++ai)
#pragma unroll
            for (int m = 0; m < 4; ++m) { const int row = row0 + ai * HALF + m * 16; const float r = rms_r(rsq, row); bf16_t* rowp = H + (size_t)row * ldh + hc0;
#pragma unroll
                for (int bj = 0; bj < 2; ++bj) { const f32x4 g = acc[ai][bj][m][0] * r, up = acc[ai][bj][m][1] * r; float h[4];
#pragma unroll
                    for (int i = 0; i < 4; ++i) h[i] = g[i] * sigmoidf_(g[i]) * up[i];
                    typedef unsigned u32x2 __attribute__((ext_vector_type(2)));
                    u32x2 w; w.x = cvt_pk_bf16(h[0], h[1]); w.y = cvt_pk_bf16(h[2], h[3]);
                    *(u32x2*)(rowp + bj * (HALF / 2)) = w; } }
    }
};
struct EpiResN {
    static constexpr bool PERM = false, AFTER_DRAIN = false;
    const float* base; float* out; int ldc; bf16_t* XBo; float* rsq_out;
    __device__ __forceinline__ void operator()(const f32x4 (&acc)[2][2][4][2], const Unit& u, int wr, int wc, int fr, int fq) const {
        const int row0 = u.pm * BM + wr * 64 + fr, col0 = u.pn * BM + wc * 32 + 4 * fq;
#pragma unroll
        for (int ai = 0; ai < 2; ++ai)
#pragma unroll
            for (int m = 0; m < 4; ++m) { const int row = row0 + ai * HALF + m * 16; const size_t off = (size_t)row * ldc + col0; f32x4 x[2][2];
#pragma unroll
                for (int bj = 0; bj < 2; ++bj)
#pragma unroll
                    for (int n = 0; n < 2; ++n) { const f32x4 b = *(const f32x4*)(base + off + bj * HALF + n * 16); x[bj][n] = b + acc[ai][bj][m][n]; *(f32x4*)(out + off + bj * HALF + n * 16) = x[bj][n]; }
                if (XBo) norm_out(x, XBo, off, rsq_out, row, fq, u.pn * 4 + wc); }
    }
};
struct EpiPleN {
    static constexpr bool PERM = false, AFTER_DRAIN = false;
    const float* base; float* out; const bf16_t* E; int ldc; const float* rsq_in; bf16_t* XBo; float* rsq_out;
    __device__ __forceinline__ void operator()(const f32x4 (&acc)[2][2][4][2], const Unit& u, int wr, int wc, int fr, int fq) const {
        const int row0 = u.pm * BM + wr * 64 + fr, col0 = u.pn * BM + wc * 32 + 4 * fq;
        typedef unsigned u32x2 __attribute__((ext_vector_type(2)));
#pragma unroll
        for (int ai = 0; ai < 2; ++ai)
#pragma unroll
            for (int m = 0; m < 4; ++m) { const int row = row0 + ai * HALF + m * 16; const size_t off = (size_t)row * ldc + col0; const float r = rms_r(rsq_in, row); f32x4 x[2][2];
#pragma unroll
                for (int bj = 0; bj < 2; ++bj)
#pragma unroll
                    for (int n = 0; n < 2; ++n) { const size_t o = off + bj * HALF + n * 16; const f32x4 b = *(const f32x4*)(base + o); const u32x2 e = *(const u32x2*)(E + o); const f32x4 a = acc[ai][bj][m][n] * r;
                        f32x4 v; v[0] = b[0] + __uint_as_float(e.x << 16) * sigmoidf_(a[0]); v[1] = b[1] + __uint_as_float(e.x & 0xffff0000u) * sigmoidf_(a[1]);
                        v[2] = b[2] + __uint_as_float(e.y << 16) * sigmoidf_(a[2]); v[3] = b[3] + __uint_as_float(e.y & 0xffff0000u) * sigmoidf_(a[3]);
                        x[bj][n] = v; *(f32x4*)(out + o) = v; }
                if (XBo) norm_out(x, XBo, off, rsq_out, row, fq, u.pn * 4 + wc); }
    }
};
__device__ __forceinline__ f32x4 ld_base4(const float* p) { return *(const f32x4*)p; }
__device__ __forceinline__ f32x4 ld_base4(const bf16_t* p) { typedef unsigned u32x2 __attribute__((ext_vector_type(2))); const u32x2 e = *(const u32x2*)p; return (f32x4){__uint_as_float(e.x << 16), __uint_as_float(e.x & 0xffff0000u), __uint_as_float(e.y << 16), __uint_as_float(e.y & 0xffff0000u)}; }
template <class BaseT> struct EpiRes2 {
    static constexpr bool PERM = false, AFTER_DRAIN = false;
    const BaseT* base; bf16_t* out; int ldc; float* rsq_out;
    __device__ __forceinline__ void operator()(const f32x4 (&acc)[2][2][4][2], const Unit& u, int wr, int wc, int fr, int fq) const {
        const int row0 = u.pm * BM + wr * 64 + fr, col0 = u.pn * BM + wc * 32 + 4 * fq;
#pragma unroll
        for (int ai = 0; ai < 2; ++ai)
#pragma unroll
            for (int m = 0; m < 4; ++m) { const int row = row0 + ai * HALF + m * 16; const size_t off = (size_t)row * ldc + col0; f32x4 x[2][2];
#pragma unroll
                for (int bj = 0; bj < 2; ++bj)
#pragma unroll
                    for (int n = 0; n < 2; ++n) x[bj][n] = ld_base4(base + off + bj * HALF + n * 16) + acc[ai][bj][m][n];
                norm_out(x, out, off, rsq_out, row, fq, u.pn * 4 + wc); }
    }
};
template <bool OUT_F32> struct EpiPle2 {
    static constexpr bool PERM = false, AFTER_DRAIN = false;
    const bf16_t* base; void* out; const bf16_t* E; int ldc; const float* rsq_in; float* rsq_out;
    __device__ __forceinline__ void operator()(const f32x4 (&acc)[2][2][4][2], const Unit& u, int wr, int wc, int fr, int fq) const {
        const int row0 = u.pm * BM + wr * 64 + fr, col0 = u.pn * BM + wc * 32 + 4 * fq;
#pragma unroll
        for (int ai = 0; ai < 2; ++ai)
#pragma unroll
            for (int m = 0; m < 4; ++m) { const int row = row0 + ai * HALF + m * 16; const size_t off = (size_t)row * ldc + col0; const float r = rms_r(rsq_in, row); f32x4 x[2][2];
#pragma unroll
                for (int bj = 0; bj < 2; ++bj)
#pragma unroll
                    for (int n = 0; n < 2; ++n) { const size_t o = off + bj * HALF + n * 16; const f32x4 b = ld_base4(base + o), e = ld_base4(E + o), a = acc[ai][bj][m][n] * r; f32x4 v;
#pragma unroll
                        for (int i = 0; i < 4; ++i) v[i] = b[i] + e[i] * sigmoidf_(a[i]);
                        x[bj][n] = v; if (OUT_F32) *(f32x4*)((float*)out + o) = v; }
                if (!OUT_F32) norm_out(x, (bf16_t*)out, off, rsq_out, row, fq, u.pn * 4 + wc); }
    }
};
}
#ifndef PG8_SP2
#define PG8_SP2 true
#endif
#ifndef PG8_ALIGN
#define PG8_ALIGN true
#endif
constexpr int NB = 32, SEQ = 2048, T = NB * SEQ, D = 1024;
constexpr int NU = 2816, UA_W = 1024, UB_W = 1792;
constexpr int FF = 2816, CI = 2048, TH = T / 2;
constexpr int NWAVES = 8;
constexpr float NORM_EPS = 1e-6f, LOG2E = 1.4426950408889634f;
constexpr int UA_K = 512, UA_V = 576, UA_IQ = 640, UA_IK = 896, UA_IW = 960;
constexpr size_t MiB = 1u << 20, QMiB = 1u << 18;
constexpr size_t WS_CTL = 0, CTL_ZERO_BYTES = 1 * MiB;
constexpr size_t WS_WIN = 4 * QMiB, WS_WLORA = 26 * QMiB, WS_WOUT = 29 * QMiB;
constexpr size_t WS_WGU0 = 37 * QMiB, WS_WD0 = 81 * QMiB, WS_WPLE0 = 103 * QMiB, WS_WPG0 = 105 * QMiB, WS_LAYER_STRIDE = 76 * QMiB;
constexpr size_t WS_WUP = 189 * QMiB, WS_WDOWN = 221 * QMiB, WS_W12 = 237 * QMiB;
static_assert(WS_WPG0 + 8 * QMiB == WS_WGU0 + WS_LAYER_STRIDE && WS_WPG0 + WS_LAYER_STRIDE + 8 * QMiB == WS_WUP && WS_W12 + QMiB <= 60 * MiB, "weight map");
constexpr size_t ACT = 60 * MiB;
constexpr size_t WS_XB = ACT, WS_UA = ACT + 128 * MiB, WS_UB = ACT + 256 * MiB, WS_LIN = ACT + 480 * MiB, WS_LOUT = ACT + 512 * MiB;
constexpr size_t WS_QN = ACT + 704 * MiB, WS_KN = ACT + 768 * MiB, WS_VT = ACT + 776 * MiB, WS_MASK = ACT + 784 * MiB;
constexpr size_t WS_XB2 = ACT + 768 * MiB;
constexpr size_t WS_H = ACT + 128 * MiB, WS_E = ACT + 480 * MiB, WS_PB = ACT + 896 * MiB;
constexpr size_t WS_XM = ACT, WS_Z = ACT + 128 * MiB, WS_XC = ACT + 256 * MiB, WS_Q = ACT + 384 * MiB, WS_K = ACT + 512 * MiB, WS_V = ACT + 640 * MiB;
constexpr size_t WS_RS = ACT + 928 * MiB, RS_ONE = (size_t)T * 16 * 4;
constexpr size_t WS_GI = ACT + 952 * MiB, WS_GA = WS_GI + 1 * MiB, WS_GAM = WS_GI + 2 * MiB, WS_GEM = WS_GI + 3 * MiB;
constexpr size_t WS_END = ACT + 956 * MiB;
static_assert(WS_END <= 1024 * MiB, "workspace");
constexpr int CW_TMO = 0, CW_BAR = 4096, CW_XRANK = 8192;
constexpr int LDS_BYTES = 155648;
constexpr int MISC_OFF = LDS_BYTES - 256;
#define GAS __attribute__((address_space(1)))
#define LAS __attribute__((address_space(3)))
typedef unsigned short bf16;
typedef unsigned v4u __attribute__((ext_vector_type(4)));
typedef unsigned v2u __attribute__((ext_vector_type(2)));
typedef float f32x4 __attribute__((ext_vector_type(4)));
typedef float f32x2 __attribute__((ext_vector_type(2)));
typedef float f32x8 __attribute__((ext_vector_type(8)));
typedef short bf16x8 __attribute__((ext_vector_type(8)));
typedef short s16x4 __attribute__((ext_vector_type(4)));
typedef GAS unsigned gu32;
#define RLX_AGENT __ATOMIC_RELAXED, __HIP_MEMORY_SCOPE_AGENT
#define LDS_WAIT() asm volatile("s_waitcnt lgkmcnt(0)" ::: "memory")
#define VM_WAIT() asm volatile("s_waitcnt vmcnt(0)" ::: "memory")
__device__ __forceinline__ unsigned f2bf(float f) { unsigned u = __builtin_bit_cast(unsigned, f); return (u + 0x7fffu + ((u >> 16) & 1u)) >> 16; }

#define XB_TMO      128
#define XB_XCNT(j)  (256  + 64 * (j))
#define XB_XSUB(j)  (1280 + 64 * (j))
#define XB_XGEN(j)  (2304 + 64 * (j))
#define XB_TOP      3328
#define XB_TOPGEN   3392
#define XCD_BAR_WORDS 3456
#define XB_SPIN_CAP (1u << 18)

__device__ __forceinline__ unsigned xb_ld(unsigned* p)              { return __hip_atomic_load(p, __ATOMIC_RELAXED, __HIP_MEMORY_SCOPE_AGENT); }
__device__ __forceinline__ unsigned xb_add(unsigned* p, unsigned v) { return __hip_atomic_fetch_add(p, v, __ATOMIC_RELAXED, __HIP_MEMORY_SCOPE_AGENT); }
__device__ __forceinline__ unsigned xb_xcc_id() { return (unsigned)__builtin_amdgcn_s_getreg((3 << 11) | 20) & 0xFu; }
#define XB_SPIN(cond, bar) do { unsigned _sp = 0; while (cond) { __builtin_amdgcn_s_sleep(1); \
    if ((++_sp & 255u) == 0u) { if (xb_ld(&(bar)[XB_TMO])) break; if (_sp > XB_SPIN_CAP) { atomicAdd(&(bar)[XB_TMO], 1u); break; } } } } while (0)

struct XcdBarrier {
    unsigned* bar; unsigned x;
    volatile LAS unsigned* st;
};

__device__ __forceinline__ XcdBarrier xcd_barrier_post(unsigned* bar, volatile LAS unsigned* st) {
    XcdBarrier b; b.bar = bar; b.x = xb_xcc_id(); b.st = st;
    if (threadIdx.x == 0) (void)xb_add(&bar[XB_XCNT(b.x)], 1u);
    return b;
}
__device__ __forceinline__ void xcd_barrier_complete(unsigned* bar, unsigned x, unsigned& nloc, unsigned& nx) {
    const unsigned G = gridDim.x * gridDim.y * gridDim.z;
    unsigned sum, cnt, mine, sp = 0u;
    for (;;) {
        sum = 0u; cnt = 0u; mine = 0u;
#pragma unroll
        for (unsigned j = 0; j < 16; ++j) { const unsigned c = xb_ld(&bar[XB_XCNT(j)]); sum += c; cnt += (c > 0u) ? 1u : 0u; mine = (j == x) ? c : mine; }
        if (sum == G) break;
        __builtin_amdgcn_s_sleep(1);
        if ((++sp & 255u) == 0u) { if (xb_ld(&bar[XB_TMO])) break; if (sp > XB_SPIN_CAP) { atomicAdd(&bar[XB_TMO], 1u); break; } }
    }
    nloc = mine > 0u ? mine : 1u; nx = cnt > 0u ? cnt : 1u;
}

__device__ __forceinline__ void xcd_barrier(const XcdBarrier& b) {
    asm volatile("s_waitcnt vmcnt(0)" ::: "memory");
    __syncthreads();
    if (threadIdx.x == 0) {
        unsigned* bar = b.bar;
        __builtin_amdgcn_s_waitcnt(0);
        unsigned nloc = b.st[0], nx = b.st[1];
        if (nloc == 0u) { xcd_barrier_complete(bar, b.x, nloc, nx); b.st[0] = nloc; b.st[1] = nx; }
        const unsigned old = xb_add(&bar[XB_XSUB(b.x)], 1u);
        const unsigned gen = old / nloc;
        if (old + 1u == (gen + 1u) * nloc) {
            __builtin_amdgcn_fence(__ATOMIC_RELEASE, "agent");
            asm volatile("s_waitcnt vmcnt(0)" ::: "memory");
            const unsigned og = xb_add(&bar[XB_TOP], 1u);
            const unsigned tg = og / nx;
            if (og + 1u == (tg + 1u) * nx) xb_add(&bar[XB_TOPGEN], 1u);
            else XB_SPIN(xb_ld(&bar[XB_TOPGEN]) == tg, bar);
            __builtin_amdgcn_fence(__ATOMIC_ACQUIRE, "agent");
            xb_add(&bar[XB_XGEN(b.x)], 1u);
            asm volatile("s_waitcnt vmcnt(0)" ::: "memory");
        } else {
            XB_SPIN(xb_ld(&bar[XB_XGEN(b.x)]) == gen, bar);
            __builtin_amdgcn_fence(__ATOMIC_ACQUIRE, "agent");
            asm volatile("s_waitcnt vmcnt(0)" ::: "memory");
        }
    }
    __syncthreads();
}

struct Frame {
    LAS unsigned char* lds;
    unsigned char* ws;
    const float* const* in;
    int tid, lane, wave, G, bid;
};
struct Args { const float* in[37]; float* out; unsigned char* ws; int ph_lo, ph_hi, use_bar, pad; };

__device__ __forceinline__ float dpp_f(float v, int ctrl_qp1) { return v; }
#define DPP_MOVF(v, ctrl) __builtin_bit_cast(float, __builtin_amdgcn_mov_dpp(__builtin_bit_cast(int, (v)), (ctrl), 0xf, 0xf, true))
__device__ __forceinline__ float wave_sum(float v) {
    v += DPP_MOVF(v, 0xB1);
    v += DPP_MOVF(v, 0x4E);
    v += DPP_MOVF(v, 0x141);
    v += DPP_MOVF(v, 0x140);
    v += __shfl_xor(v, 16); v += __shfl_xor(v, 32);
    return v;
}
__device__ __forceinline__ float wave_max(float v) {
#pragma unroll
    for (int o = 1; o < 64; o <<= 1) v = fmaxf(v, __shfl_xor(v, o));
    return v;
}
__device__ __forceinline__ float bflo(unsigned u) { return __uint_as_float(u << 16); }
__device__ __forceinline__ float bfhi(unsigned u) { return __uint_as_float(u & 0xffff0000u); }
__device__ __forceinline__ float bf1(bf16 h) { return __uint_as_float(((unsigned)h) << 16); }
__device__ __forceinline__ unsigned pk2(float lo, float hi) { return pg8::cvt_pk_bf16(lo, hi); }
__device__ __forceinline__ float sigm(float x) { return __builtin_amdgcn_rcpf(1.0f + __builtin_amdgcn_exp2f(-LOG2E * x)); }
__device__ __forceinline__ float softplusf_(float x) { return fmaxf(x, 0.f) + log1pf(__expf(-fabsf(x))); }
__device__ __forceinline__ void unpack8(const v4u& r, float (&f)[8]) { f[0] = bflo(r.x); f[1] = bfhi(r.x); f[2] = bflo(r.y); f[3] = bfhi(r.y); f[4] = bflo(r.z); f[5] = bfhi(r.z); f[6] = bflo(r.w); f[7] = bfhi(r.w); }
__device__ __forceinline__ v4u pack8(const float (&f)[8]) { v4u o; o.x = pk2(f[0], f[1]); o.y = pk2(f[2], f[3]); o.z = pk2(f[4], f[5]); o.w = pk2(f[6], f[7]); return o; }

template <class Fn> __device__ __forceinline__ void wprep(bf16* dst, int N, int K, Fn f, int gt, int NT) {
    const int items = N * (K >> 3);
    for (int it = gt; it < items; it += NT) { const int n = it % N, k0 = (it / N) << 3; float v[8];
#pragma unroll
        for (int j = 0; j < 8; ++j) v[j] = f(k0 + j, n);
        *(v4u*)(dst + (size_t)n * K + k0) = pack8(v); }
}
__device__ __forceinline__ void phase_prologue(Frame& F, const Args& a) {
    const int gt = F.bid * 512 + F.tid, NT = F.G * 512; unsigned char* ws = F.ws;
    { const float* W = a.in[5]; const float* gn0 = a.in[2];
      wprep((bf16*)(ws + WS_WIN), NU, D, [=](int k, int n) { const int c = n < 964 ? n : (n < 1024 ? -1 : n - 60); return c < 0 ? 0.f : W[(size_t)k * 2756 + c] * gn0[k]; }, gt, NT); }
    { const float* w2 = a.in[8]; const float* a2 = a.in[10]; const float* g2 = a.in[11];
      wprep((bf16*)(ws + WS_WLORA), 1536, 256, [=](int k, int n) { if (n < 512) return k < 64 ? w2[k * 512 + n] : 0.f; if (n < 1024) return (k >= 64 && k < 128) ? a2[(k - 64) * 512 + n - 512] : 0.f; return k >= 128 ? g2[(k - 128) * 512 + n - 1024] : 0.f; }, gt, NT); }
    { const float* W = a.in[17]; wprep((bf16*)(ws + WS_WOUT), D, D, [=](int k, int n) { return W[(size_t)k * D + n]; }, gt, NT); }
    for (int L = 0; L < 2; ++L) {
        const float* wg = a.in[31] + (size_t)L * D * FF; const float* wu = a.in[32] + (size_t)L * D * FF; const float* wd = a.in[33] + (size_t)L * FF * D;
        const float* wp = a.in[34] + (size_t)L * 256 * D; const float* wpg = a.in[36] + (size_t)L * D * D; const float* gnf = a.in[30] + L * D; const float* gnp = a.in[35] + L * D;
        wprep((bf16*)(ws + WS_WGU0 + L * WS_LAYER_STRIDE), 2 * FF, D, [=](int k, int n) { const int hid = 16 * (n >> 5) + (n & 15); return ((n & 31) >= 16 ? wu : wg)[(size_t)k * FF + hid] * gnf[k]; }, gt, NT);
        wprep((bf16*)(ws + WS_WD0 + L * WS_LAYER_STRIDE), D, FF, [=](int k, int n) { return wd[(size_t)k * D + n]; }, gt, NT);
        wprep((bf16*)(ws + WS_WPLE0 + L * WS_LAYER_STRIDE), D, 256, [=](int k, int n) { return wp[(size_t)k * D + n]; }, gt, NT);
        wprep((bf16*)(ws + WS_WPG0 + L * WS_LAYER_STRIDE), D, D, [=](int k, int n) { return wpg[(size_t)k * D + n] * gnp[k]; }, gt, NT);
    }
    { const float* W = a.in[18]; const float* gn1 = a.in[2] + D; wprep((bf16*)(ws + WS_WUP), 2 * CI, D, [=](int k, int n) { return W[(size_t)k * (2 * CI) + n] * gn1[k]; }, gt, NT); }
    { const float* W = a.in[29]; wprep((bf16*)(ws + WS_WDOWN), D, CI, [=](int k, int n) { return W[(size_t)k * D + n]; }, gt, NT); }
    { const float* wq = a.in[21]; const float* wk = a.in[22]; const float* wv = a.in[23]; const float* wif = a.in[24]; float* W12 = (float*)(ws + WS_W12);
      for (int it = gt; it < 4096 * 8; it += NT) { const int o = it & 7, c = (it >> 3) & 2047, part = it >> 14, g = c >> 2, i = c & 3; float s = 0.f;
          if (part == 0) { for (int j = 0; j < 4; ++j) s += wq[(g * 4 + i) * 4 + j] * wif[(size_t)(4 * g + j) * 8 + o] + wk[(g * 4 + i) * 4 + j] * wif[(size_t)(2048 + 4 * g + j) * 8 + o]; }
          else { for (int j = 0; j < 4; ++j) s += wv[(g * 4 + i) * 4 + j] * wif[(size_t)(4096 + 4 * g + j) * 8 + o]; }
          W12[it] = s; } }
}
__device__ __forceinline__ void phase_norm(Frame& F, const float* src, const float* gain, bf16* dst, int nrows) {
    const int gw = F.bid * NWAVES + F.wave, NGW = F.G * NWAVES, lane = F.lane;
    f32x4 g[4];
#pragma unroll
    for (int j = 0; j < 4; ++j) g[j] = *((const f32x4*)gain + lane + 64 * j);
    for (int m = gw; m < nrows; m += NGW) {
        const f32x4* xr = (const f32x4*)(src + (size_t)m * D) + lane; f32x4 v[4]; float s = 0.f;
#pragma unroll
        for (int j = 0; j < 4; ++j) { v[j] = xr[64 * j]; s += (v[j].x * v[j].x + v[j].y * v[j].y) + (v[j].z * v[j].z + v[j].w * v[j].w); }
        const float r = rsqrtf(wave_sum(s) * (1.f / D) + NORM_EPS);
        v2u* o = (v2u*)(dst + (size_t)m * D) + lane;
#pragma unroll
        for (int j = 0; j < 4; ++j) { v2u w; w.x = pk2(v[j].x * r * g[j].x, v[j].y * r * g[j].y); w.y = pk2(v[j].z * r * g[j].z, v[j].w * r * g[j].w); o[64 * j] = w; }
    }
}
__device__ __forceinline__ void phase_cast_sq(Frame& F, const float* src, bf16* dst, float* rsq, int nrows) {
    const int gw = F.bid * NWAVES + F.wave, NGW = F.G * NWAVES, lane = F.lane;
    for (int m = gw; m < nrows; m += NGW) {
        const f32x4* xr = (const f32x4*)(src + (size_t)m * D) + lane; f32x4 v[4]; float s = 0.f;
#pragma unroll
        for (int j = 0; j < 4; ++j) { v[j] = xr[64 * j]; s += (v[j].x * v[j].x + v[j].y * v[j].y) + (v[j].z * v[j].z + v[j].w * v[j].w); }
        s = wave_sum(s); if (lane < 16) rsq[(size_t)m * 16 + lane] = lane == 0 ? s : 0.f;
        v2u* o = (v2u*)(dst + (size_t)m * D) + lane;
#pragma unroll
        for (int j = 0; j < 4; ++j) { v2u w; w.x = pk2(v[j].x, v[j].y); w.y = pk2(v[j].z, v[j].w); o[64 * j] = w; }
    }
}
__device__ __forceinline__ void phase_cvt_p(Frame& F, const float* p, bf16* pb) {
    const size_t gt = (size_t)F.bid * 512 + F.tid, NT = (size_t)F.G * 512, n8 = (size_t)T * 256 / 8;
    for (size_t i0 = gt; i0 < n8; i0 += 4 * NT) { f32x4 a[4], b[4];
#pragma unroll
        for (int q4 = 0; q4 < 4; ++q4) { const size_t i = i0 + q4 * NT; if (i < n8) { a[q4] = *((const f32x4*)p + 2 * i); b[q4] = *((const f32x4*)p + 2 * i + 1); } }
#pragma unroll
        for (int q4 = 0; q4 < 4; ++q4) { const size_t i = i0 + q4 * NT; if (i < n8) { v4u o; o.x = pk2(a[q4].x, a[q4].y); o.y = pk2(a[q4].z, a[q4].w); o.z = pk2(b[q4].x, b[q4].y); o.w = pk2(b[q4].z, b[q4].w); *((v4u*)pb + i) = o; } } }
}
constexpr float QSCALE = 0.125f * LOG2E;
__device__ __forceinline__ void phase_prepA(Frame& F, const Args& a) {
    unsigned char* ws = F.ws; const bf16* UA = (const bf16*)(ws + WS_UA); const bf16* UB = (const bf16*)(ws + WS_UB);
    bf16* LIN = (bf16*)(ws + WS_LIN); bf16* QN = (bf16*)(ws + WS_QN); bf16* KN = (bf16*)(ws + WS_KN); bf16* VT = (bf16*)(ws + WS_VT);
    const float* mu = a.in[6]; const float* gq = a.in[3]; const float* gk = a.in[4];
    { const int gt = F.bid * 512 + F.tid, NT = F.G * 512; const int c8 = (gt & 31) << 3; float muv[8];
#pragma unroll
      for (int j = 0; j < 8; ++j) muv[j] = mu[1536 + c8 + j];
      for (int it0 = gt; it0 < T * 32; it0 += 4 * NT) { v4u ru[4], rp[4];
#pragma unroll
          for (int q4 = 0; q4 < 4; ++q4) { const int it = it0 + q4 * NT; if (it < T * 32) { const int t = it >> 5; ru[q4] = *(const v4u*)(UB + (size_t)t * UB_W + 1536 + c8); rp[q4] = *(const v4u*)(UB + (size_t)((t & (SEQ - 1)) ? t - 1 : t) * UB_W + 1536 + c8); } }
#pragma unroll
          for (int q4 = 0; q4 < 4; ++q4) { const int it = it0 + q4 * NT; if (it < T * 32) { const int t = it >> 5; float u[8], p[8], o[8]; unpack8(ru[q4], u); unpack8(rp[q4], p); const float pm = (t & (SEQ - 1)) ? 1.f : 0.f;
#pragma unroll
              for (int j = 0; j < 8; ++j) { const float s = u[j] + muv[j] * (p[j] * pm - u[j]); o[j] = c8 < 64 ? (1.0f - 2.0f * __builtin_amdgcn_rcpf(1.0f + __builtin_amdgcn_exp2f(2.0f * LOG2E * s))) : (c8 < 128 ? s : sigm(s));     }
              *(v4u*)(LIN + (size_t)t * 256 + c8) = pack8(o); } } } }
    { const int gw = F.bid * NWAVES + F.wave, NGW = F.G * NWAVES, lane = F.lane; float gqv[8], gkv[8];
#pragma unroll
      for (int j = 0; j < 8; ++j) { gqv[j] = gq[((lane & 7) << 3) + j] * QSCALE; gkv[j] = gk[((lane & 7) << 3) + j]; }
      for (int t0 = gw; t0 < T; t0 += 4 * NGW) { v4u rq[4], rk[4];
#pragma unroll
          for (int q4 = 0; q4 < 4; ++q4) { const int t = t0 + q4 * NGW; if (t < T) { rq[q4] = *(const v4u*)(UA + (size_t)t * UA_W + 8 * lane); rk[q4] = *(const v4u*)(UA + (size_t)t * UA_W + UA_K + 8 * (lane & 7)); } }
#pragma unroll
          for (int q4 = 0; q4 < 4; ++q4) { const int t = t0 + q4 * NGW; if (t < T) {
              float q[8], k[8]; unpack8(rq[q4], q); unpack8(rk[q4], k);
              float sq = 0.f, sk = 0.f;
#pragma unroll
              for (int j = 0; j < 8; ++j) { sq += q[j] * q[j]; sk += k[j] * k[j]; }
              sq += __shfl_xor(sq, 1); sq += __shfl_xor(sq, 2); sq += __shfl_xor(sq, 4); sk += __shfl_xor(sk, 1); sk += __shfl_xor(sk, 2); sk += __shfl_xor(sk, 4);
              const float rq_ = rsqrtf(sq * (1.f / 64.f) + NORM_EPS), rk_ = rsqrtf(sk * (1.f / 64.f) + NORM_EPS);
#pragma unroll
              for (int j = 0; j < 8; ++j) { q[j] *= rq_ * gqv[j]; k[j] *= rk_ * gkv[j]; }
              *(v4u*)(QN + (size_t)t * 512 + 8 * lane) = pack8(q);
              if (lane < 8) *(v4u*)(KN + (size_t)t * 64 + 8 * lane) = pack8(k); } } } }
    { const int gt = F.bid * 512 + F.tid, NT = F.G * 512;
      for (int it = gt; it < T * 8; it += NT) { const int t = it >> 3, c8 = (it & 7) << 3; *(v4u*)(VT + (size_t)t * 64 + c8) = *(const v4u*)(UA + (size_t)t * UA_W + UA_V + c8); } }
}
constexpr int IDX_STRIDE = 2052, KSEL = 256;
__device__ __forceinline__ void topk_select(const LAS float* row, int limit, unsigned* maskrow, int lane) {
    unsigned long long mybits = 0ull; const int nj = limit >> 6;
    if (limit <= KSEL) { mybits = lane < nj ? ~0ull : 0ull; }
    else {
        unsigned key[32];
#pragma unroll
        for (int j = 0; j < 32; ++j) key[j] = 0u;
#pragma unroll
        for (int g8 = 0; g8 < 4; ++g8) if (8 * g8 < nj) {
#pragma unroll
            for (int jj = 0; jj < 8; ++jj) { const int j = 8 * g8 + jj; unsigned u = __float_as_uint(row[64 * j + lane]); if (u == 0x80000000u) u = 0u; const unsigned k = (u & 0x80000000u) ? ~u : (u | 0x80000000u); key[j] = (j < nj) ? k : 0u; } }
        unsigned prefix = 0u; bool exact = false;
        for (int bit = 31; bit >= 0; --bit) { const unsigned cand = prefix | (1u << bit); int c0 = 0, c1 = 0;
#pragma unroll
            for (int g8 = 0; g8 < 4; ++g8) if (8 * g8 < nj) {
#pragma unroll
                for (int jj = 0; jj < 8; jj += 2) { c0 += (key[8 * g8 + jj] >= cand) ? 1 : 0; c1 += (key[8 * g8 + jj + 1] >= cand) ? 1 : 0; } }
            int cnt = c0 + c1;
            cnt += __builtin_amdgcn_mov_dpp(cnt, 0xB1, 0xf, 0xf, true); cnt += __builtin_amdgcn_mov_dpp(cnt, 0x4E, 0xf, 0xf, true); cnt += __builtin_amdgcn_mov_dpp(cnt, 0x141, 0xf, 0xf, true); cnt += __builtin_amdgcn_mov_dpp(cnt, 0x140, 0xf, 0xf, true);
            cnt = __builtin_amdgcn_readlane(cnt, 0) + __builtin_amdgcn_readlane(cnt, 16) + __builtin_amdgcn_readlane(cnt, 32) + __builtin_amdgcn_readlane(cnt, 48);
            if (cnt >= KSEL) { prefix = cand; if (cnt == KSEL) { exact = true; break; } } }
        int need = 0;
        if (!exact) { int cgt = 0;
#pragma unroll
            for (int j = 0; j < 32; ++j) cgt += __builtin_popcountll(__ballot(key[j] > prefix));
            need = KSEL - cgt; }
        int running = 0; const unsigned long long below = (1ull << lane) - 1ull;
#pragma unroll
        for (int g8 = 0; g8 < 4; ++g8) if (8 * g8 < nj)
#pragma unroll
        for (int jj = 0; jj < 8; ++jj) { const int j = 8 * g8 + jj;
            const bool gt = exact ? (key[j] >= prefix) : (key[j] > prefix); const bool tie = (!exact) && key[j] == prefix;
            const unsigned long long tb = __ballot(tie); const int rank = running + __builtin_popcountll(tb & below); running += __builtin_popcountll(tb);
            const unsigned long long sb = __ballot(gt || (tie && rank < need)); if (lane == j) mybits = sb; }
    }
    if (lane < 32) { v2u w; w.x = (unsigned)mybits; w.y = (unsigned)(mybits >> 32); *(v2u*)(maskrow + 2 * lane) = w; }
}
__device__ __forceinline__ void phase_indexer(Frame& F) {
    unsigned char* ws = F.ws; const bf16* UA = (const bf16*)(ws + WS_UA); unsigned* MASK = (unsigned*)(ws + WS_MASK);
    LAS float* sc = (LAS float*)F.lds; const int lane = F.lane, w = F.wave, fr = lane & 15, fq = lane >> 4;
    for (int r = 0;; ++r) { const int u = r * F.G + ((r & 1) ? (F.G - 1 - F.bid) : F.bid); if (u >= NB * 128) break;
        const int c = 31 - (u >> 7), rest = u & 127, b = rest >> 2, g4 = rest & 3, limit = 64 * (c + 1), tq0 = b * SEQ + c * 64 + g4 * 16;
        const bf16* UAb = UA + (size_t)b * SEQ * UA_W;
        bf16x8 qf[4][2]; float iwv[4];
        { const bf16* qp = UA + (size_t)(tq0 + fr) * UA_W;
#pragma unroll
          for (int hh = 0; hh < 4; ++hh) { qf[hh][0] = *(const bf16x8*)(qp + UA_IQ + hh * 64 + fq * 8); qf[hh][1] = *(const bf16x8*)(qp + UA_IQ + hh * 64 + 32 + fq * 8); iwv[hh] = bf1(qp[UA_IW + hh]) * (1.f / 16.f); } }
#ifndef IDX_SCORE_REP
#define IDX_SCORE_REP 1
#endif
#ifndef IDX_SEL_REP
#define IDX_SEL_REP 1
#endif
        for (int rp_ = 0; rp_ < IDX_SCORE_REP; ++rp_)
        for (int kt = w; kt < (limit >> 4); kt += NWAVES) {
            const bf16* kp = UAb + (size_t)(kt * 16 + fr) * UA_W + UA_IK + fq * 8; const bf16x8 a0 = *(const bf16x8*)kp, a1 = *(const bf16x8*)(kp + 32);
            f32x4 s = {0.f, 0.f, 0.f, 0.f};
#pragma unroll
            for (int hh = 0; hh < 4; ++hh) { f32x4 d = {0.f, 0.f, 0.f, 0.f}; d = __builtin_amdgcn_mfma_f32_16x16x32_bf16(a0, qf[hh][0], d, 0, 0, 0); d = __builtin_amdgcn_mfma_f32_16x16x32_bf16(a1, qf[hh][1], d, 0, 0, 0);
#pragma unroll
                for (int j = 0; j < 4; ++j) s[j] += iwv[hh] * fmaxf(d[j], 0.f); }
            *(LAS f32x4*)(sc + fr * IDX_STRIDE + kt * 16 + fq * 4) = s; }
        __syncthreads();
#pragma unroll 1
        for (int qq = 0; qq < 2 * IDX_SEL_REP; ++qq) { const int q = 2 * w + (qq & 1); topk_select(sc + q * IDX_STRIDE, limit, MASK + (size_t)(tq0 + q) * 64, lane); }
        __syncthreads(); }
}
constexpr int DA_K = 0, DA_V = 8192, DA_M = 16384, DA_STAGE = 16384 + 512;
__device__ __forceinline__ bf16x8 mk8(v2u lo, v2u hi) { v4u t; t.x = lo.x; t.y = lo.y; t.z = hi.x; t.w = hi.y; return __builtin_bit_cast(bf16x8, t); }
__device__ __forceinline__ void tr_read_v4d(unsigned a, bf16x8 (&vf)[4]) { s16x4 l0, h0, l1, h1, l2, h2, l3, h3;
    asm volatile("ds_read_b64_tr_b16 %0, %8\n\tds_read_b64_tr_b16 %1, %8 offset:512\n\tds_read_b64_tr_b16 %2, %8 offset:32\n\tds_read_b64_tr_b16 %3, %8 offset:544\n\t"
                 "ds_read_b64_tr_b16 %4, %8 offset:64\n\tds_read_b64_tr_b16 %5, %8 offset:576\n\tds_read_b64_tr_b16 %6, %8 offset:96\n\tds_read_b64_tr_b16 %7, %8 offset:608\n\ts_waitcnt lgkmcnt(0)"
                 : "=&v"(l0), "=&v"(h0), "=&v"(l1), "=&v"(h1), "=&v"(l2), "=&v"(h2), "=&v"(l3), "=&v"(h3) : "v"(a) : "memory");
    vf[0] = (bf16x8){l0[0], l0[1], l0[2], l0[3], h0[0], h0[1], h0[2], h0[3]}; vf[1] = (bf16x8){l1[0], l1[1], l1[2], l1[3], h1[0], h1[1], h1[2], h1[3]};
    vf[2] = (bf16x8){l2[0], l2[1], l2[2], l2[3], h2[0], h2[1], h2[2], h2[3]}; vf[3] = (bf16x8){l3[0], l3[1], l3[2], l3[3], h3[0], h3[1], h3[2], h3[3]}; }
__device__ __forceinline__ void phase_dsa_attn(Frame& F, const Args& a) {
    unsigned char* ws = F.ws; const bf16* QN = (const bf16*)(ws + WS_QN); const bf16* KN = (const bf16*)(ws + WS_KN); const bf16* VN = (const bf16*)(ws + WS_VT);
    const unsigned* MASK = (const unsigned*)(ws + WS_MASK); bf16* MIX = (bf16*)(ws + WS_XB);
    const int lane = F.lane, w = F.wave, fr = lane & 15, fq = lane >> 4; LAS unsigned char* lds = F.lds;
    const float mb = 8.f * LOG2E * wave_max(fabsf(a.in[3][lane])) * wave_max(fabsf(a.in[4][lane]));
    const unsigned vtr_lane = (unsigned)((8 * fq + ((lane & 15) >> 2)) * 128 + 4 * (lane & 3) * 2);
    for (int r = 0;; ++r) { const int u = r * F.G + ((r & 1) ? (F.G - 1 - F.bid) : F.bid); if (u >= NB * 32) break;
        const int c = 31 - (u >> 5), b = u & 31, nst = c + 1, t0 = b * SEQ + 64 * c;
        const bf16* Kb = KN + (size_t)b * SEQ * 64; const bf16* Vb = VN + (size_t)b * SEQ * 64; const unsigned* Mb = MASK + (size_t)t0 * 64;
#define DA_DMA(st_, buf_) do { const int so_ = (buf_) * DA_STAGE; \
            __builtin_amdgcn_global_load_lds((const unsigned*)(Kb + (size_t)(64 * (st_) + 8 * w) * 64 + lane * 8), (LAS unsigned*)(lds + so_ + DA_K + w * 1024), 16, 0, 0); \
            __builtin_amdgcn_global_load_lds((const unsigned*)(Vb + (size_t)(64 * (st_) + 8 * w) * 64 + lane * 8), (LAS unsigned*)(lds + so_ + DA_V + w * 1024), 16, 0, 0); \
            if (w < 2) __builtin_amdgcn_global_load_lds(Mb + (size_t)lane * 64 + 2 * (st_) + w, (LAS unsigned*)(lds + so_ + DA_M + w * 256), 4, 0, 0); } while (0)
        DA_DMA(0, 0);
        bf16x8 qf[4][2];
#pragma unroll
        for (int i = 0; i < 4; ++i) { const bf16* qp = QN + (size_t)(t0 + 16 * i + fr) * 512 + w * 64 + fq * 8; qf[i][0] = *(const bf16x8*)qp; qf[i][1] = *(const bf16x8*)(qp + 32); }
        f32x4 O[4][4]; float l[4];
#pragma unroll
        for (int i = 0; i < 4; ++i) { l[i] = 0.f;
#pragma unroll
            for (int dt = 0; dt < 4; ++dt) O[i][dt] = (f32x4){0.f, 0.f, 0.f, 0.f}; }
        for (int st = 0; st < nst; ++st) { const int buf = st & 1; const LAS unsigned char* sb = lds + buf * DA_STAGE;
            asm volatile("s_waitcnt vmcnt(0)" ::: "memory");
            __builtin_amdgcn_s_barrier(); asm volatile("" ::: "memory");
            if (st + 1 < nst) DA_DMA(st + 1, buf ^ 1);
#pragma unroll
            for (int sub = 0; sub < 2; ++sub) {
                bf16x8 kf[2][2], vf[4]; unsigned mw[4];
#pragma unroll
                for (int s2 = 0; s2 < 2; ++s2) { const LAS unsigned char* kp = sb + DA_K + (32 * sub + 8 * (fr >> 2) + 4 * s2 + (fr & 3)) * 128 + fq * 16;   kf[s2][0] = *(const LAS bf16x8*)kp; kf[s2][1] = *(const LAS bf16x8*)(kp + 64); }
#pragma unroll
                for (int i = 0; i < 4; ++i) mw[i] = *(const LAS unsigned*)(sb + DA_M + sub * 256 + (16 * i + fr) * 4);
                tr_read_v4d((unsigned)(size_t)(sb + DA_V + sub * 4096) + vtr_lane, vf);
#pragma unroll
                for (int i = 0; i < 4; ++i) {
                    f32x4 s0 = {0.f, 0.f, 0.f, 0.f}, s1 = {0.f, 0.f, 0.f, 0.f};
                    s0 = __builtin_amdgcn_mfma_f32_16x16x32_bf16(kf[0][0], qf[i][0], s0, 0, 0, 0); s0 = __builtin_amdgcn_mfma_f32_16x16x32_bf16(kf[0][1], qf[i][1], s0, 0, 0, 0);
                    s1 = __builtin_amdgcn_mfma_f32_16x16x32_bf16(kf[1][0], qf[i][0], s1, 0, 0, 0); s1 = __builtin_amdgcn_mfma_f32_16x16x32_bf16(kf[1][1], qf[i][1], s1, 0, 0, 0);
                    const unsigned b0 = mw[i] >> (8 * fq), b1 = mw[i] >> (8 * fq + 4); float p[8];
#pragma unroll
                    for (int j = 0; j < 4; ++j) { p[j] = ((b0 >> j) & 1u) ? __builtin_amdgcn_exp2f(s0[j] - mb) : 0.f; p[4 + j] = ((b1 >> j) & 1u) ? __builtin_amdgcn_exp2f(s1[j] - mb) : 0.f; }
                    l[i] += ((p[0] + p[1]) + (p[2] + p[3])) + ((p[4] + p[5]) + (p[6] + p[7]));
                    const bf16x8 pa = __builtin_bit_cast(bf16x8, pack8(p));
#pragma unroll
                    for (int dt = 0; dt < 4; ++dt) O[i][dt] = __builtin_amdgcn_mfma_f32_16x16x32_bf16(pa, vf[dt], O[i][dt], 0, 0, 0);
                } } }
#undef DA_DMA
#pragma unroll
        for (int i = 0; i < 4; ++i) { float li = l[i]; li += __shfl_xor(li, 16); li += __shfl_xor(li, 32);
#pragma unroll
            for (int j = 0; j < 4; ++j) { const float inv = 1.0f / __shfl(li, 4 * fq + j); bf16* op = MIX + (size_t)(t0 + 16 * i + 4 * fq + j) * D + w * 64 + fr;
#pragma unroll
                for (int dt = 0; dt < 4; ++dt) op[16 * dt] = (bf16)f2bf(O[i][dt][j] * inv); } }
        VM_WAIT(); __syncthreads();
    }
}
__device__ __forceinline__ float rw_decay(float x) { const float sp = fmaxf(-x, 0.f) + 0.6931471805599453f * __builtin_amdgcn_logf(1.0f + __builtin_amdgcn_exp2f(-LOG2E * fabsf(x)));
    return __builtin_amdgcn_exp2f(-LOG2E * __builtin_amdgcn_exp2f(-LOG2E * (sp + 0.5f))); }
#define MF32(a_, b_, c_) __builtin_amdgcn_mfma_f32_16x16x4f32((a_), (b_), (c_), 0, 0, 0)
constexpr int RT = 68, RG = 20, RGM = 16 * RG;
constexpr int RL_AH = 0, RL_BH = 64 * RT, RL_KH = 2 * 64 * RT, RL_RH = 3 * 64 * RT, RL_VX = 4 * 64 * RT, RL_GS = 5 * 64 * RT, RL_YA = 6 * 64 * RT, RL_GR = 7 * 64 * RT, RL_PM = RL_GR + 16 * RGM, RL_GC = RL_PM + 4 * RGM, RL_BON = RL_GC + 256, RL_END = RL_BON + 64;
static_assert(RL_END * 4 <= MISC_OFF, "RWKV LDS");
__device__ __forceinline__ void phase_rwkv(Frame& F, const Args& a) {
    unsigned char* ws = F.ws; const bf16* UB = (const bf16*)(ws + WS_UB); const bf16* LOUT = (const bf16*)(ws + WS_LOUT); bf16* MIX = (bf16*)(ws + WS_XB);
    const float* mu = a.in[6]; const float* w0 = a.in[7]; const float* a0 = a.in[9]; const float* k_k = a.in[12]; const float* k_a = a.in[13]; const float* r_k = a.in[14]; const float* gn_g = a.in[15]; const float* gn_b = a.in[16];
    const int lane = F.lane, w = F.wave, n = lane & 15, q = lane >> 4;
    LAS float* L = (LAS float*)F.lds;
    for (int bh = F.bid; bh < NB * 8; bh += F.G) {
        const int b = bh >> 3, h = bh & 7, c = h * 64 + lane;
        const float mur = mu[c], muk = mu[512 + c], muv = mu[1024 + c], w0c = w0[c], a0c = a0[c], kkc = k_k[c], kac = k_a[c], rkc = r_k[c], gng = gn_g[c], gnb = gn_b[c];
        f32x4 Z[4];
#pragma unroll
        for (int kt = 0; kt < 4; ++kt) Z[kt] = (f32x4){0.f, 0.f, 0.f, 0.f};
        const int ch = w >> 1, hs = w & 1;
        float r_ur[8], r_uk[8], r_uv[8], r_pr[8], r_pk[8], r_pv[8], r_wd[8], r_ad[8], r_gg[8], r_wf[8];
#define RW_RAW(batch_) do { _Pragma("unroll") for (int i = 0; i < 8; ++i) { const int sl = (batch_) * 64 + 16 * ch + 8 * hs + i; const size_t t = (size_t)b * SEQ + sl; const bf16* up = UB + t * UB_W + c; const bf16* pp_ = sl > 0 ? up - UB_W : up; \
            r_ur[i] = bf1(up[0]); r_uk[i] = bf1(up[512]); r_uv[i] = bf1(up[1024]); r_pr[i] = bf1(pp_[0]); r_pk[i] = bf1(pp_[512]); r_pv[i] = bf1(pp_[1024]); \
            const bf16* lp = LOUT + t * 1536 + c; r_wd[i] = bf1(lp[0]); r_ad[i] = bf1(lp[512]); r_gg[i] = bf1(lp[1024]); \
            r_wf[i] = bf1(LOUT[((size_t)b * SEQ + (batch_) * 64 + 16 * ch + i) * 1536 + c]); } } while (0)
        RW_RAW(0);
        for (int batch = 0; batch < SEQ / 64; ++batch) {
            { float gcur = 1.f;
              if (hs) {
#pragma unroll
                  for (int i = 0; i < 8; ++i) gcur *= rw_decay(w0c + r_wf[i]); }
#pragma unroll
              for (int i = 0; i < 8; ++i) { const int tl = 16 * ch + 8 * hs + i, sl = batch * 64 + tl; const float pm = sl > 0 ? 1.f : 0.f;
                const float ur = r_ur[i], uk = r_uk[i], uv = r_uv[i], pr = r_pr[i] * pm, pk = r_pk[i] * pm, pv = r_pv[i] * pm;
                const float rr = ur + mur * (pr - ur), kx = uk + muk * (pk - uk), vx = uv + muv * (pv - uv);
                const float decay = rw_decay(w0c + r_wd[i]), av = sigm(a0c + r_ad[i]);
                float kk = kx * kkc; kk = kk * rsqrtf(fmaxf(wave_sum(kk * kk), 1e-24f));
                const float km = kx * (1.f + (av - 1.f) * kac); const float bon = wave_sum(rr * km * rkc);
                const float gprev = gcur; gcur *= decay; const float ig = __builtin_amdgcn_rcpf(gcur);
                L[RL_AH + tl * RT + lane] = -kk * gprev; L[RL_BH + tl * RT + lane] = kk * av * ig; L[RL_KH + tl * RT + lane] = km * ig; L[RL_RH + tl * RT + lane] = rr * gcur;
                L[RL_VX + tl * RT + lane] = vx; L[RL_GS + tl * RT + lane] = r_gg[i]; if (lane == 0) L[RL_BON + tl] = bon; }
              if (hs) L[RL_GC + ch * 64 + lane] = gcur; }
            LDS_WAIT(); __syncthreads();
            if (batch + 1 < SEQ / 64) RW_RAW(batch + 1);
            { const LAS float* ah = L + RL_AH + 16 * ch * RT; const LAS float* bhm = L + RL_BH + 16 * ch * RT; const LAS float* khm = L + RL_KH + 16 * ch * RT; const LAS float* rhm = L + RL_RH + 16 * ch * RT;
              LAS float* gr = L + RL_GR + ch * 4 * RGM; LAS float* pm_ = L + RL_PM + ch * RGM;
              if (hs == 0) {
                  f32x4 m = {0.f, 0.f, 0.f, 0.f};
#pragma unroll
                  for (int s = 0; s < 16; ++s) m = MF32(bhm[n * RT + 4 * s + q], ah[n * RT + 4 * s + q], m);
                  f32x4 tm;
#pragma unroll
                  for (int j = 0; j < 4; ++j) { m[j] = (4 * q + j < n) ? m[j] : 0.f; tm[j] = m[j] + ((4 * q + j == n) ? 1.f : 0.f); pm_[(4 * q + j) * RG + n] = m[j]; gr[(4 * q + j) * RG + n] = tm[j]; }
#pragma unroll
                  for (int rd = 0; rd < 3; ++rd) { LDS_WAIT();
                      f32x4 p2 = {0.f, 0.f, 0.f, 0.f};
#pragma unroll
                      for (int s = 0; s < 4; ++s) p2 = MF32(pm_[n * RG + 4 * s + q], pm_[(4 * s + q) * RG + n], p2);
                      f32x4 ip, t2 = {0.f, 0.f, 0.f, 0.f};
#pragma unroll
                      for (int j = 0; j < 4; ++j) ip[j] = p2[j] + ((4 * q + j == n) ? 1.f : 0.f);
#pragma unroll
                      for (int j = 0; j < 4; ++j) t2 = MF32(gr[n * RG + 4 * q + j], ip[j], t2);
                      LDS_WAIT();
#pragma unroll
                      for (int j = 0; j < 4; ++j) { pm_[(4 * q + j) * RG + n] = p2[j]; gr[(4 * q + j) * RG + n] = t2[j]; } }
              } else {
                  f32x4 mk = {0.f, 0.f, 0.f, 0.f}, nb = {0.f, 0.f, 0.f, 0.f}, nk = {0.f, 0.f, 0.f, 0.f};
#pragma unroll
                  for (int s = 0; s < 16; ++s) { const float av_ = ah[n * RT + 4 * s + q], rv_ = rhm[n * RT + 4 * s + q], bv_ = bhm[n * RT + 4 * s + q], kv_ = khm[n * RT + 4 * s + q];
                      mk = MF32(kv_, av_, mk); nb = MF32(bv_, rv_, nb); nk = MF32(kv_, rv_, nk); }
#pragma unroll
                  for (int j = 0; j < 4; ++j) { const int s_ = 4 * q + j; gr[RGM + s_ * RG + n] = (s_ < n) ? mk[j] : 0.f; gr[2 * RGM + s_ * RG + n] = (s_ <= n) ? nb[j] : 0.f; gr[3 * RGM + s_ * RG + n] = (s_ <= n) ? nk[j] : 0.f; } } }
            LDS_WAIT(); __syncthreads();
#ifndef RW_C_REP
#define RW_C_REP 1
#endif
            if (w < 4) { const int v = 16 * w + n; f32x4 Zs[4]; for (int kt = 0; kt < 4; ++kt) Zs[kt] = Z[kt];
              for (int rc_ = 0; rc_ < RW_C_REP; ++rc_) { if (rc_) for (int kt = 0; kt < 4; ++kt) Z[kt] = Zs[kt];
#pragma unroll 1
                for (int cc = 0; cc < 4; ++cc) { const LAS float* ah = L + RL_AH + 16 * cc * RT; const LAS float* bhm = L + RL_BH + 16 * cc * RT; const LAS float* khm = L + RL_KH + 16 * cc * RT; const LAS float* rhm = L + RL_RH + 16 * cc * RT;
                    const LAS float* vx = L + RL_VX + 16 * cc * RT; const LAS float* gr = L + RL_GR + cc * 4 * RGM;
                    float vb[4];
#pragma unroll
                    for (int s = 0; s < 4; ++s) vb[s] = vx[(4 * s + q) * RT + v];
                    f32x4 X = {0.f, 0.f, 0.f, 0.f}, Y = {0.f, 0.f, 0.f, 0.f};
#pragma unroll
                    for (int kt = 0; kt < 4; ++kt)
#pragma unroll
                        for (int j = 0; j < 4; ++j) { X = MF32(ah[n * RT + 16 * kt + 4 * q + j], Z[kt][j], X); Y = MF32(rhm[n * RT + 16 * kt + 4 * q + j], Z[kt][j], Y); }
#pragma unroll
                    for (int s = 0; s < 4; ++s) { X = MF32(gr[RGM + (4 * s + q) * RG + n], vb[s], X); Y = MF32(gr[3 * RGM + (4 * s + q) * RG + n], vb[s], Y); }
                    f32x4 U = {0.f, 0.f, 0.f, 0.f};
#pragma unroll
                    for (int j = 0; j < 4; ++j) U = MF32(gr[(4 * q + j) * RG + n], X[j], U);
#pragma unroll
                    for (int j = 0; j < 4; ++j) Y = MF32(gr[2 * RGM + (4 * q + j) * RG + n], U[j], Y);
#pragma unroll
                    for (int j = 0; j < 4; ++j) L[RL_YA + (16 * cc + 4 * q + j) * RT + v] = Y[j];
#pragma unroll
                    for (int kt = 0; kt < 4; ++kt) {
#pragma unroll
                        for (int j = 0; j < 4; ++j) Z[kt] = MF32(bhm[(4 * q + j) * RT + 16 * kt + n], U[j], Z[kt]);
#pragma unroll
                        for (int s = 0; s < 4; ++s) Z[kt] = MF32(khm[(4 * s + q) * RT + 16 * kt + n], vb[s], Z[kt]);
                        const f32x4 gc = *(const LAS f32x4*)(L + RL_GC + cc * 64 + 16 * kt + 4 * q); Z[kt] = Z[kt] * gc; } } } }
            LDS_WAIT(); __syncthreads();
#pragma unroll
            for (int i = 0; i < 8; ++i) { const int step = w + 8 * i; const size_t t = (size_t)b * SEQ + batch * 64 + step;
                const float y = L[RL_YA + step * RT + lane], mean = wave_sum(y) * (1.f / 64.f), dlt = y - mean, var = fmaxf(wave_sum(y * y) * (1.f / 64.f) - mean * mean, 0.f);
                const float yn = dlt * rsqrtf(var + 64e-5f) * gng + gnb; const float o = (yn + L[RL_BON + step] * L[RL_VX + step * RT + lane]) * L[RL_GS + step * RT + lane];
                MIX[t * D + 512 + c] = (bf16)f2bf(o); }
            LDS_WAIT(); __syncthreads();
        }
#undef RW_RAW
    }
}
__device__ __forceinline__ void phase_l1prep(Frame& F, const Args& a, int hb) {
    unsigned char* ws = F.ws; const bf16* XM = (const bf16*)(ws + WS_XM); bf16* XC = (bf16*)(ws + WS_XC); bf16* Q = (bf16*)(ws + WS_Q); bf16* K = (bf16*)(ws + WS_K); bf16* V = (bf16*)(ws + WS_V);
    float* GI = (float*)(ws + WS_GI); const float* W12 = (const float*)(ws + WS_W12);
    const float* cw = a.in[19]; const float* cb = a.in[20]; const float* wq = a.in[21]; const float* wk = a.in[22]; const float* wv = a.in[23]; const float* b_i = a.in[25]; const float* b_f = a.in[26];
    const int g = F.tid, lane = F.lane, w = F.wave; LAS float* red = (LAS float*)F.lds;
    float cwr[4][4], cbr[4], wqr[16], wkr[16], wvr[16], w1[32], w2[32];
#pragma unroll
    for (int j = 0; j < 4; ++j)
#pragma unroll
        for (int i = 0; i < 4; ++i) cwr[j][i] = cw[j * CI + 4 * g + i];
#pragma unroll
    for (int i = 0; i < 4; ++i) cbr[i] = cb[4 * g + i];
#pragma unroll
    for (int i = 0; i < 16; ++i) { wqr[i] = wq[g * 16 + i]; wkr[i] = wk[g * 16 + i]; wvr[i] = wv[g * 16 + i]; }
#pragma unroll
    for (int i = 0; i < 32; ++i) { w1[i] = W12[(size_t)(4 * g) * 8 + i]; w2[i] = W12[(size_t)(2048 + 4 * g) * 8 + i]; }
    const int per = TH / F.G;
    const int tb = F.bid * per;
    float x0[4], x1[4], x2[4];
    { const int sl = tb & (SEQ - 1);
#pragma unroll
      for (int i = 0; i < 4; ++i) { x0[i] = 0.f; x1[i] = 0.f; x2[i] = 0.f; }
      if (sl >= 1) { const v2u r = *(const v2u*)(XM + (size_t)(tb - 1) * CI + 4 * g); x2[0] = bflo(r.x); x2[1] = bfhi(r.x); x2[2] = bflo(r.y); x2[3] = bfhi(r.y); }
      if (sl >= 2) { const v2u r = *(const v2u*)(XM + (size_t)(tb - 2) * CI + 4 * g); x1[0] = bflo(r.x); x1[1] = bfhi(r.x); x1[2] = bflo(r.y); x1[3] = bfhi(r.y); }
      if (sl >= 3) { const v2u r = *(const v2u*)(XM + (size_t)(tb - 3) * CI + 4 * g); x0[0] = bflo(r.x); x0[1] = bfhi(r.x); x0[2] = bflo(r.y); x0[3] = bfhi(r.y); } }
    constexpr int L1PF = 4;
    v2u xq[L1PF][2];
#pragma unroll
    for (int pq = 0; pq < L1PF; ++pq)
#pragma unroll
        for (int tk = 0; tk < 2; ++tk) xq[pq][tk] = *(const v2u*)(XM + (size_t)(tb + 2 * pq + tk) * CI + 4 * g);
    for (int n4 = 0; n4 < per / 2; ++n4) { const int t4 = tb + 2 * n4;
        float gs[16]; v2u xr[2];
        xr[0] = xq[0][0]; xr[1] = xq[0][1];
#pragma unroll
        for (int pq = 0; pq + 1 < L1PF; ++pq) { xq[pq][0] = xq[pq + 1][0]; xq[pq][1] = xq[pq + 1][1]; }
        { const int tn = (n4 + L1PF < per / 2) ? t4 + 2 * L1PF : t4;
#pragma unroll
          for (int tk = 0; tk < 2; ++tk) xq[L1PF - 1][tk] = *(const v2u*)(XM + (size_t)(tn + tk) * CI + 4 * g); }
#pragma unroll
        for (int tk = 0; tk < 2; ++tk) { const int t = t4 + tk;
            float x3[4]; x3[0] = bflo(xr[tk].x); x3[1] = bfhi(xr[tk].x); x3[2] = bflo(xr[tk].y); x3[3] = bfhi(xr[tk].y);
            float xc[4], q[4], k[4], v[4];
#pragma unroll
            for (int i = 0; i < 4; ++i) { const float s = fmaf(cwr[3][i], x3[i], fmaf(cwr[2][i], x2[i], fmaf(cwr[1][i], x1[i], fmaf(cwr[0][i], x0[i], cbr[i])))); xc[i] = s * sigm(s); }
#pragma unroll
            for (int j = 0; j < 4; ++j) { q[j] = fmaf(xc[3], wqr[12 + j], fmaf(xc[2], wqr[8 + j], fmaf(xc[1], wqr[4 + j], xc[0] * wqr[j]))); k[j] = fmaf(xc[3], wkr[12 + j], fmaf(xc[2], wkr[8 + j], fmaf(xc[1], wkr[4 + j], xc[0] * wkr[j])));
                v[j] = fmaf(x3[3], wvr[12 + j], fmaf(x3[2], wvr[8 + j], fmaf(x3[1], wvr[4 + j], x3[0] * wvr[j]))); }
#pragma unroll
            for (int o = 0; o < 8; ++o) { float s = 0.f;
#pragma unroll
                for (int i = 0; i < 4; ++i) s = fmaf(x3[i], w2[i * 8 + o], fmaf(xc[i], w1[i * 8 + o], s));
                gs[tk * 8 + o] = s; }
            const size_t off = (size_t)t * CI + 4 * g; const float ks = 0.044194173824159216f;
            { v2u o; o.x = pk2(xc[0], xc[1]); o.y = pk2(xc[2], xc[3]); *(v2u*)(XC + off) = o; o.x = pk2(q[0], q[1]); o.y = pk2(q[2], q[3]); *(v2u*)(Q + off) = o;
              o.x = pk2(k[0] * ks, k[1] * ks); o.y = pk2(k[2] * ks, k[3] * ks); *(v2u*)(K + off) = o; o.x = pk2(v[0], v[1]); o.y = pk2(v[2], v[3]); *(v2u*)(V + off) = o; }
#pragma unroll
            for (int i = 0; i < 4; ++i) { x0[i] = x1[i]; x1[i] = x2[i]; x2[i] = x3[i]; } }
#define L1_STAGE(mask, n) { const bool hi_ = (lane & (mask)) != 0; _Pragma("unroll") for (int i = 0; i < (n) / 2; ++i) { const float send_ = hi_ ? gs[i] : gs[(n) / 2 + i]; const float keep_ = hi_ ? gs[(n) / 2 + i] : gs[i]; gs[i] = keep_ + __shfl_xor(send_, (mask)); } }
        L1_STAGE(32, 16) L1_STAGE(16, 8) L1_STAGE(8, 4) L1_STAGE(4, 2)
#undef L1_STAGE
        gs[0] += __shfl_xor(gs[0], 2); gs[0] += __shfl_xor(gs[0], 1);
        LAS float* rp = red + (n4 & 1) * 128;
        if ((lane & 3) == 0) rp[w * 16 + (lane >> 2)] = gs[0];
        LDS_WAIT(); __syncthreads();
        if (F.tid < 16) { float s = 0.f;
#pragma unroll
            for (int ww = 0; ww < 8; ++ww) s += rp[ww * 16 + F.tid];
            const int o = F.tid & 7; GI[(size_t)(t4 + (F.tid >> 3)) * 8 + o] = s + (o < 4 ? b_i[o] : b_f[o - 4]); }
    }
}
__device__ __forceinline__ void phase_gatescan(Frame& F) {
    unsigned char* ws = F.ws; const float* GI = (const float*)(ws + WS_GI); float* GA = (float*)(ws + WS_GA); float* GAM = (float*)(ws + WS_GAM); float* GEM = (float*)(ws + WS_GEM);
    const int lane = F.lane, w = F.wave, tid = F.tid; LAS float* wtot = (LAS float*)F.lds;
    for (int sq = F.bid; sq < (NB / 2) * 4; sq += F.G) { const int bl = sq >> 2, h = sq & 3; const size_t tq = (size_t)bl * SEQ + 4 * tid;
        float ip[4], c[4];
#pragma unroll
        for (int k = 0; k < 4; ++k) { ip[k] = GI[(tq + k) * 8 + h]; c[k] = -softplusf_(-GI[(tq + k) * 8 + 4 + h]); }
        c[1] += c[0]; c[2] += c[1]; c[3] += c[2];
        float inc = c[3];
#pragma unroll
        for (int o = 1; o < 64; o <<= 1) { const float n = __shfl_up(inc, o); if (lane >= o) inc += n; }
        if (lane == 63) wtot[w] = inc;
        LDS_WAIT(); __syncthreads();
        float off = inc - c[3];
#pragma unroll
        for (int ww = 0; ww < 8; ++ww) if (ww < w) off += wtot[ww];
        float Fv[4], av[4], m[4];
#pragma unroll
        for (int k = 0; k < 4; ++k) { Fv[k] = off + c[k]; av[k] = ip[k] - Fv[k]; }
        m[0] = av[0]; m[1] = fmaxf(m[0], av[1]); m[2] = fmaxf(m[1], av[2]); m[3] = fmaxf(m[2], av[3]);
        float incm = m[3];
#pragma unroll
        for (int o = 1; o < 64; o <<= 1) { const float n = __shfl_up(incm, o); if (lane >= o) incm = fmaxf(incm, n); }
        if (lane == 63) wtot[8 + w] = incm;
        LDS_WAIT(); __syncthreads();
        float offm = __shfl_up(incm, 1); if (lane == 0) offm = -INFINITY;
#pragma unroll
        for (int ww = 0; ww < 8; ++ww) if (ww < w) offm = fmaxf(offm, wtot[8 + ww]);
#pragma unroll
        for (int k = 0; k < 4; ++k) { const float A = fmaxf(offm, m[k]); GA[(tq + k) * 4 + h] = av[k]; GAM[(tq + k) * 4 + h] = A; GEM[(tq + k) * 4 + h] = __expf(-(Fv[k] + A)); }
        LDS_WAIT(); __syncthreads();
    }
}
constexpr int ML_PITCH = 1040, ML_TILE = 32 * ML_PITCH, ML_PP = 80, ML_PT = 64 * ML_PP;
constexpr int ML_K = 0, ML_V = 2 * ML_TILE, ML_P = 4 * ML_TILE, ML_DEN = ML_P + 2 * ML_PT, ML_AT = ML_DEN + 512, ML_AS = ML_AT + 256, ML_END = ML_AS + 8192;
constexpr int ML_ST = ML_P, ML_MR = ML_P + 4096;
static_assert(ML_MR + 512 <= ML_DEN, "mLSTM LDS tables");
static_assert(ML_END <= MISC_OFF, "mLSTM LDS");
__device__ __forceinline__ void tr_read_v4(unsigned a, bf16x8 (&vf)[4]) { s16x4 l0, h0, l1, h1, l2, h2, l3, h3;
    asm volatile("ds_read_b64_tr_b16 %0, %8\n\tds_read_b64_tr_b16 %1, %8 offset:4160\n\tds_read_b64_tr_b16 %2, %8 offset:32\n\tds_read_b64_tr_b16 %3, %8 offset:4192\n\t"
                 "ds_read_b64_tr_b16 %4, %8 offset:64\n\tds_read_b64_tr_b16 %5, %8 offset:4224\n\tds_read_b64_tr_b16 %6, %8 offset:96\n\tds_read_b64_tr_b16 %7, %8 offset:4256\n\ts_waitcnt lgkmcnt(0)"
                 : "=&v"(l0), "=&v"(h0), "=&v"(l1), "=&v"(h1), "=&v"(l2), "=&v"(h2), "=&v"(l3), "=&v"(h3) : "v"(a) : "memory");
    vf[0] = (bf16x8){l0[0], l0[1], l0[2], l0[3], h0[0], h0[1], h0[2], h0[3]}; vf[1] = (bf16x8){l1[0], l1[1], l1[2], l1[3], h1[0], h1[1], h1[2], h1[3]};
    vf[2] = (bf16x8){l2[0], l2[1], l2[2], l2[3], h2[0], h2[1], h2[2], h2[3]}; vf[3] = (bf16x8){l3[0], l3[1], l3[2], l3[3], h3[0], h3[1], h3[2], h3[3]}; }
static_assert(4 * ML_PITCH == 4160, "tr_read_v4 offsets");
__device__ __forceinline__ void phase_mlstm(Frame& F, const Args& a) {
    unsigned char* ws = F.ws; const bf16* Q = (const bf16*)(ws + WS_Q); const bf16* K = (const bf16*)(ws + WS_K); const bf16* V = (const bf16*)(ws + WS_V); const bf16* XC = (const bf16*)(ws + WS_XC); const bf16* Z = (const bf16*)(ws + WS_Z);
    bf16* YC = (bf16*)(ws + WS_XM); const float* GA = (const float*)(ws + WS_GA); const float* GAM = (const float*)(ws + WS_GAM); const float* GEM = (const float*)(ws + WS_GEM);
    const float* mh_g = a.in[27]; const float* skip = a.in[28];
    const int tid = F.tid, lane = F.lane, w = F.wave, fr = lane & 15, fq = lane >> 4; LAS unsigned char* lds = F.lds;
    LAS float* den2 = (LAS float*)(lds + ML_DEN); LAS float* stats = (LAS float*)(lds + ML_ST); LAS float* mr = (LAS float*)(lds + ML_MR); LAS float* em_s = (LAS float*)(lds + ML_AT); LAS float* as_s = (LAS float*)(lds + ML_AS);
    const int tt = w >> 1, st = w & 1;
    const unsigned vtr_lane = (unsigned)((8 * fq + ((lane & 15) >> 2)) * ML_PITCH + (64 * w + 4 * (lane & 3)) * 2);
#ifndef ML_DMA_REP
#define ML_DMA_REP 1
#endif
#define ML_DMA(gbase, tile_off) do { _Pragma("unroll") for (int r4_ = 0; r4_ < 4 * ML_DMA_REP; ++r4_) { const int r4 = r4_ & 3; const int rr = w + 8 * r4; \
        __builtin_amdgcn_global_load_lds((const unsigned*)((gbase) + (size_t)rr * CI + lane * 8), (LAS unsigned*)(lds + (tile_off) + rr * ML_PITCH), 16, 0, 0); } } while (0)
    for (int r = 0; r < 8; ++r) { const int xcd = F.bid & 7, cq = F.bid >> 3, c16 = cq & 15; if (F.G != 256) break;
        const int part = r & 1, qi = part ? 31 - c16 : c16, bh = xcd + 8 * ((cq >> 4) + 2 * (r >> 1)), bl = bh >> 2, h = bh & 3; const size_t t0 = (size_t)bl * SEQ + 64 * qi; const int nk = 2 * (qi + 1), jstart = part ? 2 * (c16 + 1) : 0;
        const bf16* Kb = K + (size_t)bl * SEQ * CI + h * 512; const bf16* Vb = V + (size_t)bl * SEQ * CI + h * 512;
        ML_DMA(Kb + (size_t)(32 * jstart) * CI, ML_K); ML_DMA(Vb + (size_t)(32 * jstart) * CI, ML_V);
        bf16x8 qf[16];
        { const bf16* qp = Q + (t0 + 16 * tt + fr) * CI + h * 512 + fq * 8;
#pragma unroll
          for (int ks = 0; ks < 16; ++ks) qf[ks] = *(const bf16x8*)(qp + 32 * ks); }
        const float At = GAM[(t0 + 16 * tt + fr) * 4 + h];
        if (tid < 64) em_s[tid] = GEM[(t0 + tid) * 4 + h];
#pragma unroll
        for (int i4 = 0; i4 < 4; ++i4) { const int sidx = tid + 512 * i4; if (sidx < 64 * (qi + 1)) as_s[sidx] = GA[((size_t)bl * SEQ + sidx) * 4 + h]; }
        VM_WAIT(); LDS_WAIT();
        f32x4 O[4][4]; float denp = 0.f;
#pragma unroll
        for (int i = 0; i < 4; ++i)
#pragma unroll
            for (int e = 0; e < 4; ++e) O[i][e] = (f32x4){0.f, 0.f, 0.f, 0.f};
        for (int jj = 0; jj < nk; ++jj) { const int buf = jj & 1; int j = jj + jstart; if (j >= nk) j -= nk; int jn = j + 1; if (jn >= nk) jn -= nk;
            asm volatile("s_waitcnt vmcnt(0)" ::: "memory");
            __builtin_amdgcn_s_barrier(); asm volatile("" ::: "memory");
            if (jj + 1 < nk) ML_DMA(Kb + (size_t)(32 * jn) * CI, ML_K + (buf ^ 1) * ML_TILE);
            f32x4 sacc = {0.f, 0.f, 0.f, 0.f}, sacb = {0.f, 0.f, 0.f, 0.f};
            { const LAS unsigned char* kl = lds + ML_K + buf * ML_TILE + (16 * st + fr) * ML_PITCH + fq * 16;
#pragma unroll
              for (int ks = 0; ks < 16; ks += 2) { const bf16x8 kf = *(const LAS bf16x8*)(kl + 64 * ks), kg = *(const LAS bf16x8*)(kl + 64 * ks + 64);
                  sacc = __builtin_amdgcn_mfma_f32_16x16x32_bf16(kf, qf[ks], sacc, 0, 0, 0); sacb = __builtin_amdgcn_mfma_f32_16x16x32_bf16(kg, qf[ks + 1], sacb, 0, 0, 0); if ((ks & 3) == 2) __builtin_amdgcn_sched_barrier(0); } }
            sacc += sacb;
#ifdef ML_S_REP
            { f32x4 s2a = {0.f, 0.f, 0.f, 0.f}, s2b = {0.f, 0.f, 0.f, 0.f}; const LAS unsigned char* kl = lds + ML_K + buf * ML_TILE + (16 * st + fr) * ML_PITCH + fq * 16; asm volatile("" ::: "memory");
#pragma unroll
              for (int ks = 0; ks < 16; ks += 2) { const bf16x8 kf = *(const LAS bf16x8*)(kl + 64 * ks), kg = *(const LAS bf16x8*)(kl + 64 * ks + 64);
                  s2a = __builtin_amdgcn_mfma_f32_16x16x32_bf16(kf, qf[ks], s2a, 0, 0, 0); s2b = __builtin_amdgcn_mfma_f32_16x16x32_bf16(kg, qf[ks + 1], s2b, 0, 0, 0); if ((ks & 3) == 2) __builtin_amdgcn_sched_barrier(0); }
              sacc = (sacc + (s2a + s2b)) * 0.5f; }
#endif
            float p[4]; const f32x4 asv = *(const LAS f32x4*)(as_s + 32 * j + 16 * st + 4 * fq); const float as[4] = {asv[0], asv[1], asv[2], asv[3]};
#pragma unroll
            for (int i = 0; i < 4; ++i) { const bool ok = (32 * j + 16 * st + 4 * fq + i) <= (64 * qi + 16 * tt + fr); p[i] = ok ? sacc[i] * __builtin_amdgcn_exp2f((as[i] - At) * LOG2E) : 0.f; }
            denp += (p[0] + p[1]) + (p[2] + p[3]);
            { v2u pw; pw.x = pk2(p[0], p[1]); pw.y = pk2(p[2], p[3]); *(LAS v2u*)(lds + ML_P + buf * ML_PT + (16 * tt + fr) * ML_PP + (16 * st + 4 * fq) * 2) = pw; }
            LDS_WAIT(); __builtin_amdgcn_s_barrier(); asm volatile("" ::: "memory");
            if (jj + 1 < nk) ML_DMA(Vb + (size_t)(32 * jn) * CI, ML_V + (buf ^ 1) * ML_TILE);
            { bf16x8 vf[4], pf[4]; const unsigned vb = (unsigned)(size_t)(lds + ML_V + buf * ML_TILE) + vtr_lane;
              tr_read_v4(vb, vf);
#pragma unroll
              for (int i = 0; i < 4; ++i) pf[i] = *(const LAS bf16x8*)(lds + ML_P + buf * ML_PT + (16 * i + fr) * ML_PP + fq * 16);
#pragma unroll
              for (int i = 0; i < 4; ++i)
#pragma unroll
                  for (int e = 0; e < 4; ++e) O[i][e] = __builtin_amdgcn_mfma_f32_16x16x32_bf16(pf[i], vf[e], O[i][e], 0, 0, 0); }
        }
        { float d = denp; d += __shfl_xor(d, 16); d += __shfl_xor(d, 32); if (fq == 0) den2[st * 64 + 16 * tt + fr] = d; }
        LDS_WAIT(); __syncthreads();
        { const LAS float* den_q = den2 + 4 * fq; const LAS float* em_q = em_s + 4 * fq; LAS float* st_q = stats + (w * 64 + 4 * fq) * 2;
#pragma unroll
          for (int i = 0; i < 4; ++i) {
#pragma unroll
            for (int jj = 0; jj < 4; ++jj) { const float dn = den_q[16 * i + jj] + den_q[64 + 16 * i + jj]; const float inv = 1.0f / fmaxf(fabsf(dn), em_q[16 * i + jj]); float a1 = 0.f, a2 = 0.f;
#pragma unroll
                for (int e = 0; e < 4; ++e) { const float hv = O[i][e][jj] * inv; O[i][e][jj] = hv; a1 += hv; a2 += hv * hv; }
                { a1 += DPP_MOVF(a1, 0xB1); a2 += DPP_MOVF(a2, 0xB1); a1 += DPP_MOVF(a1, 0x4E); a2 += DPP_MOVF(a2, 0x4E); a1 += DPP_MOVF(a1, 0x141); a2 += DPP_MOVF(a2, 0x141); a1 += DPP_MOVF(a1, 0x140); a2 += DPP_MOVF(a2, 0x140); }
                if (fr == 0) { st_q[(16 * i + jj) * 2] = a1; st_q[(16 * i + jj) * 2 + 1] = a2; } } } }
        LDS_WAIT(); __syncthreads();
        if (tid < 64) { float a1 = 0.f, a2 = 0.f;
#pragma unroll
            for (int ww = 0; ww < 8; ++ww) { a1 += stats[(ww * 64 + tid) * 2]; a2 += stats[(ww * 64 + tid) * 2 + 1]; }
            const float mean = a1 * (1.f / 512.f), var = fmaxf(a2 * (1.f / 512.f) - mean * mean, 0.f); mr[2 * tid] = mean; mr[2 * tid + 1] = rsqrtf(var + 1e-5f); }
        LDS_WAIT(); __syncthreads();
        { LAS float* ytile = (LAS float*)lds; LAS float* yt_q = ytile + 4 * fq * 516 + 64 * w + fr; const LAS float* mr_q = mr + 8 * fq;
#pragma unroll
          for (int i = 0; i < 4; ++i)
#pragma unroll
            for (int jj = 0; jj < 4; ++jj) { const float mean = mr_q[(16 * i + jj) * 2], rstd = mr_q[(16 * i + jj) * 2 + 1];
#pragma unroll
                for (int e = 0; e < 4; ++e) yt_q[(16 * i + jj) * 516 + 16 * e] = (O[i][e][jj] - mean) * rstd; }
          LDS_WAIT(); __syncthreads();
          const int c8 = (tid & 63) * 8, cc = h * 512 + c8; float gm[8], sk[8];
#pragma unroll
          for (int q = 0; q < 8; ++q) { gm[q] = mh_g[cc + q]; sk[q] = skip[cc + q]; }
#pragma unroll
          for (int k8 = 0; k8 < 8; ++k8) { const int row = (tid >> 6) + 8 * k8; const size_t off = (t0 + row) * CI + cc;
              const v4u zr = *(const v4u*)(Z + off), xr = *(const v4u*)(XC + off); const f32x4 y0 = *(const LAS f32x4*)(ytile + row * 516 + c8), y1 = *(const LAS f32x4*)(ytile + row * 516 + c8 + 4);
              float zf[8], xf[8], o[8]; unpack8(zr, zf); unpack8(xr, xf);
#pragma unroll
              for (int q = 0; q < 8; ++q) { const float yv = q < 4 ? y0[q & 3] : y1[q & 3]; o[q] = (yv * gm[q] + sk[q] * xf[q]) * (zf[q] * sigm(zf[q])); }
              *(v4u*)(YC + off) = pack8(o); if (k8 & 1) asm volatile("" ::: "memory"); } }
        VM_WAIT(); __syncthreads();
    }
#undef ML_DMA
}
#define GEMM_PHASE(EPI, Aptr, Bptr, M_, N_, K_, ...) do { pg8::Gemm g{(const pg8::bf16_t*)(Aptr), (const pg8::bf16_t*)(Bptr), (M_), (N_), (K_)}; pg8::StaticOrder So; So.init((M_), (N_), F.G, F.bid); \
        pg8::EPI Ep{__VA_ARGS__}; pg8::gemm_phase<pg8::EPI, pg8::StaticOrder, PG8_ALIGN, PG8_SP2>(F.lds, g, So, Ep); } while (0)
namespace pg8 { typedef EpiRes2<float> EpiResF; typedef EpiRes2<bf16_t> EpiResB; typedef EpiPle2<false> EpiPleB; typedef EpiPle2<true> EpiPleF; }
__global__ void __launch_bounds__(NWAVES * 64, 2) trunk_fwd(Args args) {
    extern __shared__ __attribute__((aligned(16))) unsigned char lds_raw[];
    Frame F; F.lds = (LAS unsigned char*)lds_raw; F.ws = args.ws; F.in = nullptr;
    F.tid = threadIdx.x; F.lane = F.tid & 63; F.wave = __builtin_amdgcn_readfirstlane(F.tid >> 6); F.G = gridDim.x; F.bid = blockIdx.x;
    volatile LAS unsigned* MISC = (volatile LAS unsigned*)(F.lds + MISC_OFF);
    if (F.tid < 64) MISC[F.tid] = 0u;
    __syncthreads();
    XcdBarrier bar; bar.bar = (unsigned*)(args.ws + WS_CTL) + CW_BAR; bar.x = 0; bar.st = nullptr;
    if (args.use_bar) bar = xcd_barrier_post((unsigned*)(args.ws + WS_CTL) + CW_BAR, MISC + 8);
    unsigned* xrank = (unsigned*)(args.ws + WS_CTL) + CW_XRANK; const unsigned my_xcc = xb_xcc_id();
    if (args.use_bar && F.tid == 0) MISC[12] = xb_add(&xrank[64 * my_xcc], 1u);
    const int lo = args.ph_lo, hi = args.ph_hi;
#ifndef ONLY_SITE
#define ONLY_SITE -1
#endif
#define EN(n) (ONLY_SITE < 0 || ONLY_SITE == (n))
#ifndef REP_MASK
#define REP_MASK 0u
#endif
#define NREP(n) (((REP_MASK >> (n)) & 1u) ? 2 : 1)
#define IN(k) (lo <= (k) && (k) < hi)
#define SEAM(k) do { if (IN(k) && IN((k) + 1)) xcd_barrier(bar); } while (0)
    unsigned char* ws = args.ws; float* out = args.out;
    float* RS = (float*)(ws + WS_RS);
#define RSN(i) (RS + (size_t)(i) * T * 16)
#define PH(site, k, ...) if (EN(site) && IN(k)) { for (int rep_ = 0; rep_ < NREP(site); ++rep_) { if (rep_) xcd_barrier(bar); __VA_ARGS__ } } SEAM(k);
    PH(0, 0, phase_prologue(F, args); phase_cast_sq(F, args.in[0], (bf16*)(ws + WS_XB2), RSN(0), T); phase_cvt_p(F, args.in[1], (bf16*)(ws + WS_PB));)
    if (args.use_bar && lo == 0 && hi > 1) {
        bool ok = F.G == 256; for (int x = 0; x < 16; ++x) { const unsigned cx = xb_ld(&xrank[64 * x]); ok = ok && (cx == (x < 8 ? 32u : 0u)); }
        const unsigned rk = MISC[12]; if (ok && rk < 32u && my_xcc < 8u) F.bid = (int)(rk * 8u + my_xcc); }
    PH(2, 1, GEMM_PHASE(EpiBf16SplitR, ws + WS_XB2, ws + WS_WIN, T, NU, D, (pg8::bf16_t*)(ws + WS_UA), UA_W, 4, (pg8::bf16_t*)(ws + WS_UB), UB_W, RSN(0));)
    PH(3, 2, phase_prepA(F, args);)
    PH(4, 3, GEMM_PHASE(EpiBf16Split, ws + WS_LIN, ws + WS_WLORA, T, 1536, 256 + args.pad, (pg8::bf16_t*)(ws + WS_LOUT), 1536, 1 << 20, nullptr, 0);)
    PH(5, 4, phase_indexer(F);)
    PH(6, 5, phase_dsa_attn(F, args);)
    PH(7, 6, phase_rwkv(F, args);)
    PH(8, 7, GEMM_PHASE(EpiResF, ws + WS_XB, ws + WS_WOUT, T, D, D, args.in[0], (pg8::bf16_t*)(ws + WS_XB2), D, RSN(1));)
#define FFN_PLE(L, pb, rs_a, rs_b, rs_c, PLE_EPI, ple_out) do { const size_t lw = (size_t)(L) * WS_LAYER_STRIDE; \
        PH(21, (pb), GEMM_PHASE(EpiSwigluR, ws + WS_XB2, ws + WS_WGU0 + lw, T, 2 * FF, D, (pg8::bf16_t*)(ws + WS_H), FF, RSN(rs_a));) \
        PH(22, (pb) + 1, GEMM_PHASE(EpiResB, ws + WS_H, ws + WS_WD0 + lw, T, D, FF, (const pg8::bf16_t*)(ws + WS_XB2), (pg8::bf16_t*)(ws + WS_XB), D, RSN(rs_b));) \
        PH(24, (pb) + 2, GEMM_PHASE(EpiBf16Split, ws + WS_PB, ws + WS_WPLE0 + lw, T, D, 256 + args.pad, (pg8::bf16_t*)(ws + WS_E), D, 1 << 20, nullptr, 0);) \
        PH(25, (pb) + 3, GEMM_PHASE(PLE_EPI, ws + WS_XB, ws + WS_WPG0 + lw, T, D, D, (const pg8::bf16_t*)(ws + WS_XB), (void*)(ple_out), (const pg8::bf16_t*)(ws + WS_E), D, RSN(rs_b), RSN(rs_c));) } while (0)
#define L1_HALF(hb, p1) do { bf16* xbh = (bf16*)(ws + WS_XB2) + (size_t)(hb) * TH * D; \
        PH(11, (p1), GEMM_PHASE(EpiBf16SplitR, xbh, ws + WS_WUP, TH, 2 * CI, D, (pg8::bf16_t*)(ws + WS_XM), CI, 8, (pg8::bf16_t*)(ws + WS_Z), CI, RSN(3) + (size_t)(hb) * TH * 16);) \
        PH(12, (p1) + 1, phase_l1prep(F, args, hb);) \
        PH(13, (p1) + 2, phase_gatescan(F); if ((hb) == 0) phase_cvt_p(F, args.in[1] + (size_t)T * 256, (bf16*)(ws + WS_PB));) \
        PH(14, (p1) + 3, phase_mlstm(F, args);) \
        PH(15, (p1) + 4, GEMM_PHASE(EpiResB, ws + WS_XM, ws + WS_WDOWN, TH, D, CI, (const pg8::bf16_t*)xbh, (pg8::bf16_t*)xbh, D, RSN(4) + (size_t)(hb) * TH * 16);) } while (0)
    FFN_PLE(0, 8, 1, 2, 3, EpiPleB, ws + WS_XB2);
    L1_HALF(0, 12);
    L1_HALF(1, 17);
    FFN_PLE(1, 22, 4, 5, 5, EpiPleF, out);
#undef IN
#undef SEAM
}
constexpr int N_PHASES = 26;

#ifndef MK_ONE_LAUNCH
#define MK_ONE_LAUNCH 1
#endif
extern "C" void kernel_launch(void* const* d_in, const int* in_sizes, int n_in, void* d_out, int out_size, void* d_ws, size_t ws_size, hipStream_t stream) {
    static int grid = 0;
    if (grid == 0) {
        if (n_in != 37 || in_sizes[0] != T * D || out_size != T * D || ws_size < WS_END) { fprintf(stderr, "kernel_launch: unexpected shapes (n_in %d, in0 %d, out %d, ws %zu < %zu); nothing launched\n", n_in, n_in > 0 ? in_sizes[0] : -1, out_size, ws_size, (size_t)WS_END); grid = -1; return; }
        int dev = 0, cus = 0, per_cu = 0;
        if (hipGetDevice(&dev) != hipSuccess || hipDeviceGetAttribute(&cus, hipDeviceAttributeMultiprocessorCount, dev) != hipSuccess) { grid = -1; return; }
        if (hipFuncSetAttribute((const void*)trunk_fwd, hipFuncAttributeMaxDynamicSharedMemorySize, LDS_BYTES) != hipSuccess) { fprintf(stderr, "kernel_launch: hipFuncSetAttribute failed\n"); grid = -1; return; }
        if (hipOccupancyMaxActiveBlocksPerMultiprocessor(&per_cu, (const void*)trunk_fwd, NWAVES * 64, LDS_BYTES) != hipSuccess || per_cu < 1) { fprintf(stderr, "kernel_launch: occupancy query says %d\n", per_cu); }
        (void)hipGetLastError();
        grid = cus;
        if (grid != 256) { fprintf(stderr, "kernel_launch: built for 256 CUs, found %d; nothing launched\n", cus); grid = -1; return; }
    }
    if (grid < 0) return;
    if (hipMemsetAsync((char*)d_ws + WS_CTL, 0, CTL_ZERO_BYTES, stream) != hipSuccess) return;
    Args a{};
    for (int i = 0; i < 37; ++i) a.in[i] = (const float*)d_in[i];
    a.out = (float*)d_out; a.ws = (unsigned char*)d_ws; a.pad = 0;
#if MK_ONE_LAUNCH
    a.ph_lo = 0; a.ph_hi = N_PHASES; a.use_bar = 1;
    hipLaunchKernelGGL(trunk_fwd, dim3(grid), dim3(NWAVES * 64), LDS_BYTES, stream, a);
#else
    for (int p = 0; p < N_PHASES; ++p) { a.ph_lo = p; a.ph_hi = p + 1; a.use_bar = 0; hipLaunchKernelGGL(trunk_fwd, dim3(grid), dim3(NWAVES * 64), LDS_BYTES, stream, a); }
#endif
}
```

```cpp
#include <hip/hip_runtime.h>
#include <cstdio>
#include <cstdint>
namespace pg8 {
#define PG8_LAS __attribute__((address_space(3)))
typedef unsigned short bf16_t;
typedef short bf16x8 __attribute__((ext_vector_type(8)));
typedef float f32x4 __attribute__((ext_vector_type(4)));
typedef unsigned u32x4 __attribute__((ext_vector_type(4)));
constexpr int BM = 256, BK = 64, HALF = 128, HTB = HALF * BK * 2  , STAGE_BYTES = 8 * HTB, NXCD = 8, WGM = 8;

__host__ __device__ __forceinline__ int lds_byte(int r, int c) { const int st = (r >> 4) * 2 + (c >> 5), rr = r & 15, cc = c & 31, ob = rr * 64 + cc * 2; return st * 1024 + (ob ^ (((ob >> 9) & 1) << 5)); }
__host__ __device__ __forceinline__ void stage_rc(int b, int& R, int& C) { const int st = b / 1024, sb = b % 1024, swz = sb ^ (((sb >> 9) & 1) << 5); R = (st >> 1) * 16 + swz / 64; C = (st & 1) * 32 + (swz % 64) / 2; }
__host__ __device__ __forceinline__ int perm32(int rho) { const int n = rho >> 4, i = rho & 15; return 8 * (i >> 2) + 4 * n + (i & 3); }

struct Unit { int pm, pn; };
struct Gemm { const bf16_t* A; const bf16_t* Bt; int M, N, K; };

struct StaticOrder {
    int nM, nN, nwg, G, c;
    __host__ __device__ void init(int M, int N, int G_, int c_) { nM = M / BM; nN = N / BM; nwg = nM * nN; G = G_; c = c_; }
    __host__ __device__ bool next(int i, Unit& u) const {
        const long L = (long)i * G + c; if (L >= nwg) return false;
        int wgid = (int)L; { const int q = nwg / NXCD, r = nwg % NXCD, xcd = wgid % NXCD, off = wgid / NXCD; wgid = (xcd < r ? xcd * (q + 1) : r * (q + 1) + (xcd - r) * q) + off; }
        const int nig = WGM * nN, gid = wgid / nig, fm = gid * WGM, gsz = (nM - fm) < WGM ? (nM - fm) : WGM;
        u.pm = fm + ((wgid % nig) % gsz); u.pn = (wgid % nig) / gsz; return true;
    }
    __device__ __forceinline__ void a_ready(const Unit&) const {}
    __device__ __forceinline__ void done(const Unit&) const {}
};

__device__ __forceinline__ unsigned cvt_pk_bf16(float lo, float hi) { unsigned r; asm volatile("v_cvt_pk_bf16_f32 %0, %1, %2" : "=v"(r) : "v"(lo), "v"(hi)); return r; }
typedef float f32x2 __attribute__((ext_vector_type(2)));
__device__ __forceinline__ f32x2 gelu_pk(f32x2 v) {
    const f32x2 av = __builtin_elementwise_abs(v), d = av * 0.2316418882f + 1.0f;
    f32x2 t; t.x = __builtin_amdgcn_rcpf(d.x); t.y = __builtin_amdgcn_rcpf(d.y);
    f32x2 q = t * 0.5307027145f + (-0.7265760135f); q = q * t + 0.7107068705f; q = q * t + (-0.142248368f); q = q * t + 0.127414796f; q = q * t;
    const f32x2 s = (v * v) * (-0.72134752044f);
    f32x2 e; e.x = __builtin_amdgcn_exp2f(s.x); e.y = __builtin_amdgcn_exp2f(s.y);
    const f32x2 m = v * (q * e), r = v - m;
    f32x2 o; o.x = v.x < 0.f ? m.x : r.x; o.y = v.y < 0.f ? m.y : r.y; return o;
}

template <class Epi, class Sched, bool ALIGN_EPI = false, bool SP2 = false>
__device__ __forceinline__ void gemm_phase(PG8_LAS unsigned char* lds, const Gemm g, const Sched& S, const Epi& E) {
    const int tid = threadIdx.x, wid = __builtin_amdgcn_readfirstlane(tid >> 6), lane = tid & 63, wr = wid >> 2, wc = wid & 3, fr = lane & 15, fq = lane >> 4;
    const int K = g.K, nt = K / BK;
    unsigned voffA[2], voffB[2];
#pragma unroll
    for (int i = 0; i < 2; ++i) { int R, C; stage_rc(tid * 16 + i * 8192, R, C); const int Rb = Epi::PERM ? ((R & ~31) + perm32(R & 31)) : R;
        voffA[i] = (unsigned)(R * K + C) * 2u; voffB[i] = (unsigned)(Rb * K + C) * 2u; }
    const size_t kstep = (size_t)(BK * 2);
    const size_t hstep = (size_t)HALF * K * 2;
    const size_t tstep = 2 * hstep;
    const unsigned ldsw = (unsigned)wid * 1024u;
    const int aoff = lds_byte(wr * 64 + fr, fq * 8), boff = lds_byte(wc * 32 + fr, fq * 8);
#define PG8_SA(b, h) (((b) * 2 + (h)) * HTB)
#define PG8_SB(b, h) ((4 + (b) * 2 + (h)) * HTB)
#define PG8_STAGE(bufoff, gbase, voff) do { _Pragma("unroll") for (int _i = 0; _i < 2; ++_i) \
        __builtin_amdgcn_global_load_lds((const unsigned*)((const char*)(gbase) + (voff)[_i]), (PG8_LAS unsigned*)(lds + (bufoff) + ldsw + _i * 8192), 16, 0, 0); } while (0)
#define PG8_LDA(dst, b, h) do { _Pragma("unroll") for (int m = 0; m < 4; ++m) _Pragma("unroll") for (int k = 0; k < 2; ++k) dst[m][k] = *(const PG8_LAS bf16x8*)(lds + PG8_SA(b, h) + aoff + m * 2048 + k * 1024); } while (0)
#define PG8_LDB(dst, b, h) do { _Pragma("unroll") for (int n = 0; n < 2; ++n) _Pragma("unroll") for (int k = 0; k < 2; ++k) dst[n][k] = *(const PG8_LAS bf16x8*)(lds + PG8_SB(b, h) + boff + n * 2048 + k * 1024); } while (0)
#define PG8_MMA(ai, bj, At, Bt) do { __builtin_amdgcn_s_setprio(1); _Pragma("unroll") for (int m = 0; m < 4; ++m) _Pragma("unroll") for (int n = 0; n < 2; ++n) _Pragma("unroll") for (int k = 0; k < 2; ++k) \
        acc[ai][bj][m][n] = __builtin_amdgcn_mfma_f32_16x16x32_bf16(Bt[n][k], At[m][k], acc[ai][bj][m][n], 0, 0, 0); __builtin_amdgcn_s_setprio(0); } while (0)
#define PG8_WAIT_V(n) asm volatile("s_waitcnt vmcnt(" #n ")" ::: "memory")
#define PG8_WAIT_L(n) asm volatile("s_waitcnt lgkmcnt(" #n ")" ::: "memory")
#define PG8_BAR __builtin_amdgcn_s_barrier()
#define PG8_SCHED __builtin_amdgcn_sched_barrier(0)
    Unit cur, nxt; int ui = 0;
    if (!S.next(0, cur)) return;
    f32x4 acc[2][2][4][2];
#pragma unroll
    for (int a = 0; a < 2; ++a)
#pragma unroll
        for (int b = 0; b < 2; ++b)
#pragma unroll
            for (int m = 0; m < 4; ++m)
#pragma unroll
                for (int n = 0; n < 2; ++n) acc[a][b][m][n] = (f32x4){0.f, 0.f, 0.f, 0.f};
    bf16x8 At[4][2], B0[2][2], B1[2][2];
    const char* cA = (const char*)g.A + (size_t)cur.pm * tstep; const char* cB = (const char*)g.Bt + (size_t)cur.pn * tstep;
    S.a_ready(cur);
    if constexpr (SP2) {
        PG8_STAGE(PG8_SB(0, 0), cB, voffB); PG8_STAGE(PG8_SB(0, 1), cB + hstep, voffB); PG8_STAGE(PG8_SA(0, 0), cA, voffA); PG8_STAGE(PG8_SA(0, 1), cA + hstep, voffA);
        if (wr == 1) PG8_BAR;
        PG8_WAIT_V(2); PG8_BAR;
        PG8_STAGE(PG8_SB(1, 0), cB + kstep, voffB); PG8_STAGE(PG8_SA(1, 0), cA + kstep, voffA); PG8_STAGE(PG8_SB(1, 1), cB + hstep + kstep, voffB);
        PG8_WAIT_V(6); PG8_BAR;
    } else {
        PG8_STAGE(PG8_SB(0, 0), cB, voffB); PG8_STAGE(PG8_SA(0, 0), cA, voffA); PG8_STAGE(PG8_SB(0, 1), cB + hstep, voffB); PG8_STAGE(PG8_SA(0, 1), cA + hstep, voffA);
        if (wr == 1) PG8_BAR;
        PG8_WAIT_V(4); PG8_BAR;
        PG8_STAGE(PG8_SB(1, 0), cB + kstep, voffB); PG8_STAGE(PG8_SA(1, 0), cA + kstep, voffA); PG8_STAGE(PG8_SB(1, 1), cB + hstep + kstep, voffB);
        PG8_WAIT_V(6); PG8_BAR;
    }
    for (;;) {
        const bool has_next = S.next(ui + 1, nxt);
        const char* nA = has_next ? (const char*)g.A + (size_t)nxt.pm * tstep : cA; const char* nB = has_next ? (const char*)g.Bt + (size_t)nxt.pn * tstep : cB;
        for (int t = 0; t < nt; t += 2) {
            const bool last = (t == nt - 2);
            const char* a1 = cA + (size_t)(t + 1) * kstep;
            const char* a2 = last ? nA : cA + (size_t)(t + 2) * kstep; const char* b2 = last ? nB : cB + (size_t)(t + 2) * kstep;
            const char* a3 = a2 + kstep; const char* b3 = b2 + kstep;
            if (last && has_next) S.a_ready(nxt);
            if constexpr (SP2) {
            PG8_LDB(B0, 0, 0); PG8_LDB(B1, 0, 1); PG8_SCHED; PG8_LDA(At, 0, 0); PG8_STAGE(PG8_SA(1, 1), a1 + hstep, voffA);
            PG8_WAIT_V(8); PG8_WAIT_L(0); PG8_BAR; PG8_MMA(0, 0, At, B0); PG8_MMA(0, 1, At, B1); PG8_BAR; PG8_SCHED;
            PG8_LDA(At, 0, 1); PG8_STAGE(PG8_SB(0, 0), b2, voffB); PG8_STAGE(PG8_SB(0, 1), b2 + hstep, voffB); PG8_STAGE(PG8_SA(0, 0), a2, voffA);
            PG8_WAIT_V(8); PG8_WAIT_L(0); PG8_BAR; PG8_MMA(1, 0, At, B0); PG8_MMA(1, 1, At, B1); PG8_BAR; PG8_SCHED;
            PG8_LDB(B0, 1, 0); PG8_LDB(B1, 1, 1); PG8_SCHED; PG8_LDA(At, 1, 0); PG8_STAGE(PG8_SA(0, 1), a2 + hstep, voffA);
            PG8_WAIT_V(8); PG8_WAIT_L(0); PG8_BAR; PG8_MMA(0, 0, At, B0); PG8_MMA(0, 1, At, B1); PG8_BAR; PG8_SCHED;
            PG8_LDA(At, 1, 1); PG8_STAGE(PG8_SB(1, 0), b3, voffB); PG8_STAGE(PG8_SB(1, 1), b3 + hstep, voffB); PG8_STAGE(PG8_SA(1, 0), a3, voffA);
            PG8_WAIT_V(8); PG8_WAIT_L(0); PG8_BAR; PG8_MMA(1, 0, At, B0); PG8_MMA(1, 1, At, B1); PG8_BAR; PG8_SCHED;
            } else {
            PG8_LDB(B0, 0, 0); PG8_SCHED; PG8_LDA(At, 0, 0); PG8_STAGE(PG8_SA(1, 1), a1 + hstep, voffA);
            PG8_WAIT_L(8); PG8_BAR; PG8_WAIT_L(0); PG8_MMA(0, 0, At, B0); PG8_BAR; PG8_SCHED;
            PG8_LDB(B1, 0, 1); PG8_STAGE(PG8_SB(0, 0), b2, voffB);
            PG8_BAR; PG8_WAIT_L(0); PG8_MMA(0, 1, At, B1); PG8_BAR;
            PG8_LDA(At, 0, 1); PG8_STAGE(PG8_SA(0, 0), a2, voffA);
            PG8_BAR; PG8_WAIT_L(0); PG8_MMA(1, 0, At, B0); PG8_BAR; PG8_SCHED;
            PG8_STAGE(PG8_SB(0, 1), b2 + hstep, voffB);
            PG8_WAIT_V(6); PG8_BAR; PG8_MMA(1, 1, At, B1); PG8_BAR;
            PG8_LDB(B0, 1, 0); PG8_SCHED; PG8_LDA(At, 1, 0); PG8_STAGE(PG8_SA(0, 1), a2 + hstep, voffA);
            PG8_WAIT_L(8); PG8_BAR; PG8_WAIT_L(0); PG8_MMA(0, 0, At, B0); PG8_BAR; PG8_SCHED;
            PG8_LDB(B1, 1, 1); PG8_STAGE(PG8_SB(1, 0), b3, voffB);
            PG8_BAR; PG8_WAIT_L(0); PG8_MMA(0, 1, At, B1); PG8_BAR;
            PG8_LDA(At, 1, 1); PG8_STAGE(PG8_SA(1, 0), a3, voffA);
            PG8_BAR; PG8_WAIT_L(0); PG8_MMA(1, 0, At, B0); PG8_BAR; PG8_SCHED;
            PG8_STAGE(PG8_SB(1, 1), b3 + hstep, voffB);
            PG8_WAIT_V(6); PG8_BAR; PG8_MMA(1, 1, At, B1); PG8_BAR;
            }
        }
        if constexpr (ALIGN_EPI) { if (wr == 0) PG8_BAR; }
        if constexpr (!Epi::AFTER_DRAIN) { E(acc, cur, wr, wc, fr, fq); S.done(cur); }
        if (!has_next) break;
#pragma unroll
        for (int a = 0; a < 2; ++a)
#pragma unroll
            for (int b = 0; b < 2; ++b)
#pragma unroll
                for (int m = 0; m < 4; ++m)
#pragma unroll
                    for (int n = 0; n < 2; ++n) acc[a][b][m][n] = (f32x4){0.f, 0.f, 0.f, 0.f};
        cur = nxt; cA = nA; cB = nB; ++ui;
        if constexpr (ALIGN_EPI) { if (wr == 1) PG8_BAR; }
    }
    PG8_WAIT_V(0);
    if constexpr (!ALIGN_EPI) { if (wr == 0) PG8_BAR; }
    PG8_BAR;
    if constexpr (Epi::AFTER_DRAIN) { E.fused(acc, cur, wr, wc, fr, fq, lds, wid, lane); S.done(cur); }
#undef PG8_SA
#undef PG8_SB
#undef PG8_STAGE
#undef PG8_LDA
#undef PG8_LDB
#undef PG8_MMA
#undef PG8_WAIT_V
#undef PG8_WAIT_L
#undef PG8_BAR
#undef PG8_SCHED
}
}
namespace pg8 {
__device__ __forceinline__ float sigmoidf_(float x) { return __builtin_amdgcn_rcpf(1.0f + __builtin_amdgcn_exp2f(-1.4426950408889634f * x)); }
struct EpiBf16Split {
    static constexpr bool PERM = true, AFTER_DRAIN = false;
    bf16_t* O0; int ld0; int nt0; bf16_t* O1; int ld1;
    __device__ __forceinline__ void operator()(const f32x4 (&acc)[2][2][4][2], const Unit& u, int wr, int wc, int fr, int fq) const {
        const bool first = u.pn < nt0; bf16_t* base = first ? O0 : O1; const int ld = first ? ld0 : ld1; const int colt = (first ? u.pn : u.pn - nt0) * BM;
        const int row0 = u.pm * BM + wr * 64 + fr, col0 = colt + wc * 32 + 8 * fq;
#pragma unroll
        for (int ai = 0; ai < 2; ++ai)
#pragma unroll
            for (int m = 0; m < 4; ++m) { bf16_t* rowp = base + (size_t)(row0 + ai * HALF + m * 16) * ld + col0;
#pragma unroll
                for (int bj = 0; bj < 2; ++bj) { const f32x4 v0 = acc[ai][bj][m][0], v1 = acc[ai][bj][m][1];
                    u32x4 w; w.x = cvt_pk_bf16(v0[0], v0[1]); w.y = cvt_pk_bf16(v0[2], v0[3]); w.z = cvt_pk_bf16(v1[0], v1[1]); w.w = cvt_pk_bf16(v1[2], v1[3]);
                    *(u32x4*)(rowp + bj * HALF) = w; } }
    }
};
struct EpiResF32 {
    static constexpr bool PERM = false, AFTER_DRAIN = false;
    const float* base; float* out; int ldc;
    __device__ __forceinline__ void operator()(const f32x4 (&acc)[2][2][4][2], const Unit& u, int wr, int wc, int fr, int fq) const {
        const int row0 = u.pm * BM + wr * 64 + fr, col0 = u.pn * BM + wc * 32 + 4 * fq;
#pragma unroll
        for (int ai = 0; ai < 2; ++ai)
#pragma unroll
            for (int m = 0; m < 4; ++m) { const size_t off = (size_t)(row0 + ai * HALF + m * 16) * ldc + col0;
#pragma unroll
                for (int bj = 0; bj < 2; ++bj)
#pragma unroll
                    for (int n = 0; n < 2; ++n) { const f32x4 b = *(const f32x4*)(base + off + bj * HALF + n * 16); *(f32x4*)(out + off + bj * HALF + n * 16) = b + acc[ai][bj][m][n]; } }
    }
};
struct EpiSwiglu {
    static constexpr bool PERM = false, AFTER_DRAIN = false;
    bf16_t* H; int ldh;
    __device__ __forceinline__ void operator()(const f32x4 (&acc)[2][2][4][2], const Unit& u, int wr, int wc, int fr, int fq) const {
        const int row0 = u.pm * BM + wr * 64 + fr, hc0 = u.pn * (BM / 2) + wc * 16 + 4 * fq;
#pragma unroll
        for (int ai = 0; ai < 2; ++ai)
#pragma unroll
            for (int m = 0; m < 4; ++m) { bf16_t* rowp = H + (size_t)(row0 + ai * HALF + m * 16) * ldh + hc0;
#pragma unroll
                for (int bj = 0; bj < 2; ++bj) { const f32x4 g = acc[ai][bj][m][0], up = acc[ai][bj][m][1]; float h[4];
#pragma unroll
                    for (int i = 0; i < 4; ++i) h[i] = g[i] * sigmoidf_(g[i]) * up[i];
                    typedef unsigned u32x2 __attribute__((ext_vector_type(2)));
                    u32x2 w; w.x = cvt_pk_bf16(h[0], h[1]); w.y = cvt_pk_bf16(h[2], h[3]);
                    *(u32x2*)(rowp + bj * (HALF / 2)) = w; } }
    }
};
struct EpiPle {
    static constexpr bool PERM = false, AFTER_DRAIN = false;
    const float* base; float* out; const bf16_t* E; int ldc;
    __device__ __forceinline__ void operator()(const f32x4 (&acc)[2][2][4][2], const Unit& u, int wr, int wc, int fr, int fq) const {
        const int row0 = u.pm * BM + wr * 64 + fr, col0 = u.pn * BM + wc * 32 + 4 * fq;
        typedef unsigned u32x2 __attribute__((ext_vector_type(2)));
#pragma unroll
        for (int ai = 0; ai < 2; ++ai)
#pragma unroll
            for (int m = 0; m < 4; ++m) { const size_t off = (size_t)(row0 + ai * HALF + m * 16) * ldc + col0;
#pragma unroll
                for (int bj = 0; bj < 2; ++bj)
#pragma unroll
                    for (int n = 0; n < 2; ++n) { const size_t o = off + bj * HALF + n * 16; const f32x4 b = *(const f32x4*)(base + o); const u32x2 e = *(const u32x2*)(E + o); const f32x4 a = acc[ai][bj][m][n];
                        f32x4 r; r[0] = b[0] + __uint_as_float(e.x << 16) * sigmoidf_(a[0]); r[1] = b[1] + __uint_as_float(e.x & 0xffff0000u) * sigmoidf_(a[1]);
                        r[2] = b[2] + __uint_as_float(e.y << 16) * sigmoidf_(a[2]); r[3] = b[3] + __uint_as_float(e.y & 0xffff0000u) * sigmoidf_(a[3]);
                        *(f32x4*)(out + o) = r; } }
    }
};
__device__ __forceinline__ float rms_r(const float* rsq, int row) { const f32x4* p = (const f32x4*)(rsq + (size_t)row * 16); const f32x4 a = p[0], b = p[1], c = p[2], d = p[3];
    const float s = (((a[0] + a[1]) + (a[2] + a[3])) + ((b[0] + b[1]) + (b[2] + b[3]))) + (((c[0] + c[1]) + (c[2] + c[3])) + ((d[0] + d[1]) + (d[2] + d[3]))); return rsqrtf(s * (1.0f / 1024.0f) + 1e-6f); }
__device__ __forceinline__ void norm_out(const f32x4 (&x)[2][2], bf16_t* xb, size_t off, float* rsq_out, int row, int fq, int slot) {
    typedef unsigned u32x2 __attribute__((ext_vector_type(2))); float s = 0.f;
#pragma unroll
    for (int bj = 0; bj < 2; ++bj)
#pragma unroll
        for (int n = 0; n < 2; ++n) { const f32x4 v = x[bj][n]; s += (v[0] * v[0] + v[1] * v[1]) + (v[2] * v[2] + v[3] * v[3]); u32x2 w; w.x = cvt_pk_bf16(v[0], v[1]); w.y = cvt_pk_bf16(v[2], v[3]); *(u32x2*)(xb + off + bj * HALF + n * 16) = w; }
    s += __shfl_xor(s, 16); s += __shfl_xor(s, 32);
    if (fq == 0) rsq_out[(size_t)row * 16 + slot] = s;
}
struct EpiBf16SplitR {
    static constexpr bool PERM = true, AFTER_DRAIN = false;
    bf16_t* O0; int ld0; int nt0; bf16_t* O1; int ld1; const float* rsq;
    __device__ __forceinline__ void operator()(const f32x4 (&acc)[2][2][4][2], const Unit& u, int wr, int wc, int fr, int fq) const {
        const bool first = u.pn < nt0; bf16_t* base = first ? O0 : O1; const int ld = first ? ld0 : ld1; const int colt = (first ? u.pn : u.pn - nt0) * BM;
        const int row0 = u.pm * BM + wr * 64 + fr, col0 = colt + wc * 32 + 8 * fq;
#pragma unroll
        for (int ai = 0; ai < 2; ++ai)
#pragma unroll
            for (int m = 0; m < 4; ++m) { const int row = row0 + ai * HALF + m * 16; const float r = rms_r(rsq, row); bf16_t* rowp = base + (size_t)row * ld + col0;
#pragma unroll
                for (int bj = 0; bj < 2; ++bj) { const f32x4 v0 = acc[ai][bj][m][0] * r, v1 = acc[ai][bj][m][1] * r;
                    u32x4 w; w.x = cvt_pk_bf16(v0[0], v0[1]); w.y = cvt_pk_bf16(v0[2], v0[3]); w.z = cvt_pk_bf16(v1[0], v1[1]); w.w = cvt_pk_bf16(v1[2], v1[3]);
                    *(u32x4*)(rowp + bj * HALF) = w; } }
    }
};
struct EpiSwigluR {
    static constexpr bool PERM = false, AFTER_DRAIN = false;
    bf16_t* H; int ldh; const float* rsq;
    __device__ __forceinline__ void operator()(const f32x4 (&acc)[2][2][4][2], const Unit& u, int wr, int wc, int fr, int fq) const {
        const int row0 = u.pm * BM + wr * 64 + fr, hc0 = u.pn * (BM / 2) + wc * 16 + 4 * fq;
#pragma unroll
        for (int ai = 0; ai < 2; ++ai)
#pragma unroll
            for (int m = 0; m < 4; ++m) { const int row = row0 + ai * HALF + m * 16; const float r = rms_r(rsq, row); bf16_t* rowp = H + (size_t)row * ldh + hc0;
#pragma unroll
                for (int bj = 0; bj < 2; ++bj) { const f32x4 g = acc[ai][bj][m][0] * r, up = acc[ai][bj][m][1] * r; float h[4];
#pragma unroll
                    for (int i = 0; i < 4; ++i) h[i] = g[i] * sigmoidf_(g[i]) * up[i];
                    typedef unsigned u32x2 __attribute__((ext_vector_type(2)));
                    u32x2 w; w.x = cvt_pk_bf16(h[0], h[1]); w.y = cvt_pk_bf16(h[2], h[3]);
                    *(u32x2*)(rowp + bj * (HALF / 2)) = w; } }
    }
};
struct EpiResN {
    static constexpr bool PERM = false, AFTER_DRAIN = false;
    const float* base; float* out; int ldc; bf16_t* XBo; float* rsq_out;
    __device__ __forceinline__ void operator()(const f32x4 (&acc)[2][2][4][2], const Unit& u, int wr, int wc, int fr, int fq) const {
        const int row0 = u.pm * BM + wr * 64 + fr, col0 = u.pn * BM + wc * 32 + 4 * fq;
#pragma unroll
        for (int ai = 0; ai < 2; ++ai)
#pragma unroll
            for (int m = 0; m < 4; ++m) { const int row = row0 + ai * HALF + m * 16; const size_t off = (size_t)row * ldc + col0; f32x4 x[2][2];
#pragma unroll
                for (int bj = 0; bj < 2; ++bj)
#pragma unroll
                    for (int n = 0; n < 2; ++n) { const f32x4 b = *(const f32x4*)(base + off + bj * HALF + n * 16); x[bj][n] = b + acc[ai][bj][m][n]; *(f32x4*)(out + off + bj * HALF + n * 16) = x[bj][n]; }
                if (XBo) norm_out(x, XBo, off, rsq_out, row, fq, u.pn * 4 + wc); }
    }
};
struct EpiPleN {
    static constexpr bool PERM = false, AFTER_DRAIN = false;
    const float* base; float* out; const bf16_t* E; int ldc; const float* rsq_in; bf16_t* XBo; float* rsq_out;
    __device__ __forceinline__ void operator()(const f32x4 (&acc)[2][2][4][2], const Unit& u, int wr, int wc, int fr, int fq) const {
        const int row0 = u.pm * BM + wr * 64 + fr, col0 = u.pn * BM + wc * 32 + 4 * fq;
        typedef unsigned u32x2 __attribute__((ext_vector_type(2)));
#pragma unroll
        for (int ai = 0; ai < 2; ++ai)
#pragma unroll
            for (int m = 0; m < 4; ++m) { const int row = row0 + ai * HALF + m * 16; const size_t off = (size_t)row * ldc + col0; const float r = rms_r(rsq_in, row); f32x4 x[2][2];
#pragma unroll
                for (int bj = 0; bj < 2; ++bj)
#pragma unroll
                    for (int n = 0; n < 2; ++n) { const size_t o = off + bj * HALF + n * 16; const f32x4 b = *(const f32x4*)(base + o); const u32x2 e = *(const u32x2*)(E + o); const f32x4 a = acc[ai][bj][m][n] * r;
                        f32x4 v; v[0] = b[0] + __uint_as_float(e.x << 16) * sigmoidf_(a[0]); v[1] = b[1] + __uint_as_float(e.x & 0xffff0000u) * sigmoidf_(a[1]);
                        v[2] = b[2] + __uint_as_float(e.y << 16) * sigmoidf_(a[2]); v[3] = b[3] + __uint_as_float(e.y & 0xffff0000u) * sigmoidf_(a[3]);
                        x[bj][n] = v; *(f32x4*)(out + o) = v; }
                if (XBo) norm_out(x, XBo, off, rsq_out, row, fq, u.pn * 4 + wc); }
    }
};
__device__ __forceinline__ f32x4 ld_base4(const float* p) { return *(const f32x4*)p; }
__device__ __forceinline__ f32x4 ld_base4(const bf16_t* p) { typedef unsigned u32x2 __attribute__((ext_vector_type(2))); const u32x2 e = *(const u32x2*)p; return (f32x4){__uint_as_float(e.x << 16), __uint_as_float(e.x & 0xffff0000u), __uint_as_float(e.y << 16), __uint_as_float(e.y & 0xffff0000u)}; }
template <class BaseT> struct EpiRes2 {
    static constexpr bool PERM = false, AFTER_DRAIN = false;
    const BaseT* base; bf16_t* out; int ldc; float* rsq_out;
    __device__ __forceinline__ void operator()(const f32x4 (&acc)[2][2][4][2], const Unit& u, int wr, int wc, int fr, int fq) const {
        const int row0 = u.pm * BM + wr * 64 + fr, col0 = u.pn * BM + wc * 32 + 4 * fq;
#pragma unroll
        for (int ai = 0; ai < 2; ++ai)
#pragma unroll
            for (int m = 0; m < 4; ++m) { const int row = row0 + ai * HALF + m * 16; const size_t off = (size_t)row * ldc + col0; f32x4 x[2][2];
#pragma unroll
                for (int bj = 0; bj < 2; ++bj)
#pragma unroll
                    for (int n = 0; n < 2; ++n) x[bj][n] = ld_base4(base + off + bj * HALF + n * 16) + acc[ai][bj][m][n];
                norm_out(x, out, off, rsq_out, row, fq, u.pn * 4 + wc); }
    }
};
template <bool OUT_F32> struct EpiPle2 {
    static constexpr bool PERM = false, AFTER_DRAIN = false;
    const bf16_t* base; void* out; const bf16_t* E; int ldc; const float* rsq_in; float* rsq_out;
    __device__ __forceinline__ void operator()(const f32x4 (&acc)[2][2][4][2], const Unit& u, int wr, int wc, int fr, int fq) const {
        const int row0 = u.pm * BM + wr * 64 + fr, col0 = u.pn * BM + wc * 32 + 4 * fq;
#pragma unroll
        for (int ai = 0; ai < 2; ++ai)
#pragma unroll
            for (int m = 0; m < 4; ++m) { const int row = row0 + ai * HALF + m * 16; const size_t off = (size_t)row * ldc + col0; const float r = rms_r(rsq_in, row); f32x4 x[2][2];
#pragma unroll
                for (int bj = 0; bj < 2; ++bj)
#pragma unroll
                    for (int n = 0; n < 2; ++n) { const size_t o = off + bj * HALF + n * 16; const f32x4 b = ld_base4(base + o), e = ld_base4(E + o), a = acc[ai][bj][m][n] * r; f32x4 v;
#pragma unroll
                        for (int i = 0; i < 4; ++i) v[i] = b[i] + e[i] * sigmoidf_(a[i]);
                        x[bj][n] = v; if (OUT_F32) *(f32x4*)((float*)out + o) = v; }
                if (!OUT_F32) norm_out(x, (bf16_t*)out, off, rsq_out, row, fq, u.pn * 4 + wc); }
    }
};
}
#ifndef PG8_SP2
#define PG8_SP2 true
#endif
#ifndef PG8_ALIGN
#define PG8_ALIGN true
#endif
constexpr int NB = 32, SEQ = 2048, T = NB * SEQ, D = 1024;
constexpr int NU = 2816, UA_W = 1024, UB_W = 1792;
constexpr int FF = 2816, CI = 2048, TH = T / 2;
constexpr int NWAVES = 8;
constexpr float NORM_EPS = 1e-6f, LOG2E = 1.4426950408889634f;
constexpr int UA_K = 512, UA_V = 576, UA_IQ = 640, UA_IK = 896, UA_IW = 960;
constexpr size_t MiB = 1u << 20, QMiB = 1u << 18;
constexpr size_t WS_CTL = 0, CTL_ZERO_BYTES = 1 * MiB;
constexpr size_t WS_WIN = 4 * QMiB, WS_WLORA = 26 * QMiB, WS_WOUT = 29 * QMiB;
constexpr size_t WS_WGU0 = 37 * QMiB, WS_WD0 = 81 * QMiB, WS_WPLE0 = 103 * QMiB, WS_WPG0 = 105 * QMiB, WS_LAYER_STRIDE = 76 * QMiB;
constexpr size_t WS_WUP = 189 * QMiB, WS_WDOWN = 221 * QMiB, WS_W12 = 237 * QMiB;
static_assert(WS_WPG0 + 8 * QMiB == WS_WGU0 + WS_LAYER_STRIDE && WS_WPG0 + WS_LAYER_STRIDE + 8 * QMiB == WS_WUP && WS_W12 + QMiB <= 60 * MiB, "weight map");
constexpr size_t ACT = 60 * MiB;
constexpr size_t WS_XB = ACT, WS_UA = ACT + 128 * MiB, WS_UB = ACT + 256 * MiB, WS_LIN = ACT + 480 * MiB, WS_LOUT = ACT + 512 * MiB;
constexpr size_t WS_QN = ACT + 704 * MiB, WS_KN = ACT + 768 * MiB, WS_VT = ACT + 776 * MiB, WS_MASK = ACT + 784 * MiB;
constexpr size_t WS_XB2 = ACT + 768 * MiB;
constexpr size_t WS_H = ACT + 128 * MiB, WS_E = ACT + 480 * MiB, WS_PB = ACT + 896 * MiB;
constexpr size_t WS_XM = ACT, WS_Z = ACT + 128 * MiB, WS_XC = ACT + 256 * MiB, WS_Q = ACT + 384 * MiB, WS_K = ACT + 512 * MiB, WS_V = ACT + 640 * MiB;
constexpr size_t WS_RS = ACT + 928 * MiB, RS_ONE = (size_t)T * 16 * 4;
constexpr size_t WS_GI = ACT + 952 * MiB, WS_GA = WS_GI + 1 * MiB, WS_GAM = WS_GI + 2 * MiB, WS_GEM = WS_GI + 3 * MiB;
constexpr size_t WS_END = ACT + 956 * MiB;
static_assert(WS_END <= 1024 * MiB, "workspace");
constexpr int CW_TMO = 0, CW_BAR = 4096, CW_XRANK = 8192;
constexpr int LDS_BYTES = 155648;
constexpr int MISC_OFF = LDS_BYTES - 256;
#define GAS __attribute__((address_space(1)))
#define LAS __attribute__((address_space(3)))
typedef unsigned short bf16;
typedef unsigned v4u __attribute__((ext_vector_type(4)));
typedef unsigned v2u __attribute__((ext_vector_type(2)));
typedef float f32x4 __attribute__((ext_vector_type(4)));
typedef float f32x2 __attribute__((ext_vector_type(2)));
typedef float f32x8 __attribute__((ext_vector_type(8)));
typedef short bf16x8 __attribute__((ext_vector_type(8)));
typedef short s16x4 __attribute__((ext_vector_type(4)));
typedef GAS unsigned gu32;
#define RLX_AGENT __ATOMIC_RELAXED, __HIP_MEMORY_SCOPE_AGENT
#define LDS_WAIT() asm volatile("s_waitcnt lgkmcnt(0)" ::: "memory")
#define VM_WAIT() asm volatile("s_waitcnt vmcnt(0)" ::: "memory")
__device__ __forceinline__ unsigned f2bf(float f) { unsigned u = __builtin_bit_cast(unsigned, f); return (u + 0x7fffu + ((u >> 16) & 1u)) >> 16; }

#define XB_TMO      128
#define XB_XCNT(j)  (256  + 64 * (j))
#define XB_XSUB(j)  (1280 + 64 * (j))
#define XB_XGEN(j)  (2304 + 64 * (j))
#define XB_TOP      3328
#define XB_TOPGEN   3392
#define XCD_BAR_WORDS 3456
#define XB_SPIN_CAP (1u << 18)

__device__ __forceinline__ unsigned xb_ld(unsigned* p)              { return __hip_atomic_load(p, __ATOMIC_RELAXED, __HIP_MEMORY_SCOPE_AGENT); }
__device__ __forceinline__ unsigned xb_add(unsigned* p, unsigned v) { return __hip_atomic_fetch_add(p, v, __ATOMIC_RELAXED, __HIP_MEMORY_SCOPE_AGENT); }
__device__ __forceinline__ unsigned xb_xcc_id() { return (unsigned)__builtin_amdgcn_s_getreg((3 << 11) | 20) & 0xFu; }
#define XB_SPIN(cond, bar) do { unsigned _sp = 0; while (cond) { __builtin_amdgcn_s_sleep(1); \
    if ((++_sp & 255u) == 0u) { if (xb_ld(&(bar)[XB_TMO])) break; if (_sp > XB_SPIN_CAP) { atomicAdd(&(bar)[XB_TMO], 1u); break; } } } } while (0)

struct XcdBarrier {
    unsigned* bar; unsigned x;
    volatile LAS unsigned* st;
};

__device__ __forceinline__ XcdBarrier xcd_barrier_post(unsigned* bar, volatile LAS unsigned* st) {
    XcdBarrier b; b.bar = bar; b.x = xb_xcc_id(); b.st = st;
    if (threadIdx.x == 0) (void)xb_add(&bar[XB_XCNT(b.x)], 1u);
    return b;
}
__device__ __forceinline__ void xcd_barrier_complete(unsigned* bar, unsigned x, unsigned& nloc, unsigned& nx) {
    const unsigned G = gridDim.x * gridDim.y * gridDim.z;
    unsigned sum, cnt, mine, sp = 0u;
    for (;;) {
        sum = 0u; cnt = 0u; mine = 0u;
#pragma unroll
        for (unsigned j = 0; j < 16; ++j) { const unsigned c = xb_ld(&bar[XB_XCNT(j)]); sum += c; cnt += (c > 0u) ? 1u : 0u; mine = (j == x) ? c : mine; }
        if (sum == G) break;
        __builtin_amdgcn_s_sleep(1);
        if ((++sp & 255u) == 0u) { if (xb_ld(&bar[XB_TMO])) break; if (sp > XB_SPIN_CAP) { atomicAdd(&bar[XB_TMO], 1u); break; } }
    }
    nloc = mine > 0u ? mine : 1u; nx = cnt > 0u ? cnt : 1u;
}

__device__ __forceinline__ void xcd_barrier(const XcdBarrier& b) {
    asm volatile("s_waitcnt vmcnt(0)" ::: "memory");
    __syncthreads();
    if (threadIdx.x == 0) {
        unsigned* bar = b.bar;
        __builtin_amdgcn_s_waitcnt(0);
        unsigned nloc = b.st[0], nx = b.st[1];
        if (nloc == 0u) { xcd_barrier_complete(bar, b.x, nloc, nx); b.st[0] = nloc; b.st[1] = nx; }
        const unsigned old = xb_add(&bar[XB_XSUB(b.x)], 1u);
        const unsigned gen = old / nloc;
        if (old + 1u == (gen + 1u) * nloc) {
            __builtin_amdgcn_fence(__ATOMIC_RELEASE, "agent");
            asm volatile("s_waitcnt vmcnt(0)" ::: "memory");
            const unsigned og = xb_add(&bar[XB_TOP], 1u);
            const unsigned tg = og / nx;
            if (og + 1u == (tg + 1u) * nx) xb_add(&bar[XB_TOPGEN], 1u);
            else XB_SPIN(xb_ld(&bar[XB_TOPGEN]) == tg, bar);
            __builtin_amdgcn_fence(__ATOMIC_ACQUIRE, "agent");
            xb_add(&bar[XB_XGEN(b.x)], 1u);
            asm volatile("s_waitcnt vmcnt(0)" ::: "memory");
        } else {
            XB_SPIN(xb_ld(&bar[XB_XGEN(b.x)]) == gen, bar);
            __builtin_amdgcn_fence(__ATOMIC_ACQUIRE, "agent");
            asm volatile("s_waitcnt vmcnt(0)" ::: "memory");
        }
    }
    __syncthreads();
}

struct Frame {
    LAS unsigned char* lds;
    unsigned char* ws;
    const float* const* in;
    int tid, lane, wave, G, bid;
};
struct Args { const float* in[37]; float* out; unsigned char* ws; int ph_lo, ph_hi, use_bar, pad; };

__device__ __forceinline__ float dpp_f(float v, int ctrl_qp1) { return v; }
#define DPP_MOVF(v, ctrl) __builtin_bit_cast(float, __builtin_amdgcn_mov_dpp(__builtin_bit_cast(int, (v)), (ctrl), 0xf, 0xf, true))
__device__ __forceinline__ float wave_sum(float v) {
    v += DPP_MOVF(v, 0xB1);
    v += DPP_MOVF(v, 0x4E);
    v += DPP_MOVF(v, 0x141);
    v += DPP_MOVF(v, 0x140);
    v += __shfl_xor(v, 16); v += __shfl_xor(v, 32);
    return v;
}
__device__ __forceinline__ float wave_max(float v) {
#pragma unroll
    for (int o = 1; o < 64; o <<= 1) v = fmaxf(v, __shfl_xor(v, o));
    return v;
}
__device__ __forceinline__ float bflo(unsigned u) { return __uint_as_float(u << 16); }
__device__ __forceinline__ float bfhi(unsigned u) { return __uint_as_float(u & 0xffff0000u); }
__device__ __forceinline__ float bf1(bf16 h) { return __uint_as_float(((unsigned)h) << 16); }
__device__ __forceinline__ unsigned pk2(float lo, float hi) { return pg8::cvt_pk_bf16(lo, hi); }
__device__ __forceinline__ float sigm(float x) { return __builtin_amdgcn_rcpf(1.0f + __builtin_amdgcn_exp2f(-LOG2E * x)); }
__device__ __forceinline__ float softplusf_(float x) { return fmaxf(x, 0.f) + log1pf(__expf(-fabsf(x))); }
__device__ __forceinline__ void unpack8(const v4u& r, float (&f)[8]) { f[0] = bflo(r.x); f[1] = bfhi(r.x); f[2] = bflo(r.y); f[3] = bfhi(r.y); f[4] = bflo(r.z); f[5] = bfhi(r.z); f[6] = bflo(r.w); f[7] = bfhi(r.w); }
__device__ __forceinline__ v4u pack8(const float (&f)[8]) { v4u o; o.x = pk2(f[0], f[1]); o.y = pk2(f[2], f[3]); o.z = pk2(f[4], f[5]); o.w = pk2(f[6], f[7]); return o; }

template <class Fn> __device__ __forceinline__ void wprep(bf16* dst, int N, int K, Fn f, int gt, int NT) {
    const int items = N * (K >> 3);
    for (int it = gt; it < items; it += NT) { const int n = it % N, k0 = (it / N) << 3; float v[8];
#pragma unroll
        for (int j = 0; j < 8; ++j) v[j] = f(k0 + j, n);
        *(v4u*)(dst + (size_t)n * K + k0) = pack8(v); }
}
__device__ __forceinline__ void phase_prologue(Frame& F, const Args& a) {
    const int gt = F.bid * 512 + F.tid, NT = F.G * 512; unsigned char* ws = F.ws;
    { const float* W = a.in[5]; const float* gn0 = a.in[2];
      wprep((bf16*)(ws + WS_WIN), NU, D, [=](int k, int n) { const int c = n < 964 ? n : (n < 1024 ? -1 : n - 60); return c < 0 ? 0.f : W[(size_t)k * 2756 + c] * gn0[k]; }, gt, NT); }
    { const float* w2 = a.in[8]; const float* a2 = a.in[10]; const float* g2 = a.in[11];
      wprep((bf16*)(ws + WS_WLORA), 1536, 256, [=](int k, int n) { if (n < 512) return k < 64 ? w2[k * 512 + n] : 0.f; if (n < 1024) return (k >= 64 && k < 128) ? a2[(k - 64) * 512 + n - 512] : 0.f; return k >= 128 ? g2[(k - 128) * 512 + n - 1024] : 0.f; }, gt, NT); }
    { const float* W = a.in[17]; wprep((bf16*)(ws + WS_WOUT), D, D, [=](int k, int n) { return W[(size_t)k * D + n]; }, gt, NT); }
    for (int L = 0; L < 2; ++L) {
        const float* wg = a.in[31] + (size_t)L * D * FF; const float* wu = a.in[32] + (size_t)L * D * FF; const float* wd = a.in[33] + (size_t)L * FF * D;
        const float* wp = a.in[34] + (size_t)L * 256 * D; const float* wpg = a.in[36] + (size_t)L * D * D; const float* gnf = a.in[30] + L * D; const float* gnp = a.in[35] + L * D;
        wprep((bf16*)(ws + WS_WGU0 + L * WS_LAYER_STRIDE), 2 * FF, D, [=](int k, int n) { const int hid = 16 * (n >> 5) + (n & 15); return ((n & 31) >= 16 ? wu : wg)[(size_t)k * FF + hid] * gnf[k]; }, gt, NT);
        wprep((bf16*)(ws + WS_WD0 + L * WS_LAYER_STRIDE), D, FF, [=](int k, int n) { return wd[(size_t)k * D + n]; }, gt, NT);
        wprep((bf16*)(ws + WS_WPLE0 + L * WS_LAYER_STRIDE), D, 256, [=](int k, int n) { return wp[(size_t)k * D + n]; }, gt, NT);
        wprep((bf16*)(ws + WS_WPG0 + L * WS_LAYER_STRIDE), D, D, [=](int k, int n) { return wpg[(size_t)k * D + n] * gnp[k]; }, gt, NT);
    }
    { const float* W = a.in[18]; const float* gn1 = a.in[2] + D; wprep((bf16*)(ws + WS_WUP), 2 * CI, D, [=](int k, int n) { return W[(size_t)k * (2 * CI) + n] * gn1[k]; }, gt, NT); }
    { const float* W = a.in[29]; wprep((bf16*)(ws + WS_WDOWN), D, CI, [=](int k, int n) { return W[(size_t)k * D + n]; }, gt, NT); }
    { const float* wq = a.in[21]; const float* wk = a.in[22]; const float* wv = a.in[23]; const float* wif = a.in[24]; float* W12 = (float*)(ws + WS_W12);
      for (int it = gt; it < 4096 * 8; it += NT) { const int o = it & 7, c = (it >> 3) & 2047, part = it >> 14, g = c >> 2, i = c & 3; float s = 0.f;
          if (part == 0) { for (int j = 0; j < 4; ++j) s += wq[(g * 4 + i) * 4 + j] * wif[(size_t)(4 * g + j) * 8 + o] + wk[(g * 4 + i) * 4 + j] * wif[(size_t)(2048 + 4 * g + j) * 8 + o]; }
          else { for (int j = 0; j < 4; ++j) s += wv[(g * 4 + i) * 4 + j] * wif[(size_t)(4096 + 4 * g + j) * 8 + o]; }
          W12[it] = s; } }
}
__device__ __forceinline__ void phase_norm(Frame& F, const float* src, const float* gain, bf16* dst, int nrows) {
    const int gw = F.bid * NWAVES + F.wave, NGW = F.G * NWAVES, lane = F.lane;
    f32x4 g[4];
#pragma unroll
    for (int j = 0; j < 4; ++j) g[j] = *((const f32x4*)gain + lane + 64 * j);
    for (int m = gw; m < nrows; m += NGW) {
        const f32x4* xr = (const f32x4*)(src + (size_t)m * D) + lane; f32x4 v[4]; float s = 0.f;
#pragma unroll
        for (int j = 0; j < 4; ++j) { v[j] = xr[64 * j]; s += (v[j].x * v[j].x + v[j].y * v[j].y) + (v[j].z * v[j].z + v[j].w * v[j].w); }
        const float r = rsqrtf(wave_sum(s) * (1.f / D) + NORM_EPS);
        v2u* o = (v2u*)(dst + (size_t)m * D) + lane;
#pragma unroll
        for (int j = 0; j < 4; ++j) { v2u w; w.x = pk2(v[j].x * r * g[j].x, v[j].y * r * g[j].y); w.y = pk2(v[j].z * r * g[j].z, v[j].w * r * g[j].w); o[64 * j] = w; }
    }
}
__device__ __forceinline__ void phase_cast_sq(Frame& F, const float* src, bf16* dst, float* rsq, int nrows) {
    const int gw = F.bid * NWAVES + F.wave, NGW = F.G * NWAVES, lane = F.lane;
    for (int m = gw; m < nrows; m += NGW) {
        const f32x4* xr = (const f32x4*)(src + (size_t)m * D) + lane; f32x4 v[4]; float s = 0.f;
#pragma unroll
        for (int j = 0; j < 4; ++j) { v[j] = xr[64 * j]; s += (v[j].x * v[j].x + v[j].y * v[j].y) + (v[j].z * v[j].z + v[j].w * v[j].w); }
        s = wave_sum(s); if (lane < 16) rsq[(size_t)m * 16 + lane] = lane == 0 ? s : 0.f;
        v2u* o = (v2u*)(dst + (size_t)m * D) + lane;
#pragma unroll
        for (int j = 0; j < 4; ++j) { v2u w; w.x = pk2(v[j].x, v[j].y); w.y = pk2(v[j].z, v[j].w); o[64 * j] = w; }
    }
}
__device__ __forceinline__ void phase_cvt_p(Frame& F, const float* p, bf16* pb) {
    const size_t gt = (size_t)F.bid * 512 + F.tid, NT = (size_t)F.G * 512, n8 = (size_t)T * 256 / 8;
    for (size_t i0 = gt; i0 < n8; i0 += 4 * NT) { f32x4 a[4], b[4];
#pragma unroll
        for (int q4 = 0; q4 < 4; ++q4) { const size_t i = i0 + q4 * NT; if (i < n8) { a[q4] = *((const f32x4*)p + 2 * i); b[q4] = *((const f32x4*)p + 2 * i + 1); } }
#pragma unroll
        for (int q4 = 0; q4 < 4; ++q4) { const size_t i = i0 + q4 * NT; if (i < n8) { v4u o; o.x = pk2(a[q4].x, a[q4].y); o.y = pk2(a[q4].z, a[q4].w); o.z = pk2(b[q4].x, b[q4].y); o.w = pk2(b[q4].z, b[q4].w); *((v4u*)pb + i) = o; } } }
}
constexpr float QSCALE = 0.125f * LOG2E;
__device__ __forceinline__ void phase_prepA(Frame& F, const Args& a) {
    unsigned char* ws = F.ws; const bf16* UA = (const bf16*)(ws + WS_UA); const bf16* UB = (const bf16*)(ws + WS_UB);
    bf16* LIN = (bf16*)(ws + WS_LIN); bf16* QN = (bf16*)(ws + WS_QN); bf16* KN = (bf16*)(ws + WS_KN); bf16* VT = (bf16*)(ws + WS_VT);
    const float* mu = a.in[6]; const float* gq = a.in[3]; const float* gk = a.in[4];
    { const int gt = F.bid * 512 + F.tid, NT = F.G * 512; const int c8 = (gt & 31) << 3; float muv[8];
#pragma unroll
      for (int j = 0; j < 8; ++j) muv[j] = mu[1536 + c8 + j];
      for (int it0 = gt; it0 < T * 32; it0 += 4 * NT) { v4u ru[4], rp[4];
#pragma unroll
          for (int q4 = 0; q4 < 4; ++q4) { const int it = it0 + q4 * NT; if (it < T * 32) { const int t = it >> 5; ru[q4] = *(const v4u*)(UB + (size_t)t * UB_W + 1536 + c8); rp[q4] = *(const v4u*)(UB + (size_t)((t & (SEQ - 1)) ? t - 1 : t) * UB_W + 1536 + c8); } }
#pragma unroll
          for (int q4 = 0; q4 < 4; ++q4) { const int it = it0 + q4 * NT; if (it < T * 32) { const int t = it >> 5; float u[8], p[8], o[8]; unpack8(ru[q4], u); unpack8(rp[q4], p); const float pm = (t & (SEQ - 1)) ? 1.f : 0.f;
#pragma unroll
              for (int j = 0; j < 8; ++j) { const float s = u[j] + muv[j] * (p[j] * pm - u[j]); o[j] = c8 < 64 ? (1.0f - 2.0f * __builtin_amdgcn_rcpf(1.0f + __builtin_amdgcn_exp2f(2.0f * LOG2E * s))) : (c8 < 128 ? s : sigm(s));     }
              *(v4u*)(LIN + (size_t)t * 256 + c8) = pack8(o); } } } }
    { const int gw = F.bid * NWAVES + F.wave, NGW = F.G * NWAVES, lane = F.lane; float gqv[8], gkv[8];
#pragma unroll
      for (int j = 0; j < 8; ++j) { gqv[j] = gq[((lane & 7) << 3) + j] * QSCALE; gkv[j] = gk[((lane & 7) << 3) + j]; }
      for (int t0 = gw; t0 < T; t0 += 4 * NGW) { v4u rq[4], rk[4];
#pragma unroll
          for (int q4 = 0; q4 < 4; ++q4) { const int t = t0 + q4 * NGW; if (t < T) { rq[q4] = *(const v4u*)(UA + (size_t)t * UA_W + 8 * lane); rk[q4] = *(const v4u*)(UA + (size_t)t * UA_W + UA_K + 8 * (lane & 7)); } }
#pragma unroll
          for (int q4 = 0; q4 < 4; ++q4) { const int t = t0 + q4 * NGW; if (t < T) {
              float q[8], k[8]; unpack8(rq[q4], q); unpack8(rk[q4], k);
              float sq = 0.f, sk = 0.f;
#pragma unroll
              for (int j = 0; j < 8; ++j) { sq += q[j] * q[j]; sk += k[j] * k[j]; }
              sq += __shfl_xor(sq, 1); sq += __shfl_xor(sq, 2); sq += __shfl_xor(sq, 4); sk += __shfl_xor(sk, 1); sk += __shfl_xor(sk, 2); sk += __shfl_xor(sk, 4);
              const float rq_ = rsqrtf(sq * (1.f / 64.f) + NORM_EPS), rk_ = rsqrtf(sk * (1.f / 64.f) + NORM_EPS);
#pragma unroll
              for (int j = 0; j < 8; ++j) { q[j] *= rq_ * gqv[j]; k[j] *= rk_ * gkv[j]; }
              *(v4u*)(QN + (size_t)t * 512 + 8 * lane) = pack8(q);
              if (lane < 8) *(v4u*)(KN + (size_t)t * 64 + 8 * lane) = pack8(k); } } } }
    { const int gt = F.bid * 512 + F.tid, NT = F.G * 512;
      for (int it = gt; it < T * 8; it += NT) { const int t = it >> 3, c8 = (it & 7) << 3; *(v4u*)(VT + (size_t)t * 64 + c8) = *(const v4u*)(UA + (size_t)t * UA_W + UA_V + c8); } }
}
constexpr int IDX_STRIDE = 2052, KSEL = 256;
__device__ __forceinline__ void topk_select(const LAS float* row, int limit, unsigned* maskrow, int lane) {
    unsigned long long mybits = 0ull; const int nj = limit >> 6;
    if (limit <= KSEL) { mybits = lane < nj ? ~0ull : 0ull; }
    else {
        unsigned key[32];
#pragma unroll
        for (int j = 0; j < 32; ++j) key[j] = 0u;
#pragma unroll
        for (int g8 = 0; g8 < 4; ++g8) if (8 * g8 < nj) {
#pragma unroll
            for (int jj = 0; jj < 8; ++jj) { const int j = 8 * g8 + jj; unsigned u = __float_as_uint(row[64 * j + lane]); if (u == 0x80000000u) u = 0u; const unsigned k = (u & 0x80000000u) ? ~u : (u | 0x80000000u); key[j] = (j < nj) ? k : 0u; } }
        unsigned prefix = 0u; bool exact = false;
        for (int bit = 31; bit >= 0; --bit) { const unsigned cand = prefix | (1u << bit); int c0 = 0, c1 = 0;
#pragma unroll
            for (int g8 = 0; g8 < 4; ++g8) if (8 * g8 < nj) {
#pragma unroll
                for (int jj = 0; jj < 8; jj += 2) { c0 += (key[8 * g8 + jj] >= cand) ? 1 : 0; c1 += (key[8 * g8 + jj + 1] >= cand) ? 1 : 0; } }
            int cnt = c0 + c1;
            cnt += __builtin_amdgcn_mov_dpp(cnt, 0xB1, 0xf, 0xf, true); cnt += __builtin_amdgcn_mov_dpp(cnt, 0x4E, 0xf, 0xf, true); cnt += __builtin_amdgcn_mov_dpp(cnt, 0x141, 0xf, 0xf, true); cnt += __builtin_amdgcn_mov_dpp(cnt, 0x140, 0xf, 0xf, true);
            cnt = __builtin_amdgcn_readlane(cnt, 0) + __builtin_amdgcn_readlane(cnt, 16) + __builtin_amdgcn_readlane(cnt, 32) + __builtin_amdgcn_readlane(cnt, 48);
            if (cnt >= KSEL) { prefix = cand; if (cnt == KSEL) { exact = true; break; } } }
        int need = 0;
        if (!exact) { int cgt = 0;
#pragma unroll
            for (int j = 0; j < 32; ++j) cgt += __builtin_popcountll(__ballot(key[j] > prefix));
            need = KSEL - cgt; }
        int running = 0; const unsigned long long below = (1ull << lane) - 1ull;
#pragma unroll
        for (int g8 = 0; g8 < 4; ++g8) if (8 * g8 < nj)
#pragma unroll
        for (int jj = 0; jj < 8; ++jj) { const int j = 8 * g8 + jj;
            const bool gt = exact ? (key[j] >= prefix) : (key[j] > prefix); const bool tie = (!exact) && key[j] == prefix;
            const unsigned long long tb = __ballot(tie); const int rank = running + __builtin_popcountll(tb & below); running += __builtin_popcountll(tb);
            const unsigned long long sb = __ballot(gt || (tie && rank < need)); if (lane == j) mybits = sb; }
    }
    if (lane < 32) { v2u w; w.x = (unsigned)mybits; w.y = (unsigned)(mybits >> 32); *(v2u*)(maskrow + 2 * lane) = w; }
}
__device__ __forceinline__ void phase_indexer(Frame& F) {
    unsigned char* ws = F.ws; const bf16* UA = (const bf16*)(ws + WS_UA); unsigned* MASK = (unsigned*)(ws + WS_MASK);
    LAS float* sc = (LAS float*)F.lds; const int lane = F.lane, w = F.wave, fr = lane & 15, fq = lane >> 4;
    for (int r = 0;; ++r) { const int u = r * F.G + ((r & 1) ? (F.G - 1 - F.bid) : F.bid); if (u >= NB * 128) break;
        const int c = 31 - (u >> 7), rest = u & 127, b = rest >> 2, g4 = rest & 3, limit = 64 * (c + 1), tq0 = b * SEQ + c * 64 + g4 * 16;
        const bf16* UAb = UA + (size_t)b * SEQ * UA_W;
        bf16x8 qf[4][2]; float iwv[4];
        { const bf16* qp = UA + (size_t)(tq0 + fr) * UA_W;
#pragma unroll
          for (int hh = 0; hh < 4; ++hh) { qf[hh][0] = *(const bf16x8*)(qp + UA_IQ + hh * 64 + fq * 8); qf[hh][1] = *(const bf16x8*)(qp + UA_IQ + hh * 64 + 32 + fq * 8); iwv[hh] = bf1(qp[UA_IW + hh]) * (1.f / 16.f); } }
#ifndef IDX_SCORE_REP
#define IDX_SCORE_REP 1
#endif
#ifndef IDX_SEL_REP
#define IDX_SEL_REP 1
#endif
        for (int rp_ = 0; rp_ < IDX_SCORE_REP; ++rp_)
        for (int kt = w; kt < (limit >> 4); kt += NWAVES) {
            const bf16* kp = UAb + (size_t)(kt * 16 + fr) * UA_W + UA_IK + fq * 8; const bf16x8 a0 = *(const bf16x8*)kp, a1 = *(const bf16x8*)(kp + 32);
            f32x4 s = {0.f, 0.f, 0.f, 0.f};
#pragma unroll
            for (int hh = 0; hh < 4; ++hh) { f32x4 d = {0.f, 0.f, 0.f, 0.f}; d = __builtin_amdgcn_mfma_f32_16x16x32_bf16(a0, qf[hh][0], d, 0, 0, 0); d = __builtin_amdgcn_mfma_f32_16x16x32_bf16(a1, qf[hh][1], d, 0, 0, 0);
#pragma unroll
                for (int j = 0; j < 4; ++j) s[j] += iwv[hh] * fmaxf(d[j], 0.f); }
            *(LAS f32x4*)(sc + fr * IDX_STRIDE + kt * 16 + fq * 4) = s; }
        __syncthreads();
#pragma unroll 1
        for (int qq = 0; qq < 2 * IDX_SEL_REP; ++qq) { const int q = 2 * w + (qq & 1); topk_select(sc + q * IDX_STRIDE, limit, MASK + (size_t)(tq0 + q) * 64, lane); }
        __syncthreads(); }
}
constexpr int DA_K = 0, DA_V = 8192, DA_M = 16384, DA_STAGE = 16384 + 512;
__device__ __forceinline__ bf16x8 mk8(v2u lo, v2u hi) { v4u t; t.x = lo.x; t.y = lo.y; t.z = hi.x; t.w = hi.y; return __builtin_bit_cast(bf16x8, t); }
__device__ __forceinline__ void tr_read_v4d(unsigned a, bf16x8 (&vf)[4]) { s16x4 l0, h0, l1, h1, l2, h2, l3, h3;
    asm volatile("ds_read_b64_tr_b16 %0, %8\n\tds_read_b64_tr_b16 %1, %8 offset:512\n\tds_read_b64_tr_b16 %2, %8 offset:32\n\tds_read_b64_tr_b16 %3, %8 offset:544\n\t"
                 "ds_read_b64_tr_b16 %4, %8 offset:64\n\tds_read_b64_tr_b16 %5, %8 offset:576\n\tds_read_b64_tr_b16 %6, %8 offset:96\n\tds_read_b64_tr_b16 %7, %8 offset:608\n\ts_waitcnt lgkmcnt(0)"
                 : "=&v"(l0), "=&v"(h0), "=&v"(l1), "=&v"(h1), "=&v"(l2), "=&v"(h2), "=&v"(l3), "=&v"(h3) : "v"(a) : "memory");
    vf[0] = (bf16x8){l0[0], l0[1], l0[2], l0[3], h0[0], h0[1], h0[2], h0[3]}; vf[1] = (bf16x8){l1[0], l1[1], l1[2], l1[3], h1[0], h1[1], h1[2], h1[3]};
    vf[2] = (bf16x8){l2[0], l2[1], l2[2], l2[3], h2[0], h2[1], h2[2], h2[3]}; vf[3] = (bf16x8){l3[0], l3[1], l3[2], l3[3], h3[0], h3[1], h3[2], h3[3]}; }
__device__ __forceinline__ void phase_dsa_attn(Frame& F, const Args& a) {
    unsigned char* ws = F.ws; const bf16* QN = (const bf16*)(ws + WS_QN); const bf16* KN = (const bf16*)(ws + WS_KN); const bf16* VN = (const bf16*)(ws + WS_VT);
    const unsigned* MASK = (const unsigned*)(ws + WS_MASK); bf16* MIX = (bf16*)(ws + WS_XB);
    const int lane = F.lane, w = F.wave, fr = lane & 15, fq = lane >> 4; LAS unsigned char* lds = F.lds;
    const float mb = 8.f * LOG2E * wave_max(fabsf(a.in[3][lane])) * wave_max(fabsf(a.in[4][lane]));
    const unsigned vtr_lane = (unsigned)((8 * fq + ((lane & 15) >> 2)) * 128 + 4 * (lane & 3) * 2);
    for (int r = 0;; ++r) { const int u = r * F.G + ((r & 1) ? (F.G - 1 - F.bid) : F.bid); if (u >= NB * 32) break;
        const int c = 31 - (u >> 5), b = u & 31, nst = c + 1, t0 = b * SEQ + 64 * c;
        const bf16* Kb = KN + (size_t)b * SEQ * 64; const bf16* Vb = VN + (size_t)b * SEQ * 64; const unsigned* Mb = MASK + (size_t)t0 * 64;
#define DA_DMA(st_, buf_) do { const int so_ = (buf_) * DA_STAGE; \
            __builtin_amdgcn_global_load_lds((const unsigned*)(Kb + (size_t)(64 * (st_) + 8 * w) * 64 + lane * 8), (LAS unsigned*)(lds + so_ + DA_K + w * 1024), 16, 0, 0); \
            __builtin_amdgcn_global_load_lds((const unsigned*)(Vb + (size_t)(64 * (st_) + 8 * w) * 64 + lane * 8), (LAS unsigned*)(lds + so_ + DA_V + w * 1024), 16, 0, 0); \
            if (w < 2) __builtin_amdgcn_global_load_lds(Mb + (size_t)lane * 64 + 2 * (st_) + w, (LAS unsigned*)(lds + so_ + DA_M + w * 256), 4, 0, 0); } while (0)
        DA_DMA(0, 0);
        bf16x8 qf[4][2];
#pragma unroll
        for (int i = 0; i < 4; ++i) { const bf16* qp = QN + (size_t)(t0 + 16 * i + fr) * 512 + w * 64 + fq * 8; qf[i][0] = *(const bf16x8*)qp; qf[i][1] = *(const bf16x8*)(qp + 32); }
        f32x4 O[4][4]; float l[4];
#pragma unroll
        for (int i = 0; i < 4; ++i) { l[i] = 0.f;
#pragma unroll
            for (int dt = 0; dt < 4; ++dt) O[i][dt] = (f32x4){0.f, 0.f, 0.f, 0.f}; }
        for (int st = 0; st < nst; ++st) { const int buf = st & 1; const LAS unsigned char* sb = lds + buf * DA_STAGE;
            asm volatile("s_waitcnt vmcnt(0)" ::: "memory");
            __builtin_amdgcn_s_barrier(); asm volatile("" ::: "memory");
            if (st + 1 < nst) DA_DMA(st + 1, buf ^ 1);
#pragma unroll
            for (int sub = 0; sub < 2; ++sub) {
                bf16x8 kf[2][2], vf[4]; unsigned mw[4];
#pragma unroll
                for (int s2 = 0; s2 < 2; ++s2) { const LAS unsigned char* kp = sb + DA_K + (32 * sub + 8 * (fr >> 2) + 4 * s2 + (fr & 3)) * 128 + fq * 16;   kf[s2][0] = *(const LAS bf16x8*)kp; kf[s2][1] = *(const LAS bf16x8*)(kp + 64); }
#pragma unroll
                for (int i = 0; i < 4; ++i) mw[i] = *(const LAS unsigned*)(sb + DA_M + sub * 256 + (16 * i + fr) * 4);
                tr_read_v4d((unsigned)(size_t)(sb + DA_V + sub * 4096) + vtr_lane, vf);
#pragma unroll
                for (int i = 0; i < 4; ++i) {
                    f32x4 s0 = {0.f, 0.f, 0.f, 0.f}, s1 = {0.f, 0.f, 0.f, 0.f};
                    s0 = __builtin_amdgcn_mfma_f32_16x16x32_bf16(kf[0][0], qf[i][0], s0, 0, 0, 0); s0 = __builtin_amdgcn_mfma_f32_16x16x32_bf16(kf[0][1], qf[i][1], s0, 0, 0, 0);
                    s1 = __builtin_amdgcn_mfma_f32_16x16x32_bf16(kf[1][0], qf[i][0], s1, 0, 0, 0); s1 = __builtin_amdgcn_mfma_f32_16x16x32_bf16(kf[1][1], qf[i][1], s1, 0, 0, 0);
                    const unsigned b0 = mw[i] >> (8 * fq), b1 = mw[i] >> (8 * fq + 4); float p[8];
#pragma unroll
                    for (int j = 0; j < 4; ++j) { p[j] = ((b0 >> j) & 1u) ? __builtin_amdgcn_exp2f(s0[j] - mb) : 0.f; p[4 + j] = ((b1 >> j) & 1u) ? __builtin_amdgcn_exp2f(s1[j] - mb) : 0.f; }
                    l[i] += ((p[0] + p[1]) + (p[2] + p[3])) + ((p[4] + p[5]) + (p[6] + p[7]));
                    const bf16x8 pa = __builtin_bit_cast(bf16x8, pack8(p));
#pragma unroll
                    for (int dt = 0; dt < 4; ++dt) O[i][dt] = __builtin_amdgcn_mfma_f32_16x16x32_bf16(pa, vf[dt], O[i][dt], 0, 0, 0);
                } } }
#undef DA_DMA
#pragma unroll
        for (int i = 0; i < 4; ++i) { float li = l[i]; li += __shfl_xor(li, 16); li += __shfl_xor(li, 32);
#pragma unroll
            for (int j = 0; j < 4; ++j) { const float inv = 1.0f / __shfl(li, 4 * fq + j); bf16* op = MIX + (size_t)(t0 + 16 * i + 4 * fq + j) * D + w * 64 + fr;
#pragma unroll
                for (int dt = 0; dt < 4; ++dt) op[16 * dt] = (bf16)f2bf(O[i][dt][j] * inv); } }
        VM_WAIT(); __syncthreads();
    }
}
__device__ __forceinline__ float rw_decay(float x) { const float sp = fmaxf(-x, 0.f) + 0.6931471805599453f * __builtin_amdgcn_logf(1.0f + __builtin_amdgcn_exp2f(-LOG2E * fabsf(x)));
    return __builtin_amdgcn_exp2f(-LOG2E * __builtin_amdgcn_exp2f(-LOG2E * (sp + 0.5f))); }
#define MF32(a_, b_, c_) __builtin_amdgcn_mfma_f32_16x16x4f32((a_), (b_), (c_), 0, 0, 0)
constexpr int RT = 68, RG = 20, RGM = 16 * RG;
constexpr int RL_AH = 0, RL_BH = 64 * RT, RL_KH = 2 * 64 * RT, RL_RH = 3 * 64 * RT, RL_VX = 4 * 64 * RT, RL_GS = 5 * 64 * RT, RL_YA = 6 * 64 * RT, RL_GR = 7 * 64 * RT, RL_PM = RL_GR + 16 * RGM, RL_GC = RL_PM + 4 * RGM, RL_BON = RL_GC + 256, RL_END = RL_BON + 64;
static_assert(RL_END * 4 <= MISC_OFF, "RWKV LDS");
__device__ __forceinline__ void phase_rwkv(Frame& F, const Args& a) {
    unsigned char* ws = F.ws; const bf16* UB = (const bf16*)(ws + WS_UB); const bf16* LOUT = (const bf16*)(ws + WS_LOUT); bf16* MIX = (bf16*)(ws + WS_XB);
    const float* mu = a.in[6]; const float* w0 = a.in[7]; const float* a0 = a.in[9]; const float* k_k = a.in[12]; const float* k_a = a.in[13]; const float* r_k = a.in[14]; const float* gn_g = a.in[15]; const float* gn_b = a.in[16];
    const int lane = F.lane, w = F.wave, n = lane & 15, q = lane >> 4;
    LAS float* L = (LAS float*)F.lds;
    for (int bh = F.bid; bh < NB * 8; bh += F.G) {
        const int b = bh >> 3, h = bh & 7, c = h * 64 + lane;
        const float mur = mu[c], muk = mu[512 + c], muv = mu[1024 + c], w0c = w0[c], a0c = a0[c], kkc = k_k[c], kac = k_a[c], rkc = r_k[c], gng = gn_g[c], gnb = gn_b[c];
        f32x4 Z[4];
#pragma unroll
        for (int kt = 0; kt < 4; ++kt) Z[kt] = (f32x4){0.f, 0.f, 0.f, 0.f};
        const int ch = w >> 1, hs = w & 1;
        float r_ur[8], r_uk[8], r_uv[8], r_pr[8], r_pk[8], r_pv[8], r_wd[8], r_ad[8], r_gg[8], r_wf[8];
#define RW_RAW(batch_) do { _Pragma("unroll") for (int i = 0; i < 8; ++i) { const int sl = (batch_) * 64 + 16 * ch + 8 * hs + i; const size_t t = (size_t)b * SEQ + sl; const bf16* up = UB + t * UB_W + c; const bf16* pp_ = sl > 0 ? up - UB_W : up; \
            r_ur[i] = bf1(up[0]); r_uk[i] = bf1(up[512]); r_uv[i] = bf1(up[1024]); r_pr[i] = bf1(pp_[0]); r_pk[i] = bf1(pp_[512]); r_pv[i] = bf1(pp_[1024]); \
            const bf16* lp = LOUT + t * 1536 + c; r_wd[i] = bf1(lp[0]); r_ad[i] = bf1(lp[512]); r_gg[i] = bf1(lp[1024]); \
            r_wf[i] = bf1(LOUT[((size_t)b * SEQ + (batch_) * 64 + 16 * ch + i) * 1536 + c]); } } while (0)
        RW_RAW(0);
        for (int batch = 0; batch < SEQ / 64; ++batch) {
            { float gcur = 1.f;
              if (hs) {
#pragma unroll
                  for (int i = 0; i < 8; ++i) gcur *= rw_decay(w0c + r_wf[i]); }
#pragma unroll
              for (int i = 0; i < 8; ++i) { const int tl = 16 * ch + 8 * hs + i, sl = batch * 64 + tl; const float pm = sl > 0 ? 1.f : 0.f;
                const float ur = r_ur[i], uk = r_uk[i], uv = r_uv[i], pr = r_pr[i] * pm, pk = r_pk[i] * pm, pv = r_pv[i] * pm;
                const float rr = ur + mur * (pr - ur), kx = uk + muk * (pk - uk), vx = uv + muv * (pv - uv);
                const float decay = rw_decay(w0c + r_wd[i]), av = sigm(a0c + r_ad[i]);
                float kk = kx * kkc; kk = kk * rsqrtf(fmaxf(wave_sum(kk * kk), 1e-24f));
                const float km = kx * (1.f + (av - 1.f) * kac); const float bon = wave_sum(rr * km * rkc);
                const float gprev = gcur; gcur *= decay; const float ig = __builtin_amdgcn_rcpf(gcur);
                L[RL_AH + tl * RT + lane] = -kk * gprev; L[RL_BH + tl * RT + lane] = kk * av * ig; L[RL_KH + tl * RT + lane] = km * ig; L[RL_RH + tl * RT + lane] = rr * gcur;
                L[RL_VX + tl * RT + lane] = vx; L[RL_GS + tl * RT + lane] = r_gg[i]; if (lane == 0) L[RL_BON + tl] = bon; }
              if (hs) L[RL_GC + ch * 64 + lane] = gcur; }
            LDS_WAIT(); __syncthreads();
            if (batch + 1 < SEQ / 64) RW_RAW(batch + 1);
            { const LAS float* ah = L + RL_AH + 16 * ch * RT; const LAS float* bhm = L + RL_BH + 16 * ch * RT; const LAS float* khm = L + RL_KH + 16 * ch * RT; const LAS float* rhm = L + RL_RH + 16 * ch * RT;
              LAS float* gr = L + RL_GR + ch * 4 * RGM; LAS float* pm_ = L + RL_PM + ch * RGM;
              if (hs == 0) {
                  f32x4 m = {0.f, 0.f, 0.f, 0.f};
#pragma unroll
                  for (int s = 0; s < 16; ++s) m = MF32(bhm[n * RT + 4 * s + q], ah[n * RT + 4 * s + q], m);
                  f32x4 tm;
#pragma unroll
                  for (int j = 0; j < 4; ++j) { m[j] = (4 * q + j < n) ? m[j] : 0.f; tm[j] = m[j] + ((4 * q + j == n) ? 1.f : 0.f); pm_[(4 * q + j) * RG + n] = m[j]; gr[(4 * q + j) * RG + n] = tm[j]; }
#pragma unroll
                  for (int rd = 0; rd < 3; ++rd) { LDS_WAIT();
                      f32x4 p2 = {0.f, 0.f, 0.f, 0.f};
#pragma unroll
                      for (int s = 0; s < 4; ++s) p2 = MF32(pm_[n * RG + 4 * s + q], pm_[(4 * s + q) * RG + n], p2);
                      f32x4 ip, t2 = {0.f, 0.f, 0.f, 0.f};
#pragma unroll
                      for (int j = 0; j < 4; ++j) ip[j] = p2[j] + ((4 * q + j == n) ? 1.f : 0.f);
#pragma unroll
                      for (int j = 0; j < 4; ++j) t2 = MF32(gr[n * RG + 4 * q + j], ip[j], t2);
                      LDS_WAIT();
#pragma unroll
                      for (int j = 0; j < 4; ++j) { pm_[(4 * q + j) * RG + n] = p2[j]; gr[(4 * q + j) * RG + n] = t2[j]; } }
              } else {
                  f32x4 mk = {0.f, 0.f, 0.f, 0.f}, nb = {0.f, 0.f, 0.f, 0.f}, nk = {0.f, 0.f, 0.f, 0.f};
#pragma unroll
                  for (int s = 0; s < 16; ++s) { const float av_ = ah[n * RT + 4 * s + q], rv_ = rhm[n * RT + 4 * s + q], bv_ = bhm[n * RT + 4 * s + q], kv_ = khm[n * RT + 4 * s + q];
                      mk = MF32(kv_, av_, mk); nb = MF32(bv_, rv_, nb); nk = MF32(kv_, rv_, nk); }
#pragma unroll
                  for (int j = 0; j < 4; ++j) { const int s_ = 4 * q + j; gr[RGM + s_ * RG + n] = (s_ < n) ? mk[j] : 0.f; gr[2 * RGM + s_ * RG + n] = (s_ <= n) ? nb[j] : 0.f; gr[3 * RGM + s_ * RG + n] = (s_ <= n) ? nk[j] : 0.f; } } }
            LDS_WAIT(); __syncthreads();
#ifndef RW_C_REP
#define RW_C_REP 1
#endif
            if (w < 4) { const int v = 16 * w + n; f32x4 Zs[4]; for (int kt = 0; kt < 4; ++kt) Zs[kt] = Z[kt];
              for (int rc_ = 0; rc_ < RW_C_REP; ++rc_) { if (rc_) for (int kt = 0; kt < 4; ++kt) Z[kt] = Zs[kt];
#pragma unroll 1
                for (int cc = 0; cc < 4; ++cc) { const LAS float* ah = L + RL_AH + 16 * cc * RT; const LAS float* bhm = L + RL_BH + 16 * cc * RT; const LAS float* khm = L + RL_KH + 16 * cc * RT; const LAS float* rhm = L + RL_RH + 16 * cc * RT;
                    const LAS float* vx = L + RL_VX + 16 * cc * RT; const LAS float* gr = L + RL_GR + cc * 4 * RGM;
                    float vb[4];
#pragma unroll
                    for (int s = 0; s < 4; ++s) vb[s] = vx[(4 * s + q) * RT + v];
                    f32x4 X = {0.f, 0.f, 0.f, 0.f}, Y = {0.f, 0.f, 0.f, 0.f};
#pragma unroll
                    for (int kt = 0; kt < 4; ++kt)
#pragma unroll
                        for (int j = 0; j < 4; ++j) { X = MF32(ah[n * RT + 16 * kt + 4 * q + j], Z[kt][j], X); Y = MF32(rhm[n * RT + 16 * kt + 4 * q + j], Z[kt][j], Y); }
#pragma unroll
                    for (int s = 0; s < 4; ++s) { X = MF32(gr[RGM + (4 * s + q) * RG + n], vb[s], X); Y = MF32(gr[3 * RGM + (4 * s + q) * RG + n], vb[s], Y); }
                    f32x4 U = {0.f, 0.f, 0.f, 0.f};
#pragma unroll
                    for (int j = 0; j < 4; ++j) U = MF32(gr[(4 * q + j) * RG + n], X[j], U);
#pragma unroll
                    for (int j = 0; j < 4; ++j) Y = MF32(gr[2 * RGM + (4 * q + j) * RG + n], U[j], Y);
#pragma unroll
                    for (int j = 0; j < 4; ++j) L[RL_YA + (16 * cc + 4 * q + j) * RT + v] = Y[j];
#pragma unroll
                    for (int kt = 0; kt < 4; ++kt) {
#pragma unroll
                        for (int j = 0; j < 4; ++j) Z[kt] = MF32(bhm[(4 * q + j) * RT + 16 * kt + n], U[j], Z[kt]);
#pragma unroll
                        for (int s = 0; s < 4; ++s) Z[kt] = MF32(khm[(4 * s + q) * RT + 16 * kt + n], vb[s], Z[kt]);
                        const f32x4 gc = *(const LAS f32x4*)(L + RL_GC + cc * 64 + 16 * kt + 4 * q); Z[kt] = Z[kt] * gc; } } } }
            LDS_WAIT(); __syncthreads();
#pragma unroll
            for (int i = 0; i < 8; ++i) { const int step = w + 8 * i; const size_t t = (size_t)b * SEQ + batch * 64 + step;
                const float y = L[RL_YA + step * RT + lane], mean = wave_sum(y) * (1.f / 64.f), dlt = y - mean, var = fmaxf(wave_sum(y * y) * (1.f / 64.f) - mean * mean, 0.f);
                const float yn = dlt * rsqrtf(var + 64e-5f) * gng + gnb; const float o = (yn + L[RL_BON + step] * L[RL_VX + step * RT + lane]) * L[RL_GS + step * RT + lane];
                MIX[t * D + 512 + c] = (bf16)f2bf(o); }
            LDS_WAIT(); __syncthreads();
        }
#undef RW_RAW
    }
}
__device__ __forceinline__ void phase_l1prep(Frame& F, const Args& a, int hb) {
    unsigned char* ws = F.ws; const bf16* XM = (const bf16*)(ws + WS_XM); bf16* XC = (bf16*)(ws + WS_XC); bf16* Q = (bf16*)(ws + WS_Q); bf16* K = (bf16*)(ws + WS_K); bf16* V = (bf16*)(ws + WS_V);
    float* GI = (float*)(ws + WS_GI); const float* W12 = (const float*)(ws + WS_W12);
    const float* cw = a.in[19]; const float* cb = a.in[20]; const float* wq = a.in[21]; const float* wk = a.in[22]; const float* wv = a.in[23]; const float* b_i = a.in[25]; const float* b_f = a.in[26];
    const int g = F.tid, lane = F.lane, w = F.wave; LAS float* red = (LAS float*)F.lds;
    float cwr[4][4], cbr[4], wqr[16], wkr[16], wvr[16], w1[32], w2[32];
#pragma unroll
    for (int j = 0; j < 4; ++j)
#pragma unroll
        for (int i = 0; i < 4; ++i) cwr[j][i] = cw[j * CI + 4 * g + i];
#pragma unroll
    for (int i = 0; i < 4; ++i) cbr[i] = cb[4 * g + i];
#pragma unroll
    for (int i = 0; i < 16; ++i) { wqr[i] = wq[g * 16 + i]; wkr[i] = wk[g * 16 + i]; wvr[i] = wv[g * 16 + i]; }
#pragma unroll
    for (int i = 0; i < 32; ++i) { w1[i] = W12[(size_t)(4 * g) * 8 + i]; w2[i] = W12[(size_t)(2048 + 4 * g) * 8 + i]; }
    const int per = TH / F.G;
    const int tb = F.bid * per;
    float x0[4], x1[4], x2[4];
    { const int sl = tb & (SEQ - 1);
#pragma unroll
      for (int i = 0; i < 4; ++i) { x0[i] = 0.f; x1[i] = 0.f; x2[i] = 0.f; }
      if (sl >= 1) { const v2u r = *(const v2u*)(XM + (size_t)(tb - 1) * CI + 4 * g); x2[0] = bflo(r.x); x2[1] = bfhi(r.x); x2[2] = bflo(r.y); x2[3] = bfhi(r.y); }
      if (sl >= 2) { const v2u r = *(const v2u*)(XM + (size_t)(tb - 2) * CI + 4 * g); x1[0] = bflo(r.x); x1[1] = bfhi(r.x); x1[2] = bflo(r.y); x1[3] = bfhi(r.y); }
      if (sl >= 3) { const v2u r = *(const v2u*)(XM + (size_t)(tb - 3) * CI + 4 * g); x0[0] = bflo(r.x); x0[1] = bfhi(r.x); x0[2] = bflo(r.y); x0[3] = bfhi(r.y); } }
    constexpr int L1PF = 4;
    v2u xq[L1PF][2];
#pragma unroll
    for (int pq = 0; pq < L1PF; ++pq)
#pragma unroll
        for (int tk = 0; tk < 2; ++tk) xq[pq][tk] = *(const v2u*)(XM + (size_t)(tb + 2 * pq + tk) * CI + 4 * g);
    for (int n4 = 0; n4 < per / 2; ++n4) { const int t4 = tb + 2 * n4;
        float gs[16]; v2u xr[2];
        xr[0] = xq[0][0]; xr[1] = xq[0][1];
#pragma unroll
        for (int pq = 0; pq + 1 < L1PF; ++pq) { xq[pq][0] = xq[pq + 1][0]; xq[pq][1] = xq[pq + 1][1]; }
        { const int tn = (n4 + L1PF < per / 2) ? t4 + 2 * L1PF : t4;
#pragma unroll
          for (int tk = 0; tk < 2; ++tk) xq[L1PF - 1][tk] = *(const v2u*)(XM + (size_t)(tn + tk) * CI + 4 * g); }
#pragma unroll
        for (int tk = 0; tk < 2; ++tk) { const int t = t4 + tk;
            float x3[4]; x3[0] = bflo(xr[tk].x); x3[1] = bfhi(xr[tk].x); x3[2] = bflo(xr[tk].y); x3[3] = bfhi(xr[tk].y);
            float xc[4], q[4], k[4], v[4];
#pragma unroll
            for (int i = 0; i < 4; ++i) { const float s = fmaf(cwr[3][i], x3[i], fmaf(cwr[2][i], x2[i], fmaf(cwr[1][i], x1[i], fmaf(cwr[0][i], x0[i], cbr[i])))); xc[i] = s * sigm(s); }
#pragma unroll
            for (int j = 0; j < 4; ++j) { q[j] = fmaf(xc[3], wqr[12 + j], fmaf(xc[2], wqr[8 + j], fmaf(xc[1], wqr[4 + j], xc[0] * wqr[j]))); k[j] = fmaf(xc[3], wkr[12 + j], fmaf(xc[2], wkr[8 + j], fmaf(xc[1], wkr[4 + j], xc[0] * wkr[j])));
                v[j] = fmaf(x3[3], wvr[12 + j], fmaf(x3[2], wvr[8 + j], fmaf(x3[1], wvr[4 + j], x3[0] * wvr[j]))); }
#pragma unroll
            for (int o = 0; o < 8; ++o) { float s = 0.f;
#pragma unroll
                for (int i = 0; i < 4; ++i) s = fmaf(x3[i], w2[i * 8 + o], fmaf(xc[i], w1[i * 8 + o], s));
                gs[tk * 8 + o] = s; }
            const size_t off = (size_t)t * CI + 4 * g; const float ks = 0.044194173824159216f;
            { v2u o; o.x = pk2(xc[0], xc[1]); o.y = pk2(xc[2], xc[3]); *(v2u*)(XC + off) = o; o.x = pk2(q[0], q[1]); o.y = pk2(q[2], q[3]); *(v2u*)(Q + off) = o;
              o.x = pk2(k[0] * ks, k[1] * ks); o.y = pk2(k[2] * ks, k[3] * ks); *(v2u*)(K + off) = o; o.x = pk2(v[0], v[1]); o.y = pk2(v[2], v[3]); *(v2u*)(V + off) = o; }
#pragma unroll
            for (int i = 0; i < 4; ++i) { x0[i] = x1[i]; x1[i] = x2[i]; x2[i] = x3[i]; } }
#define L1_STAGE(mask, n) { const bool hi_ = (lane & (mask)) != 0; _Pragma("unroll") for (int i = 0; i < (n) / 2; ++i) { const float send_ = hi_ ? gs[i] : gs[(n) / 2 + i]; const float keep_ = hi_ ? gs[(n) / 2 + i] : gs[i]; gs[i] = keep_ + __shfl_xor(send_, (mask)); } }
        L1_STAGE(32, 16) L1_STAGE(16, 8) L1_STAGE(8, 4) L1_STAGE(4, 2)
#undef L1_STAGE
        gs[0] += __shfl_xor(gs[0], 2); gs[0] += __shfl_xor(gs[0], 1);
        LAS float* rp = red + (n4 & 1) * 128;
        if ((lane & 3) == 0) rp[w * 16 + (lane >> 2)] = gs[0];
        LDS_WAIT(); __syncthreads();
        if (F.tid < 16) { float s = 0.f;
#pragma unroll
            for (int ww = 0; ww < 8; ++ww) s += rp[ww * 16 + F.tid];
            const int o = F.tid & 7; GI[(size_t)(t4 + (F.tid >> 3)) * 8 + o] = s + (o < 4 ? b_i[o] : b_f[o - 4]); }
    }
}
__device__ __forceinline__ void phase_gatescan(Frame& F) {
    unsigned char* ws = F.ws; const float* GI = (const float*)(ws + WS_GI); float* GA = (float*)(ws + WS_GA); float* GAM = (float*)(ws + WS_GAM); float* GEM = (float*)(ws + WS_GEM);
    const int lane = F.lane, w = F.wave, tid = F.tid; LAS float* wtot = (LAS float*)F.lds;
    for (int sq = F.bid; sq < (NB / 2) * 4; sq += F.G) { const int bl = sq >> 2, h = sq & 3; const size_t tq = (size_t)bl * SEQ + 4 * tid;
        float ip[4], c[4];
#pragma unroll
        for (int k = 0; k < 4; ++k) { ip[k] = GI[(tq + k) * 8 + h]; c[k] = -softplusf_(-GI[(tq + k) * 8 + 4 + h]); }
        c[1] += c[0]; c[2] += c[1]; c[3] += c[2];
        float inc = c[3];
#pragma unroll
        for (int o = 1; o < 64; o <<= 1) { const float n = __shfl_up(inc, o); if (lane >= o) inc += n; }
        if (lane == 63) wtot[w] = inc;
        LDS_WAIT(); __syncthreads();
        float off = inc - c[3];
#pragma unroll
        for (int ww = 0; ww < 8; ++ww) if (ww < w) off += wtot[ww];
        float Fv[4], av[4], m[4];
#pragma unroll
        for (int k = 0; k < 4; ++k) { Fv[k] = off + c[k]; av[k] = ip[k] - Fv[k]; }
        m[0] = av[0]; m[1] = fmaxf(m[0], av[1]); m[2] = fmaxf(m[1], av[2]); m[3] = fmaxf(m[2], av[3]);
        float incm = m[3];
#pragma unroll
        for (int o = 1; o < 64; o <<= 1) { const float n = __shfl_up(incm, o); if (lane >= o) incm = fmaxf(incm, n); }
        if (lane == 63) wtot[8 + w] = incm;
        LDS_WAIT(); __syncthreads();
        float offm = __shfl_up(incm, 1); if (lane == 0) offm = -INFINITY;
#pragma unroll
        for (int ww = 0; ww < 8; ++ww) if (ww < w) offm = fmaxf(offm, wtot[8 + ww]);
#pragma unroll
        for (int k = 0; k < 4; ++k) { const float A = fmaxf(offm, m[k]); GA[(tq + k) * 4 + h] = av[k]; GAM[(tq + k) * 4 + h] = A; GEM[(tq + k) * 4 + h] = __expf(-(Fv[k] + A)); }
        LDS_WAIT(); __syncthreads();
    }
}
constexpr int ML_PITCH = 1040, ML_TILE = 32 * ML_PITCH, ML_PP = 80, ML_PT = 64 * ML_PP;
constexpr int ML_K = 0, ML_V = 2 * ML_TILE, ML_P = 4 * ML_TILE, ML_DEN = ML_P + 2 * ML_PT, ML_AT = ML_DEN + 512, ML_AS = ML_AT + 256, ML_END = ML_AS + 8192;
constexpr int ML_ST = ML_P, ML_MR = ML_P + 4096;
static_assert(ML_MR + 512 <= ML_DEN, "mLSTM LDS tables");
static_assert(ML_END <= MISC_OFF, "mLSTM LDS");
__device__ __forceinline__ void tr_read_v4(unsigned a, bf16x8 (&vf)[4]) { s16x4 l0, h0, l1, h1, l2, h2, l3, h3;
    asm volatile("ds_read_b64_tr_b16 %0, %8\n\tds_read_b64_tr_b16 %1, %8 offset:4160\n\tds_read_b64_tr_b16 %2, %8 offset:32\n\tds_read_b64_tr_b16 %3, %8 offset:4192\n\t"
                 "ds_read_b64_tr_b16 %4, %8 offset:64\n\tds_read_b64_tr_b16 %5, %8 offset:4224\n\tds_read_b64_tr_b16 %6, %8 offset:96\n\tds_read_b64_tr_b16 %7, %8 offset:4256\n\ts_waitcnt lgkmcnt(0)"
                 : "=&v"(l0), "=&v"(h0), "=&v"(l1), "=&v"(h1), "=&v"(l2), "=&v"(h2), "=&v"(l3), "=&v"(h3) : "v"(a) : "memory");
    vf[0] = (bf16x8){l0[0], l0[1], l0[2], l0[3], h0[0], h0[1], h0[2], h0[3]}; vf[1] = (bf16x8){l1[0], l1[1], l1[2], l1[3], h1[0], h1[1], h1[2], h1[3]};
    vf[2] = (bf16x8){l2[0], l2[1], l2[2], l2[3], h2[0], h2[1], h2[2], h2[3]}; vf[3] = (bf16x8){l3[0], l3[1], l3[2], l3[3], h3[0], h3[1], h3[2], h3[3]}; }
static_assert(4 * ML_PITCH == 4160, "tr_read_v4 offsets");
__device__ __forceinline__ void tr_read_v8(unsigned a, bf16x8 (&vf)[8]) { s16x4 l0, h0, l1, h1, l2, h2, l3, h3, l4, h4, l5, h5, l6, h6, l7, h7;
    asm volatile("ds_read_b64_tr_b16 %0, %16\n\tds_read_b64_tr_b16 %1, %16 offset:4160\n\tds_read_b64_tr_b16 %2, %16 offset:32\n\tds_read_b64_tr_b16 %3, %16 offset:4192\n\t"
                 "ds_read_b64_tr_b16 %4, %16 offset:64\n\tds_read_b64_tr_b16 %5, %16 offset:4224\n\tds_read_b64_tr_b16 %6, %16 offset:96\n\tds_read_b64_tr_b16 %7, %16 offset:4256\n\t"
                 "ds_read_b64_tr_b16 %8, %16 offset:128\n\tds_read_b64_tr_b16 %9, %16 offset:4288\n\tds_read_b64_tr_b16 %10, %16 offset:160\n\tds_read_b64_tr_b16 %11, %16 offset:4320\n\t"
                 "ds_read_b64_tr_b16 %12, %16 offset:192\n\tds_read_b64_tr_b16 %13, %16 offset:4352\n\tds_read_b64_tr_b16 %14, %16 offset:224\n\tds_read_b64_tr_b16 %15, %16 offset:4384\n\ts_waitcnt lgkmcnt(0)"
                 : "=&v"(l0), "=&v"(h0), "=&v"(l1), "=&v"(h1), "=&v"(l2), "=&v"(h2), "=&v"(l3), "=&v"(h3), "=&v"(l4), "=&v"(h4), "=&v"(l5), "=&v"(h5), "=&v"(l6), "=&v"(h6), "=&v"(l7), "=&v"(h7) : "v"(a) : "memory");
    vf[0] = (bf16x8){l0[0], l0[1], l0[2], l0[3], h0[0], h0[1], h0[2], h0[3]}; vf[1] = (bf16x8){l1[0], l1[1], l1[2], l1[3], h1[0], h1[1], h1[2], h1[3]};
    vf[2] = (bf16x8){l2[0], l2[1], l2[2], l2[3], h2[0], h2[1], h2[2], h2[3]}; vf[3] = (bf16x8){l3[0], l3[1], l3[2], l3[3], h3[0], h3[1], h3[2], h3[3]};
    vf[4] = (bf16x8){l4[0], l4[1], l4[2], l4[3], h4[0], h4[1], h4[2], h4[3]}; vf[5] = (bf16x8){l5[0], l5[1], l5[2], l5[3], h5[0], h5[1], h5[2], h5[3]};
    vf[6] = (bf16x8){l6[0], l6[1], l6[2], l6[3], h6[0], h6[1], h6[2], h6[3]}; vf[7] = (bf16x8){l7[0], l7[1], l7[2], l7[3], h7[0], h7[1], h7[2], h7[3]}; }
template <int PB> __device__ __forceinline__ void phase_mlstm_t(Frame& F, const Args& a) {
    constexpr bool skK = PB & 1, skV = PB & 2, skS = PB & 4, skP = PB & 8, skE = PB & 16;
    unsigned char* ws = F.ws; const bf16* Q = (const bf16*)(ws + WS_Q); const bf16* K = (const bf16*)(ws + WS_K); const bf16* V = (const bf16*)(ws + WS_V); const bf16* XC = (const bf16*)(ws + WS_XC); const bf16* Z = (const bf16*)(ws + WS_Z);
    bf16* YC = (bf16*)(ws + WS_XM); const float* GA = (const float*)(ws + WS_GA); const float* GAM = (const float*)(ws + WS_GAM); const float* GEM = (const float*)(ws + WS_GEM);
    const float* mh_g = a.in[27]; const float* skip = a.in[28];
    const int tid = F.tid, lane = F.lane, w = F.wave, fr = lane & 15, fq = lane >> 4; LAS unsigned char* lds = F.lds;
    LAS float* den2 = (LAS float*)(lds + ML_DEN); LAS float* stats = (LAS float*)(lds + ML_ST); LAS float* mr = (LAS float*)(lds + ML_MR); LAS float* em_s = (LAS float*)(lds + ML_AT); LAS float* as_s = (LAS float*)(lds + ML_AS);
    const int st = w & 1, tp = (w >> 1) & 1, wv = w & 3;
    const unsigned vtr_lane = (unsigned)((8 * fq + ((lane & 15) >> 2)) * ML_PITCH + (128 * wv + 4 * (lane & 3)) * 2);
#define ML_DMA(gbase, tile_off) do { _Pragma("unroll") for (int r4 = 0; r4 < 4; ++r4) { const int rr = w + 8 * r4; \
        __builtin_amdgcn_global_load_lds((const unsigned*)((gbase) + (size_t)rr * CI + lane * 8), (LAS unsigned*)(lds + (tile_off) + rr * ML_PITCH), 16, 0, 0); } } while (0)
#define ML_STEP_HEAD() const int buf = k & 1; int j = k + jstart; if (j >= nk) j -= nk; int jn = j + 1; if (jn >= nk) jn -= nk; \
        asm volatile("s_waitcnt vmcnt(0) lgkmcnt(0)" ::: "memory"); __builtin_amdgcn_s_barrier(); asm volatile("" ::: "memory"); \
        if (k + 1 < nk && !skK) ML_DMA(Kb + (size_t)(32 * jn) * CI, ML_K + (buf ^ 1) * ML_TILE); \
        if (k < nk && !skV) ML_DMA(Vb + (size_t)(32 * j) * CI, ML_V + buf * ML_TILE)
    for (int r = 0; r < 8; ++r) { const int xcd = F.bid & 7, cq = F.bid >> 3, c16 = cq & 15; if (F.G != 256) break;
        const int part = r & 1, qi = part ? 31 - c16 : c16, bh = xcd + 8 * ((cq >> 4) + 2 * (r >> 1)), bl = bh >> 2, h = bh & 3; const size_t t0 = (size_t)bl * SEQ + 64 * qi; const int nk = 2 * (qi + 1), jstart = part ? 2 * (c16 + 1) : 0;
        const bf16* Kb = K + (size_t)bl * SEQ * CI + h * 512; const bf16* Vb = V + (size_t)bl * SEQ * CI + h * 512;
        ML_DMA(Kb + (size_t)(32 * jstart) * CI, ML_K);
        float tb_e, tb_a[4];
        tb_e = GEM[(t0 + (tid & 63)) * 4 + h];
#pragma unroll
        for (int i4 = 0; i4 < 4; ++i4) tb_a[i4] = GA[((size_t)bl * SEQ + tid + 512 * i4) * 4 + h];
#define ML_TABLES() do { if (tid < 64) em_s[tid] = tb_e; _Pragma("unroll") for (int i4 = 0; i4 < 4; ++i4) { const int sidx = tid + 512 * i4; if (sidx < 64 * (qi + 1)) as_s[sidx] = tb_a[i4]; } } while (0)
        const int c8 = lane * 8, cc = h * 512 + c8;
#define ML_EPI_LOADS(N, ROW0) v4u zr[N], xr[N]; float gm[8], sk[8]; asm volatile("" ::: "memory"); __builtin_amdgcn_sched_barrier(0); if (!skE) { _Pragma("unroll") for (int k8 = 0; k8 < N; ++k8) { const size_t off = (t0 + (ROW0) + k8) * CI + cc; zr[k8] = *(const v4u*)(Z + off); xr[k8] = *(const v4u*)(XC + off); } \
        _Pragma("unroll") for (int q = 0; q < 8; ++q) { gm[q] = mh_g[cc + q]; sk[q] = skip[cc + q]; } }
#define ML_EPI_PASS(N, ROW0) if (!skE) { const LAS float* ytile = (const LAS float*)lds; _Pragma("unroll") for (int k8 = 0; k8 < N; ++k8) { const int row = (ROW0) + k8; const size_t off = (t0 + row) * CI + cc; \
              const f32x4 y0 = *(const LAS f32x4*)(ytile + row * 516 + c8), y1 = *(const LAS f32x4*)(ytile + row * 516 + c8 + 4); float zf[8], xf[8], o[8]; unpack8(zr[k8], zf); unpack8(xr[k8], xf); \
              _Pragma("unroll") for (int q = 0; q < 8; ++q) { const float yv = q < 4 ? y0[q & 3] : y1[q & 3]; o[q] = (yv * gm[q] + sk[q] * xf[q]) * (zf[q] * sigm(zf[q])); } \
              *(v4u*)(YC + off) = pack8(o); } }
        if (w < 4) {
            bf16x8 qf[2][16];
            { const bf16* qp = Q + (t0 + 32 * tp + fr) * CI + h * 512 + fq * 8;
#pragma unroll
              for (int ks = 0; ks < 16; ++ks) { qf[0][ks] = *(const bf16x8*)(qp + 32 * ks); qf[1][ks] = *(const bf16x8*)(qp + 16 * CI + 32 * ks); } }
            const float At0 = GAM[(t0 + 32 * tp + fr) * 4 + h], At1 = GAM[(t0 + 32 * tp + 16 + fr) * 4 + h];
            ML_TABLES();
            float denp0 = 0.f, denp1 = 0.f;
            for (int k = 0; k <= nk; ++k) { ML_STEP_HEAD();
                if (k < nk && !skS) {
                    f32x4 s0a = {0.f, 0.f, 0.f, 0.f}, s0b = {0.f, 0.f, 0.f, 0.f}, s1a = {0.f, 0.f, 0.f, 0.f}, s1b = {0.f, 0.f, 0.f, 0.f};
                    { const LAS unsigned char* kl = lds + ML_K + buf * ML_TILE + (16 * st + fr) * ML_PITCH + fq * 16; bf16x8 kc[4], kn[4];
#pragma unroll
                      for (int q = 0; q < 4; ++q) kc[q] = *(const LAS bf16x8*)(kl + 64 * q);
#pragma unroll
                      for (int g = 0; g < 4; ++g) {
                          if (g < 3) {
#pragma unroll
                              for (int q = 0; q < 4; ++q) kn[q] = *(const LAS bf16x8*)(kl + 64 * (4 * g + 4 + q)); }
                          __builtin_amdgcn_sched_barrier(0);
#pragma unroll
                          for (int q = 0; q < 4; q += 2) { const int ks = 4 * g + q;
                              s0a = __builtin_amdgcn_mfma_f32_16x16x32_bf16(kc[q], qf[0][ks], s0a, 0, 0, 0); s1a = __builtin_amdgcn_mfma_f32_16x16x32_bf16(kc[q], qf[1][ks], s1a, 0, 0, 0);
                              s0b = __builtin_amdgcn_mfma_f32_16x16x32_bf16(kc[q + 1], qf[0][ks + 1], s0b, 0, 0, 0); s1b = __builtin_amdgcn_mfma_f32_16x16x32_bf16(kc[q + 1], qf[1][ks + 1], s1b, 0, 0, 0); }
                          __builtin_amdgcn_sched_barrier(0);
                          if (g < 3) {
#pragma unroll
                              for (int q = 0; q < 4; ++q) kc[q] = kn[q]; } } }
                    s0a += s0b; s1a += s1b;
                    const f32x4 asv = *(const LAS f32x4*)(as_s + 32 * j + 16 * st + 4 * fq); const float as[4] = {asv[0], asv[1], asv[2], asv[3]};
                    float p0[4], p1[4]; const int sbase = 32 * j + 16 * st + 4 * fq, tbase = 64 * qi + 32 * tp + fr;
#pragma unroll
                    for (int i = 0; i < 4; ++i) { p0[i] = (sbase + i) <= tbase ? s0a[i] * __builtin_amdgcn_exp2f((as[i] - At0) * LOG2E) : 0.f; p1[i] = (sbase + i) <= tbase + 16 ? s1a[i] * __builtin_amdgcn_exp2f((as[i] - At1) * LOG2E) : 0.f; }
                    denp0 += (p0[0] + p0[1]) + (p0[2] + p0[3]); denp1 += (p1[0] + p1[1]) + (p1[2] + p1[3]);
                    { LAS unsigned char* pp = lds + ML_P + buf * ML_PT + (32 * tp + fr) * ML_PP + (16 * st + 4 * fq) * 2; v2u pw; pw.x = pk2(p0[0], p0[1]); pw.y = pk2(p0[2], p0[3]); *(LAS v2u*)pp = pw;
                      pw.x = pk2(p1[0], p1[1]); pw.y = pk2(p1[2], p1[3]); *(LAS v2u*)(pp + 16 * ML_PP) = pw; }
                } }
            ML_EPI_LOADS(12, 12 * w);
            { float d0 = denp0, d1 = denp1; d0 += __shfl_xor(d0, 16); d1 += __shfl_xor(d1, 16); d0 += __shfl_xor(d0, 32); d1 += __shfl_xor(d1, 32);
              if (fq == 0) { den2[st * 64 + 32 * tp + fr] = d0; den2[st * 64 + 32 * tp + 16 + fr] = d1; } }
            LDS_WAIT(); __builtin_amdgcn_s_barrier(); asm volatile("" ::: "memory");
            __builtin_amdgcn_s_barrier(); asm volatile("" ::: "memory");
            if (tid < 64) { float a1 = 0.f, a2 = 0.f;
#pragma unroll
                for (int ww = 0; ww < 4; ++ww) { a1 += stats[(ww * 64 + tid) * 2]; a2 += stats[(ww * 64 + tid) * 2 + 1]; }
                const float mean = a1 * (1.f / 512.f), var = fmaxf(a2 * (1.f / 512.f) - mean * mean, 0.f); mr[2 * tid] = mean; mr[2 * tid + 1] = rsqrtf(var + 1e-5f); }
            LDS_WAIT(); __builtin_amdgcn_s_barrier(); asm volatile("" ::: "memory");
            __builtin_amdgcn_s_barrier(); asm volatile("" ::: "memory");
            ML_EPI_PASS(12, 12 * w)
        } else {
            f32x4 O[4][8];
#pragma unroll
            for (int i = 0; i < 4; ++i)
#pragma unroll
                for (int e = 0; e < 8; ++e) O[i][e] = (f32x4){0.f, 0.f, 0.f, 0.f};
            ML_TABLES();
            for (int k = 0; k <= nk; ++k) { ML_STEP_HEAD();
                if (k >= 1 && !skP) { bf16x8 vf[8], pf[4]; const unsigned vb = (unsigned)(size_t)(lds + ML_V + (buf ^ 1) * ML_TILE) + vtr_lane; const LAS unsigned char* pl = lds + ML_P + (buf ^ 1) * ML_PT + fr * ML_PP + fq * 16;
#pragma unroll
                    for (int i = 0; i < 4; ++i) pf[i] = *(const LAS bf16x8*)(pl + 16 * i * ML_PP);
                    tr_read_v8(vb, vf);
#pragma unroll
                    for (int i = 0; i < 4; ++i)
#pragma unroll
                        for (int e = 0; e < 8; ++e) O[i][e] = __builtin_amdgcn_mfma_f32_16x16x32_bf16(pf[i], vf[e], O[i][e], 0, 0, 0); } }
            LDS_WAIT(); __builtin_amdgcn_s_barrier(); asm volatile("" ::: "memory");
            { const LAS float* den_q = den2 + 4 * fq; const LAS float* em_q = em_s + 4 * fq; LAS float* st_q = stats + (wv * 64 + 4 * fq) * 2;
#pragma unroll
              for (int i = 0; i < 4; ++i) {
#pragma unroll
                for (int jj = 0; jj < 4; ++jj) { const float dn = den_q[16 * i + jj] + den_q[64 + 16 * i + jj]; const float inv = 1.0f / fmaxf(fabsf(dn), em_q[16 * i + jj]); float a1 = 0.f, a2 = 0.f;
#pragma unroll
                    for (int e = 0; e < 8; ++e) { const float hv = O[i][e][jj] * inv; O[i][e][jj] = hv; a1 += hv; a2 += hv * hv; }
                    { a1 += DPP_MOVF(a1, 0xB1); a2 += DPP_MOVF(a2, 0xB1); a1 += DPP_MOVF(a1, 0x4E); a2 += DPP_MOVF(a2, 0x4E); a1 += DPP_MOVF(a1, 0x141); a2 += DPP_MOVF(a2, 0x141); a1 += DPP_MOVF(a1, 0x140); a2 += DPP_MOVF(a2, 0x140); }
                    if (fr == 0) { st_q[(16 * i + jj) * 2] = a1; st_q[(16 * i + jj) * 2 + 1] = a2; } } } }
            LDS_WAIT(); __builtin_amdgcn_s_barrier(); asm volatile("" ::: "memory");
            __builtin_amdgcn_s_barrier(); asm volatile("" ::: "memory");
            { LAS float* yt_q = (LAS float*)lds + 4 * fq * 516 + 128 * wv + fr; const LAS float* mr_q = mr + 8 * fq;
#pragma unroll
              for (int i = 0; i < 4; ++i)
#pragma unroll
                for (int jj = 0; jj < 4; ++jj) { const float mean = mr_q[(16 * i + jj) * 2], rstd = mr_q[(16 * i + jj) * 2 + 1];
#pragma unroll
                    for (int e = 0; e < 8; ++e) yt_q[(16 * i + jj) * 516 + 16 * e] = (O[i][e][jj] - mean) * rstd; } }
            LDS_WAIT(); __builtin_amdgcn_s_barrier(); asm volatile("" ::: "memory");
            ML_EPI_LOADS(4, 48 + 4 * wv);
            ML_EPI_PASS(4, 48 + 4 * wv)
        }
        VM_WAIT(); __syncthreads();
    }
#undef ML_DMA
#undef ML_STEP_HEAD
#undef ML_TABLES
#undef ML_EPI_LOADS
#undef ML_EPI_PASS
}
__device__ __forceinline__ void phase_mlstm(Frame& F, const Args& a) { phase_mlstm_t<0>(F, a); }
#ifdef ML_PROBE
__device__ __forceinline__ void phase_mlstm_probe(Frame& F, const Args& a) { phase_mlstm_t<ML_PROBE>(F, a); }
#endif

#ifdef ML_DMAPROBE
__device__ __forceinline__ void phase_mlstm_dmaprobe(Frame& F, const Args& a) {
    unsigned char* ws = F.ws; const bf16* K = (const bf16*)(ws + WS_K); const bf16* V = (const bf16*)(ws + WS_V);
    const int lane = F.lane, w = F.wave; LAS unsigned char* lds = F.lds;
#define MLP_DMA(gbase, tile_off) do { _Pragma("unroll") for (int r4 = 0; r4 < 4; ++r4) { const int rr = w + 8 * r4; \
        __builtin_amdgcn_global_load_lds((const unsigned*)((gbase) + (size_t)rr * CI + lane * 8), (LAS unsigned*)(lds + (tile_off) + rr * ML_PITCH), 16, 0, 0); } } while (0)
    for (int r = 0; r < 8; ++r) { const int xcd = F.bid & 7, cq = F.bid >> 3, c16 = cq & 15; if (F.G != 256) break;
        const int part = r & 1, qi = part ? 31 - c16 : c16, bh = xcd + 8 * ((cq >> 4) + 2 * (r >> 1)), bl = bh >> 2, h = bh & 3; const int nk = 2 * (qi + 1), jstart = part ? 2 * (c16 + 1) : 0;
        const bf16* Kb = K + (size_t)bl * SEQ * CI + h * 512; const bf16* Vb = V + (size_t)bl * SEQ * CI + h * 512;
        for (int k = 0; k <= nk; ++k) { const int buf = k & 1; int j = k + jstart; if (j >= nk) j -= nk; int jn = j + 1; if (jn >= nk) jn -= nk;
            asm volatile("s_waitcnt vmcnt(0) lgkmcnt(0)" ::: "memory"); __builtin_amdgcn_s_barrier(); asm volatile("" ::: "memory");
            if ((ML_DMAPROBE & 1) && k + 1 < nk) MLP_DMA(Kb + (size_t)(32 * jn) * CI, ML_K + (buf ^ 1) * ML_TILE);
            if ((ML_DMAPROBE & 2) && k < nk) MLP_DMA(Vb + (size_t)(32 * j) * CI, ML_V + buf * ML_TILE);
        }
        VM_WAIT(); __syncthreads();
    }
#undef MLP_DMA
}
#endif
#ifdef ML_DMAPROBE
#define ML_PROBE_CALL phase_mlstm_dmaprobe(F, args);
#elif defined(ML_PROBE)
#define ML_PROBE_CALL phase_mlstm_probe(F, args);
#else
#define ML_PROBE_CALL
#endif
#define GEMM_PHASE(EPI, Aptr, Bptr, M_, N_, K_, ...) do { pg8::Gemm g{(const pg8::bf16_t*)(Aptr), (const pg8::bf16_t*)(Bptr), (M_), (N_), (K_)}; pg8::StaticOrder So; So.init((M_), (N_), F.G, F.bid); \
        pg8::EPI Ep{__VA_ARGS__}; pg8::gemm_phase<pg8::EPI, pg8::StaticOrder, PG8_ALIGN, PG8_SP2>(F.lds, g, So, Ep); } while (0)
namespace pg8 { typedef EpiRes2<float> EpiResF; typedef EpiRes2<bf16_t> EpiResB; typedef EpiPle2<false> EpiPleB; typedef EpiPle2<true> EpiPleF; }
__global__ void __launch_bounds__(NWAVES * 64, 2) trunk_fwd(Args args) {
    extern __shared__ __attribute__((aligned(16))) unsigned char lds_raw[];
    Frame F; F.lds = (LAS unsigned char*)lds_raw; F.ws = args.ws; F.in = nullptr;
    F.tid = threadIdx.x; F.lane = F.tid & 63; F.wave = __builtin_amdgcn_readfirstlane(F.tid >> 6); F.G = gridDim.x; F.bid = blockIdx.x;
    volatile LAS unsigned* MISC = (volatile LAS unsigned*)(F.lds + MISC_OFF);
    if (F.tid < 64) MISC[F.tid] = 0u;
    __syncthreads();
    XcdBarrier bar; bar.bar = (unsigned*)(args.ws + WS_CTL) + CW_BAR; bar.x = 0; bar.st = nullptr;
    if (args.use_bar) bar = xcd_barrier_post((unsigned*)(args.ws + WS_CTL) + CW_BAR, MISC + 8);
    unsigned* xrank = (unsigned*)(args.ws + WS_CTL) + CW_XRANK; const unsigned my_xcc = xb_xcc_id();
    if (args.use_bar && F.tid == 0) MISC[12] = xb_add(&xrank[64 * my_xcc], 1u);
    const int lo = args.ph_lo, hi = args.ph_hi;
#ifndef ONLY_SITE
#define ONLY_SITE -1
#endif
#define EN(n) (ONLY_SITE < 0 || ONLY_SITE == (n))
#ifndef REP_MASK
#define REP_MASK 0u
#endif
#define NREP(n) (((REP_MASK >> (n)) & 1u) ? 2 : 1)
#define IN(k) (lo <= (k) && (k) < hi)
#define SEAM(k) do { if (IN(k) && IN((k) + 1)) xcd_barrier(bar); } while (0)
    unsigned char* ws = args.ws; float* out = args.out;
    float* RS = (float*)(ws + WS_RS);
#define RSN(i) (RS + (size_t)(i) * T * 16)
#define PH(site, k, ...) if (EN(site) && IN(k)) { for (int rep_ = 0; rep_ < NREP(site); ++rep_) { if (rep_) xcd_barrier(bar); __VA_ARGS__ } } SEAM(k);
    PH(0, 0, phase_prologue(F, args); phase_cast_sq(F, args.in[0], (bf16*)(ws + WS_XB2), RSN(0), T); phase_cvt_p(F, args.in[1], (bf16*)(ws + WS_PB));)
    if (args.use_bar && lo == 0 && hi > 1) {
        bool ok = F.G == 256; for (int x = 0; x < 16; ++x) { const unsigned cx = xb_ld(&xrank[64 * x]); ok = ok && (cx == (x < 8 ? 32u : 0u)); }
        const unsigned rk = MISC[12]; if (ok && rk < 32u && my_xcc < 8u) F.bid = (int)(rk * 8u + my_xcc); }
    PH(2, 1, GEMM_PHASE(EpiBf16SplitR, ws + WS_XB2, ws + WS_WIN, T, NU, D, (pg8::bf16_t*)(ws + WS_UA), UA_W, 4, (pg8::bf16_t*)(ws + WS_UB), UB_W, RSN(0));)
    PH(3, 2, phase_prepA(F, args);)
    PH(4, 3, GEMM_PHASE(EpiBf16Split, ws + WS_LIN, ws + WS_WLORA, T, 1536, 256 + args.pad, (pg8::bf16_t*)(ws + WS_LOUT), 1536, 1 << 20, nullptr, 0);)
    PH(5, 4, phase_indexer(F);)
    PH(6, 5, phase_dsa_attn(F, args);)
    PH(7, 6, phase_rwkv(F, args);)
    PH(8, 7, GEMM_PHASE(EpiResF, ws + WS_XB, ws + WS_WOUT, T, D, D, args.in[0], (pg8::bf16_t*)(ws + WS_XB2), D, RSN(1));)
#define FFN_PLE(L, pb, rs_a, rs_b, rs_c, PLE_EPI, ple_out) do { const size_t lw = (size_t)(L) * WS_LAYER_STRIDE; \
        PH(21, (pb), GEMM_PHASE(EpiSwigluR, ws + WS_XB2, ws + WS_WGU0 + lw, T, 2 * FF, D, (pg8::bf16_t*)(ws + WS_H), FF, RSN(rs_a));) \
        PH(22, (pb) + 1, GEMM_PHASE(EpiResB, ws + WS_H, ws + WS_WD0 + lw, T, D, FF, (const pg8::bf16_t*)(ws + WS_XB2), (pg8::bf16_t*)(ws + WS_XB), D, RSN(rs_b));) \
        PH(24, (pb) + 2, GEMM_PHASE(EpiBf16Split, ws + WS_PB, ws + WS_WPLE0 + lw, T, D, 256 + args.pad, (pg8::bf16_t*)(ws + WS_E), D, 1 << 20, nullptr, 0);) \
        PH(25, (pb) + 3, GEMM_PHASE(PLE_EPI, ws + WS_XB, ws + WS_WPG0 + lw, T, D, D, (const pg8::bf16_t*)(ws + WS_XB), (void*)(ple_out), (const pg8::bf16_t*)(ws + WS_E), D, RSN(rs_b), RSN(rs_c));) } while (0)
#define L1_HALF(hb, p1) do { bf16* xbh = (bf16*)(ws + WS_XB2) + (size_t)(hb) * TH * D; \
        PH(11, (p1), GEMM_PHASE(EpiBf16SplitR, xbh, ws + WS_WUP, TH, 2 * CI, D, (pg8::bf16_t*)(ws + WS_XM), CI, 8, (pg8::bf16_t*)(ws + WS_Z), CI, RSN(3) + (size_t)(hb) * TH * 16);) \
        PH(12, (p1) + 1, phase_l1prep(F, args, hb);) \
        PH(13, (p1) + 2, phase_gatescan(F); if ((hb) == 0) phase_cvt_p(F, args.in[1] + (size_t)T * 256, (bf16*)(ws + WS_PB));) \
        PH(14, (p1) + 3, ML_PROBE_CALL phase_mlstm(F, args);) \
        PH(15, (p1) + 4, GEMM_PHASE(EpiResB, ws + WS_XM, ws + WS_WDOWN, TH, D, CI, (const pg8::bf16_t*)xbh, (pg8::bf16_t*)xbh, D, RSN(4) + (size_t)(hb) * TH * 16);) } while (0)
    FFN_PLE(0, 8, 1, 2, 3, EpiPleB, ws + WS_XB2);
    L1_HALF(0, 12);
    L1_HALF(1, 17);
    FFN_PLE(1, 22, 4, 5, 5, EpiPleF, out);
#undef IN
#undef SEAM
}
constexpr int N_PHASES = 26;

#ifndef MK_ONE_LAUNCH
#define MK_ONE_LAUNCH 1
#endif
extern "C" void kernel_launch(void* const* d_in, const int* in_sizes, int n_in, void* d_out, int out_size, void* d_ws, size_t ws_size, hipStream_t stream) {
    static int grid = 0;
    if (grid == 0) {
        if (n_in != 37 || in_sizes[0] != T * D || out_size != T * D || ws_size < WS_END) { fprintf(stderr, "kernel_launch: unexpected shapes (n_in %d, in0 %d, out %d, ws %zu < %zu); nothing launched\n", n_in, n_in > 0 ? in_sizes[0] : -1, out_size, ws_size, (size_t)WS_END); grid = -1; return; }
        int dev = 0, cus = 0, per_cu = 0;
        if (hipGetDevice(&dev) != hipSuccess || hipDeviceGetAttribute(&cus, hipDeviceAttributeMultiprocessorCount, dev) != hipSuccess) { grid = -1; return; }
        if (hipFuncSetAttribute((const void*)trunk_fwd, hipFuncAttributeMaxDynamicSharedMemorySize, LDS_BYTES) != hipSuccess) { fprintf(stderr, "kernel_launch: hipFuncSetAttribute failed\n"); grid = -1; return; }
        if (hipOccupancyMaxActiveBlocksPerMultiprocessor(&per_cu, (const void*)trunk_fwd, NWAVES * 64, LDS_BYTES) != hipSuccess || per_cu < 1) { fprintf(stderr, "kernel_launch: occupancy query says %d\n", per_cu); }
        (void)hipGetLastError();
        grid = cus;
        if (grid != 256) { fprintf(stderr, "kernel_launch: built for 256 CUs, found %d; nothing launched\n", cus); grid = -1; return; }
    }
    if (grid < 0) return;
    if (hipMemsetAsync((char*)d_ws + WS_CTL, 0, CTL_ZERO_BYTES, stream) != hipSuccess) return;
    Args a{};
    for (int i = 0; i < 37; ++i) a.in[i] = (const float*)d_in[i];
    a.out = (float*)d_out; a.ws = (unsigned char*)d_ws; a.pad = 0;
#if MK_ONE_LAUNCH
    a.ph_lo = 0; a.ph_hi = N_PHASES; a.use_bar = 1;
    hipLaunchKernelGGL(trunk_fwd, dim3(grid), dim3(NWAVES * 64), LDS_BYTES, stream, a);
#else
    for (int p = 0; p < N_PHASES; ++p) { a.ph_lo = p; a.ph_hi = p + 1; a.use_bar = 0; hipLaunchKernelGGL(trunk_fwd, dim3(grid), dim3(NWAVES * 64), LDS_BYTES, stream, a); }
#endif
}
```

```cpp
#include <hip/hip_runtime.h>
#include <cstdio>
#include <cstdint>
namespace pg8 {
#define PG8_LAS __attribute__((address_space(3)))
typedef unsigned short bf16_t;
typedef short bf16x8 __attribute__((ext_vector_type(8)));
typedef float f32x4 __attribute__((ext_vector_type(4)));
typedef unsigned u32x4 __attribute__((ext_vector_type(4)));
constexpr int BM = 256, BK = 64, HALF = 128, HTB = HALF * BK * 2  , STAGE_BYTES = 8 * HTB, NXCD = 8, WGM = 8;

__host__ __device__ __forceinline__ int lds_byte(int r, int c) { const int st = (r >> 4) * 2 + (c >> 5), rr = r & 15, cc = c & 31, ob = rr * 64 + cc * 2; return st * 1024 + (ob ^ (((ob >> 9) & 1) << 5)); }
__host__ __device__ __forceinline__ void stage_rc(int b, int& R, int& C) { const int st = b / 1024, sb = b % 1024, swz = sb ^ (((sb >> 9) & 1) << 5); R = (st >> 1) * 16 + swz / 64; C = (st & 1) * 32 + (swz % 64) / 2; }
__host__ __device__ __forceinline__ int perm32(int rho) { const int n = rho >> 4, i = rho & 15; return 8 * (i >> 2) + 4 * n + (i & 3); }

struct Unit { int pm, pn; };
struct Gemm { const bf16_t* A; const bf16_t* Bt; int M, N, K; };

struct StaticOrder {
    int nM, nN, nwg, G, c;
    __host__ __device__ void init(int M, int N, int G_, int c_) { nM = M / BM; nN = N / BM; nwg = nM * nN; G = G_; c = c_; }
    __host__ __device__ bool next(int i, Unit& u) const {
        const long L = (long)i * G + c; if (L >= nwg) return false;
        int wgid = (int)L; { const int q = nwg / NXCD, r = nwg % NXCD, xcd = wgid % NXCD, off = wgid / NXCD; wgid = (xcd < r ? xcd * (q + 1) : r * (q + 1) + (xcd - r) * q) + off; }
        const int nig = WGM * nN, gid = wgid / nig, fm = gid * WGM, gsz = (nM - fm) < WGM ? (nM - fm) : WGM;
        u.pm = fm + ((wgid % nig) % gsz); u.pn = (wgid % nig) / gsz; return true;
    }
    __device__ __forceinline__ void a_ready(const Unit&) const {}
    __device__ __forceinline__ void done(const Unit&) const {}
};

__device__ __forceinline__ unsigned cvt_pk_bf16(float lo, float hi) { unsigned r; asm volatile("v_cvt_pk_bf16_f32 %0, %1, %2" : "=v"(r) : "v"(lo), "v"(hi)); return r; }
typedef float f32x2 __attribute__((ext_vector_type(2)));
__device__ __forceinline__ f32x2 gelu_pk(f32x2 v) {
    const f32x2 av = __builtin_elementwise_abs(v), d = av * 0.2316418882f + 1.0f;
    f32x2 t; t.x = __builtin_amdgcn_rcpf(d.x); t.y = __builtin_amdgcn_rcpf(d.y);
    f32x2 q = t * 0.5307027145f + (-0.7265760135f); q = q * t + 0.7107068705f; q = q * t + (-0.142248368f); q = q * t + 0.127414796f; q = q * t;
    const f32x2 s = (v * v) * (-0.72134752044f);
    f32x2 e; e.x = __builtin_amdgcn_exp2f(s.x); e.y = __builtin_amdgcn_exp2f(s.y);
    const f32x2 m = v * (q * e), r = v - m;
    f32x2 o; o.x = v.x < 0.f ? m.x : r.x; o.y = v.y < 0.f ? m.y : r.y; return o;
}

template <class Epi, class Sched, bool ALIGN_EPI = false, bool SP2 = false>
__device__ __forceinline__ void gemm_phase(PG8_LAS unsigned char* lds, const Gemm g, const Sched& S, const Epi& E) {
    const int tid = threadIdx.x, wid = __builtin_amdgcn_readfirstlane(tid >> 6), lane = tid & 63, wr = wid >> 2, wc = wid & 3, fr = lane & 15, fq = lane >> 4;
    const int K = g.K, nt = K / BK;
    unsigned voffA[2], voffB[2];
#pragma unroll
    for (int i = 0; i < 2; ++i) { int R, C; stage_rc(tid * 16 + i * 8192, R, C); const int Rb = Epi::PERM ? ((R & ~31) + perm32(R & 31)) : R;
        voffA[i] = (unsigned)(R * K + C) * 2u; voffB[i] = (unsigned)(Rb * K + C) * 2u; }
    const size_t kstep = (size_t)(BK * 2);
    const size_t hstep = (size_t)HALF * K * 2;
    const size_t tstep = 2 * hstep;
    const unsigned ldsw = (unsigned)wid * 1024u;
    const int aoff = lds_byte(wr * 64 + fr, fq * 8), boff = lds_byte(wc * 32 + fr, fq * 8);
#define PG8_SA(b, h) (((b) * 2 + (h)) * HTB)
#define PG8_SB(b, h) ((4 + (b) * 2 + (h)) * HTB)
#define PG8_STAGE(bufoff, gbase, voff) do { _Pragma("unroll") for (int _i = 0; _i < 2; ++_i) \
        __builtin_amdgcn_global_load_lds((const unsigned*)((const char*)(gbase) + (voff)[_i]), (PG8_LAS unsigned*)(lds + (bufoff) + ldsw + _i * 8192), 16, 0, 0); } while (0)
#define PG8_LDA(dst, b, h) do { _Pragma("unroll") for (int m = 0; m < 4; ++m) _Pragma("unroll") for (int k = 0; k < 2; ++k) dst[m][k] = *(const PG8_LAS bf16x8*)(lds + PG8_SA(b, h) + aoff + m * 2048 + k * 1024); } while (0)
#define PG8_LDB(dst, b, h) do { _Pragma("unroll") for (int n = 0; n < 2; ++n) _Pragma("unroll") for (int k = 0; k < 2; ++k) dst[n][k] = *(const PG8_LAS bf16x8*)(lds + PG8_SB(b, h) + boff + n * 2048 + k * 1024); } while (0)
#define PG8_MMA(ai, bj, At, Bt) do { __builtin_amdgcn_s_setprio(1); _Pragma("unroll") for (int m = 0; m < 4; ++m) _Pragma("unroll") for (int n = 0; n < 2; ++n) _Pragma("unroll") for (int k = 0; k < 2; ++k) \
        acc[ai][bj][m][n] = __builtin_amdgcn_mfma_f32_16x16x32_bf16(Bt[n][k], At[m][k], acc[ai][bj][m][n], 0, 0, 0); __builtin_amdgcn_s_setprio(0); } while (0)
#define PG8_WAIT_V(n) asm volatile("s_waitcnt vmcnt(" #n ")" ::: "memory")
#define PG8_WAIT_L(n) asm volatile("s_waitcnt lgkmcnt(" #n ")" ::: "memory")
#define PG8_BAR __builtin_amdgcn_s_barrier()
#define PG8_SCHED __builtin_amdgcn_sched_barrier(0)
    Unit cur, nxt; int ui = 0;
    if (!S.next(0, cur)) return;
    f32x4 acc[2][2][4][2];
#pragma unroll
    for (int a = 0; a < 2; ++a)
#pragma unroll
        for (int b = 0; b < 2; ++b)
#pragma unroll
            for (int m = 0; m < 4; ++m)
#pragma unroll
                for (int n = 0; n < 2; ++n) acc[a][b][m][n] = (f32x4){0.f, 0.f, 0.f, 0.f};
    bf16x8 At[4][2], B0[2][2], B1[2][2];
    const char* cA = (const char*)g.A + (size_t)cur.pm * tstep; const char* cB = (const char*)g.Bt + (size_t)cur.pn * tstep;
    S.a_ready(cur);
    if constexpr (SP2) {
        PG8_STAGE(PG8_SB(0, 0), cB, voffB); PG8_STAGE(PG8_SB(0, 1), cB + hstep, voffB); PG8_STAGE(PG8_SA(0, 0), cA, voffA); PG8_STAGE(PG8_SA(0, 1), cA + hstep, voffA);
        if (wr == 1) PG8_BAR;
        PG8_WAIT_V(2); PG8_BAR;
        PG8_STAGE(PG8_SB(1, 0), cB + kstep, voffB); PG8_STAGE(PG8_SA(1, 0), cA + kstep, voffA); PG8_STAGE(PG8_SB(1, 1), cB + hstep + kstep, voffB);
        PG8_WAIT_V(6); PG8_BAR;
    } else {
        PG8_STAGE(PG8_SB(0, 0), cB, voffB); PG8_STAGE(PG8_SA(0, 0), cA, voffA); PG8_STAGE(PG8_SB(0, 1), cB + hstep, voffB); PG8_STAGE(PG8_SA(0, 1), cA + hstep, voffA);
        if (wr == 1) PG8_BAR;
        PG8_WAIT_V(4); PG8_BAR;
        PG8_STAGE(PG8_SB(1, 0), cB + kstep, voffB); PG8_STAGE(PG8_SA(1, 0), cA + kstep, voffA); PG8_STAGE(PG8_SB(1, 1), cB + hstep + kstep, voffB);
        PG8_WAIT_V(6); PG8_BAR;
    }
    for (;;) {
        const bool has_next = S.next(ui + 1, nxt);
        const char* nA = has_next ? (const char*)g.A + (size_t)nxt.pm * tstep : cA; const char* nB = has_next ? (const char*)g.Bt + (size_t)nxt.pn * tstep : cB;
        for (int t = 0; t < nt; t += 2) {
            const bool last = (t == nt - 2);
            const char* a1 = cA + (size_t)(t + 1) * kstep;
            const char* a2 = last ? nA : cA + (size_t)(t + 2) * kstep; const char* b2 = last ? nB : cB + (size_t)(t + 2) * kstep;
            const char* a3 = a2 + kstep; const char* b3 = b2 + kstep;
            if (last && has_next) S.a_ready(nxt);
            if constexpr (SP2) {
            PG8_LDB(B0, 0, 0); PG8_LDB(B1, 0, 1); PG8_SCHED; PG8_LDA(At, 0, 0); PG8_STAGE(PG8_SA(1, 1), a1 + hstep, voffA);
            PG8_WAIT_V(8); PG8_WAIT_L(0); PG8_BAR; PG8_MMA(0, 0, At, B0); PG8_MMA(0, 1, At, B1); PG8_BAR; PG8_SCHED;
            PG8_LDA(At, 0, 1); PG8_STAGE(PG8_SB(0, 0), b2, voffB); PG8_STAGE(PG8_SB(0, 1), b2 + hstep, voffB); PG8_STAGE(PG8_SA(0, 0), a2, voffA);
            PG8_WAIT_V(8); PG8_WAIT_L(0); PG8_BAR; PG8_MMA(1, 0, At, B0); PG8_MMA(1, 1, At, B1); PG8_BAR; PG8_SCHED;
            PG8_LDB(B0, 1, 0); PG8_LDB(B1, 1, 1); PG8_SCHED; PG8_LDA(At, 1, 0); PG8_STAGE(PG8_SA(0, 1), a2 + hstep, voffA);
            PG8_WAIT_V(8); PG8_WAIT_L(0); PG8_BAR; PG8_MMA(0, 0, At, B0); PG8_MMA(0, 1, At, B1); PG8_BAR; PG8_SCHED;
            PG8_LDA(At, 1, 1); PG8_STAGE(PG8_SB(1, 0), b3, voffB); PG8_STAGE(PG8_SB(1, 1), b3 + hstep, voffB); PG8_STAGE(PG8_SA(1, 0), a3, voffA);
            PG8_WAIT_V(8); PG8_WAIT_L(0); PG8_BAR; PG8_MMA(1, 0, At, B0); PG8_MMA(1, 1, At, B1); PG8_BAR; PG8_SCHED;
            } else {
            PG8_LDB(B0, 0, 0); PG8_SCHED; PG8_LDA(At, 0, 0); PG8_STAGE(PG8_SA(1, 1), a1 + hstep, voffA);
            PG8_WAIT_L(8); PG8_BAR; PG8_WAIT_L(0); PG8_MMA(0, 0, At, B0); PG8_BAR; PG8_SCHED;
            PG8_LDB(B1, 0, 1); PG8_STAGE(PG8_SB(0, 0), b2, voffB);
            PG8_BAR; PG8_WAIT_L(0); PG8_MMA(0, 1, At, B1); PG8_BAR;
            PG8_LDA(At, 0, 1); PG8_STAGE(PG8_SA(0, 0), a2, voffA);
            PG8_BAR; PG8_WAIT_L(0); PG8_MMA(1, 0, At, B0); PG8_BAR; PG8_SCHED;
            PG8_STAGE(PG8_SB(0, 1), b2 + hstep, voffB);
            PG8_WAIT_V(6); PG8_BAR; PG8_MMA(1, 1, At, B1); PG8_BAR;
            PG8_LDB(B0, 1, 0); PG8_SCHED; PG8_LDA(At, 1, 0); PG8_STAGE(PG8_SA(0, 1), a2 + hstep, voffA);
            PG8_WAIT_L(8); PG8_BAR; PG8_WAIT_L(0); PG8_MMA(0, 0, At, B0); PG8_BAR; PG8_SCHED;
            PG8_LDB(B1, 1, 1); PG8_STAGE(PG8_SB(1, 0), b3, voffB);
            PG8_BAR; PG8_WAIT_L(0); PG8_MMA(0, 1, At, B1); PG8_BAR;
            PG8_LDA(At, 1, 1); PG8_STAGE(PG8_SA(1, 0), a3, voffA);
            PG8_BAR; PG8_WAIT_L(0); PG8_MMA(1, 0, At, B0); PG8_BAR; PG8_SCHED;
            PG8_STAGE(PG8_SB(1, 1), b3 + hstep, voffB);
            PG8_WAIT_V(6); PG8_BAR; PG8_MMA(1, 1, At, B1); PG8_BAR;
            }
        }
        if constexpr (ALIGN_EPI) { if (wr == 0) PG8_BAR; }
        if constexpr (!Epi::AFTER_DRAIN) { E(acc, cur, wr, wc, fr, fq); S.done(cur); }
        if (!has_next) break;
#pragma unroll
        for (int a = 0; a < 2; ++a)
#pragma unroll
            for (int b = 0; b < 2; ++b)
#pragma unroll
                for (int m = 0; m < 4; ++m)
#pragma unroll
                    for (int n = 0; n < 2; ++n) acc[a][b][m][n] = (f32x4){0.f, 0.f, 0.f, 0.f};
        cur = nxt; cA = nA; cB = nB; ++ui;
        if constexpr (ALIGN_EPI) { if (wr == 1) PG8_BAR; }
    }
    PG8_WAIT_V(0);
    if constexpr (!ALIGN_EPI) { if (wr == 0) PG8_BAR; }
    PG8_BAR;
    if constexpr (Epi::AFTER_DRAIN) { E.fused(acc, cur, wr, wc, fr, fq, lds, wid, lane); S.done(cur); }
#undef PG8_SA
#undef PG8_SB
#undef PG8_STAGE
#undef PG8_LDA
#undef PG8_LDB
#undef PG8_MMA
#undef PG8_WAIT_V
#undef PG8_WAIT_L
#undef PG8_BAR
#undef PG8_SCHED
}
}
namespace pg8 {
__device__ __forceinline__ float sigmoidf_(float x) { return __builtin_amdgcn_rcpf(1.0f + __builtin_amdgcn_exp2f(-1.4426950408889634f * x)); }
struct EpiBf16Split {
    static constexpr bool PERM = true, AFTER_DRAIN = false;
    bf16_t* O0; int ld0; int nt0; bf16_t* O1; int ld1;
    __device__ __forceinline__ void operator()(const f32x4 (&acc)[2][2][4][2], const Unit& u, int wr, int wc, int fr, int fq) const {
        const bool first = u.pn < nt0; bf16_t* base = first ? O0 : O1; const int ld = first ? ld0 : ld1; const int colt = (first ? u.pn : u.pn - nt0) * BM;
        const int row0 = u.pm * BM + wr * 64 + fr, col0 = colt + wc * 32 + 8 * fq;
#pragma unroll
        for (int ai = 0; ai < 2; ++ai)
#pragma unroll
            for (int m = 0; m < 4; ++m) { bf16_t* rowp = base + (size_t)(row0 + ai * HALF + m * 16) * ld + col0;
#pragma unroll
                for (int bj = 0; bj < 2; ++bj) { const f32x4 v0 = acc[ai][bj][m][0], v1 = acc[ai][bj][m][1];
                    u32x4 w; w.x = cvt_pk_bf16(v0[0], v0[1]); w.y = cvt_pk_bf16(v0[2], v0[3]); w.z = cvt_pk_bf16(v1[0], v1[1]); w.w = cvt_pk_bf16(v1[2], v1[3]);
                    *(u32x4*)(rowp + bj * HALF) = w; } }
    }
};
struct EpiResF32 {
    static constexpr bool PERM = false, AFTER_DRAIN = false;
    const float* base; float* out; int ldc;
    __device__ __forceinline__ void operator()(const f32x4 (&acc)[2][2][4][2], const Unit& u, int wr, int wc, int fr, int fq) const {
        const int row0 = u.pm * BM + wr * 64 + fr, col0 = u.pn * BM + wc * 32 + 4 * fq;
#pragma unroll
        for (int ai = 0; ai < 2; ++ai)
#pragma unroll
            for (int m = 0; m < 4; ++m) { const size_t off = (size_t)(row0 + ai * HALF + m * 16) * ldc + col0;
#pragma unroll
                for (int bj = 0; bj < 2; ++bj)
#pragma unroll
                    for (int n = 0; n < 2; ++n) { const f32x4 b = *(const f32x4*)(base + off + bj * HALF + n * 16); *(f32x4*)(out + off + bj * HALF + n * 16) = b + acc[ai][bj][m][n]; } }
    }
};
struct EpiSwiglu {
    static constexpr bool PERM = false, AFTER_DRAIN = false;
    bf16_t* H; int ldh;
    __device__ __forceinline__ void operator()(const f32x4 (&acc)[2][2][4][2], const Unit& u, int wr, int wc, int fr, int fq) const {
        const int row0 = u.pm * BM + wr * 64 + fr, hc0 = u.pn * (BM / 2) + wc * 16 + 4 * fq;
#pragma unroll
        for (int ai = 0; ai < 2; ++ai)
#pragma unroll
            for (int m = 0; m < 4; ++m) { bf16_t* rowp = H + (size_t)(row0 + ai * HALF + m * 16) * ldh + hc0;
#pragma unroll
                for (int bj = 0; bj < 2; ++bj) { const f32x4 g = acc[ai][bj][m][0], up = acc[ai][bj][m][1]; float h[4];
#pragma unroll
                    for (int i = 0; i < 4; ++i) h[i] = g[i] * sigmoidf_(g[i]) * up[i];
                    typedef unsigned u32x2 __attribute__((ext_vector_type(2)));
                    u32x2 w; w.x = cvt_pk_bf16(h[0], h[1]); w.y = cvt_pk_bf16(h[2], h[3]);
                    *(u32x2*)(rowp + bj * (HALF / 2)) = w; } }
    }
};
struct EpiPle {
    static constexpr bool PERM = false, AFTER_DRAIN = false;
    const float* base; float* out; const bf16_t* E; int ldc;
    __device__ __forceinline__ void operator()(const f32x4 (&acc)[2][2][4][2], const Unit& u, int wr, int wc, int fr, int fq) const {
        const int row0 = u.pm * BM + wr * 64 + fr, col0 = u.pn * BM + wc * 32 + 4 * fq;
        typedef unsigned u32x2 __attribute__((ext_vector_type(2)));
#pragma unroll
        for (int ai = 0; ai < 2; ++ai)
#pragma unroll
            for (int m = 0; m < 4; ++m) { const size_t off = (size_t)(row0 + ai * HALF + m * 16) * ldc + col0;
#pragma unroll
                for (int bj = 0; bj < 2; ++bj)
#pragma unroll
                    for (int n = 0; n < 2; ++n) { const size_t o = off + bj * HALF + n * 16; const f32x4 b = *(const f32x4*)(base + o); const u32x2 e = *(const u32x2*)(E + o); const f32x4 a = acc[ai][bj][m][n];
                        f32x4 r; r[0] = b[0] + __uint_as_float(e.x << 16) * sigmoidf_(a[0]); r[1] = b[1] + __uint_as_float(e.x & 0xffff0000u) * sigmoidf_(a[1]);
                        r[2] = b[2] + __uint_as_float(e.y << 16) * sigmoidf_(a[2]); r[3] = b[3] + __uint_as_float(e.y & 0xffff0000u) * sigmoidf_(a[3]);
                        *(f32x4*)(out + o) = r; } }
    }
};
__device__ __forceinline__ float rms_r(const float* rsq, int row) { const f32x4* p = (const f32x4*)(rsq + (size_t)row * 16); const f32x4 a = p[0], b = p[1], c = p[2], d = p[3];
    const float s = (((a[0] + a[1]) + (a[2] + a[3])) + ((b[0] + b[1]) + (b[2] + b[3]))) + (((c[0] + c[1]) + (c[2] + c[3])) + ((d[0] + d[1]) + (d[2] + d[3]))); return rsqrtf(s * (1.0f / 1024.0f) + 1e-6f); }
__device__ __forceinline__ void norm_out(const f32x4 (&x)[2][2], bf16_t* xb, size_t off, float* rsq_out, int row, int fq, int slot) {
    typedef unsigned u32x2 __attribute__((ext_vector_type(2))); float s = 0.f;
#pragma unroll
    for (int bj = 0; bj < 2; ++bj)
#pragma unroll
        for (int n = 0; n < 2; ++n) { const f32x4 v = x[bj][n]; s += (v[0] * v[0] + v[1] * v[1]) + (v[2] * v[2] + v[3] * v[3]); u32x2 w; w.x = cvt_pk_bf16(v[0], v[1]); w.y = cvt_pk_bf16(v[2], v[3]); *(u32x2*)(xb + off + bj * HALF + n * 16) = w; }
    s += __shfl_xor(s, 16); s += __shfl_xor(s, 32);
    if (fq == 0) rsq_out[(size_t)row * 16 + slot] = s;
}
struct EpiBf16SplitR {
    static constexpr bool PERM = true, AFTER_DRAIN = false;
    bf16_t* O0; int ld0; int nt0; bf16_t* O1; int ld1; const float* rsq;
    __device__ __forceinline__ void operator()(const f32x4 (&acc)[2][2][4][2], const Unit& u, int wr, int wc, int fr, int fq) const {
        const bool first = u.pn < nt0; bf16_t* base = first ? O0 : O1; const int ld = first ? ld0 : ld1; const int colt = (first ? u.pn : u.pn - nt0) * BM;
        const int row0 = u.pm * BM + wr * 64 + fr, col0 = colt + wc * 32 + 8 * fq;
#pragma unroll
        for (int ai = 0; ai < 2; ++ai)
#pragma unroll
            for (int m = 0; m < 4; ++m) { const int row = row0 + ai * HALF + m * 16; const float r = rms_r(rsq, row); bf16_t* rowp = base + (size_t)row * ld + col0;
#pragma unroll
                for (int bj = 0; bj < 2; ++bj) { const f32x4 v0 = acc[ai][bj][m][0] * r, v1 = acc[ai][bj][m][1] * r;
                    u32x4 w; w.x = cvt_pk_bf16(v0[0], v0[1]); w.y = cvt_pk_bf16(v0[2], v0[3]); w.z = cvt_pk_bf16(v1[0], v1[1]); w.w = cvt_pk_bf16(v1[2], v1[3]);
                    *(u32x4*)(rowp + bj * HALF) = w; } }
    }
};
struct EpiSwigluR {
    static constexpr bool PERM = false, AFTER_DRAIN = false;
    bf16_t* H; int ldh; const float* rsq;
    __device__ __forceinline__ void operator()(const f32x4 (&acc)[2][2][4][2], const Unit& u, int wr, int wc, int fr, int fq) const {
        const int row0 = u.pm * BM + wr * 64 + fr, hc0 = u.pn * (BM / 2) + wc * 16 + 4 * fq;
#pragma unroll
        for (int ai = 0; ai < 2; ++ai)
#pragma unroll
            for (int m = 0; m < 4; ++m) { const int row = row0 + ai * HALF + m * 16; const float r = rms_r(rsq, row); bf16_t* rowp = H + (size_t)row * ldh + hc0;
#pragma unroll
                for (int bj = 0; bj < 2; ++bj) { const f32x4 g = acc[ai][bj][m][0] * r, up = acc[ai][bj][m][1] * r; float h[4];
#pragma unroll
                    for (int i = 0; i < 4; ++i) h[i] = g[i] * sigmoidf_(g[i]) * up[i];
                    typedef unsigned u32x2 __attribute__((ext_vector_type(2)));
                    u32x2 w; w.x = cvt_pk_bf16(h[0], h[1]); w.y = cvt_pk_bf16(h[2], h[3]);
                    *(u32x2*)(rowp + bj * (HALF / 2)) = w; } }
    }
};
struct EpiResN {
    static constexpr bool PERM = false, AFTER_DRAIN = false;
    const float* base; float* out; int ldc; bf16_t* XBo; float* rsq_out;
    __device__ __forceinline__ void operator()(const f32x4 (&acc)[2][2][4][2], const Unit& u, int wr, int wc, int fr, int fq) const {
        const int row0 = u.pm * BM + wr * 64 + fr, col0 = u.pn * BM + wc * 32 + 4 * fq;
#pragma unroll
        for (int ai = 0; ai < 2; ++ai)
#pragma unroll
            for (int m = 0; m < 4; ++m) { const int row = row0 + ai * HALF + m * 16; const size_t off = (size_t)row * ldc + col0; f32x4 x[2][2];
#pragma unroll
                for (int bj = 0; bj < 2; ++bj)
#pragma unroll
                    for (int n = 0; n < 2; ++n) { const f32x4 b = *(const f32x4*)(base + off + bj * HALF + n * 16); x[bj][n] = b + acc[ai][bj][m][n]; *(f32x4*)(out + off + bj * HALF + n * 16) = x[bj][n]; }
                if (XBo) norm_out(x, XBo, off, rsq_out, row, fq, u.pn * 4 + wc); }
    }
};
struct EpiPleN {
    static constexpr bool PERM = false, AFTER_DRAIN = false;
    const float* base; float* out; const bf16_t* E; int ldc; const float* rsq_in; bf16_t* XBo; float* rsq_out;
    __device__ __forceinline__ void operator()(const f32x4 (&acc)[2][2][4][2], const Unit& u, int wr, int wc, int fr, int fq) const {
        const int row0 = u.pm * BM + wr * 64 + fr, col0 = u.pn * BM + wc * 32 + 4 * fq;
        typedef unsigned u32x2 __attribute__((ext_vector_type(2)));
#pragma unroll
        for (int ai = 0; ai < 2; ++ai)
#pragma unroll
            for (int m = 0; m < 4; ++m) { const int row = row0 + ai * HALF + m * 16; const size_t off = (size_t)row * ldc + col0; const float r = rms_r(rsq_in, row); f32x4 x[2][2];
#pragma unroll
                for (int bj = 0; bj < 2; ++bj)
#pragma unroll
                    for (int n = 0; n < 2; ++n) { const size_t o = off + bj * HALF + n * 16; const f32x4 b = *(const f32x4*)(base + o); const u32x2 e = *(const u32x2*)(E + o); const f32x4 a = acc[ai][bj][m][n] * r;
                        f32x4 v; v[0] = b[0] + __uint_as_float(e.x << 16) * sigmoidf_(a[0]); v[1] = b[1] + __uint_as_float(e.x & 0xffff0000u) * sigmoidf_(a[1]);
                        v[2] = b[2] + __uint_as_float(e.y << 16) * sigmoidf_(a[2]); v[3] = b[3] + __uint_as_float(e.y & 0xffff0000u) * sigmoidf_(a[3]);
                        x[bj][n] = v; *(f32x4*)(out + o) = v; }
                if (XBo) norm_out(x, XBo, off, rsq_out, row, fq, u.pn * 4 + wc); }
    }
};
__device__ __forceinline__ f32x4 ld_base4(const float* p) { return *(const f32x4*)p; }
__device__ __forceinline__ f32x4 ld_base4(const bf16_t* p) { typedef unsigned u32x2 __attribute__((ext_vector_type(2))); const u32x2 e = *(const u32x2*)p; return (f32x4){__uint_as_float(e.x << 16), __uint_as_float(e.x & 0xffff0000u), __uint_as_float(e.y << 16), __uint_as_float(e.y & 0xffff0000u)}; }
template <class BaseT> struct EpiRes2 {
    static constexpr bool PERM = false, AFTER_DRAIN = false;
    const BaseT* base; bf16_t* out; int ldc; float* rsq_out;
    __device__ __forceinline__ void operator()(const f32x4 (&acc)[2][2][4][2], const Unit& u, int wr, int wc, int fr, int fq) const {
        const int row0 = u.pm * BM + wr * 64 + fr, col0 = u.pn * BM + wc * 32 + 4 * fq;
#pragma unroll
        for (int ai = 0; ai < 2; ++ai)
#pragma unroll
            for (int m = 0; m < 4; ++m) { const int row = row0 + ai * HALF + m * 16; const size_t off = (size_t)row * ldc + col0; f32x4 x[2][2];
#pragma unroll
                for (int bj = 0; bj < 2; ++bj)
#pragma unroll
                    for (int n = 0; n < 2; ++n) x[bj][n] = ld_base4(base + off + bj * HALF + n * 16) + acc[ai][bj][m][n];
                norm_out(x, out, off, rsq_out, row, fq, u.pn * 4 + wc); }
    }
};
template <bool OUT_F32> struct EpiPle2 {
    static constexpr bool PERM = false, AFTER_DRAIN = false;
    const bf16_t* base; void* out; const bf16_t* E; int ldc; const float* rsq_in; float* rsq_out;
    __device__ __forceinline__ void operator()(const f32x4 (&acc)[2][2][4][2], const Unit& u, int wr, int wc, int fr, int fq) const {
        const int row0 = u.pm * BM + wr * 64 + fr, col0 = u.pn * BM + wc * 32 + 4 * fq;
#pragma unroll
        for (int ai = 0; ai < 2; ++ai)
#pragma unroll
            for (int m = 0; m < 4; ++m) { const int row = row0 + ai * HALF + m * 16; const size_t off = (size_t)row * ldc + col0; const float r = rms_r(rsq_in, row); f32x4 x[2][2];
#pragma unroll
                for (int bj = 0; bj < 2; ++bj)
#pragma unroll
                    for (int n = 0; n < 2; ++n) { const size_t o = off + bj * HALF + n * 16; const f32x4 b = ld_base4(base + o), e = ld_base4(E + o), a = acc[ai][bj][m][n] * r; f32x4 v;
#pragma unroll
                        for (int i = 0; i < 4; ++i) v[i] = b[i] + e[i] * sigmoidf_(a[i]);
                        x[bj][n] = v; if (OUT_F32) *(f32x4*)((float*)out + o) = v; }
                if (!OUT_F32) norm_out(x, (bf16_t*)out, off, rsq_out, row, fq, u.pn * 4 + wc); }
    }
};
}
#ifndef PG8_SP2
#define PG8_SP2 true
#endif
#ifndef PG8_ALIGN
#define PG8_ALIGN true
#endif
constexpr int NB = 32, SEQ = 2048, T = NB * SEQ, D = 1024;
constexpr int NU = 2816, UA_W = 1024, UB_W = 1792;
constexpr int FF = 2816, CI = 2048, TH = T / 2;
constexpr int NWAVES = 8;
constexpr float NORM_EPS = 1e-6f, LOG2E = 1.4426950408889634f;
constexpr int UA_K = 512, UA_V = 576, UA_IQ = 640, UA_IK = 896, UA_IW = 960;
constexpr size_t MiB = 1u << 20, QMiB = 1u << 18;
constexpr size_t WS_CTL = 0, CTL_ZERO_BYTES = 1 * MiB;
constexpr size_t WS_WIN = 4 * QMiB, WS_WLORA = 26 * QMiB, WS_WOUT = 29 * QMiB;
constexpr size_t WS_WGU0 = 37 * QMiB, WS_WD0 = 81 * QMiB, WS_WPLE0 = 103 * QMiB, WS_WPG0 = 105 * QMiB, WS_LAYER_STRIDE = 76 * QMiB;
constexpr size_t WS_WUP = 189 * QMiB, WS_WDOWN = 221 * QMiB, WS_W12 = 237 * QMiB;
static_assert(WS_WPG0 + 8 * QMiB == WS_WGU0 + WS_LAYER_STRIDE && WS_WPG0 + WS_LAYER_STRIDE + 8 * QMiB == WS_WUP && WS_W12 + QMiB <= 60 * MiB, "weight map");
constexpr size_t ACT = 60 * MiB;
constexpr size_t WS_XB = ACT, WS_UA = ACT + 128 * MiB, WS_UB = ACT + 256 * MiB, WS_LIN = ACT + 480 * MiB, WS_LOUT = ACT + 512 * MiB;
constexpr size_t WS_QN = ACT + 704 * MiB, WS_KN = ACT + 768 * MiB, WS_VT = ACT + 776 * MiB, WS_MASK = ACT + 784 * MiB;
constexpr size_t WS_XB2 = ACT + 768 * MiB;
constexpr size_t WS_H = ACT + 128 * MiB, WS_E = ACT + 480 * MiB, WS_PB = ACT + 896 * MiB;
constexpr size_t WS_XM = ACT, WS_Z = ACT + 128 * MiB, WS_XC = ACT + 256 * MiB, WS_Q = ACT + 384 * MiB, WS_K = ACT + 512 * MiB, WS_V = ACT + 640 * MiB;
constexpr size_t WS_RS = ACT + 928 * MiB, RS_ONE = (size_t)T * 16 * 4;
constexpr size_t WS_GI = ACT + 952 * MiB, WS_GA = WS_GI + 1 * MiB, WS_GAM = WS_GI + 2 * MiB, WS_GEM = WS_GI + 3 * MiB;
constexpr size_t WS_END = ACT + 956 * MiB;
static_assert(WS_END <= 1024 * MiB, "workspace");
constexpr int CW_TMO = 0, CW_BAR = 4096, CW_XRANK = 8192;
constexpr int LDS_BYTES = 155648;
constexpr int MISC_OFF = LDS_BYTES - 256;
#define GAS __attribute__((address_space(1)))
#define LAS __attribute__((address_space(3)))
typedef unsigned short bf16;
typedef unsigned v4u __attribute__((ext_vector_type(4)));
typedef unsigned v2u __attribute__((ext_vector_type(2)));
typedef float f32x4 __attribute__((ext_vector_type(4)));
typedef float f32x2 __attribute__((ext_vector_type(2)));
typedef float f32x8 __attribute__((ext_vector_type(8)));
typedef short bf16x8 __attribute__((ext_vector_type(8)));
typedef short s16x4 __attribute__((ext_vector_type(4)));
typedef GAS unsigned gu32;
#define RLX_AGENT __ATOMIC_RELAXED, __HIP_MEMORY_SCOPE_AGENT
#define LDS_WAIT() asm volatile("s_waitcnt lgkmcnt(0)" ::: "memory")
#define VM_WAIT() asm volatile("s_waitcnt vmcnt(0)" ::: "memory")
__device__ __forceinline__ unsigned f2bf(float f) { unsigned u = __builtin_bit_cast(unsigned, f); return (u + 0x7fffu + ((u >> 16) & 1u)) >> 16; }

#define XB_TMO      128
#define XB_XCNT(j)  (256  + 64 * (j))
#define XB_XSUB(j)  (1280 + 64 * (j))
#define XB_XGEN(j)  (2304 + 64 * (j))
#define XB_TOP      3328
#define XB_TOPGEN   3392
#define XCD_BAR_WORDS 3456
#define XB_SPIN_CAP (1u << 18)

__device__ __forceinline__ unsigned xb_ld(unsigned* p)              { return __hip_atomic_load(p, __ATOMIC_RELAXED, __HIP_MEMORY_SCOPE_AGENT); }
__device__ __forceinline__ unsigned xb_add(unsigned* p, unsigned v) { return __hip_atomic_fetch_add(p, v, __ATOMIC_RELAXED, __HIP_MEMORY_SCOPE_AGENT); }
__device__ __forceinline__ unsigned xb_xcc_id() { return (unsigned)__builtin_amdgcn_s_getreg((3 << 11) | 20) & 0xFu; }
#define XB_SPIN(cond, bar) do { unsigned _sp = 0; while (cond) { __builtin_amdgcn_s_sleep(1); \
    if ((++_sp & 255u) == 0u) { if (xb_ld(&(bar)[XB_TMO])) break; if (_sp > XB_SPIN_CAP) { atomicAdd(&(bar)[XB_TMO], 1u); break; } } } } while (0)

struct XcdBarrier {
    unsigned* bar; unsigned x;
    volatile LAS unsigned* st;
};

__device__ __forceinline__ XcdBarrier xcd_barrier_post(unsigned* bar, volatile LAS unsigned* st) {
    XcdBarrier b; b.bar = bar; b.x = xb_xcc_id(); b.st = st;
    if (threadIdx.x == 0) (void)xb_add(&bar[XB_XCNT(b.x)], 1u);
    return b;
}
__device__ __forceinline__ void xcd_barrier_complete(unsigned* bar, unsigned x, unsigned& nloc, unsigned& nx) {
    const unsigned G = gridDim.x * gridDim.y * gridDim.z;
    unsigned sum, cnt, mine, sp = 0u;
    for (;;) {
        sum = 0u; cnt = 0u; mine = 0u;
#pragma unroll
        for (unsigned j = 0; j < 16; ++j) { const unsigned c = xb_ld(&bar[XB_XCNT(j)]); sum += c; cnt += (c > 0u) ? 1u : 0u; mine = (j == x) ? c : mine; }
        if (sum == G) break;
        __builtin_amdgcn_s_sleep(1);
        if ((++sp & 255u) == 0u) { if (xb_ld(&bar[XB_TMO])) break; if (sp > XB_SPIN_CAP) { atomicAdd(&bar[XB_TMO], 1u); break; } }
    }
    nloc = mine > 0u ? mine : 1u; nx = cnt > 0u ? cnt : 1u;
}

__device__ __forceinline__ void xcd_barrier(const XcdBarrier& b) {
    asm volatile("s_waitcnt vmcnt(0)" ::: "memory");
    __syncthreads();
    if (threadIdx.x == 0) {
        unsigned* bar = b.bar;
        __builtin_amdgcn_s_waitcnt(0);
        unsigned nloc = b.st[0], nx = b.st[1];
        if (nloc == 0u) { xcd_barrier_complete(bar, b.x, nloc, nx); b.st[0] = nloc; b.st[1] = nx; }
        const unsigned old = xb_add(&bar[XB_XSUB(b.x)], 1u);
        const unsigned gen = old / nloc;
        if (old + 1u == (gen + 1u) * nloc) {
            __builtin_amdgcn_fence(__ATOMIC_RELEASE, "agent");
            asm volatile("s_waitcnt vmcnt(0)" ::: "memory");
            const unsigned og = xb_add(&bar[XB_TOP], 1u);
            const unsigned tg = og / nx;
            if (og + 1u == (tg + 1u) * nx) xb_add(&bar[XB_TOPGEN], 1u);
            else XB_SPIN(xb_ld(&bar[XB_TOPGEN]) == tg, bar);
            __builtin_amdgcn_fence(__ATOMIC_ACQUIRE, "agent");
            xb_add(&bar[XB_XGEN(b.x)], 1u);
            asm volatile("s_waitcnt vmcnt(0)" ::: "memory");
        } else {
            XB_SPIN(xb_ld(&bar[XB_XGEN(b.x)]) == gen, bar);
            __builtin_amdgcn_fence(__ATOMIC_ACQUIRE, "agent");
            asm volatile("s_waitcnt vmcnt(0)" ::: "memory");
        }
    }
    __syncthreads();
}

struct Frame {
    LAS unsigned char* lds;
    unsigned char* ws;
    const float* const* in;
    int tid, lane, wave, G, bid;
};
struct Args { const float* in[37]; float* out; unsigned char* ws; int ph_lo, ph_hi, use_bar, pad; };

__device__ __forceinline__ float dpp_f(float v, int ctrl_qp1) { return v; }
#define DPP_MOVF(v, ctrl) __builtin_bit_cast(float, __builtin_amdgcn_mov_dpp(__builtin_bit_cast(int, (v)), (ctrl), 0xf, 0xf, true))
__device__ __forceinline__ float wave_sum(float v) {
    v += DPP_MOVF(v, 0xB1);
    v += DPP_MOVF(v, 0x4E);
    v += DPP_MOVF(v, 0x141);
    v += DPP_MOVF(v, 0x140);
    v += __shfl_xor(v, 16); v += __shfl_xor(v, 32);
    return v;
}
__device__ __forceinline__ float wave_max(float v) {
#pragma unroll
    for (int o = 1; o < 64; o <<= 1) v = fmaxf(v, __shfl_xor(v, o));
    return v;
}
__device__ __forceinline__ float bflo(unsigned u) { return __uint_as_float(u << 16); }
__device__ __forceinline__ float bfhi(unsigned u) { return __uint_as_float(u & 0xffff0000u); }
__device__ __forceinline__ float bf1(bf16 h) { return __uint_as_float(((unsigned)h) << 16); }
__device__ __forceinline__ unsigned pk2(float lo, float hi) { return pg8::cvt_pk_bf16(lo, hi); }
__device__ __forceinline__ float sigm(float x) { return __builtin_amdgcn_rcpf(1.0f + __builtin_amdgcn_exp2f(-LOG2E * x)); }
__device__ __forceinline__ float softplusf_(float x) { return fmaxf(x, 0.f) + log1pf(__expf(-fabsf(x))); }
__device__ __forceinline__ void unpack8(const v4u& r, float (&f)[8]) { f[0] = bflo(r.x); f[1] = bfhi(r.x); f[2] = bflo(r.y); f[3] = bfhi(r.y); f[4] = bflo(r.z); f[5] = bfhi(r.z); f[6] = bflo(r.w); f[7] = bfhi(r.w); }
__device__ __forceinline__ v4u pack8(const float (&f)[8]) { v4u o; o.x = pk2(f[0], f[1]); o.y = pk2(f[2], f[3]); o.z = pk2(f[4], f[5]); o.w = pk2(f[6], f[7]); return o; }

template <class Fn> __device__ __forceinline__ void wprep(bf16* dst, int N, int K, Fn f, int gt, int NT) {
    const int lane = gt & 63, gwv = gt >> 6, NW = NT >> 6, ntn = N >> 3, tiles = ntn * (K >> 6);
    for (int tl = gwv; tl < tiles; tl += NW) { const int n = (tl % ntn) * 8 + (lane & 7), k0 = (tl / ntn) * 64 + (lane >> 3) * 8; float v[8];
#pragma unroll
        for (int j = 0; j < 8; ++j) v[j] = f(k0 + j, n);
        *(v4u*)(dst + (size_t)n * K + k0) = pack8(v); }
}
__device__ __forceinline__ void phase_prologue(Frame& F, const Args& a) {
    const int gt = F.bid * 512 + F.tid, NT = F.G * 512; unsigned char* ws = F.ws;
    { const float* W = a.in[5]; const float* gn0 = a.in[2];
      wprep((bf16*)(ws + WS_WIN), NU, D, [=](int k, int n) { const int c = n < 964 ? n : (n < 1024 ? -1 : n - 60); return c < 0 ? 0.f : W[(size_t)k * 2756 + c] * gn0[k]; }, gt, NT); }
    { const float* w2 = a.in[8]; const float* a2 = a.in[10]; const float* g2 = a.in[11];
      wprep((bf16*)(ws + WS_WLORA), 1536, 256, [=](int k, int n) { if (n < 512) return k < 64 ? w2[k * 512 + n] : 0.f; if (n < 1024) return (k >= 64 && k < 128) ? a2[(k - 64) * 512 + n - 512] : 0.f; return k >= 128 ? g2[(k - 128) * 512 + n - 1024] : 0.f; }, gt, NT); }
    { const float* W = a.in[17]; wprep((bf16*)(ws + WS_WOUT), D, D, [=](int k, int n) { return W[(size_t)k * D + n]; }, gt, NT); }
    for (int L = 0; L < 2; ++L) {
        const float* wg = a.in[31] + (size_t)L * D * FF; const float* wu = a.in[32] + (size_t)L * D * FF; const float* wd = a.in[33] + (size_t)L * FF * D;
        const float* wp = a.in[34] + (size_t)L * 256 * D; const float* wpg = a.in[36] + (size_t)L * D * D; const float* gnf = a.in[30] + L * D; const float* gnp = a.in[35] + L * D;
        wprep((bf16*)(ws + WS_WGU0 + L * WS_LAYER_STRIDE), 2 * FF, D, [=](int k, int n) { const int hid = 16 * (n >> 5) + (n & 15); return ((n & 31) >= 16 ? wu : wg)[(size_t)k * FF + hid] * gnf[k]; }, gt, NT);
        wprep((bf16*)(ws + WS_WD0 + L * WS_LAYER_STRIDE), D, FF, [=](int k, int n) { return wd[(size_t)k * D + n]; }, gt, NT);
        wprep((bf16*)(ws + WS_WPLE0 + L * WS_LAYER_STRIDE), D, 256, [=](int k, int n) { return wp[(size_t)k * D + n]; }, gt, NT);
        wprep((bf16*)(ws + WS_WPG0 + L * WS_LAYER_STRIDE), D, D, [=](int k, int n) { return wpg[(size_t)k * D + n] * gnp[k]; }, gt, NT);
    }
    { const float* W = a.in[18]; const float* gn1 = a.in[2] + D; wprep((bf16*)(ws + WS_WUP), 2 * CI, D, [=](int k, int n) { return W[(size_t)k * (2 * CI) + n] * gn1[k]; }, gt, NT); }
    { const float* W = a.in[29]; wprep((bf16*)(ws + WS_WDOWN), D, CI, [=](int k, int n) { return W[(size_t)k * D + n]; }, gt, NT); }
    { const float* wq = a.in[21]; const float* wk = a.in[22]; const float* wv = a.in[23]; const float* wif = a.in[24]; float* W12 = (float*)(ws + WS_W12);
      for (int it = gt; it < 4096 * 8; it += NT) { const int o = it & 7, c = (it >> 3) & 2047, part = it >> 14, g = c >> 2, i = c & 3; float s = 0.f;
          if (part == 0) { for (int j = 0; j < 4; ++j) s += wq[(g * 4 + i) * 4 + j] * wif[(size_t)(4 * g + j) * 8 + o] + wk[(g * 4 + i) * 4 + j] * wif[(size_t)(2048 + 4 * g + j) * 8 + o]; }
          else { for (int j = 0; j < 4; ++j) s += wv[(g * 4 + i) * 4 + j] * wif[(size_t)(4096 + 4 * g + j) * 8 + o]; }
          W12[it] = s; } }
}
__device__ __forceinline__ void phase_norm(Frame& F, const float* src, const float* gain, bf16* dst, int nrows) {
    const int gw = F.bid * NWAVES + F.wave, NGW = F.G * NWAVES, lane = F.lane;
    f32x4 g[4];
#pragma unroll
    for (int j = 0; j < 4; ++j) g[j] = *((const f32x4*)gain + lane + 64 * j);
    for (int m = gw; m < nrows; m += NGW) {
        const f32x4* xr = (const f32x4*)(src + (size_t)m * D) + lane; f32x4 v[4]; float s = 0.f;
#pragma unroll
        for (int j = 0; j < 4; ++j) { v[j] = xr[64 * j]; s += (v[j].x * v[j].x + v[j].y * v[j].y) + (v[j].z * v[j].z + v[j].w * v[j].w); }
        const float r = rsqrtf(wave_sum(s) * (1.f / D) + NORM_EPS);
        v2u* o = (v2u*)(dst + (size_t)m * D) + lane;
#pragma unroll
        for (int j = 0; j < 4; ++j) { v2u w; w.x = pk2(v[j].x * r * g[j].x, v[j].y * r * g[j].y); w.y = pk2(v[j].z * r * g[j].z, v[j].w * r * g[j].w); o[64 * j] = w; }
    }
}
__device__ __forceinline__ void phase_cast_sq(Frame& F, const float* src, bf16* dst, float* rsq, int nrows) {
    const int gw = F.bid * NWAVES + F.wave, NGW = F.G * NWAVES, lane = F.lane;
    for (int m = gw; m < nrows; m += 2 * NGW) { const int m2 = m + NGW; const bool has2 = m2 < nrows;
        const f32x4* xr = (const f32x4*)(src + (size_t)m * D) + lane; const f32x4* xr2 = (const f32x4*)(src + (size_t)(has2 ? m2 : m) * D) + lane; f32x4 v[4], u[4]; float s = 0.f, s2 = 0.f;
#pragma unroll
        for (int j = 0; j < 4; ++j) { v[j] = xr[64 * j]; u[j] = xr2[64 * j]; }
#pragma unroll
        for (int j = 0; j < 4; ++j) { s += (v[j].x * v[j].x + v[j].y * v[j].y) + (v[j].z * v[j].z + v[j].w * v[j].w); s2 += (u[j].x * u[j].x + u[j].y * u[j].y) + (u[j].z * u[j].z + u[j].w * u[j].w); }
        s = wave_sum(s); s2 = wave_sum(s2);
        if (lane < 16) rsq[(size_t)m * 16 + lane] = lane == 0 ? s : 0.f;
        v2u* o = (v2u*)(dst + (size_t)m * D) + lane;
#pragma unroll
        for (int j = 0; j < 4; ++j) { v2u w; w.x = pk2(v[j].x, v[j].y); w.y = pk2(v[j].z, v[j].w); o[64 * j] = w; }
        if (has2) { if (lane < 16) rsq[(size_t)m2 * 16 + lane] = lane == 0 ? s2 : 0.f;
            v2u* o2 = (v2u*)(dst + (size_t)m2 * D) + lane;
#pragma unroll
            for (int j = 0; j < 4; ++j) { v2u w; w.x = pk2(u[j].x, u[j].y); w.y = pk2(u[j].z, u[j].w); o2[64 * j] = w; } }
    }
}
__device__ __forceinline__ void phase_cvt_p(Frame& F, const float* p, bf16* pb) {
    const size_t gt = (size_t)F.bid * 512 + F.tid, NT = (size_t)F.G * 512, n8 = (size_t)T * 256 / 8;
    for (size_t i0 = gt; i0 < n8; i0 += 4 * NT) { f32x4 a[4], b[4];
#pragma unroll
        for (int q4 = 0; q4 < 4; ++q4) { const size_t i = i0 + q4 * NT; if (i < n8) { a[q4] = *((const f32x4*)p + 2 * i); b[q4] = *((const f32x4*)p + 2 * i + 1); } }
#pragma unroll
        for (int q4 = 0; q4 < 4; ++q4) { const size_t i = i0 + q4 * NT; if (i < n8) { v4u o; o.x = pk2(a[q4].x, a[q4].y); o.y = pk2(a[q4].z, a[q4].w); o.z = pk2(b[q4].x, b[q4].y); o.w = pk2(b[q4].z, b[q4].w); *((v4u*)pb + i) = o; } } }
}
constexpr float QSCALE = 0.125f * LOG2E;
__device__ __forceinline__ void phase_prepA(Frame& F, const Args& a) {
    unsigned char* ws = F.ws; const bf16* UA = (const bf16*)(ws + WS_UA); const bf16* UB = (const bf16*)(ws + WS_UB);
    bf16* LIN = (bf16*)(ws + WS_LIN); bf16* QN = (bf16*)(ws + WS_QN); bf16* KN = (bf16*)(ws + WS_KN); bf16* VT = (bf16*)(ws + WS_VT);
    const float* mu = a.in[6]; const float* gq = a.in[3]; const float* gk = a.in[4];
    { const int gt = F.bid * 512 + F.tid, NT = F.G * 512; const int c8 = (gt & 31) << 3; float muv[8];
#pragma unroll
      for (int j = 0; j < 8; ++j) muv[j] = mu[1536 + c8 + j];
      for (int it0 = gt; it0 < T * 32; it0 += 4 * NT) { v4u ru[4], rp[4];
#pragma unroll
          for (int q4 = 0; q4 < 4; ++q4) { const int it = it0 + q4 * NT; if (it < T * 32) { const int t = it >> 5; ru[q4] = *(const v4u*)(UB + (size_t)t * UB_W + 1536 + c8); rp[q4] = *(const v4u*)(UB + (size_t)((t & (SEQ - 1)) ? t - 1 : t) * UB_W + 1536 + c8); } }
#pragma unroll
          for (int q4 = 0; q4 < 4; ++q4) { const int it = it0 + q4 * NT; if (it < T * 32) { const int t = it >> 5; float u[8], p[8], o[8]; unpack8(ru[q4], u); unpack8(rp[q4], p); const float pm = (t & (SEQ - 1)) ? 1.f : 0.f;
#pragma unroll
              for (int j = 0; j < 8; ++j) { const float s = u[j] + muv[j] * (p[j] * pm - u[j]); o[j] = c8 < 64 ? (1.0f - 2.0f * __builtin_amdgcn_rcpf(1.0f + __builtin_amdgcn_exp2f(2.0f * LOG2E * s))) : (c8 < 128 ? s : sigm(s));     }
              *(v4u*)(LIN + (size_t)t * 256 + c8) = pack8(o); } } } }
    { const int gw = F.bid * NWAVES + F.wave, NGW = F.G * NWAVES, lane = F.lane; float gqv[8], gkv[8];
#pragma unroll
      for (int j = 0; j < 8; ++j) { gqv[j] = gq[((lane & 7) << 3) + j] * QSCALE; gkv[j] = gk[((lane & 7) << 3) + j]; }
      for (int t0 = gw; t0 < T; t0 += 4 * NGW) { v4u rq[4], rk[4];
#pragma unroll
          for (int q4 = 0; q4 < 4; ++q4) { const int t = t0 + q4 * NGW; if (t < T) { rq[q4] = *(const v4u*)(UA + (size_t)t * UA_W + 8 * lane); rk[q4] = *(const v4u*)(UA + (size_t)t * UA_W + UA_K + 8 * (lane & 7)); } }
#pragma unroll
          for (int q4 = 0; q4 < 4; ++q4) { const int t = t0 + q4 * NGW; if (t < T) {
              float q[8], k[8]; unpack8(rq[q4], q); unpack8(rk[q4], k);
              float sq = 0.f, sk = 0.f;
#pragma unroll
              for (int j = 0; j < 8; ++j) { sq += q[j] * q[j]; sk += k[j] * k[j]; }
              sq += __shfl_xor(sq, 1); sq += __shfl_xor(sq, 2); sq += __shfl_xor(sq, 4); sk += __shfl_xor(sk, 1); sk += __shfl_xor(sk, 2); sk += __shfl_xor(sk, 4);
              const float rq_ = rsqrtf(sq * (1.f / 64.f) + NORM_EPS), rk_ = rsqrtf(sk * (1.f / 64.f) + NORM_EPS);
#pragma unroll
              for (int j = 0; j < 8; ++j) { q[j] *= rq_ * gqv[j]; k[j] *= rk_ * gkv[j]; }
              *(v4u*)(QN + (size_t)t * 512 + 8 * lane) = pack8(q);
              if (lane < 8) *(v4u*)(KN + (size_t)t * 64 + 8 * lane) = pack8(k); } } } }
    { const int gt = F.bid * 512 + F.tid, NT = F.G * 512;
      for (int it = gt; it < T * 8; it += NT) { const int t = it >> 3, c8 = (it & 7) << 3; *(v4u*)(VT + (size_t)t * 64 + c8) = *(const v4u*)(UA + (size_t)t * UA_W + UA_V + c8); } }
}
constexpr int IDX_STRIDE = 2052, KSEL = 256;
__device__ __forceinline__ void topk_select(const LAS float* row, int limit, unsigned* maskrow, int lane) {
    unsigned long long mybits = 0ull; const int nj = limit >> 6;
    if (limit <= KSEL) { mybits = lane < nj ? ~0ull : 0ull; }
    else {
        unsigned key[32];
#pragma unroll
        for (int j = 0; j < 32; ++j) key[j] = 0u;
#pragma unroll
        for (int g8 = 0; g8 < 4; ++g8) if (8 * g8 < nj) {
#pragma unroll
            for (int jj = 0; jj < 8; ++jj) { const int j = 8 * g8 + jj; unsigned u = __float_as_uint(row[64 * j + lane]); if (u == 0x80000000u) u = 0u; const unsigned k = (u & 0x80000000u) ? ~u : (u | 0x80000000u); key[j] = (j < nj) ? k : 0u; } }
        unsigned prefix = 0u; bool exact = false;
        for (int bit = 31; bit >= 0; --bit) { const unsigned cand = prefix | (1u << bit); int c0 = 0, c1 = 0;
#pragma unroll
            for (int g8 = 0; g8 < 4; ++g8) if (8 * g8 < nj) {
#pragma unroll
                for (int jj = 0; jj < 8; jj += 2) { c0 += __builtin_popcountll(__ballot(key[8 * g8 + jj] >= cand)); c1 += __builtin_popcountll(__ballot(key[8 * g8 + jj + 1] >= cand)); } }
            const int cnt = c0 + c1;
            if (cnt >= KSEL) { prefix = cand; if (cnt == KSEL) { exact = true; break; } } }
        int need = 0;
        if (!exact) { int cgt = 0;
#pragma unroll
            for (int j = 0; j < 32; ++j) cgt += __builtin_popcountll(__ballot(key[j] > prefix));
            need = KSEL - cgt; }
        int running = 0; const unsigned long long below = (1ull << lane) - 1ull;
#pragma unroll
        for (int g8 = 0; g8 < 4; ++g8) if (8 * g8 < nj)
#pragma unroll
        for (int jj = 0; jj < 8; ++jj) { const int j = 8 * g8 + jj;
            const bool gt = exact ? (key[j] >= prefix) : (key[j] > prefix); const bool tie = (!exact) && key[j] == prefix;
            const unsigned long long tb = __ballot(tie); const int rank = running + __builtin_popcountll(tb & below); running += __builtin_popcountll(tb);
            const unsigned long long sb = __ballot(gt || (tie && rank < need)); if (lane == j) mybits = sb; }
    }
    if (lane < 32) { v2u w; w.x = (unsigned)mybits; w.y = (unsigned)(mybits >> 32); *(v2u*)(maskrow + 2 * lane) = w; }
}
__device__ __forceinline__ void phase_indexer(Frame& F) {
    unsigned char* ws = F.ws; const bf16* UA = (const bf16*)(ws + WS_UA); unsigned* MASK = (unsigned*)(ws + WS_MASK);
    LAS float* sc = (LAS float*)F.lds; const int lane = F.lane, w = F.wave, fr = lane & 15, fq = lane >> 4;
    for (int r = 0;; ++r) { const int u = r * F.G + ((r & 1) ? (F.G - 1 - F.bid) : F.bid); if (u >= NB * 128) break;
        const int c = 31 - (u >> 7), rest = u & 127, b = rest >> 2, g4 = rest & 3, limit = 64 * (c + 1), tq0 = b * SEQ + c * 64 + g4 * 16;
        const bf16* UAb = UA + (size_t)b * SEQ * UA_W;
        bf16x8 qf[4][2]; float iwv[4];
        { const bf16* qp = UA + (size_t)(tq0 + fr) * UA_W;
#pragma unroll
          for (int hh = 0; hh < 4; ++hh) { qf[hh][0] = *(const bf16x8*)(qp + UA_IQ + hh * 64 + fq * 8); qf[hh][1] = *(const bf16x8*)(qp + UA_IQ + hh * 64 + 32 + fq * 8); iwv[hh] = bf1(qp[UA_IW + hh]) * (1.f / 16.f); } }
#ifndef IDX_SCORE_REP
#define IDX_SCORE_REP 1
#endif
#ifndef IDX_SEL_REP
#define IDX_SEL_REP 1
#endif
        for (int rp_ = 0; rp_ < IDX_SCORE_REP; ++rp_)
        for (int kt = w; kt < (limit >> 4); kt += NWAVES) {
            const bf16* kp = UAb + (size_t)(kt * 16 + fr) * UA_W + UA_IK + fq * 8; const bf16x8 a0 = *(const bf16x8*)kp, a1 = *(const bf16x8*)(kp + 32);
            f32x4 s = {0.f, 0.f, 0.f, 0.f};
#pragma unroll
            for (int hh = 0; hh < 4; ++hh) { f32x4 d = {0.f, 0.f, 0.f, 0.f}; d = __builtin_amdgcn_mfma_f32_16x16x32_bf16(a0, qf[hh][0], d, 0, 0, 0); d = __builtin_amdgcn_mfma_f32_16x16x32_bf16(a1, qf[hh][1], d, 0, 0, 0);
#pragma unroll
                for (int j = 0; j < 4; ++j) s[j] += iwv[hh] * fmaxf(d[j], 0.f); }
            *(LAS f32x4*)(sc + fr * IDX_STRIDE + kt * 16 + fq * 4) = s; }
        __syncthreads();
#pragma unroll 1
        for (int qq = 0; qq < 2 * IDX_SEL_REP; ++qq) { const int q = 2 * w + (qq & 1); topk_select(sc + q * IDX_STRIDE, limit, MASK + (size_t)(tq0 + q) * 64, lane); }
        __syncthreads(); }
}
constexpr int DA_K = 0, DA_V = 8192, DA_M = 16384, DA_STAGE = 16384 + 512;
__device__ __forceinline__ bf16x8 mk8(v2u lo, v2u hi) { v4u t; t.x = lo.x; t.y = lo.y; t.z = hi.x; t.w = hi.y; return __builtin_bit_cast(bf16x8, t); }
__device__ __forceinline__ void tr_read_v4d(unsigned a, bf16x8 (&vf)[4]) { s16x4 l0, h0, l1, h1, l2, h2, l3, h3;
    asm volatile("ds_read_b64_tr_b16 %0, %8\n\tds_read_b64_tr_b16 %1, %8 offset:512\n\tds_read_b64_tr_b16 %2, %8 offset:32\n\tds_read_b64_tr_b16 %3, %8 offset:544\n\t"
                 "ds_read_b64_tr_b16 %4, %8 offset:64\n\tds_read_b64_tr_b16 %5, %8 offset:576\n\tds_read_b64_tr_b16 %6, %8 offset:96\n\tds_read_b64_tr_b16 %7, %8 offset:608\n\ts_waitcnt lgkmcnt(0)"
                 : "=&v"(l0), "=&v"(h0), "=&v"(l1), "=&v"(h1), "=&v"(l2), "=&v"(h2), "=&v"(l3), "=&v"(h3) : "v"(a) : "memory");
    vf[0] = (bf16x8){l0[0], l0[1], l0[2], l0[3], h0[0], h0[1], h0[2], h0[3]}; vf[1] = (bf16x8){l1[0], l1[1], l1[2], l1[3], h1[0], h1[1], h1[2], h1[3]};
    vf[2] = (bf16x8){l2[0], l2[1], l2[2], l2[3], h2[0], h2[1], h2[2], h2[3]}; vf[3] = (bf16x8){l3[0], l3[1], l3[2], l3[3], h3[0], h3[1], h3[2], h3[3]}; }
__device__ __forceinline__ void phase_dsa_attn(Frame& F, const Args& a) {
    unsigned char* ws = F.ws; const bf16* QN = (const bf16*)(ws + WS_QN); const bf16* KN = (const bf16*)(ws + WS_KN); const bf16* VN = (const bf16*)(ws + WS_VT);
    const unsigned* MASK = (const unsigned*)(ws + WS_MASK); bf16* MIX = (bf16*)(ws + WS_XB);
    const int lane = F.lane, w = F.wave, fr = lane & 15, fq = lane >> 4; LAS unsigned char* lds = F.lds;
    const float mb = 8.f * LOG2E * wave_max(fabsf(a.in[3][lane])) * wave_max(fabsf(a.in[4][lane]));
    const unsigned vtr_lane = (unsigned)((8 * fq + ((lane & 15) >> 2)) * 128 + 4 * (lane & 3) * 2);
    for (int r = 0;; ++r) { const int u = r * F.G + ((r & 1) ? (F.G - 1 - F.bid) : F.bid); if (u >= NB * 32) break;
        const int c = 31 - (u >> 5), b = u & 31, nst = c + 1, t0 = b * SEQ + 64 * c;
        const bf16* Kb = KN + (size_t)b * SEQ * 64; const bf16* Vb = VN + (size_t)b * SEQ * 64; const unsigned* Mb = MASK + (size_t)t0 * 64;
#define DA_DMA(st_, buf_) do { const int so_ = (buf_) * DA_STAGE; \
            __builtin_amdgcn_global_load_lds((const unsigned*)(Kb + (size_t)(64 * (st_) + 8 * w) * 64 + lane * 8), (LAS unsigned*)(lds + so_ + DA_K + w * 1024), 16, 0, 0); \
            __builtin_amdgcn_global_load_lds((const unsigned*)(Vb + (size_t)(64 * (st_) + 8 * w) * 64 + lane * 8), (LAS unsigned*)(lds + so_ + DA_V + w * 1024), 16, 0, 0); \
            if (w < 2) __builtin_amdgcn_global_load_lds(Mb + (size_t)lane * 64 + 2 * (st_) + w, (LAS unsigned*)(lds + so_ + DA_M + w * 256), 4, 0, 0); } while (0)
        DA_DMA(0, 0);
        bf16x8 qf[4][2];
#pragma unroll
        for (int i = 0; i < 4; ++i) { const bf16* qp = QN + (size_t)(t0 + 16 * i + fr) * 512 + w * 64 + fq * 8; qf[i][0] = *(const bf16x8*)qp; qf[i][1] = *(const bf16x8*)(qp + 32); }
        f32x4 O[4][4]; float l[4];
#pragma unroll
        for (int i = 0; i < 4; ++i) { l[i] = 0.f;
#pragma unroll
            for (int dt = 0; dt < 4; ++dt) O[i][dt] = (f32x4){0.f, 0.f, 0.f, 0.f}; }
        for (int st = 0; st < nst; ++st) { const int buf = st & 1; const LAS unsigned char* sb = lds + buf * DA_STAGE;
            asm volatile("s_waitcnt vmcnt(0)" ::: "memory");
            __builtin_amdgcn_s_barrier(); asm volatile("" ::: "memory");
            if (st + 1 < nst) DA_DMA(st + 1, buf ^ 1);
#pragma unroll
            for (int sub = 0; sub < 2; ++sub) {
                bf16x8 kf[2][2], vf[4]; unsigned mw[4];
#pragma unroll
                for (int s2 = 0; s2 < 2; ++s2) { const LAS unsigned char* kp = sb + DA_K + (32 * sub + 8 * (fr >> 2) + 4 * s2 + (fr & 3)) * 128 + fq * 16;   kf[s2][0] = *(const LAS bf16x8*)kp; kf[s2][1] = *(const LAS bf16x8*)(kp + 64); }
#pragma unroll
                for (int i = 0; i < 4; ++i) mw[i] = *(const LAS unsigned*)(sb + DA_M + sub * 256 + (16 * i + fr) * 4);
                tr_read_v4d((unsigned)(size_t)(sb + DA_V + sub * 4096) + vtr_lane, vf);
#pragma unroll
                for (int i = 0; i < 4; ++i) {
                    f32x4 s0 = {0.f, 0.f, 0.f, 0.f}, s1 = {0.f, 0.f, 0.f, 0.f};
                    s0 = __builtin_amdgcn_mfma_f32_16x16x32_bf16(kf[0][0], qf[i][0], s0, 0, 0, 0); s0 = __builtin_amdgcn_mfma_f32_16x16x32_bf16(kf[0][1], qf[i][1], s0, 0, 0, 0);
                    s1 = __builtin_amdgcn_mfma_f32_16x16x32_bf16(kf[1][0], qf[i][0], s1, 0, 0, 0); s1 = __builtin_amdgcn_mfma_f32_16x16x32_bf16(kf[1][1], qf[i][1], s1, 0, 0, 0);
                    const unsigned b0 = mw[i] >> (8 * fq), b1 = mw[i] >> (8 * fq + 4); float p[8];
#pragma unroll
                    for (int j = 0; j < 4; ++j) { p[j] = ((b0 >> j) & 1u) ? __builtin_amdgcn_exp2f(s0[j] - mb) : 0.f; p[4 + j] = ((b1 >> j) & 1u) ? __builtin_amdgcn_exp2f(s1[j] - mb) : 0.f; }
                    l[i] += ((p[0] + p[1]) + (p[2] + p[3])) + ((p[4] + p[5]) + (p[6] + p[7]));
                    const bf16x8 pa = __builtin_bit_cast(bf16x8, pack8(p));
#pragma unroll
                    for (int dt = 0; dt < 4; ++dt) O[i][dt] = __builtin_amdgcn_mfma_f32_16x16x32_bf16(pa, vf[dt], O[i][dt], 0, 0, 0);
                } } }
#undef DA_DMA
#pragma unroll
        for (int i = 0; i < 4; ++i) { float li = l[i]; li += __shfl_xor(li, 16); li += __shfl_xor(li, 32);
#pragma unroll
            for (int j = 0; j < 4; ++j) { const float inv = 1.0f / __shfl(li, 4 * fq + j); bf16* op = MIX + (size_t)(t0 + 16 * i + 4 * fq + j) * D + w * 64 + fr;
#pragma unroll
                for (int dt = 0; dt < 4; ++dt) op[16 * dt] = (bf16)f2bf(O[i][dt][j] * inv); } }
        VM_WAIT(); __syncthreads();
    }
}
__device__ __forceinline__ float rw_decay(float x) { const float sp = fmaxf(-x, 0.f) + 0.6931471805599453f * __builtin_amdgcn_logf(1.0f + __builtin_amdgcn_exp2f(-LOG2E * fabsf(x)));
    return __builtin_amdgcn_exp2f(-LOG2E * __builtin_amdgcn_exp2f(-LOG2E * (sp + 0.5f))); }
#define MF32(a_, b_, c_) __builtin_amdgcn_mfma_f32_16x16x4f32((a_), (b_), (c_), 0, 0, 0)
constexpr int RT = 68, RG = 20, RGM = 16 * RG;
constexpr int RL_AH = 0, RL_BH = 64 * RT, RL_KH = 2 * 64 * RT, RL_RH = 3 * 64 * RT, RL_VX = 4 * 64 * RT, RL_GS = 5 * 64 * RT, RL_YA = 6 * 64 * RT, RL_GR = 7 * 64 * RT, RL_PM = RL_GR + 16 * RGM, RL_GC = RL_PM + 4 * RGM, RL_BON = RL_GC + 256, RL_END = RL_BON + 64;
static_assert(RL_END * 4 <= MISC_OFF, "RWKV LDS");
__device__ __forceinline__ void phase_rwkv(Frame& F, const Args& a) {
    unsigned char* ws = F.ws; const bf16* UB = (const bf16*)(ws + WS_UB); const bf16* LOUT = (const bf16*)(ws + WS_LOUT); bf16* MIX = (bf16*)(ws + WS_XB);
    const float* mu = a.in[6]; const float* w0 = a.in[7]; const float* a0 = a.in[9]; const float* k_k = a.in[12]; const float* k_a = a.in[13]; const float* r_k = a.in[14]; const float* gn_g = a.in[15]; const float* gn_b = a.in[16];
    const int lane = F.lane, w = F.wave, n = lane & 15, q = lane >> 4;
    LAS float* L = (LAS float*)F.lds;
    for (int bh = F.bid; bh < NB * 8; bh += F.G) {
        const int b = bh >> 3, h = bh & 7, c = h * 64 + lane;
        const float mur = mu[c], muk = mu[512 + c], muv = mu[1024 + c], w0c = w0[c], a0c = a0[c], kkc = k_k[c], kac = k_a[c], rkc = r_k[c], gng = gn_g[c], gnb = gn_b[c];
        f32x4 Z[4];
#pragma unroll
        for (int kt = 0; kt < 4; ++kt) Z[kt] = (f32x4){0.f, 0.f, 0.f, 0.f};
        const int ch = w >> 1, hs = w & 1;
        float r_ur[8], r_uk[8], r_uv[8], r_pr[8], r_pk[8], r_pv[8], r_wd[8], r_ad[8], r_gg[8], r_wf[8];
#define RW_RAW(batch_) do { _Pragma("unroll") for (int i = 0; i < 8; ++i) { const int sl = (batch_) * 64 + 16 * ch + 8 * hs + i; const size_t t = (size_t)b * SEQ + sl; const bf16* up = UB + t * UB_W + c; const bf16* pp_ = sl > 0 ? up - UB_W : up; \
            r_ur[i] = bf1(up[0]); r_uk[i] = bf1(up[512]); r_uv[i] = bf1(up[1024]); r_pr[i] = bf1(pp_[0]); r_pk[i] = bf1(pp_[512]); r_pv[i] = bf1(pp_[1024]); \
            const bf16* lp = LOUT + t * 1536 + c; r_wd[i] = bf1(lp[0]); r_ad[i] = bf1(lp[512]); r_gg[i] = bf1(lp[1024]); \
            r_wf[i] = bf1(LOUT[((size_t)b * SEQ + (batch_) * 64 + 16 * ch + i) * 1536 + c]); } } while (0)
        RW_RAW(0);
        for (int batch = 0; batch < SEQ / 64; ++batch) {
            { float gcur = 1.f;
              if (hs) {
#pragma unroll
                  for (int i = 0; i < 8; ++i) gcur *= rw_decay(w0c + r_wf[i]); }
#pragma unroll
              for (int i = 0; i < 8; ++i) { const int tl = 16 * ch + 8 * hs + i, sl = batch * 64 + tl; const float pm = sl > 0 ? 1.f : 0.f;
                const float ur = r_ur[i], uk = r_uk[i], uv = r_uv[i], pr = r_pr[i] * pm, pk = r_pk[i] * pm, pv = r_pv[i] * pm;
                const float rr = ur + mur * (pr - ur), kx = uk + muk * (pk - uk), vx = uv + muv * (pv - uv);
                const float decay = rw_decay(w0c + r_wd[i]), av = sigm(a0c + r_ad[i]);
                float kk = kx * kkc; kk = kk * rsqrtf(fmaxf(wave_sum(kk * kk), 1e-24f));
                const float km = kx * (1.f + (av - 1.f) * kac); const float bon = wave_sum(rr * km * rkc);
                const float gprev = gcur; gcur *= decay; const float ig = __builtin_amdgcn_rcpf(gcur);
                L[RL_AH + tl * RT + lane] = -kk * gprev; L[RL_BH + tl * RT + lane] = kk * av * ig; L[RL_KH + tl * RT + lane] = km * ig; L[RL_RH + tl * RT + lane] = rr * gcur;
                L[RL_VX + tl * RT + lane] = vx; L[RL_GS + tl * RT + lane] = r_gg[i]; if (lane == 0) L[RL_BON + tl] = bon; }
              if (hs) L[RL_GC + ch * 64 + lane] = gcur; }
            LDS_WAIT(); __syncthreads();
            if (batch + 1 < SEQ / 64) RW_RAW(batch + 1);
            { const LAS float* ah = L + RL_AH + 16 * ch * RT; const LAS float* bhm = L + RL_BH + 16 * ch * RT; const LAS float* khm = L + RL_KH + 16 * ch * RT; const LAS float* rhm = L + RL_RH + 16 * ch * RT;
              LAS float* gr = L + RL_GR + ch * 4 * RGM; LAS float* pm_ = L + RL_PM + ch * RGM;
              if (hs == 0) {
                  f32x4 m = {0.f, 0.f, 0.f, 0.f};
#pragma unroll
                  for (int s = 0; s < 16; ++s) m = MF32(bhm[n * RT + 4 * s + q], ah[n * RT + 4 * s + q], m);
                  f32x4 tm;
#pragma unroll
                  for (int j = 0; j < 4; ++j) { m[j] = (4 * q + j < n) ? m[j] : 0.f; tm[j] = m[j] + ((4 * q + j == n) ? 1.f : 0.f); pm_[(4 * q + j) * RG + n] = m[j]; gr[(4 * q + j) * RG + n] = tm[j]; }
#pragma unroll
                  for (int rd = 0; rd < 3; ++rd) { LDS_WAIT();
                      f32x4 p2 = {0.f, 0.f, 0.f, 0.f};
#pragma unroll
                      for (int s = 0; s < 4; ++s) p2 = MF32(pm_[n * RG + 4 * s + q], pm_[(4 * s + q) * RG + n], p2);
                      f32x4 ip, t2 = {0.f, 0.f, 0.f, 0.f};
#pragma unroll
                      for (int j = 0; j < 4; ++j) ip[j] = p2[j] + ((4 * q + j == n) ? 1.f : 0.f);
#pragma unroll
                      for (int j = 0; j < 4; ++j) t2 = MF32(gr[n * RG + 4 * q + j], ip[j], t2);
                      LDS_WAIT();
#pragma unroll
                      for (int j = 0; j < 4; ++j) { pm_[(4 * q + j) * RG + n] = p2[j]; gr[(4 * q + j) * RG + n] = t2[j]; } }
              } else {
                  f32x4 mk = {0.f, 0.f, 0.f, 0.f}, nb = {0.f, 0.f, 0.f, 0.f}, nk = {0.f, 0.f, 0.f, 0.f};
#pragma unroll
                  for (int s = 0; s < 16; ++s) { const float av_ = ah[n * RT + 4 * s + q], rv_ = rhm[n * RT + 4 * s + q], bv_ = bhm[n * RT + 4 * s + q], kv_ = khm[n * RT + 4 * s + q];
                      mk = MF32(kv_, av_, mk); nb = MF32(bv_, rv_, nb); nk = MF32(kv_, rv_, nk); }
#pragma unroll
                  for (int j = 0; j < 4; ++j) { const int s_ = 4 * q + j; gr[RGM + s_ * RG + n] = (s_ < n) ? mk[j] : 0.f; gr[2 * RGM + s_ * RG + n] = (s_ <= n) ? nb[j] : 0.f; gr[3 * RGM + s_ * RG + n] = (s_ <= n) ? nk[j] : 0.f; } } }
            LDS_WAIT(); __syncthreads();
#ifndef RW_C_REP
#define RW_C_REP 1
#endif
            if (w < 4) { const int v = 16 * w + n; f32x4 Zs[4]; for (int kt = 0; kt < 4; ++kt) Zs[kt] = Z[kt];
              for (int rc_ = 0; rc_ < RW_C_REP; ++rc_) { if (rc_) for (int kt = 0; kt < 4; ++kt) Z[kt] = Zs[kt];
#pragma unroll 1
                for (int cc = 0; cc < 4; ++cc) { const LAS float* ah = L + RL_AH + 16 * cc * RT; const LAS float* bhm = L + RL_BH + 16 * cc * RT; const LAS float* khm = L + RL_KH + 16 * cc * RT; const LAS float* rhm = L + RL_RH + 16 * cc * RT;
                    const LAS float* vx = L + RL_VX + 16 * cc * RT; const LAS float* gr = L + RL_GR + cc * 4 * RGM;
                    float vb[4];
#pragma unroll
                    for (int s = 0; s < 4; ++s) vb[s] = vx[(4 * s + q) * RT + v];
                    f32x4 X = {0.f, 0.f, 0.f, 0.f}, Y = {0.f, 0.f, 0.f, 0.f};
#pragma unroll
                    for (int kt = 0; kt < 4; ++kt)
#pragma unroll
                        for (int j = 0; j < 4; ++j) { X = MF32(ah[n * RT + 16 * kt + 4 * q + j], Z[kt][j], X); Y = MF32(rhm[n * RT + 16 * kt + 4 * q + j], Z[kt][j], Y); }
#pragma unroll
                    for (int s = 0; s < 4; ++s) { X = MF32(gr[RGM + (4 * s + q) * RG + n], vb[s], X); Y = MF32(gr[3 * RGM + (4 * s + q) * RG + n], vb[s], Y); }
                    f32x4 U = {0.f, 0.f, 0.f, 0.f};
#pragma unroll
                    for (int j = 0; j < 4; ++j) U = MF32(gr[(4 * q + j) * RG + n], X[j], U);
#pragma unroll
                    for (int j = 0; j < 4; ++j) Y = MF32(gr[2 * RGM + (4 * q + j) * RG + n], U[j], Y);
#pragma unroll
                    for (int j = 0; j < 4; ++j) L[RL_YA + (16 * cc + 4 * q + j) * RT + v] = Y[j];
#pragma unroll
                    for (int kt = 0; kt < 4; ++kt) {
#pragma unroll
                        for (int j = 0; j < 4; ++j) Z[kt] = MF32(bhm[(4 * q + j) * RT + 16 * kt + n], U[j], Z[kt]);
#pragma unroll
                        for (int s = 0; s < 4; ++s) Z[kt] = MF32(khm[(4 * s + q) * RT + 16 * kt + n], vb[s], Z[kt]);
                        const f32x4 gc = *(const LAS f32x4*)(L + RL_GC + cc * 64 + 16 * kt + 4 * q); Z[kt] = Z[kt] * gc; } } } }
            LDS_WAIT(); __syncthreads();
#pragma unroll
            for (int i = 0; i < 8; ++i) { const int step = w + 8 * i; const size_t t = (size_t)b * SEQ + batch * 64 + step;
                const float y = L[RL_YA + step * RT + lane], mean = wave_sum(y) * (1.f / 64.f), dlt = y - mean, var = fmaxf(wave_sum(y * y) * (1.f / 64.f) - mean * mean, 0.f);
                const float yn = dlt * rsqrtf(var + 64e-5f) * gng + gnb; const float o = (yn + L[RL_BON + step] * L[RL_VX + step * RT + lane]) * L[RL_GS + step * RT + lane];
                MIX[t * D + 512 + c] = (bf16)f2bf(o); }
            LDS_WAIT(); __syncthreads();
        }
#undef RW_RAW
    }
}
__device__ __forceinline__ void phase_l1prep(Frame& F, const Args& a, int hb) {
    unsigned char* ws = F.ws; const bf16* XM = (const bf16*)(ws + WS_XM); bf16* XC = (bf16*)(ws + WS_XC); bf16* Q = (bf16*)(ws + WS_Q); bf16* K = (bf16*)(ws + WS_K); bf16* V = (bf16*)(ws + WS_V);
    float* GI = (float*)(ws + WS_GI); const float* W12 = (const float*)(ws + WS_W12);
    const float* cw = a.in[19]; const float* cb = a.in[20]; const float* wq = a.in[21]; const float* wk = a.in[22]; const float* wv = a.in[23]; const float* b_i = a.in[25]; const float* b_f = a.in[26];
    const int g = F.tid, lane = F.lane, w = F.wave; LAS float* red = (LAS float*)F.lds;
    float cwr[4][4], cbr[4], wqr[16], wkr[16], wvr[16], w1[32], w2[32];
#pragma unroll
    for (int j = 0; j < 4; ++j)
#pragma unroll
        for (int i = 0; i < 4; ++i) cwr[j][i] = cw[j * CI + 4 * g + i];
#pragma unroll
    for (int i = 0; i < 4; ++i) cbr[i] = cb[4 * g + i];
#pragma unroll
    for (int i = 0; i < 16; ++i) { wqr[i] = wq[g * 16 + i]; wkr[i] = wk[g * 16 + i]; wvr[i] = wv[g * 16 + i]; }
#pragma unroll
    for (int i = 0; i < 32; ++i) { w1[i] = W12[(size_t)(4 * g) * 8 + i]; w2[i] = W12[(size_t)(2048 + 4 * g) * 8 + i]; }
    const int per = TH / F.G;
    const int tb = F.bid * per;
    float x0[4], x1[4], x2[4];
    { const int sl = tb & (SEQ - 1);
#pragma unroll
      for (int i = 0; i < 4; ++i) { x0[i] = 0.f; x1[i] = 0.f; x2[i] = 0.f; }
      if (sl >= 1) { const v2u r = *(const v2u*)(XM + (size_t)(tb - 1) * CI + 4 * g); x2[0] = bflo(r.x); x2[1] = bfhi(r.x); x2[2] = bflo(r.y); x2[3] = bfhi(r.y); }
      if (sl >= 2) { const v2u r = *(const v2u*)(XM + (size_t)(tb - 2) * CI + 4 * g); x1[0] = bflo(r.x); x1[1] = bfhi(r.x); x1[2] = bflo(r.y); x1[3] = bfhi(r.y); }
      if (sl >= 3) { const v2u r = *(const v2u*)(XM + (size_t)(tb - 3) * CI + 4 * g); x0[0] = bflo(r.x); x0[1] = bfhi(r.x); x0[2] = bflo(r.y); x0[3] = bfhi(r.y); } }
    constexpr int L1PF = 4;
    v2u xq[L1PF][2];
#pragma unroll
    for (int pq = 0; pq < L1PF; ++pq)
#pragma unroll
        for (int tk = 0; tk < 2; ++tk) xq[pq][tk] = *(const v2u*)(XM + (size_t)(tb + 2 * pq + tk) * CI + 4 * g);
    for (int n4 = 0; n4 < per / 2; ++n4) { const int t4 = tb + 2 * n4;
        float gs[16]; v2u xr[2];
        xr[0] = xq[0][0]; xr[1] = xq[0][1];
#pragma unroll
        for (int pq = 0; pq + 1 < L1PF; ++pq) { xq[pq][0] = xq[pq + 1][0]; xq[pq][1] = xq[pq + 1][1]; }
        { const int tn = (n4 + L1PF < per / 2) ? t4 + 2 * L1PF : t4;
#pragma unroll
          for (int tk = 0; tk < 2; ++tk) xq[L1PF - 1][tk] = *(const v2u*)(XM + (size_t)(tn + tk) * CI + 4 * g); }
#pragma unroll
        for (int tk = 0; tk < 2; ++tk) { const int t = t4 + tk;
            float x3[4]; x3[0] = bflo(xr[tk].x); x3[1] = bfhi(xr[tk].x); x3[2] = bflo(xr[tk].y); x3[3] = bfhi(xr[tk].y);
            float xc[4], q[4], k[4], v[4];
#pragma unroll
            for (int i = 0; i < 4; ++i) { const float s = fmaf(cwr[3][i], x3[i], fmaf(cwr[2][i], x2[i], fmaf(cwr[1][i], x1[i], fmaf(cwr[0][i], x0[i], cbr[i])))); xc[i] = s * sigm(s); }
#pragma unroll
            for (int j = 0; j < 4; ++j) { q[j] = fmaf(xc[3], wqr[12 + j], fmaf(xc[2], wqr[8 + j], fmaf(xc[1], wqr[4 + j], xc[0] * wqr[j]))); k[j] = fmaf(xc[3], wkr[12 + j], fmaf(xc[2], wkr[8 + j], fmaf(xc[1], wkr[4 + j], xc[0] * wkr[j])));
                v[j] = fmaf(x3[3], wvr[12 + j], fmaf(x3[2], wvr[8 + j], fmaf(x3[1], wvr[4 + j], x3[0] * wvr[j]))); }
#pragma unroll
            for (int o = 0; o < 8; ++o) { float s = 0.f;
#pragma unroll
                for (int i = 0; i < 4; ++i) s = fmaf(x3[i], w2[i * 8 + o], fmaf(xc[i], w1[i * 8 + o], s));
                gs[tk * 8 + o] = s; }
            const size_t off = (size_t)t * CI + 4 * g; const float ks = 0.044194173824159216f;
            { v2u o; o.x = pk2(xc[0], xc[1]); o.y = pk2(xc[2], xc[3]); *(v2u*)(XC + off) = o; o.x = pk2(q[0], q[1]); o.y = pk2(q[2], q[3]); *(v2u*)(Q + off) = o;
              o.x = pk2(k[0] * ks, k[1] * ks); o.y = pk2(k[2] * ks, k[3] * ks); *(v2u*)(K + off) = o; o.x = pk2(v[0], v[1]); o.y = pk2(v[2], v[3]); *(v2u*)(V + off) = o; }
#pragma unroll
            for (int i = 0; i < 4; ++i) { x0[i] = x1[i]; x1[i] = x2[i]; x2[i] = x3[i]; } }
#define L1_STAGE(mask, n) { const bool hi_ = (lane & (mask)) != 0; _Pragma("unroll") for (int i = 0; i < (n) / 2; ++i) { const float send_ = hi_ ? gs[i] : gs[(n) / 2 + i]; const float keep_ = hi_ ? gs[(n) / 2 + i] : gs[i]; gs[i] = keep_ + __shfl_xor(send_, (mask)); } }
        L1_STAGE(32, 16) L1_STAGE(16, 8) L1_STAGE(8, 4) L1_STAGE(4, 2)
#undef L1_STAGE
        gs[0] += __shfl_xor(gs[0], 2); gs[0] += __shfl_xor(gs[0], 1);
        LAS float* rp = red + (n4 & 1) * 128;
        if ((lane & 3) == 0) rp[w * 16 + (lane >> 2)] = gs[0];
        LDS_WAIT(); __syncthreads();
        if (F.tid < 16) { float s = 0.f;
#pragma unroll
            for (int ww = 0; ww < 8; ++ww) s += rp[ww * 16 + F.tid];
            const int o = F.tid & 7; GI[(size_t)(t4 + (F.tid >> 3)) * 8 + o] = s + (o < 4 ? b_i[o] : b_f[o - 4]); }
    }
}
__device__ __forceinline__ void phase_gatescan(Frame& F) {
    unsigned char* ws = F.ws; const float* GI = (const float*)(ws + WS_GI); float* GA = (float*)(ws + WS_GA); float* GAM = (float*)(ws + WS_GAM); float* GEM = (float*)(ws + WS_GEM);
    const int lane = F.lane, w = F.wave, tid = F.tid; LAS float* wtot = (LAS float*)F.lds;
    for (int sq = F.bid; sq < (NB / 2) * 4; sq += F.G) { const int bl = sq >> 2, h = sq & 3; const size_t tq = (size_t)bl * SEQ + 4 * tid;
        float ip[4], c[4];
#pragma unroll
        for (int k = 0; k < 4; ++k) { ip[k] = GI[(tq + k) * 8 + h]; c[k] = -softplusf_(-GI[(tq + k) * 8 + 4 + h]); }
        c[1] += c[0]; c[2] += c[1]; c[3] += c[2];
        float inc = c[3];
#pragma unroll
        for (int o = 1; o < 64; o <<= 1) { const float n = __shfl_up(inc, o); if (lane >= o) inc += n; }
        if (lane == 63) wtot[w] = inc;
        LDS_WAIT(); __syncthreads();
        float off = inc - c[3];
#pragma unroll
        for (int ww = 0; ww < 8; ++ww) if (ww < w) off += wtot[ww];
        float Fv[4], av[4], m[4];
#pragma unroll
        for (int k = 0; k < 4; ++k) { Fv[k] = off + c[k]; av[k] = ip[k] - Fv[k]; }
        m[0] = av[0]; m[1] = fmaxf(m[0], av[1]); m[2] = fmaxf(m[1], av[2]); m[3] = fmaxf(m[2], av[3]);
        float incm = m[3];
#pragma unroll
        for (int o = 1; o < 64; o <<= 1) { const float n = __shfl_up(incm, o); if (lane >= o) incm = fmaxf(incm, n); }
        if (lane == 63) wtot[8 + w] = incm;
        LDS_WAIT(); __syncthreads();
        float offm = __shfl_up(incm, 1); if (lane == 0) offm = -INFINITY;
#pragma unroll
        for (int ww = 0; ww < 8; ++ww) if (ww < w) offm = fmaxf(offm, wtot[8 + ww]);
#pragma unroll
        for (int k = 0; k < 4; ++k) { const float A = fmaxf(offm, m[k]); GA[(tq + k) * 4 + h] = av[k]; GAM[(tq + k) * 4 + h] = A; GEM[(tq + k) * 4 + h] = __expf(-(Fv[k] + A)); }
        LDS_WAIT(); __syncthreads();
    }
}
constexpr int ML_PITCH = 1040, ML_TILE = 32 * ML_PITCH, ML_PP = 80, ML_PT = 64 * ML_PP;
constexpr int ML_K = 0, ML_V = 2 * ML_TILE, ML_P = 4 * ML_TILE, ML_DEN = ML_P + 2 * ML_PT, ML_AT = ML_DEN + 512, ML_AS = ML_AT + 256, ML_END = ML_AS + 8192;
constexpr int ML_ST = ML_P, ML_MR = ML_P + 4096;
static_assert(ML_MR + 512 <= ML_DEN, "mLSTM LDS tables");
static_assert(ML_END <= MISC_OFF, "mLSTM LDS");
__device__ __forceinline__ void tr_read_v4(unsigned a, bf16x8 (&vf)[4]) { s16x4 l0, h0, l1, h1, l2, h2, l3, h3;
    asm volatile("ds_read_b64_tr_b16 %0, %8\n\tds_read_b64_tr_b16 %1, %8 offset:4160\n\tds_read_b64_tr_b16 %2, %8 offset:32\n\tds_read_b64_tr_b16 %3, %8 offset:4192\n\t"
                 "ds_read_b64_tr_b16 %4, %8 offset:64\n\tds_read_b64_tr_b16 %5, %8 offset:4224\n\tds_read_b64_tr_b16 %6, %8 offset:96\n\tds_read_b64_tr_b16 %7, %8 offset:4256\n\ts_waitcnt lgkmcnt(0)"
                 : "=&v"(l0), "=&v"(h0), "=&v"(l1), "=&v"(h1), "=&v"(l2), "=&v"(h2), "=&v"(l3), "=&v"(h3) : "v"(a) : "memory");
    vf[0] = (bf16x8){l0[0], l0[1], l0[2], l0[3], h0[0], h0[1], h0[2], h0[3]}; vf[1] = (bf16x8){l1[0], l1[1], l1[2], l1[3], h1[0], h1[1], h1[2], h1[3]};
    vf[2] = (bf16x8){l2[0], l2[1], l2[2], l2[3], h2[0], h2[1], h2[2], h2[3]}; vf[3] = (bf16x8){l3[0], l3[1], l3[2], l3[3], h3[0], h3[1], h3[2], h3[3]}; }
static_assert(4 * ML_PITCH == 4160, "tr_read_v4 offsets");
__device__ __forceinline__ void tr_read_v8(unsigned a, bf16x8 (&vf)[8]) { s16x4 l0, h0, l1, h1, l2, h2, l3, h3, l4, h4, l5, h5, l6, h6, l7, h7;
    asm volatile("ds_read_b64_tr_b16 %0, %16\n\tds_read_b64_tr_b16 %1, %16 offset:4160\n\tds_read_b64_tr_b16 %2, %16 offset:32\n\tds_read_b64_tr_b16 %3, %16 offset:4192\n\t"
                 "ds_read_b64_tr_b16 %4, %16 offset:64\n\tds_read_b64_tr_b16 %5, %16 offset:4224\n\tds_read_b64_tr_b16 %6, %16 offset:96\n\tds_read_b64_tr_b16 %7, %16 offset:4256\n\t"
                 "ds_read_b64_tr_b16 %8, %16 offset:128\n\tds_read_b64_tr_b16 %9, %16 offset:4288\n\tds_read_b64_tr_b16 %10, %16 offset:160\n\tds_read_b64_tr_b16 %11, %16 offset:4320\n\t"
                 "ds_read_b64_tr_b16 %12, %16 offset:192\n\tds_read_b64_tr_b16 %13, %16 offset:4352\n\tds_read_b64_tr_b16 %14, %16 offset:224\n\tds_read_b64_tr_b16 %15, %16 offset:4384\n\ts_waitcnt lgkmcnt(0)"
                 : "=&v"(l0), "=&v"(h0), "=&v"(l1), "=&v"(h1), "=&v"(l2), "=&v"(h2), "=&v"(l3), "=&v"(h3), "=&v"(l4), "=&v"(h4), "=&v"(l5), "=&v"(h5), "=&v"(l6), "=&v"(h6), "=&v"(l7), "=&v"(h7) : "v"(a) : "memory");
    vf[0] = (bf16x8){l0[0], l0[1], l0[2], l0[3], h0[0], h0[1], h0[2], h0[3]}; vf[1] = (bf16x8){l1[0], l1[1], l1[2], l1[3], h1[0], h1[1], h1[2], h1[3]};
    vf[2] = (bf16x8){l2[0], l2[1], l2[2], l2[3], h2[0], h2[1], h2[2], h2[3]}; vf[3] = (bf16x8){l3[0], l3[1], l3[2], l3[3], h3[0], h3[1], h3[2], h3[3]};
    vf[4] = (bf16x8){l4[0], l4[1], l4[2], l4[3], h4[0], h4[1], h4[2], h4[3]}; vf[5] = (bf16x8){l5[0], l5[1], l5[2], l5[3], h5[0], h5[1], h5[2], h5[3]};
    vf[6] = (bf16x8){l6[0], l6[1], l6[2], l6[3], h6[0], h6[1], h6[2], h6[3]}; vf[7] = (bf16x8){l7[0], l7[1], l7[2], l7[3], h7[0], h7[1], h7[2], h7[3]}; }
template <int PB> __device__ __forceinline__ void phase_mlstm_t(Frame& F, const Args& a) {
    constexpr bool skK = PB & 1, skV = PB & 2, skS = PB & 4, skP = PB & 8, skE = PB & 16;
    unsigned char* ws = F.ws; const bf16* Q = (const bf16*)(ws + WS_Q); const bf16* K = (const bf16*)(ws + WS_K); const bf16* V = (const bf16*)(ws + WS_V); const bf16* XC = (const bf16*)(ws + WS_XC); const bf16* Z = (const bf16*)(ws + WS_Z);
    bf16* YC = (bf16*)(ws + WS_XM); const float* GA = (const float*)(ws + WS_GA); const float* GAM = (const float*)(ws + WS_GAM); const float* GEM = (const float*)(ws + WS_GEM);
    const float* mh_g = a.in[27]; const float* skip = a.in[28];
    const int tid = F.tid, lane = F.lane, w = F.wave, fr = lane & 15, fq = lane >> 4; LAS unsigned char* lds = F.lds;
    LAS float* den2 = (LAS float*)(lds + ML_DEN); LAS float* stats = (LAS float*)(lds + ML_ST); LAS float* mr = (LAS float*)(lds + ML_MR); LAS float* em_s = (LAS float*)(lds + ML_AT); LAS float* as_s = (LAS float*)(lds + ML_AS);
    const int st = w & 1, tp = (w >> 1) & 1, wv = w & 3;
    const unsigned vtr_lane = (unsigned)((8 * fq + ((lane & 15) >> 2)) * ML_PITCH + (128 * wv + 4 * (lane & 3)) * 2);
#define ML_DMA(gbase, tile_off) do { _Pragma("unroll") for (int r4 = 0; r4 < 4; ++r4) { const int rr = w + 8 * r4; \
        __builtin_amdgcn_global_load_lds((const unsigned*)((gbase) + (size_t)rr * CI + lane * 8), (LAS unsigned*)(lds + (tile_off) + rr * ML_PITCH), 16, 0, 0); } } while (0)
#define ML_STEP_HEAD() const int buf = k & 1; int j = k + jstart; if (j >= nk) j -= nk; int jn = j + 1; if (jn >= nk) jn -= nk; \
        asm volatile("s_waitcnt vmcnt(0) lgkmcnt(0)" ::: "memory"); __builtin_amdgcn_s_barrier(); asm volatile("" ::: "memory"); \
        if (k + 1 < nk && !skK) ML_DMA(Kb + (size_t)(32 * jn) * CI, ML_K + (buf ^ 1) * ML_TILE); \
        if (k < nk && !skV) ML_DMA(Vb + (size_t)(32 * j) * CI, ML_V + buf * ML_TILE)
    for (int r = 0; r < 8; ++r) { const int xcd = F.bid & 7, cq = F.bid >> 3, c16 = cq & 15; if (F.G != 256) break;
        const int part = r & 1, qi = part ? 31 - c16 : c16, bh = xcd + 8 * ((cq >> 4) + 2 * (r >> 1)), bl = bh >> 2, h = bh & 3; const size_t t0 = (size_t)bl * SEQ + 64 * qi; const int nk = 2 * (qi + 1), jstart = part ? 2 * (c16 + 1) : 0;
        const bf16* Kb = K + (size_t)bl * SEQ * CI + h * 512; const bf16* Vb = V + (size_t)bl * SEQ * CI + h * 512;
        ML_DMA(Kb + (size_t)(32 * jstart) * CI, ML_K);
        float tb_e, tb_a[4];
        tb_e = GEM[(t0 + (tid & 63)) * 4 + h];
#pragma unroll
        for (int i4 = 0; i4 < 4; ++i4) tb_a[i4] = GA[((size_t)bl * SEQ + tid + 512 * i4) * 4 + h];
#define ML_TABLES() do { if (tid < 64) em_s[tid] = tb_e; _Pragma("unroll") for (int i4 = 0; i4 < 4; ++i4) { const int sidx = tid + 512 * i4; if (sidx < 64 * (qi + 1)) as_s[sidx] = tb_a[i4]; } } while (0)
        const int c8 = lane * 8, cc = h * 512 + c8;
#define ML_EPI_LOADS(N, ROW0) v4u zr[N], xr[N]; float gm[8], sk[8]; asm volatile("" ::: "memory"); __builtin_amdgcn_sched_barrier(0); if (!skE) { _Pragma("unroll") for (int k8 = 0; k8 < N; ++k8) { const size_t off = (t0 + (ROW0) + k8) * CI + cc; zr[k8] = *(const v4u*)(Z + off); xr[k8] = *(const v4u*)(XC + off); } \
        _Pragma("unroll") for (int q = 0; q < 8; ++q) { gm[q] = mh_g[cc + q]; sk[q] = skip[cc + q]; } }
#define ML_EPI_PASS(N, ROW0) if (!skE) { const LAS float* ytile = (const LAS float*)lds; _Pragma("unroll") for (int k8 = 0; k8 < N; ++k8) { const int row = (ROW0) + k8; const size_t off = (t0 + row) * CI + cc; \
              const f32x4 y0 = *(const LAS f32x4*)(ytile + row * 516 + c8), y1 = *(const LAS f32x4*)(ytile + row * 516 + c8 + 4); float zf[8], xf[8], o[8]; unpack8(zr[k8], zf); unpack8(xr[k8], xf); \
              _Pragma("unroll") for (int q = 0; q < 8; ++q) { const float yv = q < 4 ? y0[q & 3] : y1[q & 3]; o[q] = (yv * gm[q] + sk[q] * xf[q]) * (zf[q] * sigm(zf[q])); } \
              *(v4u*)(YC + off) = pack8(o); } }
        if (w < 4) {
            bf16x8 qf[2][16];
            { const bf16* qp = Q + (t0 + 32 * tp + fr) * CI + h * 512 + fq * 8;
#pragma unroll
              for (int ks = 0; ks < 16; ++ks) { qf[0][ks] = *(const bf16x8*)(qp + 32 * ks); qf[1][ks] = *(const bf16x8*)(qp + 16 * CI + 32 * ks); } }
            const float At0 = GAM[(t0 + 32 * tp + fr) * 4 + h], At1 = GAM[(t0 + 32 * tp + 16 + fr) * 4 + h];
            ML_TABLES();
            float denp0 = 0.f, denp1 = 0.f;
            for (int k = 0; k <= nk; ++k) { ML_STEP_HEAD();
                if (k < nk && !skS) {
                    f32x4 s0a = {0.f, 0.f, 0.f, 0.f}, s0b = {0.f, 0.f, 0.f, 0.f}, s1a = {0.f, 0.f, 0.f, 0.f}, s1b = {0.f, 0.f, 0.f, 0.f};
                    { const LAS unsigned char* kl = lds + ML_K + buf * ML_TILE + (16 * st + fr) * ML_PITCH + fq * 16; bf16x8 kc[4], kn[4];
#pragma unroll
                      for (int q = 0; q < 4; ++q) kc[q] = *(const LAS bf16x8*)(kl + 64 * q);
#pragma unroll
                      for (int g = 0; g < 4; ++g) {
                          if (g < 3) {
#pragma unroll
                              for (int q = 0; q < 4; ++q) kn[q] = *(const LAS bf16x8*)(kl + 64 * (4 * g + 4 + q)); }
                          __builtin_amdgcn_sched_barrier(0);
#pragma unroll
                          for (int q = 0; q < 4; q += 2) { const int ks = 4 * g + q;
                              s0a = __builtin_amdgcn_mfma_f32_16x16x32_bf16(kc[q], qf[0][ks], s0a, 0, 0, 0); s1a = __builtin_amdgcn_mfma_f32_16x16x32_bf16(kc[q], qf[1][ks], s1a, 0, 0, 0);
                              s0b = __builtin_amdgcn_mfma_f32_16x16x32_bf16(kc[q + 1], qf[0][ks + 1], s0b, 0, 0, 0); s1b = __builtin_amdgcn_mfma_f32_16x16x32_bf16(kc[q + 1], qf[1][ks + 1], s1b, 0, 0, 0); }
                          __builtin_amdgcn_sched_barrier(0);
                          if (g < 3) {
#pragma unroll
                              for (int q = 0; q < 4; ++q) kc[q] = kn[q]; } } }
                    s0a += s0b; s1a += s1b;
                    const f32x4 asv = *(const LAS f32x4*)(as_s + 32 * j + 16 * st + 4 * fq); const float as[4] = {asv[0], asv[1], asv[2], asv[3]};
                    float p0[4], p1[4]; const int sbase = 32 * j + 16 * st + 4 * fq, tbase = 64 * qi + 32 * tp + fr;
#pragma unroll
                    for (int i = 0; i < 4; ++i) { p0[i] = (sbase + i) <= tbase ? s0a[i] * __builtin_amdgcn_exp2f((as[i] - At0) * LOG2E) : 0.f; p1[i] = (sbase + i) <= tbase + 16 ? s1a[i] * __builtin_amdgcn_exp2f((as[i] - At1) * LOG2E) : 0.f; }
                    denp0 += (p0[0] + p0[1]) + (p0[2] + p0[3]); denp1 += (p1[0] + p1[1]) + (p1[2] + p1[3]);
                    { LAS unsigned char* pp = lds + ML_P + buf * ML_PT + (32 * tp + fr) * ML_PP + (16 * st + 4 * fq) * 2; v2u pw; pw.x = pk2(p0[0], p0[1]); pw.y = pk2(p0[2], p0[3]); *(LAS v2u*)pp = pw;
                      pw.x = pk2(p1[0], p1[1]); pw.y = pk2(p1[2], p1[3]); *(LAS v2u*)(pp + 16 * ML_PP) = pw; }
                } }
            ML_EPI_LOADS(12, 12 * w);
            { float d0 = denp0, d1 = denp1; d0 += __shfl_xor(d0, 16); d1 += __shfl_xor(d1, 16); d0 += __shfl_xor(d0, 32); d1 += __shfl_xor(d1, 32);
              if (fq == 0) { den2[st * 64 + 32 * tp + fr] = d0; den2[st * 64 + 32 * tp + 16 + fr] = d1; } }
            LDS_WAIT(); __builtin_amdgcn_s_barrier(); asm volatile("" ::: "memory");
            __builtin_amdgcn_s_barrier(); asm volatile("" ::: "memory");
            if (tid < 64) { float a1 = 0.f, a2 = 0.f;
#pragma unroll
                for (int ww = 0; ww < 4; ++ww) { a1 += stats[(ww * 64 + tid) * 2]; a2 += stats[(ww * 64 + tid) * 2 + 1]; }
                const float mean = a1 * (1.f / 512.f), var = fmaxf(a2 * (1.f / 512.f) - mean * mean, 0.f); mr[2 * tid] = mean; mr[2 * tid + 1] = rsqrtf(var + 1e-5f); }
            LDS_WAIT(); __builtin_amdgcn_s_barrier(); asm volatile("" ::: "memory");
            __builtin_amdgcn_s_barrier(); asm volatile("" ::: "memory");
            ML_EPI_PASS(12, 12 * w)
        } else {
            f32x4 O[4][8];
#pragma unroll
            for (int i = 0; i < 4; ++i)
#pragma unroll
                for (int e = 0; e < 8; ++e) O[i][e] = (f32x4){0.f, 0.f, 0.f, 0.f};
            ML_TABLES();
            for (int k = 0; k <= nk; ++k) { ML_STEP_HEAD();
                if (k >= 1 && !skP) { bf16x8 vf[8], pf[4]; const unsigned vb = (unsigned)(size_t)(lds + ML_V + (buf ^ 1) * ML_TILE) + vtr_lane; const LAS unsigned char* pl = lds + ML_P + (buf ^ 1) * ML_PT + fr * ML_PP + fq * 16;
#pragma unroll
                    for (int i = 0; i < 4; ++i) pf[i] = *(const LAS bf16x8*)(pl + 16 * i * ML_PP);
                    tr_read_v8(vb, vf);
#pragma unroll
                    for (int i = 0; i < 4; ++i)
#pragma unroll
                        for (int e = 0; e < 8; ++e) O[i][e] = __builtin_amdgcn_mfma_f32_16x16x32_bf16(pf[i], vf[e], O[i][e], 0, 0, 0); } }
            LDS_WAIT(); __builtin_amdgcn_s_barrier(); asm volatile("" ::: "memory");
            { const LAS float* den_q = den2 + 4 * fq; const LAS float* em_q = em_s + 4 * fq; LAS float* st_q = stats + (wv * 64 + 4 * fq) * 2;
#pragma unroll
              for (int i = 0; i < 4; ++i) {
#pragma unroll
                for (int jj = 0; jj < 4; ++jj) { const float dn = den_q[16 * i + jj] + den_q[64 + 16 * i + jj]; const float inv = 1.0f / fmaxf(fabsf(dn), em_q[16 * i + jj]); float a1 = 0.f, a2 = 0.f;
#pragma unroll
                    for (int e = 0; e < 8; ++e) { const float hv = O[i][e][jj] * inv; O[i][e][jj] = hv; a1 += hv; a2 += hv * hv; }
                    { a1 += DPP_MOVF(a1, 0xB1); a2 += DPP_MOVF(a2, 0xB1); a1 += DPP_MOVF(a1, 0x4E); a2 += DPP_MOVF(a2, 0x4E); a1 += DPP_MOVF(a1, 0x141); a2 += DPP_MOVF(a2, 0x141); a1 += DPP_MOVF(a1, 0x140); a2 += DPP_MOVF(a2, 0x140); }
                    if (fr == 0) { st_q[(16 * i + jj) * 2] = a1; st_q[(16 * i + jj) * 2 + 1] = a2; } } } }
            LDS_WAIT(); __builtin_amdgcn_s_barrier(); asm volatile("" ::: "memory");
            __builtin_amdgcn_s_barrier(); asm volatile("" ::: "memory");
            { LAS float* yt_q = (LAS float*)lds + 4 * fq * 516 + 128 * wv + fr; const LAS float* mr_q = mr + 8 * fq;
#pragma unroll
              for (int i = 0; i < 4; ++i)
#pragma unroll
                for (int jj = 0; jj < 4; ++jj) { const float mean = mr_q[(16 * i + jj) * 2], rstd = mr_q[(16 * i + jj) * 2 + 1];
#pragma unroll
                    for (int e = 0; e < 8; ++e) yt_q[(16 * i + jj) * 516 + 16 * e] = (O[i][e][jj] - mean) * rstd; } }
            LDS_WAIT(); __builtin_amdgcn_s_barrier(); asm volatile("" ::: "memory");
            ML_EPI_LOADS(4, 48 + 4 * wv);
            ML_EPI_PASS(4, 48 + 4 * wv)
        }
        VM_WAIT(); __syncthreads();
    }
#undef ML_DMA
#undef ML_STEP_HEAD
#undef ML_TABLES
#undef ML_EPI_LOADS
#undef ML_EPI_PASS
}
__device__ __forceinline__ void phase_mlstm(Frame& F, const Args& a) { phase_mlstm_t<0>(F, a); }
#ifdef ML_PROBE
__device__ __forceinline__ void phase_mlstm_probe(Frame& F, const Args& a) { phase_mlstm_t<ML_PROBE>(F, a); }
#endif

#ifdef ML_DMAPROBE
__device__ __forceinline__ void phase_mlstm_dmaprobe(Frame& F, const Args& a) {
    unsigned char* ws = F.ws; const bf16* K = (const bf16*)(ws + WS_K); const bf16* V = (const bf16*)(ws + WS_V);
    const int lane = F.lane, w = F.wave; LAS unsigned char* lds = F.lds;
#define MLP_DMA(gbase, tile_off) do { _Pragma("unroll") for (int r4 = 0; r4 < 4; ++r4) { const int rr = w + 8 * r4; \
        __builtin_amdgcn_global_load_lds((const unsigned*)((gbase) + (size_t)rr * CI + lane * 8), (LAS unsigned*)(lds + (tile_off) + rr * ML_PITCH), 16, 0, 0); } } while (0)
    for (int r = 0; r < 8; ++r) { const int xcd = F.bid & 7, cq = F.bid >> 3, c16 = cq & 15; if (F.G != 256) break;
        const int part = r & 1, qi = part ? 31 - c16 : c16, bh = xcd + 8 * ((cq >> 4) + 2 * (r >> 1)), bl = bh >> 2, h = bh & 3; const int nk = 2 * (qi + 1), jstart = part ? 2 * (c16 + 1) : 0;
        const bf16* Kb = K + (size_t)bl * SEQ * CI + h * 512; const bf16* Vb = V + (size_t)bl * SEQ * CI + h * 512;
        for (int k = 0; k <= nk; ++k) { const int buf = k & 1; int j = k + jstart; if (j >= nk) j -= nk; int jn = j + 1; if (jn >= nk) jn -= nk;
            asm volatile("s_waitcnt vmcnt(0) lgkmcnt(0)" ::: "memory"); __builtin_amdgcn_s_barrier(); asm volatile("" ::: "memory");
            if ((ML_DMAPROBE & 1) && k + 1 < nk) MLP_DMA(Kb + (size_t)(32 * jn) * CI, ML_K + (buf ^ 1) * ML_TILE);
            if ((ML_DMAPROBE & 2) && k < nk) MLP_DMA(Vb + (size_t)(32 * j) * CI, ML_V + buf * ML_TILE);
        }
        VM_WAIT(); __syncthreads();
    }
#undef MLP_DMA
}
#endif
#ifdef ML_DMAPROBE
#define ML_PROBE_CALL phase_mlstm_dmaprobe(F, args);
#elif defined(ML_PROBE)
#define ML_PROBE_CALL phase_mlstm_probe(F, args);
#else
#define ML_PROBE_CALL
#endif
#define GEMM_PHASE(EPI, Aptr, Bptr, M_, N_, K_, ...) do { pg8::Gemm g{(const pg8::bf16_t*)(Aptr), (const pg8::bf16_t*)(Bptr), (M_), (N_), (K_)}; pg8::StaticOrder So; So.init((M_), (N_), F.G, F.bid); \
        pg8::EPI Ep{__VA_ARGS__}; pg8::gemm_phase<pg8::EPI, pg8::StaticOrder, PG8_ALIGN, PG8_SP2>(F.lds, g, So, Ep); } while (0)
namespace pg8 { typedef EpiRes2<float> EpiResF; typedef EpiRes2<bf16_t> EpiResB; typedef EpiPle2<false> EpiPleB; typedef EpiPle2<true> EpiPleF; }
__global__ void __launch_bounds__(NWAVES * 64, 2) trunk_fwd(Args args) {
    extern __shared__ __attribute__((aligned(16))) unsigned char lds_raw[];
    Frame F; F.lds = (LAS unsigned char*)lds_raw; F.ws = args.ws; F.in = nullptr;
    F.tid = threadIdx.x; F.lane = F.tid & 63; F.wave = __builtin_amdgcn_readfirstlane(F.tid >> 6); F.G = gridDim.x; F.bid = blockIdx.x;
    volatile LAS unsigned* MISC = (volatile LAS unsigned*)(F.lds + MISC_OFF);
    if (F.tid < 64) MISC[F.tid] = 0u;
    __syncthreads();
    XcdBarrier bar; bar.bar = (unsigned*)(args.ws + WS_CTL) + CW_BAR; bar.x = 0; bar.st = nullptr;
    if (args.use_bar) bar = xcd_barrier_post((unsigned*)(args.ws + WS_CTL) + CW_BAR, MISC + 8);
    unsigned* xrank = (unsigned*)(args.ws + WS_CTL) + CW_XRANK; const unsigned my_xcc = xb_xcc_id();
    if (args.use_bar && F.tid == 0) MISC[12] = xb_add(&xrank[64 * my_xcc], 1u);
    const int lo = args.ph_lo, hi = args.ph_hi;
#ifndef ONLY_SITE
#define ONLY_SITE -1
#endif
#define EN(n) (ONLY_SITE < 0 || ONLY_SITE == (n))
#ifndef REP_MASK
#define REP_MASK 0u
#endif
#define NREP(n) (((REP_MASK >> (n)) & 1u) ? 2 : 1)
#define IN(k) (lo <= (k) && (k) < hi)
#define SEAM(k) do { if (IN(k) && IN((k) + 1)) xcd_barrier(bar); } while (0)
    unsigned char* ws = args.ws; float* out = args.out;
    float* RS = (float*)(ws + WS_RS);
#define RSN(i) (RS + (size_t)(i) * T * 16)
#define PH(site, k, ...) if (EN(site) && IN(k)) { for (int rep_ = 0; rep_ < NREP(site); ++rep_) { if (rep_) xcd_barrier(bar); __VA_ARGS__ } } SEAM(k);
    PH(0, 0, phase_prologue(F, args); phase_cast_sq(F, args.in[0], (bf16*)(ws + WS_XB2), RSN(0), T); phase_cvt_p(F, args.in[1], (bf16*)(ws + WS_PB));)
    if (args.use_bar && lo == 0 && hi > 1) {
        bool ok = F.G == 256; for (int x = 0; x < 16; ++x) { const unsigned cx = xb_ld(&xrank[64 * x]); ok = ok && (cx == (x < 8 ? 32u : 0u)); }
        const unsigned rk = MISC[12]; if (ok && rk < 32u && my_xcc < 8u) F.bid = (int)(rk * 8u + my_xcc); }
    PH(2, 1, GEMM_PHASE(EpiBf16SplitR, ws + WS_XB2, ws + WS_WIN, T, NU, D, (pg8::bf16_t*)(ws + WS_UA), UA_W, 4, (pg8::bf16_t*)(ws + WS_UB), UB_W, RSN(0));)
    PH(3, 2, phase_prepA(F, args);)
    PH(4, 3, GEMM_PHASE(EpiBf16Split, ws + WS_LIN, ws + WS_WLORA, T, 1536, 256 + args.pad, (pg8::bf16_t*)(ws + WS_LOUT), 1536, 1 << 20, nullptr, 0);)
    PH(5, 4, phase_indexer(F);)
    PH(6, 5, phase_dsa_attn(F, args);)
    PH(7, 6, phase_rwkv(F, args);)
    PH(8, 7, GEMM_PHASE(EpiResF, ws + WS_XB, ws + WS_WOUT, T, D, D, args.in[0], (pg8::bf16_t*)(ws + WS_XB2), D, RSN(1));)
#define FFN_PLE(L, pb, rs_a, rs_b, rs_c, PLE_EPI, ple_out) do { const size_t lw = (size_t)(L) * WS_LAYER_STRIDE; \
        PH(21, (pb), GEMM_PHASE(EpiSwigluR, ws + WS_XB2, ws + WS_WGU0 + lw, T, 2 * FF, D, (pg8::bf16_t*)(ws + WS_H), FF, RSN(rs_a));) \
        PH(22, (pb) + 1, GEMM_PHASE(EpiResB, ws + WS_H, ws + WS_WD0 + lw, T, D, FF, (const pg8::bf16_t*)(ws + WS_XB2), (pg8::bf16_t*)(ws + WS_XB), D, RSN(rs_b));) \
        PH(24, (pb) + 2, GEMM_PHASE(EpiBf16Split, ws + WS_PB, ws + WS_WPLE0 + lw, T, D, 256 + args.pad, (pg8::bf16_t*)(ws + WS_E), D, 1 << 20, nullptr, 0);) \
        PH(25, (pb) + 3, GEMM_PHASE(PLE_EPI, ws + WS_XB, ws + WS_WPG0 + lw, T, D, D, (const pg8::bf16_t*)(ws + WS_XB), (void*)(ple_out), (const pg8::bf16_t*)(ws + WS_E), D, RSN(rs_b), RSN(rs_c));) } while (0)
#define L1_HALF(hb, p1) do { bf16* xbh = (bf16*)(ws + WS_XB2) + (size_t)(hb) * TH * D; \
        PH(11, (p1), GEMM_PHASE(EpiBf16SplitR, xbh, ws + WS_WUP, TH, 2 * CI, D, (pg8::bf16_t*)(ws + WS_XM), CI, 8, (pg8::bf16_t*)(ws + WS_Z), CI, RSN(3) + (size_t)(hb) * TH * 16);) \
        PH(12, (p1) + 1, phase_l1prep(F, args, hb);) \
        PH(13, (p1) + 2, phase_gatescan(F); if ((hb) == 0) phase_cvt_p(F, args.in[1] + (size_t)T * 256, (bf16*)(ws + WS_PB));) \
        PH(14, (p1) + 3, ML_PROBE_CALL phase_mlstm(F, args);) \
        PH(15, (p1) + 4, GEMM_PHASE(EpiResB, ws + WS_XM, ws + WS_WDOWN, TH, D, CI, (const pg8::bf16_t*)xbh, (pg8::bf16_t*)xbh, D, RSN(4) + (size_t)(hb) * TH * 16);) } while (0)
    FFN_PLE(0, 8, 1, 2, 3, EpiPleB, ws + WS_XB2);
    L1_HALF(0, 12);
    L1_HALF(1, 17);
    FFN_PLE(1, 22, 4, 5, 5, EpiPleF, out);
#undef IN
#undef SEAM
}
constexpr int N_PHASES = 26;

#ifndef MK_ONE_LAUNCH
#define MK_ONE_LAUNCH 1
#endif
extern "C" void kernel_launch(void* const* d_in, const int* in_sizes, int n_in, void* d_out, int out_size, void* d_ws, size_t ws_size, hipStream_t stream) {
    static int grid = 0;
    if (grid == 0) {
        if (n_in != 37 || in_sizes[0] != T * D || out_size != T * D || ws_size < WS_END) { fprintf(stderr, "kernel_launch: unexpected shapes (n_in %d, in0 %d, out %d, ws %zu < %zu); nothing launched\n", n_in, n_in > 0 ? in_sizes[0] : -1, out_size, ws_size, (size_t)WS_END); grid = -1; return; }
        int dev = 0, cus = 0, per_cu = 0;
        if (hipGetDevice(&dev) != hipSuccess || hipDeviceGetAttribute(&cus, hipDeviceAttributeMultiprocessorCount, dev) != hipSuccess) { grid = -1; return; }
        if (hipFuncSetAttribute((const void*)trunk_fwd, hipFuncAttributeMaxDynamicSharedMemorySize, LDS_BYTES) != hipSuccess) { fprintf(stderr, "kernel_launch: hipFuncSetAttribute failed\n"); grid = -1; return; }
        if (hipOccupancyMaxActiveBlocksPerMultiprocessor(&per_cu, (const void*)trunk_fwd, NWAVES * 64, LDS_BYTES) != hipSuccess || per_cu < 1) { fprintf(stderr, "kernel_launch: occupancy query says %d\n", per_cu); }
        (void)hipGetLastError();
        grid = cus;
        if (grid != 256) { fprintf(stderr, "kernel_launch: built for 256 CUs, found %d; nothing launched\n", cus); grid = -1; return; }
    }
    if (grid < 0) return;
    if (hipMemsetAsync((char*)d_ws + WS_CTL, 0, CTL_ZERO_BYTES, stream) != hipSuccess) return;
    Args a{};
    for (int i = 0; i < 37; ++i) a.in[i] = (const float*)d_in[i];
    a.out = (float*)d_out; a.ws = (unsigned char*)d_ws; a.pad = 0;
#if MK_ONE_LAUNCH
    a.ph_lo = 0; a.ph_hi = N_PHASES; a.use_bar = 1;
    hipLaunchKernelGGL(trunk_fwd, dim3(grid), dim3(NWAVES * 64), LDS_BYTES, stream, a);
#else
    for (int p = 0; p < N_PHASES; ++p) { a.ph_lo = p; a.ph_hi = p + 1; a.use_bar = 0; hipLaunchKernelGGL(trunk_fwd, dim3(grid), dim3(NWAVES * 64), LDS_BYTES, stream, a); }
#endif
}
```

```cpp
#include <hip/hip_runtime.h>
#include <cstdio>
#include <cstdint>
namespace pg8 {
#define PG8_LAS __attribute__((address_space(3)))
typedef unsigned short bf16_t;
typedef short bf16x8 __attribute__((ext_vector_type(8)));
typedef float f32x4 __attribute__((ext_vector_type(4)));
typedef unsigned u32x4 __attribute__((ext_vector_type(4)));
constexpr int BM = 256, BK = 64, HALF = 128, HTB = HALF * BK * 2  , STAGE_BYTES = 8 * HTB, NXCD = 8, WGM = 8;

__host__ __device__ __forceinline__ int lds_byte(int r, int c) { const int st = (r >> 4) * 2 + (c >> 5), rr = r & 15, cc = c & 31, ob = rr * 64 + cc * 2; return st * 1024 + (ob ^ (((ob >> 9) & 1) << 5)); }
__host__ __device__ __forceinline__ void stage_rc(int b, int& R, int& C) { const int st = b / 1024, sb = b % 1024, swz = sb ^ (((sb >> 9) & 1) << 5); R = (st >> 1) * 16 + swz / 64; C = (st & 1) * 32 + (swz % 64) / 2; }
__host__ __device__ __forceinline__ int perm32(int rho) { const int n = rho >> 4, i = rho & 15; return 8 * (i >> 2) + 4 * n + (i & 3); }

struct Unit { int pm, pn; };
struct Gemm { const bf16_t* A; const bf16_t* Bt; int M, N, K; };

struct StaticOrder {
    int nM, nN, nwg, G, c;
    __host__ __device__ void init(int M, int N, int G_, int c_) { nM = M / BM; nN = N / BM; nwg = nM * nN; G = G_; c = c_; }
    __host__ __device__ bool next(int i, Unit& u) const {
        const long L = (long)i * G + c; if (L >= nwg) return false;
        int wgid = (int)L; { const int q = nwg / NXCD, r = nwg % NXCD, xcd = wgid % NXCD, off = wgid / NXCD; wgid = (xcd < r ? xcd * (q + 1) : r * (q + 1) + (xcd - r) * q) + off; }
        const int nig = WGM * nN, gid = wgid / nig, fm = gid * WGM, gsz = (nM - fm) < WGM ? (nM - fm) : WGM;
        u.pm = fm + ((wgid % nig) % gsz); u.pn = (wgid % nig) / gsz; return true;
    }
    __device__ __forceinline__ void a_ready(const Unit&) const {}
    __device__ __forceinline__ void done(const Unit&) const {}
};

__device__ __forceinline__ unsigned cvt_pk_bf16(float lo, float hi) { unsigned r; asm volatile("v_cvt_pk_bf16_f32 %0, %1, %2" : "=v"(r) : "v"(lo), "v"(hi)); return r; }
typedef float f32x2 __attribute__((ext_vector_type(2)));
__device__ __forceinline__ f32x2 gelu_pk(f32x2 v) {
    const f32x2 av = __builtin_elementwise_abs(v), d = av * 0.2316418882f + 1.0f;
    f32x2 t; t.x = __builtin_amdgcn_rcpf(d.x); t.y = __builtin_amdgcn_rcpf(d.y);
    f32x2 q = t * 0.5307027145f + (-0.7265760135f); q = q * t + 0.7107068705f; q = q * t + (-0.142248368f); q = q * t + 0.127414796f; q = q * t;
    const f32x2 s = (v * v) * (-0.72134752044f);
    f32x2 e; e.x = __builtin_amdgcn_exp2f(s.x); e.y = __builtin_amdgcn_exp2f(s.y);
    const f32x2 m = v * (q * e), r = v - m;
    f32x2 o; o.x = v.x < 0.f ? m.x : r.x; o.y = v.y < 0.f ? m.y : r.y; return o;
}

template <class Epi, class Sched, bool ALIGN_EPI = false, bool SP2 = false>
__device__ __forceinline__ void gemm_phase(PG8_LAS unsigned char* lds, const Gemm g, const Sched& S, const Epi& E) {
    const int tid = threadIdx.x, wid = __builtin_amdgcn_readfirstlane(tid >> 6), lane = tid & 63, wr = wid >> 2, wc = wid & 3, fr = lane & 15, fq = lane >> 4;
    const int K = g.K, nt = K / BK;
    unsigned voffA[2], voffB[2];
#pragma unroll
    for (int i = 0; i < 2; ++i) { int R, C; stage_rc(tid * 16 + i * 8192, R, C); const int Rb = Epi::PERM ? ((R & ~31) + perm32(R & 31)) : R;
        voffA[i] = (unsigned)(R * K + C) * 2u; voffB[i] = (unsigned)(Rb * K + C) * 2u; }
    const size_t kstep = (size_t)(BK * 2);
    const size_t hstep = (size_t)HALF * K * 2;
    const size_t tstep = 2 * hstep;
    const unsigned ldsw = (unsigned)wid * 1024u;
    const int aoff = lds_byte(wr * 64 + fr, fq * 8), boff = lds_byte(wc * 32 + fr, fq * 8);
#define PG8_SA(b, h) (((b) * 2 + (h)) * HTB)
#define PG8_SB(b, h) ((4 + (b) * 2 + (h)) * HTB)
#define PG8_STAGE(bufoff, gbase, voff) do { _Pragma("unroll") for (int _i = 0; _i < 2; ++_i) \
        __builtin_amdgcn_global_load_lds((const unsigned*)((const char*)(gbase) + (voff)[_i]), (PG8_LAS unsigned*)(lds + (bufoff) + ldsw + _i * 8192), 16, 0, 0); } while (0)
#define PG8_LDA(dst, b, h) do { _Pragma("unroll") for (int m = 0; m < 4; ++m) _Pragma("unroll") for (int k = 0; k < 2; ++k) dst[m][k] = *(const PG8_LAS bf16x8*)(lds + PG8_SA(b, h) + aoff + m * 2048 + k * 1024); } while (0)
#define PG8_LDB(dst, b, h) do { _Pragma("unroll") for (int n = 0; n < 2; ++n) _Pragma("unroll") for (int k = 0; k < 2; ++k) dst[n][k] = *(const PG8_LAS bf16x8*)(lds + PG8_SB(b, h) + boff + n * 2048 + k * 1024); } while (0)
#define PG8_MMA(ai, bj, At, Bt) do { __builtin_amdgcn_s_setprio(1); _Pragma("unroll") for (int m = 0; m < 4; ++m) _Pragma("unroll") for (int n = 0; n < 2; ++n) _Pragma("unroll") for (int k = 0; k < 2; ++k) \
        acc[ai][bj][m][n] = __builtin_amdgcn_mfma_f32_16x16x32_bf16(Bt[n][k], At[m][k], acc[ai][bj][m][n], 0, 0, 0); __builtin_amdgcn_s_setprio(0); } while (0)
#define PG8_WAIT_V(n) asm volatile("s_waitcnt vmcnt(" #n ")" ::: "memory")
#define PG8_WAIT_L(n) asm volatile("s_waitcnt lgkmcnt(" #n ")" ::: "memory")
#define PG8_BAR __builtin_amdgcn_s_barrier()
#define PG8_SCHED __builtin_amdgcn_sched_barrier(0)
    Unit cur, nxt; int ui = 0;
    if (!S.next(0, cur)) return;
    f32x4 acc[2][2][4][2];
#pragma unroll
    for (int a = 0; a < 2; ++a)
#pragma unroll
        for (int b = 0; b < 2; ++b)
#pragma unroll
            for (int m = 0; m < 4; ++m)
#pragma unroll
                for (int n = 0; n < 2; ++n) acc[a][b][m][n] = (f32x4){0.f, 0.f, 0.f, 0.f};
    bf16x8 At[4][2], B0[2][2], B1[2][2];
    const char* cA = (const char*)g.A + (size_t)cur.pm * tstep; const char* cB = (const char*)g.Bt + (size_t)cur.pn * tstep;
    S.a_ready(cur);
    if constexpr (SP2) {
        PG8_STAGE(PG8_SB(0, 0), cB, voffB); PG8_STAGE(PG8_SB(0, 1), cB + hstep, voffB); PG8_STAGE(PG8_SA(0, 0), cA, voffA); PG8_STAGE(PG8_SA(0, 1), cA + hstep, voffA);
        if (wr == 1) PG8_BAR;
        PG8_WAIT_V(2); PG8_BAR;
        PG8_STAGE(PG8_SB(1, 0), cB + kstep, voffB); PG8_STAGE(PG8_SA(1, 0), cA + kstep, voffA); PG8_STAGE(PG8_SB(1, 1), cB + hstep + kstep, voffB);
        PG8_WAIT_V(6); PG8_BAR;
    } else {
        PG8_STAGE(PG8_SB(0, 0), cB, voffB); PG8_STAGE(PG8_SA(0, 0), cA, voffA); PG8_STAGE(PG8_SB(0, 1), cB + hstep, voffB); PG8_STAGE(PG8_SA(0, 1), cA + hstep, voffA);
        if (wr == 1) PG8_BAR;
        PG8_WAIT_V(4); PG8_BAR;
        PG8_STAGE(PG8_SB(1, 0), cB + kstep, voffB); PG8_STAGE(PG8_SA(1, 0), cA + kstep, voffA); PG8_STAGE(PG8_SB(1, 1), cB + hstep + kstep, voffB);
        PG8_WAIT_V(6); PG8_BAR;
    }
    for (;;) {
        const bool has_next = S.next(ui + 1, nxt);
        const char* nA = has_next ? (const char*)g.A + (size_t)nxt.pm * tstep : cA; const char* nB = has_next ? (const char*)g.Bt + (size_t)nxt.pn * tstep : cB;
        for (int t = 0; t < nt; t += 2) {
            const bool last = (t == nt - 2);
            const char* a1 = cA + (size_t)(t + 1) * kstep;
            const char* a2 = last ? nA : cA + (size_t)(t + 2) * kstep; const char* b2 = last ? nB : cB + (size_t)(t + 2) * kstep;
            const char* a3 = a2 + kstep; const char* b3 = b2 + kstep;
            if (last && has_next) S.a_ready(nxt);
            if constexpr (SP2) {
            PG8_LDB(B0, 0, 0); PG8_LDB(B1, 0, 1); PG8_SCHED; PG8_LDA(At, 0, 0); PG8_STAGE(PG8_SA(1, 1), a1 + hstep, voffA);
            PG8_WAIT_V(8); PG8_WAIT_L(0); PG8_BAR; PG8_MMA(0, 0, At, B0); PG8_MMA(0, 1, At, B1); PG8_BAR; PG8_SCHED;
            PG8_LDA(At, 0, 1); PG8_STAGE(PG8_SB(0, 0), b2, voffB); PG8_STAGE(PG8_SB(0, 1), b2 + hstep, voffB); PG8_STAGE(PG8_SA(0, 0), a2, voffA);
            PG8_WAIT_V(8); PG8_WAIT_L(0); PG8_BAR; PG8_MMA(1, 0, At, B0); PG8_MMA(1, 1, At, B1); PG8_BAR; PG8_SCHED;
            PG8_LDB(B0, 1, 0); PG8_LDB(B1, 1, 1); PG8_SCHED; PG8_LDA(At, 1, 0); PG8_STAGE(PG8_SA(0, 1), a2 + hstep, voffA);
            PG8_WAIT_V(8); PG8_WAIT_L(0); PG8_BAR; PG8_MMA(0, 0, At, B0); PG8_MMA(0, 1, At, B1); PG8_BAR; PG8_SCHED;
            PG8_LDA(At, 1, 1); PG8_STAGE(PG8_SB(1, 0), b3, voffB); PG8_STAGE(PG8_SB(1, 1), b3 + hstep, voffB); PG8_STAGE(PG8_SA(1, 0), a3, voffA);
            PG8_WAIT_V(8); PG8_WAIT_L(0); PG8_BAR; PG8_MMA(1, 0, At, B0); PG8_MMA(1, 1, At, B1); PG8_BAR; PG8_SCHED;
            } else {
            PG8_LDB(B0, 0, 0); PG8_SCHED; PG8_LDA(At, 0, 0); PG8_STAGE(PG8_SA(1, 1), a1 + hstep, voffA);
            PG8_WAIT_L(8); PG8_BAR; PG8_WAIT_L(0); PG8_MMA(0, 0, At, B0); PG8_BAR; PG8_SCHED;
            PG8_LDB(B1, 0, 1); PG8_STAGE(PG8_SB(0, 0), b2, voffB);
            PG8_BAR; PG8_WAIT_L(0); PG8_MMA(0, 1, At, B1); PG8_BAR;
            PG8_LDA(At, 0, 1); PG8_STAGE(PG8_SA(0, 0), a2, voffA);
            PG8_BAR; PG8_WAIT_L(0); PG8_MMA(1, 0, At, B0); PG8_BAR; PG8_SCHED;
            PG8_STAGE(PG8_SB(0, 1), b2 + hstep, voffB);
            PG8_WAIT_V(6); PG8_BAR; PG8_MMA(1, 1, At, B1); PG8_BAR;
            PG8_LDB(B0, 1, 0); PG8_SCHED; PG8_LDA(At, 1, 0); PG8_STAGE(PG8_SA(0, 1), a2 + hstep, voffA);
            PG8_WAIT_L(8); PG8_BAR; PG8_WAIT_L(0); PG8_MMA(0, 0, At, B0); PG8_BAR; PG8_SCHED;
            PG8_LDB(B1, 1, 1); PG8_STAGE(PG8_SB(1, 0), b3, voffB);
            PG8_BAR; PG8_WAIT_L(0); PG8_MMA(0, 1, At, B1); PG8_BAR;
            PG8_LDA(At, 1, 1); PG8_STAGE(PG8_SA(1, 0), a3, voffA);
            PG8_BAR; PG8_WAIT_L(0); PG8_MMA(1, 0, At, B0); PG8_BAR; PG8_SCHED;
            PG8_STAGE(PG8_SB(1, 1), b3 + hstep, voffB);
            PG8_WAIT_V(6); PG8_BAR; PG8_MMA(1, 1, At, B1); PG8_BAR;
            }
        }
        if constexpr (ALIGN_EPI) { if (wr == 0) PG8_BAR; }
        if constexpr (!Epi::AFTER_DRAIN) { E(acc, cur, wr, wc, fr, fq); S.done(cur); }
        if (!has_next) break;
#pragma unroll
        for (int a = 0; a < 2; ++a)
#pragma unroll
            for (int b = 0; b < 2; ++b)
#pragma unroll
                for (int m = 0; m < 4; ++m)
#pragma unroll
                    for (int n = 0; n < 2; ++n) acc[a][b][m][n] = (f32x4){0.f, 0.f, 0.f, 0.f};
        cur = nxt; cA = nA; cB = nB; ++ui;
        if constexpr (ALIGN_EPI) { if (wr == 1) PG8_BAR; }
    }
    PG8_WAIT_V(0);
    if constexpr (!ALIGN_EPI) { if (wr == 0) PG8_BAR; }
    PG8_BAR;
    if constexpr (Epi::AFTER_DRAIN) { E.fused(acc, cur, wr, wc, fr, fq, lds, wid, lane); S.done(cur); }
#undef PG8_SA
#undef PG8_SB
#undef PG8_STAGE
#undef PG8_LDA
#undef PG8_LDB
#undef PG8_MMA
#undef PG8_WAIT_V
#undef PG8_WAIT_L
#undef PG8_BAR
#undef PG8_SCHED
}
}
namespace pg8 {
__device__ __forceinline__ float sigmoidf_(float x) { return __builtin_amdgcn_rcpf(1.0f + __builtin_amdgcn_exp2f(-1.4426950408889634f * x)); }
struct EpiBf16Split {
    static constexpr bool PERM = true, AFTER_DRAIN = false;
    bf16_t* O0; int ld0; int nt0; bf16_t* O1; int ld1;
    __device__ __forceinline__ void operator()(const f32x4 (&acc)[2][2][4][2], const Unit& u, int wr, int wc, int fr, int fq) const {
        const bool first = u.pn < nt0; bf16_t* base = first ? O0 : O1; const int ld = first ? ld0 : ld1; const int colt = (first ? u.pn : u.pn - nt0) * BM;
        const int row0 = u.pm * BM + wr * 64 + fr, col0 = colt + wc * 32 + 8 * fq;
#pragma unroll
        for (int ai = 0; ai < 2; ++ai)
#pragma unroll
            for (int m = 0; m < 4; ++m) { bf16_t* rowp = base + (size_t)(row0 + ai * HALF + m * 16) * ld + col0;
#pragma unroll
                for (int bj = 0; bj < 2; ++bj) { const f32x4 v0 = acc[ai][bj][m][0], v1 = acc[ai][bj][m][1];
                    u32x4 w; w.x = cvt_pk_bf16(v0[0], v0[1]); w.y = cvt_pk_bf16(v0[2], v0[3]); w.z = cvt_pk_bf16(v1[0], v1[1]); w.w = cvt_pk_bf16(v1[2], v1[3]);
                    *(u32x4*)(rowp + bj * HALF) = w; } }
    }
};
struct EpiResF32 {
    static constexpr bool PERM = false, AFTER_DRAIN = false;
    const float* base; float* out; int ldc;
    __device__ __forceinline__ void operator()(const f32x4 (&acc)[2][2][4][2], const Unit& u, int wr, int wc, int fr, int fq) const {
        const int row0 = u.pm * BM + wr * 64 + fr, col0 = u.pn * BM + wc * 32 + 4 * fq;
#pragma unroll
        for (int ai = 0; ai < 2; ++ai)
#pragma unroll
            for (int m = 0; m < 4; ++m) { const size_t off = (size_t)(row0 + ai * HALF + m * 16) * ldc + col0;
#pragma unroll
                for (int bj = 0; bj < 2; ++bj)
#pragma unroll
                    for (int n = 0; n < 2; ++n) { const f32x4 b = *(const f32x4*)(base + off + bj * HALF + n * 16); *(f32x4*)(out + off + bj * HALF + n * 16) = b + acc[ai][bj][m][n]; } }
    }
};
struct EpiSwiglu {
    static constexpr bool PERM = false, AFTER_DRAIN = false;
    bf16_t* H; int ldh;
    __device__ __forceinline__ void operator()(const f32x4 (&acc)[2][2][4][2], const Unit& u, int wr, int wc, int fr, int fq) const {
        const int row0 = u.pm * BM + wr * 64 + fr, hc0 = u.pn * (BM / 2) + wc * 16 + 4 * fq;
#pragma unroll
        for (int ai = 0; ai < 2; ++ai)
#pragma unroll
            for (int m = 0; m < 4; ++m) { bf16_t* rowp = H + (size_t)(row0 + ai * HALF + m * 16) * ldh + hc0;
#pragma unroll
                for (int bj = 0; bj < 2; ++bj) { const f32x4 g = acc[ai][bj][m][0], up = acc[ai][bj][m][1]; float h[4];
#pragma unroll
                    for (int i = 0; i < 4; ++i) h[i] = g[i] * sigmoidf_(g[i]) * up[i];
                    typedef unsigned u32x2 __attribute__((ext_vector_type(2)));
                    u32x2 w; w.x = cvt_pk_bf16(h[0], h[1]); w.y = cvt_pk_bf16(h[2], h[3]);
                    *(u32x2*)(rowp + bj * (HALF / 2)) = w; } }
    }
};
struct EpiPle {
    static constexpr bool PERM = false, AFTER_DRAIN = false;
    const float* base; float* out; const bf16_t* E; int ldc;
    __device__ __forceinline__ void operator()(const f32x4 (&acc)[2][2][4][2], const Unit& u, int wr, int wc, int fr, int fq) const {
        const int row0 = u.pm * BM + wr * 64 + fr, col0 = u.pn * BM + wc * 32 + 4 * fq;
        typedef unsigned u32x2 __attribute__((ext_vector_type(2)));
#pragma unroll
        for (int ai = 0; ai < 2; ++ai)
#pragma unroll
            for (int m = 0; m < 4; ++m) { const size_t off = (size_t)(row0 + ai * HALF + m * 16) * ldc + col0;
#pragma unroll
                for (int bj = 0; bj < 2; ++bj)
#pragma unroll
                    for (int n = 0; n < 2; ++n) { const size_t o = off + bj * HALF + n * 16; const f32x4 b = *(const f32x4*)(base + o); const u32x2 e = *(const u32x2*)(E + o); const f32x4 a = acc[ai][bj][m][n];
                        f32x4 r; r[0] = b[0] + __uint_as_float(e.x << 16) * sigmoidf_(a[0]); r[1] = b[1] + __uint_as_float(e.x & 0xffff0000u) * sigmoidf_(a[1]);
                        r[2] = b[2] + __uint_as_float(e.y << 16) * sigmoidf_(a[2]); r[3] = b[3] + __uint_as_float(e.y & 0xffff0000u) * sigmoidf_(a[3]);
                        *(f32x4*)(out + o) = r; } }
    }
};
__device__ __forceinline__ float rms_r(const float* rsq, int row) { const f32x4* p = (const f32x4*)(rsq + (size_t)row * 16); const f32x4 a = p[0], b = p[1], c = p[2], d = p[3];
    const float s = (((a[0] + a[1]) + (a[2] + a[3])) + ((b[0] + b[1]) + (b[2] + b[3]))) + (((c[0] + c[1]) + (c[2] + c[3])) + ((d[0] + d[1]) + (d[2] + d[3]))); return rsqrtf(s * (1.0f / 1024.0f) + 1e-6f); }
__device__ __forceinline__ void norm_out(const f32x4 (&x)[2][2], bf16_t* xb, size_t off, float* rsq_out, int row, int fq, int slot) {
    typedef unsigned u32x2 __attribute__((ext_vector_type(2))); float s = 0.f;
#pragma unroll
    for (int bj = 0; bj < 2; ++bj)
#pragma unroll
        for (int n = 0; n < 2; ++n) { const f32x4 v = x[bj][n]; s += (v[0] * v[0] + v[1] * v[1]) + (v[2] * v[2] + v[3] * v[3]); u32x2 w; w.x = cvt_pk_bf16(v[0], v[1]); w.y = cvt_pk_bf16(v[2], v[3]); *(u32x2*)(xb + off + bj * HALF + n * 16) = w; }
    s += __shfl_xor(s, 16); s += __shfl_xor(s, 32);
    if (fq == 0) rsq_out[(size_t)row * 16 + slot] = s;
}
struct EpiBf16SplitR {
    static constexpr bool PERM = true, AFTER_DRAIN = false;
    bf16_t* O0; int ld0; int nt0; bf16_t* O1; int ld1; const float* rsq;
    __device__ __forceinline__ void operator()(const f32x4 (&acc)[2][2][4][2], const Unit& u, int wr, int wc, int fr, int fq) const {
        const bool first = u.pn < nt0; bf16_t* base = first ? O0 : O1; const int ld = first ? ld0 : ld1; const int colt = (first ? u.pn : u.pn - nt0) * BM;
        const int row0 = u.pm * BM + wr * 64 + fr, col0 = colt + wc * 32 + 8 * fq;
#pragma unroll
        for (int ai = 0; ai < 2; ++ai)
#pragma unroll
            for (int m = 0; m < 4; ++m) { const int row = row0 + ai * HALF + m * 16; const float r = rms_r(rsq, row); bf16_t* rowp = base + (size_t)row * ld + col0;
#pragma unroll
                for (int bj = 0; bj < 2; ++bj) { const f32x4 v0 = acc[ai][bj][m][0] * r, v1 = acc[ai][bj][m][1] * r;
                    u32x4 w; w.x = cvt_pk_bf16(v0[0], v0[1]); w.y = cvt_pk_bf16(v0[2], v0[3]); w.z = cvt_pk_bf16(v1[0], v1[1]); w.w = cvt_pk_bf16(v1[2], v1[3]);
                    *(u32x4*)(rowp + bj * HALF) = w; } }
    }
};
struct EpiSwigluR {
    static constexpr bool PERM = false, AFTER_DRAIN = false;
    bf16_t* H; int ldh; const float* rsq;
    __device__ __forceinline__ void operator()(const f32x4 (&acc)[2][2][4][2], const Unit& u, int wr, int wc, int fr, int fq) const {
        const int row0 = u.pm * BM + wr * 64 + fr, hc0 = u.pn * (BM / 2) + wc * 16 + 4 * fq;
#pragma unroll
        for (int ai = 0; ai < 2; ++ai)
#pragma unroll
            for (int m = 0; m < 4; ++m) { const int row = row0 + ai * HALF + m * 16; const float r = rms_r(rsq, row); bf16_t* rowp = H + (size_t)row * ldh + hc0;
#pragma unroll
                for (int bj = 0; bj < 2; ++bj) { const f32x4 g = acc[ai][bj][m][0] * r, up = acc[ai][bj][m][1] * r; float h[4];
#pragma unroll
                    for (int i = 0; i < 4; ++i) h[i] = g[i] * sigmoidf_(g[i]) * up[i];
                    typedef unsigned u32x2 __attribute__((ext_vector_type(2)));
                    u32x2 w; w.x = cvt_pk_bf16(h[0], h[1]); w.y = cvt_pk_bf16(h[2], h[3]);
                    *(u32x2*)(rowp + bj * (HALF / 2)) = w; } }
    }
};
struct EpiResN {
    static constexpr bool PERM = false, AFTER_DRAIN = false;
    const float* base; float* out; int ldc; bf16_t* XBo; float* rsq_out;
    __device__ __forceinline__ void operator()(const f32x4 (&acc)[2][2][4][2], const Unit& u, int wr, int wc, int fr, int fq) const {
        const int row0 = u.pm * BM + wr * 64 + fr, col0 = u.pn * BM + wc * 32 + 4 * fq;
#pragma unroll
        for (int ai = 0; ai < 2; ++ai)
#pragma unroll
            for (int m = 0; m < 4; ++m) { const int row = row0 + ai * HALF + m * 16; const size_t off = (size_t)row * ldc + col0; f32x4 x[2][2];
#pragma unroll
                for (int bj = 0; bj < 2; ++bj)
#pragma unroll
                    for (int n = 0; n < 2; ++n) { const f32x4 b = *(const f32x4*)(base + off + bj * HALF + n * 16); x[bj][n] = b + acc[ai][bj][m][n]; *(f32x4*)(out + off + bj * HALF + n * 16) = x[bj][n]; }
                if (XBo) norm_out(x, XBo, off, rsq_out, row, fq, u.pn * 4 + wc); }
    }
};
struct EpiPleN {
    static constexpr bool PERM = false, AFTER_DRAIN = false;
    const float* base; float* out; const bf16_t* E; int ldc; const float* rsq_in; bf16_t* XBo; float* rsq_out;
    __device__ __forceinline__ void operator()(const f32x4 (&acc)[2][2][4][2], const Unit& u, int wr, int wc, int fr, int fq) const {
        const int row0 = u.pm * BM + wr * 64 + fr, col0 = u.pn * BM + wc * 32 + 4 * fq;
        typedef unsigned u32x2 __attribute__((ext_vector_type(2)));
#pragma unroll
        for (int ai = 0; ai < 2; ++ai)
#pragma unroll
            for (int m = 0; m < 4; ++m) { const int row = row0 + ai * HALF + m * 16; const size_t off = (size_t)row * ldc + col0; const float r = rms_r(rsq_in, row); f32x4 x[2][2];
#pragma unroll
                for (int bj = 0; bj < 2; ++bj)
#pragma unroll
                    for (int n = 0; n < 2; ++n) { const size_t o = off + bj * HALF + n * 16; const f32x4 b = *(const f32x4*)(base + o); const u32x2 e = *(const u32x2*)(E + o); const f32x4 a = acc[ai][bj][m][n] * r;
                        f32x4 v; v[0] = b[0] + __uint_as_float(e.x << 16) * sigmoidf_(a[0]); v[1] = b[1] + __uint_as_float(e.x & 0xffff0000u) * sigmoidf_(a[1]);
                        v[2] = b[2] + __uint_as_float(e.y << 16) * sigmoidf_(a[2]); v[3] = b[3] + __uint_as_float(e.y & 0xffff0000u) * sigmoidf_(a[3]);
                        x[bj][n] = v; *(f32x4*)(out + o) = v; }
                if (XBo) norm_out(x, XBo, off, rsq_out, row, fq, u.pn * 4 + wc); }
    }
};
__device__ __forceinline__ f32x4 ld_base4(const float* p) { return *(const f32x4*)p; }
__device__ __forceinline__ f32x4 ld_base4(const bf16_t* p) { typedef unsigned u32x2 __attribute__((ext_vector_type(2))); const u32x2 e = *(const u32x2*)p; return (f32x4){__uint_as_float(e.x << 16), __uint_as_float(e.x & 0xffff0000u), __uint_as_float(e.y << 16), __uint_as_float(e.y & 0xffff0000u)}; }
template <class BaseT> struct EpiRes2 {
    static constexpr bool PERM = false, AFTER_DRAIN = false;
    const BaseT* base; bf16_t* out; int ldc; float* rsq_out;
    __device__ __forceinline__ void operator()(const f32x4 (&acc)[2][2][4][2], const Unit& u, int wr, int wc, int fr, int fq) const {
        const int row0 = u.pm * BM + wr * 64 + fr, col0 = u.pn * BM + wc * 32 + 4 * fq;
#pragma unroll
        for (int ai = 0; ai < 2; ++ai)
#pragma unroll
            for (int m = 0; m < 4; ++m) { const int row = row0 + ai * HALF + m * 16; const size_t off = (size_t)row * ldc + col0; f32x4 x[2][2];
#pragma unroll
                for (int bj = 0; bj < 2; ++bj)
#pragma unroll
                    for (int n = 0; n < 2; ++n) x[bj][n] = ld_base4(base + off + bj * HALF + n * 16) + acc[ai][bj][m][n];
                norm_out(x, out, off, rsq_out, row, fq, u.pn * 4 + wc); }
    }
};
template <bool OUT_F32> struct EpiPle2 {
    static constexpr bool PERM = false, AFTER_DRAIN = false;
    const bf16_t* base; void* out; const bf16_t* E; int ldc; const float* rsq_in; float* rsq_out;
    __device__ __forceinline__ void operator()(const f32x4 (&acc)[2][2][4][2], const Unit& u, int wr, int wc, int fr, int fq) const {
        const int row0 = u.pm * BM + wr * 64 + fr, col0 = u.pn * BM + wc * 32 + 4 * fq;
#pragma unroll
        for (int ai = 0; ai < 2; ++ai)
#pragma unroll
            for (int m = 0; m < 4; ++m) { const int row = row0 + ai * HALF + m * 16; const size_t off = (size_t)row * ldc + col0; const float r = rms_r(rsq_in, row); f32x4 x[2][2];
#pragma unroll
                for (int bj = 0; bj < 2; ++bj)
#pragma unroll
                    for (int n = 0; n < 2; ++n) { const size_t o = off + bj * HALF + n * 16; const f32x4 b = ld_base4(base + o), e = ld_base4(E + o), a = acc[ai][bj][m][n] * r; f32x4 v;
#pragma unroll
                        for (int i = 0; i < 4; ++i) v[i] = b[i] + e[i] * sigmoidf_(a[i]);
                        x[bj][n] = v; if (OUT_F32) *(f32x4*)((float*)out + o) = v; }
                if (!OUT_F32) norm_out(x, (bf16_t*)out, off, rsq_out, row, fq, u.pn * 4 + wc); }
    }
};
}
#ifndef PG8_SP2
#define PG8_SP2 true
#endif
#ifndef PG8_ALIGN
#define PG8_ALIGN true
#endif
constexpr int NB = 32, SEQ = 2048, T = NB * SEQ, D = 1024;
constexpr int NU = 2816, UA_W = 1024, UB_W = 1792;
constexpr int FF = 2816, CI = 2048, TH = T / 2;
constexpr int NWAVES = 8;
constexpr float NORM_EPS = 1e-6f, LOG2E = 1.4426950408889634f;
constexpr int UA_K = 512, UA_V = 576, UA_IQ = 640, UA_IK = 896, UA_IW = 960;
constexpr size_t MiB = 1u << 20, QMiB = 1u << 18;
constexpr size_t WS_CTL = 0, CTL_ZERO_BYTES = 1 * MiB;
constexpr size_t WS_WIN = 4 * QMiB, WS_WLORA = 26 * QMiB, WS_WOUT = 29 * QMiB;
constexpr size_t WS_WGU0 = 37 * QMiB, WS_WD0 = 81 * QMiB, WS_WPLE0 = 103 * QMiB, WS_WPG0 = 105 * QMiB, WS_LAYER_STRIDE = 76 * QMiB;
constexpr size_t WS_WUP = 189 * QMiB, WS_WDOWN = 221 * QMiB, WS_W12 = 237 * QMiB;
static_assert(WS_WPG0 + 8 * QMiB == WS_WGU0 + WS_LAYER_STRIDE && WS_WPG0 + WS_LAYER_STRIDE + 8 * QMiB == WS_WUP && WS_W12 + QMiB <= 60 * MiB, "weight map");
constexpr size_t ACT = 60 * MiB;
constexpr size_t WS_XB = ACT, WS_UA = ACT + 128 * MiB, WS_UB = ACT + 256 * MiB, WS_LIN = ACT + 480 * MiB, WS_LOUT = ACT + 512 * MiB;
constexpr size_t WS_QN = ACT + 704 * MiB, WS_KN = ACT + 768 * MiB, WS_VT = ACT + 776 * MiB, WS_MASK = ACT + 784 * MiB;
constexpr size_t WS_XB2 = ACT + 768 * MiB;
constexpr size_t WS_H = ACT + 128 * MiB, WS_E = ACT + 480 * MiB, WS_PB = ACT + 896 * MiB;
constexpr size_t WS_XM = ACT, WS_Z = ACT + 128 * MiB, WS_XC = ACT + 256 * MiB, WS_Q = ACT + 384 * MiB, WS_K = ACT + 512 * MiB, WS_V = ACT + 640 * MiB;
constexpr size_t WS_RS = ACT + 928 * MiB, RS_ONE = (size_t)T * 16 * 4;
constexpr size_t WS_GI = ACT + 952 * MiB, WS_GA = WS_GI + 1 * MiB, WS_GAM = WS_GI + 2 * MiB, WS_GEM = WS_GI + 3 * MiB;
constexpr size_t WS_END = ACT + 956 * MiB;
static_assert(WS_END <= 1024 * MiB, "workspace");
constexpr int CW_TMO = 0, CW_BAR = 4096, CW_XRANK = 8192;
constexpr int LDS_BYTES = 155648;
constexpr int MISC_OFF = LDS_BYTES - 256;
#define GAS __attribute__((address_space(1)))
#define LAS __attribute__((address_space(3)))
typedef unsigned short bf16;
typedef unsigned v4u __attribute__((ext_vector_type(4)));
typedef unsigned v2u __attribute__((ext_vector_type(2)));
typedef float f32x4 __attribute__((ext_vector_type(4)));
typedef float f32x2 __attribute__((ext_vector_type(2)));
typedef float f32x8 __attribute__((ext_vector_type(8)));
typedef short bf16x8 __attribute__((ext_vector_type(8)));
typedef short s16x4 __attribute__((ext_vector_type(4)));
typedef GAS unsigned gu32;
#define RLX_AGENT __ATOMIC_RELAXED, __HIP_MEMORY_SCOPE_AGENT
#define LDS_WAIT() asm volatile("s_waitcnt lgkmcnt(0)" ::: "memory")
#define VM_WAIT() asm volatile("s_waitcnt vmcnt(0)" ::: "memory")
__device__ __forceinline__ unsigned f2bf(float f) { unsigned u = __builtin_bit_cast(unsigned, f); return (u + 0x7fffu + ((u >> 16) & 1u)) >> 16; }

#define XB_TMO      128
#define XB_XCNT(j)  (256  + 64 * (j))
#define XB_XSUB(j)  (1280 + 64 * (j))
#define XB_XGEN(j)  (2304 + 64 * (j))
#define XB_TOP      3328
#define XB_TOPGEN   3392
#define XCD_BAR_WORDS 3456
#define XB_SPIN_CAP (1u << 18)

__device__ __forceinline__ unsigned xb_ld(unsigned* p)              { return __hip_atomic_load(p, __ATOMIC_RELAXED, __HIP_MEMORY_SCOPE_AGENT); }
__device__ __forceinline__ unsigned xb_add(unsigned* p, unsigned v) { return __hip_atomic_fetch_add(p, v, __ATOMIC_RELAXED, __HIP_MEMORY_SCOPE_AGENT); }
__device__ __forceinline__ unsigned xb_xcc_id() { return (unsigned)__builtin_amdgcn_s_getreg((3 << 11) | 20) & 0xFu; }
#define XB_SPIN(cond, bar) do { unsigned _sp = 0; while (cond) { __builtin_amdgcn_s_sleep(1); \
    if ((++_sp & 255u) == 0u) { if (xb_ld(&(bar)[XB_TMO])) break; if (_sp > XB_SPIN_CAP) { atomicAdd(&(bar)[XB_TMO], 1u); break; } } } } while (0)

struct XcdBarrier {
    unsigned* bar; unsigned x;
    volatile LAS unsigned* st;
};

__device__ __forceinline__ XcdBarrier xcd_barrier_post(unsigned* bar, volatile LAS unsigned* st) {
    XcdBarrier b; b.bar = bar; b.x = xb_xcc_id(); b.st = st;
    if (threadIdx.x == 0) (void)xb_add(&bar[XB_XCNT(b.x)], 1u);
    return b;
}
__device__ __forceinline__ void xcd_barrier_complete(unsigned* bar, unsigned x, unsigned& nloc, unsigned& nx) {
    const unsigned G = gridDim.x * gridDim.y * gridDim.z;
    unsigned sum, cnt, mine, sp = 0u;
    for (;;) {
        sum = 0u; cnt = 0u; mine = 0u;
#pragma unroll
        for (unsigned j = 0; j < 16; ++j) { const unsigned c = xb_ld(&bar[XB_XCNT(j)]); sum += c; cnt += (c > 0u) ? 1u : 0u; mine = (j == x) ? c : mine; }
        if (sum == G) break;
        __builtin_amdgcn_s_sleep(1);
        if ((++sp & 255u) == 0u) { if (xb_ld(&bar[XB_TMO])) break; if (sp > XB_SPIN_CAP) { atomicAdd(&bar[XB_TMO], 1u); break; } }
    }
    nloc = mine > 0u ? mine : 1u; nx = cnt > 0u ? cnt : 1u;
}

__device__ __forceinline__ void xcd_barrier(const XcdBarrier& b) {
    asm volatile("s_waitcnt vmcnt(0)" ::: "memory");
    __syncthreads();
    if (threadIdx.x == 0) {
        unsigned* bar = b.bar;
        __builtin_amdgcn_s_waitcnt(0);
        unsigned nloc = b.st[0], nx = b.st[1];
        if (nloc == 0u) { xcd_barrier_complete(bar, b.x, nloc, nx); b.st[0] = nloc; b.st[1] = nx; }
        const unsigned old = xb_add(&bar[XB_XSUB(b.x)], 1u);
        const unsigned gen = old / nloc;
        if (old + 1u == (gen + 1u) * nloc) {
            __builtin_amdgcn_fence(__ATOMIC_RELEASE, "agent");
            asm volatile("s_waitcnt vmcnt(0)" ::: "memory");
            const unsigned og = xb_add(&bar[XB_TOP], 1u);
            const unsigned tg = og / nx;
            if (og + 1u == (tg + 1u) * nx) xb_add(&bar[XB_TOPGEN], 1u);
            else XB_SPIN(xb_ld(&bar[XB_TOPGEN]) == tg, bar);
            __builtin_amdgcn_fence(__ATOMIC_ACQUIRE, "agent");
            xb_add(&bar[XB_XGEN(b.x)], 1u);
            asm volatile("s_waitcnt vmcnt(0)" ::: "memory");
        } else {
            XB_SPIN(xb_ld(&bar[XB_XGEN(b.x)]) == gen, bar);
            __builtin_amdgcn_fence(__ATOMIC_ACQUIRE, "agent");
            asm volatile("s_waitcnt vmcnt(0)" ::: "memory");
        }
    }
    __syncthreads();
}

struct Frame {
    LAS unsigned char* lds;
    unsigned char* ws;
    const float* const* in;
    int tid, lane, wave, G, bid;
};
struct Args { const float* in[37]; float* out; unsigned char* ws; int ph_lo, ph_hi, use_bar, pad; };

__device__ __forceinline__ float dpp_f(float v, int ctrl_qp1) { return v; }
#define DPP_MOVF(v, ctrl) __builtin_bit_cast(float, __builtin_amdgcn_mov_dpp(__builtin_bit_cast(int, (v)), (ctrl), 0xf, 0xf, true))
__device__ __forceinline__ float wave_sum(float v) {
    v += DPP_MOVF(v, 0xB1);
    v += DPP_MOVF(v, 0x4E);
    v += DPP_MOVF(v, 0x141);
    v += DPP_MOVF(v, 0x140);
    v += __shfl_xor(v, 16); v += __shfl_xor(v, 32);
    return v;
}
__device__ __forceinline__ float wave_max(float v) {
#pragma unroll
    for (int o = 1; o < 64; o <<= 1) v = fmaxf(v, __shfl_xor(v, o));
    return v;
}
__device__ __forceinline__ float bflo(unsigned u) { return __uint_as_float(u << 16); }
__device__ __forceinline__ float bfhi(unsigned u) { return __uint_as_float(u & 0xffff0000u); }
__device__ __forceinline__ float bf1(bf16 h) { return __uint_as_float(((unsigned)h) << 16); }
__device__ __forceinline__ unsigned pk2(float lo, float hi) { return pg8::cvt_pk_bf16(lo, hi); }
__device__ __forceinline__ float sigm(float x) { return __builtin_amdgcn_rcpf(1.0f + __builtin_amdgcn_exp2f(-LOG2E * x)); }
__device__ __forceinline__ float softplusf_(float x) { return fmaxf(x, 0.f) + log1pf(__expf(-fabsf(x))); }
__device__ __forceinline__ void unpack8(const v4u& r, float (&f)[8]) { f[0] = bflo(r.x); f[1] = bfhi(r.x); f[2] = bflo(r.y); f[3] = bfhi(r.y); f[4] = bflo(r.z); f[5] = bfhi(r.z); f[6] = bflo(r.w); f[7] = bfhi(r.w); }
__device__ __forceinline__ v4u pack8(const float (&f)[8]) { v4u o; o.x = pk2(f[0], f[1]); o.y = pk2(f[2], f[3]); o.z = pk2(f[4], f[5]); o.w = pk2(f[6], f[7]); return o; }

template <class Fn> __device__ __forceinline__ void wprep(bf16* dst, int N, int K, Fn f, int gt, int NT) {
    const int lane = gt & 63, gwv = gt >> 6, NW = NT >> 6, ntn = N >> 3, tiles = ntn * (K >> 6);
    for (int tl = gwv; tl < tiles; tl += NW) { const int n = (tl % ntn) * 8 + (lane & 7), k0 = (tl / ntn) * 64 + (lane >> 3) * 8; float v[8];
#pragma unroll
        for (int j = 0; j < 8; ++j) v[j] = f(k0 + j, n);
        *(v4u*)(dst + (size_t)n * K + k0) = pack8(v); }
}
__device__ __forceinline__ void phase_prologue(Frame& F, const Args& a) {
    const int gt = F.bid * 512 + F.tid, NT = F.G * 512; unsigned char* ws = F.ws;
    { const float* W = a.in[5]; const float* gn0 = a.in[2];
      wprep((bf16*)(ws + WS_WIN), NU, D, [=](int k, int n) { const int c = n < 964 ? n : (n < 1024 ? -1 : n - 60); return c < 0 ? 0.f : W[(size_t)k * 2756 + c] * gn0[k]; }, gt, NT); }
    { const float* w2 = a.in[8]; const float* a2 = a.in[10]; const float* g2 = a.in[11];
      wprep((bf16*)(ws + WS_WLORA), 1536, 256, [=](int k, int n) { if (n < 512) return k < 64 ? w2[k * 512 + n] : 0.f; if (n < 1024) return (k >= 64 && k < 128) ? a2[(k - 64) * 512 + n - 512] : 0.f; return k >= 128 ? g2[(k - 128) * 512 + n - 1024] : 0.f; }, gt, NT); }
    { const float* W = a.in[17]; wprep((bf16*)(ws + WS_WOUT), D, D, [=](int k, int n) { return W[(size_t)k * D + n]; }, gt, NT); }
    for (int L = 0; L < 2; ++L) {
        const float* wg = a.in[31] + (size_t)L * D * FF; const float* wu = a.in[32] + (size_t)L * D * FF; const float* wd = a.in[33] + (size_t)L * FF * D;
        const float* wp = a.in[34] + (size_t)L * 256 * D; const float* wpg = a.in[36] + (size_t)L * D * D; const float* gnf = a.in[30] + L * D; const float* gnp = a.in[35] + L * D;
        wprep((bf16*)(ws + WS_WGU0 + L * WS_LAYER_STRIDE), 2 * FF, D, [=](int k, int n) { const int hid = 16 * (n >> 5) + (n & 15); return ((n & 31) >= 16 ? wu : wg)[(size_t)k * FF + hid] * gnf[k]; }, gt, NT);
        wprep((bf16*)(ws + WS_WD0 + L * WS_LAYER_STRIDE), D, FF, [=](int k, int n) { return wd[(size_t)k * D + n]; }, gt, NT);
        wprep((bf16*)(ws + WS_WPLE0 + L * WS_LAYER_STRIDE), D, 256, [=](int k, int n) { return wp[(size_t)k * D + n]; }, gt, NT);
        wprep((bf16*)(ws + WS_WPG0 + L * WS_LAYER_STRIDE), D, D, [=](int k, int n) { return wpg[(size_t)k * D + n] * gnp[k]; }, gt, NT);
    }
    { const float* W = a.in[18]; const float* gn1 = a.in[2] + D; wprep((bf16*)(ws + WS_WUP), 2 * CI, D, [=](int k, int n) { return W[(size_t)k * (2 * CI) + n] * gn1[k]; }, gt, NT); }
    { const float* W = a.in[29]; wprep((bf16*)(ws + WS_WDOWN), D, CI, [=](int k, int n) { return W[(size_t)k * D + n]; }, gt, NT); }
    { const float* wq = a.in[21]; const float* wk = a.in[22]; const float* wv = a.in[23]; const float* wif = a.in[24]; float* W12 = (float*)(ws + WS_W12);
      for (int it = gt; it < 4096 * 8; it += NT) { const int o = it & 7, c = (it >> 3) & 2047, part = it >> 14, g = c >> 2, i = c & 3; float s = 0.f;
          if (part == 0) { for (int j = 0; j < 4; ++j) s += wq[(g * 4 + i) * 4 + j] * wif[(size_t)(4 * g + j) * 8 + o] + wk[(g * 4 + i) * 4 + j] * wif[(size_t)(2048 + 4 * g + j) * 8 + o]; }
          else { for (int j = 0; j < 4; ++j) s += wv[(g * 4 + i) * 4 + j] * wif[(size_t)(4096 + 4 * g + j) * 8 + o]; }
          W12[it] = s; } }
}
__device__ __forceinline__ void phase_norm(Frame& F, const float* src, const float* gain, bf16* dst, int nrows) {
    const int gw = F.bid * NWAVES + F.wave, NGW = F.G * NWAVES, lane = F.lane;
    f32x4 g[4];
#pragma unroll
    for (int j = 0; j < 4; ++j) g[j] = *((const f32x4*)gain + lane + 64 * j);
    for (int m = gw; m < nrows; m += NGW) {
        const f32x4* xr = (const f32x4*)(src + (size_t)m * D) + lane; f32x4 v[4]; float s = 0.f;
#pragma unroll
        for (int j = 0; j < 4; ++j) { v[j] = xr[64 * j]; s += (v[j].x * v[j].x + v[j].y * v[j].y) + (v[j].z * v[j].z + v[j].w * v[j].w); }
        const float r = rsqrtf(wave_sum(s) * (1.f / D) + NORM_EPS);
        v2u* o = (v2u*)(dst + (size_t)m * D) + lane;
#pragma unroll
        for (int j = 0; j < 4; ++j) { v2u w; w.x = pk2(v[j].x * r * g[j].x, v[j].y * r * g[j].y); w.y = pk2(v[j].z * r * g[j].z, v[j].w * r * g[j].w); o[64 * j] = w; }
    }
}
__device__ __forceinline__ void phase_cast_sq(Frame& F, const float* src, bf16* dst, float* rsq, int nrows) {
    const int gw = F.bid * NWAVES + F.wave, NGW = F.G * NWAVES, lane = F.lane;
    for (int m = gw; m < nrows; m += 2 * NGW) { const int m2 = m + NGW; const bool has2 = m2 < nrows;
        const f32x4* xr = (const f32x4*)(src + (size_t)m * D) + lane; const f32x4* xr2 = (const f32x4*)(src + (size_t)(has2 ? m2 : m) * D) + lane; f32x4 v[4], u[4]; float s = 0.f, s2 = 0.f;
#pragma unroll
        for (int j = 0; j < 4; ++j) { v[j] = xr[64 * j]; u[j] = xr2[64 * j]; }
#pragma unroll
        for (int j = 0; j < 4; ++j) { s += (v[j].x * v[j].x + v[j].y * v[j].y) + (v[j].z * v[j].z + v[j].w * v[j].w); s2 += (u[j].x * u[j].x + u[j].y * u[j].y) + (u[j].z * u[j].z + u[j].w * u[j].w); }
        s = wave_sum(s); s2 = wave_sum(s2);
        if (lane < 16) rsq[(size_t)m * 16 + lane] = lane == 0 ? s : 0.f;
        v2u* o = (v2u*)(dst + (size_t)m * D) + lane;
#pragma unroll
        for (int j = 0; j < 4; ++j) { v2u w; w.x = pk2(v[j].x, v[j].y); w.y = pk2(v[j].z, v[j].w); o[64 * j] = w; }
        if (has2) { if (lane < 16) rsq[(size_t)m2 * 16 + lane] = lane == 0 ? s2 : 0.f;
            v2u* o2 = (v2u*)(dst + (size_t)m2 * D) + lane;
#pragma unroll
            for (int j = 0; j < 4; ++j) { v2u w; w.x = pk2(u[j].x, u[j].y); w.y = pk2(u[j].z, u[j].w); o2[64 * j] = w; } }
    }
}
__device__ __forceinline__ void phase_cvt_p(Frame& F, const float* p, bf16* pb) {
    const size_t gt = (size_t)F.bid * 512 + F.tid, NT = (size_t)F.G * 512, n8 = (size_t)T * 256 / 8;
    for (size_t i0 = gt; i0 < n8; i0 += 4 * NT) { f32x4 a[4], b[4];
#pragma unroll
        for (int q4 = 0; q4 < 4; ++q4) { const size_t i = i0 + q4 * NT; if (i < n8) { a[q4] = *((const f32x4*)p + 2 * i); b[q4] = *((const f32x4*)p + 2 * i + 1); } }
#pragma unroll
        for (int q4 = 0; q4 < 4; ++q4) { const size_t i = i0 + q4 * NT; if (i < n8) { v4u o; o.x = pk2(a[q4].x, a[q4].y); o.y = pk2(a[q4].z, a[q4].w); o.z = pk2(b[q4].x, b[q4].y); o.w = pk2(b[q4].z, b[q4].w); *((v4u*)pb + i) = o; } } }
}
constexpr float QSCALE = 0.125f * LOG2E;
__device__ __forceinline__ void phase_prepA(Frame& F, const Args& a) {
    unsigned char* ws = F.ws; const bf16* UA = (const bf16*)(ws + WS_UA); const bf16* UB = (const bf16*)(ws + WS_UB);
    bf16* LIN = (bf16*)(ws + WS_LIN); bf16* QN = (bf16*)(ws + WS_QN); bf16* KN = (bf16*)(ws + WS_KN); bf16* VT = (bf16*)(ws + WS_VT);
    const float* mu = a.in[6]; const float* gq = a.in[3]; const float* gk = a.in[4];
    { const int gt = F.bid * 512 + F.tid, NT = F.G * 512; const int c8 = (gt & 31) << 3; float muv[8];
#pragma unroll
      for (int j = 0; j < 8; ++j) muv[j] = mu[1536 + c8 + j];
      for (int it0 = gt; it0 < T * 32; it0 += 4 * NT) { v4u ru[4], rp[4];
#pragma unroll
          for (int q4 = 0; q4 < 4; ++q4) { const int it = it0 + q4 * NT; if (it < T * 32) { const int t = it >> 5; ru[q4] = *(const v4u*)(UB + (size_t)t * UB_W + 1536 + c8); rp[q4] = *(const v4u*)(UB + (size_t)((t & (SEQ - 1)) ? t - 1 : t) * UB_W + 1536 + c8); } }
#pragma unroll
          for (int q4 = 0; q4 < 4; ++q4) { const int it = it0 + q4 * NT; if (it < T * 32) { const int t = it >> 5; float u[8], p[8], o[8]; unpack8(ru[q4], u); unpack8(rp[q4], p); const float pm = (t & (SEQ - 1)) ? 1.f : 0.f;
#pragma unroll
              for (int j = 0; j < 8; ++j) { const float s = u[j] + muv[j] * (p[j] * pm - u[j]); o[j] = c8 < 64 ? (1.0f - 2.0f * __builtin_amdgcn_rcpf(1.0f + __builtin_amdgcn_exp2f(2.0f * LOG2E * s))) : (c8 < 128 ? s : sigm(s));     }
              *(v4u*)(LIN + (size_t)t * 256 + c8) = pack8(o); } } } }
    { const int gw = F.bid * NWAVES + F.wave, NGW = F.G * NWAVES, lane = F.lane; float gqv[8], gkv[8];
#pragma unroll
      for (int j = 0; j < 8; ++j) { gqv[j] = gq[((lane & 7) << 3) + j] * QSCALE; gkv[j] = gk[((lane & 7) << 3) + j]; }
      for (int t0 = gw; t0 < T; t0 += 4 * NGW) { v4u rq[4], rk[4];
#pragma unroll
          for (int q4 = 0; q4 < 4; ++q4) { const int t = t0 + q4 * NGW; if (t < T) { rq[q4] = *(const v4u*)(UA + (size_t)t * UA_W + 8 * lane); rk[q4] = *(const v4u*)(UA + (size_t)t * UA_W + UA_K + 8 * (lane & 7)); } }
#pragma unroll
          for (int q4 = 0; q4 < 4; ++q4) { const int t = t0 + q4 * NGW; if (t < T) {
              float q[8], k[8]; unpack8(rq[q4], q); unpack8(rk[q4], k);
              float sq = 0.f, sk = 0.f;
#pragma unroll
              for (int j = 0; j < 8; ++j) { sq += q[j] * q[j]; sk += k[j] * k[j]; }
              sq += __shfl_xor(sq, 1); sq += __shfl_xor(sq, 2); sq += __shfl_xor(sq, 4); sk += __shfl_xor(sk, 1); sk += __shfl_xor(sk, 2); sk += __shfl_xor(sk, 4);
              const float rq_ = rsqrtf(sq * (1.f / 64.f) + NORM_EPS), rk_ = rsqrtf(sk * (1.f / 64.f) + NORM_EPS);
#pragma unroll
              for (int j = 0; j < 8; ++j) { q[j] *= rq_ * gqv[j]; k[j] *= rk_ * gkv[j]; }
              *(v4u*)(QN + (size_t)t * 512 + 8 * lane) = pack8(q);
              if (lane < 8) *(v4u*)(KN + (size_t)t * 64 + 8 * lane) = pack8(k); } } } }
    { const int gt = F.bid * 512 + F.tid, NT = F.G * 512;
      for (int it = gt; it < T * 8; it += NT) { const int t = it >> 3, c8 = (it & 7) << 3; *(v4u*)(VT + (size_t)t * 64 + c8) = *(const v4u*)(UA + (size_t)t * UA_W + UA_V + c8); } }
}
constexpr int IDX_STRIDE = 2052, KSEL = 256;
__device__ __forceinline__ void topk_select(const LAS float* row, int limit, unsigned* maskrow, int lane) {
    unsigned long long mybits = 0ull; const int nj = limit >> 6;
    if (limit <= KSEL) { mybits = lane < nj ? ~0ull : 0ull; }
    else {
        unsigned key[32];
#pragma unroll
        for (int j = 0; j < 32; ++j) key[j] = 0u;
#pragma unroll
        for (int g8 = 0; g8 < 4; ++g8) if (8 * g8 < nj) {
#pragma unroll
            for (int jj = 0; jj < 8; ++jj) { const int j = 8 * g8 + jj; unsigned u = __float_as_uint(row[64 * j + lane]); if (u == 0x80000000u) u = 0u; const unsigned k = (u & 0x80000000u) ? ~u : (u | 0x80000000u); key[j] = (j < nj) ? k : 0u; } }
        unsigned prefix = 0u; bool exact = false;
        for (int bit = 31; bit >= 0; --bit) { const unsigned cand = prefix | (1u << bit); int c0 = 0, c1 = 0;
#pragma unroll
            for (int g8 = 0; g8 < 4; ++g8) if (8 * g8 < nj) {
#pragma unroll
                for (int jj = 0; jj < 8; jj += 2) { c0 += __builtin_popcountll(__ballot(key[8 * g8 + jj] >= cand)); c1 += __builtin_popcountll(__ballot(key[8 * g8 + jj + 1] >= cand)); } }
            const int cnt = c0 + c1;
            if (cnt >= KSEL) { prefix = cand; if (cnt == KSEL) { exact = true; break; } } }
        int need = 0;
        if (!exact) { int cgt = 0;
#pragma unroll
            for (int j = 0; j < 32; ++j) cgt += __builtin_popcountll(__ballot(key[j] > prefix));
            need = KSEL - cgt; }
        int running = 0; const unsigned long long below = (1ull << lane) - 1ull;
#pragma unroll
        for (int g8 = 0; g8 < 4; ++g8) if (8 * g8 < nj)
#pragma unroll
        for (int jj = 0; jj < 8; ++jj) { const int j = 8 * g8 + jj;
            const bool gt = exact ? (key[j] >= prefix) : (key[j] > prefix); const bool tie = (!exact) && key[j] == prefix;
            const unsigned long long tb = __ballot(tie); const int rank = running + __builtin_popcountll(tb & below); running += __builtin_popcountll(tb);
            const unsigned long long sb = __ballot(gt || (tie && rank < need)); if (lane == j) mybits = sb; }
    }
    if (lane < 32) { v2u w; w.x = (unsigned)mybits; w.y = (unsigned)(mybits >> 32); *(v2u*)(maskrow + 2 * lane) = w; }
}
__device__ __forceinline__ void phase_indexer(Frame& F) {
    unsigned char* ws = F.ws; const bf16* UA = (const bf16*)(ws + WS_UA); unsigned* MASK = (unsigned*)(ws + WS_MASK);
    LAS float* sc = (LAS float*)F.lds; const int lane = F.lane, w = F.wave, fr = lane & 15, fq = lane >> 4;
    for (int r = 0;; ++r) { const int u = r * F.G + ((r & 1) ? (F.G - 1 - F.bid) : F.bid); if (u >= NB * 128) break;
        const int c = 31 - (u >> 7), rest = u & 127, b = rest >> 2, g4 = rest & 3, limit = 64 * (c + 1), tq0 = b * SEQ + c * 64 + g4 * 16;
        const bf16* UAb = UA + (size_t)b * SEQ * UA_W;
        bf16x8 qf[4][2]; float iwv[4];
        { const bf16* qp = UA + (size_t)(tq0 + fr) * UA_W;
#pragma unroll
          for (int hh = 0; hh < 4; ++hh) { qf[hh][0] = *(const bf16x8*)(qp + UA_IQ + hh * 64 + fq * 8); qf[hh][1] = *(const bf16x8*)(qp + UA_IQ + hh * 64 + 32 + fq * 8); iwv[hh] = bf1(qp[UA_IW + hh]) * (1.f / 16.f); } }
#ifndef IDX_SCORE_REP
#define IDX_SCORE_REP 1
#endif
#ifndef IDX_SEL_REP
#define IDX_SEL_REP 1
#endif
        for (int rp_ = 0; rp_ < IDX_SCORE_REP; ++rp_)
        for (int kt = w; kt < (limit >> 4); kt += NWAVES) {
            const bf16* kp = UAb + (size_t)(kt * 16 + fr) * UA_W + UA_IK + fq * 8; const bf16x8 a0 = *(const bf16x8*)kp, a1 = *(const bf16x8*)(kp + 32);
            f32x4 s = {0.f, 0.f, 0.f, 0.f};
#pragma unroll
            for (int hh = 0; hh < 4; ++hh) { f32x4 d = {0.f, 0.f, 0.f, 0.f}; d = __builtin_amdgcn_mfma_f32_16x16x32_bf16(a0, qf[hh][0], d, 0, 0, 0); d = __builtin_amdgcn_mfma_f32_16x16x32_bf16(a1, qf[hh][1], d, 0, 0, 0);
#pragma unroll
                for (int j = 0; j < 4; ++j) s[j] += iwv[hh] * fmaxf(d[j], 0.f); }
            *(LAS f32x4*)(sc + fr * IDX_STRIDE + kt * 16 + fq * 4) = s; }
        __syncthreads();
#pragma unroll 1
        for (int qq = 0; qq < 2 * IDX_SEL_REP; ++qq) { const int q = 2 * w + (qq & 1); topk_select(sc + q * IDX_STRIDE, limit, MASK + (size_t)(tq0 + q) * 64, lane); }
        __syncthreads(); }
}
constexpr int DA_K = 0, DA_V = 8192, DA_M = 16384, DA_STAGE = 16384 + 512;
__device__ __forceinline__ bf16x8 mk8(v2u lo, v2u hi) { v4u t; t.x = lo.x; t.y = lo.y; t.z = hi.x; t.w = hi.y; return __builtin_bit_cast(bf16x8, t); }
__device__ __forceinline__ void tr_read_v4d(unsigned a, bf16x8 (&vf)[4]) { s16x4 l0, h0, l1, h1, l2, h2, l3, h3;
    asm volatile("ds_read_b64_tr_b16 %0, %8\n\tds_read_b64_tr_b16 %1, %8 offset:512\n\tds_read_b64_tr_b16 %2, %8 offset:32\n\tds_read_b64_tr_b16 %3, %8 offset:544\n\t"
                 "ds_read_b64_tr_b16 %4, %8 offset:64\n\tds_read_b64_tr_b16 %5, %8 offset:576\n\tds_read_b64_tr_b16 %6, %8 offset:96\n\tds_read_b64_tr_b16 %7, %8 offset:608\n\ts_waitcnt lgkmcnt(0)"
                 : "=&v"(l0), "=&v"(h0), "=&v"(l1), "=&v"(h1), "=&v"(l2), "=&v"(h2), "=&v"(l3), "=&v"(h3) : "v"(a) : "memory");
    vf[0] = (bf16x8){l0[0], l0[1], l0[2], l0[3], h0[0], h0[1], h0[2], h0[3]}; vf[1] = (bf16x8){l1[0], l1[1], l1[2], l1[3], h1[0], h1[1], h1[2], h1[3]};
    vf[2] = (bf16x8){l2[0], l2[1], l2[2], l2[3], h2[0], h2[1], h2[2], h2[3]}; vf[3] = (bf16x8){l3[0], l3[1], l3[2], l3[3], h3[0], h3[1], h3[2], h3[3]}; }
__device__ __forceinline__ void phase_dsa_attn(Frame& F, const Args& a) {
    unsigned char* ws = F.ws; const bf16* QN = (const bf16*)(ws + WS_QN); const bf16* KN = (const bf16*)(ws + WS_KN); const bf16* VN = (const bf16*)(ws + WS_VT);
    const unsigned* MASK = (const unsigned*)(ws + WS_MASK); bf16* MIX = (bf16*)(ws + WS_XB);
    const int lane = F.lane, w = F.wave, fr = lane & 15, fq = lane >> 4; LAS unsigned char* lds = F.lds;
    const float mb = 8.f * LOG2E * wave_max(fabsf(a.in[3][lane])) * wave_max(fabsf(a.in[4][lane]));
    const unsigned vtr_lane = (unsigned)((8 * fq + ((lane & 15) >> 2)) * 128 + 4 * (lane & 3) * 2);
    for (int r = 0;; ++r) { const int u = r * F.G + ((r & 1) ? (F.G - 1 - F.bid) : F.bid); if (u >= NB * 32) break;
        const int c = 31 - (u >> 5), b = u & 31, nst = c + 1, t0 = b * SEQ + 64 * c;
        const bf16* Kb = KN + (size_t)b * SEQ * 64; const bf16* Vb = VN + (size_t)b * SEQ * 64; const unsigned* Mb = MASK + (size_t)t0 * 64;
#define DA_DMA(st_, buf_) do { const int so_ = (buf_) * DA_STAGE; \
            __builtin_amdgcn_global_load_lds((const unsigned*)(Kb + (size_t)(64 * (st_) + 8 * w) * 64 + lane * 8), (LAS unsigned*)(lds + so_ + DA_K + w * 1024), 16, 0, 0); \
            __builtin_amdgcn_global_load_lds((const unsigned*)(Vb + (size_t)(64 * (st_) + 8 * w) * 64 + lane * 8), (LAS unsigned*)(lds + so_ + DA_V + w * 1024), 16, 0, 0); \
            if (w < 2) __builtin_amdgcn_global_load_lds(Mb + (size_t)lane * 64 + 2 * (st_) + w, (LAS unsigned*)(lds + so_ + DA_M + w * 256), 4, 0, 0); } while (0)
        DA_DMA(0, 0);
        bf16x8 qf[4][2];
#pragma unroll
        for (int i = 0; i < 4; ++i) { const bf16* qp = QN + (size_t)(t0 + 16 * i + fr) * 512 + w * 64 + fq * 8; qf[i][0] = *(const bf16x8*)qp; qf[i][1] = *(const bf16x8*)(qp + 32); }
        f32x4 O[4][4]; float l[4];
#pragma unroll
        for (int i = 0; i < 4; ++i) { l[i] = 0.f;
#pragma unroll
            for (int dt = 0; dt < 4; ++dt) O[i][dt] = (f32x4){0.f, 0.f, 0.f, 0.f}; }
        for (int st = 0; st < nst; ++st) { const int buf = st & 1; const LAS unsigned char* sb = lds + buf * DA_STAGE;
            asm volatile("s_waitcnt vmcnt(0)" ::: "memory");
            __builtin_amdgcn_s_barrier(); asm volatile("" ::: "memory");
            if (st + 1 < nst) DA_DMA(st + 1, buf ^ 1);
#pragma unroll
            for (int sub = 0; sub < 2; ++sub) {
                bf16x8 kf[2][2], vf[4]; unsigned mw[4];
#pragma unroll
                for (int s2 = 0; s2 < 2; ++s2) { const LAS unsigned char* kp = sb + DA_K + (32 * sub + 8 * (fr >> 2) + 4 * s2 + (fr & 3)) * 128 + fq * 16;   kf[s2][0] = *(const LAS bf16x8*)kp; kf[s2][1] = *(const LAS bf16x8*)(kp + 64); }
#pragma unroll
                for (int i = 0; i < 4; ++i) mw[i] = *(const LAS unsigned*)(sb + DA_M + sub * 256 + (16 * i + fr) * 4);
                tr_read_v4d((unsigned)(size_t)(sb + DA_V + sub * 4096) + vtr_lane, vf);
#pragma unroll
                for (int i = 0; i < 4; ++i) {
                    f32x4 s0 = {0.f, 0.f, 0.f, 0.f}, s1 = {0.f, 0.f, 0.f, 0.f};
                    s0 = __builtin_amdgcn_mfma_f32_16x16x32_bf16(kf[0][0], qf[i][0], s0, 0, 0, 0); s0 = __builtin_amdgcn_mfma_f32_16x16x32_bf16(kf[0][1], qf[i][1], s0, 0, 0, 0);
                    s1 = __builtin_amdgcn_mfma_f32_16x16x32_bf16(kf[1][0], qf[i][0], s1, 0, 0, 0); s1 = __builtin_amdgcn_mfma_f32_16x16x32_bf16(kf[1][1], qf[i][1], s1, 0, 0, 0);
                    const unsigned b0 = mw[i] >> (8 * fq), b1 = mw[i] >> (8 * fq + 4); float p[8];
#pragma unroll
                    for (int j = 0; j < 4; ++j) { p[j] = ((b0 >> j) & 1u) ? __builtin_amdgcn_exp2f(s0[j] - mb) : 0.f; p[4 + j] = ((b1 >> j) & 1u) ? __builtin_amdgcn_exp2f(s1[j] - mb) : 0.f; }
                    l[i] += ((p[0] + p[1]) + (p[2] + p[3])) + ((p[4] + p[5]) + (p[6] + p[7]));
                    const bf16x8 pa = __builtin_bit_cast(bf16x8, pack8(p));
#pragma unroll
                    for (int dt = 0; dt < 4; ++dt) O[i][dt] = __builtin_amdgcn_mfma_f32_16x16x32_bf16(pa, vf[dt], O[i][dt], 0, 0, 0);
                } } }
#undef DA_DMA
#pragma unroll
        for (int i = 0; i < 4; ++i) { float li = l[i]; li += __shfl_xor(li, 16); li += __shfl_xor(li, 32);
#pragma unroll
            for (int j = 0; j < 4; ++j) { const float inv = 1.0f / __shfl(li, 4 * fq + j); bf16* op = MIX + (size_t)(t0 + 16 * i + 4 * fq + j) * D + w * 64 + fr;
#pragma unroll
                for (int dt = 0; dt < 4; ++dt) op[16 * dt] = (bf16)f2bf(O[i][dt][j] * inv); } }
        VM_WAIT(); __syncthreads();
    }
}
__device__ __forceinline__ float rw_decay(float x) { const float sp = fmaxf(-x, 0.f) + 0.6931471805599453f * __builtin_amdgcn_logf(1.0f + __builtin_amdgcn_exp2f(-LOG2E * fabsf(x)));
    return __builtin_amdgcn_exp2f(-LOG2E * __builtin_amdgcn_exp2f(-LOG2E * (sp + 0.5f))); }
#define MF32(a_, b_, c_) __builtin_amdgcn_mfma_f32_16x16x4f32((a_), (b_), (c_), 0, 0, 0)
constexpr int RT = 68, RG = 20, RGM = 16 * RG;
constexpr int RL_AH = 0, RL_BH = 64 * RT, RL_KH = 2 * 64 * RT, RL_RH = 3 * 64 * RT, RL_VX = 4 * 64 * RT, RL_GS = 5 * 64 * RT, RL_YA = 6 * 64 * RT, RL_GR = 7 * 64 * RT, RL_PM = RL_GR + 16 * RGM, RL_GC = RL_PM + 4 * RGM, RL_BON = RL_GC + 256, RL_END = RL_BON + 64;
static_assert(RL_END * 4 <= MISC_OFF, "RWKV LDS");
__device__ __forceinline__ void phase_rwkv(Frame& F, const Args& a) {
    unsigned char* ws = F.ws; const bf16* UB = (const bf16*)(ws + WS_UB); const bf16* LOUT = (const bf16*)(ws + WS_LOUT); bf16* MIX = (bf16*)(ws + WS_XB);
    const float* mu = a.in[6]; const float* w0 = a.in[7]; const float* a0 = a.in[9]; const float* k_k = a.in[12]; const float* k_a = a.in[13]; const float* r_k = a.in[14]; const float* gn_g = a.in[15]; const float* gn_b = a.in[16];
    const int lane = F.lane, w = F.wave, n = lane & 15, q = lane >> 4;
    LAS float* L = (LAS float*)F.lds;
    for (int bh = F.bid; bh < NB * 8; bh += F.G) {
        const int b = bh >> 3, h = bh & 7, c = h * 64 + lane;
        const float mur = mu[c], muk = mu[512 + c], muv = mu[1024 + c], w0c = w0[c], a0c = a0[c], kkc = k_k[c], kac = k_a[c], rkc = r_k[c], gng = gn_g[c], gnb = gn_b[c];
        f32x4 Z[4];
#pragma unroll
        for (int kt = 0; kt < 4; ++kt) Z[kt] = (f32x4){0.f, 0.f, 0.f, 0.f};
        const int ch = w >> 1, hs = w & 1;
        float r_ur[8], r_uk[8], r_uv[8], r_pr[8], r_pk[8], r_pv[8], r_wd[8], r_ad[8], r_gg[8], r_wf[8];
#define RW_RAW(batch_) do { _Pragma("unroll") for (int i = 0; i < 8; ++i) { const int sl = (batch_) * 64 + 16 * ch + 8 * hs + i; const size_t t = (size_t)b * SEQ + sl; const bf16* up = UB + t * UB_W + c; const bf16* pp_ = sl > 0 ? up - UB_W : up; \
            r_ur[i] = bf1(up[0]); r_uk[i] = bf1(up[512]); r_uv[i] = bf1(up[1024]); r_pr[i] = bf1(pp_[0]); r_pk[i] = bf1(pp_[512]); r_pv[i] = bf1(pp_[1024]); \
            const bf16* lp = LOUT + t * 1536 + c; r_wd[i] = bf1(lp[0]); r_ad[i] = bf1(lp[512]); r_gg[i] = bf1(lp[1024]); \
            r_wf[i] = bf1(LOUT[((size_t)b * SEQ + (batch_) * 64 + 16 * ch + i) * 1536 + c]); } } while (0)
        RW_RAW(0);
        for (int batch = 0; batch < SEQ / 64; ++batch) {
            { float gcur = 1.f;
              if (hs) {
#pragma unroll
                  for (int i = 0; i < 8; ++i) gcur *= rw_decay(w0c + r_wf[i]); }
#pragma unroll
              for (int i = 0; i < 8; ++i) { const int tl = 16 * ch + 8 * hs + i, sl = batch * 64 + tl; const float pm = sl > 0 ? 1.f : 0.f;
                const float ur = r_ur[i], uk = r_uk[i], uv = r_uv[i], pr = r_pr[i] * pm, pk = r_pk[i] * pm, pv = r_pv[i] * pm;
                const float rr = ur + mur * (pr - ur), kx = uk + muk * (pk - uk), vx = uv + muv * (pv - uv);
                const float decay = rw_decay(w0c + r_wd[i]), av = sigm(a0c + r_ad[i]);
                float kk = kx * kkc; kk = kk * rsqrtf(fmaxf(wave_sum(kk * kk), 1e-24f));
                const float km = kx * (1.f + (av - 1.f) * kac); const float bon = wave_sum(rr * km * rkc);
                const float gprev = gcur; gcur *= decay; const float ig = __builtin_amdgcn_rcpf(gcur);
                L[RL_AH + tl * RT + lane] = -kk * gprev; L[RL_BH + tl * RT + lane] = kk * av * ig; L[RL_KH + tl * RT + lane] = km * ig; L[RL_RH + tl * RT + lane] = rr * gcur;
                L[RL_VX + tl * RT + lane] = vx; L[RL_GS + tl * RT + lane] = r_gg[i]; if (lane == 0) L[RL_BON + tl] = bon; }
              if (hs) L[RL_GC + ch * 64 + lane] = gcur; }
            LDS_WAIT(); __syncthreads();
            if (batch + 1 < SEQ / 64) RW_RAW(batch + 1);
            { const LAS float* ah = L + RL_AH + 16 * ch * RT; const LAS float* bhm = L + RL_BH + 16 * ch * RT; const LAS float* khm = L + RL_KH + 16 * ch * RT; const LAS float* rhm = L + RL_RH + 16 * ch * RT;
              LAS float* gr = L + RL_GR + ch * 4 * RGM; LAS float* pm_ = L + RL_PM + ch * RGM;
              if (hs == 0) {
                  f32x4 m = {0.f, 0.f, 0.f, 0.f};
#pragma unroll
                  for (int s = 0; s < 16; ++s) m = MF32(bhm[n * RT + 4 * s + q], ah[n * RT + 4 * s + q], m);
                  f32x4 tm;
#pragma unroll
                  for (int j = 0; j < 4; ++j) { m[j] = (4 * q + j < n) ? m[j] : 0.f; tm[j] = m[j] + ((4 * q + j == n) ? 1.f : 0.f); pm_[(4 * q + j) * RG + n] = m[j]; gr[(4 * q + j) * RG + n] = tm[j]; }
#pragma unroll
                  for (int rd = 0; rd < 3; ++rd) { LDS_WAIT();
                      f32x4 p2 = {0.f, 0.f, 0.f, 0.f};
#pragma unroll
                      for (int s = 0; s < 4; ++s) p2 = MF32(pm_[n * RG + 4 * s + q], pm_[(4 * s + q) * RG + n], p2);
                      f32x4 ip, t2 = {0.f, 0.f, 0.f, 0.f};
#pragma unroll
                      for (int j = 0; j < 4; ++j) ip[j] = p2[j] + ((4 * q + j == n) ? 1.f : 0.f);
#pragma unroll
                      for (int j = 0; j < 4; ++j) t2 = MF32(gr[n * RG + 4 * q + j], ip[j], t2);
                      LDS_WAIT();
#pragma unroll
                      for (int j = 0; j < 4; ++j) { pm_[(4 * q + j) * RG + n] = p2[j]; gr[(4 * q + j) * RG + n] = t2[j]; } }
              } else {
                  f32x4 mk = {0.f, 0.f, 0.f, 0.f}, nb = {0.f, 0.f, 0.f, 0.f}, nk = {0.f, 0.f, 0.f, 0.f};
#pragma unroll
                  for (int s = 0; s < 16; ++s) { const float av_ = ah[n * RT + 4 * s + q], rv_ = rhm[n * RT + 4 * s + q], bv_ = bhm[n * RT + 4 * s + q], kv_ = khm[n * RT + 4 * s + q];
                      mk = MF32(kv_, av_, mk); nb = MF32(bv_, rv_, nb); nk = MF32(kv_, rv_, nk); }
#pragma unroll
                  for (int j = 0; j < 4; ++j) { const int s_ = 4 * q + j; gr[RGM + s_ * RG + n] = (s_ < n) ? mk[j] : 0.f; gr[2 * RGM + s_ * RG + n] = (s_ <= n) ? nb[j] : 0.f; gr[3 * RGM + s_ * RG + n] = (s_ <= n) ? nk[j] : 0.f; } } }
            LDS_WAIT(); __syncthreads();
#ifndef RW_C_REP
#define RW_C_REP 1
#endif
            if (w < 4) { const int v = 16 * w + n; f32x4 Zs[4]; for (int kt = 0; kt < 4; ++kt) Zs[kt] = Z[kt];
              for (int rc_ = 0; rc_ < RW_C_REP; ++rc_) { if (rc_) for (int kt = 0; kt < 4; ++kt) Z[kt] = Zs[kt];
#pragma unroll 1
                for (int cc = 0; cc < 4; ++cc) { const LAS float* ah = L + RL_AH + 16 * cc * RT; const LAS float* bhm = L + RL_BH + 16 * cc * RT; const LAS float* khm = L + RL_KH + 16 * cc * RT; const LAS float* rhm = L + RL_RH + 16 * cc * RT;
                    const LAS float* vx = L + RL_VX + 16 * cc * RT; const LAS float* gr = L + RL_GR + cc * 4 * RGM;
                    float vb[4];
#pragma unroll
                    for (int s = 0; s < 4; ++s) vb[s] = vx[(4 * s + q) * RT + v];
                    f32x4 X = {0.f, 0.f, 0.f, 0.f}, Y = {0.f, 0.f, 0.f, 0.f};
#pragma unroll
                    for (int kt = 0; kt < 4; ++kt)
#pragma unroll
                        for (int j = 0; j < 4; ++j) { X = MF32(ah[n * RT + 16 * kt + 4 * q + j], Z[kt][j], X); Y = MF32(rhm[n * RT + 16 * kt + 4 * q + j], Z[kt][j], Y); }
#pragma unroll
                    for (int s = 0; s < 4; ++s) { X = MF32(gr[RGM + (4 * s + q) * RG + n], vb[s], X); Y = MF32(gr[3 * RGM + (4 * s + q) * RG + n], vb[s], Y); }
                    f32x4 U = {0.f, 0.f, 0.f, 0.f};
#pragma unroll
                    for (int j = 0; j < 4; ++j) U = MF32(gr[(4 * q + j) * RG + n], X[j], U);
#pragma unroll
                    for (int j = 0; j < 4; ++j) Y = MF32(gr[2 * RGM + (4 * q + j) * RG + n], U[j], Y);
#pragma unroll
                    for (int j = 0; j < 4; ++j) L[RL_YA + (16 * cc + 4 * q + j) * RT + v] = Y[j];
#pragma unroll
                    for (int kt = 0; kt < 4; ++kt) {
#pragma unroll
                        for (int j = 0; j < 4; ++j) Z[kt] = MF32(bhm[(4 * q + j) * RT + 16 * kt + n], U[j], Z[kt]);
#pragma unroll
                        for (int s = 0; s < 4; ++s) Z[kt] = MF32(khm[(4 * s + q) * RT + 16 * kt + n], vb[s], Z[kt]);
                        const f32x4 gc = *(const LAS f32x4*)(L + RL_GC + cc * 64 + 16 * kt + 4 * q); Z[kt] = Z[kt] * gc; } } } }
            LDS_WAIT(); __syncthreads();
#pragma unroll
            for (int i = 0; i < 8; ++i) { const int step = w + 8 * i; const size_t t = (size_t)b * SEQ + batch * 64 + step;
                const float y = L[RL_YA + step * RT + lane], mean = wave_sum(y) * (1.f / 64.f), dlt = y - mean, var = fmaxf(wave_sum(y * y) * (1.f / 64.f) - mean * mean, 0.f);
                const float yn = dlt * rsqrtf(var + 64e-5f) * gng + gnb; const float o = (yn + L[RL_BON + step] * L[RL_VX + step * RT + lane]) * L[RL_GS + step * RT + lane];
                MIX[t * D + 512 + c] = (bf16)f2bf(o); }
            LDS_WAIT(); __syncthreads();
        }
#undef RW_RAW
    }
}
__device__ __forceinline__ void phase_l1prep(Frame& F, const Args& a, int hb) {
    unsigned char* ws = F.ws; const bf16* XM = (const bf16*)(ws + WS_XM); bf16* XC = (bf16*)(ws + WS_XC); bf16* Q = (bf16*)(ws + WS_Q); bf16* K = (bf16*)(ws + WS_K); bf16* V = (bf16*)(ws + WS_V);
    float* GI = (float*)(ws + WS_GI); const float* W12 = (const float*)(ws + WS_W12);
    const float* cw = a.in[19]; const float* cb = a.in[20]; const float* wq = a.in[21]; const float* wk = a.in[22]; const float* wv = a.in[23]; const float* b_i = a.in[25]; const float* b_f = a.in[26];
    const int g = F.tid, lane = F.lane, w = F.wave; LAS float* red = (LAS float*)F.lds;
    float cwr[4][4], cbr[4], wqr[16], wkr[16], wvr[16], w1[32], w2[32];
#pragma unroll
    for (int j = 0; j < 4; ++j)
#pragma unroll
        for (int i = 0; i < 4; ++i) cwr[j][i] = cw[j * CI + 4 * g + i];
#pragma unroll
    for (int i = 0; i < 4; ++i) cbr[i] = cb[4 * g + i];
#pragma unroll
    for (int i = 0; i < 16; ++i) { wqr[i] = wq[g * 16 + i]; wkr[i] = wk[g * 16 + i]; wvr[i] = wv[g * 16 + i]; }
#pragma unroll
    for (int i = 0; i < 32; ++i) { w1[i] = W12[(size_t)(4 * g) * 8 + i]; w2[i] = W12[(size_t)(2048 + 4 * g) * 8 + i]; }
    float wqk[16];
#pragma unroll
    for (int i = 0; i < 4; ++i)
#pragma unroll
        for (int ip = 0; ip < 4; ++ip) { float sacc = 0.f;
#pragma unroll
            for (int m = 0; m < 4; ++m) sacc = fmaf(wqr[4 * i + m], wkr[4 * ip + m], sacc);
            wqk[4 * i + ip] = sacc * 0.044194173824159216f; }
    const int per = TH / F.G;
    const int tb = F.bid * per;
    float x0[4], x1[4], x2[4];
    { const int sl = tb & (SEQ - 1);
#pragma unroll
      for (int i = 0; i < 4; ++i) { x0[i] = 0.f; x1[i] = 0.f; x2[i] = 0.f; }
      if (sl >= 1) { const v2u r = *(const v2u*)(XM + (size_t)(tb - 1) * CI + 4 * g); x2[0] = bflo(r.x); x2[1] = bfhi(r.x); x2[2] = bflo(r.y); x2[3] = bfhi(r.y); }
      if (sl >= 2) { const v2u r = *(const v2u*)(XM + (size_t)(tb - 2) * CI + 4 * g); x1[0] = bflo(r.x); x1[1] = bfhi(r.x); x1[2] = bflo(r.y); x1[3] = bfhi(r.y); }
      if (sl >= 3) { const v2u r = *(const v2u*)(XM + (size_t)(tb - 3) * CI + 4 * g); x0[0] = bflo(r.x); x0[1] = bfhi(r.x); x0[2] = bflo(r.y); x0[3] = bfhi(r.y); } }
    constexpr int L1PF = 4;
    v2u xq[L1PF][2];
#pragma unroll
    for (int pq = 0; pq < L1PF; ++pq)
#pragma unroll
        for (int tk = 0; tk < 2; ++tk) xq[pq][tk] = *(const v2u*)(XM + (size_t)(tb + 2 * pq + tk) * CI + 4 * g);
    for (int n4 = 0; n4 < per / 2; ++n4) { const int t4 = tb + 2 * n4;
        float gs[16]; v2u xr[2];
        xr[0] = xq[0][0]; xr[1] = xq[0][1];
#pragma unroll
        for (int pq = 0; pq + 1 < L1PF; ++pq) { xq[pq][0] = xq[pq + 1][0]; xq[pq][1] = xq[pq + 1][1]; }
        { const int tn = (n4 + L1PF < per / 2) ? t4 + 2 * L1PF : t4;
#pragma unroll
          for (int tk = 0; tk < 2; ++tk) xq[L1PF - 1][tk] = *(const v2u*)(XM + (size_t)(tn + tk) * CI + 4 * g); }
#pragma unroll
        for (int tk = 0; tk < 2; ++tk) { const int t = t4 + tk;
            float x3[4]; x3[0] = bflo(xr[tk].x); x3[1] = bfhi(xr[tk].x); x3[2] = bflo(xr[tk].y); x3[3] = bfhi(xr[tk].y);
            float xc[4], q[4];
#pragma unroll
            for (int i = 0; i < 4; ++i) { const float s = fmaf(cwr[3][i], x3[i], fmaf(cwr[2][i], x2[i], fmaf(cwr[1][i], x1[i], fmaf(cwr[0][i], x0[i], cbr[i])))); xc[i] = s * sigm(s); }
#pragma unroll
            for (int j = 0; j < 4; ++j) q[j] = fmaf(xc[3], wqk[12 + j], fmaf(xc[2], wqk[8 + j], fmaf(xc[1], wqk[4 + j], xc[0] * wqk[j])));
#pragma unroll
            for (int o = 0; o < 8; ++o) { float s = 0.f;
#pragma unroll
                for (int i = 0; i < 4; ++i) s = fmaf(x3[i], w2[i * 8 + o], fmaf(xc[i], w1[i * 8 + o], s));
                gs[tk * 8 + o] = s; }
            const size_t off = (size_t)t * CI + 4 * g;
            { v2u o; o.x = pk2(xc[0], xc[1]); o.y = pk2(xc[2], xc[3]); *(v2u*)(XC + off) = o; o.x = pk2(q[0], q[1]); o.y = pk2(q[2], q[3]); *(v2u*)(Q + off) = o; }
#pragma unroll
            for (int i = 0; i < 4; ++i) { x0[i] = x1[i]; x1[i] = x2[i]; x2[i] = x3[i]; } }
#define L1_STAGE(mask, n) { const bool hi_ = (lane & (mask)) != 0; _Pragma("unroll") for (int i = 0; i < (n) / 2; ++i) { const float send_ = hi_ ? gs[i] : gs[(n) / 2 + i]; const float keep_ = hi_ ? gs[(n) / 2 + i] : gs[i]; gs[i] = keep_ + __shfl_xor(send_, (mask)); } }
        L1_STAGE(32, 16) L1_STAGE(16, 8) L1_STAGE(8, 4) L1_STAGE(4, 2)
#undef L1_STAGE
        gs[0] += __shfl_xor(gs[0], 2); gs[0] += __shfl_xor(gs[0], 1);
        LAS float* rp = red + (n4 & 1) * 128;
        if ((lane & 3) == 0) rp[w * 16 + (lane >> 2)] = gs[0];
        LDS_WAIT(); __syncthreads();
        if (F.tid < 16) { float s = 0.f;
#pragma unroll
            for (int ww = 0; ww < 8; ++ww) s += rp[ww * 16 + F.tid];
            const int o = F.tid & 7; GI[(size_t)(t4 + (F.tid >> 3)) * 8 + o] = s + (o < 4 ? b_i[o] : b_f[o - 4]); }
    }
}
__device__ __forceinline__ void phase_gatescan(Frame& F) {
    unsigned char* ws = F.ws; const float* GI = (const float*)(ws + WS_GI); float* GA = (float*)(ws + WS_GA); float* GAM = (float*)(ws + WS_GAM); float* GEM = (float*)(ws + WS_GEM);
    const int lane = F.lane, w = F.wave, tid = F.tid; LAS float* wtot = (LAS float*)F.lds;
    for (int sq = F.bid; sq < (NB / 2) * 4; sq += F.G) { const int bl = sq >> 2, h = sq & 3; const size_t tq = (size_t)bl * SEQ + 4 * tid;
        float ip[4], c[4];
#pragma unroll
        for (int k = 0; k < 4; ++k) { ip[k] = GI[(tq + k) * 8 + h]; c[k] = -softplusf_(-GI[(tq + k) * 8 + 4 + h]); }
        c[1] += c[0]; c[2] += c[1]; c[3] += c[2];
        float inc = c[3];
#pragma unroll
        for (int o = 1; o < 64; o <<= 1) { const float n = __shfl_up(inc, o); if (lane >= o) inc += n; }
        if (lane == 63) wtot[w] = inc;
        LDS_WAIT(); __syncthreads();
        float off = inc - c[3];
#pragma unroll
        for (int ww = 0; ww < 8; ++ww) if (ww < w) off += wtot[ww];
        float Fv[4], av[4], m[4];
#pragma unroll
        for (int k = 0; k < 4; ++k) { Fv[k] = off + c[k]; av[k] = ip[k] - Fv[k]; }
        m[0] = av[0]; m[1] = fmaxf(m[0], av[1]); m[2] = fmaxf(m[1], av[2]); m[3] = fmaxf(m[2], av[3]);
        float incm = m[3];
#pragma unroll
        for (int o = 1; o < 64; o <<= 1) { const float n = __shfl_up(incm, o); if (lane >= o) incm = fmaxf(incm, n); }
        if (lane == 63) wtot[8 + w] = incm;
        LDS_WAIT(); __syncthreads();
        float offm = __shfl_up(incm, 1); if (lane == 0) offm = -INFINITY;
#pragma unroll
        for (int ww = 0; ww < 8; ++ww) if (ww < w) offm = fmaxf(offm, wtot[8 + ww]);
#pragma unroll
        for (int k = 0; k < 4; ++k) { const float A = fmaxf(offm, m[k]); GA[(tq + k) * 4 + h] = av[k]; GAM[(tq + k) * 4 + h] = A; GEM[(tq + k) * 4 + h] = __expf(-(Fv[k] + A)); }
        LDS_WAIT(); __syncthreads();
    }
}
constexpr int ML_PITCH = 1040, ML_TILE = 32 * ML_PITCH, ML_PP = 80, ML_PT = 64 * ML_PP;
constexpr int ML_K = 0, ML_V = 2 * ML_TILE, ML_P = 4 * ML_TILE, ML_DEN = ML_P + 2 * ML_PT, ML_AT = ML_DEN + 512, ML_AS = ML_AT + 256, ML_END = ML_AS + 8192;
constexpr int ML_ST = ML_P, ML_MR = ML_P + 4096;
static_assert(ML_MR + 512 <= ML_DEN, "mLSTM LDS tables");
static_assert(ML_END <= MISC_OFF, "mLSTM LDS");
__device__ __forceinline__ void tr_read_v4(unsigned a, bf16x8 (&vf)[4]) { s16x4 l0, h0, l1, h1, l2, h2, l3, h3;
    asm volatile("ds_read_b64_tr_b16 %0, %8\n\tds_read_b64_tr_b16 %1, %8 offset:4160\n\tds_read_b64_tr_b16 %2, %8 offset:32\n\tds_read_b64_tr_b16 %3, %8 offset:4192\n\t"
                 "ds_read_b64_tr_b16 %4, %8 offset:64\n\tds_read_b64_tr_b16 %5, %8 offset:4224\n\tds_read_b64_tr_b16 %6, %8 offset:96\n\tds_read_b64_tr_b16 %7, %8 offset:4256\n\ts_waitcnt lgkmcnt(0)"
                 : "=&v"(l0), "=&v"(h0), "=&v"(l1), "=&v"(h1), "=&v"(l2), "=&v"(h2), "=&v"(l3), "=&v"(h3) : "v"(a) : "memory");
    vf[0] = (bf16x8){l0[0], l0[1], l0[2], l0[3], h0[0], h0[1], h0[2], h0[3]}; vf[1] = (bf16x8){l1[0], l1[1], l1[2], l1[3], h1[0], h1[1], h1[2], h1[3]};
    vf[2] = (bf16x8){l2[0], l2[1], l2[2], l2[3], h2[0], h2[1], h2[2], h2[3]}; vf[3] = (bf16x8){l3[0], l3[1], l3[2], l3[3], h3[0], h3[1], h3[2], h3[3]}; }
static_assert(4 * ML_PITCH == 4160, "tr_read_v4 offsets");
__device__ __forceinline__ void tr_read_v8(unsigned a, bf16x8 (&vf)[8]) { s16x4 l0, h0, l1, h1, l2, h2, l3, h3, l4, h4, l5, h5, l6, h6, l7, h7;
    asm volatile("ds_read_b64_tr_b16 %0, %16\n\tds_read_b64_tr_b16 %1, %16 offset:4160\n\tds_read_b64_tr_b16 %2, %16 offset:32\n\tds_read_b64_tr_b16 %3, %16 offset:4192\n\t"
                 "ds_read_b64_tr_b16 %4, %16 offset:64\n\tds_read_b64_tr_b16 %5, %16 offset:4224\n\tds_read_b64_tr_b16 %6, %16 offset:96\n\tds_read_b64_tr_b16 %7, %16 offset:4256\n\t"
                 "ds_read_b64_tr_b16 %8, %16 offset:128\n\tds_read_b64_tr_b16 %9, %16 offset:4288\n\tds_read_b64_tr_b16 %10, %16 offset:160\n\tds_read_b64_tr_b16 %11, %16 offset:4320\n\t"
                 "ds_read_b64_tr_b16 %12, %16 offset:192\n\tds_read_b64_tr_b16 %13, %16 offset:4352\n\tds_read_b64_tr_b16 %14, %16 offset:224\n\tds_read_b64_tr_b16 %15, %16 offset:4384\n\ts_waitcnt lgkmcnt(0)"
                 : "=&v"(l0), "=&v"(h0), "=&v"(l1), "=&v"(h1), "=&v"(l2), "=&v"(h2), "=&v"(l3), "=&v"(h3), "=&v"(l4), "=&v"(h4), "=&v"(l5), "=&v"(h5), "=&v"(l6), "=&v"(h6), "=&v"(l7), "=&v"(h7) : "v"(a) : "memory");
    vf[0] = (bf16x8){l0[0], l0[1], l0[2], l0[3], h0[0], h0[1], h0[2], h0[3]}; vf[1] = (bf16x8){l1[0], l1[1], l1[2], l1[3], h1[0], h1[1], h1[2], h1[3]};
    vf[2] = (bf16x8){l2[0], l2[1], l2[2], l2[3], h2[0], h2[1], h2[2], h2[3]}; vf[3] = (bf16x8){l3[0], l3[1], l3[2], l3[3], h3[0], h3[1], h3[2], h3[3]};
    vf[4] = (bf16x8){l4[0], l4[1], l4[2], l4[3], h4[0], h4[1], h4[2], h4[3]}; vf[5] = (bf16x8){l5[0], l5[1], l5[2], l5[3], h5[0], h5[1], h5[2], h5[3]};
    vf[6] = (bf16x8){l6[0], l6[1], l6[2], l6[3], h6[0], h6[1], h6[2], h6[3]}; vf[7] = (bf16x8){l7[0], l7[1], l7[2], l7[3], h7[0], h7[1], h7[2], h7[3]}; }
template <int PB> __device__ __forceinline__ void phase_mlstm_t(Frame& F, const Args& a) {
    constexpr bool skK = PB & 1, skV = PB & 2, skS = PB & 4, skP = PB & 8, skE = PB & 16;
    unsigned char* ws = F.ws; const bf16* Q = (const bf16*)(ws + WS_Q); const bf16* K = (const bf16*)(ws + WS_XC); const bf16* V = (const bf16*)(ws + WS_XM); const bf16* XC = (const bf16*)(ws + WS_XC); const bf16* Z = (const bf16*)(ws + WS_Z);
    bf16* YC = (bf16*)(ws + WS_V); const float* GA = (const float*)(ws + WS_GA); const float* GAM = (const float*)(ws + WS_GAM); const float* GEM = (const float*)(ws + WS_GEM);
    const float* mh_g = a.in[27]; const float* skip = a.in[28]; const float* wvp = a.in[23];
    const int tid = F.tid, lane = F.lane, w = F.wave, fr = lane & 15, fq = lane >> 4; LAS unsigned char* lds = F.lds;
    LAS float* den2 = (LAS float*)(lds + ML_DEN); LAS float* stats = (LAS float*)(lds + ML_ST); LAS float* mr = (LAS float*)(lds + ML_MR); LAS float* em_s = (LAS float*)(lds + ML_AT); LAS float* as_s = (LAS float*)(lds + ML_AS);
    const int st = w & 1, tp = (w >> 1) & 1, wv = w & 3;
    const unsigned vtr_lane = (unsigned)((8 * fq + ((lane & 15) >> 2)) * ML_PITCH + (128 * wv + 4 * (lane & 3)) * 2);
#define ML_DMA(gbase, tile_off) do { _Pragma("unroll") for (int r4 = 0; r4 < 4; ++r4) { const int rr = w + 8 * r4; \
        __builtin_amdgcn_global_load_lds((const unsigned*)((gbase) + (size_t)rr * CI + lane * 8), (LAS unsigned*)(lds + (tile_off) + rr * ML_PITCH), 16, 0, 0); } } while (0)
#define ML_STEP_HEAD() const int buf = k & 1; int j = k + jstart; if (j >= nk) j -= nk; int jn = j + 1; if (jn >= nk) jn -= nk; \
        asm volatile("s_waitcnt vmcnt(0) lgkmcnt(0)" ::: "memory"); __builtin_amdgcn_s_barrier(); asm volatile("" ::: "memory"); \
        if (k + 1 < nk && !skK) ML_DMA(Kb + (size_t)(32 * jn) * CI, ML_K + (buf ^ 1) * ML_TILE); \
        if (k < nk && !skV) ML_DMA(Vb + (size_t)(32 * j) * CI, ML_V + buf * ML_TILE)
    for (int r = 0; r < 8; ++r) { const int xcd = F.bid & 7, cq = F.bid >> 3, c16 = cq & 15; if (F.G != 256) break;
        const int part = r & 1, qi = part ? 31 - c16 : c16, bh = xcd + 8 * ((cq >> 4) + 2 * (r >> 1)), bl = bh >> 2, h = bh & 3; const size_t t0 = (size_t)bl * SEQ + 64 * qi; const int nk = 2 * (qi + 1), jstart = part ? 2 * (c16 + 1) : 0;
        const bf16* Kb = K + (size_t)bl * SEQ * CI + h * 512; const bf16* Vb = V + (size_t)bl * SEQ * CI + h * 512;
        ML_DMA(Kb + (size_t)(32 * jstart) * CI, ML_K);
        float tb_e, tb_a[4];
        tb_e = GEM[(t0 + (tid & 63)) * 4 + h];
#pragma unroll
        for (int i4 = 0; i4 < 4; ++i4) tb_a[i4] = GA[((size_t)bl * SEQ + tid + 512 * i4) * 4 + h];
#define ML_TABLES() do { if (tid < 64) em_s[tid] = tb_e; _Pragma("unroll") for (int i4 = 0; i4 < 4; ++i4) { const int sidx = tid + 512 * i4; if (sidx < 64 * (qi + 1)) as_s[sidx] = tb_a[i4]; } } while (0)
        const int c8 = lane * 8, cc = h * 512 + c8;
#define ML_EPI_LOADS(N, ROW0) v4u zr[N], xr[N]; float gm[8], sk[8]; asm volatile("" ::: "memory"); __builtin_amdgcn_sched_barrier(0); if (!skE) { _Pragma("unroll") for (int k8 = 0; k8 < N; ++k8) { const size_t off = (t0 + (ROW0) + k8) * CI + cc; zr[k8] = *(const v4u*)(Z + off); xr[k8] = *(const v4u*)(XC + off); } \
        _Pragma("unroll") for (int q = 0; q < 8; ++q) { gm[q] = mh_g[cc + q]; sk[q] = skip[cc + q]; } }
#define ML_EPI_PASS(N, ROW0) if (!skE) { const LAS float* ytile = (const LAS float*)lds; _Pragma("unroll") for (int k8 = 0; k8 < N; ++k8) { const int row = (ROW0) + k8; const size_t off = (t0 + row) * CI + cc; \
              const f32x4 y0 = *(const LAS f32x4*)(ytile + row * 516 + c8), y1 = *(const LAS f32x4*)(ytile + row * 516 + c8 + 4); float zf[8], xf[8], o[8]; unpack8(zr[k8], zf); unpack8(xr[k8], xf); \
              float s1 = ((y0[0] + y0[1]) + (y0[2] + y0[3])) + ((y1[0] + y1[1]) + (y1[2] + y1[3])), s2 = ((y0[0] * y0[0] + y0[1] * y0[1]) + (y0[2] * y0[2] + y0[3] * y0[3])) + ((y1[0] * y1[0] + y1[1] * y1[1]) + (y1[2] * y1[2] + y1[3] * y1[3])); \
              s1 = wave_sum(s1); s2 = wave_sum(s2); const float mean = s1 * (1.f / 512.f), rstd = rsqrtf(fmaxf(s2 * (1.f / 512.f) - mean * mean, 0.f) + 1e-5f); \
              _Pragma("unroll") for (int q = 0; q < 8; ++q) { const float yv = ((q < 4 ? y0[q & 3] : y1[q & 3]) - mean) * rstd; o[q] = (yv * gm[q] + sk[q] * xf[q]) * (zf[q] * sigm(zf[q])); } \
              *(v4u*)(YC + off) = pack8(o); } }
        if (w < 4) {
            bf16x8 qf[2][16];
            { const bf16* qp = Q + (t0 + 32 * tp + fr) * CI + h * 512 + fq * 8;
#pragma unroll
              for (int ks = 0; ks < 16; ++ks) { qf[0][ks] = *(const bf16x8*)(qp + 32 * ks); qf[1][ks] = *(const bf16x8*)(qp + 16 * CI + 32 * ks); } }
            const float At0 = GAM[(t0 + 32 * tp + fr) * 4 + h], At1 = GAM[(t0 + 32 * tp + 16 + fr) * 4 + h];
            ML_TABLES();
            float denp0 = 0.f, denp1 = 0.f;
            for (int k = 0; k <= nk; ++k) { ML_STEP_HEAD();
                if (k < nk && !skS) {
                    f32x4 s0a = {0.f, 0.f, 0.f, 0.f}, s0b = {0.f, 0.f, 0.f, 0.f}, s1a = {0.f, 0.f, 0.f, 0.f}, s1b = {0.f, 0.f, 0.f, 0.f};
                    { const LAS unsigned char* kl = lds + ML_K + buf * ML_TILE + (16 * st + fr) * ML_PITCH + fq * 16; bf16x8 kc[4], kn[4];
#pragma unroll
                      for (int q = 0; q < 4; ++q) kc[q] = *(const LAS bf16x8*)(kl + 64 * q);
#pragma unroll
                      for (int g = 0; g < 4; ++g) {
                          if (g < 3) {
#pragma unroll
                              for (int q = 0; q < 4; ++q) kn[q] = *(const LAS bf16x8*)(kl + 64 * (4 * g + 4 + q)); }
                          __builtin_amdgcn_sched_barrier(0);
#pragma unroll
                          for (int q = 0; q < 4; q += 2) { const int ks = 4 * g + q;
                              s0a = __builtin_amdgcn_mfma_f32_16x16x32_bf16(kc[q], qf[0][ks], s0a, 0, 0, 0); s1a = __builtin_amdgcn_mfma_f32_16x16x32_bf16(kc[q], qf[1][ks], s1a, 0, 0, 0);
                              s0b = __builtin_amdgcn_mfma_f32_16x16x32_bf16(kc[q + 1], qf[0][ks + 1], s0b, 0, 0, 0); s1b = __builtin_amdgcn_mfma_f32_16x16x32_bf16(kc[q + 1], qf[1][ks + 1], s1b, 0, 0, 0); }
                          __builtin_amdgcn_sched_barrier(0);
                          if (g < 3) {
#pragma unroll
                              for (int q = 0; q < 4; ++q) kc[q] = kn[q]; } } }
                    s0a += s0b; s1a += s1b;
                    const f32x4 asv = *(const LAS f32x4*)(as_s + 32 * j + 16 * st + 4 * fq); const float as[4] = {asv[0], asv[1], asv[2], asv[3]};
                    float p0[4], p1[4]; const int sbase = 32 * j + 16 * st + 4 * fq, tbase = 64 * qi + 32 * tp + fr;
#pragma unroll
                    for (int i = 0; i < 4; ++i) { p0[i] = (sbase + i) <= tbase ? s0a[i] * __builtin_amdgcn_exp2f((as[i] - At0) * LOG2E) : 0.f; p1[i] = (sbase + i) <= tbase + 16 ? s1a[i] * __builtin_amdgcn_exp2f((as[i] - At1) * LOG2E) : 0.f; }
                    denp0 += (p0[0] + p0[1]) + (p0[2] + p0[3]); denp1 += (p1[0] + p1[1]) + (p1[2] + p1[3]);
                    { LAS unsigned char* pp = lds + ML_P + buf * ML_PT + (32 * tp + fr) * ML_PP + (16 * st + 4 * fq) * 2; v2u pw; pw.x = pk2(p0[0], p0[1]); pw.y = pk2(p0[2], p0[3]); *(LAS v2u*)pp = pw;
                      pw.x = pk2(p1[0], p1[1]); pw.y = pk2(p1[2], p1[3]); *(LAS v2u*)(pp + 16 * ML_PP) = pw; }
                } }
            ML_EPI_LOADS(12, 12 * w);
            { float wt[8];
#pragma unroll
              for (int u = 0; u < 8; ++u) { const int col = 2 * tid + (u >> 2); wt[u] = wvp[(size_t)(h * 128 + (col >> 2)) * 16 + 4 * (u & 3) + (col & 3)]; }
              *(LAS f32x4*)(as_s + 8 * tid) = (f32x4){wt[0], wt[1], wt[2], wt[3]}; *(LAS f32x4*)(as_s + 8 * tid + 4) = (f32x4){wt[4], wt[5], wt[6], wt[7]}; }
            { float d0 = denp0, d1 = denp1; d0 += __shfl_xor(d0, 16); d1 += __shfl_xor(d1, 16); d0 += __shfl_xor(d0, 32); d1 += __shfl_xor(d1, 32);
              if (fq == 0) { den2[st * 64 + 32 * tp + fr] = d0; den2[st * 64 + 32 * tp + 16 + fr] = d1; } }
            LDS_WAIT(); __builtin_amdgcn_s_barrier(); asm volatile("" ::: "memory");
            __builtin_amdgcn_s_barrier(); asm volatile("" ::: "memory");
            ML_EPI_PASS(12, 12 * w)
        } else {
            f32x4 O[4][8];
#pragma unroll
            for (int i = 0; i < 4; ++i)
#pragma unroll
                for (int e = 0; e < 8; ++e) O[i][e] = (f32x4){0.f, 0.f, 0.f, 0.f};
            ML_TABLES();
            for (int k = 0; k <= nk; ++k) { ML_STEP_HEAD();
                if (k >= 1 && !skP) { bf16x8 vf[8], pf[4]; const unsigned vb = (unsigned)(size_t)(lds + ML_V + (buf ^ 1) * ML_TILE) + vtr_lane; const LAS unsigned char* pl = lds + ML_P + (buf ^ 1) * ML_PT + fr * ML_PP + fq * 16;
#pragma unroll
                    for (int i = 0; i < 4; ++i) pf[i] = *(const LAS bf16x8*)(pl + 16 * i * ML_PP);
                    tr_read_v8(vb, vf);
#pragma unroll
                    for (int i = 0; i < 4; ++i)
#pragma unroll
                        for (int e = 0; e < 8; ++e) O[i][e] = __builtin_amdgcn_mfma_f32_16x16x32_bf16(pf[i], vf[e], O[i][e], 0, 0, 0); } }
            LDS_WAIT(); __builtin_amdgcn_s_barrier(); asm volatile("" ::: "memory");
            { const LAS float* den_q = den2 + 4 * fq; const LAS float* em_q = em_s + 4 * fq; LAS float* yt_q = (LAS float*)lds + 4 * fq * 516 + 128 * wv + fr; float inv[16];
#pragma unroll
              for (int i = 0; i < 4; ++i)
#pragma unroll
                for (int jj = 0; jj < 4; ++jj) { const float dn = den_q[16 * i + jj] + den_q[64 + 16 * i + jj]; inv[4 * i + jj] = 1.0f / fmaxf(fabsf(dn), em_q[16 * i + jj]); }
#pragma unroll
              for (int e = 0; e < 8; ++e) { const f32x4 wl = *(const LAS f32x4*)(as_s + (128 * wv + 16 * e + fr) * 4);
#pragma unroll
                for (int i = 0; i < 4; ++i)
#pragma unroll
                    for (int jj = 0; jj < 4; ++jj) { const float x = O[i][e][jj] * inv[4 * i + jj];
                        yt_q[(16 * i + jj) * 516 + 16 * e] = fmaf(DPP_MOVF(x, 0xFF), wl[3], fmaf(DPP_MOVF(x, 0xAA), wl[2], fmaf(DPP_MOVF(x, 0x55), wl[1], DPP_MOVF(x, 0x00) * wl[0]))); } } }
            LDS_WAIT(); __builtin_amdgcn_s_barrier(); asm volatile("" ::: "memory");
            ML_EPI_LOADS(4, 48 + 4 * wv);
            ML_EPI_PASS(4, 48 + 4 * wv)
        }
        VM_WAIT(); __syncthreads();
    }
#undef ML_DMA
#undef ML_STEP_HEAD
#undef ML_TABLES
#undef ML_EPI_LOADS
#undef ML_EPI_PASS
}
__device__ __forceinline__ void phase_mlstm(Frame& F, const Args& a) { phase_mlstm_t<0>(F, a); }
#ifdef ML_PROBE
__device__ __forceinline__ void phase_mlstm_probe(Frame& F, const Args& a) { phase_mlstm_t<ML_PROBE>(F, a); }
#endif

#ifdef ML_DMAPROBE
__device__ __forceinline__ void phase_mlstm_dmaprobe(Frame& F, const Args& a) {
    unsigned char* ws = F.ws; const bf16* K = (const bf16*)(ws + WS_K); const bf16* V = (const bf16*)(ws + WS_V);
    const int lane = F.lane, w = F.wave; LAS unsigned char* lds = F.lds;
#define MLP_DMA(gbase, tile_off) do { _Pragma("unroll") for (int r4 = 0; r4 < 4; ++r4) { const int rr = w + 8 * r4; \
        __builtin_amdgcn_global_load_lds((const unsigned*)((gbase) + (size_t)rr * CI + lane * 8), (LAS unsigned*)(lds + (tile_off) + rr * ML_PITCH), 16, 0, 0); } } while (0)
    for (int r = 0; r < 8; ++r) { const int xcd = F.bid & 7, cq = F.bid >> 3, c16 = cq & 15; if (F.G != 256) break;
        const int part = r & 1, qi = part ? 31 - c16 : c16, bh = xcd + 8 * ((cq >> 4) + 2 * (r >> 1)), bl = bh >> 2, h = bh & 3; const int nk = 2 * (qi + 1), jstart = part ? 2 * (c16 + 1) : 0;
        const bf16* Kb = K + (size_t)bl * SEQ * CI + h * 512; const bf16* Vb = V + (size_t)bl * SEQ * CI + h * 512;
        for (int k = 0; k <= nk; ++k) { const int buf = k & 1; int j = k + jstart; if (j >= nk) j -= nk; int jn = j + 1; if (jn >= nk) jn -= nk;
            asm volatile("s_waitcnt vmcnt(0) lgkmcnt(0)" ::: "memory"); __builtin_amdgcn_s_barrier(); asm volatile("" ::: "memory");
            if ((ML_DMAPROBE & 1) && k + 1 < nk) MLP_DMA(Kb + (size_t)(32 * jn) * CI, ML_K + (buf ^ 1) * ML_TILE);
            if ((ML_DMAPROBE & 2) && k < nk) MLP_DMA(Vb + (size_t)(32 * j) * CI, ML_V + buf * ML_TILE);
        }
        VM_WAIT(); __syncthreads();
    }
#undef MLP_DMA
}
#endif
#ifdef ML_DMAPROBE
#define ML_PROBE_CALL phase_mlstm_dmaprobe(F, args);
#elif defined(ML_PROBE)
#define ML_PROBE_CALL phase_mlstm_probe(F, args);
#else
#define ML_PROBE_CALL
#endif
#define GEMM_PHASE(EPI, Aptr, Bptr, M_, N_, K_, ...) do { pg8::Gemm g{(const pg8::bf16_t*)(Aptr), (const pg8::bf16_t*)(Bptr), (M_), (N_), (K_)}; pg8::StaticOrder So; So.init((M_), (N_), F.G, F.bid); \
        pg8::EPI Ep{__VA_ARGS__}; pg8::gemm_phase<pg8::EPI, pg8::StaticOrder, PG8_ALIGN, PG8_SP2>(F.lds, g, So, Ep); } while (0)
namespace pg8 { typedef EpiRes2<float> EpiResF; typedef EpiRes2<bf16_t> EpiResB; typedef EpiPle2<false> EpiPleB; typedef EpiPle2<true> EpiPleF; }
__global__ void __launch_bounds__(NWAVES * 64, 2) trunk_fwd(Args args) {
    extern __shared__ __attribute__((aligned(16))) unsigned char lds_raw[];
    Frame F; F.lds = (LAS unsigned char*)lds_raw; F.ws = args.ws; F.in = nullptr;
    F.tid = threadIdx.x; F.lane = F.tid & 63; F.wave = __builtin_amdgcn_readfirstlane(F.tid >> 6); F.G = gridDim.x; F.bid = blockIdx.x;
    volatile LAS unsigned* MISC = (volatile LAS unsigned*)(F.lds + MISC_OFF);
    if (F.tid < 64) MISC[F.tid] = 0u;
    __syncthreads();
    XcdBarrier bar; bar.bar = (unsigned*)(args.ws + WS_CTL) + CW_BAR; bar.x = 0; bar.st = nullptr;
    if (args.use_bar) bar = xcd_barrier_post((unsigned*)(args.ws + WS_CTL) + CW_BAR, MISC + 8);
    unsigned* xrank = (unsigned*)(args.ws + WS_CTL) + CW_XRANK; const unsigned my_xcc = xb_xcc_id();
    if (args.use_bar && F.tid == 0) MISC[12] = xb_add(&xrank[64 * my_xcc], 1u);
    const int lo = args.ph_lo, hi = args.ph_hi;
#ifndef ONLY_SITE
#define ONLY_SITE -1
#endif
#define EN(n) (ONLY_SITE < 0 || ONLY_SITE == (n))
#ifndef REP_MASK
#define REP_MASK 0u
#endif
#define NREP(n) (((REP_MASK >> (n)) & 1u) ? 2 : 1)
#define IN(k) (lo <= (k) && (k) < hi)
#define SEAM(k) do { if (IN(k) && IN((k) + 1)) xcd_barrier(bar); } while (0)
    unsigned char* ws = args.ws; float* out = args.out;
    float* RS = (float*)(ws + WS_RS);
#define RSN(i) (RS + (size_t)(i) * T * 16)
#define PH(site, k, ...) if (EN(site) && IN(k)) { for (int rep_ = 0; rep_ < NREP(site); ++rep_) { if (rep_) xcd_barrier(bar); __VA_ARGS__ } } SEAM(k);
    PH(0, 0, phase_prologue(F, args); phase_cast_sq(F, args.in[0], (bf16*)(ws + WS_XB2), RSN(0), T); phase_cvt_p(F, args.in[1], (bf16*)(ws + WS_PB));)
    if (args.use_bar && lo == 0 && hi > 1) {
        bool ok = F.G == 256; for (int x = 0; x < 16; ++x) { const unsigned cx = xb_ld(&xrank[64 * x]); ok = ok && (cx == (x < 8 ? 32u : 0u)); }
        const unsigned rk = MISC[12]; if (ok && rk < 32u && my_xcc < 8u) F.bid = (int)(rk * 8u + my_xcc); }
    PH(2, 1, GEMM_PHASE(EpiBf16SplitR, ws + WS_XB2, ws + WS_WIN, T, NU, D, (pg8::bf16_t*)(ws + WS_UA), UA_W, 4, (pg8::bf16_t*)(ws + WS_UB), UB_W, RSN(0));)
    PH(3, 2, phase_prepA(F, args);)
    PH(4, 3, GEMM_PHASE(EpiBf16Split, ws + WS_LIN, ws + WS_WLORA, T, 1536, 256 + args.pad, (pg8::bf16_t*)(ws + WS_LOUT), 1536, 1 << 20, nullptr, 0);)
    PH(5, 4, phase_indexer(F);)
    PH(6, 5, phase_dsa_attn(F, args);)
    PH(7, 6, phase_rwkv(F, args);)
    PH(8, 7, GEMM_PHASE(EpiResF, ws + WS_XB, ws + WS_WOUT, T, D, D, args.in[0], (pg8::bf16_t*)(ws + WS_XB2), D, RSN(1));)
#define FFN_PLE(L, pb, rs_a, rs_b, rs_c, PLE_EPI, ple_out) do { const size_t lw = (size_t)(L) * WS_LAYER_STRIDE; \
        PH(21, (pb), GEMM_PHASE(EpiSwigluR, ws + WS_XB2, ws + WS_WGU0 + lw, T, 2 * FF, D, (pg8::bf16_t*)(ws + WS_H), FF, RSN(rs_a));) \
        PH(22, (pb) + 1, GEMM_PHASE(EpiResB, ws + WS_H, ws + WS_WD0 + lw, T, D, FF, (const pg8::bf16_t*)(ws + WS_XB2), (pg8::bf16_t*)(ws + WS_XB), D, RSN(rs_b));) \
        PH(24, (pb) + 2, GEMM_PHASE(EpiBf16Split, ws + WS_PB, ws + WS_WPLE0 + lw, T, D, 256 + args.pad, (pg8::bf16_t*)(ws + WS_E), D, 1 << 20, nullptr, 0);) \
        PH(25, (pb) + 3, GEMM_PHASE(PLE_EPI, ws + WS_XB, ws + WS_WPG0 + lw, T, D, D, (const pg8::bf16_t*)(ws + WS_XB), (void*)(ple_out), (const pg8::bf16_t*)(ws + WS_E), D, RSN(rs_b), RSN(rs_c));) } while (0)
#define L1_HALF(hb, p1) do { bf16* xbh = (bf16*)(ws + WS_XB2) + (size_t)(hb) * TH * D; \
        PH(11, (p1), GEMM_PHASE(EpiBf16SplitR, xbh, ws + WS_WUP, TH, 2 * CI, D, (pg8::bf16_t*)(ws + WS_XM), CI, 8, (pg8::bf16_t*)(ws + WS_Z), CI, RSN(3) + (size_t)(hb) * TH * 16);) \
        PH(12, (p1) + 1, phase_l1prep(F, args, hb);) \
        PH(13, (p1) + 2, phase_gatescan(F); if ((hb) == 0) phase_cvt_p(F, args.in[1] + (size_t)T * 256, (bf16*)(ws + WS_PB));) \
        PH(14, (p1) + 3, ML_PROBE_CALL phase_mlstm(F, args);) \
        PH(15, (p1) + 4, GEMM_PHASE(EpiResB, ws + WS_V, ws + WS_WDOWN, TH, D, CI, (const pg8::bf16_t*)xbh, (pg8::bf16_t*)xbh, D, RSN(4) + (size_t)(hb) * TH * 16);) } while (0)
    FFN_PLE(0, 8, 1, 2, 3, EpiPleB, ws + WS_XB2);
    L1_HALF(0, 12);
    L1_HALF(1, 17);
    FFN_PLE(1, 22, 4, 5, 5, EpiPleF, out);
#undef IN
#undef SEAM
}
constexpr int N_PHASES = 26;

#ifndef MK_ONE_LAUNCH
#define MK_ONE_LAUNCH 1
#endif
extern "C" void kernel_launch(void* const* d_in, const int* in_sizes, int n_in, void* d_out, int out_size, void* d_ws, size_t ws_size, hipStream_t stream) {
    static int grid = 0;
    if (grid == 0) {
        if (n_in != 37 || in_sizes[0] != T * D || out_size != T * D || ws_size < WS_END) { fprintf(stderr, "kernel_launch: unexpected shapes (n_in %d, in0 %d, out %d, ws %zu < %zu); nothing launched\n", n_in, n_in > 0 ? in_sizes[0] : -1, out_size, ws_size, (size_t)WS_END); grid = -1; return; }
        int dev = 0, cus = 0, per_cu = 0;
        if (hipGetDevice(&dev) != hipSuccess || hipDeviceGetAttribute(&cus, hipDeviceAttributeMultiprocessorCount, dev) != hipSuccess) { grid = -1; return; }
        if (hipFuncSetAttribute((const void*)trunk_fwd, hipFuncAttributeMaxDynamicSharedMemorySize, LDS_BYTES) != hipSuccess) { fprintf(stderr, "kernel_launch: hipFuncSetAttribute failed\n"); grid = -1; return; }
        if (hipOccupancyMaxActiveBlocksPerMultiprocessor(&per_cu, (const void*)trunk_fwd, NWAVES * 64, LDS_BYTES) != hipSuccess || per_cu < 1) { fprintf(stderr, "kernel_launch: occupancy query says %d\n", per_cu); }
        (void)hipGetLastError();
        grid = cus;
        if (grid != 256) { fprintf(stderr, "kernel_launch: built for 256 CUs, found %d; nothing launched\n", cus); grid = -1; return; }
    }
    if (grid < 0) return;
    if (hipMemsetAsync((char*)d_ws + WS_CTL, 0, CTL_ZERO_BYTES, stream) != hipSuccess) return;
    Args a{};
    for (int i = 0; i < 37; ++i) a.in[i] = (const float*)d_in[i];
    a.out = (float*)d_out; a.ws = (unsigned char*)d_ws; a.pad = 0;
#if MK_ONE_LAUNCH
    a.ph_lo = 0; a.ph_hi = N_PHASES; a.use_bar = 1;
    hipLaunchKernelGGL(trunk_fwd, dim3(grid), dim3(NWAVES * 64), LDS_BYTES, stream, a);
#else
    for (int p = 0; p < N_PHASES; ++p) { a.ph_lo = p; a.ph_hi = p + 1; a.use_bar = 0; hipLaunchKernelGGL(trunk_fwd, dim3(grid), dim3(NWAVES * 64), LDS_BYTES, stream, a); }
#endif
}
```

```cpp
#include <hip/hip_runtime.h>
#include <cstdio>
#include <cstdint>
namespace pg8 {
#define PG8_LAS __attribute__((address_space(3)))
typedef unsigned short bf16_t;
typedef short bf16x8 __attribute__((ext_vector_type(8)));
typedef float f32x4 __attribute__((ext_vector_type(4)));
typedef unsigned u32x4 __attribute__((ext_vector_type(4)));
constexpr int BM = 256, BK = 64, HALF = 128, HTB = HALF * BK * 2  , STAGE_BYTES = 8 * HTB, NXCD = 8, WGM = 8;

__host__ __device__ __forceinline__ int lds_byte(int r, int c) { const int st = (r >> 4) * 2 + (c >> 5), rr = r & 15, cc = c & 31, ob = rr * 64 + cc * 2; return st * 1024 + (ob ^ (((ob >> 9) & 1) << 5)); }
__host__ __device__ __forceinline__ void stage_rc(int b, int& R, int& C) { const int st = b / 1024, sb = b % 1024, swz = sb ^ (((sb >> 9) & 1) << 5); R = (st >> 1) * 16 + swz / 64; C = (st & 1) * 32 + (swz % 64) / 2; }
__host__ __device__ __forceinline__ int perm32(int rho) { const int n = rho >> 4, i = rho & 15; return 8 * (i >> 2) + 4 * n + (i & 3); }

struct Unit { int pm, pn; };
struct Gemm { const bf16_t* A; const bf16_t* Bt; int M, N, K; };

struct StaticOrder {
    int nM, nN, nwg, G, c;
    __host__ __device__ void init(int M, int N, int G_, int c_) { nM = M / BM; nN = N / BM; nwg = nM * nN; G = G_; c = c_; }
    __host__ __device__ bool next(int i, Unit& u) const {
        const long L = (long)i * G + c; if (L >= nwg) return false;
        int wgid = (int)L; { const int q = nwg / NXCD, r = nwg % NXCD, xcd = wgid % NXCD, off = wgid / NXCD; wgid = (xcd < r ? xcd * (q + 1) : r * (q + 1) + (xcd - r) * q) + off; }
        const int nig = WGM * nN, gid = wgid / nig, fm = gid * WGM, gsz = (nM - fm) < WGM ? (nM - fm) : WGM;
        u.pm = fm + ((wgid % nig) % gsz); u.pn = (wgid % nig) / gsz; return true;
    }
    __device__ __forceinline__ void a_ready(const Unit&) const {}
    __device__ __forceinline__ void done(const Unit&) const {}
};

__device__ __forceinline__ unsigned cvt_pk_bf16(float lo, float hi) { unsigned r; asm volatile("v_cvt_pk_bf16_f32 %0, %1, %2" : "=v"(r) : "v"(lo), "v"(hi)); return r; }
typedef float f32x2 __attribute__((ext_vector_type(2)));
__device__ __forceinline__ f32x2 gelu_pk(f32x2 v) {
    const f32x2 av = __builtin_elementwise_abs(v), d = av * 0.2316418882f + 1.0f;
    f32x2 t; t.x = __builtin_amdgcn_rcpf(d.x); t.y = __builtin_amdgcn_rcpf(d.y);
    f32x2 q = t * 0.5307027145f + (-0.7265760135f); q = q * t + 0.7107068705f; q = q * t + (-0.142248368f); q = q * t + 0.127414796f; q = q * t;
    const f32x2 s = (v * v) * (-0.72134752044f);
    f32x2 e; e.x = __builtin_amdgcn_exp2f(s.x); e.y = __builtin_amdgcn_exp2f(s.y);
    const f32x2 m = v * (q * e), r = v - m;
    f32x2 o; o.x = v.x < 0.f ? m.x : r.x; o.y = v.y < 0.f ? m.y : r.y; return o;
}

template <class Epi, class Sched, bool ALIGN_EPI = false, bool SP2 = false>
__device__ __forceinline__ void gemm_phase(PG8_LAS unsigned char* lds, const Gemm g, const Sched& S, const Epi& E) {
    const int tid = threadIdx.x, wid = __builtin_amdgcn_readfirstlane(tid >> 6), lane = tid & 63, wr = wid >> 2, wc = wid & 3, fr = lane & 15, fq = lane >> 4;
    const int K = g.K, nt = K / BK;
    unsigned voffA[2], voffB[2];
#pragma unroll
    for (int i = 0; i < 2; ++i) { int R, C; stage_rc(tid * 16 + i * 8192, R, C); const int Rb = Epi::PERM ? ((R & ~31) + perm32(R & 31)) : R;
        voffA[i] = (unsigned)(R * K + C) * 2u; voffB[i] = (unsigned)(Rb * K + C) * 2u; }
    const size_t kstep = (size_t)(BK * 2);
    const size_t hstep = (size_t)HALF * K * 2;
    const size_t tstep = 2 * hstep;
    const unsigned ldsw = (unsigned)wid * 1024u;
    const int aoff = lds_byte(wr * 64 + fr, fq * 8), boff = lds_byte(wc * 32 + fr, fq * 8);
#define PG8_SA(b, h) (((b) * 2 + (h)) * HTB)
#define PG8_SB(b, h) ((4 + (b) * 2 + (h)) * HTB)
#define PG8_STAGE(bufoff, gbase, voff) do { _Pragma("unroll") for (int _i = 0; _i < 2; ++_i) \
        __builtin_amdgcn_global_load_lds((const unsigned*)((const char*)(gbase) + (voff)[_i]), (PG8_LAS unsigned*)(lds + (bufoff) + ldsw + _i * 8192), 16, 0, 0); } while (0)
#define PG8_LDA(dst, b, h) do { _Pragma("unroll") for (int m = 0; m < 4; ++m) _Pragma("unroll") for (int k = 0; k < 2; ++k) dst[m][k] = *(const PG8_LAS bf16x8*)(lds + PG8_SA(b, h) + aoff + m * 2048 + k * 1024); } while (0)
#define PG8_LDB(dst, b, h) do { _Pragma("unroll") for (int n = 0; n < 2; ++n) _Pragma("unroll") for (int k = 0; k < 2; ++k) dst[n][k] = *(const PG8_LAS bf16x8*)(lds + PG8_SB(b, h) + boff + n * 2048 + k * 1024); } while (0)
#define PG8_MMA(ai, bj, At, Bt) do { __builtin_amdgcn_s_setprio(1); _Pragma("unroll") for (int m = 0; m < 4; ++m) _Pragma("unroll") for (int n = 0; n < 2; ++n) _Pragma("unroll") for (int k = 0; k < 2; ++k) \
        acc[ai][bj][m][n] = __builtin_amdgcn_mfma_f32_16x16x32_bf16(Bt[n][k], At[m][k], acc[ai][bj][m][n], 0, 0, 0); __builtin_amdgcn_s_setprio(0); } while (0)
#define PG8_WAIT_V(n) asm volatile("s_waitcnt vmcnt(" #n ")" ::: "memory")
#define PG8_WAIT_L(n) asm volatile("s_waitcnt lgkmcnt(" #n ")" ::: "memory")
#define PG8_BAR __builtin_amdgcn_s_barrier()
#define PG8_SCHED __builtin_amdgcn_sched_barrier(0)
    Unit cur, nxt; int ui = 0;
    if (!S.next(0, cur)) return;
    f32x4 acc[2][2][4][2];
#pragma unroll
    for (int a = 0; a < 2; ++a)
#pragma unroll
        for (int b = 0; b < 2; ++b)
#pragma unroll
            for (int m = 0; m < 4; ++m)
#pragma unroll
                for (int n = 0; n < 2; ++n) acc[a][b][m][n] = (f32x4){0.f, 0.f, 0.f, 0.f};
    bf16x8 At[4][2], B0[2][2], B1[2][2];
    const char* cA = (const char*)g.A + (size_t)cur.pm * tstep; const char* cB = (const char*)g.Bt + (size_t)cur.pn * tstep;
    S.a_ready(cur);
    if constexpr (SP2) {
        PG8_STAGE(PG8_SB(0, 0), cB, voffB); PG8_STAGE(PG8_SB(0, 1), cB + hstep, voffB); PG8_STAGE(PG8_SA(0, 0), cA, voffA); PG8_STAGE(PG8_SA(0, 1), cA + hstep, voffA);
        if (wr == 1) PG8_BAR;
        PG8_WAIT_V(2); PG8_BAR;
        PG8_STAGE(PG8_SB(1, 0), cB + kstep, voffB); PG8_STAGE(PG8_SA(1, 0), cA + kstep, voffA); PG8_STAGE(PG8_SB(1, 1), cB + hstep + kstep, voffB);
        PG8_WAIT_V(6); PG8_BAR;
    } else {
        PG8_STAGE(PG8_SB(0, 0), cB, voffB); PG8_STAGE(PG8_SA(0, 0), cA, voffA); PG8_STAGE(PG8_SB(0, 1), cB + hstep, voffB); PG8_STAGE(PG8_SA(0, 1), cA + hstep, voffA);
        if (wr == 1) PG8_BAR;
        PG8_WAIT_V(4); PG8_BAR;
        PG8_STAGE(PG8_SB(1, 0), cB + kstep, voffB); PG8_STAGE(PG8_SA(1, 0), cA + kstep, voffA); PG8_STAGE(PG8_SB(1, 1), cB + hstep + kstep, voffB);
        PG8_WAIT_V(6); PG8_BAR;
    }
    for (;;) {
        const bool has_next = S.next(ui + 1, nxt);
        const char* nA = has_next ? (const char*)g.A + (size_t)nxt.pm * tstep : cA; const char* nB = has_next ? (const char*)g.Bt + (size_t)nxt.pn * tstep : cB;
        for (int t = 0; t < nt; t += 2) {
            const bool last = (t == nt - 2);
            const char* a1 = cA + (size_t)(t + 1) * kstep;
            const char* a2 = last ? nA : cA + (size_t)(t + 2) * kstep; const char* b2 = last ? nB : cB + (size_t)(t + 2) * kstep;
            const char* a3 = a2 + kstep; const char* b3 = b2 + kstep;
            if (last && has_next) S.a_ready(nxt);
            if constexpr (SP2) {
            PG8_LDB(B0, 0, 0); PG8_LDB(B1, 0, 1); PG8_SCHED; PG8_LDA(At, 0, 0); PG8_STAGE(PG8_SA(1, 1), a1 + hstep, voffA);
            PG8_WAIT_V(8); PG8_WAIT_L(0); PG8_BAR; PG8_MMA(0, 0, At, B0); PG8_MMA(0, 1, At, B1); PG8_BAR; PG8_SCHED;
            PG8_LDA(At, 0, 1); PG8_STAGE(PG8_SB(0, 0), b2, voffB); PG8_STAGE(PG8_SB(0, 1), b2 + hstep, voffB); PG8_STAGE(PG8_SA(0, 0), a2, voffA);
            PG8_WAIT_V(8); PG8_WAIT_L(0); PG8_BAR; PG8_MMA(1, 0, At, B0); PG8_MMA(1, 1, At, B1); PG8_BAR; PG8_SCHED;
            PG8_LDB(B0, 1, 0); PG8_LDB(B1, 1, 1); PG8_SCHED; PG8_LDA(At, 1, 0); PG8_STAGE(PG8_SA(0, 1), a2 + hstep, voffA);
            PG8_WAIT_V(8); PG8_WAIT_L(0); PG8_BAR; PG8_MMA(0, 0, At, B0); PG8_MMA(0, 1, At, B1); PG8_BAR; PG8_SCHED;
            PG8_LDA(At, 1, 1); PG8_STAGE(PG8_SB(1, 0), b3, voffB); PG8_STAGE(PG8_SB(1, 1), b3 + hstep, voffB); PG8_STAGE(PG8_SA(1, 0), a3, voffA);
            PG8_WAIT_V(8); PG8_WAIT_L(0); PG8_BAR; PG8_MMA(1, 0, At, B0); PG8_MMA(1, 1, At, B1); PG8_BAR; PG8_SCHED;
            } else {
            PG8_LDB(B0, 0, 0); PG8_SCHED; PG8_LDA(At, 0, 0); PG8_STAGE(PG8_SA(1, 1), a1 + hstep, voffA);
            PG8_WAIT_L(8); PG8_BAR; PG8_WAIT_L(0); PG8_MMA(0, 0, At, B0); PG8_BAR; PG8_SCHED;
            PG8_LDB(B1, 0, 1); PG8_STAGE(PG8_SB(0, 0), b2, voffB);
            PG8_BAR; PG8_WAIT_L(0); PG8_MMA(0, 1, At, B1); PG8_BAR;
            PG8_LDA(At, 0, 1); PG8_STAGE(PG8_SA(0, 0), a2, voffA);
            PG8_BAR; PG8_WAIT_L(0); PG8_MMA(1, 0, At, B0); PG8_BAR; PG8_SCHED;
            PG8_STAGE(PG8_SB(0, 1), b2 + hstep, voffB);
            PG8_WAIT_V(6); PG8_BAR; PG8_MMA(1, 1, At, B1); PG8_BAR;
            PG8_LDB(B0, 1, 0); PG8_SCHED; PG8_LDA(At, 1, 0); PG8_STAGE(PG8_SA(0, 1), a2 + hstep, voffA);
            PG8_WAIT_L(8); PG8_BAR; PG8_WAIT_L(0); PG8_MMA(0, 0, At, B0); PG8_BAR; PG8_SCHED;
            PG8_LDB(B1, 1, 1); PG8_STAGE(PG8_SB(1, 0), b3, voffB);
            PG8_BAR; PG8_WAIT_L(0); PG8_MMA(0, 1, At, B1); PG8_BAR;
            PG8_LDA(At, 1, 1); PG8_STAGE(PG8_SA(1, 0), a3, voffA);
            PG8_BAR; PG8_WAIT_L(0); PG8_MMA(1, 0, At, B0); PG8_BAR; PG8_SCHED;
            PG8_STAGE(PG8_SB(1, 1), b3 + hstep, voffB);
            PG8_WAIT_V(6); PG8_BAR; PG8_MMA(1, 1, At, B1); PG8_BAR;
            }
        }
        if constexpr (ALIGN_EPI) { if (wr == 0) PG8_BAR; }
        if constexpr (!Epi::AFTER_DRAIN) { E(acc, cur, wr, wc, fr, fq); S.done(cur); }
        if (!has_next) break;
#pragma unroll
        for (int a = 0; a < 2; ++a)
#pragma unroll
            for (int b = 0; b < 2; ++b)
#pragma unroll
                for (int m = 0; m < 4; ++m)
#pragma unroll
                    for (int n = 0; n < 2; ++n) acc[a][b][m][n] = (f32x4){0.f, 0.f, 0.f, 0.f};
        cur = nxt; cA = nA; cB = nB; ++ui;
        if constexpr (ALIGN_EPI) { if (wr == 1) PG8_BAR; }
    }
    PG8_WAIT_V(0);
    if constexpr (!ALIGN_EPI) { if (wr == 0) PG8_BAR; }
    PG8_BAR;
    if constexpr (Epi::AFTER_DRAIN) { E.fused(acc, cur, wr, wc, fr, fq, lds, wid, lane); S.done(cur); }
#undef PG8_SA
#undef PG8_SB
#undef PG8_STAGE
#undef PG8_LDA
#undef PG8_LDB
#undef PG8_MMA
#undef PG8_WAIT_V
#undef PG8_WAIT_L
#undef PG8_BAR
#undef PG8_SCHED
}
}
namespace pg8 {
__device__ __forceinline__ float sigmoidf_(float x) { return __builtin_amdgcn_rcpf(1.0f + __builtin_amdgcn_exp2f(-1.4426950408889634f * x)); }
struct EpiBf16Split {
    static constexpr bool PERM = true, AFTER_DRAIN = false;
    bf16_t* O0; int ld0; int nt0; bf16_t* O1; int ld1;
    __device__ __forceinline__ void operator()(const f32x4 (&acc)[2][2][4][2], const Unit& u, int wr, int wc, int fr, int fq) const {
        const bool first = u.pn < nt0; bf16_t* base = first ? O0 : O1; const int ld = first ? ld0 : ld1; const int colt = (first ? u.pn : u.pn - nt0) * BM;
        const int row0 = u.pm * BM + wr * 64 + fr, col0 = colt + wc * 32 + 8 * fq;
#pragma unroll
        for (int ai = 0; ai < 2; ++ai)
#pragma unroll
            for (int m = 0; m < 4; ++m) { bf16_t* rowp = base + (size_t)(row0 + ai * HALF + m * 16) * ld + col0;
#pragma unroll
                for (int bj = 0; bj < 2; ++bj) { const f32x4 v0 = acc[ai][bj][m][0], v1 = acc[ai][bj][m][1];
                    u32x4 w; w.x = cvt_pk_bf16(v0[0], v0[1]); w.y = cvt_pk_bf16(v0[2], v0[3]); w.z = cvt_pk_bf16(v1[0], v1[1]); w.w = cvt_pk_bf16(v1[2], v1[3]);
                    *(u32x4*)(rowp + bj * HALF) = w; } }
    }
};
struct EpiResF32 {
    static constexpr bool PERM = false, AFTER_DRAIN = false;
    const float* base; float* out; int ldc;
    __device__ __forceinline__ void operator()(const f32x4 (&acc)[2][2][4][2], const Unit& u, int wr, int wc, int fr, int fq) const {
        const int row0 = u.pm * BM + wr * 64 + fr, col0 = u.pn * BM + wc * 32 + 4 * fq;
#pragma unroll
        for (int ai = 0; ai < 2; ++ai)
#pragma unroll
            for (int m = 0; m < 4; ++m) { const size_t off = (size_t)(row0 + ai * HALF + m * 16) * ldc + col0;
#pragma unroll
                for (int bj = 0; bj < 2; ++bj)
#pragma unroll
                    for (int n = 0; n < 2; ++n) { const f32x4 b = *(const f32x4*)(base + off + bj * HALF + n * 16); *(f32x4*)(out + off + bj * HALF + n * 16) = b + acc[ai][bj][m][n]; } }
    }
};
struct EpiSwiglu {
    static constexpr bool PERM = false, AFTER_DRAIN = false;
    bf16_t* H; int ldh;
    __device__ __forceinline__ void operator()(const f32x4 (&acc)[2][2][4][2], const Unit& u, int wr, int wc, int fr, int fq) const {
        const int row0 = u.pm * BM + wr * 64 + fr, hc0 = u.pn * (BM / 2) + wc * 16 + 4 * fq;
#pragma unroll
        for (int ai = 0; ai < 2; ++ai)
#pragma unroll
            for (int m = 0; m < 4; ++m) { bf16_t* rowp = H + (size_t)(row0 + ai * HALF + m * 16) * ldh + hc0;
#pragma unroll
                for (int bj = 0; bj < 2; ++bj) { const f32x4 g = acc[ai][bj][m][0], up = acc[ai][bj][m][1]; float h[4];
#pragma unroll
                    for (int i = 0; i < 4; ++i) h[i] = g[i] * sigmoidf_(g[i]) * up[i];
                    typedef unsigned u32x2 __attribute__((ext_vector_type(2)));
                    u32x2 w; w.x = cvt_pk_bf16(h[0], h[1]); w.y = cvt_pk_bf16(h[2], h[3]);
                    *(u32x2*)(rowp + bj * (HALF / 2)) = w; } }
    }
};
struct EpiPle {
    static constexpr bool PERM = false, AFTER_DRAIN = false;
    const float* base; float* out; const bf16_t* E; int ldc;
    __device__ __forceinline__ void operator()(const f32x4 (&acc)[2][2][4][2], const Unit& u, int wr, int wc, int fr, int fq) const {
        const int row0 = u.pm * BM + wr * 64 + fr, col0 = u.pn * BM + wc * 32 + 4 * fq;
        typedef unsigned u32x2 __attribute__((ext_vector_type(2)));
#pragma unroll
        for (int ai = 0; ai < 2; ++ai)
#pragma unroll
            for (int m = 0; m < 4; ++m) { const size_t off = (size_t)(row0 + ai * HALF + m * 16) * ldc + col0;
#pragma unroll
                for (int bj = 0; bj < 2; ++bj)
#pragma unroll
                    for (int n = 0; n < 2; ++n) { const size_t o = off + bj * HALF + n * 16; const f32x4 b = *(const f32x4*)(base + o); const u32x2 e = *(const u32x2*)(E + o); const f32x4 a = acc[ai][bj][m][n];
                        f32x4 r; r[0] = b[0] + __uint_as_float(e.x << 16) * sigmoidf_(a[0]); r[1] = b[1] + __uint_as_float(e.x & 0xffff0000u) * sigmoidf_(a[1]);
                        r[2] = b[2] + __uint_as_float(e.y << 16) * sigmoidf_(a[2]); r[3] = b[3] + __uint_as_float(e.y & 0xffff0000u) * sigmoidf_(a[3]);
                        *(f32x4*)(out + o) = r; } }
    }
};
__device__ __forceinline__ float rms_r(const float* rsq, int row) { const f32x4* p = (const f32x4*)(rsq + (size_t)row * 16); const f32x4 a = p[0], b = p[1], c = p[2], d = p[3];
    const float s = (((a[0] + a[1]) + (a[2] + a[3])) + ((b[0] + b[1]) + (b[2] + b[3]))) + (((c[0] + c[1]) + (c[2] + c[3])) + ((d[0] + d[1]) + (d[2] + d[3]))); return rsqrtf(s * (1.0f / 1024.0f) + 1e-6f); }
__device__ __forceinline__ void norm_out(const f32x4 (&x)[2][2], bf16_t* xb, size_t off, float* rsq_out, int row, int fq, int slot) {
    typedef unsigned u32x2 __attribute__((ext_vector_type(2))); float s = 0.f;
#pragma unroll
    for (int bj = 0; bj < 2; ++bj)
#pragma unroll
        for (int n = 0; n < 2; ++n) { const f32x4 v = x[bj][n]; s += (v[0] * v[0] + v[1] * v[1]) + (v[2] * v[2] + v[3] * v[3]); u32x2 w; w.x = cvt_pk_bf16(v[0], v[1]); w.y = cvt_pk_bf16(v[2], v[3]); *(u32x2*)(xb + off + bj * HALF + n * 16) = w; }
    s += __shfl_xor(s, 16); s += __shfl_xor(s, 32);
    if (fq == 0) rsq_out[(size_t)row * 16 + slot] = s;
}
struct EpiBf16SplitR {
    static constexpr bool PERM = true, AFTER_DRAIN = false;
    bf16_t* O0; int ld0; int nt0; bf16_t* O1; int ld1; const float* rsq;
    __device__ __forceinline__ void operator()(const f32x4 (&acc)[2][2][4][2], const Unit& u, int wr, int wc, int fr, int fq) const {
        const bool first = u.pn < nt0; bf16_t* base = first ? O0 : O1; const int ld = first ? ld0 : ld1; const int colt = (first ? u.pn : u.pn - nt0) * BM;
        const int row0 = u.pm * BM + wr * 64 + fr, col0 = colt + wc * 32 + 8 * fq;
#pragma unroll
        for (int ai = 0; ai < 2; ++ai)
#pragma unroll
            for (int m = 0; m < 4; ++m) { const int row = row0 + ai * HALF + m * 16; const float r = rms_r(rsq, row); bf16_t* rowp = base + (size_t)row * ld + col0;
#pragma unroll
                for (int bj = 0; bj < 2; ++bj) { const f32x4 v0 = acc[ai][bj][m][0] * r, v1 = acc[ai][bj][m][1] * r;
                    u32x4 w; w.x = cvt_pk_bf16(v0[0], v0[1]); w.y = cvt_pk_bf16(v0[2], v0[3]); w.z = cvt_pk_bf16(v1[0], v1[1]); w.w = cvt_pk_bf16(v1[2], v1[3]);
                    *(u32x4*)(rowp + bj * HALF) = w; } }
    }
};
struct EpiSwigluR {
    static constexpr bool PERM = false, AFTER_DRAIN = false;
    bf16_t* H; int ldh; const float* rsq;
    __device__ __forceinline__ void operator()(const f32x4 (&acc)[2][2][4][2], const Unit& u, int wr, int wc, int fr, int fq) const {
        const int row0 = u.pm * BM + wr * 64 + fr, hc0 = u.pn * (BM / 2) + wc * 16 + 4 * fq;
#pragma unroll
        for (int ai = 0; ai < 2; ++ai)
#pragma unroll
            for (int m = 0; m < 4; ++m) { const int row = row0 + ai * HALF + m * 16; const float r = rms_r(rsq, row); bf16_t* rowp = H + (size_t)row * ldh + hc0;
#pragma unroll
                for (int bj = 0; bj < 2; ++bj) { const f32x4 g = acc[ai][bj][m][0] * r, up = acc[ai][bj][m][1] * r; float h[4];
#pragma unroll
                    for (int i = 0; i < 4; ++i) h[i] = g[i] * sigmoidf_(g[i]) * up[i];
                    typedef unsigned u32x2 __attribute__((ext_vector_type(2)));
                    u32x2 w; w.x = cvt_pk_bf16(h[0], h[1]); w.y = cvt_pk_bf16(h[2], h[3]);
                    *(u32x2*)(rowp + bj * (HALF / 2)) = w; } }
    }
};
struct EpiResN {
    static constexpr bool PERM = false, AFTER_DRAIN = false;
    const float* base; float* out; int ldc; bf16_t* XBo; float* rsq_out;
    __device__ __forceinline__ void operator()(const f32x4 (&acc)[2][2][4][2], const Unit& u, int wr, int wc, int fr, int fq) const {
        const int row0 = u.pm * BM + wr * 64 + fr, col0 = u.pn * BM + wc * 32 + 4 * fq;
#pragma unroll
        for (int ai = 0; ai < 2; ++ai)
#pragma unroll
            for (int m = 0; m < 4; ++m) { const int row = row0 + ai * HALF + m * 16; const size_t off = (size_t)row * ldc + col0; f32x4 x[2][2];
#pragma unroll
                for (int bj = 0; bj < 2; ++bj)
#pragma unroll
                    for (int n = 0; n < 2; ++n) { const f32x4 b = *(const f32x4*)(base + off + bj * HALF + n * 16); x[bj][n] = b + acc[ai][bj][m][n]; *(f32x4*)(out + off + bj * HALF + n * 16) = x[bj][n]; }
                if (XBo) norm_out(x, XBo, off, rsq_out, row, fq, u.pn * 4 + wc); }
    }
};
struct EpiPleN {
    static constexpr bool PERM = false, AFTER_DRAIN = false;
    const float* base; float* out; const bf16_t* E; int ldc; const float* rsq_in; bf16_t* XBo; float* rsq_out;
    __device__ __forceinline__ void operator()(const f32x4 (&acc)[2][2][4][2], const Unit& u, int wr, int wc, int fr, int fq) const {
        const int row0 = u.pm * BM + wr * 64 + fr, col0 = u.pn * BM + wc * 32 + 4 * fq;
        typedef unsigned u32x2 __attribute__((ext_vector_type(2)));
#pragma unroll
        for (int ai = 0; ai < 2; ++ai)
#pragma unroll
            for (int m = 0; m < 4; ++m) { const int row = row0 + ai * HALF + m * 16; const size_t off = (size_t)row * ldc + col0; const float r = rms_r(rsq_in, row); f32x4 x[2][2];
#pragma unroll
                for (int bj = 0; bj < 2; ++bj)
#pragma unroll
                    for (int n = 0; n < 2; ++n) { const size_t o = off + bj * HALF + n * 16; const f32x4 b = *(const f32x4*)(base + o); const u32x2 e = *(const u32x2*)(E + o); const f32x4 a = acc[ai][bj][m][n] * r;
                        f32x4 v; v[0] = b[0] + __uint_as_float(e.x << 16) * sigmoidf_(a[0]); v[1] = b[1] + __uint_as_float(e.x & 0xffff0000u) * sigmoidf_(a[1]);
                        v[2] = b[2] + __uint_as_float(e.y << 16) * sigmoidf_(a[2]); v[3] = b[3] + __uint_as_float(e.y & 0xffff0000u) * sigmoidf_(a[3]);
                        x[bj][n] = v; *(f32x4*)(out + o) = v; }
                if (XBo) norm_out(x, XBo, off, rsq_out, row, fq, u.pn * 4 + wc); }
    }
};
__device__ __forceinline__ f32x4 ld_base4(const float* p) { return *(const f32x4*)p; }
__device__ __forceinline__ f32x4 ld_base4(const bf16_t* p) { typedef unsigned u32x2 __attribute__((ext_vector_type(2))); const u32x2 e = *(const u32x2*)p; return (f32x4){__uint_as_float(e.x << 16), __uint_as_float(e.x & 0xffff0000u), __uint_as_float(e.y << 16), __uint_as_float(e.y & 0xffff0000u)}; }
template <class BaseT> struct EpiRes2 {
    static constexpr bool PERM = false, AFTER_DRAIN = false;
    const BaseT* base; bf16_t* out; int ldc; float* rsq_out;
    __device__ __forceinline__ void operator()(const f32x4 (&acc)[2][2][4][2], const Unit& u, int wr, int wc, int fr, int fq) const {
        const int row0 = u.pm * BM + wr * 64 + fr, col0 = u.pn * BM + wc * 32 + 4 * fq;
#pragma unroll
        for (int ai = 0; ai < 2; ++ai)
#pragma unroll
            for (int m = 0; m < 4; ++m) { const int row = row0 + ai * HALF + m * 16; const size_t off = (size_t)row * ldc + col0; f32x4 x[2][2];
#pragma unroll
                for (int bj = 0; bj < 2; ++bj)
#pragma unroll
                    for (int n = 0; n < 2; ++n) x[bj][n] = ld_base4(base + off + bj * HALF + n * 16) + acc[ai][bj][m][n];
                norm_out(x, out, off, rsq_out, row, fq, u.pn * 4 + wc); }
    }
};
template <bool OUT_F32> struct EpiPle2 {
    static constexpr bool PERM = false, AFTER_DRAIN = false;
    const bf16_t* base; void* out; const bf16_t* E; int ldc; const float* rsq_in; float* rsq_out;
    __device__ __forceinline__ void operator()(const f32x4 (&acc)[2][2][4][2], const Unit& u, int wr, int wc, int fr, int fq) const {
        const int row0 = u.pm * BM + wr * 64 + fr, col0 = u.pn * BM + wc * 32 + 4 * fq;
#pragma unroll
        for (int ai = 0; ai < 2; ++ai)
#pragma unroll
            for (int m = 0; m < 4; ++m) { const int row = row0 + ai * HALF + m * 16; const size_t off = (size_t)row * ldc + col0; const float r = rms_r(rsq_in, row); f32x4 x[2][2];
#pragma unroll
                for (int bj = 0; bj < 2; ++bj)
#pragma unroll
                    for (int n = 0; n < 2; ++n) { const size_t o = off + bj * HALF + n * 16; const f32x4 b = ld_base4(base + o), e = ld_base4(E + o), a = acc[ai][bj][m][n] * r; f32x4 v;
#pragma unroll
                        for (int i = 0; i < 4; ++i) v[i] = b[i] + e[i] * sigmoidf_(a[i]);
                        x[bj][n] = v; if (OUT_F32) *(f32x4*)((float*)out + o) = v; }
                if (!OUT_F32) norm_out(x, (bf16_t*)out, off, rsq_out, row, fq, u.pn * 4 + wc); }
    }
};
}
#ifndef PG8_SP2
#define PG8_SP2 true
#endif
#ifndef PG8_ALIGN
#define PG8_ALIGN true
#endif
constexpr int NB = 32, SEQ = 2048, T = NB * SEQ, D = 1024;
constexpr int NU = 2816, UA_W = 1024, UB_W = 1792;
constexpr int FF = 2816, CI = 2048, TH = T / 2;
constexpr int NWAVES = 8;
constexpr float NORM_EPS = 1e-6f, LOG2E = 1.4426950408889634f;
constexpr int UA_K = 512, UA_V = 576, UA_IQ = 640, UA_IK = 896, UA_IW = 960;
constexpr size_t MiB = 1u << 20, QMiB = 1u << 18;
constexpr size_t WS_CTL = 0, CTL_ZERO_BYTES = 1 * MiB;
constexpr size_t WS_WIN = 4 * QMiB, WS_WLORA = 26 * QMiB, WS_WOUT = 29 * QMiB;
constexpr size_t WS_WGU0 = 37 * QMiB, WS_WD0 = 81 * QMiB, WS_WPLE0 = 103 * QMiB, WS_WPG0 = 105 * QMiB, WS_LAYER_STRIDE = 76 * QMiB;
constexpr size_t WS_WUP = 189 * QMiB, WS_WDOWN = 221 * QMiB, WS_W12 = 237 * QMiB;
static_assert(WS_WPG0 + 8 * QMiB == WS_WGU0 + WS_LAYER_STRIDE && WS_WPG0 + WS_LAYER_STRIDE + 8 * QMiB == WS_WUP && WS_W12 + QMiB <= 60 * MiB, "weight map");
constexpr size_t ACT = 60 * MiB;
constexpr size_t WS_XB = ACT, WS_UA = ACT + 128 * MiB, WS_UB = ACT + 256 * MiB, WS_LIN = ACT + 480 * MiB, WS_LOUT = ACT + 512 * MiB;
constexpr size_t WS_QN = ACT + 704 * MiB, WS_KN = ACT + 768 * MiB, WS_VT = ACT + 776 * MiB, WS_MASK = ACT + 784 * MiB;
constexpr size_t WS_XB2 = ACT + 768 * MiB;
constexpr size_t WS_H = ACT + 128 * MiB, WS_E = ACT + 480 * MiB, WS_PB = ACT + 896 * MiB;
constexpr size_t WS_XM = ACT, WS_Z = ACT + 128 * MiB, WS_XC = ACT + 256 * MiB, WS_Q = ACT + 384 * MiB, WS_K = ACT + 512 * MiB, WS_V = ACT + 640 * MiB;
constexpr size_t WS_RS = ACT + 928 * MiB, RS_ONE = (size_t)T * 16 * 4;
constexpr size_t WS_GI = ACT + 952 * MiB, WS_GA = WS_GI + 1 * MiB, WS_GAM = WS_GI + 2 * MiB, WS_GEM = WS_GI + 3 * MiB;
constexpr size_t WS_END = ACT + 956 * MiB;
static_assert(WS_END <= 1024 * MiB, "workspace");
constexpr int CW_TMO = 0, CW_BAR = 4096, CW_XRANK = 8192;
constexpr int LDS_BYTES = 155648;
constexpr int MISC_OFF = LDS_BYTES - 256;
#define GAS __attribute__((address_space(1)))
#define LAS __attribute__((address_space(3)))
typedef unsigned short bf16;
typedef unsigned v4u __attribute__((ext_vector_type(4)));
typedef unsigned v2u __attribute__((ext_vector_type(2)));
typedef float f32x4 __attribute__((ext_vector_type(4)));
typedef float f32x2 __attribute__((ext_vector_type(2)));
typedef float f32x8 __attribute__((ext_vector_type(8)));
typedef short bf16x8 __attribute__((ext_vector_type(8)));
typedef short s16x4 __attribute__((ext_vector_type(4)));
typedef GAS unsigned gu32;
#define RLX_AGENT __ATOMIC_RELAXED, __HIP_MEMORY_SCOPE_AGENT
#define LDS_WAIT() asm volatile("s_waitcnt lgkmcnt(0)" ::: "memory")
#define VM_WAIT() asm volatile("s_waitcnt vmcnt(0)" ::: "memory")
__device__ __forceinline__ unsigned f2bf(float f) { unsigned u = __builtin_bit_cast(unsigned, f); return (u + 0x7fffu + ((u >> 16) & 1u)) >> 16; }

#define XB_TMO      128
#define XB_XCNT(j)  (256  + 64 * (j))
#define XB_XSUB(j)  (1280 + 64 * (j))
#define XB_XGEN(j)  (2304 + 64 * (j))
#define XB_TOP      3328
#define XB_TOPGEN   3392
#define XCD_BAR_WORDS 3456
#define XB_SPIN_CAP (1u << 18)

__device__ __forceinline__ unsigned xb_ld(unsigned* p)              { return __hip_atomic_load(p, __ATOMIC_RELAXED, __HIP_MEMORY_SCOPE_AGENT); }
__device__ __forceinline__ unsigned xb_add(unsigned* p, unsigned v) { return __hip_atomic_fetch_add(p, v, __ATOMIC_RELAXED, __HIP_MEMORY_SCOPE_AGENT); }
__device__ __forceinline__ unsigned xb_xcc_id() { return (unsigned)__builtin_amdgcn_s_getreg((3 << 11) | 20) & 0xFu; }
#define XB_SPIN(cond, bar) do { unsigned _sp = 0; while (cond) { __builtin_amdgcn_s_sleep(1); \
    if ((++_sp & 255u) == 0u) { if (xb_ld(&(bar)[XB_TMO])) break; if (_sp > XB_SPIN_CAP) { atomicAdd(&(bar)[XB_TMO], 1u); break; } } } } while (0)

struct XcdBarrier {
    unsigned* bar; unsigned x;
    volatile LAS unsigned* st;
};

__device__ __forceinline__ XcdBarrier xcd_barrier_post(unsigned* bar, volatile LAS unsigned* st) {
    XcdBarrier b; b.bar = bar; b.x = xb_xcc_id(); b.st = st;
    if (threadIdx.x == 0) (void)xb_add(&bar[XB_XCNT(b.x)], 1u);
    return b;
}
__device__ __forceinline__ void xcd_barrier_complete(unsigned* bar, unsigned x, unsigned& nloc, unsigned& nx) {
    const unsigned G = gridDim.x * gridDim.y * gridDim.z;
    unsigned sum, cnt, mine, sp = 0u;
    for (;;) {
        sum = 0u; cnt = 0u; mine = 0u;
#pragma unroll
        for (unsigned j = 0; j < 16; ++j) { const unsigned c = xb_ld(&bar[XB_XCNT(j)]); sum += c; cnt += (c > 0u) ? 1u : 0u; mine = (j == x) ? c : mine; }
        if (sum == G) break;
        __builtin_amdgcn_s_sleep(1);
        if ((++sp & 255u) == 0u) { if (xb_ld(&bar[XB_TMO])) break; if (sp > XB_SPIN_CAP) { atomicAdd(&bar[XB_TMO], 1u); break; } }
    }
    nloc = mine > 0u ? mine : 1u; nx = cnt > 0u ? cnt : 1u;
}

__device__ __forceinline__ void xcd_barrier(const XcdBarrier& b) {
    asm volatile("s_waitcnt vmcnt(0)" ::: "memory");
    __syncthreads();
    if (threadIdx.x == 0) {
        unsigned* bar = b.bar;
        __builtin_amdgcn_s_waitcnt(0);
        unsigned nloc = b.st[0], nx = b.st[1];
        if (nloc == 0u) { xcd_barrier_complete(bar, b.x, nloc, nx); b.st[0] = nloc; b.st[1] = nx; }
        const unsigned old = xb_add(&bar[XB_XSUB(b.x)], 1u);
        const unsigned gen = old / nloc;
        if (old + 1u == (gen + 1u) * nloc) {
            __builtin_amdgcn_fence(__ATOMIC_RELEASE, "agent");
            asm volatile("s_waitcnt vmcnt(0)" ::: "memory");
            const unsigned og = xb_add(&bar[XB_TOP], 1u);
            const unsigned tg = og / nx;
            if (og + 1u == (tg + 1u) * nx) xb_add(&bar[XB_TOPGEN], 1u);
            else XB_SPIN(xb_ld(&bar[XB_TOPGEN]) == tg, bar);
            __builtin_amdgcn_fence(__ATOMIC_ACQUIRE, "agent");
            xb_add(&bar[XB_XGEN(b.x)], 1u);
            asm volatile("s_waitcnt vmcnt(0)" ::: "memory");
        } else {
            XB_SPIN(xb_ld(&bar[XB_XGEN(b.x)]) == gen, bar);
            __builtin_amdgcn_fence(__ATOMIC_ACQUIRE, "agent");
            asm volatile("s_waitcnt vmcnt(0)" ::: "memory");
        }
    }
    __syncthreads();
}

struct Frame {
    LAS unsigned char* lds;
    unsigned char* ws;
    const float* const* in;
    int tid, lane, wave, G, bid;
};
struct Args { const float* in[37]; float* out; unsigned char* ws; int ph_lo, ph_hi, use_bar, pad; };

__device__ __forceinline__ float dpp_f(float v, int ctrl_qp1) { return v; }
#define DPP_MOVF(v, ctrl) __builtin_bit_cast(float, __builtin_amdgcn_mov_dpp(__builtin_bit_cast(int, (v)), (ctrl), 0xf, 0xf, true))
__device__ __forceinline__ float wave_sum(float v) {
    v += DPP_MOVF(v, 0xB1);
    v += DPP_MOVF(v, 0x4E);
    v += DPP_MOVF(v, 0x141);
    v += DPP_MOVF(v, 0x140);
    v += __shfl_xor(v, 16); v += __shfl_xor(v, 32);
    return v;
}
__device__ __forceinline__ float wave_max(float v) {
#pragma unroll
    for (int o = 1; o < 64; o <<= 1) v = fmaxf(v, __shfl_xor(v, o));
    return v;
}
__device__ __forceinline__ float bflo(unsigned u) { return __uint_as_float(u << 16); }
__device__ __forceinline__ float bfhi(unsigned u) { return __uint_as_float(u & 0xffff0000u); }
__device__ __forceinline__ float bf1(bf16 h) { return __uint_as_float(((unsigned)h) << 16); }
__device__ __forceinline__ unsigned pk2(float lo, float hi) { return pg8::cvt_pk_bf16(lo, hi); }
__device__ __forceinline__ float sigm(float x) { return __builtin_amdgcn_rcpf(1.0f + __builtin_amdgcn_exp2f(-LOG2E * x)); }
__device__ __forceinline__ float softplusf_(float x) { return fmaxf(x, 0.f) + log1pf(__expf(-fabsf(x))); }
__device__ __forceinline__ void unpack8(const v4u& r, float (&f)[8]) { f[0] = bflo(r.x); f[1] = bfhi(r.x); f[2] = bflo(r.y); f[3] = bfhi(r.y); f[4] = bflo(r.z); f[5] = bfhi(r.z); f[6] = bflo(r.w); f[7] = bfhi(r.w); }
__device__ __forceinline__ v4u pack8(const float (&f)[8]) { v4u o; o.x = pk2(f[0], f[1]); o.y = pk2(f[2], f[3]); o.z = pk2(f[4], f[5]); o.w = pk2(f[6], f[7]); return o; }

template <class Fn> __device__ __forceinline__ void wprep(bf16* dst, int N, int K, Fn f, int gt, int NT) {
    const int lane = gt & 63, gwv = gt >> 6, NW = NT >> 6, ntn = N >> 3, tiles = ntn * (K >> 6);
    for (int tl = gwv; tl < tiles; tl += NW) { const int n = (tl % ntn) * 8 + (lane & 7), k0 = (tl / ntn) * 64 + (lane >> 3) * 8; float v[8];
#pragma unroll
        for (int j = 0; j < 8; ++j) v[j] = f(k0 + j, n);
        *(v4u*)(dst + (size_t)n * K + k0) = pack8(v); }
}
__device__ __forceinline__ void phase_prologue(Frame& F, const Args& a) {
    const int gt = F.bid * 512 + F.tid, NT = F.G * 512; unsigned char* ws = F.ws;
    { const float* W = a.in[5]; const float* gn0 = a.in[2];
      wprep((bf16*)(ws + WS_WIN), NU, D, [=](int k, int n) { const int c = n < 964 ? n : (n < 1024 ? -1 : n - 60); return c < 0 ? 0.f : W[(size_t)k * 2756 + c] * gn0[k]; }, gt, NT); }
    { const float* w2 = a.in[8]; const float* a2 = a.in[10]; const float* g2 = a.in[11];
      wprep((bf16*)(ws + WS_WLORA), 1536, 256, [=](int k, int n) { if (n < 512) return k < 64 ? w2[k * 512 + n] : 0.f; if (n < 1024) return (k >= 64 && k < 128) ? a2[(k - 64) * 512 + n - 512] : 0.f; return k >= 128 ? g2[(k - 128) * 512 + n - 1024] : 0.f; }, gt, NT); }
    { const float* W = a.in[17]; wprep((bf16*)(ws + WS_WOUT), D, D, [=](int k, int n) { return W[(size_t)k * D + n]; }, gt, NT); }
    for (int L = 0; L < 2; ++L) {
        const float* wg = a.in[31] + (size_t)L * D * FF; const float* wu = a.in[32] + (size_t)L * D * FF; const float* wd = a.in[33] + (size_t)L * FF * D;
        const float* wp = a.in[34] + (size_t)L * 256 * D; const float* wpg = a.in[36] + (size_t)L * D * D; const float* gnf = a.in[30] + L * D; const float* gnp = a.in[35] + L * D;
        wprep((bf16*)(ws + WS_WGU0 + L * WS_LAYER_STRIDE), 2 * FF, D, [=](int k, int n) { const int hid = 16 * (n >> 5) + (n & 15); return ((n & 31) >= 16 ? wu : wg)[(size_t)k * FF + hid] * gnf[k]; }, gt, NT);
        wprep((bf16*)(ws + WS_WD0 + L * WS_LAYER_STRIDE), D, FF, [=](int k, int n) { return wd[(size_t)k * D + n]; }, gt, NT);
        wprep((bf16*)(ws + WS_WPLE0 + L * WS_LAYER_STRIDE), D, 256, [=](int k, int n) { return wp[(size_t)k * D + n]; }, gt, NT);
        wprep((bf16*)(ws + WS_WPG0 + L * WS_LAYER_STRIDE), D, D, [=](int k, int n) { return wpg[(size_t)k * D + n] * gnp[k]; }, gt, NT);
    }
    { const float* W = a.in[18]; const float* gn1 = a.in[2] + D; wprep((bf16*)(ws + WS_WUP), 2 * CI, D, [=](int k, int n) { return W[(size_t)k * (2 * CI) + n] * gn1[k]; }, gt, NT); }
    { const float* W = a.in[29]; wprep((bf16*)(ws + WS_WDOWN), D, CI, [=](int k, int n) { return W[(size_t)k * D + n]; }, gt, NT); }
    { const float* wq = a.in[21]; const float* wk = a.in[22]; const float* wv = a.in[23]; const float* wif = a.in[24]; float* W12 = (float*)(ws + WS_W12);
      for (int it = gt; it < 4096 * 8; it += NT) { const int o = it & 7, c = (it >> 3) & 2047, part = it >> 14, g = c >> 2, i = c & 3; float s = 0.f;
          if (part == 0) { for (int j = 0; j < 4; ++j) s += wq[(g * 4 + i) * 4 + j] * wif[(size_t)(4 * g + j) * 8 + o] + wk[(g * 4 + i) * 4 + j] * wif[(size_t)(2048 + 4 * g + j) * 8 + o]; }
          else { for (int j = 0; j < 4; ++j) s += wv[(g * 4 + i) * 4 + j] * wif[(size_t)(4096 + 4 * g + j) * 8 + o]; }
          W12[it] = s; } }
}
__device__ __forceinline__ void phase_norm(Frame& F, const float* src, const float* gain, bf16* dst, int nrows) {
    const int gw = F.bid * NWAVES + F.wave, NGW = F.G * NWAVES, lane = F.lane;
    f32x4 g[4];
#pragma unroll
    for (int j = 0; j < 4; ++j) g[j] = *((const f32x4*)gain + lane + 64 * j);
    for (int m = gw; m < nrows; m += NGW) {
        const f32x4* xr = (const f32x4*)(src + (size_t)m * D) + lane; f32x4 v[4]; float s = 0.f;
#pragma unroll
        for (int j = 0; j < 4; ++j) { v[j] = xr[64 * j]; s += (v[j].x * v[j].x + v[j].y * v[j].y) + (v[j].z * v[j].z + v[j].w * v[j].w); }
        const float r = rsqrtf(wave_sum(s) * (1.f / D) + NORM_EPS);
        v2u* o = (v2u*)(dst + (size_t)m * D) + lane;
#pragma unroll
        for (int j = 0; j < 4; ++j) { v2u w; w.x = pk2(v[j].x * r * g[j].x, v[j].y * r * g[j].y); w.y = pk2(v[j].z * r * g[j].z, v[j].w * r * g[j].w); o[64 * j] = w; }
    }
}
__device__ __forceinline__ void phase_cast_sq(Frame& F, const float* src, bf16* dst, float* rsq, int nrows) {
    const int gw = F.bid * NWAVES + F.wave, NGW = F.G * NWAVES, lane = F.lane;
    for (int m = gw; m < nrows; m += 2 * NGW) { const int m2 = m + NGW; const bool has2 = m2 < nrows;
        const f32x4* xr = (const f32x4*)(src + (size_t)m * D) + lane; const f32x4* xr2 = (const f32x4*)(src + (size_t)(has2 ? m2 : m) * D) + lane; f32x4 v[4], u[4]; float s = 0.f, s2 = 0.f;
#pragma unroll
        for (int j = 0; j < 4; ++j) { v[j] = xr[64 * j]; u[j] = xr2[64 * j]; }
#pragma unroll
        for (int j = 0; j < 4; ++j) { s += (v[j].x * v[j].x + v[j].y * v[j].y) + (v[j].z * v[j].z + v[j].w * v[j].w); s2 += (u[j].x * u[j].x + u[j].y * u[j].y) + (u[j].z * u[j].z + u[j].w * u[j].w); }
        s = wave_sum(s); s2 = wave_sum(s2);
        if (lane < 16) rsq[(size_t)m * 16 + lane] = lane == 0 ? s : 0.f;
        v2u* o = (v2u*)(dst + (size_t)m * D) + lane;
#pragma unroll
        for (int j = 0; j < 4; ++j) { v2u w; w.x = pk2(v[j].x, v[j].y); w.y = pk2(v[j].z, v[j].w); o[64 * j] = w; }
        if (has2) { if (lane < 16) rsq[(size_t)m2 * 16 + lane] = lane == 0 ? s2 : 0.f;
            v2u* o2 = (v2u*)(dst + (size_t)m2 * D) + lane;
#pragma unroll
            for (int j = 0; j < 4; ++j) { v2u w; w.x = pk2(u[j].x, u[j].y); w.y = pk2(u[j].z, u[j].w); o2[64 * j] = w; } }
    }
}
__device__ __forceinline__ void phase_cvt_p(Frame& F, const float* p, bf16* pb) {
    const size_t gt = (size_t)F.bid * 512 + F.tid, NT = (size_t)F.G * 512, n8 = (size_t)T * 256 / 8;
    for (size_t i0 = gt; i0 < n8; i0 += 4 * NT) { f32x4 a[4], b[4];
#pragma unroll
        for (int q4 = 0; q4 < 4; ++q4) { const size_t i = i0 + q4 * NT; if (i < n8) { a[q4] = *((const f32x4*)p + 2 * i); b[q4] = *((const f32x4*)p + 2 * i + 1); } }
#pragma unroll
        for (int q4 = 0; q4 < 4; ++q4) { const size_t i = i0 + q4 * NT; if (i < n8) { v4u o; o.x = pk2(a[q4].x, a[q4].y); o.y = pk2(a[q4].z, a[q4].w); o.z = pk2(b[q4].x, b[q4].y); o.w = pk2(b[q4].z, b[q4].w); *((v4u*)pb + i) = o; } } }
}
constexpr float QSCALE = 0.125f * LOG2E;
__device__ __forceinline__ void phase_prepA(Frame& F, const Args& a) {
    unsigned char* ws = F.ws; const bf16* UA = (const bf16*)(ws + WS_UA); const bf16* UB = (const bf16*)(ws + WS_UB);
    bf16* LIN = (bf16*)(ws + WS_LIN); bf16* QN = (bf16*)(ws + WS_QN); bf16* KN = (bf16*)(ws + WS_KN); bf16* VT = (bf16*)(ws + WS_VT);
    const float* mu = a.in[6]; const float* gq = a.in[3]; const float* gk = a.in[4];
    { const int gt = F.bid * 512 + F.tid, NT = F.G * 512; const int c8 = (gt & 31) << 3; float muv[8];
#pragma unroll
      for (int j = 0; j < 8; ++j) muv[j] = mu[1536 + c8 + j];
      for (int it0 = gt; it0 < T * 32; it0 += 4 * NT) { v4u ru[4], rp[4];
#pragma unroll
          for (int q4 = 0; q4 < 4; ++q4) { const int it = it0 + q4 * NT; if (it < T * 32) { const int t = it >> 5; ru[q4] = *(const v4u*)(UB + (size_t)t * UB_W + 1536 + c8); rp[q4] = *(const v4u*)(UB + (size_t)((t & (SEQ - 1)) ? t - 1 : t) * UB_W + 1536 + c8); } }
#pragma unroll
          for (int q4 = 0; q4 < 4; ++q4) { const int it = it0 + q4 * NT; if (it < T * 32) { const int t = it >> 5; float u[8], p[8], o[8]; unpack8(ru[q4], u); unpack8(rp[q4], p); const float pm = (t & (SEQ - 1)) ? 1.f : 0.f;
#pragma unroll
              for (int j = 0; j < 8; ++j) { const float s = u[j] + muv[j] * (p[j] * pm - u[j]); o[j] = c8 < 64 ? (1.0f - 2.0f * __builtin_amdgcn_rcpf(1.0f + __builtin_amdgcn_exp2f(2.0f * LOG2E * s))) : (c8 < 128 ? s : sigm(s));     }
              *(v4u*)(LIN + (size_t)t * 256 + c8) = pack8(o); } } } }
    { const int gw = F.bid * NWAVES + F.wave, NGW = F.G * NWAVES, lane = F.lane; float gqv[8], gkv[8];
#pragma unroll
      for (int j = 0; j < 8; ++j) { gqv[j] = gq[((lane & 7) << 3) + j] * QSCALE; gkv[j] = gk[((lane & 7) << 3) + j]; }
      for (int t0 = gw; t0 < T; t0 += 4 * NGW) { v4u rq[4], rk[4];
#pragma unroll
          for (int q4 = 0; q4 < 4; ++q4) { const int t = t0 + q4 * NGW; if (t < T) { rq[q4] = *(const v4u*)(UA + (size_t)t * UA_W + 8 * lane); rk[q4] = *(const v4u*)(UA + (size_t)t * UA_W + UA_K + 8 * (lane & 7)); } }
#pragma unroll
          for (int q4 = 0; q4 < 4; ++q4) { const int t = t0 + q4 * NGW; if (t < T) {
              float q[8], k[8]; unpack8(rq[q4], q); unpack8(rk[q4], k);
              float sq = 0.f, sk = 0.f;
#pragma unroll
              for (int j = 0; j < 8; ++j) { sq += q[j] * q[j]; sk += k[j] * k[j]; }
              sq += __shfl_xor(sq, 1); sq += __shfl_xor(sq, 2); sq += __shfl_xor(sq, 4); sk += __shfl_xor(sk, 1); sk += __shfl_xor(sk, 2); sk += __shfl_xor(sk, 4);
              const float rq_ = rsqrtf(sq * (1.f / 64.f) + NORM_EPS), rk_ = rsqrtf(sk * (1.f / 64.f) + NORM_EPS);
#pragma unroll
              for (int j = 0; j < 8; ++j) { q[j] *= rq_ * gqv[j]; k[j] *= rk_ * gkv[j]; }
              *(v4u*)(QN + (size_t)t * 512 + 8 * lane) = pack8(q);
              if (lane < 8) *(v4u*)(KN + (size_t)t * 64 + 8 * lane) = pack8(k); } } } }
    { const int gt = F.bid * 512 + F.tid, NT = F.G * 512;
      for (int it = gt; it < T * 8; it += NT) { const int t = it >> 3, c8 = (it & 7) << 3; *(v4u*)(VT + (size_t)t * 64 + c8) = *(const v4u*)(UA + (size_t)t * UA_W + UA_V + c8); } }
}
constexpr int IDX_STRIDE = 2052, KSEL = 256;
__device__ __forceinline__ void topk_select(const LAS float* row, int limit, unsigned* maskrow, int lane) {
    unsigned long long mybits = 0ull; const int nj = limit >> 6;
    if (limit <= KSEL) { mybits = lane < nj ? ~0ull : 0ull; }
    else {
        unsigned key[32];
#pragma unroll
        for (int j = 0; j < 32; ++j) key[j] = 0u;
#pragma unroll
        for (int g8 = 0; g8 < 4; ++g8) if (8 * g8 < nj) {
#pragma unroll
            for (int jj = 0; jj < 8; ++jj) { const int j = 8 * g8 + jj; unsigned u = __float_as_uint(row[64 * j + lane]); if (u == 0x80000000u) u = 0u; const unsigned k = (u & 0x80000000u) ? ~u : (u | 0x80000000u); key[j] = (j < nj) ? k : 0u; } }
        unsigned prefix = 0u; bool exact = false;
        for (int bit = 31; bit >= 0; --bit) { const unsigned cand = prefix | (1u << bit); int c0 = 0, c1 = 0;
#pragma unroll
            for (int g8 = 0; g8 < 4; ++g8) if (8 * g8 < nj) {
#pragma unroll
                for (int jj = 0; jj < 8; jj += 2) { c0 += __builtin_popcountll(__ballot(key[8 * g8 + jj] >= cand)); c1 += __builtin_popcountll(__ballot(key[8 * g8 + jj + 1] >= cand)); } }
            const int cnt = c0 + c1;
            if (cnt >= KSEL) { prefix = cand; if (cnt == KSEL) { exact = true; break; } } }
        int need = 0;
        if (!exact) { int cgt = 0;
#pragma unroll
            for (int j = 0; j < 32; ++j) cgt += __builtin_popcountll(__ballot(key[j] > prefix));
            need = KSEL - cgt; }
        int running = 0; const unsigned long long below = (1ull << lane) - 1ull;
#pragma unroll
        for (int g8 = 0; g8 < 4; ++g8) if (8 * g8 < nj)
#pragma unroll
        for (int jj = 0; jj < 8; ++jj) { const int j = 8 * g8 + jj;
            const bool gt = exact ? (key[j] >= prefix) : (key[j] > prefix); const bool tie = (!exact) && key[j] == prefix;
            const unsigned long long tb = __ballot(tie); const int rank = running + __builtin_popcountll(tb & below); running += __builtin_popcountll(tb);
            const unsigned long long sb = __ballot(gt || (tie && rank < need)); if (lane == j) mybits = sb; }
    }
    if (lane < 32) { v2u w; w.x = (unsigned)mybits; w.y = (unsigned)(mybits >> 32); *(v2u*)(maskrow + 2 * lane) = w; }
}
__device__ __forceinline__ void phase_indexer(Frame& F) {
    unsigned char* ws = F.ws; const bf16* UA = (const bf16*)(ws + WS_UA); unsigned* MASK = (unsigned*)(ws + WS_MASK);
    LAS float* sc = (LAS float*)F.lds; const int lane = F.lane, w = F.wave, fr = lane & 15, fq = lane >> 4;
    for (int r = 0;; ++r) { const int u = r * F.G + ((r & 1) ? (F.G - 1 - F.bid) : F.bid); if (u >= NB * 128) break;
        const int c = 31 - (u >> 7), rest = u & 127, b = rest >> 2, g4 = rest & 3, limit = 64 * (c + 1), tq0 = b * SEQ + c * 64 + g4 * 16;
        const bf16* UAb = UA + (size_t)b * SEQ * UA_W;
        bf16x8 qf[4][2]; float iwv[4];
        { const bf16* qp = UA + (size_t)(tq0 + fr) * UA_W;
#pragma unroll
          for (int hh = 0; hh < 4; ++hh) { qf[hh][0] = *(const bf16x8*)(qp + UA_IQ + hh * 64 + fq * 8); qf[hh][1] = *(const bf16x8*)(qp + UA_IQ + hh * 64 + 32 + fq * 8); iwv[hh] = bf1(qp[UA_IW + hh]) * (1.f / 16.f); } }
#ifndef IDX_SCORE_REP
#define IDX_SCORE_REP 1
#endif
#ifndef IDX_SEL_REP
#define IDX_SEL_REP 1
#endif
        for (int rp_ = 0; rp_ < IDX_SCORE_REP; ++rp_)
        for (int kt = w; kt < (limit >> 4); kt += NWAVES) {
            const bf16* kp = UAb + (size_t)(kt * 16 + fr) * UA_W + UA_IK + fq * 8; const bf16x8 a0 = *(const bf16x8*)kp, a1 = *(const bf16x8*)(kp + 32);
            f32x4 s = {0.f, 0.f, 0.f, 0.f};
#pragma unroll
            for (int hh = 0; hh < 4; ++hh) { f32x4 d = {0.f, 0.f, 0.f, 0.f}; d = __builtin_amdgcn_mfma_f32_16x16x32_bf16(a0, qf[hh][0], d, 0, 0, 0); d = __builtin_amdgcn_mfma_f32_16x16x32_bf16(a1, qf[hh][1], d, 0, 0, 0);
#pragma unroll
                for (int j = 0; j < 4; ++j) s[j] += iwv[hh] * fmaxf(d[j], 0.f); }
            *(LAS f32x4*)(sc + fr * IDX_STRIDE + kt * 16 + fq * 4) = s; }
        __syncthreads();
#pragma unroll 1
        for (int qq = 0; qq < 2 * IDX_SEL_REP; ++qq) { const int q = 2 * w + (qq & 1); topk_select(sc + q * IDX_STRIDE, limit, MASK + (size_t)(tq0 + q) * 64, lane); }
        __syncthreads(); }
}
constexpr int DA_K = 0, DA_V = 8192, DA_M = 16384, DA_STAGE = 16384 + 512;
__device__ __forceinline__ bf16x8 mk8(v2u lo, v2u hi) { v4u t; t.x = lo.x; t.y = lo.y; t.z = hi.x; t.w = hi.y; return __builtin_bit_cast(bf16x8, t); }
__device__ __forceinline__ void tr_read_v4d(unsigned a, bf16x8 (&vf)[4]) { s16x4 l0, h0, l1, h1, l2, h2, l3, h3;
    asm volatile("ds_read_b64_tr_b16 %0, %8\n\tds_read_b64_tr_b16 %1, %8 offset:512\n\tds_read_b64_tr_b16 %2, %8 offset:32\n\tds_read_b64_tr_b16 %3, %8 offset:544\n\t"
                 "ds_read_b64_tr_b16 %4, %8 offset:64\n\tds_read_b64_tr_b16 %5, %8 offset:576\n\tds_read_b64_tr_b16 %6, %8 offset:96\n\tds_read_b64_tr_b16 %7, %8 offset:608\n\ts_waitcnt lgkmcnt(0)"
                 : "=&v"(l0), "=&v"(h0), "=&v"(l1), "=&v"(h1), "=&v"(l2), "=&v"(h2), "=&v"(l3), "=&v"(h3) : "v"(a) : "memory");
    vf[0] = (bf16x8){l0[0], l0[1], l0[2], l0[3], h0[0], h0[1], h0[2], h0[3]}; vf[1] = (bf16x8){l1[0], l1[1], l1[2], l1[3], h1[0], h1[1], h1[2], h1[3]};
    vf[2] = (bf16x8){l2[0], l2[1], l2[2], l2[3], h2[0], h2[1], h2[2], h2[3]}; vf[3] = (bf16x8){l3[0], l3[1], l3[2], l3[3], h3[0], h3[1], h3[2], h3[3]}; }
__device__ __forceinline__ void phase_dsa_attn(Frame& F, const Args& a) {
    unsigned char* ws = F.ws; const bf16* QN = (const bf16*)(ws + WS_QN); const bf16* KN = (const bf16*)(ws + WS_KN); const bf16* VN = (const bf16*)(ws + WS_VT);
    const unsigned* MASK = (const unsigned*)(ws + WS_MASK); bf16* MIX = (bf16*)(ws + WS_XB);
    const int lane = F.lane, w = F.wave, fr = lane & 15, fq = lane >> 4; LAS unsigned char* lds = F.lds;
    const float mb = 8.f * LOG2E * wave_max(fabsf(a.in[3][lane])) * wave_max(fabsf(a.in[4][lane]));
    const unsigned vtr_lane = (unsigned)((8 * fq + ((lane & 15) >> 2)) * 128 + 4 * (lane & 3) * 2);
    for (int r = 0;; ++r) { const int u = r * F.G + ((r & 1) ? (F.G - 1 - F.bid) : F.bid); if (u >= NB * 32) break;
        const int c = 31 - (u >> 5), b = u & 31, nst = c + 1, t0 = b * SEQ + 64 * c;
        const bf16* Kb = KN + (size_t)b * SEQ * 64; const bf16* Vb = VN + (size_t)b * SEQ * 64; const unsigned* Mb = MASK + (size_t)t0 * 64;
#define DA_DMA(st_, buf_) do { const int so_ = (buf_) * DA_STAGE; \
            __builtin_amdgcn_global_load_lds((const unsigned*)(Kb + (size_t)(64 * (st_) + 8 * w) * 64 + lane * 8), (LAS unsigned*)(lds + so_ + DA_K + w * 1024), 16, 0, 0); \
            __builtin_amdgcn_global_load_lds((const unsigned*)(Vb + (size_t)(64 * (st_) + 8 * w) * 64 + lane * 8), (LAS unsigned*)(lds + so_ + DA_V + w * 1024), 16, 0, 0); \
            if (w < 2) __builtin_amdgcn_global_load_lds(Mb + (size_t)lane * 64 + 2 * (st_) + w, (LAS unsigned*)(lds + so_ + DA_M + w * 256), 4, 0, 0); } while (0)
        DA_DMA(0, 0);
        bf16x8 qf[4][2];
#pragma unroll
        for (int i = 0; i < 4; ++i) { const bf16* qp = QN + (size_t)(t0 + 16 * i + fr) * 512 + w * 64 + fq * 8; qf[i][0] = *(const bf16x8*)qp; qf[i][1] = *(const bf16x8*)(qp + 32); }
        f32x4 O[4][4]; float l[4];
#pragma unroll
        for (int i = 0; i < 4; ++i) { l[i] = 0.f;
#pragma unroll
            for (int dt = 0; dt < 4; ++dt) O[i][dt] = (f32x4){0.f, 0.f, 0.f, 0.f}; }
        for (int st = 0; st < nst; ++st) { const int buf = st & 1; const LAS unsigned char* sb = lds + buf * DA_STAGE;
            asm volatile("s_waitcnt vmcnt(0)" ::: "memory");
            __builtin_amdgcn_s_barrier(); asm volatile("" ::: "memory");
            if (st + 1 < nst) DA_DMA(st + 1, buf ^ 1);
#pragma unroll
            for (int sub = 0; sub < 2; ++sub) {
                bf16x8 kf[2][2], vf[4]; unsigned mw[4];
#pragma unroll
                for (int s2 = 0; s2 < 2; ++s2) { const LAS unsigned char* kp = sb + DA_K + (32 * sub + 8 * (fr >> 2) + 4 * s2 + (fr & 3)) * 128 + fq * 16;   kf[s2][0] = *(const LAS bf16x8*)kp; kf[s2][1] = *(const LAS bf16x8*)(kp + 64); }
#pragma unroll
                for (int i = 0; i < 4; ++i) mw[i] = *(const LAS unsigned*)(sb + DA_M + sub * 256 + (16 * i + fr) * 4);
                tr_read_v4d((unsigned)(size_t)(sb + DA_V + sub * 4096) + vtr_lane, vf);
#pragma unroll
                for (int i = 0; i < 4; ++i) {
                    f32x4 s0 = {0.f, 0.f, 0.f, 0.f}, s1 = {0.f, 0.f, 0.f, 0.f};
                    s0 = __builtin_amdgcn_mfma_f32_16x16x32_bf16(kf[0][0], qf[i][0], s0, 0, 0, 0); s0 = __builtin_amdgcn_mfma_f32_16x16x32_bf16(kf[0][1], qf[i][1], s0, 0, 0, 0);
                    s1 = __builtin_amdgcn_mfma_f32_16x16x32_bf16(kf[1][0], qf[i][0], s1, 0, 0, 0); s1 = __builtin_amdgcn_mfma_f32_16x16x32_bf16(kf[1][1], qf[i][1], s1, 0, 0, 0);
                    const unsigned b0 = mw[i] >> (8 * fq), b1 = mw[i] >> (8 * fq + 4); float p[8];
#pragma unroll
                    for (int j = 0; j < 4; ++j) { p[j] = ((b0 >> j) & 1u) ? __builtin_amdgcn_exp2f(s0[j] - mb) : 0.f; p[4 + j] = ((b1 >> j) & 1u) ? __builtin_amdgcn_exp2f(s1[j] - mb) : 0.f; }
                    l[i] += ((p[0] + p[1]) + (p[2] + p[3])) + ((p[4] + p[5]) + (p[6] + p[7]));
                    const bf16x8 pa = __builtin_bit_cast(bf16x8, pack8(p));
#pragma unroll
                    for (int dt = 0; dt < 4; ++dt) O[i][dt] = __builtin_amdgcn_mfma_f32_16x16x32_bf16(pa, vf[dt], O[i][dt], 0, 0, 0);
                } } }
#undef DA_DMA
#pragma unroll
        for (int i = 0; i < 4; ++i) { float li = l[i]; li += __shfl_xor(li, 16); li += __shfl_xor(li, 32);
#pragma unroll
            for (int j = 0; j < 4; ++j) { const float inv = 1.0f / __shfl(li, 4 * fq + j); bf16* op = MIX + (size_t)(t0 + 16 * i + 4 * fq + j) * D + w * 64 + fr;
#pragma unroll
                for (int dt = 0; dt < 4; ++dt) op[16 * dt] = (bf16)f2bf(O[i][dt][j] * inv); } }
        VM_WAIT(); __syncthreads();
    }
}
__device__ __forceinline__ float rw_decay(float x) { const float sp = fmaxf(-x, 0.f) + 0.6931471805599453f * __builtin_amdgcn_logf(1.0f + __builtin_amdgcn_exp2f(-LOG2E * fabsf(x)));
    return __builtin_amdgcn_exp2f(-LOG2E * __builtin_amdgcn_exp2f(-LOG2E * (sp + 0.5f))); }
#define MF32(a_, b_, c_) __builtin_amdgcn_mfma_f32_16x16x4f32((a_), (b_), (c_), 0, 0, 0)
constexpr int RT = 68, RG = 20, RGM = 16 * RG;
constexpr int RL_AH = 0, RL_BH = 64 * RT, RL_KH = 2 * 64 * RT, RL_RH = 3 * 64 * RT, RL_VX = 4 * 64 * RT, RL_GS = 5 * 64 * RT, RL_YA = 6 * 64 * RT, RL_GR = 7 * 64 * RT, RL_PM = RL_GR + 16 * RGM, RL_GC = RL_PM + 4 * RGM, RL_BON = RL_GC + 256, RL_END = RL_BON + 64;
static_assert(RL_END * 4 <= MISC_OFF, "RWKV LDS");
__device__ __forceinline__ void phase_rwkv(Frame& F, const Args& a) {
    unsigned char* ws = F.ws; const bf16* UB = (const bf16*)(ws + WS_UB); const bf16* LOUT = (const bf16*)(ws + WS_LOUT); bf16* MIX = (bf16*)(ws + WS_XB);
    const float* mu = a.in[6]; const float* w0 = a.in[7]; const float* a0 = a.in[9]; const float* k_k = a.in[12]; const float* k_a = a.in[13]; const float* r_k = a.in[14]; const float* gn_g = a.in[15]; const float* gn_b = a.in[16];
    const int lane = F.lane, w = F.wave, n = lane & 15, q = lane >> 4;
    LAS float* L = (LAS float*)F.lds;
    for (int bh = F.bid; bh < NB * 8; bh += F.G) {
        const int b = bh >> 3, h = bh & 7, c = h * 64 + lane;
        const float mur = mu[c], muk = mu[512 + c], muv = mu[1024 + c], w0c = w0[c], a0c = a0[c], kkc = k_k[c], kac = k_a[c], rkc = r_k[c], gng = gn_g[c], gnb = gn_b[c];
        f32x4 Z[4];
#pragma unroll
        for (int kt = 0; kt < 4; ++kt) Z[kt] = (f32x4){0.f, 0.f, 0.f, 0.f};
        const int ch = w >> 1, hs = w & 1;
        float r_ur[8], r_uk[8], r_uv[8], r_pr[8], r_pk[8], r_pv[8], r_wd[8], r_ad[8], r_gg[8], r_wf[8];
#define RW_RAW(batch_) do { _Pragma("unroll") for (int i = 0; i < 8; ++i) { const int sl = (batch_) * 64 + 16 * ch + 8 * hs + i; const size_t t = (size_t)b * SEQ + sl; const bf16* up = UB + t * UB_W + c; const bf16* pp_ = sl > 0 ? up - UB_W : up; \
            r_ur[i] = bf1(up[0]); r_uk[i] = bf1(up[512]); r_uv[i] = bf1(up[1024]); r_pr[i] = bf1(pp_[0]); r_pk[i] = bf1(pp_[512]); r_pv[i] = bf1(pp_[1024]); \
            const bf16* lp = LOUT + t * 1536 + c; r_wd[i] = bf1(lp[0]); r_ad[i] = bf1(lp[512]); r_gg[i] = bf1(lp[1024]); \
            r_wf[i] = bf1(LOUT[((size_t)b * SEQ + (batch_) * 64 + 16 * ch + i) * 1536 + c]); } } while (0)
        RW_RAW(0);
        for (int batch = 0; batch < SEQ / 64; ++batch) {
            { float gcur = 1.f;
              if (hs) {
#pragma unroll
                  for (int i = 0; i < 8; ++i) gcur *= rw_decay(w0c + r_wf[i]); }
#pragma unroll
              for (int i = 0; i < 8; ++i) { const int tl = 16 * ch + 8 * hs + i, sl = batch * 64 + tl; const float pm = sl > 0 ? 1.f : 0.f;
                const float ur = r_ur[i], uk = r_uk[i], uv = r_uv[i], pr = r_pr[i] * pm, pk = r_pk[i] * pm, pv = r_pv[i] * pm;
                const float rr = ur + mur * (pr - ur), kx = uk + muk * (pk - uk), vx = uv + muv * (pv - uv);
                const float decay = rw_decay(w0c + r_wd[i]), av = sigm(a0c + r_ad[i]);
                float kk = kx * kkc; kk = kk * rsqrtf(fmaxf(wave_sum(kk * kk), 1e-24f));
                const float km = kx * (1.f + (av - 1.f) * kac); const float bon = wave_sum(rr * km * rkc);
                const float gprev = gcur; gcur *= decay; const float ig = __builtin_amdgcn_rcpf(gcur);
                L[RL_AH + tl * RT + lane] = -kk * gprev; L[RL_BH + tl * RT + lane] = kk * av * ig; L[RL_KH + tl * RT + lane] = km * ig; L[RL_RH + tl * RT + lane] = rr * gcur;
                L[RL_VX + tl * RT + lane] = vx; L[RL_GS + tl * RT + lane] = r_gg[i]; if (lane == 0) L[RL_BON + tl] = bon; }
              if (hs) L[RL_GC + ch * 64 + lane] = gcur; }
            LDS_WAIT(); __syncthreads();
            if (batch + 1 < SEQ / 64) RW_RAW(batch + 1);
            { const LAS float* ah = L + RL_AH + 16 * ch * RT; const LAS float* bhm = L + RL_BH + 16 * ch * RT; const LAS float* khm = L + RL_KH + 16 * ch * RT; const LAS float* rhm = L + RL_RH + 16 * ch * RT;
              LAS float* gr = L + RL_GR + ch * 4 * RGM; LAS float* pm_ = L + RL_PM + ch * RGM;
              if (hs == 0) {
                  f32x4 m = {0.f, 0.f, 0.f, 0.f};
#pragma unroll
                  for (int s = 0; s < 16; ++s) m = MF32(bhm[n * RT + 4 * s + q], ah[n * RT + 4 * s + q], m);
                  f32x4 tm;
#pragma unroll
                  for (int j = 0; j < 4; ++j) { m[j] = (4 * q + j < n) ? m[j] : 0.f; tm[j] = m[j] + ((4 * q + j == n) ? 1.f : 0.f); pm_[(4 * q + j) * RG + n] = m[j]; gr[(4 * q + j) * RG + n] = tm[j]; }
#pragma unroll
                  for (int rd = 0; rd < 3; ++rd) { LDS_WAIT();
                      f32x4 p2 = {0.f, 0.f, 0.f, 0.f};
#pragma unroll
                      for (int s = 0; s < 4; ++s) p2 = MF32(pm_[n * RG + 4 * s + q], pm_[(4 * s + q) * RG + n], p2);
                      f32x4 ip, t2 = {0.f, 0.f, 0.f, 0.f};
#pragma unroll
                      for (int j = 0; j < 4; ++j) ip[j] = p2[j] + ((4 * q + j == n) ? 1.f : 0.f);
#pragma unroll
                      for (int j = 0; j < 4; ++j) t2 = MF32(gr[n * RG + 4 * q + j], ip[j], t2);
                      LDS_WAIT();
#pragma unroll
                      for (int j = 0; j < 4; ++j) { pm_[(4 * q + j) * RG + n] = p2[j]; gr[(4 * q + j) * RG + n] = t2[j]; } }
              } else {
                  f32x4 mk = {0.f, 0.f, 0.f, 0.f}, nb = {0.f, 0.f, 0.f, 0.f}, nk = {0.f, 0.f, 0.f, 0.f};
#pragma unroll
                  for (int s = 0; s < 16; ++s) { const float av_ = ah[n * RT + 4 * s + q], rv_ = rhm[n * RT + 4 * s + q], bv_ = bhm[n * RT + 4 * s + q], kv_ = khm[n * RT + 4 * s + q];
                      mk = MF32(kv_, av_, mk); nb = MF32(bv_, rv_, nb); nk = MF32(kv_, rv_, nk); }
#pragma unroll
                  for (int j = 0; j < 4; ++j) { const int s_ = 4 * q + j; gr[RGM + s_ * RG + n] = (s_ < n) ? mk[j] : 0.f; gr[2 * RGM + s_ * RG + n] = (s_ <= n) ? nb[j] : 0.f; gr[3 * RGM + s_ * RG + n] = (s_ <= n) ? nk[j] : 0.f; } } }
            LDS_WAIT(); __syncthreads();
#ifndef RW_C_REP
#define RW_C_REP 1
#endif
            if (w < 4) { const int v = 16 * w + n; f32x4 Zs[4]; for (int kt = 0; kt < 4; ++kt) Zs[kt] = Z[kt];
              for (int rc_ = 0; rc_ < RW_C_REP; ++rc_) { if (rc_) for (int kt = 0; kt < 4; ++kt) Z[kt] = Zs[kt];
#pragma unroll 1
                for (int cc = 0; cc < 4; ++cc) { const LAS float* ah = L + RL_AH + 16 * cc * RT; const LAS float* bhm = L + RL_BH + 16 * cc * RT; const LAS float* khm = L + RL_KH + 16 * cc * RT; const LAS float* rhm = L + RL_RH + 16 * cc * RT;
                    const LAS float* vx = L + RL_VX + 16 * cc * RT; const LAS float* gr = L + RL_GR + cc * 4 * RGM;
                    float vb[4];
#pragma unroll
                    for (int s = 0; s < 4; ++s) vb[s] = vx[(4 * s + q) * RT + v];
                    f32x4 X = {0.f, 0.f, 0.f, 0.f}, Y = {0.f, 0.f, 0.f, 0.f};
#pragma unroll
                    for (int kt = 0; kt < 4; ++kt)
#pragma unroll
                        for (int j = 0; j < 4; ++j) { X = MF32(ah[n * RT + 16 * kt + 4 * q + j], Z[kt][j], X); Y = MF32(rhm[n * RT + 16 * kt + 4 * q + j], Z[kt][j], Y); }
#pragma unroll
                    for (int s = 0; s < 4; ++s) { X = MF32(gr[RGM + (4 * s + q) * RG + n], vb[s], X); Y = MF32(gr[3 * RGM + (4 * s + q) * RG + n], vb[s], Y); }
                    f32x4 U = {0.f, 0.f, 0.f, 0.f};
#pragma unroll
                    for (int j = 0; j < 4; ++j) U = MF32(gr[(4 * q + j) * RG + n], X[j], U);
#pragma unroll
                    for (int j = 0; j < 4; ++j) Y = MF32(gr[2 * RGM + (4 * q + j) * RG + n], U[j], Y);
#pragma unroll
                    for (int j = 0; j < 4; ++j) L[RL_YA + (16 * cc + 4 * q + j) * RT + v] = Y[j];
#pragma unroll
                    for (int kt = 0; kt < 4; ++kt) {
#pragma unroll
                        for (int j = 0; j < 4; ++j) Z[kt] = MF32(bhm[(4 * q + j) * RT + 16 * kt + n], U[j], Z[kt]);
#pragma unroll
                        for (int s = 0; s < 4; ++s) Z[kt] = MF32(khm[(4 * s + q) * RT + 16 * kt + n], vb[s], Z[kt]);
                        const f32x4 gc = *(const LAS f32x4*)(L + RL_GC + cc * 64 + 16 * kt + 4 * q); Z[kt] = Z[kt] * gc; } } } }
            LDS_WAIT(); __syncthreads();
#pragma unroll
            for (int i = 0; i < 8; ++i) { const int step = w + 8 * i; const size_t t = (size_t)b * SEQ + batch * 64 + step;
                const float y = L[RL_YA + step * RT + lane], mean = wave_sum(y) * (1.f / 64.f), dlt = y - mean, var = fmaxf(wave_sum(y * y) * (1.f / 64.f) - mean * mean, 0.f);
                const float yn = dlt * rsqrtf(var + 64e-5f) * gng + gnb; const float o = (yn + L[RL_BON + step] * L[RL_VX + step * RT + lane]) * L[RL_GS + step * RT + lane];
                MIX[t * D + 512 + c] = (bf16)f2bf(o); }
            LDS_WAIT(); __syncthreads();
        }
#undef RW_RAW
    }
}
__device__ __forceinline__ void phase_l1prep(Frame& F, const Args& a, int hb) {
    unsigned char* ws = F.ws; const bf16* XM = (const bf16*)(ws + WS_XM); bf16* XC = (bf16*)(ws + WS_XC); bf16* Q = (bf16*)(ws + WS_Q); bf16* K = (bf16*)(ws + WS_K); bf16* V = (bf16*)(ws + WS_V);
    float* GI = (float*)(ws + WS_GI); const float* W12 = (const float*)(ws + WS_W12);
    const float* cw = a.in[19]; const float* cb = a.in[20]; const float* wq = a.in[21]; const float* wk = a.in[22]; const float* wv = a.in[23]; const float* b_i = a.in[25]; const float* b_f = a.in[26];
    const int g = F.tid, lane = F.lane, w = F.wave; LAS float* red = (LAS float*)F.lds;
    float cwr[4][4], cbr[4], wqr[16], wkr[16], wvr[16], w1[32], w2[32];
#pragma unroll
    for (int j = 0; j < 4; ++j)
#pragma unroll
        for (int i = 0; i < 4; ++i) cwr[j][i] = cw[j * CI + 4 * g + i];
#pragma unroll
    for (int i = 0; i < 4; ++i) cbr[i] = cb[4 * g + i];
#pragma unroll
    for (int i = 0; i < 16; ++i) { wqr[i] = wq[g * 16 + i]; wkr[i] = wk[g * 16 + i]; wvr[i] = wv[g * 16 + i]; }
#pragma unroll
    for (int i = 0; i < 32; ++i) { w1[i] = W12[(size_t)(4 * g) * 8 + i]; w2[i] = W12[(size_t)(2048 + 4 * g) * 8 + i]; }
    float wqk[16];
#pragma unroll
    for (int i = 0; i < 4; ++i)
#pragma unroll
        for (int ip = 0; ip < 4; ++ip) { float sacc = 0.f;
#pragma unroll
            for (int m = 0; m < 4; ++m) sacc = fmaf(wqr[4 * i + m], wkr[4 * ip + m], sacc);
            wqk[4 * i + ip] = sacc * 0.044194173824159216f; }
    const int per = TH / F.G;
    const int tb = F.bid * per;
    float x0[4], x1[4], x2[4];
    { const int sl = tb & (SEQ - 1);
#pragma unroll
      for (int i = 0; i < 4; ++i) { x0[i] = 0.f; x1[i] = 0.f; x2[i] = 0.f; }
      if (sl >= 1) { const v2u r = *(const v2u*)(XM + (size_t)(tb - 1) * CI + 4 * g); x2[0] = bflo(r.x); x2[1] = bfhi(r.x); x2[2] = bflo(r.y); x2[3] = bfhi(r.y); }
      if (sl >= 2) { const v2u r = *(const v2u*)(XM + (size_t)(tb - 2) * CI + 4 * g); x1[0] = bflo(r.x); x1[1] = bfhi(r.x); x1[2] = bflo(r.y); x1[3] = bfhi(r.y); }
      if (sl >= 3) { const v2u r = *(const v2u*)(XM + (size_t)(tb - 3) * CI + 4 * g); x0[0] = bflo(r.x); x0[1] = bfhi(r.x); x0[2] = bflo(r.y); x0[3] = bfhi(r.y); } }
    constexpr int L1PF = 4;
    v2u xq[L1PF][2];
#pragma unroll
    for (int pq = 0; pq < L1PF; ++pq)
#pragma unroll
        for (int tk = 0; tk < 2; ++tk) xq[pq][tk] = *(const v2u*)(XM + (size_t)(tb + 2 * pq + tk) * CI + 4 * g);
    for (int n4 = 0; n4 < per / 2; ++n4) { const int t4 = tb + 2 * n4;
        float gs[16]; v2u xr[2];
        xr[0] = xq[0][0]; xr[1] = xq[0][1];
#pragma unroll
        for (int pq = 0; pq + 1 < L1PF; ++pq) { xq[pq][0] = xq[pq + 1][0]; xq[pq][1] = xq[pq + 1][1]; }
        { const int tn = (n4 + L1PF < per / 2) ? t4 + 2 * L1PF : t4;
#pragma unroll
          for (int tk = 0; tk < 2; ++tk) xq[L1PF - 1][tk] = *(const v2u*)(XM + (size_t)(tn + tk) * CI + 4 * g); }
#pragma unroll
        for (int tk = 0; tk < 2; ++tk) { const int t = t4 + tk;
            float x3[4]; x3[0] = bflo(xr[tk].x); x3[1] = bfhi(xr[tk].x); x3[2] = bflo(xr[tk].y); x3[3] = bfhi(xr[tk].y);
            float xc[4], q[4];
#pragma unroll
            for (int i = 0; i < 4; ++i) { const float s = fmaf(cwr[3][i], x3[i], fmaf(cwr[2][i], x2[i], fmaf(cwr[1][i], x1[i], fmaf(cwr[0][i], x0[i], cbr[i])))); xc[i] = s * sigm(s); }
#pragma unroll
            for (int j = 0; j < 4; ++j) q[j] = fmaf(xc[3], wqk[12 + j], fmaf(xc[2], wqk[8 + j], fmaf(xc[1], wqk[4 + j], xc[0] * wqk[j])));
#pragma unroll
            for (int o = 0; o < 8; ++o) { float s = 0.f;
#pragma unroll
                for (int i = 0; i < 4; ++i) s = fmaf(x3[i], w2[i * 8 + o], fmaf(xc[i], w1[i * 8 + o], s));
                gs[tk * 8 + o] = s; }
            const size_t off = (size_t)t * CI + 4 * g;
            { v2u o; o.x = pk2(xc[0], xc[1]); o.y = pk2(xc[2], xc[3]); *(v2u*)(XC + off) = o; o.x = pk2(q[0], q[1]); o.y = pk2(q[2], q[3]); *(v2u*)(Q + off) = o; }
#pragma unroll
            for (int i = 0; i < 4; ++i) { x0[i] = x1[i]; x1[i] = x2[i]; x2[i] = x3[i]; } }
#define L1_STAGE(mask, n) { const bool hi_ = (lane & (mask)) != 0; _Pragma("unroll") for (int i = 0; i < (n) / 2; ++i) { const float send_ = hi_ ? gs[i] : gs[(n) / 2 + i]; const float keep_ = hi_ ? gs[(n) / 2 + i] : gs[i]; gs[i] = keep_ + __shfl_xor(send_, (mask)); } }
        L1_STAGE(32, 16) L1_STAGE(16, 8) L1_STAGE(8, 4) L1_STAGE(4, 2)
#undef L1_STAGE
        gs[0] += __shfl_xor(gs[0], 2); gs[0] += __shfl_xor(gs[0], 1);
        LAS float* rp = red + (n4 & 1) * 128;
        if ((lane & 3) == 0) rp[w * 16 + (lane >> 2)] = gs[0];
        LDS_WAIT(); __syncthreads();
        if (F.tid < 16) { float s = 0.f;
#pragma unroll
            for (int ww = 0; ww < 8; ++ww) s += rp[ww * 16 + F.tid];
            const int o = F.tid & 7; GI[(size_t)(t4 + (F.tid >> 3)) * 8 + o] = s + (o < 4 ? b_i[o] : b_f[o - 4]); }
    }
}
__device__ __forceinline__ void phase_gatescan(Frame& F) {
    unsigned char* ws = F.ws; const float* GI = (const float*)(ws + WS_GI); float* GA = (float*)(ws + WS_GA); float* GAM = (float*)(ws + WS_GAM); float* GEM = (float*)(ws + WS_GEM);
    const int lane = F.lane, w = F.wave, tid = F.tid; LAS float* wtot = (LAS float*)F.lds;
    for (int sq = F.bid; sq < (NB / 2) * 4; sq += F.G) { const int bl = sq >> 2, h = sq & 3; const size_t tq = (size_t)bl * SEQ + 4 * tid;
        float ip[4], c[4];
#pragma unroll
        for (int k = 0; k < 4; ++k) { ip[k] = GI[(tq + k) * 8 + h]; c[k] = -softplusf_(-GI[(tq + k) * 8 + 4 + h]); }
        c[1] += c[0]; c[2] += c[1]; c[3] += c[2];
        float inc = c[3];
#pragma unroll
        for (int o = 1; o < 64; o <<= 1) { const float n = __shfl_up(inc, o); if (lane >= o) inc += n; }
        if (lane == 63) wtot[w] = inc;
        LDS_WAIT(); __syncthreads();
        float off = inc - c[3];
#pragma unroll
        for (int ww = 0; ww < 8; ++ww) if (ww < w) off += wtot[ww];
        float Fv[4], av[4], m[4];
#pragma unroll
        for (int k = 0; k < 4; ++k) { Fv[k] = off + c[k]; av[k] = ip[k] - Fv[k]; }
        m[0] = av[0]; m[1] = fmaxf(m[0], av[1]); m[2] = fmaxf(m[1], av[2]); m[3] = fmaxf(m[2], av[3]);
        float incm = m[3];
#pragma unroll
        for (int o = 1; o < 64; o <<= 1) { const float n = __shfl_up(incm, o); if (lane >= o) incm = fmaxf(incm, n); }
        if (lane == 63) wtot[8 + w] = incm;
        LDS_WAIT(); __syncthreads();
        float offm = __shfl_up(incm, 1); if (lane == 0) offm = -INFINITY;
#pragma unroll
        for (int ww = 0; ww < 8; ++ww) if (ww < w) offm = fmaxf(offm, wtot[8 + ww]);
#pragma unroll
        for (int k = 0; k < 4; ++k) { const float A = fmaxf(offm, m[k]); GA[(tq + k) * 4 + h] = av[k]; GAM[(tq + k) * 4 + h] = A; GEM[(tq + k) * 4 + h] = __expf(-(Fv[k] + A)); }
        LDS_WAIT(); __syncthreads();
    }
}
constexpr int ML_PITCH = 1040, ML_TILE = 32 * ML_PITCH, ML_PP = 80, ML_PT = 64 * ML_PP;
constexpr int ML_K = 0, ML_V = 2 * ML_TILE, ML_P = 4 * ML_TILE, ML_DEN = ML_P + 2 * ML_PT, ML_AT = ML_DEN + 512, ML_AS = ML_AT + 256, ML_END = ML_AS + 8192;
constexpr int ML_ST = ML_P, ML_MR = ML_P + 4096;
static_assert(ML_MR + 512 <= ML_DEN, "mLSTM LDS tables");
static_assert(ML_END <= MISC_OFF, "mLSTM LDS");
__device__ __forceinline__ void tr_read_v4(unsigned a, bf16x8 (&vf)[4]) { s16x4 l0, h0, l1, h1, l2, h2, l3, h3;
    asm volatile("ds_read_b64_tr_b16 %0, %8\n\tds_read_b64_tr_b16 %1, %8 offset:4160\n\tds_read_b64_tr_b16 %2, %8 offset:32\n\tds_read_b64_tr_b16 %3, %8 offset:4192\n\t"
                 "ds_read_b64_tr_b16 %4, %8 offset:64\n\tds_read_b64_tr_b16 %5, %8 offset:4224\n\tds_read_b64_tr_b16 %6, %8 offset:96\n\tds_read_b64_tr_b16 %7, %8 offset:4256\n\ts_waitcnt lgkmcnt(0)"
                 : "=&v"(l0), "=&v"(h0), "=&v"(l1), "=&v"(h1), "=&v"(l2), "=&v"(h2), "=&v"(l3), "=&v"(h3) : "v"(a) : "memory");
    vf[0] = (bf16x8){l0[0], l0[1], l0[2], l0[3], h0[0], h0[1], h0[2], h0[3]}; vf[1] = (bf16x8){l1[0], l1[1], l1[2], l1[3], h1[0], h1[1], h1[2], h1[3]};
    vf[2] = (bf16x8){l2[0], l2[1], l2[2], l2[3], h2[0], h2[1], h2[2], h2[3]}; vf[3] = (bf16x8){l3[0], l3[1], l3[2], l3[3], h3[0], h3[1], h3[2], h3[3]}; }
static_assert(4 * ML_PITCH == 4160, "tr_read_v4 offsets");
__device__ __forceinline__ void tr_read_v8(unsigned a, bf16x8 (&vf)[8]) { s16x4 l0, h0, l1, h1, l2, h2, l3, h3, l4, h4, l5, h5, l6, h6, l7, h7;
    asm volatile("ds_read_b64_tr_b16 %0, %16\n\tds_read_b64_tr_b16 %1, %16 offset:4160\n\tds_read_b64_tr_b16 %2, %16 offset:32\n\tds_read_b64_tr_b16 %3, %16 offset:4192\n\t"
                 "ds_read_b64_tr_b16 %4, %16 offset:64\n\tds_read_b64_tr_b16 %5, %16 offset:4224\n\tds_read_b64_tr_b16 %6, %16 offset:96\n\tds_read_b64_tr_b16 %7, %16 offset:4256\n\t"
                 "ds_read_b64_tr_b16 %8, %16 offset:128\n\tds_read_b64_tr_b16 %9, %16 offset:4288\n\tds_read_b64_tr_b16 %10, %16 offset:160\n\tds_read_b64_tr_b16 %11, %16 offset:4320\n\t"
                 "ds_read_b64_tr_b16 %12, %16 offset:192\n\tds_read_b64_tr_b16 %13, %16 offset:4352\n\tds_read_b64_tr_b16 %14, %16 offset:224\n\tds_read_b64_tr_b16 %15, %16 offset:4384\n\ts_waitcnt lgkmcnt(0)"
                 : "=&v"(l0), "=&v"(h0), "=&v"(l1), "=&v"(h1), "=&v"(l2), "=&v"(h2), "=&v"(l3), "=&v"(h3), "=&v"(l4), "=&v"(h4), "=&v"(l5), "=&v"(h5), "=&v"(l6), "=&v"(h6), "=&v"(l7), "=&v"(h7) : "v"(a) : "memory");
    vf[0] = (bf16x8){l0[0], l0[1], l0[2], l0[3], h0[0], h0[1], h0[2], h0[3]}; vf[1] = (bf16x8){l1[0], l1[1], l1[2], l1[3], h1[0], h1[1], h1[2], h1[3]};
    vf[2] = (bf16x8){l2[0], l2[1], l2[2], l2[3], h2[0], h2[1], h2[2], h2[3]}; vf[3] = (bf16x8){l3[0], l3[1], l3[2], l3[3], h3[0], h3[1], h3[2], h3[3]};
    vf[4] = (bf16x8){l4[0], l4[1], l4[2], l4[3], h4[0], h4[1], h4[2], h4[3]}; vf[5] = (bf16x8){l5[0], l5[1], l5[2], l5[3], h5[0], h5[1], h5[2], h5[3]};
    vf[6] = (bf16x8){l6[0], l6[1], l6[2], l6[3], h6[0], h6[1], h6[2], h6[3]}; vf[7] = (bf16x8){l7[0], l7[1], l7[2], l7[3], h7[0], h7[1], h7[2], h7[3]}; }
template <int PB> __device__ __forceinline__ void phase_mlstm_t(Frame& F, const Args& a) {
    constexpr bool skK = PB & 1, skV = PB & 2, skS = PB & 4, skP = PB & 8, skE = PB & 16;
    unsigned char* ws = F.ws; const bf16* Q = (const bf16*)(ws + WS_Q); const bf16* K = (const bf16*)(ws + WS_XC); const bf16* V = (const bf16*)(ws + WS_XM); const bf16* XC = (const bf16*)(ws + WS_XC); const bf16* Z = (const bf16*)(ws + WS_Z);
    bf16* YC = (bf16*)(ws + WS_V); const float* GA = (const float*)(ws + WS_GA); const float* GAM = (const float*)(ws + WS_GAM); const float* GEM = (const float*)(ws + WS_GEM);
    const float* mh_g = a.in[27]; const float* skip = a.in[28]; const float* wvp = a.in[23];
    const int tid = F.tid, lane = F.lane, w = F.wave, fr = lane & 15, fq = lane >> 4; LAS unsigned char* lds = F.lds;
    LAS float* den2 = (LAS float*)(lds + ML_DEN); LAS float* stats = (LAS float*)(lds + ML_ST); LAS float* mr = (LAS float*)(lds + ML_MR); LAS float* em_s = (LAS float*)(lds + ML_AT); LAS float* as_s = (LAS float*)(lds + ML_AS);
    const int st = w & 1, tp = (w >> 1) & 1, wv = w & 3;
    const unsigned vtr_lane = (unsigned)((8 * fq + ((lane & 15) >> 2)) * ML_PITCH + (128 * wv + 4 * (lane & 3)) * 2);
#define ML_DMA(gbase, tile_off) do { _Pragma("unroll") for (int r4 = 0; r4 < 4; ++r4) { const int rr = w + 8 * r4; \
        __builtin_amdgcn_global_load_lds((const unsigned*)((gbase) + (size_t)rr * CI + lane * 8), (LAS unsigned*)(lds + (tile_off) + rr * ML_PITCH), 16, 0, 0); } } while (0)
#define ML_STEP_HEAD() const int buf = k & 1; int j = k + jstart; if (j >= nk) j -= nk; int jn = j + 1; if (jn >= nk) jn -= nk; \
        asm volatile("s_waitcnt vmcnt(0) lgkmcnt(0)" ::: "memory"); __builtin_amdgcn_s_barrier(); asm volatile("" ::: "memory"); \
        if (k + 1 < nk && !skK) ML_DMA(Kb + (size_t)(32 * jn) * CI, ML_K + (buf ^ 1) * ML_TILE); \
        if (k < nk && !skV) ML_DMA(Vb + (size_t)(32 * j) * CI, ML_V + buf * ML_TILE)
    for (int r = 0; r < 8; ++r) { const int xcd = F.bid & 7, cq = F.bid >> 3, c16 = cq & 15; if (F.G != 256) break;
        const int part = r & 1, qi = part ? 31 - c16 : c16, bh = xcd + 8 * ((cq >> 4) + 2 * (r >> 1)), bl = bh >> 2, h = bh & 3; const size_t t0 = (size_t)bl * SEQ + 64 * qi; const int nk = 2 * (qi + 1), jstart = part ? 2 * (c16 + 1) : 0;
        const bf16* Kb = K + (size_t)bl * SEQ * CI + h * 512; const bf16* Vb = V + (size_t)bl * SEQ * CI + h * 512;
        ML_DMA(Kb + (size_t)(32 * jstart) * CI, ML_K);
        float tb_e, tb_a[4];
        tb_e = GEM[(t0 + (tid & 63)) * 4 + h];
#pragma unroll
        for (int i4 = 0; i4 < 4; ++i4) tb_a[i4] = GA[((size_t)bl * SEQ + tid + 512 * i4) * 4 + h];
#define ML_TABLES() do { if (tid < 64) em_s[tid] = tb_e; _Pragma("unroll") for (int i4 = 0; i4 < 4; ++i4) { const int sidx = tid + 512 * i4; if (sidx < 64 * (qi + 1)) as_s[sidx] = tb_a[i4] * LOG2E; } } while (0)
        const int c8 = lane * 8, cc = h * 512 + c8;
#define ML_EPI_LOADS(N, ROW0) v4u zr[N], xr[N]; float gm[8], sk[8]; asm volatile("" ::: "memory"); __builtin_amdgcn_sched_barrier(0); if (!skE) { _Pragma("unroll") for (int k8 = 0; k8 < N; ++k8) { const size_t off = (t0 + (ROW0) + k8) * CI + cc; zr[k8] = *(const v4u*)(Z + off); xr[k8] = *(const v4u*)(XC + off); } \
        _Pragma("unroll") for (int q = 0; q < 8; ++q) { gm[q] = mh_g[cc + q]; sk[q] = skip[cc + q]; } }
#define ML_EPI_PASS(N, ROW0) if (!skE) { const LAS float* ytile = (const LAS float*)lds; _Pragma("unroll") for (int k8 = 0; k8 < N; ++k8) { const int row = (ROW0) + k8; const size_t off = (t0 + row) * CI + cc; \
              const f32x4 y0 = *(const LAS f32x4*)(ytile + row * 516 + c8), y1 = *(const LAS f32x4*)(ytile + row * 516 + c8 + 4); float zf[8], xf[8], o[8]; unpack8(zr[k8], zf); unpack8(xr[k8], xf); \
              float s1 = ((y0[0] + y0[1]) + (y0[2] + y0[3])) + ((y1[0] + y1[1]) + (y1[2] + y1[3])), s2 = ((y0[0] * y0[0] + y0[1] * y0[1]) + (y0[2] * y0[2] + y0[3] * y0[3])) + ((y1[0] * y1[0] + y1[1] * y1[1]) + (y1[2] * y1[2] + y1[3] * y1[3])); \
              s1 = wave_sum(s1); s2 = wave_sum(s2); const float mean = s1 * (1.f / 512.f), rstd = rsqrtf(fmaxf(s2 * (1.f / 512.f) - mean * mean, 0.f) + 1e-5f); \
              _Pragma("unroll") for (int q = 0; q < 8; ++q) { const float yv = ((q < 4 ? y0[q & 3] : y1[q & 3]) - mean) * rstd; o[q] = (yv * gm[q] + sk[q] * xf[q]) * (zf[q] * sigm(zf[q])); } \
              *(v4u*)(YC + off) = pack8(o); } }
        if (w < 4) {
            bf16x8 qf[2][16];
            { const bf16* qp = Q + (t0 + 32 * tp + fr) * CI + h * 512 + fq * 8;
#pragma unroll
              for (int ks = 0; ks < 16; ++ks) { qf[0][ks] = *(const bf16x8*)(qp + 32 * ks); qf[1][ks] = *(const bf16x8*)(qp + 16 * CI + 32 * ks); } }
            const float At0 = GAM[(t0 + 32 * tp + fr) * 4 + h] * LOG2E, At1 = GAM[(t0 + 32 * tp + 16 + fr) * 4 + h] * LOG2E;
            ML_TABLES();
            float denp0 = 0.f, denp1 = 0.f;
            for (int k = 0; k <= nk; ++k) { ML_STEP_HEAD();
                if (k < nk && !skS) {
                    f32x4 s0a = {0.f, 0.f, 0.f, 0.f}, s0b = {0.f, 0.f, 0.f, 0.f}, s1a = {0.f, 0.f, 0.f, 0.f}, s1b = {0.f, 0.f, 0.f, 0.f};
                    { const LAS unsigned char* kl = lds + ML_K + buf * ML_TILE + (16 * st + fr) * ML_PITCH + fq * 16; bf16x8 kc[4], kn[4];
#pragma unroll
                      for (int q = 0; q < 4; ++q) kc[q] = *(const LAS bf16x8*)(kl + 64 * q);
#pragma unroll
                      for (int g = 0; g < 4; ++g) {
                          if (g < 3) {
#pragma unroll
                              for (int q = 0; q < 4; ++q) kn[q] = *(const LAS bf16x8*)(kl + 64 * (4 * g + 4 + q)); }
                          __builtin_amdgcn_sched_barrier(0);
#pragma unroll
                          for (int q = 0; q < 4; q += 2) { const int ks = 4 * g + q;
                              s0a = __builtin_amdgcn_mfma_f32_16x16x32_bf16(kc[q], qf[0][ks], s0a, 0, 0, 0); s1a = __builtin_amdgcn_mfma_f32_16x16x32_bf16(kc[q], qf[1][ks], s1a, 0, 0, 0);
                              s0b = __builtin_amdgcn_mfma_f32_16x16x32_bf16(kc[q + 1], qf[0][ks + 1], s0b, 0, 0, 0); s1b = __builtin_amdgcn_mfma_f32_16x16x32_bf16(kc[q + 1], qf[1][ks + 1], s1b, 0, 0, 0); }
                          __builtin_amdgcn_sched_barrier(0);
                          if (g < 3) {
#pragma unroll
                              for (int q = 0; q < 4; ++q) kc[q] = kn[q]; } } }
                    s0a += s0b; s1a += s1b;
                    const f32x4 asv = *(const LAS f32x4*)(as_s + 32 * j + 16 * st + 4 * fq); const float as[4] = {asv[0], asv[1], asv[2], asv[3]};
                    float p0[4], p1[4]; const int sbase = 32 * j + 16 * st + 4 * fq, tbase = 64 * qi + 32 * tp + fr;
                    if (32 * j + 31 <= 64 * qi + 32 * tp) {
#pragma unroll
                        for (int i = 0; i < 4; ++i) { p0[i] = s0a[i] * __builtin_amdgcn_exp2f(as[i] - At0); p1[i] = s1a[i] * __builtin_amdgcn_exp2f(as[i] - At1); }
                    } else {
#pragma unroll
                        for (int i = 0; i < 4; ++i) { p0[i] = (sbase + i) <= tbase ? s0a[i] * __builtin_amdgcn_exp2f(as[i] - At0) : 0.f; p1[i] = (sbase + i) <= tbase + 16 ? s1a[i] * __builtin_amdgcn_exp2f(as[i] - At1) : 0.f; } }
                    denp0 += (p0[0] + p0[1]) + (p0[2] + p0[3]); denp1 += (p1[0] + p1[1]) + (p1[2] + p1[3]);
                    { LAS unsigned char* pp = lds + ML_P + buf * ML_PT + (32 * tp + fr) * ML_PP + (16 * st + 4 * fq) * 2; v2u pw; pw.x = pk2(p0[0], p0[1]); pw.y = pk2(p0[2], p0[3]); *(LAS v2u*)pp = pw;
                      pw.x = pk2(p1[0], p1[1]); pw.y = pk2(p1[2], p1[3]); *(LAS v2u*)(pp + 16 * ML_PP) = pw; }
                } }
            ML_EPI_LOADS(12, 12 * w);
            { float wt[8];
#pragma unroll
              for (int u = 0; u < 8; ++u) { const int col = 2 * tid + (u >> 2); wt[u] = wvp[(size_t)(h * 128 + (col >> 2)) * 16 + 4 * (u & 3) + (col & 3)]; }
              *(LAS f32x4*)(as_s + 8 * tid) = (f32x4){wt[0], wt[1], wt[2], wt[3]}; *(LAS f32x4*)(as_s + 8 * tid + 4) = (f32x4){wt[4], wt[5], wt[6], wt[7]}; }
            { float d0 = denp0, d1 = denp1; d0 += __shfl_xor(d0, 16); d1 += __shfl_xor(d1, 16); d0 += __shfl_xor(d0, 32); d1 += __shfl_xor(d1, 32);
              if (fq == 0) { den2[st * 64 + 32 * tp + fr] = d0; den2[st * 64 + 32 * tp + 16 + fr] = d1; } }
            LDS_WAIT(); __builtin_amdgcn_s_barrier(); asm volatile("" ::: "memory");
            __builtin_amdgcn_s_barrier(); asm volatile("" ::: "memory");
            ML_EPI_PASS(12, 12 * w)
        } else {
            f32x4 O[4][8];
#pragma unroll
            for (int i = 0; i < 4; ++i)
#pragma unroll
                for (int e = 0; e < 8; ++e) O[i][e] = (f32x4){0.f, 0.f, 0.f, 0.f};
            ML_TABLES();
            for (int k = 0; k <= nk; ++k) { ML_STEP_HEAD();
                if (k >= 1 && !skP) { bf16x8 vf[8], pf[4]; const unsigned vb = (unsigned)(size_t)(lds + ML_V + (buf ^ 1) * ML_TILE) + vtr_lane; const LAS unsigned char* pl = lds + ML_P + (buf ^ 1) * ML_PT + fr * ML_PP + fq * 16;
#pragma unroll
                    for (int i = 0; i < 4; ++i) pf[i] = *(const LAS bf16x8*)(pl + 16 * i * ML_PP);
                    tr_read_v8(vb, vf);
#pragma unroll
                    for (int i = 0; i < 4; ++i)
#pragma unroll
                        for (int e = 0; e < 8; ++e) O[i][e] = __builtin_amdgcn_mfma_f32_16x16x32_bf16(pf[i], vf[e], O[i][e], 0, 0, 0); } }
            LDS_WAIT(); __builtin_amdgcn_s_barrier(); asm volatile("" ::: "memory");
            { const LAS float* den_q = den2 + 4 * fq; const LAS float* em_q = em_s + 4 * fq; LAS float* yt_q = (LAS float*)lds + 4 * fq * 516 + 128 * wv + fr; float inv[16];
#pragma unroll
              for (int i = 0; i < 4; ++i)
#pragma unroll
                for (int jj = 0; jj < 4; ++jj) { const float dn = den_q[16 * i + jj] + den_q[64 + 16 * i + jj]; inv[4 * i + jj] = 1.0f / fmaxf(fabsf(dn), em_q[16 * i + jj]); }
#pragma unroll
              for (int e = 0; e < 8; ++e) { const f32x4 wl = *(const LAS f32x4*)(as_s + (128 * wv + 16 * e + fr) * 4);
#pragma unroll
                for (int i = 0; i < 4; ++i)
#pragma unroll
                    for (int jj = 0; jj < 4; ++jj) { const float x = O[i][e][jj] * inv[4 * i + jj];
                        yt_q[(16 * i + jj) * 516 + 16 * e] = fmaf(DPP_MOVF(x, 0xFF), wl[3], fmaf(DPP_MOVF(x, 0xAA), wl[2], fmaf(DPP_MOVF(x, 0x55), wl[1], DPP_MOVF(x, 0x00) * wl[0]))); } } }
            LDS_WAIT(); __builtin_amdgcn_s_barrier(); asm volatile("" ::: "memory");
            ML_EPI_LOADS(4, 48 + 4 * wv);
            ML_EPI_PASS(4, 48 + 4 * wv)
        }
        VM_WAIT(); __syncthreads();
    }
#undef ML_DMA
#undef ML_STEP_HEAD
#undef ML_TABLES
#undef ML_EPI_LOADS
#undef ML_EPI_PASS
}
__device__ __forceinline__ void phase_mlstm(Frame& F, const Args& a) { phase_mlstm_t<0>(F, a); }
#ifdef ML_PROBE
__device__ __forceinline__ void phase_mlstm_probe(Frame& F, const Args& a) { phase_mlstm_t<ML_PROBE>(F, a); }
#endif

#ifdef ML_DMAPROBE
__device__ __forceinline__ void phase_mlstm_dmaprobe(Frame& F, const Args& a) {
    unsigned char* ws = F.ws; const bf16* K = (const bf16*)(ws + WS_K); const bf16* V = (const bf16*)(ws + WS_V);
    const int lane = F.lane, w = F.wave; LAS unsigned char* lds = F.lds;
#define MLP_DMA(gbase, tile_off) do { _Pragma("unroll") for (int r4 = 0; r4 < 4; ++r4) { const int rr = w + 8 * r4; \
        __builtin_amdgcn_global_load_lds((const unsigned*)((gbase) + (size_t)rr * CI + lane * 8), (LAS unsigned*)(lds + (tile_off) + rr * ML_PITCH), 16, 0, 0); } } while (0)
    for (int r = 0; r < 8; ++r) { const int xcd = F.bid & 7, cq = F.bid >> 3, c16 = cq & 15; if (F.G != 256) break;
        const int part = r & 1, qi = part ? 31 - c16 : c16, bh = xcd + 8 * ((cq >> 4) + 2 * (r >> 1)), bl = bh >> 2, h = bh & 3; const int nk = 2 * (qi + 1), jstart = part ? 2 * (c16 + 1) : 0;
        const bf16* Kb = K + (size_t)bl * SEQ * CI + h * 512; const bf16* Vb = V + (size_t)bl * SEQ * CI + h * 512;
        for (int k = 0; k <= nk; ++k) { const int buf = k & 1; int j = k + jstart; if (j >= nk) j -= nk; int jn = j + 1; if (jn >= nk) jn -= nk;
            asm volatile("s_waitcnt vmcnt(0) lgkmcnt(0)" ::: "memory"); __builtin_amdgcn_s_barrier(); asm volatile("" ::: "memory");
            if ((ML_DMAPROBE & 1) && k + 1 < nk) MLP_DMA(Kb + (size_t)(32 * jn) * CI, ML_K + (buf ^ 1) * ML_TILE);
            if ((ML_DMAPROBE & 2) && k < nk) MLP_DMA(Vb + (size_t)(32 * j) * CI, ML_V + buf * ML_TILE);
        }
        VM_WAIT(); __syncthreads();
    }
#undef MLP_DMA
}
#endif
#ifdef ML_DMAPROBE
#define ML_PROBE_CALL phase_mlstm_dmaprobe(F, args);
#elif defined(ML_PROBE)
#define ML_PROBE_CALL phase_mlstm_probe(F, args);
#else
#define ML_PROBE_CALL
#endif
#define GEMM_PHASE(EPI, Aptr, Bptr, M_, N_, K_, ...) do { pg8::Gemm g{(const pg8::bf16_t*)(Aptr), (const pg8::bf16_t*)(Bptr), (M_), (N_), (K_)}; pg8::StaticOrder So; So.init((M_), (N_), F.G, F.bid); \
        pg8::EPI Ep{__VA_ARGS__}; pg8::gemm_phase<pg8::EPI, pg8::StaticOrder, PG8_ALIGN, PG8_SP2>(F.lds, g, So, Ep); } while (0)
namespace pg8 { typedef EpiRes2<float> EpiResF; typedef EpiRes2<bf16_t> EpiResB; typedef EpiPle2<false> EpiPleB; typedef EpiPle2<true> EpiPleF; }
__global__ void __launch_bounds__(NWAVES * 64, 2) trunk_fwd(Args args) {
    extern __shared__ __attribute__((aligned(16))) unsigned char lds_raw[];
    Frame F; F.lds = (LAS unsigned char*)lds_raw; F.ws = args.ws; F.in = nullptr;
    F.tid = threadIdx.x; F.lane = F.tid & 63; F.wave = __builtin_amdgcn_readfirstlane(F.tid >> 6); F.G = gridDim.x; F.bid = blockIdx.x;
    volatile LAS unsigned* MISC = (volatile LAS unsigned*)(F.lds + MISC_OFF);
    if (F.tid < 64) MISC[F.tid] = 0u;
    __syncthreads();
    XcdBarrier bar; bar.bar = (unsigned*)(args.ws + WS_CTL) + CW_BAR; bar.x = 0; bar.st = nullptr;
    if (args.use_bar) bar = xcd_barrier_post((unsigned*)(args.ws + WS_CTL) + CW_BAR, MISC + 8);
    unsigned* xrank = (unsigned*)(args.ws + WS_CTL) + CW_XRANK; const unsigned my_xcc = xb_xcc_id();
    if (args.use_bar && F.tid == 0) MISC[12] = xb_add(&xrank[64 * my_xcc], 1u);
    const int lo = args.ph_lo, hi = args.ph_hi;
#ifndef ONLY_SITE
#define ONLY_SITE -1
#endif
#define EN(n) (ONLY_SITE < 0 || ONLY_SITE == (n))
#ifndef REP_MASK
#define REP_MASK 0u
#endif
#define NREP(n) (((REP_MASK >> (n)) & 1u) ? 2 : 1)
#define IN(k) (lo <= (k) && (k) < hi)
#define SEAM(k) do { if (IN(k) && IN((k) + 1)) xcd_barrier(bar); } while (0)
    unsigned char* ws = args.ws; float* out = args.out;
    float* RS = (float*)(ws + WS_RS);
#define RSN(i) (RS + (size_t)(i) * T * 16)
#define PH(site, k, ...) if (EN(site) && IN(k)) { for (int rep_ = 0; rep_ < NREP(site); ++rep_) { if (rep_) xcd_barrier(bar); __VA_ARGS__ } } SEAM(k);
    PH(0, 0, phase_prologue(F, args); phase_cast_sq(F, args.in[0], (bf16*)(ws + WS_XB2), RSN(0), T); phase_cvt_p(F, args.in[1], (bf16*)(ws + WS_PB));)
    if (args.use_bar && lo == 0 && hi > 1) {
        bool ok = F.G == 256; for (int x = 0; x < 16; ++x) { const unsigned cx = xb_ld(&xrank[64 * x]); ok = ok && (cx == (x < 8 ? 32u : 0u)); }
        const unsigned rk = MISC[12]; if (ok && rk < 32u && my_xcc < 8u) F.bid = (int)(rk * 8u + my_xcc); }
    PH(2, 1, GEMM_PHASE(EpiBf16SplitR, ws + WS_XB2, ws + WS_WIN, T, NU, D, (pg8::bf16_t*)(ws + WS_UA), UA_W, 4, (pg8::bf16_t*)(ws + WS_UB), UB_W, RSN(0));)
    PH(3, 2, phase_prepA(F, args);)
    PH(4, 3, GEMM_PHASE(EpiBf16Split, ws + WS_LIN, ws + WS_WLORA, T, 1536, 256 + args.pad, (pg8::bf16_t*)(ws + WS_LOUT), 1536, 1 << 20, nullptr, 0);)
    PH(5, 4, phase_indexer(F);)
    PH(6, 5, phase_dsa_attn(F, args);)
    PH(7, 6, phase_rwkv(F, args);)
    PH(8, 7, GEMM_PHASE(EpiResF, ws + WS_XB, ws + WS_WOUT, T, D, D, args.in[0], (pg8::bf16_t*)(ws + WS_XB2), D, RSN(1));)
#define FFN_PLE(L, pb, rs_a, rs_b, rs_c, PLE_EPI, ple_out) do { const size_t lw = (size_t)(L) * WS_LAYER_STRIDE; \
        PH(21, (pb), GEMM_PHASE(EpiSwigluR, ws + WS_XB2, ws + WS_WGU0 + lw, T, 2 * FF, D, (pg8::bf16_t*)(ws + WS_H), FF, RSN(rs_a));) \
        PH(22, (pb) + 1, GEMM_PHASE(EpiResB, ws + WS_H, ws + WS_WD0 + lw, T, D, FF, (const pg8::bf16_t*)(ws + WS_XB2), (pg8::bf16_t*)(ws + WS_XB), D, RSN(rs_b));) \
        PH(24, (pb) + 2, GEMM_PHASE(EpiBf16Split, ws + WS_PB, ws + WS_WPLE0 + lw, T, D, 256 + args.pad, (pg8::bf16_t*)(ws + WS_E), D, 1 << 20, nullptr, 0);) \
        PH(25, (pb) + 3, GEMM_PHASE(PLE_EPI, ws + WS_XB, ws + WS_WPG0 + lw, T, D, D, (const pg8::bf16_t*)(ws + WS_XB), (void*)(ple_out), (const pg8::bf16_t*)(ws + WS_E), D, RSN(rs_b), RSN(rs_c));) } while (0)
#define L1_HALF(hb, p1) do { bf16* xbh = (bf16*)(ws + WS_XB2) + (size_t)(hb) * TH * D; \
        PH(11, (p1), GEMM_PHASE(EpiBf16SplitR, xbh, ws + WS_WUP, TH, 2 * CI, D, (pg8::bf16_t*)(ws + WS_XM), CI, 8, (pg8::bf16_t*)(ws + WS_Z), CI, RSN(3) + (size_t)(hb) * TH * 16);) \
        PH(12, (p1) + 1, phase_l1prep(F, args, hb);) \
        PH(13, (p1) + 2, phase_gatescan(F); if ((hb) == 0) phase_cvt_p(F, args.in[1] + (size_t)T * 256, (bf16*)(ws + WS_PB));) \
        PH(14, (p1) + 3, ML_PROBE_CALL phase_mlstm(F, args);) \
        PH(15, (p1) + 4, GEMM_PHASE(EpiResB, ws + WS_V, ws + WS_WDOWN, TH, D, CI, (const pg8::bf16_t*)xbh, (pg8::bf16_t*)xbh, D, RSN(4) + (size_t)(hb) * TH * 16);) } while (0)
    FFN_PLE(0, 8, 1, 2, 3, EpiPleB, ws + WS_XB2);
    L1_HALF(0, 12);
    L1_HALF(1, 17);
    FFN_PLE(1, 22, 4, 5, 5, EpiPleF, out);
#undef IN
#undef SEAM
}
constexpr int N_PHASES = 26;

#ifndef MK_ONE_LAUNCH
#define MK_ONE_LAUNCH 1
#endif
extern "C" void kernel_launch(void* const* d_in, const int* in_sizes, int n_in, void* d_out, int out_size, void* d_ws, size_t ws_size, hipStream_t stream) {
    static int grid = 0;
    if (grid == 0) {
        if (n_in != 37 || in_sizes[0] != T * D || out_size != T * D || ws_size < WS_END) { fprintf(stderr, "kernel_launch: unexpected shapes (n_in %d, in0 %d, out %d, ws %zu < %zu); nothing launched\n", n_in, n_in > 0 ? in_sizes[0] : -1, out_size, ws_size, (size_t)WS_END); grid = -1; return; }
        int dev = 0, cus = 0, per_cu = 0;
        if (hipGetDevice(&dev) != hipSuccess || hipDeviceGetAttribute(&cus, hipDeviceAttributeMultiprocessorCount, dev) != hipSuccess) { grid = -1; return; }
        if (hipFuncSetAttribute((const void*)trunk_fwd, hipFuncAttributeMaxDynamicSharedMemorySize, LDS_BYTES) != hipSuccess) { fprintf(stderr, "kernel_launch: hipFuncSetAttribute failed\n"); grid = -1; return; }
        if (hipOccupancyMaxActiveBlocksPerMultiprocessor(&per_cu, (const void*)trunk_fwd, NWAVES * 64, LDS_BYTES) != hipSuccess || per_cu < 1) { fprintf(stderr, "kernel_launch: occupancy query says %d\n", per_cu); }
        (void)hipGetLastError();
        grid = cus;
        if (grid != 256) { fprintf(stderr, "kernel_launch: built for 256 CUs, found %d; nothing launched\n", cus); grid = -1; return; }
    }
    if (grid < 0) return;
    if (hipMemsetAsync((char*)d_ws + WS_CTL, 0, CTL_ZERO_BYTES, stream) != hipSuccess) return;
    Args a{};
    for (int i = 0; i < 37; ++i) a.in[i] = (const float*)d_in[i];
    a.out = (float*)d_out; a.ws = (unsigned char*)d_ws; a.pad = 0;
#if MK_ONE_LAUNCH
    a.ph_lo = 0; a.ph_hi = N_PHASES; a.use_bar = 1;
    hipLaunchKernelGGL(trunk_fwd, dim3(grid), dim3(NWAVES * 64), LDS_BYTES, stream, a);
#else
    for (int p = 0; p < N_PHASES; ++p) { a.ph_lo = p; a.ph_hi = p + 1; a.use_bar = 0; hipLaunchKernelGGL(trunk_fwd, dim3(grid), dim3(NWAVES * 64), LDS_BYTES, stream, a); }
#endif
}
```

```cpp
#include <hip/hip_runtime.h>
#include <cstdio>
#include <cstdint>
namespace pg8 {
#define PG8_LAS __attribute__((address_space(3)))
typedef unsigned short bf16_t;
typedef short bf16x8 __attribute__((ext_vector_type(8)));
typedef float f32x4 __attribute__((ext_vector_type(4)));
typedef unsigned u32x4 __attribute__((ext_vector_type(4)));
constexpr int BM = 256, BK = 64, HALF = 128, HTB = HALF * BK * 2  , STAGE_BYTES = 8 * HTB, NXCD = 8, WGM = 8;

__host__ __device__ __forceinline__ int lds_byte(int r, int c) { const int st = (r >> 4) * 2 + (c >> 5), rr = r & 15, cc = c & 31, ob = rr * 64 + cc * 2; return st * 1024 + (ob ^ (((ob >> 9) & 1) << 5)); }
__host__ __device__ __forceinline__ void stage_rc(int b, int& R, int& C) { const int st = b / 1024, sb = b % 1024, swz = sb ^ (((sb >> 9) & 1) << 5); R = (st >> 1) * 16 + swz / 64; C = (st & 1) * 32 + (swz % 64) / 2; }
__host__ __device__ __forceinline__ int perm32(int rho) { const int n = rho >> 4, i = rho & 15; return 8 * (i >> 2) + 4 * n + (i & 3); }

struct Unit { int pm, pn; };
struct Gemm { const bf16_t* A; const bf16_t* Bt; int M, N, K; };

struct StaticOrder {
    int nM, nN, nwg, G, c;
    __host__ __device__ void init(int M, int N, int G_, int c_) { nM = M / BM; nN = N / BM; nwg = nM * nN; G = G_; c = c_; }
    __host__ __device__ bool next(int i, Unit& u) const {
        const long L = (long)i * G + c; if (L >= nwg) return false;
        int wgid = (int)L; { const int q = nwg / NXCD, r = nwg % NXCD, xcd = wgid % NXCD, off = wgid / NXCD; wgid = (xcd < r ? xcd * (q + 1) : r * (q + 1) + (xcd - r) * q) + off; }
        const int nig = WGM * nN, gid = wgid / nig, fm = gid * WGM, gsz = (nM - fm) < WGM ? (nM - fm) : WGM;
        u.pm = fm + ((wgid % nig) % gsz); u.pn = (wgid % nig) / gsz; return true;
    }
    __device__ __forceinline__ void a_ready(const Unit&) const {}
    __device__ __forceinline__ void done(const Unit&) const {}
};

__device__ __forceinline__ unsigned cvt_pk_bf16(float lo, float hi) { unsigned r; asm volatile("v_cvt_pk_bf16_f32 %0, %1, %2" : "=v"(r) : "v"(lo), "v"(hi)); return r; }
typedef float f32x2 __attribute__((ext_vector_type(2)));
__device__ __forceinline__ f32x2 gelu_pk(f32x2 v) {
    const f32x2 av = __builtin_elementwise_abs(v), d = av * 0.2316418882f + 1.0f;
    f32x2 t; t.x = __builtin_amdgcn_rcpf(d.x); t.y = __builtin_amdgcn_rcpf(d.y);
    f32x2 q = t * 0.5307027145f + (-0.7265760135f); q = q * t + 0.7107068705f; q = q * t + (-0.142248368f); q = q * t + 0.127414796f; q = q * t;
    const f32x2 s = (v * v) * (-0.72134752044f);
    f32x2 e; e.x = __builtin_amdgcn_exp2f(s.x); e.y = __builtin_amdgcn_exp2f(s.y);
    const f32x2 m = v * (q * e), r = v - m;
    f32x2 o; o.x = v.x < 0.f ? m.x : r.x; o.y = v.y < 0.f ? m.y : r.y; return o;
}

template <class Epi, class Sched, bool ALIGN_EPI = false, bool SP2 = false>
__device__ __forceinline__ void gemm_phase(PG8_LAS unsigned char* lds, const Gemm g, const Sched& S, const Epi& E) {
    const int tid = threadIdx.x, wid = __builtin_amdgcn_readfirstlane(tid >> 6), lane = tid & 63, wr = wid >> 2, wc = wid & 3, fr = lane & 15, fq = lane >> 4;
    const int K = g.K, nt = K / BK;
    unsigned voffA[2], voffB[2];
#pragma unroll
    for (int i = 0; i < 2; ++i) { int R, C; stage_rc(tid * 16 + i * 8192, R, C); const int Rb = Epi::PERM ? ((R & ~31) + perm32(R & 31)) : R;
        voffA[i] = (unsigned)(R * K + C) * 2u; voffB[i] = (unsigned)(Rb * K + C) * 2u; }
    const size_t kstep = (size_t)(BK * 2);
    const size_t hstep = (size_t)HALF * K * 2;
    const size_t tstep = 2 * hstep;
    const unsigned ldsw = (unsigned)wid * 1024u;
    const int aoff = lds_byte(wr * 64 + fr, fq * 8), boff = lds_byte(wc * 32 + fr, fq * 8);
#define PG8_SA(b, h) (((b) * 2 + (h)) * HTB)
#define PG8_SB(b, h) ((4 + (b) * 2 + (h)) * HTB)
#define PG8_STAGE(bufoff, gbase, voff) do { _Pragma("unroll") for (int _i = 0; _i < 2; ++_i) \
        __builtin_amdgcn_global_load_lds((const unsigned*)((const char*)(gbase) + (voff)[_i]), (PG8_LAS unsigned*)(lds + (bufoff) + ldsw + _i * 8192), 16, 0, 0); } while (0)
#define PG8_LDA(dst, b, h) do { _Pragma("unroll") for (int m = 0; m < 4; ++m) _Pragma("unroll") for (int k = 0; k < 2; ++k) dst[m][k] = *(const PG8_LAS bf16x8*)(lds + PG8_SA(b, h) + aoff + m * 2048 + k * 1024); } while (0)
#define PG8_LDB(dst, b, h) do { _Pragma("unroll") for (int n = 0; n < 2; ++n) _Pragma("unroll") for (int k = 0; k < 2; ++k) dst[n][k] = *(const PG8_LAS bf16x8*)(lds + PG8_SB(b, h) + boff + n * 2048 + k * 1024); } while (0)
#define PG8_MMA(ai, bj, At, Bt) do { __builtin_amdgcn_s_setprio(1); _Pragma("unroll") for (int m = 0; m < 4; ++m) _Pragma("unroll") for (int n = 0; n < 2; ++n) _Pragma("unroll") for (int k = 0; k < 2; ++k) \
        acc[ai][bj][m][n] = __builtin_amdgcn_mfma_f32_16x16x32_bf16(Bt[n][k], At[m][k], acc[ai][bj][m][n], 0, 0, 0); __builtin_amdgcn_s_setprio(0); } while (0)
#define PG8_WAIT_V(n) asm volatile("s_waitcnt vmcnt(" #n ")" ::: "memory")
#define PG8_WAIT_L(n) asm volatile("s_waitcnt lgkmcnt(" #n ")" ::: "memory")
#define PG8_BAR __builtin_amdgcn_s_barrier()
#define PG8_SCHED __builtin_amdgcn_sched_barrier(0)
    Unit cur, nxt; int ui = 0;
    if (!S.next(0, cur)) return;
    f32x4 acc[2][2][4][2];
#pragma unroll
    for (int a = 0; a < 2; ++a)
#pragma unroll
        for (int b = 0; b < 2; ++b)
#pragma unroll
            for (int m = 0; m < 4; ++m)
#pragma unroll
                for (int n = 0; n < 2; ++n) acc[a][b][m][n] = (f32x4){0.f, 0.f, 0.f, 0.f};
    bf16x8 At[4][2], B0[2][2], B1[2][2];
    const char* cA = (const char*)g.A + (size_t)cur.pm * tstep; const char* cB = (const char*)g.Bt + (size_t)cur.pn * tstep;
    S.a_ready(cur);
    if constexpr (SP2) {
        PG8_STAGE(PG8_SB(0, 0), cB, voffB); PG8_STAGE(PG8_SB(0, 1), cB + hstep, voffB); PG8_STAGE(PG8_SA(0, 0), cA, voffA); PG8_STAGE(PG8_SA(0, 1), cA + hstep, voffA);
        if (wr == 1) PG8_BAR;
        PG8_WAIT_V(2); PG8_BAR;
        PG8_STAGE(PG8_SB(1, 0), cB + kstep, voffB); PG8_STAGE(PG8_SA(1, 0), cA + kstep, voffA); PG8_STAGE(PG8_SB(1, 1), cB + hstep + kstep, voffB);
        PG8_WAIT_V(6); PG8_BAR;
    } else {
        PG8_STAGE(PG8_SB(0, 0), cB, voffB); PG8_STAGE(PG8_SA(0, 0), cA, voffA); PG8_STAGE(PG8_SB(0, 1), cB + hstep, voffB); PG8_STAGE(PG8_SA(0, 1), cA + hstep, voffA);
        if (wr == 1) PG8_BAR;
        PG8_WAIT_V(4); PG8_BAR;
        PG8_STAGE(PG8_SB(1, 0), cB + kstep, voffB); PG8_STAGE(PG8_SA(1, 0), cA + kstep, voffA); PG8_STAGE(PG8_SB(1, 1), cB + hstep + kstep, voffB);
        PG8_WAIT_V(6); PG8_BAR;
    }
    for (;;) {
        const bool has_next = S.next(ui + 1, nxt);
        const char* nA = has_next ? (const char*)g.A + (size_t)nxt.pm * tstep : cA; const char* nB = has_next ? (const char*)g.Bt + (size_t)nxt.pn * tstep : cB;
        for (int t = 0; t < nt; t += 2) {
            const bool last = (t == nt - 2);
            const char* a1 = cA + (size_t)(t + 1) * kstep;
            const char* a2 = last ? nA : cA + (size_t)(t + 2) * kstep; const char* b2 = last ? nB : cB + (size_t)(t + 2) * kstep;
            const char* a3 = a2 + kstep; const char* b3 = b2 + kstep;
            if (last && has_next) S.a_ready(nxt);
            if constexpr (SP2) {
            PG8_LDB(B0, 0, 0); PG8_LDB(B1, 0, 1); PG8_SCHED; PG8_LDA(At, 0, 0); PG8_STAGE(PG8_SA(1, 1), a1 + hstep, voffA);
            PG8_WAIT_V(8); PG8_WAIT_L(0); PG8_BAR; PG8_MMA(0, 0, At, B0); PG8_MMA(0, 1, At, B1); PG8_BAR; PG8_SCHED;
            PG8_LDA(At, 0, 1); PG8_STAGE(PG8_SB(0, 0), b2, voffB); PG8_STAGE(PG8_SB(0, 1), b2 + hstep, voffB); PG8_STAGE(PG8_SA(0, 0), a2, voffA);
            PG8_WAIT_V(8); PG8_WAIT_L(0); PG8_BAR; PG8_MMA(1, 0, At, B0); PG8_MMA(1, 1, At, B1); PG8_BAR; PG8_SCHED;
            PG8_LDB(B0, 1, 0); PG8_LDB(B1, 1, 1); PG8_SCHED; PG8_LDA(At, 1, 0); PG8_STAGE(PG8_SA(0, 1), a2 + hstep, voffA);
            PG8_WAIT_V(8); PG8_WAIT_L(0); PG8_BAR; PG8_MMA(0, 0, At, B0); PG8_MMA(0, 1, At, B1); PG8_BAR; PG8_SCHED;
            PG8_LDA(At, 1, 1); PG8_STAGE(PG8_SB(1, 0), b3, voffB); PG8_STAGE(PG8_SB(1, 1), b3 + hstep, voffB); PG8_STAGE(PG8_SA(1, 0), a3, voffA);
            PG8_WAIT_V(8); PG8_WAIT_L(0); PG8_BAR; PG8_MMA(1, 0, At, B0); PG8_MMA(1, 1, At, B1); PG8_BAR; PG8_SCHED;
            } else {
            PG8_LDB(B0, 0, 0); PG8_SCHED; PG8_LDA(At, 0, 0); PG8_STAGE(PG8_SA(1, 1), a1 + hstep, voffA);
            PG8_WAIT_L(8); PG8_BAR; PG8_WAIT_L(0); PG8_MMA(0, 0, At, B0); PG8_BAR; PG8_SCHED;
            PG8_LDB(B1, 0, 1); PG8_STAGE(PG8_SB(0, 0), b2, voffB);
            PG8_BAR; PG8_WAIT_L(0); PG8_MMA(0, 1, At, B1); PG8_BAR;
            PG8_LDA(At, 0, 1); PG8_STAGE(PG8_SA(0, 0), a2, voffA);
            PG8_BAR; PG8_WAIT_L(0); PG8_MMA(1, 0, At, B0); PG8_BAR; PG8_SCHED;
            PG8_STAGE(PG8_SB(0, 1), b2 + hstep, voffB);
            PG8_WAIT_V(6); PG8_BAR; PG8_MMA(1, 1, At, B1); PG8_BAR;
            PG8_LDB(B0, 1, 0); PG8_SCHED; PG8_LDA(At, 1, 0); PG8_STAGE(PG8_SA(0, 1), a2 + hstep, voffA);
            PG8_WAIT_L(8); PG8_BAR; PG8_WAIT_L(0); PG8_MMA(0, 0, At, B0); PG8_BAR; PG8_SCHED;
            PG8_LDB(B1, 1, 1); PG8_STAGE(PG8_SB(1, 0), b3, voffB);
            PG8_BAR; PG8_WAIT_L(0); PG8_MMA(0, 1, At, B1); PG8_BAR;
            PG8_LDA(At, 1, 1); PG8_STAGE(PG8_SA(1, 0), a3, voffA);
            PG8_BAR; PG8_WAIT_L(0); PG8_MMA(1, 0, At, B0); PG8_BAR; PG8_SCHED;
            PG8_STAGE(PG8_SB(1, 1), b3 + hstep, voffB);
            PG8_WAIT_V(6); PG8_BAR; PG8_MMA(1, 1, At, B1); PG8_BAR;
            }
        }
        if constexpr (ALIGN_EPI) { if (wr == 0) PG8_BAR; }
        if constexpr (!Epi::AFTER_DRAIN) { E(acc, cur, wr, wc, fr, fq); S.done(cur); }
        if (!has_next) break;
#pragma unroll
        for (int a = 0; a < 2; ++a)
#pragma unroll
            for (int b = 0; b < 2; ++b)
#pragma unroll
                for (int m = 0; m < 4; ++m)
#pragma unroll
                    for (int n = 0; n < 2; ++n) acc[a][b][m][n] = (f32x4){0.f, 0.f, 0.f, 0.f};
        cur = nxt; cA = nA; cB = nB; ++ui;
        if constexpr (ALIGN_EPI) { if (wr == 1) PG8_BAR; }
    }
    PG8_WAIT_V(0);
    if constexpr (!ALIGN_EPI) { if (wr == 0) PG8_BAR; }
    PG8_BAR;
    if constexpr (Epi::AFTER_DRAIN) { E.fused(acc, cur, wr, wc, fr, fq, lds, wid, lane); S.done(cur); }
#undef PG8_SA
#undef PG8_SB
#undef PG8_STAGE
#undef PG8_LDA
#undef PG8_LDB
#undef PG8_MMA
#undef PG8_WAIT_V
#undef PG8_WAIT_L
#undef PG8_BAR
#undef PG8_SCHED
}
}
namespace pg8 {
__device__ __forceinline__ float sigmoidf_(float x) { return __builtin_amdgcn_rcpf(1.0f + __builtin_amdgcn_exp2f(-1.4426950408889634f * x)); }
struct EpiBf16Split {
    static constexpr bool PERM = true, AFTER_DRAIN = false;
    bf16_t* O0; int ld0; int nt0; bf16_t* O1; int ld1;
    __device__ __forceinline__ void operator()(const f32x4 (&acc)[2][2][4][2], const Unit& u, int wr, int wc, int fr, int fq) const {
        const bool first = u.pn < nt0; bf16_t* base = first ? O0 : O1; const int ld = first ? ld0 : ld1; const int colt = (first ? u.pn : u.pn - nt0) * BM;
        const int row0 = u.pm * BM + wr * 64 + fr, col0 = colt + wc * 32 + 8 * fq;
#pragma unroll
        for (int ai = 0; ai < 2; ++ai)
#pragma unroll
            for (int m = 0; m < 4; ++m) { bf16_t* rowp = base + (size_t)(row0 + ai * HALF + m * 16) * ld + col0;
#pragma unroll
                for (int bj = 0; bj < 2; ++bj) { const f32x4 v0 = acc[ai][bj][m][0], v1 = acc[ai][bj][m][1];
                    u32x4 w; w.x = cvt_pk_bf16(v0[0], v0[1]); w.y = cvt_pk_bf16(v0[2], v0[3]); w.z = cvt_pk_bf16(v1[0], v1[1]); w.w = cvt_pk_bf16(v1[2], v1[3]);
                    *(u32x4*)(rowp + bj * HALF) = w; } }
    }
};
struct EpiResF32 {
    static constexpr bool PERM = false, AFTER_DRAIN = false;
    const float* base; float* out; int ldc;
    __device__ __forceinline__ void operator()(const f32x4 (&acc)[2][2][4][2], const Unit& u, int wr, int wc, int fr, int fq) const {
        const int row0 = u.pm * BM + wr * 64 + fr, col0 = u.pn * BM + wc * 32 + 4 * fq;
#pragma unroll
        for (int ai = 0; ai < 2; ++ai)
#pragma unroll
            for (int m = 0; m < 4; ++m) { const size_t off = (size_t)(row0 + ai * HALF + m * 16) * ldc + col0;
#pragma unroll
                for (int bj = 0; bj < 2; ++bj)
#pragma unroll
                    for (int n = 0; n < 2; ++n) { const f32x4 b = *(const f32x4*)(base + off + bj * HALF + n * 16); *(f32x4*)(out + off + bj * HALF + n * 16) = b + acc[ai][bj][m][n]; } }
    }
};
struct EpiSwiglu {
    static constexpr bool PERM = false, AFTER_DRAIN = false;
    bf16_t* H; int ldh;
    __device__ __forceinline__ void operator()(const f32x4 (&acc)[2][2][4][2], const Unit& u, int wr, int wc, int fr, int fq) const {
        const int row0 = u.pm * BM + wr * 64 + fr, hc0 = u.pn * (BM / 2) + wc * 16 + 4 * fq;
#pragma unroll
        for (int ai = 0; ai < 2; ++ai)
#pragma unroll
            for (int m = 0; m < 4; ++m) { bf16_t* rowp = H + (size_t)(row0 + ai * HALF + m * 16) * ldh + hc0;
#pragma unroll
                for (int bj = 0; bj < 2; ++bj) { const f32x4 g = acc[ai][bj][m][0], up = acc[ai][bj][m][1]; float h[4];
#pragma unroll
                    for (int i = 0; i < 4; ++i) h[i] = g[i] * sigmoidf_(g[i]) * up[i];
                    typedef unsigned u32x2 __attribute__((ext_vector_type(2)));
                    u32x2 w; w.x = cvt_pk_bf16(h[0], h[1]); w.y = cvt_pk_bf16(h[2], h[3]);
                    *(u32x2*)(rowp + bj * (HALF / 2)) = w; } }
    }
};
struct EpiPle {
    static constexpr bool PERM = false, AFTER_DRAIN = false;
    const float* base; float* out; const bf16_t* E; int ldc;
    __device__ __forceinline__ void operator()(const f32x4 (&acc)[2][2][4][2], const Unit& u, int wr, int wc, int fr, int fq) const {
        const int row0 = u.pm * BM + wr * 64 + fr, col0 = u.pn * BM + wc * 32 + 4 * fq;
        typedef unsigned u32x2 __attribute__((ext_vector_type(2)));
#pragma unroll
        for (int ai = 0; ai < 2; ++ai)
#pragma unroll
            for (int m = 0; m < 4; ++m) { const size_t off = (size_t)(row0 + ai * HALF + m * 16) * ldc + col0;
#pragma unroll
                for (int bj = 0; bj < 2; ++bj)
#pragma unroll
                    for (int n = 0; n < 2; ++n) { const size_t o = off + bj * HALF + n * 16; const f32x4 b = *(const f32x4*)(base + o); const u32x2 e = *(const u32x2*)(E + o); const f32x4 a = acc[ai][bj][m][n];
                        f32x4 r; r[0] = b[0] + __uint_as_float(e.x << 16) * sigmoidf_(a[0]); r[1] = b[1] + __uint_as_float(e.x & 0xffff0000u) * sigmoidf_(a[1]);
                        r[2] = b[2] + __uint_as_float(e.y << 16) * sigmoidf_(a[2]); r[3] = b[3] + __uint_as_float(e.y & 0xffff0000u) * sigmoidf_(a[3]);
                        *(f32x4*)(out + o) = r; } }
    }
};
__device__ __forceinline__ float rms_r(const float* rsq, int row) { const f32x4* p = (const f32x4*)(rsq + (size_t)row * 16); const f32x4 a = p[0], b = p[1], c = p[2], d = p[3];
    const float s = (((a[0] + a[1]) + (a[2] + a[3])) + ((b[0] + b[1]) + (b[2] + b[3]))) + (((c[0] + c[1]) + (c[2] + c[3])) + ((d[0] + d[1]) + (d[2] + d[3]))); return rsqrtf(s * (1.0f / 1024.0f) + 1e-6f); }
__device__ __forceinline__ void norm_out(const f32x4 (&x)[2][2], bf16_t* xb, size_t off, float* rsq_out, int row, int fq, int slot) {
    typedef unsigned u32x2 __attribute__((ext_vector_type(2))); float s = 0.f;
#pragma unroll
    for (int bj = 0; bj < 2; ++bj)
#pragma unroll
        for (int n = 0; n < 2; ++n) { const f32x4 v = x[bj][n]; s += (v[0] * v[0] + v[1] * v[1]) + (v[2] * v[2] + v[3] * v[3]); u32x2 w; w.x = cvt_pk_bf16(v[0], v[1]); w.y = cvt_pk_bf16(v[2], v[3]); *(u32x2*)(xb + off + bj * HALF + n * 16) = w; }
    s += __shfl_xor(s, 16); s += __shfl_xor(s, 32);
    if (fq == 0) rsq_out[(size_t)row * 16 + slot] = s;
}
struct EpiBf16SplitR {
    static constexpr bool PERM = true, AFTER_DRAIN = false;
    bf16_t* O0; int ld0; int nt0; bf16_t* O1; int ld1; const float* rsq;
    __device__ __forceinline__ void operator()(const f32x4 (&acc)[2][2][4][2], const Unit& u, int wr, int wc, int fr, int fq) const {
        const bool first = u.pn < nt0; bf16_t* base = first ? O0 : O1; const int ld = first ? ld0 : ld1; const int colt = (first ? u.pn : u.pn - nt0) * BM;
        const int row0 = u.pm * BM + wr * 64 + fr, col0 = colt + wc * 32 + 8 * fq;
#pragma unroll
        for (int ai = 0; ai < 2; ++ai)
#pragma unroll
            for (int m = 0; m < 4; ++m) { const int row = row0 + ai * HALF + m * 16; const float r = rms_r(rsq, row); bf16_t* rowp = base + (size_t)row * ld + col0;
#pragma unroll
                for (int bj = 0; bj < 2; ++bj) { const f32x4 v0 = acc[ai][bj][m][0] * r, v1 = acc[ai][bj][m][1] * r;
                    u32x4 w; w.x = cvt_pk_bf16(v0[0], v0[1]); w.y = cvt_pk_bf16(v0[2], v0[3]); w.z = cvt_pk_bf16(v1[0], v1[1]); w.w = cvt_pk_bf16(v1[2], v1[3]);
                    *(u32x4*)(rowp + bj * HALF) = w; } }
    }
};
struct EpiSwigluR {
    static constexpr bool PERM = false, AFTER_DRAIN = false;
    bf16_t* H; int ldh; const float* rsq;
    __device__ __forceinline__ void operator()(const f32x4 (&acc)[2][2][4][2], const Unit& u, int wr, int wc, int fr, int fq) const {
        const int row0 = u.pm * BM + wr * 64 + fr, hc0 = u.pn * (BM / 2) + wc * 16 + 4 * fq;
#pragma unroll
        for (int ai = 0; ai < 2; ++ai)
#pragma unroll
            for (int m = 0; m < 4; ++m) { const int row = row0 + ai * HALF + m * 16; const float r = rms_r(rsq, row); bf16_t* rowp = H + (size_t)row * ldh + hc0;
#pragma unroll
                for (int bj = 0; bj < 2; ++bj) { const f32x4 g = acc[ai][bj][m][0] * r, up = acc[ai][bj][m][1] * r; float h[4];
#pragma unroll
                    for (int i = 0; i < 4; ++i) h[i] = g[i] * sigmoidf_(g[i]) * up[i];
                    typedef unsigned u32x2 __attribute__((ext_vector_type(2)));
                    u32x2 w; w.x = cvt_pk_bf16(h[0], h[1]); w.y = cvt_pk_bf16(h[2], h[3]);
                    *(u32x2*)(rowp + bj * (HALF / 2)) = w; } }
    }
};
struct EpiResN {
    static constexpr bool PERM = false, AFTER_DRAIN = false;
    const float* base; float* out; int ldc; bf16_t* XBo; float* rsq_out;
    __device__ __forceinline__ void operator()(const f32x4 (&acc)[2][2][4][2], const Unit& u, int wr, int wc, int fr, int fq) const {
        const int row0 = u.pm * BM + wr * 64 + fr, col0 = u.pn * BM + wc * 32 + 4 * fq;
#pragma unroll
        for (int ai = 0; ai < 2; ++ai)
#pragma unroll
            for (int m = 0; m < 4; ++m) { const int row = row0 + ai * HALF + m * 16; const size_t off = (size_t)row * ldc + col0; f32x4 x[2][2];
#pragma unroll
                for (int bj = 0; bj < 2; ++bj)
#pragma unroll
                    for (int n = 0; n < 2; ++n) { const f32x4 b = *(const f32x4*)(base + off + bj * HALF + n * 16); x[bj][n] = b + acc[ai][bj][m][n]; *(f32x4*)(out + off + bj * HALF + n * 16) = x[bj][n]; }
                if (XBo) norm_out(x, XBo, off, rsq_out, row, fq, u.pn * 4 + wc); }
    }
};
struct EpiPleN {
    static constexpr bool PERM = false, AFTER_DRAIN = false;
    const float* base; float* out; const bf16_t* E; int ldc; const float* rsq_in; bf16_t* XBo; float* rsq_out;
    __device__ __forceinline__ void operator()(const f32x4 (&acc)[2][2][4][2], const Unit& u, int wr, int wc, int fr, int fq) const {
        const int row0 = u.pm * BM + wr * 64 + fr, col0 = u.pn * BM + wc * 32 + 4 * fq;
        typedef unsigned u32x2 __attribute__((ext_vector_type(2)));
#pragma unroll
        for (int ai = 0; ai < 2; ++ai)
#pragma unroll
            for (int m = 0; m < 4; ++m) { const int row = row0 + ai * HALF + m * 16; const size_t off = (size_t)row * ldc + col0; const float r = rms_r(rsq_in, row); f32x4 x[2][2];
#pragma unroll
                for (int bj = 0; bj < 2; ++bj)
#pragma unroll
                    for (int n = 0; n < 2; ++n) { const size_t o = off + bj * HALF + n * 16; const f32x4 b = *(const f32x4*)(base + o); const u32x2 e = *(const u32x2*)(E + o); const f32x4 a = acc[ai][bj][m][n] * r;
                        f32x4 v; v[0] = b[0] + __uint_as_float(e.x << 16) * sigmoidf_(a[0]); v[1] = b[1] + __uint_as_float(e.x & 0xffff0000u) * sigmoidf_(a[1]);
                        v[2] = b[2] + __uint_as_float(e.y << 16) * sigmoidf_(a[2]); v[3] = b[3] + __uint_as_float(e.y & 0xffff0000u) * sigmoidf_(a[3]);
                        x[bj][n] = v; *(f32x4*)(out + o) = v; }
                if (XBo) norm_out(x, XBo, off, rsq_out, row, fq, u.pn * 4 + wc); }
    }
};
__device__ __forceinline__ f32x4 ld_base4(const float* p) { return *(const f32x4*)p; }
__device__ __forceinline__ f32x4 ld_base4(const bf16_t* p) { typedef unsigned u32x2 __attribute__((ext_vector_type(2))); const u32x2 e = *(const u32x2*)p; return (f32x4){__uint_as_float(e.x << 16), __uint_as_float(e.x & 0xffff0000u), __uint_as_float(e.y << 16), __uint_as_float(e.y & 0xffff0000u)}; }
template <class BaseT> struct EpiRes2 {
    static constexpr bool PERM = false, AFTER_DRAIN = false;
    const BaseT* base; bf16_t* out; int ldc; float* rsq_out;
    __device__ __forceinline__ void operator()(const f32x4 (&acc)[2][2][4][2], const Unit& u, int wr, int wc, int fr, int fq) const {
        const int row0 = u.pm * BM + wr * 64 + fr, col0 = u.pn * BM + wc * 32 + 4 * fq;
#pragma unroll
        for (int ai = 0; ai < 2; ++ai)
#pragma unroll
            for (int m = 0; m < 4; ++m) { const int row = row0 + ai * HALF + m * 16; const size_t off = (size_t)row * ldc + col0; f32x4 x[2][2];
#pragma unroll
                for (int bj = 0; bj < 2; ++bj)
#pragma unroll
                    for (int n = 0; n < 2; ++n) x[bj][n] = ld_base4(base + off + bj * HALF + n * 16) + acc[ai][bj][m][n];
                norm_out(x, out, off, rsq_out, row, fq, u.pn * 4 + wc); }
    }
};
template <bool OUT_F32> struct EpiPle2 {
    static constexpr bool PERM = false, AFTER_DRAIN = false;
    const bf16_t* base; void* out; const bf16_t* E; int ldc; const float* rsq_in; float* rsq_out;
    __device__ __forceinline__ void operator()(const f32x4 (&acc)[2][2][4][2], const Unit& u, int wr, int wc, int fr, int fq) const {
        const int row0 = u.pm * BM + wr * 64 + fr, col0 = u.pn * BM + wc * 32 + 4 * fq;
#pragma unroll
        for (int ai = 0; ai < 2; ++ai)
#pragma unroll
            for (int m = 0; m < 4; ++m) { const int row = row0 + ai * HALF + m * 16; const size_t off = (size_t)row * ldc + col0; const float r = rms_r(rsq_in, row); f32x4 x[2][2];
#pragma unroll
                for (int bj = 0; bj < 2; ++bj)
#pragma unroll
                    for (int n = 0; n < 2; ++n) { const size_t o = off + bj * HALF + n * 16; const f32x4 b = ld_base4(base + o), e = ld_base4(E + o), a = acc[ai][bj][m][n] * r; f32x4 v;
#pragma unroll
                        for (int i = 0; i < 4; ++i) v[i] = b[i] + e[i] * sigmoidf_(a[i]);
                        x[bj][n] = v; if (OUT_F32) *(f32x4*)((float*)out + o) = v; }
                if (!OUT_F32) norm_out(x, (bf16_t*)out, off, rsq_out, row, fq, u.pn * 4 + wc); }
    }
};
}
#ifndef PG8_SP2
#define PG8_SP2 true
#endif
#ifndef PG8_ALIGN
#define PG8_ALIGN true
#endif
constexpr int NB = 32, SEQ = 2048, T = NB * SEQ, D = 1024;
constexpr int NU = 2816, UA_W = 1024, UB_W = 1792;
constexpr int FF = 2816, CI = 2048, TH = T / 2;
constexpr int NWAVES = 8;
constexpr float NORM_EPS = 1e-6f, LOG2E = 1.4426950408889634f;
constexpr int UA_K = 512, UA_V = 576, UA_IQ = 640, UA_IK = 896, UA_IW = 960;
constexpr size_t MiB = 1u << 20, QMiB = 1u << 18;
constexpr size_t WS_CTL = 0, CTL_ZERO_BYTES = 1 * MiB;
constexpr size_t WS_WIN = 4 * QMiB, WS_WLORA = 26 * QMiB, WS_WOUT = 29 * QMiB;
constexpr size_t WS_WGU0 = 37 * QMiB, WS_WD0 = 81 * QMiB, WS_WPLE0 = 103 * QMiB, WS_WPG0 = 105 * QMiB, WS_LAYER_STRIDE = 76 * QMiB;
constexpr size_t WS_WUP = 189 * QMiB, WS_WDOWN = 221 * QMiB, WS_W12 = 237 * QMiB;
static_assert(WS_WPG0 + 8 * QMiB == WS_WGU0 + WS_LAYER_STRIDE && WS_WPG0 + WS_LAYER_STRIDE + 8 * QMiB == WS_WUP && WS_W12 + QMiB <= 60 * MiB, "weight map");
constexpr size_t ACT = 60 * MiB;
constexpr size_t WS_XB = ACT, WS_UA = ACT + 128 * MiB, WS_UB = ACT + 256 * MiB, WS_LIN = ACT + 480 * MiB, WS_LOUT = ACT + 512 * MiB;
constexpr size_t WS_QN = ACT + 704 * MiB, WS_KN = ACT + 768 * MiB, WS_VT = ACT + 776 * MiB, WS_MASK = ACT + 784 * MiB;
constexpr size_t WS_XB2 = ACT + 768 * MiB;
constexpr size_t WS_H = ACT + 128 * MiB, WS_E = ACT + 480 * MiB, WS_PB = ACT + 896 * MiB;
constexpr size_t WS_XM = ACT, WS_Z = ACT + 128 * MiB, WS_XC = ACT + 256 * MiB, WS_Q = ACT + 384 * MiB, WS_K = ACT + 512 * MiB, WS_V = ACT + 640 * MiB;
constexpr size_t WS_RS = ACT + 928 * MiB, RS_ONE = (size_t)T * 16 * 4;
constexpr size_t WS_GI = ACT + 952 * MiB, WS_GA = WS_GI + 1 * MiB, WS_GAM = WS_GI + 2 * MiB, WS_GEM = WS_GI + 3 * MiB;
constexpr size_t WS_END = ACT + 956 * MiB;
static_assert(WS_END <= 1024 * MiB, "workspace");
constexpr int CW_TMO = 0, CW_BAR = 4096, CW_XRANK = 8192;
constexpr int LDS_BYTES = 155648;
constexpr int MISC_OFF = LDS_BYTES - 256;
#define GAS __attribute__((address_space(1)))
#define LAS __attribute__((address_space(3)))
typedef unsigned short bf16;
typedef unsigned v4u __attribute__((ext_vector_type(4)));
typedef unsigned v2u __attribute__((ext_vector_type(2)));
typedef float f32x4 __attribute__((ext_vector_type(4)));
typedef float f32x2 __attribute__((ext_vector_type(2)));
typedef float f32x8 __attribute__((ext_vector_type(8)));
typedef short bf16x8 __attribute__((ext_vector_type(8)));
typedef short s16x4 __attribute__((ext_vector_type(4)));
typedef GAS unsigned gu32;
#define RLX_AGENT __ATOMIC_RELAXED, __HIP_MEMORY_SCOPE_AGENT
#define LDS_WAIT() asm volatile("s_waitcnt lgkmcnt(0)" ::: "memory")
#define VM_WAIT() asm volatile("s_waitcnt vmcnt(0)" ::: "memory")
__device__ __forceinline__ unsigned f2bf(float f) { unsigned u = __builtin_bit_cast(unsigned, f); return (u + 0x7fffu + ((u >> 16) & 1u)) >> 16; }

#define XB_TMO      128
#define XB_XCNT(j)  (256  + 64 * (j))
#define XB_XSUB(j)  (1280 + 64 * (j))
#define XB_XGEN(j)  (2304 + 64 * (j))
#define XB_TOP      3328
#define XB_TOPGEN   3392
#define XCD_BAR_WORDS 3456
#define XB_SPIN_CAP (1u << 18)

__device__ __forceinline__ unsigned xb_ld(unsigned* p)              { return __hip_atomic_load(p, __ATOMIC_RELAXED, __HIP_MEMORY_SCOPE_AGENT); }
__device__ __forceinline__ unsigned xb_add(unsigned* p, unsigned v) { return __hip_atomic_fetch_add(p, v, __ATOMIC_RELAXED, __HIP_MEMORY_SCOPE_AGENT); }
__device__ __forceinline__ unsigned xb_xcc_id() { return (unsigned)__builtin_amdgcn_s_getreg((3 << 11) | 20) & 0xFu; }
#define XB_SPIN(cond, bar) do { unsigned _sp = 0; while (cond) { __builtin_amdgcn_s_sleep(1); \
    if ((++_sp & 255u) == 0u) { if (xb_ld(&(bar)[XB_TMO])) break; if (_sp > XB_SPIN_CAP) { atomicAdd(&(bar)[XB_TMO], 1u); break; } } } } while (0)

struct XcdBarrier {
    unsigned* bar; unsigned x;
    volatile LAS unsigned* st;
};

__device__ __forceinline__ XcdBarrier xcd_barrier_post(unsigned* bar, volatile LAS unsigned* st) {
    XcdBarrier b; b.bar = bar; b.x = xb_xcc_id(); b.st = st;
    if (threadIdx.x == 0) (void)xb_add(&bar[XB_XCNT(b.x)], 1u);
    return b;
}
__device__ __forceinline__ void xcd_barrier_complete(unsigned* bar, unsigned x, unsigned& nloc, unsigned& nx) {
    const unsigned G = gridDim.x * gridDim.y * gridDim.z;
    unsigned sum, cnt, mine, sp = 0u;
    for (;;) {
        sum = 0u; cnt = 0u; mine = 0u;
#pragma unroll
        for (unsigned j = 0; j < 16; ++j) { const unsigned c = xb_ld(&bar[XB_XCNT(j)]); sum += c; cnt += (c > 0u) ? 1u : 0u; mine = (j == x) ? c : mine; }
        if (sum == G) break;
        __builtin_amdgcn_s_sleep(1);
        if ((++sp & 255u) == 0u) { if (xb_ld(&bar[XB_TMO])) break; if (sp > XB_SPIN_CAP) { atomicAdd(&bar[XB_TMO], 1u); break; } }
    }
    nloc = mine > 0u ? mine : 1u; nx = cnt > 0u ? cnt : 1u;
}

__device__ __forceinline__ void xcd_barrier(const XcdBarrier& b) {
    asm volatile("s_waitcnt vmcnt(0)" ::: "memory");
    __syncthreads();
    if (threadIdx.x == 0) {
        unsigned* bar = b.bar;
        __builtin_amdgcn_s_waitcnt(0);
        unsigned nloc = b.st[0], nx = b.st[1];
        if (nloc == 0u) { xcd_barrier_complete(bar, b.x, nloc, nx); b.st[0] = nloc; b.st[1] = nx; }
        const unsigned old = xb_add(&bar[XB_XSUB(b.x)], 1u);
        const unsigned gen = old / nloc;
        if (old + 1u == (gen + 1u) * nloc) {
            __builtin_amdgcn_fence(__ATOMIC_RELEASE, "agent");
            asm volatile("s_waitcnt vmcnt(0)" ::: "memory");
            const unsigned og = xb_add(&bar[XB_TOP], 1u);
            const unsigned tg = og / nx;
            if (og + 1u == (tg + 1u) * nx) xb_add(&bar[XB_TOPGEN], 1u);
            else XB_SPIN(xb_ld(&bar[XB_TOPGEN]) == tg, bar);
            __builtin_amdgcn_fence(__ATOMIC_ACQUIRE, "agent");
            xb_add(&bar[XB_XGEN(b.x)], 1u);
            asm volatile("s_waitcnt vmcnt(0)" ::: "memory");
        } else {
            XB_SPIN(xb_ld(&bar[XB_XGEN(b.x)]) == gen, bar);
            __builtin_amdgcn_fence(__ATOMIC_ACQUIRE, "agent");
            asm volatile("s_waitcnt vmcnt(0)" ::: "memory");
        }
    }
    __syncthreads();
}

struct Frame {
    LAS unsigned char* lds;
    unsigned char* ws;
    const float* const* in;
    int tid, lane, wave, G, bid;
};
struct Args { const float* in[37]; float* out; unsigned char* ws; int ph_lo, ph_hi, use_bar, pad; };

__device__ __forceinline__ float dpp_f(float v, int ctrl_qp1) { return v; }
#define DPP_MOVF(v, ctrl) __builtin_bit_cast(float, __builtin_amdgcn_mov_dpp(__builtin_bit_cast(int, (v)), (ctrl), 0xf, 0xf, true))
__device__ __forceinline__ float wave_sum(float v) {
    v += DPP_MOVF(v, 0xB1);
    v += DPP_MOVF(v, 0x4E);
    v += DPP_MOVF(v, 0x141);
    v += DPP_MOVF(v, 0x140);
    v += __shfl_xor(v, 16); v += __shfl_xor(v, 32);
    return v;
}
__device__ __forceinline__ float wave_max(float v) {
#pragma unroll
    for (int o = 1; o < 64; o <<= 1) v = fmaxf(v, __shfl_xor(v, o));
    return v;
}
__device__ __forceinline__ float bflo(unsigned u) { return __uint_as_float(u << 16); }
__device__ __forceinline__ float bfhi(unsigned u) { return __uint_as_float(u & 0xffff0000u); }
__device__ __forceinline__ float bf1(bf16 h) { return __uint_as_float(((unsigned)h) << 16); }
__device__ __forceinline__ unsigned pk2(float lo, float hi) { return pg8::cvt_pk_bf16(lo, hi); }
__device__ __forceinline__ float sigm(float x) { return __builtin_amdgcn_rcpf(1.0f + __builtin_amdgcn_exp2f(-LOG2E * x)); }
__device__ __forceinline__ float softplusf_(float x) { return fmaxf(x, 0.f) + log1pf(__expf(-fabsf(x))); }
__device__ __forceinline__ void unpack8(const v4u& r, float (&f)[8]) { f[0] = bflo(r.x); f[1] = bfhi(r.x); f[2] = bflo(r.y); f[3] = bfhi(r.y); f[4] = bflo(r.z); f[5] = bfhi(r.z); f[6] = bflo(r.w); f[7] = bfhi(r.w); }
__device__ __forceinline__ v4u pack8(const float (&f)[8]) { v4u o; o.x = pk2(f[0], f[1]); o.y = pk2(f[2], f[3]); o.z = pk2(f[4], f[5]); o.w = pk2(f[6], f[7]); return o; }

template <class Fn> __device__ __forceinline__ void wprep(bf16* dst, int N, int K, Fn f, int gt, int NT) {
    const int lane = gt & 63, gwv = gt >> 6, NW = NT >> 6, ntn = N >> 3, tiles = ntn * (K >> 6);
    for (int tl = gwv; tl < tiles; tl += NW) { const int n = (tl % ntn) * 8 + (lane & 7), k0 = (tl / ntn) * 64 + (lane >> 3) * 8; float v[8];
#pragma unroll
        for (int j = 0; j < 8; ++j) v[j] = f(k0 + j, n);
        *(v4u*)(dst + (size_t)n * K + k0) = pack8(v); }
}
__device__ __forceinline__ void phase_prologue(Frame& F, const Args& a) {
    const int gt = F.bid * 512 + F.tid, NT = F.G * 512; unsigned char* ws = F.ws;
    { const float* W = a.in[5]; const float* gn0 = a.in[2];
      wprep((bf16*)(ws + WS_WIN), NU, D, [=](int k, int n) { const int c = n < 964 ? n : (n < 1024 ? -1 : n - 60); return c < 0 ? 0.f : W[(size_t)k * 2756 + c] * gn0[k]; }, gt, NT); }
    { const float* w2 = a.in[8]; const float* a2 = a.in[10]; const float* g2 = a.in[11];
      wprep((bf16*)(ws + WS_WLORA), 1536, 256, [=](int k, int n) { if (n < 512) return k < 64 ? w2[k * 512 + n] : 0.f; if (n < 1024) return (k >= 64 && k < 128) ? a2[(k - 64) * 512 + n - 512] : 0.f; return k >= 128 ? g2[(k - 128) * 512 + n - 1024] : 0.f; }, gt, NT); }
    { const float* W = a.in[17]; wprep((bf16*)(ws + WS_WOUT), D, D, [=](int k, int n) { return W[(size_t)k * D + n]; }, gt, NT); }
    for (int L = 0; L < 2; ++L) {
        const float* wg = a.in[31] + (size_t)L * D * FF; const float* wu = a.in[32] + (size_t)L * D * FF; const float* wd = a.in[33] + (size_t)L * FF * D;
        const float* wp = a.in[34] + (size_t)L * 256 * D; const float* wpg = a.in[36] + (size_t)L * D * D; const float* gnf = a.in[30] + L * D; const float* gnp = a.in[35] + L * D;
        wprep((bf16*)(ws + WS_WGU0 + L * WS_LAYER_STRIDE), 2 * FF, D, [=](int k, int n) { const int hid = 16 * (n >> 5) + (n & 15); return ((n & 31) >= 16 ? wu : wg)[(size_t)k * FF + hid] * gnf[k]; }, gt, NT);
        wprep((bf16*)(ws + WS_WD0 + L * WS_LAYER_STRIDE), D, FF, [=](int k, int n) { return wd[(size_t)k * D + n]; }, gt, NT);
        wprep((bf16*)(ws + WS_WPLE0 + L * WS_LAYER_STRIDE), D, 256, [=](int k, int n) { return wp[(size_t)k * D + n]; }, gt, NT);
        wprep((bf16*)(ws + WS_WPG0 + L * WS_LAYER_STRIDE), D, D, [=](int k, int n) { return wpg[(size_t)k * D + n] * gnp[k]; }, gt, NT);
    }
    { const float* W = a.in[18]; const float* gn1 = a.in[2] + D; wprep((bf16*)(ws + WS_WUP), 2 * CI, D, [=](int k, int n) { return W[(size_t)k * (2 * CI) + n] * gn1[k]; }, gt, NT); }
    { const float* W = a.in[29]; wprep((bf16*)(ws + WS_WDOWN), D, CI, [=](int k, int n) { return W[(size_t)k * D + n]; }, gt, NT); }
    { const float* wq = a.in[21]; const float* wk = a.in[22]; const float* wv = a.in[23]; const float* wif = a.in[24]; float* W12 = (float*)(ws + WS_W12);
      for (int it = gt; it < 4096 * 8; it += NT) { const int o = it & 7, c = (it >> 3) & 2047, part = it >> 14, g = c >> 2, i = c & 3; float s = 0.f;
          if (part == 0) { for (int j = 0; j < 4; ++j) s += wq[(g * 4 + i) * 4 + j] * wif[(size_t)(4 * g + j) * 8 + o] + wk[(g * 4 + i) * 4 + j] * wif[(size_t)(2048 + 4 * g + j) * 8 + o]; }
          else { for (int j = 0; j < 4; ++j) s += wv[(g * 4 + i) * 4 + j] * wif[(size_t)(4096 + 4 * g + j) * 8 + o]; }
          W12[it] = s; } }
}
__device__ __forceinline__ void phase_norm(Frame& F, const float* src, const float* gain, bf16* dst, int nrows) {
    const int gw = F.bid * NWAVES + F.wave, NGW = F.G * NWAVES, lane = F.lane;
    f32x4 g[4];
#pragma unroll
    for (int j = 0; j < 4; ++j) g[j] = *((const f32x4*)gain + lane + 64 * j);
    for (int m = gw; m < nrows; m += NGW) {
        const f32x4* xr = (const f32x4*)(src + (size_t)m * D) + lane; f32x4 v[4]; float s = 0.f;
#pragma unroll
        for (int j = 0; j < 4; ++j) { v[j] = xr[64 * j]; s += (v[j].x * v[j].x + v[j].y * v[j].y) + (v[j].z * v[j].z + v[j].w * v[j].w); }
        const float r = rsqrtf(wave_sum(s) * (1.f / D) + NORM_EPS);
        v2u* o = (v2u*)(dst + (size_t)m * D) + lane;
#pragma unroll
        for (int j = 0; j < 4; ++j) { v2u w; w.x = pk2(v[j].x * r * g[j].x, v[j].y * r * g[j].y); w.y = pk2(v[j].z * r * g[j].z, v[j].w * r * g[j].w); o[64 * j] = w; }
    }
}
__device__ __forceinline__ void phase_cast_sq(Frame& F, const float* src, bf16* dst, float* rsq, int nrows) {
    const int gw = F.bid * NWAVES + F.wave, NGW = F.G * NWAVES, lane = F.lane;
    for (int m = gw; m < nrows; m += 2 * NGW) { const int m2 = m + NGW; const bool has2 = m2 < nrows;
        const f32x4* xr = (const f32x4*)(src + (size_t)m * D) + lane; const f32x4* xr2 = (const f32x4*)(src + (size_t)(has2 ? m2 : m) * D) + lane; f32x4 v[4], u[4]; float s = 0.f, s2 = 0.f;
#pragma unroll
        for (int j = 0; j < 4; ++j) { v[j] = xr[64 * j]; u[j] = xr2[64 * j]; }
#pragma unroll
        for (int j = 0; j < 4; ++j) { s += (v[j].x * v[j].x + v[j].y * v[j].y) + (v[j].z * v[j].z + v[j].w * v[j].w); s2 += (u[j].x * u[j].x + u[j].y * u[j].y) + (u[j].z * u[j].z + u[j].w * u[j].w); }
        s = wave_sum(s); s2 = wave_sum(s2);
        if (lane < 16) rsq[(size_t)m * 16 + lane] = lane == 0 ? s : 0.f;
        v2u* o = (v2u*)(dst + (size_t)m * D) + lane;
#pragma unroll
        for (int j = 0; j < 4; ++j) { v2u w; w.x = pk2(v[j].x, v[j].y); w.y = pk2(v[j].z, v[j].w); o[64 * j] = w; }
        if (has2) { if (lane < 16) rsq[(size_t)m2 * 16 + lane] = lane == 0 ? s2 : 0.f;
            v2u* o2 = (v2u*)(dst + (size_t)m2 * D) + lane;
#pragma unroll
            for (int j = 0; j < 4; ++j) { v2u w; w.x = pk2(u[j].x, u[j].y); w.y = pk2(u[j].z, u[j].w); o2[64 * j] = w; } }
    }
}
__device__ __forceinline__ void phase_cvt_p(Frame& F, const float* p, bf16* pb) {
    const size_t gt = (size_t)F.bid * 512 + F.tid, NT = (size_t)F.G * 512, n8 = (size_t)T * 256 / 8;
    for (size_t i0 = gt; i0 < n8; i0 += 4 * NT) { f32x4 a[4], b[4];
#pragma unroll
        for (int q4 = 0; q4 < 4; ++q4) { const size_t i = i0 + q4 * NT; if (i < n8) { a[q4] = *((const f32x4*)p + 2 * i); b[q4] = *((const f32x4*)p + 2 * i + 1); } }
#pragma unroll
        for (int q4 = 0; q4 < 4; ++q4) { const size_t i = i0 + q4 * NT; if (i < n8) { v4u o; o.x = pk2(a[q4].x, a[q4].y); o.y = pk2(a[q4].z, a[q4].w); o.z = pk2(b[q4].x, b[q4].y); o.w = pk2(b[q4].z, b[q4].w); *((v4u*)pb + i) = o; } } }
}
constexpr float QSCALE = 0.125f * LOG2E;
__device__ __forceinline__ void phase_prepA(Frame& F, const Args& a) {
    unsigned char* ws = F.ws; const bf16* UA = (const bf16*)(ws + WS_UA); const bf16* UB = (const bf16*)(ws + WS_UB);
    bf16* LIN = (bf16*)(ws + WS_LIN); bf16* QN = (bf16*)(ws + WS_QN); bf16* KN = (bf16*)(ws + WS_KN); bf16* VT = (bf16*)(ws + WS_VT);
    const float* mu = a.in[6]; const float* gq = a.in[3]; const float* gk = a.in[4];
    { const int gt = F.bid * 512 + F.tid, NT = F.G * 512; const int c8 = (gt & 31) << 3; float muv[8];
#pragma unroll
      for (int j = 0; j < 8; ++j) muv[j] = mu[1536 + c8 + j];
      for (int it0 = gt; it0 < T * 32; it0 += 4 * NT) { v4u ru[4], rp[4];
#pragma unroll
          for (int q4 = 0; q4 < 4; ++q4) { const int it = it0 + q4 * NT; if (it < T * 32) { const int t = it >> 5; ru[q4] = *(const v4u*)(UB + (size_t)t * UB_W + 1536 + c8); rp[q4] = *(const v4u*)(UB + (size_t)((t & (SEQ - 1)) ? t - 1 : t) * UB_W + 1536 + c8); } }
#pragma unroll
          for (int q4 = 0; q4 < 4; ++q4) { const int it = it0 + q4 * NT; if (it < T * 32) { const int t = it >> 5; float u[8], p[8], o[8]; unpack8(ru[q4], u); unpack8(rp[q4], p); const float pm = (t & (SEQ - 1)) ? 1.f : 0.f;
#pragma unroll
              for (int j = 0; j < 8; ++j) { const float s = u[j] + muv[j] * (p[j] * pm - u[j]); o[j] = c8 < 64 ? (1.0f - 2.0f * __builtin_amdgcn_rcpf(1.0f + __builtin_amdgcn_exp2f(2.0f * LOG2E * s))) : (c8 < 128 ? s : sigm(s));     }
              *(v4u*)(LIN + (size_t)t * 256 + c8) = pack8(o); } } } }
    { const int gw = F.bid * NWAVES + F.wave, NGW = F.G * NWAVES, lane = F.lane; float gqv[8], gkv[8];
#pragma unroll
      for (int j = 0; j < 8; ++j) { gqv[j] = gq[((lane & 7) << 3) + j] * QSCALE; gkv[j] = gk[((lane & 7) << 3) + j]; }
      for (int t0 = gw; t0 < T; t0 += 4 * NGW) { v4u rq[4], rk[4];
#pragma unroll
          for (int q4 = 0; q4 < 4; ++q4) { const int t = t0 + q4 * NGW; if (t < T) { rq[q4] = *(const v4u*)(UA + (size_t)t * UA_W + 8 * lane); rk[q4] = *(const v4u*)(UA + (size_t)t * UA_W + UA_K + 8 * (lane & 7)); } }
#pragma unroll
          for (int q4 = 0; q4 < 4; ++q4) { const int t = t0 + q4 * NGW; if (t < T) {
              float q[8], k[8]; unpack8(rq[q4], q); unpack8(rk[q4], k);
              float sq = 0.f, sk = 0.f;
#pragma unroll
              for (int j = 0; j < 8; ++j) { sq += q[j] * q[j]; sk += k[j] * k[j]; }
              sq += __shfl_xor(sq, 1); sq += __shfl_xor(sq, 2); sq += __shfl_xor(sq, 4); sk += __shfl_xor(sk, 1); sk += __shfl_xor(sk, 2); sk += __shfl_xor(sk, 4);
              const float rq_ = rsqrtf(sq * (1.f / 64.f) + NORM_EPS), rk_ = rsqrtf(sk * (1.f / 64.f) + NORM_EPS);
#pragma unroll
              for (int j = 0; j < 8; ++j) { q[j] *= rq_ * gqv[j]; k[j] *= rk_ * gkv[j]; }
              *(v4u*)(QN + (size_t)t * 512 + 8 * lane) = pack8(q);
              if (lane < 8) *(v4u*)(KN + (size_t)t * 64 + 8 * lane) = pack8(k); } } } }
    { const int gt = F.bid * 512 + F.tid, NT = F.G * 512;
      for (int it = gt; it < T * 8; it += NT) { const int t = it >> 3, c8 = (it & 7) << 3; *(v4u*)(VT + (size_t)t * 64 + c8) = *(const v4u*)(UA + (size_t)t * UA_W + UA_V + c8); } }
}
constexpr int IDX_STRIDE = 2052, KSEL = 256;
__device__ __forceinline__ void topk_select(const LAS float* row, int limit, unsigned* maskrow, int lane) {
    unsigned long long mybits = 0ull; const int nj = limit >> 6;
    if (limit <= KSEL) { mybits = lane < nj ? ~0ull : 0ull; }
    else {
        unsigned key[32];
#pragma unroll
        for (int j = 0; j < 32; ++j) key[j] = 0u;
#pragma unroll
        for (int g8 = 0; g8 < 4; ++g8) if (8 * g8 < nj) {
#pragma unroll
            for (int jj = 0; jj < 8; ++jj) { const int j = 8 * g8 + jj; unsigned u = __float_as_uint(row[64 * j + lane]); if (u == 0x80000000u) u = 0u; const unsigned k = (u & 0x80000000u) ? ~u : (u | 0x80000000u); key[j] = (j < nj) ? k : 0u; } }
        unsigned prefix = 0u; bool exact = false;
        for (int bit = 31; bit >= 0; --bit) { const unsigned cand = prefix | (1u << bit); int c0 = 0, c1 = 0;
#pragma unroll
            for (int g8 = 0; g8 < 4; ++g8) if (8 * g8 < nj) {
#pragma unroll
                for (int jj = 0; jj < 8; jj += 2) { c0 += __builtin_popcountll(__ballot(key[8 * g8 + jj] >= cand)); c1 += __builtin_popcountll(__ballot(key[8 * g8 + jj + 1] >= cand)); } }
            const int cnt = c0 + c1;
            if (cnt >= KSEL) { prefix = cand; if (cnt == KSEL) { exact = true; break; } } }
        int need = 0;
        if (!exact) { int cgt = 0;
#pragma unroll
            for (int j = 0; j < 32; ++j) cgt += __builtin_popcountll(__ballot(key[j] > prefix));
            need = KSEL - cgt; }
        int running = 0; const unsigned long long below = (1ull << lane) - 1ull;
#pragma unroll
        for (int g8 = 0; g8 < 4; ++g8) if (8 * g8 < nj)
#pragma unroll
        for (int jj = 0; jj < 8; ++jj) { const int j = 8 * g8 + jj;
            const bool gt = exact ? (key[j] >= prefix) : (key[j] > prefix); const bool tie = (!exact) && key[j] == prefix;
            const unsigned long long tb = __ballot(tie); const int rank = running + __builtin_popcountll(tb & below); running += __builtin_popcountll(tb);
            const unsigned long long sb = __ballot(gt || (tie && rank < need)); if (lane == j) mybits = sb; }
    }
    if (lane < 32) { v2u w; w.x = (unsigned)mybits; w.y = (unsigned)(mybits >> 32); *(v2u*)(maskrow + 2 * lane) = w; }
}
__device__ __forceinline__ void phase_indexer(Frame& F) {
    unsigned char* ws = F.ws; const bf16* UA = (const bf16*)(ws + WS_UA); unsigned* MASK = (unsigned*)(ws + WS_MASK);
    LAS float* sc = (LAS float*)F.lds; const int lane = F.lane, w = F.wave, fr = lane & 15, fq = lane >> 4;
    for (int r = 0;; ++r) { const int u = r * F.G + ((r & 1) ? (F.G - 1 - F.bid) : F.bid); if (u >= NB * 128) break;
        const int c = 31 - (u >> 7), rest = u & 127, b = rest >> 2, g4 = rest & 3, limit = 64 * (c + 1), tq0 = b * SEQ + c * 64 + g4 * 16;
        const bf16* UAb = UA + (size_t)b * SEQ * UA_W;
        bf16x8 qf[4][2]; float iwv[4];
        { const bf16* qp = UA + (size_t)(tq0 + fr) * UA_W;
#pragma unroll
          for (int hh = 0; hh < 4; ++hh) { qf[hh][0] = *(const bf16x8*)(qp + UA_IQ + hh * 64 + fq * 8); qf[hh][1] = *(const bf16x8*)(qp + UA_IQ + hh * 64 + 32 + fq * 8); iwv[hh] = bf1(qp[UA_IW + hh]) * (1.f / 16.f); } }
#ifndef IDX_SCORE_REP
#define IDX_SCORE_REP 1
#endif
#ifndef IDX_SEL_REP
#define IDX_SEL_REP 1
#endif
        for (int rp_ = 0; rp_ < IDX_SCORE_REP; ++rp_)
        for (int kt = w; kt < (limit >> 4); kt += NWAVES) {
            const bf16* kp = UAb + (size_t)(kt * 16 + fr) * UA_W + UA_IK + fq * 8; const bf16x8 a0 = *(const bf16x8*)kp, a1 = *(const bf16x8*)(kp + 32);
            f32x4 s = {0.f, 0.f, 0.f, 0.f};
#pragma unroll
            for (int hh = 0; hh < 4; ++hh) { f32x4 d = {0.f, 0.f, 0.f, 0.f}; d = __builtin_amdgcn_mfma_f32_16x16x32_bf16(a0, qf[hh][0], d, 0, 0, 0); d = __builtin_amdgcn_mfma_f32_16x16x32_bf16(a1, qf[hh][1], d, 0, 0, 0);
#pragma unroll
                for (int j = 0; j < 4; ++j) s[j] += iwv[hh] * fmaxf(d[j], 0.f); }
            *(LAS f32x4*)(sc + fr * IDX_STRIDE + kt * 16 + fq * 4) = s; }
        __syncthreads();
#pragma unroll 1
        for (int qq = 0; qq < 2 * IDX_SEL_REP; ++qq) { const int q = 2 * w + (qq & 1); topk_select(sc + q * IDX_STRIDE, limit, MASK + (size_t)(tq0 + q) * 64, lane); }
        __syncthreads(); }
}
constexpr int DA_K = 0, DA_V = 8192, DA_M = 16384, DA_STAGE = 16384 + 512;
__device__ __forceinline__ bf16x8 mk8(v2u lo, v2u hi) { v4u t; t.x = lo.x; t.y = lo.y; t.z = hi.x; t.w = hi.y; return __builtin_bit_cast(bf16x8, t); }
__device__ __forceinline__ void tr_read_v4d(unsigned a, bf16x8 (&vf)[4]) { s16x4 l0, h0, l1, h1, l2, h2, l3, h3;
    asm volatile("ds_read_b64_tr_b16 %0, %8\n\tds_read_b64_tr_b16 %1, %8 offset:512\n\tds_read_b64_tr_b16 %2, %8 offset:32\n\tds_read_b64_tr_b16 %3, %8 offset:544\n\t"
                 "ds_read_b64_tr_b16 %4, %8 offset:64\n\tds_read_b64_tr_b16 %5, %8 offset:576\n\tds_read_b64_tr_b16 %6, %8 offset:96\n\tds_read_b64_tr_b16 %7, %8 offset:608\n\ts_waitcnt lgkmcnt(0)"
                 : "=&v"(l0), "=&v"(h0), "=&v"(l1), "=&v"(h1), "=&v"(l2), "=&v"(h2), "=&v"(l3), "=&v"(h3) : "v"(a) : "memory");
    vf[0] = (bf16x8){l0[0], l0[1], l0[2], l0[3], h0[0], h0[1], h0[2], h0[3]}; vf[1] = (bf16x8){l1[0], l1[1], l1[2], l1[3], h1[0], h1[1], h1[2], h1[3]};
    vf[2] = (bf16x8){l2[0], l2[1], l2[2], l2[3], h2[0], h2[1], h2[2], h2[3]}; vf[3] = (bf16x8){l3[0], l3[1], l3[2], l3[3], h3[0], h3[1], h3[2], h3[3]}; }
__device__ __forceinline__ void phase_dsa_attn(Frame& F, const Args& a) {
    unsigned char* ws = F.ws; const bf16* QN = (const bf16*)(ws + WS_QN); const bf16* KN = (const bf16*)(ws + WS_KN); const bf16* VN = (const bf16*)(ws + WS_VT);
    const unsigned* MASK = (const unsigned*)(ws + WS_MASK); bf16* MIX = (bf16*)(ws + WS_XB);
    const int lane = F.lane, w = F.wave, fr = lane & 15, fq = lane >> 4; LAS unsigned char* lds = F.lds;
    const float mb = 8.f * LOG2E * wave_max(fabsf(a.in[3][lane])) * wave_max(fabsf(a.in[4][lane]));
    const unsigned vtr_lane = (unsigned)((8 * fq + ((lane & 15) >> 2)) * 128 + 4 * (lane & 3) * 2);
    for (int r = 0;; ++r) { const int u = r * F.G + ((r & 1) ? (F.G - 1 - F.bid) : F.bid); if (u >= NB * 32) break;
        const int c = 31 - (u >> 5), b = u & 31, nst = c + 1, t0 = b * SEQ + 64 * c;
        const bf16* Kb = KN + (size_t)b * SEQ * 64; const bf16* Vb = VN + (size_t)b * SEQ * 64; const unsigned* Mb = MASK + (size_t)t0 * 64;
#define DA_DMA(st_, buf_) do { const int so_ = (buf_) * DA_STAGE; \
            __builtin_amdgcn_global_load_lds((const unsigned*)(Kb + (size_t)(64 * (st_) + 8 * w) * 64 + lane * 8), (LAS unsigned*)(lds + so_ + DA_K + w * 1024), 16, 0, 0); \
            __builtin_amdgcn_global_load_lds((const unsigned*)(Vb + (size_t)(64 * (st_) + 8 * w) * 64 + lane * 8), (LAS unsigned*)(lds + so_ + DA_V + w * 1024), 16, 0, 0); \
            if (w < 2) __builtin_amdgcn_global_load_lds(Mb + (size_t)lane * 64 + 2 * (st_) + w, (LAS unsigned*)(lds + so_ + DA_M + w * 256), 4, 0, 0); } while (0)
        DA_DMA(0, 0);
        bf16x8 qf[4][2];
#pragma unroll
        for (int i = 0; i < 4; ++i) { const bf16* qp = QN + (size_t)(t0 + 16 * i + fr) * 512 + w * 64 + fq * 8; qf[i][0] = *(const bf16x8*)qp; qf[i][1] = *(const bf16x8*)(qp + 32); }
        f32x4 O[4][4]; float l[4];
#pragma unroll
        for (int i = 0; i < 4; ++i) { l[i] = 0.f;
#pragma unroll
            for (int dt = 0; dt < 4; ++dt) O[i][dt] = (f32x4){0.f, 0.f, 0.f, 0.f}; }
        for (int st = 0; st < nst; ++st) { const int buf = st & 1; const LAS unsigned char* sb = lds + buf * DA_STAGE;
            asm volatile("s_waitcnt vmcnt(0)" ::: "memory");
            __builtin_amdgcn_s_barrier(); asm volatile("" ::: "memory");
            if (st + 1 < nst) DA_DMA(st + 1, buf ^ 1);
#pragma unroll
            for (int sub = 0; sub < 2; ++sub) {
                bf16x8 kf[2][2], vf[4]; unsigned mw[4];
#pragma unroll
                for (int s2 = 0; s2 < 2; ++s2) { const LAS unsigned char* kp = sb + DA_K + (32 * sub + 8 * (fr >> 2) + 4 * s2 + (fr & 3)) * 128 + fq * 16;   kf[s2][0] = *(const LAS bf16x8*)kp; kf[s2][1] = *(const LAS bf16x8*)(kp + 64); }
#pragma unroll
                for (int i = 0; i < 4; ++i) mw[i] = *(const LAS unsigned*)(sb + DA_M + sub * 256 + (16 * i + fr) * 4);
                tr_read_v4d((unsigned)(size_t)(sb + DA_V + sub * 4096) + vtr_lane, vf);
#pragma unroll
                for (int i = 0; i < 4; ++i) {
                    f32x4 s0 = {0.f, 0.f, 0.f, 0.f}, s1 = {0.f, 0.f, 0.f, 0.f};
                    s0 = __builtin_amdgcn_mfma_f32_16x16x32_bf16(kf[0][0], qf[i][0], s0, 0, 0, 0); s0 = __builtin_amdgcn_mfma_f32_16x16x32_bf16(kf[0][1], qf[i][1], s0, 0, 0, 0);
                    s1 = __builtin_amdgcn_mfma_f32_16x16x32_bf16(kf[1][0], qf[i][0], s1, 0, 0, 0); s1 = __builtin_amdgcn_mfma_f32_16x16x32_bf16(kf[1][1], qf[i][1], s1, 0, 0, 0);
                    const unsigned b0 = mw[i] >> (8 * fq), b1 = mw[i] >> (8 * fq + 4); float p[8];
#pragma unroll
                    for (int j = 0; j < 4; ++j) { p[j] = ((b0 >> j) & 1u) ? __builtin_amdgcn_exp2f(s0[j] - mb) : 0.f; p[4 + j] = ((b1 >> j) & 1u) ? __builtin_amdgcn_exp2f(s1[j] - mb) : 0.f; }
                    l[i] += ((p[0] + p[1]) + (p[2] + p[3])) + ((p[4] + p[5]) + (p[6] + p[7]));
                    const bf16x8 pa = __builtin_bit_cast(bf16x8, pack8(p));
#pragma unroll
                    for (int dt = 0; dt < 4; ++dt) O[i][dt] = __builtin_amdgcn_mfma_f32_16x16x32_bf16(pa, vf[dt], O[i][dt], 0, 0, 0);
                } } }
#undef DA_DMA
#pragma unroll
        for (int i = 0; i < 4; ++i) { float li = l[i]; li += __shfl_xor(li, 16); li += __shfl_xor(li, 32);
#pragma unroll
            for (int j = 0; j < 4; ++j) { const float inv = 1.0f / __shfl(li, 4 * fq + j); bf16* op = MIX + (size_t)(t0 + 16 * i + 4 * fq + j) * D + w * 64 + fr;
#pragma unroll
                for (int dt = 0; dt < 4; ++dt) op[16 * dt] = (bf16)f2bf(O[i][dt][j] * inv); } }
        VM_WAIT(); __syncthreads();
    }
}
__device__ __forceinline__ float rw_decay(float x) { const float sp = fmaxf(-x, 0.f) + 0.6931471805599453f * __builtin_amdgcn_logf(1.0f + __builtin_amdgcn_exp2f(-LOG2E * fabsf(x)));
    return __builtin_amdgcn_exp2f(-LOG2E * __builtin_amdgcn_exp2f(-LOG2E * (sp + 0.5f))); }
#define MF32(a_, b_, c_) __builtin_amdgcn_mfma_f32_16x16x4f32((a_), (b_), (c_), 0, 0, 0)
constexpr int RT = 68, RG = 20, RGM = 16 * RG;
constexpr int RL_AH = 0, RL_BH = 64 * RT, RL_KH = 2 * 64 * RT, RL_RH = 3 * 64 * RT, RL_VX = 4 * 64 * RT, RL_GS = 5 * 64 * RT, RL_YA = 6 * 64 * RT, RL_GR = 7 * 64 * RT, RL_PM = RL_GR + 16 * RGM, RL_GC = RL_PM + 4 * RGM, RL_BON = RL_GC + 256, RL_END = RL_BON + 64;
static_assert(RL_END * 4 <= MISC_OFF, "RWKV LDS");
__device__ __forceinline__ void phase_rwkv(Frame& F, const Args& a) {
    unsigned char* ws = F.ws; const bf16* UB = (const bf16*)(ws + WS_UB); const bf16* LOUT = (const bf16*)(ws + WS_LOUT); bf16* MIX = (bf16*)(ws + WS_XB);
    const float* mu = a.in[6]; const float* w0 = a.in[7]; const float* a0 = a.in[9]; const float* k_k = a.in[12]; const float* k_a = a.in[13]; const float* r_k = a.in[14]; const float* gn_g = a.in[15]; const float* gn_b = a.in[16];
    const int lane = F.lane, w = F.wave, n = lane & 15, q = lane >> 4;
    LAS float* L = (LAS float*)F.lds;
    for (int bh = F.bid; bh < NB * 8; bh += F.G) {
        const int b = bh >> 3, h = bh & 7, c = h * 64 + lane;
        const float mur = mu[c], muk = mu[512 + c], muv = mu[1024 + c], w0c = w0[c], a0c = a0[c], kkc = k_k[c], kac = k_a[c], rkc = r_k[c], gng = gn_g[c], gnb = gn_b[c];
        f32x4 Z[4];
#pragma unroll
        for (int kt = 0; kt < 4; ++kt) Z[kt] = (f32x4){0.f, 0.f, 0.f, 0.f};
        const int ch = w >> 1, hs = w & 1;
        float r_ur[8], r_uk[8], r_uv[8], r_pr[8], r_pk[8], r_pv[8], r_wd[8], r_ad[8], r_gg[8], r_wf[8];
#define RW_RAW(batch_) do { _Pragma("unroll") for (int i = 0; i < 8; ++i) { const int sl = (batch_) * 64 + 16 * ch + 8 * hs + i; const size_t t = (size_t)b * SEQ + sl; const bf16* up = UB + t * UB_W + c; const bf16* pp_ = sl > 0 ? up - UB_W : up; \
            r_ur[i] = bf1(up[0]); r_uk[i] = bf1(up[512]); r_uv[i] = bf1(up[1024]); r_pr[i] = bf1(pp_[0]); r_pk[i] = bf1(pp_[512]); r_pv[i] = bf1(pp_[1024]); \
            const bf16* lp = LOUT + t * 1536 + c; r_wd[i] = bf1(lp[0]); r_ad[i] = bf1(lp[512]); r_gg[i] = bf1(lp[1024]); \
            r_wf[i] = bf1(LOUT[((size_t)b * SEQ + (batch_) * 64 + 16 * ch + i) * 1536 + c]); } } while (0)
        RW_RAW(0);
        for (int batch = 0; batch < SEQ / 64; ++batch) {
            { float gcur = 1.f;
              if (hs) {
#pragma unroll
                  for (int i = 0; i < 8; ++i) gcur *= rw_decay(w0c + r_wf[i]); }
#pragma unroll
              for (int i = 0; i < 8; ++i) { const int tl = 16 * ch + 8 * hs + i, sl = batch * 64 + tl; const float pm = sl > 0 ? 1.f : 0.f;
                const float ur = r_ur[i], uk = r_uk[i], uv = r_uv[i], pr = r_pr[i] * pm, pk = r_pk[i] * pm, pv = r_pv[i] * pm;
                const float rr = ur + mur * (pr - ur), kx = uk + muk * (pk - uk), vx = uv + muv * (pv - uv);
                const float decay = rw_decay(w0c + r_wd[i]), av = sigm(a0c + r_ad[i]);
                float kk = kx * kkc; kk = kk * rsqrtf(fmaxf(wave_sum(kk * kk), 1e-24f));
                const float km = kx * (1.f + (av - 1.f) * kac); const float bon = wave_sum(rr * km * rkc);
                const float gprev = gcur; gcur *= decay; const float ig = __builtin_amdgcn_rcpf(gcur);
                L[RL_AH + tl * RT + lane] = -kk * gprev; L[RL_BH + tl * RT + lane] = kk * av * ig; L[RL_KH + tl * RT + lane] = km * ig; L[RL_RH + tl * RT + lane] = rr * gcur;
                L[RL_VX + tl * RT + lane] = vx; L[RL_GS + tl * RT + lane] = r_gg[i]; if (lane == 0) L[RL_BON + tl] = bon; }
              if (hs) L[RL_GC + ch * 64 + lane] = gcur; }
            LDS_WAIT(); __syncthreads();
            if (batch + 1 < SEQ / 64) RW_RAW(batch + 1);
            { const LAS float* ah = L + RL_AH + 16 * ch * RT; const LAS float* bhm = L + RL_BH + 16 * ch * RT; const LAS float* khm = L + RL_KH + 16 * ch * RT; const LAS float* rhm = L + RL_RH + 16 * ch * RT;
              LAS float* gr = L + RL_GR + ch * 4 * RGM; LAS float* pm_ = L + RL_PM + ch * RGM;
              if (hs == 0) {
                  f32x4 m = {0.f, 0.f, 0.f, 0.f};
#pragma unroll
                  for (int s = 0; s < 16; ++s) m = MF32(bhm[n * RT + 4 * s + q], ah[n * RT + 4 * s + q], m);
                  f32x4 tm;
#pragma unroll
                  for (int j = 0; j < 4; ++j) { m[j] = (4 * q + j < n) ? m[j] : 0.f; tm[j] = m[j] + ((4 * q + j == n) ? 1.f : 0.f); pm_[(4 * q + j) * RG + n] = m[j]; gr[(4 * q + j) * RG + n] = tm[j]; }
#pragma unroll
                  for (int rd = 0; rd < 3; ++rd) { LDS_WAIT();
                      f32x4 p2 = {0.f, 0.f, 0.f, 0.f};
#pragma unroll
                      for (int s = 0; s < 4; ++s) p2 = MF32(pm_[n * RG + 4 * s + q], pm_[(4 * s + q) * RG + n], p2);
                      f32x4 ip, t2 = {0.f, 0.f, 0.f, 0.f};
#pragma unroll
                      for (int j = 0; j < 4; ++j) ip[j] = p2[j] + ((4 * q + j == n) ? 1.f : 0.f);
#pragma unroll
                      for (int j = 0; j < 4; ++j) t2 = MF32(gr[n * RG + 4 * q + j], ip[j], t2);
                      LDS_WAIT();
#pragma unroll
                      for (int j = 0; j < 4; ++j) { pm_[(4 * q + j) * RG + n] = p2[j]; gr[(4 * q + j) * RG + n] = t2[j]; } }
              } else {
                  f32x4 mk = {0.f, 0.f, 0.f, 0.f}, nb = {0.f, 0.f, 0.f, 0.f}, nk = {0.f, 0.f, 0.f, 0.f};
#pragma unroll
                  for (int s = 0; s < 16; ++s) { const float av_ = ah[n * RT + 4 * s + q], rv_ = rhm[n * RT + 4 * s + q], bv_ = bhm[n * RT + 4 * s + q], kv_ = khm[n * RT + 4 * s + q];
                      mk = MF32(kv_, av_, mk); nb = MF32(bv_, rv_, nb); nk = MF32(kv_, rv_, nk); }
#pragma unroll
                  for (int j = 0; j < 4; ++j) { const int s_ = 4 * q + j; gr[RGM + s_ * RG + n] = (s_ < n) ? mk[j] : 0.f; gr[2 * RGM + s_ * RG + n] = (s_ <= n) ? nb[j] : 0.f; gr[3 * RGM + s_ * RG + n] = (s_ <= n) ? nk[j] : 0.f; } } }
            LDS_WAIT(); __syncthreads();
#ifndef RW_C_REP
#define RW_C_REP 1
#endif
            if (w < 4) { const int v = 16 * w + n; f32x4 Zs[4]; for (int kt = 0; kt < 4; ++kt) Zs[kt] = Z[kt];
              for (int rc_ = 0; rc_ < RW_C_REP; ++rc_) { if (rc_) for (int kt = 0; kt < 4; ++kt) Z[kt] = Zs[kt];
#pragma unroll 1
                for (int cc = 0; cc < 4; ++cc) { const LAS float* ah = L + RL_AH + 16 * cc * RT; const LAS float* bhm = L + RL_BH + 16 * cc * RT; const LAS float* khm = L + RL_KH + 16 * cc * RT; const LAS float* rhm = L + RL_RH + 16 * cc * RT;
                    const LAS float* vx = L + RL_VX + 16 * cc * RT; const LAS float* gr = L + RL_GR + cc * 4 * RGM;
                    float vb[4];
#pragma unroll
                    for (int s = 0; s < 4; ++s) vb[s] = vx[(4 * s + q) * RT + v];
                    f32x4 X = {0.f, 0.f, 0.f, 0.f}, Y = {0.f, 0.f, 0.f, 0.f};
#pragma unroll
                    for (int kt = 0; kt < 4; ++kt)
#pragma unroll
                        for (int j = 0; j < 4; ++j) { X = MF32(ah[n * RT + 16 * kt + 4 * q + j], Z[kt][j], X); Y = MF32(rhm[n * RT + 16 * kt + 4 * q + j], Z[kt][j], Y); }
#pragma unroll
                    for (int s = 0; s < 4; ++s) { X = MF32(gr[RGM + (4 * s + q) * RG + n], vb[s], X); Y = MF32(gr[3 * RGM + (4 * s + q) * RG + n], vb[s], Y); }
                    f32x4 U = {0.f, 0.f, 0.f, 0.f};
#pragma unroll
                    for (int j = 0; j < 4; ++j) U = MF32(gr[(4 * q + j) * RG + n], X[j], U);
#pragma unroll
                    for (int j = 0; j < 4; ++j) Y = MF32(gr[2 * RGM + (4 * q + j) * RG + n], U[j], Y);
#pragma unroll
                    for (int j = 0; j < 4; ++j) L[RL_YA + (16 * cc + 4 * q + j) * RT + v] = Y[j];
#pragma unroll
                    for (int kt = 0; kt < 4; ++kt) {
#pragma unroll
                        for (int j = 0; j < 4; ++j) Z[kt] = MF32(bhm[(4 * q + j) * RT + 16 * kt + n], U[j], Z[kt]);
#pragma unroll
                        for (int s = 0; s < 4; ++s) Z[kt] = MF32(khm[(4 * s + q) * RT + 16 * kt + n], vb[s], Z[kt]);
                        const f32x4 gc = *(const LAS f32x4*)(L + RL_GC + cc * 64 + 16 * kt + 4 * q); Z[kt] = Z[kt] * gc; } } } }
            LDS_WAIT(); __syncthreads();
#pragma unroll
            for (int i = 0; i < 8; ++i) { const int step = w + 8 * i; const size_t t = (size_t)b * SEQ + batch * 64 + step;
                const float y = L[RL_YA + step * RT + lane], mean = wave_sum(y) * (1.f / 64.f), dlt = y - mean, var = fmaxf(wave_sum(y * y) * (1.f / 64.f) - mean * mean, 0.f);
                const float yn = dlt * rsqrtf(var + 64e-5f) * gng + gnb; const float o = (yn + L[RL_BON + step] * L[RL_VX + step * RT + lane]) * L[RL_GS + step * RT + lane];
                MIX[t * D + 512 + c] = (bf16)f2bf(o); }
            LDS_WAIT(); __syncthreads();
        }
#undef RW_RAW
    }
}
__device__ __forceinline__ void phase_l1prep(Frame& F, const Args& a, int hb) {
    unsigned char* ws = F.ws; const bf16* XM = (const bf16*)(ws + WS_XM); bf16* XC = (bf16*)(ws + WS_XC); bf16* Q = (bf16*)(ws + WS_Q); bf16* K = (bf16*)(ws + WS_K); bf16* V = (bf16*)(ws + WS_V);
    float* GI = (float*)(ws + WS_GI); const float* W12 = (const float*)(ws + WS_W12);
    const float* cw = a.in[19]; const float* cb = a.in[20]; const float* wq = a.in[21]; const float* wk = a.in[22]; const float* wv = a.in[23]; const float* b_i = a.in[25]; const float* b_f = a.in[26];
    const int g = F.tid, lane = F.lane, w = F.wave; LAS float* red = (LAS float*)F.lds;
    float cwr[4][4], cbr[4], wqr[16], wkr[16], wvr[16], w1[32], w2[32];
#pragma unroll
    for (int j = 0; j < 4; ++j)
#pragma unroll
        for (int i = 0; i < 4; ++i) cwr[j][i] = cw[j * CI + 4 * g + i];
#pragma unroll
    for (int i = 0; i < 4; ++i) cbr[i] = cb[4 * g + i];
#pragma unroll
    for (int i = 0; i < 16; ++i) { wqr[i] = wq[g * 16 + i]; wkr[i] = wk[g * 16 + i]; wvr[i] = wv[g * 16 + i]; }
#pragma unroll
    for (int i = 0; i < 32; ++i) { w1[i] = W12[(size_t)(4 * g) * 8 + i]; w2[i] = W12[(size_t)(2048 + 4 * g) * 8 + i]; }
    float wqk[16];
#pragma unroll
    for (int i = 0; i < 4; ++i)
#pragma unroll
        for (int ip = 0; ip < 4; ++ip) { float sacc = 0.f;
#pragma unroll
            for (int m = 0; m < 4; ++m) sacc = fmaf(wqr[4 * i + m], wkr[4 * ip + m], sacc);
            wqk[4 * i + ip] = sacc * 0.044194173824159216f; }
    const int per = TH / F.G;
    const int tb = F.bid * per;
    float x0[4], x1[4], x2[4];
    { const int sl = tb & (SEQ - 1);
#pragma unroll
      for (int i = 0; i < 4; ++i) { x0[i] = 0.f; x1[i] = 0.f; x2[i] = 0.f; }
      if (sl >= 1) { const v2u r = *(const v2u*)(XM + (size_t)(tb - 1) * CI + 4 * g); x2[0] = bflo(r.x); x2[1] = bfhi(r.x); x2[2] = bflo(r.y); x2[3] = bfhi(r.y); }
      if (sl >= 2) { const v2u r = *(const v2u*)(XM + (size_t)(tb - 2) * CI + 4 * g); x1[0] = bflo(r.x); x1[1] = bfhi(r.x); x1[2] = bflo(r.y); x1[3] = bfhi(r.y); }
      if (sl >= 3) { const v2u r = *(const v2u*)(XM + (size_t)(tb - 3) * CI + 4 * g); x0[0] = bflo(r.x); x0[1] = bfhi(r.x); x0[2] = bflo(r.y); x0[3] = bfhi(r.y); } }
    constexpr int L1PF = 4;
    v2u xq[L1PF][2];
#pragma unroll
    for (int pq = 0; pq < L1PF; ++pq)
#pragma unroll
        for (int tk = 0; tk < 2; ++tk) xq[pq][tk] = *(const v2u*)(XM + (size_t)(tb + 2 * pq + tk) * CI + 4 * g);
    for (int n4 = 0; n4 < per / 2; ++n4) { const int t4 = tb + 2 * n4;
        float gs[16]; v2u xr[2];
        xr[0] = xq[0][0]; xr[1] = xq[0][1];
#pragma unroll
        for (int pq = 0; pq + 1 < L1PF; ++pq) { xq[pq][0] = xq[pq + 1][0]; xq[pq][1] = xq[pq + 1][1]; }
        { const int tn = (n4 + L1PF < per / 2) ? t4 + 2 * L1PF : t4;
#pragma unroll
          for (int tk = 0; tk < 2; ++tk) xq[L1PF - 1][tk] = *(const v2u*)(XM + (size_t)(tn + tk) * CI + 4 * g); }
#pragma unroll
        for (int tk = 0; tk < 2; ++tk) { const int t = t4 + tk;
            float x3[4]; x3[0] = bflo(xr[tk].x); x3[1] = bfhi(xr[tk].x); x3[2] = bflo(xr[tk].y); x3[3] = bfhi(xr[tk].y);
            float xc[4], q[4];
#pragma unroll
            for (int i = 0; i < 4; ++i) { const float s = fmaf(cwr[3][i], x3[i], fmaf(cwr[2][i], x2[i], fmaf(cwr[1][i], x1[i], fmaf(cwr[0][i], x0[i], cbr[i])))); xc[i] = s * sigm(s); }
#pragma unroll
            for (int j = 0; j < 4; ++j) q[j] = fmaf(xc[3], wqk[12 + j], fmaf(xc[2], wqk[8 + j], fmaf(xc[1], wqk[4 + j], xc[0] * wqk[j])));
#pragma unroll
            for (int o = 0; o < 8; ++o) { float s = 0.f;
#pragma unroll
                for (int i = 0; i < 4; ++i) s = fmaf(x3[i], w2[i * 8 + o], fmaf(xc[i], w1[i * 8 + o], s));
                gs[tk * 8 + o] = s; }
            const size_t off = (size_t)t * CI + 4 * g;
            { v2u o; o.x = pk2(xc[0], xc[1]); o.y = pk2(xc[2], xc[3]); *(v2u*)(XC + off) = o; o.x = pk2(q[0], q[1]); o.y = pk2(q[2], q[3]); *(v2u*)(Q + off) = o; }
#pragma unroll
            for (int i = 0; i < 4; ++i) { x0[i] = x1[i]; x1[i] = x2[i]; x2[i] = x3[i]; } }
#define L1_STAGE(mask, n) { const bool hi_ = (lane & (mask)) != 0; _Pragma("unroll") for (int i = 0; i < (n) / 2; ++i) { const float send_ = hi_ ? gs[i] : gs[(n) / 2 + i]; const float keep_ = hi_ ? gs[(n) / 2 + i] : gs[i]; gs[i] = keep_ + __shfl_xor(send_, (mask)); } }
        L1_STAGE(32, 16) L1_STAGE(16, 8) L1_STAGE(8, 4) L1_STAGE(4, 2)
#undef L1_STAGE
        gs[0] += __shfl_xor(gs[0], 2); gs[0] += __shfl_xor(gs[0], 1);
        LAS float* rp = red + (n4 & 1) * 128;
        if ((lane & 3) == 0) rp[w * 16 + (lane >> 2)] = gs[0];
        LDS_WAIT(); __syncthreads();
        if (F.tid < 16) { float s = 0.f;
#pragma unroll
            for (int ww = 0; ww < 8; ++ww) s += rp[ww * 16 + F.tid];
            const int o = F.tid & 7; GI[(size_t)(t4 + (F.tid >> 3)) * 8 + o] = s + (o < 4 ? b_i[o] : b_f[o - 4]); }
    }
}
__device__ __forceinline__ void phase_gatescan(Frame& F) {
    unsigned char* ws = F.ws; const float* GI = (const float*)(ws + WS_GI); float* GA = (float*)(ws + WS_GA); float* GAM = (float*)(ws + WS_GAM); float* GEM = (float*)(ws + WS_GEM);
    const int lane = F.lane, w = F.wave, tid = F.tid; LAS float* wtot = (LAS float*)F.lds;
    for (int sq = F.bid; sq < (NB / 2) * 4; sq += F.G) { const int bl = sq >> 2, h = sq & 3; const size_t tq = (size_t)bl * SEQ + 4 * tid;
        float ip[4], c[4];
#pragma unroll
        for (int k = 0; k < 4; ++k) { ip[k] = GI[(tq + k) * 8 + h]; c[k] = -softplusf_(-GI[(tq + k) * 8 + 4 + h]); }
        c[1] += c[0]; c[2] += c[1]; c[3] += c[2];
        float inc = c[3];
#pragma unroll
        for (int o = 1; o < 64; o <<= 1) { const float n = __shfl_up(inc, o); if (lane >= o) inc += n; }
        if (lane == 63) wtot[w] = inc;
        LDS_WAIT(); __syncthreads();
        float off = inc - c[3];
#pragma unroll
        for (int ww = 0; ww < 8; ++ww) if (ww < w) off += wtot[ww];
        float Fv[4], av[4], m[4];
#pragma unroll
        for (int k = 0; k < 4; ++k) { Fv[k] = off + c[k]; av[k] = ip[k] - Fv[k]; }
        m[0] = av[0]; m[1] = fmaxf(m[0], av[1]); m[2] = fmaxf(m[1], av[2]); m[3] = fmaxf(m[2], av[3]);
        float incm = m[3];
#pragma unroll
        for (int o = 1; o < 64; o <<= 1) { const float n = __shfl_up(incm, o); if (lane >= o) incm = fmaxf(incm, n); }
        if (lane == 63) wtot[8 + w] = incm;
        LDS_WAIT(); __syncthreads();
        float offm = __shfl_up(incm, 1); if (lane == 0) offm = -INFINITY;
#pragma unroll
        for (int ww = 0; ww < 8; ++ww) if (ww < w) offm = fmaxf(offm, wtot[8 + ww]);
#pragma unroll
        for (int k = 0; k < 4; ++k) { const float A = fmaxf(offm, m[k]); GA[(tq + k) * 4 + h] = av[k]; GAM[(tq + k) * 4 + h] = A; GEM[(tq + k) * 4 + h] = __expf(-(Fv[k] + A)); }
        LDS_WAIT(); __syncthreads();
    }
}
constexpr int ML_PITCH = 1040, ML_TILE = 32 * ML_PITCH, ML_PP = 80, ML_PT = 64 * ML_PP;
constexpr int ML_K = 0, ML_V = 2 * ML_TILE, ML_P = 4 * ML_TILE, ML_DEN = ML_P + 2 * ML_PT, ML_AT = ML_DEN + 512, ML_AS = ML_AT + 256, ML_END = ML_AS + 8192;
constexpr int ML_ST = ML_P, ML_MR = ML_P + 4096;
static_assert(ML_MR + 512 <= ML_DEN, "mLSTM LDS tables");
static_assert(ML_END <= MISC_OFF, "mLSTM LDS");
__device__ __forceinline__ void tr_read_v4(unsigned a, bf16x8 (&vf)[4]) { s16x4 l0, h0, l1, h1, l2, h2, l3, h3;
    asm volatile("ds_read_b64_tr_b16 %0, %8\n\tds_read_b64_tr_b16 %1, %8 offset:4160\n\tds_read_b64_tr_b16 %2, %8 offset:32\n\tds_read_b64_tr_b16 %3, %8 offset:4192\n\t"
                 "ds_read_b64_tr_b16 %4, %8 offset:64\n\tds_read_b64_tr_b16 %5, %8 offset:4224\n\tds_read_b64_tr_b16 %6, %8 offset:96\n\tds_read_b64_tr_b16 %7, %8 offset:4256\n\ts_waitcnt lgkmcnt(0)"
                 : "=&v"(l0), "=&v"(h0), "=&v"(l1), "=&v"(h1), "=&v"(l2), "=&v"(h2), "=&v"(l3), "=&v"(h3) : "v"(a) : "memory");
    vf[0] = (bf16x8){l0[0], l0[1], l0[2], l0[3], h0[0], h0[1], h0[2], h0[3]}; vf[1] = (bf16x8){l1[0], l1[1], l1[2], l1[3], h1[0], h1[1], h1[2], h1[3]};
    vf[2] = (bf16x8){l2[0], l2[1], l2[2], l2[3], h2[0], h2[1], h2[2], h2[3]}; vf[3] = (bf16x8){l3[0], l3[1], l3[2], l3[3], h3[0], h3[1], h3[2], h3[3]}; }
static_assert(4 * ML_PITCH == 4160, "tr_read_v4 offsets");
__device__ __forceinline__ void tr_read_v8(unsigned a, bf16x8 (&vf)[8]) { s16x4 l0, h0, l1, h1, l2, h2, l3, h3, l4, h4, l5, h5, l6, h6, l7, h7;
    asm volatile("ds_read_b64_tr_b16 %0, %16\n\tds_read_b64_tr_b16 %1, %16 offset:4160\n\tds_read_b64_tr_b16 %2, %16 offset:32\n\tds_read_b64_tr_b16 %3, %16 offset:4192\n\t"
                 "ds_read_b64_tr_b16 %4, %16 offset:64\n\tds_read_b64_tr_b16 %5, %16 offset:4224\n\tds_read_b64_tr_b16 %6, %16 offset:96\n\tds_read_b64_tr_b16 %7, %16 offset:4256\n\t"
                 "ds_read_b64_tr_b16 %8, %16 offset:128\n\tds_read_b64_tr_b16 %9, %16 offset:4288\n\tds_read_b64_tr_b16 %10, %16 offset:160\n\tds_read_b64_tr_b16 %11, %16 offset:4320\n\t"
                 "ds_read_b64_tr_b16 %12, %16 offset:192\n\tds_read_b64_tr_b16 %13, %16 offset:4352\n\tds_read_b64_tr_b16 %14, %16 offset:224\n\tds_read_b64_tr_b16 %15, %16 offset:4384\n\ts_waitcnt lgkmcnt(0)"
                 : "=&v"(l0), "=&v"(h0), "=&v"(l1), "=&v"(h1), "=&v"(l2), "=&v"(h2), "=&v"(l3), "=&v"(h3), "=&v"(l4), "=&v"(h4), "=&v"(l5), "=&v"(h5), "=&v"(l6), "=&v"(h6), "=&v"(l7), "=&v"(h7) : "v"(a) : "memory");
    vf[0] = (bf16x8){l0[0], l0[1], l0[2], l0[3], h0[0], h0[1], h0[2], h0[3]}; vf[1] = (bf16x8){l1[0], l1[1], l1[2], l1[3], h1[0], h1[1], h1[2], h1[3]};
    vf[2] = (bf16x8){l2[0], l2[1], l2[2], l2[3], h2[0], h2[1], h2[2], h2[3]}; vf[3] = (bf16x8){l3[0], l3[1], l3[2], l3[3], h3[0], h3[1], h3[2], h3[3]};
    vf[4] = (bf16x8){l4[0], l4[1], l4[2], l4[3], h4[0], h4[1], h4[2], h4[3]}; vf[5] = (bf16x8){l5[0], l5[1], l5[2], l5[3], h5[0], h5[1], h5[2], h5[3]};
    vf[6] = (bf16x8){l6[0], l6[1], l6[2], l6[3], h6[0], h6[1], h6[2], h6[3]}; vf[7] = (bf16x8){l7[0], l7[1], l7[2], l7[3], h7[0], h7[1], h7[2], h7[3]}; }
struct PvOps { bf16x8 p0, p1, p2, p3; s16x4 l0, h0, l1, h1, l2, h2, l3, h3, l4, h4, l5, h5, l6, h6, l7, h7; };
__device__ __forceinline__ void pv_issue(unsigned pa, unsigned va, PvOps& o) {
    asm volatile("ds_read_b128 %0, %20\n\tds_read_b128 %1, %20 offset:1280\n\tds_read_b128 %2, %20 offset:2560\n\tds_read_b128 %3, %20 offset:3840\n\t"
                 "ds_read_b64_tr_b16 %4, %21\n\tds_read_b64_tr_b16 %5, %21 offset:4160\n\tds_read_b64_tr_b16 %6, %21 offset:32\n\tds_read_b64_tr_b16 %7, %21 offset:4192\n\t"
                 "ds_read_b64_tr_b16 %8, %21 offset:64\n\tds_read_b64_tr_b16 %9, %21 offset:4224\n\tds_read_b64_tr_b16 %10, %21 offset:96\n\tds_read_b64_tr_b16 %11, %21 offset:4256\n\t"
                 "ds_read_b64_tr_b16 %12, %21 offset:128\n\tds_read_b64_tr_b16 %13, %21 offset:4288\n\tds_read_b64_tr_b16 %14, %21 offset:160\n\tds_read_b64_tr_b16 %15, %21 offset:4320\n\t"
                 "ds_read_b64_tr_b16 %16, %21 offset:192\n\tds_read_b64_tr_b16 %17, %21 offset:4352\n\tds_read_b64_tr_b16 %18, %21 offset:224\n\tds_read_b64_tr_b16 %19, %21 offset:4384"
                 : "=&v"(o.p0), "=&v"(o.p1), "=&v"(o.p2), "=&v"(o.p3), "=&v"(o.l0), "=&v"(o.h0), "=&v"(o.l1), "=&v"(o.h1), "=&v"(o.l2), "=&v"(o.h2), "=&v"(o.l3), "=&v"(o.h3),
                   "=&v"(o.l4), "=&v"(o.h4), "=&v"(o.l5), "=&v"(o.h5), "=&v"(o.l6), "=&v"(o.h6), "=&v"(o.l7), "=&v"(o.h7) : "v"(pa), "v"(va) : "memory"); }
#define pv_wait(o_) do { __builtin_amdgcn_sched_barrier(0); asm volatile("s_waitcnt lgkmcnt(0)" ::: "memory"); __builtin_amdgcn_sched_barrier(0); } while (0)
#define PV_CAT(l_, h_) ((bf16x8){(l_)[0], (l_)[1], (l_)[2], (l_)[3], (h_)[0], (h_)[1], (h_)[2], (h_)[3]})
static_assert(16 * ML_PP == 1280, "pv_issue offsets");
template <int PB> __device__ __forceinline__ void phase_mlstm_t(Frame& F, const Args& a) {
    constexpr bool skK = PB & 1, skV = PB & 2, skS = PB & 4, skP = PB & 8, skE = PB & 16;
    unsigned char* ws = F.ws; const bf16* Q = (const bf16*)(ws + WS_Q); const bf16* K = (const bf16*)(ws + WS_XC); const bf16* V = (const bf16*)(ws + WS_XM); const bf16* XC = (const bf16*)(ws + WS_XC); const bf16* Z = (const bf16*)(ws + WS_Z);
    bf16* YC = (bf16*)(ws + WS_V); const float* GA = (const float*)(ws + WS_GA); const float* GAM = (const float*)(ws + WS_GAM); const float* GEM = (const float*)(ws + WS_GEM);
    const float* mh_g = a.in[27]; const float* skip = a.in[28]; const float* wvp = a.in[23];
    const int tid = F.tid, lane = F.lane, w = F.wave, fr = lane & 15, fq = lane >> 4; LAS unsigned char* lds = F.lds;
    LAS float* den2 = (LAS float*)(lds + ML_DEN); LAS float* stats = (LAS float*)(lds + ML_ST); LAS float* mr = (LAS float*)(lds + ML_MR); LAS float* em_s = (LAS float*)(lds + ML_AT); LAS float* as_s = (LAS float*)(lds + ML_AS);
    const int st = w & 1, tp = (w >> 1) & 1, wv = w & 3;
    const unsigned vtr_lane = (unsigned)((8 * fq + ((lane & 15) >> 2)) * ML_PITCH + (128 * wv + 4 * (lane & 3)) * 2);
#define ML_DMA(gbase, tile_off) do { _Pragma("unroll") for (int r4 = 0; r4 < 4; ++r4) { const int rr = w + 8 * r4; \
        __builtin_amdgcn_global_load_lds((const unsigned*)((gbase) + (size_t)rr * CI + lane * 8), (LAS unsigned*)(lds + (tile_off) + rr * ML_PITCH), 16, 0, 0); } } while (0)
#define ML_STEP_HEAD() const int buf = k & 1; int j = k + jstart; if (j >= nk) j -= nk; int jn = j + 1; if (jn >= nk) jn -= nk; \
        asm volatile("s_waitcnt vmcnt(0) lgkmcnt(0)" ::: "memory"); __builtin_amdgcn_s_barrier(); asm volatile("" ::: "memory"); \
        if (k + 1 < nk && !skK) ML_DMA(Kb + (size_t)(32 * jn) * CI, ML_K + (buf ^ 1) * ML_TILE); \
        if (k < nk && !skV) ML_DMA(Vb + (size_t)(32 * j) * CI, ML_V + buf * ML_TILE)
    for (int r = 0; r < 8; ++r) { const int xcd = F.bid & 7, cq = F.bid >> 3, c16 = cq & 15; if (F.G != 256) break;
        const int part = r & 1, qi = part ? 31 - c16 : c16, bh = xcd + 8 * ((cq >> 4) + 2 * (r >> 1)), bl = bh >> 2, h = bh & 3; const size_t t0 = (size_t)bl * SEQ + 64 * qi; const int nk = 2 * (qi + 1), jstart = part ? 2 * (c16 + 1) : 0;
        const bf16* Kb = K + (size_t)bl * SEQ * CI + h * 512; const bf16* Vb = V + (size_t)bl * SEQ * CI + h * 512;
        ML_DMA(Kb + (size_t)(32 * jstart) * CI, ML_K);
        float tb_e, tb_a[4];
        tb_e = GEM[(t0 + (tid & 63)) * 4 + h];
#pragma unroll
        for (int i4 = 0; i4 < 4; ++i4) tb_a[i4] = GA[((size_t)bl * SEQ + tid + 512 * i4) * 4 + h];
#define ML_TABLES() do { if (tid < 64) em_s[tid] = tb_e; _Pragma("unroll") for (int i4 = 0; i4 < 4; ++i4) { const int sidx = tid + 512 * i4; if (sidx < 64 * (qi + 1)) as_s[sidx] = tb_a[i4] * LOG2E; } } while (0)
        const int c8 = lane * 8, cc = h * 512 + c8;
#define ML_EPI_LOADS(N, ROW0) v4u zr[N], xr[N]; float gm[8], sk[8]; asm volatile("" ::: "memory"); __builtin_amdgcn_sched_barrier(0); if (!skE) { _Pragma("unroll") for (int k8 = 0; k8 < N; ++k8) { const size_t off = (t0 + (ROW0) + k8) * CI + cc; zr[k8] = *(const v4u*)(Z + off); xr[k8] = *(const v4u*)(XC + off); } \
        _Pragma("unroll") for (int q = 0; q < 8; ++q) { gm[q] = mh_g[cc + q]; sk[q] = skip[cc + q]; } }
#define ML_EPI_PASS(N, ROW0) if (!skE) { const LAS float* ytile = (const LAS float*)lds; _Pragma("unroll") for (int k8 = 0; k8 < N; ++k8) { const int row = (ROW0) + k8; const size_t off = (t0 + row) * CI + cc; \
              const f32x4 y0 = *(const LAS f32x4*)(ytile + row * 516 + c8), y1 = *(const LAS f32x4*)(ytile + row * 516 + c8 + 4); float zf[8], xf[8], o[8]; unpack8(zr[k8], zf); unpack8(xr[k8], xf); \
              float s1 = ((y0[0] + y0[1]) + (y0[2] + y0[3])) + ((y1[0] + y1[1]) + (y1[2] + y1[3])), s2 = ((y0[0] * y0[0] + y0[1] * y0[1]) + (y0[2] * y0[2] + y0[3] * y0[3])) + ((y1[0] * y1[0] + y1[1] * y1[1]) + (y1[2] * y1[2] + y1[3] * y1[3])); \
              s1 = wave_sum(s1); s2 = wave_sum(s2); const float mean = s1 * (1.f / 512.f), rstd = rsqrtf(fmaxf(s2 * (1.f / 512.f) - mean * mean, 0.f) + 1e-5f); \
              _Pragma("unroll") for (int q = 0; q < 8; ++q) { const float yv = ((q < 4 ? y0[q & 3] : y1[q & 3]) - mean) * rstd; o[q] = (yv * gm[q] + sk[q] * xf[q]) * (zf[q] * sigm(zf[q])); } \
              *(v4u*)(YC + off) = pack8(o); } }
        if (w < 4) {
            bf16x8 qf[2][16];
            { const bf16* qp = Q + (t0 + 32 * tp + fr) * CI + h * 512 + fq * 8;
#pragma unroll
              for (int ks = 0; ks < 16; ++ks) { qf[0][ks] = *(const bf16x8*)(qp + 32 * ks); qf[1][ks] = *(const bf16x8*)(qp + 16 * CI + 32 * ks); } }
            const float At0 = GAM[(t0 + 32 * tp + fr) * 4 + h] * LOG2E, At1 = GAM[(t0 + 32 * tp + 16 + fr) * 4 + h] * LOG2E;
            ML_TABLES();
            float denp0 = 0.f, denp1 = 0.f;
            for (int k = 0; k <= nk; ++k) { ML_STEP_HEAD();
                if (k < nk && !skS) {
                    f32x4 s0a = {0.f, 0.f, 0.f, 0.f}, s0b = {0.f, 0.f, 0.f, 0.f}, s1a = {0.f, 0.f, 0.f, 0.f}, s1b = {0.f, 0.f, 0.f, 0.f};
                    { const LAS unsigned char* kl = lds + ML_K + buf * ML_TILE + (16 * st + fr) * ML_PITCH + fq * 16; bf16x8 kc[4], kn[4];
#pragma unroll
                      for (int q = 0; q < 4; ++q) kc[q] = *(const LAS bf16x8*)(kl + 64 * q);
#pragma unroll
                      for (int g = 0; g < 4; ++g) {
                          if (g < 3) {
#pragma unroll
                              for (int q = 0; q < 4; ++q) kn[q] = *(const LAS bf16x8*)(kl + 64 * (4 * g + 4 + q)); }
                          __builtin_amdgcn_sched_barrier(0);
#pragma unroll
                          for (int q = 0; q < 4; q += 2) { const int ks = 4 * g + q;
                              s0a = __builtin_amdgcn_mfma_f32_16x16x32_bf16(kc[q], qf[0][ks], s0a, 0, 0, 0); s1a = __builtin_amdgcn_mfma_f32_16x16x32_bf16(kc[q], qf[1][ks], s1a, 0, 0, 0);
                              s0b = __builtin_amdgcn_mfma_f32_16x16x32_bf16(kc[q + 1], qf[0][ks + 1], s0b, 0, 0, 0); s1b = __builtin_amdgcn_mfma_f32_16x16x32_bf16(kc[q + 1], qf[1][ks + 1], s1b, 0, 0, 0); }
                          __builtin_amdgcn_sched_barrier(0);
                          if (g < 3) {
#pragma unroll
                              for (int q = 0; q < 4; ++q) kc[q] = kn[q]; } } }
                    s0a += s0b; s1a += s1b;
                    const f32x4 asv = *(const LAS f32x4*)(as_s + 32 * j + 16 * st + 4 * fq); const float as[4] = {asv[0], asv[1], asv[2], asv[3]};
                    float p0[4], p1[4]; const int sbase = 32 * j + 16 * st + 4 * fq, tbase = 64 * qi + 32 * tp + fr;
                    if (32 * j + 31 <= 64 * qi + 32 * tp) {
#pragma unroll
                        for (int i = 0; i < 4; ++i) { p0[i] = s0a[i] * __builtin_amdgcn_exp2f(as[i] - At0); p1[i] = s1a[i] * __builtin_amdgcn_exp2f(as[i] - At1); }
                    } else {
#pragma unroll
                        for (int i = 0; i < 4; ++i) { p0[i] = (sbase + i) <= tbase ? s0a[i] * __builtin_amdgcn_exp2f(as[i] - At0) : 0.f; p1[i] = (sbase + i) <= tbase + 16 ? s1a[i] * __builtin_amdgcn_exp2f(as[i] - At1) : 0.f; } }
                    denp0 += (p0[0] + p0[1]) + (p0[2] + p0[3]); denp1 += (p1[0] + p1[1]) + (p1[2] + p1[3]);
                    { LAS unsigned char* pp = lds + ML_P + buf * ML_PT + (32 * tp + fr) * ML_PP + (16 * st + 4 * fq) * 2; v2u pw; pw.x = pk2(p0[0], p0[1]); pw.y = pk2(p0[2], p0[3]); *(LAS v2u*)pp = pw;
                      pw.x = pk2(p1[0], p1[1]); pw.y = pk2(p1[2], p1[3]); *(LAS v2u*)(pp + 16 * ML_PP) = pw; }
                } }
            ML_EPI_LOADS(12, 12 * w);
            { float wt[8];
#pragma unroll
              for (int u = 0; u < 8; ++u) { const int col = 2 * tid + (u >> 2); wt[u] = wvp[(size_t)(h * 128 + (col >> 2)) * 16 + 4 * (u & 3) + (col & 3)]; }
              *(LAS f32x4*)(as_s + 8 * tid) = (f32x4){wt[0], wt[1], wt[2], wt[3]}; *(LAS f32x4*)(as_s + 8 * tid + 4) = (f32x4){wt[4], wt[5], wt[6], wt[7]}; }
            { float d0 = denp0, d1 = denp1; d0 += __shfl_xor(d0, 16); d1 += __shfl_xor(d1, 16); d0 += __shfl_xor(d0, 32); d1 += __shfl_xor(d1, 32);
              if (fq == 0) { den2[st * 64 + 32 * tp + fr] = d0; den2[st * 64 + 32 * tp + 16 + fr] = d1; } }
            LDS_WAIT(); __builtin_amdgcn_s_barrier(); asm volatile("" ::: "memory");
            __builtin_amdgcn_s_barrier(); asm volatile("" ::: "memory");
            ML_EPI_PASS(12, 12 * w)
        } else {
            f32x4 O[4][8];
#pragma unroll
            for (int i = 0; i < 4; ++i)
#pragma unroll
                for (int e = 0; e < 8; ++e) O[i][e] = (f32x4){0.f, 0.f, 0.f, 0.f};
            ML_TABLES();
            bf16x8 pH[4], vH[2];
#pragma unroll
            for (int i = 0; i < 4; ++i) { pH[i] = (bf16x8){0, 0, 0, 0, 0, 0, 0, 0}; vH[i & 1] = (bf16x8){0, 0, 0, 0, 0, 0, 0, 0}; }
            for (int k = 0; k <= nk; ++k) { ML_STEP_HEAD();
                if (!skP) { PvOps o;
                    if (k >= 1) pv_issue((unsigned)(size_t)(lds + ML_P + (buf ^ 1) * ML_PT + fr * ML_PP + fq * 16), (unsigned)(size_t)(lds + ML_V + (buf ^ 1) * ML_TILE) + vtr_lane, o);
                    __builtin_amdgcn_sched_barrier(0);
                    if (k >= 2) {
#pragma unroll
                        for (int i = 0; i < 4; ++i)
#pragma unroll
                            for (int e = 0; e < 2; ++e) O[i][6 + e] = __builtin_amdgcn_mfma_f32_16x16x32_bf16(pH[i], vH[e], O[i][6 + e], 0, 0, 0); }
                    if (k >= 1) { pv_wait(o);
                        const bf16x8 pf[4] = {o.p0, o.p1, o.p2, o.p3}; const bf16x8 va[6] = {PV_CAT(o.l0, o.h0), PV_CAT(o.l1, o.h1), PV_CAT(o.l2, o.h2), PV_CAT(o.l3, o.h3), PV_CAT(o.l4, o.h4), PV_CAT(o.l5, o.h5)};
#pragma unroll
                        for (int i = 0; i < 4; ++i)
#pragma unroll
                            for (int e = 0; e < 6; ++e) O[i][e] = __builtin_amdgcn_mfma_f32_16x16x32_bf16(pf[i], va[e], O[i][e], 0, 0, 0);
#pragma unroll
                        for (int i = 0; i < 4; ++i) pH[i] = pf[i];
                        vH[0] = PV_CAT(o.l6, o.h6); vH[1] = PV_CAT(o.l7, o.h7); } } }
            if (!skP) {
#pragma unroll
                for (int i = 0; i < 4; ++i)
#pragma unroll
                    for (int e = 0; e < 2; ++e) O[i][6 + e] = __builtin_amdgcn_mfma_f32_16x16x32_bf16(pH[i], vH[e], O[i][6 + e], 0, 0, 0); }
            LDS_WAIT(); __builtin_amdgcn_s_barrier(); asm volatile("" ::: "memory");
            { const LAS float* den_q = den2 + 4 * fq; const LAS float* em_q = em_s + 4 * fq; LAS float* yt_q = (LAS float*)lds + 4 * fq * 516 + 128 * wv + fr; float inv[16];
#pragma unroll
              for (int i = 0; i < 4; ++i)
#pragma unroll
                for (int jj = 0; jj < 4; ++jj) { const float dn = den_q[16 * i + jj] + den_q[64 + 16 * i + jj]; inv[4 * i + jj] = 1.0f / fmaxf(fabsf(dn), em_q[16 * i + jj]); }
#pragma unroll
              for (int e = 0; e < 8; ++e) { const f32x4 wl = *(const LAS f32x4*)(as_s + (128 * wv + 16 * e + fr) * 4);
#pragma unroll
                for (int i = 0; i < 4; ++i)
#pragma unroll
                    for (int jj = 0; jj < 4; ++jj) { const float x = O[i][e][jj] * inv[4 * i + jj];
                        yt_q[(16 * i + jj) * 516 + 16 * e] = fmaf(DPP_MOVF(x, 0xFF), wl[3], fmaf(DPP_MOVF(x, 0xAA), wl[2], fmaf(DPP_MOVF(x, 0x55), wl[1], DPP_MOVF(x, 0x00) * wl[0]))); } } }
            LDS_WAIT(); __builtin_amdgcn_s_barrier(); asm volatile("" ::: "memory");
            ML_EPI_LOADS(4, 48 + 4 * wv);
            ML_EPI_PASS(4, 48 + 4 * wv)
        }
        VM_WAIT(); __syncthreads();
    }
#undef ML_DMA
#undef ML_STEP_HEAD
#undef ML_TABLES
#undef ML_EPI_LOADS
#undef ML_EPI_PASS
}
__device__ __forceinline__ void phase_mlstm(Frame& F, const Args& a) { phase_mlstm_t<0>(F, a); }
#ifdef ML_PROBE
__device__ __forceinline__ void phase_mlstm_probe(Frame& F, const Args& a) { phase_mlstm_t<ML_PROBE>(F, a); }
#endif

#ifdef ML_DMAPROBE
__device__ __forceinline__ void phase_mlstm_dmaprobe(Frame& F, const Args& a) {
    unsigned char* ws = F.ws; const bf16* K = (const bf16*)(ws + WS_K); const bf16* V = (const bf16*)(ws + WS_V);
    const int lane = F.lane, w = F.wave; LAS unsigned char* lds = F.lds;
#define MLP_DMA(gbase, tile_off) do { _Pragma("unroll") for (int r4 = 0; r4 < 4; ++r4) { const int rr = w + 8 * r4; \
        __builtin_amdgcn_global_load_lds((const unsigned*)((gbase) + (size_t)rr * CI + lane * 8), (LAS unsigned*)(lds + (tile_off) + rr * ML_PITCH), 16, 0, 0); } } while (0)
    for (int r = 0; r < 8; ++r) { const int xcd = F.bid & 7, cq = F.bid >> 3, c16 = cq & 15; if (F.G != 256) break;
        const int part = r & 1, qi = part ? 31 - c16 : c16, bh = xcd + 8 * ((cq >> 4) + 2 * (r >> 1)), bl = bh >> 2, h = bh & 3; const int nk = 2 * (qi + 1), jstart = part ? 2 * (c16 + 1) : 0;
        const bf16* Kb = K + (size_t)bl * SEQ * CI + h * 512; const bf16* Vb = V + (size_t)bl * SEQ * CI + h * 512;
        for (int k = 0; k <= nk; ++k) { const int buf = k & 1; int j = k + jstart; if (j >= nk) j -= nk; int jn = j + 1; if (jn >= nk) jn -= nk;
            asm volatile("s_waitcnt vmcnt(0) lgkmcnt(0)" ::: "memory"); __builtin_amdgcn_s_barrier(); asm volatile("" ::: "memory");
            if ((ML_DMAPROBE & 1) && k + 1 < nk) MLP_DMA(Kb + (size_t)(32 * jn) * CI, ML_K + (buf ^ 1) * ML_TILE);
            if ((ML_DMAPROBE & 2) && k < nk) MLP_DMA(Vb + (size_t)(32 * j) * CI, ML_V + buf * ML_TILE);
        }
        VM_WAIT(); __syncthreads();
    }
#undef MLP_DMA
}
#endif
#ifdef ML_DMAPROBE
#define ML_PROBE_CALL phase_mlstm_dmaprobe(F, args);
#elif defined(ML_PROBE)
#define ML_PROBE_CALL phase_mlstm_probe(F, args);
#else
#define ML_PROBE_CALL
#endif
#define GEMM_PHASE(EPI, Aptr, Bptr, M_, N_, K_, ...) do { pg8::Gemm g{(const pg8::bf16_t*)(Aptr), (const pg8::bf16_t*)(Bptr), (M_), (N_), (K_)}; pg8::StaticOrder So; So.init((M_), (N_), F.G, F.bid); \
        pg8::EPI Ep{__VA_ARGS__}; pg8::gemm_phase<pg8::EPI, pg8::StaticOrder, PG8_ALIGN, PG8_SP2>(F.lds, g, So, Ep); } while (0)
namespace pg8 { typedef EpiRes2<float> EpiResF; typedef EpiRes2<bf16_t> EpiResB; typedef EpiPle2<false> EpiPleB; typedef EpiPle2<true> EpiPleF; }
__global__ void __launch_bounds__(NWAVES * 64, 2) trunk_fwd(Args args) {
    extern __shared__ __attribute__((aligned(16))) unsigned char lds_raw[];
    Frame F; F.lds = (LAS unsigned char*)lds_raw; F.ws = args.ws; F.in = nullptr;
    F.tid = threadIdx.x; F.lane = F.tid & 63; F.wave = __builtin_amdgcn_readfirstlane(F.tid >> 6); F.G = gridDim.x; F.bid = blockIdx.x;
    volatile LAS unsigned* MISC = (volatile LAS unsigned*)(F.lds + MISC_OFF);
    if (F.tid < 64) MISC[F.tid] = 0u;
    __syncthreads();
    XcdBarrier bar; bar.bar = (unsigned*)(args.ws + WS_CTL) + CW_BAR; bar.x = 0; bar.st = nullptr;
    if (args.use_bar) bar = xcd_barrier_post((unsigned*)(args.ws + WS_CTL) + CW_BAR, MISC + 8);
    unsigned* xrank = (unsigned*)(args.ws + WS_CTL) + CW_XRANK; const unsigned my_xcc = xb_xcc_id();
    if (args.use_bar && F.tid == 0) MISC[12] = xb_add(&xrank[64 * my_xcc], 1u);
    const int lo = args.ph_lo, hi = args.ph_hi;
#ifndef ONLY_SITE
#define ONLY_SITE -1
#endif
#define EN(n) (ONLY_SITE < 0 || ONLY_SITE == (n))
#ifndef REP_MASK
#define REP_MASK 0u
#endif
#define NREP(n) (((REP_MASK >> (n)) & 1u) ? 2 : 1)
#define IN(k) (lo <= (k) && (k) < hi)
#define SEAM(k) do { if (IN(k) && IN((k) + 1)) xcd_barrier(bar); } while (0)
    unsigned char* ws = args.ws; float* out = args.out;
    float* RS = (float*)(ws + WS_RS);
#define RSN(i) (RS + (size_t)(i) * T * 16)
#define PH(site, k, ...) if (EN(site) && IN(k)) { for (int rep_ = 0; rep_ < NREP(site); ++rep_) { if (rep_) xcd_barrier(bar); __VA_ARGS__ } } SEAM(k);
    PH(0, 0, phase_prologue(F, args); phase_cast_sq(F, args.in[0], (bf16*)(ws + WS_XB2), RSN(0), T); phase_cvt_p(F, args.in[1], (bf16*)(ws + WS_PB));)
    if (args.use_bar && lo == 0 && hi > 1) {
        bool ok = F.G == 256; for (int x = 0; x < 16; ++x) { const unsigned cx = xb_ld(&xrank[64 * x]); ok = ok && (cx == (x < 8 ? 32u : 0u)); }
        const unsigned rk = MISC[12]; if (ok && rk < 32u && my_xcc < 8u) F.bid = (int)(rk * 8u + my_xcc); }
    PH(2, 1, GEMM_PHASE(EpiBf16SplitR, ws + WS_XB2, ws + WS_WIN, T, NU, D, (pg8::bf16_t*)(ws + WS_UA), UA_W, 4, (pg8::bf16_t*)(ws + WS_UB), UB_W, RSN(0));)
    PH(3, 2, phase_prepA(F, args);)
    PH(4, 3, GEMM_PHASE(EpiBf16Split, ws + WS_LIN, ws + WS_WLORA, T, 1536, 256 + args.pad, (pg8::bf16_t*)(ws + WS_LOUT), 1536, 1 << 20, nullptr, 0);)
    PH(5, 4, phase_indexer(F);)
    PH(6, 5, phase_dsa_attn(F, args);)
    PH(7, 6, phase_rwkv(F, args);)
    PH(8, 7, GEMM_PHASE(EpiResF, ws + WS_XB, ws + WS_WOUT, T, D, D, args.in[0], (pg8::bf16_t*)(ws + WS_XB2), D, RSN(1));)
#define FFN_PLE(L, pb, rs_a, rs_b, rs_c, PLE_EPI, ple_out) do { const size_t lw = (size_t)(L) * WS_LAYER_STRIDE; \
        PH(21, (pb), GEMM_PHASE(EpiSwigluR, ws + WS_XB2, ws + WS_WGU0 + lw, T, 2 * FF, D, (pg8::bf16_t*)(ws + WS_H), FF, RSN(rs_a));) \
        PH(22, (pb) + 1, GEMM_PHASE(EpiResB, ws + WS_H, ws + WS_WD0 + lw, T, D, FF, (const pg8::bf16_t*)(ws + WS_XB2), (pg8::bf16_t*)(ws + WS_XB), D, RSN(rs_b));) \
        PH(24, (pb) + 2, GEMM_PHASE(EpiBf16Split, ws + WS_PB, ws + WS_WPLE0 + lw, T, D, 256 + args.pad, (pg8::bf16_t*)(ws + WS_E), D, 1 << 20, nullptr, 0);) \
        PH(25, (pb) + 3, GEMM_PHASE(PLE_EPI, ws + WS_XB, ws + WS_WPG0 + lw, T, D, D, (const pg8::bf16_t*)(ws + WS_XB), (void*)(ple_out), (const pg8::bf16_t*)(ws + WS_E), D, RSN(rs_b), RSN(rs_c));) } while (0)
#define L1_HALF(hb, p1) do { bf16* xbh = (bf16*)(ws + WS_XB2) + (size_t)(hb) * TH * D; \
        PH(11, (p1), GEMM_PHASE(EpiBf16SplitR, xbh, ws + WS_WUP, TH, 2 * CI, D, (pg8::bf16_t*)(ws + WS_XM), CI, 8, (pg8::bf16_t*)(ws + WS_Z), CI, RSN(3) + (size_t)(hb) * TH * 16);) \
        PH(12, (p1) + 1, phase_l1prep(F, args, hb);) \
        PH(13, (p1) + 2, phase_gatescan(F); if ((hb) == 0) phase_cvt_p(F, args.in[1] + (size_t)T * 256, (bf16*)(ws + WS_PB));) \
        PH(14, (p1) + 3, ML_PROBE_CALL phase_mlstm(F, args);) \
        PH(15, (p1) + 4, GEMM_PHASE(EpiResB, ws + WS_V, ws + WS_WDOWN, TH, D, CI, (const pg8::bf16_t*)xbh, (pg8::bf16_t*)xbh, D, RSN(4) + (size_t)(hb) * TH * 16);) } while (0)
    FFN_PLE(0, 8, 1, 2, 3, EpiPleB, ws + WS_XB2);
    L1_HALF(0, 12);
    L1_HALF(1, 17);
    FFN_PLE(1, 22, 4, 5, 5, EpiPleF, out);
#undef IN
#undef SEAM
}
constexpr int N_PHASES = 26;

#ifndef MK_ONE_LAUNCH
#define MK_ONE_LAUNCH 1
#endif
extern "C" void kernel_launch(void* const* d_in, const int* in_sizes, int n_in, void* d_out, int out_size, void* d_ws, size_t ws_size, hipStream_t stream) {
    static int grid = 0;
    if (grid == 0) {
        if (n_in != 37 || in_sizes[0] != T * D || out_size != T * D || ws_size < WS_END) { fprintf(stderr, "kernel_launch: unexpected shapes (n_in %d, in0 %d, out %d, ws %zu < %zu); nothing launched\n", n_in, n_in > 0 ? in_sizes[0] : -1, out_size, ws_size, (size_t)WS_END); grid = -1; return; }
        int dev = 0, cus = 0, per_cu = 0;
        if (hipGetDevice(&dev) != hipSuccess || hipDeviceGetAttribute(&cus, hipDeviceAttributeMultiprocessorCount, dev) != hipSuccess) { grid = -1; return; }
        if (hipFuncSetAttribute((const void*)trunk_fwd, hipFuncAttributeMaxDynamicSharedMemorySize, LDS_BYTES) != hipSuccess) { fprintf(stderr, "kernel_launch: hipFuncSetAttribute failed\n"); grid = -1; return; }
        if (hipOccupancyMaxActiveBlocksPerMultiprocessor(&per_cu, (const void*)trunk_fwd, NWAVES * 64, LDS_BYTES) != hipSuccess || per_cu < 1) { fprintf(stderr, "kernel_launch: occupancy query says %d\n", per_cu); }
        (void)hipGetLastError();
        grid = cus;
        if (grid != 256) { fprintf(stderr, "kernel_launch: built for 256 CUs, found %d; nothing launched\n", cus); grid = -1; return; }
    }
    if (grid < 0) return;
    if (hipMemsetAsync((char*)d_ws + WS_CTL, 0, CTL_ZERO_BYTES, stream) != hipSuccess) return;
    Args a{};
    for (int i = 0; i < 37; ++i) a.in[i] = (const float*)d_in[i];
    a.out = (float*)d_out; a.ws = (unsigned char*)d_ws; a.pad = 0;
#if MK_ONE_LAUNCH
    a.ph_lo = 0; a.ph_hi = N_PHASES; a.use_bar = 1;
    hipLaunchKernelGGL(trunk_fwd, dim3(grid), dim3(NWAVES * 64), LDS_BYTES, stream, a);
#else
    for (int p = 0; p < N_PHASES; ++p) { a.ph_lo = p; a.ph_hi = p + 1; a.use_bar = 0; hipLaunchKernelGGL(trunk_fwd, dim3(grid), dim3(NWAVES * 64), LDS_BYTES, stream, a); }
#endif
}
```

```cpp
#include <hip/hip_runtime.h>
#include <cstdio>
#include <cstdint>
namespace pg8 {
#define PG8_LAS __attribute__((address_space(3)))
typedef unsigned short bf16_t;
typedef short bf16x8 __attribute__((ext_vector_type(8)));
typedef float f32x4 __attribute__((ext_vector_type(4)));
typedef unsigned u32x4 __attribute__((ext_vector_type(4)));
constexpr int BM = 256, BK = 64, HALF = 128, HTB = HALF * BK * 2  , STAGE_BYTES = 8 * HTB, NXCD = 8, WGM = 8;

__host__ __device__ __forceinline__ int lds_byte(int r, int c) { const int st = (r >> 4) * 2 + (c >> 5), rr = r & 15, cc = c & 31, ob = rr * 64 + cc * 2; return st * 1024 + (ob ^ (((ob >> 9) & 1) << 5)); }
__host__ __device__ __forceinline__ void stage_rc(int b, int& R, int& C) { const int st = b / 1024, sb = b % 1024, swz = sb ^ (((sb >> 9) & 1) << 5); R = (st >> 1) * 16 + swz / 64; C = (st & 1) * 32 + (swz % 64) / 2; }
__host__ __device__ __forceinline__ int perm32(int rho) { const int n = rho >> 4, i = rho & 15; return 8 * (i >> 2) + 4 * n + (i & 3); }

struct Unit { int pm, pn; };
struct Gemm { const bf16_t* A; const bf16_t* Bt; int M, N, K; };

struct StaticOrder {
    int nM, nN, nwg, G, c;
    __host__ __device__ void init(int M, int N, int G_, int c_) { nM = M / BM; nN = N / BM; nwg = nM * nN; G = G_; c = c_; }
    __host__ __device__ bool next(int i, Unit& u) const {
        const long L = (long)i * G + c; if (L >= nwg) return false;
        int wgid = (int)L; { const int q = nwg / NXCD, r = nwg % NXCD, xcd = wgid % NXCD, off = wgid / NXCD; wgid = (xcd < r ? xcd * (q + 1) : r * (q + 1) + (xcd - r) * q) + off; }
        const int nig = WGM * nN, gid = wgid / nig, fm = gid * WGM, gsz = (nM - fm) < WGM ? (nM - fm) : WGM;
        u.pm = fm + ((wgid % nig) % gsz); u.pn = (wgid % nig) / gsz; return true;
    }
    __device__ __forceinline__ void a_ready(const Unit&) const {}
    __device__ __forceinline__ void done(const Unit&) const {}
};

__device__ __forceinline__ unsigned cvt_pk_bf16(float lo, float hi) { unsigned r; asm volatile("v_cvt_pk_bf16_f32 %0, %1, %2" : "=v"(r) : "v"(lo), "v"(hi)); return r; }
typedef float f32x2 __attribute__((ext_vector_type(2)));
__device__ __forceinline__ f32x2 gelu_pk(f32x2 v) {
    const f32x2 av = __builtin_elementwise_abs(v), d = av * 0.2316418882f + 1.0f;
    f32x2 t; t.x = __builtin_amdgcn_rcpf(d.x); t.y = __builtin_amdgcn_rcpf(d.y);
    f32x2 q = t * 0.5307027145f + (-0.7265760135f); q = q * t + 0.7107068705f; q = q * t + (-0.142248368f); q = q * t + 0.127414796f; q = q * t;
    const f32x2 s = (v * v) * (-0.72134752044f);
    f32x2 e; e.x = __builtin_amdgcn_exp2f(s.x); e.y = __builtin_amdgcn_exp2f(s.y);
    const f32x2 m = v * (q * e), r = v - m;
    f32x2 o; o.x = v.x < 0.f ? m.x : r.x; o.y = v.y < 0.f ? m.y : r.y; return o;
}

template <class Epi, class Sched, bool ALIGN_EPI = false, bool SP2 = false>
__device__ __forceinline__ void gemm_phase(PG8_LAS unsigned char* lds, const Gemm g, const Sched& S, const Epi& E) {
    const int tid = threadIdx.x, wid = __builtin_amdgcn_readfirstlane(tid >> 6), lane = tid & 63, wr = wid >> 2, wc = wid & 3, fr = lane & 15, fq = lane >> 4;
    const int K = g.K, nt = K / BK;
    unsigned voffA[2], voffB[2];
#pragma unroll
    for (int i = 0; i < 2; ++i) { int R, C; stage_rc(tid * 16 + i * 8192, R, C); const int Rb = Epi::PERM ? ((R & ~31) + perm32(R & 31)) : R;
        voffA[i] = (unsigned)(R * K + C) * 2u; voffB[i] = (unsigned)(Rb * K + C) * 2u; }
    const size_t kstep = (size_t)(BK * 2);
    const size_t hstep = (size_t)HALF * K * 2;
    const size_t tstep = 2 * hstep;
    const unsigned ldsw = (unsigned)wid * 1024u;
    const int aoff = lds_byte(wr * 64 + fr, fq * 8), boff = lds_byte(wc * 32 + fr, fq * 8);
#define PG8_SA(b, h) (((b) * 2 + (h)) * HTB)
#define PG8_SB(b, h) ((4 + (b) * 2 + (h)) * HTB)
#define PG8_STAGE(bufoff, gbase, voff) do { _Pragma("unroll") for (int _i = 0; _i < 2; ++_i) \
        __builtin_amdgcn_global_load_lds((const unsigned*)((const char*)(gbase) + (voff)[_i]), (PG8_LAS unsigned*)(lds + (bufoff) + ldsw + _i * 8192), 16, 0, 0); } while (0)
#define PG8_LDA(dst, b, h) do { _Pragma("unroll") for (int m = 0; m < 4; ++m) _Pragma("unroll") for (int k = 0; k < 2; ++k) dst[m][k] = *(const PG8_LAS bf16x8*)(lds + PG8_SA(b, h) + aoff + m * 2048 + k * 1024); } while (0)
#define PG8_LDB(dst, b, h) do { _Pragma("unroll") for (int n = 0; n < 2; ++n) _Pragma("unroll") for (int k = 0; k < 2; ++k) dst[n][k] = *(const PG8_LAS bf16x8*)(lds + PG8_SB(b, h) + boff + n * 2048 + k * 1024); } while (0)
#define PG8_MMA(ai, bj, At, Bt) do { __builtin_amdgcn_s_setprio(1); _Pragma("unroll") for (int m = 0; m < 4; ++m) _Pragma("unroll") for (int n = 0; n < 2; ++n) _Pragma("unroll") for (int k = 0; k < 2; ++k) \
        acc[ai][bj][m][n] = __builtin_amdgcn_mfma_f32_16x16x32_bf16(Bt[n][k], At[m][k], acc[ai][bj][m][n], 0, 0, 0); __builtin_amdgcn_s_setprio(0); } while (0)
#define PG8_WAIT_V(n) asm volatile("s_waitcnt vmcnt(" #n ")" ::: "memory")
#define PG8_WAIT_L(n) asm volatile("s_waitcnt lgkmcnt(" #n ")" ::: "memory")
#define PG8_BAR __builtin_amdgcn_s_barrier()
#define PG8_SCHED __builtin_amdgcn_sched_barrier(0)
    Unit cur, nxt; int ui = 0;
    if (!S.next(0, cur)) return;
    f32x4 acc[2][2][4][2];
#pragma unroll
    for (int a = 0; a < 2; ++a)
#pragma unroll
        for (int b = 0; b < 2; ++b)
#pragma unroll
            for (int m = 0; m < 4; ++m)
#pragma unroll
                for (int n = 0; n < 2; ++n) acc[a][b][m][n] = (f32x4){0.f, 0.f, 0.f, 0.f};
    bf16x8 At[4][2], B0[2][2], B1[2][2];
    const char* cA = (const char*)g.A + (size_t)cur.pm * tstep; const char* cB = (const char*)g.Bt + (size_t)cur.pn * tstep;
    S.a_ready(cur);
    if constexpr (SP2) {
        PG8_STAGE(PG8_SB(0, 0), cB, voffB); PG8_STAGE(PG8_SB(0, 1), cB + hstep, voffB); PG8_STAGE(PG8_SA(0, 0), cA, voffA); PG8_STAGE(PG8_SA(0, 1), cA + hstep, voffA);
        if (wr == 1) PG8_BAR;
        PG8_WAIT_V(2); PG8_BAR;
        PG8_STAGE(PG8_SB(1, 0), cB + kstep, voffB); PG8_STAGE(PG8_SA(1, 0), cA + kstep, voffA); PG8_STAGE(PG8_SB(1, 1), cB + hstep + kstep, voffB);
        PG8_WAIT_V(6); PG8_BAR;
    } else {
        PG8_STAGE(PG8_SB(0, 0), cB, voffB); PG8_STAGE(PG8_SA(0, 0), cA, voffA); PG8_STAGE(PG8_SB(0, 1), cB + hstep, voffB); PG8_STAGE(PG8_SA(0, 1), cA + hstep, voffA);
        if (wr == 1) PG8_BAR;
        PG8_WAIT_V(4); PG8_BAR;
        PG8_STAGE(PG8_SB(1, 0), cB + kstep, voffB); PG8_STAGE(PG8_SA(1, 0), cA + kstep, voffA); PG8_STAGE(PG8_SB(1, 1), cB + hstep + kstep, voffB);
        PG8_WAIT_V(6); PG8_BAR;
    }
    for (;;) {
        const bool has_next = S.next(ui + 1, nxt);
        const char* nA = has_next ? (const char*)g.A + (size_t)nxt.pm * tstep : cA; const char* nB = has_next ? (const char*)g.Bt + (size_t)nxt.pn * tstep : cB;
        for (int t = 0; t < nt; t += 2) {
            const bool last = (t == nt - 2);
            const char* a1 = cA + (size_t)(t + 1) * kstep;
            const char* a2 = last ? nA : cA + (size_t)(t + 2) * kstep; const char* b2 = last ? nB : cB + (size_t)(t + 2) * kstep;
            const char* a3 = a2 + kstep; const char* b3 = b2 + kstep;
            if (last && has_next) S.a_ready(nxt);
            if constexpr (SP2) {
            PG8_LDB(B0, 0, 0); PG8_LDB(B1, 0, 1); PG8_SCHED; PG8_LDA(At, 0, 0); PG8_STAGE(PG8_SA(1, 1), a1 + hstep, voffA);
            PG8_WAIT_V(8); PG8_WAIT_L(0); PG8_BAR; PG8_MMA(0, 0, At, B0); PG8_MMA(0, 1, At, B1); PG8_BAR; PG8_SCHED;
            PG8_LDA(At, 0, 1); PG8_STAGE(PG8_SB(0, 0), b2, voffB); PG8_STAGE(PG8_SB(0, 1), b2 + hstep, voffB); PG8_STAGE(PG8_SA(0, 0), a2, voffA);
            PG8_WAIT_V(8); PG8_WAIT_L(0); PG8_BAR; PG8_MMA(1, 0, At, B0); PG8_MMA(1, 1, At, B1); PG8_BAR; PG8_SCHED;
            PG8_LDB(B0, 1, 0); PG8_LDB(B1, 1, 1); PG8_SCHED; PG8_LDA(At, 1, 0); PG8_STAGE(PG8_SA(0, 1), a2 + hstep, voffA);
            PG8_WAIT_V(8); PG8_WAIT_L(0); PG8_BAR; PG8_MMA(0, 0, At, B0); PG8_MMA(0, 1, At, B1); PG8_BAR; PG8_SCHED;
            PG8_LDA(At, 1, 1); PG8_STAGE(PG8_SB(1, 0), b3, voffB); PG8_STAGE(PG8_SB(1, 1), b3 + hstep, voffB); PG8_STAGE(PG8_SA(1, 0), a3, voffA);
            PG8_WAIT_V(8); PG8_WAIT_L(0); PG8_BAR; PG8_MMA(1, 0, At, B0); PG8_MMA(1, 1, At, B1); PG8_BAR; PG8_SCHED;
            } else {
            PG8_LDB(B0, 0, 0); PG8_SCHED; PG8_LDA(At, 0, 0); PG8_STAGE(PG8_SA(1, 1), a1 + hstep, voffA);
            PG8_WAIT_L(8); PG8_BAR; PG8_WAIT_L(0); PG8_MMA(0, 0, At, B0); PG8_BAR; PG8_SCHED;
            PG8_LDB(B1, 0, 1); PG8_STAGE(PG8_SB(0, 0), b2, voffB);
            PG8_BAR; PG8_WAIT_L(0); PG8_MMA(0, 1, At, B1); PG8_BAR;
            PG8_LDA(At, 0, 1); PG8_STAGE(PG8_SA(0, 0), a2, voffA);
            PG8_BAR; PG8_WAIT_L(0); PG8_MMA(1, 0, At, B0); PG8_BAR; PG8_SCHED;
            PG8_STAGE(PG8_SB(0, 1), b2 + hstep, voffB);
            PG8_WAIT_V(6); PG8_BAR; PG8_MMA(1, 1, At, B1); PG8_BAR;
            PG8_LDB(B0, 1, 0); PG8_SCHED; PG8_LDA(At, 1, 0); PG8_STAGE(PG8_SA(0, 1), a2 + hstep, voffA);
            PG8_WAIT_L(8); PG8_BAR; PG8_WAIT_L(0); PG8_MMA(0, 0, At, B0); PG8_BAR; PG8_SCHED;
            PG8_LDB(B1, 1, 1); PG8_STAGE(PG8_SB(1, 0), b3, voffB);
            PG8_BAR; PG8_WAIT_L(0); PG8_MMA(0, 1, At, B1); PG8_BAR;
            PG8_LDA(At, 1, 1); PG8_STAGE(PG8_SA(1, 0), a3, voffA);
            PG8_BAR; PG8_WAIT_L(0); PG8_MMA(1, 0, At, B0); PG8_BAR; PG8_SCHED;
            PG8_STAGE(PG8_SB(1, 1), b3 + hstep, voffB);
            PG8_WAIT_V(6); PG8_BAR; PG8_MMA(1, 1, At, B1); PG8_BAR;
            }
        }
        if constexpr (ALIGN_EPI) { if (wr == 0) PG8_BAR; }
        if constexpr (!Epi::AFTER_DRAIN) { E(acc, cur, wr, wc, fr, fq); S.done(cur); }
        if (!has_next) break;
#pragma unroll
        for (int a = 0; a < 2; ++a)
#pragma unroll
            for (int b = 0; b < 2; ++b)
#pragma unroll
                for (int m = 0; m < 4; ++m)
#pragma unroll
                    for (int n = 0; n < 2; ++n) acc[a][b][m][n] = (f32x4){0.f, 0.f, 0.f, 0.f};
        cur = nxt; cA = nA; cB = nB; ++ui;
        if constexpr (ALIGN_EPI) { if (wr == 1) PG8_BAR; }
    }
    PG8_WAIT_V(0);
    if constexpr (!ALIGN_EPI) { if (wr == 0) PG8_BAR; }
    PG8_BAR;
    if constexpr (Epi::AFTER_DRAIN) { E.fused(acc, cur, wr, wc, fr, fq, lds, wid, lane); S.done(cur); }
#undef PG8_SA
#undef PG8_SB
#undef PG8_STAGE
#undef PG8_LDA
#undef PG8_LDB
#undef PG8_MMA
#undef PG8_WAIT_V
#undef PG8_WAIT_L
#undef PG8_BAR
#undef PG8_SCHED
}
}
namespace pg8 {
__device__ __forceinline__ float sigmoidf_(float x) { return __builtin_amdgcn_rcpf(1.0f + __builtin_amdgcn_exp2f(-1.4426950408889634f * x)); }
struct EpiBf16Split {
    static constexpr bool PERM = true, AFTER_DRAIN = false;
    bf16_t* O0; int ld0; int nt0; bf16_t* O1; int ld1;
    __device__ __forceinline__ void operator()(const f32x4 (&acc)[2][2][4][2], const Unit& u, int wr, int wc, int fr, int fq) const {
        const bool first = u.pn < nt0; bf16_t* base = first ? O0 : O1; const int ld = first ? ld0 : ld1; const int colt = (first ? u.pn : u.pn - nt0) * BM;
        const int row0 = u.pm * BM + wr * 64 + fr, col0 = colt + wc * 32 + 8 * fq;
#pragma unroll
        for (int ai = 0; ai < 2; ++ai)
#pragma unroll
            for (int m = 0; m < 4; ++m) { bf16_t* rowp = base + (size_t)(row0 + ai * HALF + m * 16) * ld + col0;
#pragma unroll
                for (int bj = 0; bj < 2; ++bj) { const f32x4 v0 = acc[ai][bj][m][0], v1 = acc[ai][bj][m][1];
                    u32x4 w; w.x = cvt_pk_bf16(v0[0], v0[1]); w.y = cvt_pk_bf16(v0[2], v0[3]); w.z = cvt_pk_bf16(v1[0], v1[1]); w.w = cvt_pk_bf16(v1[2], v1[3]);
                    *(u32x4*)(rowp + bj * HALF) = w; } }
    }
};
struct EpiResF32 {
    static constexpr bool PERM = false, AFTER_DRAIN = false;
    const float* base; float* out; int ldc;
    __device__ __forceinline__ void operator()(const f32x4 (&acc)[2][2][4][2], const Unit& u, int wr, int wc, int fr, int fq) const {
        const int row0 = u.pm * BM + wr * 64 + fr, col0 = u.pn * BM + wc * 32 + 4 * fq;
#pragma unroll
        for (int ai = 0; ai < 2; ++ai)
#pragma unroll
            for (int m = 0; m < 4; ++m) { const size_t off = (size_t)(row0 + ai * HALF + m * 16) * ldc + col0;
#pragma unroll
                for (int bj = 0; bj < 2; ++bj)
#pragma unroll
                    for (int n = 0; n < 2; ++n) { const f32x4 b = *(const f32x4*)(base + off + bj * HALF + n * 16); *(f32x4*)(out + off + bj * HALF + n * 16) = b + acc[ai][bj][m][n]; } }
    }
};
struct EpiSwiglu {
    static constexpr bool PERM = false, AFTER_DRAIN = false;
    bf16_t* H; int ldh;
    __device__ __forceinline__ void operator()(const f32x4 (&acc)[2][2][4][2], const Unit& u, int wr, int wc, int fr, int fq) const {
        const int row0 = u.pm * BM + wr * 64 + fr, hc0 = u.pn * (BM / 2) + wc * 16 + 4 * fq;
#pragma unroll
        for (int ai = 0; ai < 2; ++ai)
#pragma unroll
            for (int m = 0; m < 4; ++m) { bf16_t* rowp = H + (size_t)(row0 + ai * HALF + m * 16) * ldh + hc0;
#pragma unroll
                for (int bj = 0; bj < 2; ++bj) { const f32x4 g = acc[ai][bj][m][0], up = acc[ai][bj][m][1]; float h[4];
#pragma unroll
                    for (int i = 0; i < 4; ++i) h[i] = g[i] * sigmoidf_(g[i]) * up[i];
                    typedef unsigned u32x2 __attribute__((ext_vector_type(2)));
                    u32x2 w; w.x = cvt_pk_bf16(h[0], h[1]); w.y = cvt_pk_bf16(h[2], h[3]);
                    *(u32x2*)(rowp + bj * (HALF / 2)) = w; } }
    }
};
struct EpiPle {
    static constexpr bool PERM = false, AFTER_DRAIN = false;
    const float* base; float* out; const bf16_t* E; int ldc;
    __device__ __forceinline__ void operator()(const f32x4 (&acc)[2][2][4][2], const Unit& u, int wr, int wc, int fr, int fq) const {
        const int row0 = u.pm * BM + wr * 64 + fr, col0 = u.pn * BM + wc * 32 + 4 * fq;
        typedef unsigned u32x2 __attribute__((ext_vector_type(2)));
#pragma unroll
        for (int ai = 0; ai < 2; ++ai)
#pragma unroll
            for (int m = 0; m < 4; ++m) { const size_t off = (size_t)(row0 + ai * HALF + m * 16) * ldc + col0;
#pragma unroll
                for (int bj = 0; bj < 2; ++bj)
#pragma unroll
                    for (int n = 0; n < 2; ++n) { const size_t o = off + bj * HALF + n * 16; const f32x4 b = *(const f32x4*)(base + o); const u32x2 e = *(const u32x2*)(E + o); const f32x4 a = acc[ai][bj][m][n];
                        f32x4 r; r[0] = b[0] + __uint_as_float(e.x << 16) * sigmoidf_(a[0]); r[1] = b[1] + __uint_as_float(e.x & 0xffff0000u) * sigmoidf_(a[1]);
                        r[2] = b[2] + __uint_as_float(e.y << 16) * sigmoidf_(a[2]); r[3] = b[3] + __uint_as_float(e.y & 0xffff0000u) * sigmoidf_(a[3]);
                        *(f32x4*)(out + o) = r; } }
    }
};
__device__ __forceinline__ float rms_r(const float* rsq, int row) { const f32x4* p = (const f32x4*)(rsq + (size_t)row * 16); const f32x4 a = p[0], b = p[1], c = p[2], d = p[3];
    const float s = (((a[0] + a[1]) + (a[2] + a[3])) + ((b[0] + b[1]) + (b[2] + b[3]))) + (((c[0] + c[1]) + (c[2] + c[3])) + ((d[0] + d[1]) + (d[2] + d[3]))); return rsqrtf(s * (1.0f / 1024.0f) + 1e-6f); }
__device__ __forceinline__ void norm_out(const f32x4 (&x)[2][2], bf16_t* xb, size_t off, float* rsq_out, int row, int fq, int slot) {
    typedef unsigned u32x2 __attribute__((ext_vector_type(2))); float s = 0.f;
#pragma unroll
    for (int bj = 0; bj < 2; ++bj)
#pragma unroll
        for (int n = 0; n < 2; ++n) { const f32x4 v = x[bj][n]; s += (v[0] * v[0] + v[1] * v[1]) + (v[2] * v[2] + v[3] * v[3]); u32x2 w; w.x = cvt_pk_bf16(v[0], v[1]); w.y = cvt_pk_bf16(v[2], v[3]); *(u32x2*)(xb + off + bj * HALF + n * 16) = w; }
    s += __shfl_xor(s, 16); s += __shfl_xor(s, 32);
    if (fq == 0) rsq_out[(size_t)row * 16 + slot] = s;
}
struct EpiBf16SplitR {
    static constexpr bool PERM = true, AFTER_DRAIN = false;
    bf16_t* O0; int ld0; int nt0; bf16_t* O1; int ld1; const float* rsq;
    __device__ __forceinline__ void operator()(const f32x4 (&acc)[2][2][4][2], const Unit& u, int wr, int wc, int fr, int fq) const {
        const bool first = u.pn < nt0; bf16_t* base = first ? O0 : O1; const int ld = first ? ld0 : ld1; const int colt = (first ? u.pn : u.pn - nt0) * BM;
        const int row0 = u.pm * BM + wr * 64 + fr, col0 = colt + wc * 32 + 8 * fq;
#pragma unroll
        for (int ai = 0; ai < 2; ++ai)
#pragma unroll
            for (int m = 0; m < 4; ++m) { const int row = row0 + ai * HALF + m * 16; const float r = rms_r(rsq, row); bf16_t* rowp = base + (size_t)row * ld + col0;
#pragma unroll
                for (int bj = 0; bj < 2; ++bj) { const f32x4 v0 = acc[ai][bj][m][0] * r, v1 = acc[ai][bj][m][1] * r;
                    u32x4 w; w.x = cvt_pk_bf16(v0[0], v0[1]); w.y = cvt_pk_bf16(v0[2], v0[3]); w.z = cvt_pk_bf16(v1[0], v1[1]); w.w = cvt_pk_bf16(v1[2], v1[3]);
                    *(u32x4*)(rowp + bj * HALF) = w; } }
    }
};
struct EpiSwigluR {
    static constexpr bool PERM = false, AFTER_DRAIN = false;
    bf16_t* H; int ldh; const float* rsq;
    __device__ __forceinline__ void operator()(const f32x4 (&acc)[2][2][4][2], const Unit& u, int wr, int wc, int fr, int fq) const {
        const int row0 = u.pm * BM + wr * 64 + fr, hc0 = u.pn * (BM / 2) + wc * 16 + 4 * fq;
#pragma unroll
        for (int ai = 0; ai < 2; ++ai)
#pragma unroll
            for (int m = 0; m < 4; ++m) { const int row = row0 + ai * HALF + m * 16; const float r = rms_r(rsq, row); bf16_t* rowp = H + (size_t)row * ldh + hc0;
#pragma unroll
                for (int bj = 0; bj < 2; ++bj) { const f32x4 g = acc[ai][bj][m][0] * r, up = acc[ai][bj][m][1] * r; float h[4];
#pragma unroll
                    for (int i = 0; i < 4; ++i) h[i] = g[i] * sigmoidf_(g[i]) * up[i];
                    typedef unsigned u32x2 __attribute__((ext_vector_type(2)));
                    u32x2 w; w.x = cvt_pk_bf16(h[0], h[1]); w.y = cvt_pk_bf16(h[2], h[3]);
                    *(u32x2*)(rowp + bj * (HALF / 2)) = w; } }
    }
};
struct EpiResN {
    static constexpr bool PERM = false, AFTER_DRAIN = false;
    const float* base; float* out; int ldc; bf16_t* XBo; float* rsq_out;
    __device__ __forceinline__ void operator()(const f32x4 (&acc)[2][2][4][2], const Unit& u, int wr, int wc, int fr, int fq) const {
        const int row0 = u.pm * BM + wr * 64 + fr, col0 = u.pn * BM + wc * 32 + 4 * fq;
#pragma unroll
        for (int ai = 0; ai < 2; ++ai)
#pragma unroll
            for (int m = 0; m < 4; ++m) { const int row = row0 + ai * HALF + m * 16; const size_t off = (size_t)row * ldc + col0; f32x4 x[2][2];
#pragma unroll
                for (int bj = 0; bj < 2; ++bj)
#pragma unroll
                    for (int n = 0; n < 2; ++n) { const f32x4 b = *(const f32x4*)(base + off + bj * HALF + n * 16); x[bj][n] = b + acc[ai][bj][m][n]; *(f32x4*)(out + off + bj * HALF + n * 16) = x[bj][n]; }
                if (XBo) norm_out(x, XBo, off, rsq_out, row, fq, u.pn * 4 + wc); }
    }
};
struct EpiPleN {
    static constexpr bool PERM = false, AFTER_DRAIN = false;
    const float* base; float* out; const bf16_t* E; int ldc; const float* rsq_in; bf16_t* XBo; float* rsq_out;
    __device__ __forceinline__ void operator()(const f32x4 (&acc)[2][2][4][2], const Unit& u, int wr, int wc, int fr, int fq) const {
        const int row0 = u.pm * BM + wr * 64 + fr, col0 = u.pn * BM + wc * 32 + 4 * fq;
        typedef unsigned u32x2 __attribute__((ext_vector_type(2)));
#pragma unroll
        for (int ai = 0; ai < 2; ++ai)
#pragma unroll
            for (int m = 0; m < 4; ++m) { const int row = row0 + ai * HALF + m * 16; const size_t off = (size_t)row * ldc + col0; const float r = rms_r(rsq_in, row); f32x4 x[2][2];
#pragma unroll
                for (int bj = 0; bj < 2; ++bj)
#pragma unroll
                    for (int n = 0; n < 2; ++n) { const size_t o = off + bj * HALF + n * 16; const f32x4 b = *(const f32x4*)(base + o); const u32x2 e = *(const u32x2*)(E + o); const f32x4 a = acc[ai][bj][m][n] * r;
                        f32x4 v; v[0] = b[0] + __uint_as_float(e.x << 16) * sigmoidf_(a[0]); v[1] = b[1] + __uint_as_float(e.x & 0xffff0000u) * sigmoidf_(a[1]);
                        v[2] = b[2] + __uint_as_float(e.y << 16) * sigmoidf_(a[2]); v[3] = b[3] + __uint_as_float(e.y & 0xffff0000u) * sigmoidf_(a[3]);
                        x[bj][n] = v; *(f32x4*)(out + o) = v; }
                if (XBo) norm_out(x, XBo, off, rsq_out, row, fq, u.pn * 4 + wc); }
    }
};
__device__ __forceinline__ f32x4 ld_base4(const float* p) { return *(const f32x4*)p; }
__device__ __forceinline__ f32x4 ld_base4(const bf16_t* p) { typedef unsigned u32x2 __attribute__((ext_vector_type(2))); const u32x2 e = *(const u32x2*)p; return (f32x4){__uint_as_float(e.x << 16), __uint_as_float(e.x & 0xffff0000u), __uint_as_float(e.y << 16), __uint_as_float(e.y & 0xffff0000u)}; }
template <class BaseT> struct EpiRes2 {
    static constexpr bool PERM = false, AFTER_DRAIN = false;
    const BaseT* base; bf16_t* out; int ldc; float* rsq_out;
    __device__ __forceinline__ void operator()(const f32x4 (&acc)[2][2][4][2], const Unit& u, int wr, int wc, int fr, int fq) const {
        const int row0 = u.pm * BM + wr * 64 + fr, col0 = u.pn * BM + wc * 32 + 4 * fq;
#pragma unroll
        for (int ai = 0; ai < 2; ++ai)
#pragma unroll
            for (int m = 0; m < 4; ++m) { const int row = row0 + ai * HALF + m * 16; const size_t off = (size_t)row * ldc + col0; f32x4 x[2][2];
#pragma unroll
                for (int bj = 0; bj < 2; ++bj)
#pragma unroll
                    for (int n = 0; n < 2; ++n) x[bj][n] = ld_base4(base + off + bj * HALF + n * 16) + acc[ai][bj][m][n];
                norm_out(x, out, off, rsq_out, row, fq, u.pn * 4 + wc); }
    }
};
template <bool OUT_F32> struct EpiPle2 {
    static constexpr bool PERM = false, AFTER_DRAIN = false;
    const bf16_t* base; void* out; const bf16_t* E; int ldc; const float* rsq_in; float* rsq_out;
    __device__ __forceinline__ void operator()(const f32x4 (&acc)[2][2][4][2], const Unit& u, int wr, int wc, int fr, int fq) const {
        const int row0 = u.pm * BM + wr * 64 + fr, col0 = u.pn * BM + wc * 32 + 4 * fq;
#pragma unroll
        for (int ai = 0; ai < 2; ++ai)
#pragma unroll
            for (int m = 0; m < 4; ++m) { const int row = row0 + ai * HALF + m * 16; const size_t off = (size_t)row * ldc + col0; const float r = rms_r(rsq_in, row); f32x4 x[2][2];
#pragma unroll
                for (int bj = 0; bj < 2; ++bj)
#pragma unroll
                    for (int n = 0; n < 2; ++n) { const size_t o = off + bj * HALF + n * 16; const f32x4 b = ld_base4(base + o), e = ld_base4(E + o), a = acc[ai][bj][m][n] * r; f32x4 v;
#pragma unroll
                        for (int i = 0; i < 4; ++i) v[i] = b[i] + e[i] * sigmoidf_(a[i]);
                        x[bj][n] = v; if (OUT_F32) *(f32x4*)((float*)out + o) = v; }
                if (!OUT_F32) norm_out(x, (bf16_t*)out, off, rsq_out, row, fq, u.pn * 4 + wc); }
    }
};
}
#ifndef PG8_SP2
#define PG8_SP2 true
#endif
#ifndef PG8_ALIGN
#define PG8_ALIGN true
#endif
constexpr int NB = 32, SEQ = 2048, T = NB * SEQ, D = 1024;
constexpr int NU = 2816, UA_W = 1024, UB_W = 1792;
constexpr int FF = 2816, CI = 2048, TH = T / 2;
constexpr int NWAVES = 8;
constexpr float NORM_EPS = 1e-6f, LOG2E = 1.4426950408889634f;
constexpr int UA_K = 512, UA_V = 576, UA_IQ = 640, UA_IK = 896, UA_IW = 960;
constexpr size_t MiB = 1u << 20, QMiB = 1u << 18;
constexpr size_t WS_CTL = 0, CTL_ZERO_BYTES = 1 * MiB;
constexpr size_t WS_WIN = 4 * QMiB, WS_WLORA = 26 * QMiB, WS_WOUT = 29 * QMiB;
constexpr size_t WS_WGU0 = 37 * QMiB, WS_WD0 = 81 * QMiB, WS_WPLE0 = 103 * QMiB, WS_WPG0 = 105 * QMiB, WS_LAYER_STRIDE = 76 * QMiB;
constexpr size_t WS_WUP = 189 * QMiB, WS_WDOWN = 221 * QMiB, WS_W12 = 237 * QMiB;
static_assert(WS_WPG0 + 8 * QMiB == WS_WGU0 + WS_LAYER_STRIDE && WS_WPG0 + WS_LAYER_STRIDE + 8 * QMiB == WS_WUP && WS_W12 + QMiB <= 60 * MiB, "weight map");
constexpr size_t ACT = 60 * MiB;
constexpr size_t WS_XB = ACT, WS_UA = ACT + 128 * MiB, WS_UB = ACT + 256 * MiB, WS_LIN = ACT + 480 * MiB, WS_LOUT = ACT + 512 * MiB;
constexpr size_t WS_QN = ACT + 704 * MiB, WS_KN = ACT + 768 * MiB, WS_VT = ACT + 776 * MiB, WS_MASK = ACT + 784 * MiB;
constexpr size_t WS_XB2 = ACT + 768 * MiB;
constexpr size_t WS_H = ACT + 128 * MiB, WS_E = ACT + 480 * MiB, WS_PB = ACT + 896 * MiB;
constexpr size_t WS_XM = ACT, WS_Z = ACT + 128 * MiB, WS_XC = ACT + 256 * MiB, WS_Q = ACT + 384 * MiB, WS_K = ACT + 512 * MiB, WS_V = ACT + 640 * MiB;
constexpr size_t WS_RS = ACT + 928 * MiB, RS_ONE = (size_t)T * 16 * 4;
constexpr size_t WS_GI = ACT + 952 * MiB, WS_GA = WS_GI + 1 * MiB, WS_GAM = WS_GI + 2 * MiB, WS_GEM = WS_GI + 3 * MiB;
constexpr size_t WS_END = ACT + 956 * MiB;
static_assert(WS_END <= 1024 * MiB, "workspace");
constexpr int CW_TMO = 0, CW_BAR = 4096, CW_XRANK = 8192;
constexpr int LDS_BYTES = 155648;
constexpr int MISC_OFF = LDS_BYTES - 256;
#define GAS __attribute__((address_space(1)))
#define LAS __attribute__((address_space(3)))
typedef unsigned short bf16;
typedef unsigned v4u __attribute__((ext_vector_type(4)));
typedef unsigned v2u __attribute__((ext_vector_type(2)));
typedef float f32x4 __attribute__((ext_vector_type(4)));
typedef float f32x2 __attribute__((ext_vector_type(2)));
typedef float f32x8 __attribute__((ext_vector_type(8)));
typedef short bf16x8 __attribute__((ext_vector_type(8)));
typedef short s16x4 __attribute__((ext_vector_type(4)));
typedef GAS unsigned gu32;
#define RLX_AGENT __ATOMIC_RELAXED, __HIP_MEMORY_SCOPE_AGENT
#define LDS_WAIT() asm volatile("s_waitcnt lgkmcnt(0)" ::: "memory")
#define VM_WAIT() asm volatile("s_waitcnt vmcnt(0)" ::: "memory")
__device__ __forceinline__ unsigned f2bf(float f) { unsigned u = __builtin_bit_cast(unsigned, f); return (u + 0x7fffu + ((u >> 16) & 1u)) >> 16; }

#define XB_TMO      128
#define XB_XCNT(j)  (256  + 64 * (j))
#define XB_XSUB(j)  (1280 + 64 * (j))
#define XB_XGEN(j)  (2304 + 64 * (j))
#define XB_TOP      3328
#define XB_TOPGEN   3392
#define XCD_BAR_WORDS 3456
#define XB_SPIN_CAP (1u << 18)

__device__ __forceinline__ unsigned xb_ld(unsigned* p)              { return __hip_atomic_load(p, __ATOMIC_RELAXED, __HIP_MEMORY_SCOPE_AGENT); }
__device__ __forceinline__ unsigned xb_add(unsigned* p, unsigned v) { return __hip_atomic_fetch_add(p, v, __ATOMIC_RELAXED, __HIP_MEMORY_SCOPE_AGENT); }
__device__ __forceinline__ unsigned xb_xcc_id() { return (unsigned)__builtin_amdgcn_s_getreg((3 << 11) | 20) & 0xFu; }
#define XB_SPIN(cond, bar) do { unsigned _sp = 0; while (cond) { __builtin_amdgcn_s_sleep(1); \
    if ((++_sp & 255u) == 0u) { if (xb_ld(&(bar)[XB_TMO])) break; if (_sp > XB_SPIN_CAP) { atomicAdd(&(bar)[XB_TMO], 1u); break; } } } } while (0)

struct XcdBarrier {
    unsigned* bar; unsigned x;
    volatile LAS unsigned* st;
};

__device__ __forceinline__ XcdBarrier xcd_barrier_post(unsigned* bar, volatile LAS unsigned* st) {
    XcdBarrier b; b.bar = bar; b.x = xb_xcc_id(); b.st = st;
    if (threadIdx.x == 0) (void)xb_add(&bar[XB_XCNT(b.x)], 1u);
    return b;
}
__device__ __forceinline__ void xcd_barrier_complete(unsigned* bar, unsigned x, unsigned& nloc, unsigned& nx) {
    const unsigned G = gridDim.x * gridDim.y * gridDim.z;
    unsigned sum, cnt, mine, sp = 0u;
    for (;;) {
        sum = 0u; cnt = 0u; mine = 0u;
#pragma unroll
        for (unsigned j = 0; j < 16; ++j) { const unsigned c = xb_ld(&bar[XB_XCNT(j)]); sum += c; cnt += (c > 0u) ? 1u : 0u; mine = (j == x) ? c : mine; }
        if (sum == G) break;
        __builtin_amdgcn_s_sleep(1);
        if ((++sp & 255u) == 0u) { if (xb_ld(&bar[XB_TMO])) break; if (sp > XB_SPIN_CAP) { atomicAdd(&bar[XB_TMO], 1u); break; } }
    }
    nloc = mine > 0u ? mine : 1u; nx = cnt > 0u ? cnt : 1u;
}

__device__ __forceinline__ void xcd_barrier(const XcdBarrier& b) {
    asm volatile("s_waitcnt vmcnt(0)" ::: "memory");
    __syncthreads();
    if (threadIdx.x == 0) {
        unsigned* bar = b.bar;
        __builtin_amdgcn_s_waitcnt(0);
        unsigned nloc = b.st[0], nx = b.st[1];
        if (nloc == 0u) { xcd_barrier_complete(bar, b.x, nloc, nx); b.st[0] = nloc; b.st[1] = nx; }
        const unsigned old = xb_add(&bar[XB_XSUB(b.x)], 1u);
        const unsigned gen = old / nloc;
        if (old + 1u == (gen + 1u) * nloc) {
            __builtin_amdgcn_fence(__ATOMIC_RELEASE, "agent");
            asm volatile("s_waitcnt vmcnt(0)" ::: "memory");
            const unsigned og = xb_add(&bar[XB_TOP], 1u);
            const unsigned tg = og / nx;
            if (og + 1u == (tg + 1u) * nx) xb_add(&bar[XB_TOPGEN], 1u);
            else XB_SPIN(xb_ld(&bar[XB_TOPGEN]) == tg, bar);
            __builtin_amdgcn_fence(__ATOMIC_ACQUIRE, "agent");
            xb_add(&bar[XB_XGEN(b.x)], 1u);
            asm volatile("s_waitcnt vmcnt(0)" ::: "memory");
        } else {
            XB_SPIN(xb_ld(&bar[XB_XGEN(b.x)]) == gen, bar);
            __builtin_amdgcn_fence(__ATOMIC_ACQUIRE, "agent");
            asm volatile("s_waitcnt vmcnt(0)" ::: "memory");
        }
    }
    __syncthreads();
}

struct Frame {
    LAS unsigned char* lds;
    unsigned char* ws;
    const float* const* in;
    int tid, lane, wave, G, bid;
};
struct Args { const float* in[37]; float* out; unsigned char* ws; int ph_lo, ph_hi, use_bar, pad; };

__device__ __forceinline__ float dpp_f(float v, int ctrl_qp1) { return v; }
#define DPP_MOVF(v, ctrl) __builtin_bit_cast(float, __builtin_amdgcn_mov_dpp(__builtin_bit_cast(int, (v)), (ctrl), 0xf, 0xf, true))
__device__ __forceinline__ float wave_sum(float v) {
    v += DPP_MOVF(v, 0xB1);
    v += DPP_MOVF(v, 0x4E);
    v += DPP_MOVF(v, 0x141);
    v += DPP_MOVF(v, 0x140);
    v += __shfl_xor(v, 16); v += __shfl_xor(v, 32);
    return v;
}
__device__ __forceinline__ float wave_max(float v) {
#pragma unroll
    for (int o = 1; o < 64; o <<= 1) v = fmaxf(v, __shfl_xor(v, o));
    return v;
}
__device__ __forceinline__ float bflo(unsigned u) { return __uint_as_float(u << 16); }
__device__ __forceinline__ float bfhi(unsigned u) { return __uint_as_float(u & 0xffff0000u); }
__device__ __forceinline__ float bf1(bf16 h) { return __uint_as_float(((unsigned)h) << 16); }
__device__ __forceinline__ unsigned pk2(float lo, float hi) { return pg8::cvt_pk_bf16(lo, hi); }
__device__ __forceinline__ float sigm(float x) { return __builtin_amdgcn_rcpf(1.0f + __builtin_amdgcn_exp2f(-LOG2E * x)); }
__device__ __forceinline__ float softplusf_(float x) { return fmaxf(x, 0.f) + log1pf(__expf(-fabsf(x))); }
__device__ __forceinline__ void unpack8(const v4u& r, float (&f)[8]) { f[0] = bflo(r.x); f[1] = bfhi(r.x); f[2] = bflo(r.y); f[3] = bfhi(r.y); f[4] = bflo(r.z); f[5] = bfhi(r.z); f[6] = bflo(r.w); f[7] = bfhi(r.w); }
__device__ __forceinline__ v4u pack8(const float (&f)[8]) { v4u o; o.x = pk2(f[0], f[1]); o.y = pk2(f[2], f[3]); o.z = pk2(f[4], f[5]); o.w = pk2(f[6], f[7]); return o; }

template <class Fn> __device__ __forceinline__ void wprep(bf16* dst, int N, int K, Fn f, int gt, int NT) {
    const int lane = gt & 63, gwv = gt >> 6, NW = NT >> 6, ntn = N >> 3, tiles = ntn * (K >> 6);
    for (int tl = gwv; tl < tiles; tl += NW) { const int n = (tl % ntn) * 8 + (lane & 7), k0 = (tl / ntn) * 64 + (lane >> 3) * 8; float v[8];
#pragma unroll
        for (int j = 0; j < 8; ++j) v[j] = f(k0 + j, n);
        *(v4u*)(dst + (size_t)n * K + k0) = pack8(v); }
}
template <class Fn> __device__ __forceinline__ void wprep_tile(bf16* dst, int N, int K, Fn f, int tl, int lane) {
    const int ntn = N >> 3; const int n = (tl % ntn) * 8 + (lane & 7), k0 = (tl / ntn) * 64 + (lane >> 3) * 8; float v[8];
#pragma unroll
    for (int j = 0; j < 8; ++j) v[j] = f(k0 + j, n);
    *(v4u*)(dst + (size_t)n * K + k0) = pack8(v);
}
constexpr int DT_WOUT = (D / 8) * (D / 64), DT_GU = (2 * FF / 8) * (D / 64), DT_WD = (D / 8) * (FF / 64), DT_PLE = (D / 8) * (256 / 64), DT_PG = (D / 8) * (D / 64), DT_LAYER = DT_GU + DT_WD + DT_PLE + DT_PG;
constexpr int DT_UP = (2 * CI / 8) * (D / 64), DT_DOWN = (D / 8) * (CI / 64), DT_TOTAL = DT_WOUT + 2 * DT_LAYER + DT_UP + DT_DOWN;
__device__ __forceinline__ void prep_deferred_tile(Frame& F, const Args& a, int tl) {
    unsigned char* ws = F.ws; const int lane = F.lane;
    if (tl < DT_WOUT) { const float* W = a.in[17]; wprep_tile((bf16*)(ws + WS_WOUT), D, D, [=](int k, int n) { return W[(size_t)k * D + n]; }, tl, lane); return; }
    tl -= DT_WOUT;
    if (tl < 2 * DT_LAYER) { const int L = tl >= DT_LAYER ? 1 : 0; tl -= L * DT_LAYER;
        const float* wg = a.in[31] + (size_t)L * D * FF; const float* wu = a.in[32] + (size_t)L * D * FF; const float* wd = a.in[33] + (size_t)L * FF * D;
        const float* wp = a.in[34] + (size_t)L * 256 * D; const float* wpg = a.in[36] + (size_t)L * D * D; const float* gnf = a.in[30] + L * D; const float* gnp = a.in[35] + L * D;
        if (tl < DT_GU) { wprep_tile((bf16*)(ws + WS_WGU0 + L * WS_LAYER_STRIDE), 2 * FF, D, [=](int k, int n) { const int hid = 16 * (n >> 5) + (n & 15); return ((n & 31) >= 16 ? wu : wg)[(size_t)k * FF + hid] * gnf[k]; }, tl, lane); return; }
        tl -= DT_GU;
        if (tl < DT_WD) { wprep_tile((bf16*)(ws + WS_WD0 + L * WS_LAYER_STRIDE), D, FF, [=](int k, int n) { return wd[(size_t)k * D + n]; }, tl, lane); return; }
        tl -= DT_WD;
        if (tl < DT_PLE) { wprep_tile((bf16*)(ws + WS_WPLE0 + L * WS_LAYER_STRIDE), D, 256, [=](int k, int n) { return wp[(size_t)k * D + n]; }, tl, lane); return; }
        tl -= DT_PLE;
        wprep_tile((bf16*)(ws + WS_WPG0 + L * WS_LAYER_STRIDE), D, D, [=](int k, int n) { return wpg[(size_t)k * D + n] * gnp[k]; }, tl, lane); return; }
    tl -= 2 * DT_LAYER;
    if (tl < DT_UP) { const float* W = a.in[18]; const float* gn1 = a.in[2] + D; wprep_tile((bf16*)(ws + WS_WUP), 2 * CI, D, [=](int k, int n) { return W[(size_t)k * (2 * CI) + n] * gn1[k]; }, tl, lane); return; }
    tl -= DT_UP;
    if (tl < DT_DOWN) { const float* W = a.in[29]; wprep_tile((bf16*)(ws + WS_WDOWN), D, CI, [=](int k, int n) { return W[(size_t)k * D + n]; }, tl, lane); }
}
__device__ __forceinline__ void phase_prologue(Frame& F, const Args& a) {
    const int gt = F.bid * 512 + F.tid, NT = F.G * 512; unsigned char* ws = F.ws;
    { const float* W = a.in[5]; const float* gn0 = a.in[2];
      wprep((bf16*)(ws + WS_WIN), NU, D, [=](int k, int n) { const int c = n < 964 ? n : (n < 1024 ? -1 : n - 60); return c < 0 ? 0.f : W[(size_t)k * 2756 + c] * gn0[k]; }, gt, NT); }
    { const float* w2 = a.in[8]; const float* a2 = a.in[10]; const float* g2 = a.in[11];
      wprep((bf16*)(ws + WS_WLORA), 1536, 256, [=](int k, int n) { if (n < 512) return k < 64 ? w2[k * 512 + n] : 0.f; if (n < 1024) return (k >= 64 && k < 128) ? a2[(k - 64) * 512 + n - 512] : 0.f; return k >= 128 ? g2[(k - 128) * 512 + n - 1024] : 0.f; }, gt, NT); }
    { const float* wq = a.in[21]; const float* wk = a.in[22]; const float* wv = a.in[23]; const float* wif = a.in[24]; float* W12 = (float*)(ws + WS_W12);
      for (int it = gt; it < 4096 * 8; it += NT) { const int o = it & 7, c = (it >> 3) & 2047, part = it >> 14, g = c >> 2, i = c & 3; float s = 0.f;
          if (part == 0) { for (int j = 0; j < 4; ++j) s += wq[(g * 4 + i) * 4 + j] * wif[(size_t)(4 * g + j) * 8 + o] + wk[(g * 4 + i) * 4 + j] * wif[(size_t)(2048 + 4 * g + j) * 8 + o]; }
          else { for (int j = 0; j < 4; ++j) s += wv[(g * 4 + i) * 4 + j] * wif[(size_t)(4096 + 4 * g + j) * 8 + o]; }
          W12[it] = s; } }
}
__device__ __forceinline__ void phase_norm(Frame& F, const float* src, const float* gain, bf16* dst, int nrows) {
    const int gw = F.bid * NWAVES + F.wave, NGW = F.G * NWAVES, lane = F.lane;
    f32x4 g[4];
#pragma unroll
    for (int j = 0; j < 4; ++j) g[j] = *((const f32x4*)gain + lane + 64 * j);
    for (int m = gw; m < nrows; m += NGW) {
        const f32x4* xr = (const f32x4*)(src + (size_t)m * D) + lane; f32x4 v[4]; float s = 0.f;
#pragma unroll
        for (int j = 0; j < 4; ++j) { v[j] = xr[64 * j]; s += (v[j].x * v[j].x + v[j].y * v[j].y) + (v[j].z * v[j].z + v[j].w * v[j].w); }
        const float r = rsqrtf(wave_sum(s) * (1.f / D) + NORM_EPS);
        v2u* o = (v2u*)(dst + (size_t)m * D) + lane;
#pragma unroll
        for (int j = 0; j < 4; ++j) { v2u w; w.x = pk2(v[j].x * r * g[j].x, v[j].y * r * g[j].y); w.y = pk2(v[j].z * r * g[j].z, v[j].w * r * g[j].w); o[64 * j] = w; }
    }
}
__device__ __forceinline__ void phase_cast_sq(Frame& F, const float* src, bf16* dst, float* rsq, int nrows) {
    const int gw = F.bid * NWAVES + F.wave, NGW = F.G * NWAVES, lane = F.lane;
    for (int m = gw; m < nrows; m += 2 * NGW) { const int m2 = m + NGW; const bool has2 = m2 < nrows;
        const f32x4* xr = (const f32x4*)(src + (size_t)m * D) + lane; const f32x4* xr2 = (const f32x4*)(src + (size_t)(has2 ? m2 : m) * D) + lane; f32x4 v[4], u[4]; float s = 0.f, s2 = 0.f;
#pragma unroll
        for (int j = 0; j < 4; ++j) { v[j] = xr[64 * j]; u[j] = xr2[64 * j]; }
#pragma unroll
        for (int j = 0; j < 4; ++j) { s += (v[j].x * v[j].x + v[j].y * v[j].y) + (v[j].z * v[j].z + v[j].w * v[j].w); s2 += (u[j].x * u[j].x + u[j].y * u[j].y) + (u[j].z * u[j].z + u[j].w * u[j].w); }
        s = wave_sum(s); s2 = wave_sum(s2);
        if (lane < 16) rsq[(size_t)m * 16 + lane] = lane == 0 ? s : 0.f;
        v2u* o = (v2u*)(dst + (size_t)m * D) + lane;
#pragma unroll
        for (int j = 0; j < 4; ++j) { v2u w; w.x = pk2(v[j].x, v[j].y); w.y = pk2(v[j].z, v[j].w); o[64 * j] = w; }
        if (has2) { if (lane < 16) rsq[(size_t)m2 * 16 + lane] = lane == 0 ? s2 : 0.f;
            v2u* o2 = (v2u*)(dst + (size_t)m2 * D) + lane;
#pragma unroll
            for (int j = 0; j < 4; ++j) { v2u w; w.x = pk2(u[j].x, u[j].y); w.y = pk2(u[j].z, u[j].w); o2[64 * j] = w; } }
    }
}
__device__ __forceinline__ void phase_cvt_p(Frame& F, const float* p, bf16* pb) {
    const size_t gt = (size_t)F.bid * 512 + F.tid, NT = (size_t)F.G * 512, n8 = (size_t)T * 256 / 8;
    for (size_t i0 = gt; i0 < n8; i0 += 4 * NT) { f32x4 a[4], b[4];
#pragma unroll
        for (int q4 = 0; q4 < 4; ++q4) { const size_t i = i0 + q4 * NT; if (i < n8) { a[q4] = *((const f32x4*)p + 2 * i); b[q4] = *((const f32x4*)p + 2 * i + 1); } }
#pragma unroll
        for (int q4 = 0; q4 < 4; ++q4) { const size_t i = i0 + q4 * NT; if (i < n8) { v4u o; o.x = pk2(a[q4].x, a[q4].y); o.y = pk2(a[q4].z, a[q4].w); o.z = pk2(b[q4].x, b[q4].y); o.w = pk2(b[q4].z, b[q4].w); *((v4u*)pb + i) = o; } } }
}
constexpr float QSCALE = 0.125f * LOG2E;
__device__ __forceinline__ void phase_prepA(Frame& F, const Args& a) {
    unsigned char* ws = F.ws; const bf16* UA = (const bf16*)(ws + WS_UA); const bf16* UB = (const bf16*)(ws + WS_UB);
    bf16* LIN = (bf16*)(ws + WS_LIN); bf16* QN = (bf16*)(ws + WS_QN); bf16* KN = (bf16*)(ws + WS_KN); bf16* VT = (bf16*)(ws + WS_VT);
    const float* mu = a.in[6]; const float* gq = a.in[3]; const float* gk = a.in[4];
    { const int gt = F.bid * 512 + F.tid, NT = F.G * 512; const int c8 = (gt & 31) << 3; float muv[8];
#pragma unroll
      for (int j = 0; j < 8; ++j) muv[j] = mu[1536 + c8 + j];
      for (int it0 = gt; it0 < T * 32; it0 += 4 * NT) { v4u ru[4], rp[4];
#pragma unroll
          for (int q4 = 0; q4 < 4; ++q4) { const int it = it0 + q4 * NT; if (it < T * 32) { const int t = it >> 5; ru[q4] = *(const v4u*)(UB + (size_t)t * UB_W + 1536 + c8); rp[q4] = *(const v4u*)(UB + (size_t)((t & (SEQ - 1)) ? t - 1 : t) * UB_W + 1536 + c8); } }
#pragma unroll
          for (int q4 = 0; q4 < 4; ++q4) { const int it = it0 + q4 * NT; if (it < T * 32) { const int t = it >> 5; float u[8], p[8], o[8]; unpack8(ru[q4], u); unpack8(rp[q4], p); const float pm = (t & (SEQ - 1)) ? 1.f : 0.f;
#pragma unroll
              for (int j = 0; j < 8; ++j) { const float s = u[j] + muv[j] * (p[j] * pm - u[j]); o[j] = c8 < 64 ? (1.0f - 2.0f * __builtin_amdgcn_rcpf(1.0f + __builtin_amdgcn_exp2f(2.0f * LOG2E * s))) : (c8 < 128 ? s : sigm(s));     }
              *(v4u*)(LIN + (size_t)t * 256 + c8) = pack8(o); } } } }
    { const int gw = F.bid * NWAVES + F.wave, NGW = F.G * NWAVES, lane = F.lane; float gqv[8], gkv[8];
#pragma unroll
      for (int j = 0; j < 8; ++j) { gqv[j] = gq[((lane & 7) << 3) + j] * QSCALE; gkv[j] = gk[((lane & 7) << 3) + j]; }
      for (int t0 = gw; t0 < T; t0 += 4 * NGW) { v4u rq[4], rk[4];
#pragma unroll
          for (int q4 = 0; q4 < 4; ++q4) { const int t = t0 + q4 * NGW; if (t < T) { rq[q4] = *(const v4u*)(UA + (size_t)t * UA_W + 8 * lane); rk[q4] = *(const v4u*)(UA + (size_t)t * UA_W + UA_K + 8 * (lane & 7)); } }
#pragma unroll
          for (int q4 = 0; q4 < 4; ++q4) { const int t = t0 + q4 * NGW; if (t < T) {
              float q[8], k[8]; unpack8(rq[q4], q); unpack8(rk[q4], k);
              float sq = 0.f, sk = 0.f;
#pragma unroll
              for (int j = 0; j < 8; ++j) { sq += q[j] * q[j]; sk += k[j] * k[j]; }
              sq += __shfl_xor(sq, 1); sq += __shfl_xor(sq, 2); sq += __shfl_xor(sq, 4); sk += __shfl_xor(sk, 1); sk += __shfl_xor(sk, 2); sk += __shfl_xor(sk, 4);
              const float rq_ = rsqrtf(sq * (1.f / 64.f) + NORM_EPS), rk_ = rsqrtf(sk * (1.f / 64.f) + NORM_EPS);
#pragma unroll
              for (int j = 0; j < 8; ++j) { q[j] *= rq_ * gqv[j]; k[j] *= rk_ * gkv[j]; }
              *(v4u*)(QN + (size_t)t * 512 + 8 * lane) = pack8(q);
              if (lane < 8) *(v4u*)(KN + (size_t)t * 64 + 8 * lane) = pack8(k); } } } }
    { const int gt = F.bid * 512 + F.tid, NT = F.G * 512;
      for (int it = gt; it < T * 8; it += NT) { const int t = it >> 3, c8 = (it & 7) << 3; *(v4u*)(VT + (size_t)t * 64 + c8) = *(const v4u*)(UA + (size_t)t * UA_W + UA_V + c8); } }
}
constexpr int IDX_STRIDE = 2052, KSEL = 256;
__device__ __forceinline__ void topk_select(const LAS float* row, int limit, unsigned* maskrow, int lane) {
    unsigned long long mybits = 0ull; const int nj = limit >> 6;
    if (limit <= KSEL) { mybits = lane < nj ? ~0ull : 0ull; }
    else {
        unsigned key[32];
#pragma unroll
        for (int j = 0; j < 32; ++j) key[j] = 0u;
#pragma unroll
        for (int g8 = 0; g8 < 4; ++g8) if (8 * g8 < nj) {
#pragma unroll
            for (int jj = 0; jj < 8; ++jj) { const int j = 8 * g8 + jj; unsigned u = __float_as_uint(row[64 * j + lane]); if (u == 0x80000000u) u = 0u; const unsigned k = (u & 0x80000000u) ? ~u : (u | 0x80000000u); key[j] = (j < nj) ? k : 0u; } }
        unsigned prefix = 0u; bool exact = false;
        for (int bit = 31; bit >= 0; --bit) { const unsigned cand = prefix | (1u << bit); int c0 = 0, c1 = 0;
#pragma unroll
            for (int g8 = 0; g8 < 4; ++g8) if (8 * g8 < nj) {
#pragma unroll
                for (int jj = 0; jj < 8; jj += 2) { c0 += __builtin_popcountll(__ballot(key[8 * g8 + jj] >= cand)); c1 += __builtin_popcountll(__ballot(key[8 * g8 + jj + 1] >= cand)); } }
            const int cnt = c0 + c1;
            if (cnt >= KSEL) { prefix = cand; if (cnt == KSEL) { exact = true; break; } } }
        int need = 0;
        if (!exact) { int cgt = 0;
#pragma unroll
            for (int j = 0; j < 32; ++j) cgt += __builtin_popcountll(__ballot(key[j] > prefix));
            need = KSEL - cgt; }
        int running = 0; const unsigned long long below = (1ull << lane) - 1ull;
#pragma unroll
        for (int g8 = 0; g8 < 4; ++g8) if (8 * g8 < nj)
#pragma unroll
        for (int jj = 0; jj < 8; ++jj) { const int j = 8 * g8 + jj;
            const bool gt = exact ? (key[j] >= prefix) : (key[j] > prefix); const bool tie = (!exact) && key[j] == prefix;
            const unsigned long long tb = __ballot(tie); const int rank = running + __builtin_popcountll(tb & below); running += __builtin_popcountll(tb);
            const unsigned long long sb = __ballot(gt || (tie && rank < need)); if (lane == j) mybits = sb; }
    }
    if (lane < 32) { v2u w; w.x = (unsigned)mybits; w.y = (unsigned)(mybits >> 32); *(v2u*)(maskrow + 2 * lane) = w; }
}
__device__ __forceinline__ void phase_indexer(Frame& F) {
    unsigned char* ws = F.ws; const bf16* UA = (const bf16*)(ws + WS_UA); unsigned* MASK = (unsigned*)(ws + WS_MASK);
    LAS float* sc = (LAS float*)F.lds; const int lane = F.lane, w = F.wave, fr = lane & 15, fq = lane >> 4;
    for (int r = 0;; ++r) { const int u = r * F.G + ((r & 1) ? (F.G - 1 - F.bid) : F.bid); if (u >= NB * 128) break;
        const int c = 31 - (u >> 7), rest = u & 127, b = rest >> 2, g4 = rest & 3, limit = 64 * (c + 1), tq0 = b * SEQ + c * 64 + g4 * 16;
        const bf16* UAb = UA + (size_t)b * SEQ * UA_W;
        bf16x8 qf[4][2]; float iwv[4];
        { const bf16* qp = UA + (size_t)(tq0 + fr) * UA_W;
#pragma unroll
          for (int hh = 0; hh < 4; ++hh) { qf[hh][0] = *(const bf16x8*)(qp + UA_IQ + hh * 64 + fq * 8); qf[hh][1] = *(const bf16x8*)(qp + UA_IQ + hh * 64 + 32 + fq * 8); iwv[hh] = bf1(qp[UA_IW + hh]) * (1.f / 16.f); } }
#ifndef IDX_SCORE_REP
#define IDX_SCORE_REP 1
#endif
#ifndef IDX_SEL_REP
#define IDX_SEL_REP 1
#endif
        for (int rp_ = 0; rp_ < IDX_SCORE_REP; ++rp_)
        for (int kt = w; kt < (limit >> 4); kt += NWAVES) {
            const bf16* kp = UAb + (size_t)(kt * 16 + fr) * UA_W + UA_IK + fq * 8; const bf16x8 a0 = *(const bf16x8*)kp, a1 = *(const bf16x8*)(kp + 32);
            f32x4 s = {0.f, 0.f, 0.f, 0.f};
#pragma unroll
            for (int hh = 0; hh < 4; ++hh) { f32x4 d = {0.f, 0.f, 0.f, 0.f}; d = __builtin_amdgcn_mfma_f32_16x16x32_bf16(a0, qf[hh][0], d, 0, 0, 0); d = __builtin_amdgcn_mfma_f32_16x16x32_bf16(a1, qf[hh][1], d, 0, 0, 0);
#pragma unroll
                for (int j = 0; j < 4; ++j) s[j] += iwv[hh] * fmaxf(d[j], 0.f); }
            *(LAS f32x4*)(sc + fr * IDX_STRIDE + kt * 16 + fq * 4) = s; }
        __syncthreads();
#pragma unroll 1
        for (int qq = 0; qq < 2 * IDX_SEL_REP; ++qq) { const int q = 2 * w + (qq & 1); topk_select(sc + q * IDX_STRIDE, limit, MASK + (size_t)(tq0 + q) * 64, lane); }
        __syncthreads(); }
}
constexpr int DA_K = 0, DA_V = 8192, DA_M = 16384, DA_STAGE = 16384 + 512;
__device__ __forceinline__ bf16x8 mk8(v2u lo, v2u hi) { v4u t; t.x = lo.x; t.y = lo.y; t.z = hi.x; t.w = hi.y; return __builtin_bit_cast(bf16x8, t); }
__device__ __forceinline__ void tr_read_v4d(unsigned a, bf16x8 (&vf)[4]) { s16x4 l0, h0, l1, h1, l2, h2, l3, h3;
    asm volatile("ds_read_b64_tr_b16 %0, %8\n\tds_read_b64_tr_b16 %1, %8 offset:512\n\tds_read_b64_tr_b16 %2, %8 offset:32\n\tds_read_b64_tr_b16 %3, %8 offset:544\n\t"
                 "ds_read_b64_tr_b16 %4, %8 offset:64\n\tds_read_b64_tr_b16 %5, %8 offset:576\n\tds_read_b64_tr_b16 %6, %8 offset:96\n\tds_read_b64_tr_b16 %7, %8 offset:608\n\ts_waitcnt lgkmcnt(0)"
                 : "=&v"(l0), "=&v"(h0), "=&v"(l1), "=&v"(h1), "=&v"(l2), "=&v"(h2), "=&v"(l3), "=&v"(h3) : "v"(a) : "memory");
    vf[0] = (bf16x8){l0[0], l0[1], l0[2], l0[3], h0[0], h0[1], h0[2], h0[3]}; vf[1] = (bf16x8){l1[0], l1[1], l1[2], l1[3], h1[0], h1[1], h1[2], h1[3]};
    vf[2] = (bf16x8){l2[0], l2[1], l2[2], l2[3], h2[0], h2[1], h2[2], h2[3]}; vf[3] = (bf16x8){l3[0], l3[1], l3[2], l3[3], h3[0], h3[1], h3[2], h3[3]}; }
__device__ __forceinline__ void phase_dsa_attn(Frame& F, const Args& a) {
    unsigned char* ws = F.ws; const bf16* QN = (const bf16*)(ws + WS_QN); const bf16* KN = (const bf16*)(ws + WS_KN); const bf16* VN = (const bf16*)(ws + WS_VT);
    const unsigned* MASK = (const unsigned*)(ws + WS_MASK); bf16* MIX = (bf16*)(ws + WS_XB);
    const int lane = F.lane, w = F.wave, fr = lane & 15, fq = lane >> 4; LAS unsigned char* lds = F.lds;
    const float mb = 8.f * LOG2E * wave_max(fabsf(a.in[3][lane])) * wave_max(fabsf(a.in[4][lane]));
    const unsigned vtr_lane = (unsigned)((8 * fq + ((lane & 15) >> 2)) * 128 + 4 * (lane & 3) * 2);
    for (int r = 0;; ++r) { const int u = r * F.G + ((r & 1) ? (F.G - 1 - F.bid) : F.bid); if (u >= NB * 32) break;
        const int c = 31 - (u >> 5), b = u & 31, nst = c + 1, t0 = b * SEQ + 64 * c;
        const bf16* Kb = KN + (size_t)b * SEQ * 64; const bf16* Vb = VN + (size_t)b * SEQ * 64; const unsigned* Mb = MASK + (size_t)t0 * 64;
#define DA_DMA(st_, buf_) do { const int so_ = (buf_) * DA_STAGE; \
            __builtin_amdgcn_global_load_lds((const unsigned*)(Kb + (size_t)(64 * (st_) + 8 * w) * 64 + lane * 8), (LAS unsigned*)(lds + so_ + DA_K + w * 1024), 16, 0, 0); \
            __builtin_amdgcn_global_load_lds((const unsigned*)(Vb + (size_t)(64 * (st_) + 8 * w) * 64 + lane * 8), (LAS unsigned*)(lds + so_ + DA_V + w * 1024), 16, 0, 0); \
            if (w < 2) __builtin_amdgcn_global_load_lds(Mb + (size_t)lane * 64 + 2 * (st_) + w, (LAS unsigned*)(lds + so_ + DA_M + w * 256), 4, 0, 0); } while (0)
        DA_DMA(0, 0);
        bf16x8 qf[4][2];
#pragma unroll
        for (int i = 0; i < 4; ++i) { const bf16* qp = QN + (size_t)(t0 + 16 * i + fr) * 512 + w * 64 + fq * 8; qf[i][0] = *(const bf16x8*)qp; qf[i][1] = *(const bf16x8*)(qp + 32); }
        f32x4 O[4][4]; float l[4];
#pragma unroll
        for (int i = 0; i < 4; ++i) { l[i] = 0.f;
#pragma unroll
            for (int dt = 0; dt < 4; ++dt) O[i][dt] = (f32x4){0.f, 0.f, 0.f, 0.f}; }
        for (int st = 0; st < nst; ++st) { const int buf = st & 1; const LAS unsigned char* sb = lds + buf * DA_STAGE;
            asm volatile("s_waitcnt vmcnt(0)" ::: "memory");
            __builtin_amdgcn_s_barrier(); asm volatile("" ::: "memory");
            if (st + 1 < nst) DA_DMA(st + 1, buf ^ 1);
#pragma unroll
            for (int sub = 0; sub < 2; ++sub) {
                bf16x8 kf[2][2], vf[4]; unsigned mw[4];
#pragma unroll
                for (int s2 = 0; s2 < 2; ++s2) { const LAS unsigned char* kp = sb + DA_K + (32 * sub + 8 * (fr >> 2) + 4 * s2 + (fr & 3)) * 128 + fq * 16;   kf[s2][0] = *(const LAS bf16x8*)kp; kf[s2][1] = *(const LAS bf16x8*)(kp + 64); }
#pragma unroll
                for (int i = 0; i < 4; ++i) mw[i] = *(const LAS unsigned*)(sb + DA_M + sub * 256 + (16 * i + fr) * 4);
                tr_read_v4d((unsigned)(size_t)(sb + DA_V + sub * 4096) + vtr_lane, vf);
#pragma unroll
                for (int i = 0; i < 4; ++i) {
                    f32x4 s0 = {0.f, 0.f, 0.f, 0.f}, s1 = {0.f, 0.f, 0.f, 0.f};
                    s0 = __builtin_amdgcn_mfma_f32_16x16x32_bf16(kf[0][0], qf[i][0], s0, 0, 0, 0); s0 = __builtin_amdgcn_mfma_f32_16x16x32_bf16(kf[0][1], qf[i][1], s0, 0, 0, 0);
                    s1 = __builtin_amdgcn_mfma_f32_16x16x32_bf16(kf[1][0], qf[i][0], s1, 0, 0, 0); s1 = __builtin_amdgcn_mfma_f32_16x16x32_bf16(kf[1][1], qf[i][1], s1, 0, 0, 0);
                    const unsigned b0 = mw[i] >> (8 * fq), b1 = mw[i] >> (8 * fq + 4); float p[8];
#pragma unroll
                    for (int j = 0; j < 4; ++j) { p[j] = ((b0 >> j) & 1u) ? __builtin_amdgcn_exp2f(s0[j] - mb) : 0.f; p[4 + j] = ((b1 >> j) & 1u) ? __builtin_amdgcn_exp2f(s1[j] - mb) : 0.f; }
                    l[i] += ((p[0] + p[1]) + (p[2] + p[3])) + ((p[4] + p[5]) + (p[6] + p[7]));
                    const bf16x8 pa = __builtin_bit_cast(bf16x8, pack8(p));
#pragma unroll
                    for (int dt = 0; dt < 4; ++dt) O[i][dt] = __builtin_amdgcn_mfma_f32_16x16x32_bf16(pa, vf[dt], O[i][dt], 0, 0, 0);
                } } }
#undef DA_DMA
#pragma unroll
        for (int i = 0; i < 4; ++i) { float li = l[i]; li += __shfl_xor(li, 16); li += __shfl_xor(li, 32);
#pragma unroll
            for (int j = 0; j < 4; ++j) { const float inv = 1.0f / __shfl(li, 4 * fq + j); bf16* op = MIX + (size_t)(t0 + 16 * i + 4 * fq + j) * D + w * 64 + fr;
#pragma unroll
                for (int dt = 0; dt < 4; ++dt) op[16 * dt] = (bf16)f2bf(O[i][dt][j] * inv); } }
        VM_WAIT(); __syncthreads();
    }
}
__device__ __forceinline__ float rw_decay(float x) { const float sp = fmaxf(-x, 0.f) + 0.6931471805599453f * __builtin_amdgcn_logf(1.0f + __builtin_amdgcn_exp2f(-LOG2E * fabsf(x)));
    return __builtin_amdgcn_exp2f(-LOG2E * __builtin_amdgcn_exp2f(-LOG2E * (sp + 0.5f))); }
#define MF32(a_, b_, c_) __builtin_amdgcn_mfma_f32_16x16x4f32((a_), (b_), (c_), 0, 0, 0)
constexpr int RT = 68, RG = 20, RGM = 16 * RG;
constexpr int RL_AH = 0, RL_BH = 64 * RT, RL_KH = 2 * 64 * RT, RL_RH = 3 * 64 * RT, RL_VX = 4 * 64 * RT, RL_GS = 5 * 64 * RT, RL_YA = 6 * 64 * RT, RL_GR = 7 * 64 * RT, RL_PM = RL_GR + 16 * RGM, RL_GC = RL_PM + 4 * RGM, RL_BON = RL_GC + 256, RL_END = RL_BON + 64;
static_assert(RL_END * 4 <= MISC_OFF, "RWKV LDS");
__device__ __forceinline__ void phase_rwkv(Frame& F, const Args& a) {
    unsigned char* ws = F.ws; const bf16* UB = (const bf16*)(ws + WS_UB); const bf16* LOUT = (const bf16*)(ws + WS_LOUT); bf16* MIX = (bf16*)(ws + WS_XB);
    const float* mu = a.in[6]; const float* w0 = a.in[7]; const float* a0 = a.in[9]; const float* k_k = a.in[12]; const float* k_a = a.in[13]; const float* r_k = a.in[14]; const float* gn_g = a.in[15]; const float* gn_b = a.in[16];
    const int lane = F.lane, w = F.wave, n = lane & 15, q = lane >> 4;
    LAS float* L = (LAS float*)F.lds;
    for (int bh = F.bid; bh < NB * 8; bh += F.G) {
        const int b = bh >> 3, h = bh & 7, c = h * 64 + lane;
        const float mur = mu[c], muk = mu[512 + c], muv = mu[1024 + c], w0c = w0[c], a0c = a0[c], kkc = k_k[c], kac = k_a[c], rkc = r_k[c], gng = gn_g[c], gnb = gn_b[c];
        f32x4 Z[4];
#pragma unroll
        for (int kt = 0; kt < 4; ++kt) Z[kt] = (f32x4){0.f, 0.f, 0.f, 0.f};
        const int ch = w >> 1, hs = w & 1;
        float r_ur[8], r_uk[8], r_uv[8], r_pr[8], r_pk[8], r_pv[8], r_wd[8], r_ad[8], r_gg[8], r_wf[8];
#define RW_RAW(batch_) do { _Pragma("unroll") for (int i = 0; i < 8; ++i) { const int sl = (batch_) * 64 + 16 * ch + 8 * hs + i; const size_t t = (size_t)b * SEQ + sl; const bf16* up = UB + t * UB_W + c; const bf16* pp_ = sl > 0 ? up - UB_W : up; \
            r_ur[i] = bf1(up[0]); r_uk[i] = bf1(up[512]); r_uv[i] = bf1(up[1024]); r_pr[i] = bf1(pp_[0]); r_pk[i] = bf1(pp_[512]); r_pv[i] = bf1(pp_[1024]); \
            const bf16* lp = LOUT + t * 1536 + c; r_wd[i] = bf1(lp[0]); r_ad[i] = bf1(lp[512]); r_gg[i] = bf1(lp[1024]); \
            r_wf[i] = bf1(LOUT[((size_t)b * SEQ + (batch_) * 64 + 16 * ch + i) * 1536 + c]); } } while (0)
        RW_RAW(0);
        for (int batch = 0; batch < SEQ / 64; ++batch) {
            { float gcur = 1.f;
              if (hs) {
#pragma unroll
                  for (int i = 0; i < 8; ++i) gcur *= rw_decay(w0c + r_wf[i]); }
#pragma unroll
              for (int i = 0; i < 8; ++i) { const int tl = 16 * ch + 8 * hs + i, sl = batch * 64 + tl; const float pm = sl > 0 ? 1.f : 0.f;
                const float ur = r_ur[i], uk = r_uk[i], uv = r_uv[i], pr = r_pr[i] * pm, pk = r_pk[i] * pm, pv = r_pv[i] * pm;
                const float rr = ur + mur * (pr - ur), kx = uk + muk * (pk - uk), vx = uv + muv * (pv - uv);
                const float decay = rw_decay(w0c + r_wd[i]), av = sigm(a0c + r_ad[i]);
                float kk = kx * kkc; kk = kk * rsqrtf(fmaxf(wave_sum(kk * kk), 1e-24f));
                const float km = kx * (1.f + (av - 1.f) * kac); const float bon = wave_sum(rr * km * rkc);
                const float gprev = gcur; gcur *= decay; const float ig = __builtin_amdgcn_rcpf(gcur);
                L[RL_AH + tl * RT + lane] = -kk * gprev; L[RL_BH + tl * RT + lane] = kk * av * ig; L[RL_KH + tl * RT + lane] = km * ig; L[RL_RH + tl * RT + lane] = rr * gcur;
                L[RL_VX + tl * RT + lane] = vx; L[RL_GS + tl * RT + lane] = r_gg[i]; if (lane == 0) L[RL_BON + tl] = bon; }
              if (hs) L[RL_GC + ch * 64 + lane] = gcur; }
            LDS_WAIT(); __syncthreads();
            if (batch + 1 < SEQ / 64) RW_RAW(batch + 1);
            { const LAS float* ah = L + RL_AH + 16 * ch * RT; const LAS float* bhm = L + RL_BH + 16 * ch * RT; const LAS float* khm = L + RL_KH + 16 * ch * RT; const LAS float* rhm = L + RL_RH + 16 * ch * RT;
              LAS float* gr = L + RL_GR + ch * 4 * RGM; LAS float* pm_ = L + RL_PM + ch * RGM;
              if (hs == 0) {
                  f32x4 m = {0.f, 0.f, 0.f, 0.f};
#pragma unroll
                  for (int s = 0; s < 16; ++s) m = MF32(bhm[n * RT + 4 * s + q], ah[n * RT + 4 * s + q], m);
                  f32x4 tm;
#pragma unroll
                  for (int j = 0; j < 4; ++j) { m[j] = (4 * q + j < n) ? m[j] : 0.f; tm[j] = m[j] + ((4 * q + j == n) ? 1.f : 0.f); pm_[(4 * q + j) * RG + n] = m[j]; gr[(4 * q + j) * RG + n] = tm[j]; }
#pragma unroll
                  for (int rd = 0; rd < 3; ++rd) { LDS_WAIT();
                      f32x4 p2 = {0.f, 0.f, 0.f, 0.f};
#pragma unroll
                      for (int s = 0; s < 4; ++s) p2 = MF32(pm_[n * RG + 4 * s + q], pm_[(4 * s + q) * RG + n], p2);
                      f32x4 ip, t2 = {0.f, 0.f, 0.f, 0.f};
#pragma unroll
                      for (int j = 0; j < 4; ++j) ip[j] = p2[j] + ((4 * q + j == n) ? 1.f : 0.f);
#pragma unroll
                      for (int j = 0; j < 4; ++j) t2 = MF32(gr[n * RG + 4 * q + j], ip[j], t2);
                      LDS_WAIT();
#pragma unroll
                      for (int j = 0; j < 4; ++j) { pm_[(4 * q + j) * RG + n] = p2[j]; gr[(4 * q + j) * RG + n] = t2[j]; } }
              } else {
                  f32x4 mk = {0.f, 0.f, 0.f, 0.f}, nb = {0.f, 0.f, 0.f, 0.f}, nk = {0.f, 0.f, 0.f, 0.f};
#pragma unroll
                  for (int s = 0; s < 16; ++s) { const float av_ = ah[n * RT + 4 * s + q], rv_ = rhm[n * RT + 4 * s + q], bv_ = bhm[n * RT + 4 * s + q], kv_ = khm[n * RT + 4 * s + q];
                      mk = MF32(kv_, av_, mk); nb = MF32(bv_, rv_, nb); nk = MF32(kv_, rv_, nk); }
#pragma unroll
                  for (int j = 0; j < 4; ++j) { const int s_ = 4 * q + j; gr[RGM + s_ * RG + n] = (s_ < n) ? mk[j] : 0.f; gr[2 * RGM + s_ * RG + n] = (s_ <= n) ? nb[j] : 0.f; gr[3 * RGM + s_ * RG + n] = (s_ <= n) ? nk[j] : 0.f; } } }
            LDS_WAIT(); __syncthreads();
#ifndef RW_C_REP
#define RW_C_REP 1
#endif
            if (w < 4) { const int v = 16 * w + n; f32x4 Zs[4]; for (int kt = 0; kt < 4; ++kt) Zs[kt] = Z[kt];
              for (int rc_ = 0; rc_ < RW_C_REP; ++rc_) { if (rc_) for (int kt = 0; kt < 4; ++kt) Z[kt] = Zs[kt];
#pragma unroll 1
                for (int cc = 0; cc < 4; ++cc) { const LAS float* ah = L + RL_AH + 16 * cc * RT; const LAS float* bhm = L + RL_BH + 16 * cc * RT; const LAS float* khm = L + RL_KH + 16 * cc * RT; const LAS float* rhm = L + RL_RH + 16 * cc * RT;
                    const LAS float* vx = L + RL_VX + 16 * cc * RT; const LAS float* gr = L + RL_GR + cc * 4 * RGM;
                    float vb[4];
#pragma unroll
                    for (int s = 0; s < 4; ++s) vb[s] = vx[(4 * s + q) * RT + v];
                    f32x4 X = {0.f, 0.f, 0.f, 0.f}, Y = {0.f, 0.f, 0.f, 0.f};
#pragma unroll
                    for (int kt = 0; kt < 4; ++kt)
#pragma unroll
                        for (int j = 0; j < 4; ++j) { X = MF32(ah[n * RT + 16 * kt + 4 * q + j], Z[kt][j], X); Y = MF32(rhm[n * RT + 16 * kt + 4 * q + j], Z[kt][j], Y); }
#pragma unroll
                    for (int s = 0; s < 4; ++s) { X = MF32(gr[RGM + (4 * s + q) * RG + n], vb[s], X); Y = MF32(gr[3 * RGM + (4 * s + q) * RG + n], vb[s], Y); }
                    f32x4 U = {0.f, 0.f, 0.f, 0.f};
#pragma unroll
                    for (int j = 0; j < 4; ++j) U = MF32(gr[(4 * q + j) * RG + n], X[j], U);
#pragma unroll
                    for (int j = 0; j < 4; ++j) Y = MF32(gr[2 * RGM + (4 * q + j) * RG + n], U[j], Y);
#pragma unroll
                    for (int j = 0; j < 4; ++j) L[RL_YA + (16 * cc + 4 * q + j) * RT + v] = Y[j];
#pragma unroll
                    for (int kt = 0; kt < 4; ++kt) {
#pragma unroll
                        for (int j = 0; j < 4; ++j) Z[kt] = MF32(bhm[(4 * q + j) * RT + 16 * kt + n], U[j], Z[kt]);
#pragma unroll
                        for (int s = 0; s < 4; ++s) Z[kt] = MF32(khm[(4 * s + q) * RT + 16 * kt + n], vb[s], Z[kt]);
                        const f32x4 gc = *(const LAS f32x4*)(L + RL_GC + cc * 64 + 16 * kt + 4 * q); Z[kt] = Z[kt] * gc; } } } }
            else if (F.G == 256) {
                const size_t i = ((size_t)(batch * 1024 + F.bid * 4 + (w - 4))) * 64 + lane;
                const float* p0 = a.in[1]; const f32x4 pa = *((const f32x4*)p0 + 2 * i), pb = *((const f32x4*)p0 + 2 * i + 1);
#pragma unroll 1
                for (int i2 = 0; i2 < 2; ++i2) { const int tl = (2 * batch + i2) * 1024 + F.bid * 4 + (w - 4); if (tl < DT_TOTAL) prep_deferred_tile(F, a, tl); }
                { v4u o; o.x = pk2(pa.x, pa.y); o.y = pk2(pa.z, pa.w); o.z = pk2(pb.x, pb.y); o.w = pk2(pb.z, pb.w); *((v4u*)(ws + WS_PB) + i) = o; } }
            LDS_WAIT(); __syncthreads();
#pragma unroll
            for (int i = 0; i < 8; ++i) { const int step = w + 8 * i; const size_t t = (size_t)b * SEQ + batch * 64 + step;
                const float y = L[RL_YA + step * RT + lane], mean = wave_sum(y) * (1.f / 64.f), dlt = y - mean, var = fmaxf(wave_sum(y * y) * (1.f / 64.f) - mean * mean, 0.f);
                const float yn = dlt * rsqrtf(var + 64e-5f) * gng + gnb; const float o = (yn + L[RL_BON + step] * L[RL_VX + step * RT + lane]) * L[RL_GS + step * RT + lane];
                MIX[t * D + 512 + c] = (bf16)f2bf(o); }
            LDS_WAIT(); __syncthreads();
        }
#undef RW_RAW
    }
}
__device__ __forceinline__ void phase_l1prep(Frame& F, const Args& a, int hb) {
    unsigned char* ws = F.ws; const bf16* XM = (const bf16*)(ws + WS_XM); bf16* XC = (bf16*)(ws + WS_XC); bf16* Q = (bf16*)(ws + WS_Q); bf16* K = (bf16*)(ws + WS_K); bf16* V = (bf16*)(ws + WS_V);
    float* GI = (float*)(ws + WS_GI); const float* W12 = (const float*)(ws + WS_W12);
    const float* cw = a.in[19]; const float* cb = a.in[20]; const float* wq = a.in[21]; const float* wk = a.in[22]; const float* wv = a.in[23]; const float* b_i = a.in[25]; const float* b_f = a.in[26];
    const int g = F.tid, lane = F.lane, w = F.wave; LAS float* red = (LAS float*)F.lds;
    float cwr[4][4], cbr[4], wqr[16], wkr[16], wvr[16], w1[32], w2[32];
#pragma unroll
    for (int j = 0; j < 4; ++j)
#pragma unroll
        for (int i = 0; i < 4; ++i) cwr[j][i] = cw[j * CI + 4 * g + i];
#pragma unroll
    for (int i = 0; i < 4; ++i) cbr[i] = cb[4 * g + i];
#pragma unroll
    for (int i = 0; i < 16; ++i) { wqr[i] = wq[g * 16 + i]; wkr[i] = wk[g * 16 + i]; wvr[i] = wv[g * 16 + i]; }
#pragma unroll
    for (int i = 0; i < 32; ++i) { w1[i] = W12[(size_t)(4 * g) * 8 + i]; w2[i] = W12[(size_t)(2048 + 4 * g) * 8 + i]; }
    float wqk[16];
#pragma unroll
    for (int i = 0; i < 4; ++i)
#pragma unroll
        for (int ip = 0; ip < 4; ++ip) { float sacc = 0.f;
#pragma unroll
            for (int m = 0; m < 4; ++m) sacc = fmaf(wqr[4 * i + m], wkr[4 * ip + m], sacc);
            wqk[4 * i + ip] = sacc * 0.044194173824159216f; }
    const int per = TH / F.G;
    const int tb = F.bid * per;
    float x0[4], x1[4], x2[4];
    { const int sl = tb & (SEQ - 1);
#pragma unroll
      for (int i = 0; i < 4; ++i) { x0[i] = 0.f; x1[i] = 0.f; x2[i] = 0.f; }
      if (sl >= 1) { const v2u r = *(const v2u*)(XM + (size_t)(tb - 1) * CI + 4 * g); x2[0] = bflo(r.x); x2[1] = bfhi(r.x); x2[2] = bflo(r.y); x2[3] = bfhi(r.y); }
      if (sl >= 2) { const v2u r = *(const v2u*)(XM + (size_t)(tb - 2) * CI + 4 * g); x1[0] = bflo(r.x); x1[1] = bfhi(r.x); x1[2] = bflo(r.y); x1[3] = bfhi(r.y); }
      if (sl >= 3) { const v2u r = *(const v2u*)(XM + (size_t)(tb - 3) * CI + 4 * g); x0[0] = bflo(r.x); x0[1] = bfhi(r.x); x0[2] = bflo(r.y); x0[3] = bfhi(r.y); } }
    constexpr int L1PF = 4;
    v2u xq[L1PF][2];
#pragma unroll
    for (int pq = 0; pq < L1PF; ++pq)
#pragma unroll
        for (int tk = 0; tk < 2; ++tk) xq[pq][tk] = *(const v2u*)(XM + (size_t)(tb + 2 * pq + tk) * CI + 4 * g);
    for (int n4 = 0; n4 < per / 2; ++n4) { const int t4 = tb + 2 * n4;
        float gs[16]; v2u xr[2];
        xr[0] = xq[0][0]; xr[1] = xq[0][1];
#pragma unroll
        for (int pq = 0; pq + 1 < L1PF; ++pq) { xq[pq][0] = xq[pq + 1][0]; xq[pq][1] = xq[pq + 1][1]; }
        { const int tn = (n4 + L1PF < per / 2) ? t4 + 2 * L1PF : t4;
#pragma unroll
          for (int tk = 0; tk < 2; ++tk) xq[L1PF - 1][tk] = *(const v2u*)(XM + (size_t)(tn + tk) * CI + 4 * g); }
#pragma unroll
        for (int tk = 0; tk < 2; ++tk) { const int t = t4 + tk;
            float x3[4]; x3[0] = bflo(xr[tk].x); x3[1] = bfhi(xr[tk].x); x3[2] = bflo(xr[tk].y); x3[3] = bfhi(xr[tk].y);
            float xc[4], q[4];
#pragma unroll
            for (int i = 0; i < 4; ++i) { const float s = fmaf(cwr[3][i], x3[i], fmaf(cwr[2][i], x2[i], fmaf(cwr[1][i], x1[i], fmaf(cwr[0][i], x0[i], cbr[i])))); xc[i] = s * sigm(s); }
#pragma unroll
            for (int j = 0; j < 4; ++j) q[j] = fmaf(xc[3], wqk[12 + j], fmaf(xc[2], wqk[8 + j], fmaf(xc[1], wqk[4 + j], xc[0] * wqk[j])));
#pragma unroll
            for (int o = 0; o < 8; ++o) { float s = 0.f;
#pragma unroll
                for (int i = 0; i < 4; ++i) s = fmaf(x3[i], w2[i * 8 + o], fmaf(xc[i], w1[i * 8 + o], s));
                gs[tk * 8 + o] = s; }
            const size_t off = (size_t)t * CI + 4 * g;
            { v2u o; o.x = pk2(xc[0], xc[1]); o.y = pk2(xc[2], xc[3]); *(v2u*)(XC + off) = o; o.x = pk2(q[0], q[1]); o.y = pk2(q[2], q[3]); *(v2u*)(Q + off) = o; }
#pragma unroll
            for (int i = 0; i < 4; ++i) { x0[i] = x1[i]; x1[i] = x2[i]; x2[i] = x3[i]; } }
#define L1_STAGE(mask, n) { const bool hi_ = (lane & (mask)) != 0; _Pragma("unroll") for (int i = 0; i < (n) / 2; ++i) { const float send_ = hi_ ? gs[i] : gs[(n) / 2 + i]; const float keep_ = hi_ ? gs[(n) / 2 + i] : gs[i]; gs[i] = keep_ + __shfl_xor(send_, (mask)); } }
        L1_STAGE(32, 16) L1_STAGE(16, 8) L1_STAGE(8, 4) L1_STAGE(4, 2)
#undef L1_STAGE
        gs[0] += __shfl_xor(gs[0], 2); gs[0] += __shfl_xor(gs[0], 1);
        LAS float* rp = red + (n4 & 1) * 128;
        if ((lane & 3) == 0) rp[w * 16 + (lane >> 2)] = gs[0];
        LDS_WAIT(); __syncthreads();
        if (F.tid < 16) { float s = 0.f;
#pragma unroll
            for (int ww = 0; ww < 8; ++ww) s += rp[ww * 16 + F.tid];
            const int o = F.tid & 7; GI[(size_t)(t4 + (F.tid >> 3)) * 8 + o] = s + (o < 4 ? b_i[o] : b_f[o - 4]); }
    }
}
__device__ __forceinline__ void phase_gatescan(Frame& F) {
    unsigned char* ws = F.ws; const float* GI = (const float*)(ws + WS_GI); float* GA = (float*)(ws + WS_GA); float* GAM = (float*)(ws + WS_GAM); float* GEM = (float*)(ws + WS_GEM);
    const int lane = F.lane, w = F.wave, tid = F.tid; LAS float* wtot = (LAS float*)F.lds;
    for (int sq = F.bid; sq < (NB / 2) * 4; sq += F.G) { const int bl = sq >> 2, h = sq & 3; const size_t tq = (size_t)bl * SEQ + 4 * tid;
        float ip[4], c[4];
#pragma unroll
        for (int k = 0; k < 4; ++k) { ip[k] = GI[(tq + k) * 8 + h]; c[k] = -softplusf_(-GI[(tq + k) * 8 + 4 + h]); }
        c[1] += c[0]; c[2] += c[1]; c[3] += c[2];
        float inc = c[3];
#pragma unroll
        for (int o = 1; o < 64; o <<= 1) { const float n = __shfl_up(inc, o); if (lane >= o) inc += n; }
        if (lane == 63) wtot[w] = inc;
        LDS_WAIT(); __syncthreads();
        float off = inc - c[3];
#pragma unroll
        for (int ww = 0; ww < 8; ++ww) if (ww < w) off += wtot[ww];
        float Fv[4], av[4], m[4];
#pragma unroll
        for (int k = 0; k < 4; ++k) { Fv[k] = off + c[k]; av[k] = ip[k] - Fv[k]; }
        m[0] = av[0]; m[1] = fmaxf(m[0], av[1]); m[2] = fmaxf(m[1], av[2]); m[3] = fmaxf(m[2], av[3]);
        float incm = m[3];
#pragma unroll
        for (int o = 1; o < 64; o <<= 1) { const float n = __shfl_up(incm, o); if (lane >= o) incm = fmaxf(incm, n); }
        if (lane == 63) wtot[8 + w] = incm;
        LDS_WAIT(); __syncthreads();
        float offm = __shfl_up(incm, 1); if (lane == 0) offm = -INFINITY;
#pragma unroll
        for (int ww = 0; ww < 8; ++ww) if (ww < w) offm = fmaxf(offm, wtot[8 + ww]);
#pragma unroll
        for (int k = 0; k < 4; ++k) { const float A = fmaxf(offm, m[k]); GA[(tq + k) * 4 + h] = av[k]; GAM[(tq + k) * 4 + h] = A; GEM[(tq + k) * 4 + h] = __expf(-(Fv[k] + A)); }
        LDS_WAIT(); __syncthreads();
    }
}
constexpr int ML_PITCH = 1040, ML_TILE = 32 * ML_PITCH, ML_PP = 80, ML_PT = 64 * ML_PP;
constexpr int ML_K = 0, ML_V = 2 * ML_TILE, ML_P = 4 * ML_TILE, ML_DEN = ML_P + 2 * ML_PT, ML_AT = ML_DEN + 512, ML_AS = ML_AT + 256, ML_END = ML_AS + 8192;
constexpr int ML_ST = ML_P, ML_MR = ML_P + 4096;
static_assert(ML_MR + 512 <= ML_DEN, "mLSTM LDS tables");
static_assert(ML_END <= MISC_OFF, "mLSTM LDS");
__device__ __forceinline__ void tr_read_v4(unsigned a, bf16x8 (&vf)[4]) { s16x4 l0, h0, l1, h1, l2, h2, l3, h3;
    asm volatile("ds_read_b64_tr_b16 %0, %8\n\tds_read_b64_tr_b16 %1, %8 offset:4160\n\tds_read_b64_tr_b16 %2, %8 offset:32\n\tds_read_b64_tr_b16 %3, %8 offset:4192\n\t"
                 "ds_read_b64_tr_b16 %4, %8 offset:64\n\tds_read_b64_tr_b16 %5, %8 offset:4224\n\tds_read_b64_tr_b16 %6, %8 offset:96\n\tds_read_b64_tr_b16 %7, %8 offset:4256\n\ts_waitcnt lgkmcnt(0)"
                 : "=&v"(l0), "=&v"(h0), "=&v"(l1), "=&v"(h1), "=&v"(l2), "=&v"(h2), "=&v"(l3), "=&v"(h3) : "v"(a) : "memory");
    vf[0] = (bf16x8){l0[0], l0[1], l0[2], l0[3], h0[0], h0[1], h0[2], h0[3]}; vf[1] = (bf16x8){l1[0], l1[1], l1[2], l1[3], h1[0], h1[1], h1[2], h1[3]};
    vf[2] = (bf16x8){l2[0], l2[1], l2[2], l2[3], h2[0], h2[1], h2[2], h2[3]}; vf[3] = (bf16x8){l3[0], l3[1], l3[2], l3[3], h3[0], h3[1], h3[2], h3[3]}; }
static_assert(4 * ML_PITCH == 4160, "tr_read_v4 offsets");
__device__ __forceinline__ void tr_read_v8(unsigned a, bf16x8 (&vf)[8]) { s16x4 l0, h0, l1, h1, l2, h2, l3, h3, l4, h4, l5, h5, l6, h6, l7, h7;
    asm volatile("ds_read_b64_tr_b16 %0, %16\n\tds_read_b64_tr_b16 %1, %16 offset:4160\n\tds_read_b64_tr_b16 %2, %16 offset:32\n\tds_read_b64_tr_b16 %3, %16 offset:4192\n\t"
                 "ds_read_b64_tr_b16 %4, %16 offset:64\n\tds_read_b64_tr_b16 %5, %16 offset:4224\n\tds_read_b64_tr_b16 %6, %16 offset:96\n\tds_read_b64_tr_b16 %7, %16 offset:4256\n\t"
                 "ds_read_b64_tr_b16 %8, %16 offset:128\n\tds_read_b64_tr_b16 %9, %16 offset:4288\n\tds_read_b64_tr_b16 %10, %16 offset:160\n\tds_read_b64_tr_b16 %11, %16 offset:4320\n\t"
                 "ds_read_b64_tr_b16 %12, %16 offset:192\n\tds_read_b64_tr_b16 %13, %16 offset:4352\n\tds_read_b64_tr_b16 %14, %16 offset:224\n\tds_read_b64_tr_b16 %15, %16 offset:4384\n\ts_waitcnt lgkmcnt(0)"
                 : "=&v"(l0), "=&v"(h0), "=&v"(l1), "=&v"(h1), "=&v"(l2), "=&v"(h2), "=&v"(l3), "=&v"(h3), "=&v"(l4), "=&v"(h4), "=&v"(l5), "=&v"(h5), "=&v"(l6), "=&v"(h6), "=&v"(l7), "=&v"(h7) : "v"(a) : "memory");
    vf[0] = (bf16x8){l0[0], l0[1], l0[2], l0[3], h0[0], h0[1], h0[2], h0[3]}; vf[1] = (bf16x8){l1[0], l1[1], l1[2], l1[3], h1[0], h1[1], h1[2], h1[3]};
    vf[2] = (bf16x8){l2[0], l2[1], l2[2], l2[3], h2[0], h2[1], h2[2], h2[3]}; vf[3] = (bf16x8){l3[0], l3[1], l3[2], l3[3], h3[0], h3[1], h3[2], h3[3]};
    vf[4] = (bf16x8){l4[0], l4[1], l4[2], l4[3], h4[0], h4[1], h4[2], h4[3]}; vf[5] = (bf16x8){l5[0], l5[1], l5[2], l5[3], h5[0], h5[1], h5[2], h5[3]};
    vf[6] = (bf16x8){l6[0], l6[1], l6[2], l6[3], h6[0], h6[1], h6[2], h6[3]}; vf[7] = (bf16x8){l7[0], l7[1], l7[2], l7[3], h7[0], h7[1], h7[2], h7[3]}; }
struct PvOps { bf16x8 p0, p1, p2, p3; s16x4 l0, h0, l1, h1, l2, h2, l3, h3, l4, h4, l5, h5, l6, h6, l7, h7; };
__device__ __forceinline__ void pv_issue(unsigned pa, unsigned va, PvOps& o) {
    asm volatile("ds_read_b128 %0, %20\n\tds_read_b128 %1, %20 offset:1280\n\tds_read_b128 %2, %20 offset:2560\n\tds_read_b128 %3, %20 offset:3840\n\t"
                 "ds_read_b64_tr_b16 %4, %21\n\tds_read_b64_tr_b16 %5, %21 offset:4160\n\tds_read_b64_tr_b16 %6, %21 offset:32\n\tds_read_b64_tr_b16 %7, %21 offset:4192\n\t"
                 "ds_read_b64_tr_b16 %8, %21 offset:64\n\tds_read_b64_tr_b16 %9, %21 offset:4224\n\tds_read_b64_tr_b16 %10, %21 offset:96\n\tds_read_b64_tr_b16 %11, %21 offset:4256\n\t"
                 "ds_read_b64_tr_b16 %12, %21 offset:128\n\tds_read_b64_tr_b16 %13, %21 offset:4288\n\tds_read_b64_tr_b16 %14, %21 offset:160\n\tds_read_b64_tr_b16 %15, %21 offset:4320\n\t"
                 "ds_read_b64_tr_b16 %16, %21 offset:192\n\tds_read_b64_tr_b16 %17, %21 offset:4352\n\tds_read_b64_tr_b16 %18, %21 offset:224\n\tds_read_b64_tr_b16 %19, %21 offset:4384"
                 : "=&v"(o.p0), "=&v"(o.p1), "=&v"(o.p2), "=&v"(o.p3), "=&v"(o.l0), "=&v"(o.h0), "=&v"(o.l1), "=&v"(o.h1), "=&v"(o.l2), "=&v"(o.h2), "=&v"(o.l3), "=&v"(o.h3),
                   "=&v"(o.l4), "=&v"(o.h4), "=&v"(o.l5), "=&v"(o.h5), "=&v"(o.l6), "=&v"(o.h6), "=&v"(o.l7), "=&v"(o.h7) : "v"(pa), "v"(va) : "memory"); }
#define pv_wait(o_) do { __builtin_amdgcn_sched_barrier(0); asm volatile("s_waitcnt lgkmcnt(0)" ::: "memory"); __builtin_amdgcn_sched_barrier(0); } while (0)
#define PV_CAT(l_, h_) ((bf16x8){(l_)[0], (l_)[1], (l_)[2], (l_)[3], (h_)[0], (h_)[1], (h_)[2], (h_)[3]})
static_assert(16 * ML_PP == 1280, "pv_issue offsets");
template <int PB> __device__ __forceinline__ void phase_mlstm_t(Frame& F, const Args& a) {
    constexpr bool skK = PB & 1, skV = PB & 2, skS = PB & 4, skP = PB & 8, skE = PB & 16;
    unsigned char* ws = F.ws; const bf16* Q = (const bf16*)(ws + WS_Q); const bf16* K = (const bf16*)(ws + WS_XC); const bf16* V = (const bf16*)(ws + WS_XM); const bf16* XC = (const bf16*)(ws + WS_XC); const bf16* Z = (const bf16*)(ws + WS_Z);
    bf16* YC = (bf16*)(ws + WS_V); const float* GA = (const float*)(ws + WS_GA); const float* GAM = (const float*)(ws + WS_GAM); const float* GEM = (const float*)(ws + WS_GEM);
    const float* mh_g = a.in[27]; const float* skip = a.in[28]; const float* wvp = a.in[23];
    const int tid = F.tid, lane = F.lane, w = F.wave, fr = lane & 15, fq = lane >> 4; LAS unsigned char* lds = F.lds;
    LAS float* den2 = (LAS float*)(lds + ML_DEN); LAS float* stats = (LAS float*)(lds + ML_ST); LAS float* mr = (LAS float*)(lds + ML_MR); LAS float* em_s = (LAS float*)(lds + ML_AT); LAS float* as_s = (LAS float*)(lds + ML_AS);
    const int st = w & 1, tp = (w >> 1) & 1, wv = w & 3;
    const unsigned vtr_lane = (unsigned)((8 * fq + ((lane & 15) >> 2)) * ML_PITCH + (128 * wv + 4 * (lane & 3)) * 2);
#define ML_DMA(gbase, tile_off) do { _Pragma("unroll") for (int r4 = 0; r4 < 4; ++r4) { const int rr = w + 8 * r4; \
        __builtin_amdgcn_global_load_lds((const unsigned*)((gbase) + (size_t)rr * CI + lane * 8), (LAS unsigned*)(lds + (tile_off) + rr * ML_PITCH), 16, 0, 0); } } while (0)
#define ML_STEP_HEAD() const int buf = k & 1; int j = k + jstart; if (j >= nk) j -= nk; int jn = j + 1; if (jn >= nk) jn -= nk; \
        asm volatile("s_waitcnt vmcnt(0) lgkmcnt(0)" ::: "memory"); __builtin_amdgcn_s_barrier(); asm volatile("" ::: "memory"); \
        if (k + 1 < nk && !skK) ML_DMA(Kb + (size_t)(32 * jn) * CI, ML_K + (buf ^ 1) * ML_TILE); \
        if (k < nk && !skV) ML_DMA(Vb + (size_t)(32 * j) * CI, ML_V + buf * ML_TILE)
    for (int r = 0; r < 8; ++r) { const int xcd = F.bid & 7, cq = F.bid >> 3, c16 = cq & 15; if (F.G != 256) break;
        const int part = r & 1, qi = part ? 31 - c16 : c16, bh = xcd + 8 * ((cq >> 4) + 2 * (r >> 1)), bl = bh >> 2, h = bh & 3; const size_t t0 = (size_t)bl * SEQ + 64 * qi; const int nk = 2 * (qi + 1), jstart = part ? 2 * (c16 + 1) : 0;
        const bf16* Kb = K + (size_t)bl * SEQ * CI + h * 512; const bf16* Vb = V + (size_t)bl * SEQ * CI + h * 512;
        ML_DMA(Kb + (size_t)(32 * jstart) * CI, ML_K);
        float tb_e, tb_a[4];
        tb_e = GEM[(t0 + (tid & 63)) * 4 + h];
#pragma unroll
        for (int i4 = 0; i4 < 4; ++i4) tb_a[i4] = GA[((size_t)bl * SEQ + tid + 512 * i4) * 4 + h];
#define ML_TABLES() do { if (tid < 64) em_s[tid] = tb_e; _Pragma("unroll") for (int i4 = 0; i4 < 4; ++i4) { const int sidx = tid + 512 * i4; if (sidx < 64 * (qi + 1)) as_s[sidx] = tb_a[i4] * LOG2E; } } while (0)
        const int c8 = lane * 8, cc = h * 512 + c8;
#define ML_EPI_LOADS(N, ROW0) v4u zr[N], xr[N]; float gm[8], sk[8]; asm volatile("" ::: "memory"); __builtin_amdgcn_sched_barrier(0); if (!skE) { _Pragma("unroll") for (int k8 = 0; k8 < N; ++k8) { const size_t off = (t0 + (ROW0) + k8) * CI + cc; zr[k8] = *(const v4u*)(Z + off); xr[k8] = *(const v4u*)(XC + off); } \
        _Pragma("unroll") for (int q = 0; q < 8; ++q) { gm[q] = mh_g[cc + q]; sk[q] = skip[cc + q]; } }
#define ML_EPI_PASS(N, ROW0) if (!skE) { const LAS float* ytile = (const LAS float*)lds; _Pragma("unroll") for (int k8 = 0; k8 < N; ++k8) { const int row = (ROW0) + k8; const size_t off = (t0 + row) * CI + cc; \
              const f32x4 y0 = *(const LAS f32x4*)(ytile + row * 516 + c8), y1 = *(const LAS f32x4*)(ytile + row * 516 + c8 + 4); float zf[8], xf[8], o[8]; unpack8(zr[k8], zf); unpack8(xr[k8], xf); \
              float s1 = ((y0[0] + y0[1]) + (y0[2] + y0[3])) + ((y1[0] + y1[1]) + (y1[2] + y1[3])), s2 = ((y0[0] * y0[0] + y0[1] * y0[1]) + (y0[2] * y0[2] + y0[3] * y0[3])) + ((y1[0] * y1[0] + y1[1] * y1[1]) + (y1[2] * y1[2] + y1[3] * y1[3])); \
              s1 = wave_sum(s1); s2 = wave_sum(s2); const float mean = s1 * (1.f / 512.f), rstd = rsqrtf(fmaxf(s2 * (1.f / 512.f) - mean * mean, 0.f) + 1e-5f); \
              _Pragma("unroll") for (int q = 0; q < 8; ++q) { const float yv = ((q < 4 ? y0[q & 3] : y1[q & 3]) - mean) * rstd; o[q] = (yv * gm[q] + sk[q] * xf[q]) * (zf[q] * sigm(zf[q])); } \
              *(v4u*)(YC + off) = pack8(o); } }
        if (w < 4) {
            bf16x8 qf[2][16];
            { const bf16* qp = Q + (t0 + 32 * tp + fr) * CI + h * 512 + fq * 8;
#pragma unroll
              for (int ks = 0; ks < 16; ++ks) { qf[0][ks] = *(const bf16x8*)(qp + 32 * ks); qf[1][ks] = *(const bf16x8*)(qp + 16 * CI + 32 * ks); } }
            const float At0 = GAM[(t0 + 32 * tp + fr) * 4 + h] * LOG2E, At1 = GAM[(t0 + 32 * tp + 16 + fr) * 4 + h] * LOG2E;
            ML_TABLES();
            float denp0 = 0.f, denp1 = 0.f;
            for (int k = 0; k <= nk; ++k) { ML_STEP_HEAD();
                if (k < nk && !skS) {
                    f32x4 s0a = {0.f, 0.f, 0.f, 0.f}, s0b = {0.f, 0.f, 0.f, 0.f}, s1a = {0.f, 0.f, 0.f, 0.f}, s1b = {0.f, 0.f, 0.f, 0.f};
                    { const LAS unsigned char* kl = lds + ML_K + buf * ML_TILE + (16 * st + fr) * ML_PITCH + fq * 16; bf16x8 kc[4], kn[4];
#pragma unroll
                      for (int q = 0; q < 4; ++q) kc[q] = *(const LAS bf16x8*)(kl + 64 * q);
#pragma unroll
                      for (int g = 0; g < 4; ++g) {
                          if (g < 3) {
#pragma unroll
                              for (int q = 0; q < 4; ++q) kn[q] = *(const LAS bf16x8*)(kl + 64 * (4 * g + 4 + q)); }
                          __builtin_amdgcn_sched_barrier(0);
#pragma unroll
                          for (int q = 0; q < 4; q += 2) { const int ks = 4 * g + q;
                              s0a = __builtin_amdgcn_mfma_f32_16x16x32_bf16(kc[q], qf[0][ks], s0a, 0, 0, 0); s1a = __builtin_amdgcn_mfma_f32_16x16x32_bf16(kc[q], qf[1][ks], s1a, 0, 0, 0);
                              s0b = __builtin_amdgcn_mfma_f32_16x16x32_bf16(kc[q + 1], qf[0][ks + 1], s0b, 0, 0, 0); s1b = __builtin_amdgcn_mfma_f32_16x16x32_bf16(kc[q + 1], qf[1][ks + 1], s1b, 0, 0, 0); }
                          __builtin_amdgcn_sched_barrier(0);
                          if (g < 3) {
#pragma unroll
                              for (int q = 0; q < 4; ++q) kc[q] = kn[q]; } } }
                    s0a += s0b; s1a += s1b;
                    const f32x4 asv = *(const LAS f32x4*)(as_s + 32 * j + 16 * st + 4 * fq); const float as[4] = {asv[0], asv[1], asv[2], asv[3]};
                    float p0[4], p1[4]; const int sbase = 32 * j + 16 * st + 4 * fq, tbase = 64 * qi + 32 * tp + fr;
                    if (32 * j + 31 <= 64 * qi + 32 * tp) {
#pragma unroll
                        for (int i = 0; i < 4; ++i) { p0[i] = s0a[i] * __builtin_amdgcn_exp2f(as[i] - At0); p1[i] = s1a[i] * __builtin_amdgcn_exp2f(as[i] - At1); }
                    } else {
#pragma unroll
                        for (int i = 0; i < 4; ++i) { p0[i] = (sbase + i) <= tbase ? s0a[i] * __builtin_amdgcn_exp2f(as[i] - At0) : 0.f; p1[i] = (sbase + i) <= tbase + 16 ? s1a[i] * __builtin_amdgcn_exp2f(as[i] - At1) : 0.f; } }
                    denp0 += (p0[0] + p0[1]) + (p0[2] + p0[3]); denp1 += (p1[0] + p1[1]) + (p1[2] + p1[3]);
                    { LAS unsigned char* pp = lds + ML_P + buf * ML_PT + (32 * tp + fr) * ML_PP + (16 * st + 4 * fq) * 2; v2u pw; pw.x = pk2(p0[0], p0[1]); pw.y = pk2(p0[2], p0[3]); *(LAS v2u*)pp = pw;
                      pw.x = pk2(p1[0], p1[1]); pw.y = pk2(p1[2], p1[3]); *(LAS v2u*)(pp + 16 * ML_PP) = pw; }
                } }
            ML_EPI_LOADS(12, 12 * w);
            { float wt[8];
#pragma unroll
              for (int u = 0; u < 8; ++u) { const int col = 2 * tid + (u >> 2); wt[u] = wvp[(size_t)(h * 128 + (col >> 2)) * 16 + 4 * (u & 3) + (col & 3)]; }
              *(LAS f32x4*)(as_s + 8 * tid) = (f32x4){wt[0], wt[1], wt[2], wt[3]}; *(LAS f32x4*)(as_s + 8 * tid + 4) = (f32x4){wt[4], wt[5], wt[6], wt[7]}; }
            { float d0 = denp0, d1 = denp1; d0 += __shfl_xor(d0, 16); d1 += __shfl_xor(d1, 16); d0 += __shfl_xor(d0, 32); d1 += __shfl_xor(d1, 32);
              if (fq == 0) { den2[st * 64 + 32 * tp + fr] = d0; den2[st * 64 + 32 * tp + 16 + fr] = d1; } }
            LDS_WAIT(); __builtin_amdgcn_s_barrier(); asm volatile("" ::: "memory");
            __builtin_amdgcn_s_barrier(); asm volatile("" ::: "memory");
            ML_EPI_PASS(12, 12 * w)
        } else {
            f32x4 O[4][8];
#pragma unroll
            for (int i = 0; i < 4; ++i)
#pragma unroll
                for (int e = 0; e < 8; ++e) O[i][e] = (f32x4){0.f, 0.f, 0.f, 0.f};
            ML_TABLES();
            bf16x8 pH[4], vH[2];
#pragma unroll
            for (int i = 0; i < 4; ++i) { pH[i] = (bf16x8){0, 0, 0, 0, 0, 0, 0, 0}; vH[i & 1] = (bf16x8){0, 0, 0, 0, 0, 0, 0, 0}; }
            for (int k = 0; k <= nk; ++k) { ML_STEP_HEAD();
                if (!skP) { PvOps o;
                    if (k >= 1) pv_issue((unsigned)(size_t)(lds + ML_P + (buf ^ 1) * ML_PT + fr * ML_PP + fq * 16), (unsigned)(size_t)(lds + ML_V + (buf ^ 1) * ML_TILE) + vtr_lane, o);
                    __builtin_amdgcn_sched_barrier(0);
                    if (k >= 2) {
#pragma unroll
                        for (int i = 0; i < 4; ++i)
#pragma unroll
                            for (int e = 0; e < 2; ++e) O[i][6 + e] = __builtin_amdgcn_mfma_f32_16x16x32_bf16(pH[i], vH[e], O[i][6 + e], 0, 0, 0); }
                    if (k >= 1) { pv_wait(o);
                        const bf16x8 pf[4] = {o.p0, o.p1, o.p2, o.p3}; const bf16x8 va[6] = {PV_CAT(o.l0, o.h0), PV_CAT(o.l1, o.h1), PV_CAT(o.l2, o.h2), PV_CAT(o.l3, o.h3), PV_CAT(o.l4, o.h4), PV_CAT(o.l5, o.h5)};
#pragma unroll
                        for (int i = 0; i < 4; ++i)
#pragma unroll
                            for (int e = 0; e < 6; ++e) O[i][e] = __builtin_amdgcn_mfma_f32_16x16x32_bf16(pf[i], va[e], O[i][e], 0, 0, 0);
#pragma unroll
                        for (int i = 0; i < 4; ++i) pH[i] = pf[i];
                        vH[0] = PV_CAT(o.l6, o.h6); vH[1] = PV_CAT(o.l7, o.h7); } } }
            if (!skP) {
#pragma unroll
                for (int i = 0; i < 4; ++i)
#pragma unroll
                    for (int e = 0; e < 2; ++e) O[i][6 + e] = __builtin_amdgcn_mfma_f32_16x16x32_bf16(pH[i], vH[e], O[i][6 + e], 0, 0, 0); }
            LDS_WAIT(); __builtin_amdgcn_s_barrier(); asm volatile("" ::: "memory");
            { const LAS float* den_q = den2 + 4 * fq; const LAS float* em_q = em_s + 4 * fq; LAS float* yt_q = (LAS float*)lds + 4 * fq * 516 + 128 * wv + fr; float inv[16];
#pragma unroll
              for (int i = 0; i < 4; ++i)
#pragma unroll
                for (int jj = 0; jj < 4; ++jj) { const float dn = den_q[16 * i + jj] + den_q[64 + 16 * i + jj]; inv[4 * i + jj] = 1.0f / fmaxf(fabsf(dn), em_q[16 * i + jj]); }
#pragma unroll
              for (int e = 0; e < 8; ++e) { const f32x4 wl = *(const LAS f32x4*)(as_s + (128 * wv + 16 * e + fr) * 4);
#pragma unroll
                for (int i = 0; i < 4; ++i)
#pragma unroll
                    for (int jj = 0; jj < 4; ++jj) { const float x = O[i][e][jj] * inv[4 * i + jj];
                        yt_q[(16 * i + jj) * 516 + 16 * e] = fmaf(DPP_MOVF(x, 0xFF), wl[3], fmaf(DPP_MOVF(x, 0xAA), wl[2], fmaf(DPP_MOVF(x, 0x55), wl[1], DPP_MOVF(x, 0x00) * wl[0]))); } } }
            LDS_WAIT(); __builtin_amdgcn_s_barrier(); asm volatile("" ::: "memory");
            ML_EPI_LOADS(4, 48 + 4 * wv);
            ML_EPI_PASS(4, 48 + 4 * wv)
        }
        VM_WAIT(); __syncthreads();
    }
#undef ML_DMA
#undef ML_STEP_HEAD
#undef ML_TABLES
#undef ML_EPI_LOADS
#undef ML_EPI_PASS
}
__device__ __forceinline__ void phase_mlstm(Frame& F, const Args& a) { phase_mlstm_t<0>(F, a); }
#ifdef ML_PROBE
__device__ __forceinline__ void phase_mlstm_probe(Frame& F, const Args& a) { phase_mlstm_t<ML_PROBE>(F, a); }
#endif

#ifdef ML_DMAPROBE
__device__ __forceinline__ void phase_mlstm_dmaprobe(Frame& F, const Args& a) {
    unsigned char* ws = F.ws; const bf16* K = (const bf16*)(ws + WS_K); const bf16* V = (const bf16*)(ws + WS_V);
    const int lane = F.lane, w = F.wave; LAS unsigned char* lds = F.lds;
#define MLP_DMA(gbase, tile_off) do { _Pragma("unroll") for (int r4 = 0; r4 < 4; ++r4) { const int rr = w + 8 * r4; \
        __builtin_amdgcn_global_load_lds((const unsigned*)((gbase) + (size_t)rr * CI + lane * 8), (LAS unsigned*)(lds + (tile_off) + rr * ML_PITCH), 16, 0, 0); } } while (0)
    for (int r = 0; r < 8; ++r) { const int xcd = F.bid & 7, cq = F.bid >> 3, c16 = cq & 15; if (F.G != 256) break;
        const int part = r & 1, qi = part ? 31 - c16 : c16, bh = xcd + 8 * ((cq >> 4) + 2 * (r >> 1)), bl = bh >> 2, h = bh & 3; const int nk = 2 * (qi + 1), jstart = part ? 2 * (c16 + 1) : 0;
        const bf16* Kb = K + (size_t)bl * SEQ * CI + h * 512; const bf16* Vb = V + (size_t)bl * SEQ * CI + h * 512;
        for (int k = 0; k <= nk; ++k) { const int buf = k & 1; int j = k + jstart; if (j >= nk) j -= nk; int jn = j + 1; if (jn >= nk) jn -= nk;
            asm volatile("s_waitcnt vmcnt(0) lgkmcnt(0)" ::: "memory"); __builtin_amdgcn_s_barrier(); asm volatile("" ::: "memory");
            if ((ML_DMAPROBE & 1) && k + 1 < nk) MLP_DMA(Kb + (size_t)(32 * jn) * CI, ML_K + (buf ^ 1) * ML_TILE);
            if ((ML_DMAPROBE & 2) && k < nk) MLP_DMA(Vb + (size_t)(32 * j) * CI, ML_V + buf * ML_TILE);
        }
        VM_WAIT(); __syncthreads();
    }
#undef MLP_DMA
}
#endif
#ifdef ML_DMAPROBE
#define ML_PROBE_CALL phase_mlstm_dmaprobe(F, args);
#elif defined(ML_PROBE)
#define ML_PROBE_CALL phase_mlstm_probe(F, args);
#else
#define ML_PROBE_CALL
#endif
#define GEMM_PHASE(EPI, Aptr, Bptr, M_, N_, K_, ...) do { pg8::Gemm g{(const pg8::bf16_t*)(Aptr), (const pg8::bf16_t*)(Bptr), (M_), (N_), (K_)}; pg8::StaticOrder So; So.init((M_), (N_), F.G, F.bid); \
        pg8::EPI Ep{__VA_ARGS__}; pg8::gemm_phase<pg8::EPI, pg8::StaticOrder, PG8_ALIGN, PG8_SP2>(F.lds, g, So, Ep); } while (0)
namespace pg8 { typedef EpiRes2<float> EpiResF; typedef EpiRes2<bf16_t> EpiResB; typedef EpiPle2<false> EpiPleB; typedef EpiPle2<true> EpiPleF; }
__global__ void __launch_bounds__(NWAVES * 64, 2) trunk_fwd(Args args) {
    extern __shared__ __attribute__((aligned(16))) unsigned char lds_raw[];
    Frame F; F.lds = (LAS unsigned char*)lds_raw; F.ws = args.ws; F.in = nullptr;
    F.tid = threadIdx.x; F.lane = F.tid & 63; F.wave = __builtin_amdgcn_readfirstlane(F.tid >> 6); F.G = gridDim.x; F.bid = blockIdx.x;
    volatile LAS unsigned* MISC = (volatile LAS unsigned*)(F.lds + MISC_OFF);
    if (F.tid < 64) MISC[F.tid] = 0u;
    __syncthreads();
    XcdBarrier bar; bar.bar = (unsigned*)(args.ws + WS_CTL) + CW_BAR; bar.x = 0; bar.st = nullptr;
    if (args.use_bar) bar = xcd_barrier_post((unsigned*)(args.ws + WS_CTL) + CW_BAR, MISC + 8);
    unsigned* xrank = (unsigned*)(args.ws + WS_CTL) + CW_XRANK; const unsigned my_xcc = xb_xcc_id();
    if (args.use_bar && F.tid == 0) MISC[12] = xb_add(&xrank[64 * my_xcc], 1u);
    const int lo = args.ph_lo, hi = args.ph_hi;
#ifndef ONLY_SITE
#define ONLY_SITE -1
#endif
#define EN(n) (ONLY_SITE < 0 || ONLY_SITE == (n))
#ifndef REP_MASK
#define REP_MASK 0u
#endif
#define NREP(n) (((REP_MASK >> (n)) & 1u) ? 2 : 1)
#define IN(k) (lo <= (k) && (k) < hi)
#define SEAM(k) do { if (IN(k) && IN((k) + 1)) xcd_barrier(bar); } while (0)
    unsigned char* ws = args.ws; float* out = args.out;
    float* RS = (float*)(ws + WS_RS);
#define RSN(i) (RS + (size_t)(i) * T * 16)
#define PH(site, k, ...) if (EN(site) && IN(k)) { for (int rep_ = 0; rep_ < NREP(site); ++rep_) { if (rep_) xcd_barrier(bar); __VA_ARGS__ } } SEAM(k);
    PH(0, 0, phase_prologue(F, args); phase_cast_sq(F, args.in[0], (bf16*)(ws + WS_XB2), RSN(0), T);)
    if (args.use_bar && lo == 0 && hi > 1) {
        bool ok = F.G == 256; for (int x = 0; x < 16; ++x) { const unsigned cx = xb_ld(&xrank[64 * x]); ok = ok && (cx == (x < 8 ? 32u : 0u)); }
        const unsigned rk = MISC[12]; if (ok && rk < 32u && my_xcc < 8u) F.bid = (int)(rk * 8u + my_xcc); }
    PH(2, 1, GEMM_PHASE(EpiBf16SplitR, ws + WS_XB2, ws + WS_WIN, T, NU, D, (pg8::bf16_t*)(ws + WS_UA), UA_W, 4, (pg8::bf16_t*)(ws + WS_UB), UB_W, RSN(0));)
    PH(3, 2, phase_prepA(F, args);)
    PH(4, 3, GEMM_PHASE(EpiBf16Split, ws + WS_LIN, ws + WS_WLORA, T, 1536, 256 + args.pad, (pg8::bf16_t*)(ws + WS_LOUT), 1536, 1 << 20, nullptr, 0);)
    PH(5, 4, phase_indexer(F);)
    PH(6, 5, phase_dsa_attn(F, args);)
    PH(7, 6, phase_rwkv(F, args);)
    PH(8, 7, GEMM_PHASE(EpiResF, ws + WS_XB, ws + WS_WOUT, T, D, D, args.in[0], (pg8::bf16_t*)(ws + WS_XB2), D, RSN(1));)
#define FFN_PLE(L, pb, rs_a, rs_b, rs_c, PLE_EPI, ple_out) do { const size_t lw = (size_t)(L) * WS_LAYER_STRIDE; \
        PH(21, (pb), GEMM_PHASE(EpiSwigluR, ws + WS_XB2, ws + WS_WGU0 + lw, T, 2 * FF, D, (pg8::bf16_t*)(ws + WS_H), FF, RSN(rs_a));) \
        PH(22, (pb) + 1, GEMM_PHASE(EpiResB, ws + WS_H, ws + WS_WD0 + lw, T, D, FF, (const pg8::bf16_t*)(ws + WS_XB2), (pg8::bf16_t*)(ws + WS_XB), D, RSN(rs_b));) \
        PH(24, (pb) + 2, GEMM_PHASE(EpiBf16Split, ws + WS_PB, ws + WS_WPLE0 + lw, T, D, 256 + args.pad, (pg8::bf16_t*)(ws + WS_E), D, 1 << 20, nullptr, 0);) \
        PH(25, (pb) + 3, GEMM_PHASE(PLE_EPI, ws + WS_XB, ws + WS_WPG0 + lw, T, D, D, (const pg8::bf16_t*)(ws + WS_XB), (void*)(ple_out), (const pg8::bf16_t*)(ws + WS_E), D, RSN(rs_b), RSN(rs_c));) } while (0)
#define L1_HALF(hb, p1) do { bf16* xbh = (bf16*)(ws + WS_XB2) + (size_t)(hb) * TH * D; \
        PH(11, (p1), GEMM_PHASE(EpiBf16SplitR, xbh, ws + WS_WUP, TH, 2 * CI, D, (pg8::bf16_t*)(ws + WS_XM), CI, 8, (pg8::bf16_t*)(ws + WS_Z), CI, RSN(3) + (size_t)(hb) * TH * 16);) \
        PH(12, (p1) + 1, phase_l1prep(F, args, hb);) \
        PH(13, (p1) + 2, phase_gatescan(F); if ((hb) == 0) phase_cvt_p(F, args.in[1] + (size_t)T * 256, (bf16*)(ws + WS_PB));) \
        PH(14, (p1) + 3, ML_PROBE_CALL phase_mlstm(F, args);) \
        PH(15, (p1) + 4, GEMM_PHASE(EpiResB, ws + WS_V, ws + WS_WDOWN, TH, D, CI, (const pg8::bf16_t*)xbh, (pg8::bf16_t*)xbh, D, RSN(4) + (size_t)(hb) * TH * 16);) } while (0)
    FFN_PLE(0, 8, 1, 2, 3, EpiPleB, ws + WS_XB2);
    L1_HALF(0, 12);
    L1_HALF(1, 17);
    FFN_PLE(1, 22, 4, 5, 5, EpiPleF, out);
#undef IN
#undef SEAM
}
constexpr int N_PHASES = 26;

#ifndef MK_ONE_LAUNCH
#define MK_ONE_LAUNCH 1
#endif
extern "C" void kernel_launch(void* const* d_in, const int* in_sizes, int n_in, void* d_out, int out_size, void* d_ws, size_t ws_size, hipStream_t stream) {
    static int grid = 0;
    if (grid == 0) {
        if (n_in != 37 || in_sizes[0] != T * D || out_size != T * D || ws_size < WS_END) { fprintf(stderr, "kernel_launch: unexpected shapes (n_in %d, in0 %d, out %d, ws %zu < %zu); nothing launched\n", n_in, n_in > 0 ? in_sizes[0] : -1, out_size, ws_size, (size_t)WS_END); grid = -1; return; }
        int dev = 0, cus = 0, per_cu = 0;
        if (hipGetDevice(&dev) != hipSuccess || hipDeviceGetAttribute(&cus, hipDeviceAttributeMultiprocessorCount, dev) != hipSuccess) { grid = -1; return; }
        if (hipFuncSetAttribute((const void*)trunk_fwd, hipFuncAttributeMaxDynamicSharedMemorySize, LDS_BYTES) != hipSuccess) { fprintf(stderr, "kernel_launch: hipFuncSetAttribute failed\n"); grid = -1; return; }
        if (hipOccupancyMaxActiveBlocksPerMultiprocessor(&per_cu, (const void*)trunk_fwd, NWAVES * 64, LDS_BYTES) != hipSuccess || per_cu < 1) { fprintf(stderr, "kernel_launch: occupancy query says %d\n", per_cu); }
        (void)hipGetLastError();
        grid = cus;
        if (grid != 256) { fprintf(stderr, "kernel_launch: built for 256 CUs, found %d; nothing launched\n", cus); grid = -1; return; }
    }
    if (grid < 0) return;
    if (hipMemsetAsync((char*)d_ws + WS_CTL, 0, CTL_ZERO_BYTES, stream) != hipSuccess) return;
    Args a{};
    for (int i = 0; i < 37; ++i) a.in[i] = (const float*)d_in[i];
    a.out = (float*)d_out; a.ws = (unsigned char*)d_ws; a.pad = 0;
#if MK_ONE_LAUNCH
    a.ph_lo = 0; a.ph_hi = N_PHASES; a.use_bar = 1;
    hipLaunchKernelGGL(trunk_fwd, dim3(grid), dim3(NWAVES * 64), LDS_BYTES, stream, a);
#else
    for (int p = 0; p < N_PHASES; ++p) { a.ph_lo = p; a.ph_hi = p + 1; a.use_bar = 0; hipLaunchKernelGGL(trunk_fwd, dim3(grid), dim3(NWAVES * 64), LDS_BYTES, stream, a); }
#endif
}
```

```cpp
#include <hip/hip_runtime.h>
#include <cstdio>
#include <cstdint>
namespace pg8 {
#define PG8_LAS __attribute__((address_space(3)))
typedef unsigned short bf16_t;
typedef short bf16x8 __attribute__((ext_vector_type(8)));
typedef float f32x4 __attribute__((ext_vector_type(4)));
typedef unsigned u32x4 __attribute__((ext_vector_type(4)));
constexpr int BM = 256, BK = 64, HALF = 128, HTB = HALF * BK * 2  , STAGE_BYTES = 8 * HTB, NXCD = 8, WGM = 8;

__host__ __device__ __forceinline__ int lds_byte(int r, int c) { const int st = (r >> 4) * 2 + (c >> 5), rr = r & 15, cc = c & 31, ob = rr * 64 + cc * 2; return st * 1024 + (ob ^ (((ob >> 9) & 1) << 5)); }
__host__ __device__ __forceinline__ void stage_rc(int b, int& R, int& C) { const int st = b / 1024, sb = b % 1024, swz = sb ^ (((sb >> 9) & 1) << 5); R = (st >> 1) * 16 + swz / 64; C = (st & 1) * 32 + (swz % 64) / 2; }
__host__ __device__ __forceinline__ int perm32(int rho) { const int n = rho >> 4, i = rho & 15; return 8 * (i >> 2) + 4 * n + (i & 3); }

struct Unit { int pm, pn; };
struct Gemm { const bf16_t* A; const bf16_t* Bt; int M, N, K; };

struct StaticOrder {
    int nM, nN, nwg, G, c;
    __host__ __device__ void init(int M, int N, int G_, int c_) { nM = M / BM; nN = N / BM; nwg = nM * nN; G = G_; c = c_; }
    __host__ __device__ bool next(int i, Unit& u) const {
        const long L = (long)i * G + c; if (L >= nwg) return false;
        int wgid = (int)L; { const int q = nwg / NXCD, r = nwg % NXCD, xcd = wgid % NXCD, off = wgid / NXCD; wgid = (xcd < r ? xcd * (q + 1) : r * (q + 1) + (xcd - r) * q) + off; }
        const int nig = WGM * nN, gid = wgid / nig, fm = gid * WGM, gsz = (nM - fm) < WGM ? (nM - fm) : WGM;
        u.pm = fm + ((wgid % nig) % gsz); u.pn = (wgid % nig) / gsz; return true;
    }
    __device__ __forceinline__ void a_ready(const Unit&) const {}
    __device__ __forceinline__ void done(const Unit&) const {}
};

__device__ __forceinline__ unsigned cvt_pk_bf16(float lo, float hi) { unsigned r; asm volatile("v_cvt_pk_bf16_f32 %0, %1, %2" : "=v"(r) : "v"(lo), "v"(hi)); return r; }
typedef float f32x2 __attribute__((ext_vector_type(2)));
__device__ __forceinline__ f32x2 gelu_pk(f32x2 v) {
    const f32x2 av = __builtin_elementwise_abs(v), d = av * 0.2316418882f + 1.0f;
    f32x2 t; t.x = __builtin_amdgcn_rcpf(d.x); t.y = __builtin_amdgcn_rcpf(d.y);
    f32x2 q = t * 0.5307027145f + (-0.7265760135f); q = q * t + 0.7107068705f; q = q * t + (-0.142248368f); q = q * t + 0.127414796f; q = q * t;
    const f32x2 s = (v * v) * (-0.72134752044f);
    f32x2 e; e.x = __builtin_amdgcn_exp2f(s.x); e.y = __builtin_amdgcn_exp2f(s.y);
    const f32x2 m = v * (q * e), r = v - m;
    f32x2 o; o.x = v.x < 0.f ? m.x : r.x; o.y = v.y < 0.f ? m.y : r.y; return o;
}

template <class Epi, class Sched, bool ALIGN_EPI = false, bool SP2 = false>
__device__ __forceinline__ void gemm_phase(PG8_LAS unsigned char* lds, const Gemm g, const Sched& S, const Epi& E) {
    const int tid = threadIdx.x, wid = __builtin_amdgcn_readfirstlane(tid >> 6), lane = tid & 63, wr = wid >> 2, wc = wid & 3, fr = lane & 15, fq = lane >> 4;
    const int K = g.K, nt = K / BK;
    unsigned voffA[2], voffB[2];
#pragma unroll
    for (int i = 0; i < 2; ++i) { int R, C; stage_rc(tid * 16 + i * 8192, R, C); const int Rb = Epi::PERM ? ((R & ~31) + perm32(R & 31)) : R;
        voffA[i] = (unsigned)(R * K + C) * 2u; voffB[i] = (unsigned)(Rb * K + C) * 2u; }
    const size_t kstep = (size_t)(BK * 2);
    const size_t hstep = (size_t)HALF * K * 2;
    const size_t tstep = 2 * hstep;
    const unsigned ldsw = (unsigned)wid * 1024u;
    const int aoff = lds_byte(wr * 64 + fr, fq * 8), boff = lds_byte(wc * 32 + fr, fq * 8);
#define PG8_SA(b, h) (((b) * 2 + (h)) * HTB)
#define PG8_SB(b, h) ((4 + (b) * 2 + (h)) * HTB)
#define PG8_STAGE(bufoff, gbase, voff) do { _Pragma("unroll") for (int _i = 0; _i < 2; ++_i) \
        __builtin_amdgcn_global_load_lds((const unsigned*)((const char*)(gbase) + (voff)[_i]), (PG8_LAS unsigned*)(lds + (bufoff) + ldsw + _i * 8192), 16, 0, 0); } while (0)
#define PG8_LDA(dst, b, h) do { _Pragma("unroll") for (int m = 0; m < 4; ++m) _Pragma("unroll") for (int k = 0; k < 2; ++k) dst[m][k] = *(const PG8_LAS bf16x8*)(lds + PG8_SA(b, h) + aoff + m * 2048 + k * 1024); } while (0)
#define PG8_LDB(dst, b, h) do { _Pragma("unroll") for (int n = 0; n < 2; ++n) _Pragma("unroll") for (int k = 0; k < 2; ++k) dst[n][k] = *(const PG8_LAS bf16x8*)(lds + PG8_SB(b, h) + boff + n * 2048 + k * 1024); } while (0)
#define PG8_MMA(ai, bj, At, Bt) do { __builtin_amdgcn_s_setprio(1); _Pragma("unroll") for (int m = 0; m < 4; ++m) _Pragma("unroll") for (int n = 0; n < 2; ++n) _Pragma("unroll") for (int k = 0; k < 2; ++k) \
        acc[ai][bj][m][n] = __builtin_amdgcn_mfma_f32_16x16x32_bf16(Bt[n][k], At[m][k], acc[ai][bj][m][n], 0, 0, 0); __builtin_amdgcn_s_setprio(0); } while (0)
#define PG8_WAIT_V(n) asm volatile("s_waitcnt vmcnt(" #n ")" ::: "memory")
#define PG8_WAIT_L(n) asm volatile("s_waitcnt lgkmcnt(" #n ")" ::: "memory")
#define PG8_BAR __builtin_amdgcn_s_barrier()
#define PG8_SCHED __builtin_amdgcn_sched_barrier(0)
    Unit cur, nxt; int ui = 0;
    if (!S.next(0, cur)) return;
    f32x4 acc[2][2][4][2];
#pragma unroll
    for (int a = 0; a < 2; ++a)
#pragma unroll
        for (int b = 0; b < 2; ++b)
#pragma unroll
            for (int m = 0; m < 4; ++m)
#pragma unroll
                for (int n = 0; n < 2; ++n) acc[a][b][m][n] = (f32x4){0.f, 0.f, 0.f, 0.f};
    bf16x8 At[4][2], B0[2][2], B1[2][2];
    const char* cA = (const char*)g.A + (size_t)cur.pm * tstep; const char* cB = (const char*)g.Bt + (size_t)cur.pn * tstep;
    S.a_ready(cur);
    if constexpr (SP2) {
        PG8_STAGE(PG8_SB(0, 0), cB, voffB); PG8_STAGE(PG8_SB(0, 1), cB + hstep, voffB); PG8_STAGE(PG8_SA(0, 0), cA, voffA); PG8_STAGE(PG8_SA(0, 1), cA + hstep, voffA);
        if (wr == 1) PG8_BAR;
        PG8_WAIT_V(2); PG8_BAR;
        PG8_STAGE(PG8_SB(1, 0), cB + kstep, voffB); PG8_STAGE(PG8_SA(1, 0), cA + kstep, voffA); PG8_STAGE(PG8_SB(1, 1), cB + hstep + kstep, voffB);
        PG8_WAIT_V(6); PG8_BAR;
    } else {
        PG8_STAGE(PG8_SB(0, 0), cB, voffB); PG8_STAGE(PG8_SA(0, 0), cA, voffA); PG8_STAGE(PG8_SB(0, 1), cB + hstep, voffB); PG8_STAGE(PG8_SA(0, 1), cA + hstep, voffA);
        if (wr == 1) PG8_BAR;
        PG8_WAIT_V(4); PG8_BAR;
        PG8_STAGE(PG8_SB(1, 0), cB + kstep, voffB); PG8_STAGE(PG8_SA(1, 0), cA + kstep, voffA); PG8_STAGE(PG8_SB(1, 1), cB + hstep + kstep, voffB);
        PG8_WAIT_V(6); PG8_BAR;
    }
    for (;;) {
        const bool has_next = S.next(ui + 1, nxt);
        const char* nA = has_next ? (const char*)g.A + (size_t)nxt.pm * tstep : cA; const char* nB = has_next ? (const char*)g.Bt + (size_t)nxt.pn * tstep : cB;
        for (int t = 0; t < nt; t += 2) {
            const bool last = (t == nt - 2);
            const char* a1 = cA + (size_t)(t + 1) * kstep;
            const char* a2 = last ? nA : cA + (size_t)(t + 2) * kstep; const char* b2 = last ? nB : cB + (size_t)(t + 2) * kstep;
            const char* a3 = a2 + kstep; const char* b3 = b2 + kstep;
            if (last && has_next) S.a_ready(nxt);
            if constexpr (SP2) {
            PG8_LDB(B0, 0, 0); PG8_LDB(B1, 0, 1); PG8_SCHED; PG8_LDA(At, 0, 0); PG8_STAGE(PG8_SA(1, 1), a1 + hstep, voffA);
            PG8_WAIT_V(8); PG8_WAIT_L(0); PG8_BAR; PG8_MMA(0, 0, At, B0); PG8_MMA(0, 1, At, B1); PG8_BAR; PG8_SCHED;
            PG8_LDA(At, 0, 1); PG8_STAGE(PG8_SB(0, 0), b2, voffB); PG8_STAGE(PG8_SB(0, 1), b2 + hstep, voffB); PG8_STAGE(PG8_SA(0, 0), a2, voffA);
            PG8_WAIT_V(8); PG8_WAIT_L(0); PG8_BAR; PG8_MMA(1, 0, At, B0); PG8_MMA(1, 1, At, B1); PG8_BAR; PG8_SCHED;
            PG8_LDB(B0, 1, 0); PG8_LDB(B1, 1, 1); PG8_SCHED; PG8_LDA(At, 1, 0); PG8_STAGE(PG8_SA(0, 1), a2 + hstep, voffA);
            PG8_WAIT_V(8); PG8_WAIT_L(0); PG8_BAR; PG8_MMA(0, 0, At, B0); PG8_MMA(0, 1, At, B1); PG8_BAR; PG8_SCHED;
            PG8_LDA(At, 1, 1); PG8_STAGE(PG8_SB(1, 0), b3, voffB); PG8_STAGE(PG8_SB(1, 1), b3 + hstep, voffB); PG8_STAGE(PG8_SA(1, 0), a3, voffA);
            PG8_WAIT_V(8); PG8_WAIT_L(0); PG8_BAR; PG8_MMA(1, 0, At, B0); PG8_MMA(1, 1, At, B1); PG8_BAR; PG8_SCHED;
            } else {
            PG8_LDB(B0, 0, 0); PG8_SCHED; PG8_LDA(At, 0, 0); PG8_STAGE(PG8_SA(1, 1), a1 + hstep, voffA);
            PG8_WAIT_L(8); PG8_BAR; PG8_WAIT_L(0); PG8_MMA(0, 0, At, B0); PG8_BAR; PG8_SCHED;
            PG8_LDB(B1, 0, 1); PG8_STAGE(PG8_SB(0, 0), b2, voffB);
            PG8_BAR; PG8_WAIT_L(0); PG8_MMA(0, 1, At, B1); PG8_BAR;
            PG8_LDA(At, 0, 1); PG8_STAGE(PG8_SA(0, 0), a2, voffA);
            PG8_BAR; PG8_WAIT_L(0); PG8_MMA(1, 0, At, B0); PG8_BAR; PG8_SCHED;
            PG8_STAGE(PG8_SB(0, 1), b2 + hstep, voffB);
            PG8_WAIT_V(6); PG8_BAR; PG8_MMA(1, 1, At, B1); PG8_BAR;
            PG8_LDB(B0, 1, 0); PG8_SCHED; PG8_LDA(At, 1, 0); PG8_STAGE(PG8_SA(0, 1), a2 + hstep, voffA);
            PG8_WAIT_L(8); PG8_BAR; PG8_WAIT_L(0); PG8_MMA(0, 0, At, B0); PG8_BAR; PG8_SCHED;
            PG8_LDB(B1, 1, 1); PG8_STAGE(PG8_SB(1, 0), b3, voffB);
            PG8_BAR; PG8_WAIT_L(0); PG8_MMA(0, 1, At, B1); PG8_BAR;
            PG8_LDA(At, 1, 1); PG8_STAGE(PG8_SA(1, 0), a3, voffA);
            PG8_BAR; PG8_WAIT_L(0); PG8_MMA(1, 0, At, B0); PG8_BAR; PG8_SCHED;
            PG8_STAGE(PG8_SB(1, 1), b3 + hstep, voffB);
            PG8_WAIT_V(6); PG8_BAR; PG8_MMA(1, 1, At, B1); PG8_BAR;
            }
        }
        if constexpr (ALIGN_EPI) { if (wr == 0) PG8_BAR; }
        if constexpr (!Epi::AFTER_DRAIN) { E(acc, cur, wr, wc, fr, fq); S.done(cur); }
        if (!has_next) break;
#pragma unroll
        for (int a = 0; a < 2; ++a)
#pragma unroll
            for (int b = 0; b < 2; ++b)
#pragma unroll
                for (int m = 0; m < 4; ++m)
#pragma unroll
                    for (int n = 0; n < 2; ++n) acc[a][b][m][n] = (f32x4){0.f, 0.f, 0.f, 0.f};
        cur = nxt; cA = nA; cB = nB; ++ui;
        if constexpr (ALIGN_EPI) { if (wr == 1) PG8_BAR; }
    }
    PG8_WAIT_V(0);
    if constexpr (!ALIGN_EPI) { if (wr == 0) PG8_BAR; }
    PG8_BAR;
    if constexpr (Epi::AFTER_DRAIN) { E.fused(acc, cur, wr, wc, fr, fq, lds, wid, lane); S.done(cur); }
#undef PG8_SA
#undef PG8_SB
#undef PG8_STAGE
#undef PG8_LDA
#undef PG8_LDB
#undef PG8_MMA
#undef PG8_WAIT_V
#undef PG8_WAIT_L
#undef PG8_BAR
#undef PG8_SCHED
}
}
namespace pg8 {
__device__ __forceinline__ float sigmoidf_(float x) { return __builtin_amdgcn_rcpf(1.0f + __builtin_amdgcn_exp2f(-1.4426950408889634f * x)); }
struct EpiBf16Split {
    static constexpr bool PERM = true, AFTER_DRAIN = false;
    bf16_t* O0; int ld0; int nt0; bf16_t* O1; int ld1;
    __device__ __forceinline__ void operator()(const f32x4 (&acc)[2][2][4][2], const Unit& u, int wr, int wc, int fr, int fq) const {
        const bool first = u.pn < nt0; bf16_t* base = first ? O0 : O1; const int ld = first ? ld0 : ld1; const int colt = (first ? u.pn : u.pn - nt0) * BM;
        const int row0 = u.pm * BM + wr * 64 + fr, col0 = colt + wc * 32 + 8 * fq;
#pragma unroll
        for (int ai = 0; ai < 2; ++ai)
#pragma unroll
            for (int m = 0; m < 4; ++m) { bf16_t* rowp = base + (size_t)(row0 + ai * HALF + m * 16) * ld + col0;
#pragma unroll
                for (int bj = 0; bj < 2; ++bj) { const f32x4 v0 = acc[ai][bj][m][0], v1 = acc[ai][bj][m][1];
                    u32x4 w; w.x = cvt_pk_bf16(v0[0], v0[1]); w.y = cvt_pk_bf16(v0[2], v0[3]); w.z = cvt_pk_bf16(v1[0], v1[1]); w.w = cvt_pk_bf16(v1[2], v1[3]);
                    *(u32x4*)(rowp + bj * HALF) = w; } }
    }
};
struct EpiResF32 {
    static constexpr bool PERM = false, AFTER_DRAIN = false;
    const float* base; float* out; int ldc;
    __device__ __forceinline__ void operator()(const f32x4 (&acc)[2][2][4][2], const Unit& u, int wr, int wc, int fr, int fq) const {
        const int row0 = u.pm * BM + wr * 64 + fr, col0 = u.pn * BM + wc * 32 + 4 * fq;
#pragma unroll
        for (int ai = 0; ai < 2; ++ai)
#pragma unroll
            for (int m = 0; m < 4; ++m) { const size_t off = (size_t)(row0 + ai * HALF + m * 16) * ldc + col0;
#pragma unroll
                for (int bj = 0; bj < 2; ++bj)
#pragma unroll
                    for (int n = 0; n < 2; ++n) { const f32x4 b = *(const f32x4*)(base + off + bj * HALF + n * 16); *(f32x4*)(out + off + bj * HALF + n * 16) = b + acc[ai][bj][m][n]; } }
    }
};
struct EpiSwiglu {
    static constexpr bool PERM = false, AFTER_DRAIN = false;
    bf16_t* H; int ldh;
    __device__ __forceinline__ void operator()(const f32x4 (&acc)[2][2][4][2], const Unit& u, int wr, int wc, int fr, int fq) const {
        const int row0 = u.pm * BM + wr * 64 + fr, hc0 = u.pn * (BM / 2) + wc * 16 + 4 * fq;
#pragma unroll
        for (int ai = 0; ai < 2; ++ai)
#pragma unroll
            for (int m = 0; m < 4; ++m) { bf16_t* rowp = H + (size_t)(row0 + ai * HALF + m * 16) * ldh + hc0;
#pragma unroll
                for (int bj = 0; bj < 2; ++bj) { const f32x4 g = acc[ai][bj][m][0], up = acc[ai][bj][m][1]; float h[4];
#pragma unroll
                    for (int i = 0; i < 4; ++i) h[i] = g[i] * sigmoidf_(g[i]) * up[i];
                    typedef unsigned u32x2 __attribute__((ext_vector_type(2)));
                    u32x2 w; w.x = cvt_pk_bf16(h[0], h[1]); w.y = cvt_pk_bf16(h[2], h[3]);
                    *(u32x2*)(rowp + bj * (HALF / 2)) = w; } }
    }
};
struct EpiPle {
    static constexpr bool PERM = false, AFTER_DRAIN = false;
    const float* base; float* out; const bf16_t* E; int ldc;
    __device__ __forceinline__ void operator()(const f32x4 (&acc)[2][2][4][2], const Unit& u, int wr, int wc, int fr, int fq) const {
        const int row0 = u.pm * BM + wr * 64 + fr, col0 = u.pn * BM + wc * 32 + 4 * fq;
        typedef unsigned u32x2 __attribute__((ext_vector_type(2)));
#pragma unroll
        for (int ai = 0; ai < 2; ++ai)
#pragma unroll
            for (int m = 0; m < 4; ++m) { const size_t off = (size_t)(row0 + ai * HALF + m * 16) * ldc + col0;
#pragma unroll
                for (int bj = 0; bj < 2; ++bj)
#pragma unroll
                    for (int n = 0; n < 2; ++n) { const size_t o = off + bj * HALF + n * 16; const f32x4 b = *(const f32x4*)(base + o); const u32x2 e = *(const u32x2*)(E + o); const f32x4 a = acc[ai][bj][m][n];
                        f32x4 r; r[0] = b[0] + __uint_as_float(e.x << 16) * sigmoidf_(a[0]); r[1] = b[1] + __uint_as_float(e.x & 0xffff0000u) * sigmoidf_(a[1]);
                        r[2] = b[2] + __uint_as_float(e.y << 16) * sigmoidf_(a[2]); r[3] = b[3] + __uint_as_float(e.y & 0xffff0000u) * sigmoidf_(a[3]);
                        *(f32x4*)(out + o) = r; } }
    }
};
__device__ __forceinline__ float rms_r(const float* rsq, int row) { const f32x4* p = (const f32x4*)(rsq + (size_t)row * 16); const f32x4 a = p[0], b = p[1], c = p[2], d = p[3];
    const float s = (((a[0] + a[1]) + (a[2] + a[3])) + ((b[0] + b[1]) + (b[2] + b[3]))) + (((c[0] + c[1]) + (c[2] + c[3])) + ((d[0] + d[1]) + (d[2] + d[3]))); return rsqrtf(s * (1.0f / 1024.0f) + 1e-6f); }
__device__ __forceinline__ void norm_out(const f32x4 (&x)[2][2], bf16_t* xb, size_t off, float* rsq_out, int row, int fq, int slot) {
    typedef unsigned u32x2 __attribute__((ext_vector_type(2))); float s = 0.f;
#pragma unroll
    for (int bj = 0; bj < 2; ++bj)
#pragma unroll
        for (int n = 0; n < 2; ++n) { const f32x4 v = x[bj][n]; s += (v[0] * v[0] + v[1] * v[1]) + (v[2] * v[2] + v[3] * v[3]); u32x2 w; w.x = cvt_pk_bf16(v[0], v[1]); w.y = cvt_pk_bf16(v[2], v[3]); *(u32x2*)(xb + off + bj * HALF + n * 16) = w; }
    s += __shfl_xor(s, 16); s += __shfl_xor(s, 32);
    if (fq == 0) rsq_out[(size_t)row * 16 + slot] = s;
}
struct EpiBf16SplitR {
    static constexpr bool PERM = true, AFTER_DRAIN = false;
    bf16_t* O0; int ld0; int nt0; bf16_t* O1; int ld1; const float* rsq;
    __device__ __forceinline__ void operator()(const f32x4 (&acc)[2][2][4][2], const Unit& u, int wr, int wc, int fr, int fq) const {
        const bool first = u.pn < nt0; bf16_t* base = first ? O0 : O1; const int ld = first ? ld0 : ld1; const int colt = (first ? u.pn : u.pn - nt0) * BM;
        const int row0 = u.pm * BM + wr * 64 + fr, col0 = colt + wc * 32 + 8 * fq;
#pragma unroll
        for (int ai = 0; ai < 2; ++ai)
#pragma unroll
            for (int m = 0; m < 4; ++m) { const int row = row0 + ai * HALF + m * 16; const float r = rms_r(rsq, row); bf16_t* rowp = base + (size_t)row * ld + col0;
#pragma unroll
                for (int bj = 0; bj < 2; ++bj) { const f32x4 v0 = acc[ai][bj][m][0] * r, v1 = acc[ai][bj][m][1] * r;
                    u32x4 w; w.x = cvt_pk_bf16(v0[0], v0[1]); w.y = cvt_pk_bf16(v0[2], v0[3]); w.z = cvt_pk_bf16(v1[0], v1[1]); w.w = cvt_pk_bf16(v1[2], v1[3]);
                    *(u32x4*)(rowp + bj * HALF) = w; } }
    }
};
struct EpiSwigluR {
    static constexpr bool PERM = false, AFTER_DRAIN = false;
    bf16_t* H; int ldh; const float* rsq;
    __device__ __forceinline__ void operator()(const f32x4 (&acc)[2][2][4][2], const Unit& u, int wr, int wc, int fr, int fq) const {
        const int row0 = u.pm * BM + wr * 64 + fr, hc0 = u.pn * (BM / 2) + wc * 16 + 4 * fq;
#pragma unroll
        for (int ai = 0; ai < 2; ++ai)
#pragma unroll
            for (int m = 0; m < 4; ++m) { const int row = row0 + ai * HALF + m * 16; const float r = rms_r(rsq, row); bf16_t* rowp = H + (size_t)row * ldh + hc0;
#pragma unroll
                for (int bj = 0; bj < 2; ++bj) { const f32x4 g = acc[ai][bj][m][0] * r, up = acc[ai][bj][m][1] * r; float h[4];
#pragma unroll
                    for (int i = 0; i < 4; ++i) h[i] = g[i] * sigmoidf_(g[i]) * up[i];
                    typedef unsigned u32x2 __attribute__((ext_vector_type(2)));
                    u32x2 w; w.x = cvt_pk_bf16(h[0], h[1]); w.y = cvt_pk_bf16(h[2], h[3]);
                    *(u32x2*)(rowp + bj * (HALF / 2)) = w; } }
    }
};
struct EpiResN {
    static constexpr bool PERM = false, AFTER_DRAIN = false;
    const float* base; float* out; int ldc; bf16_t* XBo; float* rsq_out;
    __device__ __forceinline__ void operator()(const f32x4 (&acc)[2][2][4][2], const Unit& u, int wr, int wc, int fr, int fq) const {
        const int row0 = u.pm * BM + wr * 64 + fr, col0 = u.pn * BM + wc * 32 + 4 * fq;
#pragma unroll
        for (int ai = 0; ai < 2; ++ai)
#pragma unroll
            for (int m = 0; m < 4; ++m) { const int row = row0 + ai * HALF + m * 16; const size_t off = (size_t)row * ldc + col0; f32x4 x[2][2];
#pragma unroll
                for (int bj = 0; bj < 2; ++bj)
#pragma unroll
                    for (int n = 0; n < 2; ++n) { const f32x4 b = *(const f32x4*)(base + off + bj * HALF + n * 16); x[bj][n] = b + acc[ai][bj][m][n]; *(f32x4*)(out + off + bj * HALF + n * 16) = x[bj][n]; }
                if (XBo) norm_out(x, XBo, off, rsq_out, row, fq, u.pn * 4 + wc); }
    }
};
struct EpiPleN {
    static constexpr bool PERM = false, AFTER_DRAIN = false;
    const float* base; float* out; const bf16_t* E; int ldc; const float* rsq_in; bf16_t* XBo; float* rsq_out;
    __device__ __forceinline__ void operator()(const f32x4 (&acc)[2][2][4][2], const Unit& u, int wr, int wc, int fr, int fq) const {
        const int row0 = u.pm * BM + wr * 64 + fr, col0 = u.pn * BM + wc * 32 + 4 * fq;
        typedef unsigned u32x2 __attribute__((ext_vector_type(2)));
#pragma unroll
        for (int ai = 0; ai < 2; ++ai)
#pragma unroll
            for (int m = 0; m < 4; ++m) { const int row = row0 + ai * HALF + m * 16; const size_t off = (size_t)row * ldc + col0; const float r = rms_r(rsq_in, row); f32x4 x[2][2];
#pragma unroll
                for (int bj = 0; bj < 2; ++bj)
#pragma unroll
                    for (int n = 0; n < 2; ++n) { const size_t o = off + bj * HALF + n * 16; const f32x4 b = *(const f32x4*)(base + o); const u32x2 e = *(const u32x2*)(E + o); const f32x4 a = acc[ai][bj][m][n] * r;
                        f32x4 v; v[0] = b[0] + __uint_as_float(e.x << 16) * sigmoidf_(a[0]); v[1] = b[1] + __uint_as_float(e.x & 0xffff0000u) * sigmoidf_(a[1]);
                        v[2] = b[2] + __uint_as_float(e.y << 16) * sigmoidf_(a[2]); v[3] = b[3] + __uint_as_float(e.y & 0xffff0000u) * sigmoidf_(a[3]);
                        x[bj][n] = v; *(f32x4*)(out + o) = v; }
                if (XBo) norm_out(x, XBo, off, rsq_out, row, fq, u.pn * 4 + wc); }
    }
};
__device__ __forceinline__ f32x4 ld_base4(const float* p) { return *(const f32x4*)p; }
__device__ __forceinline__ f32x4 ld_base4(const bf16_t* p) { typedef unsigned u32x2 __attribute__((ext_vector_type(2))); const u32x2 e = *(const u32x2*)p; return (f32x4){__uint_as_float(e.x << 16), __uint_as_float(e.x & 0xffff0000u), __uint_as_float(e.y << 16), __uint_as_float(e.y & 0xffff0000u)}; }
template <class BaseT> struct EpiRes2 {
    static constexpr bool PERM = false, AFTER_DRAIN = false;
    const BaseT* base; bf16_t* out; int ldc; float* rsq_out;
    __device__ __forceinline__ void operator()(const f32x4 (&acc)[2][2][4][2], const Unit& u, int wr, int wc, int fr, int fq) const {
        const int row0 = u.pm * BM + wr * 64 + fr, col0 = u.pn * BM + wc * 32 + 4 * fq;
#pragma unroll
        for (int ai = 0; ai < 2; ++ai)
#pragma unroll
            for (int m = 0; m < 4; ++m) { const int row = row0 + ai * HALF + m * 16; const size_t off = (size_t)row * ldc + col0; f32x4 x[2][2];
#pragma unroll
                for (int bj = 0; bj < 2; ++bj)
#pragma unroll
                    for (int n = 0; n < 2; ++n) x[bj][n] = ld_base4(base + off + bj * HALF + n * 16) + acc[ai][bj][m][n];
                norm_out(x, out, off, rsq_out, row, fq, u.pn * 4 + wc); }
    }
};
template <bool OUT_F32> struct EpiPle2 {
    static constexpr bool PERM = false, AFTER_DRAIN = false;
    const bf16_t* base; void* out; const bf16_t* E; int ldc; const float* rsq_in; float* rsq_out;
    __device__ __forceinline__ void operator()(const f32x4 (&acc)[2][2][4][2], const Unit& u, int wr, int wc, int fr, int fq) const {
        const int row0 = u.pm * BM + wr * 64 + fr, col0 = u.pn * BM + wc * 32 + 4 * fq;
#pragma unroll
        for (int ai = 0; ai < 2; ++ai)
#pragma unroll
            for (int m = 0; m < 4; ++m) { const int row = row0 + ai * HALF + m * 16; const size_t off = (size_t)row * ldc + col0; const float r = rms_r(rsq_in, row); f32x4 x[2][2];
#pragma unroll
                for (int bj = 0; bj < 2; ++bj)
#pragma unroll
                    for (int n = 0; n < 2; ++n) { const size_t o = off + bj * HALF + n * 16; const f32x4 b = ld_base4(base + o), e = ld_base4(E + o), a = acc[ai][bj][m][n] * r; f32x4 v;
#pragma unroll
                        for (int i = 0; i < 4; ++i) v[i] = b[i] + e[i] * sigmoidf_(a[i]);
                        x[bj][n] = v; if (OUT_F32) *(f32x4*)((float*)out + o) = v; }
                if (!OUT_F32) norm_out(x, (bf16_t*)out, off, rsq_out, row, fq, u.pn * 4 + wc); }
    }
};
}
#ifndef PG8_SP2
#define PG8_SP2 true
#endif
#ifndef PG8_ALIGN
#define PG8_ALIGN true
#endif
constexpr int NB = 32, SEQ = 2048, T = NB * SEQ, D = 1024;
constexpr int NU = 2816, UA_W = 1024, UB_W = 1792;
constexpr int FF = 2816, CI = 2048, TH = T / 2;
constexpr int NWAVES = 8;
constexpr float NORM_EPS = 1e-6f, LOG2E = 1.4426950408889634f;
constexpr int UA_K = 512, UA_V = 576, UA_IQ = 640, UA_IK = 896, UA_IW = 960;
constexpr size_t MiB = 1u << 20, QMiB = 1u << 18;
constexpr size_t WS_CTL = 0, CTL_ZERO_BYTES = 1 * MiB;
constexpr size_t WS_WIN = 4 * QMiB, WS_WLORA = 26 * QMiB, WS_WOUT = 29 * QMiB;
constexpr size_t WS_WGU0 = 37 * QMiB, WS_WD0 = 81 * QMiB, WS_WPLE0 = 103 * QMiB, WS_WPG0 = 105 * QMiB, WS_LAYER_STRIDE = 76 * QMiB;
constexpr size_t WS_WUP = 189 * QMiB, WS_WDOWN = 221 * QMiB, WS_W12 = 237 * QMiB;
static_assert(WS_WPG0 + 8 * QMiB == WS_WGU0 + WS_LAYER_STRIDE && WS_WPG0 + WS_LAYER_STRIDE + 8 * QMiB == WS_WUP && WS_W12 + QMiB <= 60 * MiB, "weight map");
constexpr size_t ACT = 60 * MiB;
constexpr size_t WS_XB = ACT, WS_UA = ACT + 128 * MiB, WS_UB = ACT + 256 * MiB, WS_LIN = ACT + 480 * MiB, WS_LOUT = ACT + 512 * MiB;
constexpr size_t WS_QN = ACT + 704 * MiB, WS_KN = ACT + 768 * MiB, WS_VT = ACT + 776 * MiB, WS_MASK = ACT + 784 * MiB;
constexpr size_t WS_XB2 = ACT + 768 * MiB;
constexpr size_t WS_H = ACT + 128 * MiB, WS_E = ACT + 480 * MiB, WS_PB = ACT + 896 * MiB;
constexpr size_t WS_XM = ACT, WS_Z = ACT + 128 * MiB, WS_XC = ACT + 256 * MiB, WS_Q = ACT + 384 * MiB, WS_K = ACT + 512 * MiB, WS_V = ACT + 640 * MiB;
constexpr size_t WS_RS = ACT + 928 * MiB, RS_ONE = (size_t)T * 16 * 4;
constexpr size_t WS_GI = ACT + 952 * MiB, WS_GA = WS_GI + 1 * MiB, WS_GAM = WS_GI + 2 * MiB, WS_GEM = WS_GI + 3 * MiB;
constexpr size_t WS_END = ACT + 956 * MiB;
static_assert(WS_END <= 1024 * MiB, "workspace");
constexpr int CW_TMO = 0, CW_BAR = 4096, CW_XRANK = 8192;
constexpr int LDS_BYTES = 155648;
constexpr int MISC_OFF = LDS_BYTES - 256;
#define GAS __attribute__((address_space(1)))
#define LAS __attribute__((address_space(3)))
typedef unsigned short bf16;
typedef unsigned v4u __attribute__((ext_vector_type(4)));
typedef unsigned v2u __attribute__((ext_vector_type(2)));
typedef float f32x4 __attribute__((ext_vector_type(4)));
typedef float f32x2 __attribute__((ext_vector_type(2)));
typedef float f32x8 __attribute__((ext_vector_type(8)));
typedef short bf16x8 __attribute__((ext_vector_type(8)));
typedef short s16x4 __attribute__((ext_vector_type(4)));
typedef GAS unsigned gu32;
#define RLX_AGENT __ATOMIC_RELAXED, __HIP_MEMORY_SCOPE_AGENT
#define LDS_WAIT() asm volatile("s_waitcnt lgkmcnt(0)" ::: "memory")
#define VM_WAIT() asm volatile("s_waitcnt vmcnt(0)" ::: "memory")
__device__ __forceinline__ unsigned f2bf(float f) { unsigned u = __builtin_bit_cast(unsigned, f); return (u + 0x7fffu + ((u >> 16) & 1u)) >> 16; }

#define XB_TMO      128
#define XB_XCNT(j)  (256  + 64 * (j))
#define XB_XSUB(j)  (1280 + 64 * (j))
#define XB_XGEN(j)  (2304 + 64 * (j))
#define XB_TOP      3328
#define XB_TOPGEN   3392
#define XCD_BAR_WORDS 3456
#define XB_SPIN_CAP (1u << 18)

__device__ __forceinline__ unsigned xb_ld(unsigned* p)              { return __hip_atomic_load(p, __ATOMIC_RELAXED, __HIP_MEMORY_SCOPE_AGENT); }
__device__ __forceinline__ unsigned xb_add(unsigned* p, unsigned v) { return __hip_atomic_fetch_add(p, v, __ATOMIC_RELAXED, __HIP_MEMORY_SCOPE_AGENT); }
__device__ __forceinline__ unsigned xb_xcc_id() { return (unsigned)__builtin_amdgcn_s_getreg((3 << 11) | 20) & 0xFu; }
#define XB_SPIN(cond, bar) do { unsigned _sp = 0; while (cond) { __builtin_amdgcn_s_sleep(1); \
    if ((++_sp & 255u) == 0u) { if (xb_ld(&(bar)[XB_TMO])) break; if (_sp > XB_SPIN_CAP) { atomicAdd(&(bar)[XB_TMO], 1u); break; } } } } while (0)

struct XcdBarrier {
    unsigned* bar; unsigned x;
    volatile LAS unsigned* st;
};

__device__ __forceinline__ XcdBarrier xcd_barrier_post(unsigned* bar, volatile LAS unsigned* st) {
    XcdBarrier b; b.bar = bar; b.x = xb_xcc_id(); b.st = st;
    if (threadIdx.x == 0) (void)xb_add(&bar[XB_XCNT(b.x)], 1u);
    return b;
}
__device__ __forceinline__ void xcd_barrier_complete(unsigned* bar, unsigned x, unsigned& nloc, unsigned& nx) {
    const unsigned G = gridDim.x * gridDim.y * gridDim.z;
    unsigned sum, cnt, mine, sp = 0u;
    for (;;) {
        sum = 0u; cnt = 0u; mine = 0u;
#pragma unroll
        for (unsigned j = 0; j < 16; ++j) { const unsigned c = xb_ld(&bar[XB_XCNT(j)]); sum += c; cnt += (c > 0u) ? 1u : 0u; mine = (j == x) ? c : mine; }
        if (sum == G) break;
        __builtin_amdgcn_s_sleep(1);
        if ((++sp & 255u) == 0u) { if (xb_ld(&bar[XB_TMO])) break; if (sp > XB_SPIN_CAP) { atomicAdd(&bar[XB_TMO], 1u); break; } }
    }
    nloc = mine > 0u ? mine : 1u; nx = cnt > 0u ? cnt : 1u;
}

__device__ __forceinline__ void xcd_barrier(const XcdBarrier& b) {
    asm volatile("s_waitcnt vmcnt(0)" ::: "memory");
    __syncthreads();
    if (threadIdx.x == 0) {
        unsigned* bar = b.bar;
        __builtin_amdgcn_s_waitcnt(0);
        unsigned nloc = b.st[0], nx = b.st[1];
        if (nloc == 0u) { xcd_barrier_complete(bar, b.x, nloc, nx); b.st[0] = nloc; b.st[1] = nx; }
        const unsigned old = xb_add(&bar[XB_XSUB(b.x)], 1u);
        const unsigned gen = old / nloc;
        if (old + 1u == (gen + 1u) * nloc) {
            __builtin_amdgcn_fence(__ATOMIC_RELEASE, "agent");
            asm volatile("s_waitcnt vmcnt(0)" ::: "memory");
            const unsigned og = xb_add(&bar[XB_TOP], 1u);
            const unsigned tg = og / nx;
            if (og + 1u == (tg + 1u) * nx) xb_add(&bar[XB_TOPGEN], 1u);
            else XB_SPIN(xb_ld(&bar[XB_TOPGEN]) == tg, bar);
            __builtin_amdgcn_fence(__ATOMIC_ACQUIRE, "agent");
            xb_add(&bar[XB_XGEN(b.x)], 1u);
            asm volatile("s_waitcnt vmcnt(0)" ::: "memory");
        } else {
            XB_SPIN(xb_ld(&bar[XB_XGEN(b.x)]) == gen, bar);
            __builtin_amdgcn_fence(__ATOMIC_ACQUIRE, "agent");
            asm volatile("s_waitcnt vmcnt(0)" ::: "memory");
        }
    }
    __syncthreads();
}

struct Frame {
    LAS unsigned char* lds;
    unsigned char* ws;
    const float* const* in;
    int tid, lane, wave, G, bid;
};
struct Args { const float* in[37]; float* out; unsigned char* ws; int ph_lo, ph_hi, use_bar, pad; };

__device__ __forceinline__ float dpp_f(float v, int ctrl_qp1) { return v; }
#define DPP_MOVF(v, ctrl) __builtin_bit_cast(float, __builtin_amdgcn_mov_dpp(__builtin_bit_cast(int, (v)), (ctrl), 0xf, 0xf, true))
__device__ __forceinline__ float wave_sum(float v) {
    v += DPP_MOVF(v, 0xB1);
    v += DPP_MOVF(v, 0x4E);
    v += DPP_MOVF(v, 0x141);
    v += DPP_MOVF(v, 0x140);
    v += __shfl_xor(v, 16); v += __shfl_xor(v, 32);
    return v;
}
__device__ __forceinline__ float wave_max(float v) {
#pragma unroll
    for (int o = 1; o < 64; o <<= 1) v = fmaxf(v, __shfl_xor(v, o));
    return v;
}
__device__ __forceinline__ float bflo(unsigned u) { return __uint_as_float(u << 16); }
__device__ __forceinline__ float bfhi(unsigned u) { return __uint_as_float(u & 0xffff0000u); }
__device__ __forceinline__ float bf1(bf16 h) { return __uint_as_float(((unsigned)h) << 16); }
__device__ __forceinline__ unsigned pk2(float lo, float hi) { return pg8::cvt_pk_bf16(lo, hi); }
__device__ __forceinline__ float sigm(float x) { return __builtin_amdgcn_rcpf(1.0f + __builtin_amdgcn_exp2f(-LOG2E * x)); }
__device__ __forceinline__ float softplusf_(float x) { return fmaxf(x, 0.f) + log1pf(__expf(-fabsf(x))); }
__device__ __forceinline__ void unpack8(const v4u& r, float (&f)[8]) { f[0] = bflo(r.x); f[1] = bfhi(r.x); f[2] = bflo(r.y); f[3] = bfhi(r.y); f[4] = bflo(r.z); f[5] = bfhi(r.z); f[6] = bflo(r.w); f[7] = bfhi(r.w); }
__device__ __forceinline__ v4u pack8(const float (&f)[8]) { v4u o; o.x = pk2(f[0], f[1]); o.y = pk2(f[2], f[3]); o.z = pk2(f[4], f[5]); o.w = pk2(f[6], f[7]); return o; }

template <class Fn> __device__ __forceinline__ void wprep(bf16* dst, int N, int K, Fn f, int gt, int NT) {
    const int lane = gt & 63, gwv = gt >> 6, NW = NT >> 6, ntn = N >> 3, tiles = ntn * (K >> 6);
    for (int tl = gwv; tl < tiles; tl += NW) { const int n = (tl % ntn) * 8 + (lane & 7), k0 = (tl / ntn) * 64 + (lane >> 3) * 8; float v[8];
#pragma unroll
        for (int j = 0; j < 8; ++j) v[j] = f(k0 + j, n);
        *(v4u*)(dst + (size_t)n * K + k0) = pack8(v); }
}
template <class Fn> __device__ __forceinline__ void wprep_tile(bf16* dst, int N, int K, Fn f, int tl, int lane) {
    const int ntn = N >> 3; const int n = (tl % ntn) * 8 + (lane & 7), k0 = (tl / ntn) * 64 + (lane >> 3) * 8; float v[8];
#pragma unroll
    for (int j = 0; j < 8; ++j) v[j] = f(k0 + j, n);
    *(v4u*)(dst + (size_t)n * K + k0) = pack8(v);
}
constexpr int DT_WOUT = (D / 8) * (D / 64), DT_GU = (2 * FF / 8) * (D / 64), DT_WD = (D / 8) * (FF / 64), DT_PLE = (D / 8) * (256 / 64), DT_PG = (D / 8) * (D / 64), DT_LAYER = DT_GU + DT_WD + DT_PLE + DT_PG;
constexpr int DT_UP = (2 * CI / 8) * (D / 64), DT_DOWN = (D / 8) * (CI / 64), DT_TOTAL = DT_WOUT + 2 * DT_LAYER + DT_UP + DT_DOWN;
__device__ __forceinline__ void prep_deferred_tile(Frame& F, const Args& a, int tl) {
    unsigned char* ws = F.ws; const int lane = F.lane;
    if (tl < DT_WOUT) { const float* W = a.in[17]; wprep_tile((bf16*)(ws + WS_WOUT), D, D, [=](int k, int n) { return W[(size_t)k * D + n]; }, tl, lane); return; }
    tl -= DT_WOUT;
    if (tl < 2 * DT_LAYER) { const int L = tl >= DT_LAYER ? 1 : 0; tl -= L * DT_LAYER;
        const float* wg = a.in[31] + (size_t)L * D * FF; const float* wu = a.in[32] + (size_t)L * D * FF; const float* wd = a.in[33] + (size_t)L * FF * D;
        const float* wp = a.in[34] + (size_t)L * 256 * D; const float* wpg = a.in[36] + (size_t)L * D * D; const float* gnf = a.in[30] + L * D; const float* gnp = a.in[35] + L * D;
        if (tl < DT_GU) { wprep_tile((bf16*)(ws + WS_WGU0 + L * WS_LAYER_STRIDE), 2 * FF, D, [=](int k, int n) { const int hid = 16 * (n >> 5) + (n & 15); return ((n & 31) >= 16 ? wu : wg)[(size_t)k * FF + hid] * gnf[k]; }, tl, lane); return; }
        tl -= DT_GU;
        if (tl < DT_WD) { wprep_tile((bf16*)(ws + WS_WD0 + L * WS_LAYER_STRIDE), D, FF, [=](int k, int n) { return wd[(size_t)k * D + n]; }, tl, lane); return; }
        tl -= DT_WD;
        if (tl < DT_PLE) { wprep_tile((bf16*)(ws + WS_WPLE0 + L * WS_LAYER_STRIDE), D, 256, [=](int k, int n) { return wp[(size_t)k * D + n]; }, tl, lane); return; }
        tl -= DT_PLE;
        wprep_tile((bf16*)(ws + WS_WPG0 + L * WS_LAYER_STRIDE), D, D, [=](int k, int n) { return wpg[(size_t)k * D + n] * gnp[k]; }, tl, lane); return; }
    tl -= 2 * DT_LAYER;
    if (tl < DT_UP) { const float* W = a.in[18]; const float* gn1 = a.in[2] + D; wprep_tile((bf16*)(ws + WS_WUP), 2 * CI, D, [=](int k, int n) { return W[(size_t)k * (2 * CI) + n] * gn1[k]; }, tl, lane); return; }
    tl -= DT_UP;
    if (tl < DT_DOWN) { const float* W = a.in[29]; wprep_tile((bf16*)(ws + WS_WDOWN), D, CI, [=](int k, int n) { return W[(size_t)k * D + n]; }, tl, lane); }
}
__device__ __forceinline__ void phase_prologue(Frame& F, const Args& a) {
    const int gt = F.bid * 512 + F.tid, NT = F.G * 512; unsigned char* ws = F.ws;
    { const float* W = a.in[5]; const float* gn0 = a.in[2];
      wprep((bf16*)(ws + WS_WIN), NU, D, [=](int k, int n) { const int c = n < 964 ? n : (n < 1024 ? -1 : n - 60); return c < 0 ? 0.f : W[(size_t)k * 2756 + c] * gn0[k]; }, gt, NT); }
    { const float* w2 = a.in[8]; const float* a2 = a.in[10]; const float* g2 = a.in[11];
      wprep((bf16*)(ws + WS_WLORA), 1536, 256, [=](int k, int n) { if (n < 512) return k < 64 ? w2[k * 512 + n] : 0.f; if (n < 1024) return (k >= 64 && k < 128) ? a2[(k - 64) * 512 + n - 512] : 0.f; return k >= 128 ? g2[(k - 128) * 512 + n - 1024] : 0.f; }, gt, NT); }
    { const float* wq = a.in[21]; const float* wk = a.in[22]; const float* wv = a.in[23]; const float* wif = a.in[24]; float* W12 = (float*)(ws + WS_W12);
      for (int it = gt; it < 4096 * 8; it += NT) { const int o = it & 7, c = (it >> 3) & 2047, part = it >> 14, g = c >> 2, i = c & 3; float s = 0.f;
          if (part == 0) { for (int j = 0; j < 4; ++j) s += wq[(g * 4 + i) * 4 + j] * wif[(size_t)(4 * g + j) * 8 + o] + wk[(g * 4 + i) * 4 + j] * wif[(size_t)(2048 + 4 * g + j) * 8 + o]; }
          else { for (int j = 0; j < 4; ++j) s += wv[(g * 4 + i) * 4 + j] * wif[(size_t)(4096 + 4 * g + j) * 8 + o]; }
          W12[it] = s; } }
}
__device__ __forceinline__ void phase_norm(Frame& F, const float* src, const float* gain, bf16* dst, int nrows) {
    const int gw = F.bid * NWAVES + F.wave, NGW = F.G * NWAVES, lane = F.lane;
    f32x4 g[4];
#pragma unroll
    for (int j = 0; j < 4; ++j) g[j] = *((const f32x4*)gain + lane + 64 * j);
    for (int m = gw; m < nrows; m += NGW) {
        const f32x4* xr = (const f32x4*)(src + (size_t)m * D) + lane; f32x4 v[4]; float s = 0.f;
#pragma unroll
        for (int j = 0; j < 4; ++j) { v[j] = xr[64 * j]; s += (v[j].x * v[j].x + v[j].y * v[j].y) + (v[j].z * v[j].z + v[j].w * v[j].w); }
        const float r = rsqrtf(wave_sum(s) * (1.f / D) + NORM_EPS);
        v2u* o = (v2u*)(dst + (size_t)m * D) + lane;
#pragma unroll
        for (int j = 0; j < 4; ++j) { v2u w; w.x = pk2(v[j].x * r * g[j].x, v[j].y * r * g[j].y); w.y = pk2(v[j].z * r * g[j].z, v[j].w * r * g[j].w); o[64 * j] = w; }
    }
}
__device__ __forceinline__ void phase_cast_sq(Frame& F, const float* src, bf16* dst, float* rsq, int nrows) {
    const int gw = F.bid * NWAVES + F.wave, NGW = F.G * NWAVES, lane = F.lane;
    for (int m = gw; m < nrows; m += 2 * NGW) { const int m2 = m + NGW; const bool has2 = m2 < nrows;
        const f32x4* xr = (const f32x4*)(src + (size_t)m * D) + lane; const f32x4* xr2 = (const f32x4*)(src + (size_t)(has2 ? m2 : m) * D) + lane; f32x4 v[4], u[4]; float s = 0.f, s2 = 0.f;
#pragma unroll
        for (int j = 0; j < 4; ++j) { v[j] = xr[64 * j]; u[j] = xr2[64 * j]; }
#pragma unroll
        for (int j = 0; j < 4; ++j) { s += (v[j].x * v[j].x + v[j].y * v[j].y) + (v[j].z * v[j].z + v[j].w * v[j].w); s2 += (u[j].x * u[j].x + u[j].y * u[j].y) + (u[j].z * u[j].z + u[j].w * u[j].w); }
        s = wave_sum(s); s2 = wave_sum(s2);
        if (lane < 16) rsq[(size_t)m * 16 + lane] = lane == 0 ? s : 0.f;
        v2u* o = (v2u*)(dst + (size_t)m * D) + lane;
#pragma unroll
        for (int j = 0; j < 4; ++j) { v2u w; w.x = pk2(v[j].x, v[j].y); w.y = pk2(v[j].z, v[j].w); o[64 * j] = w; }
        if (has2) { if (lane < 16) rsq[(size_t)m2 * 16 + lane] = lane == 0 ? s2 : 0.f;
            v2u* o2 = (v2u*)(dst + (size_t)m2 * D) + lane;
#pragma unroll
            for (int j = 0; j < 4; ++j) { v2u w; w.x = pk2(u[j].x, u[j].y); w.y = pk2(u[j].z, u[j].w); o2[64 * j] = w; } }
    }
}
__device__ __forceinline__ void phase_cvt_p(Frame& F, const float* p, bf16* pb) {
    const size_t gt = (size_t)F.bid * 512 + F.tid, NT = (size_t)F.G * 512, n8 = (size_t)T * 256 / 8;
    for (size_t i0 = gt; i0 < n8; i0 += 4 * NT) { f32x4 a[4], b[4];
#pragma unroll
        for (int q4 = 0; q4 < 4; ++q4) { const size_t i = i0 + q4 * NT; if (i < n8) { a[q4] = *((const f32x4*)p + 2 * i); b[q4] = *((const f32x4*)p + 2 * i + 1); } }
#pragma unroll
        for (int q4 = 0; q4 < 4; ++q4) { const size_t i = i0 + q4 * NT; if (i < n8) { v4u o; o.x = pk2(a[q4].x, a[q4].y); o.y = pk2(a[q4].z, a[q4].w); o.z = pk2(b[q4].x, b[q4].y); o.w = pk2(b[q4].z, b[q4].w); *((v4u*)pb + i) = o; } } }
}
constexpr float QSCALE = 0.125f * LOG2E;
__device__ __forceinline__ void phase_prepA(Frame& F, const Args& a) {
    unsigned char* ws = F.ws; const bf16* UA = (const bf16*)(ws + WS_UA); const bf16* UB = (const bf16*)(ws + WS_UB);
    bf16* LIN = (bf16*)(ws + WS_LIN); bf16* QN = (bf16*)(ws + WS_QN); bf16* KN = (bf16*)(ws + WS_KN); bf16* VT = (bf16*)(ws + WS_VT);
    const float* mu = a.in[6]; const float* gq = a.in[3]; const float* gk = a.in[4];
    { const int gt = F.bid * 512 + F.tid, NT = F.G * 512; const int c8 = (gt & 31) << 3; float muv[8];
#pragma unroll
      for (int j = 0; j < 8; ++j) muv[j] = mu[1536 + c8 + j];
      for (int it0 = gt; it0 < T * 32; it0 += 4 * NT) { v4u ru[4], rp[4];
#pragma unroll
          for (int q4 = 0; q4 < 4; ++q4) { const int it = it0 + q4 * NT; if (it < T * 32) { const int t = it >> 5; ru[q4] = *(const v4u*)(UB + (size_t)t * UB_W + 1536 + c8); rp[q4] = *(const v4u*)(UB + (size_t)((t & (SEQ - 1)) ? t - 1 : t) * UB_W + 1536 + c8); } }
#pragma unroll
          for (int q4 = 0; q4 < 4; ++q4) { const int it = it0 + q4 * NT; if (it < T * 32) { const int t = it >> 5; float u[8], p[8], o[8]; unpack8(ru[q4], u); unpack8(rp[q4], p); const float pm = (t & (SEQ - 1)) ? 1.f : 0.f;
#pragma unroll
              for (int j = 0; j < 8; ++j) { const float s = u[j] + muv[j] * (p[j] * pm - u[j]); o[j] = c8 < 64 ? (1.0f - 2.0f * __builtin_amdgcn_rcpf(1.0f + __builtin_amdgcn_exp2f(2.0f * LOG2E * s))) : (c8 < 128 ? s : sigm(s));     }
              *(v4u*)(LIN + (size_t)t * 256 + c8) = pack8(o); } } } }
    { const int gw = F.bid * NWAVES + F.wave, NGW = F.G * NWAVES, lane = F.lane; float gqv[8], gkv[8];
#pragma unroll
      for (int j = 0; j < 8; ++j) { gqv[j] = gq[((lane & 7) << 3) + j] * QSCALE; gkv[j] = gk[((lane & 7) << 3) + j]; }
      for (int t0 = gw; t0 < T; t0 += 4 * NGW) { v4u rq[4], rk[4];
#pragma unroll
          for (int q4 = 0; q4 < 4; ++q4) { const int t = t0 + q4 * NGW; if (t < T) { rq[q4] = *(const v4u*)(UA + (size_t)t * UA_W + 8 * lane); rk[q4] = *(const v4u*)(UA + (size_t)t * UA_W + UA_K + 8 * (lane & 7)); } }
#pragma unroll
          for (int q4 = 0; q4 < 4; ++q4) { const int t = t0 + q4 * NGW; if (t < T) {
              float q[8], k[8]; unpack8(rq[q4], q); unpack8(rk[q4], k);
              float sq = 0.f, sk = 0.f;
#pragma unroll
              for (int j = 0; j < 8; ++j) { sq += q[j] * q[j]; sk += k[j] * k[j]; }
              sq += __shfl_xor(sq, 1); sq += __shfl_xor(sq, 2); sq += __shfl_xor(sq, 4); sk += __shfl_xor(sk, 1); sk += __shfl_xor(sk, 2); sk += __shfl_xor(sk, 4);
              const float rq_ = rsqrtf(sq * (1.f / 64.f) + NORM_EPS), rk_ = rsqrtf(sk * (1.f / 64.f) + NORM_EPS);
#pragma unroll
              for (int j = 0; j < 8; ++j) { q[j] *= rq_ * gqv[j]; k[j] *= rk_ * gkv[j]; }
              *(v4u*)(QN + (size_t)t * 512 + 8 * lane) = pack8(q);
              if (lane < 8) *(v4u*)(KN + (size_t)t * 64 + 8 * lane) = pack8(k); } } } }
    { const int gt = F.bid * 512 + F.tid, NT = F.G * 512;
      for (int it = gt; it < T * 8; it += NT) { const int t = it >> 3, c8 = (it & 7) << 3; *(v4u*)(VT + (size_t)t * 64 + c8) = *(const v4u*)(UA + (size_t)t * UA_W + UA_V + c8); } }
}
constexpr int IDX_STRIDE = 2052, KSEL = 256;
__device__ __forceinline__ void topk_select(const LAS float* row, int limit, unsigned* maskrow, int lane) {
    unsigned long long mybits = 0ull; const int nj = limit >> 6;
    if (limit <= KSEL) { mybits = lane < nj ? ~0ull : 0ull; }
    else {
        unsigned key[32];
#pragma unroll
        for (int j = 0; j < 32; ++j) key[j] = 0u;
#pragma unroll
        for (int g8 = 0; g8 < 4; ++g8) if (8 * g8 < nj) {
#pragma unroll
            for (int jj = 0; jj < 8; ++jj) { const int j = 8 * g8 + jj; unsigned u = __float_as_uint(row[64 * j + lane]); if (u == 0x80000000u) u = 0u; const unsigned k = (u & 0x80000000u) ? ~u : (u | 0x80000000u); key[j] = (j < nj) ? k : 0u; } }
        unsigned prefix = 0u; bool exact = false;
        for (int bit = 31; bit >= 0; --bit) { const unsigned cand = prefix | (1u << bit); int c0 = 0, c1 = 0;
#pragma unroll
            for (int g8 = 0; g8 < 4; ++g8) if (8 * g8 < nj) {
#pragma unroll
                for (int jj = 0; jj < 8; jj += 2) { c0 += __builtin_popcountll(__ballot(key[8 * g8 + jj] >= cand)); c1 += __builtin_popcountll(__ballot(key[8 * g8 + jj + 1] >= cand)); } }
            const int cnt = c0 + c1;
            if (cnt >= KSEL) { prefix = cand; if (cnt == KSEL) { exact = true; break; } } }
        int need = 0;
        if (!exact) { int cgt = 0;
#pragma unroll
            for (int j = 0; j < 32; ++j) cgt += __builtin_popcountll(__ballot(key[j] > prefix));
            need = KSEL - cgt; }
        int running = 0; const unsigned long long below = (1ull << lane) - 1ull;
#pragma unroll
        for (int g8 = 0; g8 < 4; ++g8) if (8 * g8 < nj)
#pragma unroll
        for (int jj = 0; jj < 8; ++jj) { const int j = 8 * g8 + jj;
            const bool gt = exact ? (key[j] >= prefix) : (key[j] > prefix); const bool tie = (!exact) && key[j] == prefix;
            const unsigned long long tb = __ballot(tie); const int rank = running + __builtin_popcountll(tb & below); running += __builtin_popcountll(tb);
            const unsigned long long sb = __ballot(gt || (tie && rank < need)); if (lane == j) mybits = sb; }
    }
    if (lane < 32) { v2u w; w.x = (unsigned)mybits; w.y = (unsigned)(mybits >> 32); *(v2u*)(maskrow + 2 * lane) = w; }
}
__device__ __forceinline__ void phase_indexer(Frame& F) {
    unsigned char* ws = F.ws; const bf16* UA = (const bf16*)(ws + WS_UA); unsigned* MASK = (unsigned*)(ws + WS_MASK);
    LAS float* sc = (LAS float*)F.lds; const int lane = F.lane, w = F.wave, fr = lane & 15, fq = lane >> 4;
    for (int r = 0;; ++r) { const int u = r * F.G + ((r & 1) ? (F.G - 1 - F.bid) : F.bid); if (u >= NB * 128) break;
        const int c = 31 - (u >> 7), rest = u & 127, b = rest >> 2, g4 = rest & 3, limit = 64 * (c + 1), tq0 = b * SEQ + c * 64 + g4 * 16;
        const bf16* UAb = UA + (size_t)b * SEQ * UA_W;
        bf16x8 qf[4][2]; float iwv[4];
        { const bf16* qp = UA + (size_t)(tq0 + fr) * UA_W;
#pragma unroll
          for (int hh = 0; hh < 4; ++hh) { qf[hh][0] = *(const bf16x8*)(qp + UA_IQ + hh * 64 + fq * 8); qf[hh][1] = *(const bf16x8*)(qp + UA_IQ + hh * 64 + 32 + fq * 8); iwv[hh] = bf1(qp[UA_IW + hh]) * (1.f / 16.f); } }
#ifndef IDX_SCORE_REP
#define IDX_SCORE_REP 1
#endif
#ifndef IDX_SEL_REP
#define IDX_SEL_REP 1
#endif
        for (int rp_ = 0; rp_ < IDX_SCORE_REP; ++rp_)
        for (int kt = w; kt < (limit >> 4); kt += NWAVES) {
            const bf16* kp = UAb + (size_t)(kt * 16 + fr) * UA_W + UA_IK + fq * 8; const bf16x8 a0 = *(const bf16x8*)kp, a1 = *(const bf16x8*)(kp + 32);
            f32x4 s = {0.f, 0.f, 0.f, 0.f};
#pragma unroll
            for (int hh = 0; hh < 4; ++hh) { f32x4 d = {0.f, 0.f, 0.f, 0.f}; d = __builtin_amdgcn_mfma_f32_16x16x32_bf16(a0, qf[hh][0], d, 0, 0, 0); d = __builtin_amdgcn_mfma_f32_16x16x32_bf16(a1, qf[hh][1], d, 0, 0, 0);
#pragma unroll
                for (int j = 0; j < 4; ++j) s[j] += iwv[hh] * fmaxf(d[j], 0.f); }
            *(LAS f32x4*)(sc + fr * IDX_STRIDE + kt * 16 + fq * 4) = s; }
        __syncthreads();
#pragma unroll 1
        for (int qq = 0; qq < 2 * IDX_SEL_REP; ++qq) { const int q = 2 * w + (qq & 1); topk_select(sc + q * IDX_STRIDE, limit, MASK + (size_t)(tq0 + q) * 64, lane); }
        __syncthreads(); }
}
constexpr int DA_K = 0, DA_V = 8192, DA_M = 16384, DA_STAGE = 16384 + 512;
__device__ __forceinline__ bf16x8 mk8(v2u lo, v2u hi) { v4u t; t.x = lo.x; t.y = lo.y; t.z = hi.x; t.w = hi.y; return __builtin_bit_cast(bf16x8, t); }
__device__ __forceinline__ void tr_read_v4d(unsigned a, bf16x8 (&vf)[4]) { s16x4 l0, h0, l1, h1, l2, h2, l3, h3;
    asm volatile("ds_read_b64_tr_b16 %0, %8\n\tds_read_b64_tr_b16 %1, %8 offset:512\n\tds_read_b64_tr_b16 %2, %8 offset:32\n\tds_read_b64_tr_b16 %3, %8 offset:544\n\t"
                 "ds_read_b64_tr_b16 %4, %8 offset:64\n\tds_read_b64_tr_b16 %5, %8 offset:576\n\tds_read_b64_tr_b16 %6, %8 offset:96\n\tds_read_b64_tr_b16 %7, %8 offset:608\n\ts_waitcnt lgkmcnt(0)"
                 : "=&v"(l0), "=&v"(h0), "=&v"(l1), "=&v"(h1), "=&v"(l2), "=&v"(h2), "=&v"(l3), "=&v"(h3) : "v"(a) : "memory");
    vf[0] = (bf16x8){l0[0], l0[1], l0[2], l0[3], h0[0], h0[1], h0[2], h0[3]}; vf[1] = (bf16x8){l1[0], l1[1], l1[2], l1[3], h1[0], h1[1], h1[2], h1[3]};
    vf[2] = (bf16x8){l2[0], l2[1], l2[2], l2[3], h2[0], h2[1], h2[2], h2[3]}; vf[3] = (bf16x8){l3[0], l3[1], l3[2], l3[3], h3[0], h3[1], h3[2], h3[3]}; }
__device__ __forceinline__ void phase_dsa_attn(Frame& F, const Args& a) {
    unsigned char* ws = F.ws; const bf16* QN = (const bf16*)(ws + WS_QN); const bf16* KN = (const bf16*)(ws + WS_KN); const bf16* VN = (const bf16*)(ws + WS_VT);
    const unsigned* MASK = (const unsigned*)(ws + WS_MASK); bf16* MIX = (bf16*)(ws + WS_XB);
    const int lane = F.lane, w = F.wave, fr = lane & 15, fq = lane >> 4; LAS unsigned char* lds = F.lds;
    const float mb = 8.f * LOG2E * wave_max(fabsf(a.in[3][lane])) * wave_max(fabsf(a.in[4][lane]));
    const unsigned vtr_lane = (unsigned)((8 * fq + ((lane & 15) >> 2)) * 128 + 4 * (lane & 3) * 2);
    for (int r = 0;; ++r) { const int u = r * F.G + ((r & 1) ? (F.G - 1 - F.bid) : F.bid); if (u >= NB * 32) break;
        const int c = 31 - (u >> 5), b = u & 31, nst = c + 1, t0 = b * SEQ + 64 * c;
        const bf16* Kb = KN + (size_t)b * SEQ * 64; const bf16* Vb = VN + (size_t)b * SEQ * 64; const unsigned* Mb = MASK + (size_t)t0 * 64;
#define DA_DMA(st_, buf_) do { const int so_ = (buf_) * DA_STAGE; \
            __builtin_amdgcn_global_load_lds((const unsigned*)(Kb + (size_t)(64 * (st_) + 8 * w) * 64 + lane * 8), (LAS unsigned*)(lds + so_ + DA_K + w * 1024), 16, 0, 0); \
            __builtin_amdgcn_global_load_lds((const unsigned*)(Vb + (size_t)(64 * (st_) + 8 * w) * 64 + lane * 8), (LAS unsigned*)(lds + so_ + DA_V + w * 1024), 16, 0, 0); \
            if (w < 2) __builtin_amdgcn_global_load_lds(Mb + (size_t)lane * 64 + 2 * (st_) + w, (LAS unsigned*)(lds + so_ + DA_M + w * 256), 4, 0, 0); } while (0)
        DA_DMA(0, 0);
        bf16x8 qf[4][2];
#pragma unroll
        for (int i = 0; i < 4; ++i) { const bf16* qp = QN + (size_t)(t0 + 16 * i + fr) * 512 + w * 64 + fq * 8; qf[i][0] = *(const bf16x8*)qp; qf[i][1] = *(const bf16x8*)(qp + 32); }
        f32x4 O[4][4]; float l[4];
#pragma unroll
        for (int i = 0; i < 4; ++i) { l[i] = 0.f;
#pragma unroll
            for (int dt = 0; dt < 4; ++dt) O[i][dt] = (f32x4){0.f, 0.f, 0.f, 0.f}; }
        for (int st = 0; st < nst; ++st) { const int buf = st & 1; const LAS unsigned char* sb = lds + buf * DA_STAGE;
            asm volatile("s_waitcnt vmcnt(0)" ::: "memory");
            __builtin_amdgcn_s_barrier(); asm volatile("" ::: "memory");
            if (st + 1 < nst) DA_DMA(st + 1, buf ^ 1);
#pragma unroll
            for (int sub = 0; sub < 2; ++sub) {
                bf16x8 kf[2][2], vf[4]; unsigned mw[4];
#pragma unroll
                for (int s2 = 0; s2 < 2; ++s2) { const LAS unsigned char* kp = sb + DA_K + (32 * sub + 8 * (fr >> 2) + 4 * s2 + (fr & 3)) * 128 + fq * 16;   kf[s2][0] = *(const LAS bf16x8*)kp; kf[s2][1] = *(const LAS bf16x8*)(kp + 64); }
#pragma unroll
                for (int i = 0; i < 4; ++i) mw[i] = *(const LAS unsigned*)(sb + DA_M + sub * 256 + (16 * i + fr) * 4);
                tr_read_v4d((unsigned)(size_t)(sb + DA_V + sub * 4096) + vtr_lane, vf);
#pragma unroll
                for (int i = 0; i < 4; ++i) {
                    f32x4 s0 = {0.f, 0.f, 0.f, 0.f}, s1 = {0.f, 0.f, 0.f, 0.f};
                    s0 = __builtin_amdgcn_mfma_f32_16x16x32_bf16(kf[0][0], qf[i][0], s0, 0, 0, 0); s0 = __builtin_amdgcn_mfma_f32_16x16x32_bf16(kf[0][1], qf[i][1], s0, 0, 0, 0);
                    s1 = __builtin_amdgcn_mfma_f32_16x16x32_bf16(kf[1][0], qf[i][0], s1, 0, 0, 0); s1 = __builtin_amdgcn_mfma_f32_16x16x32_bf16(kf[1][1], qf[i][1], s1, 0, 0, 0);
                    const unsigned b0 = mw[i] >> (8 * fq), b1 = mw[i] >> (8 * fq + 4); float p[8];
#pragma unroll
                    for (int j = 0; j < 4; ++j) { p[j] = ((b0 >> j) & 1u) ? __builtin_amdgcn_exp2f(s0[j] - mb) : 0.f; p[4 + j] = ((b1 >> j) & 1u) ? __builtin_amdgcn_exp2f(s1[j] - mb) : 0.f; }
                    l[i] += ((p[0] + p[1]) + (p[2] + p[3])) + ((p[4] + p[5]) + (p[6] + p[7]));
                    const bf16x8 pa = __builtin_bit_cast(bf16x8, pack8(p));
#pragma unroll
                    for (int dt = 0; dt < 4; ++dt) O[i][dt] = __builtin_amdgcn_mfma_f32_16x16x32_bf16(pa, vf[dt], O[i][dt], 0, 0, 0);
                } } }
#undef DA_DMA
#pragma unroll
        for (int i = 0; i < 4; ++i) { float li = l[i]; li += __shfl_xor(li, 16); li += __shfl_xor(li, 32);
#pragma unroll
            for (int j = 0; j < 4; ++j) { const float inv = 1.0f / __shfl(li, 4 * fq + j); bf16* op = MIX + (size_t)(t0 + 16 * i + 4 * fq + j) * D + w * 64 + fr;
#pragma unroll
                for (int dt = 0; dt < 4; ++dt) op[16 * dt] = (bf16)f2bf(O[i][dt][j] * inv); } }
        VM_WAIT(); __syncthreads();
    }
}
__device__ __forceinline__ float rw_decay(float x) { const float sp = fmaxf(-x, 0.f) + 0.6931471805599453f * __builtin_amdgcn_logf(1.0f + __builtin_amdgcn_exp2f(-LOG2E * fabsf(x)));
    return __builtin_amdgcn_exp2f(-LOG2E * __builtin_amdgcn_exp2f(-LOG2E * (sp + 0.5f))); }
#define MF32(a_, b_, c_) __builtin_amdgcn_mfma_f32_16x16x4f32((a_), (b_), (c_), 0, 0, 0)
constexpr int RT = 68, RG = 20, RGM = 16 * RG;
constexpr int RL_AH = 0, RL_BH = 64 * RT, RL_KH = 2 * 64 * RT, RL_RH = 3 * 64 * RT, RL_VX = 4 * 64 * RT, RL_GS = 5 * 64 * RT, RL_YA = 6 * 64 * RT, RL_GR = 7 * 64 * RT, RL_PM = RL_GR + 16 * RGM, RL_GC = RL_PM + 4 * RGM, RL_BON = RL_GC + 256, RL_END = RL_BON + 64;
static_assert(RL_END * 4 <= MISC_OFF, "RWKV LDS");
__device__ __forceinline__ void phase_rwkv(Frame& F, const Args& a) {
    unsigned char* ws = F.ws; const bf16* UB = (const bf16*)(ws + WS_UB); const bf16* LOUT = (const bf16*)(ws + WS_LOUT); bf16* MIX = (bf16*)(ws + WS_XB);
    const float* mu = a.in[6]; const float* w0 = a.in[7]; const float* a0 = a.in[9]; const float* k_k = a.in[12]; const float* k_a = a.in[13]; const float* r_k = a.in[14]; const float* gn_g = a.in[15]; const float* gn_b = a.in[16];
    const int lane = F.lane, w = F.wave, n = lane & 15, q = lane >> 4;
    LAS float* L = (LAS float*)F.lds;
    for (int bh = F.bid; bh < NB * 8; bh += F.G) {
        const int b = bh >> 3, h = bh & 7, c = h * 64 + lane;
        const float mur = mu[c], muk = mu[512 + c], muv = mu[1024 + c], w0c = w0[c], a0c = a0[c], kkc = k_k[c], kac = k_a[c], rkc = r_k[c], gng = gn_g[c], gnb = gn_b[c];
        f32x4 Z[4];
#pragma unroll
        for (int kt = 0; kt < 4; ++kt) Z[kt] = (f32x4){0.f, 0.f, 0.f, 0.f};
        const int ch = w >> 1, hs = w & 1;
        float r_ur[8], r_uk[8], r_uv[8], r_pr[8], r_pk[8], r_pv[8], r_wd[8], r_ad[8], r_gg[8], r_wf[8];
#define RW_RAW(batch_) do { _Pragma("unroll") for (int i = 0; i < 8; ++i) { const int sl = (batch_) * 64 + 16 * ch + 8 * hs + i; const size_t t = (size_t)b * SEQ + sl; const bf16* up = UB + t * UB_W + c; const bf16* pp_ = sl > 0 ? up - UB_W : up; \
            r_ur[i] = bf1(up[0]); r_uk[i] = bf1(up[512]); r_uv[i] = bf1(up[1024]); r_pr[i] = bf1(pp_[0]); r_pk[i] = bf1(pp_[512]); r_pv[i] = bf1(pp_[1024]); \
            const bf16* lp = LOUT + t * 1536 + c; r_wd[i] = bf1(lp[0]); r_ad[i] = bf1(lp[512]); r_gg[i] = bf1(lp[1024]); \
            r_wf[i] = bf1(LOUT[((size_t)b * SEQ + (batch_) * 64 + 16 * ch + i) * 1536 + c]); } } while (0)
        RW_RAW(0);
        for (int batch = 0; batch < SEQ / 64; ++batch) {
            { float gcur = 1.f;
              if (hs) {
#pragma unroll
                  for (int i = 0; i < 8; ++i) gcur *= rw_decay(w0c + r_wf[i]); }
#pragma unroll
              for (int i = 0; i < 8; ++i) { const int tl = 16 * ch + 8 * hs + i, sl = batch * 64 + tl; const float pm = sl > 0 ? 1.f : 0.f;
                const float ur = r_ur[i], uk = r_uk[i], uv = r_uv[i], pr = r_pr[i] * pm, pk = r_pk[i] * pm, pv = r_pv[i] * pm;
                const float rr = ur + mur * (pr - ur), kx = uk + muk * (pk - uk), vx = uv + muv * (pv - uv);
                const float decay = rw_decay(w0c + r_wd[i]), av = sigm(a0c + r_ad[i]);
                float kk = kx * kkc; kk = kk * rsqrtf(fmaxf(wave_sum(kk * kk), 1e-24f));
                const float km = kx * (1.f + (av - 1.f) * kac); const float bon = wave_sum(rr * km * rkc);
                const float gprev = gcur; gcur *= decay; const float ig = __builtin_amdgcn_rcpf(gcur);
                L[RL_AH + tl * RT + lane] = -kk * gprev; L[RL_BH + tl * RT + lane] = kk * av * ig; L[RL_KH + tl * RT + lane] = km * ig; L[RL_RH + tl * RT + lane] = rr * gcur;
                L[RL_VX + tl * RT + lane] = vx; L[RL_GS + tl * RT + lane] = r_gg[i]; if (lane == 0) L[RL_BON + tl] = bon; }
              if (hs) L[RL_GC + ch * 64 + lane] = gcur; }
            LDS_WAIT(); __syncthreads();
            if (batch + 1 < SEQ / 64) RW_RAW(batch + 1);
            { const LAS float* ah = L + RL_AH + 16 * ch * RT; const LAS float* bhm = L + RL_BH + 16 * ch * RT; const LAS float* khm = L + RL_KH + 16 * ch * RT; const LAS float* rhm = L + RL_RH + 16 * ch * RT;
              LAS float* gr = L + RL_GR + ch * 4 * RGM; LAS float* pm_ = L + RL_PM + ch * RGM;
              if (hs == 0) {
                  f32x4 m = {0.f, 0.f, 0.f, 0.f};
#pragma unroll
                  for (int s = 0; s < 16; ++s) m = MF32(bhm[n * RT + 4 * s + q], ah[n * RT + 4 * s + q], m);
                  f32x4 tm;
#pragma unroll
                  for (int j = 0; j < 4; ++j) { m[j] = (4 * q + j < n) ? m[j] : 0.f; tm[j] = m[j] + ((4 * q + j == n) ? 1.f : 0.f); pm_[(4 * q + j) * RG + n] = m[j]; gr[(4 * q + j) * RG + n] = tm[j]; }
#pragma unroll
                  for (int rd = 0; rd < 3; ++rd) { LDS_WAIT();
                      f32x4 p2 = {0.f, 0.f, 0.f, 0.f};
#pragma unroll
                      for (int s = 0; s < 4; ++s) p2 = MF32(pm_[n * RG + 4 * s + q], pm_[(4 * s + q) * RG + n], p2);
                      f32x4 ip, t2 = {0.f, 0.f, 0.f, 0.f};
#pragma unroll
                      for (int j = 0; j < 4; ++j) ip[j] = p2[j] + ((4 * q + j == n) ? 1.f : 0.f);
#pragma unroll
                      for (int j = 0; j < 4; ++j) t2 = MF32(gr[n * RG + 4 * q + j], ip[j], t2);
                      LDS_WAIT();
#pragma unroll
                      for (int j = 0; j < 4; ++j) { pm_[(4 * q + j) * RG + n] = p2[j]; gr[(4 * q + j) * RG + n] = t2[j]; } }
              } else {
                  f32x4 mk = {0.f, 0.f, 0.f, 0.f}, nb = {0.f, 0.f, 0.f, 0.f}, nk = {0.f, 0.f, 0.f, 0.f};
#pragma unroll
                  for (int s = 0; s < 16; ++s) { const float av_ = ah[n * RT + 4 * s + q], rv_ = rhm[n * RT + 4 * s + q], bv_ = bhm[n * RT + 4 * s + q], kv_ = khm[n * RT + 4 * s + q];
                      mk = MF32(kv_, av_, mk); nb = MF32(bv_, rv_, nb); nk = MF32(kv_, rv_, nk); }
#pragma unroll
                  for (int j = 0; j < 4; ++j) { const int s_ = 4 * q + j; gr[RGM + s_ * RG + n] = (s_ < n) ? mk[j] : 0.f; gr[2 * RGM + s_ * RG + n] = (s_ <= n) ? nb[j] : 0.f; gr[3 * RGM + s_ * RG + n] = (s_ <= n) ? nk[j] : 0.f; } } }
            LDS_WAIT(); __syncthreads();
#ifndef RW_C_REP
#define RW_C_REP 1
#endif
            if (w < 4) { const int v = 16 * w + n; f32x4 Zs[4]; for (int kt = 0; kt < 4; ++kt) Zs[kt] = Z[kt];
              for (int rc_ = 0; rc_ < RW_C_REP; ++rc_) { if (rc_) for (int kt = 0; kt < 4; ++kt) Z[kt] = Zs[kt];
#pragma unroll 1
                for (int cc = 0; cc < 4; ++cc) { const LAS float* ah = L + RL_AH + 16 * cc * RT; const LAS float* bhm = L + RL_BH + 16 * cc * RT; const LAS float* khm = L + RL_KH + 16 * cc * RT; const LAS float* rhm = L + RL_RH + 16 * cc * RT;
                    const LAS float* vx = L + RL_VX + 16 * cc * RT; const LAS float* gr = L + RL_GR + cc * 4 * RGM;
                    float vb[4];
#pragma unroll
                    for (int s = 0; s < 4; ++s) vb[s] = vx[(4 * s + q) * RT + v];
                    f32x4 X = {0.f, 0.f, 0.f, 0.f}, Y = {0.f, 0.f, 0.f, 0.f};
#pragma unroll
                    for (int p = 0; p < 2; ++p) { asm volatile("" ::: "memory"); const f32x4 r0 = *(const LAS f32x4*)(rhm + n * RT + 32 * p + 4 * q), r1 = *(const LAS f32x4*)(rhm + n * RT + 32 * p + 16 + 4 * q);
                        v4u ap, bp; ap.x = pk2(r0[0], r0[1]); ap.y = pk2(r0[2], r0[3]); ap.z = pk2(r1[0], r1[1]); ap.w = pk2(r1[2], r1[3]);
                        bp.x = pk2(Z[2 * p][0], Z[2 * p][1]); bp.y = pk2(Z[2 * p][2], Z[2 * p][3]); bp.z = pk2(Z[2 * p + 1][0], Z[2 * p + 1][1]); bp.w = pk2(Z[2 * p + 1][2], Z[2 * p + 1][3]);
                        Y = __builtin_amdgcn_mfma_f32_16x16x32_bf16(__builtin_bit_cast(bf16x8, ap), __builtin_bit_cast(bf16x8, bp), Y, 0, 0, 0); }
                    __builtin_amdgcn_sched_barrier(0);
#pragma unroll
                    for (int kt = 0; kt < 4; ++kt)
#pragma unroll
                        for (int j = 0; j < 4; ++j) X = MF32(ah[n * RT + 16 * kt + 4 * q + j], Z[kt][j], X);
#pragma unroll
                    for (int s = 0; s < 4; ++s) X = MF32(gr[RGM + (4 * s + q) * RG + n], vb[s], X);
                    f32x4 U = {0.f, 0.f, 0.f, 0.f};
#pragma unroll
                    for (int j = 0; j < 4; ++j) U = MF32(gr[(4 * q + j) * RG + n], X[j], U);
                    { v4u ap, bp; ap.x = pk2(gr[2 * RGM + (4 * q) * RG + n], gr[2 * RGM + (4 * q + 1) * RG + n]); ap.y = pk2(gr[2 * RGM + (4 * q + 2) * RG + n], gr[2 * RGM + (4 * q + 3) * RG + n]);
                      ap.z = pk2(gr[3 * RGM + q * RG + n], gr[3 * RGM + (4 + q) * RG + n]); ap.w = pk2(gr[3 * RGM + (8 + q) * RG + n], gr[3 * RGM + (12 + q) * RG + n]);
                      bp.x = pk2(U[0], U[1]); bp.y = pk2(U[2], U[3]); bp.z = pk2(vb[0], vb[1]); bp.w = pk2(vb[2], vb[3]);
                      Y = __builtin_amdgcn_mfma_f32_16x16x32_bf16(__builtin_bit_cast(bf16x8, ap), __builtin_bit_cast(bf16x8, bp), Y, 0, 0, 0); }
#pragma unroll
                    for (int j = 0; j < 4; ++j) L[RL_YA + (16 * cc + 4 * q + j) * RT + v] = Y[j];
#pragma unroll
                    for (int kt = 0; kt < 4; ++kt) {
#pragma unroll
                        for (int j = 0; j < 4; ++j) Z[kt] = MF32(bhm[(4 * q + j) * RT + 16 * kt + n], U[j], Z[kt]);
#pragma unroll
                        for (int s = 0; s < 4; ++s) Z[kt] = MF32(khm[(4 * s + q) * RT + 16 * kt + n], vb[s], Z[kt]);
                        const f32x4 gc = *(const LAS f32x4*)(L + RL_GC + cc * 64 + 16 * kt + 4 * q); Z[kt] = Z[kt] * gc; } } } }
            else if (F.G == 256) {
#pragma unroll 1
                for (int i2 = 0; i2 < 2; ++i2) { const int tl = (2 * batch + i2) * 1024 + F.bid * 4 + (w - 4); if (tl < DT_TOTAL) prep_deferred_tile(F, a, tl); }
                { const size_t i = ((size_t)(batch * 1024 + F.bid * 4 + (w - 4))) * 64 + lane;
                  const float* p0 = a.in[1]; const f32x4 pa = *((const f32x4*)p0 + 2 * i), pb = *((const f32x4*)p0 + 2 * i + 1); v4u o; o.x = pk2(pa.x, pa.y); o.y = pk2(pa.z, pa.w); o.z = pk2(pb.x, pb.y); o.w = pk2(pb.z, pb.w); *((v4u*)(ws + WS_PB) + i) = o; } }
            LDS_WAIT(); __syncthreads();
#pragma unroll
            for (int i = 0; i < 8; ++i) { const int step = w + 8 * i; const size_t t = (size_t)b * SEQ + batch * 64 + step;
                const float y = L[RL_YA + step * RT + lane], mean = wave_sum(y) * (1.f / 64.f), dlt = y - mean, var = fmaxf(wave_sum(y * y) * (1.f / 64.f) - mean * mean, 0.f);
                const float yn = dlt * rsqrtf(var + 64e-5f) * gng + gnb; const float o = (yn + L[RL_BON + step] * L[RL_VX + step * RT + lane]) * L[RL_GS + step * RT + lane];
                MIX[t * D + 512 + c] = (bf16)f2bf(o); }
            LDS_WAIT(); __syncthreads();
        }
#undef RW_RAW
    }
}
__device__ __forceinline__ void phase_l1prep(Frame& F, const Args& a, int hb) {
    unsigned char* ws = F.ws; const bf16* XM = (const bf16*)(ws + WS_XM); bf16* XC = (bf16*)(ws + WS_XC); bf16* Q = (bf16*)(ws + WS_Q); bf16* K = (bf16*)(ws + WS_K); bf16* V = (bf16*)(ws + WS_V);
    float* GI = (float*)(ws + WS_GI); const float* W12 = (const float*)(ws + WS_W12);
    const float* cw = a.in[19]; const float* cb = a.in[20]; const float* wq = a.in[21]; const float* wk = a.in[22]; const float* wv = a.in[23]; const float* b_i = a.in[25]; const float* b_f = a.in[26];
    const int g = F.tid, lane = F.lane, w = F.wave; LAS float* red = (LAS float*)F.lds;
    float cwr[4][4], cbr[4], wqr[16], wkr[16], wvr[16], w1[32], w2[32];
#pragma unroll
    for (int j = 0; j < 4; ++j)
#pragma unroll
        for (int i = 0; i < 4; ++i) cwr[j][i] = cw[j * CI + 4 * g + i];
#pragma unroll
    for (int i = 0; i < 4; ++i) cbr[i] = cb[4 * g + i];
#pragma unroll
    for (int i = 0; i < 16; ++i) { wqr[i] = wq[g * 16 + i]; wkr[i] = wk[g * 16 + i]; wvr[i] = wv[g * 16 + i]; }
#pragma unroll
    for (int i = 0; i < 32; ++i) { w1[i] = W12[(size_t)(4 * g) * 8 + i]; w2[i] = W12[(size_t)(2048 + 4 * g) * 8 + i]; }
    float wqk[16];
#pragma unroll
    for (int i = 0; i < 4; ++i)
#pragma unroll
        for (int ip = 0; ip < 4; ++ip) { float sacc = 0.f;
#pragma unroll
            for (int m = 0; m < 4; ++m) sacc = fmaf(wqr[4 * i + m], wkr[4 * ip + m], sacc);
            wqk[4 * i + ip] = sacc * 0.044194173824159216f; }
    const int per = TH / F.G;
    const int tb = F.bid * per;
    float x0[4], x1[4], x2[4];
    { const int sl = tb & (SEQ - 1);
#pragma unroll
      for (int i = 0; i < 4; ++i) { x0[i] = 0.f; x1[i] = 0.f; x2[i] = 0.f; }
      if (sl >= 1) { const v2u r = *(const v2u*)(XM + (size_t)(tb - 1) * CI + 4 * g); x2[0] = bflo(r.x); x2[1] = bfhi(r.x); x2[2] = bflo(r.y); x2[3] = bfhi(r.y); }
      if (sl >= 2) { const v2u r = *(const v2u*)(XM + (size_t)(tb - 2) * CI + 4 * g); x1[0] = bflo(r.x); x1[1] = bfhi(r.x); x1[2] = bflo(r.y); x1[3] = bfhi(r.y); }
      if (sl >= 3) { const v2u r = *(const v2u*)(XM + (size_t)(tb - 3) * CI + 4 * g); x0[0] = bflo(r.x); x0[1] = bfhi(r.x); x0[2] = bflo(r.y); x0[3] = bfhi(r.y); } }
    constexpr int L1PF = 4;
    v2u xq[L1PF][2];
#pragma unroll
    for (int pq = 0; pq < L1PF; ++pq)
#pragma unroll
        for (int tk = 0; tk < 2; ++tk) xq[pq][tk] = *(const v2u*)(XM + (size_t)(tb + 2 * pq + tk) * CI + 4 * g);
    for (int n4 = 0; n4 < per / 2; ++n4) { const int t4 = tb + 2 * n4;
        float gs[16]; v2u xr[2];
        xr[0] = xq[0][0]; xr[1] = xq[0][1];
#pragma unroll
        for (int pq = 0; pq + 1 < L1PF; ++pq) { xq[pq][0] = xq[pq + 1][0]; xq[pq][1] = xq[pq + 1][1]; }
        { const int tn = (n4 + L1PF < per / 2) ? t4 + 2 * L1PF : t4;
#pragma unroll
          for (int tk = 0; tk < 2; ++tk) xq[L1PF - 1][tk] = *(const v2u*)(XM + (size_t)(tn + tk) * CI + 4 * g); }
#pragma unroll
        for (int tk = 0; tk < 2; ++tk) { const int t = t4 + tk;
            float x3[4]; x3[0] = bflo(xr[tk].x); x3[1] = bfhi(xr[tk].x); x3[2] = bflo(xr[tk].y); x3[3] = bfhi(xr[tk].y);
            float xc[4], q[4];
#pragma unroll
            for (int i = 0; i < 4; ++i) { const float s = fmaf(cwr[3][i], x3[i], fmaf(cwr[2][i], x2[i], fmaf(cwr[1][i], x1[i], fmaf(cwr[0][i], x0[i], cbr[i])))); xc[i] = s * sigm(s); }
#pragma unroll
            for (int j = 0; j < 4; ++j) q[j] = fmaf(xc[3], wqk[12 + j], fmaf(xc[2], wqk[8 + j], fmaf(xc[1], wqk[4 + j], xc[0] * wqk[j])));
#pragma unroll
            for (int o = 0; o < 8; ++o) { float s = 0.f;
#pragma unroll
                for (int i = 0; i < 4; ++i) s = fmaf(x3[i], w2[i * 8 + o], fmaf(xc[i], w1[i * 8 + o], s));
                gs[tk * 8 + o] = s; }
            const size_t off = (size_t)t * CI + 4 * g;
            { v2u o; o.x = pk2(xc[0], xc[1]); o.y = pk2(xc[2], xc[3]); *(v2u*)(XC + off) = o; o.x = pk2(q[0], q[1]); o.y = pk2(q[2], q[3]); *(v2u*)(Q + off) = o; }
#pragma unroll
            for (int i = 0; i < 4; ++i) { x0[i] = x1[i]; x1[i] = x2[i]; x2[i] = x3[i]; } }
#define L1_STAGE(mask, n) { const bool hi_ = (lane & (mask)) != 0; _Pragma("unroll") for (int i = 0; i < (n) / 2; ++i) { const float send_ = hi_ ? gs[i] : gs[(n) / 2 + i]; const float keep_ = hi_ ? gs[(n) / 2 + i] : gs[i]; gs[i] = keep_ + __shfl_xor(send_, (mask)); } }
        L1_STAGE(32, 16) L1_STAGE(16, 8) L1_STAGE(8, 4) L1_STAGE(4, 2)
#undef L1_STAGE
        gs[0] += __shfl_xor(gs[0], 2); gs[0] += __shfl_xor(gs[0], 1);
        LAS float* rp = red + (n4 & 1) * 128;
        if ((lane & 3) == 0) rp[w * 16 + (lane >> 2)] = gs[0];
        LDS_WAIT(); __syncthreads();
        if (F.tid < 16) { float s = 0.f;
#pragma unroll
            for (int ww = 0; ww < 8; ++ww) s += rp[ww * 16 + F.tid];
            const int o = F.tid & 7; GI[(size_t)(t4 + (F.tid >> 3)) * 8 + o] = s + (o < 4 ? b_i[o] : b_f[o - 4]); }
    }
}
__device__ __forceinline__ void phase_gatescan(Frame& F) {
    unsigned char* ws = F.ws; const float* GI = (const float*)(ws + WS_GI); float* GA = (float*)(ws + WS_GA); float* GAM = (float*)(ws + WS_GAM); float* GEM = (float*)(ws + WS_GEM);
    const int lane = F.lane, w = F.wave, tid = F.tid; LAS float* wtot = (LAS float*)F.lds;
    for (int sq = F.bid; sq < (NB / 2) * 4; sq += F.G) { const int bl = sq >> 2, h = sq & 3; const size_t tq = (size_t)bl * SEQ + 4 * tid;
        float ip[4], c[4];
#pragma unroll
        for (int k = 0; k < 4; ++k) { ip[k] = GI[(tq + k) * 8 + h]; c[k] = -softplusf_(-GI[(tq + k) * 8 + 4 + h]); }
        c[1] += c[0]; c[2] += c[1]; c[3] += c[2];
        float inc = c[3];
#pragma unroll
        for (int o = 1; o < 64; o <<= 1) { const float n = __shfl_up(inc, o); if (lane >= o) inc += n; }
        if (lane == 63) wtot[w] = inc;
        LDS_WAIT(); __syncthreads();
        float off = inc - c[3];
#pragma unroll
        for (int ww = 0; ww < 8; ++ww) if (ww < w) off += wtot[ww];
        float Fv[4], av[4], m[4];
#pragma unroll
        for (int k = 0; k < 4; ++k) { Fv[k] = off + c[k]; av[k] = ip[k] - Fv[k]; }
        m[0] = av[0]; m[1] = fmaxf(m[0], av[1]); m[2] = fmaxf(m[1], av[2]); m[3] = fmaxf(m[2], av[3]);
        float incm = m[3];
#pragma unroll
        for (int o = 1; o < 64; o <<= 1) { const float n = __shfl_up(incm, o); if (lane >= o) incm = fmaxf(incm, n); }
        if (lane == 63) wtot[8 + w] = incm;
        LDS_WAIT(); __syncthreads();
        float offm = __shfl_up(incm, 1); if (lane == 0) offm = -INFINITY;
#pragma unroll
        for (int ww = 0; ww < 8; ++ww) if (ww < w) offm = fmaxf(offm, wtot[8 + ww]);
#pragma unroll
        for (int k = 0; k < 4; ++k) { const float A = fmaxf(offm, m[k]); GA[(tq + k) * 4 + h] = av[k]; GAM[(tq + k) * 4 + h] = A; GEM[(tq + k) * 4 + h] = __expf(-(Fv[k] + A)); }
        LDS_WAIT(); __syncthreads();
    }
}
constexpr int ML_PITCH = 1040, ML_TILE = 32 * ML_PITCH, ML_PP = 80, ML_PT = 64 * ML_PP;
constexpr int ML_K = 0, ML_V = 2 * ML_TILE, ML_P = 4 * ML_TILE, ML_DEN = ML_P + 2 * ML_PT, ML_AT = ML_DEN + 512, ML_AS = ML_AT + 256, ML_END = ML_AS + 8192;
constexpr int ML_ST = ML_P, ML_MR = ML_P + 4096;
static_assert(ML_MR + 512 <= ML_DEN, "mLSTM LDS tables");
static_assert(ML_END <= MISC_OFF, "mLSTM LDS");
__device__ __forceinline__ void tr_read_v4(unsigned a, bf16x8 (&vf)[4]) { s16x4 l0, h0, l1, h1, l2, h2, l3, h3;
    asm volatile("ds_read_b64_tr_b16 %0, %8\n\tds_read_b64_tr_b16 %1, %8 offset:4160\n\tds_read_b64_tr_b16 %2, %8 offset:32\n\tds_read_b64_tr_b16 %3, %8 offset:4192\n\t"
                 "ds_read_b64_tr_b16 %4, %8 offset:64\n\tds_read_b64_tr_b16 %5, %8 offset:4224\n\tds_read_b64_tr_b16 %6, %8 offset:96\n\tds_read_b64_tr_b16 %7, %8 offset:4256\n\ts_waitcnt lgkmcnt(0)"
                 : "=&v"(l0), "=&v"(h0), "=&v"(l1), "=&v"(h1), "=&v"(l2), "=&v"(h2), "=&v"(l3), "=&v"(h3) : "v"(a) : "memory");
    vf[0] = (bf16x8){l0[0], l0[1], l0[2], l0[3], h0[0], h0[1], h0[2], h0[3]}; vf[1] = (bf16x8){l1[0], l1[1], l1[2], l1[3], h1[0], h1[1], h1[2], h1[3]};
    vf[2] = (bf16x8){l2[0], l2[1], l2[2], l2[3], h2[0], h2[1], h2[2], h2[3]}; vf[3] = (bf16x8){l3[0], l3[1], l3[2], l3[3], h3[0], h3[1], h3[2], h3[3]}; }
static_assert(4 * ML_PITCH == 4160, "tr_read_v4 offsets");
__device__ __forceinline__ void tr_read_v8(unsigned a, bf16x8 (&vf)[8]) { s16x4 l0, h0, l1, h1, l2, h2, l3, h3, l4, h4, l5, h5, l6, h6, l7, h7;
    asm volatile("ds_read_b64_tr_b16 %0, %16\n\tds_read_b64_tr_b16 %1, %16 offset:4160\n\tds_read_b64_tr_b16 %2, %16 offset:32\n\tds_read_b64_tr_b16 %3, %16 offset:4192\n\t"
                 "ds_read_b64_tr_b16 %4, %16 offset:64\n\tds_read_b64_tr_b16 %5, %16 offset:4224\n\tds_read_b64_tr_b16 %6, %16 offset:96\n\tds_read_b64_tr_b16 %7, %16 offset:4256\n\t"
                 "ds_read_b64_tr_b16 %8, %16 offset:128\n\tds_read_b64_tr_b16 %9, %16 offset:4288\n\tds_read_b64_tr_b16 %10, %16 offset:160\n\tds_read_b64_tr_b16 %11, %16 offset:4320\n\t"
                 "ds_read_b64_tr_b16 %12, %16 offset:192\n\tds_read_b64_tr_b16 %13, %16 offset:4352\n\tds_read_b64_tr_b16 %14, %16 offset:224\n\tds_read_b64_tr_b16 %15, %16 offset:4384\n\ts_waitcnt lgkmcnt(0)"
                 : "=&v"(l0), "=&v"(h0), "=&v"(l1), "=&v"(h1), "=&v"(l2), "=&v"(h2), "=&v"(l3), "=&v"(h3), "=&v"(l4), "=&v"(h4), "=&v"(l5), "=&v"(h5), "=&v"(l6), "=&v"(h6), "=&v"(l7), "=&v"(h7) : "v"(a) : "memory");
    vf[0] = (bf16x8){l0[0], l0[1], l0[2], l0[3], h0[0], h0[1], h0[2], h0[3]}; vf[1] = (bf16x8){l1[0], l1[1], l1[2], l1[3], h1[0], h1[1], h1[2], h1[3]};
    vf[2] = (bf16x8){l2[0], l2[1], l2[2], l2[3], h2[0], h2[1], h2[2], h2[3]}; vf[3] = (bf16x8){l3[0], l3[1], l3[2], l3[3], h3[0], h3[1], h3[2], h3[3]};
    vf[4] = (bf16x8){l4[0], l4[1], l4[2], l4[3], h4[0], h4[1], h4[2], h4[3]}; vf[5] = (bf16x8){l5[0], l5[1], l5[2], l5[3], h5[0], h5[1], h5[2], h5[3]};
    vf[6] = (bf16x8){l6[0], l6[1], l6[2], l6[3], h6[0], h6[1], h6[2], h6[3]}; vf[7] = (bf16x8){l7[0], l7[1], l7[2], l7[3], h7[0], h7[1], h7[2], h7[3]}; }
struct PvOps { bf16x8 p0, p1, p2, p3; s16x4 l0, h0, l1, h1, l2, h2, l3, h3, l4, h4, l5, h5, l6, h6, l7, h7; };
__device__ __forceinline__ void pv_issue(unsigned pa, unsigned va, PvOps& o) {
    asm volatile("ds_read_b128 %0, %20\n\tds_read_b128 %1, %20 offset:1280\n\tds_read_b128 %2, %20 offset:2560\n\tds_read_b128 %3, %20 offset:3840\n\t"
                 "ds_read_b64_tr_b16 %4, %21\n\tds_read_b64_tr_b16 %5, %21 offset:4160\n\tds_read_b64_tr_b16 %6, %21 offset:32\n\tds_read_b64_tr_b16 %7, %21 offset:4192\n\t"
                 "ds_read_b64_tr_b16 %8, %21 offset:64\n\tds_read_b64_tr_b16 %9, %21 offset:4224\n\tds_read_b64_tr_b16 %10, %21 offset:96\n\tds_read_b64_tr_b16 %11, %21 offset:4256\n\t"
                 "ds_read_b64_tr_b16 %12, %21 offset:128\n\tds_read_b64_tr_b16 %13, %21 offset:4288\n\tds_read_b64_tr_b16 %14, %21 offset:160\n\tds_read_b64_tr_b16 %15, %21 offset:4320\n\t"
                 "ds_read_b64_tr_b16 %16, %21 offset:192\n\tds_read_b64_tr_b16 %17, %21 offset:4352\n\tds_read_b64_tr_b16 %18, %21 offset:224\n\tds_read_b64_tr_b16 %19, %21 offset:4384"
                 : "=&v"(o.p0), "=&v"(o.p1), "=&v"(o.p2), "=&v"(o.p3), "=&v"(o.l0), "=&v"(o.h0), "=&v"(o.l1), "=&v"(o.h1), "=&v"(o.l2), "=&v"(o.h2), "=&v"(o.l3), "=&v"(o.h3),
                   "=&v"(o.l4), "=&v"(o.h4), "=&v"(o.l5), "=&v"(o.h5), "=&v"(o.l6), "=&v"(o.h6), "=&v"(o.l7), "=&v"(o.h7) : "v"(pa), "v"(va) : "memory"); }
#define pv_wait(o_) do { __builtin_amdgcn_sched_barrier(0); asm volatile("s_waitcnt lgkmcnt(0)" ::: "memory"); __builtin_amdgcn_sched_barrier(0); } while (0)
#define PV_CAT(l_, h_) ((bf16x8){(l_)[0], (l_)[1], (l_)[2], (l_)[3], (h_)[0], (h_)[1], (h_)[2], (h_)[3]})
static_assert(16 * ML_PP == 1280, "pv_issue offsets");
template <int PB> __device__ __forceinline__ void phase_mlstm_t(Frame& F, const Args& a) {
    constexpr bool skK = PB & 1, skV = PB & 2, skS = PB & 4, skP = PB & 8, skE = PB & 16;
    unsigned char* ws = F.ws; const bf16* Q = (const bf16*)(ws + WS_Q); const bf16* K = (const bf16*)(ws + WS_XC); const bf16* V = (const bf16*)(ws + WS_XM); const bf16* XC = (const bf16*)(ws + WS_XC); const bf16* Z = (const bf16*)(ws + WS_Z);
    bf16* YC = (bf16*)(ws + WS_V); const float* GA = (const float*)(ws + WS_GA); const float* GAM = (const float*)(ws + WS_GAM); const float* GEM = (const float*)(ws + WS_GEM);
    const float* mh_g = a.in[27]; const float* skip = a.in[28]; const float* wvp = a.in[23];
    const int tid = F.tid, lane = F.lane, w = F.wave, fr = lane & 15, fq = lane >> 4; LAS unsigned char* lds = F.lds;
    LAS float* den2 = (LAS float*)(lds + ML_DEN); LAS float* stats = (LAS float*)(lds + ML_ST); LAS float* mr = (LAS float*)(lds + ML_MR); LAS float* em_s = (LAS float*)(lds + ML_AT); LAS float* as_s = (LAS float*)(lds + ML_AS);
    const int st = w & 1, tp = (w >> 1) & 1, wv = w & 3;
    const unsigned vtr_lane = (unsigned)((8 * fq + ((lane & 15) >> 2)) * ML_PITCH + (128 * wv + 4 * (lane & 3)) * 2);
#define ML_DMA(gbase, tile_off) do { _Pragma("unroll") for (int r4 = 0; r4 < 4; ++r4) { const int rr = w + 8 * r4; \
        __builtin_amdgcn_global_load_lds((const unsigned*)((gbase) + (size_t)rr * CI + lane * 8), (LAS unsigned*)(lds + (tile_off) + rr * ML_PITCH), 16, 0, 0); } } while (0)
#define ML_STEP_HEAD() const int buf = k & 1; int j = k + jstart; if (j >= nk) j -= nk; int jn = j + 1; if (jn >= nk) jn -= nk; \
        asm volatile("s_waitcnt vmcnt(0) lgkmcnt(0)" ::: "memory"); __builtin_amdgcn_s_barrier(); asm volatile("" ::: "memory"); \
        if (k + 1 < nk && !skK) ML_DMA(Kb + (size_t)(32 * jn) * CI, ML_K + (buf ^ 1) * ML_TILE); \
        if (k < nk && !skV) ML_DMA(Vb + (size_t)(32 * j) * CI, ML_V + buf * ML_TILE)
    for (int r = 0; r < 8; ++r) { const int xcd = F.bid & 7, cq = F.bid >> 3, c16 = cq & 15; if (F.G != 256) break;
        const int part = r & 1, qi = part ? 31 - c16 : c16, bh = xcd + 8 * ((cq >> 4) + 2 * (r >> 1)), bl = bh >> 2, h = bh & 3; const size_t t0 = (size_t)bl * SEQ + 64 * qi; const int nk = 2 * (qi + 1), jstart = part ? 2 * (c16 + 1) : 0;
        const bf16* Kb = K + (size_t)bl * SEQ * CI + h * 512; const bf16* Vb = V + (size_t)bl * SEQ * CI + h * 512;
        ML_DMA(Kb + (size_t)(32 * jstart) * CI, ML_K);
        float tb_e, tb_a[4];
        tb_e = GEM[(t0 + (tid & 63)) * 4 + h];
#pragma unroll
        for (int i4 = 0; i4 < 4; ++i4) tb_a[i4] = GA[((size_t)bl * SEQ + tid + 512 * i4) * 4 + h];
#define ML_TABLES() do { if (tid < 64) em_s[tid] = tb_e; _Pragma("unroll") for (int i4 = 0; i4 < 4; ++i4) { const int sidx = tid + 512 * i4; if (sidx < 64 * (qi + 1)) as_s[sidx] = tb_a[i4] * LOG2E; } } while (0)
        const int c8 = lane * 8, cc = h * 512 + c8;
#define ML_EPI_LOADS(N, ROW0) v4u zr[N], xr[N]; float gm[8], sk[8]; asm volatile("" ::: "memory"); __builtin_amdgcn_sched_barrier(0); if (!skE) { _Pragma("unroll") for (int k8 = 0; k8 < N; ++k8) { const size_t off = (t0 + (ROW0) + k8) * CI + cc; zr[k8] = *(const v4u*)(Z + off); xr[k8] = *(const v4u*)(XC + off); } \
        _Pragma("unroll") for (int q = 0; q < 8; ++q) { gm[q] = mh_g[cc + q]; sk[q] = skip[cc + q]; } }
#define ML_EPI_PASS(N, ROW0) if (!skE) { const LAS float* ytile = (const LAS float*)lds; _Pragma("unroll") for (int k8 = 0; k8 < N; ++k8) { const int row = (ROW0) + k8; const size_t off = (t0 + row) * CI + cc; \
              const f32x4 y0 = *(const LAS f32x4*)(ytile + row * 516 + c8), y1 = *(const LAS f32x4*)(ytile + row * 516 + c8 + 4); float zf[8], xf[8], o[8]; unpack8(zr[k8], zf); unpack8(xr[k8], xf); \
              float s1 = ((y0[0] + y0[1]) + (y0[2] + y0[3])) + ((y1[0] + y1[1]) + (y1[2] + y1[3])), s2 = ((y0[0] * y0[0] + y0[1] * y0[1]) + (y0[2] * y0[2] + y0[3] * y0[3])) + ((y1[0] * y1[0] + y1[1] * y1[1]) + (y1[2] * y1[2] + y1[3] * y1[3])); \
              s1 = wave_sum(s1); s2 = wave_sum(s2); const float mean = s1 * (1.f / 512.f), rstd = rsqrtf(fmaxf(s2 * (1.f / 512.f) - mean * mean, 0.f) + 1e-5f); \
              _Pragma("unroll") for (int q = 0; q < 8; ++q) { const float yv = ((q < 4 ? y0[q & 3] : y1[q & 3]) - mean) * rstd; o[q] = (yv * gm[q] + sk[q] * xf[q]) * (zf[q] * sigm(zf[q])); } \
              *(v4u*)(YC + off) = pack8(o); } }
        if (w < 4) {
            bf16x8 qf[2][16];
            { const bf16* qp = Q + (t0 + 32 * tp + fr) * CI + h * 512 + fq * 8;
#pragma unroll
              for (int ks = 0; ks < 16; ++ks) { qf[0][ks] = *(const bf16x8*)(qp + 32 * ks); qf[1][ks] = *(const bf16x8*)(qp + 16 * CI + 32 * ks); } }
            const float At0 = GAM[(t0 + 32 * tp + fr) * 4 + h] * LOG2E, At1 = GAM[(t0 + 32 * tp + 16 + fr) * 4 + h] * LOG2E;
            ML_TABLES();
            float denp0 = 0.f, denp1 = 0.f;
            for (int k = 0; k <= nk; ++k) { ML_STEP_HEAD();
                if (k < nk && !skS) {
                    f32x4 s0a = {0.f, 0.f, 0.f, 0.f}, s0b = {0.f, 0.f, 0.f, 0.f}, s1a = {0.f, 0.f, 0.f, 0.f}, s1b = {0.f, 0.f, 0.f, 0.f};
                    { const LAS unsigned char* kl = lds + ML_K + buf * ML_TILE + (16 * st + fr) * ML_PITCH + fq * 16; bf16x8 kc[4], kn[4];
#pragma unroll
                      for (int q = 0; q < 4; ++q) kc[q] = *(const LAS bf16x8*)(kl + 64 * q);
#pragma unroll
                      for (int g = 0; g < 4; ++g) {
                          if (g < 3) {
#pragma unroll
                              for (int q = 0; q < 4; ++q) kn[q] = *(const LAS bf16x8*)(kl + 64 * (4 * g + 4 + q)); }
                          __builtin_amdgcn_sched_barrier(0);
#pragma unroll
                          for (int q = 0; q < 4; q += 2) { const int ks = 4 * g + q;
                              s0a = __builtin_amdgcn_mfma_f32_16x16x32_bf16(kc[q], qf[0][ks], s0a, 0, 0, 0); s1a = __builtin_amdgcn_mfma_f32_16x16x32_bf16(kc[q], qf[1][ks], s1a, 0, 0, 0);
                              s0b = __builtin_amdgcn_mfma_f32_16x16x32_bf16(kc[q + 1], qf[0][ks + 1], s0b, 0, 0, 0); s1b = __builtin_amdgcn_mfma_f32_16x16x32_bf16(kc[q + 1], qf[1][ks + 1], s1b, 0, 0, 0); }
                          __builtin_amdgcn_sched_barrier(0);
                          if (g < 3) {
#pragma unroll
                              for (int q = 0; q < 4; ++q) kc[q] = kn[q]; } } }
                    s0a += s0b; s1a += s1b;
                    const f32x4 asv = *(const LAS f32x4*)(as_s + 32 * j + 16 * st + 4 * fq); const float as[4] = {asv[0], asv[1], asv[2], asv[3]};
                    float p0[4], p1[4]; const int sbase = 32 * j + 16 * st + 4 * fq, tbase = 64 * qi + 32 * tp + fr;
                    if (32 * j + 31 <= 64 * qi + 32 * tp) {
#pragma unroll
                        for (int i = 0; i < 4; ++i) { p0[i] = s0a[i] * __builtin_amdgcn_exp2f(as[i] - At0); p1[i] = s1a[i] * __builtin_amdgcn_exp2f(as[i] - At1); }
                    } else {
#pragma unroll
                        for (int i = 0; i < 4; ++i) { p0[i] = (sbase + i) <= tbase ? s0a[i] * __builtin_amdgcn_exp2f(as[i] - At0) : 0.f; p1[i] = (sbase + i) <= tbase + 16 ? s1a[i] * __builtin_amdgcn_exp2f(as[i] - At1) : 0.f; } }
                    denp0 += (p0[0] + p0[1]) + (p0[2] + p0[3]); denp1 += (p1[0] + p1[1]) + (p1[2] + p1[3]);
                    { LAS unsigned char* pp = lds + ML_P + buf * ML_PT + (32 * tp + fr) * ML_PP + (16 * st + 4 * fq) * 2; v2u pw; pw.x = pk2(p0[0], p0[1]); pw.y = pk2(p0[2], p0[3]); *(LAS v2u*)pp = pw;
                      pw.x = pk2(p1[0], p1[1]); pw.y = pk2(p1[2], p1[3]); *(LAS v2u*)(pp + 16 * ML_PP) = pw; }
                } }
            ML_EPI_LOADS(12, 12 * w);
            { float wt[8];
#pragma unroll
              for (int u = 0; u < 8; ++u) { const int col = 2 * tid + (u >> 2); wt[u] = wvp[(size_t)(h * 128 + (col >> 2)) * 16 + 4 * (u & 3) + (col & 3)]; }
              *(LAS f32x4*)(as_s + 8 * tid) = (f32x4){wt[0], wt[1], wt[2], wt[3]}; *(LAS f32x4*)(as_s + 8 * tid + 4) = (f32x4){wt[4], wt[5], wt[6], wt[7]}; }
            { float d0 = denp0, d1 = denp1; d0 += __shfl_xor(d0, 16); d1 += __shfl_xor(d1, 16); d0 += __shfl_xor(d0, 32); d1 += __shfl_xor(d1, 32);
              if (fq == 0) { den2[st * 64 + 32 * tp + fr] = d0; den2[st * 64 + 32 * tp + 16 + fr] = d1; } }
            LDS_WAIT(); __builtin_amdgcn_s_barrier(); asm volatile("" ::: "memory");
            __builtin_amdgcn_s_barrier(); asm volatile("" ::: "memory");
            ML_EPI_PASS(12, 12 * w)
        } else {
            f32x4 O[4][8];
#pragma unroll
            for (int i = 0; i < 4; ++i)
#pragma unroll
                for (int e = 0; e < 8; ++e) O[i][e] = (f32x4){0.f, 0.f, 0.f, 0.f};
            ML_TABLES();
            bf16x8 pH[4], vH[2];
#pragma unroll
            for (int i = 0; i < 4; ++i) { pH[i] = (bf16x8){0, 0, 0, 0, 0, 0, 0, 0}; vH[i & 1] = (bf16x8){0, 0, 0, 0, 0, 0, 0, 0}; }
            for (int k = 0; k <= nk; ++k) { ML_STEP_HEAD();
                if (!skP) { PvOps o;
                    if (k >= 1) pv_issue((unsigned)(size_t)(lds + ML_P + (buf ^ 1) * ML_PT + fr * ML_PP + fq * 16), (unsigned)(size_t)(lds + ML_V + (buf ^ 1) * ML_TILE) + vtr_lane, o);
                    __builtin_amdgcn_sched_barrier(0);
                    if (k >= 2) {
#pragma unroll
                        for (int i = 0; i < 4; ++i)
#pragma unroll
                            for (int e = 0; e < 2; ++e) O[i][6 + e] = __builtin_amdgcn_mfma_f32_16x16x32_bf16(pH[i], vH[e], O[i][6 + e], 0, 0, 0); }
                    if (k >= 1) { pv_wait(o);
                        const bf16x8 pf[4] = {o.p0, o.p1, o.p2, o.p3}; const bf16x8 va[6] = {PV_CAT(o.l0, o.h0), PV_CAT(o.l1, o.h1), PV_CAT(o.l2, o.h2), PV_CAT(o.l3, o.h3), PV_CAT(o.l4, o.h4), PV_CAT(o.l5, o.h5)};
#pragma unroll
                        for (int i = 0; i < 4; ++i)
#pragma unroll
                            for (int e = 0; e < 6; ++e) O[i][e] = __builtin_amdgcn_mfma_f32_16x16x32_bf16(pf[i], va[e], O[i][e], 0, 0, 0);
#pragma unroll
                        for (int i = 0; i < 4; ++i) pH[i] = pf[i];
                        vH[0] = PV_CAT(o.l6, o.h6); vH[1] = PV_CAT(o.l7, o.h7); } } }
            if (!skP) {
#pragma unroll
                for (int i = 0; i < 4; ++i)
#pragma unroll
                    for (int e = 0; e < 2; ++e) O[i][6 + e] = __builtin_amdgcn_mfma_f32_16x16x32_bf16(pH[i], vH[e], O[i][6 + e], 0, 0, 0); }
            LDS_WAIT(); __builtin_amdgcn_s_barrier(); asm volatile("" ::: "memory");
            { const LAS float* den_q = den2 + 4 * fq; const LAS float* em_q = em_s + 4 * fq; LAS float* yt_q = (LAS float*)lds + 4 * fq * 516 + 128 * wv + fr; float inv[16];
#pragma unroll
              for (int i = 0; i < 4; ++i)
#pragma unroll
                for (int jj = 0; jj < 4; ++jj) { const float dn = den_q[16 * i + jj] + den_q[64 + 16 * i + jj]; inv[4 * i + jj] = 1.0f / fmaxf(fabsf(dn), em_q[16 * i + jj]); }
#pragma unroll
              for (int e = 0; e < 8; ++e) { const f32x4 wl = *(const LAS f32x4*)(as_s + (128 * wv + 16 * e + fr) * 4);
#pragma unroll
                for (int i = 0; i < 4; ++i)
#pragma unroll
                    for (int jj = 0; jj < 4; ++jj) { const float x = O[i][e][jj] * inv[4 * i + jj];
                        yt_q[(16 * i + jj) * 516 + 16 * e] = fmaf(DPP_MOVF(x, 0xFF), wl[3], fmaf(DPP_MOVF(x, 0xAA), wl[2], fmaf(DPP_MOVF(x, 0x55), wl[1], DPP_MOVF(x, 0x00) * wl[0]))); } } }
            LDS_WAIT(); __builtin_amdgcn_s_barrier(); asm volatile("" ::: "memory");
            ML_EPI_LOADS(4, 48 + 4 * wv);
            ML_EPI_PASS(4, 48 + 4 * wv)
        }
        VM_WAIT(); __syncthreads();
    }
#undef ML_DMA
#undef ML_STEP_HEAD
#undef ML_TABLES
#undef ML_EPI_LOADS
#undef ML_EPI_PASS
}
__device__ __forceinline__ void phase_mlstm(Frame& F, const Args& a) { phase_mlstm_t<0>(F, a); }
#ifdef ML_PROBE
__device__ __forceinline__ void phase_mlstm_probe(Frame& F, const Args& a) { phase_mlstm_t<ML_PROBE>(F, a); }
#endif

#ifdef ML_DMAPROBE
__device__ __forceinline__ void phase_mlstm_dmaprobe(Frame& F, const Args& a) {
    unsigned char* ws = F.ws; const bf16* K = (const bf16*)(ws + WS_K); const bf16* V = (const bf16*)(ws + WS_V);
    const int lane = F.lane, w = F.wave; LAS unsigned char* lds = F.lds;
#define MLP_DMA(gbase, tile_off) do { _Pragma("unroll") for (int r4 = 0; r4 < 4; ++r4) { const int rr = w + 8 * r4; \
        __builtin_amdgcn_global_load_lds((const unsigned*)((gbase) + (size_t)rr * CI + lane * 8), (LAS unsigned*)(lds + (tile_off) + rr * ML_PITCH), 16, 0, 0); } } while (0)
    for (int r = 0; r < 8; ++r) { const int xcd = F.bid & 7, cq = F.bid >> 3, c16 = cq & 15; if (F.G != 256) break;
        const int part = r & 1, qi = part ? 31 - c16 : c16, bh = xcd + 8 * ((cq >> 4) + 2 * (r >> 1)), bl = bh >> 2, h = bh & 3; const int nk = 2 * (qi + 1), jstart = part ? 2 * (c16 + 1) : 0;
        const bf16* Kb = K + (size_t)bl * SEQ * CI + h * 512; const bf16* Vb = V + (size_t)bl * SEQ * CI + h * 512;
        for (int k = 0; k <= nk; ++k) { const int buf = k & 1; int j = k + jstart; if (j >= nk) j -= nk; int jn = j + 1; if (jn >= nk) jn -= nk;
            asm volatile("s_waitcnt vmcnt(0) lgkmcnt(0)" ::: "memory"); __builtin_amdgcn_s_barrier(); asm volatile("" ::: "memory");
            if ((ML_DMAPROBE & 1) && k + 1 < nk) MLP_DMA(Kb + (size_t)(32 * jn) * CI, ML_K + (buf ^ 1) * ML_TILE);
            if ((ML_DMAPROBE & 2) && k < nk) MLP_DMA(Vb + (size_t)(32 * j) * CI, ML_V + buf * ML_TILE);
        }
        VM_WAIT(); __syncthreads();
    }
#undef MLP_DMA
}
#endif
#ifdef ML_DMAPROBE
#define ML_PROBE_CALL phase_mlstm_dmaprobe(F, args);
#elif defined(ML_PROBE)
#define ML_PROBE_CALL phase_mlstm_probe(F, args);
#else
#define ML_PROBE_CALL
#endif
#define GEMM_PHASE(EPI, Aptr, Bptr, M_, N_, K_, ...) do { pg8::Gemm g{(const pg8::bf16_t*)(Aptr), (const pg8::bf16_t*)(Bptr), (M_), (N_), (K_)}; pg8::StaticOrder So; So.init((M_), (N_), F.G, F.bid); \
        pg8::EPI Ep{__VA_ARGS__}; pg8::gemm_phase<pg8::EPI, pg8::StaticOrder, PG8_ALIGN, PG8_SP2>(F.lds, g, So, Ep); } while (0)
namespace pg8 { typedef EpiRes2<float> EpiResF; typedef EpiRes2<bf16_t> EpiResB; typedef EpiPle2<false> EpiPleB; typedef EpiPle2<true> EpiPleF; }
__global__ void __launch_bounds__(NWAVES * 64, 2) trunk_fwd(Args args) {
    extern __shared__ __attribute__((aligned(16))) unsigned char lds_raw[];
    Frame F; F.lds = (LAS unsigned char*)lds_raw; F.ws = args.ws; F.in = nullptr;
    F.tid = threadIdx.x; F.lane = F.tid & 63; F.wave = __builtin_amdgcn_readfirstlane(F.tid >> 6); F.G = gridDim.x; F.bid = blockIdx.x;
    volatile LAS unsigned* MISC = (volatile LAS unsigned*)(F.lds + MISC_OFF);
    if (F.tid < 64) MISC[F.tid] = 0u;
    __syncthreads();
    XcdBarrier bar; bar.bar = (unsigned*)(args.ws + WS_CTL) + CW_BAR; bar.x = 0; bar.st = nullptr;
    if (args.use_bar) bar = xcd_barrier_post((unsigned*)(args.ws + WS_CTL) + CW_BAR, MISC + 8);
    unsigned* xrank = (unsigned*)(args.ws + WS_CTL) + CW_XRANK; const unsigned my_xcc = xb_xcc_id();
    if (args.use_bar && F.tid == 0) MISC[12] = xb_add(&xrank[64 * my_xcc], 1u);
    const int lo = args.ph_lo, hi = args.ph_hi;
#ifndef ONLY_SITE
#define ONLY_SITE -1
#endif
#define EN(n) (ONLY_SITE < 0 || ONLY_SITE == (n))
#ifndef REP_MASK
#define REP_MASK 0u
#endif
#define NREP(n) (((REP_MASK >> (n)) & 1u) ? 2 : 1)
#define IN(k) (lo <= (k) && (k) < hi)
#define SEAM(k) do { if (IN(k) && IN((k) + 1)) xcd_barrier(bar); } while (0)
    unsigned char* ws = args.ws; float* out = args.out;
    float* RS = (float*)(ws + WS_RS);
#define RSN(i) (RS + (size_t)(i) * T * 16)
#define PH(site, k, ...) if (EN(site) && IN(k)) { for (int rep_ = 0; rep_ < NREP(site); ++rep_) { if (rep_) xcd_barrier(bar); __VA_ARGS__ } } SEAM(k);
    PH(0, 0, phase_prologue(F, args); phase_cast_sq(F, args.in[0], (bf16*)(ws + WS_XB2), RSN(0), T);)
    if (args.use_bar && lo == 0 && hi > 1) {
        bool ok = F.G == 256; for (int x = 0; x < 16; ++x) { const unsigned cx = xb_ld(&xrank[64 * x]); ok = ok && (cx == (x < 8 ? 32u : 0u)); }
        const unsigned rk = MISC[12]; if (ok && rk < 32u && my_xcc < 8u) F.bid = (int)(rk * 8u + my_xcc); }
    PH(2, 1, GEMM_PHASE(EpiBf16SplitR, ws + WS_XB2, ws + WS_WIN, T, NU, D, (pg8::bf16_t*)(ws + WS_UA), UA_W, 4, (pg8::bf16_t*)(ws + WS_UB), UB_W, RSN(0));)
    PH(3, 2, phase_prepA(F, args);)
    PH(4, 3, GEMM_PHASE(EpiBf16Split, ws + WS_LIN, ws + WS_WLORA, T, 1536, 256 + args.pad, (pg8::bf16_t*)(ws + WS_LOUT), 1536, 1 << 20, nullptr, 0);)
    PH(5, 4, phase_indexer(F);)
    PH(6, 5, phase_dsa_attn(F, args);)
    PH(7, 6, phase_rwkv(F, args);)
    PH(8, 7, GEMM_PHASE(EpiResF, ws + WS_XB, ws + WS_WOUT, T, D, D, args.in[0], (pg8::bf16_t*)(ws + WS_XB2), D, RSN(1));)
#define FFN_PLE(L, pb, rs_a, rs_b, rs_c, PLE_EPI, ple_out) do { const size_t lw = (size_t)(L) * WS_LAYER_STRIDE; \
        PH(21, (pb), GEMM_PHASE(EpiSwigluR, ws + WS_XB2, ws + WS_WGU0 + lw, T, 2 * FF, D, (pg8::bf16_t*)(ws + WS_H), FF, RSN(rs_a));) \
        PH(22, (pb) + 1, GEMM_PHASE(EpiResB, ws + WS_H, ws + WS_WD0 + lw, T, D, FF, (const pg8::bf16_t*)(ws + WS_XB2), (pg8::bf16_t*)(ws + WS_XB), D, RSN(rs_b));) \
        PH(24, (pb) + 2, GEMM_PHASE(EpiBf16Split, ws + WS_PB, ws + WS_WPLE0 + lw, T, D, 256 + args.pad, (pg8::bf16_t*)(ws + WS_E), D, 1 << 20, nullptr, 0);) \
        PH(25, (pb) + 3, GEMM_PHASE(PLE_EPI, ws + WS_XB, ws + WS_WPG0 + lw, T, D, D, (const pg8::bf16_t*)(ws + WS_XB), (void*)(ple_out), (const pg8::bf16_t*)(ws + WS_E), D, RSN(rs_b), RSN(rs_c));) } while (0)
#define L1_HALF(hb, p1) do { bf16* xbh = (bf16*)(ws + WS_XB2) + (size_t)(hb) * TH * D; \
        PH(11, (p1), GEMM_PHASE(EpiBf16SplitR, xbh, ws + WS_WUP, TH, 2 * CI, D, (pg8::bf16_t*)(ws + WS_XM), CI, 8, (pg8::bf16_t*)(ws + WS_Z), CI, RSN(3) + (size_t)(hb) * TH * 16);) \
        PH(12, (p1) + 1, phase_l1prep(F, args, hb);) \
        PH(13, (p1) + 2, phase_gatescan(F); if ((hb) == 0) phase_cvt_p(F, args.in[1] + (size_t)T * 256, (bf16*)(ws + WS_PB));) \
        PH(14, (p1) + 3, ML_PROBE_CALL phase_mlstm(F, args);) \
        PH(15, (p1) + 4, GEMM_PHASE(EpiResB, ws + WS_V, ws + WS_WDOWN, TH, D, CI, (const pg8::bf16_t*)xbh, (pg8::bf16_t*)xbh, D, RSN(4) + (size_t)(hb) * TH * 16);) } while (0)
    FFN_PLE(0, 8, 1, 2, 3, EpiPleB, ws + WS_XB2);
    L1_HALF(0, 12);
    L1_HALF(1, 17);
    FFN_PLE(1, 22, 4, 5, 5, EpiPleF, out);
#undef IN
#undef SEAM
}
constexpr int N_PHASES = 26;

#ifndef MK_ONE_LAUNCH
#define MK_ONE_LAUNCH 1
#endif
extern "C" void kernel_launch(void* const* d_in, const int* in_sizes, int n_in, void* d_out, int out_size, void* d_ws, size_t ws_size, hipStream_t stream) {
    static int grid = 0;
    if (grid == 0) {
        if (n_in != 37 || in_sizes[0] != T * D || out_size != T * D || ws_size < WS_END) { fprintf(stderr, "kernel_launch: unexpected shapes (n_in %d, in0 %d, out %d, ws %zu < %zu); nothing launched\n", n_in, n_in > 0 ? in_sizes[0] : -1, out_size, ws_size, (size_t)WS_END); grid = -1; return; }
        int dev = 0, cus = 0, per_cu = 0;
        if (hipGetDevice(&dev) != hipSuccess || hipDeviceGetAttribute(&cus, hipDeviceAttributeMultiprocessorCount, dev) != hipSuccess) { grid = -1; return; }
        if (hipFuncSetAttribute((const void*)trunk_fwd, hipFuncAttributeMaxDynamicSharedMemorySize, LDS_BYTES) != hipSuccess) { fprintf(stderr, "kernel_launch: hipFuncSetAttribute failed\n"); grid = -1; return; }
        if (hipOccupancyMaxActiveBlocksPerMultiprocessor(&per_cu, (const void*)trunk_fwd, NWAVES * 64, LDS_BYTES) != hipSuccess || per_cu < 1) { fprintf(stderr, "kernel_launch: occupancy query says %d\n", per_cu); }
        (void)hipGetLastError();
        grid = cus;
        if (grid != 256) { fprintf(stderr, "kernel_launch: built for 256 CUs, found %d; nothing launched\n", cus); grid = -1; return; }
    }
    if (grid < 0) return;
    if (hipMemsetAsync((char*)d_ws + WS_CTL, 0, CTL_ZERO_BYTES, stream) != hipSuccess) return;
    Args a{};
    for (int i = 0; i < 37; ++i) a.in[i] = (const float*)d_in[i];
    a.out = (float*)d_out; a.ws = (unsigned char*)d_ws; a.pad = 0;
#if MK_ONE_LAUNCH
    a.ph_lo = 0; a.ph_hi = N_PHASES; a.use_bar = 1;
    hipLaunchKernelGGL(trunk_fwd, dim3(grid), dim3(NWAVES * 64), LDS_BYTES, stream, a);
#else
    for (int p = 0; p < N_PHASES; ++p) { a.ph_lo = p; a.ph_hi = p + 1; a.use_bar = 0; hipLaunchKernelGGL(trunk_fwd, dim3(grid), dim3(NWAVES * 64), LDS_BYTES, stream, a); }
#endif
}
```

```cpp
#include <hip/hip_runtime.h>
#include <cstdio>
#include <cstdint>
namespace pg8 {
#define PG8_LAS __attribute__((address_space(3)))
typedef unsigned short bf16_t;
typedef short bf16x8 __attribute__((ext_vector_type(8)));
typedef float f32x4 __attribute__((ext_vector_type(4)));
typedef unsigned u32x4 __attribute__((ext_vector_type(4)));
constexpr int BM = 256, BK = 64, HALF = 128, HTB = HALF * BK * 2  , STAGE_BYTES = 8 * HTB, NXCD = 8, WGM = 8;

__host__ __device__ __forceinline__ int lds_byte(int r, int c) { const int st = (r >> 4) * 2 + (c >> 5), rr = r & 15, cc = c & 31, ob = rr * 64 + cc * 2; return st * 1024 + (ob ^ (((ob >> 9) & 1) << 5)); }
__host__ __device__ __forceinline__ void stage_rc(int b, int& R, int& C) { const int st = b / 1024, sb = b % 1024, swz = sb ^ (((sb >> 9) & 1) << 5); R = (st >> 1) * 16 + swz / 64; C = (st & 1) * 32 + (swz % 64) / 2; }
__host__ __device__ __forceinline__ int perm32(int rho) { const int n = rho >> 4, i = rho & 15; return 8 * (i >> 2) + 4 * n + (i & 3); }

struct Unit { int pm, pn; };
struct Gemm { const bf16_t* A; const bf16_t* Bt; int M, N, K; };

struct StaticOrder {
    int nM, nN, nwg, G, c;
    __host__ __device__ void init(int M, int N, int G_, int c_) { nM = M / BM; nN = N / BM; nwg = nM * nN; G = G_; c = c_; }
    __host__ __device__ bool next(int i, Unit& u) const {
        const long L = (long)i * G + c; if (L >= nwg) return false;
        int wgid = (int)L; { const int q = nwg / NXCD, r = nwg % NXCD, xcd = wgid % NXCD, off = wgid / NXCD; wgid = (xcd < r ? xcd * (q + 1) : r * (q + 1) + (xcd - r) * q) + off; }
        const int nig = WGM * nN, gid = wgid / nig, fm = gid * WGM, gsz = (nM - fm) < WGM ? (nM - fm) : WGM;
        u.pm = fm + ((wgid % nig) % gsz); u.pn = (wgid % nig) / gsz; return true;
    }
    __device__ __forceinline__ void a_ready(const Unit&) const {}
    __device__ __forceinline__ void done(const Unit&) const {}
};

__device__ __forceinline__ unsigned cvt_pk_bf16(float lo, float hi) { unsigned r; asm volatile("v_cvt_pk_bf16_f32 %0, %1, %2" : "=v"(r) : "v"(lo), "v"(hi)); return r; }
typedef float f32x2 __attribute__((ext_vector_type(2)));
__device__ __forceinline__ f32x2 gelu_pk(f32x2 v) {
    const f32x2 av = __builtin_elementwise_abs(v), d = av * 0.2316418882f + 1.0f;
    f32x2 t; t.x = __builtin_amdgcn_rcpf(d.x); t.y = __builtin_amdgcn_rcpf(d.y);
    f32x2 q = t * 0.5307027145f + (-0.7265760135f); q = q * t + 0.7107068705f; q = q * t + (-0.142248368f); q = q * t + 0.127414796f; q = q * t;
    const f32x2 s = (v * v) * (-0.72134752044f);
    f32x2 e; e.x = __builtin_amdgcn_exp2f(s.x); e.y = __builtin_amdgcn_exp2f(s.y);
    const f32x2 m = v * (q * e), r = v - m;
    f32x2 o; o.x = v.x < 0.f ? m.x : r.x; o.y = v.y < 0.f ? m.y : r.y; return o;
}

template <class Epi, class Sched, bool ALIGN_EPI = false, bool SP2 = false>
__device__ __forceinline__ void gemm_phase(PG8_LAS unsigned char* lds, const Gemm g, const Sched& S, const Epi& E) {
    const int tid = threadIdx.x, wid = __builtin_amdgcn_readfirstlane(tid >> 6), lane = tid & 63, wr = wid >> 2, wc = wid & 3, fr = lane & 15, fq = lane >> 4;
    const int K = g.K, nt = K / BK;
    unsigned voffA[2], voffB[2];
#pragma unroll
    for (int i = 0; i < 2; ++i) { int R, C; stage_rc(tid * 16 + i * 8192, R, C); const int Rb = Epi::PERM ? ((R & ~31) + perm32(R & 31)) : R;
        voffA[i] = (unsigned)(R * K + C) * 2u; voffB[i] = (unsigned)(Rb * K + C) * 2u; }
    const size_t kstep = (size_t)(BK * 2);
    const size_t hstep = (size_t)HALF * K * 2;
    const size_t tstep = 2 * hstep;
    const unsigned ldsw = (unsigned)wid * 1024u;
    const int aoff = lds_byte(wr * 64 + fr, fq * 8), boff = lds_byte(wc * 32 + fr, fq * 8);
#define PG8_SA(b, h) (((b) * 2 + (h)) * HTB)
#define PG8_SB(b, h) ((4 + (b) * 2 + (h)) * HTB)
#define PG8_STAGE(bufoff, gbase, voff) do { _Pragma("unroll") for (int _i = 0; _i < 2; ++_i) \
        __builtin_amdgcn_global_load_lds((const unsigned*)((const char*)(gbase) + (voff)[_i]), (PG8_LAS unsigned*)(lds + (bufoff) + ldsw + _i * 8192), 16, 0, 0); } while (0)
#define PG8_LDA(dst, b, h) do { _Pragma("unroll") for (int m = 0; m < 4; ++m) _Pragma("unroll") for (int k = 0; k < 2; ++k) dst[m][k] = *(const PG8_LAS bf16x8*)(lds + PG8_SA(b, h) + aoff + m * 2048 + k * 1024); } while (0)
#define PG8_LDB(dst, b, h) do { _Pragma("unroll") for (int n = 0; n < 2; ++n) _Pragma("unroll") for (int k = 0; k < 2; ++k) dst[n][k] = *(const PG8_LAS bf16x8*)(lds + PG8_SB(b, h) + boff + n * 2048 + k * 1024); } while (0)
#define PG8_MMA(ai, bj, At, Bt) do { __builtin_amdgcn_s_setprio(1); _Pragma("unroll") for (int m = 0; m < 4; ++m) _Pragma("unroll") for (int n = 0; n < 2; ++n) _Pragma("unroll") for (int k = 0; k < 2; ++k) \
        acc[ai][bj][m][n] = __builtin_amdgcn_mfma_f32_16x16x32_bf16(Bt[n][k], At[m][k], acc[ai][bj][m][n], 0, 0, 0); __builtin_amdgcn_s_setprio(0); } while (0)
#define PG8_WAIT_V(n) asm volatile("s_waitcnt vmcnt(" #n ")" ::: "memory")
#define PG8_WAIT_L(n) asm volatile("s_waitcnt lgkmcnt(" #n ")" ::: "memory")
#define PG8_BAR __builtin_amdgcn_s_barrier()
#define PG8_SCHED __builtin_amdgcn_sched_barrier(0)
    Unit cur, nxt; int ui = 0;
    if (!S.next(0, cur)) return;
    f32x4 acc[2][2][4][2];
#pragma unroll
    for (int a = 0; a < 2; ++a)
#pragma unroll
        for (int b = 0; b < 2; ++b)
#pragma unroll
            for (int m = 0; m < 4; ++m)
#pragma unroll
                for (int n = 0; n < 2; ++n) acc[a][b][m][n] = (f32x4){0.f, 0.f, 0.f, 0.f};
    bf16x8 At[4][2], B0[2][2], B1[2][2];
    const char* cA = (const char*)g.A + (size_t)cur.pm * tstep; const char* cB = (const char*)g.Bt + (size_t)cur.pn * tstep;
    S.a_ready(cur);
    if constexpr (SP2) {
        PG8_STAGE(PG8_SB(0, 0), cB, voffB); PG8_STAGE(PG8_SB(0, 1), cB + hstep, voffB); PG8_STAGE(PG8_SA(0, 0), cA, voffA); PG8_STAGE(PG8_SA(0, 1), cA + hstep, voffA);
        if (wr == 1) PG8_BAR;
        PG8_WAIT_V(2); PG8_BAR;
        PG8_STAGE(PG8_SB(1, 0), cB + kstep, voffB); PG8_STAGE(PG8_SA(1, 0), cA + kstep, voffA); PG8_STAGE(PG8_SB(1, 1), cB + hstep + kstep, voffB);
        PG8_WAIT_V(6); PG8_BAR;
    } else {
        PG8_STAGE(PG8_SB(0, 0), cB, voffB); PG8_STAGE(PG8_SA(0, 0), cA, voffA); PG8_STAGE(PG8_SB(0, 1), cB + hstep, voffB); PG8_STAGE(PG8_SA(0, 1), cA + hstep, voffA);
        if (wr == 1) PG8_BAR;
        PG8_WAIT_V(4); PG8_BAR;
        PG8_STAGE(PG8_SB(1, 0), cB + kstep, voffB); PG8_STAGE(PG8_SA(1, 0), cA + kstep, voffA); PG8_STAGE(PG8_SB(1, 1), cB + hstep + kstep, voffB);
        PG8_WAIT_V(6); PG8_BAR;
    }
    for (;;) {
        const bool has_next = S.next(ui + 1, nxt);
        const char* nA = has_next ? (const char*)g.A + (size_t)nxt.pm * tstep : cA; const char* nB = has_next ? (const char*)g.Bt + (size_t)nxt.pn * tstep : cB;
        for (int t = 0; t < nt; t += 2) {
            const bool last = (t == nt - 2);
            const char* a1 = cA + (size_t)(t + 1) * kstep;
            const char* a2 = last ? nA : cA + (size_t)(t + 2) * kstep; const char* b2 = last ? nB : cB + (size_t)(t + 2) * kstep;
            const char* a3 = a2 + kstep; const char* b3 = b2 + kstep;
            if (last && has_next) S.a_ready(nxt);
            if constexpr (SP2) {
            PG8_LDB(B0, 0, 0); PG8_LDB(B1, 0, 1); PG8_SCHED; PG8_LDA(At, 0, 0); PG8_STAGE(PG8_SA(1, 1), a1 + hstep, voffA);
            PG8_WAIT_V(8); PG8_WAIT_L(0); PG8_BAR; PG8_MMA(0, 0, At, B0); PG8_MMA(0, 1, At, B1); PG8_BAR; PG8_SCHED;
            PG8_LDA(At, 0, 1); PG8_STAGE(PG8_SB(0, 0), b2, voffB); PG8_STAGE(PG8_SB(0, 1), b2 + hstep, voffB); PG8_STAGE(PG8_SA(0, 0), a2, voffA);
            PG8_WAIT_V(8); PG8_WAIT_L(0); PG8_BAR; PG8_MMA(1, 0, At, B0); PG8_MMA(1, 1, At, B1); PG8_BAR; PG8_SCHED;
            PG8_LDB(B0, 1, 0); PG8_LDB(B1, 1, 1); PG8_SCHED; PG8_LDA(At, 1, 0); PG8_STAGE(PG8_SA(0, 1), a2 + hstep, voffA);
            PG8_WAIT_V(8); PG8_WAIT_L(0); PG8_BAR; PG8_MMA(0, 0, At, B0); PG8_MMA(0, 1, At, B1); PG8_BAR; PG8_SCHED;
            PG8_LDA(At, 1, 1); PG8_STAGE(PG8_SB(1, 0), b3, voffB); PG8_STAGE(PG8_SB(1, 1), b3 + hstep, voffB); PG8_STAGE(PG8_SA(1, 0), a3, voffA);
            PG8_WAIT_V(8); PG8_WAIT_L(0); PG8_BAR; PG8_MMA(1, 0, At, B0); PG8_MMA(1, 1, At, B1); PG8_BAR; PG8_SCHED;
            } else {
            PG8_LDB(B0, 0, 0); PG8_SCHED; PG8_LDA(At, 0, 0); PG8_STAGE(PG8_SA(1, 1), a1 + hstep, voffA);
            PG8_WAIT_L(8); PG8_BAR; PG8_WAIT_L(0); PG8_MMA(0, 0, At, B0); PG8_BAR; PG8_SCHED;
            PG8_LDB(B1, 0, 1); PG8_STAGE(PG8_SB(0, 0), b2, voffB);
            PG8_BAR; PG8_WAIT_L(0); PG8_MMA(0, 1, At, B1); PG8_BAR;
            PG8_LDA(At, 0, 1); PG8_STAGE(PG8_SA(0, 0), a2, voffA);
            PG8_BAR; PG8_WAIT_L(0); PG8_MMA(1, 0, At, B0); PG8_BAR; PG8_SCHED;
            PG8_STAGE(PG8_SB(0, 1), b2 + hstep, voffB);
            PG8_WAIT_V(6); PG8_BAR; PG8_MMA(1, 1, At, B1); PG8_BAR;
            PG8_LDB(B0, 1, 0); PG8_SCHED; PG8_LDA(At, 1, 0); PG8_STAGE(PG8_SA(0, 1), a2 + hstep, voffA);
            PG8_WAIT_L(8); PG8_BAR; PG8_WAIT_L(0); PG8_MMA(0, 0, At, B0); PG8_BAR; PG8_SCHED;
            PG8_LDB(B1, 1, 1); PG8_STAGE(PG8_SB(1, 0), b3, voffB);
            PG8_BAR; PG8_WAIT_L(0); PG8_MMA(0, 1, At, B1); PG8_BAR;
            PG8_LDA(At, 1, 1); PG8_STAGE(PG8_SA(1, 0), a3, voffA);
            PG8_BAR; PG8_WAIT_L(0); PG8_MMA(1, 0, At, B0); PG8_BAR; PG8_SCHED;
            PG8_STAGE(PG8_SB(1, 1), b3 + hstep, voffB);
            PG8_WAIT_V(6); PG8_BAR; PG8_MMA(1, 1, At, B1); PG8_BAR;
            }
        }
        if constexpr (ALIGN_EPI) { if (wr == 0) PG8_BAR; }
        if constexpr (!Epi::AFTER_DRAIN) { E(acc, cur, wr, wc, fr, fq); S.done(cur); }
        if (!has_next) break;
#pragma unroll
        for (int a = 0; a < 2; ++a)
#pragma unroll
            for (int b = 0; b < 2; ++b)
#pragma unroll
                for (int m = 0; m < 4; ++m)
#pragma unroll
                    for (int n = 0; n < 2; ++n) acc[a][b][m][n] = (f32x4){0.f, 0.f, 0.f, 0.f};
        cur = nxt; cA = nA; cB = nB; ++ui;
        if constexpr (ALIGN_EPI) { if (wr == 1) PG8_BAR; }
    }
    PG8_WAIT_V(0);
    if constexpr (!ALIGN_EPI) { if (wr == 0) PG8_BAR; }
    PG8_BAR;
    if constexpr (Epi::AFTER_DRAIN) { E.fused(acc, cur, wr, wc, fr, fq, lds, wid, lane); S.done(cur); }
#undef PG8_SA
#undef PG8_SB
#undef PG8_STAGE
#undef PG8_LDA
#undef PG8_LDB
#undef PG8_MMA
#undef PG8_WAIT_V
#undef PG8_WAIT_L
#undef PG8_BAR
#undef PG8_SCHED
}
}
namespace pg8 {
__device__ __forceinline__ float sigmoidf_(float x) { return __builtin_amdgcn_rcpf(1.0f + __builtin_amdgcn_exp2f(-1.4426950408889634f * x)); }
struct EpiBf16Split {
    static constexpr bool PERM = true, AFTER_DRAIN = false;
    bf16_t* O0; int ld0; int nt0; bf16_t* O1; int ld1;
    __device__ __forceinline__ void operator()(const f32x4 (&acc)[2][2][4][2], const Unit& u, int wr, int wc, int fr, int fq) const {
        const bool first = u.pn < nt0; bf16_t* base = first ? O0 : O1; const int ld = first ? ld0 : ld1; const int colt = (first ? u.pn : u.pn - nt0) * BM;
        const int row0 = u.pm * BM + wr * 64 + fr, col0 = colt + wc * 32 + 8 * fq;
#pragma unroll
        for (int ai = 0; ai < 2; ++ai)
#pragma unroll
            for (int m = 0; m < 4; ++m) { bf16_t* rowp = base + (size_t)(row0 + ai * HALF + m * 16) * ld + col0;
#pragma unroll
                for (int bj = 0; bj < 2; ++bj) { const f32x4 v0 = acc[ai][bj][m][0], v1 = acc[ai][bj][m][1];
                    u32x4 w; w.x = cvt_pk_bf16(v0[0], v0[1]); w.y = cvt_pk_bf16(v0[2], v0[3]); w.z = cvt_pk_bf16(v1[0], v1[1]); w.w = cvt_pk_bf16(v1[2], v1[3]);
                    *(u32x4*)(rowp + bj * HALF) = w; } }
    }
};
struct EpiResF32 {
    static constexpr bool PERM = false, AFTER_DRAIN = false;
    const float* base; float* out; int ldc;
    __device__ __forceinline__ void operator()(const f32x4 (&acc)[2][2][4][2], const Unit& u, int wr, int wc, int fr, int fq) const {
        const int row0 = u.pm * BM + wr * 64 + fr, col0 = u.pn * BM + wc * 32 + 4 * fq;
#pragma unroll
        for (int ai = 0; ai < 2; ++ai)
#pragma unroll
            for (int m = 0; m < 4; ++m) { const size_t off = (size_t)(row0 + ai * HALF + m * 16) * ldc + col0;
#pragma unroll
                for (int bj = 0; bj < 2; ++bj)
#pragma unroll
                    for (int n = 0; n < 2; ++n) { const f32x4 b = *(const f32x4*)(base + off + bj * HALF + n * 16); *(f32x4*)(out + off + bj * HALF + n * 16) = b + acc[ai][bj][m][n]; } }
    }
};
struct EpiSwiglu {
    static constexpr bool PERM = false, AFTER_DRAIN = false;
    bf16_t* H; int ldh;
    __device__ __forceinline__ void operator()(const f32x4 (&acc)[2][2][4][2], const Unit& u, int wr, int wc, int fr, int fq) const {
        const int row0 = u.pm * BM + wr * 64 + fr, hc0 = u.pn * (BM / 2) + wc * 16 + 4 * fq;
#pragma unroll
        for (int ai = 0; ai < 2; ++ai)
#pragma unroll
            for (int m = 0; m < 4; ++m) { bf16_t* rowp = H + (size_t)(row0 + ai * HALF + m * 16) * ldh + hc0;
#pragma unroll
                for (int bj = 0; bj < 2; ++bj) { const f32x4 g = acc[ai][bj][m][0], up = acc[ai][bj][m][1]; float h[4];
#pragma unroll
                    for (int i = 0; i < 4; ++i) h[i] = g[i] * sigmoidf_(g[i]) * up[i];
                    typedef unsigned u32x2 __attribute__((ext_vector_type(2)));
                    u32x2 w; w.x = cvt_pk_bf16(h[0], h[1]); w.y = cvt_pk_bf16(h[2], h[3]);
                    *(u32x2*)(rowp + bj * (HALF / 2)) = w; } }
    }
};
struct EpiPle {
    static constexpr bool PERM = false, AFTER_DRAIN = false;
    const float* base; float* out; const bf16_t* E; int ldc;
    __device__ __forceinline__ void operator()(const f32x4 (&acc)[2][2][4][2], const Unit& u, int wr, int wc, int fr, int fq) const {
        const int row0 = u.pm * BM + wr * 64 + fr, col0 = u.pn * BM + wc * 32 + 4 * fq;
        typedef unsigned u32x2 __attribute__((ext_vector_type(2)));
#pragma unroll
        for (int ai = 0; ai < 2; ++ai)
#pragma unroll
            for (int m = 0; m < 4; ++m) { const size_t off = (size_t)(row0 + ai * HALF + m * 16) * ldc + col0;
#pragma unroll
                for (int bj = 0; bj < 2; ++bj)
#pragma unroll
                    for (int n = 0; n < 2; ++n) { const size_t o = off + bj * HALF + n * 16; const f32x4 b = *(const f32x4*)(base + o); const u32x2 e = *(const u32x2*)(E + o); const f32x4 a = acc[ai][bj][m][n];
                        f32x4 r; r[0] = b[0] + __uint_as_float(e.x << 16) * sigmoidf_(a[0]); r[1] = b[1] + __uint_as_float(e.x & 0xffff0000u) * sigmoidf_(a[1]);
                        r[2] = b[2] + __uint_as_float(e.y << 16) * sigmoidf_(a[2]); r[3] = b[3] + __uint_as_float(e.y & 0xffff0000u) * sigmoidf_(a[3]);
                        *(f32x4*)(out + o) = r; } }
    }
};
__device__ __forceinline__ float rms_r(const float* rsq, int row) { const f32x4* p = (const f32x4*)(rsq + (size_t)row * 16); const f32x4 a = p[0], b = p[1], c = p[2], d = p[3];
    const float s = (((a[0] + a[1]) + (a[2] + a[3])) + ((b[0] + b[1]) + (b[2] + b[3]))) + (((c[0] + c[1]) + (c[2] + c[3])) + ((d[0] + d[1]) + (d[2] + d[3]))); return rsqrtf(s * (1.0f / 1024.0f) + 1e-6f); }
__device__ __forceinline__ void norm_out(const f32x4 (&x)[2][2], bf16_t* xb, size_t off, float* rsq_out, int row, int fq, int slot) {
    typedef unsigned u32x2 __attribute__((ext_vector_type(2))); float s = 0.f;
#pragma unroll
    for (int bj = 0; bj < 2; ++bj)
#pragma unroll
        for (int n = 0; n < 2; ++n) { const f32x4 v = x[bj][n]; s += (v[0] * v[0] + v[1] * v[1]) + (v[2] * v[2] + v[3] * v[3]); u32x2 w; w.x = cvt_pk_bf16(v[0], v[1]); w.y = cvt_pk_bf16(v[2], v[3]); *(u32x2*)(xb + off + bj * HALF + n * 16) = w; }
    s += __shfl_xor(s, 16); s += __shfl_xor(s, 32);
    if (fq == 0) rsq_out[(size_t)row * 16 + slot] = s;
}
struct EpiBf16SplitR {
    static constexpr bool PERM = true, AFTER_DRAIN = false;
    bf16_t* O0; int ld0; int nt0; bf16_t* O1; int ld1; const float* rsq;
    __device__ __forceinline__ void operator()(const f32x4 (&acc)[2][2][4][2], const Unit& u, int wr, int wc, int fr, int fq) const {
        const bool first = u.pn < nt0; bf16_t* base = first ? O0 : O1; const int ld = first ? ld0 : ld1; const int colt = (first ? u.pn : u.pn - nt0) * BM;
        const int row0 = u.pm * BM + wr * 64 + fr, col0 = colt + wc * 32 + 8 * fq;
#pragma unroll
        for (int ai = 0; ai < 2; ++ai)
#pragma unroll
            for (int m = 0; m < 4; ++m) { const int row = row0 + ai * HALF + m * 16; const float r = rms_r(rsq, row); bf16_t* rowp = base + (size_t)row * ld + col0;
#pragma unroll
                for (int bj = 0; bj < 2; ++bj) { const f32x4 v0 = acc[ai][bj][m][0] * r, v1 = acc[ai][bj][m][1] * r;
                    u32x4 w; w.x = cvt_pk_bf16(v0[0], v0[1]); w.y = cvt_pk_bf16(v0[2], v0[3]); w.z = cvt_pk_bf16(v1[0], v1[1]); w.w = cvt_pk_bf16(v1[2], v1[3]);
                    *(u32x4*)(rowp + bj * HALF) = w; } }
    }
};
struct EpiSwigluR {
    static constexpr bool PERM = false, AFTER_DRAIN = false;
    bf16_t* H; int ldh; const float* rsq;
    __device__ __forceinline__ void operator()(const f32x4 (&acc)[2][2][4][2], const Unit& u, int wr, int wc, int fr, int fq) const {
        const int row0 = u.pm * BM + wr * 64 + fr, hc0 = u.pn * (BM / 2) + wc * 16 + 4 * fq;
#pragma unroll
        for (int ai = 0; ai < 2; ++ai)
#pragma unroll
            for (int m = 0; m < 4; ++m) { const int row = row0 + ai * HALF + m * 16; const float r = rms_r(rsq, row); bf16_t* rowp = H + (size_t)row * ldh + hc0;
#pragma unroll
                for (int bj = 0; bj < 2; ++bj) { const f32x4 g = acc[ai][bj][m][0] * r, up = acc[ai][bj][m][1] * r; float h[4];
#pragma unroll
                    for (int i = 0; i < 4; ++i) h[i] = g[i] * sigmoidf_(g[i]) * up[i];
                    typedef unsigned u32x2 __attribute__((ext_vector_type(2)));
                    u32x2 w; w.x = cvt_pk_bf16(h[0], h[1]); w.y = cvt_pk_bf16(h[2], h[3]);
                    *(u32x2*)(rowp + bj * (HALF / 2)) = w; } }
    }
};
struct EpiResN {
    static constexpr bool PERM = false, AFTER_DRAIN = false;
    const float* base; float* out; int ldc; bf16_t* XBo; float* rsq_out;
    __device__ __forceinline__ void operator()(const f32x4 (&acc)[2][2][4][2], const Unit& u, int wr, int wc, int fr, int fq) const {
        const int row0 = u.pm * BM + wr * 64 + fr, col0 = u.pn * BM + wc * 32 + 4 * fq;
#pragma unroll
        for (int ai = 0; ai < 2; ++ai)
#pragma unroll
            for (int m = 0; m < 4; ++m) { const int row = row0 + ai * HALF + m * 16; const size_t off = (size_t)row * ldc + col0; f32x4 x[2][2];
#pragma unroll
                for (int bj = 0; bj < 2; ++bj)
#pragma unroll
                    for (int n = 0; n < 2; ++n) { const f32x4 b = *(const f32x4*)(base + off + bj * HALF + n * 16); x[bj][n] = b + acc[ai][bj][m][n]; *(f32x4*)(out + off + bj * HALF + n * 16) = x[bj][n]; }
                if (XBo) norm_out(x, XBo, off, rsq_out, row, fq, u.pn * 4 + wc); }
    }
};
struct EpiPleN {
    static constexpr bool PERM = false, AFTER_DRAIN = false;
    const float* base; float* out; const bf16_t* E; int ldc; const float* rsq_in; bf16_t* XBo; float* rsq_out;
    __device__ __forceinline__ void operator()(const f32x4 (&acc)[2][2][4][2], const Unit& u, int wr, int wc, int fr, int fq) const {
        const int row0 = u.pm * BM + wr * 64 + fr, col0 = u.pn * BM + wc * 32 + 4 * fq;
        typedef unsigned u32x2 __attribute__((ext_vector_type(2)));
#pragma unroll
        for (int ai = 0; ai < 2; ++ai)
#pragma unroll
            for (int m = 0; m < 4; ++m) { const int row = row0 + ai * HALF + m * 16; const size_t off = (size_t)row * ldc + col0; const float r = rms_r(rsq_in, row); f32x4 x[2][2];
#pragma unroll
                for (int bj = 0; bj < 2; ++bj)
#pragma unroll
                    for (int n = 0; n < 2; ++n) { const size_t o = off + bj * HALF + n * 16; const f32x4 b = *(const f32x4*)(base + o); const u32x2 e = *(const u32x2*)(E + o); const f32x4 a = acc[ai][bj][m][n] * r;
                        f32x4 v; v[0] = b[0] + __uint_as_float(e.x << 16) * sigmoidf_(a[0]); v[1] = b[1] + __uint_as_float(e.x & 0xffff0000u) * sigmoidf_(a[1]);
                        v[2] = b[2] + __uint_as_float(e.y << 16) * sigmoidf_(a[2]); v[3] = b[3] + __uint_as_float(e.y & 0xffff0000u) * sigmoidf_(a[3]);
                        x[bj][n] = v; *(f32x4*)(out + o) = v; }
                if (XBo) norm_out(x, XBo, off, rsq_out, row, fq, u.pn * 4 + wc); }
    }
};
__device__ __forceinline__ f32x4 ld_base4(const float* p) { return *(const f32x4*)p; }
__device__ __forceinline__ f32x4 ld_base4(const bf16_t* p) { typedef unsigned u32x2 __attribute__((ext_vector_type(2))); const u32x2 e = *(const u32x2*)p; return (f32x4){__uint_as_float(e.x << 16), __uint_as_float(e.x & 0xffff0000u), __uint_as_float(e.y << 16), __uint_as_float(e.y & 0xffff0000u)}; }
template <class BaseT> struct EpiRes2 {
    static constexpr bool PERM = false, AFTER_DRAIN = false;
    const BaseT* base; bf16_t* out; int ldc; float* rsq_out;
    __device__ __forceinline__ void operator()(const f32x4 (&acc)[2][2][4][2], const Unit& u, int wr, int wc, int fr, int fq) const {
        const int row0 = u.pm * BM + wr * 64 + fr, col0 = u.pn * BM + wc * 32 + 4 * fq;
#pragma unroll
        for (int ai = 0; ai < 2; ++ai)
#pragma unroll
            for (int m = 0; m < 4; ++m) { const int row = row0 + ai * HALF + m * 16; const size_t off = (size_t)row * ldc + col0; f32x4 x[2][2];
#pragma unroll
                for (int bj = 0; bj < 2; ++bj)
#pragma unroll
                    for (int n = 0; n < 2; ++n) x[bj][n] = ld_base4(base + off + bj * HALF + n * 16) + acc[ai][bj][m][n];
                norm_out(x, out, off, rsq_out, row, fq, u.pn * 4 + wc); }
    }
};
template <bool OUT_F32> struct EpiPle2 {
    static constexpr bool PERM = false, AFTER_DRAIN = false;
    const bf16_t* base; void* out; const bf16_t* E; int ldc; const float* rsq_in; float* rsq_out;
    __device__ __forceinline__ void operator()(const f32x4 (&acc)[2][2][4][2], const Unit& u, int wr, int wc, int fr, int fq) const {
        const int row0 = u.pm * BM + wr * 64 + fr, col0 = u.pn * BM + wc * 32 + 4 * fq;
#pragma unroll
        for (int ai = 0; ai < 2; ++ai)
#pragma unroll
            for (int m = 0; m < 4; ++m) { const int row = row0 + ai * HALF + m * 16; const size_t off = (size_t)row * ldc + col0; const float r = rms_r(rsq_in, row); f32x4 x[2][2];
#pragma unroll
                for (int bj = 0; bj < 2; ++bj)
#pragma unroll
                    for (int n = 0; n < 2; ++n) { const size_t o = off + bj * HALF + n * 16; const f32x4 b = ld_base4(base + o), e = ld_base4(E + o), a = acc[ai][bj][m][n] * r; f32x4 v;
#pragma unroll
                        for (int i = 0; i < 4; ++i) v[i] = b[i] + e[i] * sigmoidf_(a[i]);
                        x[bj][n] = v; if (OUT_F32) *(f32x4*)((float*)out + o) = v; }
                if (!OUT_F32) norm_out(x, (bf16_t*)out, off, rsq_out, row, fq, u.pn * 4 + wc); }
    }
};
}
#ifndef PG8_SP2
#define PG8_SP2 true
#endif
#ifndef PG8_ALIGN
#define PG8_ALIGN true
#endif
constexpr int NB = 32, SEQ = 2048, T = NB * SEQ, D = 1024;
constexpr int NU = 2816, UA_W = 1024, UB_W = 1792;
constexpr int FF = 2816, CI = 2048, TH = T / 2;
constexpr int NWAVES = 8;
constexpr float NORM_EPS = 1e-6f, LOG2E = 1.4426950408889634f;
constexpr int UA_K = 512, UA_V = 576, UA_IQ = 640, UA_IK = 896, UA_IW = 960;
constexpr size_t MiB = 1u << 20, QMiB = 1u << 18;
constexpr size_t WS_CTL = 0, CTL_ZERO_BYTES = 1 * MiB;
constexpr size_t WS_WIN = 4 * QMiB, WS_WLORA = 26 * QMiB, WS_WOUT = 29 * QMiB;
constexpr size_t WS_WGU0 = 37 * QMiB, WS_WD0 = 81 * QMiB, WS_WPLE0 = 103 * QMiB, WS_WPG0 = 105 * QMiB, WS_LAYER_STRIDE = 76 * QMiB;
constexpr size_t WS_WUP = 189 * QMiB, WS_WDOWN = 221 * QMiB, WS_W12 = 237 * QMiB;
static_assert(WS_WPG0 + 8 * QMiB == WS_WGU0 + WS_LAYER_STRIDE && WS_WPG0 + WS_LAYER_STRIDE + 8 * QMiB == WS_WUP && WS_W12 + QMiB <= 60 * MiB, "weight map");
constexpr size_t ACT = 60 * MiB;
constexpr size_t WS_XB = ACT, WS_UA = ACT + 128 * MiB, WS_UB = ACT + 256 * MiB, WS_LIN = ACT + 480 * MiB, WS_LOUT = ACT + 512 * MiB;
constexpr size_t WS_QN = ACT + 704 * MiB, WS_KN = ACT + 896 * MiB, WS_VT = ACT + 904 * MiB, WS_MASK = ACT + 912 * MiB;
constexpr size_t WS_XB2 = ACT + 768 * MiB;
constexpr size_t WS_H = ACT + 128 * MiB, WS_E = ACT + 480 * MiB, WS_PB = ACT + 896 * MiB;
constexpr size_t WS_XM = ACT, WS_Z = ACT + 128 * MiB, WS_XC = ACT + 256 * MiB, WS_Q = ACT + 384 * MiB, WS_K = ACT + 512 * MiB, WS_V = ACT + 640 * MiB;
constexpr size_t WS_RS = ACT + 928 * MiB, RS_ONE = (size_t)T * 16 * 4;
constexpr size_t WS_GI = ACT + 952 * MiB, WS_GA = WS_GI + 1 * MiB, WS_GAM = WS_GI + 2 * MiB, WS_GEM = WS_GI + 3 * MiB;
constexpr size_t WS_END = ACT + 956 * MiB;
static_assert(WS_END <= 1024 * MiB, "workspace");
constexpr int CW_TMO = 0, CW_BAR = 4096, CW_XRANK = 8192;
constexpr int LDS_BYTES = 155648;
constexpr int MISC_OFF = LDS_BYTES - 256;
#define GAS __attribute__((address_space(1)))
#define LAS __attribute__((address_space(3)))
typedef unsigned short bf16;
typedef unsigned v4u __attribute__((ext_vector_type(4)));
typedef unsigned v2u __attribute__((ext_vector_type(2)));
typedef float f32x4 __attribute__((ext_vector_type(4)));
typedef float f32x2 __attribute__((ext_vector_type(2)));
typedef float f32x8 __attribute__((ext_vector_type(8)));
typedef short bf16x8 __attribute__((ext_vector_type(8)));
typedef short s16x4 __attribute__((ext_vector_type(4)));
typedef GAS unsigned gu32;
#define RLX_AGENT __ATOMIC_RELAXED, __HIP_MEMORY_SCOPE_AGENT
#define LDS_WAIT() asm volatile("s_waitcnt lgkmcnt(0)" ::: "memory")
#define VM_WAIT() asm volatile("s_waitcnt vmcnt(0)" ::: "memory")
__device__ __forceinline__ unsigned f2bf(float f) { unsigned u = __builtin_bit_cast(unsigned, f); return (u + 0x7fffu + ((u >> 16) & 1u)) >> 16; }

#define XB_TMO      128
#define XB_XCNT(j)  (256  + 64 * (j))
#define XB_XSUB(j)  (1280 + 64 * (j))
#define XB_XGEN(j)  (2304 + 64 * (j))
#define XB_TOP      3328
#define XB_TOPGEN   3392
#define XCD_BAR_WORDS 3456
#define XB_SPIN_CAP (1u << 18)

__device__ __forceinline__ unsigned xb_ld(unsigned* p)              { return __hip_atomic_load(p, __ATOMIC_RELAXED, __HIP_MEMORY_SCOPE_AGENT); }
__device__ __forceinline__ unsigned xb_add(unsigned* p, unsigned v) { return __hip_atomic_fetch_add(p, v, __ATOMIC_RELAXED, __HIP_MEMORY_SCOPE_AGENT); }
__device__ __forceinline__ unsigned xb_xcc_id() { return (unsigned)__builtin_amdgcn_s_getreg((3 << 11) | 20) & 0xFu; }
#define XB_SPIN(cond, bar) do { unsigned _sp = 0; while (cond) { __builtin_amdgcn_s_sleep(1); \
    if ((++_sp & 255u) == 0u) { if (xb_ld(&(bar)[XB_TMO])) break; if (_sp > XB_SPIN_CAP) { atomicAdd(&(bar)[XB_TMO], 1u); break; } } } } while (0)

struct XcdBarrier {
    unsigned* bar; unsigned x;
    volatile LAS unsigned* st;
};

__device__ __forceinline__ XcdBarrier xcd_barrier_post(unsigned* bar, volatile LAS unsigned* st) {
    XcdBarrier b; b.bar = bar; b.x = xb_xcc_id(); b.st = st;
    if (threadIdx.x == 0) (void)xb_add(&bar[XB_XCNT(b.x)], 1u);
    return b;
}
__device__ __forceinline__ void xcd_barrier_complete(unsigned* bar, unsigned x, unsigned& nloc, unsigned& nx) {
    const unsigned G = gridDim.x * gridDim.y * gridDim.z;
    unsigned sum, cnt, mine, sp = 0u;
    for (;;) {
        sum = 0u; cnt = 0u; mine = 0u;
#pragma unroll
        for (unsigned j = 0; j < 16; ++j) { const unsigned c = xb_ld(&bar[XB_XCNT(j)]); sum += c; cnt += (c > 0u) ? 1u : 0u; mine = (j == x) ? c : mine; }
        if (sum == G) break;
        __builtin_amdgcn_s_sleep(1);
        if ((++sp & 255u) == 0u) { if (xb_ld(&bar[XB_TMO])) break; if (sp > XB_SPIN_CAP) { atomicAdd(&bar[XB_TMO], 1u); break; } }
    }
    nloc = mine > 0u ? mine : 1u; nx = cnt > 0u ? cnt : 1u;
}

__device__ __forceinline__ void xcd_barrier(const XcdBarrier& b) {
    asm volatile("s_waitcnt vmcnt(0)" ::: "memory");
    __syncthreads();
    if (threadIdx.x == 0) {
        unsigned* bar = b.bar;
        __builtin_amdgcn_s_waitcnt(0);
        unsigned nloc = b.st[0], nx = b.st[1];
        if (nloc == 0u) { xcd_barrier_complete(bar, b.x, nloc, nx); b.st[0] = nloc; b.st[1] = nx; }
        const unsigned old = xb_add(&bar[XB_XSUB(b.x)], 1u);
        const unsigned gen = old / nloc;
        if (old + 1u == (gen + 1u) * nloc) {
            __builtin_amdgcn_fence(__ATOMIC_RELEASE, "agent");
            asm volatile("s_waitcnt vmcnt(0)" ::: "memory");
            const unsigned og = xb_add(&bar[XB_TOP], 1u);
            const unsigned tg = og / nx;
            if (og + 1u == (tg + 1u) * nx) xb_add(&bar[XB_TOPGEN], 1u);
            else XB_SPIN(xb_ld(&bar[XB_TOPGEN]) == tg, bar);
            __builtin_amdgcn_fence(__ATOMIC_ACQUIRE, "agent");
            xb_add(&bar[XB_XGEN(b.x)], 1u);
            asm volatile("s_waitcnt vmcnt(0)" ::: "memory");
        } else {
            XB_SPIN(xb_ld(&bar[XB_XGEN(b.x)]) == gen, bar);
            __builtin_amdgcn_fence(__ATOMIC_ACQUIRE, "agent");
            asm volatile("s_waitcnt vmcnt(0)" ::: "memory");
        }
    }
    __syncthreads();
}

struct Frame {
    LAS unsigned char* lds;
    unsigned char* ws;
    const float* const* in;
    int tid, lane, wave, G, bid;
};
struct Args { const float* in[37]; float* out; unsigned char* ws; int ph_lo, ph_hi, use_bar, pad; };

__device__ __forceinline__ float dpp_f(float v, int ctrl_qp1) { return v; }
#define DPP_MOVF(v, ctrl) __builtin_bit_cast(float, __builtin_amdgcn_mov_dpp(__builtin_bit_cast(int, (v)), (ctrl), 0xf, 0xf, true))
__device__ __forceinline__ float wave_sum(float v) {
    v += DPP_MOVF(v, 0xB1);
    v += DPP_MOVF(v, 0x4E);
    v += DPP_MOVF(v, 0x141);
    v += DPP_MOVF(v, 0x140);
    v += __shfl_xor(v, 16); v += __shfl_xor(v, 32);
    return v;
}
__device__ __forceinline__ float wave_max(float v) {
#pragma unroll
    for (int o = 1; o < 64; o <<= 1) v = fmaxf(v, __shfl_xor(v, o));
    return v;
}
__device__ __forceinline__ float bflo(unsigned u) { return __uint_as_float(u << 16); }
__device__ __forceinline__ float bfhi(unsigned u) { return __uint_as_float(u & 0xffff0000u); }
__device__ __forceinline__ float bf1(bf16 h) { return __uint_as_float(((unsigned)h) << 16); }
__device__ __forceinline__ unsigned pk2(float lo, float hi) { return pg8::cvt_pk_bf16(lo, hi); }
__device__ __forceinline__ float sigm(float x) { return __builtin_amdgcn_rcpf(1.0f + __builtin_amdgcn_exp2f(-LOG2E * x)); }
__device__ __forceinline__ float softplusf_(float x) { return fmaxf(x, 0.f) + log1pf(__expf(-fabsf(x))); }
__device__ __forceinline__ void unpack8(const v4u& r, float (&f)[8]) { f[0] = bflo(r.x); f[1] = bfhi(r.x); f[2] = bflo(r.y); f[3] = bfhi(r.y); f[4] = bflo(r.z); f[5] = bfhi(r.z); f[6] = bflo(r.w); f[7] = bfhi(r.w); }
__device__ __forceinline__ v4u pack8(const float (&f)[8]) { v4u o; o.x = pk2(f[0], f[1]); o.y = pk2(f[2], f[3]); o.z = pk2(f[4], f[5]); o.w = pk2(f[6], f[7]); return o; }

template <class Fn> __device__ __forceinline__ void wprep(bf16* dst, int N, int K, Fn f, int gt, int NT) {
    const int lane = gt & 63, gwv = gt >> 6, NW = NT >> 6, ntn = N >> 3, tiles = ntn * (K >> 6);
    for (int tl = gwv; tl < tiles; tl += NW) { const int n = (tl % ntn) * 8 + (lane & 7), k0 = (tl / ntn) * 64 + (lane >> 3) * 8; float v[8];
#pragma unroll
        for (int j = 0; j < 8; ++j) v[j] = f(k0 + j, n);
        *(v4u*)(dst + (size_t)n * K + k0) = pack8(v); }
}
template <class Fn> __device__ __forceinline__ void wprep_tile(bf16* dst, int N, int K, Fn f, int tl, int lane) {
    const int ntn = N >> 3; const int n = (tl % ntn) * 8 + (lane & 7), k0 = (tl / ntn) * 64 + (lane >> 3) * 8; float v[8];
#pragma unroll
    for (int j = 0; j < 8; ++j) v[j] = f(k0 + j, n);
    *(v4u*)(dst + (size_t)n * K + k0) = pack8(v);
}
constexpr int DT_WOUT = (D / 8) * (D / 64), DT_GU = (2 * FF / 8) * (D / 64), DT_WD = (D / 8) * (FF / 64), DT_PLE = (D / 8) * (256 / 64), DT_PG = (D / 8) * (D / 64), DT_LAYER = DT_GU + DT_WD + DT_PLE + DT_PG;
constexpr int DT_UP = (2 * CI / 8) * (D / 64), DT_DOWN = (D / 8) * (CI / 64), DT_TOTAL = DT_WOUT + 2 * DT_LAYER + DT_UP + DT_DOWN;
__device__ __forceinline__ void prep_deferred_tile(Frame& F, const Args& a, int tl) {
    unsigned char* ws = F.ws; const int lane = F.lane;
    if (tl < DT_WOUT) { const float* W = a.in[17]; wprep_tile((bf16*)(ws + WS_WOUT), D, D, [=](int k, int n) { return W[(size_t)k * D + n]; }, tl, lane); return; }
    tl -= DT_WOUT;
    if (tl < 2 * DT_LAYER) { const int L = tl >= DT_LAYER ? 1 : 0; tl -= L * DT_LAYER;
        const float* wg = a.in[31] + (size_t)L * D * FF; const float* wu = a.in[32] + (size_t)L * D * FF; const float* wd = a.in[33] + (size_t)L * FF * D;
        const float* wp = a.in[34] + (size_t)L * 256 * D; const float* wpg = a.in[36] + (size_t)L * D * D; const float* gnf = a.in[30] + L * D; const float* gnp = a.in[35] + L * D;
        if (tl < DT_GU) { wprep_tile((bf16*)(ws + WS_WGU0 + L * WS_LAYER_STRIDE), 2 * FF, D, [=](int k, int n) { const int hid = 16 * (n >> 5) + (n & 15); return ((n & 31) >= 16 ? wu : wg)[(size_t)k * FF + hid] * gnf[k]; }, tl, lane); return; }
        tl -= DT_GU;
        if (tl < DT_WD) { wprep_tile((bf16*)(ws + WS_WD0 + L * WS_LAYER_STRIDE), D, FF, [=](int k, int n) { return wd[(size_t)k * D + n]; }, tl, lane); return; }
        tl -= DT_WD;
        if (tl < DT_PLE) { wprep_tile((bf16*)(ws + WS_WPLE0 + L * WS_LAYER_STRIDE), D, 256, [=](int k, int n) { return wp[(size_t)k * D + n]; }, tl, lane); return; }
        tl -= DT_PLE;
        wprep_tile((bf16*)(ws + WS_WPG0 + L * WS_LAYER_STRIDE), D, D, [=](int k, int n) { return wpg[(size_t)k * D + n] * gnp[k]; }, tl, lane); return; }
    tl -= 2 * DT_LAYER;
    if (tl < DT_UP) { const float* W = a.in[18]; const float* gn1 = a.in[2] + D; wprep_tile((bf16*)(ws + WS_WUP), 2 * CI, D, [=](int k, int n) { return W[(size_t)k * (2 * CI) + n] * gn1[k]; }, tl, lane); return; }
    tl -= DT_UP;
    if (tl < DT_DOWN) { const float* W = a.in[29]; wprep_tile((bf16*)(ws + WS_WDOWN), D, CI, [=](int k, int n) { return W[(size_t)k * D + n]; }, tl, lane); }
}
__device__ __forceinline__ void phase_prologue(Frame& F, const Args& a) {
    const int gt = F.bid * 512 + F.tid, NT = F.G * 512; unsigned char* ws = F.ws;
    { const float* W = a.in[5]; const float* gn0 = a.in[2];
      wprep((bf16*)(ws + WS_WIN), NU, D, [=](int k, int n) { const int c = n < 964 ? n : (n < 1024 ? -1 : n - 60); return c < 0 ? 0.f : W[(size_t)k * 2756 + c] * gn0[k]; }, gt, NT); }
    { const float* w2 = a.in[8]; const float* a2 = a.in[10]; const float* g2 = a.in[11];
      wprep((bf16*)(ws + WS_WLORA), 1536, 256, [=](int k, int n) { if (n < 512) return k < 64 ? w2[k * 512 + n] : 0.f; if (n < 1024) return (k >= 64 && k < 128) ? a2[(k - 64) * 512 + n - 512] : 0.f; return k >= 128 ? g2[(k - 128) * 512 + n - 1024] : 0.f; }, gt, NT); }
    { const float* wq = a.in[21]; const float* wk = a.in[22]; const float* wv = a.in[23]; const float* wif = a.in[24]; float* W12 = (float*)(ws + WS_W12);
      for (int it = gt; it < 4096 * 8; it += NT) { const int o = it & 7, c = (it >> 3) & 2047, part = it >> 14, g = c >> 2, i = c & 3; float s = 0.f;
          if (part == 0) { for (int j = 0; j < 4; ++j) s += wq[(g * 4 + i) * 4 + j] * wif[(size_t)(4 * g + j) * 8 + o] + wk[(g * 4 + i) * 4 + j] * wif[(size_t)(2048 + 4 * g + j) * 8 + o]; }
          else { for (int j = 0; j < 4; ++j) s += wv[(g * 4 + i) * 4 + j] * wif[(size_t)(4096 + 4 * g + j) * 8 + o]; }
          W12[it] = s; } }
}
__device__ __forceinline__ void phase_norm(Frame& F, const float* src, const float* gain, bf16* dst, int nrows) {
    const int gw = F.bid * NWAVES + F.wave, NGW = F.G * NWAVES, lane = F.lane;
    f32x4 g[4];
#pragma unroll
    for (int j = 0; j < 4; ++j) g[j] = *((const f32x4*)gain + lane + 64 * j);
    for (int m = gw; m < nrows; m += NGW) {
        const f32x4* xr = (const f32x4*)(src + (size_t)m * D) + lane; f32x4 v[4]; float s = 0.f;
#pragma unroll
        for (int j = 0; j < 4; ++j) { v[j] = xr[64 * j]; s += (v[j].x * v[j].x + v[j].y * v[j].y) + (v[j].z * v[j].z + v[j].w * v[j].w); }
        const float r = rsqrtf(wave_sum(s) * (1.f / D) + NORM_EPS);
        v2u* o = (v2u*)(dst + (size_t)m * D) + lane;
#pragma unroll
        for (int j = 0; j < 4; ++j) { v2u w; w.x = pk2(v[j].x * r * g[j].x, v[j].y * r * g[j].y); w.y = pk2(v[j].z * r * g[j].z, v[j].w * r * g[j].w); o[64 * j] = w; }
    }
}
__device__ __forceinline__ void phase_cast_sq(Frame& F, const float* src, bf16* dst, float* rsq, int nrows) {
    const int gw = F.bid * NWAVES + F.wave, NGW = F.G * NWAVES, lane = F.lane;
    for (int m = gw; m < nrows; m += 2 * NGW) { const int m2 = m + NGW; const bool has2 = m2 < nrows;
        const f32x4* xr = (const f32x4*)(src + (size_t)m * D) + lane; const f32x4* xr2 = (const f32x4*)(src + (size_t)(has2 ? m2 : m) * D) + lane; f32x4 v[4], u[4]; float s = 0.f, s2 = 0.f;
#pragma unroll
        for (int j = 0; j < 4; ++j) { v[j] = xr[64 * j]; u[j] = xr2[64 * j]; }
#pragma unroll
        for (int j = 0; j < 4; ++j) { s += (v[j].x * v[j].x + v[j].y * v[j].y) + (v[j].z * v[j].z + v[j].w * v[j].w); s2 += (u[j].x * u[j].x + u[j].y * u[j].y) + (u[j].z * u[j].z + u[j].w * u[j].w); }
        s = wave_sum(s); s2 = wave_sum(s2);
        if (lane < 16) rsq[(size_t)m * 16 + lane] = lane == 0 ? s : 0.f;
        v2u* o = (v2u*)(dst + (size_t)m * D) + lane;
#pragma unroll
        for (int j = 0; j < 4; ++j) { v2u w; w.x = pk2(v[j].x, v[j].y); w.y = pk2(v[j].z, v[j].w); o[64 * j] = w; }
        if (has2) { if (lane < 16) rsq[(size_t)m2 * 16 + lane] = lane == 0 ? s2 : 0.f;
            v2u* o2 = (v2u*)(dst + (size_t)m2 * D) + lane;
#pragma unroll
            for (int j = 0; j < 4; ++j) { v2u w; w.x = pk2(u[j].x, u[j].y); w.y = pk2(u[j].z, u[j].w); o2[64 * j] = w; } }
    }
}
__device__ __forceinline__ void phase_cvt_p(Frame& F, const float* p, bf16* pb) {
    const size_t gt = (size_t)F.bid * 512 + F.tid, NT = (size_t)F.G * 512, n8 = (size_t)T * 256 / 8;
    for (size_t i0 = gt; i0 < n8; i0 += 4 * NT) { f32x4 a[4], b[4];
#pragma unroll
        for (int q4 = 0; q4 < 4; ++q4) { const size_t i = i0 + q4 * NT; if (i < n8) { a[q4] = *((const f32x4*)p + 2 * i); b[q4] = *((const f32x4*)p + 2 * i + 1); } }
#pragma unroll
        for (int q4 = 0; q4 < 4; ++q4) { const size_t i = i0 + q4 * NT; if (i < n8) { v4u o; o.x = pk2(a[q4].x, a[q4].y); o.y = pk2(a[q4].z, a[q4].w); o.z = pk2(b[q4].x, b[q4].y); o.w = pk2(b[q4].z, b[q4].w); *((v4u*)pb + i) = o; } } }
}
constexpr float QSCALE = 0.125f * LOG2E;
__device__ __forceinline__ void phase_prepA(Frame& F, const Args& a) {
    unsigned char* ws = F.ws; const bf16* UA = (const bf16*)(ws + WS_UA); const bf16* UB = (const bf16*)(ws + WS_UB);
    bf16* LIN = (bf16*)(ws + WS_LIN); bf16* QN = (bf16*)(ws + WS_QN); bf16* KN = (bf16*)(ws + WS_KN); bf16* VT = (bf16*)(ws + WS_VT);
    const float* mu = a.in[6]; const float* gq = a.in[3]; const float* gk = a.in[4];
    { const int gt = F.bid * 512 + F.tid, NT = F.G * 512; const int c8 = (gt & 31) << 3; float muv[8];
#pragma unroll
      for (int j = 0; j < 8; ++j) muv[j] = mu[1536 + c8 + j];
      for (int it0 = gt; it0 < T * 32; it0 += 4 * NT) { v4u ru[4], rp[4];
#pragma unroll
          for (int q4 = 0; q4 < 4; ++q4) { const int it = it0 + q4 * NT; if (it < T * 32) { const int t = it >> 5; ru[q4] = *(const v4u*)(UB + (size_t)t * UB_W + 1536 + c8); rp[q4] = *(const v4u*)(UB + (size_t)((t & (SEQ - 1)) ? t - 1 : t) * UB_W + 1536 + c8); } }
#pragma unroll
          for (int q4 = 0; q4 < 4; ++q4) { const int it = it0 + q4 * NT; if (it < T * 32) { const int t = it >> 5; float u[8], p[8], o[8]; unpack8(ru[q4], u); unpack8(rp[q4], p); const float pm = (t & (SEQ - 1)) ? 1.f : 0.f;
#pragma unroll
              for (int j = 0; j < 8; ++j) { const float s = u[j] + muv[j] * (p[j] * pm - u[j]); o[j] = c8 < 64 ? (1.0f - 2.0f * __builtin_amdgcn_rcpf(1.0f + __builtin_amdgcn_exp2f(2.0f * LOG2E * s))) : (c8 < 128 ? s : sigm(s));     }
              *(v4u*)(LIN + (size_t)t * 256 + c8) = pack8(o); } } } }
    { const int gw = F.bid * NWAVES + F.wave, NGW = F.G * NWAVES, lane = F.lane; float gqv[8], gkv[8];
#pragma unroll
      for (int j = 0; j < 8; ++j) { gqv[j] = gq[((lane & 7) << 3) + j] * QSCALE; gkv[j] = gk[((lane & 7) << 3) + j]; }
      for (int t0 = gw; t0 < T; t0 += 4 * NGW) { v4u rq[4], rk[4];
#pragma unroll
          for (int q4 = 0; q4 < 4; ++q4) { const int t = t0 + q4 * NGW; if (t < T) { rq[q4] = *(const v4u*)(UA + (size_t)t * UA_W + 8 * lane); rk[q4] = *(const v4u*)(UA + (size_t)t * UA_W + UA_K + 8 * (lane & 7)); } }
#pragma unroll
          for (int q4 = 0; q4 < 4; ++q4) { const int t = t0 + q4 * NGW; if (t < T) {
              float q[8], k[8]; unpack8(rq[q4], q); unpack8(rk[q4], k);
              float sq = 0.f, sk = 0.f;
#pragma unroll
              for (int j = 0; j < 8; ++j) { sq += q[j] * q[j]; sk += k[j] * k[j]; }
              sq += __shfl_xor(sq, 1); sq += __shfl_xor(sq, 2); sq += __shfl_xor(sq, 4); sk += __shfl_xor(sk, 1); sk += __shfl_xor(sk, 2); sk += __shfl_xor(sk, 4);
              const float rq_ = rsqrtf(sq * (1.f / 64.f) + NORM_EPS), rk_ = rsqrtf(sk * (1.f / 64.f) + NORM_EPS);
#pragma unroll
              for (int j = 0; j < 8; ++j) { q[j] *= rq_ * gqv[j]; k[j] *= rk_ * gkv[j]; }
              *(v4u*)(QN + (size_t)t * 512 + 8 * lane) = pack8(q);
              if (lane < 8) *(v4u*)(KN + (size_t)t * 64 + 8 * lane) = pack8(k); } } } }
    { const int gt = F.bid * 512 + F.tid, NT = F.G * 512;
      for (int it = gt; it < T * 8; it += NT) { const int t = it >> 3, c8 = (it & 7) << 3; *(v4u*)(VT + (size_t)t * 64 + c8) = *(const v4u*)(UA + (size_t)t * UA_W + UA_V + c8); } }
}
constexpr int IDX_STRIDE = 2052, KSEL = 256;
__device__ __forceinline__ void topk_select(const LAS float* row, int limit, unsigned* maskrow, int lane) {
    unsigned long long mybits = 0ull; const int nj = limit >> 6;
    if (limit <= KSEL) { mybits = lane < nj ? ~0ull : 0ull; }
    else {
        unsigned key[32];
#pragma unroll
        for (int j = 0; j < 32; ++j) key[j] = 0u;
#pragma unroll
        for (int g8 = 0; g8 < 4; ++g8) if (8 * g8 < nj) {
#pragma unroll
            for (int jj = 0; jj < 8; ++jj) { const int j = 8 * g8 + jj; unsigned u = __float_as_uint(row[64 * j + lane]); if (u == 0x80000000u) u = 0u; const unsigned k = (u & 0x80000000u) ? ~u : (u | 0x80000000u); key[j] = (j < nj) ? k : 0u; } }
        unsigned prefix = 0u; bool exact = false;
        for (int bit = 31; bit >= 0; --bit) { const unsigned cand = prefix | (1u << bit); int c0 = 0, c1 = 0;
#pragma unroll
            for (int g8 = 0; g8 < 4; ++g8) if (8 * g8 < nj) {
#pragma unroll
                for (int jj = 0; jj < 8; jj += 2) { c0 += __builtin_popcountll(__ballot(key[8 * g8 + jj] >= cand)); c1 += __builtin_popcountll(__ballot(key[8 * g8 + jj + 1] >= cand)); } }
            const int cnt = c0 + c1;
            if (cnt >= KSEL) { prefix = cand; if (cnt == KSEL) { exact = true; break; } } }
        int need = 0;
        if (!exact) { int cgt = 0;
#pragma unroll
            for (int j = 0; j < 32; ++j) cgt += __builtin_popcountll(__ballot(key[j] > prefix));
            need = KSEL - cgt; }
        int running = 0; const unsigned long long below = (1ull << lane) - 1ull;
#pragma unroll
        for (int g8 = 0; g8 < 4; ++g8) if (8 * g8 < nj)
#pragma unroll
        for (int jj = 0; jj < 8; ++jj) { const int j = 8 * g8 + jj;
            const bool gt = exact ? (key[j] >= prefix) : (key[j] > prefix); const bool tie = (!exact) && key[j] == prefix;
            const unsigned long long tb = __ballot(tie); const int rank = running + __builtin_popcountll(tb & below); running += __builtin_popcountll(tb);
            const unsigned long long sb = __ballot(gt || (tie && rank < need)); if (lane == j) mybits = sb; }
    }
    if (lane < 32) { v2u w; w.x = (unsigned)mybits; w.y = (unsigned)(mybits >> 32); *(v2u*)(maskrow + 2 * lane) = w; }
}
__device__ __forceinline__ void phase_indexer(Frame& F) {
    unsigned char* ws = F.ws; const bf16* UA = (const bf16*)(ws + WS_UA); unsigned* MASK = (unsigned*)(ws + WS_MASK);
    LAS float* sc = (LAS float*)F.lds; const int lane = F.lane, w = F.wave, fr = lane & 15, fq = lane >> 4;
    for (int r = 0;; ++r) { const int u = r * F.G + ((r & 1) ? (F.G - 1 - F.bid) : F.bid); if (u >= NB * 128) break;
        const int c = 31 - (u >> 7), rest = u & 127, b = rest >> 2, g4 = rest & 3, limit = 64 * (c + 1), tq0 = b * SEQ + c * 64 + g4 * 16;
        const bf16* UAb = UA + (size_t)b * SEQ * UA_W;
        bf16x8 qf[4][2]; float iwv[4];
        { const bf16* qp = UA + (size_t)(tq0 + fr) * UA_W;
#pragma unroll
          for (int hh = 0; hh < 4; ++hh) { qf[hh][0] = *(const bf16x8*)(qp + UA_IQ + hh * 64 + fq * 8); qf[hh][1] = *(const bf16x8*)(qp + UA_IQ + hh * 64 + 32 + fq * 8); iwv[hh] = bf1(qp[UA_IW + hh]) * (1.f / 16.f); } }
#ifndef IDX_SCORE_REP
#define IDX_SCORE_REP 1
#endif
#ifndef IDX_SEL_REP
#define IDX_SEL_REP 1
#endif
        for (int rp_ = 0; rp_ < IDX_SCORE_REP; ++rp_)
        for (int kt = w; kt < (limit >> 4); kt += NWAVES) {
            const bf16* kp = UAb + (size_t)(kt * 16 + fr) * UA_W + UA_IK + fq * 8; const bf16x8 a0 = *(const bf16x8*)kp, a1 = *(const bf16x8*)(kp + 32);
            f32x4 s = {0.f, 0.f, 0.f, 0.f};
#pragma unroll
            for (int hh = 0; hh < 4; ++hh) { f32x4 d = {0.f, 0.f, 0.f, 0.f}; d = __builtin_amdgcn_mfma_f32_16x16x32_bf16(a0, qf[hh][0], d, 0, 0, 0); d = __builtin_amdgcn_mfma_f32_16x16x32_bf16(a1, qf[hh][1], d, 0, 0, 0);
#pragma unroll
                for (int j = 0; j < 4; ++j) s[j] += iwv[hh] * fmaxf(d[j], 0.f); }
            *(LAS f32x4*)(sc + fr * IDX_STRIDE + kt * 16 + fq * 4) = s; }
        __syncthreads();
#pragma unroll 1
        for (int qq = 0; qq < 2 * IDX_SEL_REP; ++qq) { const int q = 2 * w + (qq & 1); topk_select(sc + q * IDX_STRIDE, limit, MASK + (size_t)(tq0 + q) * 64, lane); }
        __syncthreads(); }
}
constexpr int DA_K = 0, DA_V = 8192, DA_M = 16384, DA_STAGE = 16384 + 512;
__device__ __forceinline__ bf16x8 mk8(v2u lo, v2u hi) { v4u t; t.x = lo.x; t.y = lo.y; t.z = hi.x; t.w = hi.y; return __builtin_bit_cast(bf16x8, t); }
__device__ __forceinline__ void tr_read_v4d(unsigned a, bf16x8 (&vf)[4]) { s16x4 l0, h0, l1, h1, l2, h2, l3, h3;
    asm volatile("ds_read_b64_tr_b16 %0, %8\n\tds_read_b64_tr_b16 %1, %8 offset:512\n\tds_read_b64_tr_b16 %2, %8 offset:32\n\tds_read_b64_tr_b16 %3, %8 offset:544\n\t"
                 "ds_read_b64_tr_b16 %4, %8 offset:64\n\tds_read_b64_tr_b16 %5, %8 offset:576\n\tds_read_b64_tr_b16 %6, %8 offset:96\n\tds_read_b64_tr_b16 %7, %8 offset:608\n\ts_waitcnt lgkmcnt(0)"
                 : "=&v"(l0), "=&v"(h0), "=&v"(l1), "=&v"(h1), "=&v"(l2), "=&v"(h2), "=&v"(l3), "=&v"(h3) : "v"(a) : "memory");
    vf[0] = (bf16x8){l0[0], l0[1], l0[2], l0[3], h0[0], h0[1], h0[2], h0[3]}; vf[1] = (bf16x8){l1[0], l1[1], l1[2], l1[3], h1[0], h1[1], h1[2], h1[3]};
    vf[2] = (bf16x8){l2[0], l2[1], l2[2], l2[3], h2[0], h2[1], h2[2], h2[3]}; vf[3] = (bf16x8){l3[0], l3[1], l3[2], l3[3], h3[0], h3[1], h3[2], h3[3]}; }
__device__ __forceinline__ void phase_dsa_attn(Frame& F, const Args& a) {
    unsigned char* ws = F.ws; const bf16* QN = (const bf16*)(ws + WS_QN); const bf16* KN = (const bf16*)(ws + WS_KN); const bf16* VN = (const bf16*)(ws + WS_VT);
    const unsigned* MASK = (const unsigned*)(ws + WS_MASK); bf16* MIX = (bf16*)(ws + WS_XB);
    const int lane = F.lane, w = F.wave, fr = lane & 15, fq = lane >> 4; LAS unsigned char* lds = F.lds;
    const float mb = 8.f * LOG2E * wave_max(fabsf(a.in[3][lane])) * wave_max(fabsf(a.in[4][lane]));
    const unsigned vtr_lane = (unsigned)((8 * fq + ((lane & 15) >> 2)) * 128 + 4 * (lane & 3) * 2);
    for (int r = 0;; ++r) { const int u = r * F.G + ((r & 1) ? (F.G - 1 - F.bid) : F.bid); if (u >= NB * 32) break;
        const int c = 31 - (u >> 5), b = u & 31, nst = c + 1, t0 = b * SEQ + 64 * c;
        const bf16* Kb = KN + (size_t)b * SEQ * 64; const bf16* Vb = VN + (size_t)b * SEQ * 64; const unsigned* Mb = MASK + (size_t)t0 * 64;
#define DA_DMA(st_, buf_) do { const int so_ = (buf_) * DA_STAGE; \
            __builtin_amdgcn_global_load_lds((const unsigned*)(Kb + (size_t)(64 * (st_) + 8 * w) * 64 + lane * 8), (LAS unsigned*)(lds + so_ + DA_K + w * 1024), 16, 0, 0); \
            __builtin_amdgcn_global_load_lds((const unsigned*)(Vb + (size_t)(64 * (st_) + 8 * w) * 64 + lane * 8), (LAS unsigned*)(lds + so_ + DA_V + w * 1024), 16, 0, 0); \
            if (w < 2) __builtin_amdgcn_global_load_lds(Mb + (size_t)lane * 64 + 2 * (st_) + w, (LAS unsigned*)(lds + so_ + DA_M + w * 256), 4, 0, 0); } while (0)
        DA_DMA(0, 0);
        bf16x8 qf[4][2];
#pragma unroll
        for (int i = 0; i < 4; ++i) { const bf16* qp = QN + (size_t)(t0 + 16 * i + fr) * 512 + w * 64 + fq * 8; qf[i][0] = *(const bf16x8*)qp; qf[i][1] = *(const bf16x8*)(qp + 32); }
        f32x4 O[4][4]; float l[4];
#pragma unroll
        for (int i = 0; i < 4; ++i) { l[i] = 0.f;
#pragma unroll
            for (int dt = 0; dt < 4; ++dt) O[i][dt] = (f32x4){0.f, 0.f, 0.f, 0.f}; }
        for (int st = 0; st < nst; ++st) { const int buf = st & 1; const LAS unsigned char* sb = lds + buf * DA_STAGE;
            asm volatile("s_waitcnt vmcnt(0)" ::: "memory");
            __builtin_amdgcn_s_barrier(); asm volatile("" ::: "memory");
            if (st + 1 < nst) DA_DMA(st + 1, buf ^ 1);
#pragma unroll
            for (int sub = 0; sub < 2; ++sub) {
                bf16x8 kf[2][2], vf[4]; unsigned mw[4];
#pragma unroll
                for (int s2 = 0; s2 < 2; ++s2) { const LAS unsigned char* kp = sb + DA_K + (32 * sub + 8 * (fr >> 2) + 4 * s2 + (fr & 3)) * 128 + fq * 16;   kf[s2][0] = *(const LAS bf16x8*)kp; kf[s2][1] = *(const LAS bf16x8*)(kp + 64); }
#pragma unroll
                for (int i = 0; i < 4; ++i) mw[i] = *(const LAS unsigned*)(sb + DA_M + sub * 256 + (16 * i + fr) * 4);
                tr_read_v4d((unsigned)(size_t)(sb + DA_V + sub * 4096) + vtr_lane, vf);
#pragma unroll
                for (int i = 0; i < 4; ++i) {
                    f32x4 s0 = {0.f, 0.f, 0.f, 0.f}, s1 = {0.f, 0.f, 0.f, 0.f};
                    s0 = __builtin_amdgcn_mfma_f32_16x16x32_bf16(kf[0][0], qf[i][0], s0, 0, 0, 0); s0 = __builtin_amdgcn_mfma_f32_16x16x32_bf16(kf[0][1], qf[i][1], s0, 0, 0, 0);
                    s1 = __builtin_amdgcn_mfma_f32_16x16x32_bf16(kf[1][0], qf[i][0], s1, 0, 0, 0); s1 = __builtin_amdgcn_mfma_f32_16x16x32_bf16(kf[1][1], qf[i][1], s1, 0, 0, 0);
                    const unsigned b0 = mw[i] >> (8 * fq), b1 = mw[i] >> (8 * fq + 4); float p[8];
#pragma unroll
                    for (int j = 0; j < 4; ++j) { p[j] = ((b0 >> j) & 1u) ? __builtin_amdgcn_exp2f(s0[j] - mb) : 0.f; p[4 + j] = ((b1 >> j) & 1u) ? __builtin_amdgcn_exp2f(s1[j] - mb) : 0.f; }
                    l[i] += ((p[0] + p[1]) + (p[2] + p[3])) + ((p[4] + p[5]) + (p[6] + p[7]));
                    const bf16x8 pa = __builtin_bit_cast(bf16x8, pack8(p));
#pragma unroll
                    for (int dt = 0; dt < 4; ++dt) O[i][dt] = __builtin_amdgcn_mfma_f32_16x16x32_bf16(pa, vf[dt], O[i][dt], 0, 0, 0);
                } } }
#undef DA_DMA
#pragma unroll
        for (int i = 0; i < 4; ++i) { float li = l[i]; li += __shfl_xor(li, 16); li += __shfl_xor(li, 32);
#pragma unroll
            for (int j = 0; j < 4; ++j) { const float inv = 1.0f / __shfl(li, 4 * fq + j); bf16* op = MIX + (size_t)(t0 + 16 * i + 4 * fq + j) * D + w * 64 + fr;
#pragma unroll
                for (int dt = 0; dt < 4; ++dt) op[16 * dt] = (bf16)f2bf(O[i][dt][j] * inv); } }
        VM_WAIT(); __syncthreads();
    }
}
__device__ __forceinline__ float rw_decay(float x) { const float sp = fmaxf(-x, 0.f) + 0.6931471805599453f * __builtin_amdgcn_logf(1.0f + __builtin_amdgcn_exp2f(-LOG2E * fabsf(x)));
    return __builtin_amdgcn_exp2f(-LOG2E * __builtin_amdgcn_exp2f(-LOG2E * (sp + 0.5f))); }
#define MF32(a_, b_, c_) __builtin_amdgcn_mfma_f32_16x16x4f32((a_), (b_), (c_), 0, 0, 0)
constexpr int RT = 68, RG = 20, RGM = 16 * RG;
constexpr int RL_AH = 0, RL_BH = 64 * RT, RL_KH = 2 * 64 * RT, RL_RH = 3 * 64 * RT, RL_VX = 4 * 64 * RT, RL_GS = 5 * 64 * RT, RL_YA = 6 * 64 * RT, RL_GR = 7 * 64 * RT, RL_PM = RL_GR + 16 * RGM, RL_GC = RL_PM + 4 * RGM, RL_BON = RL_GC + 256, RL_END = RL_BON + 64;
static_assert(RL_END * 4 <= MISC_OFF, "RWKV LDS");
__device__ __forceinline__ void phase_rwkv(Frame& F, const Args& a) {
    unsigned char* ws = F.ws; const bf16* UB = (const bf16*)(ws + WS_UB); const bf16* LOUT = (const bf16*)(ws + WS_LOUT); bf16* MIX = (bf16*)(ws + WS_XB);
    const float* mu = a.in[6]; const float* w0 = a.in[7]; const float* a0 = a.in[9]; const float* k_k = a.in[12]; const float* k_a = a.in[13]; const float* r_k = a.in[14]; const float* gn_g = a.in[15]; const float* gn_b = a.in[16];
    const int lane = F.lane, w = F.wave, n = lane & 15, q = lane >> 4;
    LAS float* L = (LAS float*)F.lds;
    for (int bh = F.bid; bh < NB * 8; bh += F.G) {
        const int b = bh >> 3, h = bh & 7, c = h * 64 + lane;
        const float mur = mu[c], muk = mu[512 + c], muv = mu[1024 + c], w0c = w0[c], a0c = a0[c], kkc = k_k[c], kac = k_a[c], rkc = r_k[c], gng = gn_g[c], gnb = gn_b[c];
        f32x4 Z[4];
#pragma unroll
        for (int kt = 0; kt < 4; ++kt) Z[kt] = (f32x4){0.f, 0.f, 0.f, 0.f};
        const int ch = w >> 1, hs = w & 1;
        float r_ur[8], r_uk[8], r_uv[8], r_pr[8], r_pk[8], r_pv[8], r_wd[8], r_ad[8], r_gg[8], r_wf[8];
#define RW_RAW(batch_) do { _Pragma("unroll") for (int i = 0; i < 8; ++i) { const int sl = (batch_) * 64 + 16 * ch + 8 * hs + i; const size_t t = (size_t)b * SEQ + sl; const bf16* up = UB + t * UB_W + c; const bf16* pp_ = sl > 0 ? up - UB_W : up; \
            r_ur[i] = bf1(up[0]); r_uk[i] = bf1(up[512]); r_uv[i] = bf1(up[1024]); r_pr[i] = bf1(pp_[0]); r_pk[i] = bf1(pp_[512]); r_pv[i] = bf1(pp_[1024]); \
            const bf16* lp = LOUT + t * 1536 + c; r_wd[i] = bf1(lp[0]); r_ad[i] = bf1(lp[512]); r_gg[i] = bf1(lp[1024]); \
            r_wf[i] = bf1(LOUT[((size_t)b * SEQ + (batch_) * 64 + 16 * ch + i) * 1536 + c]); } } while (0)
        RW_RAW(0);
        for (int batch = 0; batch < SEQ / 64; ++batch) {
            { float gcur = 1.f;
              if (hs) {
#pragma unroll
                  for (int i = 0; i < 8; ++i) gcur *= rw_decay(w0c + r_wf[i]); }
#pragma unroll
              for (int i = 0; i < 8; ++i) { const int tl = 16 * ch + 8 * hs + i, sl = batch * 64 + tl; const float pm = sl > 0 ? 1.f : 0.f;
                const float ur = r_ur[i], uk = r_uk[i], uv = r_uv[i], pr = r_pr[i] * pm, pk = r_pk[i] * pm, pv = r_pv[i] * pm;
                const float rr = ur + mur * (pr - ur), kx = uk + muk * (pk - uk), vx = uv + muv * (pv - uv);
                const float decay = rw_decay(w0c + r_wd[i]), av = sigm(a0c + r_ad[i]);
                float kk = kx * kkc; kk = kk * rsqrtf(fmaxf(wave_sum(kk * kk), 1e-24f));
                const float km = kx * (1.f + (av - 1.f) * kac); const float bon = wave_sum(rr * km * rkc);
                const float gprev = gcur; gcur *= decay; const float ig = __builtin_amdgcn_rcpf(gcur);
                L[RL_AH + tl * RT + lane] = -kk * gprev; L[RL_BH + tl * RT + lane] = kk * av * ig; L[RL_KH + tl * RT + lane] = km * ig; L[RL_RH + tl * RT + lane] = rr * gcur;
                L[RL_VX + tl * RT + lane] = vx; L[RL_GS + tl * RT + lane] = r_gg[i]; if (lane == 0) L[RL_BON + tl] = bon; }
              if (hs) L[RL_GC + ch * 64 + lane] = gcur; }
            LDS_WAIT(); __syncthreads();
            if (batch + 1 < SEQ / 64) RW_RAW(batch + 1);
            { const LAS float* ah = L + RL_AH + 16 * ch * RT; const LAS float* bhm = L + RL_BH + 16 * ch * RT; const LAS float* khm = L + RL_KH + 16 * ch * RT; const LAS float* rhm = L + RL_RH + 16 * ch * RT;
              LAS float* gr = L + RL_GR + ch * 4 * RGM; LAS float* pm_ = L + RL_PM + ch * RGM;
              if (hs == 0) {
                  f32x4 m = {0.f, 0.f, 0.f, 0.f};
#pragma unroll
                  for (int s = 0; s < 16; ++s) m = MF32(bhm[n * RT + 4 * s + q], ah[n * RT + 4 * s + q], m);
                  f32x4 tm;
#pragma unroll
                  for (int j = 0; j < 4; ++j) { m[j] = (4 * q + j < n) ? m[j] : 0.f; tm[j] = m[j] + ((4 * q + j == n) ? 1.f : 0.f); pm_[(4 * q + j) * RG + n] = m[j]; gr[(4 * q + j) * RG + n] = tm[j]; }
#pragma unroll
                  for (int rd = 0; rd < 3; ++rd) { LDS_WAIT();
                      f32x4 p2 = {0.f, 0.f, 0.f, 0.f};
#pragma unroll
                      for (int s = 0; s < 4; ++s) p2 = MF32(pm_[n * RG + 4 * s + q], pm_[(4 * s + q) * RG + n], p2);
                      f32x4 ip, t2 = {0.f, 0.f, 0.f, 0.f};
#pragma unroll
                      for (int j = 0; j < 4; ++j) ip[j] = p2[j] + ((4 * q + j == n) ? 1.f : 0.f);
#pragma unroll
                      for (int j = 0; j < 4; ++j) t2 = MF32(gr[n * RG + 4 * q + j], ip[j], t2);
                      LDS_WAIT();
#pragma unroll
                      for (int j = 0; j < 4; ++j) { pm_[(4 * q + j) * RG + n] = p2[j]; gr[(4 * q + j) * RG + n] = t2[j]; } }
              } else {
                  f32x4 mk = {0.f, 0.f, 0.f, 0.f}, nb = {0.f, 0.f, 0.f, 0.f}, nk = {0.f, 0.f, 0.f, 0.f};
#pragma unroll
                  for (int s = 0; s < 16; ++s) { const float av_ = ah[n * RT + 4 * s + q], rv_ = rhm[n * RT + 4 * s + q], bv_ = bhm[n * RT + 4 * s + q], kv_ = khm[n * RT + 4 * s + q];
                      mk = MF32(kv_, av_, mk); nb = MF32(bv_, rv_, nb); nk = MF32(kv_, rv_, nk); }
#pragma unroll
                  for (int j = 0; j < 4; ++j) { const int s_ = 4 * q + j; gr[RGM + s_ * RG + n] = (s_ < n) ? mk[j] : 0.f; gr[2 * RGM + s_ * RG + n] = (s_ <= n) ? nb[j] : 0.f; gr[3 * RGM + s_ * RG + n] = (s_ <= n) ? nk[j] : 0.f; } } }
            LDS_WAIT(); __syncthreads();
#ifndef RW_C_REP
#define RW_C_REP 1
#endif
            if (w < 4) { const int v = 16 * w + n; f32x4 Zs[4]; for (int kt = 0; kt < 4; ++kt) Zs[kt] = Z[kt];
              for (int rc_ = 0; rc_ < RW_C_REP; ++rc_) { if (rc_) for (int kt = 0; kt < 4; ++kt) Z[kt] = Zs[kt];
#pragma unroll 1
                for (int cc = 0; cc < 4; ++cc) { const LAS float* ah = L + RL_AH + 16 * cc * RT; const LAS float* bhm = L + RL_BH + 16 * cc * RT; const LAS float* khm = L + RL_KH + 16 * cc * RT; const LAS float* rhm = L + RL_RH + 16 * cc * RT;
                    const LAS float* vx = L + RL_VX + 16 * cc * RT; const LAS float* gr = L + RL_GR + cc * 4 * RGM;
                    float vb[4];
#pragma unroll
                    for (int s = 0; s < 4; ++s) vb[s] = vx[(4 * s + q) * RT + v];
                    f32x4 X = {0.f, 0.f, 0.f, 0.f}, Y = {0.f, 0.f, 0.f, 0.f};
#pragma unroll
                    for (int p = 0; p < 2; ++p) { asm volatile("" ::: "memory"); const f32x4 r0 = *(const LAS f32x4*)(rhm + n * RT + 32 * p + 4 * q), r1 = *(const LAS f32x4*)(rhm + n * RT + 32 * p + 16 + 4 * q);
                        v4u ap, bp; ap.x = pk2(r0[0], r0[1]); ap.y = pk2(r0[2], r0[3]); ap.z = pk2(r1[0], r1[1]); ap.w = pk2(r1[2], r1[3]);
                        bp.x = pk2(Z[2 * p][0], Z[2 * p][1]); bp.y = pk2(Z[2 * p][2], Z[2 * p][3]); bp.z = pk2(Z[2 * p + 1][0], Z[2 * p + 1][1]); bp.w = pk2(Z[2 * p + 1][2], Z[2 * p + 1][3]);
                        Y = __builtin_amdgcn_mfma_f32_16x16x32_bf16(__builtin_bit_cast(bf16x8, ap), __builtin_bit_cast(bf16x8, bp), Y, 0, 0, 0); }
                    __builtin_amdgcn_sched_barrier(0);
#pragma unroll
                    for (int kt = 0; kt < 4; ++kt)
#pragma unroll
                        for (int j = 0; j < 4; ++j) X = MF32(ah[n * RT + 16 * kt + 4 * q + j], Z[kt][j], X);
#pragma unroll
                    for (int s = 0; s < 4; ++s) X = MF32(gr[RGM + (4 * s + q) * RG + n], vb[s], X);
                    f32x4 U = {0.f, 0.f, 0.f, 0.f};
#pragma unroll
                    for (int j = 0; j < 4; ++j) U = MF32(gr[(4 * q + j) * RG + n], X[j], U);
                    { v4u ap, bp; ap.x = pk2(gr[2 * RGM + (4 * q) * RG + n], gr[2 * RGM + (4 * q + 1) * RG + n]); ap.y = pk2(gr[2 * RGM + (4 * q + 2) * RG + n], gr[2 * RGM + (4 * q + 3) * RG + n]);
                      ap.z = pk2(gr[3 * RGM + q * RG + n], gr[3 * RGM + (4 + q) * RG + n]); ap.w = pk2(gr[3 * RGM + (8 + q) * RG + n], gr[3 * RGM + (12 + q) * RG + n]);
                      bp.x = pk2(U[0], U[1]); bp.y = pk2(U[2], U[3]); bp.z = pk2(vb[0], vb[1]); bp.w = pk2(vb[2], vb[3]);
                      Y = __builtin_amdgcn_mfma_f32_16x16x32_bf16(__builtin_bit_cast(bf16x8, ap), __builtin_bit_cast(bf16x8, bp), Y, 0, 0, 0); }
#pragma unroll
                    for (int j = 0; j < 4; ++j) L[RL_YA + (16 * cc + 4 * q + j) * RT + v] = Y[j];
#pragma unroll
                    for (int kt = 0; kt < 4; ++kt) {
#pragma unroll
                        for (int j = 0; j < 4; ++j) Z[kt] = MF32(bhm[(4 * q + j) * RT + 16 * kt + n], U[j], Z[kt]);
#pragma unroll
                        for (int s = 0; s < 4; ++s) Z[kt] = MF32(khm[(4 * s + q) * RT + 16 * kt + n], vb[s], Z[kt]);
                        const f32x4 gc = *(const LAS f32x4*)(L + RL_GC + cc * 64 + 16 * kt + 4 * q); Z[kt] = Z[kt] * gc; } } } }
            else if (F.G == 256) {
#pragma unroll 1
                for (int i2 = 0; i2 < 2; ++i2) { const int tl = (2 * batch + i2) * 1024 + F.bid * 4 + (w - 4); if (tl < DT_TOTAL) prep_deferred_tile(F, a, tl); }
                { const size_t i = ((size_t)(batch * 1024 + F.bid * 4 + (w - 4))) * 64 + lane;
                  const float* p0 = a.in[1]; const f32x4 pa = *((const f32x4*)p0 + 2 * i), pb = *((const f32x4*)p0 + 2 * i + 1); v4u o; o.x = pk2(pa.x, pa.y); o.y = pk2(pa.z, pa.w); o.z = pk2(pb.x, pb.y); o.w = pk2(pb.z, pb.w); *((v4u*)(ws + WS_PB) + i) = o; } }
            LDS_WAIT(); __syncthreads();
#pragma unroll
            for (int i = 0; i < 8; ++i) { const int step = w + 8 * i; const size_t t = (size_t)b * SEQ + batch * 64 + step;
                const float y = L[RL_YA + step * RT + lane], mean = wave_sum(y) * (1.f / 64.f), dlt = y - mean, var = fmaxf(wave_sum(y * y) * (1.f / 64.f) - mean * mean, 0.f);
                const float yn = dlt * rsqrtf(var + 64e-5f) * gng + gnb; const float o = (yn + L[RL_BON + step] * L[RL_VX + step * RT + lane]) * L[RL_GS + step * RT + lane];
                MIX[t * D + 512 + c] = (bf16)f2bf(o); }
            LDS_WAIT(); __syncthreads();
        }
#undef RW_RAW
    }
}
__device__ __forceinline__ void phase_l1prep(Frame& F, const Args& a, int hb) {
    unsigned char* ws = F.ws; const bf16* XM = (const bf16*)(ws + WS_XM); bf16* XC = (bf16*)(ws + WS_XC); bf16* Q = (bf16*)(ws + WS_Q); bf16* K = (bf16*)(ws + WS_K); bf16* V = (bf16*)(ws + WS_V);
    float* GI = (float*)(ws + WS_GI); const float* W12 = (const float*)(ws + WS_W12);
    const float* cw = a.in[19]; const float* cb = a.in[20]; const float* wq = a.in[21]; const float* wk = a.in[22]; const float* wv = a.in[23]; const float* b_i = a.in[25]; const float* b_f = a.in[26];
    const int g = F.tid, lane = F.lane, w = F.wave; LAS float* red = (LAS float*)F.lds;
    float cwr[4][4], cbr[4], wqr[16], wkr[16], wvr[16], w1[32], w2[32];
#pragma unroll
    for (int j = 0; j < 4; ++j)
#pragma unroll
        for (int i = 0; i < 4; ++i) cwr[j][i] = cw[j * CI + 4 * g + i];
#pragma unroll
    for (int i = 0; i < 4; ++i) cbr[i] = cb[4 * g + i];
#pragma unroll
    for (int i = 0; i < 16; ++i) { wqr[i] = wq[g * 16 + i]; wkr[i] = wk[g * 16 + i]; wvr[i] = wv[g * 16 + i]; }
#pragma unroll
    for (int i = 0; i < 32; ++i) { w1[i] = W12[(size_t)(4 * g) * 8 + i]; w2[i] = W12[(size_t)(2048 + 4 * g) * 8 + i]; }
    float wqk[16];
#pragma unroll
    for (int i = 0; i < 4; ++i)
#pragma unroll
        for (int ip = 0; ip < 4; ++ip) { float sacc = 0.f;
#pragma unroll
            for (int m = 0; m < 4; ++m) sacc = fmaf(wqr[4 * i + m], wkr[4 * ip + m], sacc);
            wqk[4 * i + ip] = sacc * 0.044194173824159216f; }
    const int per = TH / F.G;
    const int tb = F.bid * per;
    float x0[4], x1[4], x2[4];
    { const int sl = tb & (SEQ - 1);
#pragma unroll
      for (int i = 0; i < 4; ++i) { x0[i] = 0.f; x1[i] = 0.f; x2[i] = 0.f; }
      if (sl >= 1) { const v2u r = *(const v2u*)(XM + (size_t)(tb - 1) * CI + 4 * g); x2[0] = bflo(r.x); x2[1] = bfhi(r.x); x2[2] = bflo(r.y); x2[3] = bfhi(r.y); }
      if (sl >= 2) { const v2u r = *(const v2u*)(XM + (size_t)(tb - 2) * CI + 4 * g); x1[0] = bflo(r.x); x1[1] = bfhi(r.x); x1[2] = bflo(r.y); x1[3] = bfhi(r.y); }
      if (sl >= 3) { const v2u r = *(const v2u*)(XM + (size_t)(tb - 3) * CI + 4 * g); x0[0] = bflo(r.x); x0[1] = bfhi(r.x); x0[2] = bflo(r.y); x0[3] = bfhi(r.y); } }
    constexpr int L1PF = 4;
    v2u xq[L1PF][2];
#pragma unroll
    for (int pq = 0; pq < L1PF; ++pq)
#pragma unroll
        for (int tk = 0; tk < 2; ++tk) xq[pq][tk] = *(const v2u*)(XM + (size_t)(tb + 2 * pq + tk) * CI + 4 * g);
    for (int n4 = 0; n4 < per / 2; ++n4) { const int t4 = tb + 2 * n4;
        float gs[16]; v2u xr[2];
        xr[0] = xq[0][0]; xr[1] = xq[0][1];
#pragma unroll
        for (int pq = 0; pq + 1 < L1PF; ++pq) { xq[pq][0] = xq[pq + 1][0]; xq[pq][1] = xq[pq + 1][1]; }
        { const int tn = (n4 + L1PF < per / 2) ? t4 + 2 * L1PF : t4;
#pragma unroll
          for (int tk = 0; tk < 2; ++tk) xq[L1PF - 1][tk] = *(const v2u*)(XM + (size_t)(tn + tk) * CI + 4 * g); }
#pragma unroll
        for (int tk = 0; tk < 2; ++tk) { const int t = t4 + tk;
            float x3[4]; x3[0] = bflo(xr[tk].x); x3[1] = bfhi(xr[tk].x); x3[2] = bflo(xr[tk].y); x3[3] = bfhi(xr[tk].y);
            float xc[4], q[4];
#pragma unroll
            for (int i = 0; i < 4; ++i) { const float s = fmaf(cwr[3][i], x3[i], fmaf(cwr[2][i], x2[i], fmaf(cwr[1][i], x1[i], fmaf(cwr[0][i], x0[i], cbr[i])))); xc[i] = s * sigm(s); }
#pragma unroll
            for (int j = 0; j < 4; ++j) q[j] = fmaf(xc[3], wqk[12 + j], fmaf(xc[2], wqk[8 + j], fmaf(xc[1], wqk[4 + j], xc[0] * wqk[j])));
#pragma unroll
            for (int o = 0; o < 8; ++o) { float s = 0.f;
#pragma unroll
                for (int i = 0; i < 4; ++i) s = fmaf(x3[i], w2[i * 8 + o], fmaf(xc[i], w1[i * 8 + o], s));
                gs[tk * 8 + o] = s; }
            const size_t off = (size_t)t * CI + 4 * g;
            { v2u o; o.x = pk2(xc[0], xc[1]); o.y = pk2(xc[2], xc[3]); *(v2u*)(XC + off) = o; o.x = pk2(q[0], q[1]); o.y = pk2(q[2], q[3]); *(v2u*)(Q + off) = o; }
#pragma unroll
            for (int i = 0; i < 4; ++i) { x0[i] = x1[i]; x1[i] = x2[i]; x2[i] = x3[i]; } }
#define L1_STAGE(mask, n) { const bool hi_ = (lane & (mask)) != 0; _Pragma("unroll") for (int i = 0; i < (n) / 2; ++i) { const float send_ = hi_ ? gs[i] : gs[(n) / 2 + i]; const float keep_ = hi_ ? gs[(n) / 2 + i] : gs[i]; gs[i] = keep_ + __shfl_xor(send_, (mask)); } }
        L1_STAGE(32, 16) L1_STAGE(16, 8) L1_STAGE(8, 4) L1_STAGE(4, 2)
#undef L1_STAGE
        gs[0] += __shfl_xor(gs[0], 2); gs[0] += __shfl_xor(gs[0], 1);
        LAS float* rp = red + (n4 & 1) * 128;
        if ((lane & 3) == 0) rp[w * 16 + (lane >> 2)] = gs[0];
        LDS_WAIT(); __syncthreads();
        if (F.tid < 16) { float s = 0.f;
#pragma unroll
            for (int ww = 0; ww < 8; ++ww) s += rp[ww * 16 + F.tid];
            const int o = F.tid & 7; GI[(size_t)(t4 + (F.tid >> 3)) * 8 + o] = s + (o < 4 ? b_i[o] : b_f[o - 4]); }
    }
}
__device__ __forceinline__ void phase_gatescan(Frame& F) {
    unsigned char* ws = F.ws; const float* GI = (const float*)(ws + WS_GI); float* GA = (float*)(ws + WS_GA); float* GAM = (float*)(ws + WS_GAM); float* GEM = (float*)(ws + WS_GEM);
    const int lane = F.lane, w = F.wave, tid = F.tid; LAS float* wtot = (LAS float*)F.lds;
    for (int sq = F.bid; sq < (NB / 2) * 4; sq += F.G) { const int bl = sq >> 2, h = sq & 3; const size_t tq = (size_t)bl * SEQ + 4 * tid;
        float ip[4], c[4];
#pragma unroll
        for (int k = 0; k < 4; ++k) { ip[k] = GI[(tq + k) * 8 + h]; c[k] = -softplusf_(-GI[(tq + k) * 8 + 4 + h]); }
        c[1] += c[0]; c[2] += c[1]; c[3] += c[2];
        float inc = c[3];
#pragma unroll
        for (int o = 1; o < 64; o <<= 1) { const float n = __shfl_up(inc, o); if (lane >= o) inc += n; }
        if (lane == 63) wtot[w] = inc;
        LDS_WAIT(); __syncthreads();
        float off = inc - c[3];
#pragma unroll
        for (int ww = 0; ww < 8; ++ww) if (ww < w) off += wtot[ww];
        float Fv[4], av[4], m[4];
#pragma unroll
        for (int k = 0; k < 4; ++k) { Fv[k] = off + c[k]; av[k] = ip[k] - Fv[k]; }
        m[0] = av[0]; m[1] = fmaxf(m[0], av[1]); m[2] = fmaxf(m[1], av[2]); m[3] = fmaxf(m[2], av[3]);
        float incm = m[3];
#pragma unroll
        for (int o = 1; o < 64; o <<= 1) { const float n = __shfl_up(incm, o); if (lane >= o) incm = fmaxf(incm, n); }
        if (lane == 63) wtot[8 + w] = incm;
        LDS_WAIT(); __syncthreads();
        float offm = __shfl_up(incm, 1); if (lane == 0) offm = -INFINITY;
#pragma unroll
        for (int ww = 0; ww < 8; ++ww) if (ww < w) offm = fmaxf(offm, wtot[8 + ww]);
#pragma unroll
        for (int k = 0; k < 4; ++k) { const float A = fmaxf(offm, m[k]); GA[(tq + k) * 4 + h] = av[k]; GAM[(tq + k) * 4 + h] = A; GEM[(tq + k) * 4 + h] = __expf(-(Fv[k] + A)); }
        LDS_WAIT(); __syncthreads();
    }
}
constexpr int ML_PITCH = 1040, ML_TILE = 32 * ML_PITCH, ML_PP = 80, ML_PT = 64 * ML_PP;
constexpr int ML_K = 0, ML_V = 2 * ML_TILE, ML_P = 4 * ML_TILE, ML_DEN = ML_P + 2 * ML_PT, ML_AT = ML_DEN + 512, ML_AS = ML_AT + 256, ML_END = ML_AS + 8192;
constexpr int ML_ST = ML_P, ML_MR = ML_P + 4096;
static_assert(ML_MR + 512 <= ML_DEN, "mLSTM LDS tables");
static_assert(ML_END <= MISC_OFF, "mLSTM LDS");
__device__ __forceinline__ void tr_read_v4(unsigned a, bf16x8 (&vf)[4]) { s16x4 l0, h0, l1, h1, l2, h2, l3, h3;
    asm volatile("ds_read_b64_tr_b16 %0, %8\n\tds_read_b64_tr_b16 %1, %8 offset:4160\n\tds_read_b64_tr_b16 %2, %8 offset:32\n\tds_read_b64_tr_b16 %3, %8 offset:4192\n\t"
                 "ds_read_b64_tr_b16 %4, %8 offset:64\n\tds_read_b64_tr_b16 %5, %8 offset:4224\n\tds_read_b64_tr_b16 %6, %8 offset:96\n\tds_read_b64_tr_b16 %7, %8 offset:4256\n\ts_waitcnt lgkmcnt(0)"
                 : "=&v"(l0), "=&v"(h0), "=&v"(l1), "=&v"(h1), "=&v"(l2), "=&v"(h2), "=&v"(l3), "=&v"(h3) : "v"(a) : "memory");
    vf[0] = (bf16x8){l0[0], l0[1], l0[2], l0[3], h0[0], h0[1], h0[2], h0[3]}; vf[1] = (bf16x8){l1[0], l1[1], l1[2], l1[3], h1[0], h1[1], h1[2], h1[3]};
    vf[2] = (bf16x8){l2[0], l2[1], l2[2], l2[3], h2[0], h2[1], h2[2], h2[3]}; vf[3] = (bf16x8){l3[0], l3[1], l3[2], l3[3], h3[0], h3[1], h3[2], h3[3]}; }
static_assert(4 * ML_PITCH == 4160, "tr_read_v4 offsets");
__device__ __forceinline__ void tr_read_v8(unsigned a, bf16x8 (&vf)[8]) { s16x4 l0, h0, l1, h1, l2, h2, l3, h3, l4, h4, l5, h5, l6, h6, l7, h7;
    asm volatile("ds_read_b64_tr_b16 %0, %16\n\tds_read_b64_tr_b16 %1, %16 offset:4160\n\tds_read_b64_tr_b16 %2, %16 offset:32\n\tds_read_b64_tr_b16 %3, %16 offset:4192\n\t"
                 "ds_read_b64_tr_b16 %4, %16 offset:64\n\tds_read_b64_tr_b16 %5, %16 offset:4224\n\tds_read_b64_tr_b16 %6, %16 offset:96\n\tds_read_b64_tr_b16 %7, %16 offset:4256\n\t"
                 "ds_read_b64_tr_b16 %8, %16 offset:128\n\tds_read_b64_tr_b16 %9, %16 offset:4288\n\tds_read_b64_tr_b16 %10, %16 offset:160\n\tds_read_b64_tr_b16 %11, %16 offset:4320\n\t"
                 "ds_read_b64_tr_b16 %12, %16 offset:192\n\tds_read_b64_tr_b16 %13, %16 offset:4352\n\tds_read_b64_tr_b16 %14, %16 offset:224\n\tds_read_b64_tr_b16 %15, %16 offset:4384\n\ts_waitcnt lgkmcnt(0)"
                 : "=&v"(l0), "=&v"(h0), "=&v"(l1), "=&v"(h1), "=&v"(l2), "=&v"(h2), "=&v"(l3), "=&v"(h3), "=&v"(l4), "=&v"(h4), "=&v"(l5), "=&v"(h5), "=&v"(l6), "=&v"(h6), "=&v"(l7), "=&v"(h7) : "v"(a) : "memory");
    vf[0] = (bf16x8){l0[0], l0[1], l0[2], l0[3], h0[0], h0[1], h0[2], h0[3]}; vf[1] = (bf16x8){l1[0], l1[1], l1[2], l1[3], h1[0], h1[1], h1[2], h1[3]};
    vf[2] = (bf16x8){l2[0], l2[1], l2[2], l2[3], h2[0], h2[1], h2[2], h2[3]}; vf[3] = (bf16x8){l3[0], l3[1], l3[2], l3[3], h3[0], h3[1], h3[2], h3[3]};
    vf[4] = (bf16x8){l4[0], l4[1], l4[2], l4[3], h4[0], h4[1], h4[2], h4[3]}; vf[5] = (bf16x8){l5[0], l5[1], l5[2], l5[3], h5[0], h5[1], h5[2], h5[3]};
    vf[6] = (bf16x8){l6[0], l6[1], l6[2], l6[3], h6[0], h6[1], h6[2], h6[3]}; vf[7] = (bf16x8){l7[0], l7[1], l7[2], l7[3], h7[0], h7[1], h7[2], h7[3]}; }
struct PvOps { bf16x8 p0, p1, p2, p3; s16x4 l0, h0, l1, h1, l2, h2, l3, h3, l4, h4, l5, h5, l6, h6, l7, h7; };
__device__ __forceinline__ void pv_issue(unsigned pa, unsigned va, PvOps& o) {
    asm volatile("ds_read_b128 %0, %20\n\tds_read_b128 %1, %20 offset:1280\n\tds_read_b128 %2, %20 offset:2560\n\tds_read_b128 %3, %20 offset:3840\n\t"
                 "ds_read_b64_tr_b16 %4, %21\n\tds_read_b64_tr_b16 %5, %21 offset:4160\n\tds_read_b64_tr_b16 %6, %21 offset:32\n\tds_read_b64_tr_b16 %7, %21 offset:4192\n\t"
                 "ds_read_b64_tr_b16 %8, %21 offset:64\n\tds_read_b64_tr_b16 %9, %21 offset:4224\n\tds_read_b64_tr_b16 %10, %21 offset:96\n\tds_read_b64_tr_b16 %11, %21 offset:4256\n\t"
                 "ds_read_b64_tr_b16 %12, %21 offset:128\n\tds_read_b64_tr_b16 %13, %21 offset:4288\n\tds_read_b64_tr_b16 %14, %21 offset:160\n\tds_read_b64_tr_b16 %15, %21 offset:4320\n\t"
                 "ds_read_b64_tr_b16 %16, %21 offset:192\n\tds_read_b64_tr_b16 %17, %21 offset:4352\n\tds_read_b64_tr_b16 %18, %21 offset:224\n\tds_read_b64_tr_b16 %19, %21 offset:4384"
                 : "=&v"(o.p0), "=&v"(o.p1), "=&v"(o.p2), "=&v"(o.p3), "=&v"(o.l0), "=&v"(o.h0), "=&v"(o.l1), "=&v"(o.h1), "=&v"(o.l2), "=&v"(o.h2), "=&v"(o.l3), "=&v"(o.h3),
                   "=&v"(o.l4), "=&v"(o.h4), "=&v"(o.l5), "=&v"(o.h5), "=&v"(o.l6), "=&v"(o.h6), "=&v"(o.l7), "=&v"(o.h7) : "v"(pa), "v"(va) : "memory"); }
#define pv_wait(o_) do { __builtin_amdgcn_sched_barrier(0); asm volatile("s_waitcnt lgkmcnt(0)" ::: "memory"); __builtin_amdgcn_sched_barrier(0); } while (0)
#define PV_CAT(l_, h_) ((bf16x8){(l_)[0], (l_)[1], (l_)[2], (l_)[3], (h_)[0], (h_)[1], (h_)[2], (h_)[3]})
static_assert(16 * ML_PP == 1280, "pv_issue offsets");
template <int PB> __device__ __forceinline__ void phase_mlstm_t(Frame& F, const Args& a) {
    constexpr bool skK = PB & 1, skV = PB & 2, skS = PB & 4, skP = PB & 8, skE = PB & 16;
    unsigned char* ws = F.ws; const bf16* Q = (const bf16*)(ws + WS_Q); const bf16* K = (const bf16*)(ws + WS_XC); const bf16* V = (const bf16*)(ws + WS_XM); const bf16* XC = (const bf16*)(ws + WS_XC); const bf16* Z = (const bf16*)(ws + WS_Z);
    bf16* YC = (bf16*)(ws + WS_V); const float* GA = (const float*)(ws + WS_GA); const float* GAM = (const float*)(ws + WS_GAM); const float* GEM = (const float*)(ws + WS_GEM);
    const float* mh_g = a.in[27]; const float* skip = a.in[28]; const float* wvp = a.in[23];
    const int tid = F.tid, lane = F.lane, w = F.wave, fr = lane & 15, fq = lane >> 4; LAS unsigned char* lds = F.lds;
    LAS float* den2 = (LAS float*)(lds + ML_DEN); LAS float* stats = (LAS float*)(lds + ML_ST); LAS float* mr = (LAS float*)(lds + ML_MR); LAS float* em_s = (LAS float*)(lds + ML_AT); LAS float* as_s = (LAS float*)(lds + ML_AS);
    const int st = w & 1, tp = (w >> 1) & 1, wv = w & 3;
    const unsigned vtr_lane = (unsigned)((8 * fq + ((lane & 15) >> 2)) * ML_PITCH + (128 * wv + 4 * (lane & 3)) * 2);
#define ML_DMA(gbase, tile_off) do { _Pragma("unroll") for (int r4 = 0; r4 < 4; ++r4) { const int rr = w + 8 * r4; \
        __builtin_amdgcn_global_load_lds((const unsigned*)((gbase) + (size_t)rr * CI + lane * 8), (LAS unsigned*)(lds + (tile_off) + rr * ML_PITCH), 16, 0, 0); } } while (0)
#define ML_STEP_HEAD() const int buf = k & 1; int j = k + jstart; if (j >= nk) j -= nk; int jn = j + 1; if (jn >= nk) jn -= nk; \
        asm volatile("s_waitcnt vmcnt(0) lgkmcnt(0)" ::: "memory"); __builtin_amdgcn_s_barrier(); asm volatile("" ::: "memory"); \
        if (k + 1 < nk && !skK) ML_DMA(Kb + (size_t)(32 * jn) * CI, ML_K + (buf ^ 1) * ML_TILE); \
        if (k < nk && !skV) ML_DMA(Vb + (size_t)(32 * j) * CI, ML_V + buf * ML_TILE)
    for (int r = 0; r < 8; ++r) { const int xcd = F.bid & 7, cq = F.bid >> 3, c16 = cq & 15; if (F.G != 256) break;
        const int part = r & 1, qi = part ? 31 - c16 : c16, bh = xcd + 8 * ((cq >> 4) + 2 * (r >> 1)), bl = bh >> 2, h = bh & 3; const size_t t0 = (size_t)bl * SEQ + 64 * qi; const int nk = 2 * (qi + 1), jstart = part ? 2 * (c16 + 1) : 0;
        const bf16* Kb = K + (size_t)bl * SEQ * CI + h * 512; const bf16* Vb = V + (size_t)bl * SEQ * CI + h * 512;
        ML_DMA(Kb + (size_t)(32 * jstart) * CI, ML_K);
        float tb_e, tb_a[4];
        tb_e = GEM[(t0 + (tid & 63)) * 4 + h];
#pragma unroll
        for (int i4 = 0; i4 < 4; ++i4) tb_a[i4] = GA[((size_t)bl * SEQ + tid + 512 * i4) * 4 + h];
#define ML_TABLES() do { if (tid < 64) em_s[tid] = tb_e; _Pragma("unroll") for (int i4 = 0; i4 < 4; ++i4) { const int sidx = tid + 512 * i4; if (sidx < 64 * (qi + 1)) as_s[sidx] = tb_a[i4] * LOG2E; } } while (0)
        const int c8 = lane * 8, cc = h * 512 + c8;
#define ML_EPI_LOADS(N, ROW0) v4u zr[N], xr[N]; float gm[8], sk[8]; asm volatile("" ::: "memory"); __builtin_amdgcn_sched_barrier(0); if (!skE) { _Pragma("unroll") for (int k8 = 0; k8 < N; ++k8) { const size_t off = (t0 + (ROW0) + k8) * CI + cc; zr[k8] = *(const v4u*)(Z + off); xr[k8] = *(const v4u*)(XC + off); } \
        _Pragma("unroll") for (int q = 0; q < 8; ++q) { gm[q] = mh_g[cc + q]; sk[q] = skip[cc + q]; } }
#define ML_EPI_PASS(N, ROW0) if (!skE) { const LAS float* ytile = (const LAS float*)lds; _Pragma("unroll") for (int k8 = 0; k8 < N; ++k8) { const int row = (ROW0) + k8; const size_t off = (t0 + row) * CI + cc; \
              const f32x4 y0 = *(const LAS f32x4*)(ytile + row * 516 + c8), y1 = *(const LAS f32x4*)(ytile + row * 516 + c8 + 4); float zf[8], xf[8], o[8]; unpack8(zr[k8], zf); unpack8(xr[k8], xf); \
              float s1 = ((y0[0] + y0[1]) + (y0[2] + y0[3])) + ((y1[0] + y1[1]) + (y1[2] + y1[3])), s2 = ((y0[0] * y0[0] + y0[1] * y0[1]) + (y0[2] * y0[2] + y0[3] * y0[3])) + ((y1[0] * y1[0] + y1[1] * y1[1]) + (y1[2] * y1[2] + y1[3] * y1[3])); \
              s1 = wave_sum(s1); s2 = wave_sum(s2); const float mean = s1 * (1.f / 512.f), rstd = rsqrtf(fmaxf(s2 * (1.f / 512.f) - mean * mean, 0.f) + 1e-5f); \
              _Pragma("unroll") for (int q = 0; q < 8; ++q) { const float yv = ((q < 4 ? y0[q & 3] : y1[q & 3]) - mean) * rstd; o[q] = (yv * gm[q] + sk[q] * xf[q]) * (zf[q] * sigm(zf[q])); } \
              *(v4u*)(YC + off) = pack8(o); } }
        if (w < 4) {
            bf16x8 qf[2][16];
            { const bf16* qp = Q + (t0 + 32 * tp + fr) * CI + h * 512 + fq * 8;
#pragma unroll
              for (int ks = 0; ks < 16; ++ks) { qf[0][ks] = *(const bf16x8*)(qp + 32 * ks); qf[1][ks] = *(const bf16x8*)(qp + 16 * CI + 32 * ks); } }
            const float At0 = GAM[(t0 + 32 * tp + fr) * 4 + h] * LOG2E, At1 = GAM[(t0 + 32 * tp + 16 + fr) * 4 + h] * LOG2E;
            ML_TABLES();
            float denp0 = 0.f, denp1 = 0.f;
            for (int k = 0; k <= nk; ++k) { ML_STEP_HEAD();
                if (k < nk && !skS) {
                    f32x4 s0a = {0.f, 0.f, 0.f, 0.f}, s0b = {0.f, 0.f, 0.f, 0.f}, s1a = {0.f, 0.f, 0.f, 0.f}, s1b = {0.f, 0.f, 0.f, 0.f};
                    { const LAS unsigned char* kl = lds + ML_K + buf * ML_TILE + (16 * st + fr) * ML_PITCH + fq * 16; bf16x8 kc[4], kn[4];
#pragma unroll
                      for (int q = 0; q < 4; ++q) kc[q] = *(const LAS bf16x8*)(kl + 64 * q);
#pragma unroll
                      for (int g = 0; g < 4; ++g) {
                          if (g < 3) {
#pragma unroll
                              for (int q = 0; q < 4; ++q) kn[q] = *(const LAS bf16x8*)(kl + 64 * (4 * g + 4 + q)); }
                          __builtin_amdgcn_sched_barrier(0);
#pragma unroll
                          for (int q = 0; q < 4; q += 2) { const int ks = 4 * g + q;
                              s0a = __builtin_amdgcn_mfma_f32_16x16x32_bf16(kc[q], qf[0][ks], s0a, 0, 0, 0); s1a = __builtin_amdgcn_mfma_f32_16x16x32_bf16(kc[q], qf[1][ks], s1a, 0, 0, 0);
                              s0b = __builtin_amdgcn_mfma_f32_16x16x32_bf16(kc[q + 1], qf[0][ks + 1], s0b, 0, 0, 0); s1b = __builtin_amdgcn_mfma_f32_16x16x32_bf16(kc[q + 1], qf[1][ks + 1], s1b, 0, 0, 0); }
                          __builtin_amdgcn_sched_barrier(0);
                          if (g < 3) {
#pragma unroll
                              for (int q = 0; q < 4; ++q) kc[q] = kn[q]; } } }
                    s0a += s0b; s1a += s1b;
                    const f32x4 asv = *(const LAS f32x4*)(as_s + 32 * j + 16 * st + 4 * fq); const float as[4] = {asv[0], asv[1], asv[2], asv[3]};
                    float p0[4], p1[4]; const int sbase = 32 * j + 16 * st + 4 * fq, tbase = 64 * qi + 32 * tp + fr;
                    if (32 * j + 31 <= 64 * qi + 32 * tp) {
#pragma unroll
                        for (int i = 0; i < 4; ++i) { p0[i] = s0a[i] * __builtin_amdgcn_exp2f(as[i] - At0); p1[i] = s1a[i] * __builtin_amdgcn_exp2f(as[i] - At1); }
                    } else {
#pragma unroll
                        for (int i = 0; i < 4; ++i) { p0[i] = (sbase + i) <= tbase ? s0a[i] * __builtin_amdgcn_exp2f(as[i] - At0) : 0.f; p1[i] = (sbase + i) <= tbase + 16 ? s1a[i] * __builtin_amdgcn_exp2f(as[i] - At1) : 0.f; } }
                    denp0 += (p0[0] + p0[1]) + (p0[2] + p0[3]); denp1 += (p1[0] + p1[1]) + (p1[2] + p1[3]);
                    { LAS unsigned char* pp = lds + ML_P + buf * ML_PT + (32 * tp + fr) * ML_PP + (16 * st + 4 * fq) * 2; v2u pw; pw.x = pk2(p0[0], p0[1]); pw.y = pk2(p0[2], p0[3]); *(LAS v2u*)pp = pw;
                      pw.x = pk2(p1[0], p1[1]); pw.y = pk2(p1[2], p1[3]); *(LAS v2u*)(pp + 16 * ML_PP) = pw; }
                } }
            ML_EPI_LOADS(12, 12 * w);
            { float wt[8];
#pragma unroll
              for (int u = 0; u < 8; ++u) { const int col = 2 * tid + (u >> 2); wt[u] = wvp[(size_t)(h * 128 + (col >> 2)) * 16 + 4 * (u & 3) + (col & 3)]; }
              *(LAS f32x4*)(as_s + 8 * tid) = (f32x4){wt[0], wt[1], wt[2], wt[3]}; *(LAS f32x4*)(as_s + 8 * tid + 4) = (f32x4){wt[4], wt[5], wt[6], wt[7]}; }
            { float d0 = denp0, d1 = denp1; d0 += __shfl_xor(d0, 16); d1 += __shfl_xor(d1, 16); d0 += __shfl_xor(d0, 32); d1 += __shfl_xor(d1, 32);
              if (fq == 0) { den2[st * 64 + 32 * tp + fr] = d0; den2[st * 64 + 32 * tp + 16 + fr] = d1; } }
            LDS_WAIT(); __builtin_amdgcn_s_barrier(); asm volatile("" ::: "memory");
            __builtin_amdgcn_s_barrier(); asm volatile("" ::: "memory");
            ML_EPI_PASS(12, 12 * w)
        } else {
            f32x4 O[4][8];
#pragma unroll
            for (int i = 0; i < 4; ++i)
#pragma unroll
                for (int e = 0; e < 8; ++e) O[i][e] = (f32x4){0.f, 0.f, 0.f, 0.f};
            ML_TABLES();
            bf16x8 pH[4], vH[2];
#pragma unroll
            for (int i = 0; i < 4; ++i) { pH[i] = (bf16x8){0, 0, 0, 0, 0, 0, 0, 0}; vH[i & 1] = (bf16x8){0, 0, 0, 0, 0, 0, 0, 0}; }
            for (int k = 0; k <= nk; ++k) { ML_STEP_HEAD();
                if (!skP) { PvOps o;
                    if (k >= 1) pv_issue((unsigned)(size_t)(lds + ML_P + (buf ^ 1) * ML_PT + fr * ML_PP + fq * 16), (unsigned)(size_t)(lds + ML_V + (buf ^ 1) * ML_TILE) + vtr_lane, o);
                    __builtin_amdgcn_sched_barrier(0);
                    if (k >= 2) {
#pragma unroll
                        for (int i = 0; i < 4; ++i)
#pragma unroll
                            for (int e = 0; e < 2; ++e) O[i][6 + e] = __builtin_amdgcn_mfma_f32_16x16x32_bf16(pH[i], vH[e], O[i][6 + e], 0, 0, 0); }
                    if (k >= 1) { pv_wait(o);
                        const bf16x8 pf[4] = {o.p0, o.p1, o.p2, o.p3}; const bf16x8 va[6] = {PV_CAT(o.l0, o.h0), PV_CAT(o.l1, o.h1), PV_CAT(o.l2, o.h2), PV_CAT(o.l3, o.h3), PV_CAT(o.l4, o.h4), PV_CAT(o.l5, o.h5)};
#pragma unroll
                        for (int i = 0; i < 4; ++i)
#pragma unroll
                            for (int e = 0; e < 6; ++e) O[i][e] = __builtin_amdgcn_mfma_f32_16x16x32_bf16(pf[i], va[e], O[i][e], 0, 0, 0);
#pragma unroll
                        for (int i = 0; i < 4; ++i) pH[i] = pf[i];
                        vH[0] = PV_CAT(o.l6, o.h6); vH[1] = PV_CAT(o.l7, o.h7); } } }
            if (!skP) {
#pragma unroll
                for (int i = 0; i < 4; ++i)
#pragma unroll
                    for (int e = 0; e < 2; ++e) O[i][6 + e] = __builtin_amdgcn_mfma_f32_16x16x32_bf16(pH[i], vH[e], O[i][6 + e], 0, 0, 0); }
            LDS_WAIT(); __builtin_amdgcn_s_barrier(); asm volatile("" ::: "memory");
            { const LAS float* den_q = den2 + 4 * fq; const LAS float* em_q = em_s + 4 * fq; LAS float* yt_q = (LAS float*)lds + 4 * fq * 516 + 128 * wv + fr; float inv[16];
#pragma unroll
              for (int i = 0; i < 4; ++i)
#pragma unroll
                for (int jj = 0; jj < 4; ++jj) { const float dn = den_q[16 * i + jj] + den_q[64 + 16 * i + jj]; inv[4 * i + jj] = 1.0f / fmaxf(fabsf(dn), em_q[16 * i + jj]); }
#pragma unroll
              for (int e = 0; e < 8; ++e) { const f32x4 wl = *(const LAS f32x4*)(as_s + (128 * wv + 16 * e + fr) * 4);
#pragma unroll
                for (int i = 0; i < 4; ++i)
#pragma unroll
                    for (int jj = 0; jj < 4; ++jj) { const float x = O[i][e][jj] * inv[4 * i + jj];
                        yt_q[(16 * i + jj) * 516 + 16 * e] = fmaf(DPP_MOVF(x, 0xFF), wl[3], fmaf(DPP_MOVF(x, 0xAA), wl[2], fmaf(DPP_MOVF(x, 0x55), wl[1], DPP_MOVF(x, 0x00) * wl[0]))); } } }
            LDS_WAIT(); __builtin_amdgcn_s_barrier(); asm volatile("" ::: "memory");
            ML_EPI_LOADS(4, 48 + 4 * wv);
            ML_EPI_PASS(4, 48 + 4 * wv)
        }
        VM_WAIT(); __syncthreads();
    }
#undef ML_DMA
#undef ML_STEP_HEAD
#undef ML_TABLES
#undef ML_EPI_LOADS
#undef ML_EPI_PASS
}
__device__ __forceinline__ void phase_mlstm(Frame& F, const Args& a) { phase_mlstm_t<0>(F, a); }
#ifdef ML_PROBE
__device__ __forceinline__ void phase_mlstm_probe(Frame& F, const Args& a) { phase_mlstm_t<ML_PROBE>(F, a); }
#endif

#ifdef ML_DMAPROBE
__device__ __forceinline__ void phase_mlstm_dmaprobe(Frame& F, const Args& a) {
    unsigned char* ws = F.ws; const bf16* K = (const bf16*)(ws + WS_K); const bf16* V = (const bf16*)(ws + WS_V);
    const int lane = F.lane, w = F.wave; LAS unsigned char* lds = F.lds;
#define MLP_DMA(gbase, tile_off) do { _Pragma("unroll") for (int r4 = 0; r4 < 4; ++r4) { const int rr = w + 8 * r4; \
        __builtin_amdgcn_global_load_lds((const unsigned*)((gbase) + (size_t)rr * CI + lane * 8), (LAS unsigned*)(lds + (tile_off) + rr * ML_PITCH), 16, 0, 0); } } while (0)
    for (int r = 0; r < 8; ++r) { const int xcd = F.bid & 7, cq = F.bid >> 3, c16 = cq & 15; if (F.G != 256) break;
        const int part = r & 1, qi = part ? 31 - c16 : c16, bh = xcd + 8 * ((cq >> 4) + 2 * (r >> 1)), bl = bh >> 2, h = bh & 3; const int nk = 2 * (qi + 1), jstart = part ? 2 * (c16 + 1) : 0;
        const bf16* Kb = K + (size_t)bl * SEQ * CI + h * 512; const bf16* Vb = V + (size_t)bl * SEQ * CI + h * 512;
        for (int k = 0; k <= nk; ++k) { const int buf = k & 1; int j = k + jstart; if (j >= nk) j -= nk; int jn = j + 1; if (jn >= nk) jn -= nk;
            asm volatile("s_waitcnt vmcnt(0) lgkmcnt(0)" ::: "memory"); __builtin_amdgcn_s_barrier(); asm volatile("" ::: "memory");
            if ((ML_DMAPROBE & 1) && k + 1 < nk) MLP_DMA(Kb + (size_t)(32 * jn) * CI, ML_K + (buf ^ 1) * ML_TILE);
            if ((ML_DMAPROBE & 2) && k < nk) MLP_DMA(Vb + (size_t)(32 * j) * CI, ML_V + buf * ML_TILE);
        }
        VM_WAIT(); __syncthreads();
    }
#undef MLP_DMA
}
#endif
#ifdef ML_DMAPROBE
#define ML_PROBE_CALL phase_mlstm_dmaprobe(F, args);
#elif defined(ML_PROBE)
#define ML_PROBE_CALL phase_mlstm_probe(F, args);
#else
#define ML_PROBE_CALL
#endif
#define GEMM_PHASE(EPI, Aptr, Bptr, M_, N_, K_, ...) do { pg8::Gemm g{(const pg8::bf16_t*)(Aptr), (const pg8::bf16_t*)(Bptr), (M_), (N_), (K_)}; pg8::StaticOrder So; So.init((M_), (N_), F.G, F.bid); \
        pg8::EPI Ep{__VA_ARGS__}; pg8::gemm_phase<pg8::EPI, pg8::StaticOrder, PG8_ALIGN, PG8_SP2>(F.lds, g, So, Ep); } while (0)
namespace pg8 { typedef EpiRes2<float> EpiResF; typedef EpiRes2<bf16_t> EpiResB; typedef EpiPle2<false> EpiPleB; typedef EpiPle2<true> EpiPleF; }
__global__ void __launch_bounds__(NWAVES * 64, 2) trunk_fwd(Args args) {
    extern __shared__ __attribute__((aligned(16))) unsigned char lds_raw[];
    Frame F; F.lds = (LAS unsigned char*)lds_raw; F.ws = args.ws; F.in = nullptr;
    F.tid = threadIdx.x; F.lane = F.tid & 63; F.wave = __builtin_amdgcn_readfirstlane(F.tid >> 6); F.G = gridDim.x; F.bid = blockIdx.x;
    volatile LAS unsigned* MISC = (volatile LAS unsigned*)(F.lds + MISC_OFF);
    if (F.tid < 64) MISC[F.tid] = 0u;
    __syncthreads();
    XcdBarrier bar; bar.bar = (unsigned*)(args.ws + WS_CTL) + CW_BAR; bar.x = 0; bar.st = nullptr;
    if (args.use_bar) bar = xcd_barrier_post((unsigned*)(args.ws + WS_CTL) + CW_BAR, MISC + 8);
    unsigned* xrank = (unsigned*)(args.ws + WS_CTL) + CW_XRANK; const unsigned my_xcc = xb_xcc_id();
    if (args.use_bar && F.tid == 0) MISC[12] = xb_add(&xrank[64 * my_xcc], 1u);
    const int lo = args.ph_lo, hi = args.ph_hi;
#ifndef ONLY_SITE
#define ONLY_SITE -1
#endif
#define EN(n) (ONLY_SITE < 0 || ONLY_SITE == (n))
#ifndef REP_MASK
#define REP_MASK 0u
#endif
#define NREP(n) (((REP_MASK >> (n)) & 1u) ? 2 : 1)
#define IN(k) (lo <= (k) && (k) < hi)
#define SEAM(k) do { if (IN(k) && IN((k) + 1)) xcd_barrier(bar); } while (0)
    unsigned char* ws = args.ws; float* out = args.out;
    float* RS = (float*)(ws + WS_RS);
#define RSN(i) (RS + (size_t)(i) * T * 16)
#define PH(site, k, ...) if (EN(site) && IN(k)) { for (int rep_ = 0; rep_ < NREP(site); ++rep_) { if (rep_) xcd_barrier(bar); __VA_ARGS__ } } SEAM(k);
    PH(0, 0, phase_prologue(F, args); phase_cast_sq(F, args.in[0], (bf16*)(ws + WS_XB2), RSN(0), T);)
    if (args.use_bar && lo == 0 && hi > 1) {
        bool ok = F.G == 256; for (int x = 0; x < 16; ++x) { const unsigned cx = xb_ld(&xrank[64 * x]); ok = ok && (cx == (x < 8 ? 32u : 0u)); }
        const unsigned rk = MISC[12]; if (ok && rk < 32u && my_xcc < 8u) F.bid = (int)(rk * 8u + my_xcc); }
    PH(2, 1, GEMM_PHASE(EpiBf16SplitR, ws + WS_XB2, ws + WS_WIN, T, NU, D, (pg8::bf16_t*)(ws + WS_UA), UA_W, 4, (pg8::bf16_t*)(ws + WS_UB), UB_W, RSN(0));)
    PH(3, 2, phase_prepA(F, args);)
    PH(4, 3, GEMM_PHASE(EpiBf16Split, ws + WS_LIN, ws + WS_WLORA, T, 1536, 256 + args.pad, (pg8::bf16_t*)(ws + WS_LOUT), 1536, 1 << 20, nullptr, 0);)
    PH(5, 4, phase_indexer(F);)
    PH(6, 5, phase_dsa_attn(F, args);)
    PH(7, 6, phase_rwkv(F, args);)
    PH(8, 7, GEMM_PHASE(EpiResB, ws + WS_XB, ws + WS_WOUT, T, D, D, (const pg8::bf16_t*)(ws + WS_XB2), (pg8::bf16_t*)(ws + WS_XB2), D, RSN(1));)
#define FFN_PLE(L, pb, rs_a, rs_b, rs_c, PLE_EPI, ple_out) do { const size_t lw = (size_t)(L) * WS_LAYER_STRIDE; \
        PH(21, (pb), GEMM_PHASE(EpiSwigluR, ws + WS_XB2, ws + WS_WGU0 + lw, T, 2 * FF, D, (pg8::bf16_t*)(ws + WS_H), FF, RSN(rs_a));) \
        PH(22, (pb) + 1, GEMM_PHASE(EpiResB, ws + WS_H, ws + WS_WD0 + lw, T, D, FF, (const pg8::bf16_t*)(ws + WS_XB2), (pg8::bf16_t*)(ws + WS_XB), D, RSN(rs_b));) \
        PH(24, (pb) + 2, GEMM_PHASE(EpiBf16Split, ws + WS_PB, ws + WS_WPLE0 + lw, T, D, 256 + args.pad, (pg8::bf16_t*)(ws + WS_E), D, 1 << 20, nullptr, 0);) \
        PH(25, (pb) + 3, GEMM_PHASE(PLE_EPI, ws + WS_XB, ws + WS_WPG0 + lw, T, D, D, (const pg8::bf16_t*)(ws + WS_XB), (void*)(ple_out), (const pg8::bf16_t*)(ws + WS_E), D, RSN(rs_b), RSN(rs_c));) } while (0)
#define L1_HALF(hb, p1) do { bf16* xbh = (bf16*)(ws + WS_XB2) + (size_t)(hb) * TH * D; \
        PH(11, (p1), GEMM_PHASE(EpiBf16SplitR, xbh, ws + WS_WUP, TH, 2 * CI, D, (pg8::bf16_t*)(ws + WS_XM), CI, 8, (pg8::bf16_t*)(ws + WS_Z), CI, RSN(3) + (size_t)(hb) * TH * 16);) \
        PH(12, (p1) + 1, phase_l1prep(F, args, hb);) \
        PH(13, (p1) + 2, phase_gatescan(F); if ((hb) == 0) phase_cvt_p(F, args.in[1] + (size_t)T * 256, (bf16*)(ws + WS_PB));) \
        PH(14, (p1) + 3, ML_PROBE_CALL phase_mlstm(F, args);) \
        PH(15, (p1) + 4, GEMM_PHASE(EpiResB, ws + WS_V, ws + WS_WDOWN, TH, D, CI, (const pg8::bf16_t*)xbh, (pg8::bf16_t*)xbh, D, RSN(4) + (size_t)(hb) * TH * 16);) } while (0)
    FFN_PLE(0, 8, 1, 2, 3, EpiPleB, ws + WS_XB2);
    L1_HALF(0, 12);
    L1_HALF(1, 17);
    FFN_PLE(1, 22, 4, 5, 5, EpiPleF, out);
#undef IN
#undef SEAM
}
constexpr int N_PHASES = 26;

#ifndef MK_ONE_LAUNCH
#define MK_ONE_LAUNCH 1
#endif
extern "C" void kernel_launch(void* const* d_in, const int* in_sizes, int n_in, void* d_out, int out_size, void* d_ws, size_t ws_size, hipStream_t stream) {
    static int grid = 0;
    if (grid == 0) {
        if (n_in != 37 || in_sizes[0] != T * D || out_size != T * D || ws_size < WS_END) { fprintf(stderr, "kernel_launch: unexpected shapes (n_in %d, in0 %d, out %d, ws %zu < %zu); nothing launched\n", n_in, n_in > 0 ? in_sizes[0] : -1, out_size, ws_size, (size_t)WS_END); grid = -1; return; }
        int dev = 0, cus = 0, per_cu = 0;
        if (hipGetDevice(&dev) != hipSuccess || hipDeviceGetAttribute(&cus, hipDeviceAttributeMultiprocessorCount, dev) != hipSuccess) { grid = -1; return; }
        if (hipFuncSetAttribute((const void*)trunk_fwd, hipFuncAttributeMaxDynamicSharedMemorySize, LDS_BYTES) != hipSuccess) { fprintf(stderr, "kernel_launch: hipFuncSetAttribute failed\n"); grid = -1; return; }
        if (hipOccupancyMaxActiveBlocksPerMultiprocessor(&per_cu, (const void*)trunk_fwd, NWAVES * 64, LDS_BYTES) != hipSuccess || per_cu < 1) { fprintf(stderr, "kernel_launch: occupancy query says %d\n", per_cu); }
        (void)hipGetLastError();
        grid = cus;
        if (grid != 256) { fprintf(stderr, "kernel_launch: built for 256 CUs, found %d; nothing launched\n", cus); grid = -1; return; }
    }
    if (grid < 0) return;
    if (hipMemsetAsync((char*)d_ws + WS_CTL, 0, CTL_ZERO_BYTES, stream) != hipSuccess) return;
    Args a{};
    for (int i = 0; i < 37; ++i) a.in[i] = (const float*)d_in[i];
    a.out = (float*)d_out; a.ws = (unsigned char*)d_ws; a.pad = 0;
#if MK_ONE_LAUNCH
    a.ph_lo = 0; a.ph_hi = N_PHASES; a.use_bar = 1;
    hipLaunchKernelGGL(trunk_fwd, dim3(grid), dim3(NWAVES * 64), LDS_BYTES, stream, a);
#else
    for (int p = 0; p < N_PHASES; ++p) { a.ph_lo = p; a.ph_hi = p + 1; a.use_bar = 0; hipLaunchKernelGGL(trunk_fwd, dim3(grid), dim3(NWAVES * 64), LDS_BYTES, stream, a); }
#endif
}
```
